# Optimizing an MI355X kernel written in HIP

```python
import jax, jax.numpy as jnp
from jax import lax
import numpy as np

D_MODEL = 2048
BATCH = 4
SEQ = 4096
DEPTH = 2

GRID_W = 64
CTX_LEN = 256
HEAD_DIM = 128
ROPE_THETA = 10000.0
BLOCK = 128
A_HEADS = 8
A_KV_HEADS = 2
A_GROUP = A_HEADS // A_KV_HEADS
B_HEADS = 8
B_Q_RANK = 512
B_KV_RANK = 256
B_NOPE = 128
B_ROPE = 64
B_VDIM = 128
B_QK = B_NOPE + B_ROPE
C_CH = 1024
CONV_K = 31
D_HEADS = 8
D_KV_HEADS = 2
D_GROUP = D_HEADS // D_KV_HEADS
WINDOW = 128
N_BRANCH = 4
A_W = A_HEADS * HEAD_DIM
A_KV_W = A_KV_HEADS * HEAD_DIM
B_W = B_HEADS * B_VDIM
D_W = D_HEADS * HEAD_DIM
D_KV_W = D_KV_HEADS * HEAD_DIM
OFF_AK = 0
OFF_AV = OFF_AK + A_KV_W
OFF_BCKV = OFF_AV + A_KV_W
OFF_BKR = OFF_BCKV + B_KV_RANK
OFF_DK = OFF_BKR + B_ROPE
OFF_DV = OFF_DK + D_KV_W
KV_COLS = OFF_DV + D_KV_W
OFF_AQ = KV_COLS
OFF_BCQ = OFF_AQ + A_W
OFF_DQ = OFF_BCQ + B_Q_RANK
OFF_GLU = OFF_DQ + D_W
OFF_GATE = OFF_GLU + 2 * C_CH
IN_COLS = OFF_GATE + N_BRANCH * D_MODEL
PEER_HEADS = 8
PEER_NKEYS = 128
PEER_EXPERTS = PEER_NKEYS * PEER_NKEYS
PEER_TOPK = 16
PEER_QDIM = 256
PEER_CHUNK = 128
ALPHA = (2 * DEPTH) ** 0.25
BETA = (8 * DEPTH) ** -0.25
SCALE_HD = HEAD_DIM ** -0.5
SCALE_MLA = B_QK ** -0.5
RMS_EPS = 1e-6
LN_EPS = 1e-5
NEG_INF = -1e30

kernel_name = 'hybrid_gated_branch_diffusion_block'


def _cols(p, off, n):
    return p[..., off:off + n]


def rms_norm(x, g):
    x32 = x.astype(jnp.float32)
    y = x32 * lax.rsqrt(jnp.mean(x32 * x32, axis=-1, keepdims=True) + RMS_EPS)
    return (y * g.astype(jnp.float32)).astype(x.dtype)


def layer_norm(x, g, b):
    x32 = x.astype(jnp.float32)
    mu = jnp.mean(x32, axis=-1, keepdims=True)
    xc = x32 - mu
    y = xc * lax.rsqrt(jnp.mean(xc * xc, axis=-1, keepdims=True) + LN_EPS)
    return (y * g.astype(jnp.float32) + b.astype(jnp.float32)).astype(x.dtype)


def axial_rope_tables(row, col, dim):
    half = dim // 2
    freq = ROPE_THETA ** (-jnp.arange(0, half, 2, dtype=jnp.float32) / half)
    ang = jnp.concatenate([row[:, None] * freq, col[:, None] * freq], axis=-1)
    return jnp.cos(ang), jnp.sin(ang)


def apply_rope(x, cos, sin):
    half = x.shape[-1] // 2
    shape = (1, x.shape[1]) + (1,) * (x.ndim - 3) + (half,)
    cos = cos.reshape(shape).astype(x.dtype)
    sin = sin.reshape(shape).astype(x.dtype)
    x1, x2 = x[..., :half], x[..., half:]
    return jnp.concatenate([x1 * cos - x2 * sin, x2 * cos + x1 * sin], axis=-1)


def kv_parts(p, a_k_norm, b_kv_norm, b_w_kv_up, rope):
    bsz, L = p.shape[:2]
    ka = rms_norm(_cols(p, OFF_AK, A_KV_W).reshape(bsz, L, A_KV_HEADS, HEAD_DIM), a_k_norm)
    va = _cols(p, OFF_AV, A_KV_W).reshape(bsz, L, A_KV_HEADS, HEAD_DIM)
    ckv = rms_norm(_cols(p, OFF_BCKV, B_KV_RANK), b_kv_norm)
    kv_up = (ckv @ b_w_kv_up).reshape(bsz, L, B_HEADS, B_NOPE + B_VDIM)
    kr = _cols(p, OFF_BKR, B_ROPE)
    kd = _cols(p, OFF_DK, D_KV_W).reshape(bsz, L, D_KV_HEADS, HEAD_DIM)
    vd = _cols(p, OFF_DV, D_KV_W).reshape(bsz, L, D_KV_HEADS, HEAD_DIM)
    if rope is not None:
        cos_h, sin_h, cos_r, sin_r = rope
        ka = apply_rope(ka, cos_h, sin_h)
        kr = apply_rope(kr, cos_r, sin_r)
        kd = apply_rope(kd, cos_h, sin_h)
    kb = jnp.concatenate([kv_up[..., :B_NOPE], jnp.broadcast_to(kr[:, :, None, :], (bsz, L, B_HEADS, B_ROPE))], axis=-1)
    vb = kv_up[..., B_NOPE:]
    return ka, va, kb, vb, kd, vd


def q_parts(p, a_q_norm, b_q_norm, b_w_q_up, rope):
    bsz, L = p.shape[:2]
    qa = rms_norm(_cols(p, OFF_AQ, A_W).reshape(bsz, L, A_KV_HEADS, A_GROUP, HEAD_DIM), a_q_norm)
    cq = rms_norm(_cols(p, OFF_BCQ, B_Q_RANK), b_q_norm)
    qb = (cq @ b_w_q_up).reshape(bsz, L, B_HEADS, B_QK)
    qd = _cols(p, OFF_DQ, D_W).reshape(bsz, L, D_KV_HEADS, D_GROUP, HEAD_DIM)
    if rope is not None:
        cos_h, sin_h, cos_r, sin_r = rope
        qa = apply_rope(qa, cos_h, sin_h)
        qb = jnp.concatenate([qb[..., :B_NOPE], apply_rope(qb[..., B_NOPE:], cos_r, sin_r)], axis=-1)
        qd = apply_rope(qd, cos_h, sin_h)
    return qa, qb[:, :, :, None, :], qd


def attend(q, k, v, scale, sink=None, mask=None):
    s = jnp.einsum('bqhgd,bkhd->bhgqk', q, k).astype(jnp.float32) * scale
    if mask is not None:
        s = jnp.where(mask, s, NEG_INF)
    if sink is not None:
        kvh, grp = q.shape[2], q.shape[3]
        sink_col = jnp.broadcast_to(sink.astype(jnp.float32).reshape(1, kvh, grp, 1, 1), s.shape[:-1] + (1,))
        s = jnp.concatenate([s, sink_col], axis=-1)
    pr = jax.nn.softmax(s, axis=-1)
    if sink is not None:
        pr = pr[..., :-1]
    return jnp.einsum('bhgqk,bkhd->bqhgd', pr.astype(v.dtype), v)


def dense_attn(q, k, v, scale):
    bsz, L = q.shape[:2]
    nb = L // BLOCK
    qb = jnp.moveaxis(q.reshape((bsz, nb, BLOCK) + q.shape[2:]), 1, 0)
    o = lax.map(lambda qi: attend(qi, k, v, scale), qb)
    return jnp.moveaxis(o, 0, 1).reshape(bsz, L, -1)


def window_attn(q, k, v, kc, vc, sink, scale):
    bsz, L = q.shape[:2]
    nb = L // BLOCK
    lc = kc.shape[1]
    kp = jnp.pad(k, ((0, 0), (BLOCK, BLOCK), (0, 0), (0, 0)))
    vp = jnp.pad(v, ((0, 0), (BLOCK, BLOCK), (0, 0), (0, 0)))
    qb = jnp.moveaxis(q.reshape((bsz, nb, BLOCK) + q.shape[2:]), 1, 0)
    ctx_ok = jnp.ones((BLOCK, lc), dtype=bool)

    def one_block(args):
        qi, n = args
        start = n * BLOCK
        kw = lax.dynamic_slice_in_dim(kp, start, 3 * BLOCK, axis=1)
        vw = lax.dynamic_slice_in_dim(vp, start, 3 * BLOCK, axis=1)
        qpos = start + jnp.arange(BLOCK)
        kpos = start - BLOCK + jnp.arange(3 * BLOCK)
        band = (jnp.abs(qpos[:, None] - kpos[None, :]) <= WINDOW) & (kpos >= 0)[None, :] & (kpos < L)[None, :]
        mask = jnp.concatenate([ctx_ok, band], axis=1)
        return attend(qi, jnp.concatenate([kc, kw], axis=1), jnp.concatenate([vc, vw], axis=1), scale, sink, mask)

    o = lax.map(one_block, (qb, jnp.arange(nb)))
    return jnp.moveaxis(o, 0, 1).reshape(bsz, L, -1)


def conformer_conv(pglu, conv_w, conv_b, ln_g, ln_b):
    a, gt = jnp.split(pglu, 2, axis=-1)
    u = a * jax.nn.sigmoid(gt)
    y = lax.conv_general_dilated(u, conv_w.reshape(CONV_K, 1, C_CH), window_strides=(1,),
                                 padding=[(CONV_K // 2, CONV_K // 2)],
                                 dimension_numbers=('NWC', 'WIO', 'NWC'),
                                 feature_group_count=C_CH) + conv_b
    return jax.nn.silu(layer_norm(y, ln_g, ln_b))


def merge_branches(branches, pgate, w_brs, w_o):
    gates = pgate.reshape(pgate.shape[:-1] + (N_BRANCH, D_MODEL))
    acc = None
    for n in range(N_BRANCH):
        term = jax.nn.sigmoid(gates[..., n, :]) * (branches[n] @ w_brs[n])
        acc = term if acc is None else acc + term
    return acc @ w_o


def peer_ffn(h, wq, subkeys, u, v):
    bsz, L, dm = h.shape
    half = PEER_QDIM // 2
    n_cand = PEER_TOPK * PEER_TOPK

    def one_chunk(xc):
        q = (xc @ wq).reshape(PEER_CHUNK, PEER_HEADS, 2, half)
        s = jnp.einsum('chpd,hpnd->chpn', q, subkeys).astype(jnp.float32)
        s_top, i_top = lax.top_k(s, PEER_TOPK)
        cand_s = (s_top[:, :, 0, :, None] + s_top[:, :, 1, None, :]).reshape(PEER_CHUNK, PEER_HEADS, n_cand)
        cand_i = (i_top[:, :, 0, :, None] * PEER_NKEYS + i_top[:, :, 1, None, :]).reshape(PEER_CHUNK, PEER_HEADS, n_cand)
        best_s, best_pos = lax.top_k(cand_s, PEER_TOPK)
        idx = jnp.take_along_axis(cand_i, best_pos, axis=-1)
        g = jax.nn.softmax(best_s, axis=-1).astype(xc.dtype)
        act = jax.nn.gelu(jnp.einsum('cd,chkd->chk', xc, u[idx]), approximate=False)
        return jnp.einsum('chk,chkd->cd', g * act, v[idx])

    out = lax.map(one_chunk, h.reshape((bsz * L) // PEER_CHUNK, PEER_CHUNK, dm))
    return out.reshape(bsz, L, dm)


def setup_inputs(seed: int = 0) -> dict:
    key = jax.random.key(seed)
    ks = iter(jax.random.split(key, 40))
    f32 = jnp.float32

    def nrm(shape, scale):
        return jax.random.normal(next(ks), shape, f32) * scale

    def gain(shape):
        return 1.0 + nrm(shape, 0.02)

    L = DEPTH
    return {
        'x': nrm((BATCH, SEQ, D_MODEL), 1.0),
        'c': nrm((BATCH, D_MODEL), 1.0),
        'ctx': nrm((BATCH, CTX_LEN, D_MODEL), 1.0),
        'c_ctx': nrm((D_MODEL,), 1.0),
        'w_ada': nrm((L, D_MODEL, 6 * D_MODEL), 0.5 * D_MODEL ** -0.5),
        'b_ada': nrm((L, 6 * D_MODEL), 0.02),
        'w_in': nrm((L, D_MODEL, IN_COLS), D_MODEL ** -0.5),
        'a_q_norm': gain((L, HEAD_DIM)),
        'a_k_norm': gain((L, HEAD_DIM)),
        'b_q_norm': gain((L, B_Q_RANK)),
        'b_w_q_up': nrm((L, B_Q_RANK, B_HEADS * B_QK), B_Q_RANK ** -0.5),
        'b_kv_norm': gain((L, B_KV_RANK)),
        'b_w_kv_up': nrm((L, B_KV_RANK, B_HEADS * (B_NOPE + B_VDIM)), B_KV_RANK ** -0.5),
        'c_conv_w': nrm((L, CONV_K, C_CH), CONV_K ** -0.5),
        'c_conv_b': nrm((L, C_CH), 0.02),
        'c_ln_g': gain((L, C_CH)),
        'c_ln_b': nrm((L, C_CH), 0.02),
        'd_sink': nrm((L, D_HEADS), 0.5),
        'w_br_a': nrm((L, A_W, D_MODEL), A_W ** -0.5),
        'w_br_b': nrm((L, B_W, D_MODEL), B_W ** -0.5),
        'w_br_c': nrm((L, C_CH, D_MODEL), C_CH ** -0.5),
        'w_br_d': nrm((L, D_W, D_MODEL), D_W ** -0.5),
        'w_o': nrm((L, D_MODEL, D_MODEL), BETA * D_MODEL ** -0.5),
        'ln1_g': gain((L, D_MODEL)),
        'ln1_b': nrm((L, D_MODEL), 0.02),
        'ln2_g': gain((L, D_MODEL)),
        'ln2_b': nrm((L, D_MODEL), 0.02),
        'peer_wq': nrm((L, D_MODEL, PEER_HEADS * PEER_QDIM), D_MODEL ** -0.5),
        'peer_subkeys': nrm((L, PEER_HEADS, 2, PEER_NKEYS, PEER_QDIM // 2), (PEER_QDIM // 2) ** -0.5),
        'peer_u': nrm((L, PEER_EXPERTS, D_MODEL), D_MODEL ** -0.5),
        'peer_v': nrm((L, PEER_EXPERTS, D_MODEL), BETA),
    }


def reference(x, c, ctx, c_ctx, w_ada, b_ada, w_in, a_q_norm, a_k_norm, b_q_norm, b_w_q_up, b_kv_norm, b_w_kv_up,
              c_conv_w, c_conv_b, c_ln_g, c_ln_b, d_sink, w_br_a, w_br_b, w_br_c, w_br_d, w_o,
              ln1_g, ln1_b, ln2_g, ln2_b, peer_wq, peer_subkeys, peer_u, peer_v):
    bsz, S, _ = x.shape
    ROWS = S // GRID_W
    row = jnp.repeat(jnp.arange(ROWS, dtype=jnp.float32), GRID_W)
    col = jnp.tile(jnp.arange(GRID_W, dtype=jnp.float32), ROWS)
    cos_h, sin_h = axial_rope_tables(row, col, HEAD_DIM)
    cos_r, sin_r = axial_rope_tables(row, col, B_ROPE)
    rope_lat = (cos_h, sin_h, cos_r, sin_r)
    sc = jax.nn.silu(c)
    scc = jax.nn.silu(c_ctx)
    xc = ctx
    for l in range(DEPTH):
        last = l == DEPTH - 1
        sh1, s1, g1, sh2, s2, g2 = jnp.split((sc @ w_ada[l] + b_ada[l])[:, None, :], 6, axis=-1)
        csh1, cs1, cg1, csh2, cs2, cg2 = jnp.split(scc @ w_ada[l] + b_ada[l], 6, axis=-1)
        wl = w_in[l]
        w_brs = (w_br_a[l], w_br_b[l], w_br_c[l], w_br_d[l])
        hc = xc * (1 + cs1) + csh1
        pc = hc @ (wl[:, :KV_COLS] if last else wl)
        akc, avc, bkc, bvc, dkc, dvc = kv_parts(pc, a_k_norm[l], b_kv_norm[l], b_w_kv_up[l], None)
        h = x * (1 + s1) + sh1
        p = h @ wl
        ak, av, bk, bv, dk, dv = kv_parts(p, a_k_norm[l], b_kv_norm[l], b_w_kv_up[l], rope_lat)
        qa, qb, qd = q_parts(p, a_q_norm[l], b_q_norm[l], b_w_q_up[l], rope_lat)
        branches = (
            dense_attn(qa, jnp.concatenate([akc, ak], axis=1), jnp.concatenate([avc, av], axis=1), SCALE_HD),
            dense_attn(qb, jnp.concatenate([bkc, bk], axis=1), jnp.concatenate([bvc, bv], axis=1), SCALE_MLA),
            conformer_conv(_cols(p, OFF_GLU, 2 * C_CH), c_conv_w[l], c_conv_b[l], c_ln_g[l], c_ln_b[l]),
            window_attn(qd, dk, dv, dkc, dvc, d_sink[l], SCALE_HD),
        )
        mix = merge_branches(branches, _cols(p, OFF_GATE, N_BRANCH * D_MODEL), w_brs, w_o[l])
        x_new = layer_norm(ALPHA * x + g1 * mix, ln1_g[l], ln1_b[l])
        y = peer_ffn(x_new * (1 + s2) + sh2, peer_wq[l], peer_subkeys[l], peer_u[l], peer_v[l])
        x_new = layer_norm(ALPHA * x_new + g2 * y, ln2_g[l], ln2_b[l])
        if not last:
            lc = xc.shape[1]
            qac, qbc, qdc = q_parts(pc, a_q_norm[l], b_q_norm[l], b_w_q_up[l], None)
            branches_c = (
                attend(qac, akc, avc, SCALE_HD).reshape(bsz, lc, -1),
                attend(qbc, bkc, bvc, SCALE_MLA).reshape(bsz, lc, -1),
                conformer_conv(_cols(pc, OFF_GLU, 2 * C_CH), c_conv_w[l], c_conv_b[l], c_ln_g[l], c_ln_b[l]),
                attend(qdc, dkc, dvc, SCALE_HD, sink=d_sink[l]).reshape(bsz, lc, -1),
            )
            mixc = merge_branches(branches_c, _cols(pc, OFF_GATE, N_BRANCH * D_MODEL), w_brs, w_o[l])
            xc = layer_norm(ALPHA * xc + cg1 * mixc, ln1_g[l], ln1_b[l])
            yc = peer_ffn(xc * (1 + cs2) + csh2, peer_wq[l], peer_subkeys[l], peer_u[l], peer_v[l])
            xc = layer_norm(ALPHA * xc + cg2 * yc, ln2_g[l], ln2_b[l])
        x = x_new
    return x
```

```cpp
#include <hip/hip_runtime.h>
#include <stdint.h>
#include <stdio.h>

#ifndef MK_PER_PHASE
#define MK_PER_PHASE 0
#endif

namespace cf {
constexpr int D = 2048, NB = 4, S = 4096, CTX = 256, RB = CTX + S  , MR = NB * RB  ;
constexpr int DEPTH = 2;
constexpr int PC_AK = 0, PC_AV = 256, PC_CKV = 512, PC_KR = 768, PC_DK = 1024, PC_DV = 1280, PC_KVEND = 1536;
constexpr int PC_AQ = 1536, PC_CQ = 2560, PC_DQ = 3072, PC_GLU = 4096, PC_GATE = 6144, NC = 14336;
constexpr int IN_COLS = 14144;
constexpr int NEXP = 16384;
constexpr float ALPHA = 1.4142135623730951f;
constexpr float LOG2E = 1.4426950408889634f;
constexpr float SCALE_HD = 0.08838834764831845f;
constexpr float SCALE_MLA = 0.07216878364870323f;
enum { I_X = 0, I_C, I_CTX, I_CCTX, I_WADA, I_BADA, I_WIN, I_AQN, I_AKN, I_BQN, I_WQUP, I_BKVN, I_WKVUP, I_CW, I_CB, I_CLG, I_CLB, I_SINK,
       I_WBRA, I_WBRB, I_WBRC, I_WBRD, I_WO, I_LN1G, I_LN1B, I_LN2G, I_LN2B, I_PWQ, I_PSK, I_PU, I_PV, N_IN };
constexpr size_t al(size_t x) { return (x + 255) / 256 * 256; }
constexpr size_t WS_CTL = 0;
constexpr size_t CTL_BYTES = 65536;
constexpr size_t WS_MOD = WS_CTL + CTL_BYTES;
constexpr size_t WS_COSH = WS_MOD + al((size_t)2 * 5 * 12288 * 4);
constexpr size_t WS_SINH = WS_COSH + (size_t)4096 * 64 * 4;
constexpr size_t WS_COSR = WS_SINH + (size_t)4096 * 64 * 4;
constexpr size_t WS_SINR = WS_COSR + (size_t)4096 * 32 * 4;
constexpr size_t WS_WIN = WS_SINR + (size_t)4096 * 32 * 4;
constexpr size_t WS_WQUP = WS_WIN + (size_t)2 * NC * 2048 * 2;
constexpr size_t WS_WKVUP = WS_WQUP + (size_t)2 * 1536 * 512 * 2;
constexpr size_t WS_WBR = WS_WKVUP + (size_t)2 * 2048 * 256 * 2;
constexpr size_t WS_WO = WS_WBR + (size_t)2 * 4 * 2048 * 1024 * 2;
constexpr size_t WS_WFOLD = WS_WO + (size_t)2 * 2048 * 2048 * 2;
constexpr size_t WS_UB = WS_WFOLD + (size_t)2 * 2048 * 2048 * 2;
constexpr size_t WS_VB2 = WS_UB + (size_t)NEXP * 2048 * 2;
constexpr size_t WS_HB = WS_VB2 + (size_t)NEXP * 2048 * 2;
constexpr size_t WS_P = WS_HB + (size_t)MR * 2048 * 2;
constexpr size_t WS_QB = WS_P + (size_t)MR * NC * 2;
constexpr size_t WS_KB = WS_QB + (size_t)MR * 1536 * 2;
constexpr size_t WS_VB = WS_KB + (size_t)MR * 1536 * 2;
constexpr size_t WS_BR = WS_VB + (size_t)MR * 1024 * 2;
constexpr size_t WS_XC = WS_BR + (size_t)MR * 4096 * 2;
constexpr size_t WS_END = WS_XC + (size_t)1024 * 2048 * 4;
constexpr size_t X1_OFF = 0, SC_OFF = (size_t)MR * 2048 * 4;
static_assert(SC_OFF * 2 <= (size_t)MR * NC * 2, "X1 + SC fit in P");
constexpr int LDS_BYTES = 132 * 1024;
constexpr int MISC_OFF = 128 * 1024;
constexpr int N_PHASES = 2 + 9 * DEPTH;
}

typedef unsigned short bf16_t;
typedef short bf16x8 __attribute__((ext_vector_type(8)));
typedef float f32x4 __attribute__((ext_vector_type(4)));
typedef float f32x2 __attribute__((ext_vector_type(2)));
typedef unsigned u32x4 __attribute__((ext_vector_type(4)));
typedef unsigned u32x2 __attribute__((ext_vector_type(2)));
#define LAS __attribute__((address_space(3)))
typedef LAS unsigned char* ldsp_t;

__device__ __forceinline__ unsigned cvt_pk_bf16(float lo, float hi) { unsigned r; asm volatile("v_cvt_pk_bf16_f32 %0, %1, %2" : "=v"(r) : "v"(lo), "v"(hi)); return r; }
__device__ __forceinline__ bf16_t f2bf(float f) { return (bf16_t)(cvt_pk_bf16(f, 0.f) & 0xffffu); }
__device__ __forceinline__ float bf2f(bf16_t b) { return __uint_as_float(((unsigned)b) << 16); }
__device__ __forceinline__ float bflo(unsigned w) { return __uint_as_float(w << 16); }
__device__ __forceinline__ float bfhi(unsigned w) { return __uint_as_float(w & 0xffff0000u); }
__device__ __forceinline__ float wave_sum(float v) {
#pragma unroll
    for (int o = 32; o >= 1; o >>= 1) v += __shfl_xor(v, o);
    return v;
}
__device__ __forceinline__ float sigmoidf_(float x) { return 1.0f / (1.0f + __expf(-x)); }

#define XB_TMO      128
#define XB_XCNT(j)  (256  + 64 * (j))
#define XB_XSUB(j)  (1280 + 64 * (j))
#define XB_XGEN(j)  (2304 + 64 * (j))
#define XB_TOP      3328
#define XB_TOPGEN   3392
#define XCD_BAR_WORDS 3456
#define XB_SPIN_CAP (1u << 23)
__device__ __forceinline__ unsigned xb_ld(unsigned* p)              { return __hip_atomic_load(p, __ATOMIC_RELAXED, __HIP_MEMORY_SCOPE_AGENT); }
__device__ __forceinline__ unsigned xb_add(unsigned* p, unsigned v) { return __hip_atomic_fetch_add(p, v, __ATOMIC_RELAXED, __HIP_MEMORY_SCOPE_AGENT); }
__device__ __forceinline__ unsigned xb_xcc_id() { return (unsigned)__builtin_amdgcn_s_getreg((3 << 11) | 20) & 0xFu; }
#define XB_SPIN(cond, bar) do { unsigned _sp = 0; while (cond) { __builtin_amdgcn_s_sleep(1); \
    if ((++_sp & 255u) == 0u) { if (xb_ld(&(bar)[XB_TMO])) break; if (_sp > XB_SPIN_CAP) { atomicAdd(&(bar)[XB_TMO], 1u); break; } } } } while (0)
struct XcdBarrier { unsigned* bar; unsigned x; volatile LAS unsigned* st; };
__device__ __forceinline__ XcdBarrier xcd_barrier_post(unsigned* bar, volatile LAS unsigned* st) {
    XcdBarrier b; b.bar = bar; b.x = xb_xcc_id(); b.st = st;
    if (threadIdx.x == 0) (void)xb_add(&bar[XB_XCNT(b.x)], 1u);
    return b;
}
__device__ __forceinline__ void xcd_barrier_complete(unsigned* bar, unsigned x, unsigned& nloc, unsigned& nx) {
    const unsigned G = gridDim.x * gridDim.y * gridDim.z;
    unsigned sum, cnt, mine, sp = 0u;
    for (;;) {
        sum = 0u; cnt = 0u; mine = 0u;
#pragma unroll
        for (unsigned j = 0; j < 16; ++j) { const unsigned c = xb_ld(&bar[XB_XCNT(j)]); sum += c; cnt += (c > 0u) ? 1u : 0u; mine = (j == x) ? c : mine; }
        if (sum == G) break;
        __builtin_amdgcn_s_sleep(1);
        if ((++sp & 255u) == 0u) { if (xb_ld(&bar[XB_TMO])) break; if (sp > XB_SPIN_CAP) { atomicAdd(&bar[XB_TMO], 1u); break; } }
    }
    nloc = mine > 0u ? mine : 1u; nx = cnt > 0u ? cnt : 1u;
}
__device__ __forceinline__ void xcd_barrier(const XcdBarrier& b) {
    asm volatile("s_waitcnt vmcnt(0)" ::: "memory");
    __syncthreads();
    if (threadIdx.x == 0) {
        unsigned* bar = b.bar;
        __builtin_amdgcn_s_waitcnt(0);
        unsigned nloc = b.st[0], nx = b.st[1];
        if (nloc == 0u) { xcd_barrier_complete(bar, b.x, nloc, nx); b.st[0] = nloc; b.st[1] = nx; }
        const unsigned old = xb_add(&bar[XB_XSUB(b.x)], 1u);
        const unsigned gen = old / nloc;
        if (old + 1u == (gen + 1u) * nloc) {
            __builtin_amdgcn_fence(__ATOMIC_RELEASE, "agent");
            asm volatile("s_waitcnt vmcnt(0)" ::: "memory");
            const unsigned og = xb_add(&bar[XB_TOP], 1u);
            const unsigned tg = og / nx;
            if (og + 1u == (tg + 1u) * nx) xb_add(&bar[XB_TOPGEN], 1u);
            else XB_SPIN(xb_ld(&bar[XB_TOPGEN]) == tg, bar);
            __builtin_amdgcn_fence(__ATOMIC_ACQUIRE, "agent");
            xb_add(&bar[XB_XGEN(b.x)], 1u);
            asm volatile("s_waitcnt vmcnt(0)" ::: "memory");
        } else {
            XB_SPIN(xb_ld(&bar[XB_XGEN(b.x)]) == gen, bar);
            __builtin_amdgcn_fence(__ATOMIC_ACQUIRE, "agent");
            asm volatile("s_waitcnt vmcnt(0)" ::: "memory");
        }
    }
    __syncthreads();
}

namespace pg8 {
constexpr int BM = 256, BK = 64, HALF = 128, HTB = HALF * BK * 2, STAGE_BYTES = 8 * HTB, NXCD = 8, WGM = 8;
__host__ __device__ __forceinline__ int lds_byte(int r, int c) { const int st = (r >> 4) * 2 + (c >> 5), rr = r & 15, cc = c & 31, ob = rr * 64 + cc * 2; return st * 1024 + (ob ^ (((ob >> 9) & 1) << 5)); }
__host__ __device__ __forceinline__ void stage_rc(int b, int& R, int& C) { const int st = b / 1024, sb = b % 1024, swz = sb ^ (((sb >> 9) & 1) << 5); R = (st >> 1) * 16 + swz / 64; C = (st & 1) * 32 + (swz % 64) / 2; }
__host__ __device__ __forceinline__ int perm32(int rho) { const int n = rho >> 4, i = rho & 15; return 8 * (i >> 2) + 4 * n + (i & 3); }
struct Unit { int pm, pn; };
struct Gemm { const bf16_t* A; const bf16_t* Bt; int lda, K; };

struct TileOrder {
    int nM, nN, nwg, G, c, mode;
    __device__ void init(int nM_, int nN_, int G_, int c_, int mode_) { nM = nM_; nN = nN_; nwg = nM * nN; G = G_; c = c_; mode = mode_; }
    __device__ bool next(int i, Unit& u) const {
        const long L = (long)i * G + c; if (L >= nwg) return false;
        int wgid = (int)L; { const int q = nwg / NXCD, r = nwg % NXCD, xcd = wgid % NXCD, off = wgid / NXCD; wgid = (xcd < r ? xcd * (q + 1) : r * (q + 1) + (xcd - r) * q) + off; }
        const int nig = WGM * nN, gid = wgid / nig, fm = gid * WGM, gsz = (nM - fm) < WGM ? (nM - fm) : WGM;
        const int pl = fm + ((wgid % nig) % gsz); u.pn = (wgid % nig) / gsz;
        u.pm = mode == 0 ? pl : (mode == 1 ? 17 * (pl >> 4) + 1 + (pl & 15) : 17 * pl);
        return true;
    }
    __device__ __forceinline__ void a_ready(const Unit&) const {}
    __device__ __forceinline__ void done(const Unit&) const {}
};

template <class Epi, class Sched>
__device__ __forceinline__ void gemm_phase(ldsp_t lds, const Gemm g, const Sched& S, const Epi& E) {
    int tid = threadIdx.x; asm volatile("" : "+v"(tid));
    const int wid = __builtin_amdgcn_readfirstlane(tid >> 6), lane = tid & 63, wr = wid >> 2, wc = wid & 3, fr = lane & 15, fq = lane >> 4;
    int K = g.K; asm volatile("" : "+s"(K));
    const int nt = K / BK, lda = g.lda;
    unsigned voffA[2], voffB[2];
#pragma unroll
    for (int i = 0; i < 2; ++i) { int R, C; stage_rc(tid * 16 + i * 8192, R, C); const int Rb = (R & ~31) + perm32(R & 31);
        voffA[i] = (unsigned)(R * lda + C) * 2u; voffB[i] = (unsigned)(Rb * K + C) * 2u; }
    const size_t kstep = (size_t)(BK * 2);
    const size_t hstepA = (size_t)HALF * lda * 2, hstepB = (size_t)HALF * K * 2;
    const size_t tstepA = 2 * hstepA, tstepB = 2 * hstepB;
    const unsigned ldsw = (unsigned)wid * 1024u;
    const int aoff = lds_byte(wr * 64 + fr, fq * 8), boff = lds_byte(wc * 32 + fr, fq * 8);
#define PG8_SA(b, h) (((b) * 2 + (h)) * HTB)
#define PG8_SB(b, h) ((4 + (b) * 2 + (h)) * HTB)
#define PG8_STAGE(bufoff, gbase, voff) do { _Pragma("unroll") for (int _i = 0; _i < 2; ++_i) \
        __builtin_amdgcn_global_load_lds((const unsigned*)((const char*)(gbase) + (voff)[_i]), (LAS unsigned*)(lds + (bufoff) + ldsw + _i * 8192), 16, 0, 0); } while (0)
#define PG8_LDA(dst, b, h) do { _Pragma("unroll") for (int m = 0; m < 4; ++m) _Pragma("unroll") for (int k = 0; k < 2; ++k) dst[m][k] = *(const LAS bf16x8*)(lds + PG8_SA(b, h) + aoff + m * 2048 + k * 1024); } while (0)
#define PG8_LDB(dst, b, h) do { _Pragma("unroll") for (int n = 0; n < 2; ++n) _Pragma("unroll") for (int k = 0; k < 2; ++k) dst[n][k] = *(const LAS bf16x8*)(lds + PG8_SB(b, h) + boff + n * 2048 + k * 1024); } while (0)
#define PG8_MMA(ai, bj, At, Bt) do { __builtin_amdgcn_s_setprio(1); _Pragma("unroll") for (int m = 0; m < 4; ++m) _Pragma("unroll") for (int n = 0; n < 2; ++n) _Pragma("unroll") for (int k = 0; k < 2; ++k) \
        acc[ai][bj][m][n] = __builtin_amdgcn_mfma_f32_16x16x32_bf16(Bt[n][k], At[m][k], acc[ai][bj][m][n], 0, 0, 0); __builtin_amdgcn_s_setprio(0); } while (0)
#define PG8_WAIT_V(n) asm volatile("s_waitcnt vmcnt(" #n ")" ::: "memory")
#define PG8_WAIT_L(n) asm volatile("s_waitcnt lgkmcnt(" #n ")" ::: "memory")
#define PG8_BAR __builtin_amdgcn_s_barrier()
#define PG8_SCHED __builtin_amdgcn_sched_barrier(0)
    Unit cur, nxt; int ui = 0;
    if (!S.next(0, cur)) return;
    f32x4 acc[2][2][4][2];
#pragma unroll
    for (int a = 0; a < 2; ++a)
#pragma unroll
        for (int b = 0; b < 2; ++b)
#pragma unroll
            for (int m = 0; m < 4; ++m)
#pragma unroll
                for (int n = 0; n < 2; ++n) acc[a][b][m][n] = (f32x4){0.f, 0.f, 0.f, 0.f};
    bf16x8 At[4][2], B0[2][2], B1[2][2];
    const char* cA = (const char*)g.A + (size_t)cur.pm * tstepA; const char* cB = (const char*)g.Bt + (size_t)cur.pn * tstepB;
    S.a_ready(cur);
    PG8_STAGE(PG8_SB(0, 0), cB, voffB); PG8_STAGE(PG8_SA(0, 0), cA, voffA); PG8_STAGE(PG8_SB(0, 1), cB + hstepB, voffB); PG8_STAGE(PG8_SA(0, 1), cA + hstepA, voffA);
    if (wr == 1) PG8_BAR;
    PG8_WAIT_V(4); PG8_BAR;
    PG8_STAGE(PG8_SB(1, 0), cB + kstep, voffB); PG8_STAGE(PG8_SA(1, 0), cA + kstep, voffA); PG8_STAGE(PG8_SB(1, 1), cB + hstepB + kstep, voffB);
    PG8_WAIT_V(6); PG8_BAR;
    for (;;) {
        const bool has_next = S.next(ui + 1, nxt);
        const char* nA = has_next ? (const char*)g.A + (size_t)nxt.pm * tstepA : cA; const char* nB = has_next ? (const char*)g.Bt + (size_t)nxt.pn * tstepB : cB;
#pragma unroll 1
        for (int t = 0; t < nt; t += 2) {
            const bool last = (t == nt - 2);
            const char* a1 = cA + (size_t)(t + 1) * kstep;
            const char* a2 = last ? nA : cA + (size_t)(t + 2) * kstep; const char* b2 = last ? nB : cB + (size_t)(t + 2) * kstep;
            const char* a3 = a2 + kstep; const char* b3 = b2 + kstep;
            if (last && has_next) S.a_ready(nxt);
            PG8_LDB(B0, 0, 0); PG8_SCHED; PG8_LDA(At, 0, 0); PG8_STAGE(PG8_SA(1, 1), a1 + hstepA, voffA);
            PG8_WAIT_L(8); PG8_BAR; PG8_WAIT_L(0); PG8_MMA(0, 0, At, B0); PG8_BAR; PG8_SCHED;
            PG8_LDB(B1, 0, 1); PG8_STAGE(PG8_SB(0, 0), b2, voffB);
            PG8_BAR; PG8_WAIT_L(0); PG8_MMA(0, 1, At, B1); PG8_BAR;
            PG8_LDA(At, 0, 1); PG8_STAGE(PG8_SA(0, 0), a2, voffA);
            PG8_BAR; PG8_WAIT_L(0); PG8_MMA(1, 0, At, B0); PG8_BAR; PG8_SCHED;
            PG8_STAGE(PG8_SB(0, 1), b2 + hstepB, voffB);
            PG8_WAIT_V(6); PG8_BAR; PG8_MMA(1, 1, At, B1); PG8_BAR;
            PG8_LDB(B0, 1, 0); PG8_SCHED; PG8_LDA(At, 1, 0); PG8_STAGE(PG8_SA(0, 1), a2 + hstepA, voffA);
            PG8_WAIT_L(8); PG8_BAR; PG8_WAIT_L(0); PG8_MMA(0, 0, At, B0); PG8_BAR; PG8_SCHED;
            PG8_LDB(B1, 1, 1); PG8_STAGE(PG8_SB(1, 0), b3, voffB);
            PG8_BAR; PG8_WAIT_L(0); PG8_MMA(0, 1, At, B1); PG8_BAR;
            PG8_LDA(At, 1, 1); PG8_STAGE(PG8_SA(1, 0), a3, voffA);
            PG8_BAR; PG8_WAIT_L(0); PG8_MMA(1, 0, At, B0); PG8_BAR; PG8_SCHED;
            PG8_STAGE(PG8_SB(1, 1), b3 + hstepB, voffB);
            PG8_WAIT_V(6); PG8_BAR; PG8_MMA(1, 1, At, B1); PG8_BAR;
        }
        E(acc, cur, wr, wc, fr, fq); S.done(cur);
        if (!has_next) break;
#pragma unroll
        for (int a = 0; a < 2; ++a)
#pragma unroll
            for (int b = 0; b < 2; ++b)
#pragma unroll
                for (int m = 0; m < 4; ++m)
#pragma unroll
                    for (int n = 0; n < 2; ++n) acc[a][b][m][n] = (f32x4){0.f, 0.f, 0.f, 0.f};
        cur = nxt; cA = nA; cB = nB; ++ui;
    }
    PG8_WAIT_V(0);
    if (wr == 0) PG8_BAR;
    PG8_BAR;
#undef PG8_SA
#undef PG8_SB
#undef PG8_STAGE
#undef PG8_LDA
#undef PG8_LDB
#undef PG8_MMA
#undef PG8_WAIT_V
#undef PG8_WAIT_L
#undef PG8_BAR
#undef PG8_SCHED
}

__device__ __forceinline__ u32x4 pack8(const f32x4 a, const f32x4 b) { u32x4 w; w.x = cvt_pk_bf16(a[0], a[1]); w.y = cvt_pk_bf16(a[2], a[3]); w.z = cvt_pk_bf16(b[0], b[1]); w.w = cvt_pk_bf16(b[2], b[3]); return w; }
#define EPI_ARGS const f32x4 (&acc)[2][2][4][2], const Unit& u, int wr, int wc, int fr_, int fq_
#define EPI_LANE int fr = fr_, fq = fq_; asm volatile("" : "+v"(fr), "+v"(fq));

struct EpiBf16 {
    bf16_t* O; int ldc;
    __device__ __forceinline__ void operator()(EPI_ARGS) const {
        EPI_LANE
        const int row0 = u.pm * BM + wr * 64 + fr, col0 = u.pn * BM + wc * 32 + 8 * fq;
#pragma unroll
        for (int ai = 0; ai < 2; ++ai)
#pragma unroll
            for (int m = 0; m < 4; ++m) { bf16_t* rowp = O + (size_t)(row0 + ai * HALF + m * 16) * ldc + col0;
#pragma unroll
                for (int bj = 0; bj < 2; ++bj) *(u32x4*)(rowp + bj * HALF) = pack8(acc[ai][bj][m][0], acc[ai][bj][m][1]); }
    }
};
struct EpiF32 {
    float* C; int ldc;
    __device__ __forceinline__ void operator()(EPI_ARGS) const {
        EPI_LANE
        const int row0 = u.pm * BM + wr * 64 + fr, col0 = u.pn * BM + wc * 32 + 8 * fq;
#pragma unroll
        for (int ai = 0; ai < 2; ++ai)
#pragma unroll
            for (int m = 0; m < 4; ++m) { float* rowp = C + (size_t)(row0 + ai * HALF + m * 16) * ldc + col0;
#pragma unroll
                for (int bj = 0; bj < 2; ++bj) { *(f32x4*)(rowp + bj * HALF) = acc[ai][bj][m][0]; *(f32x4*)(rowp + bj * HALF + 4) = acc[ai][bj][m][1]; } }
    }
};
struct EpiKvUp {
    bf16_t* KB; bf16_t* VB;
    __device__ __forceinline__ void operator()(EPI_ARGS) const {
        EPI_LANE
        const int row0 = u.pm * BM + wr * 64 + fr, d0 = wc * 32 + 8 * fq;
        const bool isk = u.pn < 4;
        bf16_t* base = isk ? KB + (2 * u.pn) * 192 + d0 : VB + (u.pn - 4) * 256 + d0;
        const int ldr = isk ? 1536 : 1024, bjs = isk ? 192 : 128;
#pragma unroll
        for (int ai = 0; ai < 2; ++ai)
#pragma unroll
            for (int m = 0; m < 4; ++m) { bf16_t* rowp = base + (size_t)(row0 + ai * HALF + m * 16) * ldr;
#pragma unroll
                for (int bj = 0; bj < 2; ++bj) *(u32x4*)(rowp + bj * bjs) = pack8(acc[ai][bj][m][0], acc[ai][bj][m][1]); }
    }
};
struct EpiQUp {
    bf16_t* QB; const float* cosr; const float* sinr;
    __device__ __forceinline__ void operator()(EPI_ARGS) const {
        EPI_LANE
        const int row0 = u.pm * BM + wr * 64 + fr;
        if (u.pn < 4) {
            const int d0 = wc * 32 + 8 * fq;
#pragma unroll
            for (int ai = 0; ai < 2; ++ai)
#pragma unroll
                for (int m = 0; m < 4; ++m) { const size_t row = (size_t)(row0 + ai * HALF + m * 16);
#pragma unroll
                    for (int bj = 0; bj < 2; ++bj) *(u32x4*)(QB + row * 1536 + (2 * u.pn + bj) * 192 + d0) = pack8(acc[ai][bj][m][0], acc[ai][bj][m][1]); }
        } else {
            const int head = 4 * (u.pn - 4) + wc, i0 = 8 * fq;
            const bool lat = (u.pm % 17) != 0; const int posbase = (u.pm % 17) * 256 - 256;
#pragma unroll
            for (int ai = 0; ai < 2; ++ai)
#pragma unroll
                for (int m = 0; m < 4; ++m) { const int rl = wr * 64 + fr + ai * HALF + m * 16; const size_t row = (size_t)u.pm * BM + rl;
                    f32x4 c0 = {1.f, 1.f, 1.f, 1.f}, c1 = c0, s0 = {0.f, 0.f, 0.f, 0.f}, s1 = s0;
                    if (lat) { const float* cp = cosr + (size_t)(posbase + rl) * 32 + i0; const float* sp = sinr + (size_t)(posbase + rl) * 32 + i0;
                        c0 = *(const f32x4*)cp; c1 = *(const f32x4*)(cp + 4); s0 = *(const f32x4*)sp; s1 = *(const f32x4*)(sp + 4); }
                    const f32x4 x1a = acc[ai][0][m][0], x1b = acc[ai][0][m][1], x2a = acc[ai][1][m][0], x2b = acc[ai][1][m][1];
                    const f32x4 o1a = x1a * c0 - x2a * s0, o1b = x1b * c1 - x2b * s1, o2a = x2a * c0 + x1a * s0, o2b = x2b * c1 + x1b * s1;
                    bf16_t* dst = QB + row * 1536 + head * 192 + 128 + i0;
                    *(u32x4*)dst = pack8(o1a, o1b); *(u32x4*)(dst + 32) = pack8(o2a, o2b); asm volatile("" ::: "memory"); }
        }
    }
};
struct EpiMerge {
    bf16_t* ACC; const bf16_t* gate; int ldg; int first;
    __device__ __forceinline__ void operator()(EPI_ARGS) const {
        EPI_LANE
        const int row0 = u.pm * BM + wr * 64 + fr, col0 = u.pn * BM + wc * 32 + 8 * fq;
#pragma unroll
        for (int ai = 0; ai < 2; ++ai)
#pragma unroll
            for (int m = 0; m < 4; ++m) { const size_t row = (size_t)(row0 + ai * HALF + m * 16);
#pragma unroll
                for (int bj = 0; bj < 2; ++bj) { const int col = col0 + bj * HALF;
                    const u32x4 gw = *(const u32x4*)(gate + row * ldg + col);
                    u32x4 pw = {0u, 0u, 0u, 0u}; if (!first) pw = *(const u32x4*)(ACC + row * 2048 + col);
                    const f32x4 a0 = acc[ai][bj][m][0], a1 = acc[ai][bj][m][1];
                    f32x4 r0, r1;
                    r0[0] = bflo(pw.x) + sigmoidf_(bflo(gw.x)) * a0[0]; r0[1] = bfhi(pw.x) + sigmoidf_(bfhi(gw.x)) * a0[1];
                    r0[2] = bflo(pw.y) + sigmoidf_(bflo(gw.y)) * a0[2]; r0[3] = bfhi(pw.y) + sigmoidf_(bfhi(gw.y)) * a0[3];
                    r1[0] = bflo(pw.z) + sigmoidf_(bflo(gw.z)) * a1[0]; r1[1] = bfhi(pw.z) + sigmoidf_(bfhi(gw.z)) * a1[1];
                    r1[2] = bflo(pw.w) + sigmoidf_(bflo(gw.w)) * a1[2]; r1[3] = bfhi(pw.w) + sigmoidf_(bfhi(gw.w)) * a1[3];
                    *(u32x4*)(ACC + row * 2048 + col) = pack8(r0, r1); } asm volatile("" ::: "memory"); }
    }
};
struct EpiWo {
    float* X1; const float* mod  ; const float* xlat  ; const float* xctx  ;
    __device__ __forceinline__ void operator()(EPI_ARGS) const {
        EPI_LANE
        const int b = u.pm / 17, tb = u.pm % 17; const bool isctx = tb == 0;
        const float* g1 = mod + (size_t)(isctx ? 4 : b) * 12288 + 2 * 2048;
        const float* xbase = isctx ? xctx + (size_t)b * cf::CTX * 2048 : xlat + ((size_t)b * cf::S + (size_t)(tb - 1) * 256) * 2048;
        const int rl0 = wr * 64 + fr, col0 = u.pn * BM + wc * 32 + 8 * fq;
#pragma unroll
        for (int ai = 0; ai < 2; ++ai)
#pragma unroll
            for (int m = 0; m < 4; ++m) { const int rl = rl0 + ai * HALF + m * 16; const size_t row = (size_t)u.pm * BM + rl;
#pragma unroll
                for (int bj = 0; bj < 2; ++bj) { const int col = col0 + bj * HALF;
                    const f32x4 x0 = *(const f32x4*)(xbase + (size_t)rl * 2048 + col), x1 = *(const f32x4*)(xbase + (size_t)rl * 2048 + col + 4);
                    const f32x4 ga = *(const f32x4*)(g1 + col), gb = *(const f32x4*)(g1 + col + 4);
                    *(f32x4*)(X1 + row * 2048 + col) = x0 * cf::ALPHA + ga * acc[ai][bj][m][0];
                    *(f32x4*)(X1 + row * 2048 + col + 4) = x1 * cf::ALPHA + gb * acc[ai][bj][m][1]; } asm volatile("" ::: "memory"); }
    }
};
}

struct Ctx {
    const float* const* in; float* out; unsigned char* ws;
    ldsp_t lds; int tid, lane, wave, G, bid;
};
#define WSP(T, off) ((T*)(F.ws + (off)))
__device__ __forceinline__ Ctx phase_ctx(const Ctx& F0) {
    Ctx C = F0;
    asm volatile("" : "+v"(C.tid));
    asm volatile("" : "+s"(C.ws));
    C.lane = C.tid & 63; C.wave = __builtin_amdgcn_readfirstlane(C.tid >> 6);
    return C;
}

__device__ __forceinline__ int srcmap(int mode, int n) {
    if (mode == 0) return n < 832 ? n : (n < 1024 ? -1 : n - 192);
    if (mode == 1) { if (n < 1024) return (n >> 7) * 192 + (n & 127);
        const int m = n - 1024, t = m >> 8, bj = (m >> 7) & 1, q = m & 127; return (4 * t + (q >> 5)) * 192 + 128 + bj * 32 + (q & 31); }
    if (mode == 2) { if (n < 1024) return (n >> 7) * 256 + (n & 127); const int m = n - 1024; return (m >> 7) * 256 + 128 + (m & 127); }
    return n;
}
__device__ __forceinline__ void tr_tile(const Ctx& F, const float* src, int ld_src, int mode, int k0, bf16_t* dst, int ldd, int n0) {
    LAS float* T = (LAS float*)F.lds;
    const int kr = F.tid >> 4, nc = (F.tid & 15) * 4, sc = srcmap(mode, n0 + nc);
#pragma unroll
    for (int h = 0; h < 2; ++h) { const int k = kr + 32 * h; f32x4 v = {0.f, 0.f, 0.f, 0.f};
        if (sc >= 0) v = *(const f32x4*)(src + (size_t)(k0 + k) * ld_src + sc);
        T[k * 65 + nc + 0] = v[0]; T[k * 65 + nc + 1] = v[1]; T[k * 65 + nc + 2] = v[2]; T[k * 65 + nc + 3] = v[3]; }
    __syncthreads();
    const int n = F.tid >> 3, kc = (F.tid & 7) * 8;
    u32x4 w;
    w.x = cvt_pk_bf16(T[(kc + 0) * 65 + n], T[(kc + 1) * 65 + n]); w.y = cvt_pk_bf16(T[(kc + 2) * 65 + n], T[(kc + 3) * 65 + n]);
    w.z = cvt_pk_bf16(T[(kc + 4) * 65 + n], T[(kc + 5) * 65 + n]); w.w = cvt_pk_bf16(T[(kc + 6) * 65 + n], T[(kc + 7) * 65 + n]);
    *(u32x4*)(dst + (size_t)(n0 + n) * ldd + k0 + kc) = w;
    __syncthreads();
}
__device__ __forceinline__ void cvt_rows(const Ctx& F, const float* src, bf16_t* dst, size_t n8) {
    for (size_t i = (size_t)F.bid * 512 + F.tid; i < n8; i += (size_t)F.G * 512) {
        const f32x4 a = *(const f32x4*)(src + i * 8), b = *(const f32x4*)(src + i * 8 + 4);
        *(u32x4*)(dst + i * 8) = pg8::pack8(a, b); }
}

__device__ __forceinline__ void ph_prologue(const Ctx& F0) {
    const Ctx F = phase_ctx(F0);
    using namespace cf;
    constexpr int T_WIN = 2 * 32 * 224, T_QUP = 2 * 8 * 24, T_KVUP = 2 * 4 * 32, T_BR = 2 * 4 * 16 * 32, T_WO = 2 * 32 * 32;
    constexpr int T_ALL = T_WIN + T_QUP + T_KVUP + T_BR + T_WO;
    for (int u = F.bid; u < T_ALL; u += F.G) {
        int t = u;
        if (t < T_WIN) { const int l = t / (32 * 224), r = t % (32 * 224), kt = r / 224, nt = r % 224;
            tr_tile(F, F.in[I_WIN] + (size_t)l * 2048 * IN_COLS, IN_COLS, 0, kt * 64, WSP(bf16_t, WS_WIN) + (size_t)l * NC * 2048, 2048, nt * 64); continue; }
        t -= T_WIN;
        if (t < T_QUP) { const int l = t / (8 * 24), r = t % (8 * 24), kt = r / 24, nt = r % 24;
            tr_tile(F, F.in[I_WQUP] + (size_t)l * 512 * 1536, 1536, 1, kt * 64, WSP(bf16_t, WS_WQUP) + (size_t)l * 1536 * 512, 512, nt * 64); continue; }
        t -= T_QUP;
        if (t < T_KVUP) { const int l = t / (4 * 32), r = t % (4 * 32), kt = r / 32, nt = r % 32;
            tr_tile(F, F.in[I_WKVUP] + (size_t)l * 256 * 2048, 2048, 2, kt * 64, WSP(bf16_t, WS_WKVUP) + (size_t)l * 2048 * 256, 256, nt * 64); continue; }
        t -= T_KVUP;
        if (t < T_BR) { const int l = t / (4 * 512), r = t % (4 * 512), br = r / 512, r2 = r % 512, kt = r2 / 32, nt = r2 % 32;
            const float* src = (br == 0 ? F.in[I_WBRA] : br == 1 ? F.in[I_WBRB] : br == 2 ? F.in[I_WBRC] : F.in[I_WBRD]) + (size_t)l * 1024 * 2048;
            tr_tile(F, src, 2048, 3, kt * 64, WSP(bf16_t, WS_WBR) + ((size_t)l * 4 + br) * 2048 * 1024, 1024, nt * 64); continue; }
        t -= T_BR;
        { const int l = t / 1024, r = t % 1024, kt = r / 32, nt = r % 32;
            tr_tile(F, F.in[I_WO] + (size_t)l * 2048 * 2048, 2048, 3, kt * 64, WSP(bf16_t, WS_WO) + (size_t)l * 2048 * 2048, 2048, nt * 64); }
    }
    for (int u = F.bid; u < 2 * 16 * 32; u += F.G) {
        const int l = u / 512, g = (u % 512) / 32, d0 = (u % 32) * 64;
        LAS float* sk = (LAS float*)F.lds; LAS float* wt = (LAS float*)(F.lds + 128 * 129 * 4);
        const float* skg = F.in[I_PSK] + ((size_t)l * 16 + g) * 128 * 128;
        const float* wqg = F.in[I_PWQ] + (size_t)l * 2048 * 2048 + (size_t)d0 * 2048 + g * 128;
        for (int i = F.tid; i < 128 * 128; i += 512) sk[(i >> 7) * 129 + (i & 127)] = skg[i];
        for (int i = F.tid; i < 64 * 128; i += 512) wt[(i >> 7) * 129 + (i & 127)] = wqg[(size_t)(i >> 7) * 2048 + (i & 127)];
        __syncthreads();
        const int n = F.tid & 127, dg = F.tid >> 7;
        float a[16];
#pragma unroll
        for (int e = 0; e < 16; ++e) a[e] = 0.f;
        for (int k = 0; k < 128; ++k) { const float s = sk[n * 129 + k];
#pragma unroll
            for (int e = 0; e < 16; ++e) a[e] += wt[(dg * 16 + e) * 129 + k] * s; }
        bf16_t* dst = WSP(bf16_t, WS_WFOLD) + (size_t)l * 2048 * 2048 + (size_t)(g * 128 + n) * 2048 + d0 + dg * 16;
        u32x4 w0, w1;
        w0.x = cvt_pk_bf16(a[0], a[1]); w0.y = cvt_pk_bf16(a[2], a[3]); w0.z = cvt_pk_bf16(a[4], a[5]); w0.w = cvt_pk_bf16(a[6], a[7]);
        w1.x = cvt_pk_bf16(a[8], a[9]); w1.y = cvt_pk_bf16(a[10], a[11]); w1.z = cvt_pk_bf16(a[12], a[13]); w1.w = cvt_pk_bf16(a[14], a[15]);
        *(u32x4*)dst = w0; *(u32x4*)(dst + 8) = w1;
        __syncthreads();
    }
    for (int u = F.bid; u < 2 * 192; u += F.G) {
        const int l = u / 192, n0 = (u % 192) * 64;
        LAS float* sl = (LAS float*)F.lds; LAS float* red = (LAS float*)(F.lds + 5 * 2048 * 4);
        for (int i = F.tid; i < 5 * 2048; i += 512) { const int r = i >> 11, k = i & 2047; const float v = r < 4 ? F.in[I_C][r * 2048 + k] : F.in[I_CCTX][k]; sl[i] = v * sigmoidf_(v); }
        __syncthreads();
        const int col = F.tid & 63, ks = F.tid >> 6;
        float a[5] = {0.f, 0.f, 0.f, 0.f, 0.f};
        const float* wp = F.in[I_WADA] + (size_t)l * 2048 * 12288 + n0 + col;
        for (int k = ks * 256; k < ks * 256 + 256; ++k) { const float w = wp[(size_t)k * 12288];
#pragma unroll
            for (int r = 0; r < 5; ++r) a[r] += sl[r * 2048 + k] * w; }
#pragma unroll
        for (int r = 0; r < 5; ++r) red[(ks * 5 + r) * 64 + col] = a[r];
        __syncthreads();
        if (F.tid < 320) { const int r = F.tid >> 6; float s = 0.f;
#pragma unroll
            for (int k2 = 0; k2 < 8; ++k2) s += red[(k2 * 5 + r) * 64 + col];
            WSP(float, WS_MOD)[((size_t)l * 5 + r) * 12288 + n0 + col] = s + F.in[I_BADA][(size_t)l * 12288 + n0 + col]; }
        __syncthreads();
    }
    for (int i = F.bid * 512 + F.tid; i < 4096 * 64; i += F.G * 512) {
        const int pos = i >> 6, j = i & 63, fi = j & 31; const float fr = powf(10000.0f, -(float)(2 * fi) / 64.0f);
        const float ang = (float)(j < 32 ? (pos >> 6) : (pos & 63)) * fr;
        WSP(float, WS_COSH)[i] = cosf(ang); WSP(float, WS_SINH)[i] = sinf(ang);
    }
    for (int i = F.bid * 512 + F.tid; i < 4096 * 32; i += F.G * 512) {
        const int pos = i >> 5, j = i & 31, fi = j & 15; const float fr = powf(10000.0f, -(float)(2 * fi) / 32.0f);
        const float ang = (float)(j < 16 ? (pos >> 6) : (pos & 63)) * fr;
        WSP(float, WS_COSR)[i] = cosf(ang); WSP(float, WS_SINR)[i] = sinf(ang);
    }
    cvt_rows(F, F.in[I_PU], WSP(bf16_t, WS_UB), (size_t)NEXP * 2048 / 8);
    cvt_rows(F, F.in[I_PV], WSP(bf16_t, WS_VB2), (size_t)NEXP * 2048 / 8);
}

__device__ __forceinline__ void ph_modulate0(const Ctx& F0) {
    const Ctx F = phase_ctx(F0);
    using namespace cf;
    const float* mod = WSP(float, WS_MOD);
    for (size_t i = (size_t)F.bid * 512 + F.tid; i < (size_t)MR * 256; i += (size_t)F.G * 512) {
        const int R = (int)(i >> 8), d = (int)(i & 255) * 8, b = R / RB, j = R % RB;
        const float* src = j < CTX ? F.in[I_CTX] + ((size_t)b * CTX + j) * 2048 : F.in[I_X] + ((size_t)b * S + (j - CTX)) * 2048;
        const float* m = mod + (size_t)(j < CTX ? 4 : b) * 12288;
        const f32x4 x0 = *(const f32x4*)(src + d), x1 = *(const f32x4*)(src + d + 4);
        const f32x4 sh0 = *(const f32x4*)(m + d), sh1 = *(const f32x4*)(m + d + 4), s0 = *(const f32x4*)(m + 2048 + d), s1 = *(const f32x4*)(m + 2048 + d + 4);
        *(u32x4*)(WSP(bf16_t, WS_HB) + (size_t)R * 2048 + d) = pg8::pack8(x0 * (s0 + 1.0f) + sh0, x1 * (s1 + 1.0f) + sh1);
    }
}

__device__ __forceinline__ void ph_post(const Ctx& F0, int layer) {
    const Ctx F = phase_ctx(F0);
    using namespace cf;
    bf16_t* P = WSP(bf16_t, WS_P); bf16_t* KB = WSP(bf16_t, WS_KB);
    const float* akn = F.in[I_AKN] + layer * 128; const float* aqn = F.in[I_AQN] + layer * 128;
    const float* bkvn = F.in[I_BKVN] + layer * 256; const float* bqn = F.in[I_BQN] + layer * 512;
    const int lane = F.lane;
    for (int R = F.bid * 8 + F.wave; R < MR; R += F.G * 8) {
        const int j = R % RB; const bool lat = j >= CTX; const int pos = lat ? j - CTX : 0;
        const bool full = lat || layer == 0;
        bf16_t* p = P + (size_t)R * NC;
        const float ch = lat ? WSP(float, WS_COSH)[pos * 64 + lane] : 1.f, sh = lat ? WSP(float, WS_SINH)[pos * 64 + lane] : 0.f;
        const float akg1 = akn[lane], akg2 = akn[64 + lane];
#pragma unroll
        for (int h = 0; h < 2; ++h) { bf16_t* q = p + PC_AK + h * 128; const float x1 = bf2f(q[lane]), x2 = bf2f(q[64 + lane]);
            const float r = rsqrtf(wave_sum(x1 * x1 + x2 * x2) * (1.f / 128.f) + 1e-6f); const float y1 = x1 * r * akg1, y2 = x2 * r * akg2;
            q[lane] = f2bf(y1 * ch - y2 * sh); q[64 + lane] = f2bf(y2 * ch + y1 * sh); }
        { bf16_t* q = p + PC_CKV; float x[4]; float ss = 0.f;
#pragma unroll
            for (int i = 0; i < 4; ++i) { x[i] = bf2f(q[lane + 64 * i]); ss += x[i] * x[i]; }
            const float r = rsqrtf(wave_sum(ss) * (1.f / 256.f) + 1e-6f);
#pragma unroll
            for (int i = 0; i < 4; ++i) q[lane + 64 * i] = f2bf(x[i] * r * bkvn[lane + 64 * i]); }
        if (lane < 32) { const float x1 = bf2f(p[PC_KR + lane]), x2 = bf2f(p[PC_KR + 32 + lane]);
            const float c = lat ? WSP(float, WS_COSR)[pos * 32 + lane] : 1.f, s = lat ? WSP(float, WS_SINR)[pos * 32 + lane] : 0.f;
            const bf16_t o1 = f2bf(x1 * c - x2 * s), o2 = f2bf(x2 * c + x1 * s);
            bf16_t* kb = KB + (size_t)R * 1536 + 128 + lane;
#pragma unroll
            for (int h = 0; h < 8; ++h) { kb[h * 192] = o1; kb[h * 192 + 32] = o2; } }
        if (lat) {
#pragma unroll
            for (int h = 0; h < 2; ++h) { bf16_t* q = p + PC_DK + h * 128; const float x1 = bf2f(q[lane]), x2 = bf2f(q[64 + lane]);
                q[lane] = f2bf(x1 * ch - x2 * sh); q[64 + lane] = f2bf(x2 * ch + x1 * sh); } }
        if (!full) continue;
        { const float g1 = aqn[lane], g2 = aqn[64 + lane];
#pragma unroll
            for (int h = 0; h < 8; ++h) { bf16_t* q = p + PC_AQ + h * 128; const float x1 = bf2f(q[lane]), x2 = bf2f(q[64 + lane]);
                const float r = rsqrtf(wave_sum(x1 * x1 + x2 * x2) * (1.f / 128.f) + 1e-6f); const float y1 = x1 * r * g1, y2 = x2 * r * g2;
                q[lane] = f2bf(y1 * ch - y2 * sh); q[64 + lane] = f2bf(y2 * ch + y1 * sh); } }
        { bf16_t* q = p + PC_CQ; float x[8]; float ss = 0.f;
#pragma unroll
            for (int i = 0; i < 8; ++i) { x[i] = bf2f(q[lane + 64 * i]); ss += x[i] * x[i]; }
            const float r = rsqrtf(wave_sum(ss) * (1.f / 512.f) + 1e-6f);
#pragma unroll
            for (int i = 0; i < 8; ++i) q[lane + 64 * i] = f2bf(x[i] * r * bqn[lane + 64 * i]); }
        if (lat) {
#pragma unroll
            for (int h = 0; h < 8; ++h) { bf16_t* q = p + PC_DQ + h * 128; const float x1 = bf2f(q[lane]), x2 = bf2f(q[64 + lane]);
                q[lane] = f2bf(x1 * ch - x2 * sh); q[64 + lane] = f2bf(x2 * ch + x1 * sh); } }
#pragma unroll
        for (int i = 0; i < 16; ++i) { const float a = bf2f(p[PC_GLU + lane + 64 * i]), gt = bf2f(p[PC_GLU + 1024 + lane + 64 * i]); p[PC_GLU + lane + 64 * i] = f2bf(a * sigmoidf_(gt)); }
    }
}

struct AttnArgs {
    const bf16_t* Q; const bf16_t* K; const bf16_t* V; bf16_t* O; int ldq, ldk, ldv, ldo;
    int seg0_row, seg0_tiles, seg1_row, seg1_tiles;
    int mask_on, qpos0, kpos1;
    float sc_log2; int has_sink; float sink_l2;
};
template <int DK>
__device__ __forceinline__ void attn_unit(ldsp_t lds, const AttnArgs a) {
    constexpr int NS = DK / 32, KST = DK + 8, KCH = DK / 8, KPT = (64 * KCH) / 512, VST = 72;
    int tid = threadIdx.x; asm volatile("" : "+v"(tid));
    const int wid = __builtin_amdgcn_readfirstlane(tid >> 6), lane = tid & 63, g = lane >> 4, c16 = lane & 15;
    ldsp_t Ks = lds, Vt = lds + 32768, Ost = lds + 65536 + wid * 4096;
    bf16x8 qf[NS];
    { const bf16_t* qrow = a.Q + (size_t)(wid * 16 + c16) * a.ldq + 8 * g;
#pragma unroll
      for (int s = 0; s < NS; ++s) qf[s] = *(const bf16x8*)(qrow + 32 * s); }
    f32x4 o[8];
#pragma unroll
    for (int nb = 0; nb < 8; ++nb) o[nb] = (f32x4){0.f, 0.f, 0.f, 0.f};
    float m_run = -1e30f, l_run = 0.f;
    const int ntiles = a.seg0_tiles + a.seg1_tiles;
    u32x4 kreg[KPT], vreg[2];
    const int vkp = tid & 31, vdc = tid >> 5;
#define ATT_LOAD(tt) do { const int _r0 = (tt) < a.seg0_tiles ? a.seg0_row + 64 * (tt) : a.seg1_row + 64 * ((tt) - a.seg0_tiles); \
        _Pragma("unroll") for (int _i = 0; _i < KPT; ++_i) { const int _c = tid + 512 * _i; kreg[_i] = *(const u32x4*)(a.K + (size_t)(_r0 + _c / KCH) * a.ldk + 8 * (_c % KCH)); } \
        vreg[0] = *(const u32x4*)(a.V + (size_t)(_r0 + 2 * vkp) * a.ldv + 8 * vdc); vreg[1] = *(const u32x4*)(a.V + (size_t)(_r0 + 2 * vkp + 1) * a.ldv + 8 * vdc); } while (0)
    ATT_LOAD(0);
    for (int tt = 0; tt < ntiles; ++tt) {
        __syncthreads();
#pragma unroll
        for (int i = 0; i < KPT; ++i) { const int c = tid + 512 * i; *(LAS u32x4*)(Ks + ((c / KCH) * KST + 8 * (c % KCH)) * 2) = kreg[i]; }
        { const unsigned a0[4] = {vreg[0].x, vreg[0].y, vreg[0].z, vreg[0].w}, a1[4] = {vreg[1].x, vreg[1].y, vreg[1].z, vreg[1].w};
#pragma unroll
          for (int e = 0; e < 4; ++e) {
              *(LAS unsigned*)(Vt + ((8 * vdc + 2 * e) * VST + 2 * vkp) * 2) = (a0[e] & 0xffffu) | (a1[e] << 16);
              *(LAS unsigned*)(Vt + ((8 * vdc + 2 * e + 1) * VST + 2 * vkp) * 2) = (a0[e] >> 16) | (a1[e] & 0xffff0000u); } }
        __syncthreads();
        if (tt + 1 < ntiles) ATT_LOAD(tt + 1);
        f32x4 sc[4];
#pragma unroll
        for (int kt = 0; kt < 4; ++kt) { sc[kt] = (f32x4){0.f, 0.f, 0.f, 0.f};
#pragma unroll
            for (int s = 0; s < NS; ++s) { const bf16x8 kf = *(const LAS bf16x8*)(Ks + ((16 * kt + c16) * KST + 32 * s + 8 * g) * 2);
                sc[kt] = __builtin_amdgcn_mfma_f32_16x16x32_bf16(kf, qf[s], sc[kt], 0, 0, 0); } }
        const bool msk = a.mask_on && tt >= a.seg0_tiles;
        const int kp0 = a.kpos1 + 64 * (tt - a.seg0_tiles) + 4 * g, qp = a.qpos0 + wid * 16 + c16;
        float mx = -1e30f;
#pragma unroll
        for (int kt = 0; kt < 4; ++kt)
#pragma unroll
            for (int r = 0; r < 4; ++r) { float t = sc[kt][r] * a.sc_log2;
                if (msk) { const int dlt = qp - (kp0 + 16 * kt + r); if (dlt > 128 || dlt < -128) t = -1e30f; }
                sc[kt][r] = t; mx = fmaxf(mx, t); }
        mx = fmaxf(mx, __shfl_xor(mx, 16)); mx = fmaxf(mx, __shfl_xor(mx, 32));
        const float m_new = fmaxf(m_run, mx), alpha = __builtin_amdgcn_exp2f(m_run - m_new); m_run = m_new;
        float ps = 0.f;
#pragma unroll
        for (int kt = 0; kt < 4; ++kt)
#pragma unroll
            for (int r = 0; r < 4; ++r) { const float p = __builtin_amdgcn_exp2f(sc[kt][r] - m_new); sc[kt][r] = p; ps += p; }
        l_run = l_run * alpha + ps;
        bf16x8 pa[2];
#pragma unroll
        for (int i = 0; i < 2; ++i) { u32x4 w; w.x = cvt_pk_bf16(sc[2 * i][0], sc[2 * i][1]); w.y = cvt_pk_bf16(sc[2 * i][2], sc[2 * i][3]);
            w.z = cvt_pk_bf16(sc[2 * i + 1][0], sc[2 * i + 1][1]); w.w = cvt_pk_bf16(sc[2 * i + 1][2], sc[2 * i + 1][3]); pa[i] = *(bf16x8*)&w; }
        { float ar[4];
#pragma unroll
          for (int r = 0; r < 4; ++r) ar[r] = __shfl(alpha, 4 * g + r);
#pragma unroll
          for (int nb = 0; nb < 8; ++nb)
#pragma unroll
              for (int r = 0; r < 4; ++r) o[nb][r] *= ar[r]; }
#pragma unroll
        for (int nb = 0; nb < 8; ++nb)
#pragma unroll
            for (int i = 0; i < 2; ++i) { const ldsp_t vp = Vt + ((c16 + 16 * nb) * VST + 32 * i + 4 * g) * 2;
                const u32x2 v0 = *(const LAS u32x2*)vp, v1 = *(const LAS u32x2*)(vp + 32);
                u32x4 w = {v0.x, v0.y, v1.x, v1.y};
                o[nb] = __builtin_amdgcn_mfma_f32_16x16x32_bf16(pa[i], *(bf16x8*)&w, o[nb], 0, 0, 0); }
    }
#undef ATT_LOAD
    float l_tot = l_run; l_tot += __shfl_xor(l_tot, 16); l_tot += __shfl_xor(l_tot, 32);
    if (a.has_sink) l_tot += __builtin_amdgcn_exp2f(a.sink_l2 - m_run);
    const float inv = 1.0f / l_tot;
    { float ir[4];
#pragma unroll
      for (int r = 0; r < 4; ++r) ir[r] = __shfl(inv, 4 * g + r);
#pragma unroll
      for (int nb = 0; nb < 8; ++nb)
#pragma unroll
          for (int r = 0; r < 4; ++r) *(LAS bf16_t*)(Ost + ((4 * g + r) * 128 + c16 + 16 * nb) * 2) = f2bf(o[nb][r] * ir[r]); }
    asm volatile("s_waitcnt lgkmcnt(0)" ::: "memory");
#pragma unroll
    for (int i = 0; i < 4; ++i) { const int c = lane + 64 * i, row = c >> 4, c8 = c & 15;
        *(u32x4*)(a.O + (size_t)(wid * 16 + row) * a.ldo + 8 * c8) = *(const LAS u32x4*)(Ost + (row * 128 + 8 * c8) * 2); }
}

__device__ __forceinline__ void conv_unit(const Ctx& F, int layer, int row0  , int seq_len, int t0) {
    using namespace cf;
    const bf16_t* P = WSP(const bf16_t, WS_P); bf16_t* BR = WSP(bf16_t, WS_BR);
    const float* cw = F.in[I_CW] + (size_t)layer * 31 * 1024; const float* cb = F.in[I_CB] + layer * 1024;
    const float* lg = F.in[I_CLG] + layer * 1024; const float* lb = F.in[I_CLB] + layer * 1024;
    int tid = F.tid; asm volatile("" : "+v"(tid));
    const int lane = tid & 63;
    LAS float* red = (LAS float*)(F.lds + 126976); LAS float* tot = red + 8 * 32;
    __syncthreads();
    for (int c = tid; c < 62 * 128; c += 512) { const int rr = c >> 7, ch = c & 127, t = t0 - 15 + rr;
        u32x4 v = {0u, 0u, 0u, 0u};
        if (t >= 0 && t < seq_len) v = *(const u32x4*)(P + (size_t)(row0 + t) * NC + PC_GLU + ch * 8);
        *(LAS u32x4*)(F.lds + rr * 2048 + ch * 16) = v; }
    float w0[31], w1[31];
#pragma unroll
    for (int k = 0; k < 31; ++k) { const f32x2 w = *(const f32x2*)(cw + k * 1024 + 2 * tid); w0[k] = w.x; w1[k] = w.y; }
    const f32x2 bv = *(const f32x2*)(cb + 2 * tid), gg = *(const f32x2*)(lg + 2 * tid), bb = *(const f32x2*)(lb + 2 * tid);
    __syncthreads();
#pragma unroll 1
    for (int part = 0; part < 4; ++part) {
        float a0[8], a1[8];
#pragma unroll
        for (int t = 0; t < 8; ++t) { a0[t] = bv.x; a1[t] = bv.y; }
        const ldsp_t base = F.lds + part * 8 * 2048 + tid * 4;
#pragma unroll
        for (int rr = 0; rr < 38; ++rr) { const unsigned xw = *(const LAS unsigned*)(base + rr * 2048); const float x0 = bflo(xw), x1 = bfhi(xw);
#pragma unroll
            for (int t = 0; t < 8; ++t) { const int k = rr - t; if (k >= 0 && k <= 30) { a0[t] += x0 * w0[k]; a1[t] += x1 * w1[k]; } } }
        float v[16];
#pragma unroll
        for (int t = 0; t < 8; ++t) { v[t] = a0[t] + a1[t]; v[8 + t] = a0[t] * a0[t] + a1[t] * a1[t]; }
#pragma unroll
        for (int i = 0; i < 8; ++i) { const bool up = lane & 32; const float snd = up ? v[i] : v[i + 8], kp = up ? v[i + 8] : v[i]; v[i] = kp + __shfl_xor(snd, 32); }
#pragma unroll
        for (int i = 0; i < 4; ++i) { const bool up = lane & 16; const float snd = up ? v[i] : v[i + 4], kp = up ? v[i + 4] : v[i]; v[i] = kp + __shfl_xor(snd, 16); }
#pragma unroll
        for (int i = 0; i < 2; ++i) { const bool up = lane & 8; const float snd = up ? v[i] : v[i + 2], kp = up ? v[i + 2] : v[i]; v[i] = kp + __shfl_xor(snd, 8); }
        { const bool up = lane & 4; const float snd = up ? v[0] : v[1], kp = up ? v[1] : v[0]; v[0] = kp + __shfl_xor(snd, 4); }
        v[0] += __shfl_xor(v[0], 2); v[0] += __shfl_xor(v[0], 1);
        if ((lane & 3) == 0) red[F.wave * 16 + (lane >> 2)] = v[0];
        __syncthreads();
        if (tid < 16) { float s = 0.f;
#pragma unroll
            for (int w = 0; w < 8; ++w) s += red[w * 16 + tid];
            tot[tid] = s; }
        __syncthreads();
#pragma unroll
        for (int t = 0; t < 8; ++t) { const float mean = tot[t] * (1.f / 1024.f), var = fmaxf(tot[8 + t] * (1.f / 1024.f) - mean * mean, 0.f), rstd = rsqrtf(var + 1e-5f);
            const float y0 = (a0[t] - mean) * rstd * gg.x + bb.x, y1 = (a1[t] - mean) * rstd * gg.y + bb.y;
            *(unsigned*)(BR + (size_t)(row0 + t0 + part * 8 + t) * 4096 + 2048 + 2 * tid) = cvt_pk_bf16(y0 * sigmoidf_(y0), y1 * sigmoidf_(y1)); }
    }
}

__device__ __forceinline__ void attn_defaults(AttnArgs& a, int isctx) {
    a.seg0_row = 0; a.seg0_tiles = isctx ? 4 : 68; a.seg1_row = 0; a.seg1_tiles = 0; a.mask_on = 0; a.qpos0 = 0; a.kpos1 = 0; a.has_sink = 0; a.sink_l2 = 0.f; }
__device__ __forceinline__ void ph_attn(const Ctx& F0, int layer) {
    const Ctx F = phase_ctx(F0);
    using namespace cf;
    const bf16_t* P = WSP(const bf16_t, WS_P); bf16_t* BR = WSP(bf16_t, WS_BR);
    for (int u = F.bid; u < (layer == 0 ? 1088 : 1024); u += F.G) {
        int b, h, qb, isctx = 0;
        if (u < 1024) { b = u >> 8; h = (u >> 5) & 7; qb = u & 31; } else { const int r = u - 1024; b = r >> 4; h = (r >> 1) & 7; qb = r & 1; isctx = 1; }
        const size_t brow = (size_t)b * RB, qrow = brow + (isctx ? 0 : CTX) + (size_t)qb * 128;
        AttnArgs a; attn_defaults(a, isctx);
        a.Q = WSP(const bf16_t, WS_QB) + qrow * 1536 + h * 192; a.ldq = 1536;
        a.K = WSP(const bf16_t, WS_KB) + brow * 1536 + h * 192; a.ldk = 1536;
        a.V = WSP(const bf16_t, WS_VB) + brow * 1024 + h * 128; a.ldv = 1024;
        a.O = BR + qrow * 4096 + 1024 + h * 128; a.ldo = 4096; a.sc_log2 = SCALE_MLA * LOG2E;
        __syncthreads();
        attn_unit<192>(F.lds, a);
    }
    for (int u0 = F.bid; u0 < (layer == 0 ? 2176 : 2048); u0 += F.G) {
        int kind, b, h, qb, isctx = 0;
        if (u0 < 2048) { kind = 1 + (u0 >> 10); const int r = u0 & 1023; b = r >> 8; h = (r >> 5) & 7; qb = r & 31; }
        else { const int r = u0 - 2048; kind = 1 + (r >> 6); const int r2 = r & 63; b = r2 >> 4; h = (r2 >> 1) & 7; qb = r2 & 1; isctx = 1; }
        const size_t brow = (size_t)b * RB, qrow = brow + (isctx ? 0 : CTX) + (size_t)qb * 128;
        AttnArgs a; attn_defaults(a, isctx);
        const int qc = kind == 1 ? PC_AQ : PC_DQ, kc = kind == 1 ? PC_AK : PC_DK, vc = kind == 1 ? PC_AV : PC_DV;
        a.Q = P + qrow * NC + qc + h * 128; a.ldq = NC;
        a.K = P + brow * NC + kc + (h >> 2) * 128; a.ldk = NC;
        a.V = P + brow * NC + vc + (h >> 2) * 128; a.ldv = NC;
        a.O = BR + qrow * 4096 + (kind == 1 ? 0 : 3072) + h * 128; a.ldo = 4096; a.sc_log2 = SCALE_HD * LOG2E;
        if (kind == 2) { a.has_sink = 1; a.sink_l2 = F.in[I_SINK][layer * 8 + h] * LOG2E; a.seg0_tiles = 4;
            if (!isctx) { const int start = qb * 128; const int lo = start - 128 < 0 ? 0 : start - 128, hi = start + 256 > S ? S : start + 256;
                a.seg1_row = CTX + lo; a.seg1_tiles = (hi - lo) / 64; a.mask_on = 1; a.qpos0 = start; a.kpos1 = lo; } }
        __syncthreads();
        attn_unit<128>(F.lds, a);
    }
    for (int u = F.bid; u < (layer == 0 ? 544 : 512); u += F.G) {
        int b, tb, isctx = 0;
        if (u < 512) { b = u >> 7; tb = u & 127; } else { const int r = u - 512; b = r >> 3; tb = r & 7; isctx = 1; }
        conv_unit(F, layer, b * RB + (isctx ? 0 : CTX), isctx ? CTX : S, tb * 32);
    }
}

__device__ __forceinline__ int tok_row(int layer, int tok) { return layer == 0 ? tok : (tok >> 12) * cf::RB + cf::CTX + (tok & 4095); }
__device__ __forceinline__ void ph_ln1(const Ctx& F0, int layer) {
    const Ctx F = phase_ctx(F0);
    using namespace cf;
    float* X1 = (float*)(F.ws + WS_P + X1_OFF); bf16_t* HB = WSP(bf16_t, WS_HB);
    const float* lg = F.in[I_LN1G] + layer * 2048; const float* lb = F.in[I_LN1B] + layer * 2048;
    const int ntok = layer == 0 ? MR : NB * S, lane = F.lane;
    for (int tok = F.bid * 8 + F.wave; tok < ntok; tok += F.G * 8) {
        const int R = tok_row(layer, tok), b = R / RB, j = R % RB;
        const float* mod = WSP(const float, WS_MOD) + ((size_t)layer * 5 + (j < CTX ? 4 : b)) * 12288;
        float* xp = X1 + (size_t)R * 2048;
        f32x4 v[8]; float s = 0.f;
#pragma unroll
        for (int i = 0; i < 8; ++i) { v[i] = *(const f32x4*)(xp + lane * 4 + 256 * i); s += (v[i][0] + v[i][1]) + (v[i][2] + v[i][3]); }
        const float mean = wave_sum(s) * (1.f / 2048.f); float q = 0.f;
#pragma unroll
        for (int i = 0; i < 8; ++i) { const f32x4 d = v[i] - mean; q += (d[0] * d[0] + d[1] * d[1]) + (d[2] * d[2] + d[3] * d[3]); }
        const float rstd = rsqrtf(wave_sum(q) * (1.f / 2048.f) + 1e-5f);
#pragma unroll
        for (int i = 0; i < 8; ++i) { const int c = lane * 4 + 256 * i;
            const f32x4 y = (v[i] - mean) * rstd * *(const f32x4*)(lg + c) + *(const f32x4*)(lb + c);
            *(f32x4*)(xp + c) = y;
            const f32x4 hp = y * (*(const f32x4*)(mod + 4 * 2048 + c) + 1.0f) + *(const f32x4*)(mod + 3 * 2048 + c);
            u32x2 w; w.x = cvt_pk_bf16(hp[0], hp[1]); w.y = cvt_pk_bf16(hp[2], hp[3]);
            *(u32x2*)(HB + (size_t)R * 2048 + c) = w; }
    }
}

typedef __bf16 bf16x2_t __attribute__((ext_vector_type(2)));
__device__ __forceinline__ unsigned ordkey(float v) { const unsigned u = __float_as_uint(v); return (u & 0x80000000u) ? ~u : (u | 0x80000000u); }
__device__ __forceinline__ int lane_rank(unsigned long long m) { return (int)__builtin_amdgcn_mbcnt_hi((unsigned)(m >> 32), __builtin_amdgcn_mbcnt_lo((unsigned)m, 0u)); }
template <int NV> __device__ __forceinline__ unsigned radix_thresh16(const unsigned (&k)[NV]) {
    unsigned T = 0u;
    for (int bit = 31; bit >= 0; --bit) { const unsigned cand = T | (1u << bit); int cnt = 0;
#pragma unroll
        for (int v = 0; v < NV; ++v) cnt += __popcll(__ballot(k[v] >= cand));
        if (cnt >= 16) T = cand; }
    return T;
}
__device__ __forceinline__ float dot2bf(unsigned a, unsigned b, float acc) { return __builtin_amdgcn_fdot2_f32_bf16(__builtin_bit_cast(bf16x2_t, a), __builtin_bit_cast(bf16x2_t, b), acc, false); }
__device__ __forceinline__ float dot8(const u32x4 a, const u32x4 b, float acc) {
    acc = dot2bf(a.x, b.x, acc); acc = dot2bf(a.y, b.y, acc); acc = dot2bf(a.z, b.z, acc); acc = dot2bf(a.w, b.w, acc);
    return acc;
}
__device__ __forceinline__ void ph_peer(const Ctx& F0, int layer) {
    const Ctx F = phase_ctx(F0);
    using namespace cf;
    const float* SC = (const float*)(F.ws + WS_P + SC_OFF); const float* X1 = (const float*)(F.ws + WS_P + X1_OFF);
    bf16_t* HB = WSP(bf16_t, WS_HB); const bf16_t* UB = WSP(const bf16_t, WS_UB); const bf16_t* VB2 = WSP(const bf16_t, WS_VB2);
    const float* lg = F.in[I_LN2G] + layer * 2048; const float* lb = F.in[I_LN2B] + layer * 2048;
    const int ntok = layer == 0 ? MR : NB * S, lane = F.lane;
    ldsp_t wl = F.lds + F.wave * 4096;
    LAS float* tv0 = (LAS float*)wl; LAS int* ti0 = (LAS int*)(wl + 64); LAS float* tv1 = (LAS float*)(wl + 128); LAS int* ti1 = (LAS int*)(wl + 192);
    LAS float* es = (LAS float*)(wl + 256); LAS int* ei = (LAS int*)(wl + 768); LAS float* eg = (LAS float*)(wl + 1280);
    for (int tok = F.bid * 8 + F.wave; tok < ntok; tok += F.G * 8) {
        const int R = tok_row(layer, tok), b = R / RB, j = R % RB; const bool isctx = j < CTX; const int modrow = isctx ? 4 : b;
        const float* sc = SC + (size_t)R * 2048;
        for (int h = 0; h < 8; ++h) {
            const float s0a = sc[(2 * h) * 128 + lane], s0b = sc[(2 * h) * 128 + 64 + lane], s1a = sc[(2 * h + 1) * 128 + lane], s1b = sc[(2 * h + 1) * 128 + 64 + lane];
            { const unsigned k[2] = {(ordkey(s0a) & ~127u) | (unsigned)(127 - lane), (ordkey(s0b) & ~127u) | (unsigned)(63 - lane)};
              const unsigned T = radix_thresh16<2>(k);
              const unsigned long long m0 = __ballot(k[0] >= T), m1 = __ballot(k[1] >= T); const int n0 = __popcll(m0);
              if (k[0] >= T) { const int r = lane_rank(m0); tv0[r] = s0a; ti0[r] = lane; }
              if (k[1] >= T) { const int r = n0 + lane_rank(m1); tv0[r] = s0b; ti0[r] = lane + 64; } }
            { const unsigned k[2] = {(ordkey(s1a) & ~127u) | (unsigned)(127 - lane), (ordkey(s1b) & ~127u) | (unsigned)(63 - lane)};
              const unsigned T = radix_thresh16<2>(k);
              const unsigned long long m0 = __ballot(k[0] >= T), m1 = __ballot(k[1] >= T); const int n0 = __popcll(m0);
              if (k[0] >= T) { const int r = lane_rank(m0); tv1[r] = s1a; ti1[r] = lane; }
              if (k[1] >= T) { const int r = n0 + lane_rank(m1); tv1[r] = s1b; ti1[r] = lane + 64; } }
            asm volatile("s_waitcnt lgkmcnt(0)" ::: "memory");
            const int ci = lane >> 2, cj = (lane & 3) * 4;
            const float a0 = tv0[ci]; const int i0 = ti0[ci];
            float c4[4]; int id4[4]; unsigned kc[4];
#pragma unroll
            for (int jj = 0; jj < 4; ++jj) { c4[jj] = a0 + tv1[cj + jj]; id4[jj] = i0 * 128 + ti1[cj + jj]; kc[jj] = (ordkey(c4[jj]) & ~255u) | (unsigned)(255 - (lane * 4 + jj)); }
            const unsigned Tc = radix_thresh16<4>(kc);
            int base = h * 16;
#pragma unroll
            for (int jj = 0; jj < 4; ++jj) { const unsigned long long m = __ballot(kc[jj] >= Tc);
                if (kc[jj] >= Tc) { const int r = base + lane_rank(m); es[r] = c4[jj]; ei[r] = id4[jj]; }
                base += __popcll(m); }
            asm volatile("s_waitcnt lgkmcnt(0)" ::: "memory");
        }
#pragma unroll
        for (int rnd = 0; rnd < 2; ++rnd) { const int e = lane + 64 * rnd; const float s = es[e];
            float m = s; m = fmaxf(m, __shfl_xor(m, 1)); m = fmaxf(m, __shfl_xor(m, 2)); m = fmaxf(m, __shfl_xor(m, 4)); m = fmaxf(m, __shfl_xor(m, 8));
            const float ex = __expf(s - m); float sum = ex; sum += __shfl_xor(sum, 1); sum += __shfl_xor(sum, 2); sum += __shfl_xor(sum, 4); sum += __shfl_xor(sum, 8);
            eg[e] = ex / sum; }
        asm volatile("s_waitcnt lgkmcnt(0)" ::: "memory");
        u32x4 xr[4];
#pragma unroll
        for (int i = 0; i < 4; ++i) xr[i] = *(const u32x4*)(HB + (size_t)R * 2048 + lane * 8 + 512 * i);
        float y[32];
#pragma unroll
        for (int i = 0; i < 32; ++i) y[i] = 0.f;
        for (int grp = 0; grp < 32; ++grp) {
            int id[4]; float gq[4];
#pragma unroll
            for (int q = 0; q < 4; ++q) { id[q] = __builtin_amdgcn_readfirstlane(ei[grp * 4 + q]); gq[q] = __uint_as_float(__builtin_amdgcn_readfirstlane(__float_as_uint(eg[grp * 4 + q]))); }
            u32x4 ur[4][4], vr[4][4];
#pragma unroll
            for (int q = 0; q < 4; ++q)
#pragma unroll
                for (int i = 0; i < 4; ++i) { ur[q][i] = *(const u32x4*)(UB + (size_t)id[q] * 2048 + lane * 8 + 512 * i); vr[q][i] = *(const u32x4*)(VB2 + (size_t)id[q] * 2048 + lane * 8 + 512 * i); }
            float d[4];
#pragma unroll
            for (int q = 0; q < 4; ++q) { float t = 0.f;
#pragma unroll
                for (int i = 0; i < 4; ++i) t = dot8(ur[q][i], xr[i], t);
                d[q] = t; }
#pragma unroll
            for (int o = 32; o >= 1; o >>= 1) {
#pragma unroll
                for (int q = 0; q < 4; ++q) d[q] += __shfl_xor(d[q], o); }
#pragma unroll
            for (int q = 0; q < 4; ++q) { const float w = gq[q] * 0.5f * d[q] * (1.0f + erff(d[q] * 0.70710678118654752f));
#pragma unroll
                for (int i = 0; i < 4; ++i) { const u32x4 vv = vr[q][i];
                    y[8 * i + 0] += w * bflo(vv.x); y[8 * i + 1] += w * bfhi(vv.x); y[8 * i + 2] += w * bflo(vv.y); y[8 * i + 3] += w * bfhi(vv.y);
                    y[8 * i + 4] += w * bflo(vv.z); y[8 * i + 5] += w * bfhi(vv.z); y[8 * i + 6] += w * bflo(vv.w); y[8 * i + 7] += w * bfhi(vv.w); } }
        }
        const float* mod = WSP(const float, WS_MOD) + ((size_t)layer * 5 + modrow) * 12288;
        float s = 0.f;
#pragma unroll
        for (int i = 0; i < 4; ++i) { const int c = lane * 8 + 512 * i;
            const f32x4 xa = *(const f32x4*)(X1 + (size_t)R * 2048 + c), xb = *(const f32x4*)(X1 + (size_t)R * 2048 + c + 4);
            const f32x4 ga = *(const f32x4*)(mod + 5 * 2048 + c), gb = *(const f32x4*)(mod + 5 * 2048 + c + 4);
#pragma unroll
            for (int e = 0; e < 4; ++e) { y[8 * i + e] = ALPHA * xa[e] + ga[e] * y[8 * i + e]; y[8 * i + 4 + e] = ALPHA * xb[e] + gb[e] * y[8 * i + 4 + e]; s += y[8 * i + e] + y[8 * i + 4 + e]; } }
        const float mean = wave_sum(s) * (1.f / 2048.f); float q2 = 0.f;
#pragma unroll
        for (int i = 0; i < 32; ++i) { const float dd = y[i] - mean; q2 += dd * dd; }
        const float rstd = rsqrtf(wave_sum(q2) * (1.f / 2048.f) + 1e-5f);
        float* dst = layer == 0 ? (isctx ? WSP(float, WS_XC) + ((size_t)b * CTX + j) * 2048 : F.out + ((size_t)b * S + (j - CTX)) * 2048) : F.out + ((size_t)b * S + (j - CTX)) * 2048;
        const float* modn = WSP(const float, WS_MOD) + ((size_t)1 * 5 + modrow) * 12288;
#pragma unroll
        for (int i = 0; i < 4; ++i) { const int c = lane * 8 + 512 * i;
            const f32x4 la = *(const f32x4*)(lg + c), lb4 = *(const f32x4*)(lg + c + 4), ba = *(const f32x4*)(lb + c), bb = *(const f32x4*)(lb + c + 4);
            f32x4 oa, ob;
#pragma unroll
            for (int e = 0; e < 4; ++e) { oa[e] = (y[8 * i + e] - mean) * rstd * la[e] + ba[e]; ob[e] = (y[8 * i + 4 + e] - mean) * rstd * lb4[e] + bb[e]; }
            *(f32x4*)(dst + c) = oa; *(f32x4*)(dst + c + 4) = ob;
            if (layer == 0) {
                const f32x4 sa = *(const f32x4*)(modn + 2048 + c), sb = *(const f32x4*)(modn + 2048 + c + 4), ha = *(const f32x4*)(modn + c), hb = *(const f32x4*)(modn + c + 4);
                *(u32x4*)(HB + (size_t)R * 2048 + c) = pg8::pack8(oa * (sa + 1.0f) + ha, ob * (sb + 1.0f) + hb); } }
    }
}

struct Params { const float* in[cf::N_IN]; float* out; unsigned char* ws; int ph_lo, ph_hi; };

__global__ void __launch_bounds__(512, 2) mega_fwd(Params p) {
    using namespace cf;
    extern __shared__ __attribute__((aligned(16))) unsigned char smem[];
    Ctx F0;
    F0.in = p.in;
    F0.out = p.out; F0.ws = p.ws; F0.lds = (ldsp_t)smem;
    F0.tid = threadIdx.x; F0.lane = F0.tid & 63; F0.wave = __builtin_amdgcn_readfirstlane(F0.tid >> 6); F0.G = gridDim.x; F0.bid = blockIdx.x;
    if (F0.tid < 64) ((LAS unsigned*)(F0.lds + MISC_OFF))[F0.tid] = 0u;
    __syncthreads();
    const int lo = p.ph_lo, hi = p.ph_hi;
    XcdBarrier bar; bar.bar = (unsigned*)(F0.ws + WS_CTL); bar.x = 0; bar.st = (volatile LAS unsigned*)(F0.lds + MISC_OFF);
    if (hi - lo > 1) bar = xcd_barrier_post((unsigned*)(F0.ws + WS_CTL), (volatile LAS unsigned*)(F0.lds + MISC_OFF));
#ifndef MK_MASK
#define MK_MASK 0xFFFF
#endif
#define ON(j) ((MK_MASK >> (j)) & 1)
#define IN(k) (lo <= (k) && (k) < hi)
#define SEAM(k) do { if (IN(k) && IN((k) + 1)) xcd_barrier(bar); } while (0)

    if (ON(9) && IN(0)) ph_prologue(F0);
    SEAM(0);
    if (ON(10) && IN(1)) ph_modulate0(F0);
    SEAM(1);
    for (int l = 0; l < DEPTH; ++l) {
        const int pb = 2 + 9 * l;
        const int rmode = l == 0 ? 0 : 1, nMl = l == 0 ? 68 : 64;
        if (ON(0) && IN(pb + 0)) { const Ctx F = phase_ctx(F0); bf16_t* P = WSP(bf16_t, WS_P); bf16_t* HB = WSP(bf16_t, WS_HB);
            if (l > 0) { cvt_rows(F, F.in[I_PU] + (size_t)l * NEXP * 2048, WSP(bf16_t, WS_UB), (size_t)NEXP * 2048 / 8);
                         cvt_rows(F, F.in[I_PV] + (size_t)l * NEXP * 2048, WSP(bf16_t, WS_VB2), (size_t)NEXP * 2048 / 8); }
            pg8::Gemm g{HB, WSP(const bf16_t, WS_WIN) + (size_t)l * NC * 2048, 2048, 2048}; pg8::EpiBf16 E{P, NC};
            pg8::TileOrder S; S.init(nMl, 56, F.G, F.bid, rmode);
            pg8::gemm_phase(F.lds, g, S, E);
            if (l > 0) { pg8::TileOrder S2; S2.init(4, 6, F.G, F.bid, 2); pg8::gemm_phase(F.lds, g, S2, E); }
        }
        SEAM(pb + 0);
        if (ON(1) && IN(pb + 1)) ph_post(F0, l);
        SEAM(pb + 1);
        if (ON(2) && IN(pb + 2)) { const Ctx F = phase_ctx(F0); bf16_t* P = WSP(bf16_t, WS_P);
            { pg8::Gemm g{P + PC_CKV, WSP(const bf16_t, WS_WKVUP) + (size_t)l * 2048 * 256, NC, 256}; pg8::EpiKvUp E{WSP(bf16_t, WS_KB), WSP(bf16_t, WS_VB)};
              pg8::TileOrder S; S.init(68, 8, F.G, F.bid, 0); pg8::gemm_phase(F.lds, g, S, E); }
            { pg8::Gemm g{P + PC_CQ, WSP(const bf16_t, WS_WQUP) + (size_t)l * 1536 * 512, NC, 512}; pg8::EpiQUp E{WSP(bf16_t, WS_QB), WSP(const float, WS_COSR), WSP(const float, WS_SINR)};
              pg8::TileOrder S; S.init(nMl, 6, F.G, F.bid, rmode); pg8::gemm_phase(F.lds, g, S, E); }
        }
        SEAM(pb + 2);
        if (ON(3) && IN(pb + 3)) ph_attn(F0, l);
        SEAM(pb + 3);
        if (ON(4) && IN(pb + 4)) { const Ctx F = phase_ctx(F0); bf16_t* P = WSP(bf16_t, WS_P); bf16_t* HB = WSP(bf16_t, WS_HB);
            for (int br = 0; br < 4; ++br) {
                pg8::Gemm g{WSP(const bf16_t, WS_BR) + br * 1024, WSP(const bf16_t, WS_WBR) + ((size_t)l * 4 + br) * 2048 * 1024, 4096, 1024};
                pg8::EpiMerge E{HB, P + PC_GATE + br * 2048, NC, br == 0};
                pg8::TileOrder S; S.init(nMl, 8, F.G, F.bid, rmode); pg8::gemm_phase(F.lds, g, S, E);
            }
        }
        SEAM(pb + 4);
        if (ON(5) && IN(pb + 5)) { const Ctx F = phase_ctx(F0); bf16_t* HB = WSP(bf16_t, WS_HB);
            pg8::Gemm g{HB, WSP(const bf16_t, WS_WO) + (size_t)l * 2048 * 2048, 2048, 2048};
            pg8::EpiWo E{(float*)(F.ws + WS_P + X1_OFF), WSP(const float, WS_MOD) + (size_t)l * 5 * 12288, l == 0 ? F.in[I_X] : (const float*)F.out, F.in[I_CTX]};
            pg8::TileOrder S; S.init(nMl, 8, F.G, F.bid, rmode); pg8::gemm_phase(F.lds, g, S, E);
        }
        SEAM(pb + 5);
        if (ON(6) && IN(pb + 6)) ph_ln1(F0, l);
        SEAM(pb + 6);
        if (ON(7) && IN(pb + 7)) { const Ctx F = phase_ctx(F0); bf16_t* HB = WSP(bf16_t, WS_HB);
            pg8::Gemm g{HB, WSP(const bf16_t, WS_WFOLD) + (size_t)l * 2048 * 2048, 2048, 2048}; pg8::EpiF32 E{(float*)(F.ws + WS_P + SC_OFF), 2048};
            pg8::TileOrder S; S.init(nMl, 8, F.G, F.bid, rmode); pg8::gemm_phase(F.lds, g, S, E);
        }
        SEAM(pb + 7);
        if (ON(8) && IN(pb + 8)) ph_peer(F0, l);
        SEAM(pb + 8);
    }
#undef IN
#undef SEAM
}

extern "C" void kernel_launch(void* const* d_in, const int* in_sizes, int n_in, void* d_out, int out_size, void* d_ws, size_t ws_size, hipStream_t stream) {
    static int grid = 0;
    if (grid == 0) {
        if (n_in != cf::N_IN || out_size != cf::NB * cf::S * cf::D || ws_size < cf::WS_END) {
            fprintf(stderr, "kernel_launch: unexpected shapes: n_in %d out %d ws %zu (need %zu)\n", n_in, out_size, ws_size, (size_t)cf::WS_END); grid = -1; return; }
        int dev = 0, cus = 0;
        if (hipGetDevice(&dev) != hipSuccess || hipDeviceGetAttribute(&cus, hipDeviceAttributeMultiprocessorCount, dev) != hipSuccess || cus < 1) { grid = -1; return; }
        if (hipFuncSetAttribute((const void*)mega_fwd, hipFuncAttributeMaxDynamicSharedMemorySize, cf::LDS_BYTES) != hipSuccess) { fprintf(stderr, "kernel_launch: hipFuncSetAttribute failed\n"); grid = -1; return; }
        int per_cu = 0;
        if (hipOccupancyMaxActiveBlocksPerMultiprocessor(&per_cu, (const void*)mega_fwd, 512, cf::LDS_BYTES) != hipSuccess || per_cu < 1)
            fprintf(stderr, "kernel_launch: note: occupancy query reports %d workgroups per CU\n", per_cu);
        (void)hipGetLastError();
        grid = cus;
    }
    if (grid < 0) return;
    (void)hipMemsetAsync((char*)d_ws + cf::WS_CTL, 0, cf::CTL_BYTES, stream);
    Params p{};
    for (int i = 0; i < cf::N_IN; ++i) p.in[i] = (const float*)d_in[i];
    p.out = (float*)d_out; p.ws = (unsigned char*)d_ws;
#if MK_PER_PHASE
    for (int k = 0; k < cf::N_PHASES; ++k) { p.ph_lo = k; p.ph_hi = k + 1; hipLaunchKernelGGL(mega_fwd, dim3(grid), dim3(512), cf::LDS_BYTES, stream, p); }
#else
    p.ph_lo = 0; p.ph_hi = cf::N_PHASES;
    hipLaunchKernelGGL(mega_fwd, dim3(grid), dim3(512), cf::LDS_BYTES, stream, p);
#endif
    const hipError_t le = hipPeekAtLastError();
    if (le != hipSuccess) fprintf(stderr, "kernel_launch: launch failed: %s\n", hipGetErrorName(le));
}
```

```cpp
#include <hip/hip_runtime.h>
#include <stdint.h>
#include <stdio.h>

#ifndef MK_DUP
#define MK_DUP 0
#endif
#define DUPN(k) (((MK_DUP >> (k)) & 1) ? 2 : 1)
#ifndef MK_PER_PHASE
#define MK_PER_PHASE 0
#endif

namespace cf {
constexpr int D = 2048, NB = 4, S = 4096, CTX = 256, RB = CTX + S  , MR = NB * RB  ;
constexpr int DEPTH = 2;
constexpr int PC_AK = 0, PC_AV = 256, PC_CKV = 512, PC_KR = 768, PC_DK = 1024, PC_DV = 1280, PC_KVEND = 1536;
constexpr int PC_AQ = 1536, PC_CQ = 2560, PC_DQ = 3072, PC_GLU = 4096, PC_GATE = 6144, NC = 14336;
constexpr int IN_COLS = 14144;
constexpr int NEXP = 16384;
constexpr float ALPHA = 1.4142135623730951f;
constexpr float LOG2E = 1.4426950408889634f;
constexpr float SCALE_HD = 0.08838834764831845f;
constexpr float SCALE_MLA = 0.07216878364870323f;
enum { I_X = 0, I_C, I_CTX, I_CCTX, I_WADA, I_BADA, I_WIN, I_AQN, I_AKN, I_BQN, I_WQUP, I_BKVN, I_WKVUP, I_CW, I_CB, I_CLG, I_CLB, I_SINK,
       I_WBRA, I_WBRB, I_WBRC, I_WBRD, I_WO, I_LN1G, I_LN1B, I_LN2G, I_LN2B, I_PWQ, I_PSK, I_PU, I_PV, N_IN };
constexpr size_t al(size_t x) { return (x + 255) / 256 * 256; }
constexpr size_t WS_CTL = 0;
constexpr size_t CTL_BYTES = 65536;
constexpr size_t WS_MOD = WS_CTL + CTL_BYTES;
constexpr size_t WS_COSH = WS_MOD + al((size_t)2 * 5 * 12288 * 4);
constexpr size_t WS_SINH = WS_COSH + (size_t)4096 * 64 * 4;
constexpr size_t WS_COSR = WS_SINH + (size_t)4096 * 64 * 4;
constexpr size_t WS_SINR = WS_COSR + (size_t)4096 * 32 * 4;
constexpr size_t WS_WIN = WS_SINR + (size_t)4096 * 32 * 4;
constexpr size_t WS_WQUP = WS_WIN + (size_t)2 * NC * 2048 * 2;
constexpr size_t WS_WKVUP = WS_WQUP + (size_t)2 * 1536 * 512 * 2;
constexpr size_t WS_WBR = WS_WKVUP + (size_t)2 * 2048 * 256 * 2;
constexpr size_t WS_WO = WS_WBR + (size_t)2 * 4 * 2048 * 1024 * 2;
constexpr size_t WS_WFOLD = WS_WO + (size_t)2 * 2048 * 2048 * 2;
constexpr size_t WS_UB = WS_WFOLD + (size_t)2 * 2048 * 2048 * 2;
constexpr size_t WS_VB2 = WS_UB + (size_t)2 * NEXP * 2048;
constexpr size_t WS_HB = WS_VB2 + (size_t)2 * NEXP * 2048;
constexpr size_t WS_P = WS_HB + (size_t)MR * 2048 * 2;
constexpr size_t WS_QB = WS_P + (size_t)MR * NC * 2;
constexpr size_t WS_KB = WS_QB + (size_t)MR * 1536 * 2;
constexpr size_t WS_VB = WS_KB + (size_t)MR * 1536 * 2;
constexpr size_t WS_BR = WS_VB + (size_t)MR * 1024 * 2;
constexpr size_t WS_XC = WS_BR + (size_t)MR * 4096 * 2;
constexpr size_t WS_END = WS_XC + (size_t)1024 * 2048 * 4;
constexpr size_t X1_OFF = 0, SC_OFF = (size_t)MR * 2048 * 4;
static_assert(SC_OFF * 2 <= (size_t)MR * NC * 2, "X1 + SC fit in P");
constexpr int LDS_BYTES = 132 * 1024;
constexpr int MISC_OFF = 128 * 1024;
constexpr int N_PHASES = 2 + 9 * DEPTH;
}

typedef unsigned short bf16_t;
typedef short bf16x8 __attribute__((ext_vector_type(8)));
typedef float f32x4 __attribute__((ext_vector_type(4)));
typedef float f32x2 __attribute__((ext_vector_type(2)));
typedef unsigned u32x4 __attribute__((ext_vector_type(4)));
typedef unsigned u32x2 __attribute__((ext_vector_type(2)));
#define LAS __attribute__((address_space(3)))
typedef LAS unsigned char* ldsp_t;

__device__ __forceinline__ unsigned cvt_pk_bf16(float lo, float hi) { unsigned r; asm volatile("v_cvt_pk_bf16_f32 %0, %1, %2" : "=v"(r) : "v"(lo), "v"(hi)); return r; }
__device__ __forceinline__ bf16_t f2bf(float f) { return (bf16_t)(cvt_pk_bf16(f, 0.f) & 0xffffu); }
__device__ __forceinline__ float bf2f(bf16_t b) { return __uint_as_float(((unsigned)b) << 16); }
__device__ __forceinline__ float bflo(unsigned w) { return __uint_as_float(w << 16); }
__device__ __forceinline__ float bfhi(unsigned w) { return __uint_as_float(w & 0xffff0000u); }
__device__ __forceinline__ float wave_sum(float v) {
#pragma unroll
    for (int o = 32; o >= 1; o >>= 1) v += __shfl_xor(v, o);
    return v;
}
__device__ __forceinline__ float sigmoidf_(float x) { return 1.0f / (1.0f + __expf(-x)); }

#define XB_TMO      128
#define XB_XCNT(j)  (256  + 64 * (j))
#define XB_XSUB(j)  (1280 + 64 * (j))
#define XB_XGEN(j)  (2304 + 64 * (j))
#define XB_TOP      3328
#define XB_TOPGEN   3392
#define XCD_BAR_WORDS 3456
#define XB_SPIN_CAP (1u << 23)
__device__ __forceinline__ unsigned xb_ld(unsigned* p)              { return __hip_atomic_load(p, __ATOMIC_RELAXED, __HIP_MEMORY_SCOPE_AGENT); }
__device__ __forceinline__ unsigned xb_add(unsigned* p, unsigned v) { return __hip_atomic_fetch_add(p, v, __ATOMIC_RELAXED, __HIP_MEMORY_SCOPE_AGENT); }
__device__ __forceinline__ unsigned xb_xcc_id() { return (unsigned)__builtin_amdgcn_s_getreg((3 << 11) | 20) & 0xFu; }
#define XB_SPIN(cond, bar) do { unsigned _sp = 0; while (cond) { __builtin_amdgcn_s_sleep(1); \
    if ((++_sp & 255u) == 0u) { if (xb_ld(&(bar)[XB_TMO])) break; if (_sp > XB_SPIN_CAP) { atomicAdd(&(bar)[XB_TMO], 1u); break; } } } } while (0)
struct XcdBarrier { unsigned* bar; unsigned x; volatile LAS unsigned* st; };
__device__ __forceinline__ XcdBarrier xcd_barrier_post(unsigned* bar, volatile LAS unsigned* st) {
    XcdBarrier b; b.bar = bar; b.x = xb_xcc_id(); b.st = st;
    if (threadIdx.x == 0) (void)xb_add(&bar[XB_XCNT(b.x)], 1u);
    return b;
}
__device__ __forceinline__ void xcd_barrier_complete(unsigned* bar, unsigned x, unsigned& nloc, unsigned& nx) {
    const unsigned G = gridDim.x * gridDim.y * gridDim.z;
    unsigned sum, cnt, mine, sp = 0u;
    for (;;) {
        sum = 0u; cnt = 0u; mine = 0u;
#pragma unroll
        for (unsigned j = 0; j < 16; ++j) { const unsigned c = xb_ld(&bar[XB_XCNT(j)]); sum += c; cnt += (c > 0u) ? 1u : 0u; mine = (j == x) ? c : mine; }
        if (sum == G) break;
        __builtin_amdgcn_s_sleep(1);
        if ((++sp & 255u) == 0u) { if (xb_ld(&bar[XB_TMO])) break; if (sp > XB_SPIN_CAP) { atomicAdd(&bar[XB_TMO], 1u); break; } }
    }
    nloc = mine > 0u ? mine : 1u; nx = cnt > 0u ? cnt : 1u;
}
__device__ __forceinline__ void xcd_barrier(const XcdBarrier& b) {
    asm volatile("s_waitcnt vmcnt(0)" ::: "memory");
    __syncthreads();
    if (threadIdx.x == 0) {
        unsigned* bar = b.bar;
        __builtin_amdgcn_s_waitcnt(0);
        unsigned nloc = b.st[0], nx = b.st[1];
        if (nloc == 0u) { xcd_barrier_complete(bar, b.x, nloc, nx); b.st[0] = nloc; b.st[1] = nx; }
        const unsigned old = xb_add(&bar[XB_XSUB(b.x)], 1u);
        const unsigned gen = old / nloc;
        if (old + 1u == (gen + 1u) * nloc) {
            __builtin_amdgcn_fence(__ATOMIC_RELEASE, "agent");
            asm volatile("s_waitcnt vmcnt(0)" ::: "memory");
            const unsigned og = xb_add(&bar[XB_TOP], 1u);
            const unsigned tg = og / nx;
            if (og + 1u == (tg + 1u) * nx) xb_add(&bar[XB_TOPGEN], 1u);
            else XB_SPIN(xb_ld(&bar[XB_TOPGEN]) == tg, bar);
            __builtin_amdgcn_fence(__ATOMIC_ACQUIRE, "agent");
            xb_add(&bar[XB_XGEN(b.x)], 1u);
            asm volatile("s_waitcnt vmcnt(0)" ::: "memory");
        } else {
            XB_SPIN(xb_ld(&bar[XB_XGEN(b.x)]) == gen, bar);
            __builtin_amdgcn_fence(__ATOMIC_ACQUIRE, "agent");
            asm volatile("s_waitcnt vmcnt(0)" ::: "memory");
        }
    }
    __syncthreads();
}

namespace pg8 {
constexpr int BM = 256, BK = 64, HALF = 128, HTB = HALF * BK * 2, STAGE_BYTES = 8 * HTB, NXCD = 8, WGM = 8;
__host__ __device__ __forceinline__ int lds_byte(int r, int c) { const int st = (r >> 4) * 2 + (c >> 5), rr = r & 15, cc = c & 31, ob = rr * 64 + cc * 2; return st * 1024 + (ob ^ (((ob >> 9) & 1) << 5)); }
__host__ __device__ __forceinline__ void stage_rc(int b, int& R, int& C) { const int st = b / 1024, sb = b % 1024, swz = sb ^ (((sb >> 9) & 1) << 5); R = (st >> 1) * 16 + swz / 64; C = (st & 1) * 32 + (swz % 64) / 2; }
__host__ __device__ __forceinline__ int perm32(int rho) { const int n = rho >> 4, i = rho & 15; return 8 * (i >> 2) + 4 * n + (i & 3); }
struct Unit { int pm, pn; };
struct Gemm { const bf16_t* A; const bf16_t* Bt; int lda, K; };

struct TileOrder {
    int nM, nN, nwg, G, c, mode;
    __device__ void init(int nM_, int nN_, int G_, int c_, int mode_) { nM = nM_; nN = nN_; nwg = nM * nN; G = G_; c = c_; mode = mode_; }
    __device__ bool next(int i, Unit& u) const {
        const long L = (long)i * G + c; if (L >= nwg) return false;
        int wgid = (int)L; { const int q = nwg / NXCD, r = nwg % NXCD, xcd = wgid % NXCD, off = wgid / NXCD; wgid = (xcd < r ? xcd * (q + 1) : r * (q + 1) + (xcd - r) * q) + off; }
        const int nig = WGM * nN, gid = wgid / nig, fm = gid * WGM, gsz = (nM - fm) < WGM ? (nM - fm) : WGM;
        const int pl = fm + ((wgid % nig) % gsz); u.pn = (wgid % nig) / gsz;
        u.pm = mode == 0 ? pl : (mode == 1 ? 17 * (pl >> 4) + 1 + (pl & 15) : 17 * pl);
        return true;
    }
    __device__ __forceinline__ void a_ready(const Unit&) const {}
    __device__ __forceinline__ void done(const Unit&) const {}
};

template <class Epi, class Sched>
__device__ __forceinline__ void gemm_phase(ldsp_t lds, const Gemm g, const Sched& S, const Epi& E) {
    int tid = threadIdx.x; asm volatile("" : "+v"(tid));
    const int wid = __builtin_amdgcn_readfirstlane(tid >> 6), lane = tid & 63, wr = wid >> 2, wc = wid & 3, fr = lane & 15, fq = lane >> 4;
    int K = g.K; asm volatile("" : "+s"(K));
    const int nt = K / BK, lda = g.lda;
    unsigned voffA[2], voffB[2];
#pragma unroll
    for (int i = 0; i < 2; ++i) { int R, C; stage_rc(tid * 16 + i * 8192, R, C); const int Rb = (R & ~31) + perm32(R & 31);
        voffA[i] = (unsigned)(R * lda + C) * 2u; voffB[i] = (unsigned)(Rb * K + C) * 2u; }
    const size_t kstep = (size_t)(BK * 2);
    const size_t hstepA = (size_t)HALF * lda * 2, hstepB = (size_t)HALF * K * 2;
    const size_t tstepA = 2 * hstepA, tstepB = 2 * hstepB;
    const unsigned ldsw = (unsigned)wid * 1024u;
    const int aoff = lds_byte(wr * 64 + fr, fq * 8), boff = lds_byte(wc * 32 + fr, fq * 8);
#define PG8_SA(b, h) (((b) * 2 + (h)) * HTB)
#define PG8_SB(b, h) ((4 + (b) * 2 + (h)) * HTB)
#define PG8_STAGE(bufoff, gbase, voff) do { _Pragma("unroll") for (int _i = 0; _i < 2; ++_i) \
        __builtin_amdgcn_global_load_lds((const unsigned*)((const char*)(gbase) + (voff)[_i]), (LAS unsigned*)(lds + (bufoff) + ldsw + _i * 8192), 16, 0, 0); } while (0)
#define PG8_LDA(dst, b, h) do { _Pragma("unroll") for (int m = 0; m < 4; ++m) _Pragma("unroll") for (int k = 0; k < 2; ++k) dst[m][k] = *(const LAS bf16x8*)(lds + PG8_SA(b, h) + aoff + m * 2048 + k * 1024); } while (0)
#define PG8_LDB(dst, b, h) do { _Pragma("unroll") for (int n = 0; n < 2; ++n) _Pragma("unroll") for (int k = 0; k < 2; ++k) dst[n][k] = *(const LAS bf16x8*)(lds + PG8_SB(b, h) + boff + n * 2048 + k * 1024); } while (0)
#define PG8_MMA(ai, bj, At, Bt) do { __builtin_amdgcn_s_setprio(1); _Pragma("unroll") for (int m = 0; m < 4; ++m) _Pragma("unroll") for (int n = 0; n < 2; ++n) _Pragma("unroll") for (int k = 0; k < 2; ++k) \
        acc[ai][bj][m][n] = __builtin_amdgcn_mfma_f32_16x16x32_bf16(Bt[n][k], At[m][k], acc[ai][bj][m][n], 0, 0, 0); __builtin_amdgcn_s_setprio(0); } while (0)
#define PG8_WAIT_V(n) asm volatile("s_waitcnt vmcnt(" #n ")" ::: "memory")
#define PG8_WAIT_L(n) asm volatile("s_waitcnt lgkmcnt(" #n ")" ::: "memory")
#define PG8_BAR __builtin_amdgcn_s_barrier()
#define PG8_SCHED __builtin_amdgcn_sched_barrier(0)
    Unit cur, nxt; int ui = 0;
    if (!S.next(0, cur)) return;
    f32x4 acc[2][2][4][2];
#pragma unroll
    for (int a = 0; a < 2; ++a)
#pragma unroll
        for (int b = 0; b < 2; ++b)
#pragma unroll
            for (int m = 0; m < 4; ++m)
#pragma unroll
                for (int n = 0; n < 2; ++n) acc[a][b][m][n] = (f32x4){0.f, 0.f, 0.f, 0.f};
    bf16x8 At[4][2], B0[2][2], B1[2][2];
    const char* cA = (const char*)g.A + (size_t)cur.pm * tstepA; const char* cB = (const char*)g.Bt + (size_t)cur.pn * tstepB;
    S.a_ready(cur);
    PG8_STAGE(PG8_SB(0, 0), cB, voffB); PG8_STAGE(PG8_SA(0, 0), cA, voffA); PG8_STAGE(PG8_SB(0, 1), cB + hstepB, voffB); PG8_STAGE(PG8_SA(0, 1), cA + hstepA, voffA);
    if (wr == 1) PG8_BAR;
    PG8_WAIT_V(4); PG8_BAR;
    PG8_STAGE(PG8_SB(1, 0), cB + kstep, voffB); PG8_STAGE(PG8_SA(1, 0), cA + kstep, voffA); PG8_STAGE(PG8_SB(1, 1), cB + hstepB + kstep, voffB);
    PG8_WAIT_V(6); PG8_BAR;
    for (;;) {
        const bool has_next = S.next(ui + 1, nxt);
        const char* nA = has_next ? (const char*)g.A + (size_t)nxt.pm * tstepA : cA; const char* nB = has_next ? (const char*)g.Bt + (size_t)nxt.pn * tstepB : cB;
#pragma unroll 1
        for (int t = 0; t < nt; t += 2) {
            const bool last = (t == nt - 2);
            const char* a1 = cA + (size_t)(t + 1) * kstep;
            const char* a2 = last ? nA : cA + (size_t)(t + 2) * kstep; const char* b2 = last ? nB : cB + (size_t)(t + 2) * kstep;
            const char* a3 = a2 + kstep; const char* b3 = b2 + kstep;
            if (last && has_next) S.a_ready(nxt);
            PG8_LDB(B0, 0, 0); PG8_SCHED; PG8_LDA(At, 0, 0); PG8_STAGE(PG8_SA(1, 1), a1 + hstepA, voffA);
            PG8_WAIT_L(8); PG8_BAR; PG8_WAIT_L(0); PG8_MMA(0, 0, At, B0); PG8_BAR; PG8_SCHED;
            PG8_LDB(B1, 0, 1); PG8_STAGE(PG8_SB(0, 0), b2, voffB);
            PG8_BAR; PG8_WAIT_L(0); PG8_MMA(0, 1, At, B1); PG8_BAR;
            PG8_LDA(At, 0, 1); PG8_STAGE(PG8_SA(0, 0), a2, voffA);
            PG8_BAR; PG8_WAIT_L(0); PG8_MMA(1, 0, At, B0); PG8_BAR; PG8_SCHED;
            PG8_STAGE(PG8_SB(0, 1), b2 + hstepB, voffB);
            PG8_WAIT_V(6); PG8_BAR; PG8_MMA(1, 1, At, B1); PG8_BAR;
            PG8_LDB(B0, 1, 0); PG8_SCHED; PG8_LDA(At, 1, 0); PG8_STAGE(PG8_SA(0, 1), a2 + hstepA, voffA);
            PG8_WAIT_L(8); PG8_BAR; PG8_WAIT_L(0); PG8_MMA(0, 0, At, B0); PG8_BAR; PG8_SCHED;
            PG8_LDB(B1, 1, 1); PG8_STAGE(PG8_SB(1, 0), b3, voffB);
            PG8_BAR; PG8_WAIT_L(0); PG8_MMA(0, 1, At, B1); PG8_BAR;
            PG8_LDA(At, 1, 1); PG8_STAGE(PG8_SA(1, 0), a3, voffA);
            PG8_BAR; PG8_WAIT_L(0); PG8_MMA(1, 0, At, B0); PG8_BAR; PG8_SCHED;
            PG8_STAGE(PG8_SB(1, 1), b3 + hstepB, voffB);
            PG8_WAIT_V(6); PG8_BAR; PG8_MMA(1, 1, At, B1); PG8_BAR;
        }
        E(acc, cur, wr, wc, fr, fq); S.done(cur);
        if (!has_next) break;
#pragma unroll
        for (int a = 0; a < 2; ++a)
#pragma unroll
            for (int b = 0; b < 2; ++b)
#pragma unroll
                for (int m = 0; m < 4; ++m)
#pragma unroll
                    for (int n = 0; n < 2; ++n) acc[a][b][m][n] = (f32x4){0.f, 0.f, 0.f, 0.f};
        cur = nxt; cA = nA; cB = nB; ++ui;
    }
    PG8_WAIT_V(0);
    if (wr == 0) PG8_BAR;
    PG8_BAR;
#undef PG8_SA
#undef PG8_SB
#undef PG8_STAGE
#undef PG8_LDA
#undef PG8_LDB
#undef PG8_MMA
#undef PG8_WAIT_V
#undef PG8_WAIT_L
#undef PG8_BAR
#undef PG8_SCHED
}

__device__ __forceinline__ u32x4 pack8(const f32x4 a, const f32x4 b) { u32x4 w; w.x = cvt_pk_bf16(a[0], a[1]); w.y = cvt_pk_bf16(a[2], a[3]); w.z = cvt_pk_bf16(b[0], b[1]); w.w = cvt_pk_bf16(b[2], b[3]); return w; }
#define EPI_ARGS const f32x4 (&acc)[2][2][4][2], const Unit& u, int wr, int wc, int fr_, int fq_
#define EPI_LANE int fr = fr_, fq = fq_; asm volatile("" : "+v"(fr), "+v"(fq));

struct EpiBf16 {
    bf16_t* O; int ldc;
    __device__ __forceinline__ void operator()(EPI_ARGS) const {
        EPI_LANE
        const int row0 = u.pm * BM + wr * 64 + fr, col0 = u.pn * BM + wc * 32 + 8 * fq;
#pragma unroll
        for (int ai = 0; ai < 2; ++ai)
#pragma unroll
            for (int m = 0; m < 4; ++m) { bf16_t* rowp = O + (size_t)(row0 + ai * HALF + m * 16) * ldc + col0;
#pragma unroll
                for (int bj = 0; bj < 2; ++bj) *(u32x4*)(rowp + bj * HALF) = pack8(acc[ai][bj][m][0], acc[ai][bj][m][1]); }
    }
};
struct EpiF32 {
    float* C; int ldc;
    __device__ __forceinline__ void operator()(EPI_ARGS) const {
        EPI_LANE
        const int row0 = u.pm * BM + wr * 64 + fr, col0 = u.pn * BM + wc * 32 + 8 * fq;
#pragma unroll
        for (int ai = 0; ai < 2; ++ai)
#pragma unroll
            for (int m = 0; m < 4; ++m) { float* rowp = C + (size_t)(row0 + ai * HALF + m * 16) * ldc + col0;
#pragma unroll
                for (int bj = 0; bj < 2; ++bj) { *(f32x4*)(rowp + bj * HALF) = acc[ai][bj][m][0]; *(f32x4*)(rowp + bj * HALF + 4) = acc[ai][bj][m][1]; } }
    }
};
struct EpiKvUp {
    bf16_t* KB; bf16_t* VB;
    __device__ __forceinline__ void operator()(EPI_ARGS) const {
        EPI_LANE
        const int row0 = u.pm * BM + wr * 64 + fr, d0 = wc * 32 + 8 * fq;
        const bool isk = u.pn < 4;
        bf16_t* base = isk ? KB + (2 * u.pn) * 192 + d0 : VB + (u.pn - 4) * 256 + d0;
        const int ldr = isk ? 1536 : 1024, bjs = isk ? 192 : 128;
#pragma unroll
        for (int ai = 0; ai < 2; ++ai)
#pragma unroll
            for (int m = 0; m < 4; ++m) { bf16_t* rowp = base + (size_t)(row0 + ai * HALF + m * 16) * ldr;
#pragma unroll
                for (int bj = 0; bj < 2; ++bj) *(u32x4*)(rowp + bj * bjs) = pack8(acc[ai][bj][m][0], acc[ai][bj][m][1]); }
    }
};
struct EpiQUp {
    bf16_t* QB; const float* cosr; const float* sinr;
    __device__ __forceinline__ void operator()(EPI_ARGS) const {
        EPI_LANE
        const int row0 = u.pm * BM + wr * 64 + fr;
        if (u.pn < 4) {
            const int d0 = wc * 32 + 8 * fq;
#pragma unroll
            for (int ai = 0; ai < 2; ++ai)
#pragma unroll
                for (int m = 0; m < 4; ++m) { const size_t row = (size_t)(row0 + ai * HALF + m * 16);
#pragma unroll
                    for (int bj = 0; bj < 2; ++bj) *(u32x4*)(QB + row * 1536 + (2 * u.pn + bj) * 192 + d0) = pack8(acc[ai][bj][m][0], acc[ai][bj][m][1]); }
        } else {
            const int head = 4 * (u.pn - 4) + wc, i0 = 8 * fq;
            const bool lat = (u.pm % 17) != 0; const int posbase = (u.pm % 17) * 256 - 256;
#pragma unroll
            for (int ai = 0; ai < 2; ++ai)
#pragma unroll
                for (int m = 0; m < 4; ++m) { const int rl = wr * 64 + fr + ai * HALF + m * 16; const size_t row = (size_t)u.pm * BM + rl;
                    f32x4 c0 = {1.f, 1.f, 1.f, 1.f}, c1 = c0, s0 = {0.f, 0.f, 0.f, 0.f}, s1 = s0;
                    if (lat) { const float* cp = cosr + (size_t)(posbase + rl) * 32 + i0; const float* sp = sinr + (size_t)(posbase + rl) * 32 + i0;
                        c0 = *(const f32x4*)cp; c1 = *(const f32x4*)(cp + 4); s0 = *(const f32x4*)sp; s1 = *(const f32x4*)(sp + 4); }
                    const f32x4 x1a = acc[ai][0][m][0], x1b = acc[ai][0][m][1], x2a = acc[ai][1][m][0], x2b = acc[ai][1][m][1];
                    const f32x4 o1a = x1a * c0 - x2a * s0, o1b = x1b * c1 - x2b * s1, o2a = x2a * c0 + x1a * s0, o2b = x2b * c1 + x1b * s1;
                    bf16_t* dst = QB + row * 1536 + head * 192 + 128 + i0;
                    *(u32x4*)dst = pack8(o1a, o1b); *(u32x4*)(dst + 32) = pack8(o2a, o2b); asm volatile("" ::: "memory"); }
        }
    }
};
struct EpiMerge {
    bf16_t* ACC; const bf16_t* gate; int ldg; int first;
    __device__ __forceinline__ void operator()(EPI_ARGS) const {
        EPI_LANE
        const int row0 = u.pm * BM + wr * 64 + fr, col0 = u.pn * BM + wc * 32 + 8 * fq;
#pragma unroll
        for (int ai = 0; ai < 2; ++ai)
#pragma unroll
            for (int m = 0; m < 4; ++m) { const size_t row = (size_t)(row0 + ai * HALF + m * 16);
#pragma unroll
                for (int bj = 0; bj < 2; ++bj) { const int col = col0 + bj * HALF;
                    const u32x4 gw = *(const u32x4*)(gate + row * ldg + col);
                    u32x4 pw = {0u, 0u, 0u, 0u}; if (!first) pw = *(const u32x4*)(ACC + row * 2048 + col);
                    const f32x4 a0 = acc[ai][bj][m][0], a1 = acc[ai][bj][m][1];
                    f32x4 r0, r1;
                    r0[0] = bflo(pw.x) + sigmoidf_(bflo(gw.x)) * a0[0]; r0[1] = bfhi(pw.x) + sigmoidf_(bfhi(gw.x)) * a0[1];
                    r0[2] = bflo(pw.y) + sigmoidf_(bflo(gw.y)) * a0[2]; r0[3] = bfhi(pw.y) + sigmoidf_(bfhi(gw.y)) * a0[3];
                    r1[0] = bflo(pw.z) + sigmoidf_(bflo(gw.z)) * a1[0]; r1[1] = bfhi(pw.z) + sigmoidf_(bfhi(gw.z)) * a1[1];
                    r1[2] = bflo(pw.w) + sigmoidf_(bflo(gw.w)) * a1[2]; r1[3] = bfhi(pw.w) + sigmoidf_(bfhi(gw.w)) * a1[3];
                    *(u32x4*)(ACC + row * 2048 + col) = pack8(r0, r1); } asm volatile("" ::: "memory"); }
    }
};
struct EpiWo {
    float* X1; const float* mod  ; const float* xlat  ; const float* xctx  ;
    __device__ __forceinline__ void operator()(EPI_ARGS) const {
        EPI_LANE
        const int b = u.pm / 17, tb = u.pm % 17; const bool isctx = tb == 0;
        const float* g1 = mod + (size_t)(isctx ? 4 : b) * 12288 + 2 * 2048;
        const float* xbase = isctx ? xctx + (size_t)b * cf::CTX * 2048 : xlat + ((size_t)b * cf::S + (size_t)(tb - 1) * 256) * 2048;
        const int rl0 = wr * 64 + fr, col0 = u.pn * BM + wc * 32 + 8 * fq;
#pragma unroll
        for (int ai = 0; ai < 2; ++ai)
#pragma unroll
            for (int m = 0; m < 4; ++m) { const int rl = rl0 + ai * HALF + m * 16; const size_t row = (size_t)u.pm * BM + rl;
#pragma unroll
                for (int bj = 0; bj < 2; ++bj) { const int col = col0 + bj * HALF;
                    const f32x4 x0 = *(const f32x4*)(xbase + (size_t)rl * 2048 + col), x1 = *(const f32x4*)(xbase + (size_t)rl * 2048 + col + 4);
                    const f32x4 ga = *(const f32x4*)(g1 + col), gb = *(const f32x4*)(g1 + col + 4);
                    *(f32x4*)(X1 + row * 2048 + col) = x0 * cf::ALPHA + ga * acc[ai][bj][m][0];
                    *(f32x4*)(X1 + row * 2048 + col + 4) = x1 * cf::ALPHA + gb * acc[ai][bj][m][1]; } asm volatile("" ::: "memory"); }
    }
};
}

struct Ctx {
    const float* const* in; float* out; unsigned char* ws;
    ldsp_t lds; int tid, lane, wave, G, bid;
};
#define WSP(T, off) ((T*)(F.ws + (off)))
__device__ __forceinline__ Ctx phase_ctx(const Ctx& F0) {
    Ctx C = F0;
    asm volatile("" : "+v"(C.tid));
    asm volatile("" : "+s"(C.ws));
    C.lane = C.tid & 63; C.wave = __builtin_amdgcn_readfirstlane(C.tid >> 6);
    return C;
}

__device__ __forceinline__ int srcmap(int mode, int n) {
    if (mode == 0) return n < 832 ? n : (n < 1024 ? -1 : n - 192);
    if (mode == 1) { if (n < 1024) return (n >> 7) * 192 + (n & 127);
        const int m = n - 1024, t = m >> 8, bj = (m >> 7) & 1, q = m & 127; return (4 * t + (q >> 5)) * 192 + 128 + bj * 32 + (q & 31); }
    if (mode == 2) { if (n < 1024) return (n >> 7) * 256 + (n & 127); const int m = n - 1024; return (m >> 7) * 256 + 128 + (m & 127); }
    return n;
}
__device__ __forceinline__ void tr_tile(const Ctx& F, const float* src, int ld_src, int mode, int k0, bf16_t* dst, int ldd, int n0) {
    LAS float* T = (LAS float*)F.lds;
    const int kr = F.tid >> 4, nc = (F.tid & 15) * 4, sc = srcmap(mode, n0 + nc);
#pragma unroll
    for (int h = 0; h < 2; ++h) { const int k = kr + 32 * h; f32x4 v = {0.f, 0.f, 0.f, 0.f};
        if (sc >= 0) v = *(const f32x4*)(src + (size_t)(k0 + k) * ld_src + sc);
        T[k * 65 + nc + 0] = v[0]; T[k * 65 + nc + 1] = v[1]; T[k * 65 + nc + 2] = v[2]; T[k * 65 + nc + 3] = v[3]; }
    __syncthreads();
    const int n = F.tid >> 3, kc = (F.tid & 7) * 8;
    u32x4 w;
    w.x = cvt_pk_bf16(T[(kc + 0) * 65 + n], T[(kc + 1) * 65 + n]); w.y = cvt_pk_bf16(T[(kc + 2) * 65 + n], T[(kc + 3) * 65 + n]);
    w.z = cvt_pk_bf16(T[(kc + 4) * 65 + n], T[(kc + 5) * 65 + n]); w.w = cvt_pk_bf16(T[(kc + 6) * 65 + n], T[(kc + 7) * 65 + n]);
    *(u32x4*)(dst + (size_t)(n0 + n) * ldd + k0 + kc) = w;
    __syncthreads();
}
__device__ __forceinline__ void cvt_rows(const Ctx& F, const float* src, bf16_t* dst, size_t n8) {
    for (size_t i = (size_t)F.bid * 512 + F.tid; i < n8; i += (size_t)F.G * 512) {
        const f32x4 a = *(const f32x4*)(src + i * 8), b = *(const f32x4*)(src + i * 8 + 4);
        *(u32x4*)(dst + i * 8) = pg8::pack8(a, b); }
}

__device__ __forceinline__ void cvt_rows_fp8(const Ctx& F, const float* src, unsigned char* dst, size_t n16, float scale) {
    for (size_t i = (size_t)F.bid * 512 + F.tid; i < n16; i += (size_t)F.G * 512) {
        u32x4 w;
#pragma unroll
        for (int j = 0; j < 4; ++j) { const f32x4 a = *(const f32x4*)(src + i * 16 + 4 * j) * scale;
            int p = 0; p = __builtin_amdgcn_cvt_pk_fp8_f32(a[0], a[1], p, false); p = __builtin_amdgcn_cvt_pk_fp8_f32(a[2], a[3], p, true); w[j] = (unsigned)p; }
        *(u32x4*)(dst + i * 16) = w; }
}

__device__ __forceinline__ void ph_prologue(const Ctx& F0) {
    const Ctx F = phase_ctx(F0);
    using namespace cf;
    constexpr int T_WIN = 2 * 32 * 224, T_QUP = 2 * 8 * 24, T_KVUP = 2 * 4 * 32, T_BR = 2 * 4 * 16 * 32, T_WO = 2 * 32 * 32;
    constexpr int T_ALL = T_WIN + T_QUP + T_KVUP + T_BR + T_WO;
    for (int u = F.bid; u < T_ALL; u += F.G) {
        int t = u;
        if (t < T_WIN) { const int l = t / (32 * 224), r = t % (32 * 224), kt = r / 224, nt = r % 224;
            tr_tile(F, F.in[I_WIN] + (size_t)l * 2048 * IN_COLS, IN_COLS, 0, kt * 64, WSP(bf16_t, WS_WIN) + (size_t)l * NC * 2048, 2048, nt * 64); continue; }
        t -= T_WIN;
        if (t < T_QUP) { const int l = t / (8 * 24), r = t % (8 * 24), kt = r / 24, nt = r % 24;
            tr_tile(F, F.in[I_WQUP] + (size_t)l * 512 * 1536, 1536, 1, kt * 64, WSP(bf16_t, WS_WQUP) + (size_t)l * 1536 * 512, 512, nt * 64); continue; }
        t -= T_QUP;
        if (t < T_KVUP) { const int l = t / (4 * 32), r = t % (4 * 32), kt = r / 32, nt = r % 32;
            tr_tile(F, F.in[I_WKVUP] + (size_t)l * 256 * 2048, 2048, 2, kt * 64, WSP(bf16_t, WS_WKVUP) + (size_t)l * 2048 * 256, 256, nt * 64); continue; }
        t -= T_KVUP;
        if (t < T_BR) { const int l = t / (4 * 512), r = t % (4 * 512), br = r / 512, r2 = r % 512, kt = r2 / 32, nt = r2 % 32;
            const float* src = (br == 0 ? F.in[I_WBRA] : br == 1 ? F.in[I_WBRB] : br == 2 ? F.in[I_WBRC] : F.in[I_WBRD]) + (size_t)l * 1024 * 2048;
            tr_tile(F, src, 2048, 3, kt * 64, WSP(bf16_t, WS_WBR) + ((size_t)l * 4 + br) * 2048 * 1024, 1024, nt * 64); continue; }
        t -= T_BR;
        { const int l = t / 1024, r = t % 1024, kt = r / 32, nt = r % 32;
            tr_tile(F, F.in[I_WO] + (size_t)l * 2048 * 2048, 2048, 3, kt * 64, WSP(bf16_t, WS_WO) + (size_t)l * 2048 * 2048, 2048, nt * 64); }
    }
    for (int u = F.bid; u < 2 * 16 * 32; u += F.G) {
        const int l = u / 512, g = (u % 512) / 32, d0 = (u % 32) * 64;
        LAS float* sk = (LAS float*)F.lds; LAS float* wt = (LAS float*)(F.lds + 128 * 129 * 4);
        const float* skg = F.in[I_PSK] + ((size_t)l * 16 + g) * 128 * 128;
        const float* wqg = F.in[I_PWQ] + (size_t)l * 2048 * 2048 + (size_t)d0 * 2048 + g * 128;
        for (int i = F.tid; i < 128 * 128; i += 512) sk[(i >> 7) * 129 + (i & 127)] = skg[i];
        for (int i = F.tid; i < 64 * 128; i += 512) wt[(i >> 7) * 129 + (i & 127)] = wqg[(size_t)(i >> 7) * 2048 + (i & 127)];
        __syncthreads();
        const int n = F.tid & 127, dg = F.tid >> 7;
        float a[16];
#pragma unroll
        for (int e = 0; e < 16; ++e) a[e] = 0.f;
        for (int k = 0; k < 128; ++k) { const float s = sk[n * 129 + k];
#pragma unroll
            for (int e = 0; e < 16; ++e) a[e] += wt[(dg * 16 + e) * 129 + k] * s; }
        bf16_t* dst = WSP(bf16_t, WS_WFOLD) + (size_t)l * 2048 * 2048 + (size_t)(g * 128 + n) * 2048 + d0 + dg * 16;
        u32x4 w0, w1;
        w0.x = cvt_pk_bf16(a[0], a[1]); w0.y = cvt_pk_bf16(a[2], a[3]); w0.z = cvt_pk_bf16(a[4], a[5]); w0.w = cvt_pk_bf16(a[6], a[7]);
        w1.x = cvt_pk_bf16(a[8], a[9]); w1.y = cvt_pk_bf16(a[10], a[11]); w1.z = cvt_pk_bf16(a[12], a[13]); w1.w = cvt_pk_bf16(a[14], a[15]);
        *(u32x4*)dst = w0; *(u32x4*)(dst + 8) = w1;
        __syncthreads();
    }
    for (int u = F.bid; u < 2 * 192; u += F.G) {
        const int l = u / 192, n0 = (u % 192) * 64;
        LAS float* sl = (LAS float*)F.lds; LAS float* red = (LAS float*)(F.lds + 5 * 2048 * 4);
        for (int i = F.tid; i < 5 * 2048; i += 512) { const int r = i >> 11, k = i & 2047; const float v = r < 4 ? F.in[I_C][r * 2048 + k] : F.in[I_CCTX][k]; sl[i] = v * sigmoidf_(v); }
        __syncthreads();
        const int col = F.tid & 63, ks = F.tid >> 6;
        float a[5] = {0.f, 0.f, 0.f, 0.f, 0.f};
        const float* wp = F.in[I_WADA] + (size_t)l * 2048 * 12288 + n0 + col;
        for (int k = ks * 256; k < ks * 256 + 256; ++k) { const float w = wp[(size_t)k * 12288];
#pragma unroll
            for (int r = 0; r < 5; ++r) a[r] += sl[r * 2048 + k] * w; }
#pragma unroll
        for (int r = 0; r < 5; ++r) red[(ks * 5 + r) * 64 + col] = a[r];
        __syncthreads();
        if (F.tid < 320) { const int r = F.tid >> 6; float s = 0.f;
#pragma unroll
            for (int k2 = 0; k2 < 8; ++k2) s += red[(k2 * 5 + r) * 64 + col];
            WSP(float, WS_MOD)[((size_t)l * 5 + r) * 12288 + n0 + col] = s + F.in[I_BADA][(size_t)l * 12288 + n0 + col]; }
        __syncthreads();
    }
    for (int i = F.bid * 512 + F.tid; i < 4096 * 64; i += F.G * 512) {
        const int pos = i >> 6, j = i & 63, fi = j & 31; const float fr = powf(10000.0f, -(float)(2 * fi) / 64.0f);
        const float ang = (float)(j < 32 ? (pos >> 6) : (pos & 63)) * fr;
        WSP(float, WS_COSH)[i] = cosf(ang); WSP(float, WS_SINH)[i] = sinf(ang);
    }
    for (int i = F.bid * 512 + F.tid; i < 4096 * 32; i += F.G * 512) {
        const int pos = i >> 5, j = i & 31, fi = j & 15; const float fr = powf(10000.0f, -(float)(2 * fi) / 32.0f);
        const float ang = (float)(j < 16 ? (pos >> 6) : (pos & 63)) * fr;
        WSP(float, WS_COSR)[i] = cosf(ang); WSP(float, WS_SINR)[i] = sinf(ang);
    }
    cvt_rows_fp8(F, F.in[I_PU], WSP(unsigned char, WS_UB), (size_t)2 * NEXP * 2048 / 16, 1024.f);
    cvt_rows_fp8(F, F.in[I_PV], WSP(unsigned char, WS_VB2), (size_t)2 * NEXP * 2048 / 16, 16.f);
}

__device__ __forceinline__ void ph_modulate0(const Ctx& F0) {
    const Ctx F = phase_ctx(F0);
    using namespace cf;
    const float* mod = WSP(float, WS_MOD);
    for (size_t i = (size_t)F.bid * 512 + F.tid; i < (size_t)MR * 256; i += (size_t)F.G * 512) {
        const int R = (int)(i >> 8), d = (int)(i & 255) * 8, b = R / RB, j = R % RB;
        const float* src = j < CTX ? F.in[I_CTX] + ((size_t)b * CTX + j) * 2048 : F.in[I_X] + ((size_t)b * S + (j - CTX)) * 2048;
        const float* m = mod + (size_t)(j < CTX ? 4 : b) * 12288;
        const f32x4 x0 = *(const f32x4*)(src + d), x1 = *(const f32x4*)(src + d + 4);
        const f32x4 sh0 = *(const f32x4*)(m + d), sh1 = *(const f32x4*)(m + d + 4), s0 = *(const f32x4*)(m + 2048 + d), s1 = *(const f32x4*)(m + 2048 + d + 4);
        *(u32x4*)(WSP(bf16_t, WS_HB) + (size_t)R * 2048 + d) = pg8::pack8(x0 * (s0 + 1.0f) + sh0, x1 * (s1 + 1.0f) + sh1);
    }
}

__device__ __forceinline__ void ph_post(const Ctx& F0, int layer) {
    const Ctx F = phase_ctx(F0);
    using namespace cf;
    bf16_t* P = WSP(bf16_t, WS_P); bf16_t* KB = WSP(bf16_t, WS_KB);
    const float* akn = F.in[I_AKN] + layer * 128; const float* aqn = F.in[I_AQN] + layer * 128;
    const float* bkvn = F.in[I_BKVN] + layer * 256; const float* bqn = F.in[I_BQN] + layer * 512;
    const int lane = F.lane;
    for (int R = F.bid * 8 + F.wave; R < MR; R += F.G * 8) {
        const int j = R % RB; const bool lat = j >= CTX; const int pos = lat ? j - CTX : 0;
        const bool full = lat || layer == 0;
        bf16_t* p = P + (size_t)R * NC;
        const float ch = lat ? WSP(float, WS_COSH)[pos * 64 + lane] : 1.f, sh = lat ? WSP(float, WS_SINH)[pos * 64 + lane] : 0.f;
        const float akg1 = akn[lane], akg2 = akn[64 + lane];
#pragma unroll
        for (int h = 0; h < 2; ++h) { bf16_t* q = p + PC_AK + h * 128; const float x1 = bf2f(q[lane]), x2 = bf2f(q[64 + lane]);
            const float r = rsqrtf(wave_sum(x1 * x1 + x2 * x2) * (1.f / 128.f) + 1e-6f); const float y1 = x1 * r * akg1, y2 = x2 * r * akg2;
            q[lane] = f2bf(y1 * ch - y2 * sh); q[64 + lane] = f2bf(y2 * ch + y1 * sh); }
        { bf16_t* q = p + PC_CKV; float x[4]; float ss = 0.f;
#pragma unroll
            for (int i = 0; i < 4; ++i) { x[i] = bf2f(q[lane + 64 * i]); ss += x[i] * x[i]; }
            const float r = rsqrtf(wave_sum(ss) * (1.f / 256.f) + 1e-6f);
#pragma unroll
            for (int i = 0; i < 4; ++i) q[lane + 64 * i] = f2bf(x[i] * r * bkvn[lane + 64 * i]); }
        if (lane < 32) { const float x1 = bf2f(p[PC_KR + lane]), x2 = bf2f(p[PC_KR + 32 + lane]);
            const float c = lat ? WSP(float, WS_COSR)[pos * 32 + lane] : 1.f, s = lat ? WSP(float, WS_SINR)[pos * 32 + lane] : 0.f;
            const bf16_t o1 = f2bf(x1 * c - x2 * s), o2 = f2bf(x2 * c + x1 * s);
            bf16_t* kb = KB + (size_t)R * 1536 + 128 + lane;
#pragma unroll
            for (int h = 0; h < 8; ++h) { kb[h * 192] = o1; kb[h * 192 + 32] = o2; } }
        if (lat) {
#pragma unroll
            for (int h = 0; h < 2; ++h) { bf16_t* q = p + PC_DK + h * 128; const float x1 = bf2f(q[lane]), x2 = bf2f(q[64 + lane]);
                q[lane] = f2bf(x1 * ch - x2 * sh); q[64 + lane] = f2bf(x2 * ch + x1 * sh); } }
        if (!full) continue;
        { const float g1 = aqn[lane], g2 = aqn[64 + lane];
#pragma unroll
            for (int h = 0; h < 8; ++h) { bf16_t* q = p + PC_AQ + h * 128; const float x1 = bf2f(q[lane]), x2 = bf2f(q[64 + lane]);
                const float r = rsqrtf(wave_sum(x1 * x1 + x2 * x2) * (1.f / 128.f) + 1e-6f); const float y1 = x1 * r * g1, y2 = x2 * r * g2;
                q[lane] = f2bf(y1 * ch - y2 * sh); q[64 + lane] = f2bf(y2 * ch + y1 * sh); } }
        { bf16_t* q = p + PC_CQ; float x[8]; float ss = 0.f;
#pragma unroll
            for (int i = 0; i < 8; ++i) { x[i] = bf2f(q[lane + 64 * i]); ss += x[i] * x[i]; }
            const float r = rsqrtf(wave_sum(ss) * (1.f / 512.f) + 1e-6f);
#pragma unroll
            for (int i = 0; i < 8; ++i) q[lane + 64 * i] = f2bf(x[i] * r * bqn[lane + 64 * i]); }
        if (lat) {
#pragma unroll
            for (int h = 0; h < 8; ++h) { bf16_t* q = p + PC_DQ + h * 128; const float x1 = bf2f(q[lane]), x2 = bf2f(q[64 + lane]);
                q[lane] = f2bf(x1 * ch - x2 * sh); q[64 + lane] = f2bf(x2 * ch + x1 * sh); } }
#pragma unroll
        for (int i = 0; i < 16; ++i) { const float a = bf2f(p[PC_GLU + lane + 64 * i]), gt = bf2f(p[PC_GLU + 1024 + lane + 64 * i]); p[PC_GLU + lane + 64 * i] = f2bf(a * sigmoidf_(gt)); }
    }
}

struct AttnArgs {
    const bf16_t* Q; const bf16_t* K; const bf16_t* V; bf16_t* O; int ldq, ldk, ldv, ldo;
    int seg0_row, seg0_tiles, seg1_row, seg1_tiles;
    int mask_on, qpos0, kpos1;
    float sc_log2; int has_sink; float sink_l2;
};
template <int DK>
__device__ __forceinline__ void attn_unit(ldsp_t lds, const AttnArgs a) {
    constexpr int NS = DK / 32, KST = DK + 8, KCH = DK / 8, KPT = (64 * KCH) / 512, VST = 72;
    int tid = threadIdx.x; asm volatile("" : "+v"(tid));
    const int wid = __builtin_amdgcn_readfirstlane(tid >> 6), lane = tid & 63, g = lane >> 4, c16 = lane & 15;
    ldsp_t Ks = lds, Vt = lds + 32768, Ost = lds + 65536 + wid * 4096;
    bf16x8 qf[NS];
    { const bf16_t* qrow = a.Q + (size_t)(wid * 16 + c16) * a.ldq + 8 * g;
#pragma unroll
      for (int s = 0; s < NS; ++s) qf[s] = *(const bf16x8*)(qrow + 32 * s); }
    f32x4 o[8];
#pragma unroll
    for (int nb = 0; nb < 8; ++nb) o[nb] = (f32x4){0.f, 0.f, 0.f, 0.f};
    float m_run = -1e30f, l_run = 0.f;
    const int ntiles = a.seg0_tiles + a.seg1_tiles;
    u32x4 kreg[KPT], vreg[2];
    const int vkp = tid & 31, vdc = tid >> 5;
#define ATT_LOAD(tt) do { const int _r0 = (tt) < a.seg0_tiles ? a.seg0_row + 64 * (tt) : a.seg1_row + 64 * ((tt) - a.seg0_tiles); \
        _Pragma("unroll") for (int _i = 0; _i < KPT; ++_i) { const int _c = tid + 512 * _i; kreg[_i] = *(const u32x4*)(a.K + (size_t)(_r0 + _c / KCH) * a.ldk + 8 * (_c % KCH)); } \
        vreg[0] = *(const u32x4*)(a.V + (size_t)(_r0 + 2 * vkp) * a.ldv + 8 * vdc); vreg[1] = *(const u32x4*)(a.V + (size_t)(_r0 + 2 * vkp + 1) * a.ldv + 8 * vdc); } while (0)
    ATT_LOAD(0);
    for (int tt = 0; tt < ntiles; ++tt) {
        __syncthreads();
#pragma unroll
        for (int i = 0; i < KPT; ++i) { const int c = tid + 512 * i; *(LAS u32x4*)(Ks + ((c / KCH) * KST + 8 * (c % KCH)) * 2) = kreg[i]; }
        { const unsigned a0[4] = {vreg[0].x, vreg[0].y, vreg[0].z, vreg[0].w}, a1[4] = {vreg[1].x, vreg[1].y, vreg[1].z, vreg[1].w};
#pragma unroll
          for (int e = 0; e < 4; ++e) {
              *(LAS unsigned*)(Vt + ((8 * vdc + 2 * e) * VST + 2 * vkp) * 2) = (a0[e] & 0xffffu) | (a1[e] << 16);
              *(LAS unsigned*)(Vt + ((8 * vdc + 2 * e + 1) * VST + 2 * vkp) * 2) = (a0[e] >> 16) | (a1[e] & 0xffff0000u); } }
        __syncthreads();
        if (tt + 1 < ntiles) ATT_LOAD(tt + 1);
        f32x4 sc[4];
#pragma unroll
        for (int kt = 0; kt < 4; ++kt) { sc[kt] = (f32x4){0.f, 0.f, 0.f, 0.f};
#pragma unroll
            for (int s = 0; s < NS; ++s) { const bf16x8 kf = *(const LAS bf16x8*)(Ks + ((16 * kt + c16) * KST + 32 * s + 8 * g) * 2);
                sc[kt] = __builtin_amdgcn_mfma_f32_16x16x32_bf16(kf, qf[s], sc[kt], 0, 0, 0); } }
        const bool msk = a.mask_on && tt >= a.seg0_tiles;
        const int kp0 = a.kpos1 + 64 * (tt - a.seg0_tiles) + 4 * g, qp = a.qpos0 + wid * 16 + c16;
        float mx = -1e30f;
#pragma unroll
        for (int kt = 0; kt < 4; ++kt)
#pragma unroll
            for (int r = 0; r < 4; ++r) { float t = sc[kt][r] * a.sc_log2;
                if (msk) { const int dlt = qp - (kp0 + 16 * kt + r); if (dlt > 128 || dlt < -128) t = -1e30f; }
                sc[kt][r] = t; mx = fmaxf(mx, t); }
        mx = fmaxf(mx, __shfl_xor(mx, 16)); mx = fmaxf(mx, __shfl_xor(mx, 32));
        const float m_new = fmaxf(m_run, mx), alpha = __builtin_amdgcn_exp2f(m_run - m_new); m_run = m_new;
        float ps = 0.f;
#pragma unroll
        for (int kt = 0; kt < 4; ++kt)
#pragma unroll
            for (int r = 0; r < 4; ++r) { const float p = __builtin_amdgcn_exp2f(sc[kt][r] - m_new); sc[kt][r] = p; ps += p; }
        l_run = l_run * alpha + ps;
        bf16x8 pa[2];
#pragma unroll
        for (int i = 0; i < 2; ++i) { u32x4 w; w.x = cvt_pk_bf16(sc[2 * i][0], sc[2 * i][1]); w.y = cvt_pk_bf16(sc[2 * i][2], sc[2 * i][3]);
            w.z = cvt_pk_bf16(sc[2 * i + 1][0], sc[2 * i + 1][1]); w.w = cvt_pk_bf16(sc[2 * i + 1][2], sc[2 * i + 1][3]); pa[i] = *(bf16x8*)&w; }
        { float ar[4];
#pragma unroll
          for (int r = 0; r < 4; ++r) ar[r] = __shfl(alpha, 4 * g + r);
#pragma unroll
          for (int nb = 0; nb < 8; ++nb)
#pragma unroll
              for (int r = 0; r < 4; ++r) o[nb][r] *= ar[r]; }
#pragma unroll
        for (int nb = 0; nb < 8; ++nb)
#pragma unroll
            for (int i = 0; i < 2; ++i) { const ldsp_t vp = Vt + ((c16 + 16 * nb) * VST + 32 * i + 4 * g) * 2;
                const u32x2 v0 = *(const LAS u32x2*)vp, v1 = *(const LAS u32x2*)(vp + 32);
                u32x4 w = {v0.x, v0.y, v1.x, v1.y};
                o[nb] = __builtin_amdgcn_mfma_f32_16x16x32_bf16(pa[i], *(bf16x8*)&w, o[nb], 0, 0, 0); }
    }
#undef ATT_LOAD
    float l_tot = l_run; l_tot += __shfl_xor(l_tot, 16); l_tot += __shfl_xor(l_tot, 32);
    if (a.has_sink) l_tot += __builtin_amdgcn_exp2f(a.sink_l2 - m_run);
    const float inv = 1.0f / l_tot;
    { float ir[4];
#pragma unroll
      for (int r = 0; r < 4; ++r) ir[r] = __shfl(inv, 4 * g + r);
#pragma unroll
      for (int nb = 0; nb < 8; ++nb)
#pragma unroll
          for (int r = 0; r < 4; ++r) *(LAS bf16_t*)(Ost + ((4 * g + r) * 128 + c16 + 16 * nb) * 2) = f2bf(o[nb][r] * ir[r]); }
    asm volatile("s_waitcnt lgkmcnt(0)" ::: "memory");
#pragma unroll
    for (int i = 0; i < 4; ++i) { const int c = lane + 64 * i, row = c >> 4, c8 = c & 15;
        *(u32x4*)(a.O + (size_t)(wid * 16 + row) * a.ldo + 8 * c8) = *(const LAS u32x4*)(Ost + (row * 128 + 8 * c8) * 2); }
}

__device__ __forceinline__ void conv_unit(const Ctx& F, int layer, int row0  , int seq_len, int t0) {
    using namespace cf;
    const bf16_t* P = WSP(const bf16_t, WS_P); bf16_t* BR = WSP(bf16_t, WS_BR);
    const float* cw = F.in[I_CW] + (size_t)layer * 31 * 1024; const float* cb = F.in[I_CB] + layer * 1024;
    const float* lg = F.in[I_CLG] + layer * 1024; const float* lb = F.in[I_CLB] + layer * 1024;
    int tid = F.tid; asm volatile("" : "+v"(tid));
    const int lane = tid & 63;
    LAS float* red = (LAS float*)(F.lds + 126976); LAS float* tot = red + 8 * 32;
    __syncthreads();
    for (int c = tid; c < 62 * 128; c += 512) { const int rr = c >> 7, ch = c & 127, t = t0 - 15 + rr;
        u32x4 v = {0u, 0u, 0u, 0u};
        if (t >= 0 && t < seq_len) v = *(const u32x4*)(P + (size_t)(row0 + t) * NC + PC_GLU + ch * 8);
        *(LAS u32x4*)(F.lds + rr * 2048 + ch * 16) = v; }
    float w0[31], w1[31];
#pragma unroll
    for (int k = 0; k < 31; ++k) { const f32x2 w = *(const f32x2*)(cw + k * 1024 + 2 * tid); w0[k] = w.x; w1[k] = w.y; }
    const f32x2 bv = *(const f32x2*)(cb + 2 * tid), gg = *(const f32x2*)(lg + 2 * tid), bb = *(const f32x2*)(lb + 2 * tid);
    __syncthreads();
#pragma unroll 1
    for (int part = 0; part < 4; ++part) {
        float a0[8], a1[8];
#pragma unroll
        for (int t = 0; t < 8; ++t) { a0[t] = bv.x; a1[t] = bv.y; }
        const ldsp_t base = F.lds + part * 8 * 2048 + tid * 4;
#pragma unroll
        for (int rr = 0; rr < 38; ++rr) { const unsigned xw = *(const LAS unsigned*)(base + rr * 2048); const float x0 = bflo(xw), x1 = bfhi(xw);
#pragma unroll
            for (int t = 0; t < 8; ++t) { const int k = rr - t; if (k >= 0 && k <= 30) { a0[t] += x0 * w0[k]; a1[t] += x1 * w1[k]; } } }
        float v[16];
#pragma unroll
        for (int t = 0; t < 8; ++t) { v[t] = a0[t] + a1[t]; v[8 + t] = a0[t] * a0[t] + a1[t] * a1[t]; }
#pragma unroll
        for (int i = 0; i < 8; ++i) { const bool up = lane & 32; const float snd = up ? v[i] : v[i + 8], kp = up ? v[i + 8] : v[i]; v[i] = kp + __shfl_xor(snd, 32); }
#pragma unroll
        for (int i = 0; i < 4; ++i) { const bool up = lane & 16; const float snd = up ? v[i] : v[i + 4], kp = up ? v[i + 4] : v[i]; v[i] = kp + __shfl_xor(snd, 16); }
#pragma unroll
        for (int i = 0; i < 2; ++i) { const bool up = lane & 8; const float snd = up ? v[i] : v[i + 2], kp = up ? v[i + 2] : v[i]; v[i] = kp + __shfl_xor(snd, 8); }
        { const bool up = lane & 4; const float snd = up ? v[0] : v[1], kp = up ? v[1] : v[0]; v[0] = kp + __shfl_xor(snd, 4); }
        v[0] += __shfl_xor(v[0], 2); v[0] += __shfl_xor(v[0], 1);
        if ((lane & 3) == 0) red[F.wave * 16 + (lane >> 2)] = v[0];
        __syncthreads();
        if (tid < 16) { float s = 0.f;
#pragma unroll
            for (int w = 0; w < 8; ++w) s += red[w * 16 + tid];
            tot[tid] = s; }
        __syncthreads();
#pragma unroll
        for (int t = 0; t < 8; ++t) { const float mean = tot[t] * (1.f / 1024.f), var = fmaxf(tot[8 + t] * (1.f / 1024.f) - mean * mean, 0.f), rstd = rsqrtf(var + 1e-5f);
            const float y0 = (a0[t] - mean) * rstd * gg.x + bb.x, y1 = (a1[t] - mean) * rstd * gg.y + bb.y;
            *(unsigned*)(BR + (size_t)(row0 + t0 + part * 8 + t) * 4096 + 2048 + 2 * tid) = cvt_pk_bf16(y0 * sigmoidf_(y0), y1 * sigmoidf_(y1)); }
    }
}

__device__ __forceinline__ void attn_defaults(AttnArgs& a, int isctx) {
    a.seg0_row = 0; a.seg0_tiles = isctx ? 4 : 68; a.seg1_row = 0; a.seg1_tiles = 0; a.mask_on = 0; a.qpos0 = 0; a.kpos1 = 0; a.has_sink = 0; a.sink_l2 = 0.f; }
__device__ __forceinline__ void ph_attn(const Ctx& F0, int layer) {
    const Ctx F = phase_ctx(F0);
    using namespace cf;
    const bf16_t* P = WSP(const bf16_t, WS_P); bf16_t* BR = WSP(bf16_t, WS_BR);
    for (int dup = 0; dup < DUPN(2); ++dup)
    for (int u = F.bid; u < (layer == 0 ? 1088 : 1024); u += F.G) {
        int b, h, qb, isctx = 0;
        if (u < 1024) { b = u >> 8; h = (u >> 5) & 7; qb = u & 31; } else { const int r = u - 1024; b = r >> 4; h = (r >> 1) & 7; qb = r & 1; isctx = 1; }
        const size_t brow = (size_t)b * RB, qrow = brow + (isctx ? 0 : CTX) + (size_t)qb * 128;
        AttnArgs a; attn_defaults(a, isctx);
        a.Q = WSP(const bf16_t, WS_QB) + qrow * 1536 + h * 192; a.ldq = 1536;
        a.K = WSP(const bf16_t, WS_KB) + brow * 1536 + h * 192; a.ldk = 1536;
        a.V = WSP(const bf16_t, WS_VB) + brow * 1024 + h * 128; a.ldv = 1024;
        a.O = BR + qrow * 4096 + 1024 + h * 128; a.ldo = 4096; a.sc_log2 = SCALE_MLA * LOG2E;
        __syncthreads();
        attn_unit<192>(F.lds, a);
    }
    for (int dup = 0; dup < DUPN(3); ++dup)
    for (int u0 = F.bid; u0 < (layer == 0 ? 2176 : 2048); u0 += F.G) {
        int kind, b, h, qb, isctx = 0;
        if (u0 < 2048) { kind = 1 + (u0 >> 10); const int r = u0 & 1023; b = r >> 8; h = (r >> 5) & 7; qb = r & 31; }
        else { const int r = u0 - 2048; kind = 1 + (r >> 6); const int r2 = r & 63; b = r2 >> 4; h = (r2 >> 1) & 7; qb = r2 & 1; isctx = 1; }
        const size_t brow = (size_t)b * RB, qrow = brow + (isctx ? 0 : CTX) + (size_t)qb * 128;
        AttnArgs a; attn_defaults(a, isctx);
        const int qc = kind == 1 ? PC_AQ : PC_DQ, kc = kind == 1 ? PC_AK : PC_DK, vc = kind == 1 ? PC_AV : PC_DV;
        a.Q = P + qrow * NC + qc + h * 128; a.ldq = NC;
        a.K = P + brow * NC + kc + (h >> 2) * 128; a.ldk = NC;
        a.V = P + brow * NC + vc + (h >> 2) * 128; a.ldv = NC;
        a.O = BR + qrow * 4096 + (kind == 1 ? 0 : 3072) + h * 128; a.ldo = 4096; a.sc_log2 = SCALE_HD * LOG2E;
        if (kind == 2) { a.has_sink = 1; a.sink_l2 = F.in[I_SINK][layer * 8 + h] * LOG2E; a.seg0_tiles = 4;
            if (!isctx) { const int start = qb * 128; const int lo = start - 128 < 0 ? 0 : start - 128, hi = start + 256 > S ? S : start + 256;
                a.seg1_row = CTX + lo; a.seg1_tiles = (hi - lo) / 64; a.mask_on = 1; a.qpos0 = start; a.kpos1 = lo; } }
        __syncthreads();
        attn_unit<128>(F.lds, a);
    }
    for (int dup = 0; dup < DUPN(4); ++dup)
    for (int u = F.bid; u < (layer == 0 ? 544 : 512); u += F.G) {
        int b, tb, isctx = 0;
        if (u < 512) { b = u >> 7; tb = u & 127; } else { const int r = u - 512; b = r >> 3; tb = r & 7; isctx = 1; }
        conv_unit(F, layer, b * RB + (isctx ? 0 : CTX), isctx ? CTX : S, tb * 32);
    }
}

__device__ __forceinline__ int tok_row(int layer, int tok) { return layer == 0 ? tok : (tok >> 12) * cf::RB + cf::CTX + (tok & 4095); }
__device__ __forceinline__ void ph_ln1(const Ctx& F0, int layer) {
    const Ctx F = phase_ctx(F0);
    using namespace cf;
    float* X1 = (float*)(F.ws + WS_P + X1_OFF); bf16_t* HB = WSP(bf16_t, WS_HB);
    const float* lg = F.in[I_LN1G] + layer * 2048; const float* lb = F.in[I_LN1B] + layer * 2048;
    const int ntok = layer == 0 ? MR : NB * S, lane = F.lane;
    for (int tok = F.bid * 8 + F.wave; tok < ntok; tok += F.G * 8) {
        const int R = tok_row(layer, tok), b = R / RB, j = R % RB;
        const float* mod = WSP(const float, WS_MOD) + ((size_t)layer * 5 + (j < CTX ? 4 : b)) * 12288;
        float* xp = X1 + (size_t)R * 2048;
        f32x4 v[8]; float s = 0.f;
#pragma unroll
        for (int i = 0; i < 8; ++i) { v[i] = *(const f32x4*)(xp + lane * 4 + 256 * i); s += (v[i][0] + v[i][1]) + (v[i][2] + v[i][3]); }
        const float mean = wave_sum(s) * (1.f / 2048.f); float q = 0.f;
#pragma unroll
        for (int i = 0; i < 8; ++i) { const f32x4 d = v[i] - mean; q += (d[0] * d[0] + d[1] * d[1]) + (d[2] * d[2] + d[3] * d[3]); }
        const float rstd = rsqrtf(wave_sum(q) * (1.f / 2048.f) + 1e-5f);
#pragma unroll
        for (int i = 0; i < 8; ++i) { const int c = lane * 4 + 256 * i;
            const f32x4 y = (v[i] - mean) * rstd * *(const f32x4*)(lg + c) + *(const f32x4*)(lb + c);
            *(f32x4*)(xp + c) = y;
            const f32x4 hp = y * (*(const f32x4*)(mod + 4 * 2048 + c) + 1.0f) + *(const f32x4*)(mod + 3 * 2048 + c);
            u32x2 w; w.x = cvt_pk_bf16(hp[0], hp[1]); w.y = cvt_pk_bf16(hp[2], hp[3]);
            *(u32x2*)(HB + (size_t)R * 2048 + c) = w; }
    }
}

typedef __bf16 bf16x2_t __attribute__((ext_vector_type(2)));
__device__ __forceinline__ unsigned ordkey(float v) { const unsigned u = __float_as_uint(v); return (u & 0x80000000u) ? ~u : (u | 0x80000000u); }
__device__ __forceinline__ int lane_rank(unsigned long long m) { return (int)__builtin_amdgcn_mbcnt_hi((unsigned)(m >> 32), __builtin_amdgcn_mbcnt_lo((unsigned)m, 0u)); }
template <int NV> __device__ __forceinline__ unsigned radix_thresh16(const unsigned (&k)[NV]) {
    unsigned T = 0u;
    for (int bit = 31; bit >= 0; --bit) { const unsigned cand = T | (1u << bit); int cnt = 0;
#pragma unroll
        for (int v = 0; v < NV; ++v) cnt += __popcll(__ballot(k[v] >= cand));
        if (cnt >= 16) T = cand; }
    return T;
}
__device__ __forceinline__ float dot2bf(unsigned a, unsigned b, float acc) { return __builtin_amdgcn_fdot2_f32_bf16(__builtin_bit_cast(bf16x2_t, a), __builtin_bit_cast(bf16x2_t, b), acc, false); }
__device__ __forceinline__ float dot8(const u32x4 a, const u32x4 b, float acc) {
    acc = dot2bf(a.x, b.x, acc); acc = dot2bf(a.y, b.y, acc); acc = dot2bf(a.z, b.z, acc); acc = dot2bf(a.w, b.w, acc);
    return acc;
}
__device__ __forceinline__ void ph_peer(const Ctx& F0, int layer) {
    const Ctx F = phase_ctx(F0);
    using namespace cf;
    const float* SC = (const float*)(F.ws + WS_P + SC_OFF); const float* X1 = (const float*)(F.ws + WS_P + X1_OFF);
    bf16_t* HB = WSP(bf16_t, WS_HB); const unsigned char* U8 = WSP(const unsigned char, WS_UB) + (size_t)layer * NEXP * 2048; const unsigned char* V8 = WSP(const unsigned char, WS_VB2) + (size_t)layer * NEXP * 2048;
    const float* lg = F.in[I_LN2G] + layer * 2048; const float* lb = F.in[I_LN2B] + layer * 2048;
    const int ntok = layer == 0 ? MR : NB * S, lane = F.lane;
    ldsp_t wl = F.lds + F.wave * 4096;
    LAS float* tv0 = (LAS float*)wl; LAS int* ti0 = (LAS int*)(wl + 64); LAS float* tv1 = (LAS float*)(wl + 128); LAS int* ti1 = (LAS int*)(wl + 192);
    LAS float* es = (LAS float*)(wl + 256); LAS int* ei = (LAS int*)(wl + 768); LAS float* eg = (LAS float*)(wl + 1280);
    for (int tok = F.bid * 8 + F.wave; tok < ntok; tok += F.G * 8) {
        const int R = tok_row(layer, tok), b = R / RB, j = R % RB; const bool isctx = j < CTX; const int modrow = isctx ? 4 : b;
        const float* sc = SC + (size_t)R * 2048;
        for (int h = 0; h < 8; ++h) {
            const float s0a = sc[(2 * h) * 128 + lane], s0b = sc[(2 * h) * 128 + 64 + lane], s1a = sc[(2 * h + 1) * 128 + lane], s1b = sc[(2 * h + 1) * 128 + 64 + lane];
            { const unsigned k[2] = {(ordkey(s0a) & ~127u) | (unsigned)(127 - lane), (ordkey(s0b) & ~127u) | (unsigned)(63 - lane)};
              const unsigned T = radix_thresh16<2>(k);
              const unsigned long long m0 = __ballot(k[0] >= T), m1 = __ballot(k[1] >= T); const int n0 = __popcll(m0);
              if (k[0] >= T) { const int r = lane_rank(m0); tv0[r] = s0a; ti0[r] = lane; }
              if (k[1] >= T) { const int r = n0 + lane_rank(m1); tv0[r] = s0b; ti0[r] = lane + 64; } }
            { const unsigned k[2] = {(ordkey(s1a) & ~127u) | (unsigned)(127 - lane), (ordkey(s1b) & ~127u) | (unsigned)(63 - lane)};
              const unsigned T = radix_thresh16<2>(k);
              const unsigned long long m0 = __ballot(k[0] >= T), m1 = __ballot(k[1] >= T); const int n0 = __popcll(m0);
              if (k[0] >= T) { const int r = lane_rank(m0); tv1[r] = s1a; ti1[r] = lane; }
              if (k[1] >= T) { const int r = n0 + lane_rank(m1); tv1[r] = s1b; ti1[r] = lane + 64; } }
            asm volatile("s_waitcnt lgkmcnt(0)" ::: "memory");
            const int ci = lane >> 2, cj = (lane & 3) * 4;
            const float a0 = tv0[ci]; const int i0 = ti0[ci];
            float c4[4]; int id4[4]; unsigned kc[4];
#pragma unroll
            for (int jj = 0; jj < 4; ++jj) { c4[jj] = a0 + tv1[cj + jj]; id4[jj] = i0 * 128 + ti1[cj + jj]; kc[jj] = (ordkey(c4[jj]) & ~255u) | (unsigned)(255 - (lane * 4 + jj)); }
            const unsigned Tc = radix_thresh16<4>(kc);
            int base = h * 16;
#pragma unroll
            for (int jj = 0; jj < 4; ++jj) { const unsigned long long m = __ballot(kc[jj] >= Tc);
                if (kc[jj] >= Tc) { const int r = base + lane_rank(m); es[r] = c4[jj]; ei[r] = id4[jj]; }
                base += __popcll(m); }
            asm volatile("s_waitcnt lgkmcnt(0)" ::: "memory");
        }
#pragma unroll
        for (int rnd = 0; rnd < 2; ++rnd) { const int e = lane + 64 * rnd; const float s = es[e];
            float m = s; m = fmaxf(m, __shfl_xor(m, 1)); m = fmaxf(m, __shfl_xor(m, 2)); m = fmaxf(m, __shfl_xor(m, 4)); m = fmaxf(m, __shfl_xor(m, 8));
            const float ex = __expf(s - m); float sum = ex; sum += __shfl_xor(sum, 1); sum += __shfl_xor(sum, 2); sum += __shfl_xor(sum, 4); sum += __shfl_xor(sum, 8);
            eg[e] = ex / sum; }
        asm volatile("s_waitcnt lgkmcnt(0)" ::: "memory");
        f32x2 xf[16];
#pragma unroll
        for (int i = 0; i < 2; ++i)
#pragma unroll
            for (int hh = 0; hh < 2; ++hh) { const u32x4 w = *(const u32x4*)(HB + (size_t)R * 2048 + lane * 16 + 1024 * i + 8 * hh);
                xf[8 * i + 4 * hh + 0] = (f32x2){bflo(w.x), bfhi(w.x)}; xf[8 * i + 4 * hh + 1] = (f32x2){bflo(w.y), bfhi(w.y)};
                xf[8 * i + 4 * hh + 2] = (f32x2){bflo(w.z), bfhi(w.z)}; xf[8 * i + 4 * hh + 3] = (f32x2){bflo(w.w), bfhi(w.w)}; }
        f32x2 y2[16];
#pragma unroll
        for (int i = 0; i < 16; ++i) y2[i] = (f32x2){0.f, 0.f};
        for (int grp = 0; grp < 32; ++grp) {
            int id[4]; float gq[4];
#pragma unroll
            for (int q = 0; q < 4; ++q) { id[q] = __builtin_amdgcn_readfirstlane(ei[grp * 4 + q]); gq[q] = __uint_as_float(__builtin_amdgcn_readfirstlane(__float_as_uint(eg[grp * 4 + q]))); }
            u32x4 ur[4][2], vr[4][2];
#pragma unroll
            for (int q = 0; q < 4; ++q)
#pragma unroll
                for (int i = 0; i < 2; ++i) { ur[q][i] = *(const u32x4*)(U8 + (size_t)id[q] * 2048 + lane * 16 + 1024 * i); vr[q][i] = *(const u32x4*)(V8 + (size_t)id[q] * 2048 + lane * 16 + 1024 * i); }
            float d[4];
#pragma unroll
            for (int q = 0; q < 4; ++q) { f32x2 t = {0.f, 0.f};
#pragma unroll
                for (int i = 0; i < 2; ++i)
#pragma unroll
                    for (int j = 0; j < 4; ++j) { const int w = (int)ur[q][i][j];
                        t += __builtin_amdgcn_cvt_pk_f32_fp8(w, false) * xf[8 * i + 2 * j]; t += __builtin_amdgcn_cvt_pk_f32_fp8(w, true) * xf[8 * i + 2 * j + 1]; }
                d[q] = t.x + t.y; }
#pragma unroll
            for (int o = 32; o >= 1; o >>= 1) {
#pragma unroll
                for (int q = 0; q < 4; ++q) d[q] += __shfl_xor(d[q], o); }
#pragma unroll
            for (int q = 0; q < 4; ++q) { const float dd = d[q] * (1.0f / 1024.0f); const float w = gq[q] * 0.5f * dd * (1.0f + erff(dd * 0.70710678118654752f)) * (1.0f / 16.0f);
                const f32x2 w2 = {w, w};
#pragma unroll
                for (int i = 0; i < 2; ++i)
#pragma unroll
                    for (int j = 0; j < 4; ++j) { const int vw = (int)vr[q][i][j];
                        y2[8 * i + 2 * j] += w2 * __builtin_amdgcn_cvt_pk_f32_fp8(vw, false); y2[8 * i + 2 * j + 1] += w2 * __builtin_amdgcn_cvt_pk_f32_fp8(vw, true); } }
        }
        const float* mod = WSP(const float, WS_MOD) + ((size_t)layer * 5 + modrow) * 12288;
        float y[32];
        float s = 0.f;
#pragma unroll
        for (int i = 0; i < 2; ++i)
#pragma unroll
            for (int j = 0; j < 4; ++j) { const int c = lane * 16 + 1024 * i + 4 * j;
                const f32x4 xa = *(const f32x4*)(X1 + (size_t)R * 2048 + c), ga = *(const f32x4*)(mod + 5 * 2048 + c);
                y[16 * i + 4 * j + 0] = ALPHA * xa[0] + ga[0] * y2[8 * i + 2 * j].x; y[16 * i + 4 * j + 1] = ALPHA * xa[1] + ga[1] * y2[8 * i + 2 * j].y;
                y[16 * i + 4 * j + 2] = ALPHA * xa[2] + ga[2] * y2[8 * i + 2 * j + 1].x; y[16 * i + 4 * j + 3] = ALPHA * xa[3] + ga[3] * y2[8 * i + 2 * j + 1].y;
                s += (y[16 * i + 4 * j + 0] + y[16 * i + 4 * j + 1]) + (y[16 * i + 4 * j + 2] + y[16 * i + 4 * j + 3]); }
        const float mean = wave_sum(s) * (1.f / 2048.f); float q2 = 0.f;
#pragma unroll
        for (int i = 0; i < 32; ++i) { const float dd = y[i] - mean; q2 += dd * dd; }
        const float rstd = rsqrtf(wave_sum(q2) * (1.f / 2048.f) + 1e-5f);
        float* dst = layer == 0 ? (isctx ? WSP(float, WS_XC) + ((size_t)b * CTX + j) * 2048 : F.out + ((size_t)b * S + (j - CTX)) * 2048) : F.out + ((size_t)b * S + (j - CTX)) * 2048;
        const float* modn = WSP(const float, WS_MOD) + ((size_t)1 * 5 + modrow) * 12288;
#pragma unroll
        for (int i = 0; i < 2; ++i)
#pragma unroll
            for (int hh = 0; hh < 2; ++hh) { f32x4 o[2];
#pragma unroll
                for (int jj = 0; jj < 2; ++jj) { const int j = 2 * hh + jj, c = lane * 16 + 1024 * i + 4 * j; const f32x4 la = *(const f32x4*)(lg + c), ba = *(const f32x4*)(lb + c);
#pragma unroll
                    for (int e = 0; e < 4; ++e) o[jj][e] = (y[16 * i + 4 * j + e] - mean) * rstd * la[e] + ba[e];
                    *(f32x4*)(dst + c) = o[jj]; }
                if (layer == 0) {
                    const int c = lane * 16 + 1024 * i + 8 * hh;
                    const f32x4 sa = *(const f32x4*)(modn + 2048 + c), sb = *(const f32x4*)(modn + 2048 + c + 4), ha = *(const f32x4*)(modn + c), hb = *(const f32x4*)(modn + c + 4);
                    *(u32x4*)(HB + (size_t)R * 2048 + c) = pg8::pack8(o[0] * (sa + 1.0f) + ha, o[1] * (sb + 1.0f) + hb); } }
    }
}

struct Params { const float* in[cf::N_IN]; float* out; unsigned char* ws; int ph_lo, ph_hi; };

__global__ void __launch_bounds__(512, 2) mega_fwd(Params p) {
    using namespace cf;
    extern __shared__ __attribute__((aligned(16))) unsigned char smem[];
    Ctx F0;
    F0.in = p.in;
    F0.out = p.out; F0.ws = p.ws; F0.lds = (ldsp_t)smem;
    F0.tid = threadIdx.x; F0.lane = F0.tid & 63; F0.wave = __builtin_amdgcn_readfirstlane(F0.tid >> 6); F0.G = gridDim.x; F0.bid = blockIdx.x;
    if (F0.tid < 64) ((LAS unsigned*)(F0.lds + MISC_OFF))[F0.tid] = 0u;
    __syncthreads();
    const int lo = p.ph_lo, hi = p.ph_hi;
    XcdBarrier bar; bar.bar = (unsigned*)(F0.ws + WS_CTL); bar.x = 0; bar.st = (volatile LAS unsigned*)(F0.lds + MISC_OFF);
    if (hi - lo > 1) bar = xcd_barrier_post((unsigned*)(F0.ws + WS_CTL), (volatile LAS unsigned*)(F0.lds + MISC_OFF));
#ifndef MK_MASK
#define MK_MASK 0xFFFF
#endif
#define ON(j) ((MK_MASK >> (j)) & 1)
#define IN(k) (lo <= (k) && (k) < hi)
#define SEAM(k) do { if (IN(k) && IN((k) + 1)) xcd_barrier(bar); } while (0)

    if (ON(9) && IN(0)) { ph_prologue(F0); if (DUPN(9) == 2) { __syncthreads(); ph_prologue(F0); } }
    SEAM(0);
    if (ON(10) && IN(1)) ph_modulate0(F0);
    SEAM(1);
    for (int l = 0; l < DEPTH; ++l) {
        const int pb = 2 + 9 * l;
        const int rmode = l == 0 ? 0 : 1, nMl = l == 0 ? 68 : 64;
        if (ON(0) && IN(pb + 0)) { const Ctx F = phase_ctx(F0); bf16_t* P = WSP(bf16_t, WS_P); bf16_t* HB = WSP(bf16_t, WS_HB);
            pg8::Gemm g{HB, WSP(const bf16_t, WS_WIN) + (size_t)l * NC * 2048, 2048, 2048}; pg8::EpiBf16 E{P, NC};
            pg8::TileOrder S; S.init(nMl, 56, F.G, F.bid, rmode);
            for (int dup = 0; dup < DUPN(0); ++dup)
            pg8::gemm_phase(F.lds, g, S, E);
            if (l > 0) { pg8::TileOrder S2; S2.init(4, 6, F.G, F.bid, 2); pg8::gemm_phase(F.lds, g, S2, E); }
        }
        SEAM(pb + 0);
        if (ON(1) && IN(pb + 1)) ph_post(F0, l);
        SEAM(pb + 1);
        if (ON(2) && IN(pb + 2)) { const Ctx F = phase_ctx(F0); bf16_t* P = WSP(bf16_t, WS_P);
            { pg8::Gemm g{P + PC_CKV, WSP(const bf16_t, WS_WKVUP) + (size_t)l * 2048 * 256, NC, 256}; pg8::EpiKvUp E{WSP(bf16_t, WS_KB), WSP(bf16_t, WS_VB)};
              pg8::TileOrder S; S.init(68, 8, F.G, F.bid, 0); for (int dup = 0; dup < DUPN(1); ++dup) pg8::gemm_phase(F.lds, g, S, E); }
            { pg8::Gemm g{P + PC_CQ, WSP(const bf16_t, WS_WQUP) + (size_t)l * 1536 * 512, NC, 512}; pg8::EpiQUp E{WSP(bf16_t, WS_QB), WSP(const float, WS_COSR), WSP(const float, WS_SINR)};
              pg8::TileOrder S; S.init(nMl, 6, F.G, F.bid, rmode); for (int dup = 0; dup < DUPN(1); ++dup) pg8::gemm_phase(F.lds, g, S, E); }
        }
        SEAM(pb + 2);
        if (ON(3) && IN(pb + 3)) ph_attn(F0, l);
        SEAM(pb + 3);
        if (ON(4) && IN(pb + 4)) { const Ctx F = phase_ctx(F0); bf16_t* P = WSP(bf16_t, WS_P); bf16_t* HB = WSP(bf16_t, WS_HB);
            for (int dup = 0; dup < DUPN(5); ++dup)
            for (int br = 0; br < 4; ++br) {
                pg8::Gemm g{WSP(const bf16_t, WS_BR) + br * 1024, WSP(const bf16_t, WS_WBR) + ((size_t)l * 4 + br) * 2048 * 1024, 4096, 1024};
                pg8::EpiMerge E{HB, P + PC_GATE + br * 2048, NC, br == 0};
                pg8::TileOrder S; S.init(nMl, 8, F.G, F.bid, rmode); pg8::gemm_phase(F.lds, g, S, E);
            }
        }
        SEAM(pb + 4);
        if (ON(5) && IN(pb + 5)) { const Ctx F = phase_ctx(F0); bf16_t* HB = WSP(bf16_t, WS_HB);
            pg8::Gemm g{HB, WSP(const bf16_t, WS_WO) + (size_t)l * 2048 * 2048, 2048, 2048};
            pg8::EpiWo E{(float*)(F.ws + WS_P + X1_OFF), WSP(const float, WS_MOD) + (size_t)l * 5 * 12288, l == 0 ? F.in[I_X] : (const float*)F.out, F.in[I_CTX]};
            pg8::TileOrder S; S.init(nMl, 8, F.G, F.bid, rmode); for (int dup = 0; dup < DUPN(6); ++dup) pg8::gemm_phase(F.lds, g, S, E);
        }
        SEAM(pb + 5);
        if (ON(6) && IN(pb + 6)) ph_ln1(F0, l);
        SEAM(pb + 6);
        if (ON(7) && IN(pb + 7)) { const Ctx F = phase_ctx(F0); bf16_t* HB = WSP(bf16_t, WS_HB);
            pg8::Gemm g{HB, WSP(const bf16_t, WS_WFOLD) + (size_t)l * 2048 * 2048, 2048, 2048}; pg8::EpiF32 E{(float*)(F.ws + WS_P + SC_OFF), 2048};
            pg8::TileOrder S; S.init(nMl, 8, F.G, F.bid, rmode); for (int dup = 0; dup < DUPN(7); ++dup) pg8::gemm_phase(F.lds, g, S, E);
        }
        SEAM(pb + 7);
        if (ON(8) && IN(pb + 8)) { ph_peer(F0, l); if (DUPN(8) == 2 && l == 1) ph_peer(F0, l); }
        SEAM(pb + 8);
    }
#undef IN
#undef SEAM
}

extern "C" void kernel_launch(void* const* d_in, const int* in_sizes, int n_in, void* d_out, int out_size, void* d_ws, size_t ws_size, hipStream_t stream) {
    static int grid = 0;
    if (grid == 0) {
        if (n_in != cf::N_IN || out_size != cf::NB * cf::S * cf::D || ws_size < cf::WS_END) {
            fprintf(stderr, "kernel_launch: unexpected shapes: n_in %d out %d ws %zu (need %zu)\n", n_in, out_size, ws_size, (size_t)cf::WS_END); grid = -1; return; }
        int dev = 0, cus = 0;
        if (hipGetDevice(&dev) != hipSuccess || hipDeviceGetAttribute(&cus, hipDeviceAttributeMultiprocessorCount, dev) != hipSuccess || cus < 1) { grid = -1; return; }
        if (hipFuncSetAttribute((const void*)mega_fwd, hipFuncAttributeMaxDynamicSharedMemorySize, cf::LDS_BYTES) != hipSuccess) { fprintf(stderr, "kernel_launch: hipFuncSetAttribute failed\n"); grid = -1; return; }
        int per_cu = 0;
        if (hipOccupancyMaxActiveBlocksPerMultiprocessor(&per_cu, (const void*)mega_fwd, 512, cf::LDS_BYTES) != hipSuccess || per_cu < 1)
            fprintf(stderr, "kernel_launch: note: occupancy query reports %d workgroups per CU\n", per_cu);
        (void)hipGetLastError();
        grid = cus;
    }
    if (grid < 0) return;
    (void)hipMemsetAsync((char*)d_ws + cf::WS_CTL, 0, cf::CTL_BYTES, stream);
    Params p{};
    for (int i = 0; i < cf::N_IN; ++i) p.in[i] = (const float*)d_in[i];
    p.out = (float*)d_out; p.ws = (unsigned char*)d_ws;
#if MK_PER_PHASE
    for (int k = 0; k < cf::N_PHASES; ++k) { p.ph_lo = k; p.ph_hi = k + 1; hipLaunchKernelGGL(mega_fwd, dim3(grid), dim3(512), cf::LDS_BYTES, stream, p); }
#else
    p.ph_lo = 0; p.ph_hi = cf::N_PHASES;
    hipLaunchKernelGGL(mega_fwd, dim3(grid), dim3(512), cf::LDS_BYTES, stream, p);
#endif
    const hipError_t le = hipPeekAtLastError();
    if (le != hipSuccess) fprintf(stderr, "kernel_launch: launch failed: %s\n", hipGetErrorName(le));
}
```

```cpp
#include <hip/hip_runtime.h>
#include <stdint.h>
#include <stdio.h>

#ifndef MK_DUP
#define MK_DUP 0
#endif
#define DUPN(k) (((MK_DUP >> (k)) & 1) ? 2 : 1)
#ifndef MK_PER_PHASE
#define MK_PER_PHASE 0
#endif

namespace cf {
constexpr int D = 2048, NB = 4, S = 4096, CTX = 256, RB = CTX + S  , MR = NB * RB  ;
constexpr int DEPTH = 2;
constexpr int PC_AK = 0, PC_AV = 256, PC_CKV = 512, PC_KR = 768, PC_DK = 1024, PC_DV = 1280, PC_KVEND = 1536;
constexpr int PC_AQ = 1536, PC_CQ = 2560, PC_DQ = 3072, PC_GLU = 4096, PC_GATE = 6144, NC = 14336;
constexpr int IN_COLS = 14144;
constexpr int NEXP = 16384;
constexpr float ALPHA = 1.4142135623730951f;
constexpr float LOG2E = 1.4426950408889634f;
constexpr float SCALE_HD = 0.08838834764831845f;
constexpr float SCALE_MLA = 0.07216878364870323f;
enum { I_X = 0, I_C, I_CTX, I_CCTX, I_WADA, I_BADA, I_WIN, I_AQN, I_AKN, I_BQN, I_WQUP, I_BKVN, I_WKVUP, I_CW, I_CB, I_CLG, I_CLB, I_SINK,
       I_WBRA, I_WBRB, I_WBRC, I_WBRD, I_WO, I_LN1G, I_LN1B, I_LN2G, I_LN2B, I_PWQ, I_PSK, I_PU, I_PV, N_IN };
constexpr size_t al(size_t x) { return (x + 255) / 256 * 256; }
constexpr size_t WS_CTL = 0;
constexpr size_t CTL_BYTES = 65536;
constexpr size_t WS_MOD = WS_CTL + CTL_BYTES;
constexpr size_t WS_COSH = WS_MOD + al((size_t)2 * 5 * 12288 * 4);
constexpr size_t WS_SINH = WS_COSH + (size_t)4096 * 64 * 4;
constexpr size_t WS_COSR = WS_SINH + (size_t)4096 * 64 * 4;
constexpr size_t WS_SINR = WS_COSR + (size_t)4096 * 32 * 4;
constexpr size_t WS_WIN = WS_SINR + (size_t)4096 * 32 * 4;
constexpr size_t WS_WQUP = WS_WIN + (size_t)2 * NC * 2048 * 2;
constexpr size_t WS_WKVUP = WS_WQUP + (size_t)2 * 1536 * 512 * 2;
constexpr size_t WS_WBR = WS_WKVUP + (size_t)2 * 2048 * 256 * 2;
constexpr size_t WS_WO = WS_WBR + (size_t)2 * 4 * 2048 * 1024 * 2;
constexpr size_t WS_WFOLD = WS_WO + (size_t)2 * 2048 * 2048 * 2;
constexpr size_t WS_UB = WS_WFOLD + (size_t)2 * 2048 * 2048 * 2;
constexpr size_t WS_VB2 = WS_UB + (size_t)2 * NEXP * 2048;
constexpr size_t WS_HB = WS_VB2 + (size_t)2 * NEXP * 2048;
constexpr size_t WS_P = WS_HB + (size_t)MR * 2048 * 2;
constexpr size_t WS_QB = WS_P + (size_t)MR * NC * 2;
constexpr size_t WS_KB = WS_QB + (size_t)MR * 1536 * 2;
constexpr size_t WS_VB = WS_KB + (size_t)MR * 1536 * 2;
constexpr size_t WS_BR = WS_VB + (size_t)MR * 1024 * 2;
constexpr size_t WS_XC = WS_BR + (size_t)MR * 4096 * 2;
constexpr size_t WS_END = WS_XC + (size_t)1024 * 2048 * 4;
constexpr size_t X1_OFF = 0, SC_OFF = (size_t)MR * 2048 * 4;
static_assert(SC_OFF * 2 <= (size_t)MR * NC * 2, "X1 + SC fit in P");
constexpr int LDS_BYTES = 132 * 1024;
constexpr int MISC_OFF = 128 * 1024;
constexpr int N_PHASES = 2 + 9 * DEPTH;
}

typedef unsigned short bf16_t;
typedef short bf16x8 __attribute__((ext_vector_type(8)));
typedef float f32x4 __attribute__((ext_vector_type(4)));
typedef float f32x2 __attribute__((ext_vector_type(2)));
typedef unsigned u32x4 __attribute__((ext_vector_type(4)));
typedef unsigned u32x2 __attribute__((ext_vector_type(2)));
#define LAS __attribute__((address_space(3)))
typedef LAS unsigned char* ldsp_t;

__device__ __forceinline__ unsigned cvt_pk_bf16(float lo, float hi) { unsigned r; asm volatile("v_cvt_pk_bf16_f32 %0, %1, %2" : "=v"(r) : "v"(lo), "v"(hi)); return r; }
__device__ __forceinline__ bf16_t f2bf(float f) { return (bf16_t)(cvt_pk_bf16(f, 0.f) & 0xffffu); }
__device__ __forceinline__ float bf2f(bf16_t b) { return __uint_as_float(((unsigned)b) << 16); }
__device__ __forceinline__ float bflo(unsigned w) { return __uint_as_float(w << 16); }
__device__ __forceinline__ float bfhi(unsigned w) { return __uint_as_float(w & 0xffff0000u); }
__device__ __forceinline__ float wave_sum(float v) {
#pragma unroll
    for (int o = 32; o >= 1; o >>= 1) v += __shfl_xor(v, o);
    return v;
}
__device__ __forceinline__ float sigmoidf_(float x) { return 1.0f / (1.0f + __expf(-x)); }

#define XB_TMO      128
#define XB_XCNT(j)  (256  + 64 * (j))
#define XB_XSUB(j)  (1280 + 64 * (j))
#define XB_XGEN(j)  (2304 + 64 * (j))
#define XB_TOP      3328
#define XB_TOPGEN   3392
#define XCD_BAR_WORDS 3456
#define XB_SPIN_CAP (1u << 23)
__device__ __forceinline__ unsigned xb_ld(unsigned* p)              { return __hip_atomic_load(p, __ATOMIC_RELAXED, __HIP_MEMORY_SCOPE_AGENT); }
__device__ __forceinline__ unsigned xb_add(unsigned* p, unsigned v) { return __hip_atomic_fetch_add(p, v, __ATOMIC_RELAXED, __HIP_MEMORY_SCOPE_AGENT); }
__device__ __forceinline__ unsigned xb_xcc_id() { return (unsigned)__builtin_amdgcn_s_getreg((3 << 11) | 20) & 0xFu; }
#define XB_SPIN(cond, bar) do { unsigned _sp = 0; while (cond) { __builtin_amdgcn_s_sleep(1); \
    if ((++_sp & 255u) == 0u) { if (xb_ld(&(bar)[XB_TMO])) break; if (_sp > XB_SPIN_CAP) { atomicAdd(&(bar)[XB_TMO], 1u); break; } } } } while (0)
struct XcdBarrier { unsigned* bar; unsigned x; volatile LAS unsigned* st; };
__device__ __forceinline__ XcdBarrier xcd_barrier_post(unsigned* bar, volatile LAS unsigned* st) {
    XcdBarrier b; b.bar = bar; b.x = xb_xcc_id(); b.st = st;
    if (threadIdx.x == 0) (void)xb_add(&bar[XB_XCNT(b.x)], 1u);
    return b;
}
__device__ __forceinline__ void xcd_barrier_complete(unsigned* bar, unsigned x, unsigned& nloc, unsigned& nx) {
    const unsigned G = gridDim.x * gridDim.y * gridDim.z;
    unsigned sum, cnt, mine, sp = 0u;
    for (;;) {
        sum = 0u; cnt = 0u; mine = 0u;
#pragma unroll
        for (unsigned j = 0; j < 16; ++j) { const unsigned c = xb_ld(&bar[XB_XCNT(j)]); sum += c; cnt += (c > 0u) ? 1u : 0u; mine = (j == x) ? c : mine; }
        if (sum == G) break;
        __builtin_amdgcn_s_sleep(1);
        if ((++sp & 255u) == 0u) { if (xb_ld(&bar[XB_TMO])) break; if (sp > XB_SPIN_CAP) { atomicAdd(&bar[XB_TMO], 1u); break; } }
    }
    nloc = mine > 0u ? mine : 1u; nx = cnt > 0u ? cnt : 1u;
}
__device__ __forceinline__ void xcd_barrier(const XcdBarrier& b) {
    asm volatile("s_waitcnt vmcnt(0)" ::: "memory");
    __syncthreads();
    if (threadIdx.x == 0) {
        unsigned* bar = b.bar;
        __builtin_amdgcn_s_waitcnt(0);
        unsigned nloc = b.st[0], nx = b.st[1];
        if (nloc == 0u) { xcd_barrier_complete(bar, b.x, nloc, nx); b.st[0] = nloc; b.st[1] = nx; }
        const unsigned old = xb_add(&bar[XB_XSUB(b.x)], 1u);
        const unsigned gen = old / nloc;
        if (old + 1u == (gen + 1u) * nloc) {
            __builtin_amdgcn_fence(__ATOMIC_RELEASE, "agent");
            asm volatile("s_waitcnt vmcnt(0)" ::: "memory");
            const unsigned og = xb_add(&bar[XB_TOP], 1u);
            const unsigned tg = og / nx;
            if (og + 1u == (tg + 1u) * nx) xb_add(&bar[XB_TOPGEN], 1u);
            else XB_SPIN(xb_ld(&bar[XB_TOPGEN]) == tg, bar);
            __builtin_amdgcn_fence(__ATOMIC_ACQUIRE, "agent");
            xb_add(&bar[XB_XGEN(b.x)], 1u);
            asm volatile("s_waitcnt vmcnt(0)" ::: "memory");
        } else {
            XB_SPIN(xb_ld(&bar[XB_XGEN(b.x)]) == gen, bar);
            __builtin_amdgcn_fence(__ATOMIC_ACQUIRE, "agent");
            asm volatile("s_waitcnt vmcnt(0)" ::: "memory");
        }
    }
    __syncthreads();
}

namespace pg8 {
constexpr int BM = 256, BK = 64, HALF = 128, HTB = HALF * BK * 2, STAGE_BYTES = 8 * HTB, NXCD = 8, WGM = 8;
__host__ __device__ __forceinline__ int lds_byte(int r, int c) { const int st = (r >> 4) * 2 + (c >> 5), rr = r & 15, cc = c & 31, ob = rr * 64 + cc * 2; return st * 1024 + (ob ^ (((ob >> 9) & 1) << 5)); }
__host__ __device__ __forceinline__ void stage_rc(int b, int& R, int& C) { const int st = b / 1024, sb = b % 1024, swz = sb ^ (((sb >> 9) & 1) << 5); R = (st >> 1) * 16 + swz / 64; C = (st & 1) * 32 + (swz % 64) / 2; }
__host__ __device__ __forceinline__ int perm32(int rho) { const int n = rho >> 4, i = rho & 15; return 8 * (i >> 2) + 4 * n + (i & 3); }
struct Unit { int pm, pn; };
struct Gemm { const bf16_t* A; const bf16_t* Bt; int lda, K; };

struct TileOrder {
    int nM, nN, nwg, G, c, mode;
    __device__ void init(int nM_, int nN_, int G_, int c_, int mode_) { nM = nM_; nN = nN_; nwg = nM * nN; G = G_; c = c_; mode = mode_; }
    __device__ bool next(int i, Unit& u) const {
        const long L = (long)i * G + c; if (L >= nwg) return false;
        int wgid = (int)L; { const int q = nwg / NXCD, r = nwg % NXCD, xcd = wgid % NXCD, off = wgid / NXCD; wgid = (xcd < r ? xcd * (q + 1) : r * (q + 1) + (xcd - r) * q) + off; }
        const int nig = WGM * nN, gid = wgid / nig, fm = gid * WGM, gsz = (nM - fm) < WGM ? (nM - fm) : WGM;
        const int pl = fm + ((wgid % nig) % gsz); u.pn = (wgid % nig) / gsz;
        u.pm = mode == 0 ? pl : (mode == 1 ? 17 * (pl >> 4) + 1 + (pl & 15) : 17 * pl);
        return true;
    }
    __device__ __forceinline__ void a_ready(const Unit&) const {}
    __device__ __forceinline__ void done(const Unit&) const {}
};

template <class Epi, class Sched>
__device__ __forceinline__ void gemm_phase(ldsp_t lds, const Gemm g, const Sched& S, const Epi& E) {
    int tid = threadIdx.x; asm volatile("" : "+v"(tid));
    const int wid = __builtin_amdgcn_readfirstlane(tid >> 6), lane = tid & 63, wr = wid >> 2, wc = wid & 3, fr = lane & 15, fq = lane >> 4;
    int K = g.K; asm volatile("" : "+s"(K));
    const int nt = K / BK, lda = g.lda;
    unsigned voffA[2], voffB[2];
#pragma unroll
    for (int i = 0; i < 2; ++i) { int R, C; stage_rc(tid * 16 + i * 8192, R, C); const int Rb = (R & ~31) + perm32(R & 31);
        voffA[i] = (unsigned)(R * lda + C) * 2u; voffB[i] = (unsigned)(Rb * K + C) * 2u; }
    const size_t kstep = (size_t)(BK * 2);
    const size_t hstepA = (size_t)HALF * lda * 2, hstepB = (size_t)HALF * K * 2;
    const size_t tstepA = 2 * hstepA, tstepB = 2 * hstepB;
    const unsigned ldsw = (unsigned)wid * 1024u;
    const int aoff = lds_byte(wr * 64 + fr, fq * 8), boff = lds_byte(wc * 32 + fr, fq * 8);
#define PG8_SA(b, h) (((b) * 2 + (h)) * HTB)
#define PG8_SB(b, h) ((4 + (b) * 2 + (h)) * HTB)
#define PG8_STAGE(bufoff, gbase, voff) do { _Pragma("unroll") for (int _i = 0; _i < 2; ++_i) \
        __builtin_amdgcn_global_load_lds((const unsigned*)((const char*)(gbase) + (voff)[_i]), (LAS unsigned*)(lds + (bufoff) + ldsw + _i * 8192), 16, 0, 0); } while (0)
#define PG8_LDA(dst, b, h) do { _Pragma("unroll") for (int m = 0; m < 4; ++m) _Pragma("unroll") for (int k = 0; k < 2; ++k) dst[m][k] = *(const LAS bf16x8*)(lds + PG8_SA(b, h) + aoff + m * 2048 + k * 1024); } while (0)
#define PG8_LDB(dst, b, h) do { _Pragma("unroll") for (int n = 0; n < 2; ++n) _Pragma("unroll") for (int k = 0; k < 2; ++k) dst[n][k] = *(const LAS bf16x8*)(lds + PG8_SB(b, h) + boff + n * 2048 + k * 1024); } while (0)
#define PG8_MMA(ai, bj, At, Bt) do { __builtin_amdgcn_s_setprio(1); _Pragma("unroll") for (int m = 0; m < 4; ++m) _Pragma("unroll") for (int n = 0; n < 2; ++n) _Pragma("unroll") for (int k = 0; k < 2; ++k) \
        acc[ai][bj][m][n] = __builtin_amdgcn_mfma_f32_16x16x32_bf16(Bt[n][k], At[m][k], acc[ai][bj][m][n], 0, 0, 0); __builtin_amdgcn_s_setprio(0); } while (0)
#define PG8_WAIT_V(n) asm volatile("s_waitcnt vmcnt(" #n ")" ::: "memory")
#define PG8_WAIT_L(n) asm volatile("s_waitcnt lgkmcnt(" #n ")" ::: "memory")
#define PG8_BAR __builtin_amdgcn_s_barrier()
#define PG8_SCHED __builtin_amdgcn_sched_barrier(0)
    Unit cur, nxt; int ui = 0;
    if (!S.next(0, cur)) return;
    f32x4 acc[2][2][4][2];
#pragma unroll
    for (int a = 0; a < 2; ++a)
#pragma unroll
        for (int b = 0; b < 2; ++b)
#pragma unroll
            for (int m = 0; m < 4; ++m)
#pragma unroll
                for (int n = 0; n < 2; ++n) acc[a][b][m][n] = (f32x4){0.f, 0.f, 0.f, 0.f};
    bf16x8 At[4][2], B0[2][2], B1[2][2];
    const char* cA = (const char*)g.A + (size_t)cur.pm * tstepA; const char* cB = (const char*)g.Bt + (size_t)cur.pn * tstepB;
    S.a_ready(cur);
    PG8_STAGE(PG8_SB(0, 0), cB, voffB); PG8_STAGE(PG8_SA(0, 0), cA, voffA); PG8_STAGE(PG8_SB(0, 1), cB + hstepB, voffB); PG8_STAGE(PG8_SA(0, 1), cA + hstepA, voffA);
    if (wr == 1) PG8_BAR;
    PG8_WAIT_V(4); PG8_BAR;
    PG8_STAGE(PG8_SB(1, 0), cB + kstep, voffB); PG8_STAGE(PG8_SA(1, 0), cA + kstep, voffA); PG8_STAGE(PG8_SB(1, 1), cB + hstepB + kstep, voffB);
    PG8_WAIT_V(6); PG8_BAR;
    for (;;) {
        const bool has_next = S.next(ui + 1, nxt);
        const char* nA = has_next ? (const char*)g.A + (size_t)nxt.pm * tstepA : cA; const char* nB = has_next ? (const char*)g.Bt + (size_t)nxt.pn * tstepB : cB;
#pragma unroll 1
        for (int t = 0; t < nt; t += 2) {
            const bool last = (t == nt - 2);
            const char* a1 = cA + (size_t)(t + 1) * kstep;
            const char* a2 = last ? nA : cA + (size_t)(t + 2) * kstep; const char* b2 = last ? nB : cB + (size_t)(t + 2) * kstep;
            const char* a3 = a2 + kstep; const char* b3 = b2 + kstep;
            if (last && has_next) S.a_ready(nxt);
            PG8_LDB(B0, 0, 0); PG8_SCHED; PG8_LDA(At, 0, 0); PG8_STAGE(PG8_SA(1, 1), a1 + hstepA, voffA);
            PG8_WAIT_L(8); PG8_BAR; PG8_WAIT_L(0); PG8_MMA(0, 0, At, B0); PG8_BAR; PG8_SCHED;
            PG8_LDB(B1, 0, 1); PG8_STAGE(PG8_SB(0, 0), b2, voffB);
            PG8_BAR; PG8_WAIT_L(0); PG8_MMA(0, 1, At, B1); PG8_BAR;
            PG8_LDA(At, 0, 1); PG8_STAGE(PG8_SA(0, 0), a2, voffA);
            PG8_BAR; PG8_WAIT_L(0); PG8_MMA(1, 0, At, B0); PG8_BAR; PG8_SCHED;
            PG8_STAGE(PG8_SB(0, 1), b2 + hstepB, voffB);
            PG8_WAIT_V(6); PG8_BAR; PG8_MMA(1, 1, At, B1); PG8_BAR;
            PG8_LDB(B0, 1, 0); PG8_SCHED; PG8_LDA(At, 1, 0); PG8_STAGE(PG8_SA(0, 1), a2 + hstepA, voffA);
            PG8_WAIT_L(8); PG8_BAR; PG8_WAIT_L(0); PG8_MMA(0, 0, At, B0); PG8_BAR; PG8_SCHED;
            PG8_LDB(B1, 1, 1); PG8_STAGE(PG8_SB(1, 0), b3, voffB);
            PG8_BAR; PG8_WAIT_L(0); PG8_MMA(0, 1, At, B1); PG8_BAR;
            PG8_LDA(At, 1, 1); PG8_STAGE(PG8_SA(1, 0), a3, voffA);
            PG8_BAR; PG8_WAIT_L(0); PG8_MMA(1, 0, At, B0); PG8_BAR; PG8_SCHED;
            PG8_STAGE(PG8_SB(1, 1), b3 + hstepB, voffB);
            PG8_WAIT_V(6); PG8_BAR; PG8_MMA(1, 1, At, B1); PG8_BAR;
        }
        E(acc, cur, wr, wc, fr, fq); S.done(cur);
        if (!has_next) break;
#pragma unroll
        for (int a = 0; a < 2; ++a)
#pragma unroll
            for (int b = 0; b < 2; ++b)
#pragma unroll
                for (int m = 0; m < 4; ++m)
#pragma unroll
                    for (int n = 0; n < 2; ++n) acc[a][b][m][n] = (f32x4){0.f, 0.f, 0.f, 0.f};
        cur = nxt; cA = nA; cB = nB; ++ui;
    }
    PG8_WAIT_V(0);
    if (wr == 0) PG8_BAR;
    PG8_BAR;
#undef PG8_SA
#undef PG8_SB
#undef PG8_STAGE
#undef PG8_LDA
#undef PG8_LDB
#undef PG8_MMA
#undef PG8_WAIT_V
#undef PG8_WAIT_L
#undef PG8_BAR
#undef PG8_SCHED
}

__device__ __forceinline__ u32x4 pack8(const f32x4 a, const f32x4 b) { u32x4 w; w.x = cvt_pk_bf16(a[0], a[1]); w.y = cvt_pk_bf16(a[2], a[3]); w.z = cvt_pk_bf16(b[0], b[1]); w.w = cvt_pk_bf16(b[2], b[3]); return w; }
#define EPI_ARGS const f32x4 (&acc)[2][2][4][2], const Unit& u, int wr, int wc, int fr_, int fq_
#define EPI_LANE int fr = fr_, fq = fq_; asm volatile("" : "+v"(fr), "+v"(fq));

struct EpiBf16 {
    bf16_t* O; int ldc;
    __device__ __forceinline__ void operator()(EPI_ARGS) const {
        EPI_LANE
        const int row0 = u.pm * BM + wr * 64 + fr, col0 = u.pn * BM + wc * 32 + 8 * fq;
#pragma unroll
        for (int ai = 0; ai < 2; ++ai)
#pragma unroll
            for (int m = 0; m < 4; ++m) { bf16_t* rowp = O + (size_t)(row0 + ai * HALF + m * 16) * ldc + col0;
#pragma unroll
                for (int bj = 0; bj < 2; ++bj) *(u32x4*)(rowp + bj * HALF) = pack8(acc[ai][bj][m][0], acc[ai][bj][m][1]); }
    }
};
struct EpiF32 {
    float* C; int ldc;
    __device__ __forceinline__ void operator()(EPI_ARGS) const {
        EPI_LANE
        const int row0 = u.pm * BM + wr * 64 + fr, col0 = u.pn * BM + wc * 32 + 8 * fq;
#pragma unroll
        for (int ai = 0; ai < 2; ++ai)
#pragma unroll
            for (int m = 0; m < 4; ++m) { float* rowp = C + (size_t)(row0 + ai * HALF + m * 16) * ldc + col0;
#pragma unroll
                for (int bj = 0; bj < 2; ++bj) { *(f32x4*)(rowp + bj * HALF) = acc[ai][bj][m][0]; *(f32x4*)(rowp + bj * HALF + 4) = acc[ai][bj][m][1]; } }
    }
};
struct EpiKvUp {
    bf16_t* KB; bf16_t* VB;
    __device__ __forceinline__ void operator()(EPI_ARGS) const {
        EPI_LANE
        const int row0 = u.pm * BM + wr * 64 + fr, d0 = wc * 32 + 8 * fq;
        const bool isk = u.pn < 4;
        bf16_t* base = isk ? KB + (2 * u.pn) * 192 + d0 : VB + (u.pn - 4) * 256 + d0;
        const int ldr = isk ? 1536 : 1024, bjs = isk ? 192 : 128;
#pragma unroll
        for (int ai = 0; ai < 2; ++ai)
#pragma unroll
            for (int m = 0; m < 4; ++m) { bf16_t* rowp = base + (size_t)(row0 + ai * HALF + m * 16) * ldr;
#pragma unroll
                for (int bj = 0; bj < 2; ++bj) *(u32x4*)(rowp + bj * bjs) = pack8(acc[ai][bj][m][0], acc[ai][bj][m][1]); }
    }
};
struct EpiQUp {
    bf16_t* QB; const float* cosr; const float* sinr;
    __device__ __forceinline__ void operator()(EPI_ARGS) const {
        EPI_LANE
        const int row0 = u.pm * BM + wr * 64 + fr;
        if (u.pn < 4) {
            const int d0 = wc * 32 + 8 * fq;
#pragma unroll
            for (int ai = 0; ai < 2; ++ai)
#pragma unroll
                for (int m = 0; m < 4; ++m) { const size_t row = (size_t)(row0 + ai * HALF + m * 16);
#pragma unroll
                    for (int bj = 0; bj < 2; ++bj) *(u32x4*)(QB + row * 1536 + (2 * u.pn + bj) * 192 + d0) = pack8(acc[ai][bj][m][0], acc[ai][bj][m][1]); }
        } else {
            const int head = 4 * (u.pn - 4) + wc, i0 = 8 * fq;
            const bool lat = (u.pm % 17) != 0; const int posbase = (u.pm % 17) * 256 - 256;
#pragma unroll
            for (int ai = 0; ai < 2; ++ai)
#pragma unroll
                for (int m = 0; m < 4; ++m) { const int rl = wr * 64 + fr + ai * HALF + m * 16; const size_t row = (size_t)u.pm * BM + rl;
                    f32x4 c0 = {1.f, 1.f, 1.f, 1.f}, c1 = c0, s0 = {0.f, 0.f, 0.f, 0.f}, s1 = s0;
                    if (lat) { const float* cp = cosr + (size_t)(posbase + rl) * 32 + i0; const float* sp = sinr + (size_t)(posbase + rl) * 32 + i0;
                        c0 = *(const f32x4*)cp; c1 = *(const f32x4*)(cp + 4); s0 = *(const f32x4*)sp; s1 = *(const f32x4*)(sp + 4); }
                    const f32x4 x1a = acc[ai][0][m][0], x1b = acc[ai][0][m][1], x2a = acc[ai][1][m][0], x2b = acc[ai][1][m][1];
                    const f32x4 o1a = x1a * c0 - x2a * s0, o1b = x1b * c1 - x2b * s1, o2a = x2a * c0 + x1a * s0, o2b = x2b * c1 + x1b * s1;
                    bf16_t* dst = QB + row * 1536 + head * 192 + 128 + i0;
                    *(u32x4*)dst = pack8(o1a, o1b); *(u32x4*)(dst + 32) = pack8(o2a, o2b); asm volatile("" ::: "memory"); }
        }
    }
};
struct EpiMerge {
    bf16_t* ACC; const bf16_t* gate; int ldg; int first;
    __device__ __forceinline__ void operator()(EPI_ARGS) const {
        EPI_LANE
        const int row0 = u.pm * BM + wr * 64 + fr, col0 = u.pn * BM + wc * 32 + 8 * fq;
#pragma unroll
        for (int ai = 0; ai < 2; ++ai)
#pragma unroll
            for (int m = 0; m < 4; ++m) { const size_t row = (size_t)(row0 + ai * HALF + m * 16);
#pragma unroll
                for (int bj = 0; bj < 2; ++bj) { const int col = col0 + bj * HALF;
                    const u32x4 gw = *(const u32x4*)(gate + row * ldg + col);
                    u32x4 pw = {0u, 0u, 0u, 0u}; if (!first) pw = *(const u32x4*)(ACC + row * 2048 + col);
                    const f32x4 a0 = acc[ai][bj][m][0], a1 = acc[ai][bj][m][1];
                    f32x4 r0, r1;
                    r0[0] = bflo(pw.x) + sigmoidf_(bflo(gw.x)) * a0[0]; r0[1] = bfhi(pw.x) + sigmoidf_(bfhi(gw.x)) * a0[1];
                    r0[2] = bflo(pw.y) + sigmoidf_(bflo(gw.y)) * a0[2]; r0[3] = bfhi(pw.y) + sigmoidf_(bfhi(gw.y)) * a0[3];
                    r1[0] = bflo(pw.z) + sigmoidf_(bflo(gw.z)) * a1[0]; r1[1] = bfhi(pw.z) + sigmoidf_(bfhi(gw.z)) * a1[1];
                    r1[2] = bflo(pw.w) + sigmoidf_(bflo(gw.w)) * a1[2]; r1[3] = bfhi(pw.w) + sigmoidf_(bfhi(gw.w)) * a1[3];
                    *(u32x4*)(ACC + row * 2048 + col) = pack8(r0, r1); } asm volatile("" ::: "memory"); }
    }
};
struct EpiWo {
    float* X1; const float* mod  ; const float* xlat  ; const float* xctx  ;
    __device__ __forceinline__ void operator()(EPI_ARGS) const {
        EPI_LANE
        const int b = u.pm / 17, tb = u.pm % 17; const bool isctx = tb == 0;
        const float* g1 = mod + (size_t)(isctx ? 4 : b) * 12288 + 2 * 2048;
        const float* xbase = isctx ? xctx + (size_t)b * cf::CTX * 2048 : xlat + ((size_t)b * cf::S + (size_t)(tb - 1) * 256) * 2048;
        const int rl0 = wr * 64 + fr, col0 = u.pn * BM + wc * 32 + 8 * fq;
#pragma unroll
        for (int ai = 0; ai < 2; ++ai)
#pragma unroll
            for (int m = 0; m < 4; ++m) { const int rl = rl0 + ai * HALF + m * 16; const size_t row = (size_t)u.pm * BM + rl;
#pragma unroll
                for (int bj = 0; bj < 2; ++bj) { const int col = col0 + bj * HALF;
                    const f32x4 x0 = *(const f32x4*)(xbase + (size_t)rl * 2048 + col), x1 = *(const f32x4*)(xbase + (size_t)rl * 2048 + col + 4);
                    const f32x4 ga = *(const f32x4*)(g1 + col), gb = *(const f32x4*)(g1 + col + 4);
                    *(f32x4*)(X1 + row * 2048 + col) = x0 * cf::ALPHA + ga * acc[ai][bj][m][0];
                    *(f32x4*)(X1 + row * 2048 + col + 4) = x1 * cf::ALPHA + gb * acc[ai][bj][m][1]; } asm volatile("" ::: "memory"); }
    }
};
}

struct Ctx {
    const float* const* in; float* out; unsigned char* ws;
    ldsp_t lds; int tid, lane, wave, G, bid;
};
#define WSP(T, off) ((T*)(F.ws + (off)))
__device__ __forceinline__ Ctx phase_ctx(const Ctx& F0) {
    Ctx C = F0;
    asm volatile("" : "+v"(C.tid));
    asm volatile("" : "+s"(C.ws));
    C.lane = C.tid & 63; C.wave = __builtin_amdgcn_readfirstlane(C.tid >> 6);
    return C;
}

__device__ __forceinline__ int srcmap(int mode, int n) {
    if (mode == 0) return n < 832 ? n : (n < 1024 ? -1 : n - 192);
    if (mode == 1) { if (n < 1024) return (n >> 7) * 192 + (n & 127);
        const int m = n - 1024, t = m >> 8, bj = (m >> 7) & 1, q = m & 127; return (4 * t + (q >> 5)) * 192 + 128 + bj * 32 + (q & 31); }
    if (mode == 2) { if (n < 1024) return (n >> 7) * 256 + (n & 127); const int m = n - 1024; return (m >> 7) * 256 + 128 + (m & 127); }
    return n;
}
__device__ __forceinline__ void tr_tile(const Ctx& F, const float* src, int ld_src, int mode, int k0, bf16_t* dst, int ldd, int n0) {
    LAS float* T = (LAS float*)F.lds;
    const int kr = F.tid >> 4, nc = (F.tid & 15) * 4, sc = srcmap(mode, n0 + nc);
#pragma unroll
    for (int h = 0; h < 2; ++h) { const int k = kr + 32 * h; f32x4 v = {0.f, 0.f, 0.f, 0.f};
        if (sc >= 0) v = *(const f32x4*)(src + (size_t)(k0 + k) * ld_src + sc);
        T[k * 65 + nc + 0] = v[0]; T[k * 65 + nc + 1] = v[1]; T[k * 65 + nc + 2] = v[2]; T[k * 65 + nc + 3] = v[3]; }
    __syncthreads();
    const int n = F.tid >> 3, kc = (F.tid & 7) * 8;
    u32x4 w;
    w.x = cvt_pk_bf16(T[(kc + 0) * 65 + n], T[(kc + 1) * 65 + n]); w.y = cvt_pk_bf16(T[(kc + 2) * 65 + n], T[(kc + 3) * 65 + n]);
    w.z = cvt_pk_bf16(T[(kc + 4) * 65 + n], T[(kc + 5) * 65 + n]); w.w = cvt_pk_bf16(T[(kc + 6) * 65 + n], T[(kc + 7) * 65 + n]);
    *(u32x4*)(dst + (size_t)(n0 + n) * ldd + k0 + kc) = w;
    __syncthreads();
}
__device__ __forceinline__ void cvt_rows(const Ctx& F, const float* src, bf16_t* dst, size_t n8) {
    for (size_t i = (size_t)F.bid * 512 + F.tid; i < n8; i += (size_t)F.G * 512) {
        const f32x4 a = *(const f32x4*)(src + i * 8), b = *(const f32x4*)(src + i * 8 + 4);
        *(u32x4*)(dst + i * 8) = pg8::pack8(a, b); }
}

__device__ __forceinline__ void cvt_rows_fp8(const Ctx& F, const float* src, unsigned char* dst, size_t n16, float scale) {
    for (size_t i = (size_t)F.bid * 512 + F.tid; i < n16; i += (size_t)F.G * 512) {
        u32x4 w;
#pragma unroll
        for (int j = 0; j < 4; ++j) { const f32x4 a = *(const f32x4*)(src + i * 16 + 4 * j) * scale;
            int p = 0; p = __builtin_amdgcn_cvt_pk_fp8_f32(a[0], a[1], p, false); p = __builtin_amdgcn_cvt_pk_fp8_f32(a[2], a[3], p, true); w[j] = (unsigned)p; }
        *(u32x4*)(dst + i * 16) = w; }
}

__device__ __forceinline__ void ph_prologue(const Ctx& F0) {
    const Ctx F = phase_ctx(F0);
    using namespace cf;
    constexpr int T_WIN = 2 * 32 * 224, T_QUP = 2 * 8 * 24, T_KVUP = 2 * 4 * 32, T_BR = 2 * 4 * 16 * 32, T_WO = 2 * 32 * 32;
    constexpr int T_ALL = T_WIN + T_QUP + T_KVUP + T_BR + T_WO;
    for (int u = F.bid; u < T_ALL; u += F.G) {
        int t = u;
        if (t < T_WIN) { const int l = t / (32 * 224), r = t % (32 * 224), kt = r / 224, nt = r % 224;
            tr_tile(F, F.in[I_WIN] + (size_t)l * 2048 * IN_COLS, IN_COLS, 0, kt * 64, WSP(bf16_t, WS_WIN) + (size_t)l * NC * 2048, 2048, nt * 64); continue; }
        t -= T_WIN;
        if (t < T_QUP) { const int l = t / (8 * 24), r = t % (8 * 24), kt = r / 24, nt = r % 24;
            tr_tile(F, F.in[I_WQUP] + (size_t)l * 512 * 1536, 1536, 1, kt * 64, WSP(bf16_t, WS_WQUP) + (size_t)l * 1536 * 512, 512, nt * 64); continue; }
        t -= T_QUP;
        if (t < T_KVUP) { const int l = t / (4 * 32), r = t % (4 * 32), kt = r / 32, nt = r % 32;
            tr_tile(F, F.in[I_WKVUP] + (size_t)l * 256 * 2048, 2048, 2, kt * 64, WSP(bf16_t, WS_WKVUP) + (size_t)l * 2048 * 256, 256, nt * 64); continue; }
        t -= T_KVUP;
        if (t < T_BR) { const int l = t / (4 * 512), r = t % (4 * 512), br = r / 512, r2 = r % 512, kt = r2 / 32, nt = r2 % 32;
            const float* src = (br == 0 ? F.in[I_WBRA] : br == 1 ? F.in[I_WBRB] : br == 2 ? F.in[I_WBRC] : F.in[I_WBRD]) + (size_t)l * 1024 * 2048;
            tr_tile(F, src, 2048, 3, kt * 64, WSP(bf16_t, WS_WBR) + ((size_t)l * 4 + br) * 2048 * 1024, 1024, nt * 64); continue; }
        t -= T_BR;
        { const int l = t / 1024, r = t % 1024, kt = r / 32, nt = r % 32;
            tr_tile(F, F.in[I_WO] + (size_t)l * 2048 * 2048, 2048, 3, kt * 64, WSP(bf16_t, WS_WO) + (size_t)l * 2048 * 2048, 2048, nt * 64); }
    }
    for (int u = F.bid; u < 2 * 16 * 32; u += F.G) {
        const int l = u / 512, g = (u % 512) / 32, d0 = (u % 32) * 64;
        LAS float* sk = (LAS float*)F.lds; LAS float* wt = (LAS float*)(F.lds + 128 * 129 * 4);
        const float* skg = F.in[I_PSK] + ((size_t)l * 16 + g) * 128 * 128;
        const float* wqg = F.in[I_PWQ] + (size_t)l * 2048 * 2048 + (size_t)d0 * 2048 + g * 128;
        for (int i = F.tid; i < 128 * 128; i += 512) sk[(i >> 7) * 129 + (i & 127)] = skg[i];
        for (int i = F.tid; i < 64 * 128; i += 512) wt[(i >> 7) * 129 + (i & 127)] = wqg[(size_t)(i >> 7) * 2048 + (i & 127)];
        __syncthreads();
        const int n = F.tid & 127, dg = F.tid >> 7;
        float a[16];
#pragma unroll
        for (int e = 0; e < 16; ++e) a[e] = 0.f;
        for (int k = 0; k < 128; ++k) { const float s = sk[n * 129 + k];
#pragma unroll
            for (int e = 0; e < 16; ++e) a[e] += wt[(dg * 16 + e) * 129 + k] * s; }
        bf16_t* dst = WSP(bf16_t, WS_WFOLD) + (size_t)l * 2048 * 2048 + (size_t)(g * 128 + n) * 2048 + d0 + dg * 16;
        u32x4 w0, w1;
        w0.x = cvt_pk_bf16(a[0], a[1]); w0.y = cvt_pk_bf16(a[2], a[3]); w0.z = cvt_pk_bf16(a[4], a[5]); w0.w = cvt_pk_bf16(a[6], a[7]);
        w1.x = cvt_pk_bf16(a[8], a[9]); w1.y = cvt_pk_bf16(a[10], a[11]); w1.z = cvt_pk_bf16(a[12], a[13]); w1.w = cvt_pk_bf16(a[14], a[15]);
        *(u32x4*)dst = w0; *(u32x4*)(dst + 8) = w1;
        __syncthreads();
    }
    for (int u = F.bid; u < 2 * 192; u += F.G) {
        const int l = u / 192, n0 = (u % 192) * 64;
        LAS float* sl = (LAS float*)F.lds; LAS float* red = (LAS float*)(F.lds + 5 * 2048 * 4);
        for (int i = F.tid; i < 5 * 2048; i += 512) { const int r = i >> 11, k = i & 2047; const float v = r < 4 ? F.in[I_C][r * 2048 + k] : F.in[I_CCTX][k]; sl[i] = v * sigmoidf_(v); }
        __syncthreads();
        const int col = F.tid & 63, ks = F.tid >> 6;
        float a[5] = {0.f, 0.f, 0.f, 0.f, 0.f};
        const float* wp = F.in[I_WADA] + (size_t)l * 2048 * 12288 + n0 + col;
        for (int k = ks * 256; k < ks * 256 + 256; ++k) { const float w = wp[(size_t)k * 12288];
#pragma unroll
            for (int r = 0; r < 5; ++r) a[r] += sl[r * 2048 + k] * w; }
#pragma unroll
        for (int r = 0; r < 5; ++r) red[(ks * 5 + r) * 64 + col] = a[r];
        __syncthreads();
        if (F.tid < 320) { const int r = F.tid >> 6; float s = 0.f;
#pragma unroll
            for (int k2 = 0; k2 < 8; ++k2) s += red[(k2 * 5 + r) * 64 + col];
            WSP(float, WS_MOD)[((size_t)l * 5 + r) * 12288 + n0 + col] = s + F.in[I_BADA][(size_t)l * 12288 + n0 + col]; }
        __syncthreads();
    }
    for (int i = F.bid * 512 + F.tid; i < 4096 * 64; i += F.G * 512) {
        const int pos = i >> 6, j = i & 63, fi = j & 31; const float fr = powf(10000.0f, -(float)(2 * fi) / 64.0f);
        const float ang = (float)(j < 32 ? (pos >> 6) : (pos & 63)) * fr;
        WSP(float, WS_COSH)[i] = cosf(ang); WSP(float, WS_SINH)[i] = sinf(ang);
    }
    for (int i = F.bid * 512 + F.tid; i < 4096 * 32; i += F.G * 512) {
        const int pos = i >> 5, j = i & 31, fi = j & 15; const float fr = powf(10000.0f, -(float)(2 * fi) / 32.0f);
        const float ang = (float)(j < 16 ? (pos >> 6) : (pos & 63)) * fr;
        WSP(float, WS_COSR)[i] = cosf(ang); WSP(float, WS_SINR)[i] = sinf(ang);
    }
    cvt_rows_fp8(F, F.in[I_PU], WSP(unsigned char, WS_UB), (size_t)2 * NEXP * 2048 / 16, 1024.f);
    cvt_rows_fp8(F, F.in[I_PV], WSP(unsigned char, WS_VB2), (size_t)2 * NEXP * 2048 / 16, 16.f);
}

__device__ __forceinline__ void ph_modulate0(const Ctx& F0) {
    const Ctx F = phase_ctx(F0);
    using namespace cf;
    const float* mod = WSP(float, WS_MOD);
    for (size_t i = (size_t)F.bid * 512 + F.tid; i < (size_t)MR * 256; i += (size_t)F.G * 512) {
        const int R = (int)(i >> 8), d = (int)(i & 255) * 8, b = R / RB, j = R % RB;
        const float* src = j < CTX ? F.in[I_CTX] + ((size_t)b * CTX + j) * 2048 : F.in[I_X] + ((size_t)b * S + (j - CTX)) * 2048;
        const float* m = mod + (size_t)(j < CTX ? 4 : b) * 12288;
        const f32x4 x0 = *(const f32x4*)(src + d), x1 = *(const f32x4*)(src + d + 4);
        const f32x4 sh0 = *(const f32x4*)(m + d), sh1 = *(const f32x4*)(m + d + 4), s0 = *(const f32x4*)(m + 2048 + d), s1 = *(const f32x4*)(m + 2048 + d + 4);
        *(u32x4*)(WSP(bf16_t, WS_HB) + (size_t)R * 2048 + d) = pg8::pack8(x0 * (s0 + 1.0f) + sh0, x1 * (s1 + 1.0f) + sh1);
    }
}

__device__ __forceinline__ void ph_post(const Ctx& F0, int layer) {
    const Ctx F = phase_ctx(F0);
    using namespace cf;
    bf16_t* P = WSP(bf16_t, WS_P); bf16_t* KB = WSP(bf16_t, WS_KB);
    const float* akn = F.in[I_AKN] + layer * 128; const float* aqn = F.in[I_AQN] + layer * 128;
    const float* bkvn = F.in[I_BKVN] + layer * 256; const float* bqn = F.in[I_BQN] + layer * 512;
    const int lane = F.lane;
    for (int R = F.bid * 8 + F.wave; R < MR; R += F.G * 8) {
        const int j = R % RB; const bool lat = j >= CTX; const int pos = lat ? j - CTX : 0;
        const bool full = lat || layer == 0;
        bf16_t* p = P + (size_t)R * NC;
        const float ch = lat ? WSP(float, WS_COSH)[pos * 64 + lane] : 1.f, sh = lat ? WSP(float, WS_SINH)[pos * 64 + lane] : 0.f;
        const float akg1 = akn[lane], akg2 = akn[64 + lane];
#pragma unroll
        for (int h = 0; h < 2; ++h) { bf16_t* q = p + PC_AK + h * 128; const float x1 = bf2f(q[lane]), x2 = bf2f(q[64 + lane]);
            const float r = rsqrtf(wave_sum(x1 * x1 + x2 * x2) * (1.f / 128.f) + 1e-6f); const float y1 = x1 * r * akg1, y2 = x2 * r * akg2;
            q[lane] = f2bf(y1 * ch - y2 * sh); q[64 + lane] = f2bf(y2 * ch + y1 * sh); }
        { bf16_t* q = p + PC_CKV; float x[4]; float ss = 0.f;
#pragma unroll
            for (int i = 0; i < 4; ++i) { x[i] = bf2f(q[lane + 64 * i]); ss += x[i] * x[i]; }
            const float r = rsqrtf(wave_sum(ss) * (1.f / 256.f) + 1e-6f);
#pragma unroll
            for (int i = 0; i < 4; ++i) q[lane + 64 * i] = f2bf(x[i] * r * bkvn[lane + 64 * i]); }
        if (lane < 32) { const float x1 = bf2f(p[PC_KR + lane]), x2 = bf2f(p[PC_KR + 32 + lane]);
            const float c = lat ? WSP(float, WS_COSR)[pos * 32 + lane] : 1.f, s = lat ? WSP(float, WS_SINR)[pos * 32 + lane] : 0.f;
            const bf16_t o1 = f2bf(x1 * c - x2 * s), o2 = f2bf(x2 * c + x1 * s);
            bf16_t* kb = KB + (size_t)R * 1536 + 128 + lane;
#pragma unroll
            for (int h = 0; h < 8; ++h) { kb[h * 192] = o1; kb[h * 192 + 32] = o2; } }
        if (lat) {
#pragma unroll
            for (int h = 0; h < 2; ++h) { bf16_t* q = p + PC_DK + h * 128; const float x1 = bf2f(q[lane]), x2 = bf2f(q[64 + lane]);
                q[lane] = f2bf(x1 * ch - x2 * sh); q[64 + lane] = f2bf(x2 * ch + x1 * sh); } }
        if (!full) continue;
        { const float g1 = aqn[lane], g2 = aqn[64 + lane];
#pragma unroll
            for (int h = 0; h < 8; ++h) { bf16_t* q = p + PC_AQ + h * 128; const float x1 = bf2f(q[lane]), x2 = bf2f(q[64 + lane]);
                const float r = rsqrtf(wave_sum(x1 * x1 + x2 * x2) * (1.f / 128.f) + 1e-6f); const float y1 = x1 * r * g1, y2 = x2 * r * g2;
                q[lane] = f2bf(y1 * ch - y2 * sh); q[64 + lane] = f2bf(y2 * ch + y1 * sh); } }
        { bf16_t* q = p + PC_CQ; float x[8]; float ss = 0.f;
#pragma unroll
            for (int i = 0; i < 8; ++i) { x[i] = bf2f(q[lane + 64 * i]); ss += x[i] * x[i]; }
            const float r = rsqrtf(wave_sum(ss) * (1.f / 512.f) + 1e-6f);
#pragma unroll
            for (int i = 0; i < 8; ++i) q[lane + 64 * i] = f2bf(x[i] * r * bqn[lane + 64 * i]); }
        if (lat) {
#pragma unroll
            for (int h = 0; h < 8; ++h) { bf16_t* q = p + PC_DQ + h * 128; const float x1 = bf2f(q[lane]), x2 = bf2f(q[64 + lane]);
                q[lane] = f2bf(x1 * ch - x2 * sh); q[64 + lane] = f2bf(x2 * ch + x1 * sh); } }
#pragma unroll
        for (int i = 0; i < 16; ++i) { const float a = bf2f(p[PC_GLU + lane + 64 * i]), gt = bf2f(p[PC_GLU + 1024 + lane + 64 * i]); p[PC_GLU + lane + 64 * i] = f2bf(a * sigmoidf_(gt)); }
    }
}

struct AttnArgs {
    const bf16_t* Q; const bf16_t* K; const bf16_t* V; bf16_t* O; int ldq, ldk, ldv, ldo;
    int seg0_row, seg0_tiles, seg1_row, seg1_tiles;
    int mask_on, qpos0, kpos1;
    float sc_log2; int has_sink; float sink_l2;
};
typedef float f32x16 __attribute__((ext_vector_type(16)));
template <int DK>
__device__ __forceinline__ void attn_unit(ldsp_t lds, const AttnArgs a) {
    constexpr int ND = DK / 16, KST = DK + 8, KCH = DK / 8, KPT = (64 * KCH) / 512, VST = 72;
    constexpr int KBUF = 64 * KST * 2, VBUF = 128 * VST * 2, VOFF = 2 * KBUF, ALOFF = VOFF + 2 * VBUF;
    int tid = threadIdx.x; asm volatile("" : "+v"(tid));
    const int wid = __builtin_amdgcn_readfirstlane(tid >> 6), lane = tid & 63, q32 = lane & 31, hi = lane >> 5;
    LAS float* al = (LAS float*)(lds + ALOFF + wid * 128);
    bf16x8 qf[ND];
    { const bf16_t* qrow = a.Q + (size_t)(wid * 32 + q32) * a.ldq + 8 * hi;
#pragma unroll
      for (int s = 0; s < ND; ++s) qf[s] = *(const bf16x8*)(qrow + 16 * s); }
    f32x16 o[4];
#pragma unroll
    for (int db = 0; db < 4; ++db)
#pragma unroll
        for (int r = 0; r < 16; ++r) o[db][r] = 0.f;
    float m_run = -1e30f, l_run = 0.f;
    const int ntiles = a.seg0_tiles + a.seg1_tiles;
    u32x4 kreg[KPT], vreg[2];
    const int vkp = tid & 31, vdc = tid >> 5;
    const int vkey = 2 * vkp, vpos = (vkey & 48) | ((vkey & 4) << 1) | ((vkey & 8) >> 1) | (vkey & 3);
#define ATT_LOAD(tt) do { const int _r0 = (tt) < a.seg0_tiles ? a.seg0_row + 64 * (tt) : a.seg1_row + 64 * ((tt) - a.seg0_tiles); \
        _Pragma("unroll") for (int _i = 0; _i < KPT; ++_i) { const int _c = tid + 512 * _i; kreg[_i] = *(const u32x4*)(a.K + (size_t)(_r0 + _c / KCH) * a.ldk + 8 * (_c % KCH)); } \
        vreg[0] = *(const u32x4*)(a.V + (size_t)(_r0 + 2 * vkp) * a.ldv + 8 * vdc); vreg[1] = *(const u32x4*)(a.V + (size_t)(_r0 + 2 * vkp + 1) * a.ldv + 8 * vdc); } while (0)
#define ATT_WRITE(buf) do { const ldsp_t _kb = lds + (buf) * KBUF; const ldsp_t _vb = lds + VOFF + (buf) * VBUF; \
        _Pragma("unroll") for (int _i = 0; _i < KPT; ++_i) { const int _c = tid + 512 * _i; *(LAS u32x4*)(_kb + ((_c / KCH) * KST + 8 * (_c % KCH)) * 2) = kreg[_i]; } \
        const unsigned _a0[4] = {vreg[0].x, vreg[0].y, vreg[0].z, vreg[0].w}, _a1[4] = {vreg[1].x, vreg[1].y, vreg[1].z, vreg[1].w}; \
        _Pragma("unroll") for (int _e = 0; _e < 4; ++_e) { \
            *(LAS unsigned*)(_vb + ((8 * vdc + 2 * _e) * VST + vpos) * 2) = (_a0[_e] & 0xffffu) | (_a1[_e] << 16); \
            *(LAS unsigned*)(_vb + ((8 * vdc + 2 * _e + 1) * VST + vpos) * 2) = (_a0[_e] >> 16) | (_a1[_e] & 0xffff0000u); } } while (0)
    ATT_LOAD(0);
    ATT_WRITE(0);
    __syncthreads();
    for (int tt = 0; tt < ntiles; ++tt) {
        const int cur = tt & 1;
        if (tt + 1 < ntiles) ATT_LOAD(tt + 1);
        const ldsp_t Ks = lds + cur * KBUF, Vt = lds + VOFF + cur * VBUF;
        f32x16 s0, s1;
#pragma unroll
        for (int r = 0; r < 16; ++r) { s0[r] = 0.f; s1[r] = 0.f; }
#pragma unroll
        for (int s = 0; s < ND; ++s) {
            const bf16x8 k0 = *(const LAS bf16x8*)(Ks + (q32 * KST + 16 * s + 8 * hi) * 2), k1 = *(const LAS bf16x8*)(Ks + ((32 + q32) * KST + 16 * s + 8 * hi) * 2);
            s0 = __builtin_amdgcn_mfma_f32_32x32x16_bf16(k0, qf[s], s0, 0, 0, 0);
            s1 = __builtin_amdgcn_mfma_f32_32x32x16_bf16(k1, qf[s], s1, 0, 0, 0); }
        const bool msk = a.mask_on && tt >= a.seg0_tiles;
        const int kp0 = a.kpos1 + 64 * (tt - a.seg0_tiles) + 4 * hi, qp = a.qpos0 + wid * 32 + q32;
        float mx = -1e30f;
#pragma unroll
        for (int r = 0; r < 16; ++r) { float t0 = s0[r] * a.sc_log2, t1 = s1[r] * a.sc_log2;
            if (msk) { const int d0 = qp - (kp0 + (r & 3) + 8 * (r >> 2)), d1 = d0 - 32; if (d0 > 128 || d0 < -128) t0 = -1e30f; if (d1 > 128 || d1 < -128) t1 = -1e30f; }
            s0[r] = t0; s1[r] = t1; mx = fmaxf(mx, fmaxf(t0, t1)); }
        mx = fmaxf(mx, __shfl_xor(mx, 32));
        const float m_new = fmaxf(m_run, mx), alpha = __builtin_amdgcn_exp2f(m_run - m_new); m_run = m_new;
        float ps = 0.f;
#pragma unroll
        for (int r = 0; r < 16; ++r) { s0[r] = __builtin_amdgcn_exp2f(s0[r] - m_new); s1[r] = __builtin_amdgcn_exp2f(s1[r] - m_new); ps += s0[r] + s1[r]; }
        l_run = l_run * alpha + ps;
        if (__any(alpha < 1.0f)) {
            if (hi == 0) al[q32] = alpha;
            asm volatile("s_waitcnt lgkmcnt(0)" ::: "memory");
#pragma unroll
            for (int g4 = 0; g4 < 4; ++g4) { const f32x4 av = *(const LAS f32x4*)(al + 8 * g4 + 4 * hi);
#pragma unroll
                for (int db = 0; db < 4; ++db)
#pragma unroll
                    for (int j = 0; j < 4; ++j) o[db][4 * g4 + j] *= av[j]; }
        }
        bf16x8 pa[4];
#pragma unroll
        for (int g2 = 0; g2 < 2; ++g2) {
            u32x4 w; w.x = cvt_pk_bf16(s0[8 * g2 + 0], s0[8 * g2 + 1]); w.y = cvt_pk_bf16(s0[8 * g2 + 2], s0[8 * g2 + 3]); w.z = cvt_pk_bf16(s0[8 * g2 + 4], s0[8 * g2 + 5]); w.w = cvt_pk_bf16(s0[8 * g2 + 6], s0[8 * g2 + 7]); pa[g2] = *(bf16x8*)&w;
            u32x4 v; v.x = cvt_pk_bf16(s1[8 * g2 + 0], s1[8 * g2 + 1]); v.y = cvt_pk_bf16(s1[8 * g2 + 2], s1[8 * g2 + 3]); v.z = cvt_pk_bf16(s1[8 * g2 + 4], s1[8 * g2 + 5]); v.w = cvt_pk_bf16(s1[8 * g2 + 6], s1[8 * g2 + 7]); pa[2 + g2] = *(bf16x8*)&v; }
#pragma unroll
        for (int db = 0; db < 4; ++db)
#pragma unroll
            for (int ks = 0; ks < 4; ++ks) { const bf16x8 vf = *(const LAS bf16x8*)(Vt + ((32 * db + q32) * VST + 16 * ks + 8 * hi) * 2);
                o[db] = __builtin_amdgcn_mfma_f32_32x32x16_bf16(pa[ks], vf, o[db], 0, 0, 0); }
        if (tt + 1 < ntiles) ATT_WRITE(cur ^ 1);
        __syncthreads();
    }
#undef ATT_LOAD
#undef ATT_WRITE
    float l_tot = l_run + __shfl_xor(l_run, 32);
    if (a.has_sink) l_tot += __builtin_amdgcn_exp2f(a.sink_l2 - m_run);
    if (hi == 0) al[q32] = 1.0f / l_tot;
    asm volatile("s_waitcnt lgkmcnt(0)" ::: "memory");
    const ldsp_t Ost = lds + wid * 8192;
#pragma unroll
    for (int g4 = 0; g4 < 4; ++g4) { const f32x4 iv = *(const LAS f32x4*)(al + 8 * g4 + 4 * hi);
#pragma unroll
        for (int db = 0; db < 4; ++db)
#pragma unroll
            for (int j = 0; j < 4; ++j) *(LAS bf16_t*)(Ost + ((8 * g4 + 4 * hi + j) * 128 + 32 * db + q32) * 2) = f2bf(o[db][4 * g4 + j] * iv[j]); }
    asm volatile("s_waitcnt lgkmcnt(0)" ::: "memory");
#pragma unroll
    for (int i = 0; i < 8; ++i) { const int c = lane + 64 * i, row = c >> 4, c8 = c & 15;
        *(u32x4*)(a.O + (size_t)(wid * 32 + row) * a.ldo + 8 * c8) = *(const LAS u32x4*)(Ost + (row * 128 + 8 * c8) * 2); }
}

__device__ __forceinline__ void conv_unit(const Ctx& F, int layer, int row0  , int seq_len, int t0) {
    using namespace cf;
    const bf16_t* P = WSP(const bf16_t, WS_P); bf16_t* BR = WSP(bf16_t, WS_BR);
    const float* cw = F.in[I_CW] + (size_t)layer * 31 * 1024; const float* cb = F.in[I_CB] + layer * 1024;
    const float* lg = F.in[I_CLG] + layer * 1024; const float* lb = F.in[I_CLB] + layer * 1024;
    int tid = F.tid; asm volatile("" : "+v"(tid));
    const int lane = tid & 63;
    LAS float* red = (LAS float*)(F.lds + 126976); LAS float* tot = red + 8 * 32;
    __syncthreads();
    for (int c = tid; c < 62 * 128; c += 512) { const int rr = c >> 7, ch = c & 127, t = t0 - 15 + rr;
        u32x4 v = {0u, 0u, 0u, 0u};
        if (t >= 0 && t < seq_len) v = *(const u32x4*)(P + (size_t)(row0 + t) * NC + PC_GLU + ch * 8);
        *(LAS u32x4*)(F.lds + rr * 2048 + ch * 16) = v; }
    float w0[31], w1[31];
#pragma unroll
    for (int k = 0; k < 31; ++k) { const f32x2 w = *(const f32x2*)(cw + k * 1024 + 2 * tid); w0[k] = w.x; w1[k] = w.y; }
    const f32x2 bv = *(const f32x2*)(cb + 2 * tid), gg = *(const f32x2*)(lg + 2 * tid), bb = *(const f32x2*)(lb + 2 * tid);
    __syncthreads();
#pragma unroll 1
    for (int part = 0; part < 4; ++part) {
        float a0[8], a1[8];
#pragma unroll
        for (int t = 0; t < 8; ++t) { a0[t] = bv.x; a1[t] = bv.y; }
        const ldsp_t base = F.lds + part * 8 * 2048 + tid * 4;
#pragma unroll
        for (int rr = 0; rr < 38; ++rr) { const unsigned xw = *(const LAS unsigned*)(base + rr * 2048); const float x0 = bflo(xw), x1 = bfhi(xw);
#pragma unroll
            for (int t = 0; t < 8; ++t) { const int k = rr - t; if (k >= 0 && k <= 30) { a0[t] += x0 * w0[k]; a1[t] += x1 * w1[k]; } } }
        float v[16];
#pragma unroll
        for (int t = 0; t < 8; ++t) { v[t] = a0[t] + a1[t]; v[8 + t] = a0[t] * a0[t] + a1[t] * a1[t]; }
#pragma unroll
        for (int i = 0; i < 8; ++i) { const bool up = lane & 32; const float snd = up ? v[i] : v[i + 8], kp = up ? v[i + 8] : v[i]; v[i] = kp + __shfl_xor(snd, 32); }
#pragma unroll
        for (int i = 0; i < 4; ++i) { const bool up = lane & 16; const float snd = up ? v[i] : v[i + 4], kp = up ? v[i + 4] : v[i]; v[i] = kp + __shfl_xor(snd, 16); }
#pragma unroll
        for (int i = 0; i < 2; ++i) { const bool up = lane & 8; const float snd = up ? v[i] : v[i + 2], kp = up ? v[i + 2] : v[i]; v[i] = kp + __shfl_xor(snd, 8); }
        { const bool up = lane & 4; const float snd = up ? v[0] : v[1], kp = up ? v[1] : v[0]; v[0] = kp + __shfl_xor(snd, 4); }
        v[0] += __shfl_xor(v[0], 2); v[0] += __shfl_xor(v[0], 1);
        if ((lane & 3) == 0) red[F.wave * 16 + (lane >> 2)] = v[0];
        __syncthreads();
        if (tid < 16) { float s = 0.f;
#pragma unroll
            for (int w = 0; w < 8; ++w) s += red[w * 16 + tid];
            tot[tid] = s; }
        __syncthreads();
#pragma unroll
        for (int t = 0; t < 8; ++t) { const float mean = tot[t] * (1.f / 1024.f), var = fmaxf(tot[8 + t] * (1.f / 1024.f) - mean * mean, 0.f), rstd = rsqrtf(var + 1e-5f);
            const float y0 = (a0[t] - mean) * rstd * gg.x + bb.x, y1 = (a1[t] - mean) * rstd * gg.y + bb.y;
            *(unsigned*)(BR + (size_t)(row0 + t0 + part * 8 + t) * 4096 + 2048 + 2 * tid) = cvt_pk_bf16(y0 * sigmoidf_(y0), y1 * sigmoidf_(y1)); }
    }
}

__device__ __forceinline__ void attn_defaults(AttnArgs& a, int isctx) {
    a.seg0_row = 0; a.seg0_tiles = isctx ? 4 : 68; a.seg1_row = 0; a.seg1_tiles = 0; a.mask_on = 0; a.qpos0 = 0; a.kpos1 = 0; a.has_sink = 0; a.sink_l2 = 0.f; }
__device__ __forceinline__ void ph_attn(const Ctx& F0, int layer) {
    const Ctx F = phase_ctx(F0);
    using namespace cf;
    const bf16_t* P = WSP(const bf16_t, WS_P); bf16_t* BR = WSP(bf16_t, WS_BR);
    for (int dup = 0; dup < DUPN(2); ++dup)
    for (int u = F.bid; u < (layer == 0 ? 544 : 512); u += F.G) {
        int b, h, qb, isctx = 0;
        if (u < 512) { b = u >> 7; h = (u >> 4) & 7; qb = u & 15; } else { const int r = u - 512; b = r >> 3; h = r & 7; qb = 0; isctx = 1; }
        const size_t brow = (size_t)b * RB, qrow = brow + (isctx ? 0 : CTX) + (size_t)qb * 256;
        AttnArgs a; attn_defaults(a, isctx);
        a.Q = WSP(const bf16_t, WS_QB) + qrow * 1536 + h * 192; a.ldq = 1536;
        a.K = WSP(const bf16_t, WS_KB) + brow * 1536 + h * 192; a.ldk = 1536;
        a.V = WSP(const bf16_t, WS_VB) + brow * 1024 + h * 128; a.ldv = 1024;
        a.O = BR + qrow * 4096 + 1024 + h * 128; a.ldo = 4096; a.sc_log2 = SCALE_MLA * LOG2E;
        __syncthreads();
        attn_unit<192>(F.lds, a);
    }
    for (int dup = 0; dup < DUPN(3); ++dup)
    for (int u0 = F.bid; u0 < (layer == 0 ? 1088 : 1024); u0 += F.G) {
        int kind, b, h, qb, isctx = 0;
        if (u0 < 1024) { kind = 1 + (u0 >> 9); const int r = u0 & 511; b = r >> 7; h = (r >> 4) & 7; qb = r & 15; }
        else { const int r = u0 - 1024; kind = 1 + (r >> 5); const int r2 = r & 31; b = r2 >> 3; h = r2 & 7; qb = 0; isctx = 1; }
        const size_t brow = (size_t)b * RB, qrow = brow + (isctx ? 0 : CTX) + (size_t)qb * 256;
        AttnArgs a; attn_defaults(a, isctx);
        const int qc = kind == 1 ? PC_AQ : PC_DQ, kc = kind == 1 ? PC_AK : PC_DK, vc = kind == 1 ? PC_AV : PC_DV;
        a.Q = P + qrow * NC + qc + h * 128; a.ldq = NC;
        a.K = P + brow * NC + kc + (h >> 2) * 128; a.ldk = NC;
        a.V = P + brow * NC + vc + (h >> 2) * 128; a.ldv = NC;
        a.O = BR + qrow * 4096 + (kind == 1 ? 0 : 3072) + h * 128; a.ldo = 4096; a.sc_log2 = SCALE_HD * LOG2E;
        if (kind == 2) { a.has_sink = 1; a.sink_l2 = F.in[I_SINK][layer * 8 + h] * LOG2E; a.seg0_tiles = 4;
            if (!isctx) { const int start = qb * 256; const int lo = start - 128 < 0 ? 0 : start - 128, hi = start + 384 > S ? S : start + 384;
                a.seg1_row = CTX + lo; a.seg1_tiles = (hi - lo) / 64; a.mask_on = 1; a.qpos0 = start; a.kpos1 = lo; } }
        __syncthreads();
        attn_unit<128>(F.lds, a);
    }
    for (int dup = 0; dup < DUPN(4); ++dup)
    for (int u = F.bid; u < (layer == 0 ? 544 : 512); u += F.G) {
        int b, tb, isctx = 0;
        if (u < 512) { b = u >> 7; tb = u & 127; } else { const int r = u - 512; b = r >> 3; tb = r & 7; isctx = 1; }
        conv_unit(F, layer, b * RB + (isctx ? 0 : CTX), isctx ? CTX : S, tb * 32);
    }
}

__device__ __forceinline__ int tok_row(int layer, int tok) { return layer == 0 ? tok : (tok >> 12) * cf::RB + cf::CTX + (tok & 4095); }
__device__ __forceinline__ void ph_ln1(const Ctx& F0, int layer) {
    const Ctx F = phase_ctx(F0);
    using namespace cf;
    float* X1 = (float*)(F.ws + WS_P + X1_OFF); bf16_t* HB = WSP(bf16_t, WS_HB);
    const float* lg = F.in[I_LN1G] + layer * 2048; const float* lb = F.in[I_LN1B] + layer * 2048;
    const int ntok = layer == 0 ? MR : NB * S, lane = F.lane;
    for (int tok = F.bid * 8 + F.wave; tok < ntok; tok += F.G * 8) {
        const int R = tok_row(layer, tok), b = R / RB, j = R % RB;
        const float* mod = WSP(const float, WS_MOD) + ((size_t)layer * 5 + (j < CTX ? 4 : b)) * 12288;
        float* xp = X1 + (size_t)R * 2048;
        f32x4 v[8]; float s = 0.f;
#pragma unroll
        for (int i = 0; i < 8; ++i) { v[i] = *(const f32x4*)(xp + lane * 4 + 256 * i); s += (v[i][0] + v[i][1]) + (v[i][2] + v[i][3]); }
        const float mean = wave_sum(s) * (1.f / 2048.f); float q = 0.f;
#pragma unroll
        for (int i = 0; i < 8; ++i) { const f32x4 d = v[i] - mean; q += (d[0] * d[0] + d[1] * d[1]) + (d[2] * d[2] + d[3] * d[3]); }
        const float rstd = rsqrtf(wave_sum(q) * (1.f / 2048.f) + 1e-5f);
#pragma unroll
        for (int i = 0; i < 8; ++i) { const int c = lane * 4 + 256 * i;
            const f32x4 y = (v[i] - mean) * rstd * *(const f32x4*)(lg + c) + *(const f32x4*)(lb + c);
            *(f32x4*)(xp + c) = y;
            const f32x4 hp = y * (*(const f32x4*)(mod + 4 * 2048 + c) + 1.0f) + *(const f32x4*)(mod + 3 * 2048 + c);
            u32x2 w; w.x = cvt_pk_bf16(hp[0], hp[1]); w.y = cvt_pk_bf16(hp[2], hp[3]);
            *(u32x2*)(HB + (size_t)R * 2048 + c) = w; }
    }
}

typedef __bf16 bf16x2_t __attribute__((ext_vector_type(2)));
__device__ __forceinline__ unsigned ordkey(float v) { const unsigned u = __float_as_uint(v); return (u & 0x80000000u) ? ~u : (u | 0x80000000u); }
__device__ __forceinline__ int lane_rank(unsigned long long m) { return (int)__builtin_amdgcn_mbcnt_hi((unsigned)(m >> 32), __builtin_amdgcn_mbcnt_lo((unsigned)m, 0u)); }
template <int NV> __device__ __forceinline__ unsigned radix_thresh16(const unsigned (&k)[NV]) {
    unsigned T = 0u;
    for (int bit = 31; bit >= 0; --bit) { const unsigned cand = T | (1u << bit); int cnt = 0;
#pragma unroll
        for (int v = 0; v < NV; ++v) cnt += __popcll(__ballot(k[v] >= cand));
        if (cnt >= 16) T = cand; }
    return T;
}
__device__ __forceinline__ float dot2bf(unsigned a, unsigned b, float acc) { return __builtin_amdgcn_fdot2_f32_bf16(__builtin_bit_cast(bf16x2_t, a), __builtin_bit_cast(bf16x2_t, b), acc, false); }
__device__ __forceinline__ float dot8(const u32x4 a, const u32x4 b, float acc) {
    acc = dot2bf(a.x, b.x, acc); acc = dot2bf(a.y, b.y, acc); acc = dot2bf(a.z, b.z, acc); acc = dot2bf(a.w, b.w, acc);
    return acc;
}
__device__ __forceinline__ void ph_peer(const Ctx& F0, int layer) {
    const Ctx F = phase_ctx(F0);
    using namespace cf;
    const float* SC = (const float*)(F.ws + WS_P + SC_OFF); const float* X1 = (const float*)(F.ws + WS_P + X1_OFF);
    bf16_t* HB = WSP(bf16_t, WS_HB); const unsigned char* U8 = WSP(const unsigned char, WS_UB) + (size_t)layer * NEXP * 2048; const unsigned char* V8 = WSP(const unsigned char, WS_VB2) + (size_t)layer * NEXP * 2048;
    const float* lg = F.in[I_LN2G] + layer * 2048; const float* lb = F.in[I_LN2B] + layer * 2048;
    const int ntok = layer == 0 ? MR : NB * S, lane = F.lane;
    ldsp_t wl = F.lds + F.wave * 4096;
    LAS float* tv0 = (LAS float*)wl; LAS int* ti0 = (LAS int*)(wl + 64); LAS float* tv1 = (LAS float*)(wl + 128); LAS int* ti1 = (LAS int*)(wl + 192);
    LAS float* es = (LAS float*)(wl + 256); LAS int* ei = (LAS int*)(wl + 768); LAS float* eg = (LAS float*)(wl + 1280);
    for (int tok = F.bid * 8 + F.wave; tok < ntok; tok += F.G * 8) {
        const int R = tok_row(layer, tok), b = R / RB, j = R % RB; const bool isctx = j < CTX; const int modrow = isctx ? 4 : b;
        const float* sc = SC + (size_t)R * 2048;
        for (int h = 0; h < 8; ++h) {
            const float s0a = sc[(2 * h) * 128 + lane], s0b = sc[(2 * h) * 128 + 64 + lane], s1a = sc[(2 * h + 1) * 128 + lane], s1b = sc[(2 * h + 1) * 128 + 64 + lane];
            { const unsigned k[2] = {(ordkey(s0a) & ~127u) | (unsigned)(127 - lane), (ordkey(s0b) & ~127u) | (unsigned)(63 - lane)};
              const unsigned T = radix_thresh16<2>(k);
              const unsigned long long m0 = __ballot(k[0] >= T), m1 = __ballot(k[1] >= T); const int n0 = __popcll(m0);
              if (k[0] >= T) { const int r = lane_rank(m0); tv0[r] = s0a; ti0[r] = lane; }
              if (k[1] >= T) { const int r = n0 + lane_rank(m1); tv0[r] = s0b; ti0[r] = lane + 64; } }
            { const unsigned k[2] = {(ordkey(s1a) & ~127u) | (unsigned)(127 - lane), (ordkey(s1b) & ~127u) | (unsigned)(63 - lane)};
              const unsigned T = radix_thresh16<2>(k);
              const unsigned long long m0 = __ballot(k[0] >= T), m1 = __ballot(k[1] >= T); const int n0 = __popcll(m0);
              if (k[0] >= T) { const int r = lane_rank(m0); tv1[r] = s1a; ti1[r] = lane; }
              if (k[1] >= T) { const int r = n0 + lane_rank(m1); tv1[r] = s1b; ti1[r] = lane + 64; } }
            asm volatile("s_waitcnt lgkmcnt(0)" ::: "memory");
            const int ci = lane >> 2, cj = (lane & 3) * 4;
            const float a0 = tv0[ci]; const int i0 = ti0[ci];
            float c4[4]; int id4[4]; unsigned kc[4];
#pragma unroll
            for (int jj = 0; jj < 4; ++jj) { c4[jj] = a0 + tv1[cj + jj]; id4[jj] = i0 * 128 + ti1[cj + jj]; kc[jj] = (ordkey(c4[jj]) & ~255u) | (unsigned)(255 - (lane * 4 + jj)); }
            const unsigned Tc = radix_thresh16<4>(kc);
            int base = h * 16;
#pragma unroll
            for (int jj = 0; jj < 4; ++jj) { const unsigned long long m = __ballot(kc[jj] >= Tc);
                if (kc[jj] >= Tc) { const int r = base + lane_rank(m); es[r] = c4[jj]; ei[r] = id4[jj]; }
                base += __popcll(m); }
            asm volatile("s_waitcnt lgkmcnt(0)" ::: "memory");
        }
#pragma unroll
        for (int rnd = 0; rnd < 2; ++rnd) { const int e = lane + 64 * rnd; const float s = es[e];
            float m = s; m = fmaxf(m, __shfl_xor(m, 1)); m = fmaxf(m, __shfl_xor(m, 2)); m = fmaxf(m, __shfl_xor(m, 4)); m = fmaxf(m, __shfl_xor(m, 8));
            const float ex = __expf(s - m); float sum = ex; sum += __shfl_xor(sum, 1); sum += __shfl_xor(sum, 2); sum += __shfl_xor(sum, 4); sum += __shfl_xor(sum, 8);
            eg[e] = ex / sum; }
        asm volatile("s_waitcnt lgkmcnt(0)" ::: "memory");
        f32x2 xf[16];
#pragma unroll
        for (int i = 0; i < 2; ++i)
#pragma unroll
            for (int hh = 0; hh < 2; ++hh) { const u32x4 w = *(const u32x4*)(HB + (size_t)R * 2048 + lane * 16 + 1024 * i + 8 * hh);
                xf[8 * i + 4 * hh + 0] = (f32x2){bflo(w.x), bfhi(w.x)}; xf[8 * i + 4 * hh + 1] = (f32x2){bflo(w.y), bfhi(w.y)};
                xf[8 * i + 4 * hh + 2] = (f32x2){bflo(w.z), bfhi(w.z)}; xf[8 * i + 4 * hh + 3] = (f32x2){bflo(w.w), bfhi(w.w)}; }
        f32x2 y2[16];
#pragma unroll
        for (int i = 0; i < 16; ++i) y2[i] = (f32x2){0.f, 0.f};
        for (int grp = 0; grp < 32; ++grp) {
            int id[4]; float gq[4];
#pragma unroll
            for (int q = 0; q < 4; ++q) { id[q] = __builtin_amdgcn_readfirstlane(ei[grp * 4 + q]); gq[q] = __uint_as_float(__builtin_amdgcn_readfirstlane(__float_as_uint(eg[grp * 4 + q]))); }
            u32x4 ur[4][2], vr[4][2];
#pragma unroll
            for (int q = 0; q < 4; ++q)
#pragma unroll
                for (int i = 0; i < 2; ++i) { ur[q][i] = *(const u32x4*)(U8 + (size_t)id[q] * 2048 + lane * 16 + 1024 * i); vr[q][i] = *(const u32x4*)(V8 + (size_t)id[q] * 2048 + lane * 16 + 1024 * i); }
            float d[4];
#pragma unroll
            for (int q = 0; q < 4; ++q) { f32x2 t = {0.f, 0.f};
#pragma unroll
                for (int i = 0; i < 2; ++i)
#pragma unroll
                    for (int j = 0; j < 4; ++j) { const int w = (int)ur[q][i][j];
                        t += __builtin_amdgcn_cvt_pk_f32_fp8(w, false) * xf[8 * i + 2 * j]; t += __builtin_amdgcn_cvt_pk_f32_fp8(w, true) * xf[8 * i + 2 * j + 1]; }
                d[q] = t.x + t.y; }
#pragma unroll
            for (int o = 32; o >= 1; o >>= 1) {
#pragma unroll
                for (int q = 0; q < 4; ++q) d[q] += __shfl_xor(d[q], o); }
#pragma unroll
            for (int q = 0; q < 4; ++q) { const float dd = d[q] * (1.0f / 1024.0f); const float w = gq[q] * 0.5f * dd * (1.0f + erff(dd * 0.70710678118654752f)) * (1.0f / 16.0f);
                const f32x2 w2 = {w, w};
#pragma unroll
                for (int i = 0; i < 2; ++i)
#pragma unroll
                    for (int j = 0; j < 4; ++j) { const int vw = (int)vr[q][i][j];
                        y2[8 * i + 2 * j] += w2 * __builtin_amdgcn_cvt_pk_f32_fp8(vw, false); y2[8 * i + 2 * j + 1] += w2 * __builtin_amdgcn_cvt_pk_f32_fp8(vw, true); } }
        }
        const float* mod = WSP(const float, WS_MOD) + ((size_t)layer * 5 + modrow) * 12288;
        float y[32];
        float s = 0.f;
#pragma unroll
        for (int i = 0; i < 2; ++i)
#pragma unroll
            for (int j = 0; j < 4; ++j) { const int c = lane * 16 + 1024 * i + 4 * j;
                const f32x4 xa = *(const f32x4*)(X1 + (size_t)R * 2048 + c), ga = *(const f32x4*)(mod + 5 * 2048 + c);
                y[16 * i + 4 * j + 0] = ALPHA * xa[0] + ga[0] * y2[8 * i + 2 * j].x; y[16 * i + 4 * j + 1] = ALPHA * xa[1] + ga[1] * y2[8 * i + 2 * j].y;
                y[16 * i + 4 * j + 2] = ALPHA * xa[2] + ga[2] * y2[8 * i + 2 * j + 1].x; y[16 * i + 4 * j + 3] = ALPHA * xa[3] + ga[3] * y2[8 * i + 2 * j + 1].y;
                s += (y[16 * i + 4 * j + 0] + y[16 * i + 4 * j + 1]) + (y[16 * i + 4 * j + 2] + y[16 * i + 4 * j + 3]); }
        const float mean = wave_sum(s) * (1.f / 2048.f); float q2 = 0.f;
#pragma unroll
        for (int i = 0; i < 32; ++i) { const float dd = y[i] - mean; q2 += dd * dd; }
        const float rstd = rsqrtf(wave_sum(q2) * (1.f / 2048.f) + 1e-5f);
        float* dst = layer == 0 ? (isctx ? WSP(float, WS_XC) + ((size_t)b * CTX + j) * 2048 : F.out + ((size_t)b * S + (j - CTX)) * 2048) : F.out + ((size_t)b * S + (j - CTX)) * 2048;
        const float* modn = WSP(const float, WS_MOD) + ((size_t)1 * 5 + modrow) * 12288;
#pragma unroll
        for (int i = 0; i < 2; ++i)
#pragma unroll
            for (int hh = 0; hh < 2; ++hh) { f32x4 o[2];
#pragma unroll
                for (int jj = 0; jj < 2; ++jj) { const int j = 2 * hh + jj, c = lane * 16 + 1024 * i + 4 * j; const f32x4 la = *(const f32x4*)(lg + c), ba = *(const f32x4*)(lb + c);
#pragma unroll
                    for (int e = 0; e < 4; ++e) o[jj][e] = (y[16 * i + 4 * j + e] - mean) * rstd * la[e] + ba[e];
                    *(f32x4*)(dst + c) = o[jj]; }
                if (layer == 0) {
                    const int c = lane * 16 + 1024 * i + 8 * hh;
                    const f32x4 sa = *(const f32x4*)(modn + 2048 + c), sb = *(const f32x4*)(modn + 2048 + c + 4), ha = *(const f32x4*)(modn + c), hb = *(const f32x4*)(modn + c + 4);
                    *(u32x4*)(HB + (size_t)R * 2048 + c) = pg8::pack8(o[0] * (sa + 1.0f) + ha, o[1] * (sb + 1.0f) + hb); } }
    }
}

struct Params { const float* in[cf::N_IN]; float* out; unsigned char* ws; int ph_lo, ph_hi; };

__global__ void __launch_bounds__(512, 2) mega_fwd(Params p) {
    using namespace cf;
    extern __shared__ __attribute__((aligned(16))) unsigned char smem[];
    Ctx F0;
    F0.in = p.in;
    F0.out = p.out; F0.ws = p.ws; F0.lds = (ldsp_t)smem;
    F0.tid = threadIdx.x; F0.lane = F0.tid & 63; F0.wave = __builtin_amdgcn_readfirstlane(F0.tid >> 6); F0.G = gridDim.x; F0.bid = blockIdx.x;
    if (F0.tid < 64) ((LAS unsigned*)(F0.lds + MISC_OFF))[F0.tid] = 0u;
    __syncthreads();
    const int lo = p.ph_lo, hi = p.ph_hi;
    XcdBarrier bar; bar.bar = (unsigned*)(F0.ws + WS_CTL); bar.x = 0; bar.st = (volatile LAS unsigned*)(F0.lds + MISC_OFF);
    if (hi - lo > 1) bar = xcd_barrier_post((unsigned*)(F0.ws + WS_CTL), (volatile LAS unsigned*)(F0.lds + MISC_OFF));
#ifndef MK_MASK
#define MK_MASK 0xFFFF
#endif
#define ON(j) ((MK_MASK >> (j)) & 1)
#define IN(k) (lo <= (k) && (k) < hi)
#define SEAM(k) do { if (IN(k) && IN((k) + 1)) xcd_barrier(bar); } while (0)

    if (ON(9) && IN(0)) { ph_prologue(F0); if (DUPN(9) == 2) { __syncthreads(); ph_prologue(F0); } }
    SEAM(0);
    if (ON(10) && IN(1)) ph_modulate0(F0);
    SEAM(1);
    for (int l = 0; l < DEPTH; ++l) {
        const int pb = 2 + 9 * l;
        const int rmode = l == 0 ? 0 : 1, nMl = l == 0 ? 68 : 64;
        if (ON(0) && IN(pb + 0)) { const Ctx F = phase_ctx(F0); bf16_t* P = WSP(bf16_t, WS_P); bf16_t* HB = WSP(bf16_t, WS_HB);
            pg8::Gemm g{HB, WSP(const bf16_t, WS_WIN) + (size_t)l * NC * 2048, 2048, 2048}; pg8::EpiBf16 E{P, NC};
            pg8::TileOrder S; S.init(nMl, 56, F.G, F.bid, rmode);
            for (int dup = 0; dup < DUPN(0); ++dup)
            pg8::gemm_phase(F.lds, g, S, E);
            if (l > 0) { pg8::TileOrder S2; S2.init(4, 6, F.G, F.bid, 2); pg8::gemm_phase(F.lds, g, S2, E); }
        }
        SEAM(pb + 0);
        if (ON(1) && IN(pb + 1)) ph_post(F0, l);
        SEAM(pb + 1);
        if (DUPN(10) == 2) {
            { const Ctx F = phase_ctx(F0); bf16_t* P = WSP(bf16_t, WS_P); bf16_t* HB = WSP(bf16_t, WS_HB);
              pg8::Gemm g{HB, WSP(const bf16_t, WS_WIN) + (size_t)l * NC * 2048, 2048, 2048}; pg8::EpiBf16 E{P, NC};
              pg8::TileOrder S; S.init(nMl, 56, F.G, F.bid, rmode); pg8::gemm_phase(F.lds, g, S, E);
              if (l > 0) { pg8::TileOrder S2; S2.init(4, 6, F.G, F.bid, 2); pg8::gemm_phase(F.lds, g, S2, E); } }
            xcd_barrier(bar); ph_post(F0, l); xcd_barrier(bar); }
        if (DUPN(11) == 2) { for (int k = 0; k < 20; ++k) xcd_barrier(bar); }
        if (ON(2) && IN(pb + 2)) { const Ctx F = phase_ctx(F0); bf16_t* P = WSP(bf16_t, WS_P);
            { pg8::Gemm g{P + PC_CKV, WSP(const bf16_t, WS_WKVUP) + (size_t)l * 2048 * 256, NC, 256}; pg8::EpiKvUp E{WSP(bf16_t, WS_KB), WSP(bf16_t, WS_VB)};
              pg8::TileOrder S; S.init(68, 8, F.G, F.bid, 0); for (int dup = 0; dup < DUPN(1); ++dup) pg8::gemm_phase(F.lds, g, S, E); }
            { pg8::Gemm g{P + PC_CQ, WSP(const bf16_t, WS_WQUP) + (size_t)l * 1536 * 512, NC, 512}; pg8::EpiQUp E{WSP(bf16_t, WS_QB), WSP(const float, WS_COSR), WSP(const float, WS_SINR)};
              pg8::TileOrder S; S.init(nMl, 6, F.G, F.bid, rmode); for (int dup = 0; dup < DUPN(1); ++dup) pg8::gemm_phase(F.lds, g, S, E); }
        }
        SEAM(pb + 2);
        if (ON(3) && IN(pb + 3)) ph_attn(F0, l);
        SEAM(pb + 3);
        if (ON(4) && IN(pb + 4)) { const Ctx F = phase_ctx(F0); bf16_t* P = WSP(bf16_t, WS_P); bf16_t* HB = WSP(bf16_t, WS_HB);
            for (int dup = 0; dup < DUPN(5); ++dup)
            for (int br = 0; br < 4; ++br) {
                pg8::Gemm g{WSP(const bf16_t, WS_BR) + br * 1024, WSP(const bf16_t, WS_WBR) + ((size_t)l * 4 + br) * 2048 * 1024, 4096, 1024};
                pg8::EpiMerge E{HB, P + PC_GATE + br * 2048, NC, br == 0};
                pg8::TileOrder S; S.init(nMl, 8, F.G, F.bid, rmode); pg8::gemm_phase(F.lds, g, S, E);
            }
        }
        SEAM(pb + 4);
        if (ON(5) && IN(pb + 5)) { const Ctx F = phase_ctx(F0); bf16_t* HB = WSP(bf16_t, WS_HB);
            pg8::Gemm g{HB, WSP(const bf16_t, WS_WO) + (size_t)l * 2048 * 2048, 2048, 2048};
            pg8::EpiWo E{(float*)(F.ws + WS_P + X1_OFF), WSP(const float, WS_MOD) + (size_t)l * 5 * 12288, l == 0 ? F.in[I_X] : (const float*)F.out, F.in[I_CTX]};
            pg8::TileOrder S; S.init(nMl, 8, F.G, F.bid, rmode); for (int dup = 0; dup < DUPN(6); ++dup) pg8::gemm_phase(F.lds, g, S, E);
        }
        SEAM(pb + 5);
        if (ON(6) && IN(pb + 6)) ph_ln1(F0, l);
        SEAM(pb + 6);
        if (ON(7) && IN(pb + 7)) { const Ctx F = phase_ctx(F0); bf16_t* HB = WSP(bf16_t, WS_HB);
            pg8::Gemm g{HB, WSP(const bf16_t, WS_WFOLD) + (size_t)l * 2048 * 2048, 2048, 2048}; pg8::EpiF32 E{(float*)(F.ws + WS_P + SC_OFF), 2048};
            pg8::TileOrder S; S.init(nMl, 8, F.G, F.bid, rmode); for (int dup = 0; dup < DUPN(7); ++dup) pg8::gemm_phase(F.lds, g, S, E);
        }
        SEAM(pb + 7);
        if (ON(8) && IN(pb + 8)) { ph_peer(F0, l); if (DUPN(8) == 2 && l == 1) ph_peer(F0, l); }
        SEAM(pb + 8);
    }
#undef IN
#undef SEAM
}

extern "C" void kernel_launch(void* const* d_in, const int* in_sizes, int n_in, void* d_out, int out_size, void* d_ws, size_t ws_size, hipStream_t stream) {
    static int grid = 0;
    if (grid == 0) {
        if (n_in != cf::N_IN || out_size != cf::NB * cf::S * cf::D || ws_size < cf::WS_END) {
            fprintf(stderr, "kernel_launch: unexpected shapes: n_in %d out %d ws %zu (need %zu)\n", n_in, out_size, ws_size, (size_t)cf::WS_END); grid = -1; return; }
        int dev = 0, cus = 0;
        if (hipGetDevice(&dev) != hipSuccess || hipDeviceGetAttribute(&cus, hipDeviceAttributeMultiprocessorCount, dev) != hipSuccess || cus < 1) { grid = -1; return; }
        if (hipFuncSetAttribute((const void*)mega_fwd, hipFuncAttributeMaxDynamicSharedMemorySize, cf::LDS_BYTES) != hipSuccess) { fprintf(stderr, "kernel_launch: hipFuncSetAttribute failed\n"); grid = -1; return; }
        int per_cu = 0;
        if (hipOccupancyMaxActiveBlocksPerMultiprocessor(&per_cu, (const void*)mega_fwd, 512, cf::LDS_BYTES) != hipSuccess || per_cu < 1)
            fprintf(stderr, "kernel_launch: note: occupancy query reports %d workgroups per CU\n", per_cu);
        (void)hipGetLastError();
        grid = cus;
    }
    if (grid < 0) return;
    (void)hipMemsetAsync((char*)d_ws + cf::WS_CTL, 0, cf::CTL_BYTES, stream);
    Params p{};
    for (int i = 0; i < cf::N_IN; ++i) p.in[i] = (const float*)d_in[i];
    p.out = (float*)d_out; p.ws = (unsigned char*)d_ws;
#if MK_PER_PHASE
    for (int k = 0; k < cf::N_PHASES; ++k) { p.ph_lo = k; p.ph_hi = k + 1; hipLaunchKernelGGL(mega_fwd, dim3(grid), dim3(512), cf::LDS_BYTES, stream, p); }
#else
    p.ph_lo = 0; p.ph_hi = cf::N_PHASES;
    hipLaunchKernelGGL(mega_fwd, dim3(grid), dim3(512), cf::LDS_BYTES, stream, p);
#endif
    const hipError_t le = hipPeekAtLastError();
    if (le != hipSuccess) fprintf(stderr, "kernel_launch: launch failed: %s\n", hipGetErrorName(le));
}
```

```cpp
#include <hip/hip_runtime.h>
#include <stdint.h>
#include <stdio.h>

#ifndef MK_DUP
#define MK_DUP 0
#endif
#define DUPN(k) (((MK_DUP >> (k)) & 1) ? 2 : 1)
#ifndef MK_PER_PHASE
#define MK_PER_PHASE 0
#endif

namespace cf {
constexpr int D = 2048, NB = 4, S = 4096, CTX = 256, RB = CTX + S  , MR = NB * RB  ;
constexpr int DEPTH = 2;
constexpr int PC_AK = 0, PC_AV = 256, PC_CKV = 512, PC_KR = 768, PC_DK = 1024, PC_DV = 1280, PC_KVEND = 1536;
constexpr int PC_AQ = 1536, PC_CQ = 2560, PC_DQ = 3072, PC_GLU = 4096, PC_GATE = 6144, NC = 14336;
constexpr int IN_COLS = 14144;
constexpr int NEXP = 16384;
constexpr float ALPHA = 1.4142135623730951f;
constexpr float LOG2E = 1.4426950408889634f;
constexpr float SCALE_HD = 0.08838834764831845f;
constexpr float SCALE_MLA = 0.07216878364870323f;
enum { I_X = 0, I_C, I_CTX, I_CCTX, I_WADA, I_BADA, I_WIN, I_AQN, I_AKN, I_BQN, I_WQUP, I_BKVN, I_WKVUP, I_CW, I_CB, I_CLG, I_CLB, I_SINK,
       I_WBRA, I_WBRB, I_WBRC, I_WBRD, I_WO, I_LN1G, I_LN1B, I_LN2G, I_LN2B, I_PWQ, I_PSK, I_PU, I_PV, N_IN };
constexpr size_t al(size_t x) { return (x + 255) / 256 * 256; }
constexpr size_t WS_CTL = 0;
constexpr size_t CTL_BYTES = 65536;
constexpr size_t WS_MOD = WS_CTL + CTL_BYTES;
constexpr size_t WS_COSH = WS_MOD + al((size_t)2 * 5 * 12288 * 4);
constexpr size_t WS_SINH = WS_COSH + (size_t)4096 * 64 * 4;
constexpr size_t WS_COSR = WS_SINH + (size_t)4096 * 64 * 4;
constexpr size_t WS_SINR = WS_COSR + (size_t)4096 * 32 * 4;
constexpr size_t WS_WIN = WS_SINR + (size_t)4096 * 32 * 4;
constexpr size_t WS_WQUP = WS_WIN + (size_t)2 * NC * 2048 * 2;
constexpr size_t WS_WKVUP = WS_WQUP + (size_t)2 * 1536 * 512 * 2;
constexpr size_t WS_WBR = WS_WKVUP + (size_t)2 * 2048 * 256 * 2;
constexpr size_t WS_WO = WS_WBR + (size_t)2 * 4 * 2048 * 1024 * 2;
constexpr size_t WS_WFOLD = WS_WO + (size_t)2 * 2048 * 2048 * 2;
constexpr size_t WS_UB = WS_WFOLD + (size_t)2 * 2048 * 2048 * 2;
constexpr size_t WS_VB2 = WS_UB + (size_t)2 * NEXP * 2048;
constexpr size_t WS_HB = WS_VB2 + (size_t)2 * NEXP * 2048;
constexpr size_t WS_P = WS_HB + (size_t)MR * 2048 * 2;
constexpr size_t WS_QB = WS_P + (size_t)MR * NC * 2;
constexpr size_t WS_KB = WS_QB + (size_t)MR * 1536 * 2;
constexpr size_t WS_VB = WS_KB + (size_t)MR * 1536 * 2;
constexpr size_t WS_BR = WS_VB + (size_t)MR * 1024 * 2;
constexpr size_t WS_XC = WS_BR + (size_t)MR * 4096 * 2;
constexpr size_t WS_SSK = WS_XC + (size_t)1024 * 2048 * 4;
constexpr size_t WS_SSQ = WS_SSK + (size_t)MR * 4 * 4;
constexpr size_t WS_SSKV = WS_SSQ + (size_t)MR * 16 * 4;
constexpr size_t WS_SSCQ = WS_SSKV + (size_t)MR * 4 * 4;
constexpr size_t WS_END = WS_SSCQ + (size_t)MR * 8 * 4;
constexpr size_t X1_OFF = 0, SC_OFF = (size_t)MR * 2048 * 4;
static_assert(SC_OFF * 2 <= (size_t)MR * NC * 2, "X1 + SC fit in P");
constexpr int LDS_BYTES = 132 * 1024;
constexpr int MISC_OFF = 128 * 1024;
constexpr int N_PHASES = 2 + 8 * DEPTH;
}

typedef unsigned short bf16_t;
typedef short bf16x8 __attribute__((ext_vector_type(8)));
typedef float f32x4 __attribute__((ext_vector_type(4)));
typedef float f32x2 __attribute__((ext_vector_type(2)));
typedef unsigned u32x4 __attribute__((ext_vector_type(4)));
typedef unsigned u32x2 __attribute__((ext_vector_type(2)));
#define LAS __attribute__((address_space(3)))
typedef LAS unsigned char* ldsp_t;

__device__ __forceinline__ unsigned cvt_pk_bf16(float lo, float hi) { unsigned r; asm volatile("v_cvt_pk_bf16_f32 %0, %1, %2" : "=v"(r) : "v"(lo), "v"(hi)); return r; }
__device__ __forceinline__ bf16_t f2bf(float f) { return (bf16_t)(cvt_pk_bf16(f, 0.f) & 0xffffu); }
__device__ __forceinline__ float bf2f(bf16_t b) { return __uint_as_float(((unsigned)b) << 16); }
__device__ __forceinline__ float bflo(unsigned w) { return __uint_as_float(w << 16); }
__device__ __forceinline__ float bfhi(unsigned w) { return __uint_as_float(w & 0xffff0000u); }
__device__ __forceinline__ float wave_sum(float v) {
#pragma unroll
    for (int o = 32; o >= 1; o >>= 1) v += __shfl_xor(v, o);
    return v;
}
__device__ __forceinline__ float sigmoidf_(float x) { return 1.0f / (1.0f + __expf(-x)); }

#define XB_TMO      128
#define XB_XCNT(j)  (256  + 64 * (j))
#define XB_XSUB(j)  (1280 + 64 * (j))
#define XB_XGEN(j)  (2304 + 64 * (j))
#define XB_TOP      3328
#define XB_TOPGEN   3392
#define XCD_BAR_WORDS 3456
#define XB_SPIN_CAP (1u << 23)
__device__ __forceinline__ unsigned xb_ld(unsigned* p)              { return __hip_atomic_load(p, __ATOMIC_RELAXED, __HIP_MEMORY_SCOPE_AGENT); }
__device__ __forceinline__ unsigned xb_add(unsigned* p, unsigned v) { return __hip_atomic_fetch_add(p, v, __ATOMIC_RELAXED, __HIP_MEMORY_SCOPE_AGENT); }
__device__ __forceinline__ unsigned xb_xcc_id() { return (unsigned)__builtin_amdgcn_s_getreg((3 << 11) | 20) & 0xFu; }
#define XB_SPIN(cond, bar) do { unsigned _sp = 0; while (cond) { __builtin_amdgcn_s_sleep(1); \
    if ((++_sp & 255u) == 0u) { if (xb_ld(&(bar)[XB_TMO])) break; if (_sp > XB_SPIN_CAP) { atomicAdd(&(bar)[XB_TMO], 1u); break; } } } } while (0)
struct XcdBarrier { unsigned* bar; unsigned x; volatile LAS unsigned* st; };
__device__ __forceinline__ XcdBarrier xcd_barrier_post(unsigned* bar, volatile LAS unsigned* st) {
    XcdBarrier b; b.bar = bar; b.x = xb_xcc_id(); b.st = st;
    if (threadIdx.x == 0) (void)xb_add(&bar[XB_XCNT(b.x)], 1u);
    return b;
}
__device__ __forceinline__ void xcd_barrier_complete(unsigned* bar, unsigned x, unsigned& nloc, unsigned& nx) {
    const unsigned G = gridDim.x * gridDim.y * gridDim.z;
    unsigned sum, cnt, mine, sp = 0u;
    for (;;) {
        sum = 0u; cnt = 0u; mine = 0u;
#pragma unroll
        for (unsigned j = 0; j < 16; ++j) { const unsigned c = xb_ld(&bar[XB_XCNT(j)]); sum += c; cnt += (c > 0u) ? 1u : 0u; mine = (j == x) ? c : mine; }
        if (sum == G) break;
        __builtin_amdgcn_s_sleep(1);
        if ((++sp & 255u) == 0u) { if (xb_ld(&bar[XB_TMO])) break; if (sp > XB_SPIN_CAP) { atomicAdd(&bar[XB_TMO], 1u); break; } }
    }
    nloc = mine > 0u ? mine : 1u; nx = cnt > 0u ? cnt : 1u;
}
__device__ __forceinline__ void xcd_barrier(const XcdBarrier& b) {
    asm volatile("s_waitcnt vmcnt(0)" ::: "memory");
    __syncthreads();
    if (threadIdx.x == 0) {
        unsigned* bar = b.bar;
        __builtin_amdgcn_s_waitcnt(0);
        unsigned nloc = b.st[0], nx = b.st[1];
        if (nloc == 0u) { xcd_barrier_complete(bar, b.x, nloc, nx); b.st[0] = nloc; b.st[1] = nx; }
        const unsigned old = xb_add(&bar[XB_XSUB(b.x)], 1u);
        const unsigned gen = old / nloc;
        if (old + 1u == (gen + 1u) * nloc) {
            __builtin_amdgcn_fence(__ATOMIC_RELEASE, "agent");
            asm volatile("s_waitcnt vmcnt(0)" ::: "memory");
            const unsigned og = xb_add(&bar[XB_TOP], 1u);
            const unsigned tg = og / nx;
            if (og + 1u == (tg + 1u) * nx) xb_add(&bar[XB_TOPGEN], 1u);
            else XB_SPIN(xb_ld(&bar[XB_TOPGEN]) == tg, bar);
            __builtin_amdgcn_fence(__ATOMIC_ACQUIRE, "agent");
            xb_add(&bar[XB_XGEN(b.x)], 1u);
            asm volatile("s_waitcnt vmcnt(0)" ::: "memory");
        } else {
            XB_SPIN(xb_ld(&bar[XB_XGEN(b.x)]) == gen, bar);
            __builtin_amdgcn_fence(__ATOMIC_ACQUIRE, "agent");
            asm volatile("s_waitcnt vmcnt(0)" ::: "memory");
        }
    }
    __syncthreads();
}

namespace pg8 {
constexpr int BM = 256, BK = 64, HALF = 128, HTB = HALF * BK * 2, STAGE_BYTES = 8 * HTB, NXCD = 8, WGM = 8;
__host__ __device__ __forceinline__ int lds_byte(int r, int c) { const int st = (r >> 4) * 2 + (c >> 5), rr = r & 15, cc = c & 31, ob = rr * 64 + cc * 2; return st * 1024 + (ob ^ (((ob >> 9) & 1) << 5)); }
__host__ __device__ __forceinline__ void stage_rc(int b, int& R, int& C) { const int st = b / 1024, sb = b % 1024, swz = sb ^ (((sb >> 9) & 1) << 5); R = (st >> 1) * 16 + swz / 64; C = (st & 1) * 32 + (swz % 64) / 2; }
__host__ __device__ __forceinline__ int perm32(int rho) { const int n = rho >> 4, i = rho & 15; return 8 * (i >> 2) + 4 * n + (i & 3); }
struct Unit { int pm, pn, sub; };
struct Gemm { const bf16_t* A; const bf16_t* Bt; int lda, K; };

struct TileOrder {
    int nM, nN, nwg, G, c, mode, nsub; size_t subA, subB;
    __device__ void init(int nM_, int nN_, int G_, int c_, int mode_, int nsub_ = 1, size_t subA_ = 0, size_t subB_ = 0) { nM = nM_; nN = nN_; nwg = nM * nN; G = G_; c = c_; mode = mode_; nsub = nsub_; subA = subA_; subB = subB_; }
    __device__ bool next(int i, Unit& u) const {
        const int it = nsub == 1 ? i : i / nsub; u.sub = nsub == 1 ? 0 : i - it * nsub;
        const long L = (long)it * G + c; if (L >= nwg) return false;
        int wgid = (int)L; { const int q = nwg / NXCD, r = nwg % NXCD, xcd = wgid % NXCD, off = wgid / NXCD; wgid = (xcd < r ? xcd * (q + 1) : r * (q + 1) + (xcd - r) * q) + off; }
        const int nig = WGM * nN, gid = wgid / nig, fm = gid * WGM, gsz = (nM - fm) < WGM ? (nM - fm) : WGM;
        const int pl = fm + ((wgid % nig) % gsz); u.pn = (wgid % nig) / gsz;
        u.pm = mode == 0 ? pl : (mode == 1 ? 17 * (pl >> 4) + 1 + (pl & 15) : 17 * pl);
        return true;
    }
    __device__ __forceinline__ void a_ready(const Unit&) const {}
    __device__ __forceinline__ void done(const Unit&) const {}
};

template <class Epi, class Sched>
__device__ __forceinline__ void gemm_phase(ldsp_t lds, const Gemm g, const Sched& S, const Epi& E) {
    int tid = threadIdx.x; asm volatile("" : "+v"(tid));
    const int wid = __builtin_amdgcn_readfirstlane(tid >> 6), lane = tid & 63, wr = wid >> 2, wc = wid & 3, fr = lane & 15, fq = lane >> 4;
    int K = g.K; asm volatile("" : "+s"(K));
    const int nt = K / BK, lda = g.lda;
    unsigned voffA[2], voffB[2];
#pragma unroll
    for (int i = 0; i < 2; ++i) { int R, C; stage_rc(tid * 16 + i * 8192, R, C); const int Rb = (R & ~31) + perm32(R & 31);
        voffA[i] = (unsigned)(R * lda + C) * 2u; voffB[i] = (unsigned)(Rb * K + C) * 2u; }
    const size_t kstep = (size_t)(BK * 2);
    const size_t hstepA = (size_t)HALF * lda * 2, hstepB = (size_t)HALF * K * 2;
    const size_t tstepA = 2 * hstepA, tstepB = 2 * hstepB;
    const unsigned ldsw = (unsigned)wid * 1024u;
    const int aoff = lds_byte(wr * 64 + fr, fq * 8), boff = lds_byte(wc * 32 + fr, fq * 8);
#define PG8_SA(b, h) (((b) * 2 + (h)) * HTB)
#define PG8_SB(b, h) ((4 + (b) * 2 + (h)) * HTB)
#define PG8_STAGE(bufoff, gbase, voff) do { _Pragma("unroll") for (int _i = 0; _i < 2; ++_i) \
        __builtin_amdgcn_global_load_lds((const unsigned*)((const char*)(gbase) + (voff)[_i]), (LAS unsigned*)(lds + (bufoff) + ldsw + _i * 8192), 16, 0, 0); } while (0)
#define PG8_LDA(dst, b, h) do { _Pragma("unroll") for (int m = 0; m < 4; ++m) _Pragma("unroll") for (int k = 0; k < 2; ++k) dst[m][k] = *(const LAS bf16x8*)(lds + PG8_SA(b, h) + aoff + m * 2048 + k * 1024); } while (0)
#define PG8_LDB(dst, b, h) do { _Pragma("unroll") for (int n = 0; n < 2; ++n) _Pragma("unroll") for (int k = 0; k < 2; ++k) dst[n][k] = *(const LAS bf16x8*)(lds + PG8_SB(b, h) + boff + n * 2048 + k * 1024); } while (0)
#define PG8_MMA(ai, bj, At, Bt) do { __builtin_amdgcn_s_setprio(1); _Pragma("unroll") for (int m = 0; m < 4; ++m) _Pragma("unroll") for (int n = 0; n < 2; ++n) _Pragma("unroll") for (int k = 0; k < 2; ++k) \
        acc[ai][bj][m][n] = __builtin_amdgcn_mfma_f32_16x16x32_bf16(Bt[n][k], At[m][k], acc[ai][bj][m][n], 0, 0, 0); __builtin_amdgcn_s_setprio(0); } while (0)
#define PG8_WAIT_V(n) asm volatile("s_waitcnt vmcnt(" #n ")" ::: "memory")
#define PG8_WAIT_L(n) asm volatile("s_waitcnt lgkmcnt(" #n ")" ::: "memory")
#define PG8_BAR __builtin_amdgcn_s_barrier()
#define PG8_SCHED __builtin_amdgcn_sched_barrier(0)
    Unit cur, nxt; int ui = 0;
    if (!S.next(0, cur)) return;
    f32x4 acc[2][2][4][2];
#pragma unroll
    for (int a = 0; a < 2; ++a)
#pragma unroll
        for (int b = 0; b < 2; ++b)
#pragma unroll
            for (int m = 0; m < 4; ++m)
#pragma unroll
                for (int n = 0; n < 2; ++n) acc[a][b][m][n] = (f32x4){0.f, 0.f, 0.f, 0.f};
    bf16x8 At[4][2], B0[2][2], B1[2][2];
    const char* cA = (const char*)g.A + (size_t)cur.pm * tstepA + cur.sub * S.subA; const char* cB = (const char*)g.Bt + (size_t)cur.pn * tstepB + cur.sub * S.subB;
    S.a_ready(cur);
    PG8_STAGE(PG8_SB(0, 0), cB, voffB); PG8_STAGE(PG8_SA(0, 0), cA, voffA); PG8_STAGE(PG8_SB(0, 1), cB + hstepB, voffB); PG8_STAGE(PG8_SA(0, 1), cA + hstepA, voffA);
    if (wr == 1) PG8_BAR;
    PG8_WAIT_V(4); PG8_BAR;
    PG8_STAGE(PG8_SB(1, 0), cB + kstep, voffB); PG8_STAGE(PG8_SA(1, 0), cA + kstep, voffA); PG8_STAGE(PG8_SB(1, 1), cB + hstepB + kstep, voffB);
    PG8_WAIT_V(6); PG8_BAR;
    for (;;) {
        const bool has_next = S.next(ui + 1, nxt);
        const char* nA = has_next ? (const char*)g.A + (size_t)nxt.pm * tstepA + nxt.sub * S.subA : cA; const char* nB = has_next ? (const char*)g.Bt + (size_t)nxt.pn * tstepB + nxt.sub * S.subB : cB;
#pragma unroll 1
        for (int t = 0; t < nt; t += 2) {
            const bool last = (t == nt - 2);
            const char* a1 = cA + (size_t)(t + 1) * kstep;
            const char* a2 = last ? nA : cA + (size_t)(t + 2) * kstep; const char* b2 = last ? nB : cB + (size_t)(t + 2) * kstep;
            const char* a3 = a2 + kstep; const char* b3 = b2 + kstep;
            if (last && has_next) S.a_ready(nxt);
            PG8_LDB(B0, 0, 0); PG8_SCHED; PG8_LDA(At, 0, 0); PG8_STAGE(PG8_SA(1, 1), a1 + hstepA, voffA);
            PG8_WAIT_L(8); PG8_BAR; PG8_WAIT_L(0); PG8_MMA(0, 0, At, B0); PG8_BAR; PG8_SCHED;
            PG8_LDB(B1, 0, 1); PG8_STAGE(PG8_SB(0, 0), b2, voffB);
            PG8_BAR; PG8_WAIT_L(0); PG8_MMA(0, 1, At, B1); PG8_BAR;
            PG8_LDA(At, 0, 1); PG8_STAGE(PG8_SA(0, 0), a2, voffA);
            PG8_BAR; PG8_WAIT_L(0); PG8_MMA(1, 0, At, B0); PG8_BAR; PG8_SCHED;
            PG8_STAGE(PG8_SB(0, 1), b2 + hstepB, voffB);
            PG8_WAIT_V(6); PG8_BAR; PG8_MMA(1, 1, At, B1); PG8_BAR;
            PG8_LDB(B0, 1, 0); PG8_SCHED; PG8_LDA(At, 1, 0); PG8_STAGE(PG8_SA(0, 1), a2 + hstepA, voffA);
            PG8_WAIT_L(8); PG8_BAR; PG8_WAIT_L(0); PG8_MMA(0, 0, At, B0); PG8_BAR; PG8_SCHED;
            PG8_LDB(B1, 1, 1); PG8_STAGE(PG8_SB(1, 0), b3, voffB);
            PG8_BAR; PG8_WAIT_L(0); PG8_MMA(0, 1, At, B1); PG8_BAR;
            PG8_LDA(At, 1, 1); PG8_STAGE(PG8_SA(1, 0), a3, voffA);
            PG8_BAR; PG8_WAIT_L(0); PG8_MMA(1, 0, At, B0); PG8_BAR; PG8_SCHED;
            PG8_STAGE(PG8_SB(1, 1), b3 + hstepB, voffB);
            PG8_WAIT_V(6); PG8_BAR; PG8_MMA(1, 1, At, B1); PG8_BAR;
        }
        E(acc, cur, wr, wc, fr, fq); S.done(cur);
        if (!has_next) break;
#pragma unroll
        for (int a = 0; a < 2; ++a)
#pragma unroll
            for (int b = 0; b < 2; ++b)
#pragma unroll
                for (int m = 0; m < 4; ++m)
#pragma unroll
                    for (int n = 0; n < 2; ++n) acc[a][b][m][n] = (f32x4){0.f, 0.f, 0.f, 0.f};
        cur = nxt; cA = nA; cB = nB; ++ui;
    }
    PG8_WAIT_V(0);
    if (wr == 0) PG8_BAR;
    PG8_BAR;
#undef PG8_SA
#undef PG8_SB
#undef PG8_STAGE
#undef PG8_LDA
#undef PG8_LDB
#undef PG8_MMA
#undef PG8_WAIT_V
#undef PG8_WAIT_L
#undef PG8_BAR
#undef PG8_SCHED
}

__device__ __forceinline__ u32x4 pack8(const f32x4 a, const f32x4 b) { u32x4 w; w.x = cvt_pk_bf16(a[0], a[1]); w.y = cvt_pk_bf16(a[2], a[3]); w.z = cvt_pk_bf16(b[0], b[1]); w.w = cvt_pk_bf16(b[2], b[3]); return w; }
#define EPI_ARGS const f32x4 (&acc)[2][2][4][2], const Unit& u, int wr, int wc, int fr_, int fq_
#define EPI_LANE int fr = fr_, fq = fq_; asm volatile("" : "+v"(fr), "+v"(fq));

struct EpiBf16 {
    bf16_t* O; int ldc;
    __device__ __forceinline__ void operator()(EPI_ARGS) const {
        EPI_LANE
        const int row0 = u.pm * BM + wr * 64 + fr, col0 = u.pn * BM + wc * 32 + 8 * fq;
#pragma unroll
        for (int ai = 0; ai < 2; ++ai)
#pragma unroll
            for (int m = 0; m < 4; ++m) { bf16_t* rowp = O + (size_t)(row0 + ai * HALF + m * 16) * ldc + col0;
#pragma unroll
                for (int bj = 0; bj < 2; ++bj) *(u32x4*)(rowp + bj * HALF) = pack8(acc[ai][bj][m][0], acc[ai][bj][m][1]); }
    }
};
struct EpiF32 {
    float* C; int ldc;
    __device__ __forceinline__ void operator()(EPI_ARGS) const {
        EPI_LANE
        const int row0 = u.pm * BM + wr * 64 + fr, col0 = u.pn * BM + wc * 32 + 8 * fq;
#pragma unroll
        for (int ai = 0; ai < 2; ++ai)
#pragma unroll
            for (int m = 0; m < 4; ++m) { float* rowp = C + (size_t)(row0 + ai * HALF + m * 16) * ldc + col0;
#pragma unroll
                for (int bj = 0; bj < 2; ++bj) { *(f32x4*)(rowp + bj * HALF) = acc[ai][bj][m][0]; *(f32x4*)(rowp + bj * HALF + 4) = acc[ai][bj][m][1]; } }
    }
};
struct EpiInProj {
    bf16_t* P; bf16_t* KB; const float* cosh; const float* sinh; const float* cosr; const float* sinr; const float* akn; const float* aqn;
    float* ssk; float* ssq; float* sskv; float* sscq;
    __device__ __forceinline__ void operator()(EPI_ARGS) const {
        EPI_LANE
        const int pn = u.pn, tb = u.pm % 17; const bool lat = tb != 0; const int posbase = (tb - 1) * 256;
        const int rl0 = wr * 64 + fr;
        if (pn >= 24) {
            const int col0 = pn * BM + wc * 32 + 8 * fq;
#pragma unroll
            for (int ai = 0; ai < 2; ++ai)
#pragma unroll
                for (int m = 0; m < 4; ++m) { bf16_t* rowp = P + ((size_t)u.pm * BM + rl0 + ai * HALF + m * 16) * cf::NC + col0;
#pragma unroll
                    for (int bj = 0; bj < 2; ++bj) { f32x4 v0 = acc[ai][bj][m][0], v1 = acc[ai][bj][m][1];
#pragma unroll
                        for (int e = 0; e < 4; ++e) { v0[e] = sigmoidf_(v0[e]); v1[e] = sigmoidf_(v1[e]); }
                        *(u32x4*)(rowp + bj * HALF) = pack8(v0, v1); } }
        } else if (pn >= 16) {
            const int col0 = cf::PC_GLU + 128 * (pn - 16) + wc * 32 + 8 * fq;
#pragma unroll
            for (int ai = 0; ai < 2; ++ai)
#pragma unroll
                for (int m = 0; m < 4; ++m) { f32x4 v0 = acc[ai][0][m][0], v1 = acc[ai][0][m][1]; const f32x4 g0 = acc[ai][1][m][0], g1 = acc[ai][1][m][1];
#pragma unroll
                    for (int e = 0; e < 4; ++e) { v0[e] *= sigmoidf_(g0[e]); v1[e] *= sigmoidf_(g1[e]); }
                    *(u32x4*)(P + ((size_t)u.pm * BM + rl0 + ai * HALF + m * 16) * cf::NC + col0) = pack8(v0, v1); }
        } else if (pn == 3) {
            if (wc == 0) { const int i0 = 8 * fq;
#pragma unroll
                for (int ai = 0; ai < 2; ++ai)
#pragma unroll
                    for (int m = 0; m < 4; ++m) { const int rl = rl0 + ai * HALF + m * 16;
                        f32x4 c0 = {1.f, 1.f, 1.f, 1.f}, c1 = c0, s0 = {0.f, 0.f, 0.f, 0.f}, s1 = s0;
                        if (lat) { const float* cp = cosr + (size_t)(posbase + rl) * 32 + i0; const float* sp = sinr + (size_t)(posbase + rl) * 32 + i0;
                            c0 = *(const f32x4*)cp; c1 = *(const f32x4*)(cp + 4); s0 = *(const f32x4*)sp; s1 = *(const f32x4*)(sp + 4); }
                        const f32x4 x1a = acc[ai][0][m][0], x1b = acc[ai][0][m][1], x2a = acc[ai][1][m][0], x2b = acc[ai][1][m][1];
                        const u32x4 w1 = pack8(x1a * c0 - x2a * s0, x1b * c1 - x2b * s1), w2 = pack8(x2a * c0 + x1a * s0, x2b * c1 + x1b * s1);
                        bf16_t* kb = KB + ((size_t)u.pm * BM + rl) * 1536 + 128 + i0;
#pragma unroll
                        for (int h = 0; h < 8; ++h) { *(u32x4*)(kb + h * 192) = w1; *(u32x4*)(kb + h * 192 + 32) = w2; }
                        asm volatile("" ::: "memory"); } }
        } else if (pn == 0 || pn == 4 || (pn >= 6 && pn <= 9) || pn >= 12) {
            const bool norm = pn == 0 || (pn >= 6 && pn <= 9);
            const int hl = wc >> 1, i0 = 32 * (wc & 1) + 8 * fq;
            f32x4 g1a = {1.f, 1.f, 1.f, 1.f}, g1b = g1a, g2a = g1a, g2b = g1a;
            if (norm) { const float* gn = (pn == 0 ? akn : aqn) + i0; g1a = *(const f32x4*)gn; g1b = *(const f32x4*)(gn + 4); g2a = *(const f32x4*)(gn + 64); g2b = *(const f32x4*)(gn + 68); }
            float* ssp = pn == 0 ? ssk + ((size_t)u.pm * BM * 2 + hl) * 2 + (wc & 1) : ssq + ((size_t)u.pm * BM * 8 + (pn - 6) * 2 + hl) * 2 + (wc & 1);
            const int sstr = pn == 0 ? 4 : 16;
#pragma unroll
            for (int ai = 0; ai < 2; ++ai)
#pragma unroll
                for (int m = 0; m < 4; ++m) { const int rl = rl0 + ai * HALF + m * 16;
                    f32x4 x1a = acc[ai][0][m][0], x1b = acc[ai][0][m][1], x2a = acc[ai][1][m][0], x2b = acc[ai][1][m][1];
                    if (norm) { const f32x4 q = x1a * x1a + x1b * x1b + x2a * x2a + x2b * x2b; float ss = (q[0] + q[1]) + (q[2] + q[3]);
                        ss += __shfl_xor(ss, 16); ss += __shfl_xor(ss, 32);
                        if (fq == 0) ssp[(size_t)rl * sstr] = ss;
                        x1a *= g1a; x1b *= g1b; x2a *= g2a; x2b *= g2b; }
                    f32x4 o1a = x1a, o1b = x1b, o2a = x2a, o2b = x2b;
                    if (lat) { const float* cp = cosh + (size_t)(posbase + rl) * 64 + i0; const float* sp = sinh + (size_t)(posbase + rl) * 64 + i0;
                        const f32x4 c0 = *(const f32x4*)cp, c1 = *(const f32x4*)(cp + 4), s0 = *(const f32x4*)sp, s1 = *(const f32x4*)(sp + 4);
                        o1a = x1a * c0 - x2a * s0; o1b = x1b * c1 - x2b * s1; o2a = x2a * c0 + x1a * s0; o2b = x2b * c1 + x1b * s1; }
                    bf16_t* dst = P + ((size_t)u.pm * BM + rl) * cf::NC + pn * BM + hl * 128 + i0;
                    *(u32x4*)dst = pack8(o1a, o1b); *(u32x4*)(dst + 64) = pack8(o2a, o2b);
                    asm volatile("" ::: "memory"); }
        } else {
            const int col0 = pn * BM + wc * 32 + 8 * fq;
            const bool ssq_on = pn == 2 || pn == 10 || pn == 11;
            float* ssp = pn == 2 ? sskv + (size_t)u.pm * BM * 4 + wc : sscq + (size_t)u.pm * BM * 8 + (pn - 10) * 4 + wc;
            const int sstr = pn == 2 ? 4 : 8;
#pragma unroll
            for (int ai = 0; ai < 2; ++ai)
#pragma unroll
                for (int m = 0; m < 4; ++m) { const int rl = rl0 + ai * HALF + m * 16; bf16_t* rowp = P + ((size_t)u.pm * BM + rl) * cf::NC + col0;
#pragma unroll
                    for (int bj = 0; bj < 2; ++bj) *(u32x4*)(rowp + bj * HALF) = pack8(acc[ai][bj][m][0], acc[ai][bj][m][1]);
                    if (ssq_on) { const f32x4 q = acc[ai][0][m][0] * acc[ai][0][m][0] + acc[ai][0][m][1] * acc[ai][0][m][1] + acc[ai][1][m][0] * acc[ai][1][m][0] + acc[ai][1][m][1] * acc[ai][1][m][1];
                        float ss = (q[0] + q[1]) + (q[2] + q[3]); ss += __shfl_xor(ss, 16); ss += __shfl_xor(ss, 32);
                        if (fq == 0) ssp[(size_t)rl * sstr] = ss; } }
        }
    }
};
struct EpiKvUp {
    bf16_t* KB; bf16_t* VB; const float* sskv;
    __device__ __forceinline__ void operator()(EPI_ARGS) const {
        EPI_LANE
        const int row0 = u.pm * BM + wr * 64 + fr, d0 = wc * 32 + 8 * fq;
        const bool isk = u.pn < 4;
        bf16_t* base = isk ? KB + (2 * u.pn) * 192 + d0 : VB + (u.pn - 4) * 256 + d0;
        const int ldr = isk ? 1536 : 1024, bjs = isk ? 192 : 128;
#pragma unroll
        for (int ai = 0; ai < 2; ++ai)
#pragma unroll
            for (int m = 0; m < 4; ++m) { const size_t row = (size_t)(row0 + ai * HALF + m * 16); bf16_t* rowp = base + row * ldr;
                const f32x4 pp = *(const f32x4*)(sskv + row * 4); const float r = rsqrtf(((pp[0] + pp[1]) + (pp[2] + pp[3])) * (1.f / 256.f) + 1e-6f);
#pragma unroll
                for (int bj = 0; bj < 2; ++bj) *(u32x4*)(rowp + bj * bjs) = pack8(acc[ai][bj][m][0] * r, acc[ai][bj][m][1] * r); }
    }
};
struct EpiQUp {
    bf16_t* QB; const float* cosr; const float* sinr; const float* sscq;
    __device__ __forceinline__ void operator()(EPI_ARGS) const {
        EPI_LANE
        const int row0 = u.pm * BM + wr * 64 + fr;
        if (u.pn < 4) {
            const int d0 = wc * 32 + 8 * fq;
#pragma unroll
            for (int ai = 0; ai < 2; ++ai)
#pragma unroll
                for (int m = 0; m < 4; ++m) { const size_t row = (size_t)(row0 + ai * HALF + m * 16);
                    const f32x4 pa = *(const f32x4*)(sscq + row * 8), pb = *(const f32x4*)(sscq + row * 8 + 4);
                    const float r = rsqrtf((((pa[0] + pa[1]) + (pa[2] + pa[3])) + ((pb[0] + pb[1]) + (pb[2] + pb[3]))) * (1.f / 512.f) + 1e-6f);
#pragma unroll
                    for (int bj = 0; bj < 2; ++bj) *(u32x4*)(QB + row * 1536 + (2 * u.pn + bj) * 192 + d0) = pack8(acc[ai][bj][m][0] * r, acc[ai][bj][m][1] * r); }
        } else {
            const int head = 4 * (u.pn - 4) + wc, i0 = 8 * fq;
            const bool lat = (u.pm % 17) != 0; const int posbase = (u.pm % 17) * 256 - 256;
#pragma unroll
            for (int ai = 0; ai < 2; ++ai)
#pragma unroll
                for (int m = 0; m < 4; ++m) { const int rl = wr * 64 + fr + ai * HALF + m * 16; const size_t row = (size_t)u.pm * BM + rl;
                    const f32x4 pa = *(const f32x4*)(sscq + row * 8), pb = *(const f32x4*)(sscq + row * 8 + 4);
                    const float r = rsqrtf((((pa[0] + pa[1]) + (pa[2] + pa[3])) + ((pb[0] + pb[1]) + (pb[2] + pb[3]))) * (1.f / 512.f) + 1e-6f);
                    f32x4 c0 = {1.f, 1.f, 1.f, 1.f}, c1 = c0, s0 = {0.f, 0.f, 0.f, 0.f}, s1 = s0;
                    if (lat) { const float* cp = cosr + (size_t)(posbase + rl) * 32 + i0; const float* sp = sinr + (size_t)(posbase + rl) * 32 + i0;
                        c0 = *(const f32x4*)cp; c1 = *(const f32x4*)(cp + 4); s0 = *(const f32x4*)sp; s1 = *(const f32x4*)(sp + 4); }
                    const f32x4 x1a = acc[ai][0][m][0] * r, x1b = acc[ai][0][m][1] * r, x2a = acc[ai][1][m][0] * r, x2b = acc[ai][1][m][1] * r;
                    const f32x4 o1a = x1a * c0 - x2a * s0, o1b = x1b * c1 - x2b * s1, o2a = x2a * c0 + x1a * s0, o2b = x2b * c1 + x1b * s1;
                    bf16_t* dst = QB + row * 1536 + head * 192 + 128 + i0;
                    *(u32x4*)dst = pack8(o1a, o1b); *(u32x4*)(dst + 32) = pack8(o2a, o2b); asm volatile("" ::: "memory"); }
        }
    }
};
struct EpiMerge {
    bf16_t* ACC; const bf16_t* gate0; int ldg;
    __device__ __forceinline__ void operator()(EPI_ARGS) const {
        EPI_LANE
        const int row0 = u.pm * BM + wr * 64 + fr, col0 = u.pn * BM + wc * 32 + 8 * fq;
        const bf16_t* gate = gate0 + u.sub * 2048; const bool first = u.sub == 0;
#pragma unroll
        for (int ai = 0; ai < 2; ++ai)
#pragma unroll
            for (int m = 0; m < 4; ++m) { const size_t row = (size_t)(row0 + ai * HALF + m * 16);
#pragma unroll
                for (int bj = 0; bj < 2; ++bj) { const int col = col0 + bj * HALF;
                    const u32x4 gw = *(const u32x4*)(gate + row * ldg + col);
                    u32x4 pw = {0u, 0u, 0u, 0u}; if (!first) pw = *(const u32x4*)(ACC + row * 2048 + col);
                    const f32x4 a0 = acc[ai][bj][m][0], a1 = acc[ai][bj][m][1];
                    f32x4 r0, r1;
                    r0[0] = bflo(pw.x) + bflo(gw.x) * a0[0]; r0[1] = bfhi(pw.x) + bfhi(gw.x) * a0[1];
                    r0[2] = bflo(pw.y) + bflo(gw.y) * a0[2]; r0[3] = bfhi(pw.y) + bfhi(gw.y) * a0[3];
                    r1[0] = bflo(pw.z) + bflo(gw.z) * a1[0]; r1[1] = bfhi(pw.z) + bfhi(gw.z) * a1[1];
                    r1[2] = bflo(pw.w) + bflo(gw.w) * a1[2]; r1[3] = bfhi(pw.w) + bfhi(gw.w) * a1[3];
                    *(u32x4*)(ACC + row * 2048 + col) = pack8(r0, r1); } asm volatile("" ::: "memory"); }
    }
};
struct EpiWo {
    float* X1; const float* mod  ; const float* xlat  ; const float* xctx  ;
    __device__ __forceinline__ void operator()(EPI_ARGS) const {
        EPI_LANE
        const int b = u.pm / 17, tb = u.pm % 17; const bool isctx = tb == 0;
        const float* g1 = mod + (size_t)(isctx ? 4 : b) * 12288 + 2 * 2048;
        const float* xbase = isctx ? xctx + (size_t)b * cf::CTX * 2048 : xlat + ((size_t)b * cf::S + (size_t)(tb - 1) * 256) * 2048;
        const int rl0 = wr * 64 + fr, col0 = u.pn * BM + wc * 32 + 8 * fq;
#pragma unroll
        for (int ai = 0; ai < 2; ++ai)
#pragma unroll
            for (int m = 0; m < 4; ++m) { const int rl = rl0 + ai * HALF + m * 16; const size_t row = (size_t)u.pm * BM + rl;
#pragma unroll
                for (int bj = 0; bj < 2; ++bj) { const int col = col0 + bj * HALF;
                    const f32x4 x0 = *(const f32x4*)(xbase + (size_t)rl * 2048 + col), x1 = *(const f32x4*)(xbase + (size_t)rl * 2048 + col + 4);
                    const f32x4 ga = *(const f32x4*)(g1 + col), gb = *(const f32x4*)(g1 + col + 4);
                    *(f32x4*)(X1 + row * 2048 + col) = x0 * cf::ALPHA + ga * acc[ai][bj][m][0];
                    *(f32x4*)(X1 + row * 2048 + col + 4) = x1 * cf::ALPHA + gb * acc[ai][bj][m][1]; } asm volatile("" ::: "memory"); }
    }
};
}

struct Ctx {
    const float* const* in; float* out; unsigned char* ws;
    ldsp_t lds; int tid, lane, wave, G, bid;
};
#define WSP(T, off) ((T*)(F.ws + (off)))
__device__ __forceinline__ Ctx phase_ctx(const Ctx& F0) {
    Ctx C = F0;
    asm volatile("" : "+v"(C.tid));
    asm volatile("" : "+s"(C.ws));
    C.lane = C.tid & 63; C.wave = __builtin_amdgcn_readfirstlane(C.tid >> 6);
    return C;
}

__device__ __forceinline__ int srcmap(int mode, int n) {
    if (mode == 0) {
        const int pn = n >> 8, q = n & 255, bj = q >> 7, r = q & 127, rope = (r >> 6) * 128 + bj * 64 + (r & 63);
        if (pn == 0) return rope;
        if (pn == 1) return 256 + q;
        if (pn == 2) return 512 + q;
        if (pn == 3) return r < 32 ? 768 + bj * 32 + r : -1;
        if (pn == 4) return 832 + rope;
        if (pn == 5) return 1088 + q;
        if (pn < 10) return 1344 + (pn - 6) * 256 + rope;
        if (pn < 12) return 2368 + (pn - 10) * 256 + q;
        if (pn < 16) return 2880 + (pn - 12) * 256 + rope;
        if (pn < 24) return 3904 + bj * 1024 + 128 * (pn - 16) + r;
        return 5952 + (n - 6144);
    }
    if (mode == 1) { if (n < 1024) return (n >> 7) * 192 + (n & 127);
        const int m = n - 1024, t = m >> 8, bj = (m >> 7) & 1, q = m & 127; return (4 * t + (q >> 5)) * 192 + 128 + bj * 32 + (q & 31); }
    if (mode == 2) { if (n < 1024) return (n >> 7) * 256 + (n & 127); const int m = n - 1024; return (m >> 7) * 256 + 128 + (m & 127); }
    return n;
}
__device__ __forceinline__ void tr_tile(const Ctx& F, const float* src, int ld_src, int mode, int k0, bf16_t* dst, int ldd, int n0, const float* kscale = nullptr) {
    LAS float* T = (LAS float*)F.lds;
    const int kr = F.tid >> 4, nc = (F.tid & 15) * 4, sc = srcmap(mode, n0 + nc);
#pragma unroll
    for (int h = 0; h < 2; ++h) { const int k = kr + 32 * h; f32x4 v = {0.f, 0.f, 0.f, 0.f};
        if (sc >= 0) v = *(const f32x4*)(src + (size_t)(k0 + k) * ld_src + sc);
        if (kscale) v = v * kscale[k0 + k];
        T[k * 65 + nc + 0] = v[0]; T[k * 65 + nc + 1] = v[1]; T[k * 65 + nc + 2] = v[2]; T[k * 65 + nc + 3] = v[3]; }
    __syncthreads();
    const int n = F.tid >> 3, kc = (F.tid & 7) * 8;
    u32x4 w;
    w.x = cvt_pk_bf16(T[(kc + 0) * 65 + n], T[(kc + 1) * 65 + n]); w.y = cvt_pk_bf16(T[(kc + 2) * 65 + n], T[(kc + 3) * 65 + n]);
    w.z = cvt_pk_bf16(T[(kc + 4) * 65 + n], T[(kc + 5) * 65 + n]); w.w = cvt_pk_bf16(T[(kc + 6) * 65 + n], T[(kc + 7) * 65 + n]);
    *(u32x4*)(dst + (size_t)(n0 + n) * ldd + k0 + kc) = w;
    __syncthreads();
}
__device__ __forceinline__ void cvt_rows(const Ctx& F, const float* src, bf16_t* dst, size_t n8) {
    for (size_t i = (size_t)F.bid * 512 + F.tid; i < n8; i += (size_t)F.G * 512) {
        const f32x4 a = *(const f32x4*)(src + i * 8), b = *(const f32x4*)(src + i * 8 + 4);
        *(u32x4*)(dst + i * 8) = pg8::pack8(a, b); }
}

__device__ __forceinline__ void cvt_rows_fp8(const Ctx& F, const float* src, unsigned char* dst, size_t n16, float scale) {
    for (size_t i = (size_t)F.bid * 512 + F.tid; i < n16; i += (size_t)F.G * 512) {
        u32x4 w;
#pragma unroll
        for (int j = 0; j < 4; ++j) { const f32x4 a = *(const f32x4*)(src + i * 16 + 4 * j) * scale;
            int p = 0; p = __builtin_amdgcn_cvt_pk_fp8_f32(a[0], a[1], p, false); p = __builtin_amdgcn_cvt_pk_fp8_f32(a[2], a[3], p, true); w[j] = (unsigned)p; }
        *(u32x4*)(dst + i * 16) = w; }
}

__device__ __forceinline__ void ph_prologue(const Ctx& F0) {
    const Ctx F = phase_ctx(F0);
    using namespace cf;
    constexpr int T_WIN = 2 * 32 * 224, T_QUP = 2 * 8 * 24, T_KVUP = 2 * 4 * 32, T_BR = 2 * 4 * 16 * 32, T_WO = 2 * 32 * 32;
    constexpr int T_ALL = T_WIN + T_QUP + T_KVUP + T_BR + T_WO;
    for (int u = F.bid; u < T_ALL; u += F.G) {
        int t = u;
        if (t < T_WIN) { const int l = t / (32 * 224), r = t % (32 * 224), kt = r / 224, nt = r % 224;
            tr_tile(F, F.in[I_WIN] + (size_t)l * 2048 * IN_COLS, IN_COLS, 0, kt * 64, WSP(bf16_t, WS_WIN) + (size_t)l * NC * 2048, 2048, nt * 64); continue; }
        t -= T_WIN;
        if (t < T_QUP) { const int l = t / (8 * 24), r = t % (8 * 24), kt = r / 24, nt = r % 24;
            tr_tile(F, F.in[I_WQUP] + (size_t)l * 512 * 1536, 1536, 1, kt * 64, WSP(bf16_t, WS_WQUP) + (size_t)l * 1536 * 512, 512, nt * 64, F.in[I_BQN] + l * 512); continue; }
        t -= T_QUP;
        if (t < T_KVUP) { const int l = t / (4 * 32), r = t % (4 * 32), kt = r / 32, nt = r % 32;
            tr_tile(F, F.in[I_WKVUP] + (size_t)l * 256 * 2048, 2048, 2, kt * 64, WSP(bf16_t, WS_WKVUP) + (size_t)l * 2048 * 256, 256, nt * 64, F.in[I_BKVN] + l * 256); continue; }
        t -= T_KVUP;
        if (t < T_BR) { const int l = t / (4 * 512), r = t % (4 * 512), br = r / 512, r2 = r % 512, kt = r2 / 32, nt = r2 % 32;
            const float* src = (br == 0 ? F.in[I_WBRA] : br == 1 ? F.in[I_WBRB] : br == 2 ? F.in[I_WBRC] : F.in[I_WBRD]) + (size_t)l * 1024 * 2048;
            tr_tile(F, src, 2048, 3, kt * 64, WSP(bf16_t, WS_WBR) + ((size_t)l * 4 + br) * 2048 * 1024, 1024, nt * 64); continue; }
        t -= T_BR;
        { const int l = t / 1024, r = t % 1024, kt = r / 32, nt = r % 32;
            tr_tile(F, F.in[I_WO] + (size_t)l * 2048 * 2048, 2048, 3, kt * 64, WSP(bf16_t, WS_WO) + (size_t)l * 2048 * 2048, 2048, nt * 64); }
    }
    for (int u = F.bid; u < 2 * 16 * 32; u += F.G) {
        const int l = u / 512, g = (u % 512) / 32, d0 = (u % 32) * 64;
        LAS float* sk = (LAS float*)F.lds; LAS float* wt = (LAS float*)(F.lds + 128 * 129 * 4);
        const float* skg = F.in[I_PSK] + ((size_t)l * 16 + g) * 128 * 128;
        const float* wqg = F.in[I_PWQ] + (size_t)l * 2048 * 2048 + (size_t)d0 * 2048 + g * 128;
        for (int i = F.tid; i < 128 * 128; i += 512) sk[(i >> 7) * 129 + (i & 127)] = skg[i];
        for (int i = F.tid; i < 64 * 128; i += 512) wt[(i >> 7) * 129 + (i & 127)] = wqg[(size_t)(i >> 7) * 2048 + (i & 127)];
        __syncthreads();
        const int n = F.tid & 127, dg = F.tid >> 7;
        float a[16];
#pragma unroll
        for (int e = 0; e < 16; ++e) a[e] = 0.f;
        for (int k = 0; k < 128; ++k) { const float s = sk[n * 129 + k];
#pragma unroll
            for (int e = 0; e < 16; ++e) a[e] += wt[(dg * 16 + e) * 129 + k] * s; }
        bf16_t* dst = WSP(bf16_t, WS_WFOLD) + (size_t)l * 2048 * 2048 + (size_t)(g * 128 + n) * 2048 + d0 + dg * 16;
        u32x4 w0, w1;
        w0.x = cvt_pk_bf16(a[0], a[1]); w0.y = cvt_pk_bf16(a[2], a[3]); w0.z = cvt_pk_bf16(a[4], a[5]); w0.w = cvt_pk_bf16(a[6], a[7]);
        w1.x = cvt_pk_bf16(a[8], a[9]); w1.y = cvt_pk_bf16(a[10], a[11]); w1.z = cvt_pk_bf16(a[12], a[13]); w1.w = cvt_pk_bf16(a[14], a[15]);
        *(u32x4*)dst = w0; *(u32x4*)(dst + 8) = w1;
        __syncthreads();
    }
    for (int u = F.bid; u < 2 * 192; u += F.G) {
        const int l = u / 192, n0 = (u % 192) * 64;
        LAS float* sl = (LAS float*)F.lds; LAS float* red = (LAS float*)(F.lds + 5 * 2048 * 4);
        for (int i = F.tid; i < 5 * 2048; i += 512) { const int r = i >> 11, k = i & 2047; const float v = r < 4 ? F.in[I_C][r * 2048 + k] : F.in[I_CCTX][k]; sl[i] = v * sigmoidf_(v); }
        __syncthreads();
        const int col = F.tid & 63, ks = F.tid >> 6;
        float a[5] = {0.f, 0.f, 0.f, 0.f, 0.f};
        const float* wp = F.in[I_WADA] + (size_t)l * 2048 * 12288 + n0 + col;
        for (int k = ks * 256; k < ks * 256 + 256; ++k) { const float w = wp[(size_t)k * 12288];
#pragma unroll
            for (int r = 0; r < 5; ++r) a[r] += sl[r * 2048 + k] * w; }
#pragma unroll
        for (int r = 0; r < 5; ++r) red[(ks * 5 + r) * 64 + col] = a[r];
        __syncthreads();
        if (F.tid < 320) { const int r = F.tid >> 6; float s = 0.f;
#pragma unroll
            for (int k2 = 0; k2 < 8; ++k2) s += red[(k2 * 5 + r) * 64 + col];
            WSP(float, WS_MOD)[((size_t)l * 5 + r) * 12288 + n0 + col] = s + F.in[I_BADA][(size_t)l * 12288 + n0 + col]; }
        __syncthreads();
    }
    for (int i = F.bid * 512 + F.tid; i < 4096 * 64; i += F.G * 512) {
        const int pos = i >> 6, j = i & 63, fi = j & 31; const float fr = powf(10000.0f, -(float)(2 * fi) / 64.0f);
        const float ang = (float)(j < 32 ? (pos >> 6) : (pos & 63)) * fr;
        WSP(float, WS_COSH)[i] = cosf(ang); WSP(float, WS_SINH)[i] = sinf(ang);
    }
    for (int i = F.bid * 512 + F.tid; i < 4096 * 32; i += F.G * 512) {
        const int pos = i >> 5, j = i & 31, fi = j & 15; const float fr = powf(10000.0f, -(float)(2 * fi) / 32.0f);
        const float ang = (float)(j < 16 ? (pos >> 6) : (pos & 63)) * fr;
        WSP(float, WS_COSR)[i] = cosf(ang); WSP(float, WS_SINR)[i] = sinf(ang);
    }
    cvt_rows_fp8(F, F.in[I_PU], WSP(unsigned char, WS_UB), (size_t)2 * NEXP * 2048 / 16, 1024.f);
    cvt_rows_fp8(F, F.in[I_PV], WSP(unsigned char, WS_VB2), (size_t)2 * NEXP * 2048 / 16, 16.f);
}

__device__ __forceinline__ void ph_modulate0(const Ctx& F0) {
    const Ctx F = phase_ctx(F0);
    using namespace cf;
    const float* mod = WSP(float, WS_MOD);
    for (size_t i = (size_t)F.bid * 512 + F.tid; i < (size_t)MR * 256; i += (size_t)F.G * 512) {
        const int R = (int)(i >> 8), d = (int)(i & 255) * 8, b = R / RB, j = R % RB;
        const float* src = j < CTX ? F.in[I_CTX] + ((size_t)b * CTX + j) * 2048 : F.in[I_X] + ((size_t)b * S + (j - CTX)) * 2048;
        const float* m = mod + (size_t)(j < CTX ? 4 : b) * 12288;
        const f32x4 x0 = *(const f32x4*)(src + d), x1 = *(const f32x4*)(src + d + 4);
        const f32x4 sh0 = *(const f32x4*)(m + d), sh1 = *(const f32x4*)(m + d + 4), s0 = *(const f32x4*)(m + 2048 + d), s1 = *(const f32x4*)(m + 2048 + d + 4);
        *(u32x4*)(WSP(bf16_t, WS_HB) + (size_t)R * 2048 + d) = pg8::pack8(x0 * (s0 + 1.0f) + sh0, x1 * (s1 + 1.0f) + sh1);
    }
}

__device__ __forceinline__ void knorm_pass(const Ctx& F) {
    using namespace cf;
    bf16_t* P = WSP(bf16_t, WS_P); const float* ssk = WSP(const float, WS_SSK);
    for (int it = F.bid * 8 + F.wave; it < MR * 2; it += F.G * 8) {
        const int R = it >> 1, h = it & 1;
        const f32x2 pp = *(const f32x2*)(ssk + (size_t)it * 2); const float r = rsqrtf((pp.x + pp.y) * (1.f / 128.f) + 1e-6f);
        unsigned* q = (unsigned*)(P + (size_t)R * NC + PC_AK + h * 128) + F.lane;
        const unsigned w = *q; *q = cvt_pk_bf16(bflo(w) * r, bfhi(w) * r);
    }
}

struct AttnArgs {
    const bf16_t* Q; const bf16_t* K; const bf16_t* V; bf16_t* O; int ldq, ldk, ldv, ldo;
    int seg0_row, seg0_tiles, seg1_row, seg1_tiles;
    int mask_on, qpos0, kpos1;
    float sc_log2; int has_sink; float sink_l2;
    const float* qss;
};
typedef float f32x16 __attribute__((ext_vector_type(16)));
template <int DK>
__device__ __forceinline__ void attn_unit(ldsp_t lds, const AttnArgs a) {
    constexpr int ND = DK / 16, KST = DK + 8, KCH = DK / 8, KPT = (64 * KCH) / 512, VST = 72;
    constexpr int KBUF = 64 * KST * 2, VBUF = 128 * VST * 2, VOFF = 2 * KBUF, ALOFF = VOFF + 2 * VBUF;
    int tid = threadIdx.x; asm volatile("" : "+v"(tid));
    const int wid = __builtin_amdgcn_readfirstlane(tid >> 6), lane = tid & 63, q32 = lane & 31, hi = lane >> 5;
    LAS float* al = (LAS float*)(lds + ALOFF + wid * 128);
    bf16x8 qf[ND];
    { const bf16_t* qrow = a.Q + (size_t)(wid * 32 + q32) * a.ldq + 8 * hi;
#pragma unroll
      for (int s = 0; s < ND; ++s) qf[s] = *(const bf16x8*)(qrow + 16 * s); }
    f32x16 o[4];
#pragma unroll
    for (int db = 0; db < 4; ++db)
#pragma unroll
        for (int r = 0; r < 16; ++r) o[db][r] = 0.f;
    float m_run = -1e30f, l_run = 0.f;
    float scq = a.sc_log2;
    if (a.qss) { const f32x2 pp = *(const f32x2*)(a.qss + (size_t)(wid * 32 + q32) * 16); scq *= rsqrtf((pp.x + pp.y) * (1.f / 128.f) + 1e-6f); }
    const int ntiles = a.seg0_tiles + a.seg1_tiles;
    u32x4 kreg[KPT], vreg[2];
    const int vkp = tid & 31, vdc = tid >> 5;
    const int vkey = 2 * vkp, vpos = (vkey & 48) | ((vkey & 4) << 1) | ((vkey & 8) >> 1) | (vkey & 3);
#define ATT_LOAD(tt) do { const int _r0 = (tt) < a.seg0_tiles ? a.seg0_row + 64 * (tt) : a.seg1_row + 64 * ((tt) - a.seg0_tiles); \
        _Pragma("unroll") for (int _i = 0; _i < KPT; ++_i) { const int _c = tid + 512 * _i; kreg[_i] = *(const u32x4*)(a.K + (size_t)(_r0 + _c / KCH) * a.ldk + 8 * (_c % KCH)); } \
        vreg[0] = *(const u32x4*)(a.V + (size_t)(_r0 + 2 * vkp) * a.ldv + 8 * vdc); vreg[1] = *(const u32x4*)(a.V + (size_t)(_r0 + 2 * vkp + 1) * a.ldv + 8 * vdc); } while (0)
#define ATT_WRITE(buf) do { const ldsp_t _kb = lds + (buf) * KBUF; const ldsp_t _vb = lds + VOFF + (buf) * VBUF; \
        _Pragma("unroll") for (int _i = 0; _i < KPT; ++_i) { const int _c = tid + 512 * _i; *(LAS u32x4*)(_kb + ((_c / KCH) * KST + 8 * (_c % KCH)) * 2) = kreg[_i]; } \
        const unsigned _a0[4] = {vreg[0].x, vreg[0].y, vreg[0].z, vreg[0].w}, _a1[4] = {vreg[1].x, vreg[1].y, vreg[1].z, vreg[1].w}; \
        _Pragma("unroll") for (int _e = 0; _e < 4; ++_e) { \
            *(LAS unsigned*)(_vb + ((8 * vdc + 2 * _e) * VST + vpos) * 2) = (_a0[_e] & 0xffffu) | (_a1[_e] << 16); \
            *(LAS unsigned*)(_vb + ((8 * vdc + 2 * _e + 1) * VST + vpos) * 2) = (_a0[_e] >> 16) | (_a1[_e] & 0xffff0000u); } } while (0)
    ATT_LOAD(0);
    ATT_WRITE(0);
    __syncthreads();
    for (int tt = 0; tt < ntiles; ++tt) {
        const int cur = tt & 1;
        if (tt + 1 < ntiles) ATT_LOAD(tt + 1);
        const ldsp_t Ks = lds + cur * KBUF, Vt = lds + VOFF + cur * VBUF;
        f32x16 s0, s1;
#pragma unroll
        for (int r = 0; r < 16; ++r) { s0[r] = 0.f; s1[r] = 0.f; }
#pragma unroll
        for (int s = 0; s < ND; ++s) {
            const bf16x8 k0 = *(const LAS bf16x8*)(Ks + (q32 * KST + 16 * s + 8 * hi) * 2), k1 = *(const LAS bf16x8*)(Ks + ((32 + q32) * KST + 16 * s + 8 * hi) * 2);
            s0 = __builtin_amdgcn_mfma_f32_32x32x16_bf16(k0, qf[s], s0, 0, 0, 0);
            s1 = __builtin_amdgcn_mfma_f32_32x32x16_bf16(k1, qf[s], s1, 0, 0, 0); }
        const bool msk = a.mask_on && tt >= a.seg0_tiles;
        const int kp0 = a.kpos1 + 64 * (tt - a.seg0_tiles) + 4 * hi, qp = a.qpos0 + wid * 32 + q32;
        float mx = -1e30f;
#pragma unroll
        for (int r = 0; r < 16; ++r) { float t0 = s0[r] * scq, t1 = s1[r] * scq;
            if (msk) { const int d0 = qp - (kp0 + (r & 3) + 8 * (r >> 2)), d1 = d0 - 32; if (d0 > 128 || d0 < -128) t0 = -1e30f; if (d1 > 128 || d1 < -128) t1 = -1e30f; }
            s0[r] = t0; s1[r] = t1; mx = fmaxf(mx, fmaxf(t0, t1)); }
        mx = fmaxf(mx, __shfl_xor(mx, 32));
        const float m_new = fmaxf(m_run, mx), alpha = __builtin_amdgcn_exp2f(m_run - m_new); m_run = m_new;
        float ps = 0.f;
#pragma unroll
        for (int r = 0; r < 16; ++r) { s0[r] = __builtin_amdgcn_exp2f(s0[r] - m_new); s1[r] = __builtin_amdgcn_exp2f(s1[r] - m_new); ps += s0[r] + s1[r]; }
        l_run = l_run * alpha + ps;
        if (__any(alpha < 1.0f)) {
            if (hi == 0) al[q32] = alpha;
            asm volatile("s_waitcnt lgkmcnt(0)" ::: "memory");
#pragma unroll
            for (int g4 = 0; g4 < 4; ++g4) { const f32x4 av = *(const LAS f32x4*)(al + 8 * g4 + 4 * hi);
#pragma unroll
                for (int db = 0; db < 4; ++db)
#pragma unroll
                    for (int j = 0; j < 4; ++j) o[db][4 * g4 + j] *= av[j]; }
        }
        bf16x8 pa[4];
#pragma unroll
        for (int g2 = 0; g2 < 2; ++g2) {
            u32x4 w; w.x = cvt_pk_bf16(s0[8 * g2 + 0], s0[8 * g2 + 1]); w.y = cvt_pk_bf16(s0[8 * g2 + 2], s0[8 * g2 + 3]); w.z = cvt_pk_bf16(s0[8 * g2 + 4], s0[8 * g2 + 5]); w.w = cvt_pk_bf16(s0[8 * g2 + 6], s0[8 * g2 + 7]); pa[g2] = *(bf16x8*)&w;
            u32x4 v; v.x = cvt_pk_bf16(s1[8 * g2 + 0], s1[8 * g2 + 1]); v.y = cvt_pk_bf16(s1[8 * g2 + 2], s1[8 * g2 + 3]); v.z = cvt_pk_bf16(s1[8 * g2 + 4], s1[8 * g2 + 5]); v.w = cvt_pk_bf16(s1[8 * g2 + 6], s1[8 * g2 + 7]); pa[2 + g2] = *(bf16x8*)&v; }
#pragma unroll
        for (int db = 0; db < 4; ++db)
#pragma unroll
            for (int ks = 0; ks < 4; ++ks) { const bf16x8 vf = *(const LAS bf16x8*)(Vt + ((32 * db + q32) * VST + 16 * ks + 8 * hi) * 2);
                o[db] = __builtin_amdgcn_mfma_f32_32x32x16_bf16(pa[ks], vf, o[db], 0, 0, 0); }
        if (tt + 1 < ntiles) ATT_WRITE(cur ^ 1);
        __syncthreads();
    }
#undef ATT_LOAD
#undef ATT_WRITE
    float l_tot = l_run + __shfl_xor(l_run, 32);
    if (a.has_sink) l_tot += __builtin_amdgcn_exp2f(a.sink_l2 - m_run);
    if (hi == 0) al[q32] = 1.0f / l_tot;
    asm volatile("s_waitcnt lgkmcnt(0)" ::: "memory");
    const ldsp_t Ost = lds + wid * 8192;
#pragma unroll
    for (int g4 = 0; g4 < 4; ++g4) { const f32x4 iv = *(const LAS f32x4*)(al + 8 * g4 + 4 * hi);
#pragma unroll
        for (int db = 0; db < 4; ++db)
#pragma unroll
            for (int j = 0; j < 4; ++j) *(LAS bf16_t*)(Ost + ((8 * g4 + 4 * hi + j) * 128 + 32 * db + q32) * 2) = f2bf(o[db][4 * g4 + j] * iv[j]); }
    asm volatile("s_waitcnt lgkmcnt(0)" ::: "memory");
#pragma unroll
    for (int i = 0; i < 8; ++i) { const int c = lane + 64 * i, row = c >> 4, c8 = c & 15;
        *(u32x4*)(a.O + (size_t)(wid * 32 + row) * a.ldo + 8 * c8) = *(const LAS u32x4*)(Ost + (row * 128 + 8 * c8) * 2); }
}

__device__ __forceinline__ void conv_unit(const Ctx& F, int layer, int row0  , int seq_len, int t0) {
    using namespace cf;
    const bf16_t* P = WSP(const bf16_t, WS_P); bf16_t* BR = WSP(bf16_t, WS_BR);
    const float* cw = F.in[I_CW] + (size_t)layer * 31 * 1024; const float* cb = F.in[I_CB] + layer * 1024;
    const float* lg = F.in[I_CLG] + layer * 1024; const float* lb = F.in[I_CLB] + layer * 1024;
    int tid = F.tid; asm volatile("" : "+v"(tid));
    const int lane = tid & 63;
    LAS float* red = (LAS float*)(F.lds + 126976); LAS float* tot = red + 8 * 32;
    __syncthreads();
    for (int c = tid; c < 62 * 128; c += 512) { const int rr = c >> 7, ch = c & 127, t = t0 - 15 + rr;
        u32x4 v = {0u, 0u, 0u, 0u};
        if (t >= 0 && t < seq_len) v = *(const u32x4*)(P + (size_t)(row0 + t) * NC + PC_GLU + ch * 8);
        *(LAS u32x4*)(F.lds + rr * 2048 + ch * 16) = v; }
    float w0[31], w1[31];
#pragma unroll
    for (int k = 0; k < 31; ++k) { const f32x2 w = *(const f32x2*)(cw + k * 1024 + 2 * tid); w0[k] = w.x; w1[k] = w.y; }
    const f32x2 bv = *(const f32x2*)(cb + 2 * tid), gg = *(const f32x2*)(lg + 2 * tid), bb = *(const f32x2*)(lb + 2 * tid);
    __syncthreads();
#pragma unroll 1
    for (int part = 0; part < 4; ++part) {
        float a0[8], a1[8];
#pragma unroll
        for (int t = 0; t < 8; ++t) { a0[t] = bv.x; a1[t] = bv.y; }
        const ldsp_t base = F.lds + part * 8 * 2048 + tid * 4;
#pragma unroll
        for (int rr = 0; rr < 38; ++rr) { const unsigned xw = *(const LAS unsigned*)(base + rr * 2048); const float x0 = bflo(xw), x1 = bfhi(xw);
#pragma unroll
            for (int t = 0; t < 8; ++t) { const int k = rr - t; if (k >= 0 && k <= 30) { a0[t] += x0 * w0[k]; a1[t] += x1 * w1[k]; } } }
        float v[16];
#pragma unroll
        for (int t = 0; t < 8; ++t) { v[t] = a0[t] + a1[t]; v[8 + t] = a0[t] * a0[t] + a1[t] * a1[t]; }
#pragma unroll
        for (int i = 0; i < 8; ++i) { const bool up = lane & 32; const float snd = up ? v[i] : v[i + 8], kp = up ? v[i + 8] : v[i]; v[i] = kp + __shfl_xor(snd, 32); }
#pragma unroll
        for (int i = 0; i < 4; ++i) { const bool up = lane & 16; const float snd = up ? v[i] : v[i + 4], kp = up ? v[i + 4] : v[i]; v[i] = kp + __shfl_xor(snd, 16); }
#pragma unroll
        for (int i = 0; i < 2; ++i) { const bool up = lane & 8; const float snd = up ? v[i] : v[i + 2], kp = up ? v[i + 2] : v[i]; v[i] = kp + __shfl_xor(snd, 8); }
        { const bool up = lane & 4; const float snd = up ? v[0] : v[1], kp = up ? v[1] : v[0]; v[0] = kp + __shfl_xor(snd, 4); }
        v[0] += __shfl_xor(v[0], 2); v[0] += __shfl_xor(v[0], 1);
        if ((lane & 3) == 0) red[F.wave * 16 + (lane >> 2)] = v[0];
        __syncthreads();
        if (tid < 16) { float s = 0.f;
#pragma unroll
            for (int w = 0; w < 8; ++w) s += red[w * 16 + tid];
            tot[tid] = s; }
        __syncthreads();
#pragma unroll
        for (int t = 0; t < 8; ++t) { const float mean = tot[t] * (1.f / 1024.f), var = fmaxf(tot[8 + t] * (1.f / 1024.f) - mean * mean, 0.f), rstd = rsqrtf(var + 1e-5f);
            const float y0 = (a0[t] - mean) * rstd * gg.x + bb.x, y1 = (a1[t] - mean) * rstd * gg.y + bb.y;
            *(unsigned*)(BR + (size_t)(row0 + t0 + part * 8 + t) * 4096 + 2048 + 2 * tid) = cvt_pk_bf16(y0 * sigmoidf_(y0), y1 * sigmoidf_(y1)); }
    }
}

__device__ __forceinline__ void attn_defaults(AttnArgs& a, int isctx) {
    a.seg0_row = 0; a.seg0_tiles = isctx ? 4 : 68; a.seg1_row = 0; a.seg1_tiles = 0; a.mask_on = 0; a.qpos0 = 0; a.kpos1 = 0; a.has_sink = 0; a.sink_l2 = 0.f; a.qss = nullptr; }
__device__ __forceinline__ void ph_attn(const Ctx& F0, int layer) {
    const Ctx F = phase_ctx(F0);
    using namespace cf;
    const bf16_t* P = WSP(const bf16_t, WS_P); bf16_t* BR = WSP(bf16_t, WS_BR);
    for (int dup = 0; dup < DUPN(2); ++dup)
    for (int u = F.bid; u < (layer == 0 ? 544 : 512); u += F.G) {
        int b, h, qb, isctx = 0;
        if (u < 512) { b = u >> 7; h = (u >> 4) & 7; qb = u & 15; } else { const int r = u - 512; b = r >> 3; h = r & 7; qb = 0; isctx = 1; }
        const size_t brow = (size_t)b * RB, qrow = brow + (isctx ? 0 : CTX) + (size_t)qb * 256;
        AttnArgs a; attn_defaults(a, isctx);
        a.Q = WSP(const bf16_t, WS_QB) + qrow * 1536 + h * 192; a.ldq = 1536;
        a.K = WSP(const bf16_t, WS_KB) + brow * 1536 + h * 192; a.ldk = 1536;
        a.V = WSP(const bf16_t, WS_VB) + brow * 1024 + h * 128; a.ldv = 1024;
        a.O = BR + qrow * 4096 + 1024 + h * 128; a.ldo = 4096; a.sc_log2 = SCALE_MLA * LOG2E;
        __syncthreads();
        attn_unit<192>(F.lds, a);
    }
    for (int dup = 0; dup < DUPN(3); ++dup)
    for (int u0 = F.bid; u0 < (layer == 0 ? 1088 : 1024); u0 += F.G) {
        int kind, b, h, qb, isctx = 0;
        if (u0 < 1024) { kind = 1 + (u0 >> 9); const int r = u0 & 511; b = r >> 7; h = (r >> 4) & 7; qb = r & 15; }
        else { const int r = u0 - 1024; kind = 1 + (r >> 5); const int r2 = r & 31; b = r2 >> 3; h = r2 & 7; qb = 0; isctx = 1; }
        const size_t brow = (size_t)b * RB, qrow = brow + (isctx ? 0 : CTX) + (size_t)qb * 256;
        AttnArgs a; attn_defaults(a, isctx);
        const int qc = kind == 1 ? PC_AQ : PC_DQ, kc = kind == 1 ? PC_AK : PC_DK, vc = kind == 1 ? PC_AV : PC_DV;
        a.Q = P + qrow * NC + qc + h * 128; a.ldq = NC;
        a.K = P + brow * NC + kc + (h >> 2) * 128; a.ldk = NC;
        a.V = P + brow * NC + vc + (h >> 2) * 128; a.ldv = NC;
        a.O = BR + qrow * 4096 + (kind == 1 ? 0 : 3072) + h * 128; a.ldo = 4096; a.sc_log2 = SCALE_HD * LOG2E;
        if (kind == 1) a.qss = WSP(const float, WS_SSQ) + qrow * 16 + h * 2;
        if (kind == 2) { a.has_sink = 1; a.sink_l2 = F.in[I_SINK][layer * 8 + h] * LOG2E; a.seg0_tiles = 4;
            if (!isctx) { const int start = qb * 256; const int lo = start - 128 < 0 ? 0 : start - 128, hi = start + 384 > S ? S : start + 384;
                a.seg1_row = CTX + lo; a.seg1_tiles = (hi - lo) / 64; a.mask_on = 1; a.qpos0 = start; a.kpos1 = lo; } }
        __syncthreads();
        attn_unit<128>(F.lds, a);
    }
    for (int dup = 0; dup < DUPN(4); ++dup)
    for (int u = F.bid; u < (layer == 0 ? 544 : 512); u += F.G) {
        int b, tb, isctx = 0;
        if (u < 512) { b = u >> 7; tb = u & 127; } else { const int r = u - 512; b = r >> 3; tb = r & 7; isctx = 1; }
        conv_unit(F, layer, b * RB + (isctx ? 0 : CTX), isctx ? CTX : S, tb * 32);
    }
}

__device__ __forceinline__ int tok_row(int layer, int tok) { return layer == 0 ? tok : (tok >> 12) * cf::RB + cf::CTX + (tok & 4095); }
__device__ __forceinline__ void ph_ln1(const Ctx& F0, int layer) {
    const Ctx F = phase_ctx(F0);
    using namespace cf;
    float* X1 = (float*)(F.ws + WS_P + X1_OFF); bf16_t* HB = WSP(bf16_t, WS_HB);
    const float* lg = F.in[I_LN1G] + layer * 2048; const float* lb = F.in[I_LN1B] + layer * 2048;
    const int ntok = layer == 0 ? MR : NB * S, lane = F.lane;
    for (int tok = F.bid * 8 + F.wave; tok < ntok; tok += F.G * 8) {
        const int R = tok_row(layer, tok), b = R / RB, j = R % RB;
        const float* mod = WSP(const float, WS_MOD) + ((size_t)layer * 5 + (j < CTX ? 4 : b)) * 12288;
        float* xp = X1 + (size_t)R * 2048;
        f32x4 v[8]; float s = 0.f;
#pragma unroll
        for (int i = 0; i < 8; ++i) { v[i] = *(const f32x4*)(xp + lane * 4 + 256 * i); s += (v[i][0] + v[i][1]) + (v[i][2] + v[i][3]); }
        const float mean = wave_sum(s) * (1.f / 2048.f); float q = 0.f;
#pragma unroll
        for (int i = 0; i < 8; ++i) { const f32x4 d = v[i] - mean; q += (d[0] * d[0] + d[1] * d[1]) + (d[2] * d[2] + d[3] * d[3]); }
        const float rstd = rsqrtf(wave_sum(q) * (1.f / 2048.f) + 1e-5f);
#pragma unroll
        for (int i = 0; i < 8; ++i) { const int c = lane * 4 + 256 * i;
            const f32x4 y = (v[i] - mean) * rstd * *(const f32x4*)(lg + c) + *(const f32x4*)(lb + c);
            *(f32x4*)(xp + c) = y;
            const f32x4 hp = y * (*(const f32x4*)(mod + 4 * 2048 + c) + 1.0f) + *(const f32x4*)(mod + 3 * 2048 + c);
            u32x2 w; w.x = cvt_pk_bf16(hp[0], hp[1]); w.y = cvt_pk_bf16(hp[2], hp[3]);
            *(u32x2*)(HB + (size_t)R * 2048 + c) = w; }
    }
}

typedef __bf16 bf16x2_t __attribute__((ext_vector_type(2)));
__device__ __forceinline__ unsigned ordkey(float v) { const unsigned u = __float_as_uint(v); return (u & 0x80000000u) ? ~u : (u | 0x80000000u); }
__device__ __forceinline__ int lane_rank(unsigned long long m) { return (int)__builtin_amdgcn_mbcnt_hi((unsigned)(m >> 32), __builtin_amdgcn_mbcnt_lo((unsigned)m, 0u)); }
template <int NV> __device__ __forceinline__ unsigned radix_thresh16(const unsigned (&k)[NV]) {
    unsigned T = 0u;
    for (int bit = 31; bit >= 0; --bit) { const unsigned cand = T | (1u << bit); int cnt = 0;
#pragma unroll
        for (int v = 0; v < NV; ++v) cnt += __popcll(__ballot(k[v] >= cand));
        if (cnt >= 16) T = cand; }
    return T;
}
__device__ __forceinline__ float dot2bf(unsigned a, unsigned b, float acc) { return __builtin_amdgcn_fdot2_f32_bf16(__builtin_bit_cast(bf16x2_t, a), __builtin_bit_cast(bf16x2_t, b), acc, false); }
__device__ __forceinline__ float dot8(const u32x4 a, const u32x4 b, float acc) {
    acc = dot2bf(a.x, b.x, acc); acc = dot2bf(a.y, b.y, acc); acc = dot2bf(a.z, b.z, acc); acc = dot2bf(a.w, b.w, acc);
    return acc;
}
__device__ __forceinline__ void ph_peer(const Ctx& F0, int layer) {
    const Ctx F = phase_ctx(F0);
    using namespace cf;
    const float* SC = (const float*)(F.ws + WS_P + SC_OFF); const float* X1 = (const float*)(F.ws + WS_P + X1_OFF);
    bf16_t* HB = WSP(bf16_t, WS_HB); const unsigned char* U8 = WSP(const unsigned char, WS_UB) + (size_t)layer * NEXP * 2048; const unsigned char* V8 = WSP(const unsigned char, WS_VB2) + (size_t)layer * NEXP * 2048;
    const float* lg = F.in[I_LN2G] + layer * 2048; const float* lb = F.in[I_LN2B] + layer * 2048;
    const int ntok = layer == 0 ? MR : NB * S, lane = F.lane;
    ldsp_t wl = F.lds + F.wave * 4096;
    LAS float* tv0 = (LAS float*)wl; LAS int* ti0 = (LAS int*)(wl + 64); LAS float* tv1 = (LAS float*)(wl + 128); LAS int* ti1 = (LAS int*)(wl + 192);
    LAS float* es = (LAS float*)(wl + 256); LAS int* ei = (LAS int*)(wl + 768); LAS float* eg = (LAS float*)(wl + 1280);
    for (int tok = F.bid * 8 + F.wave; tok < ntok; tok += F.G * 8) {
        const int R = tok_row(layer, tok), b = R / RB, j = R % RB; const bool isctx = j < CTX; const int modrow = isctx ? 4 : b;
        const float* sc = SC + (size_t)R * 2048;
        for (int h = 0; h < 8; ++h) {
            const float s0a = sc[(2 * h) * 128 + lane], s0b = sc[(2 * h) * 128 + 64 + lane], s1a = sc[(2 * h + 1) * 128 + lane], s1b = sc[(2 * h + 1) * 128 + 64 + lane];
            { const unsigned k[2] = {(ordkey(s0a) & ~127u) | (unsigned)(127 - lane), (ordkey(s0b) & ~127u) | (unsigned)(63 - lane)};
              const unsigned T = radix_thresh16<2>(k);
              const unsigned long long m0 = __ballot(k[0] >= T), m1 = __ballot(k[1] >= T); const int n0 = __popcll(m0);
              if (k[0] >= T) { const int r = lane_rank(m0); tv0[r] = s0a; ti0[r] = lane; }
              if (k[1] >= T) { const int r = n0 + lane_rank(m1); tv0[r] = s0b; ti0[r] = lane + 64; } }
            { const unsigned k[2] = {(ordkey(s1a) & ~127u) | (unsigned)(127 - lane), (ordkey(s1b) & ~127u) | (unsigned)(63 - lane)};
              const unsigned T = radix_thresh16<2>(k);
              const unsigned long long m0 = __ballot(k[0] >= T), m1 = __ballot(k[1] >= T); const int n0 = __popcll(m0);
              if (k[0] >= T) { const int r = lane_rank(m0); tv1[r] = s1a; ti1[r] = lane; }
              if (k[1] >= T) { const int r = n0 + lane_rank(m1); tv1[r] = s1b; ti1[r] = lane + 64; } }
            asm volatile("s_waitcnt lgkmcnt(0)" ::: "memory");
            const int ci = lane >> 2, cj = (lane & 3) * 4;
            const float a0 = tv0[ci]; const int i0 = ti0[ci];
            float c4[4]; int id4[4]; unsigned kc[4];
#pragma unroll
            for (int jj = 0; jj < 4; ++jj) { c4[jj] = a0 + tv1[cj + jj]; id4[jj] = i0 * 128 + ti1[cj + jj]; kc[jj] = (ordkey(c4[jj]) & ~255u) | (unsigned)(255 - (lane * 4 + jj)); }
            const unsigned Tc = radix_thresh16<4>(kc);
            int base = h * 16;
#pragma unroll
            for (int jj = 0; jj < 4; ++jj) { const unsigned long long m = __ballot(kc[jj] >= Tc);
                if (kc[jj] >= Tc) { const int r = base + lane_rank(m); es[r] = c4[jj]; ei[r] = id4[jj]; }
                base += __popcll(m); }
            asm volatile("s_waitcnt lgkmcnt(0)" ::: "memory");
        }
#pragma unroll
        for (int rnd = 0; rnd < 2; ++rnd) { const int e = lane + 64 * rnd; const float s = es[e];
            float m = s; m = fmaxf(m, __shfl_xor(m, 1)); m = fmaxf(m, __shfl_xor(m, 2)); m = fmaxf(m, __shfl_xor(m, 4)); m = fmaxf(m, __shfl_xor(m, 8));
            const float ex = __expf(s - m); float sum = ex; sum += __shfl_xor(sum, 1); sum += __shfl_xor(sum, 2); sum += __shfl_xor(sum, 4); sum += __shfl_xor(sum, 8);
            eg[e] = ex / sum; }
        asm volatile("s_waitcnt lgkmcnt(0)" ::: "memory");
        f32x2 xf[16];
#pragma unroll
        for (int i = 0; i < 2; ++i)
#pragma unroll
            for (int hh = 0; hh < 2; ++hh) { const u32x4 w = *(const u32x4*)(HB + (size_t)R * 2048 + lane * 16 + 1024 * i + 8 * hh);
                xf[8 * i + 4 * hh + 0] = (f32x2){bflo(w.x), bfhi(w.x)}; xf[8 * i + 4 * hh + 1] = (f32x2){bflo(w.y), bfhi(w.y)};
                xf[8 * i + 4 * hh + 2] = (f32x2){bflo(w.z), bfhi(w.z)}; xf[8 * i + 4 * hh + 3] = (f32x2){bflo(w.w), bfhi(w.w)}; }
        f32x2 y2[16];
#pragma unroll
        for (int i = 0; i < 16; ++i) y2[i] = (f32x2){0.f, 0.f};
        for (int grp = 0; grp < 32; ++grp) {
            int id[4]; float gq[4];
#pragma unroll
            for (int q = 0; q < 4; ++q) { id[q] = __builtin_amdgcn_readfirstlane(ei[grp * 4 + q]); gq[q] = __uint_as_float(__builtin_amdgcn_readfirstlane(__float_as_uint(eg[grp * 4 + q]))); }
            u32x4 ur[4][2], vr[4][2];
#pragma unroll
            for (int q = 0; q < 4; ++q)
#pragma unroll
                for (int i = 0; i < 2; ++i) { ur[q][i] = *(const u32x4*)(U8 + (size_t)id[q] * 2048 + lane * 16 + 1024 * i); vr[q][i] = *(const u32x4*)(V8 + (size_t)id[q] * 2048 + lane * 16 + 1024 * i); }
            float d[4];
#pragma unroll
            for (int q = 0; q < 4; ++q) { f32x2 t = {0.f, 0.f};
#pragma unroll
                for (int i = 0; i < 2; ++i)
#pragma unroll
                    for (int j = 0; j < 4; ++j) { const int w = (int)ur[q][i][j];
                        t += __builtin_amdgcn_cvt_pk_f32_fp8(w, false) * xf[8 * i + 2 * j]; t += __builtin_amdgcn_cvt_pk_f32_fp8(w, true) * xf[8 * i + 2 * j + 1]; }
                d[q] = t.x + t.y; }
#pragma unroll
            for (int o = 32; o >= 1; o >>= 1) {
#pragma unroll
                for (int q = 0; q < 4; ++q) d[q] += __shfl_xor(d[q], o); }
#pragma unroll
            for (int q = 0; q < 4; ++q) { const float dd = d[q] * (1.0f / 1024.0f); const float w = gq[q] * 0.5f * dd * (1.0f + erff(dd * 0.70710678118654752f)) * (1.0f / 16.0f);
                const f32x2 w2 = {w, w};
#pragma unroll
                for (int i = 0; i < 2; ++i)
#pragma unroll
                    for (int j = 0; j < 4; ++j) { const int vw = (int)vr[q][i][j];
                        y2[8 * i + 2 * j] += w2 * __builtin_amdgcn_cvt_pk_f32_fp8(vw, false); y2[8 * i + 2 * j + 1] += w2 * __builtin_amdgcn_cvt_pk_f32_fp8(vw, true); } }
        }
        const float* mod = WSP(const float, WS_MOD) + ((size_t)layer * 5 + modrow) * 12288;
        float y[32];
        float s = 0.f;
#pragma unroll
        for (int i = 0; i < 2; ++i)
#pragma unroll
            for (int j = 0; j < 4; ++j) { const int c = lane * 16 + 1024 * i + 4 * j;
                const f32x4 xa = *(const f32x4*)(X1 + (size_t)R * 2048 + c), ga = *(const f32x4*)(mod + 5 * 2048 + c);
                y[16 * i + 4 * j + 0] = ALPHA * xa[0] + ga[0] * y2[8 * i + 2 * j].x; y[16 * i + 4 * j + 1] = ALPHA * xa[1] + ga[1] * y2[8 * i + 2 * j].y;
                y[16 * i + 4 * j + 2] = ALPHA * xa[2] + ga[2] * y2[8 * i + 2 * j + 1].x; y[16 * i + 4 * j + 3] = ALPHA * xa[3] + ga[3] * y2[8 * i + 2 * j + 1].y;
                s += (y[16 * i + 4 * j + 0] + y[16 * i + 4 * j + 1]) + (y[16 * i + 4 * j + 2] + y[16 * i + 4 * j + 3]); }
        const float mean = wave_sum(s) * (1.f / 2048.f); float q2 = 0.f;
#pragma unroll
        for (int i = 0; i < 32; ++i) { const float dd = y[i] - mean; q2 += dd * dd; }
        const float rstd = rsqrtf(wave_sum(q2) * (1.f / 2048.f) + 1e-5f);
        float* dst = layer == 0 ? (isctx ? WSP(float, WS_XC) + ((size_t)b * CTX + j) * 2048 : F.out + ((size_t)b * S + (j - CTX)) * 2048) : F.out + ((size_t)b * S + (j - CTX)) * 2048;
        const float* modn = WSP(const float, WS_MOD) + ((size_t)1 * 5 + modrow) * 12288;
#pragma unroll
        for (int i = 0; i < 2; ++i)
#pragma unroll
            for (int hh = 0; hh < 2; ++hh) { f32x4 o[2];
#pragma unroll
                for (int jj = 0; jj < 2; ++jj) { const int j = 2 * hh + jj, c = lane * 16 + 1024 * i + 4 * j; const f32x4 la = *(const f32x4*)(lg + c), ba = *(const f32x4*)(lb + c);
#pragma unroll
                    for (int e = 0; e < 4; ++e) o[jj][e] = (y[16 * i + 4 * j + e] - mean) * rstd * la[e] + ba[e];
                    *(f32x4*)(dst + c) = o[jj]; }
                if (layer == 0) {
                    const int c = lane * 16 + 1024 * i + 8 * hh;
                    const f32x4 sa = *(const f32x4*)(modn + 2048 + c), sb = *(const f32x4*)(modn + 2048 + c + 4), ha = *(const f32x4*)(modn + c), hb = *(const f32x4*)(modn + c + 4);
                    *(u32x4*)(HB + (size_t)R * 2048 + c) = pg8::pack8(o[0] * (sa + 1.0f) + ha, o[1] * (sb + 1.0f) + hb); } }
    }
}

struct Params { const float* in[cf::N_IN]; float* out; unsigned char* ws; int ph_lo, ph_hi; };

__global__ void __launch_bounds__(512, 2) mega_fwd(Params p) {
    using namespace cf;
    extern __shared__ __attribute__((aligned(16))) unsigned char smem[];
    Ctx F0;
    F0.in = p.in;
    F0.out = p.out; F0.ws = p.ws; F0.lds = (ldsp_t)smem;
    F0.tid = threadIdx.x; F0.lane = F0.tid & 63; F0.wave = __builtin_amdgcn_readfirstlane(F0.tid >> 6); F0.G = gridDim.x; F0.bid = blockIdx.x;
    if (F0.tid < 64) ((LAS unsigned*)(F0.lds + MISC_OFF))[F0.tid] = 0u;
    __syncthreads();
    const int lo = p.ph_lo, hi = p.ph_hi;
    XcdBarrier bar; bar.bar = (unsigned*)(F0.ws + WS_CTL); bar.x = 0; bar.st = (volatile LAS unsigned*)(F0.lds + MISC_OFF);
    if (hi - lo > 1) bar = xcd_barrier_post((unsigned*)(F0.ws + WS_CTL), (volatile LAS unsigned*)(F0.lds + MISC_OFF));
#ifndef MK_MASK
#define MK_MASK 0xFFFF
#endif
#define ON(j) ((MK_MASK >> (j)) & 1)
#define IN(k) (lo <= (k) && (k) < hi)
#define SEAM(k) do { if (IN(k) && IN((k) + 1)) xcd_barrier(bar); } while (0)

    if (ON(9) && IN(0)) { ph_prologue(F0); if (DUPN(9) == 2) { __syncthreads(); ph_prologue(F0); } }
    SEAM(0);
    if (ON(10) && IN(1)) ph_modulate0(F0);
    SEAM(1);
    for (int l = 0; l < DEPTH; ++l) {
        const int pb = 2 + 8 * l;
        const int rmode = l == 0 ? 0 : 1, nMl = l == 0 ? 68 : 64;
        if (ON(0) && IN(pb + 0)) { const Ctx F = phase_ctx(F0);
            pg8::Gemm g{WSP(const bf16_t, WS_HB), WSP(const bf16_t, WS_WIN) + (size_t)l * NC * 2048, 2048, 2048};
            pg8::EpiInProj E{WSP(bf16_t, WS_P), WSP(bf16_t, WS_KB), WSP(const float, WS_COSH), WSP(const float, WS_SINH), WSP(const float, WS_COSR), WSP(const float, WS_SINR),
                             F.in[I_AKN] + l * 128, F.in[I_AQN] + l * 128, WSP(float, WS_SSK), WSP(float, WS_SSQ), WSP(float, WS_SSKV), WSP(float, WS_SSCQ)};
            pg8::TileOrder S; S.init(nMl, 56, F.G, F.bid, rmode);
            for (int dup = 0; dup < DUPN(0); ++dup)
            pg8::gemm_phase(F.lds, g, S, E);
            if (l > 0) { pg8::TileOrder S2; S2.init(4, 6, F.G, F.bid, 2); pg8::gemm_phase(F.lds, g, S2, E); }
        }
        SEAM(pb + 0);
        if (ON(2) && IN(pb + 1)) { const Ctx F = phase_ctx(F0); bf16_t* P = WSP(bf16_t, WS_P);
            knorm_pass(F);
            { pg8::Gemm g{P + PC_CKV, WSP(const bf16_t, WS_WKVUP) + (size_t)l * 2048 * 256, NC, 256}; pg8::EpiKvUp E{WSP(bf16_t, WS_KB), WSP(bf16_t, WS_VB), WSP(const float, WS_SSKV)};
              pg8::TileOrder S; S.init(68, 8, F.G, F.bid, 0); for (int dup = 0; dup < DUPN(1); ++dup) pg8::gemm_phase(F.lds, g, S, E); }
            { pg8::Gemm g{P + PC_CQ, WSP(const bf16_t, WS_WQUP) + (size_t)l * 1536 * 512, NC, 512}; pg8::EpiQUp E{WSP(bf16_t, WS_QB), WSP(const float, WS_COSR), WSP(const float, WS_SINR), WSP(const float, WS_SSCQ)};
              pg8::TileOrder S; S.init(nMl, 6, F.G, F.bid, rmode); for (int dup = 0; dup < DUPN(1); ++dup) pg8::gemm_phase(F.lds, g, S, E); }
        }
        SEAM(pb + 1);
        if (ON(3) && IN(pb + 2)) ph_attn(F0, l);
        SEAM(pb + 2);
        if (ON(4) && IN(pb + 3)) { const Ctx F = phase_ctx(F0); bf16_t* P = WSP(bf16_t, WS_P); bf16_t* HB = WSP(bf16_t, WS_HB);
            pg8::Gemm g{WSP(const bf16_t, WS_BR), WSP(const bf16_t, WS_WBR) + (size_t)l * 4 * 2048 * 1024, 4096, 1024};
            pg8::EpiMerge E{HB, P + PC_GATE, NC};
            pg8::TileOrder S; S.init(nMl, 8, F.G, F.bid, rmode, 4, (size_t)1024 * 2, (size_t)2048 * 1024 * 2);
            for (int dup = 0; dup < DUPN(5); ++dup) pg8::gemm_phase(F.lds, g, S, E);
        }
        SEAM(pb + 3);
        if (ON(5) && IN(pb + 4)) { const Ctx F = phase_ctx(F0); bf16_t* HB = WSP(bf16_t, WS_HB);
            pg8::Gemm g{HB, WSP(const bf16_t, WS_WO) + (size_t)l * 2048 * 2048, 2048, 2048};
            pg8::EpiWo E{(float*)(F.ws + WS_P + X1_OFF), WSP(const float, WS_MOD) + (size_t)l * 5 * 12288, l == 0 ? F.in[I_X] : (const float*)F.out, F.in[I_CTX]};
            pg8::TileOrder S; S.init(nMl, 8, F.G, F.bid, rmode); for (int dup = 0; dup < DUPN(6); ++dup) pg8::gemm_phase(F.lds, g, S, E);
        }
        SEAM(pb + 4);
        if (ON(6) && IN(pb + 5)) ph_ln1(F0, l);
        SEAM(pb + 5);
        if (ON(7) && IN(pb + 6)) { const Ctx F = phase_ctx(F0); bf16_t* HB = WSP(bf16_t, WS_HB);
            pg8::Gemm g{HB, WSP(const bf16_t, WS_WFOLD) + (size_t)l * 2048 * 2048, 2048, 2048}; pg8::EpiF32 E{(float*)(F.ws + WS_P + SC_OFF), 2048};
            pg8::TileOrder S; S.init(nMl, 8, F.G, F.bid, rmode); for (int dup = 0; dup < DUPN(7); ++dup) pg8::gemm_phase(F.lds, g, S, E);
        }
        SEAM(pb + 6);
        if (ON(8) && IN(pb + 7)) { ph_peer(F0, l); if (DUPN(8) == 2 && l == 1) ph_peer(F0, l); }
        SEAM(pb + 7);
    }
#undef IN
#undef SEAM
}

extern "C" void kernel_launch(void* const* d_in, const int* in_sizes, int n_in, void* d_out, int out_size, void* d_ws, size_t ws_size, hipStream_t stream) {
    static int grid = 0;
    if (grid == 0) {
        if (n_in != cf::N_IN || out_size != cf::NB * cf::S * cf::D || ws_size < cf::WS_END) {
            fprintf(stderr, "kernel_launch: unexpected shapes: n_in %d out %d ws %zu (need %zu)\n", n_in, out_size, ws_size, (size_t)cf::WS_END); grid = -1; return; }
        int dev = 0, cus = 0;
        if (hipGetDevice(&dev) != hipSuccess || hipDeviceGetAttribute(&cus, hipDeviceAttributeMultiprocessorCount, dev) != hipSuccess || cus < 1) { grid = -1; return; }
        if (hipFuncSetAttribute((const void*)mega_fwd, hipFuncAttributeMaxDynamicSharedMemorySize, cf::LDS_BYTES) != hipSuccess) { fprintf(stderr, "kernel_launch: hipFuncSetAttribute failed\n"); grid = -1; return; }
        int per_cu = 0;
        if (hipOccupancyMaxActiveBlocksPerMultiprocessor(&per_cu, (const void*)mega_fwd, 512, cf::LDS_BYTES) != hipSuccess || per_cu < 1)
            fprintf(stderr, "kernel_launch: note: occupancy query reports %d workgroups per CU\n", per_cu);
        (void)hipGetLastError();
        grid = cus;
    }
    if (grid < 0) return;
    (void)hipMemsetAsync((char*)d_ws + cf::WS_CTL, 0, cf::CTL_BYTES, stream);
    Params p{};
    for (int i = 0; i < cf::N_IN; ++i) p.in[i] = (const float*)d_in[i];
    p.out = (float*)d_out; p.ws = (unsigned char*)d_ws;
#if MK_PER_PHASE
    for (int k = 0; k < cf::N_PHASES; ++k) { p.ph_lo = k; p.ph_hi = k + 1; hipLaunchKernelGGL(mega_fwd, dim3(grid), dim3(512), cf::LDS_BYTES, stream, p); }
#else
    p.ph_lo = 0; p.ph_hi = cf::N_PHASES;
    hipLaunchKernelGGL(mega_fwd, dim3(grid), dim3(512), cf::LDS_BYTES, stream, p);
#endif
    const hipError_t le = hipPeekAtLastError();
    if (le != hipSuccess) fprintf(stderr, "kernel_launch: launch failed: %s\n", hipGetErrorName(le));
}
```

```cpp
#include <hip/hip_runtime.h>
#include <stdint.h>
#include <stdio.h>

#ifndef MK_DUP
#define MK_DUP 0
#endif
#define DUPN(k) (((MK_DUP >> (k)) & 1) ? 2 : 1)
#ifndef MK_PER_PHASE
#define MK_PER_PHASE 0
#endif

namespace cf {
constexpr int D = 2048, NB = 4, S = 4096, CTX = 256, RB = CTX + S  , MR = NB * RB  ;
constexpr int DEPTH = 2;
constexpr int PC_AK = 0, PC_AV = 256, PC_CKV = 512, PC_KR = 768, PC_DK = 1024, PC_DV = 1280, PC_KVEND = 1536;
constexpr int PC_AQ = 1536, PC_CQ = 2560, PC_DQ = 3072, PC_GLU = 4096, PC_GATE = 6144, NC = 14336;
constexpr int IN_COLS = 14144;
constexpr int NEXP = 16384;
constexpr float ALPHA = 1.4142135623730951f;
constexpr float LOG2E = 1.4426950408889634f;
constexpr float SCALE_HD = 0.08838834764831845f;
constexpr float SCALE_MLA = 0.07216878364870323f;
enum { I_X = 0, I_C, I_CTX, I_CCTX, I_WADA, I_BADA, I_WIN, I_AQN, I_AKN, I_BQN, I_WQUP, I_BKVN, I_WKVUP, I_CW, I_CB, I_CLG, I_CLB, I_SINK,
       I_WBRA, I_WBRB, I_WBRC, I_WBRD, I_WO, I_LN1G, I_LN1B, I_LN2G, I_LN2B, I_PWQ, I_PSK, I_PU, I_PV, N_IN };
constexpr size_t al(size_t x) { return (x + 255) / 256 * 256; }
constexpr size_t WS_CTL = 0;
constexpr size_t CTL_BYTES = 65536;
constexpr size_t WS_MOD = WS_CTL + CTL_BYTES;
constexpr size_t WS_COSH = WS_MOD + al((size_t)2 * 5 * 12288 * 4);
constexpr size_t WS_SINH = WS_COSH + (size_t)4096 * 64 * 4;
constexpr size_t WS_COSR = WS_SINH + (size_t)4096 * 64 * 4;
constexpr size_t WS_SINR = WS_COSR + (size_t)4096 * 32 * 4;
constexpr size_t WS_WIN = WS_SINR + (size_t)4096 * 32 * 4;
constexpr size_t WS_WQUP = WS_WIN + (size_t)2 * NC * 2048 * 2;
constexpr size_t WS_WKVUP = WS_WQUP + (size_t)2 * 1536 * 512 * 2;
constexpr size_t WS_WBR = WS_WKVUP + (size_t)2 * 2048 * 256 * 2;
constexpr size_t WS_WO = WS_WBR + (size_t)2 * 4 * 2048 * 1024 * 2;
constexpr size_t WS_WFOLD = WS_WO + (size_t)2 * 2048 * 2048 * 2;
constexpr size_t WS_UB = WS_WFOLD + (size_t)2 * 2048 * 2048 * 2;
constexpr size_t WS_VB2 = WS_UB + (size_t)2 * NEXP * 2048;
constexpr size_t WS_HB = WS_VB2 + (size_t)2 * NEXP * 2048;
constexpr size_t WS_P = WS_HB + (size_t)MR * 2048 * 2;
constexpr size_t WS_QB = WS_P + (size_t)MR * NC * 2;
constexpr size_t WS_KB = WS_QB + (size_t)MR * 1536 * 2;
constexpr size_t WS_VB = WS_KB + (size_t)MR * 1536 * 2;
constexpr size_t WS_BR = WS_VB + (size_t)MR * 1024 * 2;
constexpr size_t WS_XC = WS_BR + (size_t)MR * 4096 * 2;
constexpr size_t WS_SSK = WS_XC + (size_t)1024 * 2048 * 4;
constexpr size_t WS_SSQ = WS_SSK + (size_t)MR * 4 * 4;
constexpr size_t WS_SSKV = WS_SSQ + (size_t)MR * 16 * 4;
constexpr size_t WS_SSCQ = WS_SSKV + (size_t)MR * 4 * 4;
constexpr size_t WS_END = WS_SSCQ + (size_t)MR * 8 * 4;
constexpr size_t X1_OFF = 0, SC_OFF = (size_t)MR * 2048 * 4;
static_assert(SC_OFF * 2 <= (size_t)MR * NC * 2, "X1 + SC fit in P");
constexpr int LDS_BYTES = 132 * 1024;
constexpr int MISC_OFF = 128 * 1024;
constexpr int N_PHASES = 2 + 8 * DEPTH;
}

typedef unsigned short bf16_t;
typedef short bf16x8 __attribute__((ext_vector_type(8)));
typedef float f32x4 __attribute__((ext_vector_type(4)));
typedef float f32x2 __attribute__((ext_vector_type(2)));
typedef unsigned u32x4 __attribute__((ext_vector_type(4)));
typedef unsigned u32x2 __attribute__((ext_vector_type(2)));
#define LAS __attribute__((address_space(3)))
typedef LAS unsigned char* ldsp_t;

__device__ __forceinline__ unsigned cvt_pk_bf16(float lo, float hi) { unsigned r; asm volatile("v_cvt_pk_bf16_f32 %0, %1, %2" : "=v"(r) : "v"(lo), "v"(hi)); return r; }
__device__ __forceinline__ bf16_t f2bf(float f) { return (bf16_t)(cvt_pk_bf16(f, 0.f) & 0xffffu); }
__device__ __forceinline__ float bf2f(bf16_t b) { return __uint_as_float(((unsigned)b) << 16); }
__device__ __forceinline__ float bflo(unsigned w) { return __uint_as_float(w << 16); }
__device__ __forceinline__ float bfhi(unsigned w) { return __uint_as_float(w & 0xffff0000u); }
__device__ __forceinline__ float wave_sum(float v) {
#pragma unroll
    for (int o = 32; o >= 1; o >>= 1) v += __shfl_xor(v, o);
    return v;
}
__device__ __forceinline__ float sigmoidf_(float x) { return 1.0f / (1.0f + __expf(-x)); }

#define XB_TMO      128
#define XB_XCNT(j)  (256  + 64 * (j))
#define XB_XSUB(j)  (1280 + 64 * (j))
#define XB_XGEN(j)  (2304 + 64 * (j))
#define XB_TOP      3328
#define XB_TOPGEN   3392
#define XCD_BAR_WORDS 3456
#define XB_SPIN_CAP (1u << 23)
__device__ __forceinline__ unsigned xb_ld(unsigned* p)              { return __hip_atomic_load(p, __ATOMIC_RELAXED, __HIP_MEMORY_SCOPE_AGENT); }
__device__ __forceinline__ unsigned xb_add(unsigned* p, unsigned v) { return __hip_atomic_fetch_add(p, v, __ATOMIC_RELAXED, __HIP_MEMORY_SCOPE_AGENT); }
__device__ __forceinline__ unsigned xb_xcc_id() { return (unsigned)__builtin_amdgcn_s_getreg((3 << 11) | 20) & 0xFu; }
#define XB_SPIN(cond, bar) do { unsigned _sp = 0; while (cond) { __builtin_amdgcn_s_sleep(1); \
    if ((++_sp & 255u) == 0u) { if (xb_ld(&(bar)[XB_TMO])) break; if (_sp > XB_SPIN_CAP) { atomicAdd(&(bar)[XB_TMO], 1u); break; } } } } while (0)
struct XcdBarrier { unsigned* bar; unsigned x; volatile LAS unsigned* st; };
__device__ __forceinline__ XcdBarrier xcd_barrier_post(unsigned* bar, volatile LAS unsigned* st) {
    XcdBarrier b; b.bar = bar; b.x = xb_xcc_id(); b.st = st;
    if (threadIdx.x == 0) (void)xb_add(&bar[XB_XCNT(b.x)], 1u);
    return b;
}
__device__ __forceinline__ void xcd_barrier_complete(unsigned* bar, unsigned x, unsigned& nloc, unsigned& nx) {
    const unsigned G = gridDim.x * gridDim.y * gridDim.z;
    unsigned sum, cnt, mine, sp = 0u;
    for (;;) {
        sum = 0u; cnt = 0u; mine = 0u;
#pragma unroll
        for (unsigned j = 0; j < 16; ++j) { const unsigned c = xb_ld(&bar[XB_XCNT(j)]); sum += c; cnt += (c > 0u) ? 1u : 0u; mine = (j == x) ? c : mine; }
        if (sum == G) break;
        __builtin_amdgcn_s_sleep(1);
        if ((++sp & 255u) == 0u) { if (xb_ld(&bar[XB_TMO])) break; if (sp > XB_SPIN_CAP) { atomicAdd(&bar[XB_TMO], 1u); break; } }
    }
    nloc = mine > 0u ? mine : 1u; nx = cnt > 0u ? cnt : 1u;
}
__device__ __forceinline__ void xcd_barrier(const XcdBarrier& b) {
    asm volatile("s_waitcnt vmcnt(0)" ::: "memory");
    __syncthreads();
    if (threadIdx.x == 0) {
        unsigned* bar = b.bar;
        __builtin_amdgcn_s_waitcnt(0);
        unsigned nloc = b.st[0], nx = b.st[1];
        if (nloc == 0u) { xcd_barrier_complete(bar, b.x, nloc, nx); b.st[0] = nloc; b.st[1] = nx; }
        const unsigned old = xb_add(&bar[XB_XSUB(b.x)], 1u);
        const unsigned gen = old / nloc;
        if (old + 1u == (gen + 1u) * nloc) {
            __builtin_amdgcn_fence(__ATOMIC_RELEASE, "agent");
            asm volatile("s_waitcnt vmcnt(0)" ::: "memory");
            const unsigned og = xb_add(&bar[XB_TOP], 1u);
            const unsigned tg = og / nx;
            if (og + 1u == (tg + 1u) * nx) xb_add(&bar[XB_TOPGEN], 1u);
            else XB_SPIN(xb_ld(&bar[XB_TOPGEN]) == tg, bar);
            __builtin_amdgcn_fence(__ATOMIC_ACQUIRE, "agent");
            xb_add(&bar[XB_XGEN(b.x)], 1u);
            asm volatile("s_waitcnt vmcnt(0)" ::: "memory");
        } else {
            XB_SPIN(xb_ld(&bar[XB_XGEN(b.x)]) == gen, bar);
            __builtin_amdgcn_fence(__ATOMIC_ACQUIRE, "agent");
            asm volatile("s_waitcnt vmcnt(0)" ::: "memory");
        }
    }
    __syncthreads();
}

namespace pg8 {
constexpr int BM = 256, BK = 64, HALF = 128, HTB = HALF * BK * 2, STAGE_BYTES = 8 * HTB, NXCD = 8, WGM = 8;
__host__ __device__ __forceinline__ int lds_byte(int r, int c) { const int st = (r >> 4) * 2 + (c >> 5), rr = r & 15, cc = c & 31, ob = rr * 64 + cc * 2; return st * 1024 + (ob ^ (((ob >> 9) & 1) << 5)); }
__host__ __device__ __forceinline__ void stage_rc(int b, int& R, int& C) { const int st = b / 1024, sb = b % 1024, swz = sb ^ (((sb >> 9) & 1) << 5); R = (st >> 1) * 16 + swz / 64; C = (st & 1) * 32 + (swz % 64) / 2; }
__host__ __device__ __forceinline__ int perm32(int rho) { const int n = rho >> 4, i = rho & 15; return 8 * (i >> 2) + 4 * n + (i & 3); }
struct Unit { int pm, pn, sub; };
struct Gemm { const bf16_t* A; const bf16_t* Bt; int lda, K; };

struct TileOrder {
    int nM, nN, nwg, G, c, mode, nsub; size_t subA, subB;
    __device__ void init(int nM_, int nN_, int G_, int c_, int mode_, int nsub_ = 1, size_t subA_ = 0, size_t subB_ = 0) { nM = nM_; nN = nN_; nwg = nM * nN; G = G_; c = c_; mode = mode_; nsub = nsub_; subA = subA_; subB = subB_; }
    __device__ bool next(int i, Unit& u) const {
        const int it = nsub == 1 ? i : i / nsub; u.sub = nsub == 1 ? 0 : i - it * nsub;
        const long L = (long)it * G + c; if (L >= nwg) return false;
        int wgid = (int)L; { const int q = nwg / NXCD, r = nwg % NXCD, xcd = wgid % NXCD, off = wgid / NXCD; wgid = (xcd < r ? xcd * (q + 1) : r * (q + 1) + (xcd - r) * q) + off; }
        const int nig = WGM * nN, gid = wgid / nig, fm = gid * WGM, gsz = (nM - fm) < WGM ? (nM - fm) : WGM;
        const int pl = fm + ((wgid % nig) % gsz); u.pn = (wgid % nig) / gsz;
        u.pm = mode == 0 ? pl : (mode == 1 ? 17 * (pl >> 4) + 1 + (pl & 15) : 17 * pl);
        return true;
    }
    __device__ __forceinline__ void a_ready(const Unit&) const {}
    __device__ __forceinline__ void done(const Unit&) const {}
};

template <class Epi, class Sched>
__device__ __forceinline__ void gemm_phase(ldsp_t lds, const Gemm g, const Sched& S, const Epi& E) {
    int tid = threadIdx.x; asm volatile("" : "+v"(tid));
    const int wid = __builtin_amdgcn_readfirstlane(tid >> 6), lane = tid & 63, wr = wid >> 2, wc = wid & 3, fr = lane & 15, fq = lane >> 4;
    int K = g.K; asm volatile("" : "+s"(K));
    const int nt = K / BK, lda = g.lda;
    unsigned voffA[2], voffB[2];
#pragma unroll
    for (int i = 0; i < 2; ++i) { int R, C; stage_rc(tid * 16 + i * 8192, R, C); const int Rb = (R & ~31) + perm32(R & 31);
        voffA[i] = (unsigned)(R * lda + C) * 2u; voffB[i] = (unsigned)(Rb * K + C) * 2u; }
    const size_t kstep = (size_t)(BK * 2);
    const size_t hstepA = (size_t)HALF * lda * 2, hstepB = (size_t)HALF * K * 2;
    const size_t tstepA = 2 * hstepA, tstepB = 2 * hstepB;
    const unsigned ldsw = (unsigned)wid * 1024u;
    const int aoff = lds_byte(wr * 64 + fr, fq * 8), boff = lds_byte(wc * 32 + fr, fq * 8);
#define PG8_SA(b, h) (((b) * 2 + (h)) * HTB)
#define PG8_SB(b, h) ((4 + (b) * 2 + (h)) * HTB)
#define PG8_STAGE(bufoff, gbase, voff) do { _Pragma("unroll") for (int _i = 0; _i < 2; ++_i) \
        __builtin_amdgcn_global_load_lds((const unsigned*)((const char*)(gbase) + (voff)[_i]), (LAS unsigned*)(lds + (bufoff) + ldsw + _i * 8192), 16, 0, 0); } while (0)
#define PG8_LDA(dst, b, h) do { _Pragma("unroll") for (int m = 0; m < 4; ++m) _Pragma("unroll") for (int k = 0; k < 2; ++k) dst[m][k] = *(const LAS bf16x8*)(lds + PG8_SA(b, h) + aoff + m * 2048 + k * 1024); } while (0)
#define PG8_LDB(dst, b, h) do { _Pragma("unroll") for (int n = 0; n < 2; ++n) _Pragma("unroll") for (int k = 0; k < 2; ++k) dst[n][k] = *(const LAS bf16x8*)(lds + PG8_SB(b, h) + boff + n * 2048 + k * 1024); } while (0)
#define PG8_MMA(ai, bj, At, Bt) do { __builtin_amdgcn_s_setprio(1); _Pragma("unroll") for (int m = 0; m < 4; ++m) _Pragma("unroll") for (int n = 0; n < 2; ++n) _Pragma("unroll") for (int k = 0; k < 2; ++k) \
        acc[ai][bj][m][n] = __builtin_amdgcn_mfma_f32_16x16x32_bf16(Bt[n][k], At[m][k], acc[ai][bj][m][n], 0, 0, 0); __builtin_amdgcn_s_setprio(0); } while (0)
#define PG8_WAIT_V(n) asm volatile("s_waitcnt vmcnt(" #n ")" ::: "memory")
#define PG8_WAIT_L(n) asm volatile("s_waitcnt lgkmcnt(" #n ")" ::: "memory")
#define PG8_BAR __builtin_amdgcn_s_barrier()
#define PG8_SCHED __builtin_amdgcn_sched_barrier(0)
    Unit cur, nxt; int ui = 0;
    if (!S.next(0, cur)) return;
    f32x4 acc[2][2][4][2];
#pragma unroll
    for (int a = 0; a < 2; ++a)
#pragma unroll
        for (int b = 0; b < 2; ++b)
#pragma unroll
            for (int m = 0; m < 4; ++m)
#pragma unroll
                for (int n = 0; n < 2; ++n) acc[a][b][m][n] = (f32x4){0.f, 0.f, 0.f, 0.f};
    bf16x8 At[4][2], B0[2][2], B1[2][2];
    const char* cA = (const char*)g.A + (size_t)cur.pm * tstepA + cur.sub * S.subA; const char* cB = (const char*)g.Bt + (size_t)cur.pn * tstepB + cur.sub * S.subB;
    S.a_ready(cur);
    PG8_STAGE(PG8_SB(0, 0), cB, voffB); PG8_STAGE(PG8_SA(0, 0), cA, voffA); PG8_STAGE(PG8_SB(0, 1), cB + hstepB, voffB); PG8_STAGE(PG8_SA(0, 1), cA + hstepA, voffA);
    if (wr == 1) PG8_BAR;
    PG8_WAIT_V(4); PG8_BAR;
    PG8_STAGE(PG8_SB(1, 0), cB + kstep, voffB); PG8_STAGE(PG8_SA(1, 0), cA + kstep, voffA); PG8_STAGE(PG8_SB(1, 1), cB + hstepB + kstep, voffB);
    PG8_WAIT_V(6); PG8_BAR;
    for (;;) {
        const bool has_next = S.next(ui + 1, nxt);
        const char* nA = has_next ? (const char*)g.A + (size_t)nxt.pm * tstepA + nxt.sub * S.subA : cA; const char* nB = has_next ? (const char*)g.Bt + (size_t)nxt.pn * tstepB + nxt.sub * S.subB : cB;
#pragma unroll 1
        for (int t = 0; t < nt; t += 2) {
            const bool last = (t == nt - 2);
            const char* a1 = cA + (size_t)(t + 1) * kstep;
            const char* a2 = last ? nA : cA + (size_t)(t + 2) * kstep; const char* b2 = last ? nB : cB + (size_t)(t + 2) * kstep;
            const char* a3 = a2 + kstep; const char* b3 = b2 + kstep;
            if (last && has_next) S.a_ready(nxt);
            PG8_LDB(B0, 0, 0); PG8_SCHED; PG8_LDA(At, 0, 0); PG8_STAGE(PG8_SA(1, 1), a1 + hstepA, voffA);
            PG8_WAIT_L(8); PG8_BAR; PG8_WAIT_L(0); PG8_MMA(0, 0, At, B0); PG8_BAR; PG8_SCHED;
            PG8_LDB(B1, 0, 1); PG8_STAGE(PG8_SB(0, 0), b2, voffB);
            PG8_BAR; PG8_WAIT_L(0); PG8_MMA(0, 1, At, B1); PG8_BAR;
            PG8_LDA(At, 0, 1); PG8_STAGE(PG8_SA(0, 0), a2, voffA);
            PG8_BAR; PG8_WAIT_L(0); PG8_MMA(1, 0, At, B0); PG8_BAR; PG8_SCHED;
            PG8_STAGE(PG8_SB(0, 1), b2 + hstepB, voffB);
            PG8_WAIT_V(6); PG8_BAR; PG8_MMA(1, 1, At, B1); PG8_BAR;
            PG8_LDB(B0, 1, 0); PG8_SCHED; PG8_LDA(At, 1, 0); PG8_STAGE(PG8_SA(0, 1), a2 + hstepA, voffA);
            PG8_WAIT_L(8); PG8_BAR; PG8_WAIT_L(0); PG8_MMA(0, 0, At, B0); PG8_BAR; PG8_SCHED;
            PG8_LDB(B1, 1, 1); PG8_STAGE(PG8_SB(1, 0), b3, voffB);
            PG8_BAR; PG8_WAIT_L(0); PG8_MMA(0, 1, At, B1); PG8_BAR;
            PG8_LDA(At, 1, 1); PG8_STAGE(PG8_SA(1, 0), a3, voffA);
            PG8_BAR; PG8_WAIT_L(0); PG8_MMA(1, 0, At, B0); PG8_BAR; PG8_SCHED;
            PG8_STAGE(PG8_SB(1, 1), b3 + hstepB, voffB);
            PG8_WAIT_V(6); PG8_BAR; PG8_MMA(1, 1, At, B1); PG8_BAR;
        }
        E(acc, cur, wr, wc, fr, fq); S.done(cur);
        if (!has_next) break;
#pragma unroll
        for (int a = 0; a < 2; ++a)
#pragma unroll
            for (int b = 0; b < 2; ++b)
#pragma unroll
                for (int m = 0; m < 4; ++m)
#pragma unroll
                    for (int n = 0; n < 2; ++n) acc[a][b][m][n] = (f32x4){0.f, 0.f, 0.f, 0.f};
        cur = nxt; cA = nA; cB = nB; ++ui;
    }
    PG8_WAIT_V(0);
    if (wr == 0) PG8_BAR;
    PG8_BAR;
#undef PG8_SA
#undef PG8_SB
#undef PG8_STAGE
#undef PG8_LDA
#undef PG8_LDB
#undef PG8_MMA
#undef PG8_WAIT_V
#undef PG8_WAIT_L
#undef PG8_BAR
#undef PG8_SCHED
}

__device__ __forceinline__ u32x4 pack8(const f32x4 a, const f32x4 b) { u32x4 w; w.x = cvt_pk_bf16(a[0], a[1]); w.y = cvt_pk_bf16(a[2], a[3]); w.z = cvt_pk_bf16(b[0], b[1]); w.w = cvt_pk_bf16(b[2], b[3]); return w; }
#define EPI_ARGS const f32x4 (&acc)[2][2][4][2], const Unit& u, int wr, int wc, int fr_, int fq_
#define EPI_LANE int fr = fr_, fq = fq_; asm volatile("" : "+v"(fr), "+v"(fq));

struct EpiBf16 {
    bf16_t* O; int ldc;
    __device__ __forceinline__ void operator()(EPI_ARGS) const {
        EPI_LANE
        const int row0 = u.pm * BM + wr * 64 + fr, col0 = u.pn * BM + wc * 32 + 8 * fq;
#pragma unroll
        for (int ai = 0; ai < 2; ++ai)
#pragma unroll
            for (int m = 0; m < 4; ++m) { bf16_t* rowp = O + (size_t)(row0 + ai * HALF + m * 16) * ldc + col0;
#pragma unroll
                for (int bj = 0; bj < 2; ++bj) *(u32x4*)(rowp + bj * HALF) = pack8(acc[ai][bj][m][0], acc[ai][bj][m][1]); }
    }
};
struct EpiF32 {
    float* C; int ldc;
    __device__ __forceinline__ void operator()(EPI_ARGS) const {
        EPI_LANE
        const int row0 = u.pm * BM + wr * 64 + fr, col0 = u.pn * BM + wc * 32 + 8 * fq;
#pragma unroll
        for (int ai = 0; ai < 2; ++ai)
#pragma unroll
            for (int m = 0; m < 4; ++m) { float* rowp = C + (size_t)(row0 + ai * HALF + m * 16) * ldc + col0;
#pragma unroll
                for (int bj = 0; bj < 2; ++bj) { *(f32x4*)(rowp + bj * HALF) = acc[ai][bj][m][0]; *(f32x4*)(rowp + bj * HALF + 4) = acc[ai][bj][m][1]; } }
    }
};
struct EpiInProj {
    bf16_t* P; bf16_t* KB; const float* cosh; const float* sinh; const float* cosr; const float* sinr; const float* akn; const float* aqn;
    float* ssk; float* ssq; float* sskv; float* sscq;
    __device__ __forceinline__ void operator()(EPI_ARGS) const {
        EPI_LANE
        const int pn = u.pn, tb = u.pm % 17; const bool lat = tb != 0; const int posbase = (tb - 1) * 256;
        const int rl0 = wr * 64 + fr;
        if (pn >= 24) {
            const int col0 = pn * BM + wc * 32 + 8 * fq;
#pragma unroll
            for (int ai = 0; ai < 2; ++ai)
#pragma unroll
                for (int m = 0; m < 4; ++m) { bf16_t* rowp = P + ((size_t)u.pm * BM + rl0 + ai * HALF + m * 16) * cf::NC + col0;
#pragma unroll
                    for (int bj = 0; bj < 2; ++bj) { f32x4 v0 = acc[ai][bj][m][0], v1 = acc[ai][bj][m][1];
#pragma unroll
                        for (int e = 0; e < 4; ++e) { v0[e] = sigmoidf_(v0[e]); v1[e] = sigmoidf_(v1[e]); }
                        *(u32x4*)(rowp + bj * HALF) = pack8(v0, v1); } }
        } else if (pn >= 16) {
            const int col0 = cf::PC_GLU + 128 * (pn - 16) + wc * 32 + 8 * fq;
#pragma unroll
            for (int ai = 0; ai < 2; ++ai)
#pragma unroll
                for (int m = 0; m < 4; ++m) { f32x4 v0 = acc[ai][0][m][0], v1 = acc[ai][0][m][1]; const f32x4 g0 = acc[ai][1][m][0], g1 = acc[ai][1][m][1];
#pragma unroll
                    for (int e = 0; e < 4; ++e) { v0[e] *= sigmoidf_(g0[e]); v1[e] *= sigmoidf_(g1[e]); }
                    *(u32x4*)(P + ((size_t)u.pm * BM + rl0 + ai * HALF + m * 16) * cf::NC + col0) = pack8(v0, v1); }
        } else if (pn == 3) {
            if (wc == 0) { const int i0 = 8 * fq;
#pragma unroll
                for (int ai = 0; ai < 2; ++ai)
#pragma unroll
                    for (int m = 0; m < 4; ++m) { const int rl = rl0 + ai * HALF + m * 16;
                        f32x4 c0 = {1.f, 1.f, 1.f, 1.f}, c1 = c0, s0 = {0.f, 0.f, 0.f, 0.f}, s1 = s0;
                        if (lat) { const float* cp = cosr + (size_t)(posbase + rl) * 32 + i0; const float* sp = sinr + (size_t)(posbase + rl) * 32 + i0;
                            c0 = *(const f32x4*)cp; c1 = *(const f32x4*)(cp + 4); s0 = *(const f32x4*)sp; s1 = *(const f32x4*)(sp + 4); }
                        const f32x4 x1a = acc[ai][0][m][0], x1b = acc[ai][0][m][1], x2a = acc[ai][1][m][0], x2b = acc[ai][1][m][1];
                        const u32x4 w1 = pack8(x1a * c0 - x2a * s0, x1b * c1 - x2b * s1), w2 = pack8(x2a * c0 + x1a * s0, x2b * c1 + x1b * s1);
                        bf16_t* kb = KB + ((size_t)u.pm * BM + rl) * 1536 + 128 + i0;
#pragma unroll
                        for (int h = 0; h < 8; ++h) { *(u32x4*)(kb + h * 192) = w1; *(u32x4*)(kb + h * 192 + 32) = w2; }
                        asm volatile("" ::: "memory"); } }
        } else if (pn == 0 || pn == 4 || (pn >= 6 && pn <= 9) || pn >= 12) {
            const bool norm = pn == 0 || (pn >= 6 && pn <= 9);
            const int hl = wc >> 1, i0 = 32 * (wc & 1) + 8 * fq;
            f32x4 g1a = {1.f, 1.f, 1.f, 1.f}, g1b = g1a, g2a = g1a, g2b = g1a;
            if (norm) { const float* gn = (pn == 0 ? akn : aqn) + i0; g1a = *(const f32x4*)gn; g1b = *(const f32x4*)(gn + 4); g2a = *(const f32x4*)(gn + 64); g2b = *(const f32x4*)(gn + 68); }
            float* ssp = pn == 0 ? ssk + ((size_t)u.pm * BM * 2 + hl) * 2 + (wc & 1) : ssq + ((size_t)u.pm * BM * 8 + (pn - 6) * 2 + hl) * 2 + (wc & 1);
            const int sstr = pn == 0 ? 4 : 16;
#pragma unroll
            for (int ai = 0; ai < 2; ++ai)
#pragma unroll
                for (int m = 0; m < 4; ++m) { const int rl = rl0 + ai * HALF + m * 16;
                    f32x4 x1a = acc[ai][0][m][0], x1b = acc[ai][0][m][1], x2a = acc[ai][1][m][0], x2b = acc[ai][1][m][1];
                    if (norm) { const f32x4 q = x1a * x1a + x1b * x1b + x2a * x2a + x2b * x2b; float ss = (q[0] + q[1]) + (q[2] + q[3]);
                        ss += __shfl_xor(ss, 16); ss += __shfl_xor(ss, 32);
                        if (fq == 0) ssp[(size_t)rl * sstr] = ss;
                        x1a *= g1a; x1b *= g1b; x2a *= g2a; x2b *= g2b; }
                    f32x4 o1a = x1a, o1b = x1b, o2a = x2a, o2b = x2b;
                    if (lat) { const float* cp = cosh + (size_t)(posbase + rl) * 64 + i0; const float* sp = sinh + (size_t)(posbase + rl) * 64 + i0;
                        const f32x4 c0 = *(const f32x4*)cp, c1 = *(const f32x4*)(cp + 4), s0 = *(const f32x4*)sp, s1 = *(const f32x4*)(sp + 4);
                        o1a = x1a * c0 - x2a * s0; o1b = x1b * c1 - x2b * s1; o2a = x2a * c0 + x1a * s0; o2b = x2b * c1 + x1b * s1; }
                    bf16_t* dst = P + ((size_t)u.pm * BM + rl) * cf::NC + pn * BM + hl * 128 + i0;
                    *(u32x4*)dst = pack8(o1a, o1b); *(u32x4*)(dst + 64) = pack8(o2a, o2b);
                    asm volatile("" ::: "memory"); }
        } else {
            const int col0 = pn * BM + wc * 32 + 8 * fq;
            const bool ssq_on = pn == 2 || pn == 10 || pn == 11;
            float* ssp = pn == 2 ? sskv + (size_t)u.pm * BM * 4 + wc : sscq + (size_t)u.pm * BM * 8 + (pn - 10) * 4 + wc;
            const int sstr = pn == 2 ? 4 : 8;
#pragma unroll
            for (int ai = 0; ai < 2; ++ai)
#pragma unroll
                for (int m = 0; m < 4; ++m) { const int rl = rl0 + ai * HALF + m * 16; bf16_t* rowp = P + ((size_t)u.pm * BM + rl) * cf::NC + col0;
#pragma unroll
                    for (int bj = 0; bj < 2; ++bj) *(u32x4*)(rowp + bj * HALF) = pack8(acc[ai][bj][m][0], acc[ai][bj][m][1]);
                    if (ssq_on) { const f32x4 q = acc[ai][0][m][0] * acc[ai][0][m][0] + acc[ai][0][m][1] * acc[ai][0][m][1] + acc[ai][1][m][0] * acc[ai][1][m][0] + acc[ai][1][m][1] * acc[ai][1][m][1];
                        float ss = (q[0] + q[1]) + (q[2] + q[3]); ss += __shfl_xor(ss, 16); ss += __shfl_xor(ss, 32);
                        if (fq == 0) ssp[(size_t)rl * sstr] = ss; } }
        }
    }
};
struct EpiKvUp {
    bf16_t* KB; bf16_t* VB; const float* sskv;
    __device__ __forceinline__ void operator()(EPI_ARGS) const {
        EPI_LANE
        const int row0 = u.pm * BM + wr * 64 + fr, d0 = wc * 32 + 8 * fq;
        const bool isk = u.pn < 4;
        bf16_t* base = isk ? KB + (2 * u.pn) * 192 + d0 : VB + (u.pn - 4) * 256 + d0;
        const int ldr = isk ? 1536 : 1024, bjs = isk ? 192 : 128;
#pragma unroll
        for (int ai = 0; ai < 2; ++ai)
#pragma unroll
            for (int m = 0; m < 4; ++m) { const size_t row = (size_t)(row0 + ai * HALF + m * 16); bf16_t* rowp = base + row * ldr;
                const f32x4 pp = *(const f32x4*)(sskv + row * 4); const float r = rsqrtf(((pp[0] + pp[1]) + (pp[2] + pp[3])) * (1.f / 256.f) + 1e-6f);
#pragma unroll
                for (int bj = 0; bj < 2; ++bj) *(u32x4*)(rowp + bj * bjs) = pack8(acc[ai][bj][m][0] * r, acc[ai][bj][m][1] * r); }
    }
};
struct EpiQUp {
    bf16_t* QB; const float* cosr; const float* sinr; const float* sscq;
    __device__ __forceinline__ void operator()(EPI_ARGS) const {
        EPI_LANE
        const int row0 = u.pm * BM + wr * 64 + fr;
        if (u.pn < 4) {
            const int d0 = wc * 32 + 8 * fq;
#pragma unroll
            for (int ai = 0; ai < 2; ++ai)
#pragma unroll
                for (int m = 0; m < 4; ++m) { const size_t row = (size_t)(row0 + ai * HALF + m * 16);
                    const f32x4 pa = *(const f32x4*)(sscq + row * 8), pb = *(const f32x4*)(sscq + row * 8 + 4);
                    const float r = rsqrtf((((pa[0] + pa[1]) + (pa[2] + pa[3])) + ((pb[0] + pb[1]) + (pb[2] + pb[3]))) * (1.f / 512.f) + 1e-6f);
#pragma unroll
                    for (int bj = 0; bj < 2; ++bj) *(u32x4*)(QB + row * 1536 + (2 * u.pn + bj) * 192 + d0) = pack8(acc[ai][bj][m][0] * r, acc[ai][bj][m][1] * r); }
        } else {
            const int head = 4 * (u.pn - 4) + wc, i0 = 8 * fq;
            const bool lat = (u.pm % 17) != 0; const int posbase = (u.pm % 17) * 256 - 256;
#pragma unroll
            for (int ai = 0; ai < 2; ++ai)
#pragma unroll
                for (int m = 0; m < 4; ++m) { const int rl = wr * 64 + fr + ai * HALF + m * 16; const size_t row = (size_t)u.pm * BM + rl;
                    const f32x4 pa = *(const f32x4*)(sscq + row * 8), pb = *(const f32x4*)(sscq + row * 8 + 4);
                    const float r = rsqrtf((((pa[0] + pa[1]) + (pa[2] + pa[3])) + ((pb[0] + pb[1]) + (pb[2] + pb[3]))) * (1.f / 512.f) + 1e-6f);
                    f32x4 c0 = {1.f, 1.f, 1.f, 1.f}, c1 = c0, s0 = {0.f, 0.f, 0.f, 0.f}, s1 = s0;
                    if (lat) { const float* cp = cosr + (size_t)(posbase + rl) * 32 + i0; const float* sp = sinr + (size_t)(posbase + rl) * 32 + i0;
                        c0 = *(const f32x4*)cp; c1 = *(const f32x4*)(cp + 4); s0 = *(const f32x4*)sp; s1 = *(const f32x4*)(sp + 4); }
                    const f32x4 x1a = acc[ai][0][m][0] * r, x1b = acc[ai][0][m][1] * r, x2a = acc[ai][1][m][0] * r, x2b = acc[ai][1][m][1] * r;
                    const f32x4 o1a = x1a * c0 - x2a * s0, o1b = x1b * c1 - x2b * s1, o2a = x2a * c0 + x1a * s0, o2b = x2b * c1 + x1b * s1;
                    bf16_t* dst = QB + row * 1536 + head * 192 + 128 + i0;
                    *(u32x4*)dst = pack8(o1a, o1b); *(u32x4*)(dst + 32) = pack8(o2a, o2b); asm volatile("" ::: "memory"); }
        }
    }
};
struct EpiMerge {
    bf16_t* ACC; const bf16_t* gate0; int ldg;
    __device__ __forceinline__ void operator()(EPI_ARGS) const {
        EPI_LANE
        const int row0 = u.pm * BM + wr * 64 + fr, col0 = u.pn * BM + wc * 32 + 8 * fq;
        const bf16_t* gate = gate0 + u.sub * 2048; const bool first = u.sub == 0;
#pragma unroll
        for (int ai = 0; ai < 2; ++ai) {
            u32x4 gw[4][2], pw[4][2];
#pragma unroll
            for (int m = 0; m < 4; ++m) { const size_t row = (size_t)(row0 + ai * HALF + m * 16);
#pragma unroll
                for (int bj = 0; bj < 2; ++bj) { const int col = col0 + bj * HALF; gw[m][bj] = *(const u32x4*)(gate + row * ldg + col);
                    pw[m][bj] = (u32x4){0u, 0u, 0u, 0u}; if (!first) pw[m][bj] = *(const u32x4*)(ACC + row * 2048 + col); } }
#pragma unroll
            for (int m = 0; m < 4; ++m) { const size_t row = (size_t)(row0 + ai * HALF + m * 16);
#pragma unroll
                for (int bj = 0; bj < 2; ++bj) { const int col = col0 + bj * HALF; const u32x4 g = gw[m][bj], p = pw[m][bj];
                    const f32x4 a0 = acc[ai][bj][m][0], a1 = acc[ai][bj][m][1];
                    f32x4 r0, r1;
                    r0[0] = bflo(p.x) + bflo(g.x) * a0[0]; r0[1] = bfhi(p.x) + bfhi(g.x) * a0[1]; r0[2] = bflo(p.y) + bflo(g.y) * a0[2]; r0[3] = bfhi(p.y) + bfhi(g.y) * a0[3];
                    r1[0] = bflo(p.z) + bflo(g.z) * a1[0]; r1[1] = bfhi(p.z) + bfhi(g.z) * a1[1]; r1[2] = bflo(p.w) + bflo(g.w) * a1[2]; r1[3] = bfhi(p.w) + bfhi(g.w) * a1[3];
                    *(u32x4*)(ACC + row * 2048 + col) = pack8(r0, r1); } }
            asm volatile("" ::: "memory"); }
    }
};
struct EpiWo {
    float* X1; const float* mod  ; const float* xlat  ; const float* xctx  ;
    __device__ __forceinline__ void operator()(EPI_ARGS) const {
        EPI_LANE
        const int b = u.pm / 17, tb = u.pm % 17; const bool isctx = tb == 0;
        const float* g1 = mod + (size_t)(isctx ? 4 : b) * 12288 + 2 * 2048;
        const float* xbase = isctx ? xctx + (size_t)b * cf::CTX * 2048 : xlat + ((size_t)b * cf::S + (size_t)(tb - 1) * 256) * 2048;
        const int rl0 = wr * 64 + fr, col0 = u.pn * BM + wc * 32 + 8 * fq;
        f32x4 gv[2][2];
#pragma unroll
        for (int bj = 0; bj < 2; ++bj) { gv[bj][0] = *(const f32x4*)(g1 + col0 + bj * HALF); gv[bj][1] = *(const f32x4*)(g1 + col0 + bj * HALF + 4); }
#pragma unroll
        for (int ai = 0; ai < 2; ++ai) {
            f32x4 xv[4][2][2];
#pragma unroll
            for (int m = 0; m < 4; ++m) { const int rl = rl0 + ai * HALF + m * 16;
#pragma unroll
                for (int bj = 0; bj < 2; ++bj) { const float* xp = xbase + (size_t)rl * 2048 + col0 + bj * HALF; xv[m][bj][0] = *(const f32x4*)xp; xv[m][bj][1] = *(const f32x4*)(xp + 4); } }
#pragma unroll
            for (int m = 0; m < 4; ++m) { const int rl = rl0 + ai * HALF + m * 16; float* op = X1 + ((size_t)u.pm * BM + rl) * 2048 + col0;
#pragma unroll
                for (int bj = 0; bj < 2; ++bj) { *(f32x4*)(op + bj * HALF) = xv[m][bj][0] * cf::ALPHA + gv[bj][0] * acc[ai][bj][m][0];
                    *(f32x4*)(op + bj * HALF + 4) = xv[m][bj][1] * cf::ALPHA + gv[bj][1] * acc[ai][bj][m][1]; } }
            asm volatile("" ::: "memory"); }
    }
};
}

struct Ctx {
    const float* const* in; float* out; unsigned char* ws;
    ldsp_t lds; int tid, lane, wave, G, bid;
};
#define WSP(T, off) ((T*)(F.ws + (off)))
__device__ __forceinline__ Ctx phase_ctx(const Ctx& F0) {
    Ctx C = F0;
    asm volatile("" : "+v"(C.tid));
    asm volatile("" : "+s"(C.ws));
    C.lane = C.tid & 63; C.wave = __builtin_amdgcn_readfirstlane(C.tid >> 6);
    return C;
}

__device__ __forceinline__ int srcmap(int mode, int n) {
    if (mode == 0) {
        const int pn = n >> 8, q = n & 255, bj = q >> 7, r = q & 127, rope = (r >> 6) * 128 + bj * 64 + (r & 63);
        if (pn == 0) return rope;
        if (pn == 1) return 256 + q;
        if (pn == 2) return 512 + q;
        if (pn == 3) return r < 32 ? 768 + bj * 32 + r : -1;
        if (pn == 4) return 832 + rope;
        if (pn == 5) return 1088 + q;
        if (pn < 10) return 1344 + (pn - 6) * 256 + rope;
        if (pn < 12) return 2368 + (pn - 10) * 256 + q;
        if (pn < 16) return 2880 + (pn - 12) * 256 + rope;
        if (pn < 24) return 3904 + bj * 1024 + 128 * (pn - 16) + r;
        return 5952 + (n - 6144);
    }
    if (mode == 1) { if (n < 1024) return (n >> 7) * 192 + (n & 127);
        const int m = n - 1024, t = m >> 8, bj = (m >> 7) & 1, q = m & 127; return (4 * t + (q >> 5)) * 192 + 128 + bj * 32 + (q & 31); }
    if (mode == 2) { if (n < 1024) return (n >> 7) * 256 + (n & 127); const int m = n - 1024; return (m >> 7) * 256 + 128 + (m & 127); }
    return n;
}
__device__ __forceinline__ void tr_tile(const Ctx& F, const float* src, int ld_src, int mode, int k0, bf16_t* dst, int ldd, int n0, const float* kscale = nullptr) {
    LAS float* T = (LAS float*)F.lds;
    const int kr = F.tid >> 4, nc = (F.tid & 15) * 4, sc = srcmap(mode, n0 + nc);
#pragma unroll
    for (int h = 0; h < 2; ++h) { const int k = kr + 32 * h; f32x4 v = {0.f, 0.f, 0.f, 0.f};
        if (sc >= 0) v = *(const f32x4*)(src + (size_t)(k0 + k) * ld_src + sc);
        if (kscale) v = v * kscale[k0 + k];
        T[k * 65 + nc + 0] = v[0]; T[k * 65 + nc + 1] = v[1]; T[k * 65 + nc + 2] = v[2]; T[k * 65 + nc + 3] = v[3]; }
    __syncthreads();
    const int n = F.tid >> 3, kc = (F.tid & 7) * 8;
    u32x4 w;
    w.x = cvt_pk_bf16(T[(kc + 0) * 65 + n], T[(kc + 1) * 65 + n]); w.y = cvt_pk_bf16(T[(kc + 2) * 65 + n], T[(kc + 3) * 65 + n]);
    w.z = cvt_pk_bf16(T[(kc + 4) * 65 + n], T[(kc + 5) * 65 + n]); w.w = cvt_pk_bf16(T[(kc + 6) * 65 + n], T[(kc + 7) * 65 + n]);
    *(u32x4*)(dst + (size_t)(n0 + n) * ldd + k0 + kc) = w;
    __syncthreads();
}
__device__ __forceinline__ void cvt_rows(const Ctx& F, const float* src, bf16_t* dst, size_t n8) {
    for (size_t i = (size_t)F.bid * 512 + F.tid; i < n8; i += (size_t)F.G * 512) {
        const f32x4 a = *(const f32x4*)(src + i * 8), b = *(const f32x4*)(src + i * 8 + 4);
        *(u32x4*)(dst + i * 8) = pg8::pack8(a, b); }
}

__device__ __forceinline__ void cvt_rows_fp8(const Ctx& F, const float* src, unsigned char* dst, size_t n16, float scale) {
    for (size_t i = (size_t)F.bid * 512 + F.tid; i < n16; i += (size_t)F.G * 512) {
        u32x4 w;
#pragma unroll
        for (int j = 0; j < 4; ++j) { const f32x4 a = *(const f32x4*)(src + i * 16 + 4 * j) * scale;
            int p = 0; p = __builtin_amdgcn_cvt_pk_fp8_f32(a[0], a[1], p, false); p = __builtin_amdgcn_cvt_pk_fp8_f32(a[2], a[3], p, true); w[j] = (unsigned)p; }
        *(u32x4*)(dst + i * 16) = w; }
}

__device__ __forceinline__ void ph_prologue(const Ctx& F0) {
    const Ctx F = phase_ctx(F0);
    using namespace cf;
    constexpr int T_WIN = 2 * 32 * 224, T_QUP = 2 * 8 * 24, T_KVUP = 2 * 4 * 32, T_BR = 2 * 4 * 16 * 32, T_WO = 2 * 32 * 32;
    constexpr int T_ALL = T_WIN + T_QUP + T_KVUP + T_BR + T_WO;
    for (int u = F.bid; u < T_ALL; u += F.G) {
        int t = u;
        if (t < T_WIN) { const int l = t / (32 * 224), r = t % (32 * 224), kt = r / 224, nt = r % 224;
            tr_tile(F, F.in[I_WIN] + (size_t)l * 2048 * IN_COLS, IN_COLS, 0, kt * 64, WSP(bf16_t, WS_WIN) + (size_t)l * NC * 2048, 2048, nt * 64); continue; }
        t -= T_WIN;
        if (t < T_QUP) { const int l = t / (8 * 24), r = t % (8 * 24), kt = r / 24, nt = r % 24;
            tr_tile(F, F.in[I_WQUP] + (size_t)l * 512 * 1536, 1536, 1, kt * 64, WSP(bf16_t, WS_WQUP) + (size_t)l * 1536 * 512, 512, nt * 64, F.in[I_BQN] + l * 512); continue; }
        t -= T_QUP;
        if (t < T_KVUP) { const int l = t / (4 * 32), r = t % (4 * 32), kt = r / 32, nt = r % 32;
            tr_tile(F, F.in[I_WKVUP] + (size_t)l * 256 * 2048, 2048, 2, kt * 64, WSP(bf16_t, WS_WKVUP) + (size_t)l * 2048 * 256, 256, nt * 64, F.in[I_BKVN] + l * 256); continue; }
        t -= T_KVUP;
        if (t < T_BR) { const int l = t / (4 * 512), r = t % (4 * 512), br = r / 512, r2 = r % 512, kt = r2 / 32, nt = r2 % 32;
            const float* src = (br == 0 ? F.in[I_WBRA] : br == 1 ? F.in[I_WBRB] : br == 2 ? F.in[I_WBRC] : F.in[I_WBRD]) + (size_t)l * 1024 * 2048;
            tr_tile(F, src, 2048, 3, kt * 64, WSP(bf16_t, WS_WBR) + ((size_t)l * 4 + br) * 2048 * 1024, 1024, nt * 64); continue; }
        t -= T_BR;
        { const int l = t / 1024, r = t % 1024, kt = r / 32, nt = r % 32;
            tr_tile(F, F.in[I_WO] + (size_t)l * 2048 * 2048, 2048, 3, kt * 64, WSP(bf16_t, WS_WO) + (size_t)l * 2048 * 2048, 2048, nt * 64); }
    }
    for (int u = F.bid; u < 2 * 16 * 32; u += F.G) {
        const int l = u / 512, g = (u % 512) / 32, d0 = (u % 32) * 64;
        LAS float* sk = (LAS float*)F.lds; LAS float* wt = (LAS float*)(F.lds + 128 * 129 * 4);
        const float* skg = F.in[I_PSK] + ((size_t)l * 16 + g) * 128 * 128;
        const float* wqg = F.in[I_PWQ] + (size_t)l * 2048 * 2048 + (size_t)d0 * 2048 + g * 128;
        for (int i = F.tid; i < 128 * 128; i += 512) sk[(i >> 7) * 129 + (i & 127)] = skg[i];
        for (int i = F.tid; i < 64 * 128; i += 512) wt[(i >> 7) * 129 + (i & 127)] = wqg[(size_t)(i >> 7) * 2048 + (i & 127)];
        __syncthreads();
        const int n = F.tid & 127, dg = F.tid >> 7;
        float a[16];
#pragma unroll
        for (int e = 0; e < 16; ++e) a[e] = 0.f;
        for (int k = 0; k < 128; ++k) { const float s = sk[n * 129 + k];
#pragma unroll
            for (int e = 0; e < 16; ++e) a[e] += wt[(dg * 16 + e) * 129 + k] * s; }
        bf16_t* dst = WSP(bf16_t, WS_WFOLD) + (size_t)l * 2048 * 2048 + (size_t)(g * 128 + n) * 2048 + d0 + dg * 16;
        u32x4 w0, w1;
        w0.x = cvt_pk_bf16(a[0], a[1]); w0.y = cvt_pk_bf16(a[2], a[3]); w0.z = cvt_pk_bf16(a[4], a[5]); w0.w = cvt_pk_bf16(a[6], a[7]);
        w1.x = cvt_pk_bf16(a[8], a[9]); w1.y = cvt_pk_bf16(a[10], a[11]); w1.z = cvt_pk_bf16(a[12], a[13]); w1.w = cvt_pk_bf16(a[14], a[15]);
        *(u32x4*)dst = w0; *(u32x4*)(dst + 8) = w1;
        __syncthreads();
    }
    for (int u = F.bid; u < 2 * 192; u += F.G) {
        const int l = u / 192, n0 = (u % 192) * 64;
        LAS float* sl = (LAS float*)F.lds; LAS float* red = (LAS float*)(F.lds + 5 * 2048 * 4);
        for (int i = F.tid; i < 5 * 2048; i += 512) { const int r = i >> 11, k = i & 2047; const float v = r < 4 ? F.in[I_C][r * 2048 + k] : F.in[I_CCTX][k]; sl[i] = v * sigmoidf_(v); }
        __syncthreads();
        const int col = F.tid & 63, ks = F.tid >> 6;
        float a[5] = {0.f, 0.f, 0.f, 0.f, 0.f};
        const float* wp = F.in[I_WADA] + (size_t)l * 2048 * 12288 + n0 + col;
        for (int k = ks * 256; k < ks * 256 + 256; ++k) { const float w = wp[(size_t)k * 12288];
#pragma unroll
            for (int r = 0; r < 5; ++r) a[r] += sl[r * 2048 + k] * w; }
#pragma unroll
        for (int r = 0; r < 5; ++r) red[(ks * 5 + r) * 64 + col] = a[r];
        __syncthreads();
        if (F.tid < 320) { const int r = F.tid >> 6; float s = 0.f;
#pragma unroll
            for (int k2 = 0; k2 < 8; ++k2) s += red[(k2 * 5 + r) * 64 + col];
            WSP(float, WS_MOD)[((size_t)l * 5 + r) * 12288 + n0 + col] = s + F.in[I_BADA][(size_t)l * 12288 + n0 + col]; }
        __syncthreads();
    }
    for (int i = F.bid * 512 + F.tid; i < 4096 * 64; i += F.G * 512) {
        const int pos = i >> 6, j = i & 63, fi = j & 31; const float fr = powf(10000.0f, -(float)(2 * fi) / 64.0f);
        const float ang = (float)(j < 32 ? (pos >> 6) : (pos & 63)) * fr;
        WSP(float, WS_COSH)[i] = cosf(ang); WSP(float, WS_SINH)[i] = sinf(ang);
    }
    for (int i = F.bid * 512 + F.tid; i < 4096 * 32; i += F.G * 512) {
        const int pos = i >> 5, j = i & 31, fi = j & 15; const float fr = powf(10000.0f, -(float)(2 * fi) / 32.0f);
        const float ang = (float)(j < 16 ? (pos >> 6) : (pos & 63)) * fr;
        WSP(float, WS_COSR)[i] = cosf(ang); WSP(float, WS_SINR)[i] = sinf(ang);
    }
    cvt_rows_fp8(F, F.in[I_PU], WSP(unsigned char, WS_UB), (size_t)2 * NEXP * 2048 / 16, 1024.f);
    cvt_rows_fp8(F, F.in[I_PV], WSP(unsigned char, WS_VB2), (size_t)2 * NEXP * 2048 / 16, 16.f);
}

__device__ __forceinline__ void ph_modulate0(const Ctx& F0) {
    const Ctx F = phase_ctx(F0);
    using namespace cf;
    const float* mod = WSP(float, WS_MOD);
    for (size_t i = (size_t)F.bid * 512 + F.tid; i < (size_t)MR * 256; i += (size_t)F.G * 512) {
        const int R = (int)(i >> 8), d = (int)(i & 255) * 8, b = R / RB, j = R % RB;
        const float* src = j < CTX ? F.in[I_CTX] + ((size_t)b * CTX + j) * 2048 : F.in[I_X] + ((size_t)b * S + (j - CTX)) * 2048;
        const float* m = mod + (size_t)(j < CTX ? 4 : b) * 12288;
        const f32x4 x0 = *(const f32x4*)(src + d), x1 = *(const f32x4*)(src + d + 4);
        const f32x4 sh0 = *(const f32x4*)(m + d), sh1 = *(const f32x4*)(m + d + 4), s0 = *(const f32x4*)(m + 2048 + d), s1 = *(const f32x4*)(m + 2048 + d + 4);
        *(u32x4*)(WSP(bf16_t, WS_HB) + (size_t)R * 2048 + d) = pg8::pack8(x0 * (s0 + 1.0f) + sh0, x1 * (s1 + 1.0f) + sh1);
    }
}

__device__ __forceinline__ void knorm_pass(const Ctx& F) {
    using namespace cf;
    bf16_t* P = WSP(bf16_t, WS_P); const float* ssk = WSP(const float, WS_SSK);
    for (int it = F.bid * 8 + F.wave; it < MR * 2; it += F.G * 8) {
        const int R = it >> 1, h = it & 1;
        const f32x2 pp = *(const f32x2*)(ssk + (size_t)it * 2); const float r = rsqrtf((pp.x + pp.y) * (1.f / 128.f) + 1e-6f);
        unsigned* q = (unsigned*)(P + (size_t)R * NC + PC_AK + h * 128) + F.lane;
        const unsigned w = *q; *q = cvt_pk_bf16(bflo(w) * r, bfhi(w) * r);
    }
}

struct AttnArgs {
    const bf16_t* Q; const bf16_t* K; const bf16_t* V; bf16_t* O; int ldq, ldk, ldv, ldo;
    int seg0_row, seg0_tiles, seg1_row, seg1_tiles;
    int mask_on, qpos0, kpos1;
    float sc_log2; int has_sink; float sink_l2;
    const float* qss;
};
typedef float f32x16 __attribute__((ext_vector_type(16)));
template <int DK>
__device__ __forceinline__ void attn_unit(ldsp_t lds, const AttnArgs a) {
    constexpr int ND = DK / 16, KST = DK + 8, KCH = DK / 8, KPT = (64 * KCH) / 512, VST = 72;
    constexpr int KBUF = 64 * KST * 2, VBUF = 128 * VST * 2, VOFF = 2 * KBUF, ALOFF = VOFF + 2 * VBUF;
    int tid = threadIdx.x; asm volatile("" : "+v"(tid));
    const int wid = __builtin_amdgcn_readfirstlane(tid >> 6), lane = tid & 63, q32 = lane & 31, hi = lane >> 5;
    LAS float* al = (LAS float*)(lds + ALOFF + wid * 128);
    bf16x8 qf[ND];
    { const bf16_t* qrow = a.Q + (size_t)(wid * 32 + q32) * a.ldq + 8 * hi;
#pragma unroll
      for (int s = 0; s < ND; ++s) qf[s] = *(const bf16x8*)(qrow + 16 * s); }
    f32x16 o[4];
#pragma unroll
    for (int db = 0; db < 4; ++db)
#pragma unroll
        for (int r = 0; r < 16; ++r) o[db][r] = 0.f;
    float m_run = -1e30f, l_run = 0.f;
    float scq = a.sc_log2;
    if (a.qss) { const f32x2 pp = *(const f32x2*)(a.qss + (size_t)(wid * 32 + q32) * 16); scq *= rsqrtf((pp.x + pp.y) * (1.f / 128.f) + 1e-6f); }
    const int ntiles = a.seg0_tiles + a.seg1_tiles;
    u32x4 kreg[KPT], vreg[2];
    const int vkp = tid & 31, vdc = tid >> 5;
    const int vkey = 2 * vkp, vpos = (vkey & 48) | ((vkey & 4) << 1) | ((vkey & 8) >> 1) | (vkey & 3);
#define ATT_LOAD(tt) do { const int _r0 = (tt) < a.seg0_tiles ? a.seg0_row + 64 * (tt) : a.seg1_row + 64 * ((tt) - a.seg0_tiles); \
        _Pragma("unroll") for (int _i = 0; _i < KPT; ++_i) { const int _c = tid + 512 * _i; kreg[_i] = *(const u32x4*)(a.K + (size_t)(_r0 + _c / KCH) * a.ldk + 8 * (_c % KCH)); } \
        vreg[0] = *(const u32x4*)(a.V + (size_t)(_r0 + 2 * vkp) * a.ldv + 8 * vdc); vreg[1] = *(const u32x4*)(a.V + (size_t)(_r0 + 2 * vkp + 1) * a.ldv + 8 * vdc); } while (0)
#define ATT_WRITE(buf) do { const ldsp_t _kb = lds + (buf) * KBUF; const ldsp_t _vb = lds + VOFF + (buf) * VBUF; \
        _Pragma("unroll") for (int _i = 0; _i < KPT; ++_i) { const int _c = tid + 512 * _i; *(LAS u32x4*)(_kb + ((_c / KCH) * KST + 8 * (_c % KCH)) * 2) = kreg[_i]; } \
        const unsigned _a0[4] = {vreg[0].x, vreg[0].y, vreg[0].z, vreg[0].w}, _a1[4] = {vreg[1].x, vreg[1].y, vreg[1].z, vreg[1].w}; \
        _Pragma("unroll") for (int _e = 0; _e < 4; ++_e) { \
            *(LAS unsigned*)(_vb + ((8 * vdc + 2 * _e) * VST + vpos) * 2) = (_a0[_e] & 0xffffu) | (_a1[_e] << 16); \
            *(LAS unsigned*)(_vb + ((8 * vdc + 2 * _e + 1) * VST + vpos) * 2) = (_a0[_e] >> 16) | (_a1[_e] & 0xffff0000u); } } while (0)
    ATT_LOAD(0);
    ATT_WRITE(0);
    __syncthreads();
    for (int tt = 0; tt < ntiles; ++tt) {
        const int cur = tt & 1;
        if (tt + 1 < ntiles) ATT_LOAD(tt + 1);
        const ldsp_t Ks = lds + cur * KBUF, Vt = lds + VOFF + cur * VBUF;
        f32x16 s0, s1;
#pragma unroll
        for (int r = 0; r < 16; ++r) { s0[r] = 0.f; s1[r] = 0.f; }
#pragma unroll
        for (int s = 0; s < ND; ++s) {
            const bf16x8 k0 = *(const LAS bf16x8*)(Ks + (q32 * KST + 16 * s + 8 * hi) * 2), k1 = *(const LAS bf16x8*)(Ks + ((32 + q32) * KST + 16 * s + 8 * hi) * 2);
            s0 = __builtin_amdgcn_mfma_f32_32x32x16_bf16(k0, qf[s], s0, 0, 0, 0);
            s1 = __builtin_amdgcn_mfma_f32_32x32x16_bf16(k1, qf[s], s1, 0, 0, 0); }
        const bool msk = a.mask_on && tt >= a.seg0_tiles;
        const int kp0 = a.kpos1 + 64 * (tt - a.seg0_tiles) + 4 * hi, qp = a.qpos0 + wid * 32 + q32;
        float mx = -1e30f;
#pragma unroll
        for (int r = 0; r < 16; ++r) { float t0 = s0[r] * scq, t1 = s1[r] * scq;
            if (msk) { const int d0 = qp - (kp0 + (r & 3) + 8 * (r >> 2)), d1 = d0 - 32; if (d0 > 128 || d0 < -128) t0 = -1e30f; if (d1 > 128 || d1 < -128) t1 = -1e30f; }
            s0[r] = t0; s1[r] = t1; mx = fmaxf(mx, fmaxf(t0, t1)); }
        mx = fmaxf(mx, __shfl_xor(mx, 32));
        const float m_new = fmaxf(m_run, mx), alpha = __builtin_amdgcn_exp2f(m_run - m_new); m_run = m_new;
        float ps = 0.f;
#pragma unroll
        for (int r = 0; r < 16; ++r) { s0[r] = __builtin_amdgcn_exp2f(s0[r] - m_new); s1[r] = __builtin_amdgcn_exp2f(s1[r] - m_new); ps += s0[r] + s1[r]; }
        l_run = l_run * alpha + ps;
        if (__any(alpha < 1.0f)) {
            if (hi == 0) al[q32] = alpha;
            asm volatile("s_waitcnt lgkmcnt(0)" ::: "memory");
#pragma unroll
            for (int g4 = 0; g4 < 4; ++g4) { const f32x4 av = *(const LAS f32x4*)(al + 8 * g4 + 4 * hi);
#pragma unroll
                for (int db = 0; db < 4; ++db)
#pragma unroll
                    for (int j = 0; j < 4; ++j) o[db][4 * g4 + j] *= av[j]; }
        }
        bf16x8 pa[4];
#pragma unroll
        for (int g2 = 0; g2 < 2; ++g2) {
            u32x4 w; w.x = cvt_pk_bf16(s0[8 * g2 + 0], s0[8 * g2 + 1]); w.y = cvt_pk_bf16(s0[8 * g2 + 2], s0[8 * g2 + 3]); w.z = cvt_pk_bf16(s0[8 * g2 + 4], s0[8 * g2 + 5]); w.w = cvt_pk_bf16(s0[8 * g2 + 6], s0[8 * g2 + 7]); pa[g2] = *(bf16x8*)&w;
            u32x4 v; v.x = cvt_pk_bf16(s1[8 * g2 + 0], s1[8 * g2 + 1]); v.y = cvt_pk_bf16(s1[8 * g2 + 2], s1[8 * g2 + 3]); v.z = cvt_pk_bf16(s1[8 * g2 + 4], s1[8 * g2 + 5]); v.w = cvt_pk_bf16(s1[8 * g2 + 6], s1[8 * g2 + 7]); pa[2 + g2] = *(bf16x8*)&v; }
#pragma unroll
        for (int db = 0; db < 4; ++db)
#pragma unroll
            for (int ks = 0; ks < 4; ++ks) { const bf16x8 vf = *(const LAS bf16x8*)(Vt + ((32 * db + q32) * VST + 16 * ks + 8 * hi) * 2);
                o[db] = __builtin_amdgcn_mfma_f32_32x32x16_bf16(pa[ks], vf, o[db], 0, 0, 0); }
        if (tt + 1 < ntiles) ATT_WRITE(cur ^ 1);
        __syncthreads();
    }
#undef ATT_LOAD
#undef ATT_WRITE
    float l_tot = l_run + __shfl_xor(l_run, 32);
    if (a.has_sink) l_tot += __builtin_amdgcn_exp2f(a.sink_l2 - m_run);
    if (hi == 0) al[q32] = 1.0f / l_tot;
    asm volatile("s_waitcnt lgkmcnt(0)" ::: "memory");
    const ldsp_t Ost = lds + wid * 8192;
#pragma unroll
    for (int g4 = 0; g4 < 4; ++g4) { const f32x4 iv = *(const LAS f32x4*)(al + 8 * g4 + 4 * hi);
#pragma unroll
        for (int db = 0; db < 4; ++db)
#pragma unroll
            for (int j = 0; j < 4; ++j) *(LAS bf16_t*)(Ost + ((8 * g4 + 4 * hi + j) * 128 + 32 * db + q32) * 2) = f2bf(o[db][4 * g4 + j] * iv[j]); }
    asm volatile("s_waitcnt lgkmcnt(0)" ::: "memory");
#pragma unroll
    for (int i = 0; i < 8; ++i) { const int c = lane + 64 * i, row = c >> 4, c8 = c & 15;
        *(u32x4*)(a.O + (size_t)(wid * 32 + row) * a.ldo + 8 * c8) = *(const LAS u32x4*)(Ost + (row * 128 + 8 * c8) * 2); }
}

__device__ __forceinline__ void conv_unit(const Ctx& F, int layer, int row0  , int seq_len, int t0) {
    using namespace cf;
    const bf16_t* P = WSP(const bf16_t, WS_P); bf16_t* BR = WSP(bf16_t, WS_BR);
    const float* cw = F.in[I_CW] + (size_t)layer * 31 * 1024; const float* cb = F.in[I_CB] + layer * 1024;
    const float* lg = F.in[I_CLG] + layer * 1024; const float* lb = F.in[I_CLB] + layer * 1024;
    int tid = F.tid; asm volatile("" : "+v"(tid));
    const int lane = tid & 63;
    LAS float* red = (LAS float*)(F.lds + 126976); LAS float* tot = red + 8 * 32;
    __syncthreads();
    for (int c = tid; c < 62 * 128; c += 512) { const int rr = c >> 7, ch = c & 127, t = t0 - 15 + rr;
        u32x4 v = {0u, 0u, 0u, 0u};
        if (t >= 0 && t < seq_len) v = *(const u32x4*)(P + (size_t)(row0 + t) * NC + PC_GLU + ch * 8);
        *(LAS u32x4*)(F.lds + rr * 2048 + ch * 16) = v; }
    float w0[31], w1[31];
#pragma unroll
    for (int k = 0; k < 31; ++k) { const f32x2 w = *(const f32x2*)(cw + k * 1024 + 2 * tid); w0[k] = w.x; w1[k] = w.y; }
    const f32x2 bv = *(const f32x2*)(cb + 2 * tid), gg = *(const f32x2*)(lg + 2 * tid), bb = *(const f32x2*)(lb + 2 * tid);
    __syncthreads();
#pragma unroll 1
    for (int part = 0; part < 4; ++part) {
        float a0[8], a1[8];
#pragma unroll
        for (int t = 0; t < 8; ++t) { a0[t] = bv.x; a1[t] = bv.y; }
        const ldsp_t base = F.lds + part * 8 * 2048 + tid * 4;
#pragma unroll
        for (int rr = 0; rr < 38; ++rr) { const unsigned xw = *(const LAS unsigned*)(base + rr * 2048); const float x0 = bflo(xw), x1 = bfhi(xw);
#pragma unroll
            for (int t = 0; t < 8; ++t) { const int k = rr - t; if (k >= 0 && k <= 30) { a0[t] += x0 * w0[k]; a1[t] += x1 * w1[k]; } } }
        float v[16];
#pragma unroll
        for (int t = 0; t < 8; ++t) { v[t] = a0[t] + a1[t]; v[8 + t] = a0[t] * a0[t] + a1[t] * a1[t]; }
#pragma unroll
        for (int i = 0; i < 8; ++i) { const bool up = lane & 32; const float snd = up ? v[i] : v[i + 8], kp = up ? v[i + 8] : v[i]; v[i] = kp + __shfl_xor(snd, 32); }
#pragma unroll
        for (int i = 0; i < 4; ++i) { const bool up = lane & 16; const float snd = up ? v[i] : v[i + 4], kp = up ? v[i + 4] : v[i]; v[i] = kp + __shfl_xor(snd, 16); }
#pragma unroll
        for (int i = 0; i < 2; ++i) { const bool up = lane & 8; const float snd = up ? v[i] : v[i + 2], kp = up ? v[i + 2] : v[i]; v[i] = kp + __shfl_xor(snd, 8); }
        { const bool up = lane & 4; const float snd = up ? v[0] : v[1], kp = up ? v[1] : v[0]; v[0] = kp + __shfl_xor(snd, 4); }
        v[0] += __shfl_xor(v[0], 2); v[0] += __shfl_xor(v[0], 1);
        if ((lane & 3) == 0) red[F.wave * 16 + (lane >> 2)] = v[0];
        __syncthreads();
        if (tid < 16) { float s = 0.f;
#pragma unroll
            for (int w = 0; w < 8; ++w) s += red[w * 16 + tid];
            tot[tid] = s; }
        __syncthreads();
#pragma unroll
        for (int t = 0; t < 8; ++t) { const float mean = tot[t] * (1.f / 1024.f), var = fmaxf(tot[8 + t] * (1.f / 1024.f) - mean * mean, 0.f), rstd = rsqrtf(var + 1e-5f);
            const float y0 = (a0[t] - mean) * rstd * gg.x + bb.x, y1 = (a1[t] - mean) * rstd * gg.y + bb.y;
            *(unsigned*)(BR + (size_t)(row0 + t0 + part * 8 + t) * 4096 + 2048 + 2 * tid) = cvt_pk_bf16(y0 * sigmoidf_(y0), y1 * sigmoidf_(y1)); }
    }
}

__device__ __forceinline__ void attn_defaults(AttnArgs& a, int isctx) {
    a.seg0_row = 0; a.seg0_tiles = isctx ? 4 : 68; a.seg1_row = 0; a.seg1_tiles = 0; a.mask_on = 0; a.qpos0 = 0; a.kpos1 = 0; a.has_sink = 0; a.sink_l2 = 0.f; a.qss = nullptr; }
__device__ __forceinline__ void ph_attn(const Ctx& F0, int layer) {
    const Ctx F = phase_ctx(F0);
    using namespace cf;
    const bf16_t* P = WSP(const bf16_t, WS_P); bf16_t* BR = WSP(bf16_t, WS_BR);
    for (int dup = 0; dup < DUPN(2); ++dup)
    for (int u = F.bid; u < (layer == 0 ? 544 : 512); u += F.G) {
        int b, h, qb, isctx = 0;
        if (u < 512) { b = u >> 7; h = (u >> 4) & 7; qb = u & 15; } else { const int r = u - 512; b = r >> 3; h = r & 7; qb = 0; isctx = 1; }
        const size_t brow = (size_t)b * RB, qrow = brow + (isctx ? 0 : CTX) + (size_t)qb * 256;
        AttnArgs a; attn_defaults(a, isctx);
        a.Q = WSP(const bf16_t, WS_QB) + qrow * 1536 + h * 192; a.ldq = 1536;
        a.K = WSP(const bf16_t, WS_KB) + brow * 1536 + h * 192; a.ldk = 1536;
        a.V = WSP(const bf16_t, WS_VB) + brow * 1024 + h * 128; a.ldv = 1024;
        a.O = BR + qrow * 4096 + 1024 + h * 128; a.ldo = 4096; a.sc_log2 = SCALE_MLA * LOG2E;
        __syncthreads();
        attn_unit<192>(F.lds, a);
    }
    for (int dup = 0; dup < DUPN(3); ++dup)
    for (int u0 = F.bid; u0 < (layer == 0 ? 1088 : 1024); u0 += F.G) {
        int kind, b, h, qb, isctx = 0;
        if (u0 < 1024) { kind = 1 + (u0 >> 9); const int r = u0 & 511; b = r >> 7; h = (r >> 4) & 7; qb = r & 15; }
        else { const int r = u0 - 1024; kind = 1 + (r >> 5); const int r2 = r & 31; b = r2 >> 3; h = r2 & 7; qb = 0; isctx = 1; }
        const size_t brow = (size_t)b * RB, qrow = brow + (isctx ? 0 : CTX) + (size_t)qb * 256;
        AttnArgs a; attn_defaults(a, isctx);
        const int qc = kind == 1 ? PC_AQ : PC_DQ, kc = kind == 1 ? PC_AK : PC_DK, vc = kind == 1 ? PC_AV : PC_DV;
        a.Q = P + qrow * NC + qc + h * 128; a.ldq = NC;
        a.K = P + brow * NC + kc + (h >> 2) * 128; a.ldk = NC;
        a.V = P + brow * NC + vc + (h >> 2) * 128; a.ldv = NC;
        a.O = BR + qrow * 4096 + (kind == 1 ? 0 : 3072) + h * 128; a.ldo = 4096; a.sc_log2 = SCALE_HD * LOG2E;
        if (kind == 1) a.qss = WSP(const float, WS_SSQ) + qrow * 16 + h * 2;
        if (kind == 2) { a.has_sink = 1; a.sink_l2 = F.in[I_SINK][layer * 8 + h] * LOG2E; a.seg0_tiles = 4;
            if (!isctx) { const int start = qb * 256; const int lo = start - 128 < 0 ? 0 : start - 128, hi = start + 384 > S ? S : start + 384;
                a.seg1_row = CTX + lo; a.seg1_tiles = (hi - lo) / 64; a.mask_on = 1; a.qpos0 = start; a.kpos1 = lo; } }
        __syncthreads();
        attn_unit<128>(F.lds, a);
    }
    for (int dup = 0; dup < DUPN(4); ++dup)
    for (int u = F.bid; u < (layer == 0 ? 544 : 512); u += F.G) {
        int b, tb, isctx = 0;
        if (u < 512) { b = u >> 7; tb = u & 127; } else { const int r = u - 512; b = r >> 3; tb = r & 7; isctx = 1; }
        conv_unit(F, layer, b * RB + (isctx ? 0 : CTX), isctx ? CTX : S, tb * 32);
    }
}

__device__ __forceinline__ int tok_row(int layer, int tok) { return layer == 0 ? tok : (tok >> 12) * cf::RB + cf::CTX + (tok & 4095); }
__device__ __forceinline__ void ph_ln1(const Ctx& F0, int layer) {
    const Ctx F = phase_ctx(F0);
    using namespace cf;
    float* X1 = (float*)(F.ws + WS_P + X1_OFF); bf16_t* HB = WSP(bf16_t, WS_HB);
    const float* lg = F.in[I_LN1G] + layer * 2048; const float* lb = F.in[I_LN1B] + layer * 2048;
    const int ntok = layer == 0 ? MR : NB * S, lane = F.lane;
    for (int tok = F.bid * 8 + F.wave; tok < ntok; tok += F.G * 8) {
        const int R = tok_row(layer, tok), b = R / RB, j = R % RB;
        const float* mod = WSP(const float, WS_MOD) + ((size_t)layer * 5 + (j < CTX ? 4 : b)) * 12288;
        float* xp = X1 + (size_t)R * 2048;
        f32x4 v[8]; float s = 0.f;
#pragma unroll
        for (int i = 0; i < 8; ++i) { v[i] = *(const f32x4*)(xp + lane * 4 + 256 * i); s += (v[i][0] + v[i][1]) + (v[i][2] + v[i][3]); }
        const float mean = wave_sum(s) * (1.f / 2048.f); float q = 0.f;
#pragma unroll
        for (int i = 0; i < 8; ++i) { const f32x4 d = v[i] - mean; q += (d[0] * d[0] + d[1] * d[1]) + (d[2] * d[2] + d[3] * d[3]); }
        const float rstd = rsqrtf(wave_sum(q) * (1.f / 2048.f) + 1e-5f);
#pragma unroll
        for (int i = 0; i < 8; ++i) { const int c = lane * 4 + 256 * i;
            const f32x4 y = (v[i] - mean) * rstd * *(const f32x4*)(lg + c) + *(const f32x4*)(lb + c);
            *(f32x4*)(xp + c) = y;
            const f32x4 hp = y * (*(const f32x4*)(mod + 4 * 2048 + c) + 1.0f) + *(const f32x4*)(mod + 3 * 2048 + c);
            u32x2 w; w.x = cvt_pk_bf16(hp[0], hp[1]); w.y = cvt_pk_bf16(hp[2], hp[3]);
            *(u32x2*)(HB + (size_t)R * 2048 + c) = w; }
    }
}

typedef __bf16 bf16x2_t __attribute__((ext_vector_type(2)));
__device__ __forceinline__ unsigned ordkey(float v) { const unsigned u = __float_as_uint(v); return (u & 0x80000000u) ? ~u : (u | 0x80000000u); }
__device__ __forceinline__ int lane_rank(unsigned long long m) { return (int)__builtin_amdgcn_mbcnt_hi((unsigned)(m >> 32), __builtin_amdgcn_mbcnt_lo((unsigned)m, 0u)); }
template <int NV> __device__ __forceinline__ unsigned radix_thresh16(const unsigned (&k)[NV]) {
    unsigned T = 0u;
    for (int bit = 31; bit >= 0; --bit) { const unsigned cand = T | (1u << bit); int cnt = 0;
#pragma unroll
        for (int v = 0; v < NV; ++v) cnt += __popcll(__ballot(k[v] >= cand));
        if (cnt >= 16) T = cand; }
    return T;
}
__device__ __forceinline__ float dot2bf(unsigned a, unsigned b, float acc) { return __builtin_amdgcn_fdot2_f32_bf16(__builtin_bit_cast(bf16x2_t, a), __builtin_bit_cast(bf16x2_t, b), acc, false); }
__device__ __forceinline__ float dot8(const u32x4 a, const u32x4 b, float acc) {
    acc = dot2bf(a.x, b.x, acc); acc = dot2bf(a.y, b.y, acc); acc = dot2bf(a.z, b.z, acc); acc = dot2bf(a.w, b.w, acc);
    return acc;
}
__device__ __forceinline__ void ph_peer(const Ctx& F0, int layer) {
    const Ctx F = phase_ctx(F0);
    using namespace cf;
    const float* SC = (const float*)(F.ws + WS_P + SC_OFF); const float* X1 = (const float*)(F.ws + WS_P + X1_OFF);
    bf16_t* HB = WSP(bf16_t, WS_HB); const unsigned char* U8 = WSP(const unsigned char, WS_UB) + (size_t)layer * NEXP * 2048; const unsigned char* V8 = WSP(const unsigned char, WS_VB2) + (size_t)layer * NEXP * 2048;
    const float* lg = F.in[I_LN2G] + layer * 2048; const float* lb = F.in[I_LN2B] + layer * 2048;
    const int ntok = layer == 0 ? MR : NB * S, lane = F.lane;
    ldsp_t wl = F.lds + F.wave * 4096;
    LAS float* tv0 = (LAS float*)wl; LAS int* ti0 = (LAS int*)(wl + 64); LAS float* tv1 = (LAS float*)(wl + 128); LAS int* ti1 = (LAS int*)(wl + 192);
    LAS float* es = (LAS float*)(wl + 256); LAS int* ei = (LAS int*)(wl + 768); LAS float* eg = (LAS float*)(wl + 1280);
    for (int tok = F.bid * 8 + F.wave; tok < ntok; tok += F.G * 8) {
        const int R = tok_row(layer, tok), b = R / RB, j = R % RB; const bool isctx = j < CTX; const int modrow = isctx ? 4 : b;
        const float* sc = SC + (size_t)R * 2048;
        for (int h = 0; h < 8; ++h) {
            const float s0a = sc[(2 * h) * 128 + lane], s0b = sc[(2 * h) * 128 + 64 + lane], s1a = sc[(2 * h + 1) * 128 + lane], s1b = sc[(2 * h + 1) * 128 + 64 + lane];
            { const unsigned k[2] = {(ordkey(s0a) & ~127u) | (unsigned)(127 - lane), (ordkey(s0b) & ~127u) | (unsigned)(63 - lane)};
              const unsigned T = radix_thresh16<2>(k);
              const unsigned long long m0 = __ballot(k[0] >= T), m1 = __ballot(k[1] >= T); const int n0 = __popcll(m0);
              if (k[0] >= T) { const int r = lane_rank(m0); tv0[r] = s0a; ti0[r] = lane; }
              if (k[1] >= T) { const int r = n0 + lane_rank(m1); tv0[r] = s0b; ti0[r] = lane + 64; } }
            { const unsigned k[2] = {(ordkey(s1a) & ~127u) | (unsigned)(127 - lane), (ordkey(s1b) & ~127u) | (unsigned)(63 - lane)};
              const unsigned T = radix_thresh16<2>(k);
              const unsigned long long m0 = __ballot(k[0] >= T), m1 = __ballot(k[1] >= T); const int n0 = __popcll(m0);
              if (k[0] >= T) { const int r = lane_rank(m0); tv1[r] = s1a; ti1[r] = lane; }
              if (k[1] >= T) { const int r = n0 + lane_rank(m1); tv1[r] = s1b; ti1[r] = lane + 64; } }
            asm volatile("s_waitcnt lgkmcnt(0)" ::: "memory");
            const int ci = lane >> 2, cj = (lane & 3) * 4;
            const float a0 = tv0[ci]; const int i0 = ti0[ci];
            float c4[4]; int id4[4]; unsigned kc[4];
#pragma unroll
            for (int jj = 0; jj < 4; ++jj) { c4[jj] = a0 + tv1[cj + jj]; id4[jj] = i0 * 128 + ti1[cj + jj]; kc[jj] = (ordkey(c4[jj]) & ~255u) | (unsigned)(255 - (lane * 4 + jj)); }
            const unsigned Tc = radix_thresh16<4>(kc);
            int base = h * 16;
#pragma unroll
            for (int jj = 0; jj < 4; ++jj) { const unsigned long long m = __ballot(kc[jj] >= Tc);
                if (kc[jj] >= Tc) { const int r = base + lane_rank(m); es[r] = c4[jj]; ei[r] = id4[jj]; }
                base += __popcll(m); }
            asm volatile("s_waitcnt lgkmcnt(0)" ::: "memory");
        }
#pragma unroll
        for (int rnd = 0; rnd < 2; ++rnd) { const int e = lane + 64 * rnd; const float s = es[e];
            float m = s; m = fmaxf(m, __shfl_xor(m, 1)); m = fmaxf(m, __shfl_xor(m, 2)); m = fmaxf(m, __shfl_xor(m, 4)); m = fmaxf(m, __shfl_xor(m, 8));
            const float ex = __expf(s - m); float sum = ex; sum += __shfl_xor(sum, 1); sum += __shfl_xor(sum, 2); sum += __shfl_xor(sum, 4); sum += __shfl_xor(sum, 8);
            eg[e] = ex / sum; }
        asm volatile("s_waitcnt lgkmcnt(0)" ::: "memory");
        f32x2 xf[16];
#pragma unroll
        for (int i = 0; i < 2; ++i)
#pragma unroll
            for (int hh = 0; hh < 2; ++hh) { const u32x4 w = *(const u32x4*)(HB + (size_t)R * 2048 + lane * 16 + 1024 * i + 8 * hh);
                xf[8 * i + 4 * hh + 0] = (f32x2){bflo(w.x), bfhi(w.x)}; xf[8 * i + 4 * hh + 1] = (f32x2){bflo(w.y), bfhi(w.y)};
                xf[8 * i + 4 * hh + 2] = (f32x2){bflo(w.z), bfhi(w.z)}; xf[8 * i + 4 * hh + 3] = (f32x2){bflo(w.w), bfhi(w.w)}; }
        f32x2 y2[16];
#pragma unroll
        for (int i = 0; i < 16; ++i) y2[i] = (f32x2){0.f, 0.f};
        for (int grp = 0; grp < 32; ++grp) {
            int id[4]; float gq[4];
#pragma unroll
            for (int q = 0; q < 4; ++q) { id[q] = __builtin_amdgcn_readfirstlane(ei[grp * 4 + q]); gq[q] = __uint_as_float(__builtin_amdgcn_readfirstlane(__float_as_uint(eg[grp * 4 + q]))); }
            u32x4 ur[4][2], vr[4][2];
#pragma unroll
            for (int q = 0; q < 4; ++q)
#pragma unroll
                for (int i = 0; i < 2; ++i) { ur[q][i] = *(const u32x4*)(U8 + (size_t)id[q] * 2048 + lane * 16 + 1024 * i); vr[q][i] = *(const u32x4*)(V8 + (size_t)id[q] * 2048 + lane * 16 + 1024 * i); }
            float d[4];
#pragma unroll
            for (int q = 0; q < 4; ++q) { f32x2 t = {0.f, 0.f};
#pragma unroll
                for (int i = 0; i < 2; ++i)
#pragma unroll
                    for (int j = 0; j < 4; ++j) { const int w = (int)ur[q][i][j];
                        t += __builtin_amdgcn_cvt_pk_f32_fp8(w, false) * xf[8 * i + 2 * j]; t += __builtin_amdgcn_cvt_pk_f32_fp8(w, true) * xf[8 * i + 2 * j + 1]; }
                d[q] = t.x + t.y; }
#pragma unroll
            for (int o = 32; o >= 1; o >>= 1) {
#pragma unroll
                for (int q = 0; q < 4; ++q) d[q] += __shfl_xor(d[q], o); }
#pragma unroll
            for (int q = 0; q < 4; ++q) { const float dd = d[q] * (1.0f / 1024.0f); const float w = gq[q] * 0.5f * dd * (1.0f + erff(dd * 0.70710678118654752f)) * (1.0f / 16.0f);
                const f32x2 w2 = {w, w};
#pragma unroll
                for (int i = 0; i < 2; ++i)
#pragma unroll
                    for (int j = 0; j < 4; ++j) { const int vw = (int)vr[q][i][j];
                        y2[8 * i + 2 * j] += w2 * __builtin_amdgcn_cvt_pk_f32_fp8(vw, false); y2[8 * i + 2 * j + 1] += w2 * __builtin_amdgcn_cvt_pk_f32_fp8(vw, true); } }
        }
        const float* mod = WSP(const float, WS_MOD) + ((size_t)layer * 5 + modrow) * 12288;
        float y[32];
        float s = 0.f;
#pragma unroll
        for (int i = 0; i < 2; ++i)
#pragma unroll
            for (int j = 0; j < 4; ++j) { const int c = lane * 16 + 1024 * i + 4 * j;
                const f32x4 xa = *(const f32x4*)(X1 + (size_t)R * 2048 + c), ga = *(const f32x4*)(mod + 5 * 2048 + c);
                y[16 * i + 4 * j + 0] = ALPHA * xa[0] + ga[0] * y2[8 * i + 2 * j].x; y[16 * i + 4 * j + 1] = ALPHA * xa[1] + ga[1] * y2[8 * i + 2 * j].y;
                y[16 * i + 4 * j + 2] = ALPHA * xa[2] + ga[2] * y2[8 * i + 2 * j + 1].x; y[16 * i + 4 * j + 3] = ALPHA * xa[3] + ga[3] * y2[8 * i + 2 * j + 1].y;
                s += (y[16 * i + 4 * j + 0] + y[16 * i + 4 * j + 1]) + (y[16 * i + 4 * j + 2] + y[16 * i + 4 * j + 3]); }
        const float mean = wave_sum(s) * (1.f / 2048.f); float q2 = 0.f;
#pragma unroll
        for (int i = 0; i < 32; ++i) { const float dd = y[i] - mean; q2 += dd * dd; }
        const float rstd = rsqrtf(wave_sum(q2) * (1.f / 2048.f) + 1e-5f);
        float* dst = layer == 0 ? (isctx ? WSP(float, WS_XC) + ((size_t)b * CTX + j) * 2048 : F.out + ((size_t)b * S + (j - CTX)) * 2048) : F.out + ((size_t)b * S + (j - CTX)) * 2048;
        const float* modn = WSP(const float, WS_MOD) + ((size_t)1 * 5 + modrow) * 12288;
#pragma unroll
        for (int i = 0; i < 2; ++i)
#pragma unroll
            for (int hh = 0; hh < 2; ++hh) { f32x4 o[2];
#pragma unroll
                for (int jj = 0; jj < 2; ++jj) { const int j = 2 * hh + jj, c = lane * 16 + 1024 * i + 4 * j; const f32x4 la = *(const f32x4*)(lg + c), ba = *(const f32x4*)(lb + c);
#pragma unroll
                    for (int e = 0; e < 4; ++e) o[jj][e] = (y[16 * i + 4 * j + e] - mean) * rstd * la[e] + ba[e];
                    *(f32x4*)(dst + c) = o[jj]; }
                if (layer == 0) {
                    const int c = lane * 16 + 1024 * i + 8 * hh;
                    const f32x4 sa = *(const f32x4*)(modn + 2048 + c), sb = *(const f32x4*)(modn + 2048 + c + 4), ha = *(const f32x4*)(modn + c), hb = *(const f32x4*)(modn + c + 4);
                    *(u32x4*)(HB + (size_t)R * 2048 + c) = pg8::pack8(o[0] * (sa + 1.0f) + ha, o[1] * (sb + 1.0f) + hb); } }
    }
}

struct Params { const float* in[cf::N_IN]; float* out; unsigned char* ws; int ph_lo, ph_hi; };

__global__ void __launch_bounds__(512, 2) mega_fwd(Params p) {
    using namespace cf;
    extern __shared__ __attribute__((aligned(16))) unsigned char smem[];
    Ctx F0;
    F0.in = p.in;
    F0.out = p.out; F0.ws = p.ws; F0.lds = (ldsp_t)smem;
    F0.tid = threadIdx.x; F0.lane = F0.tid & 63; F0.wave = __builtin_amdgcn_readfirstlane(F0.tid >> 6); F0.G = gridDim.x; F0.bid = blockIdx.x;
    if (F0.tid < 64) ((LAS unsigned*)(F0.lds + MISC_OFF))[F0.tid] = 0u;
    __syncthreads();
    const int lo = p.ph_lo, hi = p.ph_hi;
    XcdBarrier bar; bar.bar = (unsigned*)(F0.ws + WS_CTL); bar.x = 0; bar.st = (volatile LAS unsigned*)(F0.lds + MISC_OFF);
    if (hi - lo > 1) bar = xcd_barrier_post((unsigned*)(F0.ws + WS_CTL), (volatile LAS unsigned*)(F0.lds + MISC_OFF));
#ifndef MK_MASK
#define MK_MASK 0xFFFF
#endif
#define ON(j) ((MK_MASK >> (j)) & 1)
#define IN(k) (lo <= (k) && (k) < hi)
#define SEAM(k) do { if (IN(k) && IN((k) + 1)) xcd_barrier(bar); } while (0)

    if (ON(9) && IN(0)) { ph_prologue(F0); if (DUPN(9) == 2) { __syncthreads(); ph_prologue(F0); } }
    SEAM(0);
    if (ON(10) && IN(1)) ph_modulate0(F0);
    SEAM(1);
    for (int l = 0; l < DEPTH; ++l) {
        const int pb = 2 + 8 * l;
        const int rmode = l == 0 ? 0 : 1, nMl = l == 0 ? 68 : 64;
        for (int blk = 0; blk < DUPN(12); ++blk) {
        if (blk) xcd_barrier(bar);
        if (ON(0) && IN(pb + 0)) { const Ctx F = phase_ctx(F0);
            pg8::Gemm g{WSP(const bf16_t, WS_HB), WSP(const bf16_t, WS_WIN) + (size_t)l * NC * 2048, 2048, 2048};
            pg8::EpiInProj E{WSP(bf16_t, WS_P), WSP(bf16_t, WS_KB), WSP(const float, WS_COSH), WSP(const float, WS_SINH), WSP(const float, WS_COSR), WSP(const float, WS_SINR),
                             F.in[I_AKN] + l * 128, F.in[I_AQN] + l * 128, WSP(float, WS_SSK), WSP(float, WS_SSQ), WSP(float, WS_SSKV), WSP(float, WS_SSCQ)};
            pg8::TileOrder S; S.init(nMl, 56, F.G, F.bid, rmode);
            for (int dup = 0; dup < DUPN(0); ++dup)
            pg8::gemm_phase(F.lds, g, S, E);
            if (l > 0) { pg8::TileOrder S2; S2.init(4, 6, F.G, F.bid, 2); pg8::gemm_phase(F.lds, g, S2, E); }
        }
        SEAM(pb + 0);
        if (ON(2) && IN(pb + 1)) { const Ctx F = phase_ctx(F0); bf16_t* P = WSP(bf16_t, WS_P);
            knorm_pass(F);
            { pg8::Gemm g{P + PC_CKV, WSP(const bf16_t, WS_WKVUP) + (size_t)l * 2048 * 256, NC, 256}; pg8::EpiKvUp E{WSP(bf16_t, WS_KB), WSP(bf16_t, WS_VB), WSP(const float, WS_SSKV)};
              pg8::TileOrder S; S.init(68, 8, F.G, F.bid, 0); for (int dup = 0; dup < DUPN(1); ++dup) pg8::gemm_phase(F.lds, g, S, E); }
            { pg8::Gemm g{P + PC_CQ, WSP(const bf16_t, WS_WQUP) + (size_t)l * 1536 * 512, NC, 512}; pg8::EpiQUp E{WSP(bf16_t, WS_QB), WSP(const float, WS_COSR), WSP(const float, WS_SINR), WSP(const float, WS_SSCQ)};
              pg8::TileOrder S; S.init(nMl, 6, F.G, F.bid, rmode); for (int dup = 0; dup < DUPN(1); ++dup) pg8::gemm_phase(F.lds, g, S, E); }
        }
        SEAM(pb + 1);
        if (ON(3) && IN(pb + 2)) ph_attn(F0, l);
        }
        SEAM(pb + 2);
        if (ON(4) && IN(pb + 3)) { const Ctx F = phase_ctx(F0); bf16_t* P = WSP(bf16_t, WS_P); bf16_t* HB = WSP(bf16_t, WS_HB);
            pg8::Gemm g{WSP(const bf16_t, WS_BR), WSP(const bf16_t, WS_WBR) + (size_t)l * 4 * 2048 * 1024, 4096, 1024};
            pg8::EpiMerge E{HB, P + PC_GATE, NC};
            pg8::TileOrder S; S.init(nMl, 8, F.G, F.bid, rmode, 4, (size_t)1024 * 2, (size_t)2048 * 1024 * 2);
            for (int dup = 0; dup < DUPN(5); ++dup) pg8::gemm_phase(F.lds, g, S, E);
        }
        SEAM(pb + 3);
        if (ON(5) && IN(pb + 4)) { const Ctx F = phase_ctx(F0); bf16_t* HB = WSP(bf16_t, WS_HB);
            pg8::Gemm g{HB, WSP(const bf16_t, WS_WO) + (size_t)l * 2048 * 2048, 2048, 2048};
            pg8::EpiWo E{(float*)(F.ws + WS_P + X1_OFF), WSP(const float, WS_MOD) + (size_t)l * 5 * 12288, l == 0 ? F.in[I_X] : (const float*)F.out, F.in[I_CTX]};
            pg8::TileOrder S; S.init(nMl, 8, F.G, F.bid, rmode); for (int dup = 0; dup < DUPN(6); ++dup) pg8::gemm_phase(F.lds, g, S, E);
        }
        SEAM(pb + 4);
        if (ON(6) && IN(pb + 5)) ph_ln1(F0, l);
        SEAM(pb + 5);
        if (ON(7) && IN(pb + 6)) { const Ctx F = phase_ctx(F0); bf16_t* HB = WSP(bf16_t, WS_HB);
            pg8::Gemm g{HB, WSP(const bf16_t, WS_WFOLD) + (size_t)l * 2048 * 2048, 2048, 2048}; pg8::EpiF32 E{(float*)(F.ws + WS_P + SC_OFF), 2048};
            pg8::TileOrder S; S.init(nMl, 8, F.G, F.bid, rmode); for (int dup = 0; dup < DUPN(7); ++dup) pg8::gemm_phase(F.lds, g, S, E);
        }
        SEAM(pb + 6);
        if (ON(8) && IN(pb + 7)) { ph_peer(F0, l); if (DUPN(8) == 2 && l == 1) ph_peer(F0, l); }
        SEAM(pb + 7);
    }
#undef IN
#undef SEAM
}

extern "C" void kernel_launch(void* const* d_in, const int* in_sizes, int n_in, void* d_out, int out_size, void* d_ws, size_t ws_size, hipStream_t stream) {
    static int grid = 0;
    if (grid == 0) {
        if (n_in != cf::N_IN || out_size != cf::NB * cf::S * cf::D || ws_size < cf::WS_END) {
            fprintf(stderr, "kernel_launch: unexpected shapes: n_in %d out %d ws %zu (need %zu)\n", n_in, out_size, ws_size, (size_t)cf::WS_END); grid = -1; return; }
        int dev = 0, cus = 0;
        if (hipGetDevice(&dev) != hipSuccess || hipDeviceGetAttribute(&cus, hipDeviceAttributeMultiprocessorCount, dev) != hipSuccess || cus < 1) { grid = -1; return; }
        if (hipFuncSetAttribute((const void*)mega_fwd, hipFuncAttributeMaxDynamicSharedMemorySize, cf::LDS_BYTES) != hipSuccess) { fprintf(stderr, "kernel_launch: hipFuncSetAttribute failed\n"); grid = -1; return; }
        int per_cu = 0;
        if (hipOccupancyMaxActiveBlocksPerMultiprocessor(&per_cu, (const void*)mega_fwd, 512, cf::LDS_BYTES) != hipSuccess || per_cu < 1)
            fprintf(stderr, "kernel_launch: note: occupancy query reports %d workgroups per CU\n", per_cu);
        (void)hipGetLastError();
        grid = cus;
    }
    if (grid < 0) return;
    (void)hipMemsetAsync((char*)d_ws + cf::WS_CTL, 0, cf::CTL_BYTES, stream);
    Params p{};
    for (int i = 0; i < cf::N_IN; ++i) p.in[i] = (const float*)d_in[i];
    p.out = (float*)d_out; p.ws = (unsigned char*)d_ws;
#if MK_PER_PHASE
    for (int k = 0; k < cf::N_PHASES; ++k) { p.ph_lo = k; p.ph_hi = k + 1; hipLaunchKernelGGL(mega_fwd, dim3(grid), dim3(512), cf::LDS_BYTES, stream, p); }
#else
    p.ph_lo = 0; p.ph_hi = cf::N_PHASES;
    hipLaunchKernelGGL(mega_fwd, dim3(grid), dim3(512), cf::LDS_BYTES, stream, p);
#endif
    const hipError_t le = hipPeekAtLastError();
    if (le != hipSuccess) fprintf(stderr, "kernel_launch: launch failed: %s\n", hipGetErrorName(le));
}
```

```cpp
#include <hip/hip_runtime.h>
#include <stdint.h>
#include <stdio.h>

#ifndef MK_DUP
#define MK_DUP 0
#endif
#define DUPN(k) (((MK_DUP >> (k)) & 1) ? 2 : 1)
#ifndef MK_PER_PHASE
#define MK_PER_PHASE 0
#endif

namespace cf {
constexpr int D = 2048, NB = 4, S = 4096, CTX = 256, RB = CTX + S  , MR = NB * RB  ;
constexpr int DEPTH = 2;
constexpr int PC_AK = 0, PC_AV = 256, PC_CKV = 512, PC_KR = 768, PC_DK = 1024, PC_DV = 1280, PC_KVEND = 1536;
constexpr int PC_AQ = 1536, PC_CQ = 2560, PC_DQ = 3072, PC_GLU = 4096, PC_GATE = 6144, NC = 14336;
constexpr int IN_COLS = 14144;
constexpr int NEXP = 16384;
constexpr float ALPHA = 1.4142135623730951f;
constexpr float LOG2E = 1.4426950408889634f;
constexpr float SCALE_HD = 0.08838834764831845f;
constexpr float SCALE_MLA = 0.07216878364870323f;
enum { I_X = 0, I_C, I_CTX, I_CCTX, I_WADA, I_BADA, I_WIN, I_AQN, I_AKN, I_BQN, I_WQUP, I_BKVN, I_WKVUP, I_CW, I_CB, I_CLG, I_CLB, I_SINK,
       I_WBRA, I_WBRB, I_WBRC, I_WBRD, I_WO, I_LN1G, I_LN1B, I_LN2G, I_LN2B, I_PWQ, I_PSK, I_PU, I_PV, N_IN };
constexpr size_t al(size_t x) { return (x + 255) / 256 * 256; }
constexpr size_t WS_CTL = 0;
constexpr size_t CTL_BYTES = 65536;
constexpr size_t WS_MOD = WS_CTL + CTL_BYTES;
constexpr size_t WS_COSH = WS_MOD + al((size_t)2 * 5 * 12288 * 4);
constexpr size_t WS_SINH = WS_COSH + (size_t)4096 * 64 * 4;
constexpr size_t WS_COSR = WS_SINH + (size_t)4096 * 64 * 4;
constexpr size_t WS_SINR = WS_COSR + (size_t)4096 * 32 * 4;
constexpr size_t WS_WIN = WS_SINR + (size_t)4096 * 32 * 4;
constexpr size_t WS_WQUP = WS_WIN + (size_t)2 * NC * 2048 * 2;
constexpr size_t WS_WKVUP = WS_WQUP + (size_t)2 * 1536 * 512 * 2;
constexpr size_t WS_WBR = WS_WKVUP + (size_t)2 * 2048 * 256 * 2;
constexpr size_t WS_WO = WS_WBR + (size_t)2 * 4 * 2048 * 1024 * 2;
constexpr size_t WS_WFOLD = WS_WO + (size_t)2 * 2048 * 2048 * 2;
constexpr size_t WS_UB = WS_WFOLD + (size_t)2 * 2048 * 2048 * 2;
constexpr size_t WS_VB2 = WS_UB + (size_t)2 * NEXP * 2048;
constexpr size_t WS_HB = WS_VB2 + (size_t)2 * NEXP * 2048;
constexpr size_t WS_P = WS_HB + (size_t)MR * 2048 * 2;
constexpr size_t WS_QB = WS_P + (size_t)MR * NC * 2;
constexpr size_t WS_KB = WS_QB + (size_t)MR * 1536 * 2;
constexpr size_t WS_VB = WS_KB + (size_t)MR * 1536 * 2;
constexpr size_t WS_BR = WS_VB + (size_t)MR * 1024 * 2;
constexpr size_t WS_XC = WS_BR + (size_t)MR * 4096 * 2;
constexpr size_t WS_SSK = WS_XC + (size_t)1024 * 2048 * 4;
constexpr size_t WS_SSQ = WS_SSK + (size_t)MR * 4 * 4;
constexpr size_t WS_SSKV = WS_SSQ + (size_t)MR * 16 * 4;
constexpr size_t WS_SSCQ = WS_SSKV + (size_t)MR * 4 * 4;
constexpr size_t WS_END = WS_SSCQ + (size_t)MR * 8 * 4;
constexpr size_t X1_OFF = 0, SC_OFF = (size_t)MR * 2048 * 4;
static_assert(SC_OFF * 2 <= (size_t)MR * NC * 2, "X1 + SC fit in P");
constexpr int LDS_BYTES = 132 * 1024;
constexpr int MISC_OFF = 128 * 1024;
constexpr int N_PHASES = 2 + 8 * DEPTH;
}

typedef unsigned short bf16_t;
typedef short bf16x8 __attribute__((ext_vector_type(8)));
typedef float f32x4 __attribute__((ext_vector_type(4)));
typedef float f32x2 __attribute__((ext_vector_type(2)));
typedef unsigned u32x4 __attribute__((ext_vector_type(4)));
typedef unsigned u32x2 __attribute__((ext_vector_type(2)));
#define LAS __attribute__((address_space(3)))
typedef LAS unsigned char* ldsp_t;

__device__ __forceinline__ unsigned cvt_pk_bf16(float lo, float hi) { unsigned r; asm volatile("v_cvt_pk_bf16_f32 %0, %1, %2" : "=v"(r) : "v"(lo), "v"(hi)); return r; }
__device__ __forceinline__ bf16_t f2bf(float f) { return (bf16_t)(cvt_pk_bf16(f, 0.f) & 0xffffu); }
__device__ __forceinline__ float bf2f(bf16_t b) { return __uint_as_float(((unsigned)b) << 16); }
__device__ __forceinline__ float bflo(unsigned w) { return __uint_as_float(w << 16); }
__device__ __forceinline__ float bfhi(unsigned w) { return __uint_as_float(w & 0xffff0000u); }
__device__ __forceinline__ float wave_sum(float v) {
#pragma unroll
    for (int o = 32; o >= 1; o >>= 1) v += __shfl_xor(v, o);
    return v;
}
__device__ __forceinline__ float sigmoidf_(float x) { return 1.0f / (1.0f + __expf(-x)); }

#define XB_TMO      128
#define XB_XCNT(j)  (256  + 64 * (j))
#define XB_XSUB(j)  (1280 + 64 * (j))
#define XB_XGEN(j)  (2304 + 64 * (j))
#define XB_TOP      3328
#define XB_TOPGEN   3392
#define XCD_BAR_WORDS 3456
#define XB_SPIN_CAP (1u << 23)
__device__ __forceinline__ unsigned xb_ld(unsigned* p)              { return __hip_atomic_load(p, __ATOMIC_RELAXED, __HIP_MEMORY_SCOPE_AGENT); }
__device__ __forceinline__ unsigned xb_add(unsigned* p, unsigned v) { return __hip_atomic_fetch_add(p, v, __ATOMIC_RELAXED, __HIP_MEMORY_SCOPE_AGENT); }
__device__ __forceinline__ unsigned xb_xcc_id() { return (unsigned)__builtin_amdgcn_s_getreg((3 << 11) | 20) & 0xFu; }
#define XB_SPIN(cond, bar) do { unsigned _sp = 0; while (cond) { __builtin_amdgcn_s_sleep(1); \
    if ((++_sp & 255u) == 0u) { if (xb_ld(&(bar)[XB_TMO])) break; if (_sp > XB_SPIN_CAP) { atomicAdd(&(bar)[XB_TMO], 1u); break; } } } } while (0)
struct XcdBarrier { unsigned* bar; unsigned x; volatile LAS unsigned* st; };
__device__ __forceinline__ XcdBarrier xcd_barrier_post(unsigned* bar, volatile LAS unsigned* st) {
    XcdBarrier b; b.bar = bar; b.x = xb_xcc_id(); b.st = st;
    if (threadIdx.x == 0) (void)xb_add(&bar[XB_XCNT(b.x)], 1u);
    return b;
}
__device__ __forceinline__ void xcd_barrier_complete(unsigned* bar, unsigned x, unsigned& nloc, unsigned& nx) {
    const unsigned G = gridDim.x * gridDim.y * gridDim.z;
    unsigned sum, cnt, mine, sp = 0u;
    for (;;) {
        sum = 0u; cnt = 0u; mine = 0u;
#pragma unroll
        for (unsigned j = 0; j < 16; ++j) { const unsigned c = xb_ld(&bar[XB_XCNT(j)]); sum += c; cnt += (c > 0u) ? 1u : 0u; mine = (j == x) ? c : mine; }
        if (sum == G) break;
        __builtin_amdgcn_s_sleep(1);
        if ((++sp & 255u) == 0u) { if (xb_ld(&bar[XB_TMO])) break; if (sp > XB_SPIN_CAP) { atomicAdd(&bar[XB_TMO], 1u); break; } }
    }
    nloc = mine > 0u ? mine : 1u; nx = cnt > 0u ? cnt : 1u;
}
__device__ __forceinline__ void xcd_barrier(const XcdBarrier& b) {
    asm volatile("s_waitcnt vmcnt(0)" ::: "memory");
    __syncthreads();
    if (threadIdx.x == 0) {
        unsigned* bar = b.bar;
        __builtin_amdgcn_s_waitcnt(0);
        unsigned nloc = b.st[0], nx = b.st[1];
        if (nloc == 0u) { xcd_barrier_complete(bar, b.x, nloc, nx); b.st[0] = nloc; b.st[1] = nx; }
        const unsigned old = xb_add(&bar[XB_XSUB(b.x)], 1u);
        const unsigned gen = old / nloc;
        if (old + 1u == (gen + 1u) * nloc) {
            __builtin_amdgcn_fence(__ATOMIC_RELEASE, "agent");
            asm volatile("s_waitcnt vmcnt(0)" ::: "memory");
            const unsigned og = xb_add(&bar[XB_TOP], 1u);
            const unsigned tg = og / nx;
            if (og + 1u == (tg + 1u) * nx) xb_add(&bar[XB_TOPGEN], 1u);
            else XB_SPIN(xb_ld(&bar[XB_TOPGEN]) == tg, bar);
            __builtin_amdgcn_fence(__ATOMIC_ACQUIRE, "agent");
            xb_add(&bar[XB_XGEN(b.x)], 1u);
            asm volatile("s_waitcnt vmcnt(0)" ::: "memory");
        } else {
            XB_SPIN(xb_ld(&bar[XB_XGEN(b.x)]) == gen, bar);
            __builtin_amdgcn_fence(__ATOMIC_ACQUIRE, "agent");
            asm volatile("s_waitcnt vmcnt(0)" ::: "memory");
        }
    }
    __syncthreads();
}

namespace pg8 {
constexpr int BM = 256, BK = 64, HALF = 128, HTB = HALF * BK * 2, STAGE_BYTES = 8 * HTB, NXCD = 8, WGM = 8;
__host__ __device__ __forceinline__ int lds_byte(int r, int c) { const int st = (r >> 4) * 2 + (c >> 5), rr = r & 15, cc = c & 31, ob = rr * 64 + cc * 2; return st * 1024 + (ob ^ (((ob >> 9) & 1) << 5)); }
__host__ __device__ __forceinline__ void stage_rc(int b, int& R, int& C) { const int st = b / 1024, sb = b % 1024, swz = sb ^ (((sb >> 9) & 1) << 5); R = (st >> 1) * 16 + swz / 64; C = (st & 1) * 32 + (swz % 64) / 2; }
__host__ __device__ __forceinline__ int perm32(int rho) { const int n = rho >> 4, i = rho & 15; return 8 * (i >> 2) + 4 * n + (i & 3); }
struct Unit { int pm, pn, sub; };
struct Gemm { const bf16_t* A; const bf16_t* Bt; int lda, K; };

struct TileOrder {
    int nM, nN, nwg, G, c, mode, nsub; size_t subA, subB;
    __device__ void init(int nM_, int nN_, int G_, int c_, int mode_, int nsub_ = 1, size_t subA_ = 0, size_t subB_ = 0) { nM = nM_; nN = nN_; nwg = nM * nN; G = G_; c = c_; mode = mode_; nsub = nsub_; subA = subA_; subB = subB_; }
    __device__ bool next(int i, Unit& u) const {
        const int it = nsub == 1 ? i : i / nsub; u.sub = nsub == 1 ? 0 : i - it * nsub;
        const long L = (long)it * G + c; if (L >= nwg) return false;
        int wgid = (int)L; { const int q = nwg / NXCD, r = nwg % NXCD, xcd = wgid % NXCD, off = wgid / NXCD; wgid = (xcd < r ? xcd * (q + 1) : r * (q + 1) + (xcd - r) * q) + off; }
        const int nig = WGM * nN, gid = wgid / nig, fm = gid * WGM, gsz = (nM - fm) < WGM ? (nM - fm) : WGM;
        const int pl = fm + ((wgid % nig) % gsz); u.pn = (wgid % nig) / gsz;
        u.pm = mode == 0 ? pl : (mode == 1 ? 17 * (pl >> 4) + 1 + (pl & 15) : 17 * pl);
        return true;
    }
    __device__ __forceinline__ void a_ready(const Unit&) const {}
    __device__ __forceinline__ void done(const Unit&) const {}
};

template <class Epi, class Sched>
__device__ __forceinline__ void gemm_phase(ldsp_t lds, const Gemm g, const Sched& S, const Epi& E) {
    int tid = threadIdx.x; asm volatile("" : "+v"(tid));
    const int wid = __builtin_amdgcn_readfirstlane(tid >> 6), lane = tid & 63, wr = wid >> 2, wc = wid & 3, fr = lane & 15, fq = lane >> 4;
    int K = g.K; asm volatile("" : "+s"(K));
    const int nt = K / BK, lda = g.lda;
    unsigned voffA[2], voffB[2];
#pragma unroll
    for (int i = 0; i < 2; ++i) { int R, C; stage_rc(tid * 16 + i * 8192, R, C); const int Rb = (R & ~31) + perm32(R & 31);
        voffA[i] = (unsigned)(R * lda + C) * 2u; voffB[i] = (unsigned)(Rb * K + C) * 2u; }
    const size_t kstep = (size_t)(BK * 2);
    const size_t hstepA = (size_t)HALF * lda * 2, hstepB = (size_t)HALF * K * 2;
    const size_t tstepA = 2 * hstepA, tstepB = 2 * hstepB;
    const unsigned ldsw = (unsigned)wid * 1024u;
    const int aoff = lds_byte(wr * 64 + fr, fq * 8), boff = lds_byte(wc * 32 + fr, fq * 8);
#define PG8_SA(b, h) (((b) * 2 + (h)) * HTB)
#define PG8_SB(b, h) ((4 + (b) * 2 + (h)) * HTB)
#define PG8_STAGE(bufoff, gbase, voff) do { _Pragma("unroll") for (int _i = 0; _i < 2; ++_i) \
        __builtin_amdgcn_global_load_lds((const unsigned*)((const char*)(gbase) + (voff)[_i]), (LAS unsigned*)(lds + (bufoff) + ldsw + _i * 8192), 16, 0, 0); } while (0)
#define PG8_LDA(dst, b, h) do { _Pragma("unroll") for (int m = 0; m < 4; ++m) _Pragma("unroll") for (int k = 0; k < 2; ++k) dst[m][k] = *(const LAS bf16x8*)(lds + PG8_SA(b, h) + aoff + m * 2048 + k * 1024); } while (0)
#define PG8_LDB(dst, b, h) do { _Pragma("unroll") for (int n = 0; n < 2; ++n) _Pragma("unroll") for (int k = 0; k < 2; ++k) dst[n][k] = *(const LAS bf16x8*)(lds + PG8_SB(b, h) + boff + n * 2048 + k * 1024); } while (0)
#define PG8_MMA(ai, bj, At, Bt) do { __builtin_amdgcn_s_setprio(1); _Pragma("unroll") for (int m = 0; m < 4; ++m) _Pragma("unroll") for (int n = 0; n < 2; ++n) _Pragma("unroll") for (int k = 0; k < 2; ++k) \
        acc[ai][bj][m][n] = __builtin_amdgcn_mfma_f32_16x16x32_bf16(Bt[n][k], At[m][k], acc[ai][bj][m][n], 0, 0, 0); __builtin_amdgcn_s_setprio(0); } while (0)
#define PG8_WAIT_V(n) asm volatile("s_waitcnt vmcnt(" #n ")" ::: "memory")
#define PG8_WAIT_L(n) asm volatile("s_waitcnt lgkmcnt(" #n ")" ::: "memory")
#define PG8_BAR __builtin_amdgcn_s_barrier()
#define PG8_SCHED __builtin_amdgcn_sched_barrier(0)
    Unit cur, nxt; int ui = 0;
    if (!S.next(0, cur)) return;
    f32x4 acc[2][2][4][2];
#pragma unroll
    for (int a = 0; a < 2; ++a)
#pragma unroll
        for (int b = 0; b < 2; ++b)
#pragma unroll
            for (int m = 0; m < 4; ++m)
#pragma unroll
                for (int n = 0; n < 2; ++n) acc[a][b][m][n] = (f32x4){0.f, 0.f, 0.f, 0.f};
    bf16x8 At[4][2], B0[2][2], B1[2][2];
    const char* cA = (const char*)g.A + (size_t)cur.pm * tstepA + cur.sub * S.subA; const char* cB = (const char*)g.Bt + (size_t)cur.pn * tstepB + cur.sub * S.subB;
    S.a_ready(cur);
    PG8_STAGE(PG8_SB(0, 0), cB, voffB); PG8_STAGE(PG8_SA(0, 0), cA, voffA); PG8_STAGE(PG8_SB(0, 1), cB + hstepB, voffB); PG8_STAGE(PG8_SA(0, 1), cA + hstepA, voffA);
    if (wr == 1) PG8_BAR;
    PG8_WAIT_V(4); PG8_BAR;
    PG8_STAGE(PG8_SB(1, 0), cB + kstep, voffB); PG8_STAGE(PG8_SA(1, 0), cA + kstep, voffA); PG8_STAGE(PG8_SB(1, 1), cB + hstepB + kstep, voffB);
    PG8_WAIT_V(6); PG8_BAR;
    for (;;) {
        const bool has_next = S.next(ui + 1, nxt);
        const char* nA = has_next ? (const char*)g.A + (size_t)nxt.pm * tstepA + nxt.sub * S.subA : cA; const char* nB = has_next ? (const char*)g.Bt + (size_t)nxt.pn * tstepB + nxt.sub * S.subB : cB;
#pragma unroll 1
        for (int t = 0; t < nt; t += 2) {
            const bool last = (t == nt - 2);
            const char* a1 = cA + (size_t)(t + 1) * kstep;
            const char* a2 = last ? nA : cA + (size_t)(t + 2) * kstep; const char* b2 = last ? nB : cB + (size_t)(t + 2) * kstep;
            const char* a3 = a2 + kstep; const char* b3 = b2 + kstep;
            if (last && has_next) S.a_ready(nxt);
            PG8_LDB(B0, 0, 0); PG8_SCHED; PG8_LDA(At, 0, 0); PG8_STAGE(PG8_SA(1, 1), a1 + hstepA, voffA);
            PG8_WAIT_L(8); PG8_BAR; PG8_WAIT_L(0); PG8_MMA(0, 0, At, B0); PG8_BAR; PG8_SCHED;
            PG8_LDB(B1, 0, 1); PG8_STAGE(PG8_SB(0, 0), b2, voffB);
            PG8_BAR; PG8_WAIT_L(0); PG8_MMA(0, 1, At, B1); PG8_BAR;
            PG8_LDA(At, 0, 1); PG8_STAGE(PG8_SA(0, 0), a2, voffA);
            PG8_BAR; PG8_WAIT_L(0); PG8_MMA(1, 0, At, B0); PG8_BAR; PG8_SCHED;
            PG8_STAGE(PG8_SB(0, 1), b2 + hstepB, voffB);
            PG8_WAIT_V(6); PG8_BAR; PG8_MMA(1, 1, At, B1); PG8_BAR;
            PG8_LDB(B0, 1, 0); PG8_SCHED; PG8_LDA(At, 1, 0); PG8_STAGE(PG8_SA(0, 1), a2 + hstepA, voffA);
            PG8_WAIT_L(8); PG8_BAR; PG8_WAIT_L(0); PG8_MMA(0, 0, At, B0); PG8_BAR; PG8_SCHED;
            PG8_LDB(B1, 1, 1); PG8_STAGE(PG8_SB(1, 0), b3, voffB);
            PG8_BAR; PG8_WAIT_L(0); PG8_MMA(0, 1, At, B1); PG8_BAR;
            PG8_LDA(At, 1, 1); PG8_STAGE(PG8_SA(1, 0), a3, voffA);
            PG8_BAR; PG8_WAIT_L(0); PG8_MMA(1, 0, At, B0); PG8_BAR; PG8_SCHED;
            PG8_STAGE(PG8_SB(1, 1), b3 + hstepB, voffB);
            PG8_WAIT_V(6); PG8_BAR; PG8_MMA(1, 1, At, B1); PG8_BAR;
        }
        E(acc, cur, wr, wc, fr, fq); S.done(cur);
        if (!has_next) break;
#pragma unroll
        for (int a = 0; a < 2; ++a)
#pragma unroll
            for (int b = 0; b < 2; ++b)
#pragma unroll
                for (int m = 0; m < 4; ++m)
#pragma unroll
                    for (int n = 0; n < 2; ++n) acc[a][b][m][n] = (f32x4){0.f, 0.f, 0.f, 0.f};
        cur = nxt; cA = nA; cB = nB; ++ui;
    }
    PG8_WAIT_V(0);
    if (wr == 0) PG8_BAR;
    PG8_BAR;
#undef PG8_SA
#undef PG8_SB
#undef PG8_STAGE
#undef PG8_LDA
#undef PG8_LDB
#undef PG8_MMA
#undef PG8_WAIT_V
#undef PG8_WAIT_L
#undef PG8_BAR
#undef PG8_SCHED
}

__device__ __forceinline__ u32x4 pack8(const f32x4 a, const f32x4 b) { u32x4 w; w.x = cvt_pk_bf16(a[0], a[1]); w.y = cvt_pk_bf16(a[2], a[3]); w.z = cvt_pk_bf16(b[0], b[1]); w.w = cvt_pk_bf16(b[2], b[3]); return w; }
#define EPI_ARGS const f32x4 (&acc)[2][2][4][2], const Unit& u, int wr, int wc, int fr_, int fq_
#define EPI_LANE int fr = fr_, fq = fq_; asm volatile("" : "+v"(fr), "+v"(fq));

struct EpiBf16 {
    bf16_t* O; int ldc;
    __device__ __forceinline__ void operator()(EPI_ARGS) const {
        EPI_LANE
        const int row0 = u.pm * BM + wr * 64 + fr, col0 = u.pn * BM + wc * 32 + 8 * fq;
#pragma unroll
        for (int ai = 0; ai < 2; ++ai)
#pragma unroll
            for (int m = 0; m < 4; ++m) { bf16_t* rowp = O + (size_t)(row0 + ai * HALF + m * 16) * ldc + col0;
#pragma unroll
                for (int bj = 0; bj < 2; ++bj) *(u32x4*)(rowp + bj * HALF) = pack8(acc[ai][bj][m][0], acc[ai][bj][m][1]); }
    }
};
struct EpiF32 {
    float* C; int ldc;
    __device__ __forceinline__ void operator()(EPI_ARGS) const {
        EPI_LANE
        const int row0 = u.pm * BM + wr * 64 + fr, col0 = u.pn * BM + wc * 32 + 8 * fq;
#pragma unroll
        for (int ai = 0; ai < 2; ++ai)
#pragma unroll
            for (int m = 0; m < 4; ++m) { float* rowp = C + (size_t)(row0 + ai * HALF + m * 16) * ldc + col0;
#pragma unroll
                for (int bj = 0; bj < 2; ++bj) { *(f32x4*)(rowp + bj * HALF) = acc[ai][bj][m][0]; *(f32x4*)(rowp + bj * HALF + 4) = acc[ai][bj][m][1]; } }
    }
};
struct EpiInProj {
    bf16_t* P; bf16_t* KB; const float* cosh; const float* sinh; const float* cosr; const float* sinr; const float* akn; const float* aqn;
    float* ssk; float* ssq; float* sskv; float* sscq;
    __device__ __forceinline__ void operator()(EPI_ARGS) const {
        EPI_LANE
        const int pn = u.pn, tb = u.pm % 17; const bool lat = tb != 0; const int posbase = (tb - 1) * 256;
        const int rl0 = wr * 64 + fr;
        if (pn >= 24) {
            const int col0 = pn * BM + wc * 32 + 8 * fq;
#pragma unroll
            for (int ai = 0; ai < 2; ++ai)
#pragma unroll
                for (int m = 0; m < 4; ++m) { bf16_t* rowp = P + ((size_t)u.pm * BM + rl0 + ai * HALF + m * 16) * cf::NC + col0;
#pragma unroll
                    for (int bj = 0; bj < 2; ++bj) { f32x4 v0 = acc[ai][bj][m][0], v1 = acc[ai][bj][m][1];
#pragma unroll
                        for (int e = 0; e < 4; ++e) { v0[e] = sigmoidf_(v0[e]); v1[e] = sigmoidf_(v1[e]); }
                        *(u32x4*)(rowp + bj * HALF) = pack8(v0, v1); } }
        } else if (pn >= 16) {
            const int col0 = cf::PC_GLU + 128 * (pn - 16) + wc * 32 + 8 * fq;
#pragma unroll
            for (int ai = 0; ai < 2; ++ai)
#pragma unroll
                for (int m = 0; m < 4; ++m) { f32x4 v0 = acc[ai][0][m][0], v1 = acc[ai][0][m][1]; const f32x4 g0 = acc[ai][1][m][0], g1 = acc[ai][1][m][1];
#pragma unroll
                    for (int e = 0; e < 4; ++e) { v0[e] *= sigmoidf_(g0[e]); v1[e] *= sigmoidf_(g1[e]); }
                    *(u32x4*)(P + ((size_t)u.pm * BM + rl0 + ai * HALF + m * 16) * cf::NC + col0) = pack8(v0, v1); }
        } else if (pn == 3) {
            if (wc == 0) { const int i0 = 8 * fq;
#pragma unroll
                for (int ai = 0; ai < 2; ++ai)
#pragma unroll
                    for (int m = 0; m < 4; ++m) { const int rl = rl0 + ai * HALF + m * 16;
                        f32x4 c0 = {1.f, 1.f, 1.f, 1.f}, c1 = c0, s0 = {0.f, 0.f, 0.f, 0.f}, s1 = s0;
                        if (lat) { const float* cp = cosr + (size_t)(posbase + rl) * 32 + i0; const float* sp = sinr + (size_t)(posbase + rl) * 32 + i0;
                            c0 = *(const f32x4*)cp; c1 = *(const f32x4*)(cp + 4); s0 = *(const f32x4*)sp; s1 = *(const f32x4*)(sp + 4); }
                        const f32x4 x1a = acc[ai][0][m][0], x1b = acc[ai][0][m][1], x2a = acc[ai][1][m][0], x2b = acc[ai][1][m][1];
                        const u32x4 w1 = pack8(x1a * c0 - x2a * s0, x1b * c1 - x2b * s1), w2 = pack8(x2a * c0 + x1a * s0, x2b * c1 + x1b * s1);
                        bf16_t* kb = KB + ((size_t)u.pm * BM + rl) * 1536 + 128 + i0;
#pragma unroll
                        for (int h = 0; h < 8; ++h) { *(u32x4*)(kb + h * 192) = w1; *(u32x4*)(kb + h * 192 + 32) = w2; }
                        asm volatile("" ::: "memory"); } }
        } else if (pn == 0 || pn == 4 || (pn >= 6 && pn <= 9) || pn >= 12) {
            const bool norm = pn == 0 || (pn >= 6 && pn <= 9);
            const int hl = wc >> 1, i0 = 32 * (wc & 1) + 8 * fq;
            f32x4 g1a = {1.f, 1.f, 1.f, 1.f}, g1b = g1a, g2a = g1a, g2b = g1a;
            if (norm) { const float* gn = (pn == 0 ? akn : aqn) + i0; g1a = *(const f32x4*)gn; g1b = *(const f32x4*)(gn + 4); g2a = *(const f32x4*)(gn + 64); g2b = *(const f32x4*)(gn + 68); }
            float* ssp = pn == 0 ? ssk + ((size_t)u.pm * BM * 2 + hl) * 2 + (wc & 1) : ssq + ((size_t)u.pm * BM * 8 + (pn - 6) * 2 + hl) * 2 + (wc & 1);
            const int sstr = pn == 0 ? 4 : 16;
#pragma unroll
            for (int ai = 0; ai < 2; ++ai)
#pragma unroll
                for (int m = 0; m < 4; ++m) { const int rl = rl0 + ai * HALF + m * 16;
                    f32x4 x1a = acc[ai][0][m][0], x1b = acc[ai][0][m][1], x2a = acc[ai][1][m][0], x2b = acc[ai][1][m][1];
                    if (norm) { const f32x4 q = x1a * x1a + x1b * x1b + x2a * x2a + x2b * x2b; float ss = (q[0] + q[1]) + (q[2] + q[3]);
                        ss += __shfl_xor(ss, 16); ss += __shfl_xor(ss, 32);
                        if (fq == 0) ssp[(size_t)rl * sstr] = ss;
                        x1a *= g1a; x1b *= g1b; x2a *= g2a; x2b *= g2b; }
                    f32x4 o1a = x1a, o1b = x1b, o2a = x2a, o2b = x2b;
                    if (lat) { const float* cp = cosh + (size_t)(posbase + rl) * 64 + i0; const float* sp = sinh + (size_t)(posbase + rl) * 64 + i0;
                        const f32x4 c0 = *(const f32x4*)cp, c1 = *(const f32x4*)(cp + 4), s0 = *(const f32x4*)sp, s1 = *(const f32x4*)(sp + 4);
                        o1a = x1a * c0 - x2a * s0; o1b = x1b * c1 - x2b * s1; o2a = x2a * c0 + x1a * s0; o2b = x2b * c1 + x1b * s1; }
                    bf16_t* dst = P + ((size_t)u.pm * BM + rl) * cf::NC + pn * BM + hl * 128 + i0;
                    *(u32x4*)dst = pack8(o1a, o1b); *(u32x4*)(dst + 64) = pack8(o2a, o2b);
                    asm volatile("" ::: "memory"); }
        } else {
            const int col0 = pn * BM + wc * 32 + 8 * fq;
            const bool ssq_on = pn == 2 || pn == 10 || pn == 11;
            float* ssp = pn == 2 ? sskv + (size_t)u.pm * BM * 4 + wc : sscq + (size_t)u.pm * BM * 8 + (pn - 10) * 4 + wc;
            const int sstr = pn == 2 ? 4 : 8;
#pragma unroll
            for (int ai = 0; ai < 2; ++ai)
#pragma unroll
                for (int m = 0; m < 4; ++m) { const int rl = rl0 + ai * HALF + m * 16; bf16_t* rowp = P + ((size_t)u.pm * BM + rl) * cf::NC + col0;
#pragma unroll
                    for (int bj = 0; bj < 2; ++bj) *(u32x4*)(rowp + bj * HALF) = pack8(acc[ai][bj][m][0], acc[ai][bj][m][1]);
                    if (ssq_on) { const f32x4 q = acc[ai][0][m][0] * acc[ai][0][m][0] + acc[ai][0][m][1] * acc[ai][0][m][1] + acc[ai][1][m][0] * acc[ai][1][m][0] + acc[ai][1][m][1] * acc[ai][1][m][1];
                        float ss = (q[0] + q[1]) + (q[2] + q[3]); ss += __shfl_xor(ss, 16); ss += __shfl_xor(ss, 32);
                        if (fq == 0) ssp[(size_t)rl * sstr] = ss; } }
        }
    }
};
struct EpiKvUp {
    bf16_t* KB; bf16_t* VB; const float* sskv;
    __device__ __forceinline__ void operator()(EPI_ARGS) const {
        EPI_LANE
        const int row0 = u.pm * BM + wr * 64 + fr, d0 = wc * 32 + 8 * fq;
        const bool isk = u.pn < 4;
        bf16_t* base = isk ? KB + (2 * u.pn) * 192 + d0 : VB + (u.pn - 4) * 256 + d0;
        const int ldr = isk ? 1536 : 1024, bjs = isk ? 192 : 128;
#pragma unroll
        for (int ai = 0; ai < 2; ++ai)
#pragma unroll
            for (int m = 0; m < 4; ++m) { const size_t row = (size_t)(row0 + ai * HALF + m * 16); bf16_t* rowp = base + row * ldr;
                const f32x4 pp = *(const f32x4*)(sskv + row * 4); const float r = rsqrtf(((pp[0] + pp[1]) + (pp[2] + pp[3])) * (1.f / 256.f) + 1e-6f);
#pragma unroll
                for (int bj = 0; bj < 2; ++bj) *(u32x4*)(rowp + bj * bjs) = pack8(acc[ai][bj][m][0] * r, acc[ai][bj][m][1] * r); }
    }
};
struct EpiQUp {
    bf16_t* QB; const float* cosr; const float* sinr; const float* sscq;
    __device__ __forceinline__ void operator()(EPI_ARGS) const {
        EPI_LANE
        const int row0 = u.pm * BM + wr * 64 + fr;
        if (u.pn < 4) {
            const int d0 = wc * 32 + 8 * fq;
#pragma unroll
            for (int ai = 0; ai < 2; ++ai)
#pragma unroll
                for (int m = 0; m < 4; ++m) { const size_t row = (size_t)(row0 + ai * HALF + m * 16);
                    const f32x4 pa = *(const f32x4*)(sscq + row * 8), pb = *(const f32x4*)(sscq + row * 8 + 4);
                    const float r = rsqrtf((((pa[0] + pa[1]) + (pa[2] + pa[3])) + ((pb[0] + pb[1]) + (pb[2] + pb[3]))) * (1.f / 512.f) + 1e-6f);
#pragma unroll
                    for (int bj = 0; bj < 2; ++bj) *(u32x4*)(QB + row * 1536 + (2 * u.pn + bj) * 192 + d0) = pack8(acc[ai][bj][m][0] * r, acc[ai][bj][m][1] * r); }
        } else {
            const int head = 4 * (u.pn - 4) + wc, i0 = 8 * fq;
            const bool lat = (u.pm % 17) != 0; const int posbase = (u.pm % 17) * 256 - 256;
#pragma unroll
            for (int ai = 0; ai < 2; ++ai)
#pragma unroll
                for (int m = 0; m < 4; ++m) { const int rl = wr * 64 + fr + ai * HALF + m * 16; const size_t row = (size_t)u.pm * BM + rl;
                    const f32x4 pa = *(const f32x4*)(sscq + row * 8), pb = *(const f32x4*)(sscq + row * 8 + 4);
                    const float r = rsqrtf((((pa[0] + pa[1]) + (pa[2] + pa[3])) + ((pb[0] + pb[1]) + (pb[2] + pb[3]))) * (1.f / 512.f) + 1e-6f);
                    f32x4 c0 = {1.f, 1.f, 1.f, 1.f}, c1 = c0, s0 = {0.f, 0.f, 0.f, 0.f}, s1 = s0;
                    if (lat) { const float* cp = cosr + (size_t)(posbase + rl) * 32 + i0; const float* sp = sinr + (size_t)(posbase + rl) * 32 + i0;
                        c0 = *(const f32x4*)cp; c1 = *(const f32x4*)(cp + 4); s0 = *(const f32x4*)sp; s1 = *(const f32x4*)(sp + 4); }
                    const f32x4 x1a = acc[ai][0][m][0] * r, x1b = acc[ai][0][m][1] * r, x2a = acc[ai][1][m][0] * r, x2b = acc[ai][1][m][1] * r;
                    const f32x4 o1a = x1a * c0 - x2a * s0, o1b = x1b * c1 - x2b * s1, o2a = x2a * c0 + x1a * s0, o2b = x2b * c1 + x1b * s1;
                    bf16_t* dst = QB + row * 1536 + head * 192 + 128 + i0;
                    *(u32x4*)dst = pack8(o1a, o1b); *(u32x4*)(dst + 32) = pack8(o2a, o2b); asm volatile("" ::: "memory"); }
        }
    }
};
struct EpiMerge {
    bf16_t* ACC; const bf16_t* gate0; int ldg;
    __device__ __forceinline__ void operator()(EPI_ARGS) const {
        EPI_LANE
        const int row0 = u.pm * BM + wr * 64 + fr, col0 = u.pn * BM + wc * 32 + 8 * fq;
        const bf16_t* gate = gate0 + u.sub * 2048; const bool first = u.sub == 0;
#pragma unroll
        for (int ai = 0; ai < 2; ++ai) {
            u32x4 gw[4][2], pw[4][2];
#pragma unroll
            for (int m = 0; m < 4; ++m) { const size_t row = (size_t)(row0 + ai * HALF + m * 16);
#pragma unroll
                for (int bj = 0; bj < 2; ++bj) { const int col = col0 + bj * HALF; gw[m][bj] = *(const u32x4*)(gate + row * ldg + col);
                    pw[m][bj] = (u32x4){0u, 0u, 0u, 0u}; if (!first) pw[m][bj] = *(const u32x4*)(ACC + row * 2048 + col); } }
#pragma unroll
            for (int m = 0; m < 4; ++m) { const size_t row = (size_t)(row0 + ai * HALF + m * 16);
#pragma unroll
                for (int bj = 0; bj < 2; ++bj) { const int col = col0 + bj * HALF; const u32x4 g = gw[m][bj], p = pw[m][bj];
                    const f32x4 a0 = acc[ai][bj][m][0], a1 = acc[ai][bj][m][1];
                    f32x4 r0, r1;
                    r0[0] = bflo(p.x) + bflo(g.x) * a0[0]; r0[1] = bfhi(p.x) + bfhi(g.x) * a0[1]; r0[2] = bflo(p.y) + bflo(g.y) * a0[2]; r0[3] = bfhi(p.y) + bfhi(g.y) * a0[3];
                    r1[0] = bflo(p.z) + bflo(g.z) * a1[0]; r1[1] = bfhi(p.z) + bfhi(g.z) * a1[1]; r1[2] = bflo(p.w) + bflo(g.w) * a1[2]; r1[3] = bfhi(p.w) + bfhi(g.w) * a1[3];
                    *(u32x4*)(ACC + row * 2048 + col) = pack8(r0, r1); } }
            asm volatile("" ::: "memory"); }
    }
};
struct EpiWo {
    float* X1; const float* mod  ; const float* xlat  ; const float* xctx  ;
    __device__ __forceinline__ void operator()(EPI_ARGS) const {
        EPI_LANE
        const int b = u.pm / 17, tb = u.pm % 17; const bool isctx = tb == 0;
        const float* g1 = mod + (size_t)(isctx ? 4 : b) * 12288 + 2 * 2048;
        const float* xbase = isctx ? xctx + (size_t)b * cf::CTX * 2048 : xlat + ((size_t)b * cf::S + (size_t)(tb - 1) * 256) * 2048;
        const int rl0 = wr * 64 + fr, col0 = u.pn * BM + wc * 32 + 8 * fq;
        f32x4 gv[2][2];
#pragma unroll
        for (int bj = 0; bj < 2; ++bj) { gv[bj][0] = *(const f32x4*)(g1 + col0 + bj * HALF); gv[bj][1] = *(const f32x4*)(g1 + col0 + bj * HALF + 4); }
#pragma unroll
        for (int ai = 0; ai < 2; ++ai) {
            f32x4 xv[4][2][2];
#pragma unroll
            for (int m = 0; m < 4; ++m) { const int rl = rl0 + ai * HALF + m * 16;
#pragma unroll
                for (int bj = 0; bj < 2; ++bj) { const float* xp = xbase + (size_t)rl * 2048 + col0 + bj * HALF; xv[m][bj][0] = *(const f32x4*)xp; xv[m][bj][1] = *(const f32x4*)(xp + 4); } }
#pragma unroll
            for (int m = 0; m < 4; ++m) { const int rl = rl0 + ai * HALF + m * 16; float* op = X1 + ((size_t)u.pm * BM + rl) * 2048 + col0;
#pragma unroll
                for (int bj = 0; bj < 2; ++bj) { *(f32x4*)(op + bj * HALF) = xv[m][bj][0] * cf::ALPHA + gv[bj][0] * acc[ai][bj][m][0];
                    *(f32x4*)(op + bj * HALF + 4) = xv[m][bj][1] * cf::ALPHA + gv[bj][1] * acc[ai][bj][m][1]; } }
            asm volatile("" ::: "memory"); }
    }
};
}

struct Ctx {
    const float* const* in; float* out; unsigned char* ws;
    ldsp_t lds; int tid, lane, wave, G, bid;
};
#define WSP(T, off) ((T*)(F.ws + (off)))
__device__ __forceinline__ Ctx phase_ctx(const Ctx& F0) {
    Ctx C = F0;
    asm volatile("" : "+v"(C.tid));
    asm volatile("" : "+s"(C.ws));
    C.lane = C.tid & 63; C.wave = __builtin_amdgcn_readfirstlane(C.tid >> 6);
    return C;
}

__device__ __forceinline__ int srcmap(int mode, int n) {
    if (mode == 0) {
        const int pn = n >> 8, q = n & 255, bj = q >> 7, r = q & 127, rope = (r >> 6) * 128 + bj * 64 + (r & 63);
        if (pn == 0) return rope;
        if (pn == 1) return 256 + q;
        if (pn == 2) return 512 + q;
        if (pn == 3) return r < 32 ? 768 + bj * 32 + r : -1;
        if (pn == 4) return 832 + rope;
        if (pn == 5) return 1088 + q;
        if (pn < 10) return 1344 + (pn - 6) * 256 + rope;
        if (pn < 12) return 2368 + (pn - 10) * 256 + q;
        if (pn < 16) return 2880 + (pn - 12) * 256 + rope;
        if (pn < 24) return 3904 + bj * 1024 + 128 * (pn - 16) + r;
        return 5952 + (n - 6144);
    }
    if (mode == 1) { if (n < 1024) return (n >> 7) * 192 + (n & 127);
        const int m = n - 1024, t = m >> 8, bj = (m >> 7) & 1, q = m & 127; return (4 * t + (q >> 5)) * 192 + 128 + bj * 32 + (q & 31); }
    if (mode == 2) { if (n < 1024) return (n >> 7) * 256 + (n & 127); const int m = n - 1024; return (m >> 7) * 256 + 128 + (m & 127); }
    return n;
}
__device__ __forceinline__ void tr_tile(const Ctx& F, const float* src, int ld_src, int mode, int k0, bf16_t* dst, int ldd, int n0, const float* kscale = nullptr) {
    LAS float* T = (LAS float*)F.lds;
    const int kr = F.tid >> 4, nc = (F.tid & 15) * 4, sc = srcmap(mode, n0 + nc);
#pragma unroll
    for (int h = 0; h < 2; ++h) { const int k = kr + 32 * h; f32x4 v = {0.f, 0.f, 0.f, 0.f};
        if (sc >= 0) v = *(const f32x4*)(src + (size_t)(k0 + k) * ld_src + sc);
        if (kscale) v = v * kscale[k0 + k];
        T[k * 65 + nc + 0] = v[0]; T[k * 65 + nc + 1] = v[1]; T[k * 65 + nc + 2] = v[2]; T[k * 65 + nc + 3] = v[3]; }
    __syncthreads();
    const int n = F.tid >> 3, kc = (F.tid & 7) * 8;
    u32x4 w;
    w.x = cvt_pk_bf16(T[(kc + 0) * 65 + n], T[(kc + 1) * 65 + n]); w.y = cvt_pk_bf16(T[(kc + 2) * 65 + n], T[(kc + 3) * 65 + n]);
    w.z = cvt_pk_bf16(T[(kc + 4) * 65 + n], T[(kc + 5) * 65 + n]); w.w = cvt_pk_bf16(T[(kc + 6) * 65 + n], T[(kc + 7) * 65 + n]);
    *(u32x4*)(dst + (size_t)(n0 + n) * ldd + k0 + kc) = w;
    __syncthreads();
}
__device__ __forceinline__ void cvt_rows(const Ctx& F, const float* src, bf16_t* dst, size_t n8) {
    for (size_t i = (size_t)F.bid * 512 + F.tid; i < n8; i += (size_t)F.G * 512) {
        const f32x4 a = *(const f32x4*)(src + i * 8), b = *(const f32x4*)(src + i * 8 + 4);
        *(u32x4*)(dst + i * 8) = pg8::pack8(a, b); }
}

__device__ __forceinline__ void cvt_rows_fp8(const Ctx& F, const float* src, unsigned char* dst, size_t n16, float scale) {
    for (size_t i = (size_t)F.bid * 512 + F.tid; i < n16; i += (size_t)F.G * 512) {
        u32x4 w;
#pragma unroll
        for (int j = 0; j < 4; ++j) { const f32x4 a = *(const f32x4*)(src + i * 16 + 4 * j) * scale;
            int p = 0; p = __builtin_amdgcn_cvt_pk_fp8_f32(a[0], a[1], p, false); p = __builtin_amdgcn_cvt_pk_fp8_f32(a[2], a[3], p, true); w[j] = (unsigned)p; }
        *(u32x4*)(dst + i * 16) = w; }
}

__device__ __forceinline__ void ph_prologue(const Ctx& F0) {
    const Ctx F = phase_ctx(F0);
    using namespace cf;
    constexpr int T_WIN = 2 * 32 * 224, T_QUP = 2 * 8 * 24, T_KVUP = 2 * 4 * 32, T_BR = 2 * 4 * 16 * 32, T_WO = 2 * 32 * 32;
    constexpr int T_ALL = T_WIN + T_QUP + T_KVUP + T_BR + T_WO;
    for (int u = F.bid; u < T_ALL; u += F.G) {
        int t = u;
        if (t < T_WIN) { const int l = t / (32 * 224), r = t % (32 * 224), kt = r / 224, nt = r % 224;
            tr_tile(F, F.in[I_WIN] + (size_t)l * 2048 * IN_COLS, IN_COLS, 0, kt * 64, WSP(bf16_t, WS_WIN) + (size_t)l * NC * 2048, 2048, nt * 64); continue; }
        t -= T_WIN;
        if (t < T_QUP) { const int l = t / (8 * 24), r = t % (8 * 24), kt = r / 24, nt = r % 24;
            tr_tile(F, F.in[I_WQUP] + (size_t)l * 512 * 1536, 1536, 1, kt * 64, WSP(bf16_t, WS_WQUP) + (size_t)l * 1536 * 512, 512, nt * 64, F.in[I_BQN] + l * 512); continue; }
        t -= T_QUP;
        if (t < T_KVUP) { const int l = t / (4 * 32), r = t % (4 * 32), kt = r / 32, nt = r % 32;
            tr_tile(F, F.in[I_WKVUP] + (size_t)l * 256 * 2048, 2048, 2, kt * 64, WSP(bf16_t, WS_WKVUP) + (size_t)l * 2048 * 256, 256, nt * 64, F.in[I_BKVN] + l * 256); continue; }
        t -= T_KVUP;
        if (t < T_BR) { const int l = t / (4 * 512), r = t % (4 * 512), br = r / 512, r2 = r % 512, kt = r2 / 32, nt = r2 % 32;
            const float* src = (br == 0 ? F.in[I_WBRA] : br == 1 ? F.in[I_WBRB] : br == 2 ? F.in[I_WBRC] : F.in[I_WBRD]) + (size_t)l * 1024 * 2048;
            tr_tile(F, src, 2048, 3, kt * 64, WSP(bf16_t, WS_WBR) + ((size_t)l * 4 + br) * 2048 * 1024, 1024, nt * 64); continue; }
        t -= T_BR;
        { const int l = t / 1024, r = t % 1024, kt = r / 32, nt = r % 32;
            tr_tile(F, F.in[I_WO] + (size_t)l * 2048 * 2048, 2048, 3, kt * 64, WSP(bf16_t, WS_WO) + (size_t)l * 2048 * 2048, 2048, nt * 64); }
    }
    for (int u = F.bid; u < 2 * 16 * 32; u += F.G) {
        const int l = u / 512, g = (u % 512) / 32, d0 = (u % 32) * 64;
        LAS float* sk = (LAS float*)F.lds; LAS float* wt = (LAS float*)(F.lds + 128 * 129 * 4);
        const float* skg = F.in[I_PSK] + ((size_t)l * 16 + g) * 128 * 128;
        const float* wqg = F.in[I_PWQ] + (size_t)l * 2048 * 2048 + (size_t)d0 * 2048 + g * 128;
        for (int i = F.tid; i < 128 * 128; i += 512) sk[(i >> 7) * 129 + (i & 127)] = skg[i];
        for (int i = F.tid; i < 64 * 128; i += 512) wt[(i >> 7) * 129 + (i & 127)] = wqg[(size_t)(i >> 7) * 2048 + (i & 127)];
        __syncthreads();
        const int n = F.tid & 127, dg = F.tid >> 7;
        float a[16];
#pragma unroll
        for (int e = 0; e < 16; ++e) a[e] = 0.f;
        for (int k = 0; k < 128; ++k) { const float s = sk[n * 129 + k];
#pragma unroll
            for (int e = 0; e < 16; ++e) a[e] += wt[(dg * 16 + e) * 129 + k] * s; }
        bf16_t* dst = WSP(bf16_t, WS_WFOLD) + (size_t)l * 2048 * 2048 + (size_t)(g * 128 + n) * 2048 + d0 + dg * 16;
        u32x4 w0, w1;
        w0.x = cvt_pk_bf16(a[0], a[1]); w0.y = cvt_pk_bf16(a[2], a[3]); w0.z = cvt_pk_bf16(a[4], a[5]); w0.w = cvt_pk_bf16(a[6], a[7]);
        w1.x = cvt_pk_bf16(a[8], a[9]); w1.y = cvt_pk_bf16(a[10], a[11]); w1.z = cvt_pk_bf16(a[12], a[13]); w1.w = cvt_pk_bf16(a[14], a[15]);
        *(u32x4*)dst = w0; *(u32x4*)(dst + 8) = w1;
        __syncthreads();
    }
    for (int u = F.bid; u < 2 * 192; u += F.G) {
        const int l = u / 192, n0 = (u % 192) * 64;
        LAS float* sl = (LAS float*)F.lds; LAS float* red = (LAS float*)(F.lds + 5 * 2048 * 4);
        for (int i = F.tid; i < 5 * 2048; i += 512) { const int r = i >> 11, k = i & 2047; const float v = r < 4 ? F.in[I_C][r * 2048 + k] : F.in[I_CCTX][k]; sl[i] = v * sigmoidf_(v); }
        __syncthreads();
        const int col = F.tid & 63, ks = F.tid >> 6;
        float a[5] = {0.f, 0.f, 0.f, 0.f, 0.f};
        const float* wp = F.in[I_WADA] + (size_t)l * 2048 * 12288 + n0 + col;
        for (int k = ks * 256; k < ks * 256 + 256; ++k) { const float w = wp[(size_t)k * 12288];
#pragma unroll
            for (int r = 0; r < 5; ++r) a[r] += sl[r * 2048 + k] * w; }
#pragma unroll
        for (int r = 0; r < 5; ++r) red[(ks * 5 + r) * 64 + col] = a[r];
        __syncthreads();
        if (F.tid < 320) { const int r = F.tid >> 6; float s = 0.f;
#pragma unroll
            for (int k2 = 0; k2 < 8; ++k2) s += red[(k2 * 5 + r) * 64 + col];
            WSP(float, WS_MOD)[((size_t)l * 5 + r) * 12288 + n0 + col] = s + F.in[I_BADA][(size_t)l * 12288 + n0 + col]; }
        __syncthreads();
    }
    for (int i = F.bid * 512 + F.tid; i < 4096 * 64; i += F.G * 512) {
        const int pos = i >> 6, j = i & 63, fi = j & 31; const float fr = powf(10000.0f, -(float)(2 * fi) / 64.0f);
        const float ang = (float)(j < 32 ? (pos >> 6) : (pos & 63)) * fr;
        WSP(float, WS_COSH)[i] = cosf(ang); WSP(float, WS_SINH)[i] = sinf(ang);
    }
    for (int i = F.bid * 512 + F.tid; i < 4096 * 32; i += F.G * 512) {
        const int pos = i >> 5, j = i & 31, fi = j & 15; const float fr = powf(10000.0f, -(float)(2 * fi) / 32.0f);
        const float ang = (float)(j < 16 ? (pos >> 6) : (pos & 63)) * fr;
        WSP(float, WS_COSR)[i] = cosf(ang); WSP(float, WS_SINR)[i] = sinf(ang);
    }
    cvt_rows_fp8(F, F.in[I_PU], WSP(unsigned char, WS_UB), (size_t)2 * NEXP * 2048 / 16, 1024.f);
    cvt_rows_fp8(F, F.in[I_PV], WSP(unsigned char, WS_VB2), (size_t)2 * NEXP * 2048 / 16, 16.f);
}

__device__ __forceinline__ void ph_modulate0(const Ctx& F0) {
    const Ctx F = phase_ctx(F0);
    using namespace cf;
    const float* mod = WSP(float, WS_MOD);
    for (size_t i = (size_t)F.bid * 512 + F.tid; i < (size_t)MR * 256; i += (size_t)F.G * 512) {
        const int R = (int)(i >> 8), d = (int)(i & 255) * 8, b = R / RB, j = R % RB;
        const float* src = j < CTX ? F.in[I_CTX] + ((size_t)b * CTX + j) * 2048 : F.in[I_X] + ((size_t)b * S + (j - CTX)) * 2048;
        const float* m = mod + (size_t)(j < CTX ? 4 : b) * 12288;
        const f32x4 x0 = *(const f32x4*)(src + d), x1 = *(const f32x4*)(src + d + 4);
        const f32x4 sh0 = *(const f32x4*)(m + d), sh1 = *(const f32x4*)(m + d + 4), s0 = *(const f32x4*)(m + 2048 + d), s1 = *(const f32x4*)(m + 2048 + d + 4);
        *(u32x4*)(WSP(bf16_t, WS_HB) + (size_t)R * 2048 + d) = pg8::pack8(x0 * (s0 + 1.0f) + sh0, x1 * (s1 + 1.0f) + sh1);
    }
}

__device__ __forceinline__ void knorm_pass(const Ctx& F) {
    using namespace cf;
    bf16_t* P = WSP(bf16_t, WS_P); const float* ssk = WSP(const float, WS_SSK);
    for (int it = F.bid * 8 + F.wave; it < MR * 2; it += F.G * 8) {
        const int R = it >> 1, h = it & 1;
        const f32x2 pp = *(const f32x2*)(ssk + (size_t)it * 2); const float r = rsqrtf((pp.x + pp.y) * (1.f / 128.f) + 1e-6f);
        unsigned* q = (unsigned*)(P + (size_t)R * NC + PC_AK + h * 128) + F.lane;
        const unsigned w = *q; *q = cvt_pk_bf16(bflo(w) * r, bfhi(w) * r);
    }
}

struct AttnArgs {
    const bf16_t* Q; const bf16_t* K; const bf16_t* V; bf16_t* O; int ldq, ldk, ldv, ldo;
    int seg0_row, seg0_tiles, seg1_row, seg1_tiles;
    int mask_on, qpos0, kpos1;
    float sc_log2; int has_sink; float sink_l2;
    const float* qss;
};
typedef float f32x16 __attribute__((ext_vector_type(16)));
template <int DK>
__device__ __forceinline__ void attn_unit(ldsp_t lds, const AttnArgs a) {
    constexpr int ND = DK / 16, KST = DK + 8, KCH = DK / 8, KPT = (64 * KCH) / 512, VST = 72;
    constexpr int KBUF = 64 * KST * 2, VBUF = 128 * VST * 2, VOFF = 2 * KBUF, ALOFF = VOFF + 3 * VBUF;
    int tid = threadIdx.x; asm volatile("" : "+v"(tid));
    const int wid = __builtin_amdgcn_readfirstlane(tid >> 6), lane = tid & 63, q32 = lane & 31, hi = lane >> 5;
    LAS float* al = (LAS float*)(lds + ALOFF + wid * 128);
    bf16x8 qf[ND];
    { float scq = a.sc_log2;
      if (a.qss) { const f32x2 pp = *(const f32x2*)(a.qss + (size_t)(wid * 32 + q32) * 16); scq *= rsqrtf((pp.x + pp.y) * (1.f / 128.f) + 1e-6f); }
      const bf16_t* qrow = a.Q + (size_t)(wid * 32 + q32) * a.ldq + 8 * hi;
#pragma unroll
      for (int s = 0; s < ND; ++s) { const u32x4 w = *(const u32x4*)(qrow + 16 * s); u32x4 o;
          o.x = cvt_pk_bf16(bflo(w.x) * scq, bfhi(w.x) * scq); o.y = cvt_pk_bf16(bflo(w.y) * scq, bfhi(w.y) * scq);
          o.z = cvt_pk_bf16(bflo(w.z) * scq, bfhi(w.z) * scq); o.w = cvt_pk_bf16(bflo(w.w) * scq, bfhi(w.w) * scq); qf[s] = *(bf16x8*)&o; } }
    f32x16 o[4];
#pragma unroll
    for (int db = 0; db < 4; ++db)
#pragma unroll
        for (int r = 0; r < 16; ++r) o[db][r] = 0.f;
    float m_run = -1e30f, l_run = 0.f;
    const int ntiles = a.seg0_tiles + a.seg1_tiles;
    u32x4 kreg[KPT], vreg[2];
    const int vkp = tid & 31, vdc = tid >> 5;
    const int vkey = 2 * vkp, vpos = (vkey & 48) | ((vkey & 4) << 1) | ((vkey & 8) >> 1) | (vkey & 3);
#define ATT_LOAD(tt) do { const int _r0 = (tt) < a.seg0_tiles ? a.seg0_row + 64 * (tt) : a.seg1_row + 64 * ((tt) - a.seg0_tiles); \
        _Pragma("unroll") for (int _i = 0; _i < KPT; ++_i) { const int _c = tid + 512 * _i; kreg[_i] = *(const u32x4*)(a.K + (size_t)(_r0 + _c / KCH) * a.ldk + 8 * (_c % KCH)); } \
        vreg[0] = *(const u32x4*)(a.V + (size_t)(_r0 + 2 * vkp) * a.ldv + 8 * vdc); vreg[1] = *(const u32x4*)(a.V + (size_t)(_r0 + 2 * vkp + 1) * a.ldv + 8 * vdc); } while (0)
#define ATT_WRITE(kb, vb) do { const ldsp_t _kb = lds + (kb) * KBUF; const ldsp_t _vb = lds + VOFF + (vb) * VBUF; \
        _Pragma("unroll") for (int _i = 0; _i < KPT; ++_i) { const int _c = tid + 512 * _i; *(LAS u32x4*)(_kb + ((_c / KCH) * KST + 8 * (_c % KCH)) * 2) = kreg[_i]; } \
        const unsigned _a0[4] = {vreg[0].x, vreg[0].y, vreg[0].z, vreg[0].w}, _a1[4] = {vreg[1].x, vreg[1].y, vreg[1].z, vreg[1].w}; \
        _Pragma("unroll") for (int _e = 0; _e < 4; ++_e) { \
            *(LAS unsigned*)(_vb + ((8 * vdc + 2 * _e) * VST + vpos) * 2) = (_a0[_e] & 0xffffu) | (_a1[_e] << 16); \
            *(LAS unsigned*)(_vb + ((8 * vdc + 2 * _e + 1) * VST + vpos) * 2) = (_a0[_e] >> 16) | (_a1[_e] & 0xffff0000u); } } while (0)
#define ATT_PV(vb) do { const ldsp_t _vt = lds + VOFF + (vb) * VBUF; \
        _Pragma("unroll") for (int db = 0; db < 4; ++db) _Pragma("unroll") for (int ks = 0; ks < 4; ++ks) { \
            const bf16x8 vf = *(const LAS bf16x8*)(_vt + ((32 * db + q32) * VST + 16 * ks + 8 * hi) * 2); \
            o[db] = __builtin_amdgcn_mfma_f32_32x32x16_bf16(pa[ks], vf, o[db], 0, 0, 0); } } while (0)
    bf16x8 pa[4];
    int vprev = 2, vcur = 0, vnext = 1;
    ATT_LOAD(0);
    ATT_WRITE(0, 0);
    __syncthreads();
    for (int tt = 0; tt < ntiles; ++tt) {
        const int cur = tt & 1;
        if (tt + 1 < ntiles) ATT_LOAD(tt + 1);
        const ldsp_t Ks = lds + cur * KBUF;
        f32x16 s0, s1;
#pragma unroll
        for (int r = 0; r < 16; ++r) { s0[r] = 0.f; s1[r] = 0.f; }
#pragma unroll
        for (int s = 0; s < ND; ++s) {
            const bf16x8 k0 = *(const LAS bf16x8*)(Ks + (q32 * KST + 16 * s + 8 * hi) * 2), k1 = *(const LAS bf16x8*)(Ks + ((32 + q32) * KST + 16 * s + 8 * hi) * 2);
            s0 = __builtin_amdgcn_mfma_f32_32x32x16_bf16(k0, qf[s], s0, 0, 0, 0);
            s1 = __builtin_amdgcn_mfma_f32_32x32x16_bf16(k1, qf[s], s1, 0, 0, 0); }
        if (tt > 0) ATT_PV(vprev);
        const bool msk = a.mask_on && tt >= a.seg0_tiles;
        const int kp0 = a.kpos1 + 64 * (tt - a.seg0_tiles) + 4 * hi, qp = a.qpos0 + wid * 32 + q32;
        float mx = -1e30f;
#pragma unroll
        for (int r = 0; r < 16; ++r) { float t0 = s0[r], t1 = s1[r];
            if (msk) { const int d0 = qp - (kp0 + (r & 3) + 8 * (r >> 2)), d1 = d0 - 32; if (d0 > 128 || d0 < -128) t0 = -1e30f; if (d1 > 128 || d1 < -128) t1 = -1e30f; s0[r] = t0; s1[r] = t1; }
            mx = fmaxf(mx, fmaxf(t0, t1)); }
        mx = fmaxf(mx, __shfl_xor(mx, 32));
        const float m_new = fmaxf(m_run, mx), alpha = __builtin_amdgcn_exp2f(m_run - m_new); m_run = m_new;
        float ps = 0.f;
#pragma unroll
        for (int r = 0; r < 16; ++r) { s0[r] = __builtin_amdgcn_exp2f(s0[r] - m_new); s1[r] = __builtin_amdgcn_exp2f(s1[r] - m_new); ps += s0[r] + s1[r]; }
        l_run = l_run * alpha + ps;
        if (__any(alpha < 1.0f)) {
            if (hi == 0) al[q32] = alpha;
            asm volatile("s_waitcnt lgkmcnt(0)" ::: "memory");
#pragma unroll
            for (int g4 = 0; g4 < 4; ++g4) { const f32x4 av = *(const LAS f32x4*)(al + 8 * g4 + 4 * hi);
#pragma unroll
                for (int db = 0; db < 4; ++db)
#pragma unroll
                    for (int j = 0; j < 4; ++j) o[db][4 * g4 + j] *= av[j]; }
        }
#pragma unroll
        for (int g2 = 0; g2 < 2; ++g2) {
            u32x4 w; w.x = cvt_pk_bf16(s0[8 * g2 + 0], s0[8 * g2 + 1]); w.y = cvt_pk_bf16(s0[8 * g2 + 2], s0[8 * g2 + 3]); w.z = cvt_pk_bf16(s0[8 * g2 + 4], s0[8 * g2 + 5]); w.w = cvt_pk_bf16(s0[8 * g2 + 6], s0[8 * g2 + 7]); pa[g2] = *(bf16x8*)&w;
            u32x4 v; v.x = cvt_pk_bf16(s1[8 * g2 + 0], s1[8 * g2 + 1]); v.y = cvt_pk_bf16(s1[8 * g2 + 2], s1[8 * g2 + 3]); v.z = cvt_pk_bf16(s1[8 * g2 + 4], s1[8 * g2 + 5]); v.w = cvt_pk_bf16(s1[8 * g2 + 6], s1[8 * g2 + 7]); pa[2 + g2] = *(bf16x8*)&v; }
        if (tt + 1 < ntiles) ATT_WRITE(cur ^ 1, vnext);
        { const int t3 = vprev; vprev = vcur; vcur = vnext; vnext = t3; }
        __syncthreads();
    }
    ATT_PV(vprev);
#undef ATT_LOAD
#undef ATT_WRITE
#undef ATT_PV
    __syncthreads();
    float l_tot = l_run + __shfl_xor(l_run, 32);
    if (a.has_sink) l_tot += __builtin_amdgcn_exp2f(a.sink_l2 - m_run);
    if (hi == 0) al[q32] = 1.0f / l_tot;
    asm volatile("s_waitcnt lgkmcnt(0)" ::: "memory");
    const ldsp_t Ost = lds + wid * 8192;
#pragma unroll
    for (int g4 = 0; g4 < 4; ++g4) { const f32x4 iv = *(const LAS f32x4*)(al + 8 * g4 + 4 * hi);
#pragma unroll
        for (int db = 0; db < 4; ++db)
#pragma unroll
            for (int j = 0; j < 4; ++j) *(LAS bf16_t*)(Ost + ((8 * g4 + 4 * hi + j) * 128 + 32 * db + q32) * 2) = f2bf(o[db][4 * g4 + j] * iv[j]); }
    asm volatile("s_waitcnt lgkmcnt(0)" ::: "memory");
#pragma unroll
    for (int i = 0; i < 8; ++i) { const int c = lane + 64 * i, row = c >> 4, c8 = c & 15;
        *(u32x4*)(a.O + (size_t)(wid * 32 + row) * a.ldo + 8 * c8) = *(const LAS u32x4*)(Ost + (row * 128 + 8 * c8) * 2); }
}

__device__ __forceinline__ void conv_unit(const Ctx& F, int layer, int row0  , int seq_len, int t0) {
    using namespace cf;
    const bf16_t* P = WSP(const bf16_t, WS_P); bf16_t* BR = WSP(bf16_t, WS_BR);
    const float* cw = F.in[I_CW] + (size_t)layer * 31 * 1024; const float* cb = F.in[I_CB] + layer * 1024;
    const float* lg = F.in[I_CLG] + layer * 1024; const float* lb = F.in[I_CLB] + layer * 1024;
    int tid = F.tid; asm volatile("" : "+v"(tid));
    const int lane = tid & 63;
    LAS float* red = (LAS float*)(F.lds + 126976); LAS float* tot = red + 8 * 32;
    __syncthreads();
    for (int c = tid; c < 62 * 128; c += 512) { const int rr = c >> 7, ch = c & 127, t = t0 - 15 + rr;
        u32x4 v = {0u, 0u, 0u, 0u};
        if (t >= 0 && t < seq_len) v = *(const u32x4*)(P + (size_t)(row0 + t) * NC + PC_GLU + ch * 8);
        *(LAS u32x4*)(F.lds + rr * 2048 + ch * 16) = v; }
    float w0[31], w1[31];
#pragma unroll
    for (int k = 0; k < 31; ++k) { const f32x2 w = *(const f32x2*)(cw + k * 1024 + 2 * tid); w0[k] = w.x; w1[k] = w.y; }
    const f32x2 bv = *(const f32x2*)(cb + 2 * tid), gg = *(const f32x2*)(lg + 2 * tid), bb = *(const f32x2*)(lb + 2 * tid);
    __syncthreads();
#pragma unroll 1
    for (int part = 0; part < 4; ++part) {
        float a0[8], a1[8];
#pragma unroll
        for (int t = 0; t < 8; ++t) { a0[t] = bv.x; a1[t] = bv.y; }
        const ldsp_t base = F.lds + part * 8 * 2048 + tid * 4;
#pragma unroll
        for (int rr = 0; rr < 38; ++rr) { const unsigned xw = *(const LAS unsigned*)(base + rr * 2048); const float x0 = bflo(xw), x1 = bfhi(xw);
#pragma unroll
            for (int t = 0; t < 8; ++t) { const int k = rr - t; if (k >= 0 && k <= 30) { a0[t] += x0 * w0[k]; a1[t] += x1 * w1[k]; } } }
        float v[16];
#pragma unroll
        for (int t = 0; t < 8; ++t) { v[t] = a0[t] + a1[t]; v[8 + t] = a0[t] * a0[t] + a1[t] * a1[t]; }
#pragma unroll
        for (int i = 0; i < 8; ++i) { const bool up = lane & 32; const float snd = up ? v[i] : v[i + 8], kp = up ? v[i + 8] : v[i]; v[i] = kp + __shfl_xor(snd, 32); }
#pragma unroll
        for (int i = 0; i < 4; ++i) { const bool up = lane & 16; const float snd = up ? v[i] : v[i + 4], kp = up ? v[i + 4] : v[i]; v[i] = kp + __shfl_xor(snd, 16); }
#pragma unroll
        for (int i = 0; i < 2; ++i) { const bool up = lane & 8; const float snd = up ? v[i] : v[i + 2], kp = up ? v[i + 2] : v[i]; v[i] = kp + __shfl_xor(snd, 8); }
        { const bool up = lane & 4; const float snd = up ? v[0] : v[1], kp = up ? v[1] : v[0]; v[0] = kp + __shfl_xor(snd, 4); }
        v[0] += __shfl_xor(v[0], 2); v[0] += __shfl_xor(v[0], 1);
        if ((lane & 3) == 0) red[F.wave * 16 + (lane >> 2)] = v[0];
        __syncthreads();
        if (tid < 16) { float s = 0.f;
#pragma unroll
            for (int w = 0; w < 8; ++w) s += red[w * 16 + tid];
            tot[tid] = s; }
        __syncthreads();
#pragma unroll
        for (int t = 0; t < 8; ++t) { const float mean = tot[t] * (1.f / 1024.f), var = fmaxf(tot[8 + t] * (1.f / 1024.f) - mean * mean, 0.f), rstd = rsqrtf(var + 1e-5f);
            const float y0 = (a0[t] - mean) * rstd * gg.x + bb.x, y1 = (a1[t] - mean) * rstd * gg.y + bb.y;
            *(unsigned*)(BR + (size_t)(row0 + t0 + part * 8 + t) * 4096 + 2048 + 2 * tid) = cvt_pk_bf16(y0 * sigmoidf_(y0), y1 * sigmoidf_(y1)); }
    }
}

__device__ __forceinline__ void attn_defaults(AttnArgs& a, int isctx) {
    a.seg0_row = 0; a.seg0_tiles = isctx ? 4 : 68; a.seg1_row = 0; a.seg1_tiles = 0; a.mask_on = 0; a.qpos0 = 0; a.kpos1 = 0; a.has_sink = 0; a.sink_l2 = 0.f; a.qss = nullptr; }
__device__ __forceinline__ void ph_attn(const Ctx& F0, int layer) {
    const Ctx F = phase_ctx(F0);
    using namespace cf;
    const bf16_t* P = WSP(const bf16_t, WS_P); bf16_t* BR = WSP(bf16_t, WS_BR);
    for (int dup = 0; dup < DUPN(2); ++dup)
    for (int u = F.bid; u < (layer == 0 ? 544 : 512); u += F.G) {
        int b, h, qb, isctx = 0;
        if (u < 512) { b = u >> 7; h = (u >> 4) & 7; qb = u & 15; } else { const int r = u - 512; b = r >> 3; h = r & 7; qb = 0; isctx = 1; }
        const size_t brow = (size_t)b * RB, qrow = brow + (isctx ? 0 : CTX) + (size_t)qb * 256;
        AttnArgs a; attn_defaults(a, isctx);
        a.Q = WSP(const bf16_t, WS_QB) + qrow * 1536 + h * 192; a.ldq = 1536;
        a.K = WSP(const bf16_t, WS_KB) + brow * 1536 + h * 192; a.ldk = 1536;
        a.V = WSP(const bf16_t, WS_VB) + brow * 1024 + h * 128; a.ldv = 1024;
        a.O = BR + qrow * 4096 + 1024 + h * 128; a.ldo = 4096; a.sc_log2 = SCALE_MLA * LOG2E;
        __syncthreads();
        attn_unit<192>(F.lds, a);
    }
    for (int dup = 0; dup < DUPN(3); ++dup)
    for (int u0 = F.bid; u0 < (layer == 0 ? 1088 : 1024); u0 += F.G) {
        int kind, b, h, qb, isctx = 0;
        if (u0 < 1024) { kind = 1 + (u0 >> 9); const int r = u0 & 511; b = r >> 7; h = (r >> 4) & 7; qb = r & 15; }
        else { const int r = u0 - 1024; kind = 1 + (r >> 5); const int r2 = r & 31; b = r2 >> 3; h = r2 & 7; qb = 0; isctx = 1; }
        const size_t brow = (size_t)b * RB, qrow = brow + (isctx ? 0 : CTX) + (size_t)qb * 256;
        AttnArgs a; attn_defaults(a, isctx);
        const int qc = kind == 1 ? PC_AQ : PC_DQ, kc = kind == 1 ? PC_AK : PC_DK, vc = kind == 1 ? PC_AV : PC_DV;
        a.Q = P + qrow * NC + qc + h * 128; a.ldq = NC;
        a.K = P + brow * NC + kc + (h >> 2) * 128; a.ldk = NC;
        a.V = P + brow * NC + vc + (h >> 2) * 128; a.ldv = NC;
        a.O = BR + qrow * 4096 + (kind == 1 ? 0 : 3072) + h * 128; a.ldo = 4096; a.sc_log2 = SCALE_HD * LOG2E;
        if (kind == 1) a.qss = WSP(const float, WS_SSQ) + qrow * 16 + h * 2;
        if (kind == 2) { a.has_sink = 1; a.sink_l2 = F.in[I_SINK][layer * 8 + h] * LOG2E; a.seg0_tiles = 4;
            if (!isctx) { const int start = qb * 256; const int lo = start - 128 < 0 ? 0 : start - 128, hi = start + 384 > S ? S : start + 384;
                a.seg1_row = CTX + lo; a.seg1_tiles = (hi - lo) / 64; a.mask_on = 1; a.qpos0 = start; a.kpos1 = lo; } }
        __syncthreads();
        attn_unit<128>(F.lds, a);
    }
    for (int dup = 0; dup < DUPN(4); ++dup)
    for (int u = F.bid; u < (layer == 0 ? 544 : 512); u += F.G) {
        int b, tb, isctx = 0;
        if (u < 512) { b = u >> 7; tb = u & 127; } else { const int r = u - 512; b = r >> 3; tb = r & 7; isctx = 1; }
        conv_unit(F, layer, b * RB + (isctx ? 0 : CTX), isctx ? CTX : S, tb * 32);
    }
}

__device__ __forceinline__ int tok_row(int layer, int tok) { return layer == 0 ? tok : (tok >> 12) * cf::RB + cf::CTX + (tok & 4095); }
__device__ __forceinline__ void ph_ln1(const Ctx& F0, int layer) {
    const Ctx F = phase_ctx(F0);
    using namespace cf;
    float* X1 = (float*)(F.ws + WS_P + X1_OFF); bf16_t* HB = WSP(bf16_t, WS_HB);
    const float* lg = F.in[I_LN1G] + layer * 2048; const float* lb = F.in[I_LN1B] + layer * 2048;
    const int ntok = layer == 0 ? MR : NB * S, lane = F.lane;
    for (int tok = F.bid * 8 + F.wave; tok < ntok; tok += F.G * 8) {
        const int R = tok_row(layer, tok), b = R / RB, j = R % RB;
        const float* mod = WSP(const float, WS_MOD) + ((size_t)layer * 5 + (j < CTX ? 4 : b)) * 12288;
        float* xp = X1 + (size_t)R * 2048;
        f32x4 v[8]; float s = 0.f;
#pragma unroll
        for (int i = 0; i < 8; ++i) { v[i] = *(const f32x4*)(xp + lane * 4 + 256 * i); s += (v[i][0] + v[i][1]) + (v[i][2] + v[i][3]); }
        const float mean = wave_sum(s) * (1.f / 2048.f); float q = 0.f;
#pragma unroll
        for (int i = 0; i < 8; ++i) { const f32x4 d = v[i] - mean; q += (d[0] * d[0] + d[1] * d[1]) + (d[2] * d[2] + d[3] * d[3]); }
        const float rstd = rsqrtf(wave_sum(q) * (1.f / 2048.f) + 1e-5f);
#pragma unroll
        for (int i = 0; i < 8; ++i) { const int c = lane * 4 + 256 * i;
            const f32x4 y = (v[i] - mean) * rstd * *(const f32x4*)(lg + c) + *(const f32x4*)(lb + c);
            *(f32x4*)(xp + c) = y;
            const f32x4 hp = y * (*(const f32x4*)(mod + 4 * 2048 + c) + 1.0f) + *(const f32x4*)(mod + 3 * 2048 + c);
            u32x2 w; w.x = cvt_pk_bf16(hp[0], hp[1]); w.y = cvt_pk_bf16(hp[2], hp[3]);
            *(u32x2*)(HB + (size_t)R * 2048 + c) = w; }
    }
}

typedef __bf16 bf16x2_t __attribute__((ext_vector_type(2)));
__device__ __forceinline__ unsigned ordkey(float v) { const unsigned u = __float_as_uint(v); return (u & 0x80000000u) ? ~u : (u | 0x80000000u); }
__device__ __forceinline__ int lane_rank(unsigned long long m) { return (int)__builtin_amdgcn_mbcnt_hi((unsigned)(m >> 32), __builtin_amdgcn_mbcnt_lo((unsigned)m, 0u)); }
template <int NV> __device__ __forceinline__ unsigned radix_thresh16(const unsigned (&k)[NV]) {
    unsigned T = 0u;
    for (int bit = 31; bit >= 0; --bit) { const unsigned cand = T | (1u << bit); int cnt = 0;
#pragma unroll
        for (int v = 0; v < NV; ++v) cnt += __popcll(__ballot(k[v] >= cand));
        if (cnt >= 16) T = cand; }
    return T;
}
__device__ __forceinline__ float dot2bf(unsigned a, unsigned b, float acc) { return __builtin_amdgcn_fdot2_f32_bf16(__builtin_bit_cast(bf16x2_t, a), __builtin_bit_cast(bf16x2_t, b), acc, false); }
__device__ __forceinline__ float dot8(const u32x4 a, const u32x4 b, float acc) {
    acc = dot2bf(a.x, b.x, acc); acc = dot2bf(a.y, b.y, acc); acc = dot2bf(a.z, b.z, acc); acc = dot2bf(a.w, b.w, acc);
    return acc;
}
__device__ __forceinline__ void ph_peer(const Ctx& F0, int layer) {
    const Ctx F = phase_ctx(F0);
    using namespace cf;
    const float* SC = (const float*)(F.ws + WS_P + SC_OFF); const float* X1 = (const float*)(F.ws + WS_P + X1_OFF);
    bf16_t* HB = WSP(bf16_t, WS_HB); const unsigned char* U8 = WSP(const unsigned char, WS_UB) + (size_t)layer * NEXP * 2048; const unsigned char* V8 = WSP(const unsigned char, WS_VB2) + (size_t)layer * NEXP * 2048;
    const float* lg = F.in[I_LN2G] + layer * 2048; const float* lb = F.in[I_LN2B] + layer * 2048;
    const int ntok = layer == 0 ? MR : NB * S, lane = F.lane;
    ldsp_t wl = F.lds + F.wave * 4096;
    LAS float* tv0 = (LAS float*)wl; LAS int* ti0 = (LAS int*)(wl + 64); LAS float* tv1 = (LAS float*)(wl + 128); LAS int* ti1 = (LAS int*)(wl + 192);
    LAS float* es = (LAS float*)(wl + 256); LAS int* ei = (LAS int*)(wl + 768); LAS float* eg = (LAS float*)(wl + 1280);
    for (int tok = F.bid * 8 + F.wave; tok < ntok; tok += F.G * 8) {
        const int R = tok_row(layer, tok), b = R / RB, j = R % RB; const bool isctx = j < CTX; const int modrow = isctx ? 4 : b;
        const float* sc = SC + (size_t)R * 2048;
        for (int h = 0; h < 8; ++h) {
            const float s0a = sc[(2 * h) * 128 + lane], s0b = sc[(2 * h) * 128 + 64 + lane], s1a = sc[(2 * h + 1) * 128 + lane], s1b = sc[(2 * h + 1) * 128 + 64 + lane];
            { const unsigned k[2] = {(ordkey(s0a) & ~127u) | (unsigned)(127 - lane), (ordkey(s0b) & ~127u) | (unsigned)(63 - lane)};
              const unsigned T = radix_thresh16<2>(k);
              const unsigned long long m0 = __ballot(k[0] >= T), m1 = __ballot(k[1] >= T); const int n0 = __popcll(m0);
              if (k[0] >= T) { const int r = lane_rank(m0); tv0[r] = s0a; ti0[r] = lane; }
              if (k[1] >= T) { const int r = n0 + lane_rank(m1); tv0[r] = s0b; ti0[r] = lane + 64; } }
            { const unsigned k[2] = {(ordkey(s1a) & ~127u) | (unsigned)(127 - lane), (ordkey(s1b) & ~127u) | (unsigned)(63 - lane)};
              const unsigned T = radix_thresh16<2>(k);
              const unsigned long long m0 = __ballot(k[0] >= T), m1 = __ballot(k[1] >= T); const int n0 = __popcll(m0);
              if (k[0] >= T) { const int r = lane_rank(m0); tv1[r] = s1a; ti1[r] = lane; }
              if (k[1] >= T) { const int r = n0 + lane_rank(m1); tv1[r] = s1b; ti1[r] = lane + 64; } }
            asm volatile("s_waitcnt lgkmcnt(0)" ::: "memory");
            const int ci = lane >> 2, cj = (lane & 3) * 4;
            const float a0 = tv0[ci]; const int i0 = ti0[ci];
            float c4[4]; int id4[4]; unsigned kc[4];
#pragma unroll
            for (int jj = 0; jj < 4; ++jj) { c4[jj] = a0 + tv1[cj + jj]; id4[jj] = i0 * 128 + ti1[cj + jj]; kc[jj] = (ordkey(c4[jj]) & ~255u) | (unsigned)(255 - (lane * 4 + jj)); }
            const unsigned Tc = radix_thresh16<4>(kc);
            int base = h * 16;
#pragma unroll
            for (int jj = 0; jj < 4; ++jj) { const unsigned long long m = __ballot(kc[jj] >= Tc);
                if (kc[jj] >= Tc) { const int r = base + lane_rank(m); es[r] = c4[jj]; ei[r] = id4[jj]; }
                base += __popcll(m); }
            asm volatile("s_waitcnt lgkmcnt(0)" ::: "memory");
        }
#pragma unroll
        for (int rnd = 0; rnd < 2; ++rnd) { const int e = lane + 64 * rnd; const float s = es[e];
            float m = s; m = fmaxf(m, __shfl_xor(m, 1)); m = fmaxf(m, __shfl_xor(m, 2)); m = fmaxf(m, __shfl_xor(m, 4)); m = fmaxf(m, __shfl_xor(m, 8));
            const float ex = __expf(s - m); float sum = ex; sum += __shfl_xor(sum, 1); sum += __shfl_xor(sum, 2); sum += __shfl_xor(sum, 4); sum += __shfl_xor(sum, 8);
            eg[e] = ex / sum; }
        asm volatile("s_waitcnt lgkmcnt(0)" ::: "memory");
        f32x2 xf[16];
#pragma unroll
        for (int i = 0; i < 2; ++i)
#pragma unroll
            for (int hh = 0; hh < 2; ++hh) { const u32x4 w = *(const u32x4*)(HB + (size_t)R * 2048 + lane * 16 + 1024 * i + 8 * hh);
                xf[8 * i + 4 * hh + 0] = (f32x2){bflo(w.x), bfhi(w.x)}; xf[8 * i + 4 * hh + 1] = (f32x2){bflo(w.y), bfhi(w.y)};
                xf[8 * i + 4 * hh + 2] = (f32x2){bflo(w.z), bfhi(w.z)}; xf[8 * i + 4 * hh + 3] = (f32x2){bflo(w.w), bfhi(w.w)}; }
        f32x2 y2[16];
#pragma unroll
        for (int i = 0; i < 16; ++i) y2[i] = (f32x2){0.f, 0.f};
        for (int grp = 0; grp < 32; ++grp) {
            int id[4]; float gq[4];
#pragma unroll
            for (int q = 0; q < 4; ++q) { id[q] = __builtin_amdgcn_readfirstlane(ei[grp * 4 + q]); gq[q] = __uint_as_float(__builtin_amdgcn_readfirstlane(__float_as_uint(eg[grp * 4 + q]))); }
            u32x4 ur[4][2], vr[4][2];
#pragma unroll
            for (int q = 0; q < 4; ++q)
#pragma unroll
                for (int i = 0; i < 2; ++i) { ur[q][i] = *(const u32x4*)(U8 + (size_t)id[q] * 2048 + lane * 16 + 1024 * i); vr[q][i] = *(const u32x4*)(V8 + (size_t)id[q] * 2048 + lane * 16 + 1024 * i); }
            float d[4];
#pragma unroll
            for (int q = 0; q < 4; ++q) { f32x2 t = {0.f, 0.f};
#pragma unroll
                for (int i = 0; i < 2; ++i)
#pragma unroll
                    for (int j = 0; j < 4; ++j) { const int w = (int)ur[q][i][j];
                        t += __builtin_amdgcn_cvt_pk_f32_fp8(w, false) * xf[8 * i + 2 * j]; t += __builtin_amdgcn_cvt_pk_f32_fp8(w, true) * xf[8 * i + 2 * j + 1]; }
                d[q] = t.x + t.y; }
#pragma unroll
            for (int o = 32; o >= 1; o >>= 1) {
#pragma unroll
                for (int q = 0; q < 4; ++q) d[q] += __shfl_xor(d[q], o); }
#pragma unroll
            for (int q = 0; q < 4; ++q) { const float dd = d[q] * (1.0f / 1024.0f); const float w = gq[q] * 0.5f * dd * (1.0f + erff(dd * 0.70710678118654752f)) * (1.0f / 16.0f);
                const f32x2 w2 = {w, w};
#pragma unroll
                for (int i = 0; i < 2; ++i)
#pragma unroll
                    for (int j = 0; j < 4; ++j) { const int vw = (int)vr[q][i][j];
                        y2[8 * i + 2 * j] += w2 * __builtin_amdgcn_cvt_pk_f32_fp8(vw, false); y2[8 * i + 2 * j + 1] += w2 * __builtin_amdgcn_cvt_pk_f32_fp8(vw, true); } }
        }
        const float* mod = WSP(const float, WS_MOD) + ((size_t)layer * 5 + modrow) * 12288;
        float y[32];
        float s = 0.f;
#pragma unroll
        for (int i = 0; i < 2; ++i)
#pragma unroll
            for (int j = 0; j < 4; ++j) { const int c = lane * 16 + 1024 * i + 4 * j;
                const f32x4 xa = *(const f32x4*)(X1 + (size_t)R * 2048 + c), ga = *(const f32x4*)(mod + 5 * 2048 + c);
                y[16 * i + 4 * j + 0] = ALPHA * xa[0] + ga[0] * y2[8 * i + 2 * j].x; y[16 * i + 4 * j + 1] = ALPHA * xa[1] + ga[1] * y2[8 * i + 2 * j].y;
                y[16 * i + 4 * j + 2] = ALPHA * xa[2] + ga[2] * y2[8 * i + 2 * j + 1].x; y[16 * i + 4 * j + 3] = ALPHA * xa[3] + ga[3] * y2[8 * i + 2 * j + 1].y;
                s += (y[16 * i + 4 * j + 0] + y[16 * i + 4 * j + 1]) + (y[16 * i + 4 * j + 2] + y[16 * i + 4 * j + 3]); }
        const float mean = wave_sum(s) * (1.f / 2048.f); float q2 = 0.f;
#pragma unroll
        for (int i = 0; i < 32; ++i) { const float dd = y[i] - mean; q2 += dd * dd; }
        const float rstd = rsqrtf(wave_sum(q2) * (1.f / 2048.f) + 1e-5f);
        float* dst = layer == 0 ? (isctx ? WSP(float, WS_XC) + ((size_t)b * CTX + j) * 2048 : F.out + ((size_t)b * S + (j - CTX)) * 2048) : F.out + ((size_t)b * S + (j - CTX)) * 2048;
        const float* modn = WSP(const float, WS_MOD) + ((size_t)1 * 5 + modrow) * 12288;
#pragma unroll
        for (int i = 0; i < 2; ++i)
#pragma unroll
            for (int hh = 0; hh < 2; ++hh) { f32x4 o[2];
#pragma unroll
                for (int jj = 0; jj < 2; ++jj) { const int j = 2 * hh + jj, c = lane * 16 + 1024 * i + 4 * j; const f32x4 la = *(const f32x4*)(lg + c), ba = *(const f32x4*)(lb + c);
#pragma unroll
                    for (int e = 0; e < 4; ++e) o[jj][e] = (y[16 * i + 4 * j + e] - mean) * rstd * la[e] + ba[e];
                    *(f32x4*)(dst + c) = o[jj]; }
                if (layer == 0) {
                    const int c = lane * 16 + 1024 * i + 8 * hh;
                    const f32x4 sa = *(const f32x4*)(modn + 2048 + c), sb = *(const f32x4*)(modn + 2048 + c + 4), ha = *(const f32x4*)(modn + c), hb = *(const f32x4*)(modn + c + 4);
                    *(u32x4*)(HB + (size_t)R * 2048 + c) = pg8::pack8(o[0] * (sa + 1.0f) + ha, o[1] * (sb + 1.0f) + hb); } }
    }
}

struct Params { const float* in[cf::N_IN]; float* out; unsigned char* ws; int ph_lo, ph_hi; };

__global__ void __launch_bounds__(512, 2) mega_fwd(Params p) {
    using namespace cf;
    extern __shared__ __attribute__((aligned(16))) unsigned char smem[];
    Ctx F0;
    F0.in = p.in;
    F0.out = p.out; F0.ws = p.ws; F0.lds = (ldsp_t)smem;
    F0.tid = threadIdx.x; F0.lane = F0.tid & 63; F0.wave = __builtin_amdgcn_readfirstlane(F0.tid >> 6); F0.G = gridDim.x; F0.bid = blockIdx.x;
    if (F0.tid < 64) ((LAS unsigned*)(F0.lds + MISC_OFF))[F0.tid] = 0u;
    __syncthreads();
    const int lo = p.ph_lo, hi = p.ph_hi;
    XcdBarrier bar; bar.bar = (unsigned*)(F0.ws + WS_CTL); bar.x = 0; bar.st = (volatile LAS unsigned*)(F0.lds + MISC_OFF);
    if (hi - lo > 1) bar = xcd_barrier_post((unsigned*)(F0.ws + WS_CTL), (volatile LAS unsigned*)(F0.lds + MISC_OFF));
#ifndef MK_MASK
#define MK_MASK 0xFFFF
#endif
#define ON(j) ((MK_MASK >> (j)) & 1)
#define IN(k) (lo <= (k) && (k) < hi)
#define SEAM(k) do { if (IN(k) && IN((k) + 1)) xcd_barrier(bar); } while (0)

    if (ON(9) && IN(0)) { ph_prologue(F0); if (DUPN(9) == 2) { __syncthreads(); ph_prologue(F0); } }
    SEAM(0);
    if (ON(10) && IN(1)) ph_modulate0(F0);
    SEAM(1);
    for (int l = 0; l < DEPTH; ++l) {
        const int pb = 2 + 8 * l;
        const int rmode = l == 0 ? 0 : 1, nMl = l == 0 ? 68 : 64;
        for (int blk = 0; blk < DUPN(12); ++blk) {
        if (blk) xcd_barrier(bar);
        if (ON(0) && IN(pb + 0)) { const Ctx F = phase_ctx(F0);
            pg8::Gemm g{WSP(const bf16_t, WS_HB), WSP(const bf16_t, WS_WIN) + (size_t)l * NC * 2048, 2048, 2048};
            pg8::EpiInProj E{WSP(bf16_t, WS_P), WSP(bf16_t, WS_KB), WSP(const float, WS_COSH), WSP(const float, WS_SINH), WSP(const float, WS_COSR), WSP(const float, WS_SINR),
                             F.in[I_AKN] + l * 128, F.in[I_AQN] + l * 128, WSP(float, WS_SSK), WSP(float, WS_SSQ), WSP(float, WS_SSKV), WSP(float, WS_SSCQ)};
            pg8::TileOrder S; S.init(nMl, 56, F.G, F.bid, rmode);
            for (int dup = 0; dup < DUPN(0); ++dup)
            pg8::gemm_phase(F.lds, g, S, E);
            if (l > 0) { pg8::TileOrder S2; S2.init(4, 6, F.G, F.bid, 2); pg8::gemm_phase(F.lds, g, S2, E); }
        }
        SEAM(pb + 0);
        if (ON(2) && IN(pb + 1)) { const Ctx F = phase_ctx(F0); bf16_t* P = WSP(bf16_t, WS_P);
            knorm_pass(F);
            { pg8::Gemm g{P + PC_CKV, WSP(const bf16_t, WS_WKVUP) + (size_t)l * 2048 * 256, NC, 256}; pg8::EpiKvUp E{WSP(bf16_t, WS_KB), WSP(bf16_t, WS_VB), WSP(const float, WS_SSKV)};
              pg8::TileOrder S; S.init(68, 8, F.G, F.bid, 0); for (int dup = 0; dup < DUPN(1); ++dup) pg8::gemm_phase(F.lds, g, S, E); }
            { pg8::Gemm g{P + PC_CQ, WSP(const bf16_t, WS_WQUP) + (size_t)l * 1536 * 512, NC, 512}; pg8::EpiQUp E{WSP(bf16_t, WS_QB), WSP(const float, WS_COSR), WSP(const float, WS_SINR), WSP(const float, WS_SSCQ)};
              pg8::TileOrder S; S.init(nMl, 6, F.G, F.bid, rmode); for (int dup = 0; dup < DUPN(1); ++dup) pg8::gemm_phase(F.lds, g, S, E); }
        }
        SEAM(pb + 1);
        if (ON(3) && IN(pb + 2)) ph_attn(F0, l);
        }
        SEAM(pb + 2);
        if (ON(4) && IN(pb + 3)) { const Ctx F = phase_ctx(F0); bf16_t* P = WSP(bf16_t, WS_P); bf16_t* HB = WSP(bf16_t, WS_HB);
            pg8::Gemm g{WSP(const bf16_t, WS_BR), WSP(const bf16_t, WS_WBR) + (size_t)l * 4 * 2048 * 1024, 4096, 1024};
            pg8::EpiMerge E{HB, P + PC_GATE, NC};
            pg8::TileOrder S; S.init(nMl, 8, F.G, F.bid, rmode, 4, (size_t)1024 * 2, (size_t)2048 * 1024 * 2);
            for (int dup = 0; dup < DUPN(5); ++dup) pg8::gemm_phase(F.lds, g, S, E);
        }
        SEAM(pb + 3);
        if (ON(5) && IN(pb + 4)) { const Ctx F = phase_ctx(F0); bf16_t* HB = WSP(bf16_t, WS_HB);
            pg8::Gemm g{HB, WSP(const bf16_t, WS_WO) + (size_t)l * 2048 * 2048, 2048, 2048};
            pg8::EpiWo E{(float*)(F.ws + WS_P + X1_OFF), WSP(const float, WS_MOD) + (size_t)l * 5 * 12288, l == 0 ? F.in[I_X] : (const float*)F.out, F.in[I_CTX]};
            pg8::TileOrder S; S.init(nMl, 8, F.G, F.bid, rmode); for (int dup = 0; dup < DUPN(6); ++dup) pg8::gemm_phase(F.lds, g, S, E);
        }
        SEAM(pb + 4);
        if (ON(6) && IN(pb + 5)) ph_ln1(F0, l);
        SEAM(pb + 5);
        if (ON(7) && IN(pb + 6)) { const Ctx F = phase_ctx(F0); bf16_t* HB = WSP(bf16_t, WS_HB);
            pg8::Gemm g{HB, WSP(const bf16_t, WS_WFOLD) + (size_t)l * 2048 * 2048, 2048, 2048}; pg8::EpiF32 E{(float*)(F.ws + WS_P + SC_OFF), 2048};
            pg8::TileOrder S; S.init(nMl, 8, F.G, F.bid, rmode); for (int dup = 0; dup < DUPN(7); ++dup) pg8::gemm_phase(F.lds, g, S, E);
        }
        SEAM(pb + 6);
        if (ON(8) && IN(pb + 7)) { ph_peer(F0, l); if (DUPN(8) == 2 && l == 1) ph_peer(F0, l); }
        SEAM(pb + 7);
    }
#undef IN
#undef SEAM
}

extern "C" void kernel_launch(void* const* d_in, const int* in_sizes, int n_in, void* d_out, int out_size, void* d_ws, size_t ws_size, hipStream_t stream) {
    static int grid = 0;
    if (grid == 0) {
        if (n_in != cf::N_IN || out_size != cf::NB * cf::S * cf::D || ws_size < cf::WS_END) {
            fprintf(stderr, "kernel_launch: unexpected shapes: n_in %d out %d ws %zu (need %zu)\n", n_in, out_size, ws_size, (size_t)cf::WS_END); grid = -1; return; }
        int dev = 0, cus = 0;
        if (hipGetDevice(&dev) != hipSuccess || hipDeviceGetAttribute(&cus, hipDeviceAttributeMultiprocessorCount, dev) != hipSuccess || cus < 1) { grid = -1; return; }
        if (hipFuncSetAttribute((const void*)mega_fwd, hipFuncAttributeMaxDynamicSharedMemorySize, cf::LDS_BYTES) != hipSuccess) { fprintf(stderr, "kernel_launch: hipFuncSetAttribute failed\n"); grid = -1; return; }
        int per_cu = 0;
        if (hipOccupancyMaxActiveBlocksPerMultiprocessor(&per_cu, (const void*)mega_fwd, 512, cf::LDS_BYTES) != hipSuccess || per_cu < 1)
            fprintf(stderr, "kernel_launch: note: occupancy query reports %d workgroups per CU\n", per_cu);
        (void)hipGetLastError();
        grid = cus;
    }
    if (grid < 0) return;
    (void)hipMemsetAsync((char*)d_ws + cf::WS_CTL, 0, cf::CTL_BYTES, stream);
    Params p{};
    for (int i = 0; i < cf::N_IN; ++i) p.in[i] = (const float*)d_in[i];
    p.out = (float*)d_out; p.ws = (unsigned char*)d_ws;
#if MK_PER_PHASE
    for (int k = 0; k < cf::N_PHASES; ++k) { p.ph_lo = k; p.ph_hi = k + 1; hipLaunchKernelGGL(mega_fwd, dim3(grid), dim3(512), cf::LDS_BYTES, stream, p); }
#else
    p.ph_lo = 0; p.ph_hi = cf::N_PHASES;
    hipLaunchKernelGGL(mega_fwd, dim3(grid), dim3(512), cf::LDS_BYTES, stream, p);
#endif
    const hipError_t le = hipPeekAtLastError();
    if (le != hipSuccess) fprintf(stderr, "kernel_launch: launch failed: %s\n", hipGetErrorName(le));
}
```

```cpp
#include <hip/hip_runtime.h>
#include <stdint.h>
#include <stdio.h>

#ifndef MK_DUP
#define MK_DUP 0
#endif
#define DUPN(k) (((MK_DUP >> (k)) & 1) ? 2 : 1)
#ifndef MK_PER_PHASE
#define MK_PER_PHASE 0
#endif

namespace cf {
constexpr int D = 2048, NB = 4, S = 4096, CTX = 256, RB = CTX + S  , MR = NB * RB  ;
constexpr int DEPTH = 2;
constexpr int PC_AK = 0, PC_AV = 256, PC_CKV = 512, PC_KR = 768, PC_DK = 1024, PC_DV = 1280, PC_KVEND = 1536;
constexpr int PC_AQ = 1536, PC_CQ = 2560, PC_DQ = 3072, PC_GLU = 4096, PC_GATE = 6144, NC = 14336;
constexpr int IN_COLS = 14144;
constexpr int NEXP = 16384;
constexpr float ALPHA = 1.4142135623730951f;
constexpr float LOG2E = 1.4426950408889634f;
constexpr float SCALE_HD = 0.08838834764831845f;
constexpr float SCALE_MLA = 0.07216878364870323f;
enum { I_X = 0, I_C, I_CTX, I_CCTX, I_WADA, I_BADA, I_WIN, I_AQN, I_AKN, I_BQN, I_WQUP, I_BKVN, I_WKVUP, I_CW, I_CB, I_CLG, I_CLB, I_SINK,
       I_WBRA, I_WBRB, I_WBRC, I_WBRD, I_WO, I_LN1G, I_LN1B, I_LN2G, I_LN2B, I_PWQ, I_PSK, I_PU, I_PV, N_IN };
constexpr size_t al(size_t x) { return (x + 255) / 256 * 256; }
constexpr size_t WS_CTL = 0;
constexpr size_t CTL_BYTES = 65536;
constexpr size_t WS_MOD = WS_CTL + CTL_BYTES;
constexpr size_t WS_COSH = WS_MOD + al((size_t)2 * 5 * 12288 * 4);
constexpr size_t WS_SINH = WS_COSH + (size_t)4096 * 64 * 4;
constexpr size_t WS_COSR = WS_SINH + (size_t)4096 * 64 * 4;
constexpr size_t WS_SINR = WS_COSR + (size_t)4096 * 32 * 4;
constexpr size_t WS_WIN = WS_SINR + (size_t)4096 * 32 * 4;
constexpr size_t WS_WQUP = WS_WIN + (size_t)2 * NC * 2048 * 2;
constexpr size_t WS_WKVUP = WS_WQUP + (size_t)2 * 1536 * 512 * 2;
constexpr size_t WS_WBR = WS_WKVUP + (size_t)2 * 2048 * 256 * 2;
constexpr size_t WS_WO = WS_WBR + (size_t)2 * 4 * 2048 * 1024 * 2;
constexpr size_t WS_WFOLD = WS_WO + (size_t)2 * 2048 * 2048 * 2;
constexpr size_t WS_UB = WS_WFOLD + (size_t)2 * 2048 * 2048 * 2;
constexpr size_t WS_VB2 = WS_UB + (size_t)2 * NEXP * 2048;
constexpr size_t WS_HB = WS_VB2 + (size_t)2 * NEXP * 2048;
constexpr size_t WS_P = WS_HB + (size_t)MR * 2048 * 2;
constexpr size_t WS_QB = WS_P + (size_t)MR * NC * 2;
constexpr size_t WS_KB = WS_QB + (size_t)MR * 1536 * 2;
constexpr size_t WS_VB = WS_KB + (size_t)MR * 1536 * 2;
constexpr size_t WS_BR = WS_VB + (size_t)MR * 1024 * 2;
constexpr size_t WS_XC = WS_BR + (size_t)MR * 4096 * 2;
constexpr size_t WS_SSK = WS_XC + (size_t)1024 * 2048 * 4;
constexpr size_t WS_SSQ = WS_SSK + (size_t)MR * 4 * 4;
constexpr size_t WS_SSKV = WS_SSQ + (size_t)MR * 16 * 4;
constexpr size_t WS_SSCQ = WS_SSKV + (size_t)MR * 4 * 4;
constexpr size_t WS_END = WS_SSCQ + (size_t)MR * 8 * 4;
constexpr size_t X1_OFF = 0, SC_OFF = (size_t)MR * 2048 * 4;
static_assert(SC_OFF * 2 <= (size_t)MR * NC * 2, "X1 + SC fit in P");
constexpr int LDS_BYTES = 132 * 1024;
constexpr int MISC_OFF = 128 * 1024;
constexpr int N_PHASES = 2 + 8 * DEPTH;
}

typedef unsigned short bf16_t;
typedef short bf16x8 __attribute__((ext_vector_type(8)));
typedef float f32x4 __attribute__((ext_vector_type(4)));
typedef float f32x2 __attribute__((ext_vector_type(2)));
typedef unsigned u32x4 __attribute__((ext_vector_type(4)));
typedef unsigned u32x2 __attribute__((ext_vector_type(2)));
#define LAS __attribute__((address_space(3)))
typedef LAS unsigned char* ldsp_t;

__device__ __forceinline__ unsigned cvt_pk_bf16(float lo, float hi) { unsigned r; asm volatile("v_cvt_pk_bf16_f32 %0, %1, %2" : "=v"(r) : "v"(lo), "v"(hi)); return r; }
__device__ __forceinline__ bf16_t f2bf(float f) { return (bf16_t)(cvt_pk_bf16(f, 0.f) & 0xffffu); }
__device__ __forceinline__ float bf2f(bf16_t b) { return __uint_as_float(((unsigned)b) << 16); }
__device__ __forceinline__ float bflo(unsigned w) { return __uint_as_float(w << 16); }
__device__ __forceinline__ float bfhi(unsigned w) { return __uint_as_float(w & 0xffff0000u); }
__device__ __forceinline__ float shx(float v, int mask, int lane) { return __int_as_float(__builtin_amdgcn_ds_bpermute((lane ^ mask) << 2, __float_as_int(v))); }
__device__ __forceinline__ float wave_sum(float v, int lane) {
#pragma unroll
    for (int o = 32; o >= 1; o >>= 1) v += shx(v, o, lane);
    return v;
}
__device__ __forceinline__ int lane_id() { int l; asm volatile("v_mbcnt_lo_u32_b32 %0, -1, 0\n\tv_mbcnt_hi_u32_b32 %0, -1, %0" : "=v"(l)); return l; }
__device__ __forceinline__ float sigmoidf_(float x) { return 1.0f / (1.0f + __expf(-x)); }

#define XB_TMO      128
#define XB_XCNT(j)  (256  + 64 * (j))
#define XB_XSUB(j)  (1280 + 64 * (j))
#define XB_XGEN(j)  (2304 + 64 * (j))
#define XB_TOP      3328
#define XB_TOPGEN   3392
#define XCD_BAR_WORDS 3456
#define XB_SPIN_CAP (1u << 23)
__device__ __forceinline__ unsigned xb_ld(unsigned* p)              { return __hip_atomic_load(p, __ATOMIC_RELAXED, __HIP_MEMORY_SCOPE_AGENT); }
__device__ __forceinline__ unsigned xb_add(unsigned* p, unsigned v) { return __hip_atomic_fetch_add(p, v, __ATOMIC_RELAXED, __HIP_MEMORY_SCOPE_AGENT); }
__device__ __forceinline__ unsigned xb_xcc_id() { return (unsigned)__builtin_amdgcn_s_getreg((3 << 11) | 20) & 0xFu; }
#define XB_SPIN(cond, bar) do { unsigned _sp = 0; while (cond) { __builtin_amdgcn_s_sleep(1); \
    if ((++_sp & 255u) == 0u) { if (xb_ld(&(bar)[XB_TMO])) break; if (_sp > XB_SPIN_CAP) { atomicAdd(&(bar)[XB_TMO], 1u); break; } } } } while (0)
struct XcdBarrier { unsigned* bar; unsigned x; volatile LAS unsigned* st; int wave; };
__device__ __forceinline__ XcdBarrier xcd_barrier_post(unsigned* bar, volatile LAS unsigned* st, int wave) {
    XcdBarrier b; b.bar = bar; b.x = xb_xcc_id(); b.st = st; b.wave = wave;
    if (wave == 0 && lane_id() == 0) (void)xb_add(&bar[XB_XCNT(b.x)], 1u);
    return b;
}
__device__ __forceinline__ void xcd_barrier_complete(unsigned* bar, unsigned x, unsigned& nloc, unsigned& nx) {
    const unsigned G = gridDim.x * gridDim.y * gridDim.z;
    unsigned sum, cnt, mine, sp = 0u;
    for (;;) {
        sum = 0u; cnt = 0u; mine = 0u;
#pragma unroll
        for (unsigned j = 0; j < 16; ++j) { const unsigned c = xb_ld(&bar[XB_XCNT(j)]); sum += c; cnt += (c > 0u) ? 1u : 0u; mine = (j == x) ? c : mine; }
        if (sum == G) break;
        __builtin_amdgcn_s_sleep(1);
        if ((++sp & 255u) == 0u) { if (xb_ld(&bar[XB_TMO])) break; if (sp > XB_SPIN_CAP) { atomicAdd(&bar[XB_TMO], 1u); break; } }
    }
    nloc = mine > 0u ? mine : 1u; nx = cnt > 0u ? cnt : 1u;
}
__device__ __forceinline__ void xcd_barrier(const XcdBarrier& b) {
    asm volatile("s_waitcnt vmcnt(0)" ::: "memory");
    __syncthreads();
    if (b.wave == 0 && lane_id() == 0) {
        unsigned* bar = b.bar;
        __builtin_amdgcn_s_waitcnt(0);
        unsigned nloc = b.st[0], nx = b.st[1];
        if (nloc == 0u) { xcd_barrier_complete(bar, b.x, nloc, nx); b.st[0] = nloc; b.st[1] = nx; }
        const unsigned old = xb_add(&bar[XB_XSUB(b.x)], 1u);
        const unsigned gen = old / nloc;
        if (old + 1u == (gen + 1u) * nloc) {
            __builtin_amdgcn_fence(__ATOMIC_RELEASE, "agent");
            asm volatile("s_waitcnt vmcnt(0)" ::: "memory");
            const unsigned og = xb_add(&bar[XB_TOP], 1u);
            const unsigned tg = og / nx;
            if (og + 1u == (tg + 1u) * nx) xb_add(&bar[XB_TOPGEN], 1u);
            else XB_SPIN(xb_ld(&bar[XB_TOPGEN]) == tg, bar);
            __builtin_amdgcn_fence(__ATOMIC_ACQUIRE, "agent");
            xb_add(&bar[XB_XGEN(b.x)], 1u);
            asm volatile("s_waitcnt vmcnt(0)" ::: "memory");
        } else {
            XB_SPIN(xb_ld(&bar[XB_XGEN(b.x)]) == gen, bar);
            __builtin_amdgcn_fence(__ATOMIC_ACQUIRE, "agent");
            asm volatile("s_waitcnt vmcnt(0)" ::: "memory");
        }
    }
    __syncthreads();
}

namespace pg8 {
constexpr int BM = 256, BK = 64, HALF = 128, HTB = HALF * BK * 2, STAGE_BYTES = 8 * HTB, NXCD = 8, WGM = 8;
__host__ __device__ __forceinline__ int lds_byte(int r, int c) { const int st = (r >> 4) * 2 + (c >> 5), rr = r & 15, cc = c & 31, ob = rr * 64 + cc * 2; return st * 1024 + (ob ^ (((ob >> 9) & 1) << 5)); }
__host__ __device__ __forceinline__ void stage_rc(int b, int& R, int& C) { const int st = b / 1024, sb = b % 1024, swz = sb ^ (((sb >> 9) & 1) << 5); R = (st >> 1) * 16 + swz / 64; C = (st & 1) * 32 + (swz % 64) / 2; }
__host__ __device__ __forceinline__ int perm32(int rho) { const int n = rho >> 4, i = rho & 15; return 8 * (i >> 2) + 4 * n + (i & 3); }
struct Unit { int pm, pn, sub; };
struct Gemm { const bf16_t* A; const bf16_t* Bt; int lda, K; };

struct TileOrder {
    int nM, nN, nwg, G, c, mode, nsub; size_t subA, subB;
    __device__ void init(int nM_, int nN_, int G_, int c_, int mode_, int nsub_ = 1, size_t subA_ = 0, size_t subB_ = 0) { nM = nM_; nN = nN_; nwg = nM * nN; G = G_; c = c_; mode = mode_; nsub = nsub_; subA = subA_; subB = subB_; }
    __device__ bool next(int i, Unit& u) const {
        const int it = nsub == 1 ? i : i / nsub; u.sub = nsub == 1 ? 0 : i - it * nsub;
        const long L = (long)it * G + c; if (L >= nwg) return false;
        int wgid = (int)L; { const int q = nwg / NXCD, r = nwg % NXCD, xcd = wgid % NXCD, off = wgid / NXCD; wgid = (xcd < r ? xcd * (q + 1) : r * (q + 1) + (xcd - r) * q) + off; }
        const int nig = WGM * nN, gid = wgid / nig, fm = gid * WGM, gsz = (nM - fm) < WGM ? (nM - fm) : WGM;
        const int pl = fm + ((wgid % nig) % gsz); u.pn = (wgid % nig) / gsz;
        u.pm = mode == 0 ? pl : (mode == 1 ? 17 * (pl >> 4) + 1 + (pl & 15) : 17 * pl);
        return true;
    }
    __device__ __forceinline__ void a_ready(const Unit&) const {}
    __device__ __forceinline__ void done(const Unit&) const {}
};

template <class Epi, class Sched>
__device__ __forceinline__ void gemm_phase(ldsp_t lds, const Gemm g, const Sched& S, const Epi& E, int wave_) {
    int tid = wave_ * 64 + lane_id(); asm volatile("" : "+v"(tid));
    const int wid = __builtin_amdgcn_readfirstlane(tid >> 6), lane = tid & 63, wr = wid >> 2, wc = wid & 3, fr = lane & 15, fq = lane >> 4;
    int K = g.K; asm volatile("" : "+s"(K));
    const int nt = K / BK, lda = g.lda;
    unsigned voffA[2], voffB[2];
#pragma unroll
    for (int i = 0; i < 2; ++i) { int R, C; stage_rc(tid * 16 + i * 8192, R, C); const int Rb = (R & ~31) + perm32(R & 31);
        voffA[i] = (unsigned)(R * lda + C) * 2u; voffB[i] = (unsigned)(Rb * K + C) * 2u; }
    const size_t kstep = (size_t)(BK * 2);
    const size_t hstepA = (size_t)HALF * lda * 2, hstepB = (size_t)HALF * K * 2;
    const size_t tstepA = 2 * hstepA, tstepB = 2 * hstepB;
    const unsigned ldsw = (unsigned)wid * 1024u;
    const int aoff = lds_byte(wr * 64 + fr, fq * 8), boff = lds_byte(wc * 32 + fr, fq * 8);
#define PG8_SA(b, h) (((b) * 2 + (h)) * HTB)
#define PG8_SB(b, h) ((4 + (b) * 2 + (h)) * HTB)
#define PG8_STAGE(bufoff, gbase, voff) do { _Pragma("unroll") for (int _i = 0; _i < 2; ++_i) \
        __builtin_amdgcn_global_load_lds((const unsigned*)((const char*)(gbase) + (voff)[_i]), (LAS unsigned*)(lds + (bufoff) + ldsw + _i * 8192), 16, 0, 0); } while (0)
#define PG8_LDA(dst, b, h) do { _Pragma("unroll") for (int m = 0; m < 4; ++m) _Pragma("unroll") for (int k = 0; k < 2; ++k) dst[m][k] = *(const LAS bf16x8*)(lds + PG8_SA(b, h) + aoff + m * 2048 + k * 1024); } while (0)
#define PG8_LDB(dst, b, h) do { _Pragma("unroll") for (int n = 0; n < 2; ++n) _Pragma("unroll") for (int k = 0; k < 2; ++k) dst[n][k] = *(const LAS bf16x8*)(lds + PG8_SB(b, h) + boff + n * 2048 + k * 1024); } while (0)
#define PG8_MMA(ai, bj, At, Bt) do { __builtin_amdgcn_s_setprio(1); _Pragma("unroll") for (int m = 0; m < 4; ++m) _Pragma("unroll") for (int n = 0; n < 2; ++n) _Pragma("unroll") for (int k = 0; k < 2; ++k) \
        acc[ai][bj][m][n] = __builtin_amdgcn_mfma_f32_16x16x32_bf16(Bt[n][k], At[m][k], acc[ai][bj][m][n], 0, 0, 0); __builtin_amdgcn_s_setprio(0); } while (0)
#define PG8_WAIT_V(n) asm volatile("s_waitcnt vmcnt(" #n ")" ::: "memory")
#define PG8_WAIT_L(n) asm volatile("s_waitcnt lgkmcnt(" #n ")" ::: "memory")
#define PG8_BAR __builtin_amdgcn_s_barrier()
#define PG8_SCHED __builtin_amdgcn_sched_barrier(0)
    Unit cur, nxt; int ui = 0;
    if (!S.next(0, cur)) return;
    f32x4 acc[2][2][4][2];
#pragma unroll
    for (int a = 0; a < 2; ++a)
#pragma unroll
        for (int b = 0; b < 2; ++b)
#pragma unroll
            for (int m = 0; m < 4; ++m)
#pragma unroll
                for (int n = 0; n < 2; ++n) acc[a][b][m][n] = (f32x4){0.f, 0.f, 0.f, 0.f};
    bf16x8 At[4][2], B0[2][2], B1[2][2];
    const char* cA = (const char*)g.A + (size_t)cur.pm * tstepA + cur.sub * S.subA; const char* cB = (const char*)g.Bt + (size_t)cur.pn * tstepB + cur.sub * S.subB;
    S.a_ready(cur);
    PG8_STAGE(PG8_SB(0, 0), cB, voffB); PG8_STAGE(PG8_SA(0, 0), cA, voffA); PG8_STAGE(PG8_SB(0, 1), cB + hstepB, voffB); PG8_STAGE(PG8_SA(0, 1), cA + hstepA, voffA);
    if (wr == 1) PG8_BAR;
    PG8_WAIT_V(4); PG8_BAR;
    PG8_STAGE(PG8_SB(1, 0), cB + kstep, voffB); PG8_STAGE(PG8_SA(1, 0), cA + kstep, voffA); PG8_STAGE(PG8_SB(1, 1), cB + hstepB + kstep, voffB);
    PG8_WAIT_V(6); PG8_BAR;
    for (;;) {
        const bool has_next = S.next(ui + 1, nxt);
        const char* nA = has_next ? (const char*)g.A + (size_t)nxt.pm * tstepA + nxt.sub * S.subA : cA; const char* nB = has_next ? (const char*)g.Bt + (size_t)nxt.pn * tstepB + nxt.sub * S.subB : cB;
#pragma unroll 1
        for (int t = 0; t < nt; t += 2) {
            const bool last = (t == nt - 2);
            const char* a1 = cA + (size_t)(t + 1) * kstep;
            const char* a2 = last ? nA : cA + (size_t)(t + 2) * kstep; const char* b2 = last ? nB : cB + (size_t)(t + 2) * kstep;
            const char* a3 = a2 + kstep; const char* b3 = b2 + kstep;
            if (last && has_next) S.a_ready(nxt);
            PG8_LDB(B0, 0, 0); PG8_SCHED; PG8_LDA(At, 0, 0); PG8_STAGE(PG8_SA(1, 1), a1 + hstepA, voffA);
            PG8_WAIT_L(8); PG8_BAR; PG8_WAIT_L(0); PG8_MMA(0, 0, At, B0); PG8_BAR; PG8_SCHED;
            PG8_LDB(B1, 0, 1); PG8_STAGE(PG8_SB(0, 0), b2, voffB);
            PG8_BAR; PG8_WAIT_L(0); PG8_MMA(0, 1, At, B1); PG8_BAR;
            PG8_LDA(At, 0, 1); PG8_STAGE(PG8_SA(0, 0), a2, voffA);
            PG8_BAR; PG8_WAIT_L(0); PG8_MMA(1, 0, At, B0); PG8_BAR; PG8_SCHED;
            PG8_STAGE(PG8_SB(0, 1), b2 + hstepB, voffB);
            PG8_WAIT_V(6); PG8_BAR; PG8_MMA(1, 1, At, B1); PG8_BAR;
            PG8_LDB(B0, 1, 0); PG8_SCHED; PG8_LDA(At, 1, 0); PG8_STAGE(PG8_SA(0, 1), a2 + hstepA, voffA);
            PG8_WAIT_L(8); PG8_BAR; PG8_WAIT_L(0); PG8_MMA(0, 0, At, B0); PG8_BAR; PG8_SCHED;
            PG8_LDB(B1, 1, 1); PG8_STAGE(PG8_SB(1, 0), b3, voffB);
            PG8_BAR; PG8_WAIT_L(0); PG8_MMA(0, 1, At, B1); PG8_BAR;
            PG8_LDA(At, 1, 1); PG8_STAGE(PG8_SA(1, 0), a3, voffA);
            PG8_BAR; PG8_WAIT_L(0); PG8_MMA(1, 0, At, B0); PG8_BAR; PG8_SCHED;
            PG8_STAGE(PG8_SB(1, 1), b3 + hstepB, voffB);
            PG8_WAIT_V(6); PG8_BAR; PG8_MMA(1, 1, At, B1); PG8_BAR;
        }
        E(acc, cur, wr, wc, fr, fq); S.done(cur);
        if (!has_next) break;
#pragma unroll
        for (int a = 0; a < 2; ++a)
#pragma unroll
            for (int b = 0; b < 2; ++b)
#pragma unroll
                for (int m = 0; m < 4; ++m)
#pragma unroll
                    for (int n = 0; n < 2; ++n) acc[a][b][m][n] = (f32x4){0.f, 0.f, 0.f, 0.f};
        cur = nxt; cA = nA; cB = nB; ++ui;
    }
    PG8_WAIT_V(0);
    if (wr == 0) PG8_BAR;
    PG8_BAR;
#undef PG8_SA
#undef PG8_SB
#undef PG8_STAGE
#undef PG8_LDA
#undef PG8_LDB
#undef PG8_MMA
#undef PG8_WAIT_V
#undef PG8_WAIT_L
#undef PG8_BAR
#undef PG8_SCHED
}

__device__ __forceinline__ u32x4 pack8(const f32x4 a, const f32x4 b) { u32x4 w; w.x = cvt_pk_bf16(a[0], a[1]); w.y = cvt_pk_bf16(a[2], a[3]); w.z = cvt_pk_bf16(b[0], b[1]); w.w = cvt_pk_bf16(b[2], b[3]); return w; }
#define EPI_ARGS const f32x4 (&acc)[2][2][4][2], const Unit& u, int wr, int wc, int fr_, int fq_
#define EPI_LANE int fr = fr_, fq = fq_; asm volatile("" : "+v"(fr), "+v"(fq));

struct EpiBf16 {
    bf16_t* O; int ldc;
    __device__ __forceinline__ void operator()(EPI_ARGS) const {
        EPI_LANE
        const int row0 = u.pm * BM + wr * 64 + fr, col0 = u.pn * BM + wc * 32 + 8 * fq;
#pragma unroll
        for (int ai = 0; ai < 2; ++ai)
#pragma unroll
            for (int m = 0; m < 4; ++m) { bf16_t* rowp = O + (size_t)(row0 + ai * HALF + m * 16) * ldc + col0;
#pragma unroll
                for (int bj = 0; bj < 2; ++bj) *(u32x4*)(rowp + bj * HALF) = pack8(acc[ai][bj][m][0], acc[ai][bj][m][1]); }
    }
};
struct EpiF32 {
    float* C; int ldc;
    __device__ __forceinline__ void operator()(EPI_ARGS) const {
        EPI_LANE
        const int row0 = u.pm * BM + wr * 64 + fr, col0 = u.pn * BM + wc * 32 + 8 * fq;
#pragma unroll
        for (int ai = 0; ai < 2; ++ai)
#pragma unroll
            for (int m = 0; m < 4; ++m) { float* rowp = C + (size_t)(row0 + ai * HALF + m * 16) * ldc + col0;
#pragma unroll
                for (int bj = 0; bj < 2; ++bj) { *(f32x4*)(rowp + bj * HALF) = acc[ai][bj][m][0]; *(f32x4*)(rowp + bj * HALF + 4) = acc[ai][bj][m][1]; } }
    }
};
struct EpiInProj {
    bf16_t* P; bf16_t* KB; const float* cosh; const float* sinh; const float* cosr; const float* sinr; const float* akn; const float* aqn;
    float* ssk; float* ssq; float* sskv; float* sscq;
    __device__ __forceinline__ void operator()(EPI_ARGS) const {
        EPI_LANE
        const int pn = u.pn, tb = u.pm % 17; const bool lat = tb != 0; const int posbase = (tb - 1) * 256;
        const int rl0 = wr * 64 + fr;
        if (pn >= 24) {
            const int col0 = pn * BM + wc * 32 + 8 * fq;
#pragma unroll
            for (int ai = 0; ai < 2; ++ai)
#pragma unroll
                for (int m = 0; m < 4; ++m) { bf16_t* rowp = P + ((size_t)u.pm * BM + rl0 + ai * HALF + m * 16) * cf::NC + col0;
#pragma unroll
                    for (int bj = 0; bj < 2; ++bj) { f32x4 v0 = acc[ai][bj][m][0], v1 = acc[ai][bj][m][1];
#pragma unroll
                        for (int e = 0; e < 4; ++e) { v0[e] = sigmoidf_(v0[e]); v1[e] = sigmoidf_(v1[e]); }
                        *(u32x4*)(rowp + bj * HALF) = pack8(v0, v1); } }
        } else if (pn >= 16) {
            const int col0 = cf::PC_GLU + 128 * (pn - 16) + wc * 32 + 8 * fq;
#pragma unroll
            for (int ai = 0; ai < 2; ++ai)
#pragma unroll
                for (int m = 0; m < 4; ++m) { f32x4 v0 = acc[ai][0][m][0], v1 = acc[ai][0][m][1]; const f32x4 g0 = acc[ai][1][m][0], g1 = acc[ai][1][m][1];
#pragma unroll
                    for (int e = 0; e < 4; ++e) { v0[e] *= sigmoidf_(g0[e]); v1[e] *= sigmoidf_(g1[e]); }
                    *(u32x4*)(P + ((size_t)u.pm * BM + rl0 + ai * HALF + m * 16) * cf::NC + col0) = pack8(v0, v1); }
        } else if (pn == 3) {
            if (wc == 0) { const int i0 = 8 * fq;
#pragma unroll
                for (int ai = 0; ai < 2; ++ai)
#pragma unroll
                    for (int m = 0; m < 4; ++m) { const int rl = rl0 + ai * HALF + m * 16;
                        f32x4 c0 = {1.f, 1.f, 1.f, 1.f}, c1 = c0, s0 = {0.f, 0.f, 0.f, 0.f}, s1 = s0;
                        if (lat) { const float* cp = cosr + (size_t)(posbase + rl) * 32 + i0; const float* sp = sinr + (size_t)(posbase + rl) * 32 + i0;
                            c0 = *(const f32x4*)cp; c1 = *(const f32x4*)(cp + 4); s0 = *(const f32x4*)sp; s1 = *(const f32x4*)(sp + 4); }
                        const f32x4 x1a = acc[ai][0][m][0], x1b = acc[ai][0][m][1], x2a = acc[ai][1][m][0], x2b = acc[ai][1][m][1];
                        const u32x4 w1 = pack8(x1a * c0 - x2a * s0, x1b * c1 - x2b * s1), w2 = pack8(x2a * c0 + x1a * s0, x2b * c1 + x1b * s1);
                        bf16_t* kb = KB + ((size_t)u.pm * BM + rl) * 1536 + 128 + i0;
#pragma unroll
                        for (int h = 0; h < 8; ++h) { *(u32x4*)(kb + h * 192) = w1; *(u32x4*)(kb + h * 192 + 32) = w2; }
                        asm volatile("" ::: "memory"); } }
        } else if (pn == 0 || pn == 4 || (pn >= 6 && pn <= 9) || pn >= 12) {
            const bool norm = pn == 0 || (pn >= 6 && pn <= 9);
            const int hl = wc >> 1, i0 = 32 * (wc & 1) + 8 * fq;
            f32x4 g1a = {1.f, 1.f, 1.f, 1.f}, g1b = g1a, g2a = g1a, g2b = g1a;
            if (norm) { const float* gn = (pn == 0 ? akn : aqn) + i0; g1a = *(const f32x4*)gn; g1b = *(const f32x4*)(gn + 4); g2a = *(const f32x4*)(gn + 64); g2b = *(const f32x4*)(gn + 68); }
            float* ssp = pn == 0 ? ssk + ((size_t)u.pm * BM * 2 + hl) * 2 + (wc & 1) : ssq + ((size_t)u.pm * BM * 8 + (pn - 6) * 2 + hl) * 2 + (wc & 1);
            const int sstr = pn == 0 ? 4 : 16;
#pragma unroll
            for (int ai = 0; ai < 2; ++ai)
#pragma unroll
                for (int m = 0; m < 4; ++m) { const int rl = rl0 + ai * HALF + m * 16;
                    f32x4 x1a = acc[ai][0][m][0], x1b = acc[ai][0][m][1], x2a = acc[ai][1][m][0], x2b = acc[ai][1][m][1];
                    if (norm) { const f32x4 q = x1a * x1a + x1b * x1b + x2a * x2a + x2b * x2b; float ss = (q[0] + q[1]) + (q[2] + q[3]);
                        ss += shx(ss, 16, fr + 16 * fq); ss += shx(ss, 32, fr + 16 * fq);
                        if (fq == 0) ssp[(size_t)rl * sstr] = ss;
                        x1a *= g1a; x1b *= g1b; x2a *= g2a; x2b *= g2b; }
                    f32x4 o1a = x1a, o1b = x1b, o2a = x2a, o2b = x2b;
                    if (lat) { const float* cp = cosh + (size_t)(posbase + rl) * 64 + i0; const float* sp = sinh + (size_t)(posbase + rl) * 64 + i0;
                        const f32x4 c0 = *(const f32x4*)cp, c1 = *(const f32x4*)(cp + 4), s0 = *(const f32x4*)sp, s1 = *(const f32x4*)(sp + 4);
                        o1a = x1a * c0 - x2a * s0; o1b = x1b * c1 - x2b * s1; o2a = x2a * c0 + x1a * s0; o2b = x2b * c1 + x1b * s1; }
                    bf16_t* dst = P + ((size_t)u.pm * BM + rl) * cf::NC + pn * BM + hl * 128 + i0;
                    *(u32x4*)dst = pack8(o1a, o1b); *(u32x4*)(dst + 64) = pack8(o2a, o2b);
                    asm volatile("" ::: "memory"); }
        } else {
            const int col0 = pn * BM + wc * 32 + 8 * fq;
            const bool ssq_on = pn == 2 || pn == 10 || pn == 11;
            float* ssp = pn == 2 ? sskv + (size_t)u.pm * BM * 4 + wc : sscq + (size_t)u.pm * BM * 8 + (pn - 10) * 4 + wc;
            const int sstr = pn == 2 ? 4 : 8;
#pragma unroll
            for (int ai = 0; ai < 2; ++ai)
#pragma unroll
                for (int m = 0; m < 4; ++m) { const int rl = rl0 + ai * HALF + m * 16; bf16_t* rowp = P + ((size_t)u.pm * BM + rl) * cf::NC + col0;
#pragma unroll
                    for (int bj = 0; bj < 2; ++bj) *(u32x4*)(rowp + bj * HALF) = pack8(acc[ai][bj][m][0], acc[ai][bj][m][1]);
                    if (ssq_on) { const f32x4 q = acc[ai][0][m][0] * acc[ai][0][m][0] + acc[ai][0][m][1] * acc[ai][0][m][1] + acc[ai][1][m][0] * acc[ai][1][m][0] + acc[ai][1][m][1] * acc[ai][1][m][1];
                        float ss = (q[0] + q[1]) + (q[2] + q[3]); ss += shx(ss, 16, fr + 16 * fq); ss += shx(ss, 32, fr + 16 * fq);
                        if (fq == 0) ssp[(size_t)rl * sstr] = ss; } }
        }
    }
};
struct EpiKvUp {
    bf16_t* KB; bf16_t* VB; const float* sskv;
    __device__ __forceinline__ void operator()(EPI_ARGS) const {
        EPI_LANE
        const int row0 = u.pm * BM + wr * 64 + fr, d0 = wc * 32 + 8 * fq;
        const bool isk = u.pn < 4;
        bf16_t* base = isk ? KB + (2 * u.pn) * 192 + d0 : VB + (u.pn - 4) * 256 + d0;
        const int ldr = isk ? 1536 : 1024, bjs = isk ? 192 : 128;
#pragma unroll
        for (int ai = 0; ai < 2; ++ai)
#pragma unroll
            for (int m = 0; m < 4; ++m) { const size_t row = (size_t)(row0 + ai * HALF + m * 16); bf16_t* rowp = base + row * ldr;
                const f32x4 pp = *(const f32x4*)(sskv + row * 4); const float r = rsqrtf(((pp[0] + pp[1]) + (pp[2] + pp[3])) * (1.f / 256.f) + 1e-6f);
#pragma unroll
                for (int bj = 0; bj < 2; ++bj) *(u32x4*)(rowp + bj * bjs) = pack8(acc[ai][bj][m][0] * r, acc[ai][bj][m][1] * r); }
    }
};
struct EpiQUp {
    bf16_t* QB; const float* cosr; const float* sinr; const float* sscq;
    __device__ __forceinline__ void operator()(EPI_ARGS) const {
        EPI_LANE
        const int row0 = u.pm * BM + wr * 64 + fr;
        if (u.pn < 4) {
            const int d0 = wc * 32 + 8 * fq;
#pragma unroll
            for (int ai = 0; ai < 2; ++ai)
#pragma unroll
                for (int m = 0; m < 4; ++m) { const size_t row = (size_t)(row0 + ai * HALF + m * 16);
                    const f32x4 pa = *(const f32x4*)(sscq + row * 8), pb = *(const f32x4*)(sscq + row * 8 + 4);
                    const float r = rsqrtf((((pa[0] + pa[1]) + (pa[2] + pa[3])) + ((pb[0] + pb[1]) + (pb[2] + pb[3]))) * (1.f / 512.f) + 1e-6f);
#pragma unroll
                    for (int bj = 0; bj < 2; ++bj) *(u32x4*)(QB + row * 1536 + (2 * u.pn + bj) * 192 + d0) = pack8(acc[ai][bj][m][0] * r, acc[ai][bj][m][1] * r); }
        } else {
            const int head = 4 * (u.pn - 4) + wc, i0 = 8 * fq;
            const bool lat = (u.pm % 17) != 0; const int posbase = (u.pm % 17) * 256 - 256;
#pragma unroll
            for (int ai = 0; ai < 2; ++ai)
#pragma unroll
                for (int m = 0; m < 4; ++m) { const int rl = wr * 64 + fr + ai * HALF + m * 16; const size_t row = (size_t)u.pm * BM + rl;
                    const f32x4 pa = *(const f32x4*)(sscq + row * 8), pb = *(const f32x4*)(sscq + row * 8 + 4);
                    const float r = rsqrtf((((pa[0] + pa[1]) + (pa[2] + pa[3])) + ((pb[0] + pb[1]) + (pb[2] + pb[3]))) * (1.f / 512.f) + 1e-6f);
                    f32x4 c0 = {1.f, 1.f, 1.f, 1.f}, c1 = c0, s0 = {0.f, 0.f, 0.f, 0.f}, s1 = s0;
                    if (lat) { const float* cp = cosr + (size_t)(posbase + rl) * 32 + i0; const float* sp = sinr + (size_t)(posbase + rl) * 32 + i0;
                        c0 = *(const f32x4*)cp; c1 = *(const f32x4*)(cp + 4); s0 = *(const f32x4*)sp; s1 = *(const f32x4*)(sp + 4); }
                    const f32x4 x1a = acc[ai][0][m][0] * r, x1b = acc[ai][0][m][1] * r, x2a = acc[ai][1][m][0] * r, x2b = acc[ai][1][m][1] * r;
                    const f32x4 o1a = x1a * c0 - x2a * s0, o1b = x1b * c1 - x2b * s1, o2a = x2a * c0 + x1a * s0, o2b = x2b * c1 + x1b * s1;
                    bf16_t* dst = QB + row * 1536 + head * 192 + 128 + i0;
                    *(u32x4*)dst = pack8(o1a, o1b); *(u32x4*)(dst + 32) = pack8(o2a, o2b); asm volatile("" ::: "memory"); }
        }
    }
};
struct EpiMerge {
    bf16_t* ACC; const bf16_t* gate0; int ldg;
    __device__ __forceinline__ void operator()(EPI_ARGS) const {
        EPI_LANE
        const int row0 = u.pm * BM + wr * 64 + fr, col0 = u.pn * BM + wc * 32 + 8 * fq;
        const bf16_t* gate = gate0 + u.sub * 2048; const bool first = u.sub == 0;
#pragma unroll
        for (int ai = 0; ai < 2; ++ai) {
            u32x4 gw[4][2], pw[4][2];
#pragma unroll
            for (int m = 0; m < 4; ++m) { const size_t row = (size_t)(row0 + ai * HALF + m * 16);
#pragma unroll
                for (int bj = 0; bj < 2; ++bj) { const int col = col0 + bj * HALF; gw[m][bj] = *(const u32x4*)(gate + row * ldg + col);
                    pw[m][bj] = (u32x4){0u, 0u, 0u, 0u}; if (!first) pw[m][bj] = *(const u32x4*)(ACC + row * 2048 + col); } }
#pragma unroll
            for (int m = 0; m < 4; ++m) { const size_t row = (size_t)(row0 + ai * HALF + m * 16);
#pragma unroll
                for (int bj = 0; bj < 2; ++bj) { const int col = col0 + bj * HALF; const u32x4 g = gw[m][bj], p = pw[m][bj];
                    const f32x4 a0 = acc[ai][bj][m][0], a1 = acc[ai][bj][m][1];
                    f32x4 r0, r1;
                    r0[0] = bflo(p.x) + bflo(g.x) * a0[0]; r0[1] = bfhi(p.x) + bfhi(g.x) * a0[1]; r0[2] = bflo(p.y) + bflo(g.y) * a0[2]; r0[3] = bfhi(p.y) + bfhi(g.y) * a0[3];
                    r1[0] = bflo(p.z) + bflo(g.z) * a1[0]; r1[1] = bfhi(p.z) + bfhi(g.z) * a1[1]; r1[2] = bflo(p.w) + bflo(g.w) * a1[2]; r1[3] = bfhi(p.w) + bfhi(g.w) * a1[3];
                    *(u32x4*)(ACC + row * 2048 + col) = pack8(r0, r1); } }
            asm volatile("" ::: "memory"); }
    }
};
struct EpiWo {
    float* X1; const float* mod  ; const float* xlat  ; const float* xctx  ;
    __device__ __forceinline__ void operator()(EPI_ARGS) const {
        EPI_LANE
        const int b = u.pm / 17, tb = u.pm % 17; const bool isctx = tb == 0;
        const float* g1 = mod + (size_t)(isctx ? 4 : b) * 12288 + 2 * 2048;
        const float* xbase = isctx ? xctx + (size_t)b * cf::CTX * 2048 : xlat + ((size_t)b * cf::S + (size_t)(tb - 1) * 256) * 2048;
        const int rl0 = wr * 64 + fr, col0 = u.pn * BM + wc * 32 + 8 * fq;
        f32x4 gv[2][2];
#pragma unroll
        for (int bj = 0; bj < 2; ++bj) { gv[bj][0] = *(const f32x4*)(g1 + col0 + bj * HALF); gv[bj][1] = *(const f32x4*)(g1 + col0 + bj * HALF + 4); }
#pragma unroll
        for (int ai = 0; ai < 2; ++ai) {
            f32x4 xv[4][2][2];
#pragma unroll
            for (int m = 0; m < 4; ++m) { const int rl = rl0 + ai * HALF + m * 16;
#pragma unroll
                for (int bj = 0; bj < 2; ++bj) { const float* xp = xbase + (size_t)rl * 2048 + col0 + bj * HALF; xv[m][bj][0] = *(const f32x4*)xp; xv[m][bj][1] = *(const f32x4*)(xp + 4); } }
#pragma unroll
            for (int m = 0; m < 4; ++m) { const int rl = rl0 + ai * HALF + m * 16; float* op = X1 + ((size_t)u.pm * BM + rl) * 2048 + col0;
#pragma unroll
                for (int bj = 0; bj < 2; ++bj) { *(f32x4*)(op + bj * HALF) = xv[m][bj][0] * cf::ALPHA + gv[bj][0] * acc[ai][bj][m][0];
                    *(f32x4*)(op + bj * HALF + 4) = xv[m][bj][1] * cf::ALPHA + gv[bj][1] * acc[ai][bj][m][1]; } }
            asm volatile("" ::: "memory"); }
    }
};
}

struct Ctx {
    const float* const* in; float* out; unsigned char* ws;
    ldsp_t lds; int tid, lane, wave, G, bid;
};
#define WSP(T, off) ((T*)(F.ws + (off)))
__device__ __forceinline__ Ctx phase_ctx(const Ctx& F0) {
    Ctx C = F0;
    C.tid = F0.wave * 64 + lane_id();
    asm volatile("" : "+v"(C.tid));
    { size_t z = 0; asm volatile("" : "+s"(z)); C.ws = F0.ws + z; }
    C.lane = C.tid & 63; C.wave = __builtin_amdgcn_readfirstlane(C.tid >> 6);
    return C;
}

__device__ __forceinline__ int srcmap(int mode, int n) {
    if (mode == 0) {
        const int pn = n >> 8, q = n & 255, bj = q >> 7, r = q & 127, rope = (r >> 6) * 128 + bj * 64 + (r & 63);
        if (pn == 0) return rope;
        if (pn == 1) return 256 + q;
        if (pn == 2) return 512 + q;
        if (pn == 3) return r < 32 ? 768 + bj * 32 + r : -1;
        if (pn == 4) return 832 + rope;
        if (pn == 5) return 1088 + q;
        if (pn < 10) return 1344 + (pn - 6) * 256 + rope;
        if (pn < 12) return 2368 + (pn - 10) * 256 + q;
        if (pn < 16) return 2880 + (pn - 12) * 256 + rope;
        if (pn < 24) return 3904 + bj * 1024 + 128 * (pn - 16) + r;
        return 5952 + (n - 6144);
    }
    if (mode == 1) { if (n < 1024) return (n >> 7) * 192 + (n & 127);
        const int m = n - 1024, t = m >> 8, bj = (m >> 7) & 1, q = m & 127; return (4 * t + (q >> 5)) * 192 + 128 + bj * 32 + (q & 31); }
    if (mode == 2) { if (n < 1024) return (n >> 7) * 256 + (n & 127); const int m = n - 1024; return (m >> 7) * 256 + 128 + (m & 127); }
    return n;
}
__device__ __forceinline__ void tr_tile(const Ctx& F, const float* src, int ld_src, int mode, int k0, bf16_t* dst, int ldd, int n0, const float* kscale = nullptr) {
    LAS float* T = (LAS float*)F.lds;
    const int kr = F.tid >> 4, nc = (F.tid & 15) * 4, sc = srcmap(mode, n0 + nc);
#pragma unroll
    for (int h = 0; h < 2; ++h) { const int k = kr + 32 * h; f32x4 v = {0.f, 0.f, 0.f, 0.f};
        if (sc >= 0) v = *(const f32x4*)(src + (size_t)(k0 + k) * ld_src + sc);
        if (kscale) v = v * kscale[k0 + k];
        T[k * 65 + nc + 0] = v[0]; T[k * 65 + nc + 1] = v[1]; T[k * 65 + nc + 2] = v[2]; T[k * 65 + nc + 3] = v[3]; }
    __syncthreads();
    const int n = F.tid >> 3, kc = (F.tid & 7) * 8;
    u32x4 w;
    w.x = cvt_pk_bf16(T[(kc + 0) * 65 + n], T[(kc + 1) * 65 + n]); w.y = cvt_pk_bf16(T[(kc + 2) * 65 + n], T[(kc + 3) * 65 + n]);
    w.z = cvt_pk_bf16(T[(kc + 4) * 65 + n], T[(kc + 5) * 65 + n]); w.w = cvt_pk_bf16(T[(kc + 6) * 65 + n], T[(kc + 7) * 65 + n]);
    *(u32x4*)(dst + (size_t)(n0 + n) * ldd + k0 + kc) = w;
    __syncthreads();
}
__device__ __forceinline__ void cvt_rows(const Ctx& F, const float* src, bf16_t* dst, size_t n8) {
    for (size_t i = (size_t)F.bid * 512 + F.tid; i < n8; i += (size_t)F.G * 512) {
        const f32x4 a = *(const f32x4*)(src + i * 8), b = *(const f32x4*)(src + i * 8 + 4);
        *(u32x4*)(dst + i * 8) = pg8::pack8(a, b); }
}

__device__ __forceinline__ void cvt_rows_fp8(const Ctx& F, const float* src, unsigned char* dst, size_t n16, float scale) {
    for (size_t i = (size_t)F.bid * 512 + F.tid; i < n16; i += (size_t)F.G * 512) {
        u32x4 w;
#pragma unroll
        for (int j = 0; j < 4; ++j) { const f32x4 a = *(const f32x4*)(src + i * 16 + 4 * j) * scale;
            int p = 0; p = __builtin_amdgcn_cvt_pk_fp8_f32(a[0], a[1], p, false); p = __builtin_amdgcn_cvt_pk_fp8_f32(a[2], a[3], p, true); w[j] = (unsigned)p; }
        *(u32x4*)(dst + i * 16) = w; }
}

__device__ __forceinline__ void ph_prologue(const Ctx& F0) {
    const Ctx F = phase_ctx(F0);
    using namespace cf;
    constexpr int T_WIN = 2 * 32 * 224, T_QUP = 2 * 8 * 24, T_KVUP = 2 * 4 * 32, T_BR = 2 * 4 * 16 * 32, T_WO = 2 * 32 * 32;
    constexpr int T_ALL = T_WIN + T_QUP + T_KVUP + T_BR + T_WO;
    for (int u = F.bid; u < T_ALL; u += F.G) {
        int t = u;
        if (t < T_WIN) { const int l = t / (32 * 224), r = t % (32 * 224), kt = r / 224, nt = r % 224;
            tr_tile(F, F.in[I_WIN] + (size_t)l * 2048 * IN_COLS, IN_COLS, 0, kt * 64, WSP(bf16_t, WS_WIN) + (size_t)l * NC * 2048, 2048, nt * 64); continue; }
        t -= T_WIN;
        if (t < T_QUP) { const int l = t / (8 * 24), r = t % (8 * 24), kt = r / 24, nt = r % 24;
            tr_tile(F, F.in[I_WQUP] + (size_t)l * 512 * 1536, 1536, 1, kt * 64, WSP(bf16_t, WS_WQUP) + (size_t)l * 1536 * 512, 512, nt * 64, F.in[I_BQN] + l * 512); continue; }
        t -= T_QUP;
        if (t < T_KVUP) { const int l = t / (4 * 32), r = t % (4 * 32), kt = r / 32, nt = r % 32;
            tr_tile(F, F.in[I_WKVUP] + (size_t)l * 256 * 2048, 2048, 2, kt * 64, WSP(bf16_t, WS_WKVUP) + (size_t)l * 2048 * 256, 256, nt * 64, F.in[I_BKVN] + l * 256); continue; }
        t -= T_KVUP;
        if (t < T_BR) { const int l = t / (4 * 512), r = t % (4 * 512), br = r / 512, r2 = r % 512, kt = r2 / 32, nt = r2 % 32;
            const float* src = (br == 0 ? F.in[I_WBRA] : br == 1 ? F.in[I_WBRB] : br == 2 ? F.in[I_WBRC] : F.in[I_WBRD]) + (size_t)l * 1024 * 2048;
            tr_tile(F, src, 2048, 3, kt * 64, WSP(bf16_t, WS_WBR) + ((size_t)l * 4 + br) * 2048 * 1024, 1024, nt * 64); continue; }
        t -= T_BR;
        { const int l = t / 1024, r = t % 1024, kt = r / 32, nt = r % 32;
            tr_tile(F, F.in[I_WO] + (size_t)l * 2048 * 2048, 2048, 3, kt * 64, WSP(bf16_t, WS_WO) + (size_t)l * 2048 * 2048, 2048, nt * 64); }
    }
    for (int u = F.bid; u < 2 * 16 * 32; u += F.G) {
        const int l = u / 512, g = (u % 512) / 32, d0 = (u % 32) * 64;
        LAS float* sk = (LAS float*)F.lds; LAS float* wt = (LAS float*)(F.lds + 128 * 129 * 4);
        const float* skg = F.in[I_PSK] + ((size_t)l * 16 + g) * 128 * 128;
        const float* wqg = F.in[I_PWQ] + (size_t)l * 2048 * 2048 + (size_t)d0 * 2048 + g * 128;
        for (int i = F.tid; i < 128 * 128; i += 512) sk[(i >> 7) * 129 + (i & 127)] = skg[i];
        for (int i = F.tid; i < 64 * 128; i += 512) wt[(i >> 7) * 129 + (i & 127)] = wqg[(size_t)(i >> 7) * 2048 + (i & 127)];
        __syncthreads();
        const int n = F.tid & 127, dg = F.tid >> 7;
        float a[16];
#pragma unroll
        for (int e = 0; e < 16; ++e) a[e] = 0.f;
        for (int k = 0; k < 128; ++k) { const float s = sk[n * 129 + k];
#pragma unroll
            for (int e = 0; e < 16; ++e) a[e] += wt[(dg * 16 + e) * 129 + k] * s; }
        bf16_t* dst = WSP(bf16_t, WS_WFOLD) + (size_t)l * 2048 * 2048 + (size_t)(g * 128 + n) * 2048 + d0 + dg * 16;
        u32x4 w0, w1;
        w0.x = cvt_pk_bf16(a[0], a[1]); w0.y = cvt_pk_bf16(a[2], a[3]); w0.z = cvt_pk_bf16(a[4], a[5]); w0.w = cvt_pk_bf16(a[6], a[7]);
        w1.x = cvt_pk_bf16(a[8], a[9]); w1.y = cvt_pk_bf16(a[10], a[11]); w1.z = cvt_pk_bf16(a[12], a[13]); w1.w = cvt_pk_bf16(a[14], a[15]);
        *(u32x4*)dst = w0; *(u32x4*)(dst + 8) = w1;
        __syncthreads();
    }
    for (int u = F.bid; u < 2 * 192; u += F.G) {
        const int l = u / 192, n0 = (u % 192) * 64;
        LAS float* sl = (LAS float*)F.lds; LAS float* red = (LAS float*)(F.lds + 5 * 2048 * 4);
        for (int i = F.tid; i < 5 * 2048; i += 512) { const int r = i >> 11, k = i & 2047; const float v = r < 4 ? F.in[I_C][r * 2048 + k] : F.in[I_CCTX][k]; sl[i] = v * sigmoidf_(v); }
        __syncthreads();
        const int col = F.tid & 63, ks = F.tid >> 6;
        float a[5] = {0.f, 0.f, 0.f, 0.f, 0.f};
        const float* wp = F.in[I_WADA] + (size_t)l * 2048 * 12288 + n0 + col;
        for (int k = ks * 256; k < ks * 256 + 256; ++k) { const float w = wp[(size_t)k * 12288];
#pragma unroll
            for (int r = 0; r < 5; ++r) a[r] += sl[r * 2048 + k] * w; }
#pragma unroll
        for (int r = 0; r < 5; ++r) red[(ks * 5 + r) * 64 + col] = a[r];
        __syncthreads();
        if (F.tid < 320) { const int r = F.tid >> 6; float s = 0.f;
#pragma unroll
            for (int k2 = 0; k2 < 8; ++k2) s += red[(k2 * 5 + r) * 64 + col];
            WSP(float, WS_MOD)[((size_t)l * 5 + r) * 12288 + n0 + col] = s + F.in[I_BADA][(size_t)l * 12288 + n0 + col]; }
        __syncthreads();
    }
    for (int i = F.bid * 512 + F.tid; i < 4096 * 64; i += F.G * 512) {
        const int pos = i >> 6, j = i & 63, fi = j & 31; const float fr = powf(10000.0f, -(float)(2 * fi) / 64.0f);
        const float ang = (float)(j < 32 ? (pos >> 6) : (pos & 63)) * fr;
        WSP(float, WS_COSH)[i] = cosf(ang); WSP(float, WS_SINH)[i] = sinf(ang);
    }
    for (int i = F.bid * 512 + F.tid; i < 4096 * 32; i += F.G * 512) {
        const int pos = i >> 5, j = i & 31, fi = j & 15; const float fr = powf(10000.0f, -(float)(2 * fi) / 32.0f);
        const float ang = (float)(j < 16 ? (pos >> 6) : (pos & 63)) * fr;
        WSP(float, WS_COSR)[i] = cosf(ang); WSP(float, WS_SINR)[i] = sinf(ang);
    }
    cvt_rows_fp8(F, F.in[I_PU], WSP(unsigned char, WS_UB), (size_t)2 * NEXP * 2048 / 16, 1024.f);
    cvt_rows_fp8(F, F.in[I_PV], WSP(unsigned char, WS_VB2), (size_t)2 * NEXP * 2048 / 16, 16.f);
}

__device__ __forceinline__ void ph_modulate0(const Ctx& F0) {
    const Ctx F = phase_ctx(F0);
    using namespace cf;
    const float* mod = WSP(float, WS_MOD);
    for (size_t i = (size_t)F.bid * 512 + F.tid; i < (size_t)MR * 256; i += (size_t)F.G * 512) {
        const int R = (int)(i >> 8), d = (int)(i & 255) * 8, b = R / RB, j = R % RB;
        const float* src = j < CTX ? F.in[I_CTX] + ((size_t)b * CTX + j) * 2048 : F.in[I_X] + ((size_t)b * S + (j - CTX)) * 2048;
        const float* m = mod + (size_t)(j < CTX ? 4 : b) * 12288;
        const f32x4 x0 = *(const f32x4*)(src + d), x1 = *(const f32x4*)(src + d + 4);
        const f32x4 sh0 = *(const f32x4*)(m + d), sh1 = *(const f32x4*)(m + d + 4), s0 = *(const f32x4*)(m + 2048 + d), s1 = *(const f32x4*)(m + 2048 + d + 4);
        *(u32x4*)(WSP(bf16_t, WS_HB) + (size_t)R * 2048 + d) = pg8::pack8(x0 * (s0 + 1.0f) + sh0, x1 * (s1 + 1.0f) + sh1);
    }
}

__device__ __forceinline__ void knorm_pass(const Ctx& F) {
    using namespace cf;
    bf16_t* P = WSP(bf16_t, WS_P); const float* ssk = WSP(const float, WS_SSK);
    for (int it = F.bid * 8 + F.wave; it < MR * 2; it += F.G * 8) {
        const int R = it >> 1, h = it & 1;
        const f32x2 pp = *(const f32x2*)(ssk + (size_t)it * 2); const float r = rsqrtf((pp.x + pp.y) * (1.f / 128.f) + 1e-6f);
        unsigned* q = (unsigned*)(P + (size_t)R * NC + PC_AK + h * 128) + F.lane;
        const unsigned w = *q; *q = cvt_pk_bf16(bflo(w) * r, bfhi(w) * r);
    }
}

struct AttnArgs {
    const bf16_t* Q; const bf16_t* K; const bf16_t* V; bf16_t* O; int ldq, ldk, ldv, ldo;
    int seg0_row, seg0_tiles, seg1_row, seg1_tiles;
    int mask_on, qpos0, kpos1;
    float sc_log2; int has_sink; float sink_l2;
    const float* qss;
};
typedef float f32x16 __attribute__((ext_vector_type(16)));
template <int DK>
__device__ __forceinline__ void attn_unit(ldsp_t lds, const AttnArgs a, int wave_) {
    constexpr int ND = DK / 16, KST = DK + 8, KCH = DK / 8, KPT = (64 * KCH) / 512, VST = 72;
    constexpr int KBUF = 64 * KST * 2, VBUF = 128 * VST * 2, VOFF = 2 * KBUF, ALOFF = VOFF + 3 * VBUF;
    int tid = wave_ * 64 + lane_id(); asm volatile("" : "+v"(tid));
    const int wid = __builtin_amdgcn_readfirstlane(tid >> 6), lane = tid & 63, q32 = lane & 31, hi = lane >> 5;
    LAS float* al = (LAS float*)(lds + ALOFF + wid * 128);
    bf16x8 qf[ND];
    { float scq = a.sc_log2;
      if (a.qss) { const f32x2 pp = *(const f32x2*)(a.qss + (size_t)(wid * 32 + q32) * 16); scq *= rsqrtf((pp.x + pp.y) * (1.f / 128.f) + 1e-6f); }
      const bf16_t* qrow = a.Q + (size_t)(wid * 32 + q32) * a.ldq + 8 * hi;
#pragma unroll
      for (int s = 0; s < ND; ++s) { const u32x4 w = *(const u32x4*)(qrow + 16 * s); u32x4 o;
          o.x = cvt_pk_bf16(bflo(w.x) * scq, bfhi(w.x) * scq); o.y = cvt_pk_bf16(bflo(w.y) * scq, bfhi(w.y) * scq);
          o.z = cvt_pk_bf16(bflo(w.z) * scq, bfhi(w.z) * scq); o.w = cvt_pk_bf16(bflo(w.w) * scq, bfhi(w.w) * scq); qf[s] = *(bf16x8*)&o; } }
    f32x16 o[4];
#pragma unroll
    for (int db = 0; db < 4; ++db)
#pragma unroll
        for (int r = 0; r < 16; ++r) o[db][r] = 0.f;
    float m_run = -1e30f, l_run = 0.f;
    const int ntiles = a.seg0_tiles + a.seg1_tiles;
    u32x4 kreg[KPT], vreg[2];
    const int vkp = tid & 31, vdc = tid >> 5;
    const int vkey = 2 * vkp, vpos = (vkey & 48) | ((vkey & 4) << 1) | ((vkey & 8) >> 1) | (vkey & 3);
#define ATT_LOAD(tt) do { const int _r0 = (tt) < a.seg0_tiles ? a.seg0_row + 64 * (tt) : a.seg1_row + 64 * ((tt) - a.seg0_tiles); \
        _Pragma("unroll") for (int _i = 0; _i < KPT; ++_i) { const int _c = tid + 512 * _i; kreg[_i] = *(const u32x4*)(a.K + (size_t)(_r0 + _c / KCH) * a.ldk + 8 * (_c % KCH)); } \
        vreg[0] = *(const u32x4*)(a.V + (size_t)(_r0 + 2 * vkp) * a.ldv + 8 * vdc); vreg[1] = *(const u32x4*)(a.V + (size_t)(_r0 + 2 * vkp + 1) * a.ldv + 8 * vdc); } while (0)
#define ATT_WRITE(kb, vb) do { const ldsp_t _kb = lds + (kb) * KBUF; const ldsp_t _vb = lds + VOFF + (vb) * VBUF; \
        _Pragma("unroll") for (int _i = 0; _i < KPT; ++_i) { const int _c = tid + 512 * _i; *(LAS u32x4*)(_kb + ((_c / KCH) * KST + 8 * (_c % KCH)) * 2) = kreg[_i]; } \
        const unsigned _a0[4] = {vreg[0].x, vreg[0].y, vreg[0].z, vreg[0].w}, _a1[4] = {vreg[1].x, vreg[1].y, vreg[1].z, vreg[1].w}; \
        _Pragma("unroll") for (int _e = 0; _e < 4; ++_e) { \
            *(LAS unsigned*)(_vb + ((8 * vdc + 2 * _e) * VST + vpos) * 2) = (_a0[_e] & 0xffffu) | (_a1[_e] << 16); \
            *(LAS unsigned*)(_vb + ((8 * vdc + 2 * _e + 1) * VST + vpos) * 2) = (_a0[_e] >> 16) | (_a1[_e] & 0xffff0000u); } } while (0)
#define ATT_LDV(p, db) do { _Pragma("unroll") for (int _k = 0; _k < 4; ++_k) vfr[p][_k] = *(const LAS bf16x8*)(_vt + ((32 * (db) + q32) * VST + 16 * _k + 8 * hi) * 2); } while (0)
#define ATT_PV(vb) do { const ldsp_t _vt = lds + VOFF + (vb) * VBUF; bf16x8 vfr[2][4]; \
        ATT_LDV(0, 0); __builtin_amdgcn_sched_barrier(0); \
        _Pragma("unroll") for (int db = 0; db < 4; ++db) { if (db + 1 < 4) ATT_LDV((db + 1) & 1, db + 1); __builtin_amdgcn_sched_barrier(0); \
            _Pragma("unroll") for (int ks = 0; ks < 4; ++ks) o[db] = __builtin_amdgcn_mfma_f32_32x32x16_bf16(pa[ks], vfr[db & 1][ks], o[db], 0, 0, 0); \
            __builtin_amdgcn_sched_barrier(0); } } while (0)
    bf16x8 pa[4];
    int vprev = 2, vcur = 0, vnext = 1;
    ATT_LOAD(0);
    ATT_WRITE(0, 0);
    __syncthreads();
    for (int tt = 0; tt < ntiles; ++tt) {
        const int cur = tt & 1;
        if (tt + 1 < ntiles) ATT_LOAD(tt + 1);
        const ldsp_t Ks = lds + cur * KBUF;
        f32x16 s0, s1;
#pragma unroll
        for (int r = 0; r < 16; ++r) { s0[r] = 0.f; s1[r] = 0.f; }
        { bf16x8 kf[2][4];
#define ATT_LDK(p, sb) do { _Pragma("unroll") for (int _j = 0; _j < 2; ++_j) { \
            kf[p][2 * _j] = *(const LAS bf16x8*)(Ks + (q32 * KST + 16 * (2 * (sb) + _j) + 8 * hi) * 2); \
            kf[p][2 * _j + 1] = *(const LAS bf16x8*)(Ks + ((32 + q32) * KST + 16 * (2 * (sb) + _j) + 8 * hi) * 2); } } while (0)
          ATT_LDK(0, 0); __builtin_amdgcn_sched_barrier(0);
#pragma unroll
          for (int sb = 0; sb < ND / 2; ++sb) {
              if (sb + 1 < ND / 2) ATT_LDK((sb + 1) & 1, sb + 1);
              __builtin_amdgcn_sched_barrier(0);
#pragma unroll
              for (int j = 0; j < 2; ++j) { s0 = __builtin_amdgcn_mfma_f32_32x32x16_bf16(kf[sb & 1][2 * j], qf[2 * sb + j], s0, 0, 0, 0);
                  s1 = __builtin_amdgcn_mfma_f32_32x32x16_bf16(kf[sb & 1][2 * j + 1], qf[2 * sb + j], s1, 0, 0, 0); }
              __builtin_amdgcn_sched_barrier(0); }
#undef ATT_LDK
        }
        if (tt > 0) ATT_PV(vprev);
        const bool msk = a.mask_on && tt >= a.seg0_tiles;
        const int kp0 = a.kpos1 + 64 * (tt - a.seg0_tiles) + 4 * hi, qp = a.qpos0 + wid * 32 + q32;
        float mx = -1e30f;
#pragma unroll
        for (int r = 0; r < 16; ++r) { float t0 = s0[r], t1 = s1[r];
            if (msk) { const int d0 = qp - (kp0 + (r & 3) + 8 * (r >> 2)), d1 = d0 - 32; if (d0 > 128 || d0 < -128) t0 = -1e30f; if (d1 > 128 || d1 < -128) t1 = -1e30f; s0[r] = t0; s1[r] = t1; }
            mx = fmaxf(mx, fmaxf(t0, t1)); }
        mx = fmaxf(mx, shx(mx, 32, lane));
        const float m_new = fmaxf(m_run, mx), alpha = __builtin_amdgcn_exp2f(m_run - m_new); m_run = m_new;
        float ps = 0.f;
#pragma unroll
        for (int r = 0; r < 16; ++r) { s0[r] = __builtin_amdgcn_exp2f(s0[r] - m_new); s1[r] = __builtin_amdgcn_exp2f(s1[r] - m_new); ps += s0[r] + s1[r]; }
        l_run = l_run * alpha + ps;
        if (__any(alpha < 1.0f)) {
            if (hi == 0) al[q32] = alpha;
            asm volatile("s_waitcnt lgkmcnt(0)" ::: "memory");
#pragma unroll
            for (int g4 = 0; g4 < 4; ++g4) { const f32x4 av = *(const LAS f32x4*)(al + 8 * g4 + 4 * hi);
#pragma unroll
                for (int db = 0; db < 4; ++db)
#pragma unroll
                    for (int j = 0; j < 4; ++j) o[db][4 * g4 + j] *= av[j]; }
        }
#pragma unroll
        for (int g2 = 0; g2 < 2; ++g2) {
            u32x4 w; w.x = cvt_pk_bf16(s0[8 * g2 + 0], s0[8 * g2 + 1]); w.y = cvt_pk_bf16(s0[8 * g2 + 2], s0[8 * g2 + 3]); w.z = cvt_pk_bf16(s0[8 * g2 + 4], s0[8 * g2 + 5]); w.w = cvt_pk_bf16(s0[8 * g2 + 6], s0[8 * g2 + 7]); pa[g2] = *(bf16x8*)&w;
            u32x4 v; v.x = cvt_pk_bf16(s1[8 * g2 + 0], s1[8 * g2 + 1]); v.y = cvt_pk_bf16(s1[8 * g2 + 2], s1[8 * g2 + 3]); v.z = cvt_pk_bf16(s1[8 * g2 + 4], s1[8 * g2 + 5]); v.w = cvt_pk_bf16(s1[8 * g2 + 6], s1[8 * g2 + 7]); pa[2 + g2] = *(bf16x8*)&v; }
        if (tt + 1 < ntiles) ATT_WRITE(cur ^ 1, vnext);
        { const int t3 = vprev; vprev = vcur; vcur = vnext; vnext = t3; }
        __syncthreads();
    }
    ATT_PV(vprev);
#undef ATT_LOAD
#undef ATT_WRITE
#undef ATT_PV
#undef ATT_LDV
    __syncthreads();
    float l_tot = l_run + shx(l_run, 32, lane);
    if (a.has_sink) l_tot += __builtin_amdgcn_exp2f(a.sink_l2 - m_run);
    if (hi == 0) al[q32] = 1.0f / l_tot;
    asm volatile("s_waitcnt lgkmcnt(0)" ::: "memory");
    const ldsp_t Ost = lds + wid * 8192;
#pragma unroll
    for (int g4 = 0; g4 < 4; ++g4) { const f32x4 iv = *(const LAS f32x4*)(al + 8 * g4 + 4 * hi);
#pragma unroll
        for (int db = 0; db < 4; ++db)
#pragma unroll
            for (int j = 0; j < 4; ++j) *(LAS bf16_t*)(Ost + ((8 * g4 + 4 * hi + j) * 128 + 32 * db + q32) * 2) = f2bf(o[db][4 * g4 + j] * iv[j]); }
    asm volatile("s_waitcnt lgkmcnt(0)" ::: "memory");
#pragma unroll
    for (int i = 0; i < 8; ++i) { const int c = lane + 64 * i, row = c >> 4, c8 = c & 15;
        *(u32x4*)(a.O + (size_t)(wid * 32 + row) * a.ldo + 8 * c8) = *(const LAS u32x4*)(Ost + (row * 128 + 8 * c8) * 2); }
}

__device__ __forceinline__ void conv_unit(const Ctx& F, int layer, int row0  , int seq_len, int t0) {
    using namespace cf;
    const bf16_t* P = WSP(const bf16_t, WS_P); bf16_t* BR = WSP(bf16_t, WS_BR);
    const float* cw = F.in[I_CW] + (size_t)layer * 31 * 1024; const float* cb = F.in[I_CB] + layer * 1024;
    const float* lg = F.in[I_CLG] + layer * 1024; const float* lb = F.in[I_CLB] + layer * 1024;
    int tid = F.tid; asm volatile("" : "+v"(tid));
    const int lane = tid & 63;
    LAS float* red = (LAS float*)(F.lds + 126976); LAS float* tot = red + 8 * 32;
    __syncthreads();
    for (int c = tid; c < 62 * 128; c += 512) { const int rr = c >> 7, ch = c & 127, t = t0 - 15 + rr;
        u32x4 v = {0u, 0u, 0u, 0u};
        if (t >= 0 && t < seq_len) v = *(const u32x4*)(P + (size_t)(row0 + t) * NC + PC_GLU + ch * 8);
        *(LAS u32x4*)(F.lds + rr * 2048 + ch * 16) = v; }
    float w0[31], w1[31];
#pragma unroll
    for (int k = 0; k < 31; ++k) { const f32x2 w = *(const f32x2*)(cw + k * 1024 + 2 * tid); w0[k] = w.x; w1[k] = w.y; }
    const f32x2 bv = *(const f32x2*)(cb + 2 * tid), gg = *(const f32x2*)(lg + 2 * tid), bb = *(const f32x2*)(lb + 2 * tid);
    __syncthreads();
#pragma unroll 1
    for (int part = 0; part < 4; ++part) {
        float a0[8], a1[8];
#pragma unroll
        for (int t = 0; t < 8; ++t) { a0[t] = bv.x; a1[t] = bv.y; }
        const ldsp_t base = F.lds + part * 8 * 2048 + tid * 4;
#pragma unroll
        for (int rr = 0; rr < 38; ++rr) { const unsigned xw = *(const LAS unsigned*)(base + rr * 2048); const float x0 = bflo(xw), x1 = bfhi(xw);
#pragma unroll
            for (int t = 0; t < 8; ++t) { const int k = rr - t; if (k >= 0 && k <= 30) { a0[t] += x0 * w0[k]; a1[t] += x1 * w1[k]; } } }
        float v[16];
#pragma unroll
        for (int t = 0; t < 8; ++t) { v[t] = a0[t] + a1[t]; v[8 + t] = a0[t] * a0[t] + a1[t] * a1[t]; }
#pragma unroll
        for (int i = 0; i < 8; ++i) { const bool up = lane & 32; const float snd = up ? v[i] : v[i + 8], kp = up ? v[i + 8] : v[i]; v[i] = kp + shx(snd, 32, lane); }
#pragma unroll
        for (int i = 0; i < 4; ++i) { const bool up = lane & 16; const float snd = up ? v[i] : v[i + 4], kp = up ? v[i + 4] : v[i]; v[i] = kp + shx(snd, 16, lane); }
#pragma unroll
        for (int i = 0; i < 2; ++i) { const bool up = lane & 8; const float snd = up ? v[i] : v[i + 2], kp = up ? v[i + 2] : v[i]; v[i] = kp + shx(snd, 8, lane); }
        { const bool up = lane & 4; const float snd = up ? v[0] : v[1], kp = up ? v[1] : v[0]; v[0] = kp + shx(snd, 4, lane); }
        v[0] += shx(v[0], 2, lane); v[0] += shx(v[0], 1, lane);
        if ((lane & 3) == 0) red[F.wave * 16 + (lane >> 2)] = v[0];
        __syncthreads();
        if (tid < 16) { float s = 0.f;
#pragma unroll
            for (int w = 0; w < 8; ++w) s += red[w * 16 + tid];
            tot[tid] = s; }
        __syncthreads();
#pragma unroll
        for (int t = 0; t < 8; ++t) { const float mean = tot[t] * (1.f / 1024.f), var = fmaxf(tot[8 + t] * (1.f / 1024.f) - mean * mean, 0.f), rstd = rsqrtf(var + 1e-5f);
            const float y0 = (a0[t] - mean) * rstd * gg.x + bb.x, y1 = (a1[t] - mean) * rstd * gg.y + bb.y;
            *(unsigned*)(BR + (size_t)(row0 + t0 + part * 8 + t) * 4096 + 2048 + 2 * tid) = cvt_pk_bf16(y0 * sigmoidf_(y0), y1 * sigmoidf_(y1)); }
    }
}

__device__ __forceinline__ void attn_defaults(AttnArgs& a, int isctx) {
    a.seg0_row = 0; a.seg0_tiles = isctx ? 4 : 68; a.seg1_row = 0; a.seg1_tiles = 0; a.mask_on = 0; a.qpos0 = 0; a.kpos1 = 0; a.has_sink = 0; a.sink_l2 = 0.f; a.qss = nullptr; }
__device__ __forceinline__ void ph_attn(const Ctx& F0, int layer) {
    const Ctx F = phase_ctx(F0);
    using namespace cf;
    const bf16_t* P = WSP(const bf16_t, WS_P); bf16_t* BR = WSP(bf16_t, WS_BR);
    for (int dup = 0; dup < DUPN(2); ++dup)
    for (int u = F.bid; u < (layer == 0 ? 544 : 512); u += F.G) {
        int b, h, qb, isctx = 0;
        if (u < 512) { b = u >> 7; h = (u >> 4) & 7; qb = u & 15; } else { const int r = u - 512; b = r >> 3; h = r & 7; qb = 0; isctx = 1; }
        const size_t brow = (size_t)b * RB, qrow = brow + (isctx ? 0 : CTX) + (size_t)qb * 256;
        AttnArgs a; attn_defaults(a, isctx);
        a.Q = WSP(const bf16_t, WS_QB) + qrow * 1536 + h * 192; a.ldq = 1536;
        a.K = WSP(const bf16_t, WS_KB) + brow * 1536 + h * 192; a.ldk = 1536;
        a.V = WSP(const bf16_t, WS_VB) + brow * 1024 + h * 128; a.ldv = 1024;
        a.O = BR + qrow * 4096 + 1024 + h * 128; a.ldo = 4096; a.sc_log2 = SCALE_MLA * LOG2E;
        __syncthreads();
        attn_unit<192>(F.lds, a, F.wave);
    }
    for (int dup = 0; dup < DUPN(3); ++dup)
    for (int u0 = F.bid; u0 < (layer == 0 ? 1088 : 1024); u0 += F.G) {
        int kind, b, h, qb, isctx = 0;
        if (u0 < 1024) { kind = 1 + (u0 >> 9); const int r = u0 & 511; b = r >> 7; h = (r >> 4) & 7; qb = r & 15; }
        else { const int r = u0 - 1024; kind = 1 + (r >> 5); const int r2 = r & 31; b = r2 >> 3; h = r2 & 7; qb = 0; isctx = 1; }
        const size_t brow = (size_t)b * RB, qrow = brow + (isctx ? 0 : CTX) + (size_t)qb * 256;
        AttnArgs a; attn_defaults(a, isctx);
        const int qc = kind == 1 ? PC_AQ : PC_DQ, kc = kind == 1 ? PC_AK : PC_DK, vc = kind == 1 ? PC_AV : PC_DV;
        a.Q = P + qrow * NC + qc + h * 128; a.ldq = NC;
        a.K = P + brow * NC + kc + (h >> 2) * 128; a.ldk = NC;
        a.V = P + brow * NC + vc + (h >> 2) * 128; a.ldv = NC;
        a.O = BR + qrow * 4096 + (kind == 1 ? 0 : 3072) + h * 128; a.ldo = 4096; a.sc_log2 = SCALE_HD * LOG2E;
        if (kind == 1) a.qss = WSP(const float, WS_SSQ) + qrow * 16 + h * 2;
        if (kind == 2) { a.has_sink = 1; a.sink_l2 = F.in[I_SINK][layer * 8 + h] * LOG2E; a.seg0_tiles = 4;
            if (!isctx) { const int start = qb * 256; const int lo = start - 128 < 0 ? 0 : start - 128, hi = start + 384 > S ? S : start + 384;
                a.seg1_row = CTX + lo; a.seg1_tiles = (hi - lo) / 64; a.mask_on = 1; a.qpos0 = start; a.kpos1 = lo; } }
        __syncthreads();
        attn_unit<128>(F.lds, a, F.wave);
    }
    for (int dup = 0; dup < DUPN(4); ++dup)
    for (int u = F.bid; u < (layer == 0 ? 544 : 512); u += F.G) {
        int b, tb, isctx = 0;
        if (u < 512) { b = u >> 7; tb = u & 127; } else { const int r = u - 512; b = r >> 3; tb = r & 7; isctx = 1; }
        conv_unit(F, layer, b * RB + (isctx ? 0 : CTX), isctx ? CTX : S, tb * 32);
    }
}

__device__ __forceinline__ int tok_row(int layer, int tok) { return layer == 0 ? tok : (tok >> 12) * cf::RB + cf::CTX + (tok & 4095); }
__device__ __forceinline__ void ph_ln1(const Ctx& F0, int layer) {
    const Ctx F = phase_ctx(F0);
    using namespace cf;
    float* X1 = (float*)(F.ws + WS_P + X1_OFF); bf16_t* HB = WSP(bf16_t, WS_HB);
    const float* lg = F.in[I_LN1G] + layer * 2048; const float* lb = F.in[I_LN1B] + layer * 2048;
    const int ntok = layer == 0 ? MR : NB * S, lane = F.lane;
    for (int tok = F.bid * 8 + F.wave; tok < ntok; tok += F.G * 8) {
        const int R = tok_row(layer, tok), b = R / RB, j = R % RB;
        const float* mod = WSP(const float, WS_MOD) + ((size_t)layer * 5 + (j < CTX ? 4 : b)) * 12288;
        float* xp = X1 + (size_t)R * 2048;
        f32x4 v[8]; float s = 0.f;
#pragma unroll
        for (int i = 0; i < 8; ++i) { v[i] = *(const f32x4*)(xp + lane * 4 + 256 * i); s += (v[i][0] + v[i][1]) + (v[i][2] + v[i][3]); }
        const float mean = wave_sum(s, lane) * (1.f / 2048.f); float q = 0.f;
#pragma unroll
        for (int i = 0; i < 8; ++i) { const f32x4 d = v[i] - mean; q += (d[0] * d[0] + d[1] * d[1]) + (d[2] * d[2] + d[3] * d[3]); }
        const float rstd = rsqrtf(wave_sum(q, lane) * (1.f / 2048.f) + 1e-5f);
#pragma unroll
        for (int i = 0; i < 8; ++i) { const int c = lane * 4 + 256 * i;
            const f32x4 y = (v[i] - mean) * rstd * *(const f32x4*)(lg + c) + *(const f32x4*)(lb + c);
            *(f32x4*)(xp + c) = y;
            const f32x4 hp = y * (*(const f32x4*)(mod + 4 * 2048 + c) + 1.0f) + *(const f32x4*)(mod + 3 * 2048 + c);
            u32x2 w; w.x = cvt_pk_bf16(hp[0], hp[1]); w.y = cvt_pk_bf16(hp[2], hp[3]);
            *(u32x2*)(HB + (size_t)R * 2048 + c) = w; }
    }
}

typedef __bf16 bf16x2_t __attribute__((ext_vector_type(2)));
__device__ __forceinline__ unsigned ordkey(float v) { const unsigned u = __float_as_uint(v); return (u & 0x80000000u) ? ~u : (u | 0x80000000u); }
__device__ __forceinline__ int lane_rank(unsigned long long m) { return (int)__builtin_amdgcn_mbcnt_hi((unsigned)(m >> 32), __builtin_amdgcn_mbcnt_lo((unsigned)m, 0u)); }
template <int NV> __device__ __forceinline__ unsigned radix_thresh16(const unsigned (&k)[NV]) {
    unsigned T = 0u;
    for (int bit = 31; bit >= 0; --bit) { const unsigned cand = T | (1u << bit); int cnt = 0;
#pragma unroll
        for (int v = 0; v < NV; ++v) cnt += __popcll(__ballot(k[v] >= cand));
        if (cnt >= 16) T = cand; }
    return T;
}
__device__ __forceinline__ float dot2bf(unsigned a, unsigned b, float acc) { return __builtin_amdgcn_fdot2_f32_bf16(__builtin_bit_cast(bf16x2_t, a), __builtin_bit_cast(bf16x2_t, b), acc, false); }
__device__ __forceinline__ float dot8(const u32x4 a, const u32x4 b, float acc) {
    acc = dot2bf(a.x, b.x, acc); acc = dot2bf(a.y, b.y, acc); acc = dot2bf(a.z, b.z, acc); acc = dot2bf(a.w, b.w, acc);
    return acc;
}
__device__ __forceinline__ void ph_peer(const Ctx& F0, int layer) {
    const Ctx F = phase_ctx(F0);
    using namespace cf;
    const float* SC = (const float*)(F.ws + WS_P + SC_OFF); const float* X1 = (const float*)(F.ws + WS_P + X1_OFF);
    bf16_t* HB = WSP(bf16_t, WS_HB); const unsigned char* U8 = WSP(const unsigned char, WS_UB) + (size_t)layer * NEXP * 2048; const unsigned char* V8 = WSP(const unsigned char, WS_VB2) + (size_t)layer * NEXP * 2048;
    const float* lg = F.in[I_LN2G] + layer * 2048; const float* lb = F.in[I_LN2B] + layer * 2048;
    const int ntok = layer == 0 ? MR : NB * S, lane = F.lane;
    ldsp_t wl = F.lds + F.wave * 4096;
    LAS float* tv0 = (LAS float*)wl; LAS int* ti0 = (LAS int*)(wl + 64); LAS float* tv1 = (LAS float*)(wl + 128); LAS int* ti1 = (LAS int*)(wl + 192);
    LAS float* es = (LAS float*)(wl + 256); LAS int* ei = (LAS int*)(wl + 768); LAS float* eg = (LAS float*)(wl + 1280);
    for (int tok = F.bid * 8 + F.wave; tok < ntok; tok += F.G * 8) {
        const int R = tok_row(layer, tok), b = R / RB, j = R % RB; const bool isctx = j < CTX; const int modrow = isctx ? 4 : b;
        const float* sc = SC + (size_t)R * 2048;
        for (int h = 0; h < 8; ++h) {
            const float s0a = sc[(2 * h) * 128 + lane], s0b = sc[(2 * h) * 128 + 64 + lane], s1a = sc[(2 * h + 1) * 128 + lane], s1b = sc[(2 * h + 1) * 128 + 64 + lane];
            { const unsigned k[2] = {(ordkey(s0a) & ~127u) | (unsigned)(127 - lane), (ordkey(s0b) & ~127u) | (unsigned)(63 - lane)};
              const unsigned T = radix_thresh16<2>(k);
              const unsigned long long m0 = __ballot(k[0] >= T), m1 = __ballot(k[1] >= T); const int n0 = __popcll(m0);
              if (k[0] >= T) { const int r = lane_rank(m0); tv0[r] = s0a; ti0[r] = lane; }
              if (k[1] >= T) { const int r = n0 + lane_rank(m1); tv0[r] = s0b; ti0[r] = lane + 64; } }
            { const unsigned k[2] = {(ordkey(s1a) & ~127u) | (unsigned)(127 - lane), (ordkey(s1b) & ~127u) | (unsigned)(63 - lane)};
              const unsigned T = radix_thresh16<2>(k);
              const unsigned long long m0 = __ballot(k[0] >= T), m1 = __ballot(k[1] >= T); const int n0 = __popcll(m0);
              if (k[0] >= T) { const int r = lane_rank(m0); tv1[r] = s1a; ti1[r] = lane; }
              if (k[1] >= T) { const int r = n0 + lane_rank(m1); tv1[r] = s1b; ti1[r] = lane + 64; } }
            asm volatile("s_waitcnt lgkmcnt(0)" ::: "memory");
            const int ci = lane >> 2, cj = (lane & 3) * 4;
            const float a0 = tv0[ci]; const int i0 = ti0[ci];
            float c4[4]; int id4[4]; unsigned kc[4];
#pragma unroll
            for (int jj = 0; jj < 4; ++jj) { c4[jj] = a0 + tv1[cj + jj]; id4[jj] = i0 * 128 + ti1[cj + jj]; kc[jj] = (ordkey(c4[jj]) & ~255u) | (unsigned)(255 - (lane * 4 + jj)); }
            const unsigned Tc = radix_thresh16<4>(kc);
            int base = h * 16;
#pragma unroll
            for (int jj = 0; jj < 4; ++jj) { const unsigned long long m = __ballot(kc[jj] >= Tc);
                if (kc[jj] >= Tc) { const int r = base + lane_rank(m); es[r] = c4[jj]; ei[r] = id4[jj]; }
                base += __popcll(m); }
            asm volatile("s_waitcnt lgkmcnt(0)" ::: "memory");
        }
#pragma unroll
        for (int rnd = 0; rnd < 2; ++rnd) { const int e = lane + 64 * rnd; const float s = es[e];
            float m = s; m = fmaxf(m, shx(m, 1, lane)); m = fmaxf(m, shx(m, 2, lane)); m = fmaxf(m, shx(m, 4, lane)); m = fmaxf(m, shx(m, 8, lane));
            const float ex = __expf(s - m); float sum = ex; sum += shx(sum, 1, lane); sum += shx(sum, 2, lane); sum += shx(sum, 4, lane); sum += shx(sum, 8, lane);
            eg[e] = ex / sum; }
        asm volatile("s_waitcnt lgkmcnt(0)" ::: "memory");
        f32x2 xf[16];
#pragma unroll
        for (int i = 0; i < 2; ++i)
#pragma unroll
            for (int hh = 0; hh < 2; ++hh) { const u32x4 w = *(const u32x4*)(HB + (size_t)R * 2048 + lane * 16 + 1024 * i + 8 * hh);
                xf[8 * i + 4 * hh + 0] = (f32x2){bflo(w.x), bfhi(w.x)}; xf[8 * i + 4 * hh + 1] = (f32x2){bflo(w.y), bfhi(w.y)};
                xf[8 * i + 4 * hh + 2] = (f32x2){bflo(w.z), bfhi(w.z)}; xf[8 * i + 4 * hh + 3] = (f32x2){bflo(w.w), bfhi(w.w)}; }
        f32x2 y2[16];
#pragma unroll
        for (int i = 0; i < 16; ++i) y2[i] = (f32x2){0.f, 0.f};
        for (int grp = 0; grp < 32; ++grp) {
            int id[4]; float gq[4];
#pragma unroll
            for (int q = 0; q < 4; ++q) { id[q] = __builtin_amdgcn_readfirstlane(ei[grp * 4 + q]); gq[q] = __uint_as_float(__builtin_amdgcn_readfirstlane(__float_as_uint(eg[grp * 4 + q]))); }
            u32x4 ur[4][2], vr[4][2];
#pragma unroll
            for (int q = 0; q < 4; ++q)
#pragma unroll
                for (int i = 0; i < 2; ++i) { ur[q][i] = *(const u32x4*)(U8 + (size_t)id[q] * 2048 + lane * 16 + 1024 * i); vr[q][i] = *(const u32x4*)(V8 + (size_t)id[q] * 2048 + lane * 16 + 1024 * i); }
            float d[4];
#pragma unroll
            for (int q = 0; q < 4; ++q) { f32x2 t = {0.f, 0.f};
#pragma unroll
                for (int i = 0; i < 2; ++i)
#pragma unroll
                    for (int j = 0; j < 4; ++j) { const int w = (int)ur[q][i][j];
                        t += __builtin_amdgcn_cvt_pk_f32_fp8(w, false) * xf[8 * i + 2 * j]; t += __builtin_amdgcn_cvt_pk_f32_fp8(w, true) * xf[8 * i + 2 * j + 1]; }
                d[q] = t.x + t.y; }
#pragma unroll
            for (int o = 32; o >= 1; o >>= 1) {
#pragma unroll
                for (int q = 0; q < 4; ++q) d[q] += shx(d[q], o, lane); }
#pragma unroll
            for (int q = 0; q < 4; ++q) { const float dd = d[q] * (1.0f / 1024.0f); const float w = gq[q] * 0.5f * dd * (1.0f + erff(dd * 0.70710678118654752f)) * (1.0f / 16.0f);
                const f32x2 w2 = {w, w};
#pragma unroll
                for (int i = 0; i < 2; ++i)
#pragma unroll
                    for (int j = 0; j < 4; ++j) { const int vw = (int)vr[q][i][j];
                        y2[8 * i + 2 * j] += w2 * __builtin_amdgcn_cvt_pk_f32_fp8(vw, false); y2[8 * i + 2 * j + 1] += w2 * __builtin_amdgcn_cvt_pk_f32_fp8(vw, true); } }
        }
        const float* mod = WSP(const float, WS_MOD) + ((size_t)layer * 5 + modrow) * 12288;
        float y[32];
        float s = 0.f;
#pragma unroll
        for (int i = 0; i < 2; ++i)
#pragma unroll
            for (int j = 0; j < 4; ++j) { const int c = lane * 16 + 1024 * i + 4 * j;
                const f32x4 xa = *(const f32x4*)(X1 + (size_t)R * 2048 + c), ga = *(const f32x4*)(mod + 5 * 2048 + c);
                y[16 * i + 4 * j + 0] = ALPHA * xa[0] + ga[0] * y2[8 * i + 2 * j].x; y[16 * i + 4 * j + 1] = ALPHA * xa[1] + ga[1] * y2[8 * i + 2 * j].y;
                y[16 * i + 4 * j + 2] = ALPHA * xa[2] + ga[2] * y2[8 * i + 2 * j + 1].x; y[16 * i + 4 * j + 3] = ALPHA * xa[3] + ga[3] * y2[8 * i + 2 * j + 1].y;
                s += (y[16 * i + 4 * j + 0] + y[16 * i + 4 * j + 1]) + (y[16 * i + 4 * j + 2] + y[16 * i + 4 * j + 3]); }
        const float mean = wave_sum(s, lane) * (1.f / 2048.f); float q2 = 0.f;
#pragma unroll
        for (int i = 0; i < 32; ++i) { const float dd = y[i] - mean; q2 += dd * dd; }
        const float rstd = rsqrtf(wave_sum(q2, lane) * (1.f / 2048.f) + 1e-5f);
        float* dst = layer == 0 ? (isctx ? WSP(float, WS_XC) + ((size_t)b * CTX + j) * 2048 : F.out + ((size_t)b * S + (j - CTX)) * 2048) : F.out + ((size_t)b * S + (j - CTX)) * 2048;
        const float* modn = WSP(const float, WS_MOD) + ((size_t)1 * 5 + modrow) * 12288;
#pragma unroll
        for (int i = 0; i < 2; ++i)
#pragma unroll
            for (int hh = 0; hh < 2; ++hh) { f32x4 o[2];
#pragma unroll
                for (int jj = 0; jj < 2; ++jj) { const int j = 2 * hh + jj, c = lane * 16 + 1024 * i + 4 * j; const f32x4 la = *(const f32x4*)(lg + c), ba = *(const f32x4*)(lb + c);
#pragma unroll
                    for (int e = 0; e < 4; ++e) o[jj][e] = (y[16 * i + 4 * j + e] - mean) * rstd * la[e] + ba[e];
                    *(f32x4*)(dst + c) = o[jj]; }
                if (layer == 0) {
                    const int c = lane * 16 + 1024 * i + 8 * hh;
                    const f32x4 sa = *(const f32x4*)(modn + 2048 + c), sb = *(const f32x4*)(modn + 2048 + c + 4), ha = *(const f32x4*)(modn + c), hb = *(const f32x4*)(modn + c + 4);
                    *(u32x4*)(HB + (size_t)R * 2048 + c) = pg8::pack8(o[0] * (sa + 1.0f) + ha, o[1] * (sb + 1.0f) + hb); } }
    }
}

struct Params { const float* in[cf::N_IN]; float* out; unsigned char* ws; int ph_lo, ph_hi; };

__global__ void __launch_bounds__(512, 2) mega_fwd(Params p) {
    using namespace cf;
    extern __shared__ __attribute__((aligned(16))) unsigned char smem[];
    Ctx F0;
    F0.in = p.in;
    F0.out = p.out; F0.ws = p.ws; F0.lds = (ldsp_t)smem;
    F0.tid = 0; F0.lane = 0; F0.wave = __builtin_amdgcn_readfirstlane(threadIdx.x >> 6); F0.G = gridDim.x; F0.bid = blockIdx.x;
    if (threadIdx.x < 64) ((LAS unsigned*)(F0.lds + MISC_OFF))[threadIdx.x] = 0u;
    __syncthreads();
    const int lo = p.ph_lo, hi = p.ph_hi;
    XcdBarrier bar; bar.bar = (unsigned*)(F0.ws + WS_CTL); bar.x = 0; bar.st = (volatile LAS unsigned*)(F0.lds + MISC_OFF); bar.wave = F0.wave;
    if (hi - lo > 1) bar = xcd_barrier_post((unsigned*)(F0.ws + WS_CTL), (volatile LAS unsigned*)(F0.lds + MISC_OFF), F0.wave);
#ifndef MK_MASK
#define MK_MASK 0xFFFF
#endif
#define ON(j) ((MK_MASK >> (j)) & 1)
#define IN(k) (lo <= (k) && (k) < hi)
#define SEAM(k) do { if (IN(k) && IN((k) + 1)) xcd_barrier(bar); } while (0)

    if (ON(9) && IN(0)) { ph_prologue(F0); if (DUPN(9) == 2) { __syncthreads(); ph_prologue(F0); } }
    SEAM(0);
    if (ON(10) && IN(1)) ph_modulate0(F0);
    SEAM(1);
    for (int l = 0; l < DEPTH; ++l) {
        const int pb = 2 + 8 * l;
        const int rmode = l == 0 ? 0 : 1, nMl = l == 0 ? 68 : 64;
        for (int blk = 0; blk < DUPN(12); ++blk) {
        if (blk) xcd_barrier(bar);
        if (ON(0) && IN(pb + 0)) { const Ctx F = phase_ctx(F0);
            pg8::Gemm g{WSP(const bf16_t, WS_HB), WSP(const bf16_t, WS_WIN) + (size_t)l * NC * 2048, 2048, 2048};
            pg8::EpiInProj E{WSP(bf16_t, WS_P), WSP(bf16_t, WS_KB), WSP(const float, WS_COSH), WSP(const float, WS_SINH), WSP(const float, WS_COSR), WSP(const float, WS_SINR),
                             F.in[I_AKN] + l * 128, F.in[I_AQN] + l * 128, WSP(float, WS_SSK), WSP(float, WS_SSQ), WSP(float, WS_SSKV), WSP(float, WS_SSCQ)};
            pg8::TileOrder S; S.init(nMl, 56, F.G, F.bid, rmode);
            for (int dup = 0; dup < DUPN(0); ++dup)
            pg8::gemm_phase(F.lds, g, S, E, F.wave);
            if (l > 0) { pg8::TileOrder S2; S2.init(4, 6, F.G, F.bid, 2); pg8::gemm_phase(F.lds, g, S2, E, F.wave); }
        }
        SEAM(pb + 0);
        if (ON(2) && IN(pb + 1)) { const Ctx F = phase_ctx(F0); bf16_t* P = WSP(bf16_t, WS_P);
            knorm_pass(F);
            { pg8::Gemm g{P + PC_CKV, WSP(const bf16_t, WS_WKVUP) + (size_t)l * 2048 * 256, NC, 256}; pg8::EpiKvUp E{WSP(bf16_t, WS_KB), WSP(bf16_t, WS_VB), WSP(const float, WS_SSKV)};
              pg8::TileOrder S; S.init(68, 8, F.G, F.bid, 0); for (int dup = 0; dup < DUPN(1); ++dup) pg8::gemm_phase(F.lds, g, S, E, F.wave); }
            { pg8::Gemm g{P + PC_CQ, WSP(const bf16_t, WS_WQUP) + (size_t)l * 1536 * 512, NC, 512}; pg8::EpiQUp E{WSP(bf16_t, WS_QB), WSP(const float, WS_COSR), WSP(const float, WS_SINR), WSP(const float, WS_SSCQ)};
              pg8::TileOrder S; S.init(nMl, 6, F.G, F.bid, rmode); for (int dup = 0; dup < DUPN(1); ++dup) pg8::gemm_phase(F.lds, g, S, E, F.wave); }
        }
        SEAM(pb + 1);
        if (ON(3) && IN(pb + 2)) ph_attn(F0, l);
        }
        SEAM(pb + 2);
        if (ON(4) && IN(pb + 3)) { const Ctx F = phase_ctx(F0); bf16_t* P = WSP(bf16_t, WS_P); bf16_t* HB = WSP(bf16_t, WS_HB);
            pg8::Gemm g{WSP(const bf16_t, WS_BR), WSP(const bf16_t, WS_WBR) + (size_t)l * 4 * 2048 * 1024, 4096, 1024};
            pg8::EpiMerge E{HB, P + PC_GATE, NC};
            pg8::TileOrder S; S.init(nMl, 8, F.G, F.bid, rmode, 4, (size_t)1024 * 2, (size_t)2048 * 1024 * 2);
            for (int dup = 0; dup < DUPN(5); ++dup) pg8::gemm_phase(F.lds, g, S, E, F.wave);
        }
        SEAM(pb + 3);
        if (ON(5) && IN(pb + 4)) { const Ctx F = phase_ctx(F0); bf16_t* HB = WSP(bf16_t, WS_HB);
            pg8::Gemm g{HB, WSP(const bf16_t, WS_WO) + (size_t)l * 2048 * 2048, 2048, 2048};
            pg8::EpiWo E{(float*)(F.ws + WS_P + X1_OFF), WSP(const float, WS_MOD) + (size_t)l * 5 * 12288, l == 0 ? F.in[I_X] : (const float*)F.out, F.in[I_CTX]};
            pg8::TileOrder S; S.init(nMl, 8, F.G, F.bid, rmode); for (int dup = 0; dup < DUPN(6); ++dup) pg8::gemm_phase(F.lds, g, S, E, F.wave);
        }
        SEAM(pb + 4);
        if (ON(6) && IN(pb + 5)) ph_ln1(F0, l);
        SEAM(pb + 5);
        if (ON(7) && IN(pb + 6)) { const Ctx F = phase_ctx(F0); bf16_t* HB = WSP(bf16_t, WS_HB);
            pg8::Gemm g{HB, WSP(const bf16_t, WS_WFOLD) + (size_t)l * 2048 * 2048, 2048, 2048}; pg8::EpiF32 E{(float*)(F.ws + WS_P + SC_OFF), 2048};
            pg8::TileOrder S; S.init(nMl, 8, F.G, F.bid, rmode); for (int dup = 0; dup < DUPN(7); ++dup) pg8::gemm_phase(F.lds, g, S, E, F.wave);
        }
        SEAM(pb + 6);
        if (ON(8) && IN(pb + 7)) { ph_peer(F0, l); if (DUPN(8) == 2 && l == 1) ph_peer(F0, l); }
        SEAM(pb + 7);
    }
#undef IN
#undef SEAM
}

extern "C" void kernel_launch(void* const* d_in, const int* in_sizes, int n_in, void* d_out, int out_size, void* d_ws, size_t ws_size, hipStream_t stream) {
    static int grid = 0;
    if (grid == 0) {
        if (n_in != cf::N_IN || out_size != cf::NB * cf::S * cf::D || ws_size < cf::WS_END) {
            fprintf(stderr, "kernel_launch: unexpected shapes: n_in %d out %d ws %zu (need %zu)\n", n_in, out_size, ws_size, (size_t)cf::WS_END); grid = -1; return; }
        int dev = 0, cus = 0;
        if (hipGetDevice(&dev) != hipSuccess || hipDeviceGetAttribute(&cus, hipDeviceAttributeMultiprocessorCount, dev) != hipSuccess || cus < 1) { grid = -1; return; }
        if (hipFuncSetAttribute((const void*)mega_fwd, hipFuncAttributeMaxDynamicSharedMemorySize, cf::LDS_BYTES) != hipSuccess) { fprintf(stderr, "kernel_launch: hipFuncSetAttribute failed\n"); grid = -1; return; }
        int per_cu = 0;
        if (hipOccupancyMaxActiveBlocksPerMultiprocessor(&per_cu, (const void*)mega_fwd, 512, cf::LDS_BYTES) != hipSuccess || per_cu < 1)
            fprintf(stderr, "kernel_launch: note: occupancy query reports %d workgroups per CU\n", per_cu);
        (void)hipGetLastError();
        grid = cus;
    }
    if (grid < 0) return;
    (void)hipMemsetAsync((char*)d_ws + cf::WS_CTL, 0, cf::CTL_BYTES, stream);
    Params p{};
    for (int i = 0; i < cf::N_IN; ++i) p.in[i] = (const float*)d_in[i];
    p.out = (float*)d_out; p.ws = (unsigned char*)d_ws;
#if MK_PER_PHASE
    for (int k = 0; k < cf::N_PHASES; ++k) { p.ph_lo = k; p.ph_hi = k + 1; hipLaunchKernelGGL(mega_fwd, dim3(grid), dim3(512), cf::LDS_BYTES, stream, p); }
#else
    p.ph_lo = 0; p.ph_hi = cf::N_PHASES;
    hipLaunchKernelGGL(mega_fwd, dim3(grid), dim3(512), cf::LDS_BYTES, stream, p);
#endif
    const hipError_t le = hipPeekAtLastError();
    if (le != hipSuccess) fprintf(stderr, "kernel_launch: launch failed: %s\n", hipGetErrorName(le));
}
```

```cpp
#include <hip/hip_runtime.h>
#include <stdint.h>
#include <stdio.h>

#ifndef MK_DUP
#define MK_DUP 0
#endif
#define DUPN(k) (((MK_DUP >> (k)) & 1) ? 2 : 1)
#ifndef MK_AV
#define MK_AV 0
#endif
#ifndef MK_PER_PHASE
#define MK_PER_PHASE 0
#endif

namespace cf {
constexpr int D = 2048, NB = 4, S = 4096, CTX = 256, RB = CTX + S  , MR = NB * RB  ;
constexpr int DEPTH = 2;
constexpr int PC_AK = 0, PC_AV = 256, PC_CKV = 512, PC_KR = 768, PC_DK = 1024, PC_DV = 1280, PC_KVEND = 1536;
constexpr int PC_AQ = 1536, PC_CQ = 2560, PC_DQ = 3072, PC_GLU = 4096, PC_GATE = 6144, NC = 14336;
constexpr int IN_COLS = 14144;
constexpr int NEXP = 16384;
constexpr float ALPHA = 1.4142135623730951f;
constexpr float LOG2E = 1.4426950408889634f;
constexpr float SCALE_HD = 0.08838834764831845f;
constexpr float SCALE_MLA = 0.07216878364870323f;
enum { I_X = 0, I_C, I_CTX, I_CCTX, I_WADA, I_BADA, I_WIN, I_AQN, I_AKN, I_BQN, I_WQUP, I_BKVN, I_WKVUP, I_CW, I_CB, I_CLG, I_CLB, I_SINK,
       I_WBRA, I_WBRB, I_WBRC, I_WBRD, I_WO, I_LN1G, I_LN1B, I_LN2G, I_LN2B, I_PWQ, I_PSK, I_PU, I_PV, N_IN };
constexpr size_t al(size_t x) { return (x + 255) / 256 * 256; }
constexpr size_t WS_CTL = 0;
constexpr size_t CTL_BYTES = 65536;
constexpr size_t WS_MOD = WS_CTL + CTL_BYTES;
constexpr size_t WS_COSH = WS_MOD + al((size_t)2 * 5 * 12288 * 4);
constexpr size_t WS_SINH = WS_COSH + (size_t)4096 * 64 * 4;
constexpr size_t WS_COSR = WS_SINH + (size_t)4096 * 64 * 4;
constexpr size_t WS_SINR = WS_COSR + (size_t)4096 * 32 * 4;
constexpr size_t WS_WIN = WS_SINR + (size_t)4096 * 32 * 4;
constexpr size_t WS_WQUP = WS_WIN + (size_t)2 * NC * 2048 * 2;
constexpr size_t WS_WKVUP = WS_WQUP + (size_t)2 * 1536 * 512 * 2;
constexpr size_t WS_WBR = WS_WKVUP + (size_t)2 * 2048 * 256 * 2;
constexpr size_t WS_WO = WS_WBR + (size_t)2 * 4 * 2048 * 1024 * 2;
constexpr size_t WS_WFOLD = WS_WO + (size_t)2 * 2048 * 2048 * 2;
constexpr size_t WS_UB = WS_WFOLD + (size_t)2 * 2048 * 2048 * 2;
constexpr size_t WS_VB2 = WS_UB + (size_t)2 * NEXP * 2048;
constexpr size_t WS_HB = WS_VB2 + (size_t)2 * NEXP * 2048;
constexpr size_t WS_P = WS_HB + (size_t)MR * 2048 * 2;
constexpr size_t WS_QB = WS_P + (size_t)MR * NC * 2;
constexpr size_t WS_KB = WS_QB + (size_t)MR * 1536 * 2;
constexpr size_t WS_VB = WS_KB + (size_t)MR * 1536 * 2;
constexpr size_t WS_BR = WS_VB + (size_t)MR * 1024 * 2;
constexpr size_t WS_XC = WS_BR + (size_t)MR * 4096 * 2;
constexpr size_t WS_SSK = WS_XC + (size_t)1024 * 2048 * 4;
constexpr size_t WS_SSQ = WS_SSK + (size_t)MR * 4 * 4;
constexpr size_t WS_SSKV = WS_SSQ + (size_t)MR * 16 * 4;
constexpr size_t WS_SSCQ = WS_SSKV + (size_t)MR * 4 * 4;
constexpr size_t WS_END = WS_SSCQ + (size_t)MR * 8 * 4;
constexpr size_t X1_OFF = 0, SC_OFF = (size_t)MR * 2048 * 4;
static_assert(SC_OFF * 2 <= (size_t)MR * NC * 2, "X1 + SC fit in P");
constexpr int LDS_BYTES = 132 * 1024;
constexpr int MISC_OFF = 128 * 1024;
constexpr int N_PHASES = 2 + 8 * DEPTH;
}

typedef unsigned short bf16_t;
typedef short bf16x8 __attribute__((ext_vector_type(8)));
typedef float f32x4 __attribute__((ext_vector_type(4)));
typedef float f32x2 __attribute__((ext_vector_type(2)));
typedef unsigned u32x4 __attribute__((ext_vector_type(4)));
typedef unsigned u32x2 __attribute__((ext_vector_type(2)));
#define LAS __attribute__((address_space(3)))
typedef LAS unsigned char* ldsp_t;

__device__ __forceinline__ unsigned cvt_pk_bf16(float lo, float hi) { unsigned r; asm volatile("v_cvt_pk_bf16_f32 %0, %1, %2" : "=v"(r) : "v"(lo), "v"(hi)); return r; }
__device__ __forceinline__ bf16_t f2bf(float f) { return (bf16_t)(cvt_pk_bf16(f, 0.f) & 0xffffu); }
__device__ __forceinline__ float bf2f(bf16_t b) { return __uint_as_float(((unsigned)b) << 16); }
__device__ __forceinline__ float bflo(unsigned w) { return __uint_as_float(w << 16); }
__device__ __forceinline__ float bfhi(unsigned w) { return __uint_as_float(w & 0xffff0000u); }
__device__ __forceinline__ float shx(float v, int mask, int lane) { return __int_as_float(__builtin_amdgcn_ds_bpermute((lane ^ mask) << 2, __float_as_int(v))); }
__device__ __forceinline__ float wave_sum(float v, int lane) {
#pragma unroll
    for (int o = 32; o >= 1; o >>= 1) v += shx(v, o, lane);
    return v;
}
__device__ __forceinline__ int lane_id() { int l; asm volatile("v_mbcnt_lo_u32_b32 %0, -1, 0\n\tv_mbcnt_hi_u32_b32 %0, -1, %0" : "=v"(l)); return l; }
__device__ __forceinline__ float sigmoidf_(float x) { return 1.0f / (1.0f + __expf(-x)); }

#define XB_TMO      128
#define XB_XCNT(j)  (256  + 64 * (j))
#define XB_XSUB(j)  (1280 + 64 * (j))
#define XB_XGEN(j)  (2304 + 64 * (j))
#define XB_TOP      3328
#define XB_TOPGEN   3392
#define XCD_BAR_WORDS 3456
#define XB_SPIN_CAP (1u << 23)
__device__ __forceinline__ unsigned xb_ld(unsigned* p)              { return __hip_atomic_load(p, __ATOMIC_RELAXED, __HIP_MEMORY_SCOPE_AGENT); }
__device__ __forceinline__ unsigned xb_add(unsigned* p, unsigned v) { return __hip_atomic_fetch_add(p, v, __ATOMIC_RELAXED, __HIP_MEMORY_SCOPE_AGENT); }
__device__ __forceinline__ unsigned xb_xcc_id() { return (unsigned)__builtin_amdgcn_s_getreg((3 << 11) | 20) & 0xFu; }
#define XB_SPIN(cond, bar) do { unsigned _sp = 0; while (cond) { __builtin_amdgcn_s_sleep(1); \
    if ((++_sp & 255u) == 0u) { if (xb_ld(&(bar)[XB_TMO])) break; if (_sp > XB_SPIN_CAP) { atomicAdd(&(bar)[XB_TMO], 1u); break; } } } } while (0)
struct XcdBarrier { unsigned* bar; unsigned x; volatile LAS unsigned* st; int wave; };
__device__ __forceinline__ XcdBarrier xcd_barrier_post(unsigned* bar, volatile LAS unsigned* st, int wave) {
    XcdBarrier b; b.bar = bar; b.x = xb_xcc_id(); b.st = st; b.wave = wave;
    if (wave == 0 && lane_id() == 0) (void)xb_add(&bar[XB_XCNT(b.x)], 1u);
    return b;
}
__device__ __forceinline__ void xcd_barrier_complete(unsigned* bar, unsigned x, unsigned& nloc, unsigned& nx) {
    const unsigned G = gridDim.x * gridDim.y * gridDim.z;
    unsigned sum, cnt, mine, sp = 0u;
    for (;;) {
        sum = 0u; cnt = 0u; mine = 0u;
#pragma unroll
        for (unsigned j = 0; j < 16; ++j) { const unsigned c = xb_ld(&bar[XB_XCNT(j)]); sum += c; cnt += (c > 0u) ? 1u : 0u; mine = (j == x) ? c : mine; }
        if (sum == G) break;
        __builtin_amdgcn_s_sleep(1);
        if ((++sp & 255u) == 0u) { if (xb_ld(&bar[XB_TMO])) break; if (sp > XB_SPIN_CAP) { atomicAdd(&bar[XB_TMO], 1u); break; } }
    }
    nloc = mine > 0u ? mine : 1u; nx = cnt > 0u ? cnt : 1u;
}
__device__ __forceinline__ void xcd_barrier(const XcdBarrier& b) {
    asm volatile("s_waitcnt vmcnt(0)" ::: "memory");
    __syncthreads();
    if (b.wave == 0 && lane_id() == 0) {
        unsigned* bar = b.bar;
        __builtin_amdgcn_s_waitcnt(0);
        unsigned nloc = b.st[0], nx = b.st[1];
        if (nloc == 0u) { xcd_barrier_complete(bar, b.x, nloc, nx); b.st[0] = nloc; b.st[1] = nx; }
        const unsigned old = xb_add(&bar[XB_XSUB(b.x)], 1u);
        const unsigned gen = old / nloc;
        if (old + 1u == (gen + 1u) * nloc) {
            __builtin_amdgcn_fence(__ATOMIC_RELEASE, "agent");
            asm volatile("s_waitcnt vmcnt(0)" ::: "memory");
            const unsigned og = xb_add(&bar[XB_TOP], 1u);
            const unsigned tg = og / nx;
            if (og + 1u == (tg + 1u) * nx) xb_add(&bar[XB_TOPGEN], 1u);
            else XB_SPIN(xb_ld(&bar[XB_TOPGEN]) == tg, bar);
            __builtin_amdgcn_fence(__ATOMIC_ACQUIRE, "agent");
            xb_add(&bar[XB_XGEN(b.x)], 1u);
            asm volatile("s_waitcnt vmcnt(0)" ::: "memory");
        } else {
            XB_SPIN(xb_ld(&bar[XB_XGEN(b.x)]) == gen, bar);
            __builtin_amdgcn_fence(__ATOMIC_ACQUIRE, "agent");
            asm volatile("s_waitcnt vmcnt(0)" ::: "memory");
        }
    }
    __syncthreads();
}

namespace pg8 {
constexpr int BM = 256, BK = 64, HALF = 128, HTB = HALF * BK * 2, STAGE_BYTES = 8 * HTB, NXCD = 8, WGM = 8;
__host__ __device__ __forceinline__ int lds_byte(int r, int c) { const int st = (r >> 4) * 2 + (c >> 5), rr = r & 15, cc = c & 31, ob = rr * 64 + cc * 2; return st * 1024 + (ob ^ (((ob >> 9) & 1) << 5)); }
__host__ __device__ __forceinline__ void stage_rc(int b, int& R, int& C) { const int st = b / 1024, sb = b % 1024, swz = sb ^ (((sb >> 9) & 1) << 5); R = (st >> 1) * 16 + swz / 64; C = (st & 1) * 32 + (swz % 64) / 2; }
__host__ __device__ __forceinline__ int perm32(int rho) { const int n = rho >> 4, i = rho & 15; return 8 * (i >> 2) + 4 * n + (i & 3); }
struct Unit { int pm, pn, sub; };
struct Gemm { const bf16_t* A; const bf16_t* Bt; int lda, K; };

struct TileOrder {
    int nM, nN, nwg, G, c, mode, nsub; size_t subA, subB;
    __device__ void init(int nM_, int nN_, int G_, int c_, int mode_, int nsub_ = 1, size_t subA_ = 0, size_t subB_ = 0) { nM = nM_; nN = nN_; nwg = nM * nN; G = G_; c = c_; mode = mode_; nsub = nsub_; subA = subA_; subB = subB_; }
    __device__ bool next(int i, Unit& u) const {
        const int it = nsub == 1 ? i : i / nsub; u.sub = nsub == 1 ? 0 : i - it * nsub;
        const long L = (long)it * G + c; if (L >= nwg) return false;
        int wgid = (int)L; { const int q = nwg / NXCD, r = nwg % NXCD, xcd = wgid % NXCD, off = wgid / NXCD; wgid = (xcd < r ? xcd * (q + 1) : r * (q + 1) + (xcd - r) * q) + off; }
        const int nig = WGM * nN, gid = wgid / nig, fm = gid * WGM, gsz = (nM - fm) < WGM ? (nM - fm) : WGM;
        const int pl = fm + ((wgid % nig) % gsz); u.pn = (wgid % nig) / gsz;
        u.pm = mode == 0 ? pl : (mode == 1 ? 17 * (pl >> 4) + 1 + (pl & 15) : 17 * pl);
        return true;
    }
    __device__ __forceinline__ void a_ready(const Unit&) const {}
    __device__ __forceinline__ void done(const Unit&) const {}
};

template <class Epi, class Sched>
__device__ __forceinline__ void gemm_phase(ldsp_t lds, const Gemm g, const Sched& S, const Epi& E, int wave_) {
    int tid = wave_ * 64 + lane_id(); asm volatile("" : "+v"(tid));
    const int wid = __builtin_amdgcn_readfirstlane(tid >> 6), lane = tid & 63, wr = wid >> 2, wc = wid & 3, fr = lane & 15, fq = lane >> 4;
    int K = g.K; asm volatile("" : "+s"(K));
    const int nt = K / BK, lda = g.lda;
    unsigned voffA[2], voffB[2];
#pragma unroll
    for (int i = 0; i < 2; ++i) { int R, C; stage_rc(tid * 16 + i * 8192, R, C); const int Rb = (R & ~31) + perm32(R & 31);
        voffA[i] = (unsigned)(R * lda + C) * 2u; voffB[i] = (unsigned)(Rb * K + C) * 2u; }
    const size_t kstep = (size_t)(BK * 2);
    const size_t hstepA = (size_t)HALF * lda * 2, hstepB = (size_t)HALF * K * 2;
    const size_t tstepA = 2 * hstepA, tstepB = 2 * hstepB;
    const unsigned ldsw = (unsigned)wid * 1024u;
    const int aoff = lds_byte(wr * 64 + fr, fq * 8), boff = lds_byte(wc * 32 + fr, fq * 8);
#define PG8_SA(b, h) (((b) * 2 + (h)) * HTB)
#define PG8_SB(b, h) ((4 + (b) * 2 + (h)) * HTB)
#define PG8_STAGE(bufoff, gbase, voff) do { _Pragma("unroll") for (int _i = 0; _i < 2; ++_i) \
        __builtin_amdgcn_global_load_lds((const unsigned*)((const char*)(gbase) + (voff)[_i]), (LAS unsigned*)(lds + (bufoff) + ldsw + _i * 8192), 16, 0, 0); } while (0)
#define PG8_LDA(dst, b, h) do { _Pragma("unroll") for (int m = 0; m < 4; ++m) _Pragma("unroll") for (int k = 0; k < 2; ++k) dst[m][k] = *(const LAS bf16x8*)(lds + PG8_SA(b, h) + aoff + m * 2048 + k * 1024); } while (0)
#define PG8_LDB(dst, b, h) do { _Pragma("unroll") for (int n = 0; n < 2; ++n) _Pragma("unroll") for (int k = 0; k < 2; ++k) dst[n][k] = *(const LAS bf16x8*)(lds + PG8_SB(b, h) + boff + n * 2048 + k * 1024); } while (0)
#define PG8_MMA(ai, bj, At, Bt) do { __builtin_amdgcn_s_setprio(1); _Pragma("unroll") for (int m = 0; m < 4; ++m) _Pragma("unroll") for (int n = 0; n < 2; ++n) _Pragma("unroll") for (int k = 0; k < 2; ++k) \
        acc[ai][bj][m][n] = __builtin_amdgcn_mfma_f32_16x16x32_bf16(Bt[n][k], At[m][k], acc[ai][bj][m][n], 0, 0, 0); __builtin_amdgcn_s_setprio(0); } while (0)
#define PG8_WAIT_V(n) asm volatile("s_waitcnt vmcnt(" #n ")" ::: "memory")
#define PG8_WAIT_L(n) asm volatile("s_waitcnt lgkmcnt(" #n ")" ::: "memory")
#define PG8_BAR __builtin_amdgcn_s_barrier()
#define PG8_SCHED __builtin_amdgcn_sched_barrier(0)
    Unit cur, nxt; int ui = 0;
    if (!S.next(0, cur)) return;
    f32x4 acc[2][2][4][2];
#pragma unroll
    for (int a = 0; a < 2; ++a)
#pragma unroll
        for (int b = 0; b < 2; ++b)
#pragma unroll
            for (int m = 0; m < 4; ++m)
#pragma unroll
                for (int n = 0; n < 2; ++n) acc[a][b][m][n] = (f32x4){0.f, 0.f, 0.f, 0.f};
    bf16x8 At[4][2], B0[2][2], B1[2][2];
    const char* cA = (const char*)g.A + (size_t)cur.pm * tstepA + cur.sub * S.subA; const char* cB = (const char*)g.Bt + (size_t)cur.pn * tstepB + cur.sub * S.subB;
    S.a_ready(cur);
    PG8_STAGE(PG8_SB(0, 0), cB, voffB); PG8_STAGE(PG8_SA(0, 0), cA, voffA); PG8_STAGE(PG8_SB(0, 1), cB + hstepB, voffB); PG8_STAGE(PG8_SA(0, 1), cA + hstepA, voffA);
    if (wr == 1) PG8_BAR;
    PG8_WAIT_V(4); PG8_BAR;
    PG8_STAGE(PG8_SB(1, 0), cB + kstep, voffB); PG8_STAGE(PG8_SA(1, 0), cA + kstep, voffA); PG8_STAGE(PG8_SB(1, 1), cB + hstepB + kstep, voffB);
    PG8_WAIT_V(6); PG8_BAR;
    for (;;) {
        const bool has_next = S.next(ui + 1, nxt);
        const char* nA = has_next ? (const char*)g.A + (size_t)nxt.pm * tstepA + nxt.sub * S.subA : cA; const char* nB = has_next ? (const char*)g.Bt + (size_t)nxt.pn * tstepB + nxt.sub * S.subB : cB;
#pragma unroll 1
        for (int t = 0; t < nt; t += 2) {
            const bool last = (t == nt - 2);
            const char* a1 = cA + (size_t)(t + 1) * kstep;
            const char* a2 = last ? nA : cA + (size_t)(t + 2) * kstep; const char* b2 = last ? nB : cB + (size_t)(t + 2) * kstep;
            const char* a3 = a2 + kstep; const char* b3 = b2 + kstep;
            if (last && has_next) S.a_ready(nxt);
            PG8_LDB(B0, 0, 0); PG8_SCHED; PG8_LDA(At, 0, 0); PG8_STAGE(PG8_SA(1, 1), a1 + hstepA, voffA);
            PG8_WAIT_L(8); PG8_BAR; PG8_WAIT_L(0); PG8_MMA(0, 0, At, B0); PG8_BAR; PG8_SCHED;
            PG8_LDB(B1, 0, 1); PG8_STAGE(PG8_SB(0, 0), b2, voffB);
            PG8_BAR; PG8_WAIT_L(0); PG8_MMA(0, 1, At, B1); PG8_BAR;
            PG8_LDA(At, 0, 1); PG8_STAGE(PG8_SA(0, 0), a2, voffA);
            PG8_BAR; PG8_WAIT_L(0); PG8_MMA(1, 0, At, B0); PG8_BAR; PG8_SCHED;
            PG8_STAGE(PG8_SB(0, 1), b2 + hstepB, voffB);
            PG8_WAIT_V(6); PG8_BAR; PG8_MMA(1, 1, At, B1); PG8_BAR;
            PG8_LDB(B0, 1, 0); PG8_SCHED; PG8_LDA(At, 1, 0); PG8_STAGE(PG8_SA(0, 1), a2 + hstepA, voffA);
            PG8_WAIT_L(8); PG8_BAR; PG8_WAIT_L(0); PG8_MMA(0, 0, At, B0); PG8_BAR; PG8_SCHED;
            PG8_LDB(B1, 1, 1); PG8_STAGE(PG8_SB(1, 0), b3, voffB);
            PG8_BAR; PG8_WAIT_L(0); PG8_MMA(0, 1, At, B1); PG8_BAR;
            PG8_LDA(At, 1, 1); PG8_STAGE(PG8_SA(1, 0), a3, voffA);
            PG8_BAR; PG8_WAIT_L(0); PG8_MMA(1, 0, At, B0); PG8_BAR; PG8_SCHED;
            PG8_STAGE(PG8_SB(1, 1), b3 + hstepB, voffB);
            PG8_WAIT_V(6); PG8_BAR; PG8_MMA(1, 1, At, B1); PG8_BAR;
        }
        E(acc, cur, wr, wc, fr, fq); S.done(cur);
        if (!has_next) break;
#pragma unroll
        for (int a = 0; a < 2; ++a)
#pragma unroll
            for (int b = 0; b < 2; ++b)
#pragma unroll
                for (int m = 0; m < 4; ++m)
#pragma unroll
                    for (int n = 0; n < 2; ++n) acc[a][b][m][n] = (f32x4){0.f, 0.f, 0.f, 0.f};
        cur = nxt; cA = nA; cB = nB; ++ui;
    }
    PG8_WAIT_V(0);
    if (wr == 0) PG8_BAR;
    PG8_BAR;
#undef PG8_SA
#undef PG8_SB
#undef PG8_STAGE
#undef PG8_LDA
#undef PG8_LDB
#undef PG8_MMA
#undef PG8_WAIT_V
#undef PG8_WAIT_L
#undef PG8_BAR
#undef PG8_SCHED
}

__device__ __forceinline__ u32x4 pack8(const f32x4 a, const f32x4 b) { u32x4 w; w.x = cvt_pk_bf16(a[0], a[1]); w.y = cvt_pk_bf16(a[2], a[3]); w.z = cvt_pk_bf16(b[0], b[1]); w.w = cvt_pk_bf16(b[2], b[3]); return w; }
#define EPI_ARGS const f32x4 (&acc)[2][2][4][2], const Unit& u, int wr, int wc, int fr_, int fq_
#define EPI_LANE int fr = fr_, fq = fq_; asm volatile("" : "+v"(fr), "+v"(fq));

struct EpiBf16 {
    bf16_t* O; int ldc;
    __device__ __forceinline__ void operator()(EPI_ARGS) const {
        EPI_LANE
        const int row0 = u.pm * BM + wr * 64 + fr, col0 = u.pn * BM + wc * 32 + 8 * fq;
#pragma unroll
        for (int ai = 0; ai < 2; ++ai)
#pragma unroll
            for (int m = 0; m < 4; ++m) { bf16_t* rowp = O + (size_t)(row0 + ai * HALF + m * 16) * ldc + col0;
#pragma unroll
                for (int bj = 0; bj < 2; ++bj) *(u32x4*)(rowp + bj * HALF) = pack8(acc[ai][bj][m][0], acc[ai][bj][m][1]); }
    }
};
struct EpiF32 {
    float* C; int ldc;
    __device__ __forceinline__ void operator()(EPI_ARGS) const {
        EPI_LANE
        const int row0 = u.pm * BM + wr * 64 + fr, col0 = u.pn * BM + wc * 32 + 8 * fq;
#pragma unroll
        for (int ai = 0; ai < 2; ++ai)
#pragma unroll
            for (int m = 0; m < 4; ++m) { float* rowp = C + (size_t)(row0 + ai * HALF + m * 16) * ldc + col0;
#pragma unroll
                for (int bj = 0; bj < 2; ++bj) { *(f32x4*)(rowp + bj * HALF) = acc[ai][bj][m][0]; *(f32x4*)(rowp + bj * HALF + 4) = acc[ai][bj][m][1]; } }
    }
};
struct EpiInProj {
    bf16_t* P; bf16_t* KB; const float* cosh; const float* sinh; const float* cosr; const float* sinr; const float* akn; const float* aqn;
    float* ssk; float* ssq; float* sskv; float* sscq;
    __device__ __forceinline__ void operator()(EPI_ARGS) const {
        EPI_LANE
        const int pn = u.pn, tb = u.pm % 17; const bool lat = tb != 0; const int posbase = (tb - 1) * 256;
        const int rl0 = wr * 64 + fr;
        if (pn >= 24) {
            const int col0 = pn * BM + wc * 32 + 8 * fq;
#pragma unroll
            for (int ai = 0; ai < 2; ++ai)
#pragma unroll
                for (int m = 0; m < 4; ++m) { bf16_t* rowp = P + ((size_t)u.pm * BM + rl0 + ai * HALF + m * 16) * cf::NC + col0;
#pragma unroll
                    for (int bj = 0; bj < 2; ++bj) { f32x4 v0 = acc[ai][bj][m][0], v1 = acc[ai][bj][m][1];
#pragma unroll
                        for (int e = 0; e < 4; ++e) { v0[e] = sigmoidf_(v0[e]); v1[e] = sigmoidf_(v1[e]); }
                        *(u32x4*)(rowp + bj * HALF) = pack8(v0, v1); } }
        } else if (pn >= 16) {
            const int col0 = cf::PC_GLU + 128 * (pn - 16) + wc * 32 + 8 * fq;
#pragma unroll
            for (int ai = 0; ai < 2; ++ai)
#pragma unroll
                for (int m = 0; m < 4; ++m) { f32x4 v0 = acc[ai][0][m][0], v1 = acc[ai][0][m][1]; const f32x4 g0 = acc[ai][1][m][0], g1 = acc[ai][1][m][1];
#pragma unroll
                    for (int e = 0; e < 4; ++e) { v0[e] *= sigmoidf_(g0[e]); v1[e] *= sigmoidf_(g1[e]); }
                    *(u32x4*)(P + ((size_t)u.pm * BM + rl0 + ai * HALF + m * 16) * cf::NC + col0) = pack8(v0, v1); }
        } else if (pn == 3) {
            if (wc == 0) { const int i0 = 8 * fq;
#pragma unroll
                for (int ai = 0; ai < 2; ++ai)
#pragma unroll
                    for (int m = 0; m < 4; ++m) { const int rl = rl0 + ai * HALF + m * 16;
                        f32x4 c0 = {1.f, 1.f, 1.f, 1.f}, c1 = c0, s0 = {0.f, 0.f, 0.f, 0.f}, s1 = s0;
                        if (lat) { const float* cp = cosr + (size_t)(posbase + rl) * 32 + i0; const float* sp = sinr + (size_t)(posbase + rl) * 32 + i0;
                            c0 = *(const f32x4*)cp; c1 = *(const f32x4*)(cp + 4); s0 = *(const f32x4*)sp; s1 = *(const f32x4*)(sp + 4); }
                        const f32x4 x1a = acc[ai][0][m][0], x1b = acc[ai][0][m][1], x2a = acc[ai][1][m][0], x2b = acc[ai][1][m][1];
                        const u32x4 w1 = pack8(x1a * c0 - x2a * s0, x1b * c1 - x2b * s1), w2 = pack8(x2a * c0 + x1a * s0, x2b * c1 + x1b * s1);
                        bf16_t* kb = KB + ((size_t)u.pm * BM + rl) * 1536 + 128 + i0;
#pragma unroll
                        for (int h = 0; h < 8; ++h) { *(u32x4*)(kb + h * 192) = w1; *(u32x4*)(kb + h * 192 + 32) = w2; }
                        asm volatile("" ::: "memory"); } }
        } else if (pn == 0 || pn == 4 || (pn >= 6 && pn <= 9) || pn >= 12) {
            const bool norm = pn == 0 || (pn >= 6 && pn <= 9);
            const int hl = wc >> 1, i0 = 32 * (wc & 1) + 8 * fq;
            f32x4 g1a = {1.f, 1.f, 1.f, 1.f}, g1b = g1a, g2a = g1a, g2b = g1a;
            if (norm) { const float* gn = (pn == 0 ? akn : aqn) + i0; g1a = *(const f32x4*)gn; g1b = *(const f32x4*)(gn + 4); g2a = *(const f32x4*)(gn + 64); g2b = *(const f32x4*)(gn + 68); }
            float* ssp = pn == 0 ? ssk + ((size_t)u.pm * BM * 2 + hl) * 2 + (wc & 1) : ssq + ((size_t)u.pm * BM * 8 + (pn - 6) * 2 + hl) * 2 + (wc & 1);
            const int sstr = pn == 0 ? 4 : 16;
#pragma unroll
            for (int ai = 0; ai < 2; ++ai)
#pragma unroll
                for (int m = 0; m < 4; ++m) { const int rl = rl0 + ai * HALF + m * 16;
                    f32x4 x1a = acc[ai][0][m][0], x1b = acc[ai][0][m][1], x2a = acc[ai][1][m][0], x2b = acc[ai][1][m][1];
                    if (norm) { const f32x4 q = x1a * x1a + x1b * x1b + x2a * x2a + x2b * x2b; float ss = (q[0] + q[1]) + (q[2] + q[3]);
                        ss += shx(ss, 16, fr + 16 * fq); ss += shx(ss, 32, fr + 16 * fq);
                        if (fq == 0) ssp[(size_t)rl * sstr] = ss;
                        x1a *= g1a; x1b *= g1b; x2a *= g2a; x2b *= g2b; }
                    f32x4 o1a = x1a, o1b = x1b, o2a = x2a, o2b = x2b;
                    if (lat) { const float* cp = cosh + (size_t)(posbase + rl) * 64 + i0; const float* sp = sinh + (size_t)(posbase + rl) * 64 + i0;
                        const f32x4 c0 = *(const f32x4*)cp, c1 = *(const f32x4*)(cp + 4), s0 = *(const f32x4*)sp, s1 = *(const f32x4*)(sp + 4);
                        o1a = x1a * c0 - x2a * s0; o1b = x1b * c1 - x2b * s1; o2a = x2a * c0 + x1a * s0; o2b = x2b * c1 + x1b * s1; }
                    bf16_t* dst = P + ((size_t)u.pm * BM + rl) * cf::NC + pn * BM + hl * 128 + i0;
                    *(u32x4*)dst = pack8(o1a, o1b); *(u32x4*)(dst + 64) = pack8(o2a, o2b);
                    asm volatile("" ::: "memory"); }
        } else {
            const int col0 = pn * BM + wc * 32 + 8 * fq;
            const bool ssq_on = pn == 2 || pn == 10 || pn == 11;
            float* ssp = pn == 2 ? sskv + (size_t)u.pm * BM * 4 + wc : sscq + (size_t)u.pm * BM * 8 + (pn - 10) * 4 + wc;
            const int sstr = pn == 2 ? 4 : 8;
#pragma unroll
            for (int ai = 0; ai < 2; ++ai)
#pragma unroll
                for (int m = 0; m < 4; ++m) { const int rl = rl0 + ai * HALF + m * 16; bf16_t* rowp = P + ((size_t)u.pm * BM + rl) * cf::NC + col0;
#pragma unroll
                    for (int bj = 0; bj < 2; ++bj) *(u32x4*)(rowp + bj * HALF) = pack8(acc[ai][bj][m][0], acc[ai][bj][m][1]);
                    if (ssq_on) { const f32x4 q = acc[ai][0][m][0] * acc[ai][0][m][0] + acc[ai][0][m][1] * acc[ai][0][m][1] + acc[ai][1][m][0] * acc[ai][1][m][0] + acc[ai][1][m][1] * acc[ai][1][m][1];
                        float ss = (q[0] + q[1]) + (q[2] + q[3]); ss += shx(ss, 16, fr + 16 * fq); ss += shx(ss, 32, fr + 16 * fq);
                        if (fq == 0) ssp[(size_t)rl * sstr] = ss; } }
        }
    }
};
struct EpiKvUp {
    bf16_t* KB; bf16_t* VB; const float* sskv;
    __device__ __forceinline__ void operator()(EPI_ARGS) const {
        EPI_LANE
        const int row0 = u.pm * BM + wr * 64 + fr, d0 = wc * 32 + 8 * fq;
        const bool isk = u.pn < 4;
        bf16_t* base = isk ? KB + (2 * u.pn) * 192 + d0 : VB + (u.pn - 4) * 256 + d0;
        const int ldr = isk ? 1536 : 1024, bjs = isk ? 192 : 128;
#pragma unroll
        for (int ai = 0; ai < 2; ++ai)
#pragma unroll
            for (int m = 0; m < 4; ++m) { const size_t row = (size_t)(row0 + ai * HALF + m * 16); bf16_t* rowp = base + row * ldr;
                const f32x4 pp = *(const f32x4*)(sskv + row * 4); const float r = rsqrtf(((pp[0] + pp[1]) + (pp[2] + pp[3])) * (1.f / 256.f) + 1e-6f);
#pragma unroll
                for (int bj = 0; bj < 2; ++bj) *(u32x4*)(rowp + bj * bjs) = pack8(acc[ai][bj][m][0] * r, acc[ai][bj][m][1] * r); }
    }
};
struct EpiQUp {
    bf16_t* QB; const float* cosr; const float* sinr; const float* sscq;
    __device__ __forceinline__ void operator()(EPI_ARGS) const {
        EPI_LANE
        const int row0 = u.pm * BM + wr * 64 + fr;
        if (u.pn < 4) {
            const int d0 = wc * 32 + 8 * fq;
#pragma unroll
            for (int ai = 0; ai < 2; ++ai)
#pragma unroll
                for (int m = 0; m < 4; ++m) { const size_t row = (size_t)(row0 + ai * HALF + m * 16);
                    const f32x4 pa = *(const f32x4*)(sscq + row * 8), pb = *(const f32x4*)(sscq + row * 8 + 4);
                    const float r = rsqrtf((((pa[0] + pa[1]) + (pa[2] + pa[3])) + ((pb[0] + pb[1]) + (pb[2] + pb[3]))) * (1.f / 512.f) + 1e-6f);
#pragma unroll
                    for (int bj = 0; bj < 2; ++bj) *(u32x4*)(QB + row * 1536 + (2 * u.pn + bj) * 192 + d0) = pack8(acc[ai][bj][m][0] * r, acc[ai][bj][m][1] * r); }
        } else {
            const int head = 4 * (u.pn - 4) + wc, i0 = 8 * fq;
            const bool lat = (u.pm % 17) != 0; const int posbase = (u.pm % 17) * 256 - 256;
#pragma unroll
            for (int ai = 0; ai < 2; ++ai)
#pragma unroll
                for (int m = 0; m < 4; ++m) { const int rl = wr * 64 + fr + ai * HALF + m * 16; const size_t row = (size_t)u.pm * BM + rl;
                    const f32x4 pa = *(const f32x4*)(sscq + row * 8), pb = *(const f32x4*)(sscq + row * 8 + 4);
                    const float r = rsqrtf((((pa[0] + pa[1]) + (pa[2] + pa[3])) + ((pb[0] + pb[1]) + (pb[2] + pb[3]))) * (1.f / 512.f) + 1e-6f);
                    f32x4 c0 = {1.f, 1.f, 1.f, 1.f}, c1 = c0, s0 = {0.f, 0.f, 0.f, 0.f}, s1 = s0;
                    if (lat) { const float* cp = cosr + (size_t)(posbase + rl) * 32 + i0; const float* sp = sinr + (size_t)(posbase + rl) * 32 + i0;
                        c0 = *(const f32x4*)cp; c1 = *(const f32x4*)(cp + 4); s0 = *(const f32x4*)sp; s1 = *(const f32x4*)(sp + 4); }
                    const f32x4 x1a = acc[ai][0][m][0] * r, x1b = acc[ai][0][m][1] * r, x2a = acc[ai][1][m][0] * r, x2b = acc[ai][1][m][1] * r;
                    const f32x4 o1a = x1a * c0 - x2a * s0, o1b = x1b * c1 - x2b * s1, o2a = x2a * c0 + x1a * s0, o2b = x2b * c1 + x1b * s1;
                    bf16_t* dst = QB + row * 1536 + head * 192 + 128 + i0;
                    *(u32x4*)dst = pack8(o1a, o1b); *(u32x4*)(dst + 32) = pack8(o2a, o2b); asm volatile("" ::: "memory"); }
        }
    }
};
struct EpiMerge {
    bf16_t* ACC; const bf16_t* gate0; int ldg;
    __device__ __forceinline__ void operator()(EPI_ARGS) const {
        EPI_LANE
        const int row0 = u.pm * BM + wr * 64 + fr, col0 = u.pn * BM + wc * 32 + 8 * fq;
        const bf16_t* gate = gate0 + u.sub * 2048; const bool first = u.sub == 0;
#pragma unroll
        for (int ai = 0; ai < 2; ++ai) {
            u32x4 gw[4][2], pw[4][2];
#pragma unroll
            for (int m = 0; m < 4; ++m) { const size_t row = (size_t)(row0 + ai * HALF + m * 16);
#pragma unroll
                for (int bj = 0; bj < 2; ++bj) { const int col = col0 + bj * HALF; gw[m][bj] = *(const u32x4*)(gate + row * ldg + col);
                    pw[m][bj] = (u32x4){0u, 0u, 0u, 0u}; if (!first) pw[m][bj] = *(const u32x4*)(ACC + row * 2048 + col); } }
#pragma unroll
            for (int m = 0; m < 4; ++m) { const size_t row = (size_t)(row0 + ai * HALF + m * 16);
#pragma unroll
                for (int bj = 0; bj < 2; ++bj) { const int col = col0 + bj * HALF; const u32x4 g = gw[m][bj], p = pw[m][bj];
                    const f32x4 a0 = acc[ai][bj][m][0], a1 = acc[ai][bj][m][1];
                    f32x4 r0, r1;
                    r0[0] = bflo(p.x) + bflo(g.x) * a0[0]; r0[1] = bfhi(p.x) + bfhi(g.x) * a0[1]; r0[2] = bflo(p.y) + bflo(g.y) * a0[2]; r0[3] = bfhi(p.y) + bfhi(g.y) * a0[3];
                    r1[0] = bflo(p.z) + bflo(g.z) * a1[0]; r1[1] = bfhi(p.z) + bfhi(g.z) * a1[1]; r1[2] = bflo(p.w) + bflo(g.w) * a1[2]; r1[3] = bfhi(p.w) + bfhi(g.w) * a1[3];
                    *(u32x4*)(ACC + row * 2048 + col) = pack8(r0, r1); } }
            asm volatile("" ::: "memory"); }
    }
};
struct EpiWo {
    float* X1; const float* mod  ; const float* xlat  ; const float* xctx  ;
    __device__ __forceinline__ void operator()(EPI_ARGS) const {
        EPI_LANE
        const int b = u.pm / 17, tb = u.pm % 17; const bool isctx = tb == 0;
        const float* g1 = mod + (size_t)(isctx ? 4 : b) * 12288 + 2 * 2048;
        const float* xbase = isctx ? xctx + (size_t)b * cf::CTX * 2048 : xlat + ((size_t)b * cf::S + (size_t)(tb - 1) * 256) * 2048;
        const int rl0 = wr * 64 + fr, col0 = u.pn * BM + wc * 32 + 8 * fq;
        f32x4 gv[2][2];
#pragma unroll
        for (int bj = 0; bj < 2; ++bj) { gv[bj][0] = *(const f32x4*)(g1 + col0 + bj * HALF); gv[bj][1] = *(const f32x4*)(g1 + col0 + bj * HALF + 4); }
#pragma unroll
        for (int ai = 0; ai < 2; ++ai) {
            f32x4 xv[4][2][2];
#pragma unroll
            for (int m = 0; m < 4; ++m) { const int rl = rl0 + ai * HALF + m * 16;
#pragma unroll
                for (int bj = 0; bj < 2; ++bj) { const float* xp = xbase + (size_t)rl * 2048 + col0 + bj * HALF; xv[m][bj][0] = *(const f32x4*)xp; xv[m][bj][1] = *(const f32x4*)(xp + 4); } }
#pragma unroll
            for (int m = 0; m < 4; ++m) { const int rl = rl0 + ai * HALF + m * 16; float* op = X1 + ((size_t)u.pm * BM + rl) * 2048 + col0;
#pragma unroll
                for (int bj = 0; bj < 2; ++bj) { *(f32x4*)(op + bj * HALF) = xv[m][bj][0] * cf::ALPHA + gv[bj][0] * acc[ai][bj][m][0];
                    *(f32x4*)(op + bj * HALF + 4) = xv[m][bj][1] * cf::ALPHA + gv[bj][1] * acc[ai][bj][m][1]; } }
            asm volatile("" ::: "memory"); }
    }
};
}

struct Ctx {
    const float* const* in; float* out; unsigned char* ws;
    ldsp_t lds; int tid, lane, wave, G, bid;
};
#define WSP(T, off) ((T*)(F.ws + (off)))
__device__ __forceinline__ Ctx phase_ctx(const Ctx& F0) {
    Ctx C = F0;
    C.tid = F0.wave * 64 + lane_id();
    asm volatile("" : "+v"(C.tid));
    { size_t z = 0; asm volatile("" : "+s"(z)); C.ws = F0.ws + z; }
    C.lane = C.tid & 63; C.wave = __builtin_amdgcn_readfirstlane(C.tid >> 6);
    return C;
}

__device__ __forceinline__ int srcmap(int mode, int n) {
    if (mode == 0) {
        const int pn = n >> 8, q = n & 255, bj = q >> 7, r = q & 127, rope = (r >> 6) * 128 + bj * 64 + (r & 63);
        if (pn == 0) return rope;
        if (pn == 1) return 256 + q;
        if (pn == 2) return 512 + q;
        if (pn == 3) return r < 32 ? 768 + bj * 32 + r : -1;
        if (pn == 4) return 832 + rope;
        if (pn == 5) return 1088 + q;
        if (pn < 10) return 1344 + (pn - 6) * 256 + rope;
        if (pn < 12) return 2368 + (pn - 10) * 256 + q;
        if (pn < 16) return 2880 + (pn - 12) * 256 + rope;
        if (pn < 24) return 3904 + bj * 1024 + 128 * (pn - 16) + r;
        return 5952 + (n - 6144);
    }
    if (mode == 1) { if (n < 1024) return (n >> 7) * 192 + (n & 127);
        const int m = n - 1024, t = m >> 8, bj = (m >> 7) & 1, q = m & 127; return (4 * t + (q >> 5)) * 192 + 128 + bj * 32 + (q & 31); }
    if (mode == 2) { if (n < 1024) return (n >> 7) * 256 + (n & 127); const int m = n - 1024; return (m >> 7) * 256 + 128 + (m & 127); }
    return n;
}
__device__ __forceinline__ void tr_tile(const Ctx& F, const float* src, int ld_src, int mode, int k0, bf16_t* dst, int ldd, int n0, const float* kscale = nullptr) {
    LAS float* T = (LAS float*)F.lds;
    const int kr = F.tid >> 6, nc = (F.tid & 63) * 4, sc = srcmap(mode, n0 + nc);
    f32x4 v[8];
#pragma unroll
    for (int h = 0; h < 8; ++h) { v[h] = (f32x4){0.f, 0.f, 0.f, 0.f}; if (sc >= 0) v[h] = *(const f32x4*)(src + (size_t)(k0 + kr + 8 * h) * ld_src + sc); }
#pragma unroll
    for (int h = 0; h < 8; ++h) { const int k = kr + 8 * h; f32x4 x = v[h]; if (kscale) x = x * kscale[k0 + k];
        T[k * 257 + nc + 0] = x[0]; T[k * 257 + nc + 1] = x[1]; T[k * 257 + nc + 2] = x[2]; T[k * 257 + nc + 3] = x[3]; }
    __syncthreads();
    const int n = F.tid >> 1, kc = (F.tid & 1) * 32;
#pragma unroll
    for (int j = 0; j < 4; ++j) { u32x4 w; const int kb = kc + 8 * j;
        w.x = cvt_pk_bf16(T[(kb + 0) * 257 + n], T[(kb + 1) * 257 + n]); w.y = cvt_pk_bf16(T[(kb + 2) * 257 + n], T[(kb + 3) * 257 + n]);
        w.z = cvt_pk_bf16(T[(kb + 4) * 257 + n], T[(kb + 5) * 257 + n]); w.w = cvt_pk_bf16(T[(kb + 6) * 257 + n], T[(kb + 7) * 257 + n]);
        *(u32x4*)(dst + (size_t)(n0 + n) * ldd + k0 + kb) = w; }
    __syncthreads();
}
__device__ __forceinline__ void cvt_rows(const Ctx& F, const float* src, bf16_t* dst, size_t n8) {
    for (size_t i = (size_t)F.bid * 512 + F.tid; i < n8; i += (size_t)F.G * 512) {
        const f32x4 a = *(const f32x4*)(src + i * 8), b = *(const f32x4*)(src + i * 8 + 4);
        *(u32x4*)(dst + i * 8) = pg8::pack8(a, b); }
}

__device__ __forceinline__ void cvt_rows_fp8(const Ctx& F, const float* src, unsigned char* dst, size_t n16, float scale) {
    const size_t stride = (size_t)F.G * 512;
    for (size_t i = (size_t)F.bid * 512 + F.tid; i < n16; i += 2 * stride) {
        const size_t i2 = i + stride; const bool two = i2 < n16;
        f32x4 a[8];
#pragma unroll
        for (int j = 0; j < 4; ++j) { a[j] = *(const f32x4*)(src + i * 16 + 4 * j); a[4 + j] = two ? *(const f32x4*)(src + i2 * 16 + 4 * j) : (f32x4){0.f, 0.f, 0.f, 0.f}; }
        u32x4 w0, w1;
#pragma unroll
        for (int j = 0; j < 4; ++j) { const f32x4 x = a[j] * scale, y = a[4 + j] * scale;
            int p = 0; p = __builtin_amdgcn_cvt_pk_fp8_f32(x[0], x[1], p, false); p = __builtin_amdgcn_cvt_pk_fp8_f32(x[2], x[3], p, true); w0[j] = (unsigned)p;
            int q = 0; q = __builtin_amdgcn_cvt_pk_fp8_f32(y[0], y[1], q, false); q = __builtin_amdgcn_cvt_pk_fp8_f32(y[2], y[3], q, true); w1[j] = (unsigned)q; }
        *(u32x4*)(dst + i * 16) = w0; if (two) *(u32x4*)(dst + i2 * 16) = w1; }
}

constexpr int V4_ROW = 1088;
__device__ __forceinline__ void cvt_rows_fp4(const Ctx& F, const float* src, unsigned char* dst, size_t nblk) {
    for (size_t i = (size_t)F.bid * 512 + F.tid; i < nblk; i += (size_t)F.G * 512) {
        f32x4 a[8]; float amax = 0.f;
#pragma unroll
        for (int j = 0; j < 8; ++j) { a[j] = *(const f32x4*)(src + i * 32 + 4 * j); amax = fmaxf(amax, fmaxf(fmaxf(fabsf(a[j][0]), fabsf(a[j][1])), fmaxf(fabsf(a[j][2]), fabsf(a[j][3])))); }
        int e = amax > 0.f ? (int)ceilf(log2f(amax * (1.0f / 6.0f))) : -126; e = e < -126 ? -126 : (e > 126 ? 126 : e);
        const float inv = __uint_as_float((unsigned)(127 - e) << 23);
        u32x4 w;
#pragma unroll
        for (int j = 0; j < 4; ++j) { const f32x4 x = a[2 * j] * inv, y = a[2 * j + 1] * inv; unsigned p = 0u;
            p = __builtin_amdgcn_cvt_scalef32_pk_fp4_f32(p, x[0], x[1], 1.0f, 0); p = __builtin_amdgcn_cvt_scalef32_pk_fp4_f32(p, x[2], x[3], 1.0f, 1);
            p = __builtin_amdgcn_cvt_scalef32_pk_fp4_f32(p, y[0], y[1], 1.0f, 2); p = __builtin_amdgcn_cvt_scalef32_pk_fp4_f32(p, y[2], y[3], 1.0f, 3); w[j] = p; }
        const size_t row = i >> 6; const int bl = (int)(i & 63);
        *(u32x4*)(dst + row * V4_ROW + bl * 16) = w; dst[row * V4_ROW + 1024 + bl] = (unsigned char)(e + 127);
    }
}

__device__ __forceinline__ void ph_prologue(const Ctx& F0) {
    const Ctx F = phase_ctx(F0);
    using namespace cf;
    constexpr int T_WIN = 2 * 32 * 56, T_QUP = 2 * 8 * 6, T_KVUP = 2 * 4 * 8, T_BR = 2 * 4 * 16 * 8, T_WO = 2 * 32 * 8;
    constexpr int T_ALL = T_WIN + T_QUP + T_KVUP + T_BR + T_WO;
    for (int u = F.bid; u < T_ALL; u += F.G) {
        int t = u;
        if (t < T_WIN) { const int l = t / (32 * 56), r = t % (32 * 56), kt = r / 56, nt = r % 56;
            tr_tile(F, F.in[I_WIN] + (size_t)l * 2048 * IN_COLS, IN_COLS, 0, kt * 64, WSP(bf16_t, WS_WIN) + (size_t)l * NC * 2048, 2048, nt * 256); continue; }
        t -= T_WIN;
        if (t < T_QUP) { const int l = t / (8 * 6), r = t % (8 * 6), kt = r / 6, nt = r % 6;
            tr_tile(F, F.in[I_WQUP] + (size_t)l * 512 * 1536, 1536, 1, kt * 64, WSP(bf16_t, WS_WQUP) + (size_t)l * 1536 * 512, 512, nt * 256, F.in[I_BQN] + l * 512); continue; }
        t -= T_QUP;
        if (t < T_KVUP) { const int l = t / (4 * 8), r = t % (4 * 8), kt = r / 8, nt = r % 8;
            tr_tile(F, F.in[I_WKVUP] + (size_t)l * 256 * 2048, 2048, 2, kt * 64, WSP(bf16_t, WS_WKVUP) + (size_t)l * 2048 * 256, 256, nt * 256, F.in[I_BKVN] + l * 256); continue; }
        t -= T_KVUP;
        if (t < T_BR) { const int l = t / (4 * 128), r = t % (4 * 128), br = r / 128, r2 = r % 128, kt = r2 / 8, nt = r2 % 8;
            const float* src = (br == 0 ? F.in[I_WBRA] : br == 1 ? F.in[I_WBRB] : br == 2 ? F.in[I_WBRC] : F.in[I_WBRD]) + (size_t)l * 1024 * 2048;
            tr_tile(F, src, 2048, 3, kt * 64, WSP(bf16_t, WS_WBR) + ((size_t)l * 4 + br) * 2048 * 1024, 1024, nt * 256); continue; }
        t -= T_BR;
        { const int l = t / 256, r = t % 256, kt = r / 8, nt = r % 8;
            tr_tile(F, F.in[I_WO] + (size_t)l * 2048 * 2048, 2048, 3, kt * 64, WSP(bf16_t, WS_WO) + (size_t)l * 2048 * 2048, 2048, nt * 256); }
    }
    for (int u = F.bid; u < 2 * 16 * 32; u += F.G) {
        const int l = u / 512, g = (u % 512) / 32, d0 = (u % 32) * 64;
        LAS float* sk = (LAS float*)F.lds; LAS float* wt = (LAS float*)(F.lds + 128 * 129 * 4);
        const float* skg = F.in[I_PSK] + ((size_t)l * 16 + g) * 128 * 128;
        const float* wqg = F.in[I_PWQ] + (size_t)l * 2048 * 2048 + (size_t)d0 * 2048 + g * 128;
        for (int i = F.tid; i < 128 * 128; i += 512) sk[(i >> 7) * 129 + (i & 127)] = skg[i];
        for (int i = F.tid; i < 64 * 128; i += 512) wt[(i >> 7) * 129 + (i & 127)] = wqg[(size_t)(i >> 7) * 2048 + (i & 127)];
        __syncthreads();
        const int n = F.tid & 127, dg = F.tid >> 7;
        float a[16];
#pragma unroll
        for (int e = 0; e < 16; ++e) a[e] = 0.f;
        for (int k = 0; k < 128; ++k) { const float s = sk[n * 129 + k];
#pragma unroll
            for (int e = 0; e < 16; ++e) a[e] += wt[(dg * 16 + e) * 129 + k] * s; }
        bf16_t* dst = WSP(bf16_t, WS_WFOLD) + (size_t)l * 2048 * 2048 + (size_t)(g * 128 + n) * 2048 + d0 + dg * 16;
        u32x4 w0, w1;
        w0.x = cvt_pk_bf16(a[0], a[1]); w0.y = cvt_pk_bf16(a[2], a[3]); w0.z = cvt_pk_bf16(a[4], a[5]); w0.w = cvt_pk_bf16(a[6], a[7]);
        w1.x = cvt_pk_bf16(a[8], a[9]); w1.y = cvt_pk_bf16(a[10], a[11]); w1.z = cvt_pk_bf16(a[12], a[13]); w1.w = cvt_pk_bf16(a[14], a[15]);
        *(u32x4*)dst = w0; *(u32x4*)(dst + 8) = w1;
        __syncthreads();
    }
    for (int u = F.bid; u < 2 * 192; u += F.G) {
        const int l = u / 192, n0 = (u % 192) * 64;
        LAS float* sl = (LAS float*)F.lds; LAS float* red = (LAS float*)(F.lds + 5 * 2048 * 4);
        for (int i = F.tid; i < 5 * 2048; i += 512) { const int r = i >> 11, k = i & 2047; const float v = r < 4 ? F.in[I_C][r * 2048 + k] : F.in[I_CCTX][k]; sl[i] = v * sigmoidf_(v); }
        __syncthreads();
        const int cg = F.tid & 15, ks = F.tid >> 4;
        f32x4 a[5];
#pragma unroll
        for (int r = 0; r < 5; ++r) a[r] = (f32x4){0.f, 0.f, 0.f, 0.f};
        const float* wp = F.in[I_WADA] + (size_t)l * 2048 * 12288 + n0 + cg * 4;
#pragma unroll 8
        for (int k = ks * 64; k < ks * 64 + 64; ++k) { const f32x4 w = *(const f32x4*)(wp + (size_t)k * 12288);
#pragma unroll
            for (int r = 0; r < 5; ++r) a[r] += w * sl[r * 2048 + k]; }
#pragma unroll
        for (int r = 0; r < 5; ++r) *(LAS f32x4*)(red + (ks * 5 + r) * 64 + cg * 4) = a[r];
        __syncthreads();
        if (F.tid < 320) { const int r = F.tid >> 6, col = F.tid & 63; float sacc = 0.f;
#pragma unroll
            for (int k2 = 0; k2 < 32; ++k2) sacc += red[(k2 * 5 + r) * 64 + col];
            WSP(float, WS_MOD)[((size_t)l * 5 + r) * 12288 + n0 + col] = sacc + F.in[I_BADA][(size_t)l * 12288 + n0 + col]; }
        __syncthreads();
    }
    for (int i = F.bid * 512 + F.tid; i < 4096 * 64; i += F.G * 512) {
        const int pos = i >> 6, j = i & 63, fi = j & 31; const float fr = powf(10000.0f, -(float)(2 * fi) / 64.0f);
        const float ang = (float)(j < 32 ? (pos >> 6) : (pos & 63)) * fr;
        WSP(float, WS_COSH)[i] = cosf(ang); WSP(float, WS_SINH)[i] = sinf(ang);
    }
    for (int i = F.bid * 512 + F.tid; i < 4096 * 32; i += F.G * 512) {
        const int pos = i >> 5, j = i & 31, fi = j & 15; const float fr = powf(10000.0f, -(float)(2 * fi) / 32.0f);
        const float ang = (float)(j < 16 ? (pos >> 6) : (pos & 63)) * fr;
        WSP(float, WS_COSR)[i] = cosf(ang); WSP(float, WS_SINR)[i] = sinf(ang);
    }
    cvt_rows_fp8(F, F.in[I_PU], WSP(unsigned char, WS_UB), (size_t)2 * NEXP * 2048 / 16, 1024.f);
    cvt_rows_fp4(F, F.in[I_PV], WSP(unsigned char, WS_VB2), (size_t)2 * NEXP * 64);
}

__device__ __forceinline__ void ph_modulate0(const Ctx& F0) {
    const Ctx F = phase_ctx(F0);
    using namespace cf;
    const float* mod = WSP(float, WS_MOD);
    for (size_t i = (size_t)F.bid * 512 + F.tid; i < (size_t)MR * 256; i += (size_t)F.G * 512) {
        const int R = (int)(i >> 8), d = (int)(i & 255) * 8, b = R / RB, j = R % RB;
        const float* src = j < CTX ? F.in[I_CTX] + ((size_t)b * CTX + j) * 2048 : F.in[I_X] + ((size_t)b * S + (j - CTX)) * 2048;
        const float* m = mod + (size_t)(j < CTX ? 4 : b) * 12288;
        const f32x4 x0 = *(const f32x4*)(src + d), x1 = *(const f32x4*)(src + d + 4);
        const f32x4 sh0 = *(const f32x4*)(m + d), sh1 = *(const f32x4*)(m + d + 4), s0 = *(const f32x4*)(m + 2048 + d), s1 = *(const f32x4*)(m + 2048 + d + 4);
        *(u32x4*)(WSP(bf16_t, WS_HB) + (size_t)R * 2048 + d) = pg8::pack8(x0 * (s0 + 1.0f) + sh0, x1 * (s1 + 1.0f) + sh1);
    }
}

__device__ __forceinline__ void knorm_pass(const Ctx& F) {
    using namespace cf;
    bf16_t* P = WSP(bf16_t, WS_P); const float* ssk = WSP(const float, WS_SSK);
    for (int it = F.bid * 8 + F.wave; it < MR * 2; it += F.G * 8) {
        const int R = it >> 1, h = it & 1;
        const f32x2 pp = *(const f32x2*)(ssk + (size_t)it * 2); const float r = rsqrtf((pp.x + pp.y) * (1.f / 128.f) + 1e-6f);
        unsigned* q = (unsigned*)(P + (size_t)R * NC + PC_AK + h * 128) + F.lane;
        const unsigned w = *q; *q = cvt_pk_bf16(bflo(w) * r, bfhi(w) * r);
    }
}

struct AttnArgs {
    const bf16_t* Q; const bf16_t* K; const bf16_t* V; bf16_t* O; int ldq, ldk, ldv, ldo;
    int seg0_row, seg0_tiles, seg1_row, seg1_tiles;
    int mask_on, qpos0, kpos1;
    float sc_log2; int has_sink; float sink_l2;
    int variant;
    const float* qss;
};
typedef float f32x16 __attribute__((ext_vector_type(16)));
template <int DK, bool MASKED>
__device__ __forceinline__ void attn_unit(ldsp_t lds, const AttnArgs a, int wave_) {
    constexpr int ND = DK / 16, KST = DK + 8, KCH = DK / 8, KPT = (64 * KCH) / 512, VST = 72;
    constexpr int KBUF = 64 * KST * 2, VBUF = 128 * VST * 2, VOFF = 2 * KBUF, ALOFF = VOFF + 3 * VBUF;
    int tid = wave_ * 64 + lane_id(); asm volatile("" : "+v"(tid));
    const int wid = __builtin_amdgcn_readfirstlane(tid >> 6), lane = tid & 63, q32 = lane & 31, hi = lane >> 5;
    LAS float* al = (LAS float*)(lds + ALOFF + wid * 128);
    bf16x8 qf[ND];
    { float scq = a.sc_log2;
      if (a.qss) { const f32x2 pp = *(const f32x2*)(a.qss + (size_t)(wid * 32 + q32) * 16); scq *= rsqrtf((pp.x + pp.y) * (1.f / 128.f) + 1e-6f); }
      const bf16_t* qrow = a.Q + (size_t)(wid * 32 + q32) * a.ldq + 8 * hi;
#pragma unroll
      for (int s = 0; s < ND; ++s) { const u32x4 w = *(const u32x4*)(qrow + 16 * s); u32x4 o;
          o.x = cvt_pk_bf16(bflo(w.x) * scq, bfhi(w.x) * scq); o.y = cvt_pk_bf16(bflo(w.y) * scq, bfhi(w.y) * scq);
          o.z = cvt_pk_bf16(bflo(w.z) * scq, bfhi(w.z) * scq); o.w = cvt_pk_bf16(bflo(w.w) * scq, bfhi(w.w) * scq); qf[s] = *(bf16x8*)&o; } }
    f32x16 o[4];
#pragma unroll
    for (int db = 0; db < 4; ++db)
#pragma unroll
        for (int r = 0; r < 16; ++r) o[db][r] = 0.f;
    float m_run = -1e30f, l_run = 0.f;
    const int PV_ = MK_AV ? a.variant : 0;
    const int ntiles = a.seg0_tiles + a.seg1_tiles;
    u32x4 kreg[KPT], vreg[2];
    const int vkp = tid & 31, vdc = tid >> 5;
    const int vkey = 2 * vkp, vpos = (vkey & 48) | ((vkey & 4) << 1) | ((vkey & 8) >> 1) | (vkey & 3);
#define ATT_LOAD(tt) do { const int _r0 = (tt) < a.seg0_tiles ? a.seg0_row + 64 * (tt) : a.seg1_row + 64 * ((tt) - a.seg0_tiles); \
        _Pragma("unroll") for (int _i = 0; _i < KPT; ++_i) { const int _c = tid + 512 * _i; kreg[_i] = *(const u32x4*)(a.K + (size_t)(_r0 + _c / KCH) * a.ldk + 8 * (_c % KCH)); } \
        vreg[0] = *(const u32x4*)(a.V + (size_t)(_r0 + 2 * vkp) * a.ldv + 8 * vdc); vreg[1] = *(const u32x4*)(a.V + (size_t)(_r0 + 2 * vkp + 1) * a.ldv + 8 * vdc); } while (0)
#define ATT_WRITE(kb, vb) do { const ldsp_t _kb = lds + (kb) * KBUF; const ldsp_t _vb = lds + VOFF + (vb) * VBUF; \
        _Pragma("unroll") for (int _i = 0; _i < KPT; ++_i) { const int _c = tid + 512 * _i; *(LAS u32x4*)(_kb + ((_c / KCH) * KST + 8 * (_c % KCH)) * 2) = kreg[_i]; } \
        const unsigned _a0[4] = {vreg[0].x, vreg[0].y, vreg[0].z, vreg[0].w}, _a1[4] = {vreg[1].x, vreg[1].y, vreg[1].z, vreg[1].w}; \
        _Pragma("unroll") for (int _e = 0; _e < 4; ++_e) { \
            *(LAS unsigned*)(_vb + ((8 * vdc + 2 * _e) * VST + vpos) * 2) = (_a0[_e] & 0xffffu) | (_a1[_e] << 16); \
            *(LAS unsigned*)(_vb + ((8 * vdc + 2 * _e + 1) * VST + vpos) * 2) = (_a0[_e] >> 16) | (_a1[_e] & 0xffff0000u); } } while (0)
#define ATT_PV(vb) do { const ldsp_t _vt = lds + VOFF + (vb) * VBUF; \
        _Pragma("unroll") for (int db = 0; db < 4; ++db) _Pragma("unroll") for (int ks = 0; ks < 4; ++ks) { \
            const bf16x8 vf = *(const LAS bf16x8*)(_vt + ((32 * db + q32) * VST + 16 * ks + 8 * hi) * 2); \
            o[db] = __builtin_amdgcn_mfma_f32_32x32x16_bf16(pa[ks], vf, o[db], 0, 0, 0); } } while (0)
    bf16x8 pa[4];
#pragma unroll
    for (int i = 0; i < 4; ++i) pa[i] = (bf16x8){0, 0, 0, 0, 0, 0, 0, 0};
    int vprev = 2, vcur = 0, vnext = 1;
    { unsigned z0 = 0u; asm volatile("" : "+v"(z0));
      for (int i = tid; i < VBUF / 16; i += 512) *(LAS u32x4*)(lds + VOFF + 2 * VBUF + i * 16) = (u32x4){z0, z0, z0, z0}; }
    ATT_LOAD(0);
    ATT_WRITE(0, 0);
    __syncthreads();
    for (int tt = 0; tt < ntiles; ++tt) {
        const int cur = tt & 1;
        if (tt + 1 < ntiles && PV_ != 4) ATT_LOAD(tt + 1);
        const ldsp_t Ks = lds + cur * KBUF;
        f32x16 s0, s1;
#pragma unroll
        for (int r = 0; r < 16; ++r) { s0[r] = 0.f; s1[r] = 0.f; }
        { bf16x8 kf[2][2];
#define ATT_LDK(p, sb) do { kf[p][0] = *(const LAS bf16x8*)(Ks + (q32 * KST + 16 * (sb) + 8 * hi) * 2); kf[p][1] = *(const LAS bf16x8*)(Ks + ((32 + q32) * KST + 16 * (sb) + 8 * hi) * 2); } while (0)
          if (PV_ != 2) {
          ATT_LDK(0, 0); __builtin_amdgcn_sched_barrier(0);
#pragma unroll
          for (int sb = 0; sb < ND; ++sb) {
              if (sb + 1 < ND) ATT_LDK((sb + 1) & 1, sb + 1);
              __builtin_amdgcn_sched_barrier(0);
              s0 = __builtin_amdgcn_mfma_f32_32x32x16_bf16(kf[sb & 1][0], qf[sb], s0, 0, 0, 0);
              s1 = __builtin_amdgcn_mfma_f32_32x32x16_bf16(kf[sb & 1][1], qf[sb], s1, 0, 0, 0);
              __builtin_amdgcn_sched_barrier(0); }
          }
#undef ATT_LDK
        }
        __builtin_amdgcn_sched_barrier(0);
        const bool msk = MASKED && a.mask_on && tt >= a.seg0_tiles;
        if (MASKED) { const int kp0 = a.kpos1 + 64 * (tt - a.seg0_tiles) + 4 * hi, qp = a.qpos0 + wid * 32 + q32;
#pragma unroll
            for (int r = 0; r < 16; ++r) { float t0 = s0[r], t1 = s1[r];
                if (msk) { const int d0 = qp - (kp0 + (r & 3) + 8 * (r >> 2)), d1 = d0 - 32; if (d0 > 128 || d0 < -128) t0 = -1e30f; if (d1 > 128 || d1 < -128) t1 = -1e30f; s0[r] = t0; s1[r] = t1; } }
            __builtin_amdgcn_sched_barrier(0); }
        float mx = -1e30f, m_new = 0.f, alpha = 1.f, ps = 0.f;
        bf16x8 pn[4] = {pa[0], pa[1], pa[2], pa[3]};
        { const ldsp_t _vt = lds + VOFF + vprev * VBUF; bf16x8 vfr[3]; vfr[2] = pa[0];
#define ATT_LDV(i) (*(const LAS bf16x8*)(_vt + ((32 * ((i) >> 2) + q32) * VST + 16 * ((i) & 3) + 8 * hi) * 2))
#define SCV(e) ((e) < 16 ? s0[(e) & 15] : s1[(e) & 15])
          vfr[0] = ATT_LDV(0); vfr[1] = ATT_LDV(1);
          __builtin_amdgcn_sched_barrier(0);
#pragma unroll
          for (int i = 0; i < 16; ++i) {
              if (PV_ != 3) { if (i + 2 < 16) vfr[(i + 2) % 3] = ATT_LDV(i + 2);
              o[i >> 2] = __builtin_amdgcn_mfma_f32_32x32x16_bf16(pa[i & 3], vfr[i % 3], o[i >> 2], 0, 0, 0); }
              if (PV_ == 1) {} else if (i < 4) {
#pragma unroll
                  for (int e = 0; e < 4; ++e) mx = fmaxf(mx, fmaxf(s0[4 * i + e], s1[4 * i + e]));
              } else if (i == 4) {
                  mx = fmaxf(mx, shx(mx, 32, lane)); m_new = fmaxf(m_run, mx); alpha = __builtin_amdgcn_exp2f(m_run - m_new); m_run = m_new;
              } else if (i < 13) {
#pragma unroll
                  for (int e = 0; e < 2; ++e) { const int r = 2 * (i - 5) + e; s0[r] = __builtin_amdgcn_exp2f(s0[r] - m_new); s1[r] = __builtin_amdgcn_exp2f(s1[r] - m_new); ps += s0[r] + s1[r]; }
              } else if (i == 13) {
                  u32x4 w; w.x = cvt_pk_bf16(s0[0], s0[1]); w.y = cvt_pk_bf16(s0[2], s0[3]); w.z = cvt_pk_bf16(s0[4], s0[5]); w.w = cvt_pk_bf16(s0[6], s0[7]); pn[0] = *(bf16x8*)&w;
                  u32x4 v; v.x = cvt_pk_bf16(s0[8], s0[9]); v.y = cvt_pk_bf16(s0[10], s0[11]); v.z = cvt_pk_bf16(s0[12], s0[13]); v.w = cvt_pk_bf16(s0[14], s0[15]); pn[1] = *(bf16x8*)&v;
              } else if (i == 14) {
                  u32x4 w; w.x = cvt_pk_bf16(s1[0], s1[1]); w.y = cvt_pk_bf16(s1[2], s1[3]); w.z = cvt_pk_bf16(s1[4], s1[5]); w.w = cvt_pk_bf16(s1[6], s1[7]); pn[2] = *(bf16x8*)&w;
                  u32x4 v; v.x = cvt_pk_bf16(s1[8], s1[9]); v.y = cvt_pk_bf16(s1[10], s1[11]); v.z = cvt_pk_bf16(s1[12], s1[13]); v.w = cvt_pk_bf16(s1[14], s1[15]); pn[3] = *(bf16x8*)&v;
              } else { l_run = l_run * alpha + ps; }
              __builtin_amdgcn_sched_barrier(0);
          }
#undef ATT_LDV
#undef SCV
        }
#pragma unroll
        for (int i = 0; i < 4; ++i) pa[i] = pn[i];
        if (__any(alpha < 1.0f)) {
            if (hi == 0) al[q32] = alpha;
            asm volatile("s_waitcnt lgkmcnt(0)" ::: "memory");
#pragma unroll
            for (int g4 = 0; g4 < 4; ++g4) { const f32x4 av = *(const LAS f32x4*)(al + 8 * g4 + 4 * hi);
#pragma unroll
                for (int db = 0; db < 4; ++db)
#pragma unroll
                    for (int j = 0; j < 4; ++j) o[db][4 * g4 + j] *= av[j]; }
        }
        if (tt + 1 < ntiles && PV_ != 4) ATT_WRITE(cur ^ 1, vnext);
        { const int t3 = vprev; vprev = vcur; vcur = vnext; vnext = t3; }
        if (PV_ != 5) __syncthreads();
    }
    ATT_PV(vprev);
#undef ATT_LOAD
#undef ATT_WRITE
#undef ATT_PV
    __syncthreads();
    float l_tot = l_run + shx(l_run, 32, lane);
    if (a.has_sink) l_tot += __builtin_amdgcn_exp2f(a.sink_l2 - m_run);
    if (hi == 0) al[q32] = 1.0f / l_tot;
    asm volatile("s_waitcnt lgkmcnt(0)" ::: "memory");
    const ldsp_t Ost = lds + wid * 8192;
#pragma unroll
    for (int g4 = 0; g4 < 4; ++g4) { const f32x4 iv = *(const LAS f32x4*)(al + 8 * g4 + 4 * hi);
#pragma unroll
        for (int db = 0; db < 4; ++db)
#pragma unroll
            for (int j = 0; j < 4; ++j) *(LAS bf16_t*)(Ost + ((8 * g4 + 4 * hi + j) * 128 + 32 * db + q32) * 2) = f2bf(o[db][4 * g4 + j] * iv[j]); }
    asm volatile("s_waitcnt lgkmcnt(0)" ::: "memory");
#pragma unroll
    for (int i = 0; i < 8; ++i) { const int c = lane + 64 * i, row = c >> 4, c8 = c & 15;
        *(u32x4*)(a.O + (size_t)(wid * 32 + row) * a.ldo + 8 * c8) = *(const LAS u32x4*)(Ost + (row * 128 + 8 * c8) * 2); }
}

__device__ __forceinline__ void conv_unit(const Ctx& F, int layer, int row0  , int seq_len, int t0) {
    using namespace cf;
    const bf16_t* P = WSP(const bf16_t, WS_P); bf16_t* BR = WSP(bf16_t, WS_BR);
    const float* cw = F.in[I_CW] + (size_t)layer * 31 * 1024; const float* cb = F.in[I_CB] + layer * 1024;
    const float* lg = F.in[I_CLG] + layer * 1024; const float* lb = F.in[I_CLB] + layer * 1024;
    int tid = F.wave * 64 + lane_id(); asm volatile("" : "+v"(tid));
    const int lane = tid & 63;
    LAS float* red = (LAS float*)(F.lds + 126976); LAS float* tot = red + 8 * 32;
    __syncthreads();
    for (int c = tid; c < 62 * 128; c += 512) { const int rr = c >> 7, ch = c & 127, t = t0 - 15 + rr;
        u32x4 v = {0u, 0u, 0u, 0u};
        if (t >= 0 && t < seq_len) v = *(const u32x4*)(P + (size_t)(row0 + t) * NC + PC_GLU + ch * 8);
        *(LAS u32x4*)(F.lds + rr * 2048 + ch * 16) = v; }
    float w0[31], w1[31];
#pragma unroll
    for (int k = 0; k < 31; ++k) { const f32x2 w = *(const f32x2*)(cw + k * 1024 + 2 * tid); w0[k] = w.x; w1[k] = w.y; }
    const f32x2 bv = *(const f32x2*)(cb + 2 * tid), gg = *(const f32x2*)(lg + 2 * tid), bb = *(const f32x2*)(lb + 2 * tid);
    __syncthreads();
#pragma unroll 1
    for (int part = 0; part < 4; ++part) {
        float a0[8], a1[8];
#pragma unroll
        for (int t = 0; t < 8; ++t) { a0[t] = bv.x; a1[t] = bv.y; }
        const ldsp_t base = F.lds + part * 8 * 2048 + tid * 4;
#pragma unroll
        for (int rr = 0; rr < 38; ++rr) { const unsigned xw = *(const LAS unsigned*)(base + rr * 2048); const float x0 = bflo(xw), x1 = bfhi(xw);
#pragma unroll
            for (int t = 0; t < 8; ++t) { const int k = rr - t; if (k >= 0 && k <= 30) { a0[t] += x0 * w0[k]; a1[t] += x1 * w1[k]; } } }
        float v[16];
#pragma unroll
        for (int t = 0; t < 8; ++t) { v[t] = a0[t] + a1[t]; v[8 + t] = a0[t] * a0[t] + a1[t] * a1[t]; }
#pragma unroll
        for (int i = 0; i < 8; ++i) { const bool up = lane & 32; const float snd = up ? v[i] : v[i + 8], kp = up ? v[i + 8] : v[i]; v[i] = kp + shx(snd, 32, lane); }
#pragma unroll
        for (int i = 0; i < 4; ++i) { const bool up = lane & 16; const float snd = up ? v[i] : v[i + 4], kp = up ? v[i + 4] : v[i]; v[i] = kp + shx(snd, 16, lane); }
#pragma unroll
        for (int i = 0; i < 2; ++i) { const bool up = lane & 8; const float snd = up ? v[i] : v[i + 2], kp = up ? v[i + 2] : v[i]; v[i] = kp + shx(snd, 8, lane); }
        { const bool up = lane & 4; const float snd = up ? v[0] : v[1], kp = up ? v[1] : v[0]; v[0] = kp + shx(snd, 4, lane); }
        v[0] += shx(v[0], 2, lane); v[0] += shx(v[0], 1, lane);
        if ((lane & 3) == 0) red[F.wave * 16 + (lane >> 2)] = v[0];
        __syncthreads();
        if (tid < 16) { float s = 0.f;
#pragma unroll
            for (int w = 0; w < 8; ++w) s += red[w * 16 + tid];
            tot[tid] = s; }
        __syncthreads();
#pragma unroll
        for (int t = 0; t < 8; ++t) { const float mean = tot[t] * (1.f / 1024.f), var = fmaxf(tot[8 + t] * (1.f / 1024.f) - mean * mean, 0.f), rstd = rsqrtf(var + 1e-5f);
            const float y0 = (a0[t] - mean) * rstd * gg.x + bb.x, y1 = (a1[t] - mean) * rstd * gg.y + bb.y;
            *(unsigned*)(BR + (size_t)(row0 + t0 + part * 8 + t) * 4096 + 2048 + 2 * tid) = cvt_pk_bf16(y0 * sigmoidf_(y0), y1 * sigmoidf_(y1)); }
    }
}

__device__ __forceinline__ void attn_defaults(AttnArgs& a, int isctx) {
    a.seg0_row = 0; a.seg0_tiles = isctx ? 4 : 68; a.seg1_row = 0; a.seg1_tiles = 0; a.mask_on = 0; a.qpos0 = 0; a.kpos1 = 0; a.has_sink = 0; a.sink_l2 = 0.f; a.qss = nullptr; a.variant = 0; }
__device__ __forceinline__ void ph_attn(const Ctx& F0, int layer) {
    const Ctx F = phase_ctx(F0);
    using namespace cf;
    const bf16_t* P = WSP(const bf16_t, WS_P); bf16_t* BR = WSP(bf16_t, WS_BR);
    for (int dup = 0; dup < DUPN(2); ++dup)
    for (int u = F.bid; u < (layer == 0 ? 544 : 512); u += F.G) {
        int b, h, qb, isctx = 0;
        if (u < 512) { b = u >> 7; h = (u >> 4) & 7; qb = u & 15; } else { const int r = u - 512; b = r >> 3; h = r & 7; qb = 0; isctx = 1; }
        const size_t brow = (size_t)b * RB, qrow = brow + (isctx ? 0 : CTX) + (size_t)qb * 256;
        AttnArgs a; attn_defaults(a, isctx);
        a.Q = WSP(const bf16_t, WS_QB) + qrow * 1536 + h * 192; a.ldq = 1536;
        a.K = WSP(const bf16_t, WS_KB) + brow * 1536 + h * 192; a.ldk = 1536;
        a.V = WSP(const bf16_t, WS_VB) + brow * 1024 + h * 128; a.ldv = 1024;
        a.O = BR + qrow * 4096 + 1024 + h * 128; a.ldo = 4096; a.sc_log2 = SCALE_MLA * LOG2E;
        __syncthreads();
        attn_unit<192, false>(F.lds, a, F.wave);
    }
    for (int dup = 0; dup < DUPN(3); ++dup)
    for (int u0 = F.bid; u0 < (layer == 0 ? 544 : 512); u0 += F.G) {
        int b, h, qb, isctx = 0;
        if (u0 < 512) { b = u0 >> 7; h = (u0 >> 4) & 7; qb = u0 & 15; } else { const int r = u0 - 512; b = r >> 3; h = r & 7; qb = 0; isctx = 1; }
        const size_t brow = (size_t)b * RB, qrow = brow + (isctx ? 0 : CTX) + (size_t)qb * 256;
        AttnArgs a; attn_defaults(a, isctx);
        a.Q = P + qrow * NC + PC_AQ + h * 128; a.ldq = NC;
        a.K = P + brow * NC + PC_AK + (h >> 2) * 128; a.ldk = NC;
        a.V = P + brow * NC + PC_AV + (h >> 2) * 128; a.ldv = NC;
        a.O = BR + qrow * 4096 + h * 128; a.ldo = 4096; a.sc_log2 = SCALE_HD * LOG2E;
        a.qss = WSP(const float, WS_SSQ) + qrow * 16 + h * 2;
        if (MK_AV && dup == 1) { a.variant = MK_AV; a.O = WSP(bf16_t, WS_HB) + qrow * 2048 + h * 128; a.ldo = 2048; }
        __syncthreads();
        attn_unit<128, false>(F.lds, a, F.wave);
    }
    for (int dup = 0; dup < DUPN(13); ++dup)
    for (int u0 = F.bid; u0 < (layer == 0 ? 544 : 512); u0 += F.G) {
        int b, h, qb, isctx = 0;
        if (u0 < 512) { b = u0 >> 7; h = (u0 >> 4) & 7; qb = u0 & 15; } else { const int r = u0 - 512; b = r >> 3; h = r & 7; qb = 0; isctx = 1; }
        const size_t brow = (size_t)b * RB, qrow = brow + (isctx ? 0 : CTX) + (size_t)qb * 256;
        AttnArgs a; attn_defaults(a, isctx);
        a.Q = P + qrow * NC + PC_DQ + h * 128; a.ldq = NC;
        a.K = P + brow * NC + PC_DK + (h >> 2) * 128; a.ldk = NC;
        a.V = P + brow * NC + PC_DV + (h >> 2) * 128; a.ldv = NC;
        a.O = BR + qrow * 4096 + 3072 + h * 128; a.ldo = 4096; a.sc_log2 = SCALE_HD * LOG2E;
        a.has_sink = 1; a.sink_l2 = F.in[I_SINK][layer * 8 + h] * LOG2E; a.seg0_tiles = 4;
        if (!isctx) { const int start = qb * 256; const int lo = start - 128 < 0 ? 0 : start - 128, hi = start + 384 > S ? S : start + 384;
            a.seg1_row = CTX + lo; a.seg1_tiles = (hi - lo) / 64; a.mask_on = 1; a.qpos0 = start; a.kpos1 = lo; }
        __syncthreads();
        attn_unit<128, true>(F.lds, a, F.wave);
    }
    for (int dup = 0; dup < DUPN(4); ++dup)
    for (int u = F.bid; u < (layer == 0 ? 544 : 512); u += F.G) {
        int b, tb, isctx = 0;
        if (u < 512) { b = u >> 7; tb = u & 127; } else { const int r = u - 512; b = r >> 3; tb = r & 7; isctx = 1; }
        conv_unit(F, layer, b * RB + (isctx ? 0 : CTX), isctx ? CTX : S, tb * 32);
    }
}

__device__ __forceinline__ int tok_row(int layer, int tok) { return layer == 0 ? tok : (tok >> 12) * cf::RB + cf::CTX + (tok & 4095); }
__device__ __forceinline__ void ph_ln1(const Ctx& F0, int layer) {
    const Ctx F = phase_ctx(F0);
    using namespace cf;
    float* X1 = (float*)(F.ws + WS_P + X1_OFF); bf16_t* HB = WSP(bf16_t, WS_HB);
    const float* lg = F.in[I_LN1G] + layer * 2048; const float* lb = F.in[I_LN1B] + layer * 2048;
    const int ntok = layer == 0 ? MR : NB * S, lane = F.lane;
    for (int tok = F.bid * 8 + F.wave; tok < ntok; tok += F.G * 8) {
        const int R = tok_row(layer, tok), b = R / RB, j = R % RB;
        const float* mod = WSP(const float, WS_MOD) + ((size_t)layer * 5 + (j < CTX ? 4 : b)) * 12288;
        float* xp = X1 + (size_t)R * 2048;
        f32x4 v[8]; float s = 0.f;
#pragma unroll
        for (int i = 0; i < 8; ++i) { v[i] = *(const f32x4*)(xp + lane * 4 + 256 * i); s += (v[i][0] + v[i][1]) + (v[i][2] + v[i][3]); }
        const float mean = wave_sum(s, lane) * (1.f / 2048.f); float q = 0.f;
#pragma unroll
        for (int i = 0; i < 8; ++i) { const f32x4 d = v[i] - mean; q += (d[0] * d[0] + d[1] * d[1]) + (d[2] * d[2] + d[3] * d[3]); }
        const float rstd = rsqrtf(wave_sum(q, lane) * (1.f / 2048.f) + 1e-5f);
#pragma unroll
        for (int i = 0; i < 8; ++i) { const int c = lane * 4 + 256 * i;
            const f32x4 y = (v[i] - mean) * rstd * *(const f32x4*)(lg + c) + *(const f32x4*)(lb + c);
            *(f32x4*)(xp + c) = y;
            const f32x4 hp = y * (*(const f32x4*)(mod + 4 * 2048 + c) + 1.0f) + *(const f32x4*)(mod + 3 * 2048 + c);
            u32x2 w; w.x = cvt_pk_bf16(hp[0], hp[1]); w.y = cvt_pk_bf16(hp[2], hp[3]);
            *(u32x2*)(HB + (size_t)R * 2048 + c) = w; }
    }
}

typedef __bf16 bf16x2_t __attribute__((ext_vector_type(2)));
__device__ __forceinline__ unsigned ordkey(float v) { const unsigned u = __float_as_uint(v); return (u & 0x80000000u) ? ~u : (u | 0x80000000u); }
__device__ __forceinline__ int lane_rank(unsigned long long m) { return (int)__builtin_amdgcn_mbcnt_hi((unsigned)(m >> 32), __builtin_amdgcn_mbcnt_lo((unsigned)m, 0u)); }
template <int NV> __device__ __forceinline__ unsigned radix_thresh16(const unsigned (&k)[NV]) {
    unsigned T = 0u;
    for (int bit = 31; bit >= 0; --bit) { const unsigned cand = T | (1u << bit); int cnt = 0;
#pragma unroll
        for (int v = 0; v < NV; ++v) cnt += __popcll(__ballot(k[v] >= cand));
        if (cnt >= 16) { T = cand; if (cnt == 16) break; } }
    return T;
}
__device__ __forceinline__ void radix_thresh16x2(const unsigned (&ka)[2], const unsigned (&kb)[2], unsigned& Ta, unsigned& Tb) {
    unsigned T0 = 0u, T1 = 0u; bool d0 = false, d1 = false;
    for (int bit = 31; bit >= 0; --bit) { const unsigned c0 = T0 | (1u << bit), c1 = T1 | (1u << bit);
        const int n0 = __popcll(__ballot(ka[0] >= c0)) + __popcll(__ballot(ka[1] >= c0)), n1 = __popcll(__ballot(kb[0] >= c1)) + __popcll(__ballot(kb[1] >= c1));
        if (!d0 && n0 >= 16) { T0 = c0; d0 = n0 == 16; }
        if (!d1 && n1 >= 16) { T1 = c1; d1 = n1 == 16; }
        if (d0 && d1) break; }
    Ta = T0; Tb = T1;
}
__device__ __forceinline__ float dot2bf(unsigned a, unsigned b, float acc) { return __builtin_amdgcn_fdot2_f32_bf16(__builtin_bit_cast(bf16x2_t, a), __builtin_bit_cast(bf16x2_t, b), acc, false); }
__device__ __forceinline__ float dot8(const u32x4 a, const u32x4 b, float acc) {
    acc = dot2bf(a.x, b.x, acc); acc = dot2bf(a.y, b.y, acc); acc = dot2bf(a.z, b.z, acc); acc = dot2bf(a.w, b.w, acc);
    return acc;
}
__device__ __forceinline__ float gelu_as(float v) {
    const float av = fabsf(v), t = __builtin_amdgcn_rcpf(av * 0.2316418882f + 1.0f);
    float q = t * 0.5307027145f + (-0.7265760135f); q = q * t + 0.7107068705f; q = q * t + (-0.142248368f); q = q * t + 0.127414796f; q = q * t;
    const float e = __builtin_amdgcn_exp2f((v * v) * (-0.72134752044f)), m = v * (q * e);
    return v < 0.f ? m : v - m;
}
__device__ __forceinline__ void peer_load(u32x4 (&ur)[4][2], u32x4 (&vr)[4], unsigned (&vs)[4], float (&gq)[4], const LAS int* ei, const LAS float* eg,
                                          const unsigned char* U8, const unsigned char* V4, int lane, int grp) {
#pragma unroll
    for (int q = 0; q < 4; ++q) { const int id = __builtin_amdgcn_readfirstlane(ei[grp * 4 + q]); gq[q] = __uint_as_float(__builtin_amdgcn_readfirstlane(__float_as_uint(eg[grp * 4 + q])));
        ur[q][0] = *(const u32x4*)(U8 + (size_t)id * 2048 + lane * 16); ur[q][1] = *(const u32x4*)(U8 + (size_t)id * 2048 + lane * 16 + 1024);
        vr[q] = *(const u32x4*)(V4 + (size_t)id * V4_ROW + lane * 16); vs[q] = V4[(size_t)id * V4_ROW + 1024 + lane]; }
}
__device__ __forceinline__ void peer_comp(const u32x4 (&ur)[4][2], const u32x4 (&vr)[4], const unsigned (&vs)[4], const float (&gq)[4], const f32x2 (&xf)[16], f32x2 (&y2)[16], int lane) {
    float d[4];
#pragma unroll
    for (int q = 0; q < 4; ++q) { f32x2 t = {0.f, 0.f};
#pragma unroll
        for (int i = 0; i < 2; ++i)
#pragma unroll
            for (int j = 0; j < 4; ++j) { const int w = (int)ur[q][i][j];
                t += __builtin_amdgcn_cvt_pk_f32_fp8(w, false) * xf[8 * i + 2 * j]; t += __builtin_amdgcn_cvt_pk_f32_fp8(w, true) * xf[8 * i + 2 * j + 1]; }
        d[q] = t.x + t.y; }
#pragma unroll
    for (int o = 32; o >= 1; o >>= 1) {
#pragma unroll
        for (int q = 0; q < 4; ++q) d[q] += shx(d[q], o, lane); }
#pragma unroll
    for (int q = 0; q < 4; ++q) { const float dd = d[q] * (1.0f / 1024.0f); const float w = gq[q] * gelu_as(dd) * __uint_as_float(vs[q] << 23);
        const f32x2 w2 = {w, w};
#pragma unroll
        for (int j = 0; j < 4; ++j) { const unsigned vw = vr[q][j];
            y2[4 * j + 0] += w2 * __builtin_amdgcn_cvt_scalef32_pk_f32_fp4(vw, 1.0f, 0); y2[4 * j + 1] += w2 * __builtin_amdgcn_cvt_scalef32_pk_f32_fp4(vw, 1.0f, 1);
            y2[4 * j + 2] += w2 * __builtin_amdgcn_cvt_scalef32_pk_f32_fp4(vw, 1.0f, 2); y2[4 * j + 3] += w2 * __builtin_amdgcn_cvt_scalef32_pk_f32_fp4(vw, 1.0f, 3); } }
}
__device__ __forceinline__ void ph_peer(const Ctx& F0, int layer) {
    const Ctx F = phase_ctx(F0);
    using namespace cf;
    const float* SC = (const float*)(F.ws + WS_P + SC_OFF); const float* X1 = (const float*)(F.ws + WS_P + X1_OFF);
    bf16_t* HB = WSP(bf16_t, WS_HB); const unsigned char* U8 = WSP(const unsigned char, WS_UB) + (size_t)layer * NEXP * 2048; const unsigned char* V4 = WSP(const unsigned char, WS_VB2) + (size_t)layer * NEXP * V4_ROW;
    const float* lg = F.in[I_LN2G] + layer * 2048; const float* lb = F.in[I_LN2B] + layer * 2048;
    const int ntok = layer == 0 ? MR : NB * S, lane = F.lane;
    ldsp_t wl = F.lds + F.wave * 4096;
    LAS float* tv0 = (LAS float*)wl; LAS int* ti0 = (LAS int*)(wl + 64); LAS float* tv1 = (LAS float*)(wl + 128); LAS int* ti1 = (LAS int*)(wl + 192);
    LAS float* es = (LAS float*)(wl + 256); LAS int* ei = (LAS int*)(wl + 768); LAS float* eg = (LAS float*)(wl + 1280);
    for (int tok = F.bid * 8 + F.wave; tok < ntok; tok += F.G * 8) {
        const int R = tok_row(layer, tok), b = R / RB, j = R % RB; const bool isctx = j < CTX; const int modrow = isctx ? 4 : b;
        const float* sc = SC + (size_t)R * 2048;
        float scv[8][4];
#pragma unroll
        for (int h = 0; h < 8; ++h) { scv[h][0] = sc[(2 * h) * 128 + lane]; scv[h][1] = sc[(2 * h) * 128 + 64 + lane]; scv[h][2] = sc[(2 * h + 1) * 128 + lane]; scv[h][3] = sc[(2 * h + 1) * 128 + 64 + lane]; }
#pragma unroll
        for (int h = 0; h < 8; ++h) {
            const float s0a = scv[h][0], s0b = scv[h][1], s1a = scv[h][2], s1b = scv[h][3];
            { const unsigned ka[2] = {(ordkey(s0a) & ~127u) | (unsigned)(127 - lane), (ordkey(s0b) & ~127u) | (unsigned)(63 - lane)};
              const unsigned kb[2] = {(ordkey(s1a) & ~127u) | (unsigned)(127 - lane), (ordkey(s1b) & ~127u) | (unsigned)(63 - lane)};
              unsigned Ta, Tb; radix_thresh16x2(ka, kb, Ta, Tb);
              { const unsigned long long m0 = __ballot(ka[0] >= Ta), m1 = __ballot(ka[1] >= Ta); const int n0 = __popcll(m0);
                if (ka[0] >= Ta) { const int r = lane_rank(m0); tv0[r] = s0a; ti0[r] = lane; }
                if (ka[1] >= Ta) { const int r = n0 + lane_rank(m1); tv0[r] = s0b; ti0[r] = lane + 64; } }
              { const unsigned long long m0 = __ballot(kb[0] >= Tb), m1 = __ballot(kb[1] >= Tb); const int n0 = __popcll(m0);
                if (kb[0] >= Tb) { const int r = lane_rank(m0); tv1[r] = s1a; ti1[r] = lane; }
                if (kb[1] >= Tb) { const int r = n0 + lane_rank(m1); tv1[r] = s1b; ti1[r] = lane + 64; } } }
            asm volatile("s_waitcnt lgkmcnt(0)" ::: "memory");
            const int ci = lane >> 2, cj = (lane & 3) * 4;
            const float a0 = tv0[ci]; const int i0 = ti0[ci];
            float c4[4]; int id4[4]; unsigned kc[4];
#pragma unroll
            for (int jj = 0; jj < 4; ++jj) { c4[jj] = a0 + tv1[cj + jj]; id4[jj] = i0 * 128 + ti1[cj + jj]; kc[jj] = (ordkey(c4[jj]) & ~255u) | (unsigned)(255 - (lane * 4 + jj)); }
            const unsigned Tc = radix_thresh16<4>(kc);
            int base = h * 16;
#pragma unroll
            for (int jj = 0; jj < 4; ++jj) { const unsigned long long m = __ballot(kc[jj] >= Tc);
                if (kc[jj] >= Tc) { const int r = base + lane_rank(m); es[r] = c4[jj]; ei[r] = id4[jj]; }
                base += __popcll(m); }
            asm volatile("s_waitcnt lgkmcnt(0)" ::: "memory");
        }
#pragma unroll
        for (int rnd = 0; rnd < 2; ++rnd) { const int e = lane + 64 * rnd; const float s = es[e];
            float m = s; m = fmaxf(m, shx(m, 1, lane)); m = fmaxf(m, shx(m, 2, lane)); m = fmaxf(m, shx(m, 4, lane)); m = fmaxf(m, shx(m, 8, lane));
            const float ex = __expf(s - m); float sum = ex; sum += shx(sum, 1, lane); sum += shx(sum, 2, lane); sum += shx(sum, 4, lane); sum += shx(sum, 8, lane);
            eg[e] = ex / sum; }
        asm volatile("s_waitcnt lgkmcnt(0)" ::: "memory");
        f32x2 xf[16];
#pragma unroll
        for (int i = 0; i < 2; ++i)
#pragma unroll
            for (int hh = 0; hh < 2; ++hh) { const u32x4 w = *(const u32x4*)(HB + (size_t)R * 2048 + lane * 16 + 1024 * i + 8 * hh);
                xf[8 * i + 4 * hh + 0] = (f32x2){bflo(w.x), bfhi(w.x)}; xf[8 * i + 4 * hh + 1] = (f32x2){bflo(w.y), bfhi(w.y)};
                xf[8 * i + 4 * hh + 2] = (f32x2){bflo(w.z), bfhi(w.z)}; xf[8 * i + 4 * hh + 3] = (f32x2){bflo(w.w), bfhi(w.w)}; }
        f32x2 y2[16];
#pragma unroll
        for (int i = 0; i < 16; ++i) y2[i] = (f32x2){0.f, 0.f};
        f32x4 xrow[8];
#pragma unroll
        for (int k = 0; k < 8; ++k) xrow[k] = *(const f32x4*)(X1 + (size_t)R * 2048 + lane * 32 + 4 * k);
        { u32x4 urA[4][2], vrA[4], urB[4][2], vrB[4]; unsigned vsA[4], vsB[4]; float gqA[4], gqB[4];
          peer_load(urA, vrA, vsA, gqA, ei, eg, U8, V4, lane, 0);
          for (int grp = 0; grp < 32; grp += 2) {
              peer_load(urB, vrB, vsB, gqB, ei, eg, U8, V4, lane, grp + 1);
              peer_comp(urA, vrA, vsA, gqA, xf, y2, lane);
              peer_load(urA, vrA, vsA, gqA, ei, eg, U8, V4, lane, grp + 2 < 32 ? grp + 2 : 31);
              peer_comp(urB, vrB, vsB, gqB, xf, y2, lane);
          } }
        const float* mod = WSP(const float, WS_MOD) + ((size_t)layer * 5 + modrow) * 12288;
        float y[32];
        float s = 0.f;
#pragma unroll
        for (int k = 0; k < 8; ++k) { const int c = lane * 32 + 4 * k;
            const f32x4 xa = xrow[k], ga = *(const f32x4*)(mod + 5 * 2048 + c);
            y[4 * k + 0] = ALPHA * xa[0] + ga[0] * y2[2 * k].x; y[4 * k + 1] = ALPHA * xa[1] + ga[1] * y2[2 * k].y;
            y[4 * k + 2] = ALPHA * xa[2] + ga[2] * y2[2 * k + 1].x; y[4 * k + 3] = ALPHA * xa[3] + ga[3] * y2[2 * k + 1].y;
            s += (y[4 * k + 0] + y[4 * k + 1]) + (y[4 * k + 2] + y[4 * k + 3]); }
        const float mean = wave_sum(s, lane) * (1.f / 2048.f); float q2 = 0.f;
#pragma unroll
        for (int i = 0; i < 32; ++i) { const float dd = y[i] - mean; q2 += dd * dd; }
        const float rstd = rsqrtf(wave_sum(q2, lane) * (1.f / 2048.f) + 1e-5f);
        float* dst = layer == 0 ? (isctx ? WSP(float, WS_XC) + ((size_t)b * CTX + j) * 2048 : F.out + ((size_t)b * S + (j - CTX)) * 2048) : F.out + ((size_t)b * S + (j - CTX)) * 2048;
        const float* modn = WSP(const float, WS_MOD) + ((size_t)1 * 5 + modrow) * 12288;
#pragma unroll
        for (int kk = 0; kk < 4; ++kk) { f32x4 o[2];
#pragma unroll
            for (int jj = 0; jj < 2; ++jj) { const int k = 2 * kk + jj, c = lane * 32 + 4 * k; const f32x4 la = *(const f32x4*)(lg + c), ba = *(const f32x4*)(lb + c);
#pragma unroll
                for (int e = 0; e < 4; ++e) o[jj][e] = (y[4 * k + e] - mean) * rstd * la[e] + ba[e];
                *(f32x4*)(dst + c) = o[jj]; }
            if (layer == 0) {
                const int c = lane * 32 + 8 * kk;
                const f32x4 sa = *(const f32x4*)(modn + 2048 + c), sb = *(const f32x4*)(modn + 2048 + c + 4), ha = *(const f32x4*)(modn + c), hb = *(const f32x4*)(modn + c + 4);
                *(u32x4*)(HB + (size_t)R * 2048 + c) = pg8::pack8(o[0] * (sa + 1.0f) + ha, o[1] * (sb + 1.0f) + hb); } }
    }
}

struct Params { const float* in[cf::N_IN]; float* out; unsigned char* ws; int ph_lo, ph_hi; };

__global__ void __launch_bounds__(512, 2) mega_fwd(Params p) {
    using namespace cf;
    extern __shared__ __attribute__((aligned(16))) unsigned char smem[];
    Ctx F0;
    F0.in = p.in;
    F0.out = p.out; F0.ws = p.ws; F0.lds = (ldsp_t)smem;
    F0.tid = 0; F0.lane = 0; F0.wave = __builtin_amdgcn_readfirstlane(threadIdx.x >> 6); F0.G = gridDim.x; F0.bid = blockIdx.x;
    if (threadIdx.x < 64) ((LAS unsigned*)(F0.lds + MISC_OFF))[threadIdx.x] = 0u;
    __syncthreads();
    const int lo = p.ph_lo, hi = p.ph_hi;
    XcdBarrier bar; bar.bar = (unsigned*)(F0.ws + WS_CTL); bar.x = 0; bar.st = (volatile LAS unsigned*)(F0.lds + MISC_OFF); bar.wave = F0.wave;
    if (hi - lo > 1) bar = xcd_barrier_post((unsigned*)(F0.ws + WS_CTL), (volatile LAS unsigned*)(F0.lds + MISC_OFF), F0.wave);
#ifndef MK_MASK
#define MK_MASK 0xFFFF
#endif
#define ON(j) ((MK_MASK >> (j)) & 1)
#define IN(k) (lo <= (k) && (k) < hi)
#define SEAM(k) do { if (IN(k) && IN((k) + 1)) xcd_barrier(bar); } while (0)

    if (ON(9) && IN(0)) { ph_prologue(F0); if (DUPN(9) == 2) { __syncthreads(); ph_prologue(F0); } }
    SEAM(0);
    if (ON(10) && IN(1)) ph_modulate0(F0);
    SEAM(1);
    for (int l = 0; l < DEPTH; ++l) {
        const int pb = 2 + 8 * l;
        const int rmode = l == 0 ? 0 : 1, nMl = l == 0 ? 68 : 64;
        for (int blk = 0; blk < DUPN(12); ++blk) {
        if (blk) xcd_barrier(bar);
        if (ON(0) && IN(pb + 0)) { const Ctx F = phase_ctx(F0);
            pg8::Gemm g{WSP(const bf16_t, WS_HB), WSP(const bf16_t, WS_WIN) + (size_t)l * NC * 2048, 2048, 2048};
            pg8::EpiInProj E{WSP(bf16_t, WS_P), WSP(bf16_t, WS_KB), WSP(const float, WS_COSH), WSP(const float, WS_SINH), WSP(const float, WS_COSR), WSP(const float, WS_SINR),
                             F.in[I_AKN] + l * 128, F.in[I_AQN] + l * 128, WSP(float, WS_SSK), WSP(float, WS_SSQ), WSP(float, WS_SSKV), WSP(float, WS_SSCQ)};
            pg8::TileOrder S; S.init(nMl, 56, F.G, F.bid, rmode);
            for (int dup = 0; dup < DUPN(0); ++dup)
            pg8::gemm_phase(F.lds, g, S, E, F.wave);
            if (l > 0) { pg8::TileOrder S2; S2.init(4, 6, F.G, F.bid, 2); pg8::gemm_phase(F.lds, g, S2, E, F.wave); }
        }
        SEAM(pb + 0);
        if (ON(2) && IN(pb + 1)) { const Ctx F = phase_ctx(F0); bf16_t* P = WSP(bf16_t, WS_P);
            knorm_pass(F);
            { pg8::Gemm g{P + PC_CKV, WSP(const bf16_t, WS_WKVUP) + (size_t)l * 2048 * 256, NC, 256}; pg8::EpiKvUp E{WSP(bf16_t, WS_KB), WSP(bf16_t, WS_VB), WSP(const float, WS_SSKV)};
              pg8::TileOrder S; S.init(68, 8, F.G, F.bid, 0); for (int dup = 0; dup < DUPN(1); ++dup) pg8::gemm_phase(F.lds, g, S, E, F.wave); }
            { pg8::Gemm g{P + PC_CQ, WSP(const bf16_t, WS_WQUP) + (size_t)l * 1536 * 512, NC, 512}; pg8::EpiQUp E{WSP(bf16_t, WS_QB), WSP(const float, WS_COSR), WSP(const float, WS_SINR), WSP(const float, WS_SSCQ)};
              pg8::TileOrder S; S.init(nMl, 6, F.G, F.bid, rmode); for (int dup = 0; dup < DUPN(1); ++dup) pg8::gemm_phase(F.lds, g, S, E, F.wave); }
        }
        SEAM(pb + 1);
        if (ON(3) && IN(pb + 2)) ph_attn(F0, l);
        }
        SEAM(pb + 2);
        if (ON(4) && IN(pb + 3)) { const Ctx F = phase_ctx(F0); bf16_t* P = WSP(bf16_t, WS_P); bf16_t* HB = WSP(bf16_t, WS_HB);
            pg8::Gemm g{WSP(const bf16_t, WS_BR), WSP(const bf16_t, WS_WBR) + (size_t)l * 4 * 2048 * 1024, 4096, 1024};
            pg8::EpiMerge E{HB, P + PC_GATE, NC};
            pg8::TileOrder S; S.init(nMl, 8, F.G, F.bid, rmode, 4, (size_t)1024 * 2, (size_t)2048 * 1024 * 2);
            for (int dup = 0; dup < DUPN(5); ++dup) pg8::gemm_phase(F.lds, g, S, E, F.wave);
        }
        SEAM(pb + 3);
        if (ON(5) && IN(pb + 4)) { const Ctx F = phase_ctx(F0); bf16_t* HB = WSP(bf16_t, WS_HB);
            pg8::Gemm g{HB, WSP(const bf16_t, WS_WO) + (size_t)l * 2048 * 2048, 2048, 2048};
            pg8::EpiWo E{(float*)(F.ws + WS_P + X1_OFF), WSP(const float, WS_MOD) + (size_t)l * 5 * 12288, l == 0 ? F.in[I_X] : (const float*)F.out, F.in[I_CTX]};
            pg8::TileOrder S; S.init(nMl, 8, F.G, F.bid, rmode); for (int dup = 0; dup < DUPN(6); ++dup) pg8::gemm_phase(F.lds, g, S, E, F.wave);
        }
        SEAM(pb + 4);
        if (ON(6) && IN(pb + 5)) ph_ln1(F0, l);
        SEAM(pb + 5);
        if (ON(7) && IN(pb + 6)) { const Ctx F = phase_ctx(F0); bf16_t* HB = WSP(bf16_t, WS_HB);
            pg8::Gemm g{HB, WSP(const bf16_t, WS_WFOLD) + (size_t)l * 2048 * 2048, 2048, 2048}; pg8::EpiF32 E{(float*)(F.ws + WS_P + SC_OFF), 2048};
            pg8::TileOrder S; S.init(nMl, 8, F.G, F.bid, rmode); for (int dup = 0; dup < DUPN(7); ++dup) pg8::gemm_phase(F.lds, g, S, E, F.wave);
        }
        SEAM(pb + 6);
        if (ON(8) && IN(pb + 7)) { ph_peer(F0, l); if (DUPN(8) == 2 && l == 1) ph_peer(F0, l); }
        SEAM(pb + 7);
    }
#undef IN
#undef SEAM
}

extern "C" void kernel_launch(void* const* d_in, const int* in_sizes, int n_in, void* d_out, int out_size, void* d_ws, size_t ws_size, hipStream_t stream) {
    static int grid = 0;
    if (grid == 0) {
        if (n_in != cf::N_IN || out_size != cf::NB * cf::S * cf::D || ws_size < cf::WS_END) {
            fprintf(stderr, "kernel_launch: unexpected shapes: n_in %d out %d ws %zu (need %zu)\n", n_in, out_size, ws_size, (size_t)cf::WS_END); grid = -1; return; }
        int dev = 0, cus = 0;
        if (hipGetDevice(&dev) != hipSuccess || hipDeviceGetAttribute(&cus, hipDeviceAttributeMultiprocessorCount, dev) != hipSuccess || cus < 1) { grid = -1; return; }
        if (hipFuncSetAttribute((const void*)mega_fwd, hipFuncAttributeMaxDynamicSharedMemorySize, cf::LDS_BYTES) != hipSuccess) { fprintf(stderr, "kernel_launch: hipFuncSetAttribute failed\n"); grid = -1; return; }
        int per_cu = 0;
        if (hipOccupancyMaxActiveBlocksPerMultiprocessor(&per_cu, (const void*)mega_fwd, 512, cf::LDS_BYTES) != hipSuccess || per_cu < 1)
            fprintf(stderr, "kernel_launch: note: occupancy query reports %d workgroups per CU\n", per_cu);
        (void)hipGetLastError();
        grid = cus;
    }
    if (grid < 0) return;
    (void)hipMemsetAsync((char*)d_ws + cf::WS_CTL, 0, cf::CTL_BYTES, stream);
    Params p{};
    for (int i = 0; i < cf::N_IN; ++i) p.in[i] = (const float*)d_in[i];
    p.out = (float*)d_out; p.ws = (unsigned char*)d_ws;
#if MK_PER_PHASE
    for (int k = 0; k < cf::N_PHASES; ++k) { p.ph_lo = k; p.ph_hi = k + 1; hipLaunchKernelGGL(mega_fwd, dim3(grid), dim3(512), cf::LDS_BYTES, stream, p); }
#else
    p.ph_lo = 0; p.ph_hi = cf::N_PHASES;
    hipLaunchKernelGGL(mega_fwd, dim3(grid), dim3(512), cf::LDS_BYTES, stream, p);
#endif
    const hipError_t le = hipPeekAtLastError();
    if (le != hipSuccess) fprintf(stderr, "kernel_launch: launch failed: %s\n", hipGetErrorName(le));
}
```

```cpp
#include <hip/hip_runtime.h>
#include <stdint.h>
#include <stdio.h>

#ifndef MK_DUP
#define MK_DUP 0
#endif
#define DUPN(k) (((MK_DUP >> (k)) & 1) ? 2 : 1)
#ifndef MK_AV
#define MK_AV 0
#endif
#ifndef MK_PER_PHASE
#define MK_PER_PHASE 0
#endif

namespace cf {
constexpr int D = 2048, NB = 4, S = 4096, CTX = 256, RB = CTX + S  , MR = NB * RB  ;
constexpr int DEPTH = 2;
constexpr int PC_AK = 0, PC_AV = 256, PC_CKV = 512, PC_KR = 768, PC_DK = 1024, PC_DV = 1280, PC_KVEND = 1536;
constexpr int PC_AQ = 1536, PC_CQ = 2560, PC_DQ = 3072, PC_GLU = 4096, PC_GATE = 6144, NC = 14336;
constexpr int IN_COLS = 14144;
constexpr int NEXP = 16384;
constexpr float ALPHA = 1.4142135623730951f;
constexpr float LOG2E = 1.4426950408889634f;
constexpr float SCALE_HD = 0.08838834764831845f;
constexpr float SCALE_MLA = 0.07216878364870323f;
enum { I_X = 0, I_C, I_CTX, I_CCTX, I_WADA, I_BADA, I_WIN, I_AQN, I_AKN, I_BQN, I_WQUP, I_BKVN, I_WKVUP, I_CW, I_CB, I_CLG, I_CLB, I_SINK,
       I_WBRA, I_WBRB, I_WBRC, I_WBRD, I_WO, I_LN1G, I_LN1B, I_LN2G, I_LN2B, I_PWQ, I_PSK, I_PU, I_PV, N_IN };
constexpr size_t al(size_t x) { return (x + 255) / 256 * 256; }
constexpr size_t WS_CTL = 0;
constexpr size_t CTL_BYTES = 65536;
constexpr size_t WS_MOD = WS_CTL + CTL_BYTES;
constexpr size_t WS_COSH = WS_MOD + al((size_t)2 * 5 * 12288 * 4);
constexpr size_t WS_SINH = WS_COSH + (size_t)4096 * 64 * 4;
constexpr size_t WS_COSR = WS_SINH + (size_t)4096 * 64 * 4;
constexpr size_t WS_SINR = WS_COSR + (size_t)4096 * 32 * 4;
constexpr size_t WS_WIN = WS_SINR + (size_t)4096 * 32 * 4;
constexpr size_t WS_WQUP = WS_WIN + (size_t)2 * NC * 2048 * 2;
constexpr size_t WS_WKVUP = WS_WQUP + (size_t)2 * 1536 * 512 * 2;
constexpr size_t WS_WBR = WS_WKVUP + (size_t)2 * 2048 * 256 * 2;
constexpr size_t WS_WO = WS_WBR + (size_t)2 * 4 * 2048 * 1024 * 2;
constexpr size_t WS_WFOLD = WS_WO + (size_t)2 * 2048 * 2048 * 2;
constexpr size_t WS_UB = WS_WFOLD + (size_t)2 * 2048 * 2048 * 2;
constexpr size_t WS_VB2 = WS_UB + (size_t)2 * NEXP * 2048;
constexpr size_t WS_HB = WS_VB2 + (size_t)2 * NEXP * 2048;
constexpr size_t WS_P = WS_HB + (size_t)MR * 2048 * 2;
constexpr size_t WS_QB = WS_P + (size_t)MR * NC * 2;
constexpr size_t WS_KB = WS_QB + (size_t)MR * 1536 * 2;
constexpr size_t WS_VB = WS_KB + (size_t)MR * 1536 * 2;
constexpr size_t WS_BR = WS_VB + (size_t)MR * 1024 * 2;
constexpr size_t WS_XC = WS_BR + (size_t)MR * 4096 * 2;
constexpr size_t WS_SSK = WS_XC + (size_t)1024 * 2048 * 4;
constexpr size_t WS_SSQ = WS_SSK + (size_t)MR * 4 * 4;
constexpr size_t WS_SSKV = WS_SSQ + (size_t)MR * 16 * 4;
constexpr size_t WS_SSCQ = WS_SSKV + (size_t)MR * 4 * 4;
constexpr size_t WS_END = WS_SSCQ + (size_t)MR * 8 * 4;
constexpr size_t X1_OFF = 0, SC_OFF = (size_t)MR * 2048 * 4;
static_assert(SC_OFF * 2 <= (size_t)MR * NC * 2, "X1 + SC fit in P");
constexpr int LDS_BYTES = 132 * 1024;
constexpr int MISC_OFF = 128 * 1024;
constexpr int N_PHASES = 2 + 8 * DEPTH;
}

typedef unsigned short bf16_t;
typedef short bf16x8 __attribute__((ext_vector_type(8)));
typedef float f32x4 __attribute__((ext_vector_type(4)));
typedef float f32x2 __attribute__((ext_vector_type(2)));
typedef unsigned u32x4 __attribute__((ext_vector_type(4)));
typedef unsigned u32x2 __attribute__((ext_vector_type(2)));
#define LAS __attribute__((address_space(3)))
typedef LAS unsigned char* ldsp_t;

__device__ __forceinline__ unsigned cvt_pk_bf16(float lo, float hi) { unsigned r; asm volatile("v_cvt_pk_bf16_f32 %0, %1, %2" : "=v"(r) : "v"(lo), "v"(hi)); return r; }
__device__ __forceinline__ bf16_t f2bf(float f) { return (bf16_t)(cvt_pk_bf16(f, 0.f) & 0xffffu); }
__device__ __forceinline__ float bf2f(bf16_t b) { return __uint_as_float(((unsigned)b) << 16); }
__device__ __forceinline__ float bflo(unsigned w) { return __uint_as_float(w << 16); }
__device__ __forceinline__ float bfhi(unsigned w) { return __uint_as_float(w & 0xffff0000u); }
__device__ __forceinline__ float shx(float v, int mask, int lane) { return __int_as_float(__builtin_amdgcn_ds_bpermute((lane ^ mask) << 2, __float_as_int(v))); }
__device__ __forceinline__ float wave_sum(float v, int lane) {
#pragma unroll
    for (int o = 32; o >= 1; o >>= 1) v += shx(v, o, lane);
    return v;
}
__device__ __forceinline__ int lane_id() { int l; asm volatile("v_mbcnt_lo_u32_b32 %0, -1, 0\n\tv_mbcnt_hi_u32_b32 %0, -1, %0" : "=v"(l)); return l; }
__device__ __forceinline__ float sigmoidf_(float x) { return 1.0f / (1.0f + __expf(-x)); }

#define XB_TMO      128
#define XB_XCNT(j)  (256  + 64 * (j))
#define XB_XSUB(j)  (1280 + 64 * (j))
#define XB_XGEN(j)  (2304 + 64 * (j))
#define XB_TOP      3328
#define XB_TOPGEN   3392
#define XCD_BAR_WORDS 3456
#define XB_SPIN_CAP (1u << 23)
__device__ __forceinline__ unsigned xb_ld(unsigned* p)              { return __hip_atomic_load(p, __ATOMIC_RELAXED, __HIP_MEMORY_SCOPE_AGENT); }
__device__ __forceinline__ unsigned xb_add(unsigned* p, unsigned v) { return __hip_atomic_fetch_add(p, v, __ATOMIC_RELAXED, __HIP_MEMORY_SCOPE_AGENT); }
__device__ __forceinline__ unsigned xb_xcc_id() { return (unsigned)__builtin_amdgcn_s_getreg((3 << 11) | 20) & 0xFu; }
#define XB_SPIN(cond, bar) do { unsigned _sp = 0; while (cond) { __builtin_amdgcn_s_sleep(1); \
    if ((++_sp & 255u) == 0u) { if (xb_ld(&(bar)[XB_TMO])) break; if (_sp > XB_SPIN_CAP) { atomicAdd(&(bar)[XB_TMO], 1u); break; } } } } while (0)
struct XcdBarrier { unsigned* bar; unsigned x; volatile LAS unsigned* st; int wave; };
__device__ __forceinline__ XcdBarrier xcd_barrier_post(unsigned* bar, volatile LAS unsigned* st, int wave) {
    XcdBarrier b; b.bar = bar; b.x = xb_xcc_id(); b.st = st; b.wave = wave;
    if (wave == 0 && lane_id() == 0) (void)xb_add(&bar[XB_XCNT(b.x)], 1u);
    return b;
}
__device__ __forceinline__ void xcd_barrier_complete(unsigned* bar, unsigned x, unsigned& nloc, unsigned& nx) {
    const unsigned G = gridDim.x * gridDim.y * gridDim.z;
    unsigned sum, cnt, mine, sp = 0u;
    for (;;) {
        sum = 0u; cnt = 0u; mine = 0u;
#pragma unroll
        for (unsigned j = 0; j < 16; ++j) { const unsigned c = xb_ld(&bar[XB_XCNT(j)]); sum += c; cnt += (c > 0u) ? 1u : 0u; mine = (j == x) ? c : mine; }
        if (sum == G) break;
        __builtin_amdgcn_s_sleep(1);
        if ((++sp & 255u) == 0u) { if (xb_ld(&bar[XB_TMO])) break; if (sp > XB_SPIN_CAP) { atomicAdd(&bar[XB_TMO], 1u); break; } }
    }
    nloc = mine > 0u ? mine : 1u; nx = cnt > 0u ? cnt : 1u;
}
__device__ __forceinline__ void xcd_barrier(const XcdBarrier& b) {
    asm volatile("s_waitcnt vmcnt(0)" ::: "memory");
    __syncthreads();
    if (b.wave == 0 && lane_id() == 0) {
        unsigned* bar = b.bar;
        __builtin_amdgcn_s_waitcnt(0);
        unsigned nloc = b.st[0], nx = b.st[1];
        if (nloc == 0u) { xcd_barrier_complete(bar, b.x, nloc, nx); b.st[0] = nloc; b.st[1] = nx; }
        const unsigned old = xb_add(&bar[XB_XSUB(b.x)], 1u);
        const unsigned gen = old / nloc;
        if (old + 1u == (gen + 1u) * nloc) {
            __builtin_amdgcn_fence(__ATOMIC_RELEASE, "agent");
            asm volatile("s_waitcnt vmcnt(0)" ::: "memory");
            const unsigned og = xb_add(&bar[XB_TOP], 1u);
            const unsigned tg = og / nx;
            if (og + 1u == (tg + 1u) * nx) xb_add(&bar[XB_TOPGEN], 1u);
            else XB_SPIN(xb_ld(&bar[XB_TOPGEN]) == tg, bar);
            __builtin_amdgcn_fence(__ATOMIC_ACQUIRE, "agent");
            xb_add(&bar[XB_XGEN(b.x)], 1u);
            asm volatile("s_waitcnt vmcnt(0)" ::: "memory");
        } else {
            XB_SPIN(xb_ld(&bar[XB_XGEN(b.x)]) == gen, bar);
            __builtin_amdgcn_fence(__ATOMIC_ACQUIRE, "agent");
            asm volatile("s_waitcnt vmcnt(0)" ::: "memory");
        }
    }
    __syncthreads();
}

namespace pg8 {
constexpr int BM = 256, BK = 64, HALF = 128, HTB = HALF * BK * 2, STAGE_BYTES = 8 * HTB, NXCD = 8, WGM = 8;
__host__ __device__ __forceinline__ int lds_byte(int r, int c) { const int st = (r >> 4) * 2 + (c >> 5), rr = r & 15, cc = c & 31, ob = rr * 64 + cc * 2; return st * 1024 + (ob ^ (((ob >> 9) & 1) << 5)); }
__host__ __device__ __forceinline__ void stage_rc(int b, int& R, int& C) { const int st = b / 1024, sb = b % 1024, swz = sb ^ (((sb >> 9) & 1) << 5); R = (st >> 1) * 16 + swz / 64; C = (st & 1) * 32 + (swz % 64) / 2; }
__host__ __device__ __forceinline__ int perm32(int rho) { const int n = rho >> 4, i = rho & 15; return 8 * (i >> 2) + 4 * n + (i & 3); }
struct Unit { int pm, pn, sub; };
struct Gemm { const bf16_t* A; const bf16_t* Bt; int lda, K; };

struct TileOrder {
    int nM, nN, nwg, G, c, mode, nsub; size_t subA, subB;
    __device__ void init(int nM_, int nN_, int G_, int c_, int mode_, int nsub_ = 1, size_t subA_ = 0, size_t subB_ = 0) { nM = nM_; nN = nN_; nwg = nM * nN; G = G_; c = c_; mode = mode_; nsub = nsub_; subA = subA_; subB = subB_; }
    __device__ bool next(int i, Unit& u) const {
        const int it = nsub == 1 ? i : i / nsub; u.sub = nsub == 1 ? 0 : i - it * nsub;
        const long L = (long)it * G + c; if (L >= nwg) return false;
        int wgid = (int)L; { const int q = nwg / NXCD, r = nwg % NXCD, xcd = wgid % NXCD, off = wgid / NXCD; wgid = (xcd < r ? xcd * (q + 1) : r * (q + 1) + (xcd - r) * q) + off; }
        const int nig = WGM * nN, gid = wgid / nig, fm = gid * WGM, gsz = (nM - fm) < WGM ? (nM - fm) : WGM;
        const int pl = fm + ((wgid % nig) % gsz); u.pn = (wgid % nig) / gsz;
        u.pm = mode == 0 ? pl : (mode == 1 ? 17 * (pl >> 4) + 1 + (pl & 15) : 17 * pl);
        return true;
    }
    __device__ __forceinline__ void a_ready(const Unit&) const {}
    __device__ __forceinline__ void done(const Unit&) const {}
};

template <class Epi, class Sched>
__device__ __forceinline__ void gemm_phase(ldsp_t lds, const Gemm g, const Sched& S, const Epi& E, int wave_) {
    int tid = wave_ * 64 + lane_id(); asm volatile("" : "+v"(tid));
    const int wid = __builtin_amdgcn_readfirstlane(tid >> 6), lane = tid & 63, wr = wid >> 2, wc = wid & 3, fr = lane & 15, fq = lane >> 4;
    int K = g.K; asm volatile("" : "+s"(K));
    const int nt = K / BK, lda = g.lda;
    unsigned voffA[2], voffB[2];
#pragma unroll
    for (int i = 0; i < 2; ++i) { int R, C; stage_rc(tid * 16 + i * 8192, R, C); const int Rb = (R & ~31) + perm32(R & 31);
        voffA[i] = (unsigned)(R * lda + C) * 2u; voffB[i] = (unsigned)(Rb * K + C) * 2u; }
    const size_t kstep = (size_t)(BK * 2);
    const size_t hstepA = (size_t)HALF * lda * 2, hstepB = (size_t)HALF * K * 2;
    const size_t tstepA = 2 * hstepA, tstepB = 2 * hstepB;
    const unsigned ldsw = (unsigned)wid * 1024u;
    const int aoff = lds_byte(wr * 64 + fr, fq * 8), boff = lds_byte(wc * 32 + fr, fq * 8);
#define PG8_SA(b, h) (((b) * 2 + (h)) * HTB)
#define PG8_SB(b, h) ((4 + (b) * 2 + (h)) * HTB)
#define PG8_STAGE(bufoff, gbase, voff) do { _Pragma("unroll") for (int _i = 0; _i < 2; ++_i) \
        __builtin_amdgcn_global_load_lds((const unsigned*)((const char*)(gbase) + (voff)[_i]), (LAS unsigned*)(lds + (bufoff) + ldsw + _i * 8192), 16, 0, 0); } while (0)
#define PG8_LDA(dst, b, h) do { _Pragma("unroll") for (int m = 0; m < 4; ++m) _Pragma("unroll") for (int k = 0; k < 2; ++k) dst[m][k] = *(const LAS bf16x8*)(lds + PG8_SA(b, h) + aoff + m * 2048 + k * 1024); } while (0)
#define PG8_LDB(dst, b, h) do { _Pragma("unroll") for (int n = 0; n < 2; ++n) _Pragma("unroll") for (int k = 0; k < 2; ++k) dst[n][k] = *(const LAS bf16x8*)(lds + PG8_SB(b, h) + boff + n * 2048 + k * 1024); } while (0)
#define PG8_MMA(ai, bj, At, Bt) do { __builtin_amdgcn_s_setprio(1); _Pragma("unroll") for (int m = 0; m < 4; ++m) _Pragma("unroll") for (int n = 0; n < 2; ++n) _Pragma("unroll") for (int k = 0; k < 2; ++k) \
        acc[ai][bj][m][n] = __builtin_amdgcn_mfma_f32_16x16x32_bf16(Bt[n][k], At[m][k], acc[ai][bj][m][n], 0, 0, 0); __builtin_amdgcn_s_setprio(0); } while (0)
#define PG8_WAIT_V(n) asm volatile("s_waitcnt vmcnt(" #n ")" ::: "memory")
#define PG8_WAIT_L(n) asm volatile("s_waitcnt lgkmcnt(" #n ")" ::: "memory")
#define PG8_BAR __builtin_amdgcn_s_barrier()
#define PG8_SCHED __builtin_amdgcn_sched_barrier(0)
    Unit cur, nxt; int ui = 0;
    if (!S.next(0, cur)) return;
    f32x4 acc[2][2][4][2];
#pragma unroll
    for (int a = 0; a < 2; ++a)
#pragma unroll
        for (int b = 0; b < 2; ++b)
#pragma unroll
            for (int m = 0; m < 4; ++m)
#pragma unroll
                for (int n = 0; n < 2; ++n) acc[a][b][m][n] = (f32x4){0.f, 0.f, 0.f, 0.f};
    bf16x8 At[4][2], B0[2][2], B1[2][2];
    const char* cA = (const char*)g.A + (size_t)cur.pm * tstepA + cur.sub * S.subA; const char* cB = (const char*)g.Bt + (size_t)cur.pn * tstepB + cur.sub * S.subB;
    S.a_ready(cur);
    PG8_STAGE(PG8_SB(0, 0), cB, voffB); PG8_STAGE(PG8_SA(0, 0), cA, voffA); PG8_STAGE(PG8_SB(0, 1), cB + hstepB, voffB); PG8_STAGE(PG8_SA(0, 1), cA + hstepA, voffA);
    if (wr == 1) PG8_BAR;
    PG8_WAIT_V(4); PG8_BAR;
    PG8_STAGE(PG8_SB(1, 0), cB + kstep, voffB); PG8_STAGE(PG8_SA(1, 0), cA + kstep, voffA); PG8_STAGE(PG8_SB(1, 1), cB + hstepB + kstep, voffB);
    PG8_WAIT_V(6); PG8_BAR;
    for (;;) {
        const bool has_next = S.next(ui + 1, nxt);
        const char* nA = has_next ? (const char*)g.A + (size_t)nxt.pm * tstepA + nxt.sub * S.subA : cA; const char* nB = has_next ? (const char*)g.Bt + (size_t)nxt.pn * tstepB + nxt.sub * S.subB : cB;
#pragma unroll 1
        for (int t = 0; t < nt; t += 2) {
            const bool last = (t == nt - 2);
            const char* a1 = cA + (size_t)(t + 1) * kstep;
            const char* a2 = last ? nA : cA + (size_t)(t + 2) * kstep; const char* b2 = last ? nB : cB + (size_t)(t + 2) * kstep;
            const char* a3 = a2 + kstep; const char* b3 = b2 + kstep;
            if (last && has_next) S.a_ready(nxt);
            PG8_LDB(B0, 0, 0); PG8_SCHED; PG8_LDA(At, 0, 0); PG8_STAGE(PG8_SA(1, 1), a1 + hstepA, voffA);
            PG8_WAIT_L(8); PG8_BAR; PG8_WAIT_L(0); PG8_MMA(0, 0, At, B0); PG8_BAR; PG8_SCHED;
            PG8_LDB(B1, 0, 1); PG8_STAGE(PG8_SB(0, 0), b2, voffB);
            PG8_BAR; PG8_WAIT_L(0); PG8_MMA(0, 1, At, B1); PG8_BAR;
            PG8_LDA(At, 0, 1); PG8_STAGE(PG8_SA(0, 0), a2, voffA);
            PG8_BAR; PG8_WAIT_L(0); PG8_MMA(1, 0, At, B0); PG8_BAR; PG8_SCHED;
            PG8_STAGE(PG8_SB(0, 1), b2 + hstepB, voffB);
            PG8_WAIT_V(6); PG8_BAR; PG8_MMA(1, 1, At, B1); PG8_BAR;
            PG8_LDB(B0, 1, 0); PG8_SCHED; PG8_LDA(At, 1, 0); PG8_STAGE(PG8_SA(0, 1), a2 + hstepA, voffA);
            PG8_WAIT_L(8); PG8_BAR; PG8_WAIT_L(0); PG8_MMA(0, 0, At, B0); PG8_BAR; PG8_SCHED;
            PG8_LDB(B1, 1, 1); PG8_STAGE(PG8_SB(1, 0), b3, voffB);
            PG8_BAR; PG8_WAIT_L(0); PG8_MMA(0, 1, At, B1); PG8_BAR;
            PG8_LDA(At, 1, 1); PG8_STAGE(PG8_SA(1, 0), a3, voffA);
            PG8_BAR; PG8_WAIT_L(0); PG8_MMA(1, 0, At, B0); PG8_BAR; PG8_SCHED;
            PG8_STAGE(PG8_SB(1, 1), b3 + hstepB, voffB);
            PG8_WAIT_V(6); PG8_BAR; PG8_MMA(1, 1, At, B1); PG8_BAR;
        }
        E(acc, cur, wr, wc, fr, fq); S.done(cur);
        if (!has_next) break;
#pragma unroll
        for (int a = 0; a < 2; ++a)
#pragma unroll
            for (int b = 0; b < 2; ++b)
#pragma unroll
                for (int m = 0; m < 4; ++m)
#pragma unroll
                    for (int n = 0; n < 2; ++n) acc[a][b][m][n] = (f32x4){0.f, 0.f, 0.f, 0.f};
        cur = nxt; cA = nA; cB = nB; ++ui;
    }
    PG8_WAIT_V(0);
    if (wr == 0) PG8_BAR;
    PG8_BAR;
#undef PG8_SA
#undef PG8_SB
#undef PG8_STAGE
#undef PG8_LDA
#undef PG8_LDB
#undef PG8_MMA
#undef PG8_WAIT_V
#undef PG8_WAIT_L
#undef PG8_BAR
#undef PG8_SCHED
}

__device__ __forceinline__ u32x4 pack8(const f32x4 a, const f32x4 b) { u32x4 w; w.x = cvt_pk_bf16(a[0], a[1]); w.y = cvt_pk_bf16(a[2], a[3]); w.z = cvt_pk_bf16(b[0], b[1]); w.w = cvt_pk_bf16(b[2], b[3]); return w; }
#define EPI_ARGS const f32x4 (&acc)[2][2][4][2], const Unit& u, int wr, int wc, int fr_, int fq_
#define EPI_LANE int fr = fr_, fq = fq_; asm volatile("" : "+v"(fr), "+v"(fq));

struct EpiBf16 {
    bf16_t* O; int ldc;
    __device__ __forceinline__ void operator()(EPI_ARGS) const {
        EPI_LANE
        const int row0 = u.pm * BM + wr * 64 + fr, col0 = u.pn * BM + wc * 32 + 8 * fq;
#pragma unroll
        for (int ai = 0; ai < 2; ++ai)
#pragma unroll
            for (int m = 0; m < 4; ++m) { bf16_t* rowp = O + (size_t)(row0 + ai * HALF + m * 16) * ldc + col0;
#pragma unroll
                for (int bj = 0; bj < 2; ++bj) *(u32x4*)(rowp + bj * HALF) = pack8(acc[ai][bj][m][0], acc[ai][bj][m][1]); }
    }
};
struct EpiF32 {
    float* C; int ldc;
    __device__ __forceinline__ void operator()(EPI_ARGS) const {
        EPI_LANE
        const int row0 = u.pm * BM + wr * 64 + fr, col0 = u.pn * BM + wc * 32 + 8 * fq;
#pragma unroll
        for (int ai = 0; ai < 2; ++ai)
#pragma unroll
            for (int m = 0; m < 4; ++m) { float* rowp = C + (size_t)(row0 + ai * HALF + m * 16) * ldc + col0;
#pragma unroll
                for (int bj = 0; bj < 2; ++bj) { *(f32x4*)(rowp + bj * HALF) = acc[ai][bj][m][0]; *(f32x4*)(rowp + bj * HALF + 4) = acc[ai][bj][m][1]; } }
    }
};
struct EpiInProj {
    bf16_t* P; bf16_t* KB; const float* cosh; const float* sinh; const float* cosr; const float* sinr; const float* akn; const float* aqn;
    float* ssk; float* ssq; float* sskv; float* sscq;
    __device__ __forceinline__ void operator()(EPI_ARGS) const {
        EPI_LANE
        const int pn = u.pn, tb = u.pm % 17; const bool lat = tb != 0; const int posbase = (tb - 1) * 256;
        const int rl0 = wr * 64 + fr;
        if (pn >= 24) {
            const int col0 = pn * BM + wc * 32 + 8 * fq;
#pragma unroll
            for (int ai = 0; ai < 2; ++ai)
#pragma unroll
                for (int m = 0; m < 4; ++m) { bf16_t* rowp = P + ((size_t)u.pm * BM + rl0 + ai * HALF + m * 16) * cf::NC + col0;
#pragma unroll
                    for (int bj = 0; bj < 2; ++bj) { f32x4 v0 = acc[ai][bj][m][0], v1 = acc[ai][bj][m][1];
#pragma unroll
                        for (int e = 0; e < 4; ++e) { v0[e] = sigmoidf_(v0[e]); v1[e] = sigmoidf_(v1[e]); }
                        *(u32x4*)(rowp + bj * HALF) = pack8(v0, v1); } }
        } else if (pn >= 16) {
            const int col0 = cf::PC_GLU + 128 * (pn - 16) + wc * 32 + 8 * fq;
#pragma unroll
            for (int ai = 0; ai < 2; ++ai)
#pragma unroll
                for (int m = 0; m < 4; ++m) { f32x4 v0 = acc[ai][0][m][0], v1 = acc[ai][0][m][1]; const f32x4 g0 = acc[ai][1][m][0], g1 = acc[ai][1][m][1];
#pragma unroll
                    for (int e = 0; e < 4; ++e) { v0[e] *= sigmoidf_(g0[e]); v1[e] *= sigmoidf_(g1[e]); }
                    *(u32x4*)(P + ((size_t)u.pm * BM + rl0 + ai * HALF + m * 16) * cf::NC + col0) = pack8(v0, v1); }
        } else if (pn == 3) {
            if (wc == 0) { const int i0 = 8 * fq;
#pragma unroll
                for (int ai = 0; ai < 2; ++ai)
#pragma unroll
                    for (int m = 0; m < 4; ++m) { const int rl = rl0 + ai * HALF + m * 16;
                        f32x4 c0 = {1.f, 1.f, 1.f, 1.f}, c1 = c0, s0 = {0.f, 0.f, 0.f, 0.f}, s1 = s0;
                        if (lat) { const float* cp = cosr + (size_t)(posbase + rl) * 32 + i0; const float* sp = sinr + (size_t)(posbase + rl) * 32 + i0;
                            c0 = *(const f32x4*)cp; c1 = *(const f32x4*)(cp + 4); s0 = *(const f32x4*)sp; s1 = *(const f32x4*)(sp + 4); }
                        const f32x4 x1a = acc[ai][0][m][0], x1b = acc[ai][0][m][1], x2a = acc[ai][1][m][0], x2b = acc[ai][1][m][1];
                        const u32x4 w1 = pack8(x1a * c0 - x2a * s0, x1b * c1 - x2b * s1), w2 = pack8(x2a * c0 + x1a * s0, x2b * c1 + x1b * s1);
                        bf16_t* kb = KB + ((size_t)u.pm * BM + rl) * 1536 + 128 + i0;
#pragma unroll
                        for (int h = 0; h < 8; ++h) { *(u32x4*)(kb + h * 192) = w1; *(u32x4*)(kb + h * 192 + 32) = w2; }
                        asm volatile("" ::: "memory"); } }
        } else if (pn == 0 || pn == 4 || (pn >= 6 && pn <= 9) || pn >= 12) {
            const bool norm = pn == 0 || (pn >= 6 && pn <= 9);
            const int hl = wc >> 1, i0 = 32 * (wc & 1) + 8 * fq;
            f32x4 g1a = {1.f, 1.f, 1.f, 1.f}, g1b = g1a, g2a = g1a, g2b = g1a;
            if (norm) { const float* gn = (pn == 0 ? akn : aqn) + i0; g1a = *(const f32x4*)gn; g1b = *(const f32x4*)(gn + 4); g2a = *(const f32x4*)(gn + 64); g2b = *(const f32x4*)(gn + 68); }
            float* ssp = pn == 0 ? ssk + ((size_t)u.pm * BM * 2 + hl) * 2 + (wc & 1) : ssq + ((size_t)u.pm * BM * 8 + (pn - 6) * 2 + hl) * 2 + (wc & 1);
            const int sstr = pn == 0 ? 4 : 16;
#pragma unroll
            for (int ai = 0; ai < 2; ++ai)
#pragma unroll
                for (int m = 0; m < 4; ++m) { const int rl = rl0 + ai * HALF + m * 16;
                    f32x4 x1a = acc[ai][0][m][0], x1b = acc[ai][0][m][1], x2a = acc[ai][1][m][0], x2b = acc[ai][1][m][1];
                    if (norm) { const f32x4 q = x1a * x1a + x1b * x1b + x2a * x2a + x2b * x2b; float ss = (q[0] + q[1]) + (q[2] + q[3]);
                        ss += shx(ss, 16, fr + 16 * fq); ss += shx(ss, 32, fr + 16 * fq);
                        if (fq == 0) ssp[(size_t)rl * sstr] = ss;
                        x1a *= g1a; x1b *= g1b; x2a *= g2a; x2b *= g2b; }
                    f32x4 o1a = x1a, o1b = x1b, o2a = x2a, o2b = x2b;
                    if (lat) { const float* cp = cosh + (size_t)(posbase + rl) * 64 + i0; const float* sp = sinh + (size_t)(posbase + rl) * 64 + i0;
                        const f32x4 c0 = *(const f32x4*)cp, c1 = *(const f32x4*)(cp + 4), s0 = *(const f32x4*)sp, s1 = *(const f32x4*)(sp + 4);
                        o1a = x1a * c0 - x2a * s0; o1b = x1b * c1 - x2b * s1; o2a = x2a * c0 + x1a * s0; o2b = x2b * c1 + x1b * s1; }
                    bf16_t* dst = P + ((size_t)u.pm * BM + rl) * cf::NC + pn * BM + hl * 128 + i0;
                    *(u32x4*)dst = pack8(o1a, o1b); *(u32x4*)(dst + 64) = pack8(o2a, o2b);
                    asm volatile("" ::: "memory"); }
        } else {
            const int col0 = pn * BM + wc * 32 + 8 * fq;
            const bool ssq_on = pn == 2 || pn == 10 || pn == 11;
            float* ssp = pn == 2 ? sskv + (size_t)u.pm * BM * 4 + wc : sscq + (size_t)u.pm * BM * 8 + (pn - 10) * 4 + wc;
            const int sstr = pn == 2 ? 4 : 8;
#pragma unroll
            for (int ai = 0; ai < 2; ++ai)
#pragma unroll
                for (int m = 0; m < 4; ++m) { const int rl = rl0 + ai * HALF + m * 16; bf16_t* rowp = P + ((size_t)u.pm * BM + rl) * cf::NC + col0;
#pragma unroll
                    for (int bj = 0; bj < 2; ++bj) *(u32x4*)(rowp + bj * HALF) = pack8(acc[ai][bj][m][0], acc[ai][bj][m][1]);
                    if (ssq_on) { const f32x4 q = acc[ai][0][m][0] * acc[ai][0][m][0] + acc[ai][0][m][1] * acc[ai][0][m][1] + acc[ai][1][m][0] * acc[ai][1][m][0] + acc[ai][1][m][1] * acc[ai][1][m][1];
                        float ss = (q[0] + q[1]) + (q[2] + q[3]); ss += shx(ss, 16, fr + 16 * fq); ss += shx(ss, 32, fr + 16 * fq);
                        if (fq == 0) ssp[(size_t)rl * sstr] = ss; } }
        }
    }
};
struct EpiKvUp {
    bf16_t* KB; bf16_t* VB; const float* sskv;
    __device__ __forceinline__ void operator()(EPI_ARGS) const {
        EPI_LANE
        const int row0 = u.pm * BM + wr * 64 + fr, d0 = wc * 32 + 8 * fq;
        const bool isk = u.pn < 4;
        bf16_t* base = isk ? KB + (2 * u.pn) * 192 + d0 : VB + (u.pn - 4) * 256 + d0;
        const int ldr = isk ? 1536 : 1024, bjs = isk ? 192 : 128;
#pragma unroll
        for (int ai = 0; ai < 2; ++ai)
#pragma unroll
            for (int m = 0; m < 4; ++m) { const size_t row = (size_t)(row0 + ai * HALF + m * 16); bf16_t* rowp = base + row * ldr;
                const f32x4 pp = *(const f32x4*)(sskv + row * 4); const float r = rsqrtf(((pp[0] + pp[1]) + (pp[2] + pp[3])) * (1.f / 256.f) + 1e-6f);
#pragma unroll
                for (int bj = 0; bj < 2; ++bj) *(u32x4*)(rowp + bj * bjs) = pack8(acc[ai][bj][m][0] * r, acc[ai][bj][m][1] * r); }
    }
};
struct EpiQUp {
    bf16_t* QB; const float* cosr; const float* sinr; const float* sscq;
    __device__ __forceinline__ void operator()(EPI_ARGS) const {
        EPI_LANE
        const int row0 = u.pm * BM + wr * 64 + fr;
        if (u.pn < 4) {
            const int d0 = wc * 32 + 8 * fq;
#pragma unroll
            for (int ai = 0; ai < 2; ++ai)
#pragma unroll
                for (int m = 0; m < 4; ++m) { const size_t row = (size_t)(row0 + ai * HALF + m * 16);
                    const f32x4 pa = *(const f32x4*)(sscq + row * 8), pb = *(const f32x4*)(sscq + row * 8 + 4);
                    const float r = rsqrtf((((pa[0] + pa[1]) + (pa[2] + pa[3])) + ((pb[0] + pb[1]) + (pb[2] + pb[3]))) * (1.f / 512.f) + 1e-6f);
#pragma unroll
                    for (int bj = 0; bj < 2; ++bj) *(u32x4*)(QB + row * 1536 + (2 * u.pn + bj) * 192 + d0) = pack8(acc[ai][bj][m][0] * r, acc[ai][bj][m][1] * r); }
        } else {
            const int head = 4 * (u.pn - 4) + wc, i0 = 8 * fq;
            const bool lat = (u.pm % 17) != 0; const int posbase = (u.pm % 17) * 256 - 256;
#pragma unroll
            for (int ai = 0; ai < 2; ++ai)
#pragma unroll
                for (int m = 0; m < 4; ++m) { const int rl = wr * 64 + fr + ai * HALF + m * 16; const size_t row = (size_t)u.pm * BM + rl;
                    const f32x4 pa = *(const f32x4*)(sscq + row * 8), pb = *(const f32x4*)(sscq + row * 8 + 4);
                    const float r = rsqrtf((((pa[0] + pa[1]) + (pa[2] + pa[3])) + ((pb[0] + pb[1]) + (pb[2] + pb[3]))) * (1.f / 512.f) + 1e-6f);
                    f32x4 c0 = {1.f, 1.f, 1.f, 1.f}, c1 = c0, s0 = {0.f, 0.f, 0.f, 0.f}, s1 = s0;
                    if (lat) { const float* cp = cosr + (size_t)(posbase + rl) * 32 + i0; const float* sp = sinr + (size_t)(posbase + rl) * 32 + i0;
                        c0 = *(const f32x4*)cp; c1 = *(const f32x4*)(cp + 4); s0 = *(const f32x4*)sp; s1 = *(const f32x4*)(sp + 4); }
                    const f32x4 x1a = acc[ai][0][m][0] * r, x1b = acc[ai][0][m][1] * r, x2a = acc[ai][1][m][0] * r, x2b = acc[ai][1][m][1] * r;
                    const f32x4 o1a = x1a * c0 - x2a * s0, o1b = x1b * c1 - x2b * s1, o2a = x2a * c0 + x1a * s0, o2b = x2b * c1 + x1b * s1;
                    bf16_t* dst = QB + row * 1536 + head * 192 + 128 + i0;
                    *(u32x4*)dst = pack8(o1a, o1b); *(u32x4*)(dst + 32) = pack8(o2a, o2b); asm volatile("" ::: "memory"); }
        }
    }
};
struct EpiMerge {
    bf16_t* ACC; const bf16_t* gate0; int ldg;
    __device__ __forceinline__ void operator()(EPI_ARGS) const {
        EPI_LANE
        const int row0 = u.pm * BM + wr * 64 + fr, col0 = u.pn * BM + wc * 32 + 8 * fq;
        const bf16_t* gate = gate0 + u.sub * 2048; const bool first = u.sub == 0;
#pragma unroll
        for (int ai = 0; ai < 2; ++ai) {
            u32x4 gw[4][2], pw[4][2];
#pragma unroll
            for (int m = 0; m < 4; ++m) { const size_t row = (size_t)(row0 + ai * HALF + m * 16);
#pragma unroll
                for (int bj = 0; bj < 2; ++bj) { const int col = col0 + bj * HALF; gw[m][bj] = *(const u32x4*)(gate + row * ldg + col);
                    pw[m][bj] = (u32x4){0u, 0u, 0u, 0u}; if (!first) pw[m][bj] = *(const u32x4*)(ACC + row * 2048 + col); } }
#pragma unroll
            for (int m = 0; m < 4; ++m) { const size_t row = (size_t)(row0 + ai * HALF + m * 16);
#pragma unroll
                for (int bj = 0; bj < 2; ++bj) { const int col = col0 + bj * HALF; const u32x4 g = gw[m][bj], p = pw[m][bj];
                    const f32x4 a0 = acc[ai][bj][m][0], a1 = acc[ai][bj][m][1];
                    f32x4 r0, r1;
                    r0[0] = bflo(p.x) + bflo(g.x) * a0[0]; r0[1] = bfhi(p.x) + bfhi(g.x) * a0[1]; r0[2] = bflo(p.y) + bflo(g.y) * a0[2]; r0[3] = bfhi(p.y) + bfhi(g.y) * a0[3];
                    r1[0] = bflo(p.z) + bflo(g.z) * a1[0]; r1[1] = bfhi(p.z) + bfhi(g.z) * a1[1]; r1[2] = bflo(p.w) + bflo(g.w) * a1[2]; r1[3] = bfhi(p.w) + bfhi(g.w) * a1[3];
                    *(u32x4*)(ACC + row * 2048 + col) = pack8(r0, r1); } }
            asm volatile("" ::: "memory"); }
    }
};
struct EpiWo {
    float* X1; const float* mod  ; const float* xlat  ; const float* xctx  ;
    __device__ __forceinline__ void operator()(EPI_ARGS) const {
        EPI_LANE
        const int b = u.pm / 17, tb = u.pm % 17; const bool isctx = tb == 0;
        const float* g1 = mod + (size_t)(isctx ? 4 : b) * 12288 + 2 * 2048;
        const float* xbase = isctx ? xctx + (size_t)b * cf::CTX * 2048 : xlat + ((size_t)b * cf::S + (size_t)(tb - 1) * 256) * 2048;
        const int rl0 = wr * 64 + fr, col0 = u.pn * BM + wc * 32 + 8 * fq;
        f32x4 gv[2][2];
#pragma unroll
        for (int bj = 0; bj < 2; ++bj) { gv[bj][0] = *(const f32x4*)(g1 + col0 + bj * HALF); gv[bj][1] = *(const f32x4*)(g1 + col0 + bj * HALF + 4); }
#pragma unroll
        for (int ai = 0; ai < 2; ++ai) {
            f32x4 xv[4][2][2];
#pragma unroll
            for (int m = 0; m < 4; ++m) { const int rl = rl0 + ai * HALF + m * 16;
#pragma unroll
                for (int bj = 0; bj < 2; ++bj) { const float* xp = xbase + (size_t)rl * 2048 + col0 + bj * HALF; xv[m][bj][0] = *(const f32x4*)xp; xv[m][bj][1] = *(const f32x4*)(xp + 4); } }
#pragma unroll
            for (int m = 0; m < 4; ++m) { const int rl = rl0 + ai * HALF + m * 16; float* op = X1 + ((size_t)u.pm * BM + rl) * 2048 + col0;
#pragma unroll
                for (int bj = 0; bj < 2; ++bj) { *(f32x4*)(op + bj * HALF) = xv[m][bj][0] * cf::ALPHA + gv[bj][0] * acc[ai][bj][m][0];
                    *(f32x4*)(op + bj * HALF + 4) = xv[m][bj][1] * cf::ALPHA + gv[bj][1] * acc[ai][bj][m][1]; } }
            asm volatile("" ::: "memory"); }
    }
};
}

struct Ctx {
    const float* const* in; float* out; unsigned char* ws;
    ldsp_t lds; int tid, lane, wave, G, bid;
};
#define WSP(T, off) ((T*)(F.ws + (off)))
__device__ __forceinline__ Ctx phase_ctx(const Ctx& F0) {
    Ctx C = F0;
    C.tid = F0.wave * 64 + lane_id();
    asm volatile("" : "+v"(C.tid));
    { size_t z = 0; asm volatile("" : "+s"(z)); C.ws = F0.ws + z; }
    C.lane = C.tid & 63; C.wave = __builtin_amdgcn_readfirstlane(C.tid >> 6);
    return C;
}

__device__ __forceinline__ int srcmap(int mode, int n) {
    if (mode == 0) {
        const int pn = n >> 8, q = n & 255, bj = q >> 7, r = q & 127, rope = (r >> 6) * 128 + bj * 64 + (r & 63);
        if (pn == 0) return rope;
        if (pn == 1) return 256 + q;
        if (pn == 2) return 512 + q;
        if (pn == 3) return r < 32 ? 768 + bj * 32 + r : -1;
        if (pn == 4) return 832 + rope;
        if (pn == 5) return 1088 + q;
        if (pn < 10) return 1344 + (pn - 6) * 256 + rope;
        if (pn < 12) return 2368 + (pn - 10) * 256 + q;
        if (pn < 16) return 2880 + (pn - 12) * 256 + rope;
        if (pn < 24) return 3904 + bj * 1024 + 128 * (pn - 16) + r;
        return 5952 + (n - 6144);
    }
    if (mode == 1) { if (n < 1024) return (n >> 7) * 192 + (n & 127);
        const int m = n - 1024, t = m >> 8, bj = (m >> 7) & 1, q = m & 127; return (4 * t + (q >> 5)) * 192 + 128 + bj * 32 + (q & 31); }
    if (mode == 2) { if (n < 1024) return (n >> 7) * 256 + (n & 127); const int m = n - 1024; return (m >> 7) * 256 + 128 + (m & 127); }
    return n;
}
__device__ __forceinline__ void tr_tile(const Ctx& F, const float* src, int ld_src, int mode, int k0, bf16_t* dst, int ldd, int n0, const float* kscale = nullptr) {
    LAS float* T = (LAS float*)F.lds;
    const int kr = F.tid >> 6, nc = (F.tid & 63) * 4, sc = srcmap(mode, n0 + nc);
    f32x4 v[8];
#pragma unroll
    for (int h = 0; h < 8; ++h) { v[h] = (f32x4){0.f, 0.f, 0.f, 0.f}; if (sc >= 0) v[h] = *(const f32x4*)(src + (size_t)(k0 + kr + 8 * h) * ld_src + sc); }
#pragma unroll
    for (int h = 0; h < 8; ++h) { const int k = kr + 8 * h; f32x4 x = v[h]; if (kscale) x = x * kscale[k0 + k];
        T[k * 257 + nc + 0] = x[0]; T[k * 257 + nc + 1] = x[1]; T[k * 257 + nc + 2] = x[2]; T[k * 257 + nc + 3] = x[3]; }
    __syncthreads();
    const int n = F.tid >> 1, kc = (F.tid & 1) * 32;
#pragma unroll
    for (int j = 0; j < 4; ++j) { u32x4 w; const int kb = kc + 8 * j;
        w.x = cvt_pk_bf16(T[(kb + 0) * 257 + n], T[(kb + 1) * 257 + n]); w.y = cvt_pk_bf16(T[(kb + 2) * 257 + n], T[(kb + 3) * 257 + n]);
        w.z = cvt_pk_bf16(T[(kb + 4) * 257 + n], T[(kb + 5) * 257 + n]); w.w = cvt_pk_bf16(T[(kb + 6) * 257 + n], T[(kb + 7) * 257 + n]);
        *(u32x4*)(dst + (size_t)(n0 + n) * ldd + k0 + kb) = w; }
    __syncthreads();
}
__device__ __forceinline__ void cvt_rows(const Ctx& F, const float* src, bf16_t* dst, size_t n8) {
    for (size_t i = (size_t)F.bid * 512 + F.tid; i < n8; i += (size_t)F.G * 512) {
        const f32x4 a = *(const f32x4*)(src + i * 8), b = *(const f32x4*)(src + i * 8 + 4);
        *(u32x4*)(dst + i * 8) = pg8::pack8(a, b); }
}

__device__ __forceinline__ void cvt_rows_fp8(const Ctx& F, const float* src, unsigned char* dst, size_t n16, float scale) {
    const size_t stride = (size_t)F.G * 512;
    for (size_t i = (size_t)F.bid * 512 + F.tid; i < n16; i += 2 * stride) {
        const size_t i2 = i + stride; const bool two = i2 < n16;
        f32x4 a[8];
#pragma unroll
        for (int j = 0; j < 4; ++j) { a[j] = *(const f32x4*)(src + i * 16 + 4 * j); a[4 + j] = two ? *(const f32x4*)(src + i2 * 16 + 4 * j) : (f32x4){0.f, 0.f, 0.f, 0.f}; }
        u32x4 w0, w1;
#pragma unroll
        for (int j = 0; j < 4; ++j) { const f32x4 x = a[j] * scale, y = a[4 + j] * scale;
            int p = 0; p = __builtin_amdgcn_cvt_pk_fp8_f32(x[0], x[1], p, false); p = __builtin_amdgcn_cvt_pk_fp8_f32(x[2], x[3], p, true); w0[j] = (unsigned)p;
            int q = 0; q = __builtin_amdgcn_cvt_pk_fp8_f32(y[0], y[1], q, false); q = __builtin_amdgcn_cvt_pk_fp8_f32(y[2], y[3], q, true); w1[j] = (unsigned)q; }
        *(u32x4*)(dst + i * 16) = w0; if (two) *(u32x4*)(dst + i2 * 16) = w1; }
}

constexpr int V4_ROW = 1088;
__device__ __forceinline__ void cvt_rows_fp4(const Ctx& F, const float* src, unsigned char* dst, size_t nblk) {
    for (size_t i = (size_t)F.bid * 512 + F.tid; i < nblk; i += (size_t)F.G * 512) {
        f32x4 a[8]; float amax = 0.f;
#pragma unroll
        for (int j = 0; j < 8; ++j) { a[j] = *(const f32x4*)(src + i * 32 + 4 * j); amax = fmaxf(amax, fmaxf(fmaxf(fabsf(a[j][0]), fabsf(a[j][1])), fmaxf(fabsf(a[j][2]), fabsf(a[j][3])))); }
        int e = amax > 0.f ? (int)ceilf(log2f(amax * (1.0f / 6.0f))) : -126; e = e < -126 ? -126 : (e > 126 ? 126 : e);
        const float inv = __uint_as_float((unsigned)(127 - e) << 23);
        u32x4 w;
#pragma unroll
        for (int j = 0; j < 4; ++j) { const f32x4 x = a[2 * j] * inv, y = a[2 * j + 1] * inv; unsigned p = 0u;
            p = __builtin_amdgcn_cvt_scalef32_pk_fp4_f32(p, x[0], x[1], 1.0f, 0); p = __builtin_amdgcn_cvt_scalef32_pk_fp4_f32(p, x[2], x[3], 1.0f, 1);
            p = __builtin_amdgcn_cvt_scalef32_pk_fp4_f32(p, y[0], y[1], 1.0f, 2); p = __builtin_amdgcn_cvt_scalef32_pk_fp4_f32(p, y[2], y[3], 1.0f, 3); w[j] = p; }
        const size_t row = i >> 6; const int bl = (int)(i & 63);
        *(u32x4*)(dst + row * V4_ROW + bl * 16) = w; dst[row * V4_ROW + 1024 + bl] = (unsigned char)(e + 127);
    }
}

__device__ __forceinline__ void ph_prologue(const Ctx& F0) {
    const Ctx F = phase_ctx(F0);
    using namespace cf;
    constexpr int T_WIN = 2 * 32 * 56, T_QUP = 2 * 8 * 6, T_KVUP = 2 * 4 * 8, T_BR = 2 * 4 * 16 * 8, T_WO = 2 * 32 * 8;
    constexpr int T_ALL = T_WIN + T_QUP + T_KVUP + T_BR + T_WO;
    for (int u = F.bid; u < T_ALL; u += F.G) {
        int t = u;
        if (t < T_WIN) { const int l = t / (32 * 56), r = t % (32 * 56), kt = r / 56, nt = r % 56;
            tr_tile(F, F.in[I_WIN] + (size_t)l * 2048 * IN_COLS, IN_COLS, 0, kt * 64, WSP(bf16_t, WS_WIN) + (size_t)l * NC * 2048, 2048, nt * 256); continue; }
        t -= T_WIN;
        if (t < T_QUP) { const int l = t / (8 * 6), r = t % (8 * 6), kt = r / 6, nt = r % 6;
            tr_tile(F, F.in[I_WQUP] + (size_t)l * 512 * 1536, 1536, 1, kt * 64, WSP(bf16_t, WS_WQUP) + (size_t)l * 1536 * 512, 512, nt * 256, F.in[I_BQN] + l * 512); continue; }
        t -= T_QUP;
        if (t < T_KVUP) { const int l = t / (4 * 8), r = t % (4 * 8), kt = r / 8, nt = r % 8;
            tr_tile(F, F.in[I_WKVUP] + (size_t)l * 256 * 2048, 2048, 2, kt * 64, WSP(bf16_t, WS_WKVUP) + (size_t)l * 2048 * 256, 256, nt * 256, F.in[I_BKVN] + l * 256); continue; }
        t -= T_KVUP;
        if (t < T_BR) { const int l = t / (4 * 128), r = t % (4 * 128), br = r / 128, r2 = r % 128, kt = r2 / 8, nt = r2 % 8;
            const float* src = (br == 0 ? F.in[I_WBRA] : br == 1 ? F.in[I_WBRB] : br == 2 ? F.in[I_WBRC] : F.in[I_WBRD]) + (size_t)l * 1024 * 2048;
            tr_tile(F, src, 2048, 3, kt * 64, WSP(bf16_t, WS_WBR) + ((size_t)l * 4 + br) * 2048 * 1024, 1024, nt * 256); continue; }
        t -= T_BR;
        { const int l = t / 256, r = t % 256, kt = r / 8, nt = r % 8;
            tr_tile(F, F.in[I_WO] + (size_t)l * 2048 * 2048, 2048, 3, kt * 64, WSP(bf16_t, WS_WO) + (size_t)l * 2048 * 2048, 2048, nt * 256); }
    }
    for (int u = F.bid; u < 2 * 16 * 32; u += F.G) {
        const int l = u / 512, g = (u % 512) / 32, d0 = (u % 32) * 64;
        LAS float* sk = (LAS float*)F.lds; LAS float* wt = (LAS float*)(F.lds + 128 * 129 * 4);
        const float* skg = F.in[I_PSK] + ((size_t)l * 16 + g) * 128 * 128;
        const float* wqg = F.in[I_PWQ] + (size_t)l * 2048 * 2048 + (size_t)d0 * 2048 + g * 128;
        for (int i = F.tid; i < 128 * 128; i += 512) sk[(i >> 7) * 129 + (i & 127)] = skg[i];
        for (int i = F.tid; i < 64 * 128; i += 512) wt[(i >> 7) * 129 + (i & 127)] = wqg[(size_t)(i >> 7) * 2048 + (i & 127)];
        __syncthreads();
        const int n = F.tid & 127, dg = F.tid >> 7;
        float a[16];
#pragma unroll
        for (int e = 0; e < 16; ++e) a[e] = 0.f;
        for (int k = 0; k < 128; ++k) { const float s = sk[n * 129 + k];
#pragma unroll
            for (int e = 0; e < 16; ++e) a[e] += wt[(dg * 16 + e) * 129 + k] * s; }
        bf16_t* dst = WSP(bf16_t, WS_WFOLD) + (size_t)l * 2048 * 2048 + (size_t)(g * 128 + n) * 2048 + d0 + dg * 16;
        u32x4 w0, w1;
        w0.x = cvt_pk_bf16(a[0], a[1]); w0.y = cvt_pk_bf16(a[2], a[3]); w0.z = cvt_pk_bf16(a[4], a[5]); w0.w = cvt_pk_bf16(a[6], a[7]);
        w1.x = cvt_pk_bf16(a[8], a[9]); w1.y = cvt_pk_bf16(a[10], a[11]); w1.z = cvt_pk_bf16(a[12], a[13]); w1.w = cvt_pk_bf16(a[14], a[15]);
        *(u32x4*)dst = w0; *(u32x4*)(dst + 8) = w1;
        __syncthreads();
    }
    for (int u = F.bid; u < 2 * 192; u += F.G) {
        const int l = u / 192, n0 = (u % 192) * 64;
        LAS float* sl = (LAS float*)F.lds; LAS float* red = (LAS float*)(F.lds + 5 * 2048 * 4);
        for (int i = F.tid; i < 5 * 2048; i += 512) { const int r = i >> 11, k = i & 2047; const float v = r < 4 ? F.in[I_C][r * 2048 + k] : F.in[I_CCTX][k]; sl[i] = v * sigmoidf_(v); }
        __syncthreads();
        const int cg = F.tid & 15, ks = F.tid >> 4;
        f32x4 a[5];
#pragma unroll
        for (int r = 0; r < 5; ++r) a[r] = (f32x4){0.f, 0.f, 0.f, 0.f};
        const float* wp = F.in[I_WADA] + (size_t)l * 2048 * 12288 + n0 + cg * 4;
#pragma unroll 8
        for (int k = ks * 64; k < ks * 64 + 64; ++k) { const f32x4 w = *(const f32x4*)(wp + (size_t)k * 12288);
#pragma unroll
            for (int r = 0; r < 5; ++r) a[r] += w * sl[r * 2048 + k]; }
#pragma unroll
        for (int r = 0; r < 5; ++r) *(LAS f32x4*)(red + (ks * 5 + r) * 64 + cg * 4) = a[r];
        __syncthreads();
        if (F.tid < 320) { const int r = F.tid >> 6, col = F.tid & 63; float sacc = 0.f;
#pragma unroll
            for (int k2 = 0; k2 < 32; ++k2) sacc += red[(k2 * 5 + r) * 64 + col];
            WSP(float, WS_MOD)[((size_t)l * 5 + r) * 12288 + n0 + col] = sacc + F.in[I_BADA][(size_t)l * 12288 + n0 + col]; }
        __syncthreads();
    }
    for (int i = F.bid * 512 + F.tid; i < 4096 * 64; i += F.G * 512) {
        const int pos = i >> 6, j = i & 63, fi = j & 31; const float fr = powf(10000.0f, -(float)(2 * fi) / 64.0f);
        const float ang = (float)(j < 32 ? (pos >> 6) : (pos & 63)) * fr;
        WSP(float, WS_COSH)[i] = cosf(ang); WSP(float, WS_SINH)[i] = sinf(ang);
    }
    for (int i = F.bid * 512 + F.tid; i < 4096 * 32; i += F.G * 512) {
        const int pos = i >> 5, j = i & 31, fi = j & 15; const float fr = powf(10000.0f, -(float)(2 * fi) / 32.0f);
        const float ang = (float)(j < 16 ? (pos >> 6) : (pos & 63)) * fr;
        WSP(float, WS_COSR)[i] = cosf(ang); WSP(float, WS_SINR)[i] = sinf(ang);
    }
    cvt_rows_fp8(F, F.in[I_PU], WSP(unsigned char, WS_UB), (size_t)2 * NEXP * 2048 / 16, 1024.f);
    cvt_rows_fp4(F, F.in[I_PV], WSP(unsigned char, WS_VB2), (size_t)2 * NEXP * 64);
}

__device__ __forceinline__ void ph_modulate0(const Ctx& F0) {
    const Ctx F = phase_ctx(F0);
    using namespace cf;
    const float* mod = WSP(float, WS_MOD);
    for (size_t i = (size_t)F.bid * 512 + F.tid; i < (size_t)MR * 256; i += (size_t)F.G * 512) {
        const int R = (int)(i >> 8), d = (int)(i & 255) * 8, b = R / RB, j = R % RB;
        const float* src = j < CTX ? F.in[I_CTX] + ((size_t)b * CTX + j) * 2048 : F.in[I_X] + ((size_t)b * S + (j - CTX)) * 2048;
        const float* m = mod + (size_t)(j < CTX ? 4 : b) * 12288;
        const f32x4 x0 = *(const f32x4*)(src + d), x1 = *(const f32x4*)(src + d + 4);
        const f32x4 sh0 = *(const f32x4*)(m + d), sh1 = *(const f32x4*)(m + d + 4), s0 = *(const f32x4*)(m + 2048 + d), s1 = *(const f32x4*)(m + 2048 + d + 4);
        *(u32x4*)(WSP(bf16_t, WS_HB) + (size_t)R * 2048 + d) = pg8::pack8(x0 * (s0 + 1.0f) + sh0, x1 * (s1 + 1.0f) + sh1);
    }
}

__device__ __forceinline__ void knorm_pass(const Ctx& F) {
    using namespace cf;
    bf16_t* P = WSP(bf16_t, WS_P); const float* ssk = WSP(const float, WS_SSK);
    for (int it = F.bid * 8 + F.wave; it < MR * 2; it += F.G * 8) {
        const int R = it >> 1, h = it & 1;
        const f32x2 pp = *(const f32x2*)(ssk + (size_t)it * 2); const float r = rsqrtf((pp.x + pp.y) * (1.f / 128.f) + 1e-6f);
        unsigned* q = (unsigned*)(P + (size_t)R * NC + PC_AK + h * 128) + F.lane;
        const unsigned w = *q; *q = cvt_pk_bf16(bflo(w) * r, bfhi(w) * r);
    }
}

struct AttnArgs {
    const bf16_t* Q; const bf16_t* K; const bf16_t* V; bf16_t* O; int ldq, ldk, ldv, ldo;
    int seg0_row, seg0_tiles, seg1_row, seg1_tiles;
    int mask_on, qpos0, kpos1;
    float sc_log2; int has_sink; float sink_l2;
    int variant;
    const float* qss;
};
typedef float f32x16 __attribute__((ext_vector_type(16)));
template <int DK, bool MASKED>
__device__ __forceinline__ void attn_unit(ldsp_t lds, const AttnArgs a, int wave_) {
    constexpr int ND = DK / 16, KCH = DK / 8, KPT = (64 * KCH) / 512, VST = 72, KM = DK == 128 ? 15 : 7;
    constexpr int KBUF = 64 * DK * 2, VBUF = 128 * VST * 2, VOFF = 2 * KBUF, ALOFF = VOFF + 3 * VBUF;
    int tid = wave_ * 64 + lane_id(); asm volatile("" : "+v"(tid));
    const int wid = __builtin_amdgcn_readfirstlane(tid >> 6), lane = tid & 63, q32 = lane & 31, hi = lane >> 5;
    LAS float* al = (LAS float*)(lds + ALOFF + wid * 128);
    bf16x8 qf[ND];
    { float scq = a.sc_log2;
      if (a.qss) { const f32x2 pp = *(const f32x2*)(a.qss + (size_t)(wid * 32 + q32) * 16); scq *= rsqrtf((pp.x + pp.y) * (1.f / 128.f) + 1e-6f); }
      const bf16_t* qrow = a.Q + (size_t)(wid * 32 + q32) * a.ldq + 8 * hi;
#pragma unroll
      for (int s = 0; s < ND; ++s) { const u32x4 w = *(const u32x4*)(qrow + 16 * s); u32x4 o;
          o.x = cvt_pk_bf16(bflo(w.x) * scq, bfhi(w.x) * scq); o.y = cvt_pk_bf16(bflo(w.y) * scq, bfhi(w.y) * scq);
          o.z = cvt_pk_bf16(bflo(w.z) * scq, bfhi(w.z) * scq); o.w = cvt_pk_bf16(bflo(w.w) * scq, bfhi(w.w) * scq); qf[s] = *(bf16x8*)&o; } }
    f32x16 o[4];
#pragma unroll
    for (int db = 0; db < 4; ++db)
#pragma unroll
        for (int r = 0; r < 16; ++r) o[db][r] = 0.f;
    float m_run = -1e30f, l_run = 0.f;
    const int PV_ = MK_AV ? a.variant : 0;
    const int ntiles = a.seg0_tiles + a.seg1_tiles;
    u32x4 vreg[2];
    const int vkp = tid & 31, vdc = tid >> 5;
    const int vkey = 2 * vkp, vpos = (vkey & 48) | ((vkey & 4) << 1) | ((vkey & 8) >> 1) | (vkey & 3);
    unsigned koff[KPT];
#pragma unroll
    for (int i = 0; i < KPT; ++i) { const int P = (i * 8 + wid) * 64 + lane, row = P / KCH, cp = P % KCH; koff[i] = (unsigned)(row * a.ldk + 8 * (cp ^ (row & KM))) * 2u; }
#define ATT_LOAD(tt, kb) do { const int _r0 = (tt) < a.seg0_tiles ? a.seg0_row + 64 * (tt) : a.seg1_row + 64 * ((tt) - a.seg0_tiles); \
        const char* _kg = (const char*)(a.K + (size_t)_r0 * a.ldk); \
        _Pragma("unroll") for (int _i = 0; _i < KPT; ++_i) __builtin_amdgcn_global_load_lds((const unsigned*)(_kg + koff[_i]), (LAS unsigned*)(lds + (kb) * KBUF + (_i * 8 + wid) * 1024), 16, 0, 0); \
        vreg[0] = *(const u32x4*)(a.V + (size_t)(_r0 + 2 * vkp) * a.ldv + 8 * vdc); vreg[1] = *(const u32x4*)(a.V + (size_t)(_r0 + 2 * vkp + 1) * a.ldv + 8 * vdc); } while (0)
#define ATT_WRITE(vb) do { const ldsp_t _vb = lds + VOFF + (vb) * VBUF; \
        const unsigned _a0[4] = {vreg[0].x, vreg[0].y, vreg[0].z, vreg[0].w}, _a1[4] = {vreg[1].x, vreg[1].y, vreg[1].z, vreg[1].w}; \
        _Pragma("unroll") for (int _e = 0; _e < 4; ++_e) { \
            *(LAS unsigned*)(_vb + ((8 * vdc + 2 * _e) * VST + vpos) * 2) = (_a0[_e] & 0xffffu) | (_a1[_e] << 16); \
            *(LAS unsigned*)(_vb + ((8 * vdc + 2 * _e + 1) * VST + vpos) * 2) = (_a0[_e] >> 16) | (_a1[_e] & 0xffff0000u); } } while (0)
#define ATT_PV(vb) do { const ldsp_t _vt = lds + VOFF + (vb) * VBUF; \
        _Pragma("unroll") for (int db = 0; db < 4; ++db) _Pragma("unroll") for (int ks = 0; ks < 4; ++ks) { \
            const bf16x8 vf = *(const LAS bf16x8*)(_vt + ((32 * db + q32) * VST + 16 * ks + 8 * hi) * 2); \
            o[db] = __builtin_amdgcn_mfma_f32_32x32x16_bf16(pa[ks], vf, o[db], 0, 0, 0); } } while (0)
    bf16x8 pa[4];
#pragma unroll
    for (int i = 0; i < 4; ++i) pa[i] = (bf16x8){0, 0, 0, 0, 0, 0, 0, 0};
    int vprev = 2, vcur = 0, vnext = 1;
    { unsigned z0 = 0u; asm volatile("" : "+v"(z0));
      for (int i = tid; i < VBUF / 16; i += 512) *(LAS u32x4*)(lds + VOFF + 2 * VBUF + i * 16) = (u32x4){z0, z0, z0, z0}; }
    ATT_LOAD(0, 0);
    ATT_WRITE(0);
    asm volatile("s_waitcnt vmcnt(0)" ::: "memory");
    __syncthreads();
    for (int tt = 0; tt < ntiles; ++tt) {
        const int cur = tt & 1;
        if (tt + 1 < ntiles && PV_ != 4) ATT_LOAD(tt + 1, cur ^ 1);
        const ldsp_t Ks = lds + cur * KBUF;
        f32x16 s0, s1;
#pragma unroll
        for (int r = 0; r < 16; ++r) { s0[r] = 0.f; s1[r] = 0.f; }
        { bf16x8 kf[2][2];
#define ATT_LDK(p, sb) do { kf[p][0] = *(const LAS bf16x8*)(Ks + (q32 * KCH + ((2 * (sb) + hi) ^ (q32 & KM))) * 16); kf[p][1] = *(const LAS bf16x8*)(Ks + ((32 + q32) * KCH + ((2 * (sb) + hi) ^ (q32 & KM))) * 16); } while (0)
          if (PV_ != 2) {
          ATT_LDK(0, 0); __builtin_amdgcn_sched_barrier(0);
#pragma unroll
          for (int sb = 0; sb < ND; ++sb) {
              if (sb + 1 < ND) ATT_LDK((sb + 1) & 1, sb + 1);
              __builtin_amdgcn_sched_barrier(0);
              s0 = __builtin_amdgcn_mfma_f32_32x32x16_bf16(kf[sb & 1][0], qf[sb], s0, 0, 0, 0);
              s1 = __builtin_amdgcn_mfma_f32_32x32x16_bf16(kf[sb & 1][1], qf[sb], s1, 0, 0, 0);
              __builtin_amdgcn_sched_barrier(0); }
          }
#undef ATT_LDK
        }
        __builtin_amdgcn_sched_barrier(0);
        const bool msk = MASKED && a.mask_on && tt >= a.seg0_tiles;
        if (MASKED) { const int kp0 = a.kpos1 + 64 * (tt - a.seg0_tiles) + 4 * hi, qp = a.qpos0 + wid * 32 + q32;
#pragma unroll
            for (int r = 0; r < 16; ++r) { float t0 = s0[r], t1 = s1[r];
                if (msk) { const int d0 = qp - (kp0 + (r & 3) + 8 * (r >> 2)), d1 = d0 - 32; if (d0 > 128 || d0 < -128) t0 = -1e30f; if (d1 > 128 || d1 < -128) t1 = -1e30f; s0[r] = t0; s1[r] = t1; } }
            __builtin_amdgcn_sched_barrier(0); }
        float mx = -1e30f, m_new = 0.f, alpha = 1.f, ps = 0.f;
        bf16x8 pn[4] = {pa[0], pa[1], pa[2], pa[3]};
        { const ldsp_t _vt = lds + VOFF + vprev * VBUF; bf16x8 vfr[3]; vfr[2] = pa[0];
#define ATT_LDV(i) (*(const LAS bf16x8*)(_vt + ((32 * ((i) >> 2) + q32) * VST + 16 * ((i) & 3) + 8 * hi) * 2))
#define SCV(e) ((e) < 16 ? s0[(e) & 15] : s1[(e) & 15])
          vfr[0] = ATT_LDV(0); vfr[1] = ATT_LDV(1);
          __builtin_amdgcn_sched_barrier(0);
#pragma unroll
          for (int i = 0; i < 16; ++i) {
              if (PV_ != 3) { if (i + 2 < 16) vfr[(i + 2) % 3] = ATT_LDV(i + 2);
              o[i >> 2] = __builtin_amdgcn_mfma_f32_32x32x16_bf16(pa[i & 3], vfr[i % 3], o[i >> 2], 0, 0, 0); }
              if (PV_ == 1) {} else if (i < 4) {
#pragma unroll
                  for (int e = 0; e < 4; ++e) mx = fmaxf(mx, fmaxf(s0[4 * i + e], s1[4 * i + e]));
              } else if (i == 4) {
                  mx = fmaxf(mx, shx(mx, 32, lane)); m_new = fmaxf(m_run, mx); alpha = __builtin_amdgcn_exp2f(m_run - m_new); m_run = m_new;
              } else if (i < 13) {
#pragma unroll
                  for (int e = 0; e < 2; ++e) { const int r = 2 * (i - 5) + e; s0[r] = __builtin_amdgcn_exp2f(s0[r] - m_new); s1[r] = __builtin_amdgcn_exp2f(s1[r] - m_new); ps += s0[r] + s1[r]; }
              } else if (i == 13) {
                  u32x4 w; w.x = cvt_pk_bf16(s0[0], s0[1]); w.y = cvt_pk_bf16(s0[2], s0[3]); w.z = cvt_pk_bf16(s0[4], s0[5]); w.w = cvt_pk_bf16(s0[6], s0[7]); pn[0] = *(bf16x8*)&w;
                  u32x4 v; v.x = cvt_pk_bf16(s0[8], s0[9]); v.y = cvt_pk_bf16(s0[10], s0[11]); v.z = cvt_pk_bf16(s0[12], s0[13]); v.w = cvt_pk_bf16(s0[14], s0[15]); pn[1] = *(bf16x8*)&v;
              } else if (i == 14) {
                  u32x4 w; w.x = cvt_pk_bf16(s1[0], s1[1]); w.y = cvt_pk_bf16(s1[2], s1[3]); w.z = cvt_pk_bf16(s1[4], s1[5]); w.w = cvt_pk_bf16(s1[6], s1[7]); pn[2] = *(bf16x8*)&w;
                  u32x4 v; v.x = cvt_pk_bf16(s1[8], s1[9]); v.y = cvt_pk_bf16(s1[10], s1[11]); v.z = cvt_pk_bf16(s1[12], s1[13]); v.w = cvt_pk_bf16(s1[14], s1[15]); pn[3] = *(bf16x8*)&v;
              } else { l_run = l_run * alpha + ps; }
              __builtin_amdgcn_sched_barrier(0);
          }
#undef ATT_LDV
#undef SCV
        }
#pragma unroll
        for (int i = 0; i < 4; ++i) pa[i] = pn[i];
        if (__any(alpha < 1.0f)) {
            if (hi == 0) al[q32] = alpha;
            asm volatile("s_waitcnt lgkmcnt(0)" ::: "memory");
#pragma unroll
            for (int g4 = 0; g4 < 4; ++g4) { const f32x4 av = *(const LAS f32x4*)(al + 8 * g4 + 4 * hi);
#pragma unroll
                for (int db = 0; db < 4; ++db)
#pragma unroll
                    for (int j = 0; j < 4; ++j) o[db][4 * g4 + j] *= av[j]; }
        }
        if (tt + 1 < ntiles && PV_ != 4) ATT_WRITE(vnext);
        { const int t3 = vprev; vprev = vcur; vcur = vnext; vnext = t3; }
        asm volatile("s_waitcnt vmcnt(0)" ::: "memory");
        if (PV_ != 5) __syncthreads();
    }
    ATT_PV(vprev);
#undef ATT_LOAD
#undef ATT_WRITE
#undef ATT_PV
    __syncthreads();
    float l_tot = l_run + shx(l_run, 32, lane);
    if (a.has_sink) l_tot += __builtin_amdgcn_exp2f(a.sink_l2 - m_run);
    if (hi == 0) al[q32] = 1.0f / l_tot;
    asm volatile("s_waitcnt lgkmcnt(0)" ::: "memory");
    const ldsp_t Ost = lds + wid * 8192;
#pragma unroll
    for (int g4 = 0; g4 < 4; ++g4) { const f32x4 iv = *(const LAS f32x4*)(al + 8 * g4 + 4 * hi);
#pragma unroll
        for (int db = 0; db < 4; ++db)
#pragma unroll
            for (int j = 0; j < 4; ++j) *(LAS bf16_t*)(Ost + ((8 * g4 + 4 * hi + j) * 128 + 32 * db + q32) * 2) = f2bf(o[db][4 * g4 + j] * iv[j]); }
    asm volatile("s_waitcnt lgkmcnt(0)" ::: "memory");
#pragma unroll
    for (int i = 0; i < 8; ++i) { const int c = lane + 64 * i, row = c >> 4, c8 = c & 15;
        *(u32x4*)(a.O + (size_t)(wid * 32 + row) * a.ldo + 8 * c8) = *(const LAS u32x4*)(Ost + (row * 128 + 8 * c8) * 2); }
}

__device__ __forceinline__ void conv_unit(const Ctx& F, int layer, int row0  , int seq_len, int t0) {
    using namespace cf;
    const bf16_t* P = WSP(const bf16_t, WS_P); bf16_t* BR = WSP(bf16_t, WS_BR);
    const float* cw = F.in[I_CW] + (size_t)layer * 31 * 1024; const float* cb = F.in[I_CB] + layer * 1024;
    const float* lg = F.in[I_CLG] + layer * 1024; const float* lb = F.in[I_CLB] + layer * 1024;
    int tid = F.wave * 64 + lane_id(); asm volatile("" : "+v"(tid));
    const int lane = tid & 63;
    LAS float* red = (LAS float*)(F.lds + 126976); LAS float* tot = red + 8 * 32;
    __syncthreads();
    for (int c = tid; c < 62 * 128; c += 512) { const int rr = c >> 7, ch = c & 127, t = t0 - 15 + rr;
        u32x4 v = {0u, 0u, 0u, 0u};
        if (t >= 0 && t < seq_len) v = *(const u32x4*)(P + (size_t)(row0 + t) * NC + PC_GLU + ch * 8);
        *(LAS u32x4*)(F.lds + rr * 2048 + ch * 16) = v; }
    float w0[31], w1[31];
#pragma unroll
    for (int k = 0; k < 31; ++k) { const f32x2 w = *(const f32x2*)(cw + k * 1024 + 2 * tid); w0[k] = w.x; w1[k] = w.y; }
    const f32x2 bv = *(const f32x2*)(cb + 2 * tid), gg = *(const f32x2*)(lg + 2 * tid), bb = *(const f32x2*)(lb + 2 * tid);
    __syncthreads();
#pragma unroll 1
    for (int part = 0; part < 4; ++part) {
        float a0[8], a1[8];
#pragma unroll
        for (int t = 0; t < 8; ++t) { a0[t] = bv.x; a1[t] = bv.y; }
        const ldsp_t base = F.lds + part * 8 * 2048 + tid * 4;
#pragma unroll
        for (int rr = 0; rr < 38; ++rr) { const unsigned xw = *(const LAS unsigned*)(base + rr * 2048); const float x0 = bflo(xw), x1 = bfhi(xw);
#pragma unroll
            for (int t = 0; t < 8; ++t) { const int k = rr - t; if (k >= 0 && k <= 30) { a0[t] += x0 * w0[k]; a1[t] += x1 * w1[k]; } } }
        float v[16];
#pragma unroll
        for (int t = 0; t < 8; ++t) { v[t] = a0[t] + a1[t]; v[8 + t] = a0[t] * a0[t] + a1[t] * a1[t]; }
#pragma unroll
        for (int i = 0; i < 8; ++i) { const bool up = lane & 32; const float snd = up ? v[i] : v[i + 8], kp = up ? v[i + 8] : v[i]; v[i] = kp + shx(snd, 32, lane); }
#pragma unroll
        for (int i = 0; i < 4; ++i) { const bool up = lane & 16; const float snd = up ? v[i] : v[i + 4], kp = up ? v[i + 4] : v[i]; v[i] = kp + shx(snd, 16, lane); }
#pragma unroll
        for (int i = 0; i < 2; ++i) { const bool up = lane & 8; const float snd = up ? v[i] : v[i + 2], kp = up ? v[i + 2] : v[i]; v[i] = kp + shx(snd, 8, lane); }
        { const bool up = lane & 4; const float snd = up ? v[0] : v[1], kp = up ? v[1] : v[0]; v[0] = kp + shx(snd, 4, lane); }
        v[0] += shx(v[0], 2, lane); v[0] += shx(v[0], 1, lane);
        if ((lane & 3) == 0) red[F.wave * 16 + (lane >> 2)] = v[0];
        __syncthreads();
        if (tid < 16) { float s = 0.f;
#pragma unroll
            for (int w = 0; w < 8; ++w) s += red[w * 16 + tid];
            tot[tid] = s; }
        __syncthreads();
#pragma unroll
        for (int t = 0; t < 8; ++t) { const float mean = tot[t] * (1.f / 1024.f), var = fmaxf(tot[8 + t] * (1.f / 1024.f) - mean * mean, 0.f), rstd = rsqrtf(var + 1e-5f);
            const float y0 = (a0[t] - mean) * rstd * gg.x + bb.x, y1 = (a1[t] - mean) * rstd * gg.y + bb.y;
            *(unsigned*)(BR + (size_t)(row0 + t0 + part * 8 + t) * 4096 + 2048 + 2 * tid) = cvt_pk_bf16(y0 * sigmoidf_(y0), y1 * sigmoidf_(y1)); }
    }
}

__device__ __forceinline__ void attn_defaults(AttnArgs& a, int isctx) {
    a.seg0_row = 0; a.seg0_tiles = isctx ? 4 : 68; a.seg1_row = 0; a.seg1_tiles = 0; a.mask_on = 0; a.qpos0 = 0; a.kpos1 = 0; a.has_sink = 0; a.sink_l2 = 0.f; a.qss = nullptr; a.variant = 0; }
__device__ __forceinline__ void ph_attn(const Ctx& F0, int layer) {
    const Ctx F = phase_ctx(F0);
    using namespace cf;
    const bf16_t* P = WSP(const bf16_t, WS_P); bf16_t* BR = WSP(bf16_t, WS_BR);
    for (int dup = 0; dup < DUPN(2); ++dup)
    for (int u = F.bid; u < (layer == 0 ? 544 : 512); u += F.G) {
        int b, h, qb, isctx = 0;
        if (u < 512) { b = u >> 7; h = (u >> 4) & 7; qb = u & 15; } else { const int r = u - 512; b = r >> 3; h = r & 7; qb = 0; isctx = 1; }
        const size_t brow = (size_t)b * RB, qrow = brow + (isctx ? 0 : CTX) + (size_t)qb * 256;
        AttnArgs a; attn_defaults(a, isctx);
        a.Q = WSP(const bf16_t, WS_QB) + qrow * 1536 + h * 192; a.ldq = 1536;
        a.K = WSP(const bf16_t, WS_KB) + brow * 1536 + h * 192; a.ldk = 1536;
        a.V = WSP(const bf16_t, WS_VB) + brow * 1024 + h * 128; a.ldv = 1024;
        a.O = BR + qrow * 4096 + 1024 + h * 128; a.ldo = 4096; a.sc_log2 = SCALE_MLA * LOG2E;
        __syncthreads();
        attn_unit<192, false>(F.lds, a, F.wave);
    }
    for (int dup = 0; dup < DUPN(3); ++dup)
    for (int u0 = F.bid; u0 < (layer == 0 ? 544 : 512); u0 += F.G) {
        int b, h, qb, isctx = 0;
        if (u0 < 512) { b = u0 >> 7; h = (u0 >> 4) & 7; qb = u0 & 15; } else { const int r = u0 - 512; b = r >> 3; h = r & 7; qb = 0; isctx = 1; }
        const size_t brow = (size_t)b * RB, qrow = brow + (isctx ? 0 : CTX) + (size_t)qb * 256;
        AttnArgs a; attn_defaults(a, isctx);
        a.Q = P + qrow * NC + PC_AQ + h * 128; a.ldq = NC;
        a.K = P + brow * NC + PC_AK + (h >> 2) * 128; a.ldk = NC;
        a.V = P + brow * NC + PC_AV + (h >> 2) * 128; a.ldv = NC;
        a.O = BR + qrow * 4096 + h * 128; a.ldo = 4096; a.sc_log2 = SCALE_HD * LOG2E;
        a.qss = WSP(const float, WS_SSQ) + qrow * 16 + h * 2;
        if (MK_AV && dup == 1) { a.variant = MK_AV; a.O = WSP(bf16_t, WS_HB) + qrow * 2048 + h * 128; a.ldo = 2048; }
        __syncthreads();
        attn_unit<128, false>(F.lds, a, F.wave);
    }
    for (int dup = 0; dup < DUPN(13); ++dup)
    for (int u0 = F.bid; u0 < (layer == 0 ? 544 : 512); u0 += F.G) {
        int b, h, qb, isctx = 0;
        if (u0 < 512) { b = u0 >> 7; h = (u0 >> 4) & 7; qb = u0 & 15; } else { const int r = u0 - 512; b = r >> 3; h = r & 7; qb = 0; isctx = 1; }
        const size_t brow = (size_t)b * RB, qrow = brow + (isctx ? 0 : CTX) + (size_t)qb * 256;
        AttnArgs a; attn_defaults(a, isctx);
        a.Q = P + qrow * NC + PC_DQ + h * 128; a.ldq = NC;
        a.K = P + brow * NC + PC_DK + (h >> 2) * 128; a.ldk = NC;
        a.V = P + brow * NC + PC_DV + (h >> 2) * 128; a.ldv = NC;
        a.O = BR + qrow * 4096 + 3072 + h * 128; a.ldo = 4096; a.sc_log2 = SCALE_HD * LOG2E;
        a.has_sink = 1; a.sink_l2 = F.in[I_SINK][layer * 8 + h] * LOG2E; a.seg0_tiles = 4;
        if (!isctx) { const int start = qb * 256; const int lo = start - 128 < 0 ? 0 : start - 128, hi = start + 384 > S ? S : start + 384;
            a.seg1_row = CTX + lo; a.seg1_tiles = (hi - lo) / 64; a.mask_on = 1; a.qpos0 = start; a.kpos1 = lo; }
        __syncthreads();
        attn_unit<128, true>(F.lds, a, F.wave);
    }
    for (int dup = 0; dup < DUPN(4); ++dup)
    for (int u = F.bid; u < (layer == 0 ? 544 : 512); u += F.G) {
        int b, tb, isctx = 0;
        if (u < 512) { b = u >> 7; tb = u & 127; } else { const int r = u - 512; b = r >> 3; tb = r & 7; isctx = 1; }
        conv_unit(F, layer, b * RB + (isctx ? 0 : CTX), isctx ? CTX : S, tb * 32);
    }
}

__device__ __forceinline__ int tok_row(int layer, int tok) { return layer == 0 ? tok : (tok >> 12) * cf::RB + cf::CTX + (tok & 4095); }
__device__ __forceinline__ void ph_ln1(const Ctx& F0, int layer) {
    const Ctx F = phase_ctx(F0);
    using namespace cf;
    float* X1 = (float*)(F.ws + WS_P + X1_OFF); bf16_t* HB = WSP(bf16_t, WS_HB);
    const float* lg = F.in[I_LN1G] + layer * 2048; const float* lb = F.in[I_LN1B] + layer * 2048;
    const int ntok = layer == 0 ? MR : NB * S, lane = F.lane;
    for (int tok = F.bid * 8 + F.wave; tok < ntok; tok += F.G * 8) {
        const int R = tok_row(layer, tok), b = R / RB, j = R % RB;
        const float* mod = WSP(const float, WS_MOD) + ((size_t)layer * 5 + (j < CTX ? 4 : b)) * 12288;
        float* xp = X1 + (size_t)R * 2048;
        f32x4 v[8]; float s = 0.f;
#pragma unroll
        for (int i = 0; i < 8; ++i) { v[i] = *(const f32x4*)(xp + lane * 4 + 256 * i); s += (v[i][0] + v[i][1]) + (v[i][2] + v[i][3]); }
        const float mean = wave_sum(s, lane) * (1.f / 2048.f); float q = 0.f;
#pragma unroll
        for (int i = 0; i < 8; ++i) { const f32x4 d = v[i] - mean; q += (d[0] * d[0] + d[1] * d[1]) + (d[2] * d[2] + d[3] * d[3]); }
        const float rstd = rsqrtf(wave_sum(q, lane) * (1.f / 2048.f) + 1e-5f);
#pragma unroll
        for (int i = 0; i < 8; ++i) { const int c = lane * 4 + 256 * i;
            const f32x4 y = (v[i] - mean) * rstd * *(const f32x4*)(lg + c) + *(const f32x4*)(lb + c);
            *(f32x4*)(xp + c) = y;
            const f32x4 hp = y * (*(const f32x4*)(mod + 4 * 2048 + c) + 1.0f) + *(const f32x4*)(mod + 3 * 2048 + c);
            u32x2 w; w.x = cvt_pk_bf16(hp[0], hp[1]); w.y = cvt_pk_bf16(hp[2], hp[3]);
            *(u32x2*)(HB + (size_t)R * 2048 + c) = w; }
    }
}

typedef __bf16 bf16x2_t __attribute__((ext_vector_type(2)));
__device__ __forceinline__ unsigned ordkey(float v) { const unsigned u = __float_as_uint(v); return (u & 0x80000000u) ? ~u : (u | 0x80000000u); }
__device__ __forceinline__ int lane_rank(unsigned long long m) { return (int)__builtin_amdgcn_mbcnt_hi((unsigned)(m >> 32), __builtin_amdgcn_mbcnt_lo((unsigned)m, 0u)); }
template <int NV> __device__ __forceinline__ unsigned radix_thresh16(const unsigned (&k)[NV]) {
    unsigned T = 0u;
    for (int bit = 31; bit >= 0; --bit) { const unsigned cand = T | (1u << bit); int cnt = 0;
#pragma unroll
        for (int v = 0; v < NV; ++v) cnt += __popcll(__ballot(k[v] >= cand));
        if (cnt >= 16) { T = cand; if (cnt == 16) break; } }
    return T;
}
__device__ __forceinline__ void radix_thresh16x2(const unsigned (&ka)[2], const unsigned (&kb)[2], unsigned& Ta, unsigned& Tb) {
    unsigned T0 = 0u, T1 = 0u; bool d0 = false, d1 = false;
    for (int bit = 31; bit >= 0; --bit) { const unsigned c0 = T0 | (1u << bit), c1 = T1 | (1u << bit);
        const int n0 = __popcll(__ballot(ka[0] >= c0)) + __popcll(__ballot(ka[1] >= c0)), n1 = __popcll(__ballot(kb[0] >= c1)) + __popcll(__ballot(kb[1] >= c1));
        if (!d0 && n0 >= 16) { T0 = c0; d0 = n0 == 16; }
        if (!d1 && n1 >= 16) { T1 = c1; d1 = n1 == 16; }
        if (d0 && d1) break; }
    Ta = T0; Tb = T1;
}
__device__ __forceinline__ float dot2bf(unsigned a, unsigned b, float acc) { return __builtin_amdgcn_fdot2_f32_bf16(__builtin_bit_cast(bf16x2_t, a), __builtin_bit_cast(bf16x2_t, b), acc, false); }
__device__ __forceinline__ float dot8(const u32x4 a, const u32x4 b, float acc) {
    acc = dot2bf(a.x, b.x, acc); acc = dot2bf(a.y, b.y, acc); acc = dot2bf(a.z, b.z, acc); acc = dot2bf(a.w, b.w, acc);
    return acc;
}
__device__ __forceinline__ float gelu_as(float v) {
    const float av = fabsf(v), t = __builtin_amdgcn_rcpf(av * 0.2316418882f + 1.0f);
    float q = t * 0.5307027145f + (-0.7265760135f); q = q * t + 0.7107068705f; q = q * t + (-0.142248368f); q = q * t + 0.127414796f; q = q * t;
    const float e = __builtin_amdgcn_exp2f((v * v) * (-0.72134752044f)), m = v * (q * e);
    return v < 0.f ? m : v - m;
}
__device__ __forceinline__ void peer_load(u32x4 (&ur)[4][2], u32x4 (&vr)[4], unsigned (&vs)[4], float (&gq)[4], const LAS int* ei, const LAS float* eg,
                                          const unsigned char* U8, const unsigned char* V4, int lane, int grp) {
#pragma unroll
    for (int q = 0; q < 4; ++q) { const int id = __builtin_amdgcn_readfirstlane(ei[grp * 4 + q]); gq[q] = __uint_as_float(__builtin_amdgcn_readfirstlane(__float_as_uint(eg[grp * 4 + q])));
        ur[q][0] = *(const u32x4*)(U8 + (size_t)id * 2048 + lane * 16); ur[q][1] = *(const u32x4*)(U8 + (size_t)id * 2048 + lane * 16 + 1024);
        vr[q] = *(const u32x4*)(V4 + (size_t)id * V4_ROW + lane * 16); vs[q] = V4[(size_t)id * V4_ROW + 1024 + lane]; }
}
__device__ __forceinline__ void peer_comp(const u32x4 (&ur)[4][2], const u32x4 (&vr)[4], const unsigned (&vs)[4], const float (&gq)[4], const f32x2 (&xf)[16], f32x2 (&y2)[16], int lane) {
    float d[4];
#pragma unroll
    for (int q = 0; q < 4; ++q) { f32x2 t = {0.f, 0.f};
#pragma unroll
        for (int i = 0; i < 2; ++i)
#pragma unroll
            for (int j = 0; j < 4; ++j) { const int w = (int)ur[q][i][j];
                t += __builtin_amdgcn_cvt_pk_f32_fp8(w, false) * xf[8 * i + 2 * j]; t += __builtin_amdgcn_cvt_pk_f32_fp8(w, true) * xf[8 * i + 2 * j + 1]; }
        d[q] = t.x + t.y; }
#pragma unroll
    for (int o = 32; o >= 1; o >>= 1) {
#pragma unroll
        for (int q = 0; q < 4; ++q) d[q] += shx(d[q], o, lane); }
#pragma unroll
    for (int q = 0; q < 4; ++q) { const float dd = d[q] * (1.0f / 1024.0f); const float w = gq[q] * gelu_as(dd) * __uint_as_float(vs[q] << 23);
        const f32x2 w2 = {w, w};
#pragma unroll
        for (int j = 0; j < 4; ++j) { const unsigned vw = vr[q][j];
            y2[4 * j + 0] += w2 * __builtin_amdgcn_cvt_scalef32_pk_f32_fp4(vw, 1.0f, 0); y2[4 * j + 1] += w2 * __builtin_amdgcn_cvt_scalef32_pk_f32_fp4(vw, 1.0f, 1);
            y2[4 * j + 2] += w2 * __builtin_amdgcn_cvt_scalef32_pk_f32_fp4(vw, 1.0f, 2); y2[4 * j + 3] += w2 * __builtin_amdgcn_cvt_scalef32_pk_f32_fp4(vw, 1.0f, 3); } }
}
__device__ __forceinline__ unsigned inv_ordkey(unsigned k) { return (k & 0x80000000u) ? (k & 0x7fffffffu) : ~k; }
template <int N, int GRP> __device__ __forceinline__ unsigned lane_radix16(const unsigned (&key)[N], int lane) {
    unsigned T = 0u; bool done = false;
    for (int bit = 31; bit >= 0; --bit) { const unsigned cand = T | (1u << bit); int cnt = 0;
#pragma unroll
        for (int n = 0; n < N; ++n) cnt += key[n] >= cand ? 1 : 0;
        if (GRP >= 2) cnt += __builtin_amdgcn_ds_bpermute((lane ^ 1) << 2, cnt);
        if (GRP >= 4) cnt += __builtin_amdgcn_ds_bpermute((lane ^ 2) << 2, cnt);
        if (!done && cnt >= 16) { T = cand; done = cnt == 16; }
        if (__all(done)) break; }
    return T;
}
__device__ __forceinline__ void ph_peer(const Ctx& F0, int layer) {
    const Ctx F = phase_ctx(F0);
    using namespace cf;
    const float* SC = (const float*)(F.ws + WS_P + SC_OFF); const float* X1 = (const float*)(F.ws + WS_P + X1_OFF);
    bf16_t* HB = WSP(bf16_t, WS_HB); const unsigned char* U8 = WSP(const unsigned char, WS_UB) + (size_t)layer * NEXP * 2048; const unsigned char* V4 = WSP(const unsigned char, WS_VB2) + (size_t)layer * NEXP * V4_ROW;
    const float* lg = F.in[I_LN2G] + layer * 2048; const float* lb = F.in[I_LN2B] + layer * 2048;
    const int ntok = layer == 0 ? MR : NB * S;
    ldsp_t wl = F.lds + F.wave * 8192;
    LAS float* lstv = (LAS float*)wl; LAS int* lsti = (LAS int*)(wl + 2176);
    LAS float* es4 = (LAS float*)(wl + 4352); LAS int* ei4 = (LAS int*)(wl + 5376); LAS float* eg4 = (LAS float*)(wl + 6400);
    const int nwv = F.G * 8;
    for (int tok0 = F.bid * 8 + F.wave; tok0 < ntok; tok0 += 2 * nwv) {
        { int lane = F.lane; asm volatile("" : "+v"(lane));
          const int t2 = lane >> 5, set = lane >> 1, sset = set & 15, part = lane & 1;
          int tokl = tok0 + t2 * nwv; if (tokl >= ntok) tokl = tok0;
          const int Rl = tok_row(layer, tokl);
          unsigned key[64];
          const float* sp = SC + (size_t)Rl * 2048 + sset * 128 + part * 64;
#pragma unroll
          for (int i = 0; i < 16; ++i) { const f32x4 v = *(const f32x4*)(sp + 4 * i);
#pragma unroll
              for (int e = 0; e < 4; ++e) key[4 * i + e] = (ordkey(v[e]) & ~127u) | (unsigned)(127 - (64 * part + 4 * i + e)); }
          const unsigned T = lane_radix16<64, 2>(key, lane);
          int c = 0;
#pragma unroll
          for (int n = 0; n < 64; ++n) { if (key[n] >= T) { const int r = set * 17 + (part ? 15 - c : c); lstv[r] = __uint_as_float(inv_ordkey((key[n] & ~127u) | 64u)); lsti[r] = 64 * part + n; ++c; }
              if ((n & 15) == 15) __builtin_amdgcn_sched_barrier(0); }
        }
        asm volatile("s_waitcnt lgkmcnt(0)" ::: "memory");
        {
          int lane = F.lane; asm volatile("" : "+v"(lane));
          const int t2 = lane >> 5, hq = (lane >> 2) & 7, q = lane & 3, sa = (lane >> 2) * 2, sb = sa + 1;
          float Av[4], Bv[16]; int Ai[4], Bi[16];
#pragma unroll
          for (int i = 0; i < 4; ++i) { Av[i] = lstv[sa * 17 + 4 * q + i]; Ai[i] = lsti[sa * 17 + 4 * q + i]; }
#pragma unroll
          for (int jx = 0; jx < 16; ++jx) { Bv[jx] = lstv[sb * 17 + jx]; Bi[jx] = lsti[sb * 17 + jx]; }
          unsigned key[64];
#pragma unroll
          for (int i = 0; i < 4; ++i)
#pragma unroll
              for (int jx = 0; jx < 16; ++jx) key[i * 16 + jx] = (ordkey(Av[i] + Bv[jx]) & ~255u) | (unsigned)(255 - ((4 * q + i) * 16 + jx));
          const unsigned T = lane_radix16<64, 4>(key, lane);
          int mine = 0;
#pragma unroll
          for (int n = 0; n < 64; ++n) mine += key[n] >= T ? 1 : 0;
          const int c1 = __builtin_amdgcn_ds_bpermute((lane ^ 1) << 2, mine), c2 = __builtin_amdgcn_ds_bpermute((lane ^ 2) << 2, mine), c3 = __builtin_amdgcn_ds_bpermute((lane ^ 3) << 2, mine);
          int c = (q == 1) ? c1 : (q == 2) ? c2 + c3 : (q == 3) ? c1 + c2 + c3 : 0;
#pragma unroll
          for (int i = 0; i < 4; ++i) {
#pragma unroll
              for (int jx = 0; jx < 16; ++jx) if (key[i * 16 + jx] >= T) { const int r = t2 * 128 + hq * 16 + c; es4[r] = Av[i] + Bv[jx]; ei4[r] = Ai[i] * 128 + Bi[jx]; ++c; }
              __builtin_amdgcn_sched_barrier(0); }
        }
        asm volatile("s_waitcnt lgkmcnt(0)" ::: "memory");
        { int lane = F.lane; asm volatile("" : "+v"(lane));
#pragma unroll
        for (int rnd = 0; rnd < 4; ++rnd) { const int e = lane + 64 * rnd; const float s = es4[e];
            float m = s; m = fmaxf(m, shx(m, 1, lane)); m = fmaxf(m, shx(m, 2, lane)); m = fmaxf(m, shx(m, 4, lane)); m = fmaxf(m, shx(m, 8, lane));
            const float ex = __expf(s - m); float sum = ex; sum += shx(sum, 1, lane); sum += shx(sum, 2, lane); sum += shx(sum, 4, lane); sum += shx(sum, 8, lane);
            eg4[e] = ex / sum; } }
        asm volatile("s_waitcnt lgkmcnt(0)" ::: "memory");
      for (int tslot = 0; tslot < 2; ++tslot) {
        const int tok = tok0 + tslot * nwv; if (tok >= ntok) break;
        int lane = F.lane; asm volatile("" : "+v"(lane));
        const int R = tok_row(layer, tok), b = R / RB, j = R % RB; const bool isctx = j < CTX; const int modrow = isctx ? 4 : b;
        const LAS int* ei = ei4 + tslot * 128; const LAS float* eg = eg4 + tslot * 128;
        f32x2 xf[16];
#pragma unroll
        for (int i = 0; i < 2; ++i)
#pragma unroll
            for (int hh = 0; hh < 2; ++hh) { const u32x4 w = *(const u32x4*)(HB + (size_t)R * 2048 + lane * 16 + 1024 * i + 8 * hh);
                xf[8 * i + 4 * hh + 0] = (f32x2){bflo(w.x), bfhi(w.x)}; xf[8 * i + 4 * hh + 1] = (f32x2){bflo(w.y), bfhi(w.y)};
                xf[8 * i + 4 * hh + 2] = (f32x2){bflo(w.z), bfhi(w.z)}; xf[8 * i + 4 * hh + 3] = (f32x2){bflo(w.w), bfhi(w.w)}; }
        f32x2 y2[16];
#pragma unroll
        for (int i = 0; i < 16; ++i) y2[i] = (f32x2){0.f, 0.f};
        f32x4 xrow[8];
#pragma unroll
        for (int k = 0; k < 8; ++k) xrow[k] = *(const f32x4*)(X1 + (size_t)R * 2048 + lane * 32 + 4 * k);
        { u32x4 urA[4][2], vrA[4], urB[4][2], vrB[4]; unsigned vsA[4], vsB[4]; float gqA[4], gqB[4];
          peer_load(urA, vrA, vsA, gqA, ei, eg, U8, V4, lane, 0);
          for (int grp = 0; grp < 32; grp += 2) {
              peer_load(urB, vrB, vsB, gqB, ei, eg, U8, V4, lane, grp + 1);
              peer_comp(urA, vrA, vsA, gqA, xf, y2, lane);
              peer_load(urA, vrA, vsA, gqA, ei, eg, U8, V4, lane, grp + 2 < 32 ? grp + 2 : 31);
              peer_comp(urB, vrB, vsB, gqB, xf, y2, lane);
          } }
        const float* mod = WSP(const float, WS_MOD) + ((size_t)layer * 5 + modrow) * 12288;
        float y[32];
        float s = 0.f;
#pragma unroll
        for (int k = 0; k < 8; ++k) { const int c = lane * 32 + 4 * k;
            const f32x4 xa = xrow[k], ga = *(const f32x4*)(mod + 5 * 2048 + c);
            y[4 * k + 0] = ALPHA * xa[0] + ga[0] * y2[2 * k].x; y[4 * k + 1] = ALPHA * xa[1] + ga[1] * y2[2 * k].y;
            y[4 * k + 2] = ALPHA * xa[2] + ga[2] * y2[2 * k + 1].x; y[4 * k + 3] = ALPHA * xa[3] + ga[3] * y2[2 * k + 1].y;
            s += (y[4 * k + 0] + y[4 * k + 1]) + (y[4 * k + 2] + y[4 * k + 3]); }
        const float mean = wave_sum(s, lane) * (1.f / 2048.f); float q2 = 0.f;
#pragma unroll
        for (int i = 0; i < 32; ++i) { const float dd = y[i] - mean; q2 += dd * dd; }
        const float rstd = rsqrtf(wave_sum(q2, lane) * (1.f / 2048.f) + 1e-5f);
        float* dst = layer == 0 ? (isctx ? WSP(float, WS_XC) + ((size_t)b * CTX + j) * 2048 : F.out + ((size_t)b * S + (j - CTX)) * 2048) : F.out + ((size_t)b * S + (j - CTX)) * 2048;
        const float* modn = WSP(const float, WS_MOD) + ((size_t)1 * 5 + modrow) * 12288;
#pragma unroll
        for (int kk = 0; kk < 4; ++kk) { f32x4 o[2];
#pragma unroll
            for (int jj = 0; jj < 2; ++jj) { const int k = 2 * kk + jj, c = lane * 32 + 4 * k; const f32x4 la = *(const f32x4*)(lg + c), ba = *(const f32x4*)(lb + c);
#pragma unroll
                for (int e = 0; e < 4; ++e) o[jj][e] = (y[4 * k + e] - mean) * rstd * la[e] + ba[e];
                *(f32x4*)(dst + c) = o[jj]; }
            if (layer == 0) {
                const int c = lane * 32 + 8 * kk;
                const f32x4 sa = *(const f32x4*)(modn + 2048 + c), sb = *(const f32x4*)(modn + 2048 + c + 4), ha = *(const f32x4*)(modn + c), hb = *(const f32x4*)(modn + c + 4);
                *(u32x4*)(HB + (size_t)R * 2048 + c) = pg8::pack8(o[0] * (sa + 1.0f) + ha, o[1] * (sb + 1.0f) + hb); } }
      }
    }
}

struct Params { const float* in[cf::N_IN]; float* out; unsigned char* ws; int ph_lo, ph_hi; };

__global__ void __launch_bounds__(512, 2) mega_fwd(Params p) {
    using namespace cf;
    extern __shared__ __attribute__((aligned(16))) unsigned char smem[];
    Ctx F0;
    F0.in = p.in;
    F0.out = p.out; F0.ws = p.ws; F0.lds = (ldsp_t)smem;
    F0.tid = 0; F0.lane = 0; F0.wave = __builtin_amdgcn_readfirstlane(threadIdx.x >> 6); F0.G = gridDim.x; F0.bid = blockIdx.x;
    if (threadIdx.x < 64) ((LAS unsigned*)(F0.lds + MISC_OFF))[threadIdx.x] = 0u;
    __syncthreads();
    const int lo = p.ph_lo, hi = p.ph_hi;
    XcdBarrier bar; bar.bar = (unsigned*)(F0.ws + WS_CTL); bar.x = 0; bar.st = (volatile LAS unsigned*)(F0.lds + MISC_OFF); bar.wave = F0.wave;
    if (hi - lo > 1) bar = xcd_barrier_post((unsigned*)(F0.ws + WS_CTL), (volatile LAS unsigned*)(F0.lds + MISC_OFF), F0.wave);
#ifndef MK_MASK
#define MK_MASK 0xFFFF
#endif
#define ON(j) ((MK_MASK >> (j)) & 1)
#define IN(k) (lo <= (k) && (k) < hi)
#define SEAM(k) do { if (IN(k) && IN((k) + 1)) xcd_barrier(bar); } while (0)

    if (ON(9) && IN(0)) { ph_prologue(F0); if (DUPN(9) == 2) { __syncthreads(); ph_prologue(F0); } }
    SEAM(0);
    if (ON(10) && IN(1)) ph_modulate0(F0);
    SEAM(1);
    for (int l = 0; l < DEPTH; ++l) {
        const int pb = 2 + 8 * l;
        const int rmode = l == 0 ? 0 : 1, nMl = l == 0 ? 68 : 64;
        for (int blk = 0; blk < DUPN(12); ++blk) {
        if (blk) xcd_barrier(bar);
        if (ON(0) && IN(pb + 0)) { const Ctx F = phase_ctx(F0);
            pg8::Gemm g{WSP(const bf16_t, WS_HB), WSP(const bf16_t, WS_WIN) + (size_t)l * NC * 2048, 2048, 2048};
            pg8::EpiInProj E{WSP(bf16_t, WS_P), WSP(bf16_t, WS_KB), WSP(const float, WS_COSH), WSP(const float, WS_SINH), WSP(const float, WS_COSR), WSP(const float, WS_SINR),
                             F.in[I_AKN] + l * 128, F.in[I_AQN] + l * 128, WSP(float, WS_SSK), WSP(float, WS_SSQ), WSP(float, WS_SSKV), WSP(float, WS_SSCQ)};
            pg8::TileOrder S; S.init(nMl, 56, F.G, F.bid, rmode);
            for (int dup = 0; dup < DUPN(0); ++dup)
            pg8::gemm_phase(F.lds, g, S, E, F.wave);
            if (l > 0) { pg8::TileOrder S2; S2.init(4, 6, F.G, F.bid, 2); pg8::gemm_phase(F.lds, g, S2, E, F.wave); }
        }
        SEAM(pb + 0);
        if (ON(2) && IN(pb + 1)) { const Ctx F = phase_ctx(F0); bf16_t* P = WSP(bf16_t, WS_P);
            knorm_pass(F);
            { pg8::Gemm g{P + PC_CKV, WSP(const bf16_t, WS_WKVUP) + (size_t)l * 2048 * 256, NC, 256}; pg8::EpiKvUp E{WSP(bf16_t, WS_KB), WSP(bf16_t, WS_VB), WSP(const float, WS_SSKV)};
              pg8::TileOrder S; S.init(68, 8, F.G, F.bid, 0); for (int dup = 0; dup < DUPN(1); ++dup) pg8::gemm_phase(F.lds, g, S, E, F.wave); }
            { pg8::Gemm g{P + PC_CQ, WSP(const bf16_t, WS_WQUP) + (size_t)l * 1536 * 512, NC, 512}; pg8::EpiQUp E{WSP(bf16_t, WS_QB), WSP(const float, WS_COSR), WSP(const float, WS_SINR), WSP(const float, WS_SSCQ)};
              pg8::TileOrder S; S.init(nMl, 6, F.G, F.bid, rmode); for (int dup = 0; dup < DUPN(1); ++dup) pg8::gemm_phase(F.lds, g, S, E, F.wave); }
        }
        SEAM(pb + 1);
        if (ON(3) && IN(pb + 2)) ph_attn(F0, l);
        }
        SEAM(pb + 2);
        if (ON(4) && IN(pb + 3)) { const Ctx F = phase_ctx(F0); bf16_t* P = WSP(bf16_t, WS_P); bf16_t* HB = WSP(bf16_t, WS_HB);
            pg8::Gemm g{WSP(const bf16_t, WS_BR), WSP(const bf16_t, WS_WBR) + (size_t)l * 4 * 2048 * 1024, 4096, 1024};
            pg8::EpiMerge E{HB, P + PC_GATE, NC};
            pg8::TileOrder S; S.init(nMl, 8, F.G, F.bid, rmode, 4, (size_t)1024 * 2, (size_t)2048 * 1024 * 2);
            for (int dup = 0; dup < DUPN(5); ++dup) pg8::gemm_phase(F.lds, g, S, E, F.wave);
        }
        SEAM(pb + 3);
        if (ON(5) && IN(pb + 4)) { const Ctx F = phase_ctx(F0); bf16_t* HB = WSP(bf16_t, WS_HB);
            pg8::Gemm g{HB, WSP(const bf16_t, WS_WO) + (size_t)l * 2048 * 2048, 2048, 2048};
            pg8::EpiWo E{(float*)(F.ws + WS_P + X1_OFF), WSP(const float, WS_MOD) + (size_t)l * 5 * 12288, l == 0 ? F.in[I_X] : (const float*)F.out, F.in[I_CTX]};
            pg8::TileOrder S; S.init(nMl, 8, F.G, F.bid, rmode); for (int dup = 0; dup < DUPN(6); ++dup) pg8::gemm_phase(F.lds, g, S, E, F.wave);
        }
        SEAM(pb + 4);
        if (ON(6) && IN(pb + 5)) ph_ln1(F0, l);
        SEAM(pb + 5);
        if (ON(7) && IN(pb + 6)) { const Ctx F = phase_ctx(F0); bf16_t* HB = WSP(bf16_t, WS_HB);
            pg8::Gemm g{HB, WSP(const bf16_t, WS_WFOLD) + (size_t)l * 2048 * 2048, 2048, 2048}; pg8::EpiF32 E{(float*)(F.ws + WS_P + SC_OFF), 2048};
            pg8::TileOrder S; S.init(nMl, 8, F.G, F.bid, rmode); for (int dup = 0; dup < DUPN(7); ++dup) pg8::gemm_phase(F.lds, g, S, E, F.wave);
        }
        SEAM(pb + 6);
        if (ON(8) && IN(pb + 7)) { ph_peer(F0, l); if (DUPN(8) == 2 && l == 1) ph_peer(F0, l); }
        SEAM(pb + 7);
    }
#undef IN
#undef SEAM
}

extern "C" void kernel_launch(void* const* d_in, const int* in_sizes, int n_in, void* d_out, int out_size, void* d_ws, size_t ws_size, hipStream_t stream) {
    static int grid = 0;
    if (grid == 0) {
        if (n_in != cf::N_IN || out_size != cf::NB * cf::S * cf::D || ws_size < cf::WS_END) {
            fprintf(stderr, "kernel_launch: unexpected shapes: n_in %d out %d ws %zu (need %zu)\n", n_in, out_size, ws_size, (size_t)cf::WS_END); grid = -1; return; }
        int dev = 0, cus = 0;
        if (hipGetDevice(&dev) != hipSuccess || hipDeviceGetAttribute(&cus, hipDeviceAttributeMultiprocessorCount, dev) != hipSuccess || cus < 1) { grid = -1; return; }
        if (hipFuncSetAttribute((const void*)mega_fwd, hipFuncAttributeMaxDynamicSharedMemorySize, cf::LDS_BYTES) != hipSuccess) { fprintf(stderr, "kernel_launch: hipFuncSetAttribute failed\n"); grid = -1; return; }
        int per_cu = 0;
        if (hipOccupancyMaxActiveBlocksPerMultiprocessor(&per_cu, (const void*)mega_fwd, 512, cf::LDS_BYTES) != hipSuccess || per_cu < 1)
            fprintf(stderr, "kernel_launch: note: occupancy query reports %d workgroups per CU\n", per_cu);
        (void)hipGetLastError();
        grid = cus;
    }
    if (grid < 0) return;
    (void)hipMemsetAsync((char*)d_ws + cf::WS_CTL, 0, cf::CTL_BYTES, stream);
    Params p{};
    for (int i = 0; i < cf::N_IN; ++i) p.in[i] = (const float*)d_in[i];
    p.out = (float*)d_out; p.ws = (unsigned char*)d_ws;
#if MK_PER_PHASE
    for (int k = 0; k < cf::N_PHASES; ++k) { p.ph_lo = k; p.ph_hi = k + 1; hipLaunchKernelGGL(mega_fwd, dim3(grid), dim3(512), cf::LDS_BYTES, stream, p); }
#else
    p.ph_lo = 0; p.ph_hi = cf::N_PHASES;
    hipLaunchKernelGGL(mega_fwd, dim3(grid), dim3(512), cf::LDS_BYTES, stream, p);
#endif
    const hipError_t le = hipPeekAtLastError();
    if (le != hipSuccess) fprintf(stderr, "kernel_launch: launch failed: %s\n", hipGetErrorName(le));
}
```

```cpp
#include <hip/hip_runtime.h>
#include <stdint.h>
#include <stdio.h>

#ifndef MK_DUP
#define MK_DUP 0
#endif
#define DUPN(k) (((MK_DUP >> (k)) & 1) ? 2 : 1)
#ifndef MK_AV
#define MK_AV 0
#endif
#ifndef MK_PER_PHASE
#define MK_PER_PHASE 0
#endif

namespace cf {
constexpr int D = 2048, NB = 4, S = 4096, CTX = 256, RB = CTX + S  , MR = NB * RB  ;
constexpr int DEPTH = 2;
constexpr int PC_AK = 0, PC_AV = 256, PC_CKV = 512, PC_KR = 768, PC_DK = 1024, PC_DV = 1280, PC_KVEND = 1536;
constexpr int PC_AQ = 1536, PC_CQ = 2560, PC_DQ = 3072, PC_GLU = 4096, PC_GATE = 6144, NC = 14336;
constexpr int IN_COLS = 14144;
constexpr int NEXP = 16384;
constexpr float ALPHA = 1.4142135623730951f;
constexpr float LOG2E = 1.4426950408889634f;
constexpr float SCALE_HD = 0.08838834764831845f;
constexpr float SCALE_MLA = 0.07216878364870323f;
enum { I_X = 0, I_C, I_CTX, I_CCTX, I_WADA, I_BADA, I_WIN, I_AQN, I_AKN, I_BQN, I_WQUP, I_BKVN, I_WKVUP, I_CW, I_CB, I_CLG, I_CLB, I_SINK,
       I_WBRA, I_WBRB, I_WBRC, I_WBRD, I_WO, I_LN1G, I_LN1B, I_LN2G, I_LN2B, I_PWQ, I_PSK, I_PU, I_PV, N_IN };
constexpr size_t al(size_t x) { return (x + 255) / 256 * 256; }
constexpr size_t WS_CTL = 0;
constexpr size_t CTL_BYTES = 65536;
constexpr size_t WS_MOD = WS_CTL + CTL_BYTES;
constexpr size_t WS_COSH = WS_MOD + al((size_t)2 * 5 * 12288 * 4);
constexpr size_t WS_SINH = WS_COSH + (size_t)4096 * 64 * 4;
constexpr size_t WS_COSR = WS_SINH + (size_t)4096 * 64 * 4;
constexpr size_t WS_SINR = WS_COSR + (size_t)4096 * 32 * 4;
constexpr size_t WS_WIN = WS_SINR + (size_t)4096 * 32 * 4;
constexpr size_t WS_WQUP = WS_WIN + (size_t)2 * NC * 2048 * 2;
constexpr size_t WS_WKVUP = WS_WQUP + (size_t)2 * 1536 * 512 * 2;
constexpr size_t WS_WBR = WS_WKVUP + (size_t)2 * 2048 * 256 * 2;
constexpr size_t WS_WO = WS_WBR + (size_t)2 * 4 * 2048 * 1024 * 2;
constexpr size_t WS_WFOLD = WS_WO + (size_t)2 * 2048 * 2048 * 2;
constexpr size_t WS_UB = WS_WFOLD + (size_t)2 * 2048 * 2048 * 2;
constexpr size_t WS_VB2 = WS_UB + (size_t)2 * NEXP * 2048;
constexpr size_t WS_HB = WS_VB2 + (size_t)2 * NEXP * 2048;
constexpr size_t WS_P = WS_HB + (size_t)MR * 2048 * 2;
constexpr size_t WS_QB = WS_P + (size_t)MR * NC * 2;
constexpr size_t WS_KB = WS_QB + (size_t)MR * 1536 * 2;
constexpr size_t WS_VB = WS_KB + (size_t)MR * 1536 * 2;
constexpr size_t WS_BR = WS_VB + (size_t)MR * 1024 * 2;
constexpr size_t WS_XC = WS_BR + (size_t)MR * 4096 * 2;
constexpr size_t WS_SSK = WS_XC + (size_t)1024 * 2048 * 4;
constexpr size_t WS_SSQ = WS_SSK + (size_t)MR * 4 * 4;
constexpr size_t WS_SSKV = WS_SSQ + (size_t)MR * 16 * 4;
constexpr size_t WS_SSCQ = WS_SSKV + (size_t)MR * 4 * 4;
constexpr size_t WS_END = WS_SSCQ + (size_t)MR * 8 * 4;
constexpr size_t X1_OFF = 0, SC_OFF = (size_t)MR * 2048 * 4;
static_assert(SC_OFF * 2 <= (size_t)MR * NC * 2, "X1 + SC fit in P");
constexpr int LDS_BYTES = 132 * 1024;
constexpr int MISC_OFF = 128 * 1024;
constexpr int N_PHASES = 2 + 8 * DEPTH;
}

typedef unsigned short bf16_t;
typedef short bf16x8 __attribute__((ext_vector_type(8)));
typedef float f32x4 __attribute__((ext_vector_type(4)));
typedef float f32x2 __attribute__((ext_vector_type(2)));
typedef unsigned u32x4 __attribute__((ext_vector_type(4)));
typedef unsigned u32x2 __attribute__((ext_vector_type(2)));
#define LAS __attribute__((address_space(3)))
typedef LAS unsigned char* ldsp_t;

typedef __bf16 bf16x2v_t __attribute__((ext_vector_type(2)));
__device__ __forceinline__ unsigned cvt_pk_bf16(float lo, float hi) { const bf16x2v_t r = __builtin_convertvector((f32x2){lo, hi}, bf16x2v_t); return __builtin_bit_cast(unsigned, r); }
__device__ __forceinline__ bf16_t f2bf(float f) { return (bf16_t)(cvt_pk_bf16(f, 0.f) & 0xffffu); }
__device__ __forceinline__ float bf2f(bf16_t b) { return __uint_as_float(((unsigned)b) << 16); }
__device__ __forceinline__ float bflo(unsigned w) { return __uint_as_float(w << 16); }
__device__ __forceinline__ float bfhi(unsigned w) { return __uint_as_float(w & 0xffff0000u); }
__device__ __forceinline__ float shx(float v, int mask, int lane) { return __int_as_float(__builtin_amdgcn_ds_bpermute((lane ^ mask) << 2, __float_as_int(v))); }
__device__ __forceinline__ float wave_sum(float v, int lane) {
#pragma unroll
    for (int o = 32; o >= 1; o >>= 1) v += shx(v, o, lane);
    return v;
}
__device__ __forceinline__ int lane_id() { int l; asm volatile("v_mbcnt_lo_u32_b32 %0, -1, 0\n\tv_mbcnt_hi_u32_b32 %0, -1, %0" : "=v"(l)); return l; }
__device__ __forceinline__ float sigmoidf_(float x) { return __builtin_amdgcn_rcpf(1.0f + __builtin_amdgcn_exp2f(x * -1.4426950408889634f)); }

#define XB_TMO      128
#define XB_XCNT(j)  (256  + 64 * (j))
#define XB_XSUB(j)  (1280 + 64 * (j))
#define XB_XGEN(j)  (2304 + 64 * (j))
#define XB_TOP      3328
#define XB_TOPGEN   3392
#define XCD_BAR_WORDS 3456
#define XB_SPIN_CAP (1u << 23)
__device__ __forceinline__ unsigned xb_ld(unsigned* p)              { return __hip_atomic_load(p, __ATOMIC_RELAXED, __HIP_MEMORY_SCOPE_AGENT); }
__device__ __forceinline__ unsigned xb_add(unsigned* p, unsigned v) { return __hip_atomic_fetch_add(p, v, __ATOMIC_RELAXED, __HIP_MEMORY_SCOPE_AGENT); }
__device__ __forceinline__ unsigned xb_xcc_id() { return (unsigned)__builtin_amdgcn_s_getreg((3 << 11) | 20) & 0xFu; }
#define XB_SPIN(cond, bar) do { unsigned _sp = 0; while (cond) { __builtin_amdgcn_s_sleep(1); \
    if ((++_sp & 255u) == 0u) { if (xb_ld(&(bar)[XB_TMO])) break; if (_sp > XB_SPIN_CAP) { atomicAdd(&(bar)[XB_TMO], 1u); break; } } } } while (0)
struct XcdBarrier { unsigned* bar; unsigned x; volatile LAS unsigned* st; int wave; };
__device__ __forceinline__ XcdBarrier xcd_barrier_post(unsigned* bar, volatile LAS unsigned* st, int wave) {
    XcdBarrier b; b.bar = bar; b.x = xb_xcc_id(); b.st = st; b.wave = wave;
    if (wave == 0 && lane_id() == 0) (void)xb_add(&bar[XB_XCNT(b.x)], 1u);
    return b;
}
__device__ __forceinline__ void xcd_barrier_complete(unsigned* bar, unsigned x, unsigned& nloc, unsigned& nx) {
    const unsigned G = gridDim.x * gridDim.y * gridDim.z;
    unsigned sum, cnt, mine, sp = 0u;
    for (;;) {
        sum = 0u; cnt = 0u; mine = 0u;
#pragma unroll
        for (unsigned j = 0; j < 16; ++j) { const unsigned c = xb_ld(&bar[XB_XCNT(j)]); sum += c; cnt += (c > 0u) ? 1u : 0u; mine = (j == x) ? c : mine; }
        if (sum == G) break;
        __builtin_amdgcn_s_sleep(1);
        if ((++sp & 255u) == 0u) { if (xb_ld(&bar[XB_TMO])) break; if (sp > XB_SPIN_CAP) { atomicAdd(&bar[XB_TMO], 1u); break; } }
    }
    nloc = mine > 0u ? mine : 1u; nx = cnt > 0u ? cnt : 1u;
}
__device__ __forceinline__ void xcd_barrier(const XcdBarrier& b) {
    asm volatile("s_waitcnt vmcnt(0)" ::: "memory");
    __syncthreads();
    if (b.wave == 0 && lane_id() == 0) {
        unsigned* bar = b.bar;
        __builtin_amdgcn_s_waitcnt(0);
        unsigned nloc = b.st[0], nx = b.st[1];
        if (nloc == 0u) { xcd_barrier_complete(bar, b.x, nloc, nx); b.st[0] = nloc; b.st[1] = nx; }
        const unsigned old = xb_add(&bar[XB_XSUB(b.x)], 1u);
        const unsigned gen = old / nloc;
        if (old + 1u == (gen + 1u) * nloc) {
            __builtin_amdgcn_fence(__ATOMIC_RELEASE, "agent");
            asm volatile("s_waitcnt vmcnt(0)" ::: "memory");
            const unsigned og = xb_add(&bar[XB_TOP], 1u);
            const unsigned tg = og / nx;
            if (og + 1u == (tg + 1u) * nx) xb_add(&bar[XB_TOPGEN], 1u);
            else XB_SPIN(xb_ld(&bar[XB_TOPGEN]) == tg, bar);
            __builtin_amdgcn_fence(__ATOMIC_ACQUIRE, "agent");
            xb_add(&bar[XB_XGEN(b.x)], 1u);
            asm volatile("s_waitcnt vmcnt(0)" ::: "memory");
        } else {
            XB_SPIN(xb_ld(&bar[XB_XGEN(b.x)]) == gen, bar);
            __builtin_amdgcn_fence(__ATOMIC_ACQUIRE, "agent");
            asm volatile("s_waitcnt vmcnt(0)" ::: "memory");
        }
    }
    __syncthreads();
}

namespace pg8 {
constexpr int BM = 256, BK = 64, HALF = 128, HTB = HALF * BK * 2, STAGE_BYTES = 8 * HTB, NXCD = 8, WGM = 8;
__host__ __device__ __forceinline__ int lds_byte(int r, int c) { const int st = (r >> 4) * 2 + (c >> 5), rr = r & 15, cc = c & 31, ob = rr * 64 + cc * 2; return st * 1024 + (ob ^ (((ob >> 9) & 1) << 5)); }
__host__ __device__ __forceinline__ void stage_rc(int b, int& R, int& C) { const int st = b / 1024, sb = b % 1024, swz = sb ^ (((sb >> 9) & 1) << 5); R = (st >> 1) * 16 + swz / 64; C = (st & 1) * 32 + (swz % 64) / 2; }
__host__ __device__ __forceinline__ int perm32(int rho) { const int n = rho >> 4, i = rho & 15; return 8 * (i >> 2) + 4 * n + (i & 3); }
struct Unit { int pm, pn, sub; };
struct Gemm { const bf16_t* A; const bf16_t* Bt; int lda, K; };

struct TileOrder {
    int nM, nN, nwg, G, c, mode, nsub; size_t subA, subB;
    __device__ void init(int nM_, int nN_, int G_, int c_, int mode_, int nsub_ = 1, size_t subA_ = 0, size_t subB_ = 0) { nM = nM_; nN = nN_; nwg = nM * nN; G = G_; c = c_; mode = mode_; nsub = nsub_; subA = subA_; subB = subB_; }
    __device__ bool next(int i, Unit& u) const {
        const int it = nsub == 1 ? i : i / nsub; u.sub = nsub == 1 ? 0 : i - it * nsub;
        const long L = (long)it * G + c; if (L >= nwg) return false;
        int wgid = (int)L; { const int q = nwg / NXCD, r = nwg % NXCD, xcd = wgid % NXCD, off = wgid / NXCD; wgid = (xcd < r ? xcd * (q + 1) : r * (q + 1) + (xcd - r) * q) + off; }
        const int nig = WGM * nN, gid = wgid / nig, fm = gid * WGM, gsz = (nM - fm) < WGM ? (nM - fm) : WGM;
        const int pl = fm + ((wgid % nig) % gsz); u.pn = (wgid % nig) / gsz;
        u.pm = mode == 0 ? pl : (mode == 1 ? 17 * (pl >> 4) + 1 + (pl & 15) : 17 * pl);
        return true;
    }
    __device__ __forceinline__ void a_ready(const Unit&) const {}
    __device__ __forceinline__ void done(const Unit&) const {}
};

template <class Epi, class Sched>
__device__ __forceinline__ void gemm_phase(ldsp_t lds, const Gemm g, const Sched& S, const Epi& E, int wave_) {
    int tid = wave_ * 64 + lane_id(); asm volatile("" : "+v"(tid));
    const int wid = __builtin_amdgcn_readfirstlane(tid >> 6), lane = tid & 63, wr = wid >> 2, wc = wid & 3, fr = lane & 15, fq = lane >> 4;
    int K = g.K; asm volatile("" : "+s"(K));
    const int nt = K / BK, lda = g.lda;
    unsigned voffA[2], voffB[2];
#pragma unroll
    for (int i = 0; i < 2; ++i) { int R, C; stage_rc(tid * 16 + i * 8192, R, C); const int Rb = (R & ~31) + perm32(R & 31);
        voffA[i] = (unsigned)(R * lda + C) * 2u; voffB[i] = (unsigned)(Rb * K + C) * 2u; }
    const size_t kstep = (size_t)(BK * 2);
    const size_t hstepA = (size_t)HALF * lda * 2, hstepB = (size_t)HALF * K * 2;
    const size_t tstepA = 2 * hstepA, tstepB = 2 * hstepB;
    const unsigned ldsw = (unsigned)wid * 1024u;
    const int aoff = lds_byte(wr * 64 + fr, fq * 8), boff = lds_byte(wc * 32 + fr, fq * 8);
#define PG8_SA(b, h) (((b) * 2 + (h)) * HTB)
#define PG8_SB(b, h) ((4 + (b) * 2 + (h)) * HTB)
#define PG8_STAGE(bufoff, gbase, voff) do { _Pragma("unroll") for (int _i = 0; _i < 2; ++_i) \
        __builtin_amdgcn_global_load_lds((const unsigned*)((const char*)(gbase) + (voff)[_i]), (LAS unsigned*)(lds + (bufoff) + ldsw + _i * 8192), 16, 0, 0); } while (0)
#define PG8_LDA(dst, b, h) do { _Pragma("unroll") for (int m = 0; m < 4; ++m) _Pragma("unroll") for (int k = 0; k < 2; ++k) dst[m][k] = *(const LAS bf16x8*)(lds + PG8_SA(b, h) + aoff + m * 2048 + k * 1024); } while (0)
#define PG8_LDB(dst, b, h) do { _Pragma("unroll") for (int n = 0; n < 2; ++n) _Pragma("unroll") for (int k = 0; k < 2; ++k) dst[n][k] = *(const LAS bf16x8*)(lds + PG8_SB(b, h) + boff + n * 2048 + k * 1024); } while (0)
#define PG8_MMA(ai, bj, At, Bt) do { __builtin_amdgcn_s_setprio(1); _Pragma("unroll") for (int m = 0; m < 4; ++m) _Pragma("unroll") for (int n = 0; n < 2; ++n) _Pragma("unroll") for (int k = 0; k < 2; ++k) \
        acc[ai][bj][m][n] = __builtin_amdgcn_mfma_f32_16x16x32_bf16(Bt[n][k], At[m][k], acc[ai][bj][m][n], 0, 0, 0); __builtin_amdgcn_s_setprio(0); } while (0)
#define PG8_WAIT_V(n) asm volatile("s_waitcnt vmcnt(" #n ")" ::: "memory")
#define PG8_WAIT_L(n) asm volatile("s_waitcnt lgkmcnt(" #n ")" ::: "memory")
#define PG8_BAR __builtin_amdgcn_s_barrier()
#define PG8_SCHED __builtin_amdgcn_sched_barrier(0)
    Unit cur, nxt; int ui = 0;
    if (!S.next(0, cur)) return;
    f32x4 acc[2][2][4][2];
#pragma unroll
    for (int a = 0; a < 2; ++a)
#pragma unroll
        for (int b = 0; b < 2; ++b)
#pragma unroll
            for (int m = 0; m < 4; ++m)
#pragma unroll
                for (int n = 0; n < 2; ++n) acc[a][b][m][n] = (f32x4){0.f, 0.f, 0.f, 0.f};
    bf16x8 At[4][2], B0[2][2], B1[2][2];
    const char* cA = (const char*)g.A + (size_t)cur.pm * tstepA + cur.sub * S.subA; const char* cB = (const char*)g.Bt + (size_t)cur.pn * tstepB + cur.sub * S.subB;
    S.a_ready(cur);
    PG8_STAGE(PG8_SB(0, 0), cB, voffB); PG8_STAGE(PG8_SA(0, 0), cA, voffA); PG8_STAGE(PG8_SB(0, 1), cB + hstepB, voffB); PG8_STAGE(PG8_SA(0, 1), cA + hstepA, voffA);
    if (wr == 1) PG8_BAR;
    PG8_WAIT_V(4); PG8_BAR;
    PG8_STAGE(PG8_SB(1, 0), cB + kstep, voffB); PG8_STAGE(PG8_SA(1, 0), cA + kstep, voffA); PG8_STAGE(PG8_SB(1, 1), cB + hstepB + kstep, voffB);
    PG8_WAIT_V(6); PG8_BAR;
    for (;;) {
        const bool has_next = S.next(ui + 1, nxt);
        const char* nA = has_next ? (const char*)g.A + (size_t)nxt.pm * tstepA + nxt.sub * S.subA : cA; const char* nB = has_next ? (const char*)g.Bt + (size_t)nxt.pn * tstepB + nxt.sub * S.subB : cB;
#pragma unroll 1
        for (int t = 0; t < nt; t += 2) {
            const bool last = (t == nt - 2);
            const char* a1 = cA + (size_t)(t + 1) * kstep;
            const char* a2 = last ? nA : cA + (size_t)(t + 2) * kstep; const char* b2 = last ? nB : cB + (size_t)(t + 2) * kstep;
            const char* a3 = a2 + kstep; const char* b3 = b2 + kstep;
            if (last && has_next) S.a_ready(nxt);
            PG8_LDB(B0, 0, 0); PG8_SCHED; PG8_LDA(At, 0, 0); PG8_STAGE(PG8_SA(1, 1), a1 + hstepA, voffA);
            PG8_WAIT_L(8); PG8_BAR; PG8_WAIT_L(0); PG8_MMA(0, 0, At, B0); PG8_BAR; PG8_SCHED;
            PG8_LDB(B1, 0, 1); PG8_STAGE(PG8_SB(0, 0), b2, voffB);
            PG8_BAR; PG8_WAIT_L(0); PG8_MMA(0, 1, At, B1); PG8_BAR;
            PG8_LDA(At, 0, 1); PG8_STAGE(PG8_SA(0, 0), a2, voffA);
            PG8_BAR; PG8_WAIT_L(0); PG8_MMA(1, 0, At, B0); PG8_BAR; PG8_SCHED;
            PG8_STAGE(PG8_SB(0, 1), b2 + hstepB, voffB);
            PG8_WAIT_V(6); PG8_BAR; PG8_MMA(1, 1, At, B1); PG8_BAR;
            PG8_LDB(B0, 1, 0); PG8_SCHED; PG8_LDA(At, 1, 0); PG8_STAGE(PG8_SA(0, 1), a2 + hstepA, voffA);
            PG8_WAIT_L(8); PG8_BAR; PG8_WAIT_L(0); PG8_MMA(0, 0, At, B0); PG8_BAR; PG8_SCHED;
            PG8_LDB(B1, 1, 1); PG8_STAGE(PG8_SB(1, 0), b3, voffB);
            PG8_BAR; PG8_WAIT_L(0); PG8_MMA(0, 1, At, B1); PG8_BAR;
            PG8_LDA(At, 1, 1); PG8_STAGE(PG8_SA(1, 0), a3, voffA);
            PG8_BAR; PG8_WAIT_L(0); PG8_MMA(1, 0, At, B0); PG8_BAR; PG8_SCHED;
            PG8_STAGE(PG8_SB(1, 1), b3 + hstepB, voffB);
            PG8_WAIT_V(6); PG8_BAR; PG8_MMA(1, 1, At, B1); PG8_BAR;
        }
        E(acc, cur, wr, wc, fr, fq); S.done(cur);
        if (!has_next) break;
#pragma unroll
        for (int a = 0; a < 2; ++a)
#pragma unroll
            for (int b = 0; b < 2; ++b)
#pragma unroll
                for (int m = 0; m < 4; ++m)
#pragma unroll
                    for (int n = 0; n < 2; ++n) acc[a][b][m][n] = (f32x4){0.f, 0.f, 0.f, 0.f};
        cur = nxt; cA = nA; cB = nB; ++ui;
    }
    PG8_WAIT_V(0);
    if (wr == 0) PG8_BAR;
    PG8_BAR;
#undef PG8_SA
#undef PG8_SB
#undef PG8_STAGE
#undef PG8_LDA
#undef PG8_LDB
#undef PG8_MMA
#undef PG8_WAIT_V
#undef PG8_WAIT_L
#undef PG8_BAR
#undef PG8_SCHED
}

__device__ __forceinline__ u32x4 pack8(const f32x4 a, const f32x4 b) { u32x4 w; w.x = cvt_pk_bf16(a[0], a[1]); w.y = cvt_pk_bf16(a[2], a[3]); w.z = cvt_pk_bf16(b[0], b[1]); w.w = cvt_pk_bf16(b[2], b[3]); return w; }
#define EPI_ARGS const f32x4 (&acc)[2][2][4][2], const Unit& u, int wr, int wc, int fr_, int fq_
#define EPI_LANE int fr = fr_, fq = fq_; asm volatile("" : "+v"(fr), "+v"(fq));

struct EpiBf16 {
    bf16_t* O; int ldc;
    __device__ __forceinline__ void operator()(EPI_ARGS) const {
        EPI_LANE
        const int row0 = u.pm * BM + wr * 64 + fr, col0 = u.pn * BM + wc * 32 + 8 * fq;
#pragma unroll
        for (int ai = 0; ai < 2; ++ai)
#pragma unroll
            for (int m = 0; m < 4; ++m) { bf16_t* rowp = O + (size_t)(row0 + ai * HALF + m * 16) * ldc + col0;
#pragma unroll
                for (int bj = 0; bj < 2; ++bj) *(u32x4*)(rowp + bj * HALF) = pack8(acc[ai][bj][m][0], acc[ai][bj][m][1]); }
    }
};
struct EpiF32 {
    float* C; int ldc;
    __device__ __forceinline__ void operator()(EPI_ARGS) const {
        EPI_LANE
        const int row0 = u.pm * BM + wr * 64 + fr, col0 = u.pn * BM + wc * 32 + 8 * fq;
#pragma unroll
        for (int ai = 0; ai < 2; ++ai)
#pragma unroll
            for (int m = 0; m < 4; ++m) { float* rowp = C + (size_t)(row0 + ai * HALF + m * 16) * ldc + col0;
#pragma unroll
                for (int bj = 0; bj < 2; ++bj) { *(f32x4*)(rowp + bj * HALF) = acc[ai][bj][m][0]; *(f32x4*)(rowp + bj * HALF + 4) = acc[ai][bj][m][1]; } }
    }
};
struct EpiInProj {
    bf16_t* P; bf16_t* KB; const float* cosh; const float* sinh; const float* cosr; const float* sinr; const float* akn; const float* aqn;
    float* ssk; float* ssq; float* sskv; float* sscq;
    __device__ __forceinline__ void operator()(EPI_ARGS) const {
        EPI_LANE
        const int pn = u.pn, tb = u.pm % 17; const bool lat = tb != 0; const int posbase = (tb - 1) * 256;
        const int rl0 = wr * 64 + fr;
        if (pn >= 24) {
            const int col0 = pn * BM + wc * 32 + 8 * fq;
#pragma unroll
            for (int ai = 0; ai < 2; ++ai)
#pragma unroll
                for (int m = 0; m < 4; ++m) { bf16_t* rowp = P + ((size_t)u.pm * BM + rl0 + ai * HALF + m * 16) * cf::NC + col0;
#pragma unroll
                    for (int bj = 0; bj < 2; ++bj) { f32x4 v0 = acc[ai][bj][m][0], v1 = acc[ai][bj][m][1];
#pragma unroll
                        for (int e = 0; e < 4; ++e) { v0[e] = sigmoidf_(v0[e]); v1[e] = sigmoidf_(v1[e]); }
                        *(u32x4*)(rowp + bj * HALF) = pack8(v0, v1); } }
        } else if (pn >= 16) {
            const int col0 = cf::PC_GLU + 128 * (pn - 16) + wc * 32 + 8 * fq;
#pragma unroll
            for (int ai = 0; ai < 2; ++ai)
#pragma unroll
                for (int m = 0; m < 4; ++m) { f32x4 v0 = acc[ai][0][m][0], v1 = acc[ai][0][m][1]; const f32x4 g0 = acc[ai][1][m][0], g1 = acc[ai][1][m][1];
#pragma unroll
                    for (int e = 0; e < 4; ++e) { v0[e] *= sigmoidf_(g0[e]); v1[e] *= sigmoidf_(g1[e]); }
                    *(u32x4*)(P + ((size_t)u.pm * BM + rl0 + ai * HALF + m * 16) * cf::NC + col0) = pack8(v0, v1); }
        } else if (pn == 3) {
            if (wc == 0) { const int i0 = 8 * fq;
#pragma unroll
                for (int ai = 0; ai < 2; ++ai)
#pragma unroll
                    for (int m = 0; m < 4; ++m) { const int rl = rl0 + ai * HALF + m * 16;
                        f32x4 c0 = {1.f, 1.f, 1.f, 1.f}, c1 = c0, s0 = {0.f, 0.f, 0.f, 0.f}, s1 = s0;
                        if (lat) { const float* cp = cosr + (size_t)(posbase + rl) * 32 + i0; const float* sp = sinr + (size_t)(posbase + rl) * 32 + i0;
                            c0 = *(const f32x4*)cp; c1 = *(const f32x4*)(cp + 4); s0 = *(const f32x4*)sp; s1 = *(const f32x4*)(sp + 4); }
                        const f32x4 x1a = acc[ai][0][m][0], x1b = acc[ai][0][m][1], x2a = acc[ai][1][m][0], x2b = acc[ai][1][m][1];
                        const u32x4 w1 = pack8(x1a * c0 - x2a * s0, x1b * c1 - x2b * s1), w2 = pack8(x2a * c0 + x1a * s0, x2b * c1 + x1b * s1);
                        bf16_t* kb = KB + ((size_t)u.pm * BM + rl) * 1536 + 128 + i0;
#pragma unroll
                        for (int h = 0; h < 8; ++h) { *(u32x4*)(kb + h * 192) = w1; *(u32x4*)(kb + h * 192 + 32) = w2; }
                        asm volatile("" ::: "memory"); } }
        } else if (pn == 0 || pn == 4 || (pn >= 6 && pn <= 9) || pn >= 12) {
            const bool norm = pn == 0 || (pn >= 6 && pn <= 9);
            const int hl = wc >> 1, i0 = 32 * (wc & 1) + 8 * fq;
            f32x4 g1a = {1.f, 1.f, 1.f, 1.f}, g1b = g1a, g2a = g1a, g2b = g1a;
            if (norm) { const float* gn = (pn == 0 ? akn : aqn) + i0; g1a = *(const f32x4*)gn; g1b = *(const f32x4*)(gn + 4); g2a = *(const f32x4*)(gn + 64); g2b = *(const f32x4*)(gn + 68); }
            float* ssp = pn == 0 ? ssk + ((size_t)u.pm * BM * 2 + hl) * 2 + (wc & 1) : ssq + ((size_t)u.pm * BM * 8 + (pn - 6) * 2 + hl) * 2 + (wc & 1);
            const int sstr = pn == 0 ? 4 : 16;
#pragma unroll
            for (int ai = 0; ai < 2; ++ai)
#pragma unroll
                for (int m = 0; m < 4; ++m) { const int rl = rl0 + ai * HALF + m * 16;
                    f32x4 x1a = acc[ai][0][m][0], x1b = acc[ai][0][m][1], x2a = acc[ai][1][m][0], x2b = acc[ai][1][m][1];
                    if (norm) { const f32x4 q = x1a * x1a + x1b * x1b + x2a * x2a + x2b * x2b; float ss = (q[0] + q[1]) + (q[2] + q[3]);
                        ss += shx(ss, 16, fr + 16 * fq); ss += shx(ss, 32, fr + 16 * fq);
                        if (fq == 0) ssp[(size_t)rl * sstr] = ss;
                        x1a *= g1a; x1b *= g1b; x2a *= g2a; x2b *= g2b; }
                    f32x4 o1a = x1a, o1b = x1b, o2a = x2a, o2b = x2b;
                    if (lat) { const float* cp = cosh + (size_t)(posbase + rl) * 64 + i0; const float* sp = sinh + (size_t)(posbase + rl) * 64 + i0;
                        const f32x4 c0 = *(const f32x4*)cp, c1 = *(const f32x4*)(cp + 4), s0 = *(const f32x4*)sp, s1 = *(const f32x4*)(sp + 4);
                        o1a = x1a * c0 - x2a * s0; o1b = x1b * c1 - x2b * s1; o2a = x2a * c0 + x1a * s0; o2b = x2b * c1 + x1b * s1; }
                    bf16_t* dst = P + ((size_t)u.pm * BM + rl) * cf::NC + pn * BM + hl * 128 + i0;
                    *(u32x4*)dst = pack8(o1a, o1b); *(u32x4*)(dst + 64) = pack8(o2a, o2b);
                    asm volatile("" ::: "memory"); }
        } else {
            const int col0 = pn * BM + wc * 32 + 8 * fq;
            const bool ssq_on = pn == 2 || pn == 10 || pn == 11;
            float* ssp = pn == 2 ? sskv + (size_t)u.pm * BM * 4 + wc : sscq + (size_t)u.pm * BM * 8 + (pn - 10) * 4 + wc;
            const int sstr = pn == 2 ? 4 : 8;
#pragma unroll
            for (int ai = 0; ai < 2; ++ai)
#pragma unroll
                for (int m = 0; m < 4; ++m) { const int rl = rl0 + ai * HALF + m * 16; bf16_t* rowp = P + ((size_t)u.pm * BM + rl) * cf::NC + col0;
#pragma unroll
                    for (int bj = 0; bj < 2; ++bj) *(u32x4*)(rowp + bj * HALF) = pack8(acc[ai][bj][m][0], acc[ai][bj][m][1]);
                    if (ssq_on) { const f32x4 q = acc[ai][0][m][0] * acc[ai][0][m][0] + acc[ai][0][m][1] * acc[ai][0][m][1] + acc[ai][1][m][0] * acc[ai][1][m][0] + acc[ai][1][m][1] * acc[ai][1][m][1];
                        float ss = (q[0] + q[1]) + (q[2] + q[3]); ss += shx(ss, 16, fr + 16 * fq); ss += shx(ss, 32, fr + 16 * fq);
                        if (fq == 0) ssp[(size_t)rl * sstr] = ss; } }
        }
    }
};
struct EpiKvUp {
    bf16_t* KB; bf16_t* VB; const float* sskv;
    __device__ __forceinline__ void operator()(EPI_ARGS) const {
        EPI_LANE
        const int row0 = u.pm * BM + wr * 64 + fr, d0 = wc * 32 + 8 * fq;
        const bool isk = u.pn < 4;
        bf16_t* base = isk ? KB + (2 * u.pn) * 192 + d0 : VB + (u.pn - 4) * 256 + d0;
        const int ldr = isk ? 1536 : 1024, bjs = isk ? 192 : 128;
#pragma unroll
        for (int ai = 0; ai < 2; ++ai)
#pragma unroll
            for (int m = 0; m < 4; ++m) { const size_t row = (size_t)(row0 + ai * HALF + m * 16); bf16_t* rowp = base + row * ldr;
                const f32x4 pp = *(const f32x4*)(sskv + row * 4); const float r = rsqrtf(((pp[0] + pp[1]) + (pp[2] + pp[3])) * (1.f / 256.f) + 1e-6f);
#pragma unroll
                for (int bj = 0; bj < 2; ++bj) *(u32x4*)(rowp + bj * bjs) = pack8(acc[ai][bj][m][0] * r, acc[ai][bj][m][1] * r); }
    }
};
struct EpiQUp {
    bf16_t* QB; const float* cosr; const float* sinr; const float* sscq;
    __device__ __forceinline__ void operator()(EPI_ARGS) const {
        EPI_LANE
        const int row0 = u.pm * BM + wr * 64 + fr;
        if (u.pn < 4) {
            const int d0 = wc * 32 + 8 * fq;
#pragma unroll
            for (int ai = 0; ai < 2; ++ai)
#pragma unroll
                for (int m = 0; m < 4; ++m) { const size_t row = (size_t)(row0 + ai * HALF + m * 16);
                    const f32x4 pa = *(const f32x4*)(sscq + row * 8), pb = *(const f32x4*)(sscq + row * 8 + 4);
                    const float r = rsqrtf((((pa[0] + pa[1]) + (pa[2] + pa[3])) + ((pb[0] + pb[1]) + (pb[2] + pb[3]))) * (1.f / 512.f) + 1e-6f);
#pragma unroll
                    for (int bj = 0; bj < 2; ++bj) *(u32x4*)(QB + row * 1536 + (2 * u.pn + bj) * 192 + d0) = pack8(acc[ai][bj][m][0] * r, acc[ai][bj][m][1] * r); }
        } else {
            const int head = 4 * (u.pn - 4) + wc, i0 = 8 * fq;
            const bool lat = (u.pm % 17) != 0; const int posbase = (u.pm % 17) * 256 - 256;
#pragma unroll
            for (int ai = 0; ai < 2; ++ai)
#pragma unroll
                for (int m = 0; m < 4; ++m) { const int rl = wr * 64 + fr + ai * HALF + m * 16; const size_t row = (size_t)u.pm * BM + rl;
                    const f32x4 pa = *(const f32x4*)(sscq + row * 8), pb = *(const f32x4*)(sscq + row * 8 + 4);
                    const float r = rsqrtf((((pa[0] + pa[1]) + (pa[2] + pa[3])) + ((pb[0] + pb[1]) + (pb[2] + pb[3]))) * (1.f / 512.f) + 1e-6f);
                    f32x4 c0 = {1.f, 1.f, 1.f, 1.f}, c1 = c0, s0 = {0.f, 0.f, 0.f, 0.f}, s1 = s0;
                    if (lat) { const float* cp = cosr + (size_t)(posbase + rl) * 32 + i0; const float* sp = sinr + (size_t)(posbase + rl) * 32 + i0;
                        c0 = *(const f32x4*)cp; c1 = *(const f32x4*)(cp + 4); s0 = *(const f32x4*)sp; s1 = *(const f32x4*)(sp + 4); }
                    const f32x4 x1a = acc[ai][0][m][0] * r, x1b = acc[ai][0][m][1] * r, x2a = acc[ai][1][m][0] * r, x2b = acc[ai][1][m][1] * r;
                    const f32x4 o1a = x1a * c0 - x2a * s0, o1b = x1b * c1 - x2b * s1, o2a = x2a * c0 + x1a * s0, o2b = x2b * c1 + x1b * s1;
                    bf16_t* dst = QB + row * 1536 + head * 192 + 128 + i0;
                    *(u32x4*)dst = pack8(o1a, o1b); *(u32x4*)(dst + 32) = pack8(o2a, o2b); asm volatile("" ::: "memory"); }
        }
    }
};
struct EpiMerge {
    bf16_t* ACC; const bf16_t* gate0; int ldg;
    __device__ __forceinline__ void operator()(EPI_ARGS) const {
        EPI_LANE
        const int row0 = u.pm * BM + wr * 64 + fr, col0 = u.pn * BM + wc * 32 + 8 * fq;
        const bf16_t* gate = gate0 + u.sub * 2048; const bool first = u.sub == 0;
#pragma unroll
        for (int ai = 0; ai < 2; ++ai) {
            u32x4 gw[4][2], pw[4][2];
#pragma unroll
            for (int m = 0; m < 4; ++m) { const size_t row = (size_t)(row0 + ai * HALF + m * 16);
#pragma unroll
                for (int bj = 0; bj < 2; ++bj) { const int col = col0 + bj * HALF; gw[m][bj] = *(const u32x4*)(gate + row * ldg + col);
                    pw[m][bj] = (u32x4){0u, 0u, 0u, 0u}; if (!first) pw[m][bj] = *(const u32x4*)(ACC + row * 2048 + col); } }
#pragma unroll
            for (int m = 0; m < 4; ++m) { const size_t row = (size_t)(row0 + ai * HALF + m * 16);
#pragma unroll
                for (int bj = 0; bj < 2; ++bj) { const int col = col0 + bj * HALF; const u32x4 g = gw[m][bj], p = pw[m][bj];
                    const f32x4 a0 = acc[ai][bj][m][0], a1 = acc[ai][bj][m][1];
                    f32x4 r0, r1;
                    r0[0] = bflo(p.x) + bflo(g.x) * a0[0]; r0[1] = bfhi(p.x) + bfhi(g.x) * a0[1]; r0[2] = bflo(p.y) + bflo(g.y) * a0[2]; r0[3] = bfhi(p.y) + bfhi(g.y) * a0[3];
                    r1[0] = bflo(p.z) + bflo(g.z) * a1[0]; r1[1] = bfhi(p.z) + bfhi(g.z) * a1[1]; r1[2] = bflo(p.w) + bflo(g.w) * a1[2]; r1[3] = bfhi(p.w) + bfhi(g.w) * a1[3];
                    *(u32x4*)(ACC + row * 2048 + col) = pack8(r0, r1); } }
            asm volatile("" ::: "memory"); }
    }
};
struct EpiWo {
    float* X1; const float* mod  ; const float* xlat  ; const float* xctx  ;
    __device__ __forceinline__ void operator()(EPI_ARGS) const {
        EPI_LANE
        const int b = u.pm / 17, tb = u.pm % 17; const bool isctx = tb == 0;
        const float* g1 = mod + (size_t)(isctx ? 4 : b) * 12288 + 2 * 2048;
        const float* xbase = isctx ? xctx + (size_t)b * cf::CTX * 2048 : xlat + ((size_t)b * cf::S + (size_t)(tb - 1) * 256) * 2048;
        const int rl0 = wr * 64 + fr, col0 = u.pn * BM + wc * 32 + 8 * fq;
        f32x4 gv[2][2];
#pragma unroll
        for (int bj = 0; bj < 2; ++bj) { gv[bj][0] = *(const f32x4*)(g1 + col0 + bj * HALF); gv[bj][1] = *(const f32x4*)(g1 + col0 + bj * HALF + 4); }
#pragma unroll
        for (int ai = 0; ai < 2; ++ai) {
            f32x4 xv[4][2][2];
#pragma unroll
            for (int m = 0; m < 4; ++m) { const int rl = rl0 + ai * HALF + m * 16;
#pragma unroll
                for (int bj = 0; bj < 2; ++bj) { const float* xp = xbase + (size_t)rl * 2048 + col0 + bj * HALF; xv[m][bj][0] = *(const f32x4*)xp; xv[m][bj][1] = *(const f32x4*)(xp + 4); } }
#pragma unroll
            for (int m = 0; m < 4; ++m) { const int rl = rl0 + ai * HALF + m * 16; float* op = X1 + ((size_t)u.pm * BM + rl) * 2048 + col0;
#pragma unroll
                for (int bj = 0; bj < 2; ++bj) { *(f32x4*)(op + bj * HALF) = xv[m][bj][0] * cf::ALPHA + gv[bj][0] * acc[ai][bj][m][0];
                    *(f32x4*)(op + bj * HALF + 4) = xv[m][bj][1] * cf::ALPHA + gv[bj][1] * acc[ai][bj][m][1]; } }
            asm volatile("" ::: "memory"); }
    }
};
}

struct Ctx {
    const float* const* in; float* out; unsigned char* ws;
    ldsp_t lds; int tid, lane, wave, G, bid;
};
#define WSP(T, off) ((T*)(F.ws + (off)))
__device__ __forceinline__ Ctx phase_ctx(const Ctx& F0) {
    Ctx C = F0;
    C.tid = F0.wave * 64 + lane_id();
    asm volatile("" : "+v"(C.tid));
    { size_t z = 0; asm volatile("" : "+s"(z)); C.ws = F0.ws + z; }
    C.lane = C.tid & 63; C.wave = __builtin_amdgcn_readfirstlane(C.tid >> 6);
    return C;
}

__device__ __forceinline__ int srcmap(int mode, int n) {
    if (mode == 0) {
        const int pn = n >> 8, q = n & 255, bj = q >> 7, r = q & 127, rope = (r >> 6) * 128 + bj * 64 + (r & 63);
        if (pn == 0) return rope;
        if (pn == 1) return 256 + q;
        if (pn == 2) return 512 + q;
        if (pn == 3) return r < 32 ? 768 + bj * 32 + r : -1;
        if (pn == 4) return 832 + rope;
        if (pn == 5) return 1088 + q;
        if (pn < 10) return 1344 + (pn - 6) * 256 + rope;
        if (pn < 12) return 2368 + (pn - 10) * 256 + q;
        if (pn < 16) return 2880 + (pn - 12) * 256 + rope;
        if (pn < 24) return 3904 + bj * 1024 + 128 * (pn - 16) + r;
        return 5952 + (n - 6144);
    }
    if (mode == 1) { if (n < 1024) return (n >> 7) * 192 + (n & 127);
        const int m = n - 1024, t = m >> 8, bj = (m >> 7) & 1, q = m & 127; return (4 * t + (q >> 5)) * 192 + 128 + bj * 32 + (q & 31); }
    if (mode == 2) { if (n < 1024) return (n >> 7) * 256 + (n & 127); const int m = n - 1024; return (m >> 7) * 256 + 128 + (m & 127); }
    return n;
}
__device__ __forceinline__ void tr_tile(const Ctx& F, const float* src, int ld_src, int mode, int k0, bf16_t* dst, int ldd, int n0, const float* kscale = nullptr) {
    LAS float* T = (LAS float*)F.lds;
    const int kr = F.tid >> 6, nc = (F.tid & 63) * 4, sc = srcmap(mode, n0 + nc);
    f32x4 v[8];
#pragma unroll
    for (int h = 0; h < 8; ++h) { v[h] = (f32x4){0.f, 0.f, 0.f, 0.f}; if (sc >= 0) v[h] = *(const f32x4*)(src + (size_t)(k0 + kr + 8 * h) * ld_src + sc); }
#pragma unroll
    for (int h = 0; h < 8; ++h) { const int k = kr + 8 * h; f32x4 x = v[h]; if (kscale) x = x * kscale[k0 + k];
        T[k * 257 + nc + 0] = x[0]; T[k * 257 + nc + 1] = x[1]; T[k * 257 + nc + 2] = x[2]; T[k * 257 + nc + 3] = x[3]; }
    __syncthreads();
    const int n = F.tid >> 1, kc = (F.tid & 1) * 32;
#pragma unroll
    for (int j = 0; j < 4; ++j) { u32x4 w; const int kb = kc + 8 * j;
        w.x = cvt_pk_bf16(T[(kb + 0) * 257 + n], T[(kb + 1) * 257 + n]); w.y = cvt_pk_bf16(T[(kb + 2) * 257 + n], T[(kb + 3) * 257 + n]);
        w.z = cvt_pk_bf16(T[(kb + 4) * 257 + n], T[(kb + 5) * 257 + n]); w.w = cvt_pk_bf16(T[(kb + 6) * 257 + n], T[(kb + 7) * 257 + n]);
        *(u32x4*)(dst + (size_t)(n0 + n) * ldd + k0 + kb) = w; }
    __syncthreads();
}
__device__ __forceinline__ void cvt_rows(const Ctx& F, const float* src, bf16_t* dst, size_t n8) {
    for (size_t i = (size_t)F.bid * 512 + F.tid; i < n8; i += (size_t)F.G * 512) {
        const f32x4 a = *(const f32x4*)(src + i * 8), b = *(const f32x4*)(src + i * 8 + 4);
        *(u32x4*)(dst + i * 8) = pg8::pack8(a, b); }
}

__device__ __forceinline__ void cvt_rows_fp8(const Ctx& F, const float* src, unsigned char* dst, size_t n16, float scale) {
    const size_t stride = (size_t)F.G * 512;
    for (size_t i = (size_t)F.bid * 512 + F.tid; i < n16; i += 2 * stride) {
        const size_t i2 = i + stride; const bool two = i2 < n16;
        f32x4 a[8];
#pragma unroll
        for (int j = 0; j < 4; ++j) { a[j] = *(const f32x4*)(src + i * 16 + 4 * j); a[4 + j] = two ? *(const f32x4*)(src + i2 * 16 + 4 * j) : (f32x4){0.f, 0.f, 0.f, 0.f}; }
        u32x4 w0, w1;
#pragma unroll
        for (int j = 0; j < 4; ++j) { const f32x4 x = a[j] * scale, y = a[4 + j] * scale;
            int p = 0; p = __builtin_amdgcn_cvt_pk_fp8_f32(x[0], x[1], p, false); p = __builtin_amdgcn_cvt_pk_fp8_f32(x[2], x[3], p, true); w0[j] = (unsigned)p;
            int q = 0; q = __builtin_amdgcn_cvt_pk_fp8_f32(y[0], y[1], q, false); q = __builtin_amdgcn_cvt_pk_fp8_f32(y[2], y[3], q, true); w1[j] = (unsigned)q; }
        *(u32x4*)(dst + i * 16) = w0; if (two) *(u32x4*)(dst + i2 * 16) = w1; }
}

constexpr int V4_ROW = 1088;
__device__ __forceinline__ void cvt_rows_fp4(const Ctx& F, const float* src, unsigned char* dst, size_t nblk) {
    for (size_t i = (size_t)F.bid * 512 + F.tid; i < nblk; i += (size_t)F.G * 512) {
        f32x4 a[8]; float amax = 0.f;
#pragma unroll
        for (int j = 0; j < 8; ++j) { a[j] = *(const f32x4*)(src + i * 32 + 4 * j); amax = fmaxf(amax, fmaxf(fmaxf(fabsf(a[j][0]), fabsf(a[j][1])), fmaxf(fabsf(a[j][2]), fabsf(a[j][3])))); }
        int e = amax > 0.f ? (int)ceilf(log2f(amax * (1.0f / 6.0f))) : -126; e = e < -126 ? -126 : (e > 126 ? 126 : e);
        const float inv = __uint_as_float((unsigned)(127 - e) << 23);
        u32x4 w;
#pragma unroll
        for (int j = 0; j < 4; ++j) { const f32x4 x = a[2 * j] * inv, y = a[2 * j + 1] * inv; unsigned p = 0u;
            p = __builtin_amdgcn_cvt_scalef32_pk_fp4_f32(p, x[0], x[1], 1.0f, 0); p = __builtin_amdgcn_cvt_scalef32_pk_fp4_f32(p, x[2], x[3], 1.0f, 1);
            p = __builtin_amdgcn_cvt_scalef32_pk_fp4_f32(p, y[0], y[1], 1.0f, 2); p = __builtin_amdgcn_cvt_scalef32_pk_fp4_f32(p, y[2], y[3], 1.0f, 3); w[j] = p; }
        const size_t row = i >> 6; const int bl = (int)(i & 63);
        *(u32x4*)(dst + row * V4_ROW + bl * 16) = w; dst[row * V4_ROW + 1024 + bl] = (unsigned char)(e + 127);
    }
}

__device__ __forceinline__ void ph_prologue(const Ctx& F0) {
    const Ctx F = phase_ctx(F0);
    using namespace cf;
    constexpr int T_WIN = 2 * 32 * 56, T_QUP = 2 * 8 * 6, T_KVUP = 2 * 4 * 8, T_BR = 2 * 4 * 16 * 8, T_WO = 2 * 32 * 8;
    constexpr int T_ALL = T_WIN + T_QUP + T_KVUP + T_BR + T_WO;
    for (int u = F.bid; u < T_ALL; u += F.G) {
        int t = u;
        if (t < T_WIN) { const int l = t / (32 * 56), r = t % (32 * 56), kt = r / 56, nt = r % 56;
            tr_tile(F, F.in[I_WIN] + (size_t)l * 2048 * IN_COLS, IN_COLS, 0, kt * 64, WSP(bf16_t, WS_WIN) + (size_t)l * NC * 2048, 2048, nt * 256); continue; }
        t -= T_WIN;
        if (t < T_QUP) { const int l = t / (8 * 6), r = t % (8 * 6), kt = r / 6, nt = r % 6;
            tr_tile(F, F.in[I_WQUP] + (size_t)l * 512 * 1536, 1536, 1, kt * 64, WSP(bf16_t, WS_WQUP) + (size_t)l * 1536 * 512, 512, nt * 256, F.in[I_BQN] + l * 512); continue; }
        t -= T_QUP;
        if (t < T_KVUP) { const int l = t / (4 * 8), r = t % (4 * 8), kt = r / 8, nt = r % 8;
            tr_tile(F, F.in[I_WKVUP] + (size_t)l * 256 * 2048, 2048, 2, kt * 64, WSP(bf16_t, WS_WKVUP) + (size_t)l * 2048 * 256, 256, nt * 256, F.in[I_BKVN] + l * 256); continue; }
        t -= T_KVUP;
        if (t < T_BR) { const int l = t / (4 * 128), r = t % (4 * 128), br = r / 128, r2 = r % 128, kt = r2 / 8, nt = r2 % 8;
            const float* src = (br == 0 ? F.in[I_WBRA] : br == 1 ? F.in[I_WBRB] : br == 2 ? F.in[I_WBRC] : F.in[I_WBRD]) + (size_t)l * 1024 * 2048;
            tr_tile(F, src, 2048, 3, kt * 64, WSP(bf16_t, WS_WBR) + ((size_t)l * 4 + br) * 2048 * 1024, 1024, nt * 256); continue; }
        t -= T_BR;
        { const int l = t / 256, r = t % 256, kt = r / 8, nt = r % 8;
            tr_tile(F, F.in[I_WO] + (size_t)l * 2048 * 2048, 2048, 3, kt * 64, WSP(bf16_t, WS_WO) + (size_t)l * 2048 * 2048, 2048, nt * 256); }
    }
    for (int u = F.bid; u < 2 * 16 * 32; u += F.G) {
        const int l = u / 512, g = (u % 512) / 32, d0 = (u % 32) * 64;
        LAS float* sk = (LAS float*)F.lds; LAS float* wt = (LAS float*)(F.lds + 128 * 129 * 4);
        const float* skg = F.in[I_PSK] + ((size_t)l * 16 + g) * 128 * 128;
        const float* wqg = F.in[I_PWQ] + (size_t)l * 2048 * 2048 + (size_t)d0 * 2048 + g * 128;
        for (int i = F.tid; i < 128 * 128; i += 512) sk[(i >> 7) * 129 + (i & 127)] = skg[i];
        for (int i = F.tid; i < 64 * 128; i += 512) wt[(i >> 7) * 129 + (i & 127)] = wqg[(size_t)(i >> 7) * 2048 + (i & 127)];
        __syncthreads();
        const int n = F.tid & 127, dg = F.tid >> 7;
        float a[16];
#pragma unroll
        for (int e = 0; e < 16; ++e) a[e] = 0.f;
        for (int k = 0; k < 128; ++k) { const float s = sk[n * 129 + k];
#pragma unroll
            for (int e = 0; e < 16; ++e) a[e] += wt[(dg * 16 + e) * 129 + k] * s; }
        bf16_t* dst = WSP(bf16_t, WS_WFOLD) + (size_t)l * 2048 * 2048 + (size_t)(g * 128 + n) * 2048 + d0 + dg * 16;
        u32x4 w0, w1;
        w0.x = cvt_pk_bf16(a[0], a[1]); w0.y = cvt_pk_bf16(a[2], a[3]); w0.z = cvt_pk_bf16(a[4], a[5]); w0.w = cvt_pk_bf16(a[6], a[7]);
        w1.x = cvt_pk_bf16(a[8], a[9]); w1.y = cvt_pk_bf16(a[10], a[11]); w1.z = cvt_pk_bf16(a[12], a[13]); w1.w = cvt_pk_bf16(a[14], a[15]);
        *(u32x4*)dst = w0; *(u32x4*)(dst + 8) = w1;
        __syncthreads();
    }
    for (int u = F.bid; u < 2 * 192; u += F.G) {
        const int l = u / 192, n0 = (u % 192) * 64;
        LAS float* sl = (LAS float*)F.lds; LAS float* red = (LAS float*)(F.lds + 5 * 2048 * 4);
        for (int i = F.tid; i < 5 * 2048; i += 512) { const int r = i >> 11, k = i & 2047; const float v = r < 4 ? F.in[I_C][r * 2048 + k] : F.in[I_CCTX][k]; sl[i] = v * sigmoidf_(v); }
        __syncthreads();
        const int cg = F.tid & 15, ks = F.tid >> 4;
        f32x4 a[5];
#pragma unroll
        for (int r = 0; r < 5; ++r) a[r] = (f32x4){0.f, 0.f, 0.f, 0.f};
        const float* wp = F.in[I_WADA] + (size_t)l * 2048 * 12288 + n0 + cg * 4;
#pragma unroll 8
        for (int k = ks * 64; k < ks * 64 + 64; ++k) { const f32x4 w = *(const f32x4*)(wp + (size_t)k * 12288);
#pragma unroll
            for (int r = 0; r < 5; ++r) a[r] += w * sl[r * 2048 + k]; }
#pragma unroll
        for (int r = 0; r < 5; ++r) *(LAS f32x4*)(red + (ks * 5 + r) * 64 + cg * 4) = a[r];
        __syncthreads();
        if (F.tid < 320) { const int r = F.tid >> 6, col = F.tid & 63; float sacc = 0.f;
#pragma unroll
            for (int k2 = 0; k2 < 32; ++k2) sacc += red[(k2 * 5 + r) * 64 + col];
            WSP(float, WS_MOD)[((size_t)l * 5 + r) * 12288 + n0 + col] = sacc + F.in[I_BADA][(size_t)l * 12288 + n0 + col]; }
        __syncthreads();
    }
    for (int i = F.bid * 512 + F.tid; i < 4096 * 64; i += F.G * 512) {
        const int pos = i >> 6, j = i & 63, fi = j & 31; const float fr = powf(10000.0f, -(float)(2 * fi) / 64.0f);
        const float ang = (float)(j < 32 ? (pos >> 6) : (pos & 63)) * fr;
        WSP(float, WS_COSH)[i] = cosf(ang); WSP(float, WS_SINH)[i] = sinf(ang);
    }
    for (int i = F.bid * 512 + F.tid; i < 4096 * 32; i += F.G * 512) {
        const int pos = i >> 5, j = i & 31, fi = j & 15; const float fr = powf(10000.0f, -(float)(2 * fi) / 32.0f);
        const float ang = (float)(j < 16 ? (pos >> 6) : (pos & 63)) * fr;
        WSP(float, WS_COSR)[i] = cosf(ang); WSP(float, WS_SINR)[i] = sinf(ang);
    }
    cvt_rows_fp8(F, F.in[I_PU], WSP(unsigned char, WS_UB), (size_t)2 * NEXP * 2048 / 16, 1024.f);
    cvt_rows_fp4(F, F.in[I_PV], WSP(unsigned char, WS_VB2), (size_t)2 * NEXP * 64);
}

__device__ __forceinline__ void ph_modulate0(const Ctx& F0) {
    const Ctx F = phase_ctx(F0);
    using namespace cf;
    const float* mod = WSP(float, WS_MOD);
    for (size_t i = (size_t)F.bid * 512 + F.tid; i < (size_t)MR * 256; i += (size_t)F.G * 512) {
        const int R = (int)(i >> 8), d = (int)(i & 255) * 8, b = R / RB, j = R % RB;
        const float* src = j < CTX ? F.in[I_CTX] + ((size_t)b * CTX + j) * 2048 : F.in[I_X] + ((size_t)b * S + (j - CTX)) * 2048;
        const float* m = mod + (size_t)(j < CTX ? 4 : b) * 12288;
        const f32x4 x0 = *(const f32x4*)(src + d), x1 = *(const f32x4*)(src + d + 4);
        const f32x4 sh0 = *(const f32x4*)(m + d), sh1 = *(const f32x4*)(m + d + 4), s0 = *(const f32x4*)(m + 2048 + d), s1 = *(const f32x4*)(m + 2048 + d + 4);
        *(u32x4*)(WSP(bf16_t, WS_HB) + (size_t)R * 2048 + d) = pg8::pack8(x0 * (s0 + 1.0f) + sh0, x1 * (s1 + 1.0f) + sh1);
    }
}

__device__ __forceinline__ void knorm_pass(const Ctx& F) {
    using namespace cf;
    bf16_t* P = WSP(bf16_t, WS_P); const float* ssk = WSP(const float, WS_SSK);
    for (int it = F.bid * 8 + F.wave; it < MR * 2; it += F.G * 8) {
        const int R = it >> 1, h = it & 1;
        const f32x2 pp = *(const f32x2*)(ssk + (size_t)it * 2); const float r = rsqrtf((pp.x + pp.y) * (1.f / 128.f) + 1e-6f);
        unsigned* q = (unsigned*)(P + (size_t)R * NC + PC_AK + h * 128) + F.lane;
        const unsigned w = *q; *q = cvt_pk_bf16(bflo(w) * r, bfhi(w) * r);
    }
}

struct AttnArgs {
    const bf16_t* Q; const bf16_t* K; const bf16_t* V; bf16_t* O; int ldq, ldk, ldv, ldo;
    int seg0_row, seg0_tiles, seg1_row, seg1_tiles;
    int mask_on, qpos0, kpos1;
    float sc_log2; int has_sink; float sink_l2;
    int variant;
    const float* qss;
};
typedef float f32x16 __attribute__((ext_vector_type(16)));
template <int DK, bool MASKED>
__device__ __forceinline__ void attn_unit(ldsp_t lds, const AttnArgs a, int wave_) {
    constexpr int ND = DK / 16, KCH = DK / 8, KPT = (64 * KCH) / 512, VST = 72, KM = DK == 128 ? 15 : 7;
    constexpr int KBUF = 64 * DK * 2, VBUF = 128 * VST * 2, VOFF = 2 * KBUF, ALOFF = VOFF + 3 * VBUF;
    int tid = wave_ * 64 + lane_id(); asm volatile("" : "+v"(tid));
    const int wid = __builtin_amdgcn_readfirstlane(tid >> 6), lane = tid & 63, q32 = lane & 31, hi = lane >> 5;
    LAS float* al = (LAS float*)(lds + ALOFF + wid * 128);
    bf16x8 qf[ND];
    { float scq = a.sc_log2;
      if (a.qss) { const f32x2 pp = *(const f32x2*)(a.qss + (size_t)(wid * 32 + q32) * 16); scq *= rsqrtf((pp.x + pp.y) * (1.f / 128.f) + 1e-6f); }
      const bf16_t* qrow = a.Q + (size_t)(wid * 32 + q32) * a.ldq + 8 * hi;
#pragma unroll
      for (int s = 0; s < ND; ++s) { const u32x4 w = *(const u32x4*)(qrow + 16 * s); u32x4 o;
          o.x = cvt_pk_bf16(bflo(w.x) * scq, bfhi(w.x) * scq); o.y = cvt_pk_bf16(bflo(w.y) * scq, bfhi(w.y) * scq);
          o.z = cvt_pk_bf16(bflo(w.z) * scq, bfhi(w.z) * scq); o.w = cvt_pk_bf16(bflo(w.w) * scq, bfhi(w.w) * scq); qf[s] = *(bf16x8*)&o; } }
    f32x16 o[4];
#pragma unroll
    for (int db = 0; db < 4; ++db)
#pragma unroll
        for (int r = 0; r < 16; ++r) o[db][r] = 0.f;
    float m_run = -1e30f, l_run = 0.f;
    const int PV_ = MK_AV ? a.variant : 0;
    const int ntiles = a.seg0_tiles + a.seg1_tiles;
    u32x4 vreg[2];
    const int vkp = tid & 31, vdc = tid >> 5;
    const int vkey = 2 * vkp, vpos = (vkey & 48) | ((vkey & 4) << 1) | ((vkey & 8) >> 1) | (vkey & 3);
    unsigned koff[KPT];
#pragma unroll
    for (int i = 0; i < KPT; ++i) { const int P = (i * 8 + wid) * 64 + lane, row = P / KCH, cp = P % KCH; koff[i] = (unsigned)(row * a.ldk + 8 * (cp ^ (row & KM))) * 2u; }
#define ATT_LOAD(tt, kb) do { const int _r0 = (tt) < a.seg0_tiles ? a.seg0_row + 64 * (tt) : a.seg1_row + 64 * ((tt) - a.seg0_tiles); \
        const char* _kg = (const char*)(a.K + (size_t)_r0 * a.ldk); \
        _Pragma("unroll") for (int _i = 0; _i < KPT; ++_i) __builtin_amdgcn_global_load_lds((const unsigned*)(_kg + koff[_i]), (LAS unsigned*)(lds + (kb) * KBUF + (_i * 8 + wid) * 1024), 16, 0, 0); \
        vreg[0] = *(const u32x4*)(a.V + (size_t)(_r0 + 2 * vkp) * a.ldv + 8 * vdc); vreg[1] = *(const u32x4*)(a.V + (size_t)(_r0 + 2 * vkp + 1) * a.ldv + 8 * vdc); } while (0)
#define ATT_WRITE(vb) do { const ldsp_t _vb = lds + VOFF + (vb) * VBUF; \
        const unsigned _a0[4] = {vreg[0].x, vreg[0].y, vreg[0].z, vreg[0].w}, _a1[4] = {vreg[1].x, vreg[1].y, vreg[1].z, vreg[1].w}; \
        _Pragma("unroll") for (int _e = 0; _e < 4; ++_e) { \
            *(LAS unsigned*)(_vb + ((8 * vdc + 2 * _e) * VST + vpos) * 2) = (_a0[_e] & 0xffffu) | (_a1[_e] << 16); \
            *(LAS unsigned*)(_vb + ((8 * vdc + 2 * _e + 1) * VST + vpos) * 2) = (_a0[_e] >> 16) | (_a1[_e] & 0xffff0000u); } } while (0)
#define ATT_PV(vb) do { const ldsp_t _vt = lds + VOFF + (vb) * VBUF; \
        _Pragma("unroll") for (int db = 0; db < 4; ++db) _Pragma("unroll") for (int ks = 0; ks < 4; ++ks) { \
            const bf16x8 vf = *(const LAS bf16x8*)(_vt + ((32 * db + q32) * VST + 16 * ks + 8 * hi) * 2); \
            o[db] = __builtin_amdgcn_mfma_f32_32x32x16_bf16(pa[ks], vf, o[db], 0, 0, 0); } } while (0)
    bf16x8 pa[4];
#pragma unroll
    for (int i = 0; i < 4; ++i) pa[i] = (bf16x8){0, 0, 0, 0, 0, 0, 0, 0};
    int vprev = 2, vcur = 0, vnext = 1;
    { unsigned z0 = 0u; asm volatile("" : "+v"(z0));
      for (int i = tid; i < VBUF / 16; i += 512) *(LAS u32x4*)(lds + VOFF + 2 * VBUF + i * 16) = (u32x4){z0, z0, z0, z0}; }
    ATT_LOAD(0, 0);
    ATT_WRITE(0);
    asm volatile("s_waitcnt vmcnt(0)" ::: "memory");
    __syncthreads();
    for (int tt = 0; tt < ntiles; ++tt) {
        const int cur = tt & 1;
        if (tt + 1 < ntiles && PV_ != 4) ATT_LOAD(tt + 1, cur ^ 1);
        const ldsp_t Ks = lds + cur * KBUF;
        f32x16 s0, s1;
#pragma unroll
        for (int r = 0; r < 16; ++r) { s0[r] = 0.f; s1[r] = 0.f; }
        { bf16x8 kf[2][2];
#define ATT_LDK(p, sb) do { kf[p][0] = *(const LAS bf16x8*)(Ks + (q32 * KCH + ((2 * (sb) + hi) ^ (q32 & KM))) * 16); kf[p][1] = *(const LAS bf16x8*)(Ks + ((32 + q32) * KCH + ((2 * (sb) + hi) ^ (q32 & KM))) * 16); } while (0)
          if (PV_ != 2) {
          ATT_LDK(0, 0); __builtin_amdgcn_sched_barrier(0);
#pragma unroll
          for (int sb = 0; sb < ND; ++sb) {
              if (sb + 1 < ND) ATT_LDK((sb + 1) & 1, sb + 1);
              __builtin_amdgcn_sched_barrier(0);
              s0 = __builtin_amdgcn_mfma_f32_32x32x16_bf16(kf[sb & 1][0], qf[sb], s0, 0, 0, 0);
              s1 = __builtin_amdgcn_mfma_f32_32x32x16_bf16(kf[sb & 1][1], qf[sb], s1, 0, 0, 0);
              __builtin_amdgcn_sched_barrier(0); }
          }
#undef ATT_LDK
        }
        __builtin_amdgcn_sched_barrier(0);
        const bool msk = MASKED && a.mask_on && tt >= a.seg0_tiles;
        if (MASKED) { const int kp0 = a.kpos1 + 64 * (tt - a.seg0_tiles) + 4 * hi, qp = a.qpos0 + wid * 32 + q32;
#pragma unroll
            for (int r = 0; r < 16; ++r) { float t0 = s0[r], t1 = s1[r];
                if (msk) { const int d0 = qp - (kp0 + (r & 3) + 8 * (r >> 2)), d1 = d0 - 32; if (d0 > 128 || d0 < -128) t0 = -1e30f; if (d1 > 128 || d1 < -128) t1 = -1e30f; s0[r] = t0; s1[r] = t1; } }
            __builtin_amdgcn_sched_barrier(0); }
        float mx = -1e30f, m_new = 0.f, alpha = 1.f, ps = 0.f;
        bf16x8 pn[4] = {pa[0], pa[1], pa[2], pa[3]};
        { const ldsp_t _vt = lds + VOFF + vprev * VBUF; bf16x8 vfr[3]; vfr[2] = pa[0];
#define ATT_LDV(i) (*(const LAS bf16x8*)(_vt + ((32 * ((i) >> 2) + q32) * VST + 16 * ((i) & 3) + 8 * hi) * 2))
#define SCV(e) ((e) < 16 ? s0[(e) & 15] : s1[(e) & 15])
          vfr[0] = ATT_LDV(0); vfr[1] = ATT_LDV(1);
          __builtin_amdgcn_sched_barrier(0);
#pragma unroll
          for (int i = 0; i < 16; ++i) {
              if (PV_ != 3) { if (i + 2 < 16) vfr[(i + 2) % 3] = ATT_LDV(i + 2);
              o[i >> 2] = __builtin_amdgcn_mfma_f32_32x32x16_bf16(pa[i & 3], vfr[i % 3], o[i >> 2], 0, 0, 0); }
              if (PV_ == 1) {} else if (i < 4) {
#pragma unroll
                  for (int e = 0; e < 4; ++e) mx = fmaxf(mx, fmaxf(s0[4 * i + e], s1[4 * i + e]));
              } else if (i == 4) {
                  mx = fmaxf(mx, shx(mx, 32, lane)); m_new = fmaxf(m_run, mx); alpha = __builtin_amdgcn_exp2f(m_run - m_new); m_run = m_new;
              } else if (i < 13) {
#pragma unroll
                  for (int e = 0; e < 2; ++e) { const int r = 2 * (i - 5) + e; s0[r] = __builtin_amdgcn_exp2f(s0[r] - m_new); s1[r] = __builtin_amdgcn_exp2f(s1[r] - m_new); ps += s0[r] + s1[r]; }
              } else if (i == 13) {
                  u32x4 w; w.x = cvt_pk_bf16(s0[0], s0[1]); w.y = cvt_pk_bf16(s0[2], s0[3]); w.z = cvt_pk_bf16(s0[4], s0[5]); w.w = cvt_pk_bf16(s0[6], s0[7]); pn[0] = *(bf16x8*)&w;
                  u32x4 v; v.x = cvt_pk_bf16(s0[8], s0[9]); v.y = cvt_pk_bf16(s0[10], s0[11]); v.z = cvt_pk_bf16(s0[12], s0[13]); v.w = cvt_pk_bf16(s0[14], s0[15]); pn[1] = *(bf16x8*)&v;
              } else if (i == 14) {
                  u32x4 w; w.x = cvt_pk_bf16(s1[0], s1[1]); w.y = cvt_pk_bf16(s1[2], s1[3]); w.z = cvt_pk_bf16(s1[4], s1[5]); w.w = cvt_pk_bf16(s1[6], s1[7]); pn[2] = *(bf16x8*)&w;
                  u32x4 v; v.x = cvt_pk_bf16(s1[8], s1[9]); v.y = cvt_pk_bf16(s1[10], s1[11]); v.z = cvt_pk_bf16(s1[12], s1[13]); v.w = cvt_pk_bf16(s1[14], s1[15]); pn[3] = *(bf16x8*)&v;
              } else { l_run = l_run * alpha + ps; }
              __builtin_amdgcn_sched_barrier(0);
          }
#undef ATT_LDV
#undef SCV
        }
#pragma unroll
        for (int i = 0; i < 4; ++i) pa[i] = pn[i];
        if (__any(alpha < 1.0f)) {
            if (hi == 0) al[q32] = alpha;
            asm volatile("s_waitcnt lgkmcnt(0)" ::: "memory");
#pragma unroll
            for (int g4 = 0; g4 < 4; ++g4) { const f32x4 av = *(const LAS f32x4*)(al + 8 * g4 + 4 * hi);
#pragma unroll
                for (int db = 0; db < 4; ++db)
#pragma unroll
                    for (int j = 0; j < 4; ++j) o[db][4 * g4 + j] *= av[j]; }
        }
        if (tt + 1 < ntiles && PV_ != 4) ATT_WRITE(vnext);
        { const int t3 = vprev; vprev = vcur; vcur = vnext; vnext = t3; }
        asm volatile("s_waitcnt vmcnt(0)" ::: "memory");
        if (PV_ != 5) __syncthreads();
    }
    ATT_PV(vprev);
#undef ATT_LOAD
#undef ATT_WRITE
#undef ATT_PV
    __syncthreads();
    float l_tot = l_run + shx(l_run, 32, lane);
    if (a.has_sink) l_tot += __builtin_amdgcn_exp2f(a.sink_l2 - m_run);
    if (hi == 0) al[q32] = 1.0f / l_tot;
    asm volatile("s_waitcnt lgkmcnt(0)" ::: "memory");
    const ldsp_t Ost = lds + wid * 8192;
#pragma unroll
    for (int g4 = 0; g4 < 4; ++g4) { const f32x4 iv = *(const LAS f32x4*)(al + 8 * g4 + 4 * hi);
#pragma unroll
        for (int db = 0; db < 4; ++db)
#pragma unroll
            for (int j = 0; j < 4; ++j) *(LAS bf16_t*)(Ost + ((8 * g4 + 4 * hi + j) * 128 + 32 * db + q32) * 2) = f2bf(o[db][4 * g4 + j] * iv[j]); }
    asm volatile("s_waitcnt lgkmcnt(0)" ::: "memory");
    const int lane_o = lane_id();
#pragma unroll
    for (int i = 0; i < 8; ++i) { const int c = lane_o + 64 * i, row = c >> 4, c8 = c & 15;
        *(u32x4*)(a.O + (size_t)(wid * 32 + row) * a.ldo + 8 * c8) = *(const LAS u32x4*)(Ost + (row * 128 + 8 * c8) * 2); }
}

__device__ __forceinline__ void conv_unit(const Ctx& F, int layer, int row0  , int seq_len, int t0) {
    using namespace cf;
    const bf16_t* P = WSP(const bf16_t, WS_P); bf16_t* BR = WSP(bf16_t, WS_BR);
    const float* cw = F.in[I_CW] + (size_t)layer * 31 * 1024; const float* cb = F.in[I_CB] + layer * 1024;
    const float* lg = F.in[I_CLG] + layer * 1024; const float* lb = F.in[I_CLB] + layer * 1024;
    int tid = F.wave * 64 + lane_id(); asm volatile("" : "+v"(tid));
    const int lane = tid & 63;
    LAS float* red = (LAS float*)(F.lds + 126976); LAS float* tot = red + 8 * 32;
    __syncthreads();
    for (int c = tid; c < 62 * 128; c += 512) { const int rr = c >> 7, ch = c & 127, t = t0 - 15 + rr;
        u32x4 v = {0u, 0u, 0u, 0u};
        if (t >= 0 && t < seq_len) v = *(const u32x4*)(P + (size_t)(row0 + t) * NC + PC_GLU + ch * 8);
        *(LAS u32x4*)(F.lds + rr * 2048 + ch * 16) = v; }
    float w0[31], w1[31];
#pragma unroll
    for (int k = 0; k < 31; ++k) { const f32x2 w = *(const f32x2*)(cw + k * 1024 + 2 * tid); w0[k] = w.x; w1[k] = w.y; }
    const f32x2 bv = *(const f32x2*)(cb + 2 * tid), gg = *(const f32x2*)(lg + 2 * tid), bb = *(const f32x2*)(lb + 2 * tid);
    __syncthreads();
#pragma unroll 1
    for (int part = 0; part < 4; ++part) {
        float a0[8], a1[8];
#pragma unroll
        for (int t = 0; t < 8; ++t) { a0[t] = bv.x; a1[t] = bv.y; }
        const ldsp_t base = F.lds + part * 8 * 2048 + tid * 4;
#pragma unroll
        for (int rr = 0; rr < 38; ++rr) { const unsigned xw = *(const LAS unsigned*)(base + rr * 2048); const float x0 = bflo(xw), x1 = bfhi(xw);
#pragma unroll
            for (int t = 0; t < 8; ++t) { const int k = rr - t; if (k >= 0 && k <= 30) { a0[t] += x0 * w0[k]; a1[t] += x1 * w1[k]; } } }
        float v[16];
#pragma unroll
        for (int t = 0; t < 8; ++t) { v[t] = a0[t] + a1[t]; v[8 + t] = a0[t] * a0[t] + a1[t] * a1[t]; }
#pragma unroll
        for (int i = 0; i < 8; ++i) { const bool up = lane & 32; const float snd = up ? v[i] : v[i + 8], kp = up ? v[i + 8] : v[i]; v[i] = kp + shx(snd, 32, lane); }
#pragma unroll
        for (int i = 0; i < 4; ++i) { const bool up = lane & 16; const float snd = up ? v[i] : v[i + 4], kp = up ? v[i + 4] : v[i]; v[i] = kp + shx(snd, 16, lane); }
#pragma unroll
        for (int i = 0; i < 2; ++i) { const bool up = lane & 8; const float snd = up ? v[i] : v[i + 2], kp = up ? v[i + 2] : v[i]; v[i] = kp + shx(snd, 8, lane); }
        { const bool up = lane & 4; const float snd = up ? v[0] : v[1], kp = up ? v[1] : v[0]; v[0] = kp + shx(snd, 4, lane); }
        v[0] += shx(v[0], 2, lane); v[0] += shx(v[0], 1, lane);
        if ((lane & 3) == 0) red[F.wave * 16 + (lane >> 2)] = v[0];
        __syncthreads();
        if (tid < 16) { float s = 0.f;
#pragma unroll
            for (int w = 0; w < 8; ++w) s += red[w * 16 + tid];
            tot[tid] = s; }
        __syncthreads();
#pragma unroll
        for (int t = 0; t < 8; ++t) { const float mean = tot[t] * (1.f / 1024.f), var = fmaxf(tot[8 + t] * (1.f / 1024.f) - mean * mean, 0.f), rstd = rsqrtf(var + 1e-5f);
            const float y0 = (a0[t] - mean) * rstd * gg.x + bb.x, y1 = (a1[t] - mean) * rstd * gg.y + bb.y;
            *(unsigned*)(BR + (size_t)(row0 + t0 + part * 8 + t) * 4096 + 2048 + 2 * tid) = cvt_pk_bf16(y0 * sigmoidf_(y0), y1 * sigmoidf_(y1)); }
    }
}

__device__ __forceinline__ void attn_defaults(AttnArgs& a, int isctx) {
    a.seg0_row = 0; a.seg0_tiles = isctx ? 4 : 68; a.seg1_row = 0; a.seg1_tiles = 0; a.mask_on = 0; a.qpos0 = 0; a.kpos1 = 0; a.has_sink = 0; a.sink_l2 = 0.f; a.qss = nullptr; a.variant = 0; }
__device__ __forceinline__ void ph_attn(const Ctx& F0, int layer) {
    const Ctx F = phase_ctx(F0);
    using namespace cf;
    const bf16_t* P = WSP(const bf16_t, WS_P); bf16_t* BR = WSP(bf16_t, WS_BR);
    for (int dup = 0; dup < DUPN(2); ++dup)
    for (int u = F.bid; u < (layer == 0 ? 544 : 512); u += F.G) {
        int b, h, qb, isctx = 0;
        if (u < 512) { b = u >> 7; h = (u >> 4) & 7; qb = u & 15; } else { const int r = u - 512; b = r >> 3; h = r & 7; qb = 0; isctx = 1; }
        const size_t brow = (size_t)b * RB, qrow = brow + (isctx ? 0 : CTX) + (size_t)qb * 256;
        AttnArgs a; attn_defaults(a, isctx);
        a.Q = WSP(const bf16_t, WS_QB) + qrow * 1536 + h * 192; a.ldq = 1536;
        a.K = WSP(const bf16_t, WS_KB) + brow * 1536 + h * 192; a.ldk = 1536;
        a.V = WSP(const bf16_t, WS_VB) + brow * 1024 + h * 128; a.ldv = 1024;
        a.O = BR + qrow * 4096 + 1024 + h * 128; a.ldo = 4096; a.sc_log2 = SCALE_MLA * LOG2E;
        __syncthreads();
        attn_unit<192, false>(F.lds, a, F.wave);
    }
    for (int dup = 0; dup < DUPN(3); ++dup)
    for (int u0 = F.bid; u0 < (layer == 0 ? 544 : 512); u0 += F.G) {
        int b, h, qb, isctx = 0;
        if (u0 < 512) { b = u0 >> 7; h = (u0 >> 4) & 7; qb = u0 & 15; } else { const int r = u0 - 512; b = r >> 3; h = r & 7; qb = 0; isctx = 1; }
        const size_t brow = (size_t)b * RB, qrow = brow + (isctx ? 0 : CTX) + (size_t)qb * 256;
        AttnArgs a; attn_defaults(a, isctx);
        a.Q = P + qrow * NC + PC_AQ + h * 128; a.ldq = NC;
        a.K = P + brow * NC + PC_AK + (h >> 2) * 128; a.ldk = NC;
        a.V = P + brow * NC + PC_AV + (h >> 2) * 128; a.ldv = NC;
        a.O = BR + qrow * 4096 + h * 128; a.ldo = 4096; a.sc_log2 = SCALE_HD * LOG2E;
        a.qss = WSP(const float, WS_SSQ) + qrow * 16 + h * 2;
        if (MK_AV && dup == 1) { a.variant = MK_AV; a.O = WSP(bf16_t, WS_HB) + qrow * 2048 + h * 128; a.ldo = 2048; }
        __syncthreads();
        attn_unit<128, false>(F.lds, a, F.wave);
    }
    for (int dup = 0; dup < DUPN(13); ++dup)
    for (int u0 = F.bid; u0 < (layer == 0 ? 544 : 512); u0 += F.G) {
        int b, h, qb, isctx = 0;
        if (u0 < 512) { b = u0 >> 7; h = (u0 >> 4) & 7; qb = u0 & 15; } else { const int r = u0 - 512; b = r >> 3; h = r & 7; qb = 0; isctx = 1; }
        const size_t brow = (size_t)b * RB, qrow = brow + (isctx ? 0 : CTX) + (size_t)qb * 256;
        AttnArgs a; attn_defaults(a, isctx);
        a.Q = P + qrow * NC + PC_DQ + h * 128; a.ldq = NC;
        a.K = P + brow * NC + PC_DK + (h >> 2) * 128; a.ldk = NC;
        a.V = P + brow * NC + PC_DV + (h >> 2) * 128; a.ldv = NC;
        a.O = BR + qrow * 4096 + 3072 + h * 128; a.ldo = 4096; a.sc_log2 = SCALE_HD * LOG2E;
        a.has_sink = 1; a.sink_l2 = F.in[I_SINK][layer * 8 + h] * LOG2E; a.seg0_tiles = 4;
        if (!isctx) { const int start = qb * 256; const int lo = start - 128 < 0 ? 0 : start - 128, hi = start + 384 > S ? S : start + 384;
            a.seg1_row = CTX + lo; a.seg1_tiles = (hi - lo) / 64; a.mask_on = 1; a.qpos0 = start; a.kpos1 = lo; }
        __syncthreads();
        attn_unit<128, true>(F.lds, a, F.wave);
    }
    for (int dup = 0; dup < DUPN(4); ++dup)
    for (int u = F.bid; u < (layer == 0 ? 544 : 512); u += F.G) {
        int b, tb, isctx = 0;
        if (u < 512) { b = u >> 7; tb = u & 127; } else { const int r = u - 512; b = r >> 3; tb = r & 7; isctx = 1; }
        conv_unit(F, layer, b * RB + (isctx ? 0 : CTX), isctx ? CTX : S, tb * 32);
    }
}

__device__ __forceinline__ int tok_row(int layer, int tok) { return layer == 0 ? tok : (tok >> 12) * cf::RB + cf::CTX + (tok & 4095); }
__device__ __forceinline__ void ph_ln1(const Ctx& F0, int layer) {
    const Ctx F = phase_ctx(F0);
    using namespace cf;
    float* X1 = (float*)(F.ws + WS_P + X1_OFF); bf16_t* HB = WSP(bf16_t, WS_HB);
    const float* lg = F.in[I_LN1G] + layer * 2048; const float* lb = F.in[I_LN1B] + layer * 2048;
    const int ntok = layer == 0 ? MR : NB * S, lane = F.lane;
    for (int tok = F.bid * 8 + F.wave; tok < ntok; tok += F.G * 8) {
        const int R = tok_row(layer, tok), b = R / RB, j = R % RB;
        const float* mod = WSP(const float, WS_MOD) + ((size_t)layer * 5 + (j < CTX ? 4 : b)) * 12288;
        float* xp = X1 + (size_t)R * 2048;
        f32x4 v[8]; float s = 0.f;
#pragma unroll
        for (int i = 0; i < 8; ++i) { v[i] = *(const f32x4*)(xp + lane * 4 + 256 * i); s += (v[i][0] + v[i][1]) + (v[i][2] + v[i][3]); }
        const float mean = wave_sum(s, lane) * (1.f / 2048.f); float q = 0.f;
#pragma unroll
        for (int i = 0; i < 8; ++i) { const f32x4 d = v[i] - mean; q += (d[0] * d[0] + d[1] * d[1]) + (d[2] * d[2] + d[3] * d[3]); }
        const float rstd = rsqrtf(wave_sum(q, lane) * (1.f / 2048.f) + 1e-5f);
#pragma unroll
        for (int i = 0; i < 8; ++i) { const int c = lane * 4 + 256 * i;
            const f32x4 y = (v[i] - mean) * rstd * *(const f32x4*)(lg + c) + *(const f32x4*)(lb + c);
            *(f32x4*)(xp + c) = y;
            const f32x4 hp = y * (*(const f32x4*)(mod + 4 * 2048 + c) + 1.0f) + *(const f32x4*)(mod + 3 * 2048 + c);
            u32x2 w; w.x = cvt_pk_bf16(hp[0], hp[1]); w.y = cvt_pk_bf16(hp[2], hp[3]);
            *(u32x2*)(HB + (size_t)R * 2048 + c) = w; }
    }
}

typedef __bf16 bf16x2_t __attribute__((ext_vector_type(2)));
__device__ __forceinline__ unsigned ordkey(float v) { const unsigned u = __float_as_uint(v); return (u & 0x80000000u) ? ~u : (u | 0x80000000u); }
__device__ __forceinline__ int lane_rank(unsigned long long m) { return (int)__builtin_amdgcn_mbcnt_hi((unsigned)(m >> 32), __builtin_amdgcn_mbcnt_lo((unsigned)m, 0u)); }
template <int NV> __device__ __forceinline__ unsigned radix_thresh16(const unsigned (&k)[NV]) {
    unsigned T = 0u;
    for (int bit = 31; bit >= 0; --bit) { const unsigned cand = T | (1u << bit); int cnt = 0;
#pragma unroll
        for (int v = 0; v < NV; ++v) cnt += __popcll(__ballot(k[v] >= cand));
        if (cnt >= 16) { T = cand; if (cnt == 16) break; } }
    return T;
}
__device__ __forceinline__ void radix_thresh16x2(const unsigned (&ka)[2], const unsigned (&kb)[2], unsigned& Ta, unsigned& Tb) {
    unsigned T0 = 0u, T1 = 0u; bool d0 = false, d1 = false;
    for (int bit = 31; bit >= 0; --bit) { const unsigned c0 = T0 | (1u << bit), c1 = T1 | (1u << bit);
        const int n0 = __popcll(__ballot(ka[0] >= c0)) + __popcll(__ballot(ka[1] >= c0)), n1 = __popcll(__ballot(kb[0] >= c1)) + __popcll(__ballot(kb[1] >= c1));
        if (!d0 && n0 >= 16) { T0 = c0; d0 = n0 == 16; }
        if (!d1 && n1 >= 16) { T1 = c1; d1 = n1 == 16; }
        if (d0 && d1) break; }
    Ta = T0; Tb = T1;
}
__device__ __forceinline__ float dot2bf(unsigned a, unsigned b, float acc) { return __builtin_amdgcn_fdot2_f32_bf16(__builtin_bit_cast(bf16x2_t, a), __builtin_bit_cast(bf16x2_t, b), acc, false); }
__device__ __forceinline__ float dot8(const u32x4 a, const u32x4 b, float acc) {
    acc = dot2bf(a.x, b.x, acc); acc = dot2bf(a.y, b.y, acc); acc = dot2bf(a.z, b.z, acc); acc = dot2bf(a.w, b.w, acc);
    return acc;
}
__device__ __forceinline__ float gelu_as(float v) {
    const float av = fabsf(v), t = __builtin_amdgcn_rcpf(av * 0.2316418882f + 1.0f);
    float q = t * 0.5307027145f + (-0.7265760135f); q = q * t + 0.7107068705f; q = q * t + (-0.142248368f); q = q * t + 0.127414796f; q = q * t;
    const float e = __builtin_amdgcn_exp2f((v * v) * (-0.72134752044f)), m = v * (q * e);
    return v < 0.f ? m : v - m;
}
__device__ __forceinline__ void peer_load(u32x4 (&ur)[4][2], u32x4 (&vr)[4], unsigned (&vs)[4], float (&gq)[4], const LAS int* ei, const LAS float* eg,
                                          const unsigned char* U8, const unsigned char* V4, int lane, int grp) {
#pragma unroll
    for (int q = 0; q < 4; ++q) { const int id = __builtin_amdgcn_readfirstlane(ei[grp * 4 + q]); gq[q] = __uint_as_float(__builtin_amdgcn_readfirstlane(__float_as_uint(eg[grp * 4 + q])));
        ur[q][0] = *(const u32x4*)(U8 + (size_t)id * 2048 + lane * 16); ur[q][1] = *(const u32x4*)(U8 + (size_t)id * 2048 + lane * 16 + 1024);
        vr[q] = *(const u32x4*)(V4 + (size_t)id * V4_ROW + lane * 16); vs[q] = V4[(size_t)id * V4_ROW + 1024 + lane]; }
}
__device__ __forceinline__ void peer_comp(const u32x4 (&ur)[4][2], const u32x4 (&vr)[4], const unsigned (&vs)[4], const float (&gq)[4], const f32x2 (&xf)[16], f32x2 (&y2)[16], int lane) {
    float d[4];
#pragma unroll
    for (int q = 0; q < 4; ++q) { f32x2 t = {0.f, 0.f};
#pragma unroll
        for (int i = 0; i < 2; ++i)
#pragma unroll
            for (int j = 0; j < 4; ++j) { const int w = (int)ur[q][i][j];
                t += __builtin_amdgcn_cvt_pk_f32_fp8(w, false) * xf[8 * i + 2 * j]; t += __builtin_amdgcn_cvt_pk_f32_fp8(w, true) * xf[8 * i + 2 * j + 1]; }
        d[q] = t.x + t.y; }
#pragma unroll
    for (int o = 32; o >= 1; o >>= 1) {
#pragma unroll
        for (int q = 0; q < 4; ++q) d[q] += shx(d[q], o, lane); }
#pragma unroll
    for (int q = 0; q < 4; ++q) { const float dd = d[q] * (1.0f / 1024.0f); const float w = gq[q] * gelu_as(dd) * __uint_as_float(vs[q] << 23);
        const f32x2 w2 = {w, w};
#pragma unroll
        for (int j = 0; j < 4; ++j) { const unsigned vw = vr[q][j];
            y2[4 * j + 0] += w2 * __builtin_amdgcn_cvt_scalef32_pk_f32_fp4(vw, 1.0f, 0); y2[4 * j + 1] += w2 * __builtin_amdgcn_cvt_scalef32_pk_f32_fp4(vw, 1.0f, 1);
            y2[4 * j + 2] += w2 * __builtin_amdgcn_cvt_scalef32_pk_f32_fp4(vw, 1.0f, 2); y2[4 * j + 3] += w2 * __builtin_amdgcn_cvt_scalef32_pk_f32_fp4(vw, 1.0f, 3); } }
}
__device__ __forceinline__ unsigned inv_ordkey(unsigned k) { return (k & 0x80000000u) ? (k & 0x7fffffffu) : ~k; }
template <int N, int GRP> __device__ __forceinline__ unsigned lane_radix16(const unsigned (&key)[N], int lane) {
    unsigned T = 0u; bool done = false;
    for (int bit = 31; bit >= 0; --bit) { const unsigned cand = T | (1u << bit); int cnt = 0;
#pragma unroll
        for (int n = 0; n < N; ++n) cnt += key[n] >= cand ? 1 : 0;
        if (GRP >= 2) cnt += __builtin_amdgcn_ds_bpermute((lane ^ 1) << 2, cnt);
        if (GRP >= 4) cnt += __builtin_amdgcn_ds_bpermute((lane ^ 2) << 2, cnt);
        if (!done && cnt >= 16) { T = cand; done = cnt == 16; }
        if (__all(done)) break; }
    return T;
}
__device__ __forceinline__ void ph_peer(const Ctx& F0, int layer) {
    const Ctx F = phase_ctx(F0);
    using namespace cf;
    const float* SC = (const float*)(F.ws + WS_P + SC_OFF); const float* X1 = (const float*)(F.ws + WS_P + X1_OFF);
    bf16_t* HB = WSP(bf16_t, WS_HB); const unsigned char* U8 = WSP(const unsigned char, WS_UB) + (size_t)layer * NEXP * 2048; const unsigned char* V4 = WSP(const unsigned char, WS_VB2) + (size_t)layer * NEXP * V4_ROW;
    const float* lg = F.in[I_LN2G] + layer * 2048; const float* lb = F.in[I_LN2B] + layer * 2048;
    const int ntok = layer == 0 ? MR : NB * S;
    ldsp_t wl = F.lds + F.wave * 8192;
    LAS float* lstv = (LAS float*)wl; LAS int* lsti = (LAS int*)(wl + 2176);
    LAS float* es4 = (LAS float*)(wl + 4352); LAS int* ei4 = (LAS int*)(wl + 5376); LAS float* eg4 = (LAS float*)(wl + 6400);
    const int nwv = F.G * 8;
    for (int tok0 = F.bid * 8 + F.wave; tok0 < ntok; tok0 += 2 * nwv) {
        { int lane = F.lane; asm volatile("" : "+v"(lane));
          const int t2 = lane >> 5, set = lane >> 1, sset = set & 15, part = lane & 1;
          int tokl = tok0 + t2 * nwv; if (tokl >= ntok) tokl = tok0;
          const int Rl = tok_row(layer, tokl);
          unsigned key[64];
          const float* sp = SC + (size_t)Rl * 2048 + sset * 128 + part * 64;
#pragma unroll
          for (int i = 0; i < 16; ++i) { const f32x4 v = *(const f32x4*)(sp + 4 * i);
#pragma unroll
              for (int e = 0; e < 4; ++e) key[4 * i + e] = (ordkey(v[e]) & ~127u) | (unsigned)(127 - (64 * part + 4 * i + e)); }
          const unsigned T = lane_radix16<64, 2>(key, lane);
          int c = 0;
#pragma unroll
          for (int n = 0; n < 64; ++n) { if (key[n] >= T) { const int r = set * 17 + (part ? 15 - c : c); lstv[r] = __uint_as_float(inv_ordkey((key[n] & ~127u) | 64u)); lsti[r] = 64 * part + n; ++c; }
              if ((n & 15) == 15) __builtin_amdgcn_sched_barrier(0); }
        }
        asm volatile("s_waitcnt lgkmcnt(0)" ::: "memory");
        {
          int lane = F.lane; asm volatile("" : "+v"(lane));
          const int t2 = lane >> 5, hq = (lane >> 2) & 7, q = lane & 3, sa = (lane >> 2) * 2, sb = sa + 1;
          float Av[4], Bv[16]; int Ai[4], Bi[16];
#pragma unroll
          for (int i = 0; i < 4; ++i) { Av[i] = lstv[sa * 17 + 4 * q + i]; Ai[i] = lsti[sa * 17 + 4 * q + i]; }
#pragma unroll
          for (int jx = 0; jx < 16; ++jx) { Bv[jx] = lstv[sb * 17 + jx]; Bi[jx] = lsti[sb * 17 + jx]; }
          unsigned key[64];
#pragma unroll
          for (int i = 0; i < 4; ++i)
#pragma unroll
              for (int jx = 0; jx < 16; ++jx) key[i * 16 + jx] = (ordkey(Av[i] + Bv[jx]) & ~255u) | (unsigned)(255 - ((4 * q + i) * 16 + jx));
          const unsigned T = lane_radix16<64, 4>(key, lane);
          int mine = 0;
#pragma unroll
          for (int n = 0; n < 64; ++n) mine += key[n] >= T ? 1 : 0;
          const int c1 = __builtin_amdgcn_ds_bpermute((lane ^ 1) << 2, mine), c2 = __builtin_amdgcn_ds_bpermute((lane ^ 2) << 2, mine), c3 = __builtin_amdgcn_ds_bpermute((lane ^ 3) << 2, mine);
          int c = (q == 1) ? c1 : (q == 2) ? c2 + c3 : (q == 3) ? c1 + c2 + c3 : 0;
#pragma unroll
          for (int i = 0; i < 4; ++i) {
#pragma unroll
              for (int jx = 0; jx < 16; ++jx) if (key[i * 16 + jx] >= T) { const int r = t2 * 128 + hq * 16 + c; es4[r] = Av[i] + Bv[jx]; ei4[r] = Ai[i] * 128 + Bi[jx]; ++c; }
              __builtin_amdgcn_sched_barrier(0); }
        }
        asm volatile("s_waitcnt lgkmcnt(0)" ::: "memory");
        { int lane = F.lane; asm volatile("" : "+v"(lane));
#pragma unroll
        for (int rnd = 0; rnd < 4; ++rnd) { const int e = lane + 64 * rnd; const float s = es4[e];
            float m = s; m = fmaxf(m, shx(m, 1, lane)); m = fmaxf(m, shx(m, 2, lane)); m = fmaxf(m, shx(m, 4, lane)); m = fmaxf(m, shx(m, 8, lane));
            const float ex = __expf(s - m); float sum = ex; sum += shx(sum, 1, lane); sum += shx(sum, 2, lane); sum += shx(sum, 4, lane); sum += shx(sum, 8, lane);
            eg4[e] = ex / sum; } }
        asm volatile("s_waitcnt lgkmcnt(0)" ::: "memory");
      for (int tslot = 0; tslot < 2; ++tslot) {
        const int tok = tok0 + tslot * nwv; if (tok >= ntok) break;
        int lane = F.lane; asm volatile("" : "+v"(lane));
        const int R = tok_row(layer, tok), b = R / RB, j = R % RB; const bool isctx = j < CTX; const int modrow = isctx ? 4 : b;
        const LAS int* ei = ei4 + tslot * 128; const LAS float* eg = eg4 + tslot * 128;
        f32x2 xf[16];
#pragma unroll
        for (int i = 0; i < 2; ++i)
#pragma unroll
            for (int hh = 0; hh < 2; ++hh) { const u32x4 w = *(const u32x4*)(HB + (size_t)R * 2048 + lane * 16 + 1024 * i + 8 * hh);
                xf[8 * i + 4 * hh + 0] = (f32x2){bflo(w.x), bfhi(w.x)}; xf[8 * i + 4 * hh + 1] = (f32x2){bflo(w.y), bfhi(w.y)};
                xf[8 * i + 4 * hh + 2] = (f32x2){bflo(w.z), bfhi(w.z)}; xf[8 * i + 4 * hh + 3] = (f32x2){bflo(w.w), bfhi(w.w)}; }
        f32x2 y2[16];
#pragma unroll
        for (int i = 0; i < 16; ++i) y2[i] = (f32x2){0.f, 0.f};
        f32x4 xrow[8];
#pragma unroll
        for (int k = 0; k < 8; ++k) xrow[k] = *(const f32x4*)(X1 + (size_t)R * 2048 + lane * 32 + 4 * k);
        { u32x4 urA[4][2], vrA[4], urB[4][2], vrB[4]; unsigned vsA[4], vsB[4]; float gqA[4], gqB[4];
          peer_load(urA, vrA, vsA, gqA, ei, eg, U8, V4, lane, 0);
          for (int grp = 0; grp < 32; grp += 2) {
              peer_load(urB, vrB, vsB, gqB, ei, eg, U8, V4, lane, grp + 1);
              peer_comp(urA, vrA, vsA, gqA, xf, y2, lane);
              peer_load(urA, vrA, vsA, gqA, ei, eg, U8, V4, lane, grp + 2 < 32 ? grp + 2 : 31);
              peer_comp(urB, vrB, vsB, gqB, xf, y2, lane);
          } }
        const float* mod = WSP(const float, WS_MOD) + ((size_t)layer * 5 + modrow) * 12288;
        float y[32];
        float s = 0.f;
#pragma unroll
        for (int k = 0; k < 8; ++k) { const int c = lane * 32 + 4 * k;
            const f32x4 xa = xrow[k], ga = *(const f32x4*)(mod + 5 * 2048 + c);
            y[4 * k + 0] = ALPHA * xa[0] + ga[0] * y2[2 * k].x; y[4 * k + 1] = ALPHA * xa[1] + ga[1] * y2[2 * k].y;
            y[4 * k + 2] = ALPHA * xa[2] + ga[2] * y2[2 * k + 1].x; y[4 * k + 3] = ALPHA * xa[3] + ga[3] * y2[2 * k + 1].y;
            s += (y[4 * k + 0] + y[4 * k + 1]) + (y[4 * k + 2] + y[4 * k + 3]); }
        const float mean = wave_sum(s, lane) * (1.f / 2048.f); float q2 = 0.f;
#pragma unroll
        for (int i = 0; i < 32; ++i) { const float dd = y[i] - mean; q2 += dd * dd; }
        const float rstd = rsqrtf(wave_sum(q2, lane) * (1.f / 2048.f) + 1e-5f);
        float* dst = layer == 0 ? (isctx ? WSP(float, WS_XC) + ((size_t)b * CTX + j) * 2048 : F.out + ((size_t)b * S + (j - CTX)) * 2048) : F.out + ((size_t)b * S + (j - CTX)) * 2048;
        const float* modn = WSP(const float, WS_MOD) + ((size_t)1 * 5 + modrow) * 12288;
#pragma unroll
        for (int kk = 0; kk < 4; ++kk) { f32x4 o[2];
#pragma unroll
            for (int jj = 0; jj < 2; ++jj) { const int k = 2 * kk + jj, c = lane * 32 + 4 * k; const f32x4 la = *(const f32x4*)(lg + c), ba = *(const f32x4*)(lb + c);
#pragma unroll
                for (int e = 0; e < 4; ++e) o[jj][e] = (y[4 * k + e] - mean) * rstd * la[e] + ba[e];
                *(f32x4*)(dst + c) = o[jj]; }
            if (layer == 0) {
                const int c = lane * 32 + 8 * kk;
                const f32x4 sa = *(const f32x4*)(modn + 2048 + c), sb = *(const f32x4*)(modn + 2048 + c + 4), ha = *(const f32x4*)(modn + c), hb = *(const f32x4*)(modn + c + 4);
                *(u32x4*)(HB + (size_t)R * 2048 + c) = pg8::pack8(o[0] * (sa + 1.0f) + ha, o[1] * (sb + 1.0f) + hb); } }
      }
    }
}

struct Params { const float* in[cf::N_IN]; float* out; unsigned char* ws; int ph_lo, ph_hi; };

__global__ void __launch_bounds__(512, 2) mega_fwd(Params p) {
    using namespace cf;
    extern __shared__ __attribute__((aligned(16))) unsigned char smem[];
    Ctx F0;
    F0.in = p.in;
    F0.out = p.out; F0.ws = p.ws; F0.lds = (ldsp_t)smem;
    F0.tid = 0; F0.lane = 0; F0.wave = __builtin_amdgcn_readfirstlane(threadIdx.x >> 6); F0.G = gridDim.x; F0.bid = blockIdx.x;
    if (threadIdx.x < 64) ((LAS unsigned*)(F0.lds + MISC_OFF))[threadIdx.x] = 0u;
    __syncthreads();
    const int lo = p.ph_lo, hi = p.ph_hi;
    XcdBarrier bar; bar.bar = (unsigned*)(F0.ws + WS_CTL); bar.x = 0; bar.st = (volatile LAS unsigned*)(F0.lds + MISC_OFF); bar.wave = F0.wave;
    if (hi - lo > 1) bar = xcd_barrier_post((unsigned*)(F0.ws + WS_CTL), (volatile LAS unsigned*)(F0.lds + MISC_OFF), F0.wave);
#ifndef MK_MASK
#define MK_MASK 0xFFFF
#endif
#define ON(j) ((MK_MASK >> (j)) & 1)
#define IN(k) (lo <= (k) && (k) < hi)
#define SEAM(k) do { if (IN(k) && IN((k) + 1)) xcd_barrier(bar); } while (0)

    if (ON(9) && IN(0)) { ph_prologue(F0); if (DUPN(9) == 2) { __syncthreads(); ph_prologue(F0); } }
    SEAM(0);
    if (ON(10) && IN(1)) ph_modulate0(F0);
    SEAM(1);
    for (int l = 0; l < DEPTH; ++l) {
        const int pb = 2 + 8 * l;
        const int rmode = l == 0 ? 0 : 1, nMl = l == 0 ? 68 : 64;
        for (int blk = 0; blk < DUPN(12); ++blk) {
        if (blk) xcd_barrier(bar);
        if (ON(0) && IN(pb + 0)) { const Ctx F = phase_ctx(F0);
            pg8::Gemm g{WSP(const bf16_t, WS_HB), WSP(const bf16_t, WS_WIN) + (size_t)l * NC * 2048, 2048, 2048};
            pg8::EpiInProj E{WSP(bf16_t, WS_P), WSP(bf16_t, WS_KB), WSP(const float, WS_COSH), WSP(const float, WS_SINH), WSP(const float, WS_COSR), WSP(const float, WS_SINR),
                             F.in[I_AKN] + l * 128, F.in[I_AQN] + l * 128, WSP(float, WS_SSK), WSP(float, WS_SSQ), WSP(float, WS_SSKV), WSP(float, WS_SSCQ)};
            pg8::TileOrder S; S.init(nMl, 56, F.G, F.bid, rmode);
            for (int dup = 0; dup < DUPN(0); ++dup)
            pg8::gemm_phase(F.lds, g, S, E, F.wave);
            if (l > 0) { pg8::TileOrder S2; S2.init(4, 6, F.G, F.bid, 2); pg8::gemm_phase(F.lds, g, S2, E, F.wave); }
        }
        SEAM(pb + 0);
        if (ON(2) && IN(pb + 1)) { const Ctx F = phase_ctx(F0); bf16_t* P = WSP(bf16_t, WS_P);
            knorm_pass(F);
            { pg8::Gemm g{P + PC_CKV, WSP(const bf16_t, WS_WKVUP) + (size_t)l * 2048 * 256, NC, 256}; pg8::EpiKvUp E{WSP(bf16_t, WS_KB), WSP(bf16_t, WS_VB), WSP(const float, WS_SSKV)};
              pg8::TileOrder S; S.init(68, 8, F.G, F.bid, 0); for (int dup = 0; dup < DUPN(1); ++dup) pg8::gemm_phase(F.lds, g, S, E, F.wave); }
            { pg8::Gemm g{P + PC_CQ, WSP(const bf16_t, WS_WQUP) + (size_t)l * 1536 * 512, NC, 512}; pg8::EpiQUp E{WSP(bf16_t, WS_QB), WSP(const float, WS_COSR), WSP(const float, WS_SINR), WSP(const float, WS_SSCQ)};
              pg8::TileOrder S; S.init(nMl, 6, F.G, F.bid, rmode); for (int dup = 0; dup < DUPN(1); ++dup) pg8::gemm_phase(F.lds, g, S, E, F.wave); }
        }
        SEAM(pb + 1);
        if (ON(3) && IN(pb + 2)) ph_attn(F0, l);
        }
        SEAM(pb + 2);
        if (ON(4) && IN(pb + 3)) { const Ctx F = phase_ctx(F0); bf16_t* P = WSP(bf16_t, WS_P); bf16_t* HB = WSP(bf16_t, WS_HB);
            pg8::Gemm g{WSP(const bf16_t, WS_BR), WSP(const bf16_t, WS_WBR) + (size_t)l * 4 * 2048 * 1024, 4096, 1024};
            pg8::EpiMerge E{HB, P + PC_GATE, NC};
            pg8::TileOrder S; S.init(nMl, 8, F.G, F.bid, rmode, 4, (size_t)1024 * 2, (size_t)2048 * 1024 * 2);
            for (int dup = 0; dup < DUPN(5); ++dup) pg8::gemm_phase(F.lds, g, S, E, F.wave);
        }
        SEAM(pb + 3);
        if (ON(5) && IN(pb + 4)) { const Ctx F = phase_ctx(F0); bf16_t* HB = WSP(bf16_t, WS_HB);
            pg8::Gemm g{HB, WSP(const bf16_t, WS_WO) + (size_t)l * 2048 * 2048, 2048, 2048};
            pg8::EpiWo E{(float*)(F.ws + WS_P + X1_OFF), WSP(const float, WS_MOD) + (size_t)l * 5 * 12288, l == 0 ? F.in[I_X] : (const float*)F.out, F.in[I_CTX]};
            pg8::TileOrder S; S.init(nMl, 8, F.G, F.bid, rmode); for (int dup = 0; dup < DUPN(6); ++dup) pg8::gemm_phase(F.lds, g, S, E, F.wave);
        }
        SEAM(pb + 4);
        if (ON(6) && IN(pb + 5)) ph_ln1(F0, l);
        SEAM(pb + 5);
        if (ON(7) && IN(pb + 6)) { const Ctx F = phase_ctx(F0); bf16_t* HB = WSP(bf16_t, WS_HB);
            pg8::Gemm g{HB, WSP(const bf16_t, WS_WFOLD) + (size_t)l * 2048 * 2048, 2048, 2048}; pg8::EpiF32 E{(float*)(F.ws + WS_P + SC_OFF), 2048};
            pg8::TileOrder S; S.init(nMl, 8, F.G, F.bid, rmode); for (int dup = 0; dup < DUPN(7); ++dup) pg8::gemm_phase(F.lds, g, S, E, F.wave);
        }
        SEAM(pb + 6);
        if (ON(8) && IN(pb + 7)) { ph_peer(F0, l); if (DUPN(8) == 2 && l == 1) ph_peer(F0, l); }
        SEAM(pb + 7);
    }
#undef IN
#undef SEAM
}

extern "C" void kernel_launch(void* const* d_in, const int* in_sizes, int n_in, void* d_out, int out_size, void* d_ws, size_t ws_size, hipStream_t stream) {
    static int grid = 0;
    if (grid == 0) {
        if (n_in != cf::N_IN || out_size != cf::NB * cf::S * cf::D || ws_size < cf::WS_END) {
            fprintf(stderr, "kernel_launch: unexpected shapes: n_in %d out %d ws %zu (need %zu)\n", n_in, out_size, ws_size, (size_t)cf::WS_END); grid = -1; return; }
        int dev = 0, cus = 0;
        if (hipGetDevice(&dev) != hipSuccess || hipDeviceGetAttribute(&cus, hipDeviceAttributeMultiprocessorCount, dev) != hipSuccess || cus < 1) { grid = -1; return; }
        if (hipFuncSetAttribute((const void*)mega_fwd, hipFuncAttributeMaxDynamicSharedMemorySize, cf::LDS_BYTES) != hipSuccess) { fprintf(stderr, "kernel_launch: hipFuncSetAttribute failed\n"); grid = -1; return; }
        int per_cu = 0;
        if (hipOccupancyMaxActiveBlocksPerMultiprocessor(&per_cu, (const void*)mega_fwd, 512, cf::LDS_BYTES) != hipSuccess || per_cu < 1)
            fprintf(stderr, "kernel_launch: note: occupancy query reports %d workgroups per CU\n", per_cu);
        (void)hipGetLastError();
        grid = cus;
    }
    if (grid < 0) return;
    (void)hipMemsetAsync((char*)d_ws + cf::WS_CTL, 0, cf::CTL_BYTES, stream);
    Params p{};
    for (int i = 0; i < cf::N_IN; ++i) p.in[i] = (const float*)d_in[i];
    p.out = (float*)d_out; p.ws = (unsigned char*)d_ws;
#if MK_PER_PHASE
    for (int k = 0; k < cf::N_PHASES; ++k) { p.ph_lo = k; p.ph_hi = k + 1; hipLaunchKernelGGL(mega_fwd, dim3(grid), dim3(512), cf::LDS_BYTES, stream, p); }
#else
    p.ph_lo = 0; p.ph_hi = cf::N_PHASES;
    hipLaunchKernelGGL(mega_fwd, dim3(grid), dim3(512), cf::LDS_BYTES, stream, p);
#endif
    const hipError_t le = hipPeekAtLastError();
    if (le != hipSuccess) fprintf(stderr, "kernel_launch: launch failed: %s\n", hipGetErrorName(le));
}
```

```cpp
#include <hip/hip_runtime.h>
#include <stdint.h>
#include <stdio.h>

#ifndef MK_DUP
#define MK_DUP 0
#endif
#define DUPN(k) (((MK_DUP >> (k)) & 1) ? 2 : 1)
#ifndef MK_AV
#define MK_AV 0
#endif
#ifndef MK_PER_PHASE
#define MK_PER_PHASE 0
#endif

namespace cf {
constexpr int D = 2048, NB = 4, S = 4096, CTX = 256, RB = CTX + S  , MR = NB * RB  ;
constexpr int DEPTH = 2;
constexpr int PC_AK = 0, PC_AV = 256, PC_CKV = 512, PC_KR = 768, PC_DK = 1024, PC_DV = 1280, PC_KVEND = 1536;
constexpr int PC_AQ = 1536, PC_CQ = 2560, PC_DQ = 3072, PC_GLU = 4096, PC_GATE = 6144, NC = 14336;
constexpr int IN_COLS = 14144;
constexpr int NEXP = 16384;
constexpr float ALPHA = 1.4142135623730951f;
constexpr float LOG2E = 1.4426950408889634f;
constexpr float SCALE_HD = 0.08838834764831845f;
constexpr float SCALE_MLA = 0.07216878364870323f;
enum { I_X = 0, I_C, I_CTX, I_CCTX, I_WADA, I_BADA, I_WIN, I_AQN, I_AKN, I_BQN, I_WQUP, I_BKVN, I_WKVUP, I_CW, I_CB, I_CLG, I_CLB, I_SINK,
       I_WBRA, I_WBRB, I_WBRC, I_WBRD, I_WO, I_LN1G, I_LN1B, I_LN2G, I_LN2B, I_PWQ, I_PSK, I_PU, I_PV, N_IN };
constexpr size_t al(size_t x) { return (x + 255) / 256 * 256; }
constexpr size_t WS_CTL = 0;
constexpr size_t CTL_BYTES = 65536;
constexpr size_t WS_MOD = WS_CTL + CTL_BYTES;
constexpr size_t WS_COSH = WS_MOD + al((size_t)2 * 5 * 12288 * 4);
constexpr size_t WS_SINH = WS_COSH + (size_t)4096 * 64 * 4;
constexpr size_t WS_COSR = WS_SINH + (size_t)4096 * 64 * 4;
constexpr size_t WS_SINR = WS_COSR + (size_t)4096 * 32 * 4;
constexpr size_t WS_WIN = WS_SINR + (size_t)4096 * 32 * 4;
constexpr size_t WS_WQUP = WS_WIN + (size_t)2 * NC * 2048 * 2;
constexpr size_t WS_WKVUP = WS_WQUP + (size_t)2 * 1536 * 512 * 2;
constexpr size_t WS_WBR = WS_WKVUP + (size_t)2 * 2048 * 256 * 2;
constexpr size_t WS_WO = WS_WBR + (size_t)2 * 4 * 2048 * 1024 * 2;
constexpr size_t WS_WFOLD = WS_WO + (size_t)2 * 2048 * 2048 * 2;
constexpr size_t WS_UB = WS_WFOLD + (size_t)2 * 2048 * 2048 * 2;
constexpr size_t WS_VB2 = WS_UB + (size_t)2 * NEXP * 2048;
constexpr size_t WS_HB = WS_VB2 + (size_t)2 * NEXP * 2048;
constexpr size_t WS_P = WS_HB + (size_t)MR * 2048 * 2;
constexpr size_t WS_QB = WS_P + (size_t)MR * NC * 2;
constexpr size_t WS_KB = WS_QB + (size_t)MR * 1536 * 2;
constexpr size_t WS_VB = WS_KB + (size_t)MR * 1536 * 2;
constexpr size_t WS_BR = WS_VB + (size_t)MR * 1024 * 2;
constexpr size_t WS_XC = WS_BR + (size_t)MR * 4096 * 2;
constexpr size_t WS_SSK = WS_XC + (size_t)1024 * 2048 * 4;
constexpr size_t WS_SSQ = WS_SSK + (size_t)MR * 4 * 4;
constexpr size_t WS_SSKV = WS_SSQ + (size_t)MR * 16 * 4;
constexpr size_t WS_SSCQ = WS_SSKV + (size_t)MR * 4 * 4;
constexpr size_t WS_END = WS_SSCQ + (size_t)MR * 8 * 4;
constexpr size_t X1_OFF = 0, SC_OFF = (size_t)MR * 2048 * 4;
static_assert(SC_OFF * 2 <= (size_t)MR * NC * 2, "X1 + SC fit in P");
constexpr int LDS_BYTES = 132 * 1024;
constexpr int MISC_OFF = 128 * 1024;
constexpr int N_PHASES = 2 + 8 * DEPTH;
}

typedef unsigned short bf16_t;
typedef short bf16x8 __attribute__((ext_vector_type(8)));
typedef float f32x4 __attribute__((ext_vector_type(4)));
typedef float f32x2 __attribute__((ext_vector_type(2)));
typedef unsigned u32x4 __attribute__((ext_vector_type(4)));
typedef unsigned u32x2 __attribute__((ext_vector_type(2)));
#define LAS __attribute__((address_space(3)))
typedef LAS unsigned char* ldsp_t;

typedef __bf16 bf16x2v_t __attribute__((ext_vector_type(2)));
__device__ __forceinline__ unsigned cvt_pk_bf16(float lo, float hi) { const bf16x2v_t r = __builtin_convertvector((f32x2){lo, hi}, bf16x2v_t); return __builtin_bit_cast(unsigned, r); }
__device__ __forceinline__ bf16_t f2bf(float f) { return (bf16_t)(cvt_pk_bf16(f, 0.f) & 0xffffu); }
__device__ __forceinline__ float bf2f(bf16_t b) { return __uint_as_float(((unsigned)b) << 16); }
__device__ __forceinline__ float bflo(unsigned w) { return __uint_as_float(w << 16); }
__device__ __forceinline__ float bfhi(unsigned w) { return __uint_as_float(w & 0xffff0000u); }
__device__ __forceinline__ float shx(float v, int mask, int lane) { return __int_as_float(__builtin_amdgcn_ds_bpermute((lane ^ mask) << 2, __float_as_int(v))); }
__device__ __forceinline__ float wave_sum(float v, int lane) {
#pragma unroll
    for (int o = 32; o >= 1; o >>= 1) v += shx(v, o, lane);
    return v;
}
__device__ __forceinline__ int lane_id() { int l; asm volatile("v_mbcnt_lo_u32_b32 %0, -1, 0\n\tv_mbcnt_hi_u32_b32 %0, -1, %0" : "=v"(l)); return l; }
__device__ __forceinline__ float sigmoidf_(float x) { return __builtin_amdgcn_rcpf(1.0f + __builtin_amdgcn_exp2f(x * -1.4426950408889634f)); }

#define XB_TMO      128
#define XB_XCNT(j)  (256  + 64 * (j))
#define XB_XSUB(j)  (1280 + 64 * (j))
#define XB_XGEN(j)  (2304 + 64 * (j))
#define XB_TOP      3328
#define XB_TOPGEN   3392
#define XCD_BAR_WORDS 3456
#define XB_SPIN_CAP (1u << 23)
__device__ __forceinline__ unsigned xb_ld(unsigned* p)              { return __hip_atomic_load(p, __ATOMIC_RELAXED, __HIP_MEMORY_SCOPE_AGENT); }
__device__ __forceinline__ unsigned xb_add(unsigned* p, unsigned v) { return __hip_atomic_fetch_add(p, v, __ATOMIC_RELAXED, __HIP_MEMORY_SCOPE_AGENT); }
__device__ __forceinline__ unsigned xb_xcc_id() { return (unsigned)__builtin_amdgcn_s_getreg((3 << 11) | 20) & 0xFu; }
#define XB_SPIN(cond, bar) do { unsigned _sp = 0; while (cond) { __builtin_amdgcn_s_sleep(1); \
    if ((++_sp & 255u) == 0u) { if (xb_ld(&(bar)[XB_TMO])) break; if (_sp > XB_SPIN_CAP) { atomicAdd(&(bar)[XB_TMO], 1u); break; } } } } while (0)
struct XcdBarrier { unsigned* bar; unsigned x; volatile LAS unsigned* st; int wave; };
__device__ __forceinline__ XcdBarrier xcd_barrier_post(unsigned* bar, volatile LAS unsigned* st, int wave) {
    XcdBarrier b; b.bar = bar; b.x = xb_xcc_id(); b.st = st; b.wave = wave;
    if (wave == 0 && lane_id() == 0) (void)xb_add(&bar[XB_XCNT(b.x)], 1u);
    return b;
}
__device__ __forceinline__ void xcd_barrier_complete(unsigned* bar, unsigned x, unsigned& nloc, unsigned& nx) {
    const unsigned G = gridDim.x * gridDim.y * gridDim.z;
    unsigned sum, cnt, mine, sp = 0u;
    for (;;) {
        sum = 0u; cnt = 0u; mine = 0u;
#pragma unroll
        for (unsigned j = 0; j < 16; ++j) { const unsigned c = xb_ld(&bar[XB_XCNT(j)]); sum += c; cnt += (c > 0u) ? 1u : 0u; mine = (j == x) ? c : mine; }
        if (sum == G) break;
        __builtin_amdgcn_s_sleep(1);
        if ((++sp & 255u) == 0u) { if (xb_ld(&bar[XB_TMO])) break; if (sp > XB_SPIN_CAP) { atomicAdd(&bar[XB_TMO], 1u); break; } }
    }
    nloc = mine > 0u ? mine : 1u; nx = cnt > 0u ? cnt : 1u;
}
__device__ __forceinline__ void xcd_barrier(const XcdBarrier& b) {
    asm volatile("s_waitcnt vmcnt(0)" ::: "memory");
    __syncthreads();
    if (b.wave == 0 && lane_id() == 0) {
        unsigned* bar = b.bar;
        __builtin_amdgcn_s_waitcnt(0);
        unsigned nloc = b.st[0], nx = b.st[1];
        if (nloc == 0u) { xcd_barrier_complete(bar, b.x, nloc, nx); b.st[0] = nloc; b.st[1] = nx; }
        const unsigned old = xb_add(&bar[XB_XSUB(b.x)], 1u);
        const unsigned gen = old / nloc;
        if (old + 1u == (gen + 1u) * nloc) {
            __builtin_amdgcn_fence(__ATOMIC_RELEASE, "agent");
            asm volatile("s_waitcnt vmcnt(0)" ::: "memory");
            const unsigned og = xb_add(&bar[XB_TOP], 1u);
            const unsigned tg = og / nx;
            if (og + 1u == (tg + 1u) * nx) xb_add(&bar[XB_TOPGEN], 1u);
            else XB_SPIN(xb_ld(&bar[XB_TOPGEN]) == tg, bar);
            __builtin_amdgcn_fence(__ATOMIC_ACQUIRE, "agent");
            xb_add(&bar[XB_XGEN(b.x)], 1u);
            asm volatile("s_waitcnt vmcnt(0)" ::: "memory");
        } else {
            XB_SPIN(xb_ld(&bar[XB_XGEN(b.x)]) == gen, bar);
            __builtin_amdgcn_fence(__ATOMIC_ACQUIRE, "agent");
            asm volatile("s_waitcnt vmcnt(0)" ::: "memory");
        }
    }
    __syncthreads();
}

namespace pg8 {
constexpr int BM = 256, BK = 64, HALF = 128, HTB = HALF * BK * 2, STAGE_BYTES = 8 * HTB, NXCD = 8, WGM = 8;
__host__ __device__ __forceinline__ int lds_byte(int r, int c) { const int st = (r >> 4) * 2 + (c >> 5), rr = r & 15, cc = c & 31, ob = rr * 64 + cc * 2; return st * 1024 + (ob ^ (((ob >> 9) & 1) << 5)); }
__host__ __device__ __forceinline__ void stage_rc(int b, int& R, int& C) { const int st = b / 1024, sb = b % 1024, swz = sb ^ (((sb >> 9) & 1) << 5); R = (st >> 1) * 16 + swz / 64; C = (st & 1) * 32 + (swz % 64) / 2; }
__host__ __device__ __forceinline__ int perm32(int rho) { const int n = rho >> 4, i = rho & 15; return 8 * (i >> 2) + 4 * n + (i & 3); }
struct Unit { int pm, pn, sub; };
struct Gemm { const bf16_t* A; const bf16_t* Bt; int lda, K; };

struct TileOrder {
    int nM, nN, nwg, G, c, mode, nsub; size_t subA, subB;
    __device__ void init(int nM_, int nN_, int G_, int c_, int mode_, int nsub_ = 1, size_t subA_ = 0, size_t subB_ = 0) { nM = nM_; nN = nN_; nwg = nM * nN; G = G_; c = c_; mode = mode_; nsub = nsub_; subA = subA_; subB = subB_; }
    __device__ bool next(int i, Unit& u) const {
        const int it = nsub == 1 ? i : i / nsub; u.sub = nsub == 1 ? 0 : i - it * nsub;
        const long L = (long)it * G + c; if (L >= nwg) return false;
        int wgid = (int)L; { const int q = nwg / NXCD, r = nwg % NXCD, xcd = wgid % NXCD, off = wgid / NXCD; wgid = (xcd < r ? xcd * (q + 1) : r * (q + 1) + (xcd - r) * q) + off; }
        const int nig = WGM * nN, gid = wgid / nig, fm = gid * WGM, gsz = (nM - fm) < WGM ? (nM - fm) : WGM;
        const int pl = fm + ((wgid % nig) % gsz); u.pn = (wgid % nig) / gsz;
        u.pm = mode == 0 ? pl : (mode == 1 ? 17 * (pl >> 4) + 1 + (pl & 15) : 17 * pl);
        return true;
    }
    __device__ __forceinline__ void a_ready(const Unit&) const {}
    __device__ __forceinline__ void done(const Unit&) const {}
};

template <class Epi, class Sched>
__device__ __forceinline__ void gemm_phase(ldsp_t lds, const Gemm g, const Sched& S, const Epi& E, int wave_) {
    int tid = wave_ * 64 + lane_id(); asm volatile("" : "+v"(tid));
    const int wid = __builtin_amdgcn_readfirstlane(tid >> 6), lane = tid & 63, wr = wid >> 2, wc = wid & 3, fr = lane & 15, fq = lane >> 4;
    int K = g.K; asm volatile("" : "+s"(K));
    const int nt = K / BK, lda = g.lda;
    unsigned voffA[2], voffB[2];
#pragma unroll
    for (int i = 0; i < 2; ++i) { int R, C; stage_rc(tid * 16 + i * 8192, R, C); const int Rb = (R & ~31) + perm32(R & 31);
        voffA[i] = (unsigned)(R * lda + C) * 2u; voffB[i] = (unsigned)(Rb * K + C) * 2u; }
    const size_t kstep = (size_t)(BK * 2);
    const size_t hstepA = (size_t)HALF * lda * 2, hstepB = (size_t)HALF * K * 2;
    const size_t tstepA = 2 * hstepA, tstepB = 2 * hstepB;
    const unsigned ldsw = (unsigned)wid * 1024u;
    const int aoff = lds_byte(wr * 64 + fr, fq * 8), boff = lds_byte(wc * 32 + fr, fq * 8);
#define PG8_SA(b, h) (((b) * 2 + (h)) * HTB)
#define PG8_SB(b, h) ((4 + (b) * 2 + (h)) * HTB)
#define PG8_STAGE(bufoff, gbase, voff) do { _Pragma("unroll") for (int _i = 0; _i < 2; ++_i) \
        __builtin_amdgcn_global_load_lds((const unsigned*)((const char*)(gbase) + (voff)[_i]), (LAS unsigned*)(lds + (bufoff) + ldsw + _i * 8192), 16, 0, 0); } while (0)
#define PG8_LDA(dst, b, h) do { _Pragma("unroll") for (int m = 0; m < 4; ++m) _Pragma("unroll") for (int k = 0; k < 2; ++k) dst[m][k] = *(const LAS bf16x8*)(lds + PG8_SA(b, h) + aoff + m * 2048 + k * 1024); } while (0)
#define PG8_LDB(dst, b, h) do { _Pragma("unroll") for (int n = 0; n < 2; ++n) _Pragma("unroll") for (int k = 0; k < 2; ++k) dst[n][k] = *(const LAS bf16x8*)(lds + PG8_SB(b, h) + boff + n * 2048 + k * 1024); } while (0)
#define PG8_MMA(ai, bj, At, Bt) do { __builtin_amdgcn_s_setprio(1); _Pragma("unroll") for (int m = 0; m < 4; ++m) _Pragma("unroll") for (int n = 0; n < 2; ++n) _Pragma("unroll") for (int k = 0; k < 2; ++k) \
        acc[ai][bj][m][n] = __builtin_amdgcn_mfma_f32_16x16x32_bf16(Bt[n][k], At[m][k], acc[ai][bj][m][n], 0, 0, 0); __builtin_amdgcn_s_setprio(0); } while (0)
#define PG8_WAIT_V(n) asm volatile("s_waitcnt vmcnt(" #n ")" ::: "memory")
#define PG8_WAIT_L(n) asm volatile("s_waitcnt lgkmcnt(" #n ")" ::: "memory")
#define PG8_BAR __builtin_amdgcn_s_barrier()
#define PG8_SCHED __builtin_amdgcn_sched_barrier(0)
    Unit cur, nxt; int ui = 0;
    if (!S.next(0, cur)) return;
    f32x4 acc[2][2][4][2];
#pragma unroll
    for (int a = 0; a < 2; ++a)
#pragma unroll
        for (int b = 0; b < 2; ++b)
#pragma unroll
            for (int m = 0; m < 4; ++m)
#pragma unroll
                for (int n = 0; n < 2; ++n) acc[a][b][m][n] = (f32x4){0.f, 0.f, 0.f, 0.f};
    bf16x8 At[4][2], B0[2][2], B1[2][2];
    const char* cA = (const char*)g.A + (size_t)cur.pm * tstepA + cur.sub * S.subA; const char* cB = (const char*)g.Bt + (size_t)cur.pn * tstepB + cur.sub * S.subB;
    S.a_ready(cur);
    PG8_STAGE(PG8_SB(0, 0), cB, voffB); PG8_STAGE(PG8_SA(0, 0), cA, voffA); PG8_STAGE(PG8_SB(0, 1), cB + hstepB, voffB); PG8_STAGE(PG8_SA(0, 1), cA + hstepA, voffA);
    if (wr == 1) PG8_BAR;
    PG8_WAIT_V(4); PG8_BAR;
    PG8_STAGE(PG8_SB(1, 0), cB + kstep, voffB); PG8_STAGE(PG8_SA(1, 0), cA + kstep, voffA); PG8_STAGE(PG8_SB(1, 1), cB + hstepB + kstep, voffB);
    PG8_WAIT_V(6); PG8_BAR;
    for (;;) {
        const bool has_next = S.next(ui + 1, nxt);
        const char* nA = has_next ? (const char*)g.A + (size_t)nxt.pm * tstepA + nxt.sub * S.subA : cA; const char* nB = has_next ? (const char*)g.Bt + (size_t)nxt.pn * tstepB + nxt.sub * S.subB : cB;
#pragma unroll 1
        for (int t = 0; t < nt; t += 2) {
            const bool last = (t == nt - 2);
            const char* a1 = cA + (size_t)(t + 1) * kstep;
            const char* a2 = last ? nA : cA + (size_t)(t + 2) * kstep; const char* b2 = last ? nB : cB + (size_t)(t + 2) * kstep;
            const char* a3 = a2 + kstep; const char* b3 = b2 + kstep;
            if (last && has_next) S.a_ready(nxt);
            PG8_LDB(B0, 0, 0); PG8_SCHED; PG8_LDA(At, 0, 0); PG8_STAGE(PG8_SA(1, 1), a1 + hstepA, voffA);
            PG8_WAIT_L(8); PG8_BAR; PG8_WAIT_L(0); PG8_MMA(0, 0, At, B0); PG8_BAR; PG8_SCHED;
            PG8_LDB(B1, 0, 1); PG8_STAGE(PG8_SB(0, 0), b2, voffB);
            PG8_BAR; PG8_WAIT_L(0); PG8_MMA(0, 1, At, B1); PG8_BAR;
            PG8_LDA(At, 0, 1); PG8_STAGE(PG8_SA(0, 0), a2, voffA);
            PG8_BAR; PG8_WAIT_L(0); PG8_MMA(1, 0, At, B0); PG8_BAR; PG8_SCHED;
            PG8_STAGE(PG8_SB(0, 1), b2 + hstepB, voffB);
            PG8_WAIT_V(6); PG8_BAR; PG8_MMA(1, 1, At, B1); PG8_BAR;
            PG8_LDB(B0, 1, 0); PG8_SCHED; PG8_LDA(At, 1, 0); PG8_STAGE(PG8_SA(0, 1), a2 + hstepA, voffA);
            PG8_WAIT_L(8); PG8_BAR; PG8_WAIT_L(0); PG8_MMA(0, 0, At, B0); PG8_BAR; PG8_SCHED;
            PG8_LDB(B1, 1, 1); PG8_STAGE(PG8_SB(1, 0), b3, voffB);
            PG8_BAR; PG8_WAIT_L(0); PG8_MMA(0, 1, At, B1); PG8_BAR;
            PG8_LDA(At, 1, 1); PG8_STAGE(PG8_SA(1, 0), a3, voffA);
            PG8_BAR; PG8_WAIT_L(0); PG8_MMA(1, 0, At, B0); PG8_BAR; PG8_SCHED;
            PG8_STAGE(PG8_SB(1, 1), b3 + hstepB, voffB);
            PG8_WAIT_V(6); PG8_BAR; PG8_MMA(1, 1, At, B1); PG8_BAR;
        }
        E(acc, cur, wr, wc, fr, fq); S.done(cur);
        if (!has_next) break;
#pragma unroll
        for (int a = 0; a < 2; ++a)
#pragma unroll
            for (int b = 0; b < 2; ++b)
#pragma unroll
                for (int m = 0; m < 4; ++m)
#pragma unroll
                    for (int n = 0; n < 2; ++n) acc[a][b][m][n] = (f32x4){0.f, 0.f, 0.f, 0.f};
        cur = nxt; cA = nA; cB = nB; ++ui;
    }
    PG8_WAIT_V(0);
    if (wr == 0) PG8_BAR;
    PG8_BAR;
#undef PG8_SA
#undef PG8_SB
#undef PG8_STAGE
#undef PG8_LDA
#undef PG8_LDB
#undef PG8_MMA
#undef PG8_WAIT_V
#undef PG8_WAIT_L
#undef PG8_BAR
#undef PG8_SCHED
}

__device__ __forceinline__ u32x4 pack8(const f32x4 a, const f32x4 b) { u32x4 w; w.x = cvt_pk_bf16(a[0], a[1]); w.y = cvt_pk_bf16(a[2], a[3]); w.z = cvt_pk_bf16(b[0], b[1]); w.w = cvt_pk_bf16(b[2], b[3]); return w; }
#define EPI_ARGS const f32x4 (&acc)[2][2][4][2], const Unit& u, int wr, int wc, int fr_, int fq_
#define EPI_LANE int fr = fr_, fq = fq_; asm volatile("" : "+v"(fr), "+v"(fq));

struct EpiBf16 {
    bf16_t* O; int ldc;
    __device__ __forceinline__ void operator()(EPI_ARGS) const {
        EPI_LANE
        const int row0 = u.pm * BM + wr * 64 + fr, col0 = u.pn * BM + wc * 32 + 8 * fq;
#pragma unroll
        for (int ai = 0; ai < 2; ++ai)
#pragma unroll
            for (int m = 0; m < 4; ++m) { bf16_t* rowp = O + (size_t)(row0 + ai * HALF + m * 16) * ldc + col0;
#pragma unroll
                for (int bj = 0; bj < 2; ++bj) *(u32x4*)(rowp + bj * HALF) = pack8(acc[ai][bj][m][0], acc[ai][bj][m][1]); }
    }
};
struct EpiF32 {
    float* C; int ldc;
    __device__ __forceinline__ void operator()(EPI_ARGS) const {
        EPI_LANE
        const int row0 = u.pm * BM + wr * 64 + fr, col0 = u.pn * BM + wc * 32 + 8 * fq;
#pragma unroll
        for (int ai = 0; ai < 2; ++ai)
#pragma unroll
            for (int m = 0; m < 4; ++m) { float* rowp = C + (size_t)(row0 + ai * HALF + m * 16) * ldc + col0;
#pragma unroll
                for (int bj = 0; bj < 2; ++bj) { *(f32x4*)(rowp + bj * HALF) = acc[ai][bj][m][0]; *(f32x4*)(rowp + bj * HALF + 4) = acc[ai][bj][m][1]; } }
    }
};
struct EpiInProj {
    bf16_t* P; bf16_t* KB; const float* cosh; const float* sinh; const float* cosr; const float* sinr; const float* akn; const float* aqn;
    float* ssk; float* ssq; float* sskv; float* sscq;
    __device__ __forceinline__ void operator()(EPI_ARGS) const {
        EPI_LANE
        const int pn = u.pn, tb = u.pm % 17; const bool lat = tb != 0; const int posbase = (tb - 1) * 256;
        const int rl0 = wr * 64 + fr;
        if (pn >= 24) {
            const int col0 = pn * BM + wc * 32 + 8 * fq;
#pragma unroll
            for (int ai = 0; ai < 2; ++ai)
#pragma unroll
                for (int m = 0; m < 4; ++m) { bf16_t* rowp = P + ((size_t)u.pm * BM + rl0 + ai * HALF + m * 16) * cf::NC + col0;
#pragma unroll
                    for (int bj = 0; bj < 2; ++bj) { f32x4 v0 = acc[ai][bj][m][0], v1 = acc[ai][bj][m][1];
#pragma unroll
                        for (int e = 0; e < 4; ++e) { v0[e] = sigmoidf_(v0[e]); v1[e] = sigmoidf_(v1[e]); }
                        *(u32x4*)(rowp + bj * HALF) = pack8(v0, v1); } }
        } else if (pn >= 16) {
            const int col0 = cf::PC_GLU + 128 * (pn - 16) + wc * 32 + 8 * fq;
#pragma unroll
            for (int ai = 0; ai < 2; ++ai)
#pragma unroll
                for (int m = 0; m < 4; ++m) { f32x4 v0 = acc[ai][0][m][0], v1 = acc[ai][0][m][1]; const f32x4 g0 = acc[ai][1][m][0], g1 = acc[ai][1][m][1];
#pragma unroll
                    for (int e = 0; e < 4; ++e) { v0[e] *= sigmoidf_(g0[e]); v1[e] *= sigmoidf_(g1[e]); }
                    *(u32x4*)(P + ((size_t)u.pm * BM + rl0 + ai * HALF + m * 16) * cf::NC + col0) = pack8(v0, v1); }
        } else if (pn == 3) {
            if (wc == 0) { const int i0 = 8 * fq;
#pragma unroll
                for (int ai = 0; ai < 2; ++ai)
#pragma unroll
                    for (int m = 0; m < 4; ++m) { const int rl = rl0 + ai * HALF + m * 16;
                        f32x4 c0 = {1.f, 1.f, 1.f, 1.f}, c1 = c0, s0 = {0.f, 0.f, 0.f, 0.f}, s1 = s0;
                        if (lat) { const float* cp = cosr + (size_t)(posbase + rl) * 32 + i0; const float* sp = sinr + (size_t)(posbase + rl) * 32 + i0;
                            c0 = *(const f32x4*)cp; c1 = *(const f32x4*)(cp + 4); s0 = *(const f32x4*)sp; s1 = *(const f32x4*)(sp + 4); }
                        const f32x4 x1a = acc[ai][0][m][0], x1b = acc[ai][0][m][1], x2a = acc[ai][1][m][0], x2b = acc[ai][1][m][1];
                        const u32x4 w1 = pack8(x1a * c0 - x2a * s0, x1b * c1 - x2b * s1), w2 = pack8(x2a * c0 + x1a * s0, x2b * c1 + x1b * s1);
                        bf16_t* kb = KB + ((size_t)u.pm * BM + rl) * 1536 + 128 + i0;
#pragma unroll
                        for (int h = 0; h < 8; ++h) { *(u32x4*)(kb + h * 192) = w1; *(u32x4*)(kb + h * 192 + 32) = w2; }
                        asm volatile("" ::: "memory"); } }
        } else if (pn == 0 || pn == 4 || (pn >= 6 && pn <= 9) || pn >= 12) {
            const bool norm = pn == 0 || (pn >= 6 && pn <= 9);
            const int hl = wc >> 1, i0 = 32 * (wc & 1) + 8 * fq;
            f32x4 g1a = {1.f, 1.f, 1.f, 1.f}, g1b = g1a, g2a = g1a, g2b = g1a;
            if (norm) { const float* gn = (pn == 0 ? akn : aqn) + i0; g1a = *(const f32x4*)gn; g1b = *(const f32x4*)(gn + 4); g2a = *(const f32x4*)(gn + 64); g2b = *(const f32x4*)(gn + 68); }
            float* ssp = pn == 0 ? ssk + ((size_t)u.pm * BM * 2 + hl) * 2 + (wc & 1) : ssq + ((size_t)u.pm * BM * 8 + (pn - 6) * 2 + hl) * 2 + (wc & 1);
            const int sstr = pn == 0 ? 4 : 16;
#pragma unroll
            for (int ai = 0; ai < 2; ++ai)
#pragma unroll
                for (int m = 0; m < 4; ++m) { const int rl = rl0 + ai * HALF + m * 16;
                    f32x4 x1a = acc[ai][0][m][0], x1b = acc[ai][0][m][1], x2a = acc[ai][1][m][0], x2b = acc[ai][1][m][1];
                    if (norm) { const f32x4 q = x1a * x1a + x1b * x1b + x2a * x2a + x2b * x2b; float ss = (q[0] + q[1]) + (q[2] + q[3]);
                        ss += shx(ss, 16, fr + 16 * fq); ss += shx(ss, 32, fr + 16 * fq);
                        if (fq == 0) ssp[(size_t)rl * sstr] = ss;
                        x1a *= g1a; x1b *= g1b; x2a *= g2a; x2b *= g2b; }
                    f32x4 o1a = x1a, o1b = x1b, o2a = x2a, o2b = x2b;
                    if (lat) { const float* cp = cosh + (size_t)(posbase + rl) * 64 + i0; const float* sp = sinh + (size_t)(posbase + rl) * 64 + i0;
                        const f32x4 c0 = *(const f32x4*)cp, c1 = *(const f32x4*)(cp + 4), s0 = *(const f32x4*)sp, s1 = *(const f32x4*)(sp + 4);
                        o1a = x1a * c0 - x2a * s0; o1b = x1b * c1 - x2b * s1; o2a = x2a * c0 + x1a * s0; o2b = x2b * c1 + x1b * s1; }
                    bf16_t* dst = P + ((size_t)u.pm * BM + rl) * cf::NC + pn * BM + hl * 128 + i0;
                    *(u32x4*)dst = pack8(o1a, o1b); *(u32x4*)(dst + 64) = pack8(o2a, o2b);
                    asm volatile("" ::: "memory"); }
        } else {
            const int col0 = pn * BM + wc * 32 + 8 * fq;
            const bool ssq_on = pn == 2 || pn == 10 || pn == 11;
            float* ssp = pn == 2 ? sskv + (size_t)u.pm * BM * 4 + wc : sscq + (size_t)u.pm * BM * 8 + (pn - 10) * 4 + wc;
            const int sstr = pn == 2 ? 4 : 8;
#pragma unroll
            for (int ai = 0; ai < 2; ++ai)
#pragma unroll
                for (int m = 0; m < 4; ++m) { const int rl = rl0 + ai * HALF + m * 16; bf16_t* rowp = P + ((size_t)u.pm * BM + rl) * cf::NC + col0;
#pragma unroll
                    for (int bj = 0; bj < 2; ++bj) *(u32x4*)(rowp + bj * HALF) = pack8(acc[ai][bj][m][0], acc[ai][bj][m][1]);
                    if (ssq_on) { const f32x4 q = acc[ai][0][m][0] * acc[ai][0][m][0] + acc[ai][0][m][1] * acc[ai][0][m][1] + acc[ai][1][m][0] * acc[ai][1][m][0] + acc[ai][1][m][1] * acc[ai][1][m][1];
                        float ss = (q[0] + q[1]) + (q[2] + q[3]); ss += shx(ss, 16, fr + 16 * fq); ss += shx(ss, 32, fr + 16 * fq);
                        if (fq == 0) ssp[(size_t)rl * sstr] = ss; } }
        }
    }
};
struct EpiKvUp {
    bf16_t* KB; bf16_t* VB; const float* sskv;
    __device__ __forceinline__ void operator()(EPI_ARGS) const {
        EPI_LANE
        const int row0 = u.pm * BM + wr * 64 + fr, d0 = wc * 32 + 8 * fq;
        const bool isk = u.pn < 4;
        bf16_t* base = isk ? KB + (2 * u.pn) * 192 + d0 : VB + (u.pn - 4) * 256 + d0;
        const int ldr = isk ? 1536 : 1024, bjs = isk ? 192 : 128;
#pragma unroll
        for (int ai = 0; ai < 2; ++ai)
#pragma unroll
            for (int m = 0; m < 4; ++m) { const size_t row = (size_t)(row0 + ai * HALF + m * 16); bf16_t* rowp = base + row * ldr;
                const f32x4 pp = *(const f32x4*)(sskv + row * 4); const float r = rsqrtf(((pp[0] + pp[1]) + (pp[2] + pp[3])) * (1.f / 256.f) + 1e-6f);
#pragma unroll
                for (int bj = 0; bj < 2; ++bj) *(u32x4*)(rowp + bj * bjs) = pack8(acc[ai][bj][m][0] * r, acc[ai][bj][m][1] * r); }
    }
};
struct EpiQUp {
    bf16_t* QB; const float* cosr; const float* sinr; const float* sscq;
    __device__ __forceinline__ void operator()(EPI_ARGS) const {
        EPI_LANE
        const int row0 = u.pm * BM + wr * 64 + fr;
        if (u.pn < 4) {
            const int d0 = wc * 32 + 8 * fq;
#pragma unroll
            for (int ai = 0; ai < 2; ++ai)
#pragma unroll
                for (int m = 0; m < 4; ++m) { const size_t row = (size_t)(row0 + ai * HALF + m * 16);
                    const f32x4 pa = *(const f32x4*)(sscq + row * 8), pb = *(const f32x4*)(sscq + row * 8 + 4);
                    const float r = rsqrtf((((pa[0] + pa[1]) + (pa[2] + pa[3])) + ((pb[0] + pb[1]) + (pb[2] + pb[3]))) * (1.f / 512.f) + 1e-6f);
#pragma unroll
                    for (int bj = 0; bj < 2; ++bj) *(u32x4*)(QB + row * 1536 + (2 * u.pn + bj) * 192 + d0) = pack8(acc[ai][bj][m][0] * r, acc[ai][bj][m][1] * r); }
        } else {
            const int head = 4 * (u.pn - 4) + wc, i0 = 8 * fq;
            const bool lat = (u.pm % 17) != 0; const int posbase = (u.pm % 17) * 256 - 256;
#pragma unroll
            for (int ai = 0; ai < 2; ++ai)
#pragma unroll
                for (int m = 0; m < 4; ++m) { const int rl = wr * 64 + fr + ai * HALF + m * 16; const size_t row = (size_t)u.pm * BM + rl;
                    const f32x4 pa = *(const f32x4*)(sscq + row * 8), pb = *(const f32x4*)(sscq + row * 8 + 4);
                    const float r = rsqrtf((((pa[0] + pa[1]) + (pa[2] + pa[3])) + ((pb[0] + pb[1]) + (pb[2] + pb[3]))) * (1.f / 512.f) + 1e-6f);
                    f32x4 c0 = {1.f, 1.f, 1.f, 1.f}, c1 = c0, s0 = {0.f, 0.f, 0.f, 0.f}, s1 = s0;
                    if (lat) { const float* cp = cosr + (size_t)(posbase + rl) * 32 + i0; const float* sp = sinr + (size_t)(posbase + rl) * 32 + i0;
                        c0 = *(const f32x4*)cp; c1 = *(const f32x4*)(cp + 4); s0 = *(const f32x4*)sp; s1 = *(const f32x4*)(sp + 4); }
                    const f32x4 x1a = acc[ai][0][m][0] * r, x1b = acc[ai][0][m][1] * r, x2a = acc[ai][1][m][0] * r, x2b = acc[ai][1][m][1] * r;
                    const f32x4 o1a = x1a * c0 - x2a * s0, o1b = x1b * c1 - x2b * s1, o2a = x2a * c0 + x1a * s0, o2b = x2b * c1 + x1b * s1;
                    bf16_t* dst = QB + row * 1536 + head * 192 + 128 + i0;
                    *(u32x4*)dst = pack8(o1a, o1b); *(u32x4*)(dst + 32) = pack8(o2a, o2b); asm volatile("" ::: "memory"); }
        }
    }
};
struct EpiMerge {
    bf16_t* ACC; const bf16_t* gate0; int ldg;
    __device__ __forceinline__ void operator()(EPI_ARGS) const {
        EPI_LANE
        const int row0 = u.pm * BM + wr * 64 + fr, col0 = u.pn * BM + wc * 32 + 8 * fq;
        const bf16_t* gate = gate0 + u.sub * 2048; const bool first = u.sub == 0;
#pragma unroll
        for (int ai = 0; ai < 2; ++ai) {
            u32x4 gw[4][2], pw[4][2];
#pragma unroll
            for (int m = 0; m < 4; ++m) { const size_t row = (size_t)(row0 + ai * HALF + m * 16);
#pragma unroll
                for (int bj = 0; bj < 2; ++bj) { const int col = col0 + bj * HALF; gw[m][bj] = *(const u32x4*)(gate + row * ldg + col);
                    pw[m][bj] = (u32x4){0u, 0u, 0u, 0u}; if (!first) pw[m][bj] = *(const u32x4*)(ACC + row * 2048 + col); } }
#pragma unroll
            for (int m = 0; m < 4; ++m) { const size_t row = (size_t)(row0 + ai * HALF + m * 16);
#pragma unroll
                for (int bj = 0; bj < 2; ++bj) { const int col = col0 + bj * HALF; const u32x4 g = gw[m][bj], p = pw[m][bj];
                    const f32x4 a0 = acc[ai][bj][m][0], a1 = acc[ai][bj][m][1];
                    f32x4 r0, r1;
                    r0[0] = bflo(p.x) + bflo(g.x) * a0[0]; r0[1] = bfhi(p.x) + bfhi(g.x) * a0[1]; r0[2] = bflo(p.y) + bflo(g.y) * a0[2]; r0[3] = bfhi(p.y) + bfhi(g.y) * a0[3];
                    r1[0] = bflo(p.z) + bflo(g.z) * a1[0]; r1[1] = bfhi(p.z) + bfhi(g.z) * a1[1]; r1[2] = bflo(p.w) + bflo(g.w) * a1[2]; r1[3] = bfhi(p.w) + bfhi(g.w) * a1[3];
                    *(u32x4*)(ACC + row * 2048 + col) = pack8(r0, r1); } }
            asm volatile("" ::: "memory"); }
    }
};
struct EpiWo {
    float* X1; const float* mod  ; const float* xlat  ; const float* xctx  ;
    __device__ __forceinline__ void operator()(EPI_ARGS) const {
        EPI_LANE
        const int b = u.pm / 17, tb = u.pm % 17; const bool isctx = tb == 0;
        const float* g1 = mod + (size_t)(isctx ? 4 : b) * 12288 + 2 * 2048;
        const float* xbase = isctx ? xctx + (size_t)b * cf::CTX * 2048 : xlat + ((size_t)b * cf::S + (size_t)(tb - 1) * 256) * 2048;
        const int rl0 = wr * 64 + fr, col0 = u.pn * BM + wc * 32 + 8 * fq;
        f32x4 gv[2][2];
#pragma unroll
        for (int bj = 0; bj < 2; ++bj) { gv[bj][0] = *(const f32x4*)(g1 + col0 + bj * HALF); gv[bj][1] = *(const f32x4*)(g1 + col0 + bj * HALF + 4); }
#pragma unroll
        for (int ai = 0; ai < 2; ++ai) {
            f32x4 xv[4][2][2];
#pragma unroll
            for (int m = 0; m < 4; ++m) { const int rl = rl0 + ai * HALF + m * 16;
#pragma unroll
                for (int bj = 0; bj < 2; ++bj) { const float* xp = xbase + (size_t)rl * 2048 + col0 + bj * HALF; xv[m][bj][0] = *(const f32x4*)xp; xv[m][bj][1] = *(const f32x4*)(xp + 4); } }
#pragma unroll
            for (int m = 0; m < 4; ++m) { const int rl = rl0 + ai * HALF + m * 16; float* op = X1 + ((size_t)u.pm * BM + rl) * 2048 + col0;
#pragma unroll
                for (int bj = 0; bj < 2; ++bj) { *(f32x4*)(op + bj * HALF) = xv[m][bj][0] * cf::ALPHA + gv[bj][0] * acc[ai][bj][m][0];
                    *(f32x4*)(op + bj * HALF + 4) = xv[m][bj][1] * cf::ALPHA + gv[bj][1] * acc[ai][bj][m][1]; } }
            asm volatile("" ::: "memory"); }
    }
};
}

struct Ctx {
    const float* const* in; float* out; unsigned char* ws;
    ldsp_t lds; int tid, lane, wave, G, bid;
};
#define WSP(T, off) ((T*)(F.ws + (off)))
__device__ __forceinline__ Ctx phase_ctx(const Ctx& F0) {
    Ctx C = F0;
    C.tid = F0.wave * 64 + lane_id();
    asm volatile("" : "+v"(C.tid));
    { size_t z = 0; asm volatile("" : "+s"(z)); C.ws = F0.ws + z; }
    C.lane = C.tid & 63; C.wave = __builtin_amdgcn_readfirstlane(C.tid >> 6);
    return C;
}

__device__ __forceinline__ int srcmap(int mode, int n) {
    if (mode == 0) {
        const int pn = n >> 8, q = n & 255, bj = q >> 7, r = q & 127, rope = (r >> 6) * 128 + bj * 64 + (r & 63);
        if (pn == 0) return rope;
        if (pn == 1) return 256 + q;
        if (pn == 2) return 512 + q;
        if (pn == 3) return r < 32 ? 768 + bj * 32 + r : -1;
        if (pn == 4) return 832 + rope;
        if (pn == 5) return 1088 + q;
        if (pn < 10) return 1344 + (pn - 6) * 256 + rope;
        if (pn < 12) return 2368 + (pn - 10) * 256 + q;
        if (pn < 16) return 2880 + (pn - 12) * 256 + rope;
        if (pn < 24) return 3904 + bj * 1024 + 128 * (pn - 16) + r;
        return 5952 + (n - 6144);
    }
    if (mode == 1) { if (n < 1024) return (n >> 7) * 192 + (n & 127);
        const int m = n - 1024, t = m >> 8, bj = (m >> 7) & 1, q = m & 127; return (4 * t + (q >> 5)) * 192 + 128 + bj * 32 + (q & 31); }
    if (mode == 2) { if (n < 1024) return (n >> 7) * 256 + (n & 127); const int m = n - 1024; return (m >> 7) * 256 + 128 + (m & 127); }
    return n;
}
__device__ __forceinline__ void tr_tile(const Ctx& F, const float* src, int ld_src, int mode, int k0, bf16_t* dst, int ldd, int n0, const float* kscale = nullptr) {
    LAS float* T = (LAS float*)F.lds;
    const int kr = F.tid >> 6, nc = (F.tid & 63) * 4, sc = srcmap(mode, n0 + nc);
    f32x4 v[8];
#pragma unroll
    for (int h = 0; h < 8; ++h) { v[h] = (f32x4){0.f, 0.f, 0.f, 0.f}; if (sc >= 0) v[h] = *(const f32x4*)(src + (size_t)(k0 + kr + 8 * h) * ld_src + sc); }
#pragma unroll
    for (int h = 0; h < 8; ++h) { const int k = kr + 8 * h; f32x4 x = v[h]; if (kscale) x = x * kscale[k0 + k];
        T[k * 257 + nc + 0] = x[0]; T[k * 257 + nc + 1] = x[1]; T[k * 257 + nc + 2] = x[2]; T[k * 257 + nc + 3] = x[3]; }
    __syncthreads();
    const int n = F.tid >> 1, kc = (F.tid & 1) * 32;
#pragma unroll
    for (int j = 0; j < 4; ++j) { u32x4 w; const int kb = kc + 8 * j;
        w.x = cvt_pk_bf16(T[(kb + 0) * 257 + n], T[(kb + 1) * 257 + n]); w.y = cvt_pk_bf16(T[(kb + 2) * 257 + n], T[(kb + 3) * 257 + n]);
        w.z = cvt_pk_bf16(T[(kb + 4) * 257 + n], T[(kb + 5) * 257 + n]); w.w = cvt_pk_bf16(T[(kb + 6) * 257 + n], T[(kb + 7) * 257 + n]);
        *(u32x4*)(dst + (size_t)(n0 + n) * ldd + k0 + kb) = w; }
    __syncthreads();
}
__device__ __forceinline__ void cvt_rows(const Ctx& F, const float* src, bf16_t* dst, size_t n8) {
    for (size_t i = (size_t)F.bid * 512 + F.tid; i < n8; i += (size_t)F.G * 512) {
        const f32x4 a = *(const f32x4*)(src + i * 8), b = *(const f32x4*)(src + i * 8 + 4);
        *(u32x4*)(dst + i * 8) = pg8::pack8(a, b); }
}

__device__ __forceinline__ void cvt_rows_fp8(const Ctx& F, const float* src, unsigned char* dst, size_t n16, float scale) {
    const size_t stride = (size_t)F.G * 512;
    for (size_t i = (size_t)F.bid * 512 + F.tid; i < n16; i += 2 * stride) {
        const size_t i2 = i + stride; const bool two = i2 < n16;
        f32x4 a[8];
#pragma unroll
        for (int j = 0; j < 4; ++j) { a[j] = *(const f32x4*)(src + i * 16 + 4 * j); a[4 + j] = two ? *(const f32x4*)(src + i2 * 16 + 4 * j) : (f32x4){0.f, 0.f, 0.f, 0.f}; }
        u32x4 w0, w1;
#pragma unroll
        for (int j = 0; j < 4; ++j) { const f32x4 x = a[j] * scale, y = a[4 + j] * scale;
            int p = 0; p = __builtin_amdgcn_cvt_pk_fp8_f32(x[0], x[1], p, false); p = __builtin_amdgcn_cvt_pk_fp8_f32(x[2], x[3], p, true); w0[j] = (unsigned)p;
            int q = 0; q = __builtin_amdgcn_cvt_pk_fp8_f32(y[0], y[1], q, false); q = __builtin_amdgcn_cvt_pk_fp8_f32(y[2], y[3], q, true); w1[j] = (unsigned)q; }
        *(u32x4*)(dst + i * 16) = w0; if (two) *(u32x4*)(dst + i2 * 16) = w1; }
}

constexpr int V4_ROW = 1088;
__device__ __forceinline__ void cvt_rows_fp4(const Ctx& F, const float* src, unsigned char* dst, size_t nblk) {
    for (size_t i = (size_t)F.bid * 512 + F.tid; i < nblk; i += (size_t)F.G * 512) {
        f32x4 a[8]; float amax = 0.f;
#pragma unroll
        for (int j = 0; j < 8; ++j) { a[j] = *(const f32x4*)(src + i * 32 + 4 * j); amax = fmaxf(amax, fmaxf(fmaxf(fabsf(a[j][0]), fabsf(a[j][1])), fmaxf(fabsf(a[j][2]), fabsf(a[j][3])))); }
        int e = amax > 0.f ? (int)ceilf(log2f(amax * (1.0f / 6.0f))) : -126; e = e < -126 ? -126 : (e > 126 ? 126 : e);
        const float inv = __uint_as_float((unsigned)(127 - e) << 23);
        u32x4 w;
#pragma unroll
        for (int j = 0; j < 4; ++j) { const f32x4 x = a[2 * j] * inv, y = a[2 * j + 1] * inv; unsigned p = 0u;
            p = __builtin_amdgcn_cvt_scalef32_pk_fp4_f32(p, x[0], x[1], 1.0f, 0); p = __builtin_amdgcn_cvt_scalef32_pk_fp4_f32(p, x[2], x[3], 1.0f, 1);
            p = __builtin_amdgcn_cvt_scalef32_pk_fp4_f32(p, y[0], y[1], 1.0f, 2); p = __builtin_amdgcn_cvt_scalef32_pk_fp4_f32(p, y[2], y[3], 1.0f, 3); w[j] = p; }
        const size_t row = i >> 6; const int bl = (int)(i & 63);
        *(u32x4*)(dst + row * V4_ROW + bl * 16) = w; dst[row * V4_ROW + 1024 + bl] = (unsigned char)(e + 127);
    }
}

__device__ __forceinline__ void ph_prologue(const Ctx& F0) {
    const Ctx F = phase_ctx(F0);
    using namespace cf;
    constexpr int T_WIN = 2 * 32 * 56, T_QUP = 2 * 8 * 6, T_KVUP = 2 * 4 * 8, T_BR = 2 * 4 * 16 * 8, T_WO = 2 * 32 * 8;
    constexpr int T_ALL = T_WIN + T_QUP + T_KVUP + T_BR + T_WO;
    for (int u = F.bid; u < T_ALL; u += F.G) {
        int t = u;
        if (t < T_WIN) { const int l = t / (32 * 56), r = t % (32 * 56), kt = r / 56, nt = r % 56;
            tr_tile(F, F.in[I_WIN] + (size_t)l * 2048 * IN_COLS, IN_COLS, 0, kt * 64, WSP(bf16_t, WS_WIN) + (size_t)l * NC * 2048, 2048, nt * 256); continue; }
        t -= T_WIN;
        if (t < T_QUP) { const int l = t / (8 * 6), r = t % (8 * 6), kt = r / 6, nt = r % 6;
            tr_tile(F, F.in[I_WQUP] + (size_t)l * 512 * 1536, 1536, 1, kt * 64, WSP(bf16_t, WS_WQUP) + (size_t)l * 1536 * 512, 512, nt * 256, F.in[I_BQN] + l * 512); continue; }
        t -= T_QUP;
        if (t < T_KVUP) { const int l = t / (4 * 8), r = t % (4 * 8), kt = r / 8, nt = r % 8;
            tr_tile(F, F.in[I_WKVUP] + (size_t)l * 256 * 2048, 2048, 2, kt * 64, WSP(bf16_t, WS_WKVUP) + (size_t)l * 2048 * 256, 256, nt * 256, F.in[I_BKVN] + l * 256); continue; }
        t -= T_KVUP;
        if (t < T_BR) { const int l = t / (4 * 128), r = t % (4 * 128), br = r / 128, r2 = r % 128, kt = r2 / 8, nt = r2 % 8;
            const float* src = (br == 0 ? F.in[I_WBRA] : br == 1 ? F.in[I_WBRB] : br == 2 ? F.in[I_WBRC] : F.in[I_WBRD]) + (size_t)l * 1024 * 2048;
            tr_tile(F, src, 2048, 3, kt * 64, WSP(bf16_t, WS_WBR) + ((size_t)l * 4 + br) * 2048 * 1024, 1024, nt * 256); continue; }
        t -= T_BR;
        { const int l = t / 256, r = t % 256, kt = r / 8, nt = r % 8;
            tr_tile(F, F.in[I_WO] + (size_t)l * 2048 * 2048, 2048, 3, kt * 64, WSP(bf16_t, WS_WO) + (size_t)l * 2048 * 2048, 2048, nt * 256); }
    }
    for (int u = F.bid; u < 2 * 16 * 32; u += F.G) {
        const int l = u / 512, g = (u % 512) / 32, d0 = (u % 32) * 64;
        LAS float* sk = (LAS float*)F.lds; LAS float* wt = (LAS float*)(F.lds + 128 * 129 * 4);
        const float* skg = F.in[I_PSK] + ((size_t)l * 16 + g) * 128 * 128;
        const float* wqg = F.in[I_PWQ] + (size_t)l * 2048 * 2048 + (size_t)d0 * 2048 + g * 128;
        for (int i = F.tid; i < 128 * 128; i += 512) sk[(i >> 7) * 129 + (i & 127)] = skg[i];
        for (int i = F.tid; i < 64 * 128; i += 512) wt[(i >> 7) * 129 + (i & 127)] = wqg[(size_t)(i >> 7) * 2048 + (i & 127)];
        __syncthreads();
        const int n = F.tid & 127, dg = F.tid >> 7;
        float a[16];
#pragma unroll
        for (int e = 0; e < 16; ++e) a[e] = 0.f;
        for (int k = 0; k < 128; ++k) { const float s = sk[n * 129 + k];
#pragma unroll
            for (int e = 0; e < 16; ++e) a[e] += wt[(dg * 16 + e) * 129 + k] * s; }
        bf16_t* dst = WSP(bf16_t, WS_WFOLD) + (size_t)l * 2048 * 2048 + (size_t)(g * 128 + n) * 2048 + d0 + dg * 16;
        u32x4 w0, w1;
        w0.x = cvt_pk_bf16(a[0], a[1]); w0.y = cvt_pk_bf16(a[2], a[3]); w0.z = cvt_pk_bf16(a[4], a[5]); w0.w = cvt_pk_bf16(a[6], a[7]);
        w1.x = cvt_pk_bf16(a[8], a[9]); w1.y = cvt_pk_bf16(a[10], a[11]); w1.z = cvt_pk_bf16(a[12], a[13]); w1.w = cvt_pk_bf16(a[14], a[15]);
        *(u32x4*)dst = w0; *(u32x4*)(dst + 8) = w1;
        __syncthreads();
    }
    for (int u = F.bid; u < 2 * 192; u += F.G) {
        const int l = u / 192, n0 = (u % 192) * 64;
        LAS float* sl = (LAS float*)F.lds; LAS float* red = (LAS float*)(F.lds + 5 * 2048 * 4);
        for (int i = F.tid; i < 5 * 2048; i += 512) { const int r = i >> 11, k = i & 2047; const float v = r < 4 ? F.in[I_C][r * 2048 + k] : F.in[I_CCTX][k]; sl[i] = v * sigmoidf_(v); }
        __syncthreads();
        const int cg = F.tid & 15, ks = F.tid >> 4;
        f32x4 a[5];
#pragma unroll
        for (int r = 0; r < 5; ++r) a[r] = (f32x4){0.f, 0.f, 0.f, 0.f};
        const float* wp = F.in[I_WADA] + (size_t)l * 2048 * 12288 + n0 + cg * 4;
#pragma unroll 8
        for (int k = ks * 64; k < ks * 64 + 64; ++k) { const f32x4 w = *(const f32x4*)(wp + (size_t)k * 12288);
#pragma unroll
            for (int r = 0; r < 5; ++r) a[r] += w * sl[r * 2048 + k]; }
#pragma unroll
        for (int r = 0; r < 5; ++r) *(LAS f32x4*)(red + (ks * 5 + r) * 64 + cg * 4) = a[r];
        __syncthreads();
        if (F.tid < 320) { const int r = F.tid >> 6, col = F.tid & 63; float sacc = 0.f;
#pragma unroll
            for (int k2 = 0; k2 < 32; ++k2) sacc += red[(k2 * 5 + r) * 64 + col];
            WSP(float, WS_MOD)[((size_t)l * 5 + r) * 12288 + n0 + col] = sacc + F.in[I_BADA][(size_t)l * 12288 + n0 + col]; }
        __syncthreads();
    }
    for (int i = F.bid * 512 + F.tid; i < 4096 * 64; i += F.G * 512) {
        const int pos = i >> 6, j = i & 63, fi = j & 31; const float fr = powf(10000.0f, -(float)(2 * fi) / 64.0f);
        const float ang = (float)(j < 32 ? (pos >> 6) : (pos & 63)) * fr;
        WSP(float, WS_COSH)[i] = cosf(ang); WSP(float, WS_SINH)[i] = sinf(ang);
    }
    for (int i = F.bid * 512 + F.tid; i < 4096 * 32; i += F.G * 512) {
        const int pos = i >> 5, j = i & 31, fi = j & 15; const float fr = powf(10000.0f, -(float)(2 * fi) / 32.0f);
        const float ang = (float)(j < 16 ? (pos >> 6) : (pos & 63)) * fr;
        WSP(float, WS_COSR)[i] = cosf(ang); WSP(float, WS_SINR)[i] = sinf(ang);
    }
    cvt_rows_fp8(F, F.in[I_PU], WSP(unsigned char, WS_UB), (size_t)2 * NEXP * 2048 / 16, 1024.f);
    cvt_rows_fp4(F, F.in[I_PV], WSP(unsigned char, WS_VB2), (size_t)2 * NEXP * 64);
}

__device__ __forceinline__ void ph_modulate0(const Ctx& F0) {
    const Ctx F = phase_ctx(F0);
    using namespace cf;
    const float* mod = WSP(float, WS_MOD);
    for (size_t i = (size_t)F.bid * 512 + F.tid; i < (size_t)MR * 256; i += (size_t)F.G * 512) {
        const int R = (int)(i >> 8), d = (int)(i & 255) * 8, b = R / RB, j = R % RB;
        const float* src = j < CTX ? F.in[I_CTX] + ((size_t)b * CTX + j) * 2048 : F.in[I_X] + ((size_t)b * S + (j - CTX)) * 2048;
        const float* m = mod + (size_t)(j < CTX ? 4 : b) * 12288;
        const f32x4 x0 = *(const f32x4*)(src + d), x1 = *(const f32x4*)(src + d + 4);
        const f32x4 sh0 = *(const f32x4*)(m + d), sh1 = *(const f32x4*)(m + d + 4), s0 = *(const f32x4*)(m + 2048 + d), s1 = *(const f32x4*)(m + 2048 + d + 4);
        *(u32x4*)(WSP(bf16_t, WS_HB) + (size_t)R * 2048 + d) = pg8::pack8(x0 * (s0 + 1.0f) + sh0, x1 * (s1 + 1.0f) + sh1);
    }
}

__device__ __forceinline__ void knorm_pass(const Ctx& F) {
    using namespace cf;
    bf16_t* P = WSP(bf16_t, WS_P); const float* ssk = WSP(const float, WS_SSK);
    for (int it = F.bid * 8 + F.wave; it < MR * 2; it += F.G * 8) {
        const int R = it >> 1, h = it & 1;
        const f32x2 pp = *(const f32x2*)(ssk + (size_t)it * 2); const float r = rsqrtf((pp.x + pp.y) * (1.f / 128.f) + 1e-6f);
        unsigned* q = (unsigned*)(P + (size_t)R * NC + PC_AK + h * 128) + F.lane;
        const unsigned w = *q; *q = cvt_pk_bf16(bflo(w) * r, bfhi(w) * r);
    }
}

struct AttnArgs {
    const bf16_t* Q; const bf16_t* K; const bf16_t* V; bf16_t* O; int ldq, ldk, ldv, ldo;
    int seg0_row, seg0_tiles, seg1_row, seg1_tiles;
    int mask_on, qpos0, kpos1;
    float sc_log2; int has_sink; float sink_l2;
    int variant;
    const float* qss;
};
typedef float f32x16 __attribute__((ext_vector_type(16)));
template <int DK, bool MASKED>
__device__ __forceinline__ void attn_unit(ldsp_t lds, const AttnArgs a, int wave_) {
    constexpr int ND = DK / 16, KCH = DK / 8, KPT = (64 * KCH) / 512, VST = 72, KM = DK == 128 ? 15 : 7;
    constexpr int KBUF = 64 * DK * 2, VBUF = 128 * VST * 2, VOFF = 2 * KBUF, ALOFF = VOFF + 3 * VBUF;
    int tid = wave_ * 64 + lane_id(); asm volatile("" : "+v"(tid));
    const int wid = __builtin_amdgcn_readfirstlane(tid >> 6), lane = tid & 63, q32 = lane & 31, hi = lane >> 5;
    LAS float* al = (LAS float*)(lds + ALOFF + wid * 128);
    bf16x8 qf[ND];
    { float scq = a.sc_log2;
      if (a.qss) { const f32x2 pp = *(const f32x2*)(a.qss + (size_t)(wid * 32 + q32) * 16); scq *= rsqrtf((pp.x + pp.y) * (1.f / 128.f) + 1e-6f); }
      const bf16_t* qrow = a.Q + (size_t)(wid * 32 + q32) * a.ldq + 8 * hi;
#pragma unroll
      for (int s = 0; s < ND; ++s) { const u32x4 w = *(const u32x4*)(qrow + 16 * s); u32x4 o;
          o.x = cvt_pk_bf16(bflo(w.x) * scq, bfhi(w.x) * scq); o.y = cvt_pk_bf16(bflo(w.y) * scq, bfhi(w.y) * scq);
          o.z = cvt_pk_bf16(bflo(w.z) * scq, bfhi(w.z) * scq); o.w = cvt_pk_bf16(bflo(w.w) * scq, bfhi(w.w) * scq); qf[s] = *(bf16x8*)&o; } }
    f32x16 o[4];
#pragma unroll
    for (int db = 0; db < 4; ++db)
#pragma unroll
        for (int r = 0; r < 16; ++r) o[db][r] = 0.f;
    float m_run = -1e30f, l_run = 0.f;
    const int PV_ = MK_AV ? a.variant : 0;
    const int ntiles = a.seg0_tiles + a.seg1_tiles;
    u32x4 vreg[2];
    const int vkp = tid & 31, vdc = tid >> 5;
    const int vkey = 2 * vkp, vpos = (vkey & 48) | ((vkey & 4) << 1) | ((vkey & 8) >> 1) | (vkey & 3);
    unsigned koff[KPT];
#pragma unroll
    for (int i = 0; i < KPT; ++i) { const int P = (i * 8 + wid) * 64 + lane, row = P / KCH, cp = P % KCH; koff[i] = (unsigned)(row * a.ldk + 8 * (cp ^ (row & KM))) * 2u; }
#define ATT_LOAD(tt, kb) do { const int _r0 = (tt) < a.seg0_tiles ? a.seg0_row + 64 * (tt) : a.seg1_row + 64 * ((tt) - a.seg0_tiles); \
        const char* _kg = (const char*)(a.K + (size_t)_r0 * a.ldk); \
        _Pragma("unroll") for (int _i = 0; _i < KPT; ++_i) __builtin_amdgcn_global_load_lds((const unsigned*)(_kg + koff[_i]), (LAS unsigned*)(lds + (kb) * KBUF + (_i * 8 + wid) * 1024), 16, 0, 0); \
        vreg[0] = *(const u32x4*)(a.V + (size_t)(_r0 + 2 * vkp) * a.ldv + 8 * vdc); vreg[1] = *(const u32x4*)(a.V + (size_t)(_r0 + 2 * vkp + 1) * a.ldv + 8 * vdc); } while (0)
#define ATT_WRITE(vb) do { const ldsp_t _vb = lds + VOFF + (vb) * VBUF; \
        const unsigned _a0[4] = {vreg[0].x, vreg[0].y, vreg[0].z, vreg[0].w}, _a1[4] = {vreg[1].x, vreg[1].y, vreg[1].z, vreg[1].w}; \
        _Pragma("unroll") for (int _e = 0; _e < 4; ++_e) { \
            *(LAS unsigned*)(_vb + ((8 * vdc + 2 * _e) * VST + vpos) * 2) = (_a0[_e] & 0xffffu) | (_a1[_e] << 16); \
            *(LAS unsigned*)(_vb + ((8 * vdc + 2 * _e + 1) * VST + vpos) * 2) = (_a0[_e] >> 16) | (_a1[_e] & 0xffff0000u); } } while (0)
#define ATT_PV(vb) do { const ldsp_t _vt = lds + VOFF + (vb) * VBUF; \
        _Pragma("unroll") for (int db = 0; db < 4; ++db) _Pragma("unroll") for (int ks = 0; ks < 4; ++ks) { \
            const bf16x8 vf = *(const LAS bf16x8*)(_vt + ((32 * db + q32) * VST + 16 * ks + 8 * hi) * 2); \
            o[db] = __builtin_amdgcn_mfma_f32_32x32x16_bf16(pa[ks], vf, o[db], 0, 0, 0); } } while (0)
    bf16x8 pa[4];
#pragma unroll
    for (int i = 0; i < 4; ++i) pa[i] = (bf16x8){0, 0, 0, 0, 0, 0, 0, 0};
    int vprev = 2, vcur = 0, vnext = 1;
    { unsigned z0 = 0u; asm volatile("" : "+v"(z0));
      for (int i = tid; i < VBUF / 16; i += 512) *(LAS u32x4*)(lds + VOFF + 2 * VBUF + i * 16) = (u32x4){z0, z0, z0, z0}; }
    ATT_LOAD(0, 0);
    ATT_WRITE(0);
    asm volatile("s_waitcnt vmcnt(0)" ::: "memory");
    __syncthreads();
    for (int tt = 0; tt < ntiles; ++tt) {
        const int cur = tt & 1;
        if (tt + 1 < ntiles && PV_ != 4) ATT_LOAD(tt + 1, cur ^ 1);
        const ldsp_t Ks = lds + cur * KBUF;
        f32x16 s0, s1;
#pragma unroll
        for (int r = 0; r < 16; ++r) { s0[r] = 0.f; s1[r] = 0.f; }
        { bf16x8 kf[2][2];
#define ATT_LDK(p, sb) do { kf[p][0] = *(const LAS bf16x8*)(Ks + (q32 * KCH + ((2 * (sb) + hi) ^ (q32 & KM))) * 16); kf[p][1] = *(const LAS bf16x8*)(Ks + ((32 + q32) * KCH + ((2 * (sb) + hi) ^ (q32 & KM))) * 16); } while (0)
          if (PV_ != 2) {
          ATT_LDK(0, 0);
#pragma unroll
          for (int sb = 0; sb < ND; ++sb) {
              if (sb + 1 < ND) ATT_LDK((sb + 1) & 1, sb + 1);
              s0 = __builtin_amdgcn_mfma_f32_32x32x16_bf16(kf[sb & 1][0], qf[sb], s0, 0, 0, 0);
              s1 = __builtin_amdgcn_mfma_f32_32x32x16_bf16(kf[sb & 1][1], qf[sb], s1, 0, 0, 0);
              }
          }
#undef ATT_LDK
        }
        const bool msk = MASKED && a.mask_on && tt >= a.seg0_tiles;
        if (MASKED) { const int kp0 = a.kpos1 + 64 * (tt - a.seg0_tiles) + 4 * hi, qp = a.qpos0 + wid * 32 + q32;
#pragma unroll
            for (int r = 0; r < 16; ++r) { float t0 = s0[r], t1 = s1[r];
                if (msk) { const int d0 = qp - (kp0 + (r & 3) + 8 * (r >> 2)), d1 = d0 - 32; if (d0 > 128 || d0 < -128) t0 = -1e30f; if (d1 > 128 || d1 < -128) t1 = -1e30f; s0[r] = t0; s1[r] = t1; } }
            __builtin_amdgcn_sched_barrier(0); }
        float mx = -1e30f, m_new = 0.f, alpha = 1.f, ps = 0.f;
        bf16x8 pn[4] = {pa[0], pa[1], pa[2], pa[3]};
        { const ldsp_t _vt = lds + VOFF + vprev * VBUF; bf16x8 vfr[3]; vfr[2] = pa[0];
#define ATT_LDV(i) (*(const LAS bf16x8*)(_vt + ((32 * ((i) >> 2) + q32) * VST + 16 * ((i) & 3) + 8 * hi) * 2))
#define SCV(e) ((e) < 16 ? s0[(e) & 15] : s1[(e) & 15])
          vfr[0] = ATT_LDV(0); vfr[1] = ATT_LDV(1);
#pragma unroll
          for (int i = 0; i < 16; ++i) {
              if (PV_ != 3) { if (i + 2 < 16) vfr[(i + 2) % 3] = ATT_LDV(i + 2);
              o[i >> 2] = __builtin_amdgcn_mfma_f32_32x32x16_bf16(pa[i & 3], vfr[i % 3], o[i >> 2], 0, 0, 0); }
              if (PV_ == 1) {} else if (i < 4) {
#pragma unroll
                  for (int e = 0; e < 4; ++e) mx = fmaxf(mx, fmaxf(s0[4 * i + e], s1[4 * i + e]));
              } else if (i == 4) {
                  mx = fmaxf(mx, shx(mx, 32, lane)); m_new = fmaxf(m_run, mx); alpha = __builtin_amdgcn_exp2f(m_run - m_new); m_run = m_new;
              } else if (i < 13) {
#pragma unroll
                  for (int e = 0; e < 2; ++e) { const int r = 2 * (i - 5) + e; s0[r] = __builtin_amdgcn_exp2f(s0[r] - m_new); s1[r] = __builtin_amdgcn_exp2f(s1[r] - m_new); ps += s0[r] + s1[r]; }
              } else if (i == 13) {
                  u32x4 w; w.x = cvt_pk_bf16(s0[0], s0[1]); w.y = cvt_pk_bf16(s0[2], s0[3]); w.z = cvt_pk_bf16(s0[4], s0[5]); w.w = cvt_pk_bf16(s0[6], s0[7]); pn[0] = *(bf16x8*)&w;
                  u32x4 v; v.x = cvt_pk_bf16(s0[8], s0[9]); v.y = cvt_pk_bf16(s0[10], s0[11]); v.z = cvt_pk_bf16(s0[12], s0[13]); v.w = cvt_pk_bf16(s0[14], s0[15]); pn[1] = *(bf16x8*)&v;
              } else if (i == 14) {
                  u32x4 w; w.x = cvt_pk_bf16(s1[0], s1[1]); w.y = cvt_pk_bf16(s1[2], s1[3]); w.z = cvt_pk_bf16(s1[4], s1[5]); w.w = cvt_pk_bf16(s1[6], s1[7]); pn[2] = *(bf16x8*)&w;
                  u32x4 v; v.x = cvt_pk_bf16(s1[8], s1[9]); v.y = cvt_pk_bf16(s1[10], s1[11]); v.z = cvt_pk_bf16(s1[12], s1[13]); v.w = cvt_pk_bf16(s1[14], s1[15]); pn[3] = *(bf16x8*)&v;
              } else { l_run = l_run * alpha + ps; }
          }
#undef ATT_LDV
#undef SCV
        }
#pragma unroll
        for (int i = 0; i < 4; ++i) pa[i] = pn[i];
        if (__any(alpha < 1.0f)) {
            if (hi == 0) al[q32] = alpha;
            asm volatile("s_waitcnt lgkmcnt(0)" ::: "memory");
#pragma unroll
            for (int g4 = 0; g4 < 4; ++g4) { const f32x4 av = *(const LAS f32x4*)(al + 8 * g4 + 4 * hi);
#pragma unroll
                for (int db = 0; db < 4; ++db)
#pragma unroll
                    for (int j = 0; j < 4; ++j) o[db][4 * g4 + j] *= av[j]; }
        }
        if (tt + 1 < ntiles && PV_ != 4) ATT_WRITE(vnext);
        { const int t3 = vprev; vprev = vcur; vcur = vnext; vnext = t3; }
        asm volatile("s_waitcnt vmcnt(0)" ::: "memory");
        if (PV_ != 5) __syncthreads();
    }
    ATT_PV(vprev);
#undef ATT_LOAD
#undef ATT_WRITE
#undef ATT_PV
    __syncthreads();
    float l_tot = l_run + shx(l_run, 32, lane);
    if (a.has_sink) l_tot += __builtin_amdgcn_exp2f(a.sink_l2 - m_run);
    if (hi == 0) al[q32] = 1.0f / l_tot;
    asm volatile("s_waitcnt lgkmcnt(0)" ::: "memory");
    const ldsp_t Ost = lds + wid * 8192;
#pragma unroll
    for (int g4 = 0; g4 < 4; ++g4) { const f32x4 iv = *(const LAS f32x4*)(al + 8 * g4 + 4 * hi);
#pragma unroll
        for (int db = 0; db < 4; ++db)
#pragma unroll
            for (int j = 0; j < 4; ++j) *(LAS bf16_t*)(Ost + ((8 * g4 + 4 * hi + j) * 128 + 32 * db + q32) * 2) = f2bf(o[db][4 * g4 + j] * iv[j]); }
    asm volatile("s_waitcnt lgkmcnt(0)" ::: "memory");
    const int lane_o = lane_id();
#pragma unroll
    for (int i = 0; i < 8; ++i) { const int c = lane_o + 64 * i, row = c >> 4, c8 = c & 15;
        *(u32x4*)(a.O + (size_t)(wid * 32 + row) * a.ldo + 8 * c8) = *(const LAS u32x4*)(Ost + (row * 128 + 8 * c8) * 2); }
}

__device__ __forceinline__ void conv_unit(const Ctx& F, int layer, int row0  , int seq_len, int t0) {
    using namespace cf;
    const bf16_t* P = WSP(const bf16_t, WS_P); bf16_t* BR = WSP(bf16_t, WS_BR);
    const float* cw = F.in[I_CW] + (size_t)layer * 31 * 1024; const float* cb = F.in[I_CB] + layer * 1024;
    const float* lg = F.in[I_CLG] + layer * 1024; const float* lb = F.in[I_CLB] + layer * 1024;
    int tid = F.wave * 64 + lane_id(); asm volatile("" : "+v"(tid));
    const int lane = tid & 63;
    LAS float* red = (LAS float*)(F.lds + 126976); LAS float* tot = red + 8 * 32;
    __syncthreads();
    for (int c = tid; c < 62 * 128; c += 512) { const int rr = c >> 7, ch = c & 127, t = t0 - 15 + rr;
        u32x4 v = {0u, 0u, 0u, 0u};
        if (t >= 0 && t < seq_len) v = *(const u32x4*)(P + (size_t)(row0 + t) * NC + PC_GLU + ch * 8);
        *(LAS u32x4*)(F.lds + rr * 2048 + ch * 16) = v; }
    float w0[31], w1[31];
#pragma unroll
    for (int k = 0; k < 31; ++k) { const f32x2 w = *(const f32x2*)(cw + k * 1024 + 2 * tid); w0[k] = w.x; w1[k] = w.y; }
    const f32x2 bv = *(const f32x2*)(cb + 2 * tid), gg = *(const f32x2*)(lg + 2 * tid), bb = *(const f32x2*)(lb + 2 * tid);
    __syncthreads();
#pragma unroll 1
    for (int part = 0; part < 4; ++part) {
        float a0[8], a1[8];
#pragma unroll
        for (int t = 0; t < 8; ++t) { a0[t] = bv.x; a1[t] = bv.y; }
        const ldsp_t base = F.lds + part * 8 * 2048 + tid * 4;
#pragma unroll
        for (int rr = 0; rr < 38; ++rr) { const unsigned xw = *(const LAS unsigned*)(base + rr * 2048); const float x0 = bflo(xw), x1 = bfhi(xw);
#pragma unroll
            for (int t = 0; t < 8; ++t) { const int k = rr - t; if (k >= 0 && k <= 30) { a0[t] += x0 * w0[k]; a1[t] += x1 * w1[k]; } } }
        float v[16];
#pragma unroll
        for (int t = 0; t < 8; ++t) { v[t] = a0[t] + a1[t]; v[8 + t] = a0[t] * a0[t] + a1[t] * a1[t]; }
#pragma unroll
        for (int i = 0; i < 8; ++i) { const bool up = lane & 32; const float snd = up ? v[i] : v[i + 8], kp = up ? v[i + 8] : v[i]; v[i] = kp + shx(snd, 32, lane); }
#pragma unroll
        for (int i = 0; i < 4; ++i) { const bool up = lane & 16; const float snd = up ? v[i] : v[i + 4], kp = up ? v[i + 4] : v[i]; v[i] = kp + shx(snd, 16, lane); }
#pragma unroll
        for (int i = 0; i < 2; ++i) { const bool up = lane & 8; const float snd = up ? v[i] : v[i + 2], kp = up ? v[i + 2] : v[i]; v[i] = kp + shx(snd, 8, lane); }
        { const bool up = lane & 4; const float snd = up ? v[0] : v[1], kp = up ? v[1] : v[0]; v[0] = kp + shx(snd, 4, lane); }
        v[0] += shx(v[0], 2, lane); v[0] += shx(v[0], 1, lane);
        if ((lane & 3) == 0) red[F.wave * 16 + (lane >> 2)] = v[0];
        __syncthreads();
        if (tid < 16) { float s = 0.f;
#pragma unroll
            for (int w = 0; w < 8; ++w) s += red[w * 16 + tid];
            tot[tid] = s; }
        __syncthreads();
#pragma unroll
        for (int t = 0; t < 8; ++t) { const float mean = tot[t] * (1.f / 1024.f), var = fmaxf(tot[8 + t] * (1.f / 1024.f) - mean * mean, 0.f), rstd = rsqrtf(var + 1e-5f);
            const float y0 = (a0[t] - mean) * rstd * gg.x + bb.x, y1 = (a1[t] - mean) * rstd * gg.y + bb.y;
            *(unsigned*)(BR + (size_t)(row0 + t0 + part * 8 + t) * 4096 + 2048 + 2 * tid) = cvt_pk_bf16(y0 * sigmoidf_(y0), y1 * sigmoidf_(y1)); }
    }
}

__device__ __forceinline__ void attn_defaults(AttnArgs& a, int isctx) {
    a.seg0_row = 0; a.seg0_tiles = isctx ? 4 : 68; a.seg1_row = 0; a.seg1_tiles = 0; a.mask_on = 0; a.qpos0 = 0; a.kpos1 = 0; a.has_sink = 0; a.sink_l2 = 0.f; a.qss = nullptr; a.variant = 0; }
__device__ __forceinline__ void ph_attn(const Ctx& F0, int layer) {
    const Ctx F = phase_ctx(F0);
    using namespace cf;
    const bf16_t* P = WSP(const bf16_t, WS_P); bf16_t* BR = WSP(bf16_t, WS_BR);
    for (int dup = 0; dup < DUPN(2); ++dup)
    for (int u = F.bid; u < (layer == 0 ? 544 : 512); u += F.G) {
        int b, h, qb, isctx = 0;
        if (u < 512) { b = u >> 7; h = (u >> 4) & 7; qb = u & 15; } else { const int r = u - 512; b = r >> 3; h = r & 7; qb = 0; isctx = 1; }
        const size_t brow = (size_t)b * RB, qrow = brow + (isctx ? 0 : CTX) + (size_t)qb * 256;
        AttnArgs a; attn_defaults(a, isctx);
        a.Q = WSP(const bf16_t, WS_QB) + qrow * 1536 + h * 192; a.ldq = 1536;
        a.K = WSP(const bf16_t, WS_KB) + brow * 1536 + h * 192; a.ldk = 1536;
        a.V = WSP(const bf16_t, WS_VB) + brow * 1024 + h * 128; a.ldv = 1024;
        a.O = BR + qrow * 4096 + 1024 + h * 128; a.ldo = 4096; a.sc_log2 = SCALE_MLA * LOG2E;
        __syncthreads();
        attn_unit<192, false>(F.lds, a, F.wave);
    }
    for (int dup = 0; dup < DUPN(3); ++dup)
    for (int u0 = F.bid; u0 < (layer == 0 ? 544 : 512); u0 += F.G) {
        int b, h, qb, isctx = 0;
        if (u0 < 512) { b = u0 >> 7; h = (u0 >> 4) & 7; qb = u0 & 15; } else { const int r = u0 - 512; b = r >> 3; h = r & 7; qb = 0; isctx = 1; }
        const size_t brow = (size_t)b * RB, qrow = brow + (isctx ? 0 : CTX) + (size_t)qb * 256;
        AttnArgs a; attn_defaults(a, isctx);
        a.Q = P + qrow * NC + PC_AQ + h * 128; a.ldq = NC;
        a.K = P + brow * NC + PC_AK + (h >> 2) * 128; a.ldk = NC;
        a.V = P + brow * NC + PC_AV + (h >> 2) * 128; a.ldv = NC;
        a.O = BR + qrow * 4096 + h * 128; a.ldo = 4096; a.sc_log2 = SCALE_HD * LOG2E;
        a.qss = WSP(const float, WS_SSQ) + qrow * 16 + h * 2;
        if (MK_AV && dup == 1) { a.variant = MK_AV; a.O = WSP(bf16_t, WS_HB) + qrow * 2048 + h * 128; a.ldo = 2048; }
        __syncthreads();
        attn_unit<128, false>(F.lds, a, F.wave);
    }
    for (int dup = 0; dup < DUPN(13); ++dup)
    for (int u0 = F.bid; u0 < (layer == 0 ? 544 : 512); u0 += F.G) {
        int b, h, qb, isctx = 0;
        if (u0 < 512) { b = u0 >> 7; h = (u0 >> 4) & 7; qb = u0 & 15; } else { const int r = u0 - 512; b = r >> 3; h = r & 7; qb = 0; isctx = 1; }
        const size_t brow = (size_t)b * RB, qrow = brow + (isctx ? 0 : CTX) + (size_t)qb * 256;
        AttnArgs a; attn_defaults(a, isctx);
        a.Q = P + qrow * NC + PC_DQ + h * 128; a.ldq = NC;
        a.K = P + brow * NC + PC_DK + (h >> 2) * 128; a.ldk = NC;
        a.V = P + brow * NC + PC_DV + (h >> 2) * 128; a.ldv = NC;
        a.O = BR + qrow * 4096 + 3072 + h * 128; a.ldo = 4096; a.sc_log2 = SCALE_HD * LOG2E;
        a.has_sink = 1; a.sink_l2 = F.in[I_SINK][layer * 8 + h] * LOG2E; a.seg0_tiles = 4;
        if (!isctx) { const int start = qb * 256; const int lo = start - 128 < 0 ? 0 : start - 128, hi = start + 384 > S ? S : start + 384;
            a.seg1_row = CTX + lo; a.seg1_tiles = (hi - lo) / 64; a.mask_on = 1; a.qpos0 = start; a.kpos1 = lo; }
        __syncthreads();
        attn_unit<128, true>(F.lds, a, F.wave);
    }
    for (int dup = 0; dup < DUPN(4); ++dup)
    for (int u = F.bid; u < (layer == 0 ? 544 : 512); u += F.G) {
        int b, tb, isctx = 0;
        if (u < 512) { b = u >> 7; tb = u & 127; } else { const int r = u - 512; b = r >> 3; tb = r & 7; isctx = 1; }
        conv_unit(F, layer, b * RB + (isctx ? 0 : CTX), isctx ? CTX : S, tb * 32);
    }
}

__device__ __forceinline__ int tok_row(int layer, int tok) { return layer == 0 ? tok : (tok >> 12) * cf::RB + cf::CTX + (tok & 4095); }
__device__ __forceinline__ void ph_ln1(const Ctx& F0, int layer) {
    const Ctx F = phase_ctx(F0);
    using namespace cf;
    float* X1 = (float*)(F.ws + WS_P + X1_OFF); bf16_t* HB = WSP(bf16_t, WS_HB);
    const float* lg = F.in[I_LN1G] + layer * 2048; const float* lb = F.in[I_LN1B] + layer * 2048;
    const int ntok = layer == 0 ? MR : NB * S, lane = F.lane;
    for (int tok = F.bid * 8 + F.wave; tok < ntok; tok += F.G * 8) {
        const int R = tok_row(layer, tok), b = R / RB, j = R % RB;
        const float* mod = WSP(const float, WS_MOD) + ((size_t)layer * 5 + (j < CTX ? 4 : b)) * 12288;
        float* xp = X1 + (size_t)R * 2048;
        f32x4 v[8]; float s = 0.f;
#pragma unroll
        for (int i = 0; i < 8; ++i) { v[i] = *(const f32x4*)(xp + lane * 4 + 256 * i); s += (v[i][0] + v[i][1]) + (v[i][2] + v[i][3]); }
        const float mean = wave_sum(s, lane) * (1.f / 2048.f); float q = 0.f;
#pragma unroll
        for (int i = 0; i < 8; ++i) { const f32x4 d = v[i] - mean; q += (d[0] * d[0] + d[1] * d[1]) + (d[2] * d[2] + d[3] * d[3]); }
        const float rstd = rsqrtf(wave_sum(q, lane) * (1.f / 2048.f) + 1e-5f);
#pragma unroll
        for (int i = 0; i < 8; ++i) { const int c = lane * 4 + 256 * i;
            const f32x4 y = (v[i] - mean) * rstd * *(const f32x4*)(lg + c) + *(const f32x4*)(lb + c);
            *(f32x4*)(xp + c) = y;
            const f32x4 hp = y * (*(const f32x4*)(mod + 4 * 2048 + c) + 1.0f) + *(const f32x4*)(mod + 3 * 2048 + c);
            u32x2 w; w.x = cvt_pk_bf16(hp[0], hp[1]); w.y = cvt_pk_bf16(hp[2], hp[3]);
            *(u32x2*)(HB + (size_t)R * 2048 + c) = w; }
    }
}

typedef __bf16 bf16x2_t __attribute__((ext_vector_type(2)));
__device__ __forceinline__ unsigned ordkey(float v) { const unsigned u = __float_as_uint(v); return (u & 0x80000000u) ? ~u : (u | 0x80000000u); }
__device__ __forceinline__ int lane_rank(unsigned long long m) { return (int)__builtin_amdgcn_mbcnt_hi((unsigned)(m >> 32), __builtin_amdgcn_mbcnt_lo((unsigned)m, 0u)); }
template <int NV> __device__ __forceinline__ unsigned radix_thresh16(const unsigned (&k)[NV]) {
    unsigned T = 0u;
    for (int bit = 31; bit >= 0; --bit) { const unsigned cand = T | (1u << bit); int cnt = 0;
#pragma unroll
        for (int v = 0; v < NV; ++v) cnt += __popcll(__ballot(k[v] >= cand));
        if (cnt >= 16) { T = cand; if (cnt == 16) break; } }
    return T;
}
__device__ __forceinline__ void radix_thresh16x2(const unsigned (&ka)[2], const unsigned (&kb)[2], unsigned& Ta, unsigned& Tb) {
    unsigned T0 = 0u, T1 = 0u; bool d0 = false, d1 = false;
    for (int bit = 31; bit >= 0; --bit) { const unsigned c0 = T0 | (1u << bit), c1 = T1 | (1u << bit);
        const int n0 = __popcll(__ballot(ka[0] >= c0)) + __popcll(__ballot(ka[1] >= c0)), n1 = __popcll(__ballot(kb[0] >= c1)) + __popcll(__ballot(kb[1] >= c1));
        if (!d0 && n0 >= 16) { T0 = c0; d0 = n0 == 16; }
        if (!d1 && n1 >= 16) { T1 = c1; d1 = n1 == 16; }
        if (d0 && d1) break; }
    Ta = T0; Tb = T1;
}
__device__ __forceinline__ float dot2bf(unsigned a, unsigned b, float acc) { return __builtin_amdgcn_fdot2_f32_bf16(__builtin_bit_cast(bf16x2_t, a), __builtin_bit_cast(bf16x2_t, b), acc, false); }
__device__ __forceinline__ float dot8(const u32x4 a, const u32x4 b, float acc) {
    acc = dot2bf(a.x, b.x, acc); acc = dot2bf(a.y, b.y, acc); acc = dot2bf(a.z, b.z, acc); acc = dot2bf(a.w, b.w, acc);
    return acc;
}
__device__ __forceinline__ float gelu_as(float v) {
    const float av = fabsf(v), t = __builtin_amdgcn_rcpf(av * 0.2316418882f + 1.0f);
    float q = t * 0.5307027145f + (-0.7265760135f); q = q * t + 0.7107068705f; q = q * t + (-0.142248368f); q = q * t + 0.127414796f; q = q * t;
    const float e = __builtin_amdgcn_exp2f((v * v) * (-0.72134752044f)), m = v * (q * e);
    return v < 0.f ? m : v - m;
}
__device__ __forceinline__ void peer_load(u32x4 (&ur)[4][2], u32x4 (&vr)[4], unsigned (&vs)[4], float (&gq)[4], const LAS int* ei, const LAS float* eg,
                                          const unsigned char* U8, const unsigned char* V4, int lane, int grp) {
#pragma unroll
    for (int q = 0; q < 4; ++q) { const int id = __builtin_amdgcn_readfirstlane(ei[grp * 4 + q]); gq[q] = __uint_as_float(__builtin_amdgcn_readfirstlane(__float_as_uint(eg[grp * 4 + q])));
        ur[q][0] = *(const u32x4*)(U8 + (size_t)id * 2048 + lane * 16); ur[q][1] = *(const u32x4*)(U8 + (size_t)id * 2048 + lane * 16 + 1024);
        vr[q] = *(const u32x4*)(V4 + (size_t)id * V4_ROW + lane * 16); vs[q] = V4[(size_t)id * V4_ROW + 1024 + lane]; }
}
__device__ __forceinline__ void peer_comp(const u32x4 (&ur)[4][2], const u32x4 (&vr)[4], const unsigned (&vs)[4], const float (&gq)[4], const f32x2 (&xf)[16], f32x2 (&y2)[16], int lane) {
    float d[4];
#pragma unroll
    for (int q = 0; q < 4; ++q) { f32x2 t = {0.f, 0.f};
#pragma unroll
        for (int i = 0; i < 2; ++i)
#pragma unroll
            for (int j = 0; j < 4; ++j) { const int w = (int)ur[q][i][j];
                t += __builtin_amdgcn_cvt_pk_f32_fp8(w, false) * xf[8 * i + 2 * j]; t += __builtin_amdgcn_cvt_pk_f32_fp8(w, true) * xf[8 * i + 2 * j + 1]; }
        d[q] = t.x + t.y; }
#pragma unroll
    for (int o = 32; o >= 1; o >>= 1) {
#pragma unroll
        for (int q = 0; q < 4; ++q) d[q] += shx(d[q], o, lane); }
#pragma unroll
    for (int q = 0; q < 4; ++q) { const float dd = d[q] * (1.0f / 1024.0f); const float w = gq[q] * gelu_as(dd) * __uint_as_float(vs[q] << 23);
        const f32x2 w2 = {w, w};
#pragma unroll
        for (int j = 0; j < 4; ++j) { const unsigned vw = vr[q][j];
            y2[4 * j + 0] += w2 * __builtin_amdgcn_cvt_scalef32_pk_f32_fp4(vw, 1.0f, 0); y2[4 * j + 1] += w2 * __builtin_amdgcn_cvt_scalef32_pk_f32_fp4(vw, 1.0f, 1);
            y2[4 * j + 2] += w2 * __builtin_amdgcn_cvt_scalef32_pk_f32_fp4(vw, 1.0f, 2); y2[4 * j + 3] += w2 * __builtin_amdgcn_cvt_scalef32_pk_f32_fp4(vw, 1.0f, 3); } }
}
__device__ __forceinline__ unsigned inv_ordkey(unsigned k) { return (k & 0x80000000u) ? (k & 0x7fffffffu) : ~k; }
template <int N, int GRP> __device__ __forceinline__ unsigned lane_radix16(const unsigned (&key)[N], int lane) {
    unsigned T = 0u; bool done = false;
    for (int bit = 31; bit >= 0; --bit) { const unsigned cand = T | (1u << bit); int cnt = 0;
#pragma unroll
        for (int n = 0; n < N; ++n) cnt += key[n] >= cand ? 1 : 0;
        if (GRP >= 2) cnt += __builtin_amdgcn_ds_bpermute((lane ^ 1) << 2, cnt);
        if (GRP >= 4) cnt += __builtin_amdgcn_ds_bpermute((lane ^ 2) << 2, cnt);
        if (!done && cnt >= 16) { T = cand; done = cnt == 16; }
        if (__all(done)) break; }
    return T;
}
__device__ __forceinline__ void ph_peer(const Ctx& F0, int layer) {
    const Ctx F = phase_ctx(F0);
    using namespace cf;
    const float* SC = (const float*)(F.ws + WS_P + SC_OFF); const float* X1 = (const float*)(F.ws + WS_P + X1_OFF);
    bf16_t* HB = WSP(bf16_t, WS_HB); const unsigned char* U8 = WSP(const unsigned char, WS_UB) + (size_t)layer * NEXP * 2048; const unsigned char* V4 = WSP(const unsigned char, WS_VB2) + (size_t)layer * NEXP * V4_ROW;
    const float* lg = F.in[I_LN2G] + layer * 2048; const float* lb = F.in[I_LN2B] + layer * 2048;
    const int ntok = layer == 0 ? MR : NB * S;
    ldsp_t wl = F.lds + F.wave * 8192;
    LAS float* lstv = (LAS float*)wl; LAS int* lsti = (LAS int*)(wl + 2176);
    LAS float* es4 = (LAS float*)(wl + 4352); LAS int* ei4 = (LAS int*)(wl + 5376); LAS float* eg4 = (LAS float*)(wl + 6400);
    const int nwv = F.G * 8;
    for (int tok0 = F.bid * 8 + F.wave; tok0 < ntok; tok0 += 2 * nwv) {
        { int lane = F.lane; asm volatile("" : "+v"(lane));
          const int t2 = lane >> 5, set = lane >> 1, sset = set & 15, part = lane & 1;
          int tokl = tok0 + t2 * nwv; if (tokl >= ntok) tokl = tok0;
          const int Rl = tok_row(layer, tokl);
          unsigned key[64];
          const float* sp = SC + (size_t)Rl * 2048 + sset * 128 + part * 64;
#pragma unroll
          for (int i = 0; i < 16; ++i) { const f32x4 v = *(const f32x4*)(sp + 4 * i);
#pragma unroll
              for (int e = 0; e < 4; ++e) key[4 * i + e] = (ordkey(v[e]) & ~127u) | (unsigned)(127 - (64 * part + 4 * i + e)); }
          const unsigned T = lane_radix16<64, 2>(key, lane);
          int c = 0;
#pragma unroll
          for (int n = 0; n < 64; ++n) { if (key[n] >= T) { const int r = set * 17 + (part ? 15 - c : c); lstv[r] = __uint_as_float(inv_ordkey((key[n] & ~127u) | 64u)); lsti[r] = 64 * part + n; ++c; }
              if ((n & 15) == 15) __builtin_amdgcn_sched_barrier(0); }
        }
        asm volatile("s_waitcnt lgkmcnt(0)" ::: "memory");
        {
          int lane = F.lane; asm volatile("" : "+v"(lane));
          const int t2 = lane >> 5, hq = (lane >> 2) & 7, q = lane & 3, sa = (lane >> 2) * 2, sb = sa + 1;
          float Av[4], Bv[16]; int Ai[4], Bi[16];
#pragma unroll
          for (int i = 0; i < 4; ++i) { Av[i] = lstv[sa * 17 + 4 * q + i]; Ai[i] = lsti[sa * 17 + 4 * q + i]; }
#pragma unroll
          for (int jx = 0; jx < 16; ++jx) { Bv[jx] = lstv[sb * 17 + jx]; Bi[jx] = lsti[sb * 17 + jx]; }
          unsigned key[64];
#pragma unroll
          for (int i = 0; i < 4; ++i)
#pragma unroll
              for (int jx = 0; jx < 16; ++jx) key[i * 16 + jx] = (ordkey(Av[i] + Bv[jx]) & ~255u) | (unsigned)(255 - ((4 * q + i) * 16 + jx));
          const unsigned T = lane_radix16<64, 4>(key, lane);
          int mine = 0;
#pragma unroll
          for (int n = 0; n < 64; ++n) mine += key[n] >= T ? 1 : 0;
          const int c1 = __builtin_amdgcn_ds_bpermute((lane ^ 1) << 2, mine), c2 = __builtin_amdgcn_ds_bpermute((lane ^ 2) << 2, mine), c3 = __builtin_amdgcn_ds_bpermute((lane ^ 3) << 2, mine);
          int c = (q == 1) ? c1 : (q == 2) ? c2 + c3 : (q == 3) ? c1 + c2 + c3 : 0;
#pragma unroll
          for (int i = 0; i < 4; ++i) {
#pragma unroll
              for (int jx = 0; jx < 16; ++jx) if (key[i * 16 + jx] >= T) { const int r = t2 * 128 + hq * 16 + c; es4[r] = Av[i] + Bv[jx]; ei4[r] = Ai[i] * 128 + Bi[jx]; ++c; }
              __builtin_amdgcn_sched_barrier(0); }
        }
        asm volatile("s_waitcnt lgkmcnt(0)" ::: "memory");
        { int lane = F.lane; asm volatile("" : "+v"(lane));
#pragma unroll
        for (int rnd = 0; rnd < 4; ++rnd) { const int e = lane + 64 * rnd; const float s = es4[e];
            float m = s; m = fmaxf(m, shx(m, 1, lane)); m = fmaxf(m, shx(m, 2, lane)); m = fmaxf(m, shx(m, 4, lane)); m = fmaxf(m, shx(m, 8, lane));
            const float ex = __expf(s - m); float sum = ex; sum += shx(sum, 1, lane); sum += shx(sum, 2, lane); sum += shx(sum, 4, lane); sum += shx(sum, 8, lane);
            eg4[e] = ex / sum; } }
        asm volatile("s_waitcnt lgkmcnt(0)" ::: "memory");
      for (int tslot = 0; tslot < 2; ++tslot) {
        const int tok = tok0 + tslot * nwv; if (tok >= ntok) break;
        int lane = F.lane; asm volatile("" : "+v"(lane));
        const int R = tok_row(layer, tok), b = R / RB, j = R % RB; const bool isctx = j < CTX; const int modrow = isctx ? 4 : b;
        const LAS int* ei = ei4 + tslot * 128; const LAS float* eg = eg4 + tslot * 128;
        f32x2 xf[16];
#pragma unroll
        for (int i = 0; i < 2; ++i)
#pragma unroll
            for (int hh = 0; hh < 2; ++hh) { const u32x4 w = *(const u32x4*)(HB + (size_t)R * 2048 + lane * 16 + 1024 * i + 8 * hh);
                xf[8 * i + 4 * hh + 0] = (f32x2){bflo(w.x), bfhi(w.x)}; xf[8 * i + 4 * hh + 1] = (f32x2){bflo(w.y), bfhi(w.y)};
                xf[8 * i + 4 * hh + 2] = (f32x2){bflo(w.z), bfhi(w.z)}; xf[8 * i + 4 * hh + 3] = (f32x2){bflo(w.w), bfhi(w.w)}; }
        f32x2 y2[16];
#pragma unroll
        for (int i = 0; i < 16; ++i) y2[i] = (f32x2){0.f, 0.f};
        f32x4 xrow[8];
#pragma unroll
        for (int k = 0; k < 8; ++k) xrow[k] = *(const f32x4*)(X1 + (size_t)R * 2048 + lane * 32 + 4 * k);
        { u32x4 urA[4][2], vrA[4], urB[4][2], vrB[4]; unsigned vsA[4], vsB[4]; float gqA[4], gqB[4];
          peer_load(urA, vrA, vsA, gqA, ei, eg, U8, V4, lane, 0);
          for (int grp = 0; grp < 32; grp += 2) {
              peer_load(urB, vrB, vsB, gqB, ei, eg, U8, V4, lane, grp + 1);
              peer_comp(urA, vrA, vsA, gqA, xf, y2, lane);
              peer_load(urA, vrA, vsA, gqA, ei, eg, U8, V4, lane, grp + 2 < 32 ? grp + 2 : 31);
              peer_comp(urB, vrB, vsB, gqB, xf, y2, lane);
          } }
        const float* mod = WSP(const float, WS_MOD) + ((size_t)layer * 5 + modrow) * 12288;
        float y[32];
        float s = 0.f;
#pragma unroll
        for (int k = 0; k < 8; ++k) { const int c = lane * 32 + 4 * k;
            const f32x4 xa = xrow[k], ga = *(const f32x4*)(mod + 5 * 2048 + c);
            y[4 * k + 0] = ALPHA * xa[0] + ga[0] * y2[2 * k].x; y[4 * k + 1] = ALPHA * xa[1] + ga[1] * y2[2 * k].y;
            y[4 * k + 2] = ALPHA * xa[2] + ga[2] * y2[2 * k + 1].x; y[4 * k + 3] = ALPHA * xa[3] + ga[3] * y2[2 * k + 1].y;
            s += (y[4 * k + 0] + y[4 * k + 1]) + (y[4 * k + 2] + y[4 * k + 3]); }
        const float mean = wave_sum(s, lane) * (1.f / 2048.f); float q2 = 0.f;
#pragma unroll
        for (int i = 0; i < 32; ++i) { const float dd = y[i] - mean; q2 += dd * dd; }
        const float rstd = rsqrtf(wave_sum(q2, lane) * (1.f / 2048.f) + 1e-5f);
        float* dst = layer == 0 ? (isctx ? WSP(float, WS_XC) + ((size_t)b * CTX + j) * 2048 : F.out + ((size_t)b * S + (j - CTX)) * 2048) : F.out + ((size_t)b * S + (j - CTX)) * 2048;
        const float* modn = WSP(const float, WS_MOD) + ((size_t)1 * 5 + modrow) * 12288;
#pragma unroll
        for (int kk = 0; kk < 4; ++kk) { f32x4 o[2];
#pragma unroll
            for (int jj = 0; jj < 2; ++jj) { const int k = 2 * kk + jj, c = lane * 32 + 4 * k; const f32x4 la = *(const f32x4*)(lg + c), ba = *(const f32x4*)(lb + c);
#pragma unroll
                for (int e = 0; e < 4; ++e) o[jj][e] = (y[4 * k + e] - mean) * rstd * la[e] + ba[e];
                *(f32x4*)(dst + c) = o[jj]; }
            if (layer == 0) {
                const int c = lane * 32 + 8 * kk;
                const f32x4 sa = *(const f32x4*)(modn + 2048 + c), sb = *(const f32x4*)(modn + 2048 + c + 4), ha = *(const f32x4*)(modn + c), hb = *(const f32x4*)(modn + c + 4);
                *(u32x4*)(HB + (size_t)R * 2048 + c) = pg8::pack8(o[0] * (sa + 1.0f) + ha, o[1] * (sb + 1.0f) + hb); } }
      }
    }
}

struct Params { const float* in[cf::N_IN]; float* out; unsigned char* ws; int ph_lo, ph_hi; };

__global__ void __launch_bounds__(512, 2) mega_fwd(Params p) {
    using namespace cf;
    extern __shared__ __attribute__((aligned(16))) unsigned char smem[];
    Ctx F0;
    F0.in = p.in;
    F0.out = p.out; F0.ws = p.ws; F0.lds = (ldsp_t)smem;
    F0.tid = 0; F0.lane = 0; F0.wave = __builtin_amdgcn_readfirstlane(threadIdx.x >> 6); F0.G = gridDim.x; F0.bid = blockIdx.x;
    if (threadIdx.x < 64) ((LAS unsigned*)(F0.lds + MISC_OFF))[threadIdx.x] = 0u;
    __syncthreads();
    const int lo = p.ph_lo, hi = p.ph_hi;
    XcdBarrier bar; bar.bar = (unsigned*)(F0.ws + WS_CTL); bar.x = 0; bar.st = (volatile LAS unsigned*)(F0.lds + MISC_OFF); bar.wave = F0.wave;
    if (hi - lo > 1) bar = xcd_barrier_post((unsigned*)(F0.ws + WS_CTL), (volatile LAS unsigned*)(F0.lds + MISC_OFF), F0.wave);
#ifndef MK_MASK
#define MK_MASK 0xFFFF
#endif
#define ON(j) ((MK_MASK >> (j)) & 1)
#define IN(k) (lo <= (k) && (k) < hi)
#define SEAM(k) do { if (IN(k) && IN((k) + 1)) xcd_barrier(bar); } while (0)

    if (ON(9) && IN(0)) { ph_prologue(F0); if (DUPN(9) == 2) { __syncthreads(); ph_prologue(F0); } }
    SEAM(0);
    if (ON(10) && IN(1)) ph_modulate0(F0);
    SEAM(1);
    for (int l = 0; l < DEPTH; ++l) {
        const int pb = 2 + 8 * l;
        const int rmode = l == 0 ? 0 : 1, nMl = l == 0 ? 68 : 64;
        for (int blk = 0; blk < DUPN(12); ++blk) {
        if (blk) xcd_barrier(bar);
        if (ON(0) && IN(pb + 0)) { const Ctx F = phase_ctx(F0);
            pg8::Gemm g{WSP(const bf16_t, WS_HB), WSP(const bf16_t, WS_WIN) + (size_t)l * NC * 2048, 2048, 2048};
            pg8::EpiInProj E{WSP(bf16_t, WS_P), WSP(bf16_t, WS_KB), WSP(const float, WS_COSH), WSP(const float, WS_SINH), WSP(const float, WS_COSR), WSP(const float, WS_SINR),
                             F.in[I_AKN] + l * 128, F.in[I_AQN] + l * 128, WSP(float, WS_SSK), WSP(float, WS_SSQ), WSP(float, WS_SSKV), WSP(float, WS_SSCQ)};
            pg8::TileOrder S; S.init(nMl, 56, F.G, F.bid, rmode);
            for (int dup = 0; dup < DUPN(0); ++dup)
            pg8::gemm_phase(F.lds, g, S, E, F.wave);
            if (l > 0) { pg8::TileOrder S2; S2.init(4, 6, F.G, F.bid, 2); pg8::gemm_phase(F.lds, g, S2, E, F.wave); }
        }
        SEAM(pb + 0);
        if (ON(2) && IN(pb + 1)) { const Ctx F = phase_ctx(F0); bf16_t* P = WSP(bf16_t, WS_P);
            knorm_pass(F);
            { pg8::Gemm g{P + PC_CKV, WSP(const bf16_t, WS_WKVUP) + (size_t)l * 2048 * 256, NC, 256}; pg8::EpiKvUp E{WSP(bf16_t, WS_KB), WSP(bf16_t, WS_VB), WSP(const float, WS_SSKV)};
              pg8::TileOrder S; S.init(68, 8, F.G, F.bid, 0); for (int dup = 0; dup < DUPN(1); ++dup) pg8::gemm_phase(F.lds, g, S, E, F.wave); }
            { pg8::Gemm g{P + PC_CQ, WSP(const bf16_t, WS_WQUP) + (size_t)l * 1536 * 512, NC, 512}; pg8::EpiQUp E{WSP(bf16_t, WS_QB), WSP(const float, WS_COSR), WSP(const float, WS_SINR), WSP(const float, WS_SSCQ)};
              pg8::TileOrder S; S.init(nMl, 6, F.G, F.bid, rmode); for (int dup = 0; dup < DUPN(1); ++dup) pg8::gemm_phase(F.lds, g, S, E, F.wave); }
        }
        SEAM(pb + 1);
        if (ON(3) && IN(pb + 2)) ph_attn(F0, l);
        }
        SEAM(pb + 2);
        if (ON(4) && IN(pb + 3)) { const Ctx F = phase_ctx(F0); bf16_t* P = WSP(bf16_t, WS_P); bf16_t* HB = WSP(bf16_t, WS_HB);
            pg8::Gemm g{WSP(const bf16_t, WS_BR), WSP(const bf16_t, WS_WBR) + (size_t)l * 4 * 2048 * 1024, 4096, 1024};
            pg8::EpiMerge E{HB, P + PC_GATE, NC};
            pg8::TileOrder S; S.init(nMl, 8, F.G, F.bid, rmode, 4, (size_t)1024 * 2, (size_t)2048 * 1024 * 2);
            for (int dup = 0; dup < DUPN(5); ++dup) pg8::gemm_phase(F.lds, g, S, E, F.wave);
        }
        SEAM(pb + 3);
        if (ON(5) && IN(pb + 4)) { const Ctx F = phase_ctx(F0); bf16_t* HB = WSP(bf16_t, WS_HB);
            pg8::Gemm g{HB, WSP(const bf16_t, WS_WO) + (size_t)l * 2048 * 2048, 2048, 2048};
            pg8::EpiWo E{(float*)(F.ws + WS_P + X1_OFF), WSP(const float, WS_MOD) + (size_t)l * 5 * 12288, l == 0 ? F.in[I_X] : (const float*)F.out, F.in[I_CTX]};
            pg8::TileOrder S; S.init(nMl, 8, F.G, F.bid, rmode); for (int dup = 0; dup < DUPN(6); ++dup) pg8::gemm_phase(F.lds, g, S, E, F.wave);
        }
        SEAM(pb + 4);
        if (ON(6) && IN(pb + 5)) ph_ln1(F0, l);
        SEAM(pb + 5);
        if (ON(7) && IN(pb + 6)) { const Ctx F = phase_ctx(F0); bf16_t* HB = WSP(bf16_t, WS_HB);
            pg8::Gemm g{HB, WSP(const bf16_t, WS_WFOLD) + (size_t)l * 2048 * 2048, 2048, 2048}; pg8::EpiF32 E{(float*)(F.ws + WS_P + SC_OFF), 2048};
            pg8::TileOrder S; S.init(nMl, 8, F.G, F.bid, rmode); for (int dup = 0; dup < DUPN(7); ++dup) pg8::gemm_phase(F.lds, g, S, E, F.wave);
        }
        SEAM(pb + 6);
        if (ON(8) && IN(pb + 7)) { ph_peer(F0, l); if (DUPN(8) == 2 && l == 1) ph_peer(F0, l); }
        SEAM(pb + 7);
    }
#undef IN
#undef SEAM
}

extern "C" void kernel_launch(void* const* d_in, const int* in_sizes, int n_in, void* d_out, int out_size, void* d_ws, size_t ws_size, hipStream_t stream) {
    static int grid = 0;
    if (grid == 0) {
        if (n_in != cf::N_IN || out_size != cf::NB * cf::S * cf::D || ws_size < cf::WS_END) {
            fprintf(stderr, "kernel_launch: unexpected shapes: n_in %d out %d ws %zu (need %zu)\n", n_in, out_size, ws_size, (size_t)cf::WS_END); grid = -1; return; }
        int dev = 0, cus = 0;
        if (hipGetDevice(&dev) != hipSuccess || hipDeviceGetAttribute(&cus, hipDeviceAttributeMultiprocessorCount, dev) != hipSuccess || cus < 1) { grid = -1; return; }
        if (hipFuncSetAttribute((const void*)mega_fwd, hipFuncAttributeMaxDynamicSharedMemorySize, cf::LDS_BYTES) != hipSuccess) { fprintf(stderr, "kernel_launch: hipFuncSetAttribute failed\n"); grid = -1; return; }
        int per_cu = 0;
        if (hipOccupancyMaxActiveBlocksPerMultiprocessor(&per_cu, (const void*)mega_fwd, 512, cf::LDS_BYTES) != hipSuccess || per_cu < 1)
            fprintf(stderr, "kernel_launch: note: occupancy query reports %d workgroups per CU\n", per_cu);
        (void)hipGetLastError();
        grid = cus;
    }
    if (grid < 0) return;
    (void)hipMemsetAsync((char*)d_ws + cf::WS_CTL, 0, cf::CTL_BYTES, stream);
    Params p{};
    for (int i = 0; i < cf::N_IN; ++i) p.in[i] = (const float*)d_in[i];
    p.out = (float*)d_out; p.ws = (unsigned char*)d_ws;
#if MK_PER_PHASE
    for (int k = 0; k < cf::N_PHASES; ++k) { p.ph_lo = k; p.ph_hi = k + 1; hipLaunchKernelGGL(mega_fwd, dim3(grid), dim3(512), cf::LDS_BYTES, stream, p); }
#else
    p.ph_lo = 0; p.ph_hi = cf::N_PHASES;
    hipLaunchKernelGGL(mega_fwd, dim3(grid), dim3(512), cf::LDS_BYTES, stream, p);
#endif
    const hipError_t le = hipPeekAtLastError();
    if (le != hipSuccess) fprintf(stderr, "kernel_launch: launch failed: %s\n", hipGetErrorName(le));
}
```

```cpp
#include <hip/hip_runtime.h>
#include <stdint.h>
#include <stdio.h>

#ifndef MK_DUP
#define MK_DUP 0
#endif
#define DUPN(k) (((MK_DUP >> (k)) & 1) ? 2 : 1)
#ifndef MK_AV
#define MK_AV 0
#endif
#ifndef MK_PER_PHASE
#define MK_PER_PHASE 0
#endif

namespace cf {
constexpr int D = 2048, NB = 4, S = 4096, CTX = 256, RB = CTX + S  , MR = NB * RB  ;
constexpr int DEPTH = 2;
constexpr int PC_AK = 0, PC_AV = 256, PC_CKV = 512, PC_KR = 768, PC_DK = 1024, PC_DV = 1280, PC_KVEND = 1536;
constexpr int PC_AQ = 1536, PC_CQ = 2560, PC_DQ = 3072, PC_GLU = 4096, PC_GATE = 6144, NC = 14336;
constexpr int IN_COLS = 14144;
constexpr int NEXP = 16384;
constexpr float ALPHA = 1.4142135623730951f;
constexpr float LOG2E = 1.4426950408889634f;
constexpr float SCALE_HD = 0.08838834764831845f;
constexpr float SCALE_MLA = 0.07216878364870323f;
enum { I_X = 0, I_C, I_CTX, I_CCTX, I_WADA, I_BADA, I_WIN, I_AQN, I_AKN, I_BQN, I_WQUP, I_BKVN, I_WKVUP, I_CW, I_CB, I_CLG, I_CLB, I_SINK,
       I_WBRA, I_WBRB, I_WBRC, I_WBRD, I_WO, I_LN1G, I_LN1B, I_LN2G, I_LN2B, I_PWQ, I_PSK, I_PU, I_PV, N_IN };
constexpr size_t al(size_t x) { return (x + 255) / 256 * 256; }
constexpr size_t WS_CTL = 0;
constexpr size_t CTL_BYTES = 65536;
constexpr size_t WS_MOD = WS_CTL + CTL_BYTES;
constexpr size_t WS_COSH = WS_MOD + al((size_t)2 * 5 * 12288 * 4);
constexpr size_t WS_SINH = WS_COSH + (size_t)4096 * 64 * 4;
constexpr size_t WS_COSR = WS_SINH + (size_t)4096 * 64 * 4;
constexpr size_t WS_SINR = WS_COSR + (size_t)4096 * 32 * 4;
constexpr size_t WS_WIN = WS_SINR + (size_t)4096 * 32 * 4;
constexpr size_t WS_WQUP = WS_WIN + (size_t)2 * NC * 2048 * 2;
constexpr size_t WS_WKVUP = WS_WQUP + (size_t)2 * 1536 * 512 * 2;
constexpr size_t WS_WBR = WS_WKVUP + (size_t)2 * 2048 * 256 * 2;
constexpr size_t WS_WO = WS_WBR + (size_t)2 * 4 * 2048 * 1024 * 2;
constexpr size_t WS_WFOLD = WS_WO + (size_t)2 * 2048 * 2048 * 2;
constexpr size_t WS_UB = WS_WFOLD + (size_t)2 * 2048 * 2048 * 2;
constexpr size_t WS_VB2 = WS_UB + (size_t)2 * NEXP * 2048;
constexpr size_t WS_HB = WS_VB2 + (size_t)2 * NEXP * 2048;
constexpr size_t WS_P = WS_HB + (size_t)MR * 2048 * 2;
constexpr size_t WS_QB = WS_P + (size_t)MR * NC * 2;
constexpr size_t WS_KB = WS_QB + (size_t)MR * 1536 * 2;
constexpr size_t WS_VB = WS_KB + (size_t)MR * 1536 * 2;
constexpr size_t WS_BR = WS_VB + (size_t)MR * 1024 * 2;
constexpr size_t WS_XC = WS_BR + (size_t)MR * 4096 * 2;
constexpr size_t WS_SSK = WS_XC + (size_t)1024 * 2048 * 4;
constexpr size_t WS_SSQ = WS_SSK + (size_t)MR * 4 * 4;
constexpr size_t WS_SSKV = WS_SSQ + (size_t)MR * 16 * 4;
constexpr size_t WS_SSCQ = WS_SSKV + (size_t)MR * 4 * 4;
constexpr size_t WS_END = WS_SSCQ + (size_t)MR * 8 * 4;
constexpr size_t X1_OFF = 0, SC_OFF = (size_t)MR * 2048 * 4;
static_assert(SC_OFF * 2 <= (size_t)MR * NC * 2, "X1 + SC fit in P");
constexpr int LDS_BYTES = 132 * 1024;
constexpr int MISC_OFF = 128 * 1024;
constexpr int N_PHASES = 2 + 8 * DEPTH;
}

typedef unsigned short bf16_t;
typedef short bf16x8 __attribute__((ext_vector_type(8)));
typedef float f32x4 __attribute__((ext_vector_type(4)));
typedef float f32x2 __attribute__((ext_vector_type(2)));
typedef unsigned u32x4 __attribute__((ext_vector_type(4)));
typedef unsigned u32x2 __attribute__((ext_vector_type(2)));
#define LAS __attribute__((address_space(3)))
typedef LAS unsigned char* ldsp_t;

typedef __bf16 bf16x2v_t __attribute__((ext_vector_type(2)));
__device__ __forceinline__ unsigned cvt_pk_bf16(float lo, float hi) { const bf16x2v_t r = __builtin_convertvector((f32x2){lo, hi}, bf16x2v_t); return __builtin_bit_cast(unsigned, r); }
__device__ __forceinline__ bf16_t f2bf(float f) { return (bf16_t)(cvt_pk_bf16(f, 0.f) & 0xffffu); }
__device__ __forceinline__ float bf2f(bf16_t b) { return __uint_as_float(((unsigned)b) << 16); }
__device__ __forceinline__ float bflo(unsigned w) { return __uint_as_float(w << 16); }
__device__ __forceinline__ float bfhi(unsigned w) { return __uint_as_float(w & 0xffff0000u); }
__device__ __forceinline__ float shx(float v, int mask, int lane) { return __int_as_float(__builtin_amdgcn_ds_bpermute((lane ^ mask) << 2, __float_as_int(v))); }
__device__ __forceinline__ float wave_sum(float v, int lane) {
#pragma unroll
    for (int o = 32; o >= 1; o >>= 1) v += shx(v, o, lane);
    return v;
}
__device__ __forceinline__ int lane_id() { int l; asm volatile("v_mbcnt_lo_u32_b32 %0, -1, 0\n\tv_mbcnt_hi_u32_b32 %0, -1, %0" : "=v"(l)); return l; }
__device__ __forceinline__ float sigmoidf_(float x) { return __builtin_amdgcn_rcpf(1.0f + __builtin_amdgcn_exp2f(x * -1.4426950408889634f)); }

#define XB_TMO      128
#define XB_XCNT(j)  (256  + 64 * (j))
#define XB_XSUB(j)  (1280 + 64 * (j))
#define XB_XGEN(j)  (2304 + 64 * (j))
#define XB_TOP      3328
#define XB_TOPGEN   3392
#define XCD_BAR_WORDS 3456
#define XB_SPIN_CAP (1u << 23)
__device__ __forceinline__ unsigned xb_ld(unsigned* p)              { return __hip_atomic_load(p, __ATOMIC_RELAXED, __HIP_MEMORY_SCOPE_AGENT); }
__device__ __forceinline__ unsigned xb_add(unsigned* p, unsigned v) { return __hip_atomic_fetch_add(p, v, __ATOMIC_RELAXED, __HIP_MEMORY_SCOPE_AGENT); }
__device__ __forceinline__ unsigned xb_xcc_id() { return (unsigned)__builtin_amdgcn_s_getreg((3 << 11) | 20) & 0xFu; }
#define XB_SPIN(cond, bar) do { unsigned _sp = 0; while (cond) { __builtin_amdgcn_s_sleep(1); \
    if ((++_sp & 255u) == 0u) { if (xb_ld(&(bar)[XB_TMO])) break; if (_sp > XB_SPIN_CAP) { atomicAdd(&(bar)[XB_TMO], 1u); break; } } } } while (0)
struct XcdBarrier { unsigned* bar; unsigned x; volatile LAS unsigned* st; int wave; };
__device__ __forceinline__ XcdBarrier xcd_barrier_post(unsigned* bar, volatile LAS unsigned* st, int wave) {
    XcdBarrier b; b.bar = bar; b.x = xb_xcc_id(); b.st = st; b.wave = wave;
    if (wave == 0 && lane_id() == 0) (void)xb_add(&bar[XB_XCNT(b.x)], 1u);
    return b;
}
__device__ __forceinline__ void xcd_barrier_complete(unsigned* bar, unsigned x, unsigned& nloc, unsigned& nx) {
    const unsigned G = gridDim.x * gridDim.y * gridDim.z;
    unsigned sum, cnt, mine, sp = 0u;
    for (;;) {
        sum = 0u; cnt = 0u; mine = 0u;
#pragma unroll
        for (unsigned j = 0; j < 16; ++j) { const unsigned c = xb_ld(&bar[XB_XCNT(j)]); sum += c; cnt += (c > 0u) ? 1u : 0u; mine = (j == x) ? c : mine; }
        if (sum == G) break;
        __builtin_amdgcn_s_sleep(1);
        if ((++sp & 255u) == 0u) { if (xb_ld(&bar[XB_TMO])) break; if (sp > XB_SPIN_CAP) { atomicAdd(&bar[XB_TMO], 1u); break; } }
    }
    nloc = mine > 0u ? mine : 1u; nx = cnt > 0u ? cnt : 1u;
}
__device__ __forceinline__ void xcd_barrier(const XcdBarrier& b) {
    asm volatile("s_waitcnt vmcnt(0)" ::: "memory");
    __syncthreads();
    if (b.wave == 0 && lane_id() == 0) {
        unsigned* bar = b.bar;
        __builtin_amdgcn_s_waitcnt(0);
        unsigned nloc = b.st[0], nx = b.st[1];
        if (nloc == 0u) { xcd_barrier_complete(bar, b.x, nloc, nx); b.st[0] = nloc; b.st[1] = nx; }
        const unsigned old = xb_add(&bar[XB_XSUB(b.x)], 1u);
        const unsigned gen = old / nloc;
        if (old + 1u == (gen + 1u) * nloc) {
            __builtin_amdgcn_fence(__ATOMIC_RELEASE, "agent");
            asm volatile("s_waitcnt vmcnt(0)" ::: "memory");
            const unsigned og = xb_add(&bar[XB_TOP], 1u);
            const unsigned tg = og / nx;
            if (og + 1u == (tg + 1u) * nx) xb_add(&bar[XB_TOPGEN], 1u);
            else XB_SPIN(xb_ld(&bar[XB_TOPGEN]) == tg, bar);
            __builtin_amdgcn_fence(__ATOMIC_ACQUIRE, "agent");
            xb_add(&bar[XB_XGEN(b.x)], 1u);
            asm volatile("s_waitcnt vmcnt(0)" ::: "memory");
        } else {
            XB_SPIN(xb_ld(&bar[XB_XGEN(b.x)]) == gen, bar);
            __builtin_amdgcn_fence(__ATOMIC_ACQUIRE, "agent");
            asm volatile("s_waitcnt vmcnt(0)" ::: "memory");
        }
    }
    __syncthreads();
}

namespace pg8 {
constexpr int BM = 256, BK = 64, HALF = 128, HTB = HALF * BK * 2, STAGE_BYTES = 8 * HTB, NXCD = 8, WGM = 8;
__host__ __device__ __forceinline__ int lds_byte(int r, int c) { const int st = (r >> 4) * 2 + (c >> 5), rr = r & 15, cc = c & 31, ob = rr * 64 + cc * 2; return st * 1024 + (ob ^ (((ob >> 9) & 1) << 5)); }
__host__ __device__ __forceinline__ void stage_rc(int b, int& R, int& C) { const int st = b / 1024, sb = b % 1024, swz = sb ^ (((sb >> 9) & 1) << 5); R = (st >> 1) * 16 + swz / 64; C = (st & 1) * 32 + (swz % 64) / 2; }
__host__ __device__ __forceinline__ int perm32(int rho) { const int n = rho >> 4, i = rho & 15; return 8 * (i >> 2) + 4 * n + (i & 3); }
struct Unit { int pm, pn, sub; };
struct Gemm { const bf16_t* A; const bf16_t* Bt; int lda, K; };

struct TileOrder {
    int nM, nN, nwg, G, c, mode, nsub; size_t subA, subB;
    __device__ void init(int nM_, int nN_, int G_, int c_, int mode_, int nsub_ = 1, size_t subA_ = 0, size_t subB_ = 0) { nM = nM_; nN = nN_; nwg = nM * nN; G = G_; c = c_; mode = mode_; nsub = nsub_; subA = subA_; subB = subB_; }
    __device__ bool next(int i, Unit& u) const {
        const int it = nsub == 1 ? i : i / nsub; u.sub = nsub == 1 ? 0 : i - it * nsub;
        const long L = (long)it * G + c; if (L >= nwg) return false;
        int wgid = (int)L; { const int q = nwg / NXCD, r = nwg % NXCD, xcd = wgid % NXCD, off = wgid / NXCD; wgid = (xcd < r ? xcd * (q + 1) : r * (q + 1) + (xcd - r) * q) + off; }
        const int nig = WGM * nN, gid = wgid / nig, fm = gid * WGM, gsz = (nM - fm) < WGM ? (nM - fm) : WGM;
        const int pl = fm + ((wgid % nig) % gsz); u.pn = (wgid % nig) / gsz;
        u.pm = mode == 0 ? pl : (mode == 1 ? 17 * (pl >> 4) + 1 + (pl & 15) : 17 * pl);
        return true;
    }
    __device__ __forceinline__ void a_ready(const Unit&) const {}
    __device__ __forceinline__ void done(const Unit&) const {}
};

template <class Epi, class Sched>
__device__ __forceinline__ void gemm_phase(ldsp_t lds, const Gemm g, const Sched& S, const Epi& E, int wave_) {
    int tid = wave_ * 64 + lane_id(); asm volatile("" : "+v"(tid));
    const int wid = __builtin_amdgcn_readfirstlane(tid >> 6), lane = tid & 63, wr = wid >> 2, wc = wid & 3, fr = lane & 15, fq = lane >> 4;
    int K = g.K; asm volatile("" : "+s"(K));
    const int nt = K / BK, lda = g.lda;
    unsigned voffA[2], voffB[2];
#pragma unroll
    for (int i = 0; i < 2; ++i) { int R, C; stage_rc(tid * 16 + i * 8192, R, C); const int Rb = (R & ~31) + perm32(R & 31);
        voffA[i] = (unsigned)(R * lda + C) * 2u; voffB[i] = (unsigned)(Rb * K + C) * 2u; }
    const size_t kstep = (size_t)(BK * 2);
    const size_t hstepA = (size_t)HALF * lda * 2, hstepB = (size_t)HALF * K * 2;
    const size_t tstepA = 2 * hstepA, tstepB = 2 * hstepB;
    const unsigned ldsw = (unsigned)wid * 1024u;
    const int aoff = lds_byte(wr * 64 + fr, fq * 8), boff = lds_byte(wc * 32 + fr, fq * 8);
#define PG8_SA(b, h) (((b) * 2 + (h)) * HTB)
#define PG8_SB(b, h) ((4 + (b) * 2 + (h)) * HTB)
#define PG8_STAGE(bufoff, gbase, voff) do { _Pragma("unroll") for (int _i = 0; _i < 2; ++_i) \
        __builtin_amdgcn_global_load_lds((const unsigned*)((const char*)(gbase) + (voff)[_i]), (LAS unsigned*)(lds + (bufoff) + ldsw + _i * 8192), 16, 0, 0); } while (0)
#define PG8_LDA(dst, b, h) do { _Pragma("unroll") for (int m = 0; m < 4; ++m) _Pragma("unroll") for (int k = 0; k < 2; ++k) dst[m][k] = *(const LAS bf16x8*)(lds + PG8_SA(b, h) + aoff + m * 2048 + k * 1024); } while (0)
#define PG8_LDB(dst, b, h) do { _Pragma("unroll") for (int n = 0; n < 2; ++n) _Pragma("unroll") for (int k = 0; k < 2; ++k) dst[n][k] = *(const LAS bf16x8*)(lds + PG8_SB(b, h) + boff + n * 2048 + k * 1024); } while (0)
#define PG8_MMA(ai, bj, At, Bt) do { __builtin_amdgcn_s_setprio(1); _Pragma("unroll") for (int m = 0; m < 4; ++m) _Pragma("unroll") for (int n = 0; n < 2; ++n) _Pragma("unroll") for (int k = 0; k < 2; ++k) \
        acc[ai][bj][m][n] = __builtin_amdgcn_mfma_f32_16x16x32_bf16(Bt[n][k], At[m][k], acc[ai][bj][m][n], 0, 0, 0); __builtin_amdgcn_s_setprio(0); } while (0)
#define PG8_WAIT_V(n) asm volatile("s_waitcnt vmcnt(" #n ")" ::: "memory")
#define PG8_WAIT_L(n) asm volatile("s_waitcnt lgkmcnt(" #n ")" ::: "memory")
#define PG8_BAR __builtin_amdgcn_s_barrier()
#define PG8_SCHED __builtin_amdgcn_sched_barrier(0)
    Unit cur, nxt; int ui = 0;
    if (!S.next(0, cur)) return;
    f32x4 acc[2][2][4][2];
#pragma unroll
    for (int a = 0; a < 2; ++a)
#pragma unroll
        for (int b = 0; b < 2; ++b)
#pragma unroll
            for (int m = 0; m < 4; ++m)
#pragma unroll
                for (int n = 0; n < 2; ++n) acc[a][b][m][n] = (f32x4){0.f, 0.f, 0.f, 0.f};
    bf16x8 At[4][2], B0[2][2], B1[2][2];
    const char* cA = (const char*)g.A + (size_t)cur.pm * tstepA + cur.sub * S.subA; const char* cB = (const char*)g.Bt + (size_t)cur.pn * tstepB + cur.sub * S.subB;
    S.a_ready(cur);
    PG8_STAGE(PG8_SB(0, 0), cB, voffB); PG8_STAGE(PG8_SA(0, 0), cA, voffA); PG8_STAGE(PG8_SB(0, 1), cB + hstepB, voffB); PG8_STAGE(PG8_SA(0, 1), cA + hstepA, voffA);
    if (wr == 1) PG8_BAR;
    PG8_WAIT_V(4); PG8_BAR;
    PG8_STAGE(PG8_SB(1, 0), cB + kstep, voffB); PG8_STAGE(PG8_SA(1, 0), cA + kstep, voffA); PG8_STAGE(PG8_SB(1, 1), cB + hstepB + kstep, voffB);
    PG8_WAIT_V(6); PG8_BAR;
    for (;;) {
        const bool has_next = S.next(ui + 1, nxt);
        const char* nA = has_next ? (const char*)g.A + (size_t)nxt.pm * tstepA + nxt.sub * S.subA : cA; const char* nB = has_next ? (const char*)g.Bt + (size_t)nxt.pn * tstepB + nxt.sub * S.subB : cB;
#pragma unroll 1
        for (int t = 0; t < nt; t += 2) {
            const bool last = (t == nt - 2);
            const char* a1 = cA + (size_t)(t + 1) * kstep;
            const char* a2 = last ? nA : cA + (size_t)(t + 2) * kstep; const char* b2 = last ? nB : cB + (size_t)(t + 2) * kstep;
            const char* a3 = a2 + kstep; const char* b3 = b2 + kstep;
            if (last && has_next) S.a_ready(nxt);
            PG8_LDB(B0, 0, 0); PG8_SCHED; PG8_LDA(At, 0, 0); PG8_STAGE(PG8_SA(1, 1), a1 + hstepA, voffA);
            PG8_WAIT_L(8); PG8_BAR; PG8_WAIT_L(0); PG8_MMA(0, 0, At, B0); PG8_BAR; PG8_SCHED;
            PG8_LDB(B1, 0, 1); PG8_STAGE(PG8_SB(0, 0), b2, voffB);
            PG8_BAR; PG8_WAIT_L(0); PG8_MMA(0, 1, At, B1); PG8_BAR;
            PG8_LDA(At, 0, 1); PG8_STAGE(PG8_SA(0, 0), a2, voffA);
            PG8_BAR; PG8_WAIT_L(0); PG8_MMA(1, 0, At, B0); PG8_BAR; PG8_SCHED;
            PG8_STAGE(PG8_SB(0, 1), b2 + hstepB, voffB);
            PG8_WAIT_V(6); PG8_BAR; PG8_MMA(1, 1, At, B1); PG8_BAR;
            PG8_LDB(B0, 1, 0); PG8_SCHED; PG8_LDA(At, 1, 0); PG8_STAGE(PG8_SA(0, 1), a2 + hstepA, voffA);
            PG8_WAIT_L(8); PG8_BAR; PG8_WAIT_L(0); PG8_MMA(0, 0, At, B0); PG8_BAR; PG8_SCHED;
            PG8_LDB(B1, 1, 1); PG8_STAGE(PG8_SB(1, 0), b3, voffB);
            PG8_BAR; PG8_WAIT_L(0); PG8_MMA(0, 1, At, B1); PG8_BAR;
            PG8_LDA(At, 1, 1); PG8_STAGE(PG8_SA(1, 0), a3, voffA);
            PG8_BAR; PG8_WAIT_L(0); PG8_MMA(1, 0, At, B0); PG8_BAR; PG8_SCHED;
            PG8_STAGE(PG8_SB(1, 1), b3 + hstepB, voffB);
            PG8_WAIT_V(6); PG8_BAR; PG8_MMA(1, 1, At, B1); PG8_BAR;
        }
        E(acc, cur, wr, wc, fr, fq); S.done(cur);
        if (!has_next) break;
#pragma unroll
        for (int a = 0; a < 2; ++a)
#pragma unroll
            for (int b = 0; b < 2; ++b)
#pragma unroll
                for (int m = 0; m < 4; ++m)
#pragma unroll
                    for (int n = 0; n < 2; ++n) acc[a][b][m][n] = (f32x4){0.f, 0.f, 0.f, 0.f};
        cur = nxt; cA = nA; cB = nB; ++ui;
    }
    PG8_WAIT_V(0);
    if (wr == 0) PG8_BAR;
    PG8_BAR;
#undef PG8_SA
#undef PG8_SB
#undef PG8_STAGE
#undef PG8_LDA
#undef PG8_LDB
#undef PG8_MMA
#undef PG8_WAIT_V
#undef PG8_WAIT_L
#undef PG8_BAR
#undef PG8_SCHED
}

__device__ __forceinline__ u32x4 pack8(const f32x4 a, const f32x4 b) { u32x4 w; w.x = cvt_pk_bf16(a[0], a[1]); w.y = cvt_pk_bf16(a[2], a[3]); w.z = cvt_pk_bf16(b[0], b[1]); w.w = cvt_pk_bf16(b[2], b[3]); return w; }
#define EPI_ARGS const f32x4 (&acc)[2][2][4][2], const Unit& u, int wr, int wc, int fr_, int fq_
#define EPI_LANE int fr = fr_, fq = fq_; asm volatile("" : "+v"(fr), "+v"(fq));

struct EpiBf16 {
    bf16_t* O; int ldc;
    __device__ __forceinline__ void operator()(EPI_ARGS) const {
        EPI_LANE
        const int row0 = u.pm * BM + wr * 64 + fr, col0 = u.pn * BM + wc * 32 + 8 * fq;
#pragma unroll
        for (int ai = 0; ai < 2; ++ai)
#pragma unroll
            for (int m = 0; m < 4; ++m) { bf16_t* rowp = O + (size_t)(row0 + ai * HALF + m * 16) * ldc + col0;
#pragma unroll
                for (int bj = 0; bj < 2; ++bj) *(u32x4*)(rowp + bj * HALF) = pack8(acc[ai][bj][m][0], acc[ai][bj][m][1]); }
    }
};
struct EpiF32 {
    float* C; int ldc;
    __device__ __forceinline__ void operator()(EPI_ARGS) const {
        EPI_LANE
        const int row0 = u.pm * BM + wr * 64 + fr, col0 = u.pn * BM + wc * 32 + 8 * fq;
#pragma unroll
        for (int ai = 0; ai < 2; ++ai)
#pragma unroll
            for (int m = 0; m < 4; ++m) { float* rowp = C + (size_t)(row0 + ai * HALF + m * 16) * ldc + col0;
#pragma unroll
                for (int bj = 0; bj < 2; ++bj) { *(f32x4*)(rowp + bj * HALF) = acc[ai][bj][m][0]; *(f32x4*)(rowp + bj * HALF + 4) = acc[ai][bj][m][1]; } }
    }
};
struct EpiInProj {
    bf16_t* P; bf16_t* KB; const float* cosh; const float* sinh; const float* cosr; const float* sinr; const float* akn; const float* aqn;
    float* ssk; float* ssq; float* sskv; float* sscq;
    __device__ __forceinline__ void operator()(EPI_ARGS) const {
        EPI_LANE
        const int pn = u.pn, tb = u.pm % 17; const bool lat = tb != 0; const int posbase = (tb - 1) * 256;
        const int rl0 = wr * 64 + fr;
        if (pn >= 24) {
            const int col0 = pn * BM + wc * 32 + 8 * fq;
#pragma unroll
            for (int ai = 0; ai < 2; ++ai)
#pragma unroll
                for (int m = 0; m < 4; ++m) { bf16_t* rowp = P + ((size_t)u.pm * BM + rl0 + ai * HALF + m * 16) * cf::NC + col0;
#pragma unroll
                    for (int bj = 0; bj < 2; ++bj) { f32x4 v0 = acc[ai][bj][m][0], v1 = acc[ai][bj][m][1];
#pragma unroll
                        for (int e = 0; e < 4; ++e) { v0[e] = sigmoidf_(v0[e]); v1[e] = sigmoidf_(v1[e]); }
                        *(u32x4*)(rowp + bj * HALF) = pack8(v0, v1); } }
        } else if (pn >= 16) {
            const int col0 = cf::PC_GLU + 128 * (pn - 16) + wc * 32 + 8 * fq;
#pragma unroll
            for (int ai = 0; ai < 2; ++ai)
#pragma unroll
                for (int m = 0; m < 4; ++m) { f32x4 v0 = acc[ai][0][m][0], v1 = acc[ai][0][m][1]; const f32x4 g0 = acc[ai][1][m][0], g1 = acc[ai][1][m][1];
#pragma unroll
                    for (int e = 0; e < 4; ++e) { v0[e] *= sigmoidf_(g0[e]); v1[e] *= sigmoidf_(g1[e]); }
                    *(u32x4*)(P + ((size_t)u.pm * BM + rl0 + ai * HALF + m * 16) * cf::NC + col0) = pack8(v0, v1); }
        } else if (pn == 3) {
            if (wc == 0) { const int i0 = 8 * fq;
#pragma unroll
                for (int ai = 0; ai < 2; ++ai)
#pragma unroll
                    for (int m = 0; m < 4; ++m) { const int rl = rl0 + ai * HALF + m * 16;
                        f32x4 c0 = {1.f, 1.f, 1.f, 1.f}, c1 = c0, s0 = {0.f, 0.f, 0.f, 0.f}, s1 = s0;
                        if (lat) { const float* cp = cosr + (size_t)(posbase + rl) * 32 + i0; const float* sp = sinr + (size_t)(posbase + rl) * 32 + i0;
                            c0 = *(const f32x4*)cp; c1 = *(const f32x4*)(cp + 4); s0 = *(const f32x4*)sp; s1 = *(const f32x4*)(sp + 4); }
                        const f32x4 x1a = acc[ai][0][m][0], x1b = acc[ai][0][m][1], x2a = acc[ai][1][m][0], x2b = acc[ai][1][m][1];
                        const u32x4 w1 = pack8(x1a * c0 - x2a * s0, x1b * c1 - x2b * s1), w2 = pack8(x2a * c0 + x1a * s0, x2b * c1 + x1b * s1);
                        bf16_t* kb = KB + ((size_t)u.pm * BM + rl) * 1536 + 128 + i0;
#pragma unroll
                        for (int h = 0; h < 8; ++h) { *(u32x4*)(kb + h * 192) = w1; *(u32x4*)(kb + h * 192 + 32) = w2; }
                        asm volatile("" ::: "memory"); } }
        } else if (pn == 0 || pn == 4 || (pn >= 6 && pn <= 9) || pn >= 12) {
            const bool norm = pn == 0 || (pn >= 6 && pn <= 9);
            const int hl = wc >> 1, i0 = 32 * (wc & 1) + 8 * fq;
            f32x4 g1a = {1.f, 1.f, 1.f, 1.f}, g1b = g1a, g2a = g1a, g2b = g1a;
            if (norm) { const float* gn = (pn == 0 ? akn : aqn) + i0; g1a = *(const f32x4*)gn; g1b = *(const f32x4*)(gn + 4); g2a = *(const f32x4*)(gn + 64); g2b = *(const f32x4*)(gn + 68); }
            float* ssp = pn == 0 ? ssk + ((size_t)u.pm * BM * 2 + hl) * 2 + (wc & 1) : ssq + ((size_t)u.pm * BM * 8 + (pn - 6) * 2 + hl) * 2 + (wc & 1);
            const int sstr = pn == 0 ? 4 : 16;
#pragma unroll
            for (int ai = 0; ai < 2; ++ai)
#pragma unroll
                for (int m = 0; m < 4; ++m) { const int rl = rl0 + ai * HALF + m * 16;
                    f32x4 x1a = acc[ai][0][m][0], x1b = acc[ai][0][m][1], x2a = acc[ai][1][m][0], x2b = acc[ai][1][m][1];
                    if (norm) { const f32x4 q = x1a * x1a + x1b * x1b + x2a * x2a + x2b * x2b; float ss = (q[0] + q[1]) + (q[2] + q[3]);
                        ss += shx(ss, 16, fr + 16 * fq); ss += shx(ss, 32, fr + 16 * fq);
                        if (fq == 0) ssp[(size_t)rl * sstr] = ss;
                        x1a *= g1a; x1b *= g1b; x2a *= g2a; x2b *= g2b; }
                    f32x4 o1a = x1a, o1b = x1b, o2a = x2a, o2b = x2b;
                    if (lat) { const float* cp = cosh + (size_t)(posbase + rl) * 64 + i0; const float* sp = sinh + (size_t)(posbase + rl) * 64 + i0;
                        const f32x4 c0 = *(const f32x4*)cp, c1 = *(const f32x4*)(cp + 4), s0 = *(const f32x4*)sp, s1 = *(const f32x4*)(sp + 4);
                        o1a = x1a * c0 - x2a * s0; o1b = x1b * c1 - x2b * s1; o2a = x2a * c0 + x1a * s0; o2b = x2b * c1 + x1b * s1; }
                    bf16_t* dst = P + ((size_t)u.pm * BM + rl) * cf::NC + pn * BM + hl * 128 + i0;
                    *(u32x4*)dst = pack8(o1a, o1b); *(u32x4*)(dst + 64) = pack8(o2a, o2b);
                    asm volatile("" ::: "memory"); }
        } else {
            const int col0 = pn * BM + wc * 32 + 8 * fq;
            const bool ssq_on = pn == 2 || pn == 10 || pn == 11;
            float* ssp = pn == 2 ? sskv + (size_t)u.pm * BM * 4 + wc : sscq + (size_t)u.pm * BM * 8 + (pn - 10) * 4 + wc;
            const int sstr = pn == 2 ? 4 : 8;
#pragma unroll
            for (int ai = 0; ai < 2; ++ai)
#pragma unroll
                for (int m = 0; m < 4; ++m) { const int rl = rl0 + ai * HALF + m * 16; bf16_t* rowp = P + ((size_t)u.pm * BM + rl) * cf::NC + col0;
#pragma unroll
                    for (int bj = 0; bj < 2; ++bj) *(u32x4*)(rowp + bj * HALF) = pack8(acc[ai][bj][m][0], acc[ai][bj][m][1]);
                    if (ssq_on) { const f32x4 q = acc[ai][0][m][0] * acc[ai][0][m][0] + acc[ai][0][m][1] * acc[ai][0][m][1] + acc[ai][1][m][0] * acc[ai][1][m][0] + acc[ai][1][m][1] * acc[ai][1][m][1];
                        float ss = (q[0] + q[1]) + (q[2] + q[3]); ss += shx(ss, 16, fr + 16 * fq); ss += shx(ss, 32, fr + 16 * fq);
                        if (fq == 0) ssp[(size_t)rl * sstr] = ss; } }
        }
    }
};
struct EpiKvUp {
    bf16_t* KB; bf16_t* VB; const float* sskv;
    __device__ __forceinline__ void operator()(EPI_ARGS) const {
        EPI_LANE
        const int row0 = u.pm * BM + wr * 64 + fr, d0 = wc * 32 + 8 * fq;
        const bool isk = u.pn < 4;
        bf16_t* base = isk ? KB + (2 * u.pn) * 192 + d0 : VB + (u.pn - 4) * 256 + d0;
        const int ldr = isk ? 1536 : 1024, bjs = isk ? 192 : 128;
#pragma unroll
        for (int ai = 0; ai < 2; ++ai)
#pragma unroll
            for (int m = 0; m < 4; ++m) { const size_t row = (size_t)(row0 + ai * HALF + m * 16); bf16_t* rowp = base + row * ldr;
                const f32x4 pp = *(const f32x4*)(sskv + row * 4); const float r = rsqrtf(((pp[0] + pp[1]) + (pp[2] + pp[3])) * (1.f / 256.f) + 1e-6f);
#pragma unroll
                for (int bj = 0; bj < 2; ++bj) *(u32x4*)(rowp + bj * bjs) = pack8(acc[ai][bj][m][0] * r, acc[ai][bj][m][1] * r); }
    }
};
struct EpiQUp {
    bf16_t* QB; const float* cosr; const float* sinr; const float* sscq;
    __device__ __forceinline__ void operator()(EPI_ARGS) const {
        EPI_LANE
        const int row0 = u.pm * BM + wr * 64 + fr;
        if (u.pn < 4) {
            const int d0 = wc * 32 + 8 * fq;
#pragma unroll
            for (int ai = 0; ai < 2; ++ai)
#pragma unroll
                for (int m = 0; m < 4; ++m) { const size_t row = (size_t)(row0 + ai * HALF + m * 16);
                    const f32x4 pa = *(const f32x4*)(sscq + row * 8), pb = *(const f32x4*)(sscq + row * 8 + 4);
                    const float r = rsqrtf((((pa[0] + pa[1]) + (pa[2] + pa[3])) + ((pb[0] + pb[1]) + (pb[2] + pb[3]))) * (1.f / 512.f) + 1e-6f);
#pragma unroll
                    for (int bj = 0; bj < 2; ++bj) *(u32x4*)(QB + row * 1536 + (2 * u.pn + bj) * 192 + d0) = pack8(acc[ai][bj][m][0] * r, acc[ai][bj][m][1] * r); }
        } else {
            const int head = 4 * (u.pn - 4) + wc, i0 = 8 * fq;
            const bool lat = (u.pm % 17) != 0; const int posbase = (u.pm % 17) * 256 - 256;
#pragma unroll
            for (int ai = 0; ai < 2; ++ai)
#pragma unroll
                for (int m = 0; m < 4; ++m) { const int rl = wr * 64 + fr + ai * HALF + m * 16; const size_t row = (size_t)u.pm * BM + rl;
                    const f32x4 pa = *(const f32x4*)(sscq + row * 8), pb = *(const f32x4*)(sscq + row * 8 + 4);
                    const float r = rsqrtf((((pa[0] + pa[1]) + (pa[2] + pa[3])) + ((pb[0] + pb[1]) + (pb[2] + pb[3]))) * (1.f / 512.f) + 1e-6f);
                    f32x4 c0 = {1.f, 1.f, 1.f, 1.f}, c1 = c0, s0 = {0.f, 0.f, 0.f, 0.f}, s1 = s0;
                    if (lat) { const float* cp = cosr + (size_t)(posbase + rl) * 32 + i0; const float* sp = sinr + (size_t)(posbase + rl) * 32 + i0;
                        c0 = *(const f32x4*)cp; c1 = *(const f32x4*)(cp + 4); s0 = *(const f32x4*)sp; s1 = *(const f32x4*)(sp + 4); }
                    const f32x4 x1a = acc[ai][0][m][0] * r, x1b = acc[ai][0][m][1] * r, x2a = acc[ai][1][m][0] * r, x2b = acc[ai][1][m][1] * r;
                    const f32x4 o1a = x1a * c0 - x2a * s0, o1b = x1b * c1 - x2b * s1, o2a = x2a * c0 + x1a * s0, o2b = x2b * c1 + x1b * s1;
                    bf16_t* dst = QB + row * 1536 + head * 192 + 128 + i0;
                    *(u32x4*)dst = pack8(o1a, o1b); *(u32x4*)(dst + 32) = pack8(o2a, o2b); asm volatile("" ::: "memory"); }
        }
    }
};
struct EpiMerge {
    bf16_t* ACC; const bf16_t* gate0; int ldg;
    __device__ __forceinline__ void operator()(EPI_ARGS) const {
        EPI_LANE
        const int row0 = u.pm * BM + wr * 64 + fr, col0 = u.pn * BM + wc * 32 + 8 * fq;
        const bf16_t* gate = gate0 + u.sub * 2048; const bool first = u.sub == 0;
#pragma unroll
        for (int ai = 0; ai < 2; ++ai) {
            u32x4 gw[4][2], pw[4][2];
#pragma unroll
            for (int m = 0; m < 4; ++m) { const size_t row = (size_t)(row0 + ai * HALF + m * 16);
#pragma unroll
                for (int bj = 0; bj < 2; ++bj) { const int col = col0 + bj * HALF; gw[m][bj] = *(const u32x4*)(gate + row * ldg + col);
                    pw[m][bj] = (u32x4){0u, 0u, 0u, 0u}; if (!first) pw[m][bj] = *(const u32x4*)(ACC + row * 2048 + col); } }
#pragma unroll
            for (int m = 0; m < 4; ++m) { const size_t row = (size_t)(row0 + ai * HALF + m * 16);
#pragma unroll
                for (int bj = 0; bj < 2; ++bj) { const int col = col0 + bj * HALF; const u32x4 g = gw[m][bj], p = pw[m][bj];
                    const f32x4 a0 = acc[ai][bj][m][0], a1 = acc[ai][bj][m][1];
                    f32x4 r0, r1;
                    r0[0] = bflo(p.x) + bflo(g.x) * a0[0]; r0[1] = bfhi(p.x) + bfhi(g.x) * a0[1]; r0[2] = bflo(p.y) + bflo(g.y) * a0[2]; r0[3] = bfhi(p.y) + bfhi(g.y) * a0[3];
                    r1[0] = bflo(p.z) + bflo(g.z) * a1[0]; r1[1] = bfhi(p.z) + bfhi(g.z) * a1[1]; r1[2] = bflo(p.w) + bflo(g.w) * a1[2]; r1[3] = bfhi(p.w) + bfhi(g.w) * a1[3];
                    *(u32x4*)(ACC + row * 2048 + col) = pack8(r0, r1); } }
            asm volatile("" ::: "memory"); }
    }
};
struct EpiWo {
    float* X1; const float* mod  ; const float* xlat  ; const float* xctx  ;
    __device__ __forceinline__ void operator()(EPI_ARGS) const {
        EPI_LANE
        const int b = u.pm / 17, tb = u.pm % 17; const bool isctx = tb == 0;
        const float* g1 = mod + (size_t)(isctx ? 4 : b) * 12288 + 2 * 2048;
        const float* xbase = isctx ? xctx + (size_t)b * cf::CTX * 2048 : xlat + ((size_t)b * cf::S + (size_t)(tb - 1) * 256) * 2048;
        const int rl0 = wr * 64 + fr, col0 = u.pn * BM + wc * 32 + 8 * fq;
        f32x4 gv[2][2];
#pragma unroll
        for (int bj = 0; bj < 2; ++bj) { gv[bj][0] = *(const f32x4*)(g1 + col0 + bj * HALF); gv[bj][1] = *(const f32x4*)(g1 + col0 + bj * HALF + 4); }
#pragma unroll
        for (int ai = 0; ai < 2; ++ai) {
            f32x4 xv[4][2][2];
#pragma unroll
            for (int m = 0; m < 4; ++m) { const int rl = rl0 + ai * HALF + m * 16;
#pragma unroll
                for (int bj = 0; bj < 2; ++bj) { const float* xp = xbase + (size_t)rl * 2048 + col0 + bj * HALF; xv[m][bj][0] = *(const f32x4*)xp; xv[m][bj][1] = *(const f32x4*)(xp + 4); } }
#pragma unroll
            for (int m = 0; m < 4; ++m) { const int rl = rl0 + ai * HALF + m * 16; float* op = X1 + ((size_t)u.pm * BM + rl) * 2048 + col0;
#pragma unroll
                for (int bj = 0; bj < 2; ++bj) { *(f32x4*)(op + bj * HALF) = xv[m][bj][0] * cf::ALPHA + gv[bj][0] * acc[ai][bj][m][0];
                    *(f32x4*)(op + bj * HALF + 4) = xv[m][bj][1] * cf::ALPHA + gv[bj][1] * acc[ai][bj][m][1]; } }
            asm volatile("" ::: "memory"); }
    }
};
}

struct Ctx {
    const float* const* in; float* out; unsigned char* ws;
    ldsp_t lds; int tid, lane, wave, G, bid;
};
#define WSP(T, off) ((T*)(F.ws + (off)))
__device__ __forceinline__ Ctx phase_ctx(const Ctx& F0) {
    Ctx C = F0;
    C.tid = F0.wave * 64 + lane_id();
    asm volatile("" : "+v"(C.tid));
    { size_t z = 0; asm volatile("" : "+s"(z)); C.ws = F0.ws + z; }
    C.lane = C.tid & 63; C.wave = __builtin_amdgcn_readfirstlane(C.tid >> 6);
    return C;
}

__device__ __forceinline__ int srcmap(int mode, int n) {
    if (mode == 0) {
        const int pn = n >> 8, q = n & 255, bj = q >> 7, r = q & 127, rope = (r >> 6) * 128 + bj * 64 + (r & 63);
        if (pn == 0) return rope;
        if (pn == 1) return 256 + q;
        if (pn == 2) return 512 + q;
        if (pn == 3) return r < 32 ? 768 + bj * 32 + r : -1;
        if (pn == 4) return 832 + rope;
        if (pn == 5) return 1088 + q;
        if (pn < 10) return 1344 + (pn - 6) * 256 + rope;
        if (pn < 12) return 2368 + (pn - 10) * 256 + q;
        if (pn < 16) return 2880 + (pn - 12) * 256 + rope;
        if (pn < 24) return 3904 + bj * 1024 + 128 * (pn - 16) + r;
        return 5952 + (n - 6144);
    }
    if (mode == 1) { if (n < 1024) return (n >> 7) * 192 + (n & 127);
        const int m = n - 1024, t = m >> 8, bj = (m >> 7) & 1, q = m & 127; return (4 * t + (q >> 5)) * 192 + 128 + bj * 32 + (q & 31); }
    if (mode == 2) { if (n < 1024) return (n >> 7) * 256 + (n & 127); const int m = n - 1024; return (m >> 7) * 256 + 128 + (m & 127); }
    return n;
}
__device__ __forceinline__ void tr_tile(const Ctx& F, const float* src, int ld_src, int mode, int k0, bf16_t* dst, int ldd, int n0, const float* kscale = nullptr) {
    LAS float* T = (LAS float*)F.lds;
    const int kr = F.tid >> 6, nc = (F.tid & 63) * 4, sc = srcmap(mode, n0 + nc);
    f32x4 v[8];
#pragma unroll
    for (int h = 0; h < 8; ++h) { v[h] = (f32x4){0.f, 0.f, 0.f, 0.f}; if (sc >= 0) v[h] = *(const f32x4*)(src + (size_t)(k0 + kr + 8 * h) * ld_src + sc); }
#pragma unroll
    for (int h = 0; h < 8; ++h) { const int k = kr + 8 * h; f32x4 x = v[h]; if (kscale) x = x * kscale[k0 + k];
        T[k * 257 + nc + 0] = x[0]; T[k * 257 + nc + 1] = x[1]; T[k * 257 + nc + 2] = x[2]; T[k * 257 + nc + 3] = x[3]; }
    __syncthreads();
    const int n = F.tid >> 1, kc = (F.tid & 1) * 32;
#pragma unroll
    for (int j = 0; j < 4; ++j) { u32x4 w; const int kb = kc + 8 * j;
        w.x = cvt_pk_bf16(T[(kb + 0) * 257 + n], T[(kb + 1) * 257 + n]); w.y = cvt_pk_bf16(T[(kb + 2) * 257 + n], T[(kb + 3) * 257 + n]);
        w.z = cvt_pk_bf16(T[(kb + 4) * 257 + n], T[(kb + 5) * 257 + n]); w.w = cvt_pk_bf16(T[(kb + 6) * 257 + n], T[(kb + 7) * 257 + n]);
        *(u32x4*)(dst + (size_t)(n0 + n) * ldd + k0 + kb) = w; }
    __syncthreads();
}
__device__ __forceinline__ void cvt_rows(const Ctx& F, const float* src, bf16_t* dst, size_t n8) {
    for (size_t i = (size_t)F.bid * 512 + F.tid; i < n8; i += (size_t)F.G * 512) {
        const f32x4 a = *(const f32x4*)(src + i * 8), b = *(const f32x4*)(src + i * 8 + 4);
        *(u32x4*)(dst + i * 8) = pg8::pack8(a, b); }
}

__device__ __forceinline__ void cvt_rows_fp8(const Ctx& F, const float* src, unsigned char* dst, size_t n16, float scale) {
    const size_t stride = (size_t)F.G * 512;
    for (size_t i = (size_t)F.bid * 512 + F.tid; i < n16; i += 2 * stride) {
        const size_t i2 = i + stride; const bool two = i2 < n16;
        f32x4 a[8];
#pragma unroll
        for (int j = 0; j < 4; ++j) { a[j] = *(const f32x4*)(src + i * 16 + 4 * j); a[4 + j] = two ? *(const f32x4*)(src + i2 * 16 + 4 * j) : (f32x4){0.f, 0.f, 0.f, 0.f}; }
        u32x4 w0, w1;
#pragma unroll
        for (int j = 0; j < 4; ++j) { const f32x4 x = a[j] * scale, y = a[4 + j] * scale;
            int p = 0; p = __builtin_amdgcn_cvt_pk_fp8_f32(x[0], x[1], p, false); p = __builtin_amdgcn_cvt_pk_fp8_f32(x[2], x[3], p, true); w0[j] = (unsigned)p;
            int q = 0; q = __builtin_amdgcn_cvt_pk_fp8_f32(y[0], y[1], q, false); q = __builtin_amdgcn_cvt_pk_fp8_f32(y[2], y[3], q, true); w1[j] = (unsigned)q; }
        *(u32x4*)(dst + i * 16) = w0; if (two) *(u32x4*)(dst + i2 * 16) = w1; }
}

constexpr int V4_ROW = 1088;
__device__ __forceinline__ void cvt_rows_fp4(const Ctx& F, const float* src, unsigned char* dst, size_t nblk) {
    for (size_t i = (size_t)F.bid * 512 + F.tid; i < nblk; i += (size_t)F.G * 512) {
        f32x4 a[8]; float amax = 0.f;
#pragma unroll
        for (int j = 0; j < 8; ++j) { a[j] = *(const f32x4*)(src + i * 32 + 4 * j); amax = fmaxf(amax, fmaxf(fmaxf(fabsf(a[j][0]), fabsf(a[j][1])), fmaxf(fabsf(a[j][2]), fabsf(a[j][3])))); }
        int e = amax > 0.f ? (int)ceilf(log2f(amax * (1.0f / 6.0f))) : -126; e = e < -126 ? -126 : (e > 126 ? 126 : e);
        const float inv = __uint_as_float((unsigned)(127 - e) << 23);
        u32x4 w;
#pragma unroll
        for (int j = 0; j < 4; ++j) { const f32x4 x = a[2 * j] * inv, y = a[2 * j + 1] * inv; unsigned p = 0u;
            p = __builtin_amdgcn_cvt_scalef32_pk_fp4_f32(p, x[0], x[1], 1.0f, 0); p = __builtin_amdgcn_cvt_scalef32_pk_fp4_f32(p, x[2], x[3], 1.0f, 1);
            p = __builtin_amdgcn_cvt_scalef32_pk_fp4_f32(p, y[0], y[1], 1.0f, 2); p = __builtin_amdgcn_cvt_scalef32_pk_fp4_f32(p, y[2], y[3], 1.0f, 3); w[j] = p; }
        const size_t row = i >> 6; const int bl = (int)(i & 63);
        *(u32x4*)(dst + row * V4_ROW + bl * 16) = w; dst[row * V4_ROW + 1024 + bl] = (unsigned char)(e + 127);
    }
}

__device__ __forceinline__ void ph_prologue(const Ctx& F0) {
    const Ctx F = phase_ctx(F0);
    using namespace cf;
    constexpr int T_WIN = 2 * 32 * 56, T_QUP = 2 * 8 * 6, T_KVUP = 2 * 4 * 8, T_BR = 2 * 4 * 16 * 8, T_WO = 2 * 32 * 8;
    constexpr int T_ALL = T_WIN + T_QUP + T_KVUP + T_BR + T_WO;
    for (int u = F.bid; u < T_ALL; u += F.G) {
        int t = u;
        if (t < T_WIN) { const int l = t / (32 * 56), r = t % (32 * 56), kt = r / 56, nt = r % 56;
            tr_tile(F, F.in[I_WIN] + (size_t)l * 2048 * IN_COLS, IN_COLS, 0, kt * 64, WSP(bf16_t, WS_WIN) + (size_t)l * NC * 2048, 2048, nt * 256); continue; }
        t -= T_WIN;
        if (t < T_QUP) { const int l = t / (8 * 6), r = t % (8 * 6), kt = r / 6, nt = r % 6;
            tr_tile(F, F.in[I_WQUP] + (size_t)l * 512 * 1536, 1536, 1, kt * 64, WSP(bf16_t, WS_WQUP) + (size_t)l * 1536 * 512, 512, nt * 256, F.in[I_BQN] + l * 512); continue; }
        t -= T_QUP;
        if (t < T_KVUP) { const int l = t / (4 * 8), r = t % (4 * 8), kt = r / 8, nt = r % 8;
            tr_tile(F, F.in[I_WKVUP] + (size_t)l * 256 * 2048, 2048, 2, kt * 64, WSP(bf16_t, WS_WKVUP) + (size_t)l * 2048 * 256, 256, nt * 256, F.in[I_BKVN] + l * 256); continue; }
        t -= T_KVUP;
        if (t < T_BR) { const int l = t / (4 * 128), r = t % (4 * 128), br = r / 128, r2 = r % 128, kt = r2 / 8, nt = r2 % 8;
            const float* src = (br == 0 ? F.in[I_WBRA] : br == 1 ? F.in[I_WBRB] : br == 2 ? F.in[I_WBRC] : F.in[I_WBRD]) + (size_t)l * 1024 * 2048;
            tr_tile(F, src, 2048, 3, kt * 64, WSP(bf16_t, WS_WBR) + ((size_t)l * 4 + br) * 2048 * 1024, 1024, nt * 256); continue; }
        t -= T_BR;
        { const int l = t / 256, r = t % 256, kt = r / 8, nt = r % 8;
            tr_tile(F, F.in[I_WO] + (size_t)l * 2048 * 2048, 2048, 3, kt * 64, WSP(bf16_t, WS_WO) + (size_t)l * 2048 * 2048, 2048, nt * 256); }
    }
    for (int u = F.bid; u < 2 * 16 * 32; u += F.G) {
        const int l = u / 512, g = (u % 512) / 32, d0 = (u % 32) * 64;
        LAS float* sk = (LAS float*)F.lds; LAS float* wt = (LAS float*)(F.lds + 128 * 129 * 4);
        const float* skg = F.in[I_PSK] + ((size_t)l * 16 + g) * 128 * 128;
        const float* wqg = F.in[I_PWQ] + (size_t)l * 2048 * 2048 + (size_t)d0 * 2048 + g * 128;
        for (int i = F.tid; i < 128 * 128; i += 512) sk[(i >> 7) * 129 + (i & 127)] = skg[i];
        for (int i = F.tid; i < 64 * 128; i += 512) wt[(i >> 7) * 129 + (i & 127)] = wqg[(size_t)(i >> 7) * 2048 + (i & 127)];
        __syncthreads();
        const int n = F.tid & 127, dg = F.tid >> 7;
        float a[16];
#pragma unroll
        for (int e = 0; e < 16; ++e) a[e] = 0.f;
        for (int k = 0; k < 128; ++k) { const float s = sk[n * 129 + k];
#pragma unroll
            for (int e = 0; e < 16; ++e) a[e] += wt[(dg * 16 + e) * 129 + k] * s; }
        bf16_t* dst = WSP(bf16_t, WS_WFOLD) + (size_t)l * 2048 * 2048 + (size_t)(g * 128 + n) * 2048 + d0 + dg * 16;
        u32x4 w0, w1;
        w0.x = cvt_pk_bf16(a[0], a[1]); w0.y = cvt_pk_bf16(a[2], a[3]); w0.z = cvt_pk_bf16(a[4], a[5]); w0.w = cvt_pk_bf16(a[6], a[7]);
        w1.x = cvt_pk_bf16(a[8], a[9]); w1.y = cvt_pk_bf16(a[10], a[11]); w1.z = cvt_pk_bf16(a[12], a[13]); w1.w = cvt_pk_bf16(a[14], a[15]);
        *(u32x4*)dst = w0; *(u32x4*)(dst + 8) = w1;
        __syncthreads();
    }
    for (int u = F.bid; u < 2 * 192; u += F.G) {
        const int l = u / 192, n0 = (u % 192) * 64;
        LAS float* sl = (LAS float*)F.lds; LAS float* red = (LAS float*)(F.lds + 5 * 2048 * 4);
        for (int i = F.tid; i < 5 * 2048; i += 512) { const int r = i >> 11, k = i & 2047; const float v = r < 4 ? F.in[I_C][r * 2048 + k] : F.in[I_CCTX][k]; sl[i] = v * sigmoidf_(v); }
        __syncthreads();
        const int cg = F.tid & 15, ks = F.tid >> 4;
        f32x4 a[5];
#pragma unroll
        for (int r = 0; r < 5; ++r) a[r] = (f32x4){0.f, 0.f, 0.f, 0.f};
        const float* wp = F.in[I_WADA] + (size_t)l * 2048 * 12288 + n0 + cg * 4;
#pragma unroll 8
        for (int k = ks * 64; k < ks * 64 + 64; ++k) { const f32x4 w = *(const f32x4*)(wp + (size_t)k * 12288);
#pragma unroll
            for (int r = 0; r < 5; ++r) a[r] += w * sl[r * 2048 + k]; }
#pragma unroll
        for (int r = 0; r < 5; ++r) *(LAS f32x4*)(red + (ks * 5 + r) * 64 + cg * 4) = a[r];
        __syncthreads();
        if (F.tid < 320) { const int r = F.tid >> 6, col = F.tid & 63; float sacc = 0.f;
#pragma unroll
            for (int k2 = 0; k2 < 32; ++k2) sacc += red[(k2 * 5 + r) * 64 + col];
            WSP(float, WS_MOD)[((size_t)l * 5 + r) * 12288 + n0 + col] = sacc + F.in[I_BADA][(size_t)l * 12288 + n0 + col]; }
        __syncthreads();
    }
    for (int i = F.bid * 512 + F.tid; i < 4096 * 64; i += F.G * 512) {
        const int pos = i >> 6, j = i & 63, fi = j & 31; const float fr = powf(10000.0f, -(float)(2 * fi) / 64.0f);
        const float ang = (float)(j < 32 ? (pos >> 6) : (pos & 63)) * fr;
        WSP(float, WS_COSH)[i] = cosf(ang); WSP(float, WS_SINH)[i] = sinf(ang);
    }
    for (int i = F.bid * 512 + F.tid; i < 4096 * 32; i += F.G * 512) {
        const int pos = i >> 5, j = i & 31, fi = j & 15; const float fr = powf(10000.0f, -(float)(2 * fi) / 32.0f);
        const float ang = (float)(j < 16 ? (pos >> 6) : (pos & 63)) * fr;
        WSP(float, WS_COSR)[i] = cosf(ang); WSP(float, WS_SINR)[i] = sinf(ang);
    }
    cvt_rows_fp8(F, F.in[I_PU], WSP(unsigned char, WS_UB), (size_t)2 * NEXP * 2048 / 16, 1024.f);
    cvt_rows_fp4(F, F.in[I_PV], WSP(unsigned char, WS_VB2), (size_t)2 * NEXP * 64);
}

__device__ __forceinline__ void ph_modulate0(const Ctx& F0) {
    const Ctx F = phase_ctx(F0);
    using namespace cf;
    const float* mod = WSP(float, WS_MOD);
    for (size_t i = (size_t)F.bid * 512 + F.tid; i < (size_t)MR * 256; i += (size_t)F.G * 512) {
        const int R = (int)(i >> 8), d = (int)(i & 255) * 8, b = R / RB, j = R % RB;
        const float* src = j < CTX ? F.in[I_CTX] + ((size_t)b * CTX + j) * 2048 : F.in[I_X] + ((size_t)b * S + (j - CTX)) * 2048;
        const float* m = mod + (size_t)(j < CTX ? 4 : b) * 12288;
        const f32x4 x0 = *(const f32x4*)(src + d), x1 = *(const f32x4*)(src + d + 4);
        const f32x4 sh0 = *(const f32x4*)(m + d), sh1 = *(const f32x4*)(m + d + 4), s0 = *(const f32x4*)(m + 2048 + d), s1 = *(const f32x4*)(m + 2048 + d + 4);
        *(u32x4*)(WSP(bf16_t, WS_HB) + (size_t)R * 2048 + d) = pg8::pack8(x0 * (s0 + 1.0f) + sh0, x1 * (s1 + 1.0f) + sh1);
    }
}

__device__ __forceinline__ void knorm_pass(const Ctx& F) {
    using namespace cf;
    bf16_t* P = WSP(bf16_t, WS_P); const float* ssk = WSP(const float, WS_SSK);
    for (int it = F.bid * 8 + F.wave; it < MR * 2; it += F.G * 8) {
        const int R = it >> 1, h = it & 1;
        const f32x2 pp = *(const f32x2*)(ssk + (size_t)it * 2); const float r = rsqrtf((pp.x + pp.y) * (1.f / 128.f) + 1e-6f);
        unsigned* q = (unsigned*)(P + (size_t)R * NC + PC_AK + h * 128) + F.lane;
        const unsigned w = *q; *q = cvt_pk_bf16(bflo(w) * r, bfhi(w) * r);
    }
}

struct AttnArgs {
    const bf16_t* Q; const bf16_t* K; const bf16_t* V; bf16_t* O; int ldq, ldk, ldv, ldo;
    int seg0_row, seg0_tiles, seg1_row, seg1_tiles;
    int mask_on, qpos0, kpos1;
    float sc_log2; int has_sink; float sink_l2;
    int variant;
    const float* qss;
};
typedef float f32x16 __attribute__((ext_vector_type(16)));
template <int DK, bool MASKED>
__device__ __forceinline__ void attn_unit(ldsp_t lds, const AttnArgs a, int wave_) {
    constexpr int ND = DK / 16, KCH = DK / 8, KPT = (64 * KCH) / 512, VST = 72, KM = DK == 128 ? 15 : 7;
    constexpr int KBUF = 64 * DK * 2, VBUF = 128 * VST * 2, VOFF = 2 * KBUF, ALOFF = VOFF + 3 * VBUF;
    int tid = wave_ * 64 + lane_id(); asm volatile("" : "+v"(tid));
    const int wid = __builtin_amdgcn_readfirstlane(tid >> 6), lane = tid & 63, q32 = lane & 31, hi = lane >> 5;
    LAS float* al = (LAS float*)(lds + ALOFF + wid * 128);
    bf16x8 qf[ND];
    { float scq = a.sc_log2;
      if (a.qss) { const f32x2 pp = *(const f32x2*)(a.qss + (size_t)(wid * 32 + q32) * 16); scq *= rsqrtf((pp.x + pp.y) * (1.f / 128.f) + 1e-6f); }
      const bf16_t* qrow = a.Q + (size_t)(wid * 32 + q32) * a.ldq + 8 * hi;
#pragma unroll
      for (int s = 0; s < ND; ++s) { const u32x4 w = *(const u32x4*)(qrow + 16 * s); u32x4 o;
          o.x = cvt_pk_bf16(bflo(w.x) * scq, bfhi(w.x) * scq); o.y = cvt_pk_bf16(bflo(w.y) * scq, bfhi(w.y) * scq);
          o.z = cvt_pk_bf16(bflo(w.z) * scq, bfhi(w.z) * scq); o.w = cvt_pk_bf16(bflo(w.w) * scq, bfhi(w.w) * scq); qf[s] = *(bf16x8*)&o; } }
    f32x16 o[4];
#pragma unroll
    for (int db = 0; db < 4; ++db)
#pragma unroll
        for (int r = 0; r < 16; ++r) o[db][r] = 0.f;
    float m_run = -1e30f, l_run = 0.f;
    const int PV_ = MK_AV ? a.variant : 0;
    const int ntiles = a.seg0_tiles + a.seg1_tiles;
    u32x4 vreg[2];
    const int vkp = tid & 31, vdc = tid >> 5;
    const int vkey = 2 * vkp, vpos = (vkey & 48) | ((vkey & 4) << 1) | ((vkey & 8) >> 1) | (vkey & 3);
    unsigned koff[KPT];
#pragma unroll
    for (int i = 0; i < KPT; ++i) { const int P = (i * 8 + wid) * 64 + lane, row = P / KCH, cp = P % KCH; koff[i] = (unsigned)(row * a.ldk + 8 * (cp ^ (row & KM))) * 2u; }
#define ATT_LOAD(tt, kb) do { const int _r0 = (tt) < a.seg0_tiles ? a.seg0_row + 64 * (tt) : a.seg1_row + 64 * ((tt) - a.seg0_tiles); \
        const char* _kg = (const char*)(a.K + (size_t)_r0 * a.ldk); \
        _Pragma("unroll") for (int _i = 0; _i < KPT; ++_i) __builtin_amdgcn_global_load_lds((const unsigned*)(_kg + koff[_i]), (LAS unsigned*)(lds + (kb) * KBUF + (_i * 8 + wid) * 1024), 16, 0, 0); \
        vreg[0] = *(const u32x4*)(a.V + (size_t)(_r0 + 2 * vkp) * a.ldv + 8 * vdc); vreg[1] = *(const u32x4*)(a.V + (size_t)(_r0 + 2 * vkp + 1) * a.ldv + 8 * vdc); } while (0)
#define ATT_WRITE(vb) do { const ldsp_t _vb = lds + VOFF + (vb) * VBUF; \
        const unsigned _a0[4] = {vreg[0].x, vreg[0].y, vreg[0].z, vreg[0].w}, _a1[4] = {vreg[1].x, vreg[1].y, vreg[1].z, vreg[1].w}; \
        _Pragma("unroll") for (int _e = 0; _e < 4; ++_e) { \
            *(LAS unsigned*)(_vb + ((8 * vdc + 2 * _e) * VST + vpos) * 2) = (_a0[_e] & 0xffffu) | (_a1[_e] << 16); \
            *(LAS unsigned*)(_vb + ((8 * vdc + 2 * _e + 1) * VST + vpos) * 2) = (_a0[_e] >> 16) | (_a1[_e] & 0xffff0000u); } } while (0)
#define ATT_PV(vb) do { const ldsp_t _vt = lds + VOFF + (vb) * VBUF; \
        _Pragma("unroll") for (int db = 0; db < 4; ++db) _Pragma("unroll") for (int ks = 0; ks < 4; ++ks) { \
            const bf16x8 vf = *(const LAS bf16x8*)(_vt + ((32 * db + q32) * VST + 16 * ks + 8 * hi) * 2); \
            o[db] = __builtin_amdgcn_mfma_f32_32x32x16_bf16(pa[ks], vf, o[db], 0, 0, 0); } } while (0)
    bf16x8 pa[4];
#pragma unroll
    for (int i = 0; i < 4; ++i) pa[i] = (bf16x8){0, 0, 0, 0, 0, 0, 0, 0};
    int vprev = 2, vcur = 0, vnext = 1;
    { unsigned z0 = 0u; asm volatile("" : "+v"(z0));
      for (int i = tid; i < VBUF / 16; i += 512) *(LAS u32x4*)(lds + VOFF + 2 * VBUF + i * 16) = (u32x4){z0, z0, z0, z0}; }
    ATT_LOAD(0, 0);
    ATT_WRITE(0);
    asm volatile("s_waitcnt vmcnt(0)" ::: "memory");
    __syncthreads();
    for (int tt = 0; tt < ntiles; ++tt) {
        const int cur = tt & 1;
        if (tt + 1 < ntiles && PV_ != 4) ATT_LOAD(tt + 1, cur ^ 1);
        const ldsp_t Ks = lds + cur * KBUF;
        f32x16 s0, s1;
#pragma unroll
        for (int r = 0; r < 16; ++r) { s0[r] = 0.f; s1[r] = 0.f; }
        { bf16x8 kf[2][2];
#define ATT_LDK(p, sb) do { kf[p][0] = *(const LAS bf16x8*)(Ks + (q32 * KCH + ((2 * (sb) + hi) ^ (q32 & KM))) * 16); kf[p][1] = *(const LAS bf16x8*)(Ks + ((32 + q32) * KCH + ((2 * (sb) + hi) ^ (q32 & KM))) * 16); } while (0)
          if (PV_ != 2) {
          ATT_LDK(0, 0);
#pragma unroll
          for (int sb = 0; sb < ND; ++sb) {
              if (sb + 1 < ND) ATT_LDK((sb + 1) & 1, sb + 1);
              s0 = __builtin_amdgcn_mfma_f32_32x32x16_bf16(kf[sb & 1][0], qf[sb], s0, 0, 0, 0);
              s1 = __builtin_amdgcn_mfma_f32_32x32x16_bf16(kf[sb & 1][1], qf[sb], s1, 0, 0, 0);
              }
          }
#undef ATT_LDK
        }
        const bool msk = MASKED && a.mask_on && tt >= a.seg0_tiles;
        if (MASKED) { const int kp0 = a.kpos1 + 64 * (tt - a.seg0_tiles) + 4 * hi, qp = a.qpos0 + wid * 32 + q32;
#pragma unroll
            for (int r = 0; r < 16; ++r) { float t0 = s0[r], t1 = s1[r];
                if (msk) { const int d0 = qp - (kp0 + (r & 3) + 8 * (r >> 2)), d1 = d0 - 32; if (d0 > 128 || d0 < -128) t0 = -1e30f; if (d1 > 128 || d1 < -128) t1 = -1e30f; s0[r] = t0; s1[r] = t1; } }
            __builtin_amdgcn_sched_barrier(0); }
        float mx = -1e30f, m_new = 0.f, alpha = 1.f, ps = 0.f;
        bf16x8 pn[4] = {pa[0], pa[1], pa[2], pa[3]};
        { const ldsp_t _vt = lds + VOFF + vprev * VBUF; bf16x8 vfr[3]; vfr[2] = pa[0];
#define ATT_LDV(i) (*(const LAS bf16x8*)(_vt + ((32 * ((i) >> 2) + q32) * VST + 16 * ((i) & 3) + 8 * hi) * 2))
#define SCV(e) ((e) < 16 ? s0[(e) & 15] : s1[(e) & 15])
          vfr[0] = ATT_LDV(0); vfr[1] = ATT_LDV(1);
#pragma unroll
          for (int i = 0; i < 16; ++i) {
              if (PV_ != 3) { if (i + 2 < 16) vfr[(i + 2) % 3] = ATT_LDV(i + 2);
              o[i >> 2] = __builtin_amdgcn_mfma_f32_32x32x16_bf16(pa[i & 3], vfr[i % 3], o[i >> 2], 0, 0, 0); }
              if (PV_ == 1) {} else if (i < 4) {
#pragma unroll
                  for (int e = 0; e < 4; ++e) mx = fmaxf(mx, fmaxf(s0[4 * i + e], s1[4 * i + e]));
              } else if (i == 4) {
                  mx = fmaxf(mx, shx(mx, 32, lane)); m_new = fmaxf(m_run, mx); alpha = __builtin_amdgcn_exp2f(m_run - m_new); m_run = m_new;
              } else if (i < 13) {
#pragma unroll
                  for (int e = 0; e < 2; ++e) { const int r = 2 * (i - 5) + e; s0[r] = __builtin_amdgcn_exp2f(s0[r] - m_new); s1[r] = __builtin_amdgcn_exp2f(s1[r] - m_new); ps += s0[r] + s1[r]; }
              } else if (i == 13) {
                  u32x4 w; w.x = cvt_pk_bf16(s0[0], s0[1]); w.y = cvt_pk_bf16(s0[2], s0[3]); w.z = cvt_pk_bf16(s0[4], s0[5]); w.w = cvt_pk_bf16(s0[6], s0[7]); pn[0] = *(bf16x8*)&w;
                  u32x4 v; v.x = cvt_pk_bf16(s0[8], s0[9]); v.y = cvt_pk_bf16(s0[10], s0[11]); v.z = cvt_pk_bf16(s0[12], s0[13]); v.w = cvt_pk_bf16(s0[14], s0[15]); pn[1] = *(bf16x8*)&v;
              } else if (i == 14) {
                  u32x4 w; w.x = cvt_pk_bf16(s1[0], s1[1]); w.y = cvt_pk_bf16(s1[2], s1[3]); w.z = cvt_pk_bf16(s1[4], s1[5]); w.w = cvt_pk_bf16(s1[6], s1[7]); pn[2] = *(bf16x8*)&w;
                  u32x4 v; v.x = cvt_pk_bf16(s1[8], s1[9]); v.y = cvt_pk_bf16(s1[10], s1[11]); v.z = cvt_pk_bf16(s1[12], s1[13]); v.w = cvt_pk_bf16(s1[14], s1[15]); pn[3] = *(bf16x8*)&v;
              } else { l_run = l_run * alpha + ps; }
          }
#undef ATT_LDV
#undef SCV
        }
#pragma unroll
        for (int i = 0; i < 4; ++i) pa[i] = pn[i];
        if (__any(alpha < 1.0f)) {
            if (hi == 0) al[q32] = alpha;
            asm volatile("s_waitcnt lgkmcnt(0)" ::: "memory");
#pragma unroll
            for (int g4 = 0; g4 < 4; ++g4) { const f32x4 av = *(const LAS f32x4*)(al + 8 * g4 + 4 * hi);
#pragma unroll
                for (int db = 0; db < 4; ++db)
#pragma unroll
                    for (int j = 0; j < 4; ++j) o[db][4 * g4 + j] *= av[j]; }
        }
        if (tt + 1 < ntiles && PV_ != 4) ATT_WRITE(vnext);
        { const int t3 = vprev; vprev = vcur; vcur = vnext; vnext = t3; }
        asm volatile("s_waitcnt vmcnt(0)" ::: "memory");
        if (PV_ != 5) __syncthreads();
    }
    ATT_PV(vprev);
#undef ATT_LOAD
#undef ATT_WRITE
#undef ATT_PV
    __syncthreads();
    float l_tot = l_run + shx(l_run, 32, lane);
    if (a.has_sink) l_tot += __builtin_amdgcn_exp2f(a.sink_l2 - m_run);
    if (hi == 0) al[q32] = 1.0f / l_tot;
    asm volatile("s_waitcnt lgkmcnt(0)" ::: "memory");
    const ldsp_t Ost = lds + wid * 8192;
#pragma unroll
    for (int g4 = 0; g4 < 4; ++g4) { const f32x4 iv = *(const LAS f32x4*)(al + 8 * g4 + 4 * hi);
#pragma unroll
        for (int db = 0; db < 4; ++db)
#pragma unroll
            for (int j = 0; j < 4; ++j) *(LAS bf16_t*)(Ost + ((8 * g4 + 4 * hi + j) * 128 + 32 * db + q32) * 2) = f2bf(o[db][4 * g4 + j] * iv[j]); }
    asm volatile("s_waitcnt lgkmcnt(0)" ::: "memory");
    const int lane_o = lane_id();
#pragma unroll
    for (int i = 0; i < 8; ++i) { const int c = lane_o + 64 * i, row = c >> 4, c8 = c & 15;
        *(u32x4*)(a.O + (size_t)(wid * 32 + row) * a.ldo + 8 * c8) = *(const LAS u32x4*)(Ost + (row * 128 + 8 * c8) * 2); }
}

__device__ __forceinline__ void conv_unit(const Ctx& F, int layer, int row0  , int seq_len, int t0) {
    using namespace cf;
    const bf16_t* P = WSP(const bf16_t, WS_P); bf16_t* BR = WSP(bf16_t, WS_BR);
    const float* cw = F.in[I_CW] + (size_t)layer * 31 * 1024; const float* cb = F.in[I_CB] + layer * 1024;
    const float* lg = F.in[I_CLG] + layer * 1024; const float* lb = F.in[I_CLB] + layer * 1024;
    int tid = F.wave * 64 + lane_id(); asm volatile("" : "+v"(tid));
    const int lane = tid & 63;
    LAS float* red = (LAS float*)(F.lds + 126976); LAS float* tot = red + 8 * 32;
    __syncthreads();
    for (int c = tid; c < 62 * 128; c += 512) { const int rr = c >> 7, ch = c & 127, t = t0 - 15 + rr;
        u32x4 v = {0u, 0u, 0u, 0u};
        if (t >= 0 && t < seq_len) v = *(const u32x4*)(P + (size_t)(row0 + t) * NC + PC_GLU + ch * 8);
        *(LAS u32x4*)(F.lds + rr * 2048 + ch * 16) = v; }
    float w0[31], w1[31];
#pragma unroll
    for (int k = 0; k < 31; ++k) { const f32x2 w = *(const f32x2*)(cw + k * 1024 + 2 * tid); w0[k] = w.x; w1[k] = w.y; }
    const f32x2 bv = *(const f32x2*)(cb + 2 * tid), gg = *(const f32x2*)(lg + 2 * tid), bb = *(const f32x2*)(lb + 2 * tid);
    __syncthreads();
#pragma unroll 1
    for (int part = 0; part < 4; ++part) {
        float a0[8], a1[8];
#pragma unroll
        for (int t = 0; t < 8; ++t) { a0[t] = bv.x; a1[t] = bv.y; }
        const ldsp_t base = F.lds + part * 8 * 2048 + tid * 4;
#pragma unroll
        for (int rr = 0; rr < 38; ++rr) { const unsigned xw = *(const LAS unsigned*)(base + rr * 2048); const float x0 = bflo(xw), x1 = bfhi(xw);
#pragma unroll
            for (int t = 0; t < 8; ++t) { const int k = rr - t; if (k >= 0 && k <= 30) { a0[t] += x0 * w0[k]; a1[t] += x1 * w1[k]; } } }
        float v[16];
#pragma unroll
        for (int t = 0; t < 8; ++t) { v[t] = a0[t] + a1[t]; v[8 + t] = a0[t] * a0[t] + a1[t] * a1[t]; }
#pragma unroll
        for (int i = 0; i < 8; ++i) { const bool up = lane & 32; const float snd = up ? v[i] : v[i + 8], kp = up ? v[i + 8] : v[i]; v[i] = kp + shx(snd, 32, lane); }
#pragma unroll
        for (int i = 0; i < 4; ++i) { const bool up = lane & 16; const float snd = up ? v[i] : v[i + 4], kp = up ? v[i + 4] : v[i]; v[i] = kp + shx(snd, 16, lane); }
#pragma unroll
        for (int i = 0; i < 2; ++i) { const bool up = lane & 8; const float snd = up ? v[i] : v[i + 2], kp = up ? v[i + 2] : v[i]; v[i] = kp + shx(snd, 8, lane); }
        { const bool up = lane & 4; const float snd = up ? v[0] : v[1], kp = up ? v[1] : v[0]; v[0] = kp + shx(snd, 4, lane); }
        v[0] += shx(v[0], 2, lane); v[0] += shx(v[0], 1, lane);
        if ((lane & 3) == 0) red[F.wave * 16 + (lane >> 2)] = v[0];
        __syncthreads();
        if (tid < 16) { float s = 0.f;
#pragma unroll
            for (int w = 0; w < 8; ++w) s += red[w * 16 + tid];
            tot[tid] = s; }
        __syncthreads();
#pragma unroll
        for (int t = 0; t < 8; ++t) { const float mean = tot[t] * (1.f / 1024.f), var = fmaxf(tot[8 + t] * (1.f / 1024.f) - mean * mean, 0.f), rstd = rsqrtf(var + 1e-5f);
            const float y0 = (a0[t] - mean) * rstd * gg.x + bb.x, y1 = (a1[t] - mean) * rstd * gg.y + bb.y;
            *(unsigned*)(BR + (size_t)(row0 + t0 + part * 8 + t) * 4096 + 2048 + 2 * tid) = cvt_pk_bf16(y0 * sigmoidf_(y0), y1 * sigmoidf_(y1)); }
    }
}

__device__ __forceinline__ void attn_defaults(AttnArgs& a, int isctx) {
    a.seg0_row = 0; a.seg0_tiles = isctx ? 4 : 68; a.seg1_row = 0; a.seg1_tiles = 0; a.mask_on = 0; a.qpos0 = 0; a.kpos1 = 0; a.has_sink = 0; a.sink_l2 = 0.f; a.qss = nullptr; a.variant = 0; }
__device__ __forceinline__ void attn_unit_decode(int u, int G, bool gqa, int& b, int& h, int& qb) {
    if (G != 256) { b = u >> 7; h = (u >> 4) & 7; qb = u & 15; return; }
    const int bid = u & 255, r = u >> 8, x = bid & 7, local = (bid >> 3) + 32 * r;
    qb = local & 15;
    if (gqa) { b = x >> 1; h = (x & 1) * 4 + (local >> 4); }
    else { const int pair = x * 4 + (local >> 4); b = pair >> 3; h = pair & 7; }
}
__device__ __forceinline__ void ph_attn(const Ctx& F0, int layer) {
    const Ctx F = phase_ctx(F0);
    using namespace cf;
    const bf16_t* P = WSP(const bf16_t, WS_P); bf16_t* BR = WSP(bf16_t, WS_BR);
    for (int dup = 0; dup < DUPN(2); ++dup)
    for (int u = F.bid; u < (layer == 0 ? 544 : 512); u += F.G) {
        int b, h, qb, isctx = 0;
        if (u < 512) attn_unit_decode(u, F.G, false, b, h, qb); else { const int r = u - 512; b = r >> 3; h = r & 7; qb = 0; isctx = 1; }
        const size_t brow = (size_t)b * RB, qrow = brow + (isctx ? 0 : CTX) + (size_t)qb * 256;
        AttnArgs a; attn_defaults(a, isctx);
        a.Q = WSP(const bf16_t, WS_QB) + qrow * 1536 + h * 192; a.ldq = 1536;
        a.K = WSP(const bf16_t, WS_KB) + brow * 1536 + h * 192; a.ldk = 1536;
        a.V = WSP(const bf16_t, WS_VB) + brow * 1024 + h * 128; a.ldv = 1024;
        a.O = BR + qrow * 4096 + 1024 + h * 128; a.ldo = 4096; a.sc_log2 = SCALE_MLA * LOG2E;
        __syncthreads();
        attn_unit<192, false>(F.lds, a, F.wave);
    }
    for (int dup = 0; dup < DUPN(3); ++dup)
    for (int u0 = F.bid; u0 < (layer == 0 ? 544 : 512); u0 += F.G) {
        int b, h, qb, isctx = 0;
        if (u0 < 512) attn_unit_decode(u0, F.G, true, b, h, qb); else { const int r = u0 - 512; b = r >> 3; h = r & 7; qb = 0; isctx = 1; }
        const size_t brow = (size_t)b * RB, qrow = brow + (isctx ? 0 : CTX) + (size_t)qb * 256;
        AttnArgs a; attn_defaults(a, isctx);
        a.Q = P + qrow * NC + PC_AQ + h * 128; a.ldq = NC;
        a.K = P + brow * NC + PC_AK + (h >> 2) * 128; a.ldk = NC;
        a.V = P + brow * NC + PC_AV + (h >> 2) * 128; a.ldv = NC;
        a.O = BR + qrow * 4096 + h * 128; a.ldo = 4096; a.sc_log2 = SCALE_HD * LOG2E;
        a.qss = WSP(const float, WS_SSQ) + qrow * 16 + h * 2;
        if (MK_AV && dup == 1) { a.variant = MK_AV; a.O = WSP(bf16_t, WS_HB) + qrow * 2048 + h * 128; a.ldo = 2048; }
        __syncthreads();
        attn_unit<128, false>(F.lds, a, F.wave);
    }
    for (int dup = 0; dup < DUPN(13); ++dup)
    for (int u0 = F.bid; u0 < (layer == 0 ? 544 : 512); u0 += F.G) {
        int b, h, qb, isctx = 0;
        if (u0 < 512) attn_unit_decode(u0, F.G, true, b, h, qb); else { const int r = u0 - 512; b = r >> 3; h = r & 7; qb = 0; isctx = 1; }
        const size_t brow = (size_t)b * RB, qrow = brow + (isctx ? 0 : CTX) + (size_t)qb * 256;
        AttnArgs a; attn_defaults(a, isctx);
        a.Q = P + qrow * NC + PC_DQ + h * 128; a.ldq = NC;
        a.K = P + brow * NC + PC_DK + (h >> 2) * 128; a.ldk = NC;
        a.V = P + brow * NC + PC_DV + (h >> 2) * 128; a.ldv = NC;
        a.O = BR + qrow * 4096 + 3072 + h * 128; a.ldo = 4096; a.sc_log2 = SCALE_HD * LOG2E;
        a.has_sink = 1; a.sink_l2 = F.in[I_SINK][layer * 8 + h] * LOG2E; a.seg0_tiles = 4;
        if (!isctx) { const int start = qb * 256; const int lo = start - 128 < 0 ? 0 : start - 128, hi = start + 384 > S ? S : start + 384;
            a.seg1_row = CTX + lo; a.seg1_tiles = (hi - lo) / 64; a.mask_on = 1; a.qpos0 = start; a.kpos1 = lo; }
        __syncthreads();
        attn_unit<128, true>(F.lds, a, F.wave);
    }
    for (int dup = 0; dup < DUPN(4); ++dup)
    for (int u = F.bid; u < (layer == 0 ? 544 : 512); u += F.G) {
        int b, tb, isctx = 0;
        if (u < 512) { b = u >> 7; tb = u & 127; } else { const int r = u - 512; b = r >> 3; tb = r & 7; isctx = 1; }
        conv_unit(F, layer, b * RB + (isctx ? 0 : CTX), isctx ? CTX : S, tb * 32);
    }
}

__device__ __forceinline__ int tok_row(int layer, int tok) { return layer == 0 ? tok : (tok >> 12) * cf::RB + cf::CTX + (tok & 4095); }
__device__ __forceinline__ void ph_ln1(const Ctx& F0, int layer) {
    const Ctx F = phase_ctx(F0);
    using namespace cf;
    float* X1 = (float*)(F.ws + WS_P + X1_OFF); bf16_t* HB = WSP(bf16_t, WS_HB);
    const float* lg = F.in[I_LN1G] + layer * 2048; const float* lb = F.in[I_LN1B] + layer * 2048;
    const int ntok = layer == 0 ? MR : NB * S, lane = F.lane;
    for (int tok = F.bid * 8 + F.wave; tok < ntok; tok += F.G * 8) {
        const int R = tok_row(layer, tok), b = R / RB, j = R % RB;
        const float* mod = WSP(const float, WS_MOD) + ((size_t)layer * 5 + (j < CTX ? 4 : b)) * 12288;
        float* xp = X1 + (size_t)R * 2048;
        f32x4 v[8]; float s = 0.f;
#pragma unroll
        for (int i = 0; i < 8; ++i) { v[i] = *(const f32x4*)(xp + lane * 4 + 256 * i); s += (v[i][0] + v[i][1]) + (v[i][2] + v[i][3]); }
        const float mean = wave_sum(s, lane) * (1.f / 2048.f); float q = 0.f;
#pragma unroll
        for (int i = 0; i < 8; ++i) { const f32x4 d = v[i] - mean; q += (d[0] * d[0] + d[1] * d[1]) + (d[2] * d[2] + d[3] * d[3]); }
        const float rstd = rsqrtf(wave_sum(q, lane) * (1.f / 2048.f) + 1e-5f);
#pragma unroll
        for (int i = 0; i < 8; ++i) { const int c = lane * 4 + 256 * i;
            const f32x4 y = (v[i] - mean) * rstd * *(const f32x4*)(lg + c) + *(const f32x4*)(lb + c);
            *(f32x4*)(xp + c) = y;
            const f32x4 hp = y * (*(const f32x4*)(mod + 4 * 2048 + c) + 1.0f) + *(const f32x4*)(mod + 3 * 2048 + c);
            u32x2 w; w.x = cvt_pk_bf16(hp[0], hp[1]); w.y = cvt_pk_bf16(hp[2], hp[3]);
            *(u32x2*)(HB + (size_t)R * 2048 + c) = w; }
    }
}

typedef __bf16 bf16x2_t __attribute__((ext_vector_type(2)));
__device__ __forceinline__ unsigned ordkey(float v) { const unsigned u = __float_as_uint(v); return (u & 0x80000000u) ? ~u : (u | 0x80000000u); }
__device__ __forceinline__ int lane_rank(unsigned long long m) { return (int)__builtin_amdgcn_mbcnt_hi((unsigned)(m >> 32), __builtin_amdgcn_mbcnt_lo((unsigned)m, 0u)); }
template <int NV> __device__ __forceinline__ unsigned radix_thresh16(const unsigned (&k)[NV]) {
    unsigned T = 0u;
    for (int bit = 31; bit >= 0; --bit) { const unsigned cand = T | (1u << bit); int cnt = 0;
#pragma unroll
        for (int v = 0; v < NV; ++v) cnt += __popcll(__ballot(k[v] >= cand));
        if (cnt >= 16) { T = cand; if (cnt == 16) break; } }
    return T;
}
__device__ __forceinline__ void radix_thresh16x2(const unsigned (&ka)[2], const unsigned (&kb)[2], unsigned& Ta, unsigned& Tb) {
    unsigned T0 = 0u, T1 = 0u; bool d0 = false, d1 = false;
    for (int bit = 31; bit >= 0; --bit) { const unsigned c0 = T0 | (1u << bit), c1 = T1 | (1u << bit);
        const int n0 = __popcll(__ballot(ka[0] >= c0)) + __popcll(__ballot(ka[1] >= c0)), n1 = __popcll(__ballot(kb[0] >= c1)) + __popcll(__ballot(kb[1] >= c1));
        if (!d0 && n0 >= 16) { T0 = c0; d0 = n0 == 16; }
        if (!d1 && n1 >= 16) { T1 = c1; d1 = n1 == 16; }
        if (d0 && d1) break; }
    Ta = T0; Tb = T1;
}
__device__ __forceinline__ float dot2bf(unsigned a, unsigned b, float acc) { return __builtin_amdgcn_fdot2_f32_bf16(__builtin_bit_cast(bf16x2_t, a), __builtin_bit_cast(bf16x2_t, b), acc, false); }
__device__ __forceinline__ float dot8(const u32x4 a, const u32x4 b, float acc) {
    acc = dot2bf(a.x, b.x, acc); acc = dot2bf(a.y, b.y, acc); acc = dot2bf(a.z, b.z, acc); acc = dot2bf(a.w, b.w, acc);
    return acc;
}
__device__ __forceinline__ float gelu_as(float v) {
    const float av = fabsf(v), t = __builtin_amdgcn_rcpf(av * 0.2316418882f + 1.0f);
    float q = t * 0.5307027145f + (-0.7265760135f); q = q * t + 0.7107068705f; q = q * t + (-0.142248368f); q = q * t + 0.127414796f; q = q * t;
    const float e = __builtin_amdgcn_exp2f((v * v) * (-0.72134752044f)), m = v * (q * e);
    return v < 0.f ? m : v - m;
}
__device__ __forceinline__ void peer_load(u32x4 (&ur)[4][2], u32x4 (&vr)[4], unsigned (&vs)[4], float (&gq)[4], const LAS int* ei, const LAS float* eg,
                                          const unsigned char* U8, const unsigned char* V4, int lane, int grp) {
#pragma unroll
    for (int q = 0; q < 4; ++q) { const int id = __builtin_amdgcn_readfirstlane(ei[grp * 4 + q]); gq[q] = __uint_as_float(__builtin_amdgcn_readfirstlane(__float_as_uint(eg[grp * 4 + q])));
        ur[q][0] = *(const u32x4*)(U8 + (size_t)id * 2048 + lane * 16); ur[q][1] = *(const u32x4*)(U8 + (size_t)id * 2048 + lane * 16 + 1024);
        vr[q] = *(const u32x4*)(V4 + (size_t)id * V4_ROW + lane * 16); vs[q] = V4[(size_t)id * V4_ROW + 1024 + lane]; }
}
__device__ __forceinline__ void peer_comp(const u32x4 (&ur)[4][2], const u32x4 (&vr)[4], const unsigned (&vs)[4], const float (&gq)[4], const f32x2 (&xf)[16], f32x2 (&y2)[16], int lane) {
    float d[4];
#pragma unroll
    for (int q = 0; q < 4; ++q) { f32x2 t = {0.f, 0.f};
#pragma unroll
        for (int i = 0; i < 2; ++i)
#pragma unroll
            for (int j = 0; j < 4; ++j) { const int w = (int)ur[q][i][j];
                t += __builtin_amdgcn_cvt_pk_f32_fp8(w, false) * xf[8 * i + 2 * j]; t += __builtin_amdgcn_cvt_pk_f32_fp8(w, true) * xf[8 * i + 2 * j + 1]; }
        d[q] = t.x + t.y; }
#pragma unroll
    for (int o = 32; o >= 1; o >>= 1) {
#pragma unroll
        for (int q = 0; q < 4; ++q) d[q] += shx(d[q], o, lane); }
#pragma unroll
    for (int q = 0; q < 4; ++q) { const float dd = d[q] * (1.0f / 1024.0f); const float w = gq[q] * gelu_as(dd) * __uint_as_float(vs[q] << 23);
        const f32x2 w2 = {w, w};
#pragma unroll
        for (int j = 0; j < 4; ++j) { const unsigned vw = vr[q][j];
            y2[4 * j + 0] += w2 * __builtin_amdgcn_cvt_scalef32_pk_f32_fp4(vw, 1.0f, 0); y2[4 * j + 1] += w2 * __builtin_amdgcn_cvt_scalef32_pk_f32_fp4(vw, 1.0f, 1);
            y2[4 * j + 2] += w2 * __builtin_amdgcn_cvt_scalef32_pk_f32_fp4(vw, 1.0f, 2); y2[4 * j + 3] += w2 * __builtin_amdgcn_cvt_scalef32_pk_f32_fp4(vw, 1.0f, 3); } }
}
__device__ __forceinline__ unsigned inv_ordkey(unsigned k) { return (k & 0x80000000u) ? (k & 0x7fffffffu) : ~k; }
template <int N, int GRP> __device__ __forceinline__ unsigned lane_radix16(const unsigned (&key)[N], int lane) {
    unsigned T = 0u; bool done = false;
    for (int bit = 31; bit >= 0; --bit) { const unsigned cand = T | (1u << bit); int cnt = 0;
#pragma unroll
        for (int n = 0; n < N; ++n) cnt += key[n] >= cand ? 1 : 0;
        if (GRP >= 2) cnt += __builtin_amdgcn_ds_bpermute((lane ^ 1) << 2, cnt);
        if (GRP >= 4) cnt += __builtin_amdgcn_ds_bpermute((lane ^ 2) << 2, cnt);
        if (!done && cnt >= 16) { T = cand; done = cnt == 16; }
        if (__all(done)) break; }
    return T;
}
__device__ __forceinline__ void ph_peer(const Ctx& F0, int layer) {
    const Ctx F = phase_ctx(F0);
    using namespace cf;
    const float* SC = (const float*)(F.ws + WS_P + SC_OFF); const float* X1 = (const float*)(F.ws + WS_P + X1_OFF);
    bf16_t* HB = WSP(bf16_t, WS_HB); const unsigned char* U8 = WSP(const unsigned char, WS_UB) + (size_t)layer * NEXP * 2048; const unsigned char* V4 = WSP(const unsigned char, WS_VB2) + (size_t)layer * NEXP * V4_ROW;
    const float* lg = F.in[I_LN2G] + layer * 2048; const float* lb = F.in[I_LN2B] + layer * 2048;
    const int ntok = layer == 0 ? MR : NB * S;
    ldsp_t wl = F.lds + F.wave * 8192;
    LAS float* lstv = (LAS float*)wl; LAS int* lsti = (LAS int*)(wl + 2176);
    LAS float* es4 = (LAS float*)(wl + 4352); LAS int* ei4 = (LAS int*)(wl + 5376); LAS float* eg4 = (LAS float*)(wl + 6400);
    const int nwv = F.G * 8;
    for (int tok0 = F.bid * 8 + F.wave; tok0 < ntok; tok0 += 2 * nwv) {
        { int lane = F.lane; asm volatile("" : "+v"(lane));
          const int t2 = lane >> 5, set = lane >> 1, sset = set & 15, part = lane & 1;
          int tokl = tok0 + t2 * nwv; if (tokl >= ntok) tokl = tok0;
          const int Rl = tok_row(layer, tokl);
          unsigned key[64];
          const float* sp = SC + (size_t)Rl * 2048 + sset * 128 + part * 64;
#pragma unroll
          for (int i = 0; i < 16; ++i) { const f32x4 v = *(const f32x4*)(sp + 4 * i);
#pragma unroll
              for (int e = 0; e < 4; ++e) key[4 * i + e] = (ordkey(v[e]) & ~127u) | (unsigned)(127 - (64 * part + 4 * i + e)); }
          const unsigned T = lane_radix16<64, 2>(key, lane);
          int c = 0;
#pragma unroll
          for (int n = 0; n < 64; ++n) { if (key[n] >= T) { const int r = set * 17 + (part ? 15 - c : c); lstv[r] = __uint_as_float(inv_ordkey((key[n] & ~127u) | 64u)); lsti[r] = 64 * part + n; ++c; }
              if ((n & 15) == 15) __builtin_amdgcn_sched_barrier(0); }
        }
        asm volatile("s_waitcnt lgkmcnt(0)" ::: "memory");
        {
          int lane = F.lane; asm volatile("" : "+v"(lane));
          const int t2 = lane >> 5, hq = (lane >> 2) & 7, q = lane & 3, sa = (lane >> 2) * 2, sb = sa + 1;
          float Av[4], Bv[16]; int Ai[4], Bi[16];
#pragma unroll
          for (int i = 0; i < 4; ++i) { Av[i] = lstv[sa * 17 + 4 * q + i]; Ai[i] = lsti[sa * 17 + 4 * q + i]; }
#pragma unroll
          for (int jx = 0; jx < 16; ++jx) { Bv[jx] = lstv[sb * 17 + jx]; Bi[jx] = lsti[sb * 17 + jx]; }
          unsigned key[64];
#pragma unroll
          for (int i = 0; i < 4; ++i)
#pragma unroll
              for (int jx = 0; jx < 16; ++jx) key[i * 16 + jx] = (ordkey(Av[i] + Bv[jx]) & ~255u) | (unsigned)(255 - ((4 * q + i) * 16 + jx));
          const unsigned T = lane_radix16<64, 4>(key, lane);
          int mine = 0;
#pragma unroll
          for (int n = 0; n < 64; ++n) mine += key[n] >= T ? 1 : 0;
          const int c1 = __builtin_amdgcn_ds_bpermute((lane ^ 1) << 2, mine), c2 = __builtin_amdgcn_ds_bpermute((lane ^ 2) << 2, mine), c3 = __builtin_amdgcn_ds_bpermute((lane ^ 3) << 2, mine);
          int c = (q == 1) ? c1 : (q == 2) ? c2 + c3 : (q == 3) ? c1 + c2 + c3 : 0;
#pragma unroll
          for (int i = 0; i < 4; ++i) {
#pragma unroll
              for (int jx = 0; jx < 16; ++jx) if (key[i * 16 + jx] >= T) { const int r = t2 * 128 + hq * 16 + c; es4[r] = Av[i] + Bv[jx]; ei4[r] = Ai[i] * 128 + Bi[jx]; ++c; }
              __builtin_amdgcn_sched_barrier(0); }
        }
        asm volatile("s_waitcnt lgkmcnt(0)" ::: "memory");
        { int lane = F.lane; asm volatile("" : "+v"(lane));
#pragma unroll
        for (int rnd = 0; rnd < 4; ++rnd) { const int e = lane + 64 * rnd; const float s = es4[e];
            float m = s; m = fmaxf(m, shx(m, 1, lane)); m = fmaxf(m, shx(m, 2, lane)); m = fmaxf(m, shx(m, 4, lane)); m = fmaxf(m, shx(m, 8, lane));
            const float ex = __expf(s - m); float sum = ex; sum += shx(sum, 1, lane); sum += shx(sum, 2, lane); sum += shx(sum, 4, lane); sum += shx(sum, 8, lane);
            eg4[e] = ex / sum; } }
        asm volatile("s_waitcnt lgkmcnt(0)" ::: "memory");
      for (int tslot = 0; tslot < 2; ++tslot) {
        const int tok = tok0 + tslot * nwv; if (tok >= ntok) break;
        int lane = F.lane; asm volatile("" : "+v"(lane));
        const int R = tok_row(layer, tok), b = R / RB, j = R % RB; const bool isctx = j < CTX; const int modrow = isctx ? 4 : b;
        const LAS int* ei = ei4 + tslot * 128; const LAS float* eg = eg4 + tslot * 128;
        f32x2 xf[16];
#pragma unroll
        for (int i = 0; i < 2; ++i)
#pragma unroll
            for (int hh = 0; hh < 2; ++hh) { const u32x4 w = *(const u32x4*)(HB + (size_t)R * 2048 + lane * 16 + 1024 * i + 8 * hh);
                xf[8 * i + 4 * hh + 0] = (f32x2){bflo(w.x), bfhi(w.x)}; xf[8 * i + 4 * hh + 1] = (f32x2){bflo(w.y), bfhi(w.y)};
                xf[8 * i + 4 * hh + 2] = (f32x2){bflo(w.z), bfhi(w.z)}; xf[8 * i + 4 * hh + 3] = (f32x2){bflo(w.w), bfhi(w.w)}; }
        f32x2 y2[16];
#pragma unroll
        for (int i = 0; i < 16; ++i) y2[i] = (f32x2){0.f, 0.f};
        f32x4 xrow[8];
#pragma unroll
        for (int k = 0; k < 8; ++k) xrow[k] = *(const f32x4*)(X1 + (size_t)R * 2048 + lane * 32 + 4 * k);
        { u32x4 urA[4][2], vrA[4], urB[4][2], vrB[4]; unsigned vsA[4], vsB[4]; float gqA[4], gqB[4];
          peer_load(urA, vrA, vsA, gqA, ei, eg, U8, V4, lane, 0);
          for (int grp = 0; grp < 32; grp += 2) {
              peer_load(urB, vrB, vsB, gqB, ei, eg, U8, V4, lane, grp + 1);
              peer_comp(urA, vrA, vsA, gqA, xf, y2, lane);
              peer_load(urA, vrA, vsA, gqA, ei, eg, U8, V4, lane, grp + 2 < 32 ? grp + 2 : 31);
              peer_comp(urB, vrB, vsB, gqB, xf, y2, lane);
          } }
        const float* mod = WSP(const float, WS_MOD) + ((size_t)layer * 5 + modrow) * 12288;
        float y[32];
        float s = 0.f;
#pragma unroll
        for (int k = 0; k < 8; ++k) { const int c = lane * 32 + 4 * k;
            const f32x4 xa = xrow[k], ga = *(const f32x4*)(mod + 5 * 2048 + c);
            y[4 * k + 0] = ALPHA * xa[0] + ga[0] * y2[2 * k].x; y[4 * k + 1] = ALPHA * xa[1] + ga[1] * y2[2 * k].y;
            y[4 * k + 2] = ALPHA * xa[2] + ga[2] * y2[2 * k + 1].x; y[4 * k + 3] = ALPHA * xa[3] + ga[3] * y2[2 * k + 1].y;
            s += (y[4 * k + 0] + y[4 * k + 1]) + (y[4 * k + 2] + y[4 * k + 3]); }
        const float mean = wave_sum(s, lane) * (1.f / 2048.f); float q2 = 0.f;
#pragma unroll
        for (int i = 0; i < 32; ++i) { const float dd = y[i] - mean; q2 += dd * dd; }
        const float rstd = rsqrtf(wave_sum(q2, lane) * (1.f / 2048.f) + 1e-5f);
        float* dst = layer == 0 ? (isctx ? WSP(float, WS_XC) + ((size_t)b * CTX + j) * 2048 : F.out + ((size_t)b * S + (j - CTX)) * 2048) : F.out + ((size_t)b * S + (j - CTX)) * 2048;
        const float* modn = WSP(const float, WS_MOD) + ((size_t)1 * 5 + modrow) * 12288;
#pragma unroll
        for (int kk = 0; kk < 4; ++kk) { f32x4 o[2];
#pragma unroll
            for (int jj = 0; jj < 2; ++jj) { const int k = 2 * kk + jj, c = lane * 32 + 4 * k; const f32x4 la = *(const f32x4*)(lg + c), ba = *(const f32x4*)(lb + c);
#pragma unroll
                for (int e = 0; e < 4; ++e) o[jj][e] = (y[4 * k + e] - mean) * rstd * la[e] + ba[e];
                *(f32x4*)(dst + c) = o[jj]; }
            if (layer == 0) {
                const int c = lane * 32 + 8 * kk;
                const f32x4 sa = *(const f32x4*)(modn + 2048 + c), sb = *(const f32x4*)(modn + 2048 + c + 4), ha = *(const f32x4*)(modn + c), hb = *(const f32x4*)(modn + c + 4);
                *(u32x4*)(HB + (size_t)R * 2048 + c) = pg8::pack8(o[0] * (sa + 1.0f) + ha, o[1] * (sb + 1.0f) + hb); } }
      }
    }
}

struct Params { const float* in[cf::N_IN]; float* out; unsigned char* ws; int ph_lo, ph_hi; };

__global__ void __launch_bounds__(512, 2) mega_fwd(Params p) {
    using namespace cf;
    extern __shared__ __attribute__((aligned(16))) unsigned char smem[];
    Ctx F0;
    F0.in = p.in;
    F0.out = p.out; F0.ws = p.ws; F0.lds = (ldsp_t)smem;
    F0.tid = 0; F0.lane = 0; F0.wave = __builtin_amdgcn_readfirstlane(threadIdx.x >> 6); F0.G = gridDim.x; F0.bid = blockIdx.x;
    if (threadIdx.x < 64) ((LAS unsigned*)(F0.lds + MISC_OFF))[threadIdx.x] = 0u;
    __syncthreads();
    const int lo = p.ph_lo, hi = p.ph_hi;
    XcdBarrier bar; bar.bar = (unsigned*)(F0.ws + WS_CTL); bar.x = 0; bar.st = (volatile LAS unsigned*)(F0.lds + MISC_OFF); bar.wave = F0.wave;
    if (hi - lo > 1) bar = xcd_barrier_post((unsigned*)(F0.ws + WS_CTL), (volatile LAS unsigned*)(F0.lds + MISC_OFF), F0.wave);
#ifndef MK_MASK
#define MK_MASK 0xFFFF
#endif
#define ON(j) ((MK_MASK >> (j)) & 1)
#define IN(k) (lo <= (k) && (k) < hi)
#define SEAM(k) do { if (IN(k) && IN((k) + 1)) xcd_barrier(bar); } while (0)

    if (ON(9) && IN(0)) { ph_prologue(F0); if (DUPN(9) == 2) { __syncthreads(); ph_prologue(F0); } }
    SEAM(0);
    if (ON(10) && IN(1)) ph_modulate0(F0);
    SEAM(1);
    for (int l = 0; l < DEPTH; ++l) {
        const int pb = 2 + 8 * l;
        const int rmode = l == 0 ? 0 : 1, nMl = l == 0 ? 68 : 64;
        for (int blk = 0; blk < DUPN(12); ++blk) {
        if (blk) xcd_barrier(bar);
        if (ON(0) && IN(pb + 0)) { const Ctx F = phase_ctx(F0);
            pg8::Gemm g{WSP(const bf16_t, WS_HB), WSP(const bf16_t, WS_WIN) + (size_t)l * NC * 2048, 2048, 2048};
            pg8::EpiInProj E{WSP(bf16_t, WS_P), WSP(bf16_t, WS_KB), WSP(const float, WS_COSH), WSP(const float, WS_SINH), WSP(const float, WS_COSR), WSP(const float, WS_SINR),
                             F.in[I_AKN] + l * 128, F.in[I_AQN] + l * 128, WSP(float, WS_SSK), WSP(float, WS_SSQ), WSP(float, WS_SSKV), WSP(float, WS_SSCQ)};
            pg8::TileOrder S; S.init(nMl, 56, F.G, F.bid, rmode);
            for (int dup = 0; dup < DUPN(0); ++dup)
            pg8::gemm_phase(F.lds, g, S, E, F.wave);
            if (l > 0) { pg8::TileOrder S2; S2.init(4, 6, F.G, F.bid, 2); pg8::gemm_phase(F.lds, g, S2, E, F.wave); }
        }
        SEAM(pb + 0);
        if (ON(2) && IN(pb + 1)) { const Ctx F = phase_ctx(F0); bf16_t* P = WSP(bf16_t, WS_P);
            knorm_pass(F);
            { pg8::Gemm g{P + PC_CKV, WSP(const bf16_t, WS_WKVUP) + (size_t)l * 2048 * 256, NC, 256}; pg8::EpiKvUp E{WSP(bf16_t, WS_KB), WSP(bf16_t, WS_VB), WSP(const float, WS_SSKV)};
              pg8::TileOrder S; S.init(68, 8, F.G, F.bid, 0); for (int dup = 0; dup < DUPN(1); ++dup) pg8::gemm_phase(F.lds, g, S, E, F.wave); }
            { pg8::Gemm g{P + PC_CQ, WSP(const bf16_t, WS_WQUP) + (size_t)l * 1536 * 512, NC, 512}; pg8::EpiQUp E{WSP(bf16_t, WS_QB), WSP(const float, WS_COSR), WSP(const float, WS_SINR), WSP(const float, WS_SSCQ)};
              pg8::TileOrder S; S.init(nMl, 6, F.G, F.bid, rmode); for (int dup = 0; dup < DUPN(1); ++dup) pg8::gemm_phase(F.lds, g, S, E, F.wave); }
        }
        SEAM(pb + 1);
        if (ON(3) && IN(pb + 2)) ph_attn(F0, l);
        }
        SEAM(pb + 2);
        if (ON(4) && IN(pb + 3)) { const Ctx F = phase_ctx(F0); bf16_t* P = WSP(bf16_t, WS_P); bf16_t* HB = WSP(bf16_t, WS_HB);
            pg8::Gemm g{WSP(const bf16_t, WS_BR), WSP(const bf16_t, WS_WBR) + (size_t)l * 4 * 2048 * 1024, 4096, 1024};
            pg8::EpiMerge E{HB, P + PC_GATE, NC};
            pg8::TileOrder S; S.init(nMl, 8, F.G, F.bid, rmode, 4, (size_t)1024 * 2, (size_t)2048 * 1024 * 2);
            for (int dup = 0; dup < DUPN(5); ++dup) pg8::gemm_phase(F.lds, g, S, E, F.wave);
        }
        SEAM(pb + 3);
        if (ON(5) && IN(pb + 4)) { const Ctx F = phase_ctx(F0); bf16_t* HB = WSP(bf16_t, WS_HB);
            pg8::Gemm g{HB, WSP(const bf16_t, WS_WO) + (size_t)l * 2048 * 2048, 2048, 2048};
            pg8::EpiWo E{(float*)(F.ws + WS_P + X1_OFF), WSP(const float, WS_MOD) + (size_t)l * 5 * 12288, l == 0 ? F.in[I_X] : (const float*)F.out, F.in[I_CTX]};
            pg8::TileOrder S; S.init(nMl, 8, F.G, F.bid, rmode); for (int dup = 0; dup < DUPN(6); ++dup) pg8::gemm_phase(F.lds, g, S, E, F.wave);
        }
        SEAM(pb + 4);
        if (ON(6) && IN(pb + 5)) ph_ln1(F0, l);
        SEAM(pb + 5);
        if (ON(7) && IN(pb + 6)) { const Ctx F = phase_ctx(F0); bf16_t* HB = WSP(bf16_t, WS_HB);
            pg8::Gemm g{HB, WSP(const bf16_t, WS_WFOLD) + (size_t)l * 2048 * 2048, 2048, 2048}; pg8::EpiF32 E{(float*)(F.ws + WS_P + SC_OFF), 2048};
            pg8::TileOrder S; S.init(nMl, 8, F.G, F.bid, rmode); for (int dup = 0; dup < DUPN(7); ++dup) pg8::gemm_phase(F.lds, g, S, E, F.wave);
        }
        SEAM(pb + 6);
        if (ON(8) && IN(pb + 7)) { ph_peer(F0, l); if (DUPN(8) == 2 && l == 1) ph_peer(F0, l); }
        SEAM(pb + 7);
    }
#undef IN
#undef SEAM
}

extern "C" void kernel_launch(void* const* d_in, const int* in_sizes, int n_in, void* d_out, int out_size, void* d_ws, size_t ws_size, hipStream_t stream) {
    static int grid = 0;
    if (grid == 0) {
        if (n_in != cf::N_IN || out_size != cf::NB * cf::S * cf::D || ws_size < cf::WS_END) {
            fprintf(stderr, "kernel_launch: unexpected shapes: n_in %d out %d ws %zu (need %zu)\n", n_in, out_size, ws_size, (size_t)cf::WS_END); grid = -1; return; }
        int dev = 0, cus = 0;
        if (hipGetDevice(&dev) != hipSuccess || hipDeviceGetAttribute(&cus, hipDeviceAttributeMultiprocessorCount, dev) != hipSuccess || cus < 1) { grid = -1; return; }
        if (hipFuncSetAttribute((const void*)mega_fwd, hipFuncAttributeMaxDynamicSharedMemorySize, cf::LDS_BYTES) != hipSuccess) { fprintf(stderr, "kernel_launch: hipFuncSetAttribute failed\n"); grid = -1; return; }
        int per_cu = 0;
        if (hipOccupancyMaxActiveBlocksPerMultiprocessor(&per_cu, (const void*)mega_fwd, 512, cf::LDS_BYTES) != hipSuccess || per_cu < 1)
            fprintf(stderr, "kernel_launch: note: occupancy query reports %d workgroups per CU\n", per_cu);
        (void)hipGetLastError();
        grid = cus;
    }
    if (grid < 0) return;
    (void)hipMemsetAsync((char*)d_ws + cf::WS_CTL, 0, cf::CTL_BYTES, stream);
    Params p{};
    for (int i = 0; i < cf::N_IN; ++i) p.in[i] = (const float*)d_in[i];
    p.out = (float*)d_out; p.ws = (unsigned char*)d_ws;
#if MK_PER_PHASE
    for (int k = 0; k < cf::N_PHASES; ++k) { p.ph_lo = k; p.ph_hi = k + 1; hipLaunchKernelGGL(mega_fwd, dim3(grid), dim3(512), cf::LDS_BYTES, stream, p); }
#else
    p.ph_lo = 0; p.ph_hi = cf::N_PHASES;
    hipLaunchKernelGGL(mega_fwd, dim3(grid), dim3(512), cf::LDS_BYTES, stream, p);
#endif
    const hipError_t le = hipPeekAtLastError();
    if (le != hipSuccess) fprintf(stderr, "kernel_launch: launch failed: %s\n", hipGetErrorName(le));
}
```

```cpp
#include <hip/hip_runtime.h>
#include <stdint.h>
#include <stdio.h>

#ifndef MK_DUP
#define MK_DUP 0
#endif
#define DUPN(k) (((MK_DUP >> (k)) & 1) ? 2 : 1)
#ifndef MK_AV
#define MK_AV 0
#endif
#ifndef MK_PER_PHASE
#define MK_PER_PHASE 0
#endif

namespace cf {
constexpr int D = 2048, NB = 4, S = 4096, CTX = 256, RB = CTX + S  , MR = NB * RB  ;
constexpr int DEPTH = 2;
constexpr int PC_AK = 0, PC_AV = 256, PC_CKV = 512, PC_KR = 768, PC_DK = 1024, PC_DV = 1280, PC_KVEND = 1536;
constexpr int PC_AQ = 1536, PC_CQ = 2560, PC_DQ = 3072, PC_GLU = 4096, PC_GATE = 6144, NC = 14336;
constexpr int IN_COLS = 14144;
constexpr int NEXP = 16384;
constexpr float ALPHA = 1.4142135623730951f;
constexpr float LOG2E = 1.4426950408889634f;
constexpr float SCALE_HD = 0.08838834764831845f;
constexpr float SCALE_MLA = 0.07216878364870323f;
enum { I_X = 0, I_C, I_CTX, I_CCTX, I_WADA, I_BADA, I_WIN, I_AQN, I_AKN, I_BQN, I_WQUP, I_BKVN, I_WKVUP, I_CW, I_CB, I_CLG, I_CLB, I_SINK,
       I_WBRA, I_WBRB, I_WBRC, I_WBRD, I_WO, I_LN1G, I_LN1B, I_LN2G, I_LN2B, I_PWQ, I_PSK, I_PU, I_PV, N_IN };
constexpr size_t al(size_t x) { return (x + 255) / 256 * 256; }
constexpr size_t WS_CTL = 0;
constexpr size_t CTL_BYTES = 65536;
constexpr size_t WS_MOD = WS_CTL + CTL_BYTES;
constexpr size_t WS_COSH = WS_MOD + al((size_t)2 * 5 * 12288 * 4);
constexpr size_t WS_SINH = WS_COSH + (size_t)4096 * 64 * 4;
constexpr size_t WS_COSR = WS_SINH + (size_t)4096 * 64 * 4;
constexpr size_t WS_SINR = WS_COSR + (size_t)4096 * 32 * 4;
constexpr size_t WS_WIN = WS_SINR + (size_t)4096 * 32 * 4;
constexpr size_t WS_WQUP = WS_WIN + (size_t)2 * NC * 2048 * 2;
constexpr size_t WS_WKVUP = WS_WQUP + (size_t)2 * 1536 * 512 * 2;
constexpr size_t WS_WBR = WS_WKVUP + (size_t)2 * 2048 * 256 * 2;
constexpr size_t WS_WO = WS_WBR + (size_t)2 * 4 * 2048 * 1024 * 2;
constexpr size_t WS_WFOLD = WS_WO + (size_t)2 * 2048 * 2048 * 2;
constexpr size_t WS_UB = WS_WFOLD + (size_t)2 * 2048 * 2048 * 2;
constexpr size_t WS_VB2 = WS_UB + (size_t)2 * NEXP * 2048;
constexpr size_t WS_HB = WS_VB2 + (size_t)2 * NEXP * 2048;
constexpr size_t WS_P = WS_HB + (size_t)MR * 2048 * 2;
constexpr size_t WS_QB = WS_P + (size_t)MR * NC * 2;
constexpr size_t WS_KB = WS_QB + (size_t)MR * 1536 * 2;
constexpr size_t WS_VB = WS_KB + (size_t)MR * 1536 * 2;
constexpr size_t WS_BR = WS_VB + (size_t)MR * 1024 * 2;
constexpr size_t WS_XC = WS_BR + (size_t)MR * 4096 * 2;
constexpr size_t WS_SSK = WS_XC + (size_t)1024 * 2048 * 4;
constexpr size_t WS_SSQ = WS_SSK + (size_t)MR * 4 * 4;
constexpr size_t WS_SSKV = WS_SSQ + (size_t)MR * 16 * 4;
constexpr size_t WS_SSCQ = WS_SSKV + (size_t)MR * 4 * 4;
constexpr size_t WS_END = WS_SSCQ + (size_t)MR * 8 * 4;
constexpr size_t X1_OFF = 0, SC_OFF = (size_t)MR * 2048 * 4;
static_assert(SC_OFF * 2 <= (size_t)MR * NC * 2, "X1 + SC fit in P");
constexpr int LDS_BYTES = 132 * 1024;
constexpr int MISC_OFF = 128 * 1024;
constexpr int N_PHASES = 2 + 8 * DEPTH;
}

typedef unsigned short bf16_t;
typedef short bf16x8 __attribute__((ext_vector_type(8)));
typedef float f32x4 __attribute__((ext_vector_type(4)));
typedef float f32x2 __attribute__((ext_vector_type(2)));
typedef unsigned u32x4 __attribute__((ext_vector_type(4)));
typedef unsigned u32x2 __attribute__((ext_vector_type(2)));
#define LAS __attribute__((address_space(3)))
typedef LAS unsigned char* ldsp_t;

typedef __bf16 bf16x2v_t __attribute__((ext_vector_type(2)));
__device__ __forceinline__ unsigned cvt_pk_bf16(float lo, float hi) { const bf16x2v_t r = __builtin_convertvector((f32x2){lo, hi}, bf16x2v_t); return __builtin_bit_cast(unsigned, r); }
__device__ __forceinline__ bf16_t f2bf(float f) { return (bf16_t)(cvt_pk_bf16(f, 0.f) & 0xffffu); }
__device__ __forceinline__ float bf2f(bf16_t b) { return __uint_as_float(((unsigned)b) << 16); }
__device__ __forceinline__ float bflo(unsigned w) { return __uint_as_float(w << 16); }
__device__ __forceinline__ float bfhi(unsigned w) { return __uint_as_float(w & 0xffff0000u); }
__device__ __forceinline__ float shx(float v, int mask, int lane) { return __int_as_float(__builtin_amdgcn_ds_bpermute((lane ^ mask) << 2, __float_as_int(v))); }
__device__ __forceinline__ float wave_sum(float v, int lane) {
#pragma unroll
    for (int o = 32; o >= 1; o >>= 1) v += shx(v, o, lane);
    return v;
}
__device__ __forceinline__ int lane_id() { int l; asm volatile("v_mbcnt_lo_u32_b32 %0, -1, 0\n\tv_mbcnt_hi_u32_b32 %0, -1, %0" : "=v"(l)); return l; }
__device__ __forceinline__ float sigmoidf_(float x) { return __builtin_amdgcn_rcpf(1.0f + __builtin_amdgcn_exp2f(x * -1.4426950408889634f)); }

#define XB_TMO      128
#define XB_XCNT(j)  (256  + 64 * (j))
#define XB_XSUB(j)  (1280 + 64 * (j))
#define XB_XGEN(j)  (2304 + 64 * (j))
#define XB_TOP      3328
#define XB_TOPGEN   3392
#define XCD_BAR_WORDS 3456
#define XB_SPIN_CAP (1u << 23)
__device__ __forceinline__ unsigned xb_ld(unsigned* p)              { return __hip_atomic_load(p, __ATOMIC_RELAXED, __HIP_MEMORY_SCOPE_AGENT); }
__device__ __forceinline__ unsigned xb_add(unsigned* p, unsigned v) { return __hip_atomic_fetch_add(p, v, __ATOMIC_RELAXED, __HIP_MEMORY_SCOPE_AGENT); }
__device__ __forceinline__ unsigned xb_xcc_id() { return (unsigned)__builtin_amdgcn_s_getreg((3 << 11) | 20) & 0xFu; }
#define XB_SPIN(cond, bar) do { unsigned _sp = 0; while (cond) { __builtin_amdgcn_s_sleep(1); \
    if ((++_sp & 255u) == 0u) { if (xb_ld(&(bar)[XB_TMO])) break; if (_sp > XB_SPIN_CAP) { atomicAdd(&(bar)[XB_TMO], 1u); break; } } } } while (0)
struct XcdBarrier { unsigned* bar; unsigned x; volatile LAS unsigned* st; int wave; };
__device__ __forceinline__ XcdBarrier xcd_barrier_post(unsigned* bar, volatile LAS unsigned* st, int wave) {
    XcdBarrier b; b.bar = bar; b.x = xb_xcc_id(); b.st = st; b.wave = wave;
    if (wave == 0 && lane_id() == 0) (void)xb_add(&bar[XB_XCNT(b.x)], 1u);
    return b;
}
__device__ __forceinline__ void xcd_barrier_complete(unsigned* bar, unsigned x, unsigned& nloc, unsigned& nx) {
    const unsigned G = gridDim.x * gridDim.y * gridDim.z;
    unsigned sum, cnt, mine, sp = 0u;
    for (;;) {
        sum = 0u; cnt = 0u; mine = 0u;
#pragma unroll
        for (unsigned j = 0; j < 16; ++j) { const unsigned c = xb_ld(&bar[XB_XCNT(j)]); sum += c; cnt += (c > 0u) ? 1u : 0u; mine = (j == x) ? c : mine; }
        if (sum == G) break;
        __builtin_amdgcn_s_sleep(1);
        if ((++sp & 255u) == 0u) { if (xb_ld(&bar[XB_TMO])) break; if (sp > XB_SPIN_CAP) { atomicAdd(&bar[XB_TMO], 1u); break; } }
    }
    nloc = mine > 0u ? mine : 1u; nx = cnt > 0u ? cnt : 1u;
}
__device__ __forceinline__ void xcd_barrier(const XcdBarrier& b) {
    asm volatile("s_waitcnt vmcnt(0)" ::: "memory");
    __syncthreads();
    if (b.wave == 0 && lane_id() == 0) {
        unsigned* bar = b.bar;
        __builtin_amdgcn_s_waitcnt(0);
        unsigned nloc = b.st[0], nx = b.st[1];
        if (nloc == 0u) { xcd_barrier_complete(bar, b.x, nloc, nx); b.st[0] = nloc; b.st[1] = nx; }
        const unsigned old = xb_add(&bar[XB_XSUB(b.x)], 1u);
        const unsigned gen = old / nloc;
        if (old + 1u == (gen + 1u) * nloc) {
            __builtin_amdgcn_fence(__ATOMIC_RELEASE, "agent");
            asm volatile("s_waitcnt vmcnt(0)" ::: "memory");
            const unsigned og = xb_add(&bar[XB_TOP], 1u);
            const unsigned tg = og / nx;
            if (og + 1u == (tg + 1u) * nx) xb_add(&bar[XB_TOPGEN], 1u);
            else XB_SPIN(xb_ld(&bar[XB_TOPGEN]) == tg, bar);
            __builtin_amdgcn_fence(__ATOMIC_ACQUIRE, "agent");
            xb_add(&bar[XB_XGEN(b.x)], 1u);
            asm volatile("s_waitcnt vmcnt(0)" ::: "memory");
        } else {
            XB_SPIN(xb_ld(&bar[XB_XGEN(b.x)]) == gen, bar);
            __builtin_amdgcn_fence(__ATOMIC_ACQUIRE, "agent");
            asm volatile("s_waitcnt vmcnt(0)" ::: "memory");
        }
    }
    __syncthreads();
}

namespace pg8 {
constexpr int BM = 256, BK = 64, HALF = 128, HTB = HALF * BK * 2, STAGE_BYTES = 8 * HTB, NXCD = 8, WGM = 8;
__host__ __device__ __forceinline__ int lds_byte(int r, int c) { const int st = (r >> 4) * 2 + (c >> 5), rr = r & 15, cc = c & 31, ob = rr * 64 + cc * 2; return st * 1024 + (ob ^ (((ob >> 9) & 1) << 5)); }
__host__ __device__ __forceinline__ void stage_rc(int b, int& R, int& C) { const int st = b / 1024, sb = b % 1024, swz = sb ^ (((sb >> 9) & 1) << 5); R = (st >> 1) * 16 + swz / 64; C = (st & 1) * 32 + (swz % 64) / 2; }
__host__ __device__ __forceinline__ int perm32(int rho) { const int n = rho >> 4, i = rho & 15; return 8 * (i >> 2) + 4 * n + (i & 3); }
struct Unit { int pm, pn, sub; };
struct Gemm { const bf16_t* A; const bf16_t* Bt; int lda, K; };

struct TileOrder {
    int nM, nN, nwg, G, c, mode, nsub; size_t subA, subB;
    __device__ void init(int nM_, int nN_, int G_, int c_, int mode_, int nsub_ = 1, size_t subA_ = 0, size_t subB_ = 0) { nM = nM_; nN = nN_; nwg = nM * nN; G = G_; c = c_; mode = mode_; nsub = nsub_; subA = subA_; subB = subB_; }
    __device__ bool next(int i, Unit& u) const {
        const int it = nsub == 1 ? i : i / nsub; u.sub = nsub == 1 ? 0 : i - it * nsub;
        const long L = (long)it * G + c; if (L >= nwg) return false;
        int wgid = (int)L; { const int q = nwg / NXCD, r = nwg % NXCD, xcd = wgid % NXCD, off = wgid / NXCD; wgid = (xcd < r ? xcd * (q + 1) : r * (q + 1) + (xcd - r) * q) + off; }
        const int nig = WGM * nN, gid = wgid / nig, fm = gid * WGM, gsz = (nM - fm) < WGM ? (nM - fm) : WGM;
        const int pl = fm + ((wgid % nig) % gsz); u.pn = (wgid % nig) / gsz;
        u.pm = mode == 0 ? pl : (mode == 1 ? 17 * (pl >> 4) + 1 + (pl & 15) : 17 * pl);
        return true;
    }
    __device__ __forceinline__ void a_ready(const Unit&) const {}
    __device__ __forceinline__ void done(const Unit&) const {}
};

template <class Epi, class Sched>
__device__ __forceinline__ void gemm_phase(ldsp_t lds, const Gemm g, const Sched& S, const Epi& E, int wave_) {
    int tid = wave_ * 64 + lane_id(); asm volatile("" : "+v"(tid));
    const int wid = __builtin_amdgcn_readfirstlane(tid >> 6), lane = tid & 63, wr = wid >> 2, wc = wid & 3, fr = lane & 15, fq = lane >> 4;
    int K = g.K; asm volatile("" : "+s"(K));
    const int nt = K / BK, lda = g.lda;
    unsigned voffA[2], voffB[2];
#pragma unroll
    for (int i = 0; i < 2; ++i) { int R, C; stage_rc(tid * 16 + i * 8192, R, C); const int Rb = (R & ~31) + perm32(R & 31);
        voffA[i] = (unsigned)(R * lda + C) * 2u; voffB[i] = (unsigned)(Rb * K + C) * 2u; }
    const size_t kstep = (size_t)(BK * 2);
    const size_t hstepA = (size_t)HALF * lda * 2, hstepB = (size_t)HALF * K * 2;
    const size_t tstepA = 2 * hstepA, tstepB = 2 * hstepB;
    const unsigned ldsw = (unsigned)wid * 1024u;
    const int aoff = lds_byte(wr * 64 + fr, fq * 8), boff = lds_byte(wc * 32 + fr, fq * 8);
#define PG8_SA(b, h) (((b) * 2 + (h)) * HTB)
#define PG8_SB(b, h) ((4 + (b) * 2 + (h)) * HTB)
#define PG8_STAGE(bufoff, gbase, voff) do { _Pragma("unroll") for (int _i = 0; _i < 2; ++_i) \
        __builtin_amdgcn_global_load_lds((const unsigned*)((const char*)(gbase) + (voff)[_i]), (LAS unsigned*)(lds + (bufoff) + ldsw + _i * 8192), 16, 0, 0); } while (0)
#define PG8_LDA(dst, b, h) do { _Pragma("unroll") for (int m = 0; m < 4; ++m) _Pragma("unroll") for (int k = 0; k < 2; ++k) dst[m][k] = *(const LAS bf16x8*)(lds + PG8_SA(b, h) + aoff + m * 2048 + k * 1024); } while (0)
#define PG8_LDB(dst, b, h) do { _Pragma("unroll") for (int n = 0; n < 2; ++n) _Pragma("unroll") for (int k = 0; k < 2; ++k) dst[n][k] = *(const LAS bf16x8*)(lds + PG8_SB(b, h) + boff + n * 2048 + k * 1024); } while (0)
#define PG8_MMA(ai, bj, At, Bt) do { __builtin_amdgcn_s_setprio(1); _Pragma("unroll") for (int m = 0; m < 4; ++m) _Pragma("unroll") for (int n = 0; n < 2; ++n) _Pragma("unroll") for (int k = 0; k < 2; ++k) \
        acc[ai][bj][m][n] = __builtin_amdgcn_mfma_f32_16x16x32_bf16(Bt[n][k], At[m][k], acc[ai][bj][m][n], 0, 0, 0); __builtin_amdgcn_s_setprio(0); } while (0)
#define PG8_WAIT_V(n) asm volatile("s_waitcnt vmcnt(" #n ")" ::: "memory")
#define PG8_WAIT_L(n) asm volatile("s_waitcnt lgkmcnt(" #n ")" ::: "memory")
#define PG8_BAR __builtin_amdgcn_s_barrier()
#define PG8_SCHED __builtin_amdgcn_sched_barrier(0)
    Unit cur, nxt; int ui = 0;
    if (!S.next(0, cur)) return;
    f32x4 acc[2][2][4][2];
#pragma unroll
    for (int a = 0; a < 2; ++a)
#pragma unroll
        for (int b = 0; b < 2; ++b)
#pragma unroll
            for (int m = 0; m < 4; ++m)
#pragma unroll
                for (int n = 0; n < 2; ++n) acc[a][b][m][n] = (f32x4){0.f, 0.f, 0.f, 0.f};
    bf16x8 At[4][2], B0[2][2], B1[2][2];
    const char* cA = (const char*)g.A + (size_t)cur.pm * tstepA + cur.sub * S.subA; const char* cB = (const char*)g.Bt + (size_t)cur.pn * tstepB + cur.sub * S.subB;
    S.a_ready(cur);
    PG8_STAGE(PG8_SB(0, 0), cB, voffB); PG8_STAGE(PG8_SA(0, 0), cA, voffA); PG8_STAGE(PG8_SB(0, 1), cB + hstepB, voffB); PG8_STAGE(PG8_SA(0, 1), cA + hstepA, voffA);
    if (wr == 1) PG8_BAR;
    PG8_WAIT_V(4); PG8_BAR;
    PG8_STAGE(PG8_SB(1, 0), cB + kstep, voffB); PG8_STAGE(PG8_SA(1, 0), cA + kstep, voffA); PG8_STAGE(PG8_SB(1, 1), cB + hstepB + kstep, voffB);
    PG8_WAIT_V(6); PG8_BAR;
    for (;;) {
        const bool has_next = S.next(ui + 1, nxt);
        const char* nA = has_next ? (const char*)g.A + (size_t)nxt.pm * tstepA + nxt.sub * S.subA : cA; const char* nB = has_next ? (const char*)g.Bt + (size_t)nxt.pn * tstepB + nxt.sub * S.subB : cB;
#pragma unroll 1
        for (int t = 0; t < nt; t += 2) {
            const bool last = (t == nt - 2);
            const char* a1 = cA + (size_t)(t + 1) * kstep;
            const char* a2 = last ? nA : cA + (size_t)(t + 2) * kstep; const char* b2 = last ? nB : cB + (size_t)(t + 2) * kstep;
            const char* a3 = a2 + kstep; const char* b3 = b2 + kstep;
            if (last && has_next) S.a_ready(nxt);
            PG8_LDB(B0, 0, 0); PG8_SCHED; PG8_LDA(At, 0, 0); PG8_STAGE(PG8_SA(1, 1), a1 + hstepA, voffA);
            PG8_WAIT_L(8); PG8_BAR; PG8_WAIT_L(0); PG8_MMA(0, 0, At, B0); PG8_BAR; PG8_SCHED;
            PG8_LDB(B1, 0, 1); PG8_STAGE(PG8_SB(0, 0), b2, voffB);
            PG8_BAR; PG8_WAIT_L(0); PG8_MMA(0, 1, At, B1); PG8_BAR;
            PG8_LDA(At, 0, 1); PG8_STAGE(PG8_SA(0, 0), a2, voffA);
            PG8_BAR; PG8_WAIT_L(0); PG8_MMA(1, 0, At, B0); PG8_BAR; PG8_SCHED;
            PG8_STAGE(PG8_SB(0, 1), b2 + hstepB, voffB);
            PG8_WAIT_V(6); PG8_BAR; PG8_MMA(1, 1, At, B1); PG8_BAR;
            PG8_LDB(B0, 1, 0); PG8_SCHED; PG8_LDA(At, 1, 0); PG8_STAGE(PG8_SA(0, 1), a2 + hstepA, voffA);
            PG8_WAIT_L(8); PG8_BAR; PG8_WAIT_L(0); PG8_MMA(0, 0, At, B0); PG8_BAR; PG8_SCHED;
            PG8_LDB(B1, 1, 1); PG8_STAGE(PG8_SB(1, 0), b3, voffB);
            PG8_BAR; PG8_WAIT_L(0); PG8_MMA(0, 1, At, B1); PG8_BAR;
            PG8_LDA(At, 1, 1); PG8_STAGE(PG8_SA(1, 0), a3, voffA);
            PG8_BAR; PG8_WAIT_L(0); PG8_MMA(1, 0, At, B0); PG8_BAR; PG8_SCHED;
            PG8_STAGE(PG8_SB(1, 1), b3 + hstepB, voffB);
            PG8_WAIT_V(6); PG8_BAR; PG8_MMA(1, 1, At, B1); PG8_BAR;
        }
        E(acc, cur, wr, wc, fr, fq); S.done(cur);
        if (!has_next) break;
#pragma unroll
        for (int a = 0; a < 2; ++a)
#pragma unroll
            for (int b = 0; b < 2; ++b)
#pragma unroll
                for (int m = 0; m < 4; ++m)
#pragma unroll
                    for (int n = 0; n < 2; ++n) acc[a][b][m][n] = (f32x4){0.f, 0.f, 0.f, 0.f};
        cur = nxt; cA = nA; cB = nB; ++ui;
    }
    PG8_WAIT_V(0);
    if (wr == 0) PG8_BAR;
    PG8_BAR;
#undef PG8_SA
#undef PG8_SB
#undef PG8_STAGE
#undef PG8_LDA
#undef PG8_LDB
#undef PG8_MMA
#undef PG8_WAIT_V
#undef PG8_WAIT_L
#undef PG8_BAR
#undef PG8_SCHED
}

__device__ __forceinline__ u32x4 pack8(const f32x4 a, const f32x4 b) { u32x4 w; w.x = cvt_pk_bf16(a[0], a[1]); w.y = cvt_pk_bf16(a[2], a[3]); w.z = cvt_pk_bf16(b[0], b[1]); w.w = cvt_pk_bf16(b[2], b[3]); return w; }
#define EPI_ARGS const f32x4 (&acc)[2][2][4][2], const Unit& u, int wr, int wc, int fr_, int fq_
#define EPI_LANE int fr = fr_, fq = fq_; asm volatile("" : "+v"(fr), "+v"(fq));

struct EpiBf16 {
    bf16_t* O; int ldc;
    __device__ __forceinline__ void operator()(EPI_ARGS) const {
        EPI_LANE
        const int row0 = u.pm * BM + wr * 64 + fr, col0 = u.pn * BM + wc * 32 + 8 * fq;
#pragma unroll
        for (int ai = 0; ai < 2; ++ai)
#pragma unroll
            for (int m = 0; m < 4; ++m) { bf16_t* rowp = O + (size_t)(row0 + ai * HALF + m * 16) * ldc + col0;
#pragma unroll
                for (int bj = 0; bj < 2; ++bj) *(u32x4*)(rowp + bj * HALF) = pack8(acc[ai][bj][m][0], acc[ai][bj][m][1]); }
    }
};
struct EpiF32 {
    float* C; int ldc;
    __device__ __forceinline__ void operator()(EPI_ARGS) const {
        EPI_LANE
        const int row0 = u.pm * BM + wr * 64 + fr, col0 = u.pn * BM + wc * 32 + 8 * fq;
#pragma unroll
        for (int ai = 0; ai < 2; ++ai)
#pragma unroll
            for (int m = 0; m < 4; ++m) { float* rowp = C + (size_t)(row0 + ai * HALF + m * 16) * ldc + col0;
#pragma unroll
                for (int bj = 0; bj < 2; ++bj) { *(f32x4*)(rowp + bj * HALF) = acc[ai][bj][m][0]; *(f32x4*)(rowp + bj * HALF + 4) = acc[ai][bj][m][1]; } }
    }
};
struct EpiInProj {
    bf16_t* P; bf16_t* KB; const float* cosh; const float* sinh; const float* cosr; const float* sinr; const float* akn; const float* aqn;
    float* ssk; float* ssq; float* sskv; float* sscq;
    __device__ __forceinline__ void operator()(EPI_ARGS) const {
        EPI_LANE
        const int pn = u.pn, tb = u.pm % 17; const bool lat = tb != 0; const int posbase = (tb - 1) * 256;
        const int rl0 = wr * 64 + fr;
        if (pn >= 24) {
            const int col0 = pn * BM + wc * 32 + 8 * fq;
#pragma unroll
            for (int ai = 0; ai < 2; ++ai)
#pragma unroll
                for (int m = 0; m < 4; ++m) { bf16_t* rowp = P + ((size_t)u.pm * BM + rl0 + ai * HALF + m * 16) * cf::NC + col0;
#pragma unroll
                    for (int bj = 0; bj < 2; ++bj) { f32x4 v0 = acc[ai][bj][m][0], v1 = acc[ai][bj][m][1];
#pragma unroll
                        for (int e = 0; e < 4; ++e) { v0[e] = sigmoidf_(v0[e]); v1[e] = sigmoidf_(v1[e]); }
                        *(u32x4*)(rowp + bj * HALF) = pack8(v0, v1); } }
        } else if (pn >= 16) {
            const int col0 = cf::PC_GLU + 128 * (pn - 16) + wc * 32 + 8 * fq;
#pragma unroll
            for (int ai = 0; ai < 2; ++ai)
#pragma unroll
                for (int m = 0; m < 4; ++m) { f32x4 v0 = acc[ai][0][m][0], v1 = acc[ai][0][m][1]; const f32x4 g0 = acc[ai][1][m][0], g1 = acc[ai][1][m][1];
#pragma unroll
                    for (int e = 0; e < 4; ++e) { v0[e] *= sigmoidf_(g0[e]); v1[e] *= sigmoidf_(g1[e]); }
                    *(u32x4*)(P + ((size_t)u.pm * BM + rl0 + ai * HALF + m * 16) * cf::NC + col0) = pack8(v0, v1); }
        } else if (pn == 3) {
            if (wc == 0) { const int i0 = 8 * fq;
#pragma unroll
                for (int ai = 0; ai < 2; ++ai)
#pragma unroll
                    for (int m = 0; m < 4; ++m) { const int rl = rl0 + ai * HALF + m * 16;
                        f32x4 c0 = {1.f, 1.f, 1.f, 1.f}, c1 = c0, s0 = {0.f, 0.f, 0.f, 0.f}, s1 = s0;
                        if (lat) { const float* cp = cosr + (size_t)(posbase + rl) * 32 + i0; const float* sp = sinr + (size_t)(posbase + rl) * 32 + i0;
                            c0 = *(const f32x4*)cp; c1 = *(const f32x4*)(cp + 4); s0 = *(const f32x4*)sp; s1 = *(const f32x4*)(sp + 4); }
                        const f32x4 x1a = acc[ai][0][m][0], x1b = acc[ai][0][m][1], x2a = acc[ai][1][m][0], x2b = acc[ai][1][m][1];
                        const u32x4 w1 = pack8(x1a * c0 - x2a * s0, x1b * c1 - x2b * s1), w2 = pack8(x2a * c0 + x1a * s0, x2b * c1 + x1b * s1);
                        bf16_t* kb = KB + ((size_t)u.pm * BM + rl) * 1536 + 128 + i0;
#pragma unroll
                        for (int h = 0; h < 8; ++h) { *(u32x4*)(kb + h * 192) = w1; *(u32x4*)(kb + h * 192 + 32) = w2; }
                        asm volatile("" ::: "memory"); } }
        } else if (pn == 0 || pn == 4 || (pn >= 6 && pn <= 9) || pn >= 12) {
            const bool norm = pn == 0 || (pn >= 6 && pn <= 9);
            const int hl = wc >> 1, i0 = 32 * (wc & 1) + 8 * fq;
            f32x4 g1a = {1.f, 1.f, 1.f, 1.f}, g1b = g1a, g2a = g1a, g2b = g1a;
            if (norm) { const float* gn = (pn == 0 ? akn : aqn) + i0; g1a = *(const f32x4*)gn; g1b = *(const f32x4*)(gn + 4); g2a = *(const f32x4*)(gn + 64); g2b = *(const f32x4*)(gn + 68); }
            float* ssp = pn == 0 ? ssk + ((size_t)u.pm * BM * 2 + hl) * 2 + (wc & 1) : ssq + ((size_t)u.pm * BM * 8 + (pn - 6) * 2 + hl) * 2 + (wc & 1);
            const int sstr = pn == 0 ? 4 : 16;
#pragma unroll
            for (int ai = 0; ai < 2; ++ai)
#pragma unroll
                for (int m = 0; m < 4; ++m) { const int rl = rl0 + ai * HALF + m * 16;
                    f32x4 x1a = acc[ai][0][m][0], x1b = acc[ai][0][m][1], x2a = acc[ai][1][m][0], x2b = acc[ai][1][m][1];
                    if (norm) { const f32x4 q = x1a * x1a + x1b * x1b + x2a * x2a + x2b * x2b; float ss = (q[0] + q[1]) + (q[2] + q[3]);
                        ss += shx(ss, 16, fr + 16 * fq); ss += shx(ss, 32, fr + 16 * fq);
                        if (fq == 0) ssp[(size_t)rl * sstr] = ss;
                        x1a *= g1a; x1b *= g1b; x2a *= g2a; x2b *= g2b; }
                    f32x4 o1a = x1a, o1b = x1b, o2a = x2a, o2b = x2b;
                    if (lat) { const float* cp = cosh + (size_t)(posbase + rl) * 64 + i0; const float* sp = sinh + (size_t)(posbase + rl) * 64 + i0;
                        const f32x4 c0 = *(const f32x4*)cp, c1 = *(const f32x4*)(cp + 4), s0 = *(const f32x4*)sp, s1 = *(const f32x4*)(sp + 4);
                        o1a = x1a * c0 - x2a * s0; o1b = x1b * c1 - x2b * s1; o2a = x2a * c0 + x1a * s0; o2b = x2b * c1 + x1b * s1; }
                    bf16_t* dst = P + ((size_t)u.pm * BM + rl) * cf::NC + pn * BM + hl * 128 + i0;
                    *(u32x4*)dst = pack8(o1a, o1b); *(u32x4*)(dst + 64) = pack8(o2a, o2b);
                    asm volatile("" ::: "memory"); }
        } else {
            const int col0 = pn * BM + wc * 32 + 8 * fq;
            const bool ssq_on = pn == 2 || pn == 10 || pn == 11;
            float* ssp = pn == 2 ? sskv + (size_t)u.pm * BM * 4 + wc : sscq + (size_t)u.pm * BM * 8 + (pn - 10) * 4 + wc;
            const int sstr = pn == 2 ? 4 : 8;
#pragma unroll
            for (int ai = 0; ai < 2; ++ai)
#pragma unroll
                for (int m = 0; m < 4; ++m) { const int rl = rl0 + ai * HALF + m * 16; bf16_t* rowp = P + ((size_t)u.pm * BM + rl) * cf::NC + col0;
#pragma unroll
                    for (int bj = 0; bj < 2; ++bj) *(u32x4*)(rowp + bj * HALF) = pack8(acc[ai][bj][m][0], acc[ai][bj][m][1]);
                    if (ssq_on) { const f32x4 q = acc[ai][0][m][0] * acc[ai][0][m][0] + acc[ai][0][m][1] * acc[ai][0][m][1] + acc[ai][1][m][0] * acc[ai][1][m][0] + acc[ai][1][m][1] * acc[ai][1][m][1];
                        float ss = (q[0] + q[1]) + (q[2] + q[3]); ss += shx(ss, 16, fr + 16 * fq); ss += shx(ss, 32, fr + 16 * fq);
                        if (fq == 0) ssp[(size_t)rl * sstr] = ss; } }
        }
    }
};
struct EpiKvUp {
    bf16_t* KB; bf16_t* VB; const float* sskv;
    __device__ __forceinline__ void operator()(EPI_ARGS) const {
        EPI_LANE
        const int row0 = u.pm * BM + wr * 64 + fr, d0 = wc * 32 + 8 * fq;
        const bool isk = u.pn < 4;
        bf16_t* base = isk ? KB + (2 * u.pn) * 192 + d0 : VB + (u.pn - 4) * 256 + d0;
        const int ldr = isk ? 1536 : 1024, bjs = isk ? 192 : 128;
#pragma unroll
        for (int ai = 0; ai < 2; ++ai)
#pragma unroll
            for (int m = 0; m < 4; ++m) { const size_t row = (size_t)(row0 + ai * HALF + m * 16); bf16_t* rowp = base + row * ldr;
                const f32x4 pp = *(const f32x4*)(sskv + row * 4); const float r = rsqrtf(((pp[0] + pp[1]) + (pp[2] + pp[3])) * (1.f / 256.f) + 1e-6f);
#pragma unroll
                for (int bj = 0; bj < 2; ++bj) *(u32x4*)(rowp + bj * bjs) = pack8(acc[ai][bj][m][0] * r, acc[ai][bj][m][1] * r); }
    }
};
struct EpiQUp {
    bf16_t* QB; const float* cosr; const float* sinr; const float* sscq;
    __device__ __forceinline__ void operator()(EPI_ARGS) const {
        EPI_LANE
        const int row0 = u.pm * BM + wr * 64 + fr;
        if (u.pn < 4) {
            const int d0 = wc * 32 + 8 * fq;
#pragma unroll
            for (int ai = 0; ai < 2; ++ai)
#pragma unroll
                for (int m = 0; m < 4; ++m) { const size_t row = (size_t)(row0 + ai * HALF + m * 16);
                    const f32x4 pa = *(const f32x4*)(sscq + row * 8), pb = *(const f32x4*)(sscq + row * 8 + 4);
                    const float r = rsqrtf((((pa[0] + pa[1]) + (pa[2] + pa[3])) + ((pb[0] + pb[1]) + (pb[2] + pb[3]))) * (1.f / 512.f) + 1e-6f);
#pragma unroll
                    for (int bj = 0; bj < 2; ++bj) *(u32x4*)(QB + row * 1536 + (2 * u.pn + bj) * 192 + d0) = pack8(acc[ai][bj][m][0] * r, acc[ai][bj][m][1] * r); }
        } else {
            const int head = 4 * (u.pn - 4) + wc, i0 = 8 * fq;
            const bool lat = (u.pm % 17) != 0; const int posbase = (u.pm % 17) * 256 - 256;
#pragma unroll
            for (int ai = 0; ai < 2; ++ai)
#pragma unroll
                for (int m = 0; m < 4; ++m) { const int rl = wr * 64 + fr + ai * HALF + m * 16; const size_t row = (size_t)u.pm * BM + rl;
                    const f32x4 pa = *(const f32x4*)(sscq + row * 8), pb = *(const f32x4*)(sscq + row * 8 + 4);
                    const float r = rsqrtf((((pa[0] + pa[1]) + (pa[2] + pa[3])) + ((pb[0] + pb[1]) + (pb[2] + pb[3]))) * (1.f / 512.f) + 1e-6f);
                    f32x4 c0 = {1.f, 1.f, 1.f, 1.f}, c1 = c0, s0 = {0.f, 0.f, 0.f, 0.f}, s1 = s0;
                    if (lat) { const float* cp = cosr + (size_t)(posbase + rl) * 32 + i0; const float* sp = sinr + (size_t)(posbase + rl) * 32 + i0;
                        c0 = *(const f32x4*)cp; c1 = *(const f32x4*)(cp + 4); s0 = *(const f32x4*)sp; s1 = *(const f32x4*)(sp + 4); }
                    const f32x4 x1a = acc[ai][0][m][0] * r, x1b = acc[ai][0][m][1] * r, x2a = acc[ai][1][m][0] * r, x2b = acc[ai][1][m][1] * r;
                    const f32x4 o1a = x1a * c0 - x2a * s0, o1b = x1b * c1 - x2b * s1, o2a = x2a * c0 + x1a * s0, o2b = x2b * c1 + x1b * s1;
                    bf16_t* dst = QB + row * 1536 + head * 192 + 128 + i0;
                    *(u32x4*)dst = pack8(o1a, o1b); *(u32x4*)(dst + 32) = pack8(o2a, o2b); asm volatile("" ::: "memory"); }
        }
    }
};
struct EpiMerge {
    bf16_t* ACC; const bf16_t* gate0; int ldg;
    __device__ __forceinline__ void operator()(EPI_ARGS) const {
        EPI_LANE
        const int row0 = u.pm * BM + wr * 64 + fr, col0 = u.pn * BM + wc * 32 + 8 * fq;
        const bf16_t* gate = gate0 + u.sub * 2048; const bool first = u.sub == 0;
#pragma unroll
        for (int ai = 0; ai < 2; ++ai) {
            u32x4 gw[4][2], pw[4][2];
#pragma unroll
            for (int m = 0; m < 4; ++m) { const size_t row = (size_t)(row0 + ai * HALF + m * 16);
#pragma unroll
                for (int bj = 0; bj < 2; ++bj) { const int col = col0 + bj * HALF; gw[m][bj] = *(const u32x4*)(gate + row * ldg + col);
                    pw[m][bj] = (u32x4){0u, 0u, 0u, 0u}; if (!first) pw[m][bj] = *(const u32x4*)(ACC + row * 2048 + col); } }
#pragma unroll
            for (int m = 0; m < 4; ++m) { const size_t row = (size_t)(row0 + ai * HALF + m * 16);
#pragma unroll
                for (int bj = 0; bj < 2; ++bj) { const int col = col0 + bj * HALF; const u32x4 g = gw[m][bj], p = pw[m][bj];
                    const f32x4 a0 = acc[ai][bj][m][0], a1 = acc[ai][bj][m][1];
                    f32x4 r0, r1;
                    r0[0] = bflo(p.x) + bflo(g.x) * a0[0]; r0[1] = bfhi(p.x) + bfhi(g.x) * a0[1]; r0[2] = bflo(p.y) + bflo(g.y) * a0[2]; r0[3] = bfhi(p.y) + bfhi(g.y) * a0[3];
                    r1[0] = bflo(p.z) + bflo(g.z) * a1[0]; r1[1] = bfhi(p.z) + bfhi(g.z) * a1[1]; r1[2] = bflo(p.w) + bflo(g.w) * a1[2]; r1[3] = bfhi(p.w) + bfhi(g.w) * a1[3];
                    *(u32x4*)(ACC + row * 2048 + col) = pack8(r0, r1); } }
            asm volatile("" ::: "memory"); }
    }
};
struct EpiWo {
    float* X1; const float* mod  ; const float* xlat  ; const float* xctx  ;
    __device__ __forceinline__ void operator()(EPI_ARGS) const {
        EPI_LANE
        const int b = u.pm / 17, tb = u.pm % 17; const bool isctx = tb == 0;
        const float* g1 = mod + (size_t)(isctx ? 4 : b) * 12288 + 2 * 2048;
        const float* xbase = isctx ? xctx + (size_t)b * cf::CTX * 2048 : xlat + ((size_t)b * cf::S + (size_t)(tb - 1) * 256) * 2048;
        const int rl0 = wr * 64 + fr, col0 = u.pn * BM + wc * 32 + 8 * fq;
        f32x4 gv[2][2];
#pragma unroll
        for (int bj = 0; bj < 2; ++bj) { gv[bj][0] = *(const f32x4*)(g1 + col0 + bj * HALF); gv[bj][1] = *(const f32x4*)(g1 + col0 + bj * HALF + 4); }
#pragma unroll
        for (int ai = 0; ai < 2; ++ai) {
            f32x4 xv[4][2][2];
#pragma unroll
            for (int m = 0; m < 4; ++m) { const int rl = rl0 + ai * HALF + m * 16;
#pragma unroll
                for (int bj = 0; bj < 2; ++bj) { const float* xp = xbase + (size_t)rl * 2048 + col0 + bj * HALF; xv[m][bj][0] = *(const f32x4*)xp; xv[m][bj][1] = *(const f32x4*)(xp + 4); } }
#pragma unroll
            for (int m = 0; m < 4; ++m) { const int rl = rl0 + ai * HALF + m * 16; float* op = X1 + ((size_t)u.pm * BM + rl) * 2048 + col0;
#pragma unroll
                for (int bj = 0; bj < 2; ++bj) { *(f32x4*)(op + bj * HALF) = xv[m][bj][0] * cf::ALPHA + gv[bj][0] * acc[ai][bj][m][0];
                    *(f32x4*)(op + bj * HALF + 4) = xv[m][bj][1] * cf::ALPHA + gv[bj][1] * acc[ai][bj][m][1]; } }
            asm volatile("" ::: "memory"); }
    }
};
}

struct Ctx {
    const float* const* in; float* out; unsigned char* ws;
    ldsp_t lds; int tid, lane, wave, G, bid;
};
#define WSP(T, off) ((T*)(F.ws + (off)))
__device__ __forceinline__ Ctx phase_ctx(const Ctx& F0) {
    Ctx C = F0;
    C.tid = F0.wave * 64 + lane_id();
    asm volatile("" : "+v"(C.tid));
    { size_t z = 0; asm volatile("" : "+s"(z)); C.ws = F0.ws + z; }
    C.lane = C.tid & 63; C.wave = __builtin_amdgcn_readfirstlane(C.tid >> 6);
    return C;
}

__device__ __forceinline__ int srcmap(int mode, int n) {
    if (mode == 0) {
        const int pn = n >> 8, q = n & 255, bj = q >> 7, r = q & 127, rope = (r >> 6) * 128 + bj * 64 + (r & 63);
        if (pn == 0) return rope;
        if (pn == 1) return 256 + q;
        if (pn == 2) return 512 + q;
        if (pn == 3) return r < 32 ? 768 + bj * 32 + r : -1;
        if (pn == 4) return 832 + rope;
        if (pn == 5) return 1088 + q;
        if (pn < 10) return 1344 + (pn - 6) * 256 + rope;
        if (pn < 12) return 2368 + (pn - 10) * 256 + q;
        if (pn < 16) return 2880 + (pn - 12) * 256 + rope;
        if (pn < 24) return 3904 + bj * 1024 + 128 * (pn - 16) + r;
        return 5952 + (n - 6144);
    }
    if (mode == 1) { if (n < 1024) return (n >> 7) * 192 + (n & 127);
        const int m = n - 1024, t = m >> 8, bj = (m >> 7) & 1, q = m & 127; return (4 * t + (q >> 5)) * 192 + 128 + bj * 32 + (q & 31); }
    if (mode == 2) { if (n < 1024) return (n >> 7) * 256 + (n & 127); const int m = n - 1024; return (m >> 7) * 256 + 128 + (m & 127); }
    return n;
}
__device__ __forceinline__ void tr_tile(const Ctx& F, const float* src, int ld_src, int mode, int k0, bf16_t* dst, int ldd, int n0, const float* kscale = nullptr) {
    LAS float* T = (LAS float*)F.lds;
    const int kr = F.tid >> 6, nc = (F.tid & 63) * 4, sc = srcmap(mode, n0 + nc);
    f32x4 v[8];
#pragma unroll
    for (int h = 0; h < 8; ++h) { v[h] = (f32x4){0.f, 0.f, 0.f, 0.f}; if (sc >= 0) v[h] = *(const f32x4*)(src + (size_t)(k0 + kr + 8 * h) * ld_src + sc); }
#pragma unroll
    for (int h = 0; h < 8; ++h) { const int k = kr + 8 * h; f32x4 x = v[h]; if (kscale) x = x * kscale[k0 + k];
        T[k * 257 + nc + 0] = x[0]; T[k * 257 + nc + 1] = x[1]; T[k * 257 + nc + 2] = x[2]; T[k * 257 + nc + 3] = x[3]; }
    __syncthreads();
    const int n = F.tid >> 1, kc = (F.tid & 1) * 32;
#pragma unroll
    for (int j = 0; j < 4; ++j) { u32x4 w; const int kb = kc + 8 * j;
        w.x = cvt_pk_bf16(T[(kb + 0) * 257 + n], T[(kb + 1) * 257 + n]); w.y = cvt_pk_bf16(T[(kb + 2) * 257 + n], T[(kb + 3) * 257 + n]);
        w.z = cvt_pk_bf16(T[(kb + 4) * 257 + n], T[(kb + 5) * 257 + n]); w.w = cvt_pk_bf16(T[(kb + 6) * 257 + n], T[(kb + 7) * 257 + n]);
        *(u32x4*)(dst + (size_t)(n0 + n) * ldd + k0 + kb) = w; }
    __syncthreads();
}
__device__ __forceinline__ void cvt_rows(const Ctx& F, const float* src, bf16_t* dst, size_t n8) {
    for (size_t i = (size_t)F.bid * 512 + F.tid; i < n8; i += (size_t)F.G * 512) {
        const f32x4 a = *(const f32x4*)(src + i * 8), b = *(const f32x4*)(src + i * 8 + 4);
        *(u32x4*)(dst + i * 8) = pg8::pack8(a, b); }
}

__device__ __forceinline__ void cvt_rows_fp8(const Ctx& F, const float* src, unsigned char* dst, size_t n16, float scale) {
    const size_t stride = (size_t)F.G * 512;
    for (size_t i = (size_t)F.bid * 512 + F.tid; i < n16; i += 2 * stride) {
        const size_t i2 = i + stride; const bool two = i2 < n16;
        f32x4 a[8];
#pragma unroll
        for (int j = 0; j < 4; ++j) { a[j] = *(const f32x4*)(src + i * 16 + 4 * j); a[4 + j] = two ? *(const f32x4*)(src + i2 * 16 + 4 * j) : (f32x4){0.f, 0.f, 0.f, 0.f}; }
        u32x4 w0, w1;
#pragma unroll
        for (int j = 0; j < 4; ++j) { const f32x4 x = a[j] * scale, y = a[4 + j] * scale;
            int p = 0; p = __builtin_amdgcn_cvt_pk_fp8_f32(x[0], x[1], p, false); p = __builtin_amdgcn_cvt_pk_fp8_f32(x[2], x[3], p, true); w0[j] = (unsigned)p;
            int q = 0; q = __builtin_amdgcn_cvt_pk_fp8_f32(y[0], y[1], q, false); q = __builtin_amdgcn_cvt_pk_fp8_f32(y[2], y[3], q, true); w1[j] = (unsigned)q; }
        *(u32x4*)(dst + i * 16) = w0; if (two) *(u32x4*)(dst + i2 * 16) = w1; }
}

constexpr int V4_ROW = 1088;
__device__ __forceinline__ void cvt_rows_fp4(const Ctx& F, const float* src, unsigned char* dst, size_t nblk) {
    for (size_t i = (size_t)F.bid * 512 + F.tid; i < nblk; i += (size_t)F.G * 512) {
        f32x4 a[8]; float amax = 0.f;
#pragma unroll
        for (int j = 0; j < 8; ++j) { a[j] = *(const f32x4*)(src + i * 32 + 4 * j); amax = fmaxf(amax, fmaxf(fmaxf(fabsf(a[j][0]), fabsf(a[j][1])), fmaxf(fabsf(a[j][2]), fabsf(a[j][3])))); }
        int e = amax > 0.f ? (int)ceilf(log2f(amax * (1.0f / 6.0f))) : -126; e = e < -126 ? -126 : (e > 126 ? 126 : e);
        const float inv = __uint_as_float((unsigned)(127 - e) << 23);
        u32x4 w;
#pragma unroll
        for (int j = 0; j < 4; ++j) { const f32x4 x = a[2 * j] * inv, y = a[2 * j + 1] * inv; unsigned p = 0u;
            p = __builtin_amdgcn_cvt_scalef32_pk_fp4_f32(p, x[0], x[1], 1.0f, 0); p = __builtin_amdgcn_cvt_scalef32_pk_fp4_f32(p, x[2], x[3], 1.0f, 1);
            p = __builtin_amdgcn_cvt_scalef32_pk_fp4_f32(p, y[0], y[1], 1.0f, 2); p = __builtin_amdgcn_cvt_scalef32_pk_fp4_f32(p, y[2], y[3], 1.0f, 3); w[j] = p; }
        const size_t row = i >> 6; const int bl = (int)(i & 63);
        *(u32x4*)(dst + row * V4_ROW + bl * 16) = w; dst[row * V4_ROW + 1024 + bl] = (unsigned char)(e + 127);
    }
}

__device__ __forceinline__ void ph_prologue(const Ctx& F0) {
    const Ctx F = phase_ctx(F0);
    using namespace cf;
    constexpr int T_WIN = 2 * 32 * 56, T_QUP = 2 * 8 * 6, T_KVUP = 2 * 4 * 8, T_BR = 2 * 4 * 16 * 8, T_WO = 2 * 32 * 8;
    constexpr int T_ALL = T_WIN + T_QUP + T_KVUP + T_BR + T_WO;
    for (int u = F.bid; u < T_ALL; u += F.G) {
        int t = u;
        if (t < T_WIN) { const int l = t / (32 * 56), r = t % (32 * 56), kt = r / 56, nt = r % 56;
            tr_tile(F, F.in[I_WIN] + (size_t)l * 2048 * IN_COLS, IN_COLS, 0, kt * 64, WSP(bf16_t, WS_WIN) + (size_t)l * NC * 2048, 2048, nt * 256); continue; }
        t -= T_WIN;
        if (t < T_QUP) { const int l = t / (8 * 6), r = t % (8 * 6), kt = r / 6, nt = r % 6;
            tr_tile(F, F.in[I_WQUP] + (size_t)l * 512 * 1536, 1536, 1, kt * 64, WSP(bf16_t, WS_WQUP) + (size_t)l * 1536 * 512, 512, nt * 256, F.in[I_BQN] + l * 512); continue; }
        t -= T_QUP;
        if (t < T_KVUP) { const int l = t / (4 * 8), r = t % (4 * 8), kt = r / 8, nt = r % 8;
            tr_tile(F, F.in[I_WKVUP] + (size_t)l * 256 * 2048, 2048, 2, kt * 64, WSP(bf16_t, WS_WKVUP) + (size_t)l * 2048 * 256, 256, nt * 256, F.in[I_BKVN] + l * 256); continue; }
        t -= T_KVUP;
        if (t < T_BR) { const int l = t / (4 * 128), r = t % (4 * 128), br = r / 128, r2 = r % 128, kt = r2 / 8, nt = r2 % 8;
            const float* src = (br == 0 ? F.in[I_WBRA] : br == 1 ? F.in[I_WBRB] : br == 2 ? F.in[I_WBRC] : F.in[I_WBRD]) + (size_t)l * 1024 * 2048;
            tr_tile(F, src, 2048, 3, kt * 64, WSP(bf16_t, WS_WBR) + ((size_t)l * 4 + br) * 2048 * 1024, 1024, nt * 256); continue; }
        t -= T_BR;
        { const int l = t / 256, r = t % 256, kt = r / 8, nt = r % 8;
            tr_tile(F, F.in[I_WO] + (size_t)l * 2048 * 2048, 2048, 3, kt * 64, WSP(bf16_t, WS_WO) + (size_t)l * 2048 * 2048, 2048, nt * 256); }
    }
    for (int u = F.bid; u < 2 * 16 * 32; u += F.G) {
        const int l = u / 512, g = (u % 512) / 32, d0 = (u % 32) * 64;
        LAS float* sk = (LAS float*)F.lds; LAS float* wt = (LAS float*)(F.lds + 128 * 129 * 4);
        const float* skg = F.in[I_PSK] + ((size_t)l * 16 + g) * 128 * 128;
        const float* wqg = F.in[I_PWQ] + (size_t)l * 2048 * 2048 + (size_t)d0 * 2048 + g * 128;
        for (int i = F.tid; i < 128 * 128; i += 512) sk[(i >> 7) * 129 + (i & 127)] = skg[i];
        for (int i = F.tid; i < 64 * 128; i += 512) wt[(i >> 7) * 129 + (i & 127)] = wqg[(size_t)(i >> 7) * 2048 + (i & 127)];
        __syncthreads();
        const int n = F.tid & 127, dg = F.tid >> 7;
        float a[16];
#pragma unroll
        for (int e = 0; e < 16; ++e) a[e] = 0.f;
        for (int k = 0; k < 128; ++k) { const float s = sk[n * 129 + k];
#pragma unroll
            for (int e = 0; e < 16; ++e) a[e] += wt[(dg * 16 + e) * 129 + k] * s; }
        bf16_t* dst = WSP(bf16_t, WS_WFOLD) + (size_t)l * 2048 * 2048 + (size_t)(g * 128 + n) * 2048 + d0 + dg * 16;
        u32x4 w0, w1;
        w0.x = cvt_pk_bf16(a[0], a[1]); w0.y = cvt_pk_bf16(a[2], a[3]); w0.z = cvt_pk_bf16(a[4], a[5]); w0.w = cvt_pk_bf16(a[6], a[7]);
        w1.x = cvt_pk_bf16(a[8], a[9]); w1.y = cvt_pk_bf16(a[10], a[11]); w1.z = cvt_pk_bf16(a[12], a[13]); w1.w = cvt_pk_bf16(a[14], a[15]);
        *(u32x4*)dst = w0; *(u32x4*)(dst + 8) = w1;
        __syncthreads();
    }
    for (int u = F.bid; u < 2 * 192; u += F.G) {
        const int l = u / 192, n0 = (u % 192) * 64;
        LAS float* sl = (LAS float*)F.lds; LAS float* red = (LAS float*)(F.lds + 5 * 2048 * 4);
        for (int i = F.tid; i < 5 * 2048; i += 512) { const int r = i >> 11, k = i & 2047; const float v = r < 4 ? F.in[I_C][r * 2048 + k] : F.in[I_CCTX][k]; sl[i] = v * sigmoidf_(v); }
        __syncthreads();
        const int cg = F.tid & 15, ks = F.tid >> 4;
        f32x4 a[5];
#pragma unroll
        for (int r = 0; r < 5; ++r) a[r] = (f32x4){0.f, 0.f, 0.f, 0.f};
        const float* wp = F.in[I_WADA] + (size_t)l * 2048 * 12288 + n0 + cg * 4;
#pragma unroll 8
        for (int k = ks * 64; k < ks * 64 + 64; ++k) { const f32x4 w = *(const f32x4*)(wp + (size_t)k * 12288);
#pragma unroll
            for (int r = 0; r < 5; ++r) a[r] += w * sl[r * 2048 + k]; }
#pragma unroll
        for (int r = 0; r < 5; ++r) *(LAS f32x4*)(red + (ks * 5 + r) * 64 + cg * 4) = a[r];
        __syncthreads();
        if (F.tid < 320) { const int r = F.tid >> 6, col = F.tid & 63; float sacc = 0.f;
#pragma unroll
            for (int k2 = 0; k2 < 32; ++k2) sacc += red[(k2 * 5 + r) * 64 + col];
            WSP(float, WS_MOD)[((size_t)l * 5 + r) * 12288 + n0 + col] = sacc + F.in[I_BADA][(size_t)l * 12288 + n0 + col]; }
        __syncthreads();
    }
    for (int i = F.bid * 512 + F.tid; i < 4096 * 64; i += F.G * 512) {
        const int pos = i >> 6, j = i & 63, fi = j & 31; const float fr = powf(10000.0f, -(float)(2 * fi) / 64.0f);
        const float ang = (float)(j < 32 ? (pos >> 6) : (pos & 63)) * fr;
        WSP(float, WS_COSH)[i] = cosf(ang); WSP(float, WS_SINH)[i] = sinf(ang);
    }
    for (int i = F.bid * 512 + F.tid; i < 4096 * 32; i += F.G * 512) {
        const int pos = i >> 5, j = i & 31, fi = j & 15; const float fr = powf(10000.0f, -(float)(2 * fi) / 32.0f);
        const float ang = (float)(j < 16 ? (pos >> 6) : (pos & 63)) * fr;
        WSP(float, WS_COSR)[i] = cosf(ang); WSP(float, WS_SINR)[i] = sinf(ang);
    }
    cvt_rows_fp8(F, F.in[I_PU], WSP(unsigned char, WS_UB), (size_t)2 * NEXP * 2048 / 16, 1024.f);
    cvt_rows_fp4(F, F.in[I_PV], WSP(unsigned char, WS_VB2), (size_t)2 * NEXP * 64);
}

__device__ __forceinline__ void ph_modulate0(const Ctx& F0) {
    const Ctx F = phase_ctx(F0);
    using namespace cf;
    const float* mod = WSP(float, WS_MOD);
    for (size_t i = (size_t)F.bid * 512 + F.tid; i < (size_t)MR * 256; i += (size_t)F.G * 512) {
        const int R = (int)(i >> 8), d = (int)(i & 255) * 8, b = R / RB, j = R % RB;
        const float* src = j < CTX ? F.in[I_CTX] + ((size_t)b * CTX + j) * 2048 : F.in[I_X] + ((size_t)b * S + (j - CTX)) * 2048;
        const float* m = mod + (size_t)(j < CTX ? 4 : b) * 12288;
        const f32x4 x0 = *(const f32x4*)(src + d), x1 = *(const f32x4*)(src + d + 4);
        const f32x4 sh0 = *(const f32x4*)(m + d), sh1 = *(const f32x4*)(m + d + 4), s0 = *(const f32x4*)(m + 2048 + d), s1 = *(const f32x4*)(m + 2048 + d + 4);
        *(u32x4*)(WSP(bf16_t, WS_HB) + (size_t)R * 2048 + d) = pg8::pack8(x0 * (s0 + 1.0f) + sh0, x1 * (s1 + 1.0f) + sh1);
    }
}

__device__ __forceinline__ void knorm_pass(const Ctx& F) {
    using namespace cf;
    bf16_t* P = WSP(bf16_t, WS_P); const float* ssk = WSP(const float, WS_SSK);
    for (int it = F.bid * 8 + F.wave; it < MR * 2; it += F.G * 8) {
        const int R = it >> 1, h = it & 1;
        const f32x2 pp = *(const f32x2*)(ssk + (size_t)it * 2); const float r = rsqrtf((pp.x + pp.y) * (1.f / 128.f) + 1e-6f);
        unsigned* q = (unsigned*)(P + (size_t)R * NC + PC_AK + h * 128) + F.lane;
        const unsigned w = *q; *q = cvt_pk_bf16(bflo(w) * r, bfhi(w) * r);
    }
}

struct AttnArgs {
    const bf16_t* Q; const bf16_t* K; const bf16_t* V; bf16_t* O; int ldq, ldk, ldv, ldo;
    int seg0_row, seg0_tiles, seg1_row, seg1_tiles;
    int mask_on, qpos0, kpos1;
    float sc_log2; int has_sink; float sink_l2;
    int variant;
    const float* qss;
};
typedef float f32x16 __attribute__((ext_vector_type(16)));
constexpr float LOG2E_F = 1.4426950408889634f;
template <int DK, bool MASKED>
__device__ __forceinline__ void attn_unit(ldsp_t lds, const AttnArgs a, int wave_) {
    constexpr int ND = DK / 16, KCH = DK / 8, KPT = (64 * KCH) / 512, VST = 72, KM = DK == 128 ? 15 : 7;
    constexpr int KBUF = 64 * DK * 2, VBUF = 128 * VST * 2, VOFF = 2 * KBUF, ALOFF = VOFF + 3 * VBUF;
    int tid = wave_ * 64 + lane_id(); asm volatile("" : "+v"(tid));
    const int wid = __builtin_amdgcn_readfirstlane(tid >> 6), lane = tid & 63, q32 = lane & 31, hi = lane >> 5;
    LAS float* al = (LAS float*)(lds + ALOFF + wid * 128);
    bf16x8 qf[ND];
    { float scq = a.sc_log2;
      if (a.qss) { const f32x2 pp = *(const f32x2*)(a.qss + (size_t)(wid * 32 + q32) * 16); scq *= rsqrtf((pp.x + pp.y) * (1.f / 128.f) + 1e-6f); }
      const bf16_t* qrow = a.Q + (size_t)(wid * 32 + q32) * a.ldq + 8 * hi;
#pragma unroll
      for (int s = 0; s < ND; ++s) { const u32x4 w = *(const u32x4*)(qrow + 16 * s); u32x4 o;
          o.x = cvt_pk_bf16(bflo(w.x) * scq, bfhi(w.x) * scq); o.y = cvt_pk_bf16(bflo(w.y) * scq, bfhi(w.y) * scq);
          o.z = cvt_pk_bf16(bflo(w.z) * scq, bfhi(w.z) * scq); o.w = cvt_pk_bf16(bflo(w.w) * scq, bfhi(w.w) * scq); qf[s] = *(bf16x8*)&o; } }
    f32x16 o[4];
#pragma unroll
    for (int db = 0; db < 4; ++db)
#pragma unroll
        for (int r = 0; r < 16; ++r) o[db][r] = 0.f;
    float m_run = -1e30f, l_run = 0.f;
    const int PV_ = MK_AV ? a.variant : 0;
    const int ntiles = a.seg0_tiles + a.seg1_tiles;
    u32x4 vreg[2];
    const int vkp = tid & 31, vdc = tid >> 5;
    const int vkey = 2 * vkp, vpos = (vkey & 48) | ((vkey & 4) << 1) | ((vkey & 8) >> 1) | (vkey & 3);
    unsigned koff[KPT];
#pragma unroll
    for (int i = 0; i < KPT; ++i) { const int P = (i * 8 + wid) * 64 + lane, row = P / KCH, cp = P % KCH; koff[i] = (unsigned)(row * a.ldk + 8 * (cp ^ (row & KM))) * 2u; }
#define ATT_LOAD(tt, kb) do { const int _r0 = (tt) < a.seg0_tiles ? a.seg0_row + 64 * (tt) : a.seg1_row + 64 * ((tt) - a.seg0_tiles); \
        const char* _kg = (const char*)(a.K + (size_t)_r0 * a.ldk); \
        _Pragma("unroll") for (int _i = 0; _i < KPT; ++_i) __builtin_amdgcn_global_load_lds((const unsigned*)(_kg + koff[_i]), (LAS unsigned*)(lds + (kb) * KBUF + (_i * 8 + wid) * 1024), 16, 0, 0); \
        vreg[0] = *(const u32x4*)(a.V + (size_t)(_r0 + 2 * vkp) * a.ldv + 8 * vdc); vreg[1] = *(const u32x4*)(a.V + (size_t)(_r0 + 2 * vkp + 1) * a.ldv + 8 * vdc); } while (0)
#define ATT_WRITE(vb) do { const ldsp_t _vb = lds + VOFF + (vb) * VBUF; \
        const unsigned _a0[4] = {vreg[0].x, vreg[0].y, vreg[0].z, vreg[0].w}, _a1[4] = {vreg[1].x, vreg[1].y, vreg[1].z, vreg[1].w}; \
        _Pragma("unroll") for (int _e = 0; _e < 4; ++_e) { \
            *(LAS unsigned*)(_vb + ((8 * vdc + 2 * _e) * VST + vpos) * 2) = (_a0[_e] & 0xffffu) | (_a1[_e] << 16); \
            *(LAS unsigned*)(_vb + ((8 * vdc + 2 * _e + 1) * VST + vpos) * 2) = (_a0[_e] >> 16) | (_a1[_e] & 0xffff0000u); } } while (0)
#define ATT_PV(vb) do { const ldsp_t _vt = lds + VOFF + (vb) * VBUF; \
        _Pragma("unroll") for (int db = 0; db < 4; ++db) _Pragma("unroll") for (int ks = 0; ks < 4; ++ks) { \
            const bf16x8 vf = *(const LAS bf16x8*)(_vt + ((32 * db + q32) * VST + 16 * ks + 8 * hi) * 2); \
            o[db] = __builtin_amdgcn_mfma_f32_32x32x16_bf16(pa[ks], vf, o[db], 0, 0, 0); } } while (0)
    bf16x8 pa[4];
#pragma unroll
    for (int i = 0; i < 4; ++i) pa[i] = (bf16x8){0, 0, 0, 0, 0, 0, 0, 0};
    int vprev = 2, vcur = 0, vnext = 1;
    { unsigned z0 = 0u; asm volatile("" : "+v"(z0));
      for (int i = tid; i < VBUF / 16; i += 512) *(LAS u32x4*)(lds + VOFF + 2 * VBUF + i * 16) = (u32x4){z0, z0, z0, z0}; }
    ATT_LOAD(0, 0);
    ATT_WRITE(0);
    asm volatile("s_waitcnt vmcnt(0)" ::: "memory");
    __syncthreads();
    for (int tt = 0; tt < ntiles; ++tt) {
        const int cur = tt & 1;
        if (tt + 1 < ntiles && PV_ != 4) ATT_LOAD(tt + 1, cur ^ 1);
        const ldsp_t Ks = lds + cur * KBUF;
        f32x16 s0, s1;
#pragma unroll
        for (int r = 0; r < 16; ++r) { s0[r] = 0.f; s1[r] = 0.f; }
        { bf16x8 kf[2][2];
#define ATT_LDK(p, sb) do { kf[p][0] = *(const LAS bf16x8*)(Ks + (q32 * KCH + ((2 * (sb) + hi) ^ (q32 & KM))) * 16); kf[p][1] = *(const LAS bf16x8*)(Ks + ((32 + q32) * KCH + ((2 * (sb) + hi) ^ (q32 & KM))) * 16); } while (0)
          if (PV_ != 2) {
          ATT_LDK(0, 0);
#pragma unroll
          for (int sb = 0; sb < ND; ++sb) {
              if (sb + 1 < ND) ATT_LDK((sb + 1) & 1, sb + 1);
              s0 = __builtin_amdgcn_mfma_f32_32x32x16_bf16(kf[sb & 1][0], qf[sb], s0, 0, 0, 0);
              s1 = __builtin_amdgcn_mfma_f32_32x32x16_bf16(kf[sb & 1][1], qf[sb], s1, 0, 0, 0);
              }
          }
#undef ATT_LDK
        }
        const bool msk = MASKED && a.mask_on && tt >= a.seg0_tiles;
        if (MASKED) { const int kp0 = a.kpos1 + 64 * (tt - a.seg0_tiles) + 4 * hi, qp = a.qpos0 + wid * 32 + q32;
#pragma unroll
            for (int r = 0; r < 16; ++r) { float t0 = s0[r], t1 = s1[r];
                if (msk) { const int d0 = qp - (kp0 + (r & 3) + 8 * (r >> 2)), d1 = d0 - 32; if (d0 > 128 || d0 < -128) t0 = -1e30f; if (d1 > 128 || d1 < -128) t1 = -1e30f; s0[r] = t0; s1[r] = t1; } }
            __builtin_amdgcn_sched_barrier(0); }
        float mx = -1e30f, m_new = 0.f, alpha = 1.f, ps = 0.f;
        bf16x8 pn[4] = {pa[0], pa[1], pa[2], pa[3]};
        { const ldsp_t _vt = lds + VOFF + vprev * VBUF; bf16x8 vfr[3]; vfr[2] = pa[0];
#define ATT_LDV(i) (*(const LAS bf16x8*)(_vt + ((32 * ((i) >> 2) + q32) * VST + 16 * ((i) & 3) + 8 * hi) * 2))
#define SCV(e) ((e) < 16 ? s0[(e) & 15] : s1[(e) & 15])
          vfr[0] = ATT_LDV(0); vfr[1] = ATT_LDV(1);
#pragma unroll
          for (int i = 0; i < 16; ++i) {
              if (PV_ != 3) { if (i + 2 < 16) vfr[(i + 2) % 3] = ATT_LDV(i + 2);
              o[i >> 2] = __builtin_amdgcn_mfma_f32_32x32x16_bf16(pa[i & 3], vfr[i % 3], o[i >> 2], 0, 0, 0); }
              if (PV_ == 1) {} else if (i < 4) {
#pragma unroll
                  for (int e = 0; e < 4; ++e) mx = fmaxf(mx, fmaxf(s0[4 * i + e], s1[4 * i + e]));
              } else if (i == 4) {
                  { const auto rr = __builtin_amdgcn_permlane32_swap(__float_as_uint(mx), __float_as_uint(mx), false, false);
                    mx = fmaxf(__uint_as_float(rr[0]), __uint_as_float(rr[1])); }
                  if (__all(mx - m_run <= 8.0f * LOG2E_F)) { m_new = m_run; alpha = 1.f; }
                  else { m_new = fmaxf(m_run, mx); alpha = __builtin_amdgcn_exp2f(m_run - m_new); m_run = m_new; }
              } else if (i < 13) {
#pragma unroll
                  for (int e = 0; e < 2; ++e) { const int r = 2 * (i - 5) + e; s0[r] = __builtin_amdgcn_exp2f(s0[r] - m_new); s1[r] = __builtin_amdgcn_exp2f(s1[r] - m_new); ps += s0[r] + s1[r]; }
              } else if (i == 13) {
                  u32x4 w; w.x = cvt_pk_bf16(s0[0], s0[1]); w.y = cvt_pk_bf16(s0[2], s0[3]); w.z = cvt_pk_bf16(s0[4], s0[5]); w.w = cvt_pk_bf16(s0[6], s0[7]); pn[0] = *(bf16x8*)&w;
                  u32x4 v; v.x = cvt_pk_bf16(s0[8], s0[9]); v.y = cvt_pk_bf16(s0[10], s0[11]); v.z = cvt_pk_bf16(s0[12], s0[13]); v.w = cvt_pk_bf16(s0[14], s0[15]); pn[1] = *(bf16x8*)&v;
              } else if (i == 14) {
                  u32x4 w; w.x = cvt_pk_bf16(s1[0], s1[1]); w.y = cvt_pk_bf16(s1[2], s1[3]); w.z = cvt_pk_bf16(s1[4], s1[5]); w.w = cvt_pk_bf16(s1[6], s1[7]); pn[2] = *(bf16x8*)&w;
                  u32x4 v; v.x = cvt_pk_bf16(s1[8], s1[9]); v.y = cvt_pk_bf16(s1[10], s1[11]); v.z = cvt_pk_bf16(s1[12], s1[13]); v.w = cvt_pk_bf16(s1[14], s1[15]); pn[3] = *(bf16x8*)&v;
              } else { l_run = l_run * alpha + ps; }
          }
#undef ATT_LDV
#undef SCV
        }
#pragma unroll
        for (int i = 0; i < 4; ++i) pa[i] = pn[i];
        if (__any(alpha < 1.0f)) {
            if (hi == 0) al[q32] = alpha;
            asm volatile("s_waitcnt lgkmcnt(0)" ::: "memory");
#pragma unroll
            for (int g4 = 0; g4 < 4; ++g4) { const f32x4 av = *(const LAS f32x4*)(al + 8 * g4 + 4 * hi);
#pragma unroll
                for (int db = 0; db < 4; ++db)
#pragma unroll
                    for (int j = 0; j < 4; ++j) o[db][4 * g4 + j] *= av[j]; }
        }
        if (tt + 1 < ntiles && PV_ != 4) ATT_WRITE(vnext);
        { const int t3 = vprev; vprev = vcur; vcur = vnext; vnext = t3; }
        asm volatile("s_waitcnt vmcnt(0)" ::: "memory");
        if (PV_ != 5) __syncthreads();
    }
    ATT_PV(vprev);
#undef ATT_LOAD
#undef ATT_WRITE
#undef ATT_PV
    __syncthreads();
    float l_tot; { const auto rr = __builtin_amdgcn_permlane32_swap(__float_as_uint(l_run), __float_as_uint(l_run), false, false); l_tot = __uint_as_float(rr[0]) + __uint_as_float(rr[1]); }
    if (a.has_sink) l_tot += __builtin_amdgcn_exp2f(a.sink_l2 - m_run);
    if (hi == 0) al[q32] = 1.0f / l_tot;
    asm volatile("s_waitcnt lgkmcnt(0)" ::: "memory");
    const ldsp_t Ost = lds + wid * 8192;
#pragma unroll
    for (int g4 = 0; g4 < 4; ++g4) { const f32x4 iv = *(const LAS f32x4*)(al + 8 * g4 + 4 * hi);
#pragma unroll
        for (int db = 0; db < 4; ++db)
#pragma unroll
            for (int j = 0; j < 4; ++j) *(LAS bf16_t*)(Ost + ((8 * g4 + 4 * hi + j) * 128 + 32 * db + q32) * 2) = f2bf(o[db][4 * g4 + j] * iv[j]); }
    asm volatile("s_waitcnt lgkmcnt(0)" ::: "memory");
    const int lane_o = lane_id();
#pragma unroll
    for (int i = 0; i < 8; ++i) { const int c = lane_o + 64 * i, row = c >> 4, c8 = c & 15;
        *(u32x4*)(a.O + (size_t)(wid * 32 + row) * a.ldo + 8 * c8) = *(const LAS u32x4*)(Ost + (row * 128 + 8 * c8) * 2); }
}

__device__ __forceinline__ void conv_unit(const Ctx& F, int layer, int row0  , int seq_len, int t0) {
    using namespace cf;
    const bf16_t* P = WSP(const bf16_t, WS_P); bf16_t* BR = WSP(bf16_t, WS_BR);
    const float* cw = F.in[I_CW] + (size_t)layer * 31 * 1024; const float* cb = F.in[I_CB] + layer * 1024;
    const float* lg = F.in[I_CLG] + layer * 1024; const float* lb = F.in[I_CLB] + layer * 1024;
    int tid = F.wave * 64 + lane_id(); asm volatile("" : "+v"(tid));
    const int lane = tid & 63;
    LAS float* red = (LAS float*)(F.lds + 126976); LAS float* tot = red + 8 * 32;
    __syncthreads();
    for (int c = tid; c < 62 * 128; c += 512) { const int rr = c >> 7, ch = c & 127, t = t0 - 15 + rr;
        u32x4 v = {0u, 0u, 0u, 0u};
        if (t >= 0 && t < seq_len) v = *(const u32x4*)(P + (size_t)(row0 + t) * NC + PC_GLU + ch * 8);
        *(LAS u32x4*)(F.lds + rr * 2048 + ch * 16) = v; }
    float w0[31], w1[31];
#pragma unroll
    for (int k = 0; k < 31; ++k) { const f32x2 w = *(const f32x2*)(cw + k * 1024 + 2 * tid); w0[k] = w.x; w1[k] = w.y; }
    const f32x2 bv = *(const f32x2*)(cb + 2 * tid), gg = *(const f32x2*)(lg + 2 * tid), bb = *(const f32x2*)(lb + 2 * tid);
    __syncthreads();
#pragma unroll 1
    for (int part = 0; part < 4; ++part) {
        float a0[8], a1[8];
#pragma unroll
        for (int t = 0; t < 8; ++t) { a0[t] = bv.x; a1[t] = bv.y; }
        const ldsp_t base = F.lds + part * 8 * 2048 + tid * 4;
#pragma unroll
        for (int rr = 0; rr < 38; ++rr) { const unsigned xw = *(const LAS unsigned*)(base + rr * 2048); const float x0 = bflo(xw), x1 = bfhi(xw);
#pragma unroll
            for (int t = 0; t < 8; ++t) { const int k = rr - t; if (k >= 0 && k <= 30) { a0[t] += x0 * w0[k]; a1[t] += x1 * w1[k]; } } }
        float v[16];
#pragma unroll
        for (int t = 0; t < 8; ++t) { v[t] = a0[t] + a1[t]; v[8 + t] = a0[t] * a0[t] + a1[t] * a1[t]; }
#pragma unroll
        for (int i = 0; i < 8; ++i) { const bool up = lane & 32; const float snd = up ? v[i] : v[i + 8], kp = up ? v[i + 8] : v[i]; v[i] = kp + shx(snd, 32, lane); }
#pragma unroll
        for (int i = 0; i < 4; ++i) { const bool up = lane & 16; const float snd = up ? v[i] : v[i + 4], kp = up ? v[i + 4] : v[i]; v[i] = kp + shx(snd, 16, lane); }
#pragma unroll
        for (int i = 0; i < 2; ++i) { const bool up = lane & 8; const float snd = up ? v[i] : v[i + 2], kp = up ? v[i + 2] : v[i]; v[i] = kp + shx(snd, 8, lane); }
        { const bool up = lane & 4; const float snd = up ? v[0] : v[1], kp = up ? v[1] : v[0]; v[0] = kp + shx(snd, 4, lane); }
        v[0] += shx(v[0], 2, lane); v[0] += shx(v[0], 1, lane);
        if ((lane & 3) == 0) red[F.wave * 16 + (lane >> 2)] = v[0];
        __syncthreads();
        if (tid < 16) { float s = 0.f;
#pragma unroll
            for (int w = 0; w < 8; ++w) s += red[w * 16 + tid];
            tot[tid] = s; }
        __syncthreads();
#pragma unroll
        for (int t = 0; t < 8; ++t) { const float mean = tot[t] * (1.f / 1024.f), var = fmaxf(tot[8 + t] * (1.f / 1024.f) - mean * mean, 0.f), rstd = rsqrtf(var + 1e-5f);
            const float y0 = (a0[t] - mean) * rstd * gg.x + bb.x, y1 = (a1[t] - mean) * rstd * gg.y + bb.y;
            *(unsigned*)(BR + (size_t)(row0 + t0 + part * 8 + t) * 4096 + 2048 + 2 * tid) = cvt_pk_bf16(y0 * sigmoidf_(y0), y1 * sigmoidf_(y1)); }
    }
}

__device__ __forceinline__ void attn_defaults(AttnArgs& a, int isctx) {
    a.seg0_row = 0; a.seg0_tiles = isctx ? 4 : 68; a.seg1_row = 0; a.seg1_tiles = 0; a.mask_on = 0; a.qpos0 = 0; a.kpos1 = 0; a.has_sink = 0; a.sink_l2 = 0.f; a.qss = nullptr; a.variant = 0; }
__device__ __forceinline__ void attn_unit_decode(int u, int G, bool gqa, int& b, int& h, int& qb) {
    if (G != 256) { b = u >> 7; h = (u >> 4) & 7; qb = u & 15; return; }
    const int bid = u & 255, r = u >> 8, x = bid & 7, local = (bid >> 3) + 32 * r;
    qb = local & 15;
    if (gqa) { b = x >> 1; h = (x & 1) * 4 + (local >> 4); }
    else { const int pair = x * 4 + (local >> 4); b = pair >> 3; h = pair & 7; }
}
__device__ __forceinline__ void ph_attn(const Ctx& F0, int layer) {
    const Ctx F = phase_ctx(F0);
    using namespace cf;
    const bf16_t* P = WSP(const bf16_t, WS_P); bf16_t* BR = WSP(bf16_t, WS_BR);
    for (int dup = 0; dup < DUPN(2); ++dup)
    for (int u = F.bid; u < (layer == 0 ? 544 : 512); u += F.G) {
        int b, h, qb, isctx = 0;
        if (u < 512) attn_unit_decode(u, F.G, false, b, h, qb); else { const int r = u - 512; b = r >> 3; h = r & 7; qb = 0; isctx = 1; }
        const size_t brow = (size_t)b * RB, qrow = brow + (isctx ? 0 : CTX) + (size_t)qb * 256;
        AttnArgs a; attn_defaults(a, isctx);
        a.Q = WSP(const bf16_t, WS_QB) + qrow * 1536 + h * 192; a.ldq = 1536;
        a.K = WSP(const bf16_t, WS_KB) + brow * 1536 + h * 192; a.ldk = 1536;
        a.V = WSP(const bf16_t, WS_VB) + brow * 1024 + h * 128; a.ldv = 1024;
        a.O = BR + qrow * 4096 + 1024 + h * 128; a.ldo = 4096; a.sc_log2 = SCALE_MLA * LOG2E;
        __syncthreads();
        attn_unit<192, false>(F.lds, a, F.wave);
    }
    for (int dup = 0; dup < DUPN(3); ++dup)
    for (int u0 = F.bid; u0 < (layer == 0 ? 544 : 512); u0 += F.G) {
        int b, h, qb, isctx = 0;
        if (u0 < 512) attn_unit_decode(u0, F.G, true, b, h, qb); else { const int r = u0 - 512; b = r >> 3; h = r & 7; qb = 0; isctx = 1; }
        const size_t brow = (size_t)b * RB, qrow = brow + (isctx ? 0 : CTX) + (size_t)qb * 256;
        AttnArgs a; attn_defaults(a, isctx);
        a.Q = P + qrow * NC + PC_AQ + h * 128; a.ldq = NC;
        a.K = P + brow * NC + PC_AK + (h >> 2) * 128; a.ldk = NC;
        a.V = P + brow * NC + PC_AV + (h >> 2) * 128; a.ldv = NC;
        a.O = BR + qrow * 4096 + h * 128; a.ldo = 4096; a.sc_log2 = SCALE_HD * LOG2E;
        a.qss = WSP(const float, WS_SSQ) + qrow * 16 + h * 2;
        if (MK_AV && dup == 1) { a.variant = MK_AV; a.O = WSP(bf16_t, WS_HB) + qrow * 2048 + h * 128; a.ldo = 2048; }
        __syncthreads();
        attn_unit<128, false>(F.lds, a, F.wave);
    }
    for (int dup = 0; dup < DUPN(13); ++dup)
    for (int u0 = F.bid; u0 < (layer == 0 ? 544 : 512); u0 += F.G) {
        int b, h, qb, isctx = 0;
        if (u0 < 512) attn_unit_decode(u0, F.G, true, b, h, qb); else { const int r = u0 - 512; b = r >> 3; h = r & 7; qb = 0; isctx = 1; }
        const size_t brow = (size_t)b * RB, qrow = brow + (isctx ? 0 : CTX) + (size_t)qb * 256;
        AttnArgs a; attn_defaults(a, isctx);
        a.Q = P + qrow * NC + PC_DQ + h * 128; a.ldq = NC;
        a.K = P + brow * NC + PC_DK + (h >> 2) * 128; a.ldk = NC;
        a.V = P + brow * NC + PC_DV + (h >> 2) * 128; a.ldv = NC;
        a.O = BR + qrow * 4096 + 3072 + h * 128; a.ldo = 4096; a.sc_log2 = SCALE_HD * LOG2E;
        a.has_sink = 1; a.sink_l2 = F.in[I_SINK][layer * 8 + h] * LOG2E; a.seg0_tiles = 4;
        if (!isctx) { const int start = qb * 256; const int lo = start - 128 < 0 ? 0 : start - 128, hi = start + 384 > S ? S : start + 384;
            a.seg1_row = CTX + lo; a.seg1_tiles = (hi - lo) / 64; a.mask_on = 1; a.qpos0 = start; a.kpos1 = lo; }
        __syncthreads();
        attn_unit<128, true>(F.lds, a, F.wave);
    }
    for (int dup = 0; dup < DUPN(4); ++dup)
    for (int u = F.bid; u < (layer == 0 ? 544 : 512); u += F.G) {
        int b, tb, isctx = 0;
        if (u < 512) { b = u >> 7; tb = u & 127; } else { const int r = u - 512; b = r >> 3; tb = r & 7; isctx = 1; }
        conv_unit(F, layer, b * RB + (isctx ? 0 : CTX), isctx ? CTX : S, tb * 32);
    }
}

__device__ __forceinline__ int tok_row(int layer, int tok) { return layer == 0 ? tok : (tok >> 12) * cf::RB + cf::CTX + (tok & 4095); }
__device__ __forceinline__ void ph_ln1(const Ctx& F0, int layer) {
    const Ctx F = phase_ctx(F0);
    using namespace cf;
    float* X1 = (float*)(F.ws + WS_P + X1_OFF); bf16_t* HB = WSP(bf16_t, WS_HB);
    const float* lg = F.in[I_LN1G] + layer * 2048; const float* lb = F.in[I_LN1B] + layer * 2048;
    const int ntok = layer == 0 ? MR : NB * S, lane = F.lane;
    for (int tok = F.bid * 8 + F.wave; tok < ntok; tok += F.G * 8) {
        const int R = tok_row(layer, tok), b = R / RB, j = R % RB;
        const float* mod = WSP(const float, WS_MOD) + ((size_t)layer * 5 + (j < CTX ? 4 : b)) * 12288;
        float* xp = X1 + (size_t)R * 2048;
        f32x4 v[8]; float s = 0.f;
#pragma unroll
        for (int i = 0; i < 8; ++i) { v[i] = *(const f32x4*)(xp + lane * 4 + 256 * i); s += (v[i][0] + v[i][1]) + (v[i][2] + v[i][3]); }
        const float mean = wave_sum(s, lane) * (1.f / 2048.f); float q = 0.f;
#pragma unroll
        for (int i = 0; i < 8; ++i) { const f32x4 d = v[i] - mean; q += (d[0] * d[0] + d[1] * d[1]) + (d[2] * d[2] + d[3] * d[3]); }
        const float rstd = rsqrtf(wave_sum(q, lane) * (1.f / 2048.f) + 1e-5f);
#pragma unroll
        for (int i = 0; i < 8; ++i) { const int c = lane * 4 + 256 * i;
            const f32x4 y = (v[i] - mean) * rstd * *(const f32x4*)(lg + c) + *(const f32x4*)(lb + c);
            *(f32x4*)(xp + c) = y;
            const f32x4 hp = y * (*(const f32x4*)(mod + 4 * 2048 + c) + 1.0f) + *(const f32x4*)(mod + 3 * 2048 + c);
            u32x2 w; w.x = cvt_pk_bf16(hp[0], hp[1]); w.y = cvt_pk_bf16(hp[2], hp[3]);
            *(u32x2*)(HB + (size_t)R * 2048 + c) = w; }
    }
}

typedef __bf16 bf16x2_t __attribute__((ext_vector_type(2)));
__device__ __forceinline__ unsigned ordkey(float v) { const unsigned u = __float_as_uint(v); return (u & 0x80000000u) ? ~u : (u | 0x80000000u); }
__device__ __forceinline__ int lane_rank(unsigned long long m) { return (int)__builtin_amdgcn_mbcnt_hi((unsigned)(m >> 32), __builtin_amdgcn_mbcnt_lo((unsigned)m, 0u)); }
template <int NV> __device__ __forceinline__ unsigned radix_thresh16(const unsigned (&k)[NV]) {
    unsigned T = 0u;
    for (int bit = 31; bit >= 0; --bit) { const unsigned cand = T | (1u << bit); int cnt = 0;
#pragma unroll
        for (int v = 0; v < NV; ++v) cnt += __popcll(__ballot(k[v] >= cand));
        if (cnt >= 16) { T = cand; if (cnt == 16) break; } }
    return T;
}
__device__ __forceinline__ void radix_thresh16x2(const unsigned (&ka)[2], const unsigned (&kb)[2], unsigned& Ta, unsigned& Tb) {
    unsigned T0 = 0u, T1 = 0u; bool d0 = false, d1 = false;
    for (int bit = 31; bit >= 0; --bit) { const unsigned c0 = T0 | (1u << bit), c1 = T1 | (1u << bit);
        const int n0 = __popcll(__ballot(ka[0] >= c0)) + __popcll(__ballot(ka[1] >= c0)), n1 = __popcll(__ballot(kb[0] >= c1)) + __popcll(__ballot(kb[1] >= c1));
        if (!d0 && n0 >= 16) { T0 = c0; d0 = n0 == 16; }
        if (!d1 && n1 >= 16) { T1 = c1; d1 = n1 == 16; }
        if (d0 && d1) break; }
    Ta = T0; Tb = T1;
}
__device__ __forceinline__ float dot2bf(unsigned a, unsigned b, float acc) { return __builtin_amdgcn_fdot2_f32_bf16(__builtin_bit_cast(bf16x2_t, a), __builtin_bit_cast(bf16x2_t, b), acc, false); }
__device__ __forceinline__ float dot8(const u32x4 a, const u32x4 b, float acc) {
    acc = dot2bf(a.x, b.x, acc); acc = dot2bf(a.y, b.y, acc); acc = dot2bf(a.z, b.z, acc); acc = dot2bf(a.w, b.w, acc);
    return acc;
}
__device__ __forceinline__ float gelu_as(float v) {
    const float av = fabsf(v), t = __builtin_amdgcn_rcpf(av * 0.2316418882f + 1.0f);
    float q = t * 0.5307027145f + (-0.7265760135f); q = q * t + 0.7107068705f; q = q * t + (-0.142248368f); q = q * t + 0.127414796f; q = q * t;
    const float e = __builtin_amdgcn_exp2f((v * v) * (-0.72134752044f)), m = v * (q * e);
    return v < 0.f ? m : v - m;
}
__device__ __forceinline__ void peer_load(u32x4 (&ur)[4][2], u32x4 (&vr)[4], unsigned (&vs)[4], float (&gq)[4], const LAS int* ei, const LAS float* eg,
                                          const unsigned char* U8, const unsigned char* V4, int lane, int grp) {
#pragma unroll
    for (int q = 0; q < 4; ++q) { const int id = __builtin_amdgcn_readfirstlane(ei[grp * 4 + q]); gq[q] = __uint_as_float(__builtin_amdgcn_readfirstlane(__float_as_uint(eg[grp * 4 + q])));
        ur[q][0] = *(const u32x4*)(U8 + (size_t)id * 2048 + lane * 16); ur[q][1] = *(const u32x4*)(U8 + (size_t)id * 2048 + lane * 16 + 1024);
        vr[q] = *(const u32x4*)(V4 + (size_t)id * V4_ROW + lane * 16); vs[q] = V4[(size_t)id * V4_ROW + 1024 + lane]; }
}
__device__ __forceinline__ void peer_comp(const u32x4 (&ur)[4][2], const u32x4 (&vr)[4], const unsigned (&vs)[4], const float (&gq)[4], const f32x2 (&xf)[16], f32x2 (&y2)[16], int lane) {
    float d[4];
#pragma unroll
    for (int q = 0; q < 4; ++q) { f32x2 t = {0.f, 0.f};
#pragma unroll
        for (int i = 0; i < 2; ++i)
#pragma unroll
            for (int j = 0; j < 4; ++j) { const int w = (int)ur[q][i][j];
                t += __builtin_amdgcn_cvt_pk_f32_fp8(w, false) * xf[8 * i + 2 * j]; t += __builtin_amdgcn_cvt_pk_f32_fp8(w, true) * xf[8 * i + 2 * j + 1]; }
        d[q] = t.x + t.y; }
#pragma unroll
    for (int o = 32; o >= 1; o >>= 1) {
#pragma unroll
        for (int q = 0; q < 4; ++q) d[q] += shx(d[q], o, lane); }
#pragma unroll
    for (int q = 0; q < 4; ++q) { const float dd = d[q] * (1.0f / 1024.0f); const float w = gq[q] * gelu_as(dd) * __uint_as_float(vs[q] << 23);
        const f32x2 w2 = {w, w};
#pragma unroll
        for (int j = 0; j < 4; ++j) { const unsigned vw = vr[q][j];
            y2[4 * j + 0] += w2 * __builtin_amdgcn_cvt_scalef32_pk_f32_fp4(vw, 1.0f, 0); y2[4 * j + 1] += w2 * __builtin_amdgcn_cvt_scalef32_pk_f32_fp4(vw, 1.0f, 1);
            y2[4 * j + 2] += w2 * __builtin_amdgcn_cvt_scalef32_pk_f32_fp4(vw, 1.0f, 2); y2[4 * j + 3] += w2 * __builtin_amdgcn_cvt_scalef32_pk_f32_fp4(vw, 1.0f, 3); } }
}
__device__ __forceinline__ unsigned inv_ordkey(unsigned k) { return (k & 0x80000000u) ? (k & 0x7fffffffu) : ~k; }
template <int N, int GRP> __device__ __forceinline__ unsigned lane_radix16(const unsigned (&key)[N], int lane) {
    unsigned T = 0u; bool done = false;
    for (int bit = 31; bit >= 0; --bit) { const unsigned cand = T | (1u << bit); int cnt = 0;
#pragma unroll
        for (int n = 0; n < N; ++n) cnt += key[n] >= cand ? 1 : 0;
        if (GRP >= 2) cnt += __builtin_amdgcn_ds_bpermute((lane ^ 1) << 2, cnt);
        if (GRP >= 4) cnt += __builtin_amdgcn_ds_bpermute((lane ^ 2) << 2, cnt);
        if (!done && cnt >= 16) { T = cand; done = cnt == 16; }
        if (__all(done)) break; }
    return T;
}
__device__ __forceinline__ void ph_peer(const Ctx& F0, int layer) {
    const Ctx F = phase_ctx(F0);
    using namespace cf;
    const float* SC = (const float*)(F.ws + WS_P + SC_OFF); const float* X1 = (const float*)(F.ws + WS_P + X1_OFF);
    bf16_t* HB = WSP(bf16_t, WS_HB); const unsigned char* U8 = WSP(const unsigned char, WS_UB) + (size_t)layer * NEXP * 2048; const unsigned char* V4 = WSP(const unsigned char, WS_VB2) + (size_t)layer * NEXP * V4_ROW;
    const float* lg = F.in[I_LN2G] + layer * 2048; const float* lb = F.in[I_LN2B] + layer * 2048;
    const int ntok = layer == 0 ? MR : NB * S;
    constexpr int NSLOT = 8;
    ldsp_t ring = F.lds;
#ifndef NPROD
#define NPROD 2
#endif
    const int pw = F.wave - (8 - NPROD);
    ldsp_t pscr = F.lds + 32768 + (pw < 0 ? 0 : pw) * 6144;
    LAS float* lstv = (LAS float*)(pscr); LAS int* lsti = (LAS int*)(pscr + 2176);
    LAS float* es4 = (LAS float*)(pscr + 4352);
    volatile LAS unsigned* ready = (volatile LAS unsigned*)(F.lds + 24576); volatile LAS unsigned* done = ready + NSLOT; LAS unsigned* next_tok = (LAS unsigned*)(F.lds + 24576 + 2 * NSLOT * 4);
    __syncthreads();
    if (F.tid < 2 * NSLOT + 1) ((LAS unsigned*)(F.lds + 24576))[F.tid] = 0u;
    __syncthreads();
    const int ntw = ntok / F.G;
    if (pw >= 0) {
      for (int p = pw; p < ntw / 2; p += NPROD) {
        const int slot = p & (NSLOT - 1);
        while (done[slot] < 2u * (unsigned)(p / NSLOT)) __builtin_amdgcn_s_sleep(2);
        asm volatile("" ::: "memory");
        LAS int* ei4 = (LAS int*)(ring + slot * 2048); LAS float* eg4 = (LAS float*)(ring + slot * 2048 + 512);
        const int tok0 = F.bid + (2 * p) * F.G, nwv = F.G;
        { int lane = F.lane; asm volatile("" : "+v"(lane));
          const int t2 = lane >> 5, set = lane >> 1, sset = set & 15, part = lane & 1;
          const int Rl = tok_row(layer, tok0 + t2 * nwv);
          unsigned key[64];
          const float* sp = SC + (size_t)Rl * 2048 + sset * 128 + part * 64;
#pragma unroll
          for (int i = 0; i < 16; ++i) { const f32x4 v = *(const f32x4*)(sp + 4 * i);
#pragma unroll
              for (int e = 0; e < 4; ++e) key[4 * i + e] = (ordkey(v[e]) & ~127u) | (unsigned)(127 - (64 * part + 4 * i + e)); }
          const unsigned T = lane_radix16<64, 2>(key, lane);
          int c = 0;
#pragma unroll
          for (int n = 0; n < 64; ++n) { if (key[n] >= T) { const int r = set * 17 + (part ? 15 - c : c); lstv[r] = __uint_as_float(inv_ordkey((key[n] & ~127u) | 64u)); lsti[r] = 64 * part + n; ++c; }
              if ((n & 15) == 15) __builtin_amdgcn_sched_barrier(0); }
        }
        asm volatile("s_waitcnt lgkmcnt(0)" ::: "memory");
        {
          int lane = F.lane; asm volatile("" : "+v"(lane));
          const int t2 = lane >> 5, hq = (lane >> 2) & 7, q = lane & 3, sa = (lane >> 2) * 2, sb = sa + 1;
          float Av[4], Bv[16]; int Ai[4], Bi[16];
#pragma unroll
          for (int i = 0; i < 4; ++i) { Av[i] = lstv[sa * 17 + 4 * q + i]; Ai[i] = lsti[sa * 17 + 4 * q + i]; }
#pragma unroll
          for (int jx = 0; jx < 16; ++jx) { Bv[jx] = lstv[sb * 17 + jx]; Bi[jx] = lsti[sb * 17 + jx]; }
          unsigned key[64];
#pragma unroll
          for (int i = 0; i < 4; ++i)
#pragma unroll
              for (int jx = 0; jx < 16; ++jx) key[i * 16 + jx] = (ordkey(Av[i] + Bv[jx]) & ~255u) | (unsigned)(255 - ((4 * q + i) * 16 + jx));
          const unsigned T = lane_radix16<64, 4>(key, lane);
          int mine = 0;
#pragma unroll
          for (int n = 0; n < 64; ++n) mine += key[n] >= T ? 1 : 0;
          const int c1 = __builtin_amdgcn_ds_bpermute((lane ^ 1) << 2, mine), c2 = __builtin_amdgcn_ds_bpermute((lane ^ 2) << 2, mine), c3 = __builtin_amdgcn_ds_bpermute((lane ^ 3) << 2, mine);
          int c = (q == 1) ? c1 : (q == 2) ? c2 + c3 : (q == 3) ? c1 + c2 + c3 : 0;
#pragma unroll
          for (int i = 0; i < 4; ++i) {
#pragma unroll
              for (int jx = 0; jx < 16; ++jx) if (key[i * 16 + jx] >= T) { es4[t2 * 128 + hq * 16 + c] = Av[i] + Bv[jx]; ei4[t2 * 256 + hq * 16 + c] = Ai[i] * 128 + Bi[jx]; ++c; }
              __builtin_amdgcn_sched_barrier(0); }
        }
        asm volatile("s_waitcnt lgkmcnt(0)" ::: "memory");
        { int lane = F.lane; asm volatile("" : "+v"(lane));
#pragma unroll
        for (int rnd = 0; rnd < 4; ++rnd) { const int e = lane + 64 * rnd; const float sv = es4[e];
            float m = sv; m = fmaxf(m, shx(m, 1, lane)); m = fmaxf(m, shx(m, 2, lane)); m = fmaxf(m, shx(m, 4, lane)); m = fmaxf(m, shx(m, 8, lane));
            const float ex = __expf(sv - m); float sum = ex; sum += shx(sum, 1, lane); sum += shx(sum, 2, lane); sum += shx(sum, 4, lane); sum += shx(sum, 8, lane);
            eg4[(e >> 7) * 256 + (e & 127)] = ex / sum; } }
        asm volatile("s_waitcnt lgkmcnt(0)" ::: "memory");
        if (F.lane == 0) ready[slot] = (unsigned)(p + 1);
      }
    } else {
      for (;;) {
        unsigned tq = 0u; if (F.lane == 0) tq = __hip_atomic_fetch_add(next_tok, 1u, __ATOMIC_RELAXED, __HIP_MEMORY_SCOPE_WORKGROUP);
        const int t = __builtin_amdgcn_readfirstlane((int)tq);
        if (t >= ntw) break;
        const int p = t >> 1, slot = p & (NSLOT - 1), tslot = t & 1;
        while (ready[slot] < (unsigned)(p + 1)) __builtin_amdgcn_s_sleep(2);
        asm volatile("" ::: "memory");
        const int tok = F.bid + t * F.G;
        int lane = F.lane; asm volatile("" : "+v"(lane));
        const int R = tok_row(layer, tok), b = R / RB, j = R % RB; const bool isctx = j < CTX; const int modrow = isctx ? 4 : b;
        const LAS int* ei = (const LAS int*)(ring + slot * 2048 + tslot * 1024); const LAS float* eg = (const LAS float*)(ring + slot * 2048 + tslot * 1024 + 512);
        f32x2 xf[16];
#pragma unroll
        for (int i = 0; i < 2; ++i)
#pragma unroll
            for (int hh = 0; hh < 2; ++hh) { const u32x4 w = *(const u32x4*)(HB + (size_t)R * 2048 + lane * 16 + 1024 * i + 8 * hh);
                xf[8 * i + 4 * hh + 0] = (f32x2){bflo(w.x), bfhi(w.x)}; xf[8 * i + 4 * hh + 1] = (f32x2){bflo(w.y), bfhi(w.y)};
                xf[8 * i + 4 * hh + 2] = (f32x2){bflo(w.z), bfhi(w.z)}; xf[8 * i + 4 * hh + 3] = (f32x2){bflo(w.w), bfhi(w.w)}; }
        f32x2 y2[16];
#pragma unroll
        for (int i = 0; i < 16; ++i) y2[i] = (f32x2){0.f, 0.f};
        f32x4 xrow[8];
#pragma unroll
        for (int k = 0; k < 8; ++k) xrow[k] = *(const f32x4*)(X1 + (size_t)R * 2048 + lane * 32 + 4 * k);
        { u32x4 urA[4][2], vrA[4], urB[4][2], vrB[4]; unsigned vsA[4], vsB[4]; float gqA[4], gqB[4];
          peer_load(urA, vrA, vsA, gqA, ei, eg, U8, V4, lane, 0);
          for (int grp = 0; grp < 32; grp += 2) {
              peer_load(urB, vrB, vsB, gqB, ei, eg, U8, V4, lane, grp + 1);
              peer_comp(urA, vrA, vsA, gqA, xf, y2, lane);
              peer_load(urA, vrA, vsA, gqA, ei, eg, U8, V4, lane, grp + 2 < 32 ? grp + 2 : 31);
              peer_comp(urB, vrB, vsB, gqB, xf, y2, lane);
          } }
        asm volatile("s_waitcnt lgkmcnt(0)" ::: "memory");
        if (F.lane == 0) __hip_atomic_fetch_add((LAS unsigned*)(done + slot), 1u, __ATOMIC_RELAXED, __HIP_MEMORY_SCOPE_WORKGROUP);
        const float* mod = WSP(const float, WS_MOD) + ((size_t)layer * 5 + modrow) * 12288;
        float y[32];
        float s = 0.f;
#pragma unroll
        for (int k = 0; k < 8; ++k) { const int c = lane * 32 + 4 * k;
            const f32x4 xa = xrow[k], ga = *(const f32x4*)(mod + 5 * 2048 + c);
            y[4 * k + 0] = ALPHA * xa[0] + ga[0] * y2[2 * k].x; y[4 * k + 1] = ALPHA * xa[1] + ga[1] * y2[2 * k].y;
            y[4 * k + 2] = ALPHA * xa[2] + ga[2] * y2[2 * k + 1].x; y[4 * k + 3] = ALPHA * xa[3] + ga[3] * y2[2 * k + 1].y;
            s += (y[4 * k + 0] + y[4 * k + 1]) + (y[4 * k + 2] + y[4 * k + 3]); }
        const float mean = wave_sum(s, lane) * (1.f / 2048.f); float q2 = 0.f;
#pragma unroll
        for (int i = 0; i < 32; ++i) { const float dd = y[i] - mean; q2 += dd * dd; }
        const float rstd = rsqrtf(wave_sum(q2, lane) * (1.f / 2048.f) + 1e-5f);
        float* dst = layer == 0 ? (isctx ? WSP(float, WS_XC) + ((size_t)b * CTX + j) * 2048 : F.out + ((size_t)b * S + (j - CTX)) * 2048) : F.out + ((size_t)b * S + (j - CTX)) * 2048;
        const float* modn = WSP(const float, WS_MOD) + ((size_t)1 * 5 + modrow) * 12288;
#pragma unroll
        for (int kk = 0; kk < 4; ++kk) { f32x4 o[2];
#pragma unroll
            for (int jj = 0; jj < 2; ++jj) { const int k = 2 * kk + jj, c = lane * 32 + 4 * k; const f32x4 la = *(const f32x4*)(lg + c), ba = *(const f32x4*)(lb + c);
#pragma unroll
                for (int e = 0; e < 4; ++e) o[jj][e] = (y[4 * k + e] - mean) * rstd * la[e] + ba[e];
                *(f32x4*)(dst + c) = o[jj]; }
            if (layer == 0) {
                const int c = lane * 32 + 8 * kk;
                const f32x4 sa = *(const f32x4*)(modn + 2048 + c), sb = *(const f32x4*)(modn + 2048 + c + 4), ha = *(const f32x4*)(modn + c), hb = *(const f32x4*)(modn + c + 4);
                *(u32x4*)(HB + (size_t)R * 2048 + c) = pg8::pack8(o[0] * (sa + 1.0f) + ha, o[1] * (sb + 1.0f) + hb); } }
      }
    }
}

struct Params { const float* in[cf::N_IN]; float* out; unsigned char* ws; int ph_lo, ph_hi; };

__global__ void __launch_bounds__(512, 2) mega_fwd(Params p) {
    using namespace cf;
    extern __shared__ __attribute__((aligned(16))) unsigned char smem[];
    Ctx F0;
    F0.in = p.in;
    F0.out = p.out; F0.ws = p.ws; F0.lds = (ldsp_t)smem;
    F0.tid = 0; F0.lane = 0; F0.wave = __builtin_amdgcn_readfirstlane(threadIdx.x >> 6); F0.G = gridDim.x; F0.bid = blockIdx.x;
    if (threadIdx.x < 64) ((LAS unsigned*)(F0.lds + MISC_OFF))[threadIdx.x] = 0u;
    __syncthreads();
    const int lo = p.ph_lo, hi = p.ph_hi;
    XcdBarrier bar; bar.bar = (unsigned*)(F0.ws + WS_CTL); bar.x = 0; bar.st = (volatile LAS unsigned*)(F0.lds + MISC_OFF); bar.wave = F0.wave;
    if (hi - lo > 1) bar = xcd_barrier_post((unsigned*)(F0.ws + WS_CTL), (volatile LAS unsigned*)(F0.lds + MISC_OFF), F0.wave);
#ifndef MK_MASK
#define MK_MASK 0xFFFF
#endif
#define ON(j) ((MK_MASK >> (j)) & 1)
#define IN(k) (lo <= (k) && (k) < hi)
#define SEAM(k) do { if (IN(k) && IN((k) + 1)) xcd_barrier(bar); } while (0)

    if (ON(9) && IN(0)) { ph_prologue(F0); if (DUPN(9) == 2) { __syncthreads(); ph_prologue(F0); } }
    SEAM(0);
    if (ON(10) && IN(1)) ph_modulate0(F0);
    SEAM(1);
    for (int l = 0; l < DEPTH; ++l) {
        const int pb = 2 + 8 * l;
        const int rmode = l == 0 ? 0 : 1, nMl = l == 0 ? 68 : 64;
        for (int blk = 0; blk < DUPN(12); ++blk) {
        if (blk) xcd_barrier(bar);
        if (ON(0) && IN(pb + 0)) { const Ctx F = phase_ctx(F0);
            pg8::Gemm g{WSP(const bf16_t, WS_HB), WSP(const bf16_t, WS_WIN) + (size_t)l * NC * 2048, 2048, 2048};
            pg8::EpiInProj E{WSP(bf16_t, WS_P), WSP(bf16_t, WS_KB), WSP(const float, WS_COSH), WSP(const float, WS_SINH), WSP(const float, WS_COSR), WSP(const float, WS_SINR),
                             F.in[I_AKN] + l * 128, F.in[I_AQN] + l * 128, WSP(float, WS_SSK), WSP(float, WS_SSQ), WSP(float, WS_SSKV), WSP(float, WS_SSCQ)};
            pg8::TileOrder S; S.init(nMl, 56, F.G, F.bid, rmode);
            for (int dup = 0; dup < DUPN(0); ++dup)
            pg8::gemm_phase(F.lds, g, S, E, F.wave);
            if (l > 0) { pg8::TileOrder S2; S2.init(4, 6, F.G, F.bid, 2); pg8::gemm_phase(F.lds, g, S2, E, F.wave); }
        }
        SEAM(pb + 0);
        if (ON(2) && IN(pb + 1)) { const Ctx F = phase_ctx(F0); bf16_t* P = WSP(bf16_t, WS_P);
            knorm_pass(F);
            { pg8::Gemm g{P + PC_CKV, WSP(const bf16_t, WS_WKVUP) + (size_t)l * 2048 * 256, NC, 256}; pg8::EpiKvUp E{WSP(bf16_t, WS_KB), WSP(bf16_t, WS_VB), WSP(const float, WS_SSKV)};
              pg8::TileOrder S; S.init(68, 8, F.G, F.bid, 0); for (int dup = 0; dup < DUPN(1); ++dup) pg8::gemm_phase(F.lds, g, S, E, F.wave); }
            { pg8::Gemm g{P + PC_CQ, WSP(const bf16_t, WS_WQUP) + (size_t)l * 1536 * 512, NC, 512}; pg8::EpiQUp E{WSP(bf16_t, WS_QB), WSP(const float, WS_COSR), WSP(const float, WS_SINR), WSP(const float, WS_SSCQ)};
              pg8::TileOrder S; S.init(nMl, 6, F.G, F.bid, rmode); for (int dup = 0; dup < DUPN(1); ++dup) pg8::gemm_phase(F.lds, g, S, E, F.wave); }
        }
        SEAM(pb + 1);
        if (ON(3) && IN(pb + 2)) ph_attn(F0, l);
        }
        SEAM(pb + 2);
        if (ON(4) && IN(pb + 3)) { const Ctx F = phase_ctx(F0); bf16_t* P = WSP(bf16_t, WS_P); bf16_t* HB = WSP(bf16_t, WS_HB);
            pg8::Gemm g{WSP(const bf16_t, WS_BR), WSP(const bf16_t, WS_WBR) + (size_t)l * 4 * 2048 * 1024, 4096, 1024};
            pg8::EpiMerge E{HB, P + PC_GATE, NC};
            pg8::TileOrder S; S.init(nMl, 8, F.G, F.bid, rmode, 4, (size_t)1024 * 2, (size_t)2048 * 1024 * 2);
            for (int dup = 0; dup < DUPN(5); ++dup) pg8::gemm_phase(F.lds, g, S, E, F.wave);
        }
        SEAM(pb + 3);
        if (ON(5) && IN(pb + 4)) { const Ctx F = phase_ctx(F0); bf16_t* HB = WSP(bf16_t, WS_HB);
            pg8::Gemm g{HB, WSP(const bf16_t, WS_WO) + (size_t)l * 2048 * 2048, 2048, 2048};
            pg8::EpiWo E{(float*)(F.ws + WS_P + X1_OFF), WSP(const float, WS_MOD) + (size_t)l * 5 * 12288, l == 0 ? F.in[I_X] : (const float*)F.out, F.in[I_CTX]};
            pg8::TileOrder S; S.init(nMl, 8, F.G, F.bid, rmode); for (int dup = 0; dup < DUPN(6); ++dup) pg8::gemm_phase(F.lds, g, S, E, F.wave);
        }
        SEAM(pb + 4);
        if (ON(6) && IN(pb + 5)) ph_ln1(F0, l);
        SEAM(pb + 5);
        if (ON(7) && IN(pb + 6)) { const Ctx F = phase_ctx(F0); bf16_t* HB = WSP(bf16_t, WS_HB);
            pg8::Gemm g{HB, WSP(const bf16_t, WS_WFOLD) + (size_t)l * 2048 * 2048, 2048, 2048}; pg8::EpiF32 E{(float*)(F.ws + WS_P + SC_OFF), 2048};
            pg8::TileOrder S; S.init(nMl, 8, F.G, F.bid, rmode); for (int dup = 0; dup < DUPN(7); ++dup) pg8::gemm_phase(F.lds, g, S, E, F.wave);
        }
        SEAM(pb + 6);
        if (ON(8) && IN(pb + 7)) { ph_peer(F0, l); if (DUPN(8) == 2 && l == 1) ph_peer(F0, l); }
        SEAM(pb + 7);
    }
#undef IN
#undef SEAM
}

extern "C" void kernel_launch(void* const* d_in, const int* in_sizes, int n_in, void* d_out, int out_size, void* d_ws, size_t ws_size, hipStream_t stream) {
    static int grid = 0;
    if (grid == 0) {
        if (n_in != cf::N_IN || out_size != cf::NB * cf::S * cf::D || ws_size < cf::WS_END) {
            fprintf(stderr, "kernel_launch: unexpected shapes: n_in %d out %d ws %zu (need %zu)\n", n_in, out_size, ws_size, (size_t)cf::WS_END); grid = -1; return; }
        int dev = 0, cus = 0;
        if (hipGetDevice(&dev) != hipSuccess || hipDeviceGetAttribute(&cus, hipDeviceAttributeMultiprocessorCount, dev) != hipSuccess || cus < 1) { grid = -1; return; }
        if (hipFuncSetAttribute((const void*)mega_fwd, hipFuncAttributeMaxDynamicSharedMemorySize, cf::LDS_BYTES) != hipSuccess) { fprintf(stderr, "kernel_launch: hipFuncSetAttribute failed\n"); grid = -1; return; }
        int per_cu = 0;
        if (hipOccupancyMaxActiveBlocksPerMultiprocessor(&per_cu, (const void*)mega_fwd, 512, cf::LDS_BYTES) != hipSuccess || per_cu < 1)
            fprintf(stderr, "kernel_launch: note: occupancy query reports %d workgroups per CU\n", per_cu);
        (void)hipGetLastError();
        grid = cus;
    }
    if (grid < 0) return;
    (void)hipMemsetAsync((char*)d_ws + cf::WS_CTL, 0, cf::CTL_BYTES, stream);
    Params p{};
    for (int i = 0; i < cf::N_IN; ++i) p.in[i] = (const float*)d_in[i];
    p.out = (float*)d_out; p.ws = (unsigned char*)d_ws;
#if MK_PER_PHASE
    for (int k = 0; k < cf::N_PHASES; ++k) { p.ph_lo = k; p.ph_hi = k + 1; hipLaunchKernelGGL(mega_fwd, dim3(grid), dim3(512), cf::LDS_BYTES, stream, p); }
#else
    p.ph_lo = 0; p.ph_hi = cf::N_PHASES;
    hipLaunchKernelGGL(mega_fwd, dim3(grid), dim3(512), cf::LDS_BYTES, stream, p);
#endif
    const hipError_t le = hipPeekAtLastError();
    if (le != hipSuccess) fprintf(stderr, "kernel_launch: launch failed: %s\n", hipGetErrorName(le));
}
```

```cpp
#include <hip/hip_runtime.h>
#include <stdint.h>
#include <stdio.h>

#ifndef MK_DUP
#define MK_DUP 0
#endif
#define DUPN(k) (((MK_DUP >> (k)) & 1) ? 2 : 1)
#ifndef MK_PV
#define MK_PV 0
#endif
#ifndef MK_AV
#define MK_AV 0
#endif
#ifndef MK_PER_PHASE
#define MK_PER_PHASE 0
#endif

namespace cf {
constexpr int D = 2048, NB = 4, S = 4096, CTX = 256, RB = CTX + S  , MR = NB * RB  ;
constexpr int DEPTH = 2;
constexpr int PC_AK = 0, PC_AV = 256, PC_CKV = 512, PC_KR = 768, PC_DK = 1024, PC_DV = 1280, PC_KVEND = 1536;
constexpr int PC_AQ = 1536, PC_CQ = 2560, PC_DQ = 3072, PC_GLU = 4096, PC_GATE = 6144, NC = 14336;
constexpr int IN_COLS = 14144;
constexpr int NEXP = 16384;
constexpr float ALPHA = 1.4142135623730951f;
constexpr float LOG2E = 1.4426950408889634f;
constexpr float SCALE_HD = 0.08838834764831845f;
constexpr float SCALE_MLA = 0.07216878364870323f;
enum { I_X = 0, I_C, I_CTX, I_CCTX, I_WADA, I_BADA, I_WIN, I_AQN, I_AKN, I_BQN, I_WQUP, I_BKVN, I_WKVUP, I_CW, I_CB, I_CLG, I_CLB, I_SINK,
       I_WBRA, I_WBRB, I_WBRC, I_WBRD, I_WO, I_LN1G, I_LN1B, I_LN2G, I_LN2B, I_PWQ, I_PSK, I_PU, I_PV, N_IN };
constexpr size_t al(size_t x) { return (x + 255) / 256 * 256; }
constexpr size_t WS_CTL = 0;
constexpr size_t CTL_BYTES = 65536;
constexpr size_t WS_MOD = WS_CTL + CTL_BYTES;
constexpr size_t WS_COSH = WS_MOD + al((size_t)2 * 5 * 12288 * 4);
constexpr size_t WS_SINH = WS_COSH + (size_t)4096 * 64 * 4;
constexpr size_t WS_COSR = WS_SINH + (size_t)4096 * 64 * 4;
constexpr size_t WS_SINR = WS_COSR + (size_t)4096 * 32 * 4;
constexpr size_t WS_WIN = WS_SINR + (size_t)4096 * 32 * 4;
constexpr size_t WS_WQUP = WS_WIN + (size_t)2 * NC * 2048 * 2;
constexpr size_t WS_WKVUP = WS_WQUP + (size_t)2 * 1536 * 512 * 2;
constexpr size_t WS_WBR = WS_WKVUP + (size_t)2 * 2048 * 256 * 2;
constexpr size_t WS_WO = WS_WBR + (size_t)2 * 4 * 2048 * 1024 * 2;
constexpr size_t WS_WFOLD = WS_WO + (size_t)2 * 2048 * 2048 * 2;
constexpr size_t WS_UB = WS_WFOLD + (size_t)2 * 2048 * 2048 * 2;
constexpr size_t WS_VB2 = WS_UB + (size_t)2 * NEXP * 2048;
constexpr size_t WS_HB = WS_VB2 + (size_t)2 * NEXP * 2048;
constexpr size_t WS_P = WS_HB + (size_t)MR * 2048 * 2;
constexpr size_t WS_QB = WS_P + (size_t)MR * NC * 2;
constexpr size_t WS_KB = WS_QB + (size_t)MR * 1536 * 2;
constexpr size_t WS_VB = WS_KB + (size_t)MR * 1536 * 2;
constexpr size_t WS_BR = WS_VB + (size_t)MR * 1024 * 2;
constexpr size_t WS_XC = WS_BR + (size_t)MR * 4096 * 2;
constexpr size_t WS_SSK = WS_XC + (size_t)1024 * 2048 * 4;
constexpr size_t WS_SSQ = WS_SSK + (size_t)MR * 4 * 4;
constexpr size_t WS_SSKV = WS_SSQ + (size_t)MR * 16 * 4;
constexpr size_t WS_SSCQ = WS_SSKV + (size_t)MR * 4 * 4;
constexpr size_t WS_END = WS_SSCQ + (size_t)MR * 8 * 4;
constexpr size_t X1_OFF = 0, SC_OFF = (size_t)MR * 2048 * 4;
static_assert(SC_OFF * 2 <= (size_t)MR * NC * 2, "X1 + SC fit in P");
constexpr int LDS_BYTES = 132 * 1024;
constexpr int MISC_OFF = 128 * 1024;
constexpr int N_PHASES = 2 + 8 * DEPTH;
}

typedef unsigned short bf16_t;
typedef short bf16x8 __attribute__((ext_vector_type(8)));
typedef float f32x4 __attribute__((ext_vector_type(4)));
typedef float f32x2 __attribute__((ext_vector_type(2)));
typedef unsigned u32x4 __attribute__((ext_vector_type(4)));
typedef unsigned u32x2 __attribute__((ext_vector_type(2)));
#define LAS __attribute__((address_space(3)))
typedef LAS unsigned char* ldsp_t;

typedef __bf16 bf16x2v_t __attribute__((ext_vector_type(2)));
__device__ __forceinline__ unsigned cvt_pk_bf16(float lo, float hi) { const bf16x2v_t r = __builtin_convertvector((f32x2){lo, hi}, bf16x2v_t); return __builtin_bit_cast(unsigned, r); }
__device__ __forceinline__ bf16_t f2bf(float f) { return (bf16_t)(cvt_pk_bf16(f, 0.f) & 0xffffu); }
__device__ __forceinline__ float bf2f(bf16_t b) { return __uint_as_float(((unsigned)b) << 16); }
__device__ __forceinline__ float bflo(unsigned w) { return __uint_as_float(w << 16); }
__device__ __forceinline__ float bfhi(unsigned w) { return __uint_as_float(w & 0xffff0000u); }
__device__ __forceinline__ float shx(float v, int mask, int lane) { return __int_as_float(__builtin_amdgcn_ds_bpermute((lane ^ mask) << 2, __float_as_int(v))); }
__device__ __forceinline__ float wave_sum(float v, int lane) {
#pragma unroll
    for (int o = 32; o >= 1; o >>= 1) v += shx(v, o, lane);
    return v;
}
__device__ __forceinline__ int lane_id() { int l; asm volatile("v_mbcnt_lo_u32_b32 %0, -1, 0\n\tv_mbcnt_hi_u32_b32 %0, -1, %0" : "=v"(l)); return l; }
__device__ __forceinline__ float sigmoidf_(float x) { return __builtin_amdgcn_rcpf(1.0f + __builtin_amdgcn_exp2f(x * -1.4426950408889634f)); }

#define XB_TMO      128
#define XB_XCNT(j)  (256  + 64 * (j))
#define XB_XSUB(j)  (1280 + 64 * (j))
#define XB_XGEN(j)  (2304 + 64 * (j))
#define XB_TOP      3328
#define XB_TOPGEN   3392
#define XCD_BAR_WORDS 3456
#define XB_SPIN_CAP (1u << 23)
__device__ __forceinline__ unsigned xb_ld(unsigned* p)              { return __hip_atomic_load(p, __ATOMIC_RELAXED, __HIP_MEMORY_SCOPE_AGENT); }
__device__ __forceinline__ unsigned xb_add(unsigned* p, unsigned v) { return __hip_atomic_fetch_add(p, v, __ATOMIC_RELAXED, __HIP_MEMORY_SCOPE_AGENT); }
__device__ __forceinline__ unsigned xb_xcc_id() { return (unsigned)__builtin_amdgcn_s_getreg((3 << 11) | 20) & 0xFu; }
#define XB_SPIN(cond, bar) do { unsigned _sp = 0; while (cond) { __builtin_amdgcn_s_sleep(1); \
    if ((++_sp & 255u) == 0u) { if (xb_ld(&(bar)[XB_TMO])) break; if (_sp > XB_SPIN_CAP) { atomicAdd(&(bar)[XB_TMO], 1u); break; } } } } while (0)
struct XcdBarrier { unsigned* bar; unsigned x; volatile LAS unsigned* st; int wave; };
__device__ __forceinline__ XcdBarrier xcd_barrier_post(unsigned* bar, volatile LAS unsigned* st, int wave) {
    XcdBarrier b; b.bar = bar; b.x = xb_xcc_id(); b.st = st; b.wave = wave;
    if (wave == 0 && lane_id() == 0) (void)xb_add(&bar[XB_XCNT(b.x)], 1u);
    return b;
}
__device__ __forceinline__ void xcd_barrier_complete(unsigned* bar, unsigned x, unsigned& nloc, unsigned& nx) {
    const unsigned G = gridDim.x * gridDim.y * gridDim.z;
    unsigned sum, cnt, mine, sp = 0u;
    for (;;) {
        sum = 0u; cnt = 0u; mine = 0u;
#pragma unroll
        for (unsigned j = 0; j < 16; ++j) { const unsigned c = xb_ld(&bar[XB_XCNT(j)]); sum += c; cnt += (c > 0u) ? 1u : 0u; mine = (j == x) ? c : mine; }
        if (sum == G) break;
        __builtin_amdgcn_s_sleep(1);
        if ((++sp & 255u) == 0u) { if (xb_ld(&bar[XB_TMO])) break; if (sp > XB_SPIN_CAP) { atomicAdd(&bar[XB_TMO], 1u); break; } }
    }
    nloc = mine > 0u ? mine : 1u; nx = cnt > 0u ? cnt : 1u;
}
__device__ __forceinline__ void xcd_barrier(const XcdBarrier& b) {
    asm volatile("s_waitcnt vmcnt(0)" ::: "memory");
    __syncthreads();
    if (b.wave == 0 && lane_id() == 0) {
        unsigned* bar = b.bar;
        __builtin_amdgcn_s_waitcnt(0);
        unsigned nloc = b.st[0], nx = b.st[1];
        if (nloc == 0u) { xcd_barrier_complete(bar, b.x, nloc, nx); b.st[0] = nloc; b.st[1] = nx; }
        const unsigned old = xb_add(&bar[XB_XSUB(b.x)], 1u);
        const unsigned gen = old / nloc;
        if (old + 1u == (gen + 1u) * nloc) {
            __builtin_amdgcn_fence(__ATOMIC_RELEASE, "agent");
            asm volatile("s_waitcnt vmcnt(0)" ::: "memory");
            const unsigned og = xb_add(&bar[XB_TOP], 1u);
            const unsigned tg = og / nx;
            if (og + 1u == (tg + 1u) * nx) xb_add(&bar[XB_TOPGEN], 1u);
            else XB_SPIN(xb_ld(&bar[XB_TOPGEN]) == tg, bar);
            __builtin_amdgcn_fence(__ATOMIC_ACQUIRE, "agent");
            xb_add(&bar[XB_XGEN(b.x)], 1u);
            asm volatile("s_waitcnt vmcnt(0)" ::: "memory");
        } else {
            XB_SPIN(xb_ld(&bar[XB_XGEN(b.x)]) == gen, bar);
            __builtin_amdgcn_fence(__ATOMIC_ACQUIRE, "agent");
            asm volatile("s_waitcnt vmcnt(0)" ::: "memory");
        }
    }
    __syncthreads();
}

namespace pg8 {
constexpr int BM = 256, BK = 64, HALF = 128, HTB = HALF * BK * 2, STAGE_BYTES = 8 * HTB, NXCD = 8, WGM = 8;
__host__ __device__ __forceinline__ int lds_byte(int r, int c) { const int st = (r >> 4) * 2 + (c >> 5), rr = r & 15, cc = c & 31, ob = rr * 64 + cc * 2; return st * 1024 + (ob ^ (((ob >> 9) & 1) << 5)); }
__host__ __device__ __forceinline__ void stage_rc(int b, int& R, int& C) { const int st = b / 1024, sb = b % 1024, swz = sb ^ (((sb >> 9) & 1) << 5); R = (st >> 1) * 16 + swz / 64; C = (st & 1) * 32 + (swz % 64) / 2; }
__host__ __device__ __forceinline__ int perm32(int rho) { const int n = rho >> 4, i = rho & 15; return 8 * (i >> 2) + 4 * n + (i & 3); }
struct Unit { int pm, pn, sub; };
struct Gemm { const bf16_t* A; const bf16_t* Bt; int lda, K; };

struct TileOrder {
    int nM, nN, nwg, G, c, mode, nsub; size_t subA, subB;
    __device__ void init(int nM_, int nN_, int G_, int c_, int mode_, int nsub_ = 1, size_t subA_ = 0, size_t subB_ = 0) { nM = nM_; nN = nN_; nwg = nM * nN; G = G_; c = c_; mode = mode_; nsub = nsub_; subA = subA_; subB = subB_; }
    __device__ bool next(int i, Unit& u) const {
        const int it = nsub == 1 ? i : i / nsub; u.sub = nsub == 1 ? 0 : i - it * nsub;
        const long L = (long)it * G + c; if (L >= nwg) return false;
        int wgid = (int)L; { const int q = nwg / NXCD, r = nwg % NXCD, xcd = wgid % NXCD, off = wgid / NXCD; wgid = (xcd < r ? xcd * (q + 1) : r * (q + 1) + (xcd - r) * q) + off; }
        const int nig = WGM * nN, gid = wgid / nig, fm = gid * WGM, gsz = (nM - fm) < WGM ? (nM - fm) : WGM;
        const int pl = fm + ((wgid % nig) % gsz); u.pn = (wgid % nig) / gsz;
        u.pm = mode == 0 ? pl : (mode == 1 ? 17 * (pl >> 4) + 1 + (pl & 15) : 17 * pl);
        return true;
    }
    __device__ __forceinline__ void a_ready(const Unit&) const {}
    __device__ __forceinline__ void done(const Unit&) const {}
};

template <class Epi, class Sched>
__device__ __forceinline__ void gemm_phase(ldsp_t lds, const Gemm g, const Sched& S, const Epi& E, int wave_) {
    int tid = wave_ * 64 + lane_id(); asm volatile("" : "+v"(tid));
    const int wid = __builtin_amdgcn_readfirstlane(tid >> 6), lane = tid & 63, wr = wid >> 2, wc = wid & 3, fr = lane & 15, fq = lane >> 4;
    int K = g.K; asm volatile("" : "+s"(K));
    const int nt = K / BK, lda = g.lda;
    unsigned voffA[2], voffB[2];
#pragma unroll
    for (int i = 0; i < 2; ++i) { int R, C; stage_rc(tid * 16 + i * 8192, R, C); const int Rb = (R & ~31) + perm32(R & 31);
        voffA[i] = (unsigned)(R * lda + C) * 2u; voffB[i] = (unsigned)(Rb * K + C) * 2u; }
    const size_t kstep = (size_t)(BK * 2);
    const size_t hstepA = (size_t)HALF * lda * 2, hstepB = (size_t)HALF * K * 2;
    const size_t tstepA = 2 * hstepA, tstepB = 2 * hstepB;
    const unsigned ldsw = (unsigned)wid * 1024u;
    const int aoff = lds_byte(wr * 64 + fr, fq * 8), boff = lds_byte(wc * 32 + fr, fq * 8);
#define PG8_SA(b, h) (((b) * 2 + (h)) * HTB)
#define PG8_SB(b, h) ((4 + (b) * 2 + (h)) * HTB)
#define PG8_STAGE(bufoff, gbase, voff) do { _Pragma("unroll") for (int _i = 0; _i < 2; ++_i) \
        __builtin_amdgcn_global_load_lds((const unsigned*)((const char*)(gbase) + (voff)[_i]), (LAS unsigned*)(lds + (bufoff) + ldsw + _i * 8192), 16, 0, 0); } while (0)
#define PG8_LDA(dst, b, h) do { _Pragma("unroll") for (int m = 0; m < 4; ++m) _Pragma("unroll") for (int k = 0; k < 2; ++k) dst[m][k] = *(const LAS bf16x8*)(lds + PG8_SA(b, h) + aoff + m * 2048 + k * 1024); } while (0)
#define PG8_LDB(dst, b, h) do { _Pragma("unroll") for (int n = 0; n < 2; ++n) _Pragma("unroll") for (int k = 0; k < 2; ++k) dst[n][k] = *(const LAS bf16x8*)(lds + PG8_SB(b, h) + boff + n * 2048 + k * 1024); } while (0)
#define PG8_MMA(ai, bj, At, Bt) do { __builtin_amdgcn_s_setprio(1); _Pragma("unroll") for (int m = 0; m < 4; ++m) _Pragma("unroll") for (int n = 0; n < 2; ++n) _Pragma("unroll") for (int k = 0; k < 2; ++k) \
        acc[ai][bj][m][n] = __builtin_amdgcn_mfma_f32_16x16x32_bf16(Bt[n][k], At[m][k], acc[ai][bj][m][n], 0, 0, 0); __builtin_amdgcn_s_setprio(0); } while (0)
#define PG8_WAIT_V(n) asm volatile("s_waitcnt vmcnt(" #n ")" ::: "memory")
#define PG8_WAIT_L(n) asm volatile("s_waitcnt lgkmcnt(" #n ")" ::: "memory")
#define PG8_BAR __builtin_amdgcn_s_barrier()
#define PG8_SCHED __builtin_amdgcn_sched_barrier(0)
    Unit cur, nxt; int ui = 0;
    if (!S.next(0, cur)) return;
    f32x4 acc[2][2][4][2];
#pragma unroll
    for (int a = 0; a < 2; ++a)
#pragma unroll
        for (int b = 0; b < 2; ++b)
#pragma unroll
            for (int m = 0; m < 4; ++m)
#pragma unroll
                for (int n = 0; n < 2; ++n) acc[a][b][m][n] = (f32x4){0.f, 0.f, 0.f, 0.f};
    bf16x8 At[4][2], B0[2][2], B1[2][2];
    const char* cA = (const char*)g.A + (size_t)cur.pm * tstepA + cur.sub * S.subA; const char* cB = (const char*)g.Bt + (size_t)cur.pn * tstepB + cur.sub * S.subB;
    S.a_ready(cur);
    PG8_STAGE(PG8_SB(0, 0), cB, voffB); PG8_STAGE(PG8_SA(0, 0), cA, voffA); PG8_STAGE(PG8_SB(0, 1), cB + hstepB, voffB); PG8_STAGE(PG8_SA(0, 1), cA + hstepA, voffA);
    if (wr == 1) PG8_BAR;
    PG8_WAIT_V(4); PG8_BAR;
    PG8_STAGE(PG8_SB(1, 0), cB + kstep, voffB); PG8_STAGE(PG8_SA(1, 0), cA + kstep, voffA); PG8_STAGE(PG8_SB(1, 1), cB + hstepB + kstep, voffB);
    PG8_WAIT_V(6); PG8_BAR;
    for (;;) {
        const bool has_next = S.next(ui + 1, nxt);
        const char* nA = has_next ? (const char*)g.A + (size_t)nxt.pm * tstepA + nxt.sub * S.subA : cA; const char* nB = has_next ? (const char*)g.Bt + (size_t)nxt.pn * tstepB + nxt.sub * S.subB : cB;
#pragma unroll 1
        for (int t = 0; t < nt; t += 2) {
            const bool last = (t == nt - 2);
            const char* a1 = cA + (size_t)(t + 1) * kstep;
            const char* a2 = last ? nA : cA + (size_t)(t + 2) * kstep; const char* b2 = last ? nB : cB + (size_t)(t + 2) * kstep;
            const char* a3 = a2 + kstep; const char* b3 = b2 + kstep;
            if (last && has_next) S.a_ready(nxt);
            PG8_LDB(B0, 0, 0); PG8_SCHED; PG8_LDA(At, 0, 0); PG8_STAGE(PG8_SA(1, 1), a1 + hstepA, voffA);
            PG8_WAIT_L(8); PG8_BAR; PG8_WAIT_L(0); PG8_MMA(0, 0, At, B0); PG8_BAR; PG8_SCHED;
            PG8_LDB(B1, 0, 1); PG8_STAGE(PG8_SB(0, 0), b2, voffB);
            PG8_BAR; PG8_WAIT_L(0); PG8_MMA(0, 1, At, B1); PG8_BAR;
            PG8_LDA(At, 0, 1); PG8_STAGE(PG8_SA(0, 0), a2, voffA);
            PG8_BAR; PG8_WAIT_L(0); PG8_MMA(1, 0, At, B0); PG8_BAR; PG8_SCHED;
            PG8_STAGE(PG8_SB(0, 1), b2 + hstepB, voffB);
            PG8_WAIT_V(6); PG8_BAR; PG8_MMA(1, 1, At, B1); PG8_BAR;
            PG8_LDB(B0, 1, 0); PG8_SCHED; PG8_LDA(At, 1, 0); PG8_STAGE(PG8_SA(0, 1), a2 + hstepA, voffA);
            PG8_WAIT_L(8); PG8_BAR; PG8_WAIT_L(0); PG8_MMA(0, 0, At, B0); PG8_BAR; PG8_SCHED;
            PG8_LDB(B1, 1, 1); PG8_STAGE(PG8_SB(1, 0), b3, voffB);
            PG8_BAR; PG8_WAIT_L(0); PG8_MMA(0, 1, At, B1); PG8_BAR;
            PG8_LDA(At, 1, 1); PG8_STAGE(PG8_SA(1, 0), a3, voffA);
            PG8_BAR; PG8_WAIT_L(0); PG8_MMA(1, 0, At, B0); PG8_BAR; PG8_SCHED;
            PG8_STAGE(PG8_SB(1, 1), b3 + hstepB, voffB);
            PG8_WAIT_V(6); PG8_BAR; PG8_MMA(1, 1, At, B1); PG8_BAR;
        }
        E(acc, cur, wr, wc, fr, fq); S.done(cur);
        if (!has_next) break;
#pragma unroll
        for (int a = 0; a < 2; ++a)
#pragma unroll
            for (int b = 0; b < 2; ++b)
#pragma unroll
                for (int m = 0; m < 4; ++m)
#pragma unroll
                    for (int n = 0; n < 2; ++n) acc[a][b][m][n] = (f32x4){0.f, 0.f, 0.f, 0.f};
        cur = nxt; cA = nA; cB = nB; ++ui;
    }
    PG8_WAIT_V(0);
    if (wr == 0) PG8_BAR;
    PG8_BAR;
#undef PG8_SA
#undef PG8_SB
#undef PG8_STAGE
#undef PG8_LDA
#undef PG8_LDB
#undef PG8_MMA
#undef PG8_WAIT_V
#undef PG8_WAIT_L
#undef PG8_BAR
#undef PG8_SCHED
}

__device__ __forceinline__ u32x4 pack8(const f32x4 a, const f32x4 b) { u32x4 w; w.x = cvt_pk_bf16(a[0], a[1]); w.y = cvt_pk_bf16(a[2], a[3]); w.z = cvt_pk_bf16(b[0], b[1]); w.w = cvt_pk_bf16(b[2], b[3]); return w; }
#define EPI_ARGS const f32x4 (&acc)[2][2][4][2], const Unit& u, int wr, int wc, int fr_, int fq_
#define EPI_LANE int fr = fr_, fq = fq_; asm volatile("" : "+v"(fr), "+v"(fq));

struct EpiBf16 {
    bf16_t* O; int ldc;
    __device__ __forceinline__ void operator()(EPI_ARGS) const {
        EPI_LANE
        const int row0 = u.pm * BM + wr * 64 + fr, col0 = u.pn * BM + wc * 32 + 8 * fq;
#pragma unroll
        for (int ai = 0; ai < 2; ++ai)
#pragma unroll
            for (int m = 0; m < 4; ++m) { bf16_t* rowp = O + (size_t)(row0 + ai * HALF + m * 16) * ldc + col0;
#pragma unroll
                for (int bj = 0; bj < 2; ++bj) *(u32x4*)(rowp + bj * HALF) = pack8(acc[ai][bj][m][0], acc[ai][bj][m][1]); }
    }
};
struct EpiF32 {
    float* C; int ldc;
    __device__ __forceinline__ void operator()(EPI_ARGS) const {
        EPI_LANE
        const int row0 = u.pm * BM + wr * 64 + fr, col0 = u.pn * BM + wc * 32 + 8 * fq;
#pragma unroll
        for (int ai = 0; ai < 2; ++ai)
#pragma unroll
            for (int m = 0; m < 4; ++m) { float* rowp = C + (size_t)(row0 + ai * HALF + m * 16) * ldc + col0;
#pragma unroll
                for (int bj = 0; bj < 2; ++bj) { *(f32x4*)(rowp + bj * HALF) = acc[ai][bj][m][0]; *(f32x4*)(rowp + bj * HALF + 4) = acc[ai][bj][m][1]; } }
    }
};
struct EpiInProj {
    bf16_t* P; bf16_t* KB; const float* cosh; const float* sinh; const float* cosr; const float* sinr; const float* akn; const float* aqn;
    float* ssk; float* ssq; float* sskv; float* sscq;
    __device__ __forceinline__ void operator()(EPI_ARGS) const {
        EPI_LANE
        const int pn = u.pn, tb = u.pm % 17; const bool lat = tb != 0; const int posbase = (tb - 1) * 256;
        const int rl0 = wr * 64 + fr;
        if (pn >= 24) {
            const int col0 = pn * BM + wc * 32 + 8 * fq;
#pragma unroll
            for (int ai = 0; ai < 2; ++ai)
#pragma unroll
                for (int m = 0; m < 4; ++m) { bf16_t* rowp = P + ((size_t)u.pm * BM + rl0 + ai * HALF + m * 16) * cf::NC + col0;
#pragma unroll
                    for (int bj = 0; bj < 2; ++bj) { f32x4 v0 = acc[ai][bj][m][0], v1 = acc[ai][bj][m][1];
#pragma unroll
                        for (int e = 0; e < 4; ++e) { v0[e] = sigmoidf_(v0[e]); v1[e] = sigmoidf_(v1[e]); }
                        *(u32x4*)(rowp + bj * HALF) = pack8(v0, v1); } }
        } else if (pn >= 16) {
            const int col0 = cf::PC_GLU + 128 * (pn - 16) + wc * 32 + 8 * fq;
#pragma unroll
            for (int ai = 0; ai < 2; ++ai)
#pragma unroll
                for (int m = 0; m < 4; ++m) { f32x4 v0 = acc[ai][0][m][0], v1 = acc[ai][0][m][1]; const f32x4 g0 = acc[ai][1][m][0], g1 = acc[ai][1][m][1];
#pragma unroll
                    for (int e = 0; e < 4; ++e) { v0[e] *= sigmoidf_(g0[e]); v1[e] *= sigmoidf_(g1[e]); }
                    *(u32x4*)(P + ((size_t)u.pm * BM + rl0 + ai * HALF + m * 16) * cf::NC + col0) = pack8(v0, v1); }
        } else if (pn == 3) {
            if (wc == 0) { const int i0 = 8 * fq;
#pragma unroll
                for (int ai = 0; ai < 2; ++ai)
#pragma unroll
                    for (int m = 0; m < 4; ++m) { const int rl = rl0 + ai * HALF + m * 16;
                        f32x4 c0 = {1.f, 1.f, 1.f, 1.f}, c1 = c0, s0 = {0.f, 0.f, 0.f, 0.f}, s1 = s0;
                        if (lat) { const float* cp = cosr + (size_t)(posbase + rl) * 32 + i0; const float* sp = sinr + (size_t)(posbase + rl) * 32 + i0;
                            c0 = *(const f32x4*)cp; c1 = *(const f32x4*)(cp + 4); s0 = *(const f32x4*)sp; s1 = *(const f32x4*)(sp + 4); }
                        const f32x4 x1a = acc[ai][0][m][0], x1b = acc[ai][0][m][1], x2a = acc[ai][1][m][0], x2b = acc[ai][1][m][1];
                        const u32x4 w1 = pack8(x1a * c0 - x2a * s0, x1b * c1 - x2b * s1), w2 = pack8(x2a * c0 + x1a * s0, x2b * c1 + x1b * s1);
                        bf16_t* kb = KB + ((size_t)u.pm * BM + rl) * 1536 + 128 + i0;
#pragma unroll
                        for (int h = 0; h < 8; ++h) { *(u32x4*)(kb + h * 192) = w1; *(u32x4*)(kb + h * 192 + 32) = w2; }
                        asm volatile("" ::: "memory"); } }
        } else if (pn == 0 || pn == 4 || (pn >= 6 && pn <= 9) || pn >= 12) {
            const bool norm = pn == 0 || (pn >= 6 && pn <= 9);
            const int hl = wc >> 1, i0 = 32 * (wc & 1) + 8 * fq;
            f32x4 g1a = {1.f, 1.f, 1.f, 1.f}, g1b = g1a, g2a = g1a, g2b = g1a;
            if (norm) { const float* gn = (pn == 0 ? akn : aqn) + i0; g1a = *(const f32x4*)gn; g1b = *(const f32x4*)(gn + 4); g2a = *(const f32x4*)(gn + 64); g2b = *(const f32x4*)(gn + 68); }
            float* ssp = pn == 0 ? ssk + ((size_t)u.pm * BM * 2 + hl) * 2 + (wc & 1) : ssq + ((size_t)u.pm * BM * 8 + (pn - 6) * 2 + hl) * 2 + (wc & 1);
            const int sstr = pn == 0 ? 4 : 16;
#pragma unroll
            for (int ai = 0; ai < 2; ++ai)
#pragma unroll
                for (int m = 0; m < 4; ++m) { const int rl = rl0 + ai * HALF + m * 16;
                    f32x4 x1a = acc[ai][0][m][0], x1b = acc[ai][0][m][1], x2a = acc[ai][1][m][0], x2b = acc[ai][1][m][1];
                    if (norm) { const f32x4 q = x1a * x1a + x1b * x1b + x2a * x2a + x2b * x2b; float ss = (q[0] + q[1]) + (q[2] + q[3]);
                        ss += shx(ss, 16, fr + 16 * fq); ss += shx(ss, 32, fr + 16 * fq);
                        if (fq == 0) ssp[(size_t)rl * sstr] = ss;
                        x1a *= g1a; x1b *= g1b; x2a *= g2a; x2b *= g2b; }
                    f32x4 o1a = x1a, o1b = x1b, o2a = x2a, o2b = x2b;
                    if (lat) { const float* cp = cosh + (size_t)(posbase + rl) * 64 + i0; const float* sp = sinh + (size_t)(posbase + rl) * 64 + i0;
                        const f32x4 c0 = *(const f32x4*)cp, c1 = *(const f32x4*)(cp + 4), s0 = *(const f32x4*)sp, s1 = *(const f32x4*)(sp + 4);
                        o1a = x1a * c0 - x2a * s0; o1b = x1b * c1 - x2b * s1; o2a = x2a * c0 + x1a * s0; o2b = x2b * c1 + x1b * s1; }
                    bf16_t* dst = P + ((size_t)u.pm * BM + rl) * cf::NC + pn * BM + hl * 128 + i0;
                    *(u32x4*)dst = pack8(o1a, o1b); *(u32x4*)(dst + 64) = pack8(o2a, o2b);
                    asm volatile("" ::: "memory"); }
        } else {
            const int col0 = pn * BM + wc * 32 + 8 * fq;
            const bool ssq_on = pn == 2 || pn == 10 || pn == 11;
            float* ssp = pn == 2 ? sskv + (size_t)u.pm * BM * 4 + wc : sscq + (size_t)u.pm * BM * 8 + (pn - 10) * 4 + wc;
            const int sstr = pn == 2 ? 4 : 8;
#pragma unroll
            for (int ai = 0; ai < 2; ++ai)
#pragma unroll
                for (int m = 0; m < 4; ++m) { const int rl = rl0 + ai * HALF + m * 16; bf16_t* rowp = P + ((size_t)u.pm * BM + rl) * cf::NC + col0;
#pragma unroll
                    for (int bj = 0; bj < 2; ++bj) *(u32x4*)(rowp + bj * HALF) = pack8(acc[ai][bj][m][0], acc[ai][bj][m][1]);
                    if (ssq_on) { const f32x4 q = acc[ai][0][m][0] * acc[ai][0][m][0] + acc[ai][0][m][1] * acc[ai][0][m][1] + acc[ai][1][m][0] * acc[ai][1][m][0] + acc[ai][1][m][1] * acc[ai][1][m][1];
                        float ss = (q[0] + q[1]) + (q[2] + q[3]); ss += shx(ss, 16, fr + 16 * fq); ss += shx(ss, 32, fr + 16 * fq);
                        if (fq == 0) ssp[(size_t)rl * sstr] = ss; } }
        }
    }
};
struct EpiKvUp {
    bf16_t* KB; bf16_t* VB; const float* sskv;
    __device__ __forceinline__ void operator()(EPI_ARGS) const {
        EPI_LANE
        const int row0 = u.pm * BM + wr * 64 + fr, d0 = wc * 32 + 8 * fq;
        const bool isk = u.pn < 4;
        bf16_t* base = isk ? KB + (2 * u.pn) * 192 + d0 : VB + (u.pn - 4) * 256 + d0;
        const int ldr = isk ? 1536 : 1024, bjs = isk ? 192 : 128;
#pragma unroll
        for (int ai = 0; ai < 2; ++ai)
#pragma unroll
            for (int m = 0; m < 4; ++m) { const size_t row = (size_t)(row0 + ai * HALF + m * 16); bf16_t* rowp = base + row * ldr;
                const f32x4 pp = *(const f32x4*)(sskv + row * 4); const float r = rsqrtf(((pp[0] + pp[1]) + (pp[2] + pp[3])) * (1.f / 256.f) + 1e-6f);
#pragma unroll
                for (int bj = 0; bj < 2; ++bj) *(u32x4*)(rowp + bj * bjs) = pack8(acc[ai][bj][m][0] * r, acc[ai][bj][m][1] * r); }
    }
};
struct EpiQUp {
    bf16_t* QB; const float* cosr; const float* sinr; const float* sscq;
    __device__ __forceinline__ void operator()(EPI_ARGS) const {
        EPI_LANE
        const int row0 = u.pm * BM + wr * 64 + fr;
        if (u.pn < 4) {
            const int d0 = wc * 32 + 8 * fq;
#pragma unroll
            for (int ai = 0; ai < 2; ++ai)
#pragma unroll
                for (int m = 0; m < 4; ++m) { const size_t row = (size_t)(row0 + ai * HALF + m * 16);
                    const f32x4 pa = *(const f32x4*)(sscq + row * 8), pb = *(const f32x4*)(sscq + row * 8 + 4);
                    const float r = rsqrtf((((pa[0] + pa[1]) + (pa[2] + pa[3])) + ((pb[0] + pb[1]) + (pb[2] + pb[3]))) * (1.f / 512.f) + 1e-6f);
#pragma unroll
                    for (int bj = 0; bj < 2; ++bj) *(u32x4*)(QB + row * 1536 + (2 * u.pn + bj) * 192 + d0) = pack8(acc[ai][bj][m][0] * r, acc[ai][bj][m][1] * r); }
        } else {
            const int head = 4 * (u.pn - 4) + wc, i0 = 8 * fq;
            const bool lat = (u.pm % 17) != 0; const int posbase = (u.pm % 17) * 256 - 256;
#pragma unroll
            for (int ai = 0; ai < 2; ++ai)
#pragma unroll
                for (int m = 0; m < 4; ++m) { const int rl = wr * 64 + fr + ai * HALF + m * 16; const size_t row = (size_t)u.pm * BM + rl;
                    const f32x4 pa = *(const f32x4*)(sscq + row * 8), pb = *(const f32x4*)(sscq + row * 8 + 4);
                    const float r = rsqrtf((((pa[0] + pa[1]) + (pa[2] + pa[3])) + ((pb[0] + pb[1]) + (pb[2] + pb[3]))) * (1.f / 512.f) + 1e-6f);
                    f32x4 c0 = {1.f, 1.f, 1.f, 1.f}, c1 = c0, s0 = {0.f, 0.f, 0.f, 0.f}, s1 = s0;
                    if (lat) { const float* cp = cosr + (size_t)(posbase + rl) * 32 + i0; const float* sp = sinr + (size_t)(posbase + rl) * 32 + i0;
                        c0 = *(const f32x4*)cp; c1 = *(const f32x4*)(cp + 4); s0 = *(const f32x4*)sp; s1 = *(const f32x4*)(sp + 4); }
                    const f32x4 x1a = acc[ai][0][m][0] * r, x1b = acc[ai][0][m][1] * r, x2a = acc[ai][1][m][0] * r, x2b = acc[ai][1][m][1] * r;
                    const f32x4 o1a = x1a * c0 - x2a * s0, o1b = x1b * c1 - x2b * s1, o2a = x2a * c0 + x1a * s0, o2b = x2b * c1 + x1b * s1;
                    bf16_t* dst = QB + row * 1536 + head * 192 + 128 + i0;
                    *(u32x4*)dst = pack8(o1a, o1b); *(u32x4*)(dst + 32) = pack8(o2a, o2b); asm volatile("" ::: "memory"); }
        }
    }
};
struct EpiMerge {
    bf16_t* ACC; const bf16_t* gate0; int ldg;
    __device__ __forceinline__ void operator()(EPI_ARGS) const {
        EPI_LANE
        const int row0 = u.pm * BM + wr * 64 + fr, col0 = u.pn * BM + wc * 32 + 8 * fq;
        const bf16_t* gate = gate0 + u.sub * 2048; const bool first = u.sub == 0;
#pragma unroll
        for (int ai = 0; ai < 2; ++ai) {
            u32x4 gw[4][2], pw[4][2];
#pragma unroll
            for (int m = 0; m < 4; ++m) { const size_t row = (size_t)(row0 + ai * HALF + m * 16);
#pragma unroll
                for (int bj = 0; bj < 2; ++bj) { const int col = col0 + bj * HALF; gw[m][bj] = *(const u32x4*)(gate + row * ldg + col);
                    pw[m][bj] = (u32x4){0u, 0u, 0u, 0u}; if (!first) pw[m][bj] = *(const u32x4*)(ACC + row * 2048 + col); } }
#pragma unroll
            for (int m = 0; m < 4; ++m) { const size_t row = (size_t)(row0 + ai * HALF + m * 16);
#pragma unroll
                for (int bj = 0; bj < 2; ++bj) { const int col = col0 + bj * HALF; const u32x4 g = gw[m][bj], p = pw[m][bj];
                    const f32x4 a0 = acc[ai][bj][m][0], a1 = acc[ai][bj][m][1];
                    f32x4 r0, r1;
                    r0[0] = bflo(p.x) + bflo(g.x) * a0[0]; r0[1] = bfhi(p.x) + bfhi(g.x) * a0[1]; r0[2] = bflo(p.y) + bflo(g.y) * a0[2]; r0[3] = bfhi(p.y) + bfhi(g.y) * a0[3];
                    r1[0] = bflo(p.z) + bflo(g.z) * a1[0]; r1[1] = bfhi(p.z) + bfhi(g.z) * a1[1]; r1[2] = bflo(p.w) + bflo(g.w) * a1[2]; r1[3] = bfhi(p.w) + bfhi(g.w) * a1[3];
                    *(u32x4*)(ACC + row * 2048 + col) = pack8(r0, r1); } }
            asm volatile("" ::: "memory"); }
    }
};
struct EpiWo {
    float* X1; const float* mod  ; const float* xlat  ; const float* xctx  ;
    __device__ __forceinline__ void operator()(EPI_ARGS) const {
        EPI_LANE
        const int b = u.pm / 17, tb = u.pm % 17; const bool isctx = tb == 0;
        const float* g1 = mod + (size_t)(isctx ? 4 : b) * 12288 + 2 * 2048;
        const float* xbase = isctx ? xctx + (size_t)b * cf::CTX * 2048 : xlat + ((size_t)b * cf::S + (size_t)(tb - 1) * 256) * 2048;
        const int rl0 = wr * 64 + fr, col0 = u.pn * BM + wc * 32 + 8 * fq;
        f32x4 gv[2][2];
#pragma unroll
        for (int bj = 0; bj < 2; ++bj) { gv[bj][0] = *(const f32x4*)(g1 + col0 + bj * HALF); gv[bj][1] = *(const f32x4*)(g1 + col0 + bj * HALF + 4); }
#pragma unroll
        for (int ai = 0; ai < 2; ++ai) {
            f32x4 xv[4][2][2];
#pragma unroll
            for (int m = 0; m < 4; ++m) { const int rl = rl0 + ai * HALF + m * 16;
#pragma unroll
                for (int bj = 0; bj < 2; ++bj) { const float* xp = xbase + (size_t)rl * 2048 + col0 + bj * HALF; xv[m][bj][0] = *(const f32x4*)xp; xv[m][bj][1] = *(const f32x4*)(xp + 4); } }
#pragma unroll
            for (int m = 0; m < 4; ++m) { const int rl = rl0 + ai * HALF + m * 16; float* op = X1 + ((size_t)u.pm * BM + rl) * 2048 + col0;
#pragma unroll
                for (int bj = 0; bj < 2; ++bj) { *(f32x4*)(op + bj * HALF) = xv[m][bj][0] * cf::ALPHA + gv[bj][0] * acc[ai][bj][m][0];
                    *(f32x4*)(op + bj * HALF + 4) = xv[m][bj][1] * cf::ALPHA + gv[bj][1] * acc[ai][bj][m][1]; } }
            asm volatile("" ::: "memory"); }
    }
};
}

struct Ctx {
    const float* const* in; float* out; unsigned char* ws;
    ldsp_t lds; int tid, lane, wave, G, bid;
};
#define WSP(T, off) ((T*)(F.ws + (off)))
__device__ __forceinline__ Ctx phase_ctx(const Ctx& F0) {
    Ctx C = F0;
    C.tid = F0.wave * 64 + lane_id();
    asm volatile("" : "+v"(C.tid));
    { size_t z = 0; asm volatile("" : "+s"(z)); C.ws = F0.ws + z; }
    C.lane = C.tid & 63; C.wave = __builtin_amdgcn_readfirstlane(C.tid >> 6);
    return C;
}

__device__ __forceinline__ int srcmap(int mode, int n) {
    if (mode == 0) {
        const int pn = n >> 8, q = n & 255, bj = q >> 7, r = q & 127, rope = (r >> 6) * 128 + bj * 64 + (r & 63);
        if (pn == 0) return rope;
        if (pn == 1) return 256 + q;
        if (pn == 2) return 512 + q;
        if (pn == 3) return r < 32 ? 768 + bj * 32 + r : -1;
        if (pn == 4) return 832 + rope;
        if (pn == 5) return 1088 + q;
        if (pn < 10) return 1344 + (pn - 6) * 256 + rope;
        if (pn < 12) return 2368 + (pn - 10) * 256 + q;
        if (pn < 16) return 2880 + (pn - 12) * 256 + rope;
        if (pn < 24) return 3904 + bj * 1024 + 128 * (pn - 16) + r;
        return 5952 + (n - 6144);
    }
    if (mode == 1) { if (n < 1024) return (n >> 7) * 192 + (n & 127);
        const int m = n - 1024, t = m >> 8, bj = (m >> 7) & 1, q = m & 127; return (4 * t + (q >> 5)) * 192 + 128 + bj * 32 + (q & 31); }
    if (mode == 2) { if (n < 1024) return (n >> 7) * 256 + (n & 127); const int m = n - 1024; return (m >> 7) * 256 + 128 + (m & 127); }
    return n;
}
__device__ __forceinline__ void tr_tile(const Ctx& F, const float* src, int ld_src, int mode, int k0, bf16_t* dst, int ldd, int n0, const float* kscale = nullptr) {
    LAS float* T = (LAS float*)F.lds;
    const int kr = F.tid >> 6, nc = (F.tid & 63) * 4, sc = srcmap(mode, n0 + nc);
    f32x4 v[8];
#pragma unroll
    for (int h = 0; h < 8; ++h) { v[h] = (f32x4){0.f, 0.f, 0.f, 0.f}; if (sc >= 0) v[h] = *(const f32x4*)(src + (size_t)(k0 + kr + 8 * h) * ld_src + sc); }
#pragma unroll
    for (int h = 0; h < 8; ++h) { const int k = kr + 8 * h; f32x4 x = v[h]; if (kscale) x = x * kscale[k0 + k];
        T[k * 257 + nc + 0] = x[0]; T[k * 257 + nc + 1] = x[1]; T[k * 257 + nc + 2] = x[2]; T[k * 257 + nc + 3] = x[3]; }
    __syncthreads();
    const int n = F.tid >> 1, kc = (F.tid & 1) * 32;
#pragma unroll
    for (int j = 0; j < 4; ++j) { u32x4 w; const int kb = kc + 8 * j;
        w.x = cvt_pk_bf16(T[(kb + 0) * 257 + n], T[(kb + 1) * 257 + n]); w.y = cvt_pk_bf16(T[(kb + 2) * 257 + n], T[(kb + 3) * 257 + n]);
        w.z = cvt_pk_bf16(T[(kb + 4) * 257 + n], T[(kb + 5) * 257 + n]); w.w = cvt_pk_bf16(T[(kb + 6) * 257 + n], T[(kb + 7) * 257 + n]);
        *(u32x4*)(dst + (size_t)(n0 + n) * ldd + k0 + kb) = w; }
    __syncthreads();
}
__device__ __forceinline__ void cvt_rows(const Ctx& F, const float* src, bf16_t* dst, size_t n8) {
    for (size_t i = (size_t)F.bid * 512 + F.tid; i < n8; i += (size_t)F.G * 512) {
        const f32x4 a = *(const f32x4*)(src + i * 8), b = *(const f32x4*)(src + i * 8 + 4);
        *(u32x4*)(dst + i * 8) = pg8::pack8(a, b); }
}

__device__ __forceinline__ void cvt_rows_fp8(const Ctx& F, const float* src, unsigned char* dst, size_t n16, float scale) {
    const size_t stride = (size_t)F.G * 512;
    for (size_t i = (size_t)F.bid * 512 + F.tid; i < n16; i += 2 * stride) {
        const size_t i2 = i + stride; const bool two = i2 < n16;
        f32x4 a[8];
#pragma unroll
        for (int j = 0; j < 4; ++j) { a[j] = *(const f32x4*)(src + i * 16 + 4 * j); a[4 + j] = two ? *(const f32x4*)(src + i2 * 16 + 4 * j) : (f32x4){0.f, 0.f, 0.f, 0.f}; }
        u32x4 w0, w1;
#pragma unroll
        for (int j = 0; j < 4; ++j) { const f32x4 x = a[j] * scale, y = a[4 + j] * scale;
            int p = 0; p = __builtin_amdgcn_cvt_pk_fp8_f32(x[0], x[1], p, false); p = __builtin_amdgcn_cvt_pk_fp8_f32(x[2], x[3], p, true); w0[j] = (unsigned)p;
            int q = 0; q = __builtin_amdgcn_cvt_pk_fp8_f32(y[0], y[1], q, false); q = __builtin_amdgcn_cvt_pk_fp8_f32(y[2], y[3], q, true); w1[j] = (unsigned)q; }
        *(u32x4*)(dst + i * 16) = w0; if (two) *(u32x4*)(dst + i2 * 16) = w1; }
}

constexpr int V4_ROW = 1088;
__device__ __forceinline__ void cvt_rows_fp4(const Ctx& F, const float* src, unsigned char* dst, size_t nblk) {
    for (size_t i = (size_t)F.bid * 512 + F.tid; i < nblk; i += (size_t)F.G * 512) {
        f32x4 a[8]; float amax = 0.f;
#pragma unroll
        for (int j = 0; j < 8; ++j) { a[j] = *(const f32x4*)(src + i * 32 + 4 * j); amax = fmaxf(amax, fmaxf(fmaxf(fabsf(a[j][0]), fabsf(a[j][1])), fmaxf(fabsf(a[j][2]), fabsf(a[j][3])))); }
        int e = amax > 0.f ? (int)ceilf(log2f(amax * (1.0f / 6.0f))) : -126; e = e < -126 ? -126 : (e > 126 ? 126 : e);
        const float inv = __uint_as_float((unsigned)(127 - e) << 23);
        u32x4 w;
#pragma unroll
        for (int j = 0; j < 4; ++j) { const f32x4 x = a[2 * j] * inv, y = a[2 * j + 1] * inv; unsigned p = 0u;
            p = __builtin_amdgcn_cvt_scalef32_pk_fp4_f32(p, x[0], x[1], 1.0f, 0); p = __builtin_amdgcn_cvt_scalef32_pk_fp4_f32(p, x[2], x[3], 1.0f, 1);
            p = __builtin_amdgcn_cvt_scalef32_pk_fp4_f32(p, y[0], y[1], 1.0f, 2); p = __builtin_amdgcn_cvt_scalef32_pk_fp4_f32(p, y[2], y[3], 1.0f, 3); w[j] = p; }
        const size_t row = i >> 6; const int bl = (int)(i & 63);
        *(u32x4*)(dst + row * V4_ROW + bl * 16) = w; dst[row * V4_ROW + 1024 + bl] = (unsigned char)(e + 127);
    }
}

__device__ __forceinline__ void ph_prologue(const Ctx& F0) {
    const Ctx F = phase_ctx(F0);
    using namespace cf;
    constexpr int T_WIN = 2 * 32 * 56, T_QUP = 2 * 8 * 6, T_KVUP = 2 * 4 * 8, T_BR = 2 * 4 * 16 * 8, T_WO = 2 * 32 * 8;
    constexpr int T_ALL = T_WIN + T_QUP + T_KVUP + T_BR + T_WO;
    for (int u = F.bid; u < T_ALL; u += F.G) {
        int t = u;
        if (t < T_WIN) { const int l = t / (32 * 56), r = t % (32 * 56), kt = r / 56, nt = r % 56;
            tr_tile(F, F.in[I_WIN] + (size_t)l * 2048 * IN_COLS, IN_COLS, 0, kt * 64, WSP(bf16_t, WS_WIN) + (size_t)l * NC * 2048, 2048, nt * 256); continue; }
        t -= T_WIN;
        if (t < T_QUP) { const int l = t / (8 * 6), r = t % (8 * 6), kt = r / 6, nt = r % 6;
            tr_tile(F, F.in[I_WQUP] + (size_t)l * 512 * 1536, 1536, 1, kt * 64, WSP(bf16_t, WS_WQUP) + (size_t)l * 1536 * 512, 512, nt * 256, F.in[I_BQN] + l * 512); continue; }
        t -= T_QUP;
        if (t < T_KVUP) { const int l = t / (4 * 8), r = t % (4 * 8), kt = r / 8, nt = r % 8;
            tr_tile(F, F.in[I_WKVUP] + (size_t)l * 256 * 2048, 2048, 2, kt * 64, WSP(bf16_t, WS_WKVUP) + (size_t)l * 2048 * 256, 256, nt * 256, F.in[I_BKVN] + l * 256); continue; }
        t -= T_KVUP;
        if (t < T_BR) { const int l = t / (4 * 128), r = t % (4 * 128), br = r / 128, r2 = r % 128, kt = r2 / 8, nt = r2 % 8;
            const float* src = (br == 0 ? F.in[I_WBRA] : br == 1 ? F.in[I_WBRB] : br == 2 ? F.in[I_WBRC] : F.in[I_WBRD]) + (size_t)l * 1024 * 2048;
            tr_tile(F, src, 2048, 3, kt * 64, WSP(bf16_t, WS_WBR) + ((size_t)l * 4 + br) * 2048 * 1024, 1024, nt * 256); continue; }
        t -= T_BR;
        { const int l = t / 256, r = t % 256, kt = r / 8, nt = r % 8;
            tr_tile(F, F.in[I_WO] + (size_t)l * 2048 * 2048, 2048, 3, kt * 64, WSP(bf16_t, WS_WO) + (size_t)l * 2048 * 2048, 2048, nt * 256); }
    }
    for (int u = F.bid; u < 2 * 16 * 32; u += F.G) {
        const int l = u / 512, g = (u % 512) / 32, d0 = (u % 32) * 64;
        LAS float* sk = (LAS float*)F.lds; LAS float* wt = (LAS float*)(F.lds + 128 * 129 * 4);
        const float* skg = F.in[I_PSK] + ((size_t)l * 16 + g) * 128 * 128;
        const float* wqg = F.in[I_PWQ] + (size_t)l * 2048 * 2048 + (size_t)d0 * 2048 + g * 128;
        for (int i = F.tid; i < 128 * 128; i += 512) sk[(i >> 7) * 129 + (i & 127)] = skg[i];
        for (int i = F.tid; i < 64 * 128; i += 512) wt[(i >> 7) * 129 + (i & 127)] = wqg[(size_t)(i >> 7) * 2048 + (i & 127)];
        __syncthreads();
        const int n = F.tid & 127, dg = F.tid >> 7;
        float a[16];
#pragma unroll
        for (int e = 0; e < 16; ++e) a[e] = 0.f;
        for (int k = 0; k < 128; ++k) { const float s = sk[n * 129 + k];
#pragma unroll
            for (int e = 0; e < 16; ++e) a[e] += wt[(dg * 16 + e) * 129 + k] * s; }
        bf16_t* dst = WSP(bf16_t, WS_WFOLD) + (size_t)l * 2048 * 2048 + (size_t)(g * 128 + n) * 2048 + d0 + dg * 16;
        u32x4 w0, w1;
        w0.x = cvt_pk_bf16(a[0], a[1]); w0.y = cvt_pk_bf16(a[2], a[3]); w0.z = cvt_pk_bf16(a[4], a[5]); w0.w = cvt_pk_bf16(a[6], a[7]);
        w1.x = cvt_pk_bf16(a[8], a[9]); w1.y = cvt_pk_bf16(a[10], a[11]); w1.z = cvt_pk_bf16(a[12], a[13]); w1.w = cvt_pk_bf16(a[14], a[15]);
        *(u32x4*)dst = w0; *(u32x4*)(dst + 8) = w1;
        __syncthreads();
    }
    for (int u = F.bid; u < 2 * 192; u += F.G) {
        const int l = u / 192, n0 = (u % 192) * 64;
        LAS float* sl = (LAS float*)F.lds; LAS float* red = (LAS float*)(F.lds + 5 * 2048 * 4);
        for (int i = F.tid; i < 5 * 2048; i += 512) { const int r = i >> 11, k = i & 2047; const float v = r < 4 ? F.in[I_C][r * 2048 + k] : F.in[I_CCTX][k]; sl[i] = v * sigmoidf_(v); }
        __syncthreads();
        const int cg = F.tid & 15, ks = F.tid >> 4;
        f32x4 a[5];
#pragma unroll
        for (int r = 0; r < 5; ++r) a[r] = (f32x4){0.f, 0.f, 0.f, 0.f};
        const float* wp = F.in[I_WADA] + (size_t)l * 2048 * 12288 + n0 + cg * 4;
#pragma unroll 8
        for (int k = ks * 64; k < ks * 64 + 64; ++k) { const f32x4 w = *(const f32x4*)(wp + (size_t)k * 12288);
#pragma unroll
            for (int r = 0; r < 5; ++r) a[r] += w * sl[r * 2048 + k]; }
#pragma unroll
        for (int r = 0; r < 5; ++r) *(LAS f32x4*)(red + (ks * 5 + r) * 64 + cg * 4) = a[r];
        __syncthreads();
        if (F.tid < 320) { const int r = F.tid >> 6, col = F.tid & 63; float sacc = 0.f;
#pragma unroll
            for (int k2 = 0; k2 < 32; ++k2) sacc += red[(k2 * 5 + r) * 64 + col];
            WSP(float, WS_MOD)[((size_t)l * 5 + r) * 12288 + n0 + col] = sacc + F.in[I_BADA][(size_t)l * 12288 + n0 + col]; }
        __syncthreads();
    }
    for (int i = F.bid * 512 + F.tid; i < 4096 * 64; i += F.G * 512) {
        const int pos = i >> 6, j = i & 63, fi = j & 31; const float fr = powf(10000.0f, -(float)(2 * fi) / 64.0f);
        const float ang = (float)(j < 32 ? (pos >> 6) : (pos & 63)) * fr;
        WSP(float, WS_COSH)[i] = cosf(ang); WSP(float, WS_SINH)[i] = sinf(ang);
    }
    for (int i = F.bid * 512 + F.tid; i < 4096 * 32; i += F.G * 512) {
        const int pos = i >> 5, j = i & 31, fi = j & 15; const float fr = powf(10000.0f, -(float)(2 * fi) / 32.0f);
        const float ang = (float)(j < 16 ? (pos >> 6) : (pos & 63)) * fr;
        WSP(float, WS_COSR)[i] = cosf(ang); WSP(float, WS_SINR)[i] = sinf(ang);
    }
    cvt_rows_fp8(F, F.in[I_PU], WSP(unsigned char, WS_UB), (size_t)2 * NEXP * 2048 / 16, 1024.f);
    cvt_rows_fp4(F, F.in[I_PV], WSP(unsigned char, WS_VB2), (size_t)2 * NEXP * 64);
}

__device__ __forceinline__ void ph_modulate0(const Ctx& F0) {
    const Ctx F = phase_ctx(F0);
    using namespace cf;
    const float* mod = WSP(float, WS_MOD);
    for (size_t i = (size_t)F.bid * 512 + F.tid; i < (size_t)MR * 256; i += (size_t)F.G * 512) {
        const int R = (int)(i >> 8), d = (int)(i & 255) * 8, b = R / RB, j = R % RB;
        const float* src = j < CTX ? F.in[I_CTX] + ((size_t)b * CTX + j) * 2048 : F.in[I_X] + ((size_t)b * S + (j - CTX)) * 2048;
        const float* m = mod + (size_t)(j < CTX ? 4 : b) * 12288;
        const f32x4 x0 = *(const f32x4*)(src + d), x1 = *(const f32x4*)(src + d + 4);
        const f32x4 sh0 = *(const f32x4*)(m + d), sh1 = *(const f32x4*)(m + d + 4), s0 = *(const f32x4*)(m + 2048 + d), s1 = *(const f32x4*)(m + 2048 + d + 4);
        *(u32x4*)(WSP(bf16_t, WS_HB) + (size_t)R * 2048 + d) = pg8::pack8(x0 * (s0 + 1.0f) + sh0, x1 * (s1 + 1.0f) + sh1);
    }
}

__device__ __forceinline__ void knorm_pass(const Ctx& F) {
    using namespace cf;
    bf16_t* P = WSP(bf16_t, WS_P); const float* ssk = WSP(const float, WS_SSK);
    for (int it = F.bid * 8 + F.wave; it < MR * 2; it += F.G * 8) {
        const int R = it >> 1, h = it & 1;
        const f32x2 pp = *(const f32x2*)(ssk + (size_t)it * 2); const float r = rsqrtf((pp.x + pp.y) * (1.f / 128.f) + 1e-6f);
        unsigned* q = (unsigned*)(P + (size_t)R * NC + PC_AK + h * 128) + F.lane;
        const unsigned w = *q; *q = cvt_pk_bf16(bflo(w) * r, bfhi(w) * r);
    }
}

struct AttnArgs {
    const bf16_t* Q; const bf16_t* K; const bf16_t* V; bf16_t* O; int ldq, ldk, ldv, ldo;
    int seg0_row, seg0_tiles, seg1_row, seg1_tiles;
    int mask_on, qpos0, kpos1;
    float sc_log2; int has_sink; float sink_l2;
    int variant;
    const float* qss;
};
typedef float f32x16 __attribute__((ext_vector_type(16)));
constexpr float LOG2E_F = 1.4426950408889634f;
template <int DK, bool MASKED>
__device__ __forceinline__ void attn_unit(ldsp_t lds, const AttnArgs a, int wave_) {
    constexpr int ND = DK / 16, KCH = DK / 8, KPT = (64 * KCH) / 512, VST = 72, KM = DK == 128 ? 15 : 7;
    constexpr int KBUF = 64 * DK * 2, VBUF = 128 * VST * 2, VOFF = 2 * KBUF, ALOFF = VOFF + 3 * VBUF;
    int tid = wave_ * 64 + lane_id(); asm volatile("" : "+v"(tid));
    const int wid = __builtin_amdgcn_readfirstlane(tid >> 6), lane = tid & 63, q32 = lane & 31, hi = lane >> 5;
    LAS float* al = (LAS float*)(lds + ALOFF + wid * 128);
    bf16x8 qf[ND];
    { float scq = a.sc_log2;
      if (a.qss) { const f32x2 pp = *(const f32x2*)(a.qss + (size_t)(wid * 32 + q32) * 16); scq *= rsqrtf((pp.x + pp.y) * (1.f / 128.f) + 1e-6f); }
      const bf16_t* qrow = a.Q + (size_t)(wid * 32 + q32) * a.ldq + 8 * hi;
#pragma unroll
      for (int s = 0; s < ND; ++s) { const u32x4 w = *(const u32x4*)(qrow + 16 * s); u32x4 o;
          o.x = cvt_pk_bf16(bflo(w.x) * scq, bfhi(w.x) * scq); o.y = cvt_pk_bf16(bflo(w.y) * scq, bfhi(w.y) * scq);
          o.z = cvt_pk_bf16(bflo(w.z) * scq, bfhi(w.z) * scq); o.w = cvt_pk_bf16(bflo(w.w) * scq, bfhi(w.w) * scq); qf[s] = *(bf16x8*)&o; } }
    f32x16 o[4];
#pragma unroll
    for (int db = 0; db < 4; ++db)
#pragma unroll
        for (int r = 0; r < 16; ++r) o[db][r] = 0.f;
    float m_run = -1e30f, l_run = 0.f;
    const int PV_ = MK_AV ? a.variant : 0;
    const int ntiles = a.seg0_tiles + a.seg1_tiles;
    u32x4 vreg[2];
    const int vkp = tid & 31, vdc = tid >> 5;
    const int vkey = 2 * vkp, vpos = (vkey & 48) | ((vkey & 4) << 1) | ((vkey & 8) >> 1) | (vkey & 3);
    unsigned koff[KPT];
#pragma unroll
    for (int i = 0; i < KPT; ++i) { const int P = (i * 8 + wid) * 64 + lane, row = P / KCH, cp = P % KCH; koff[i] = (unsigned)(row * a.ldk + 8 * (cp ^ (row & KM))) * 2u; }
#define ATT_LOAD(tt, kb) do { const int _r0 = (tt) < a.seg0_tiles ? a.seg0_row + 64 * (tt) : a.seg1_row + 64 * ((tt) - a.seg0_tiles); \
        const char* _kg = (const char*)(a.K + (size_t)_r0 * a.ldk); \
        _Pragma("unroll") for (int _i = 0; _i < KPT; ++_i) __builtin_amdgcn_global_load_lds((const unsigned*)(_kg + koff[_i]), (LAS unsigned*)(lds + (kb) * KBUF + (_i * 8 + wid) * 1024), 16, 0, 0); \
        vreg[0] = *(const u32x4*)(a.V + (size_t)(_r0 + 2 * vkp) * a.ldv + 8 * vdc); vreg[1] = *(const u32x4*)(a.V + (size_t)(_r0 + 2 * vkp + 1) * a.ldv + 8 * vdc); } while (0)
#define ATT_WRITE(vb) do { const ldsp_t _vb = lds + VOFF + (vb) * VBUF; \
        const unsigned _a0[4] = {vreg[0].x, vreg[0].y, vreg[0].z, vreg[0].w}, _a1[4] = {vreg[1].x, vreg[1].y, vreg[1].z, vreg[1].w}; \
        _Pragma("unroll") for (int _e = 0; _e < 4; ++_e) { \
            *(LAS unsigned*)(_vb + ((8 * vdc + 2 * _e) * VST + vpos) * 2) = (_a0[_e] & 0xffffu) | (_a1[_e] << 16); \
            *(LAS unsigned*)(_vb + ((8 * vdc + 2 * _e + 1) * VST + vpos) * 2) = (_a0[_e] >> 16) | (_a1[_e] & 0xffff0000u); } } while (0)
#define ATT_PV(vb) do { const ldsp_t _vt = lds + VOFF + (vb) * VBUF; \
        _Pragma("unroll") for (int db = 0; db < 4; ++db) _Pragma("unroll") for (int ks = 0; ks < 4; ++ks) { \
            const bf16x8 vf = *(const LAS bf16x8*)(_vt + ((32 * db + q32) * VST + 16 * ks + 8 * hi) * 2); \
            o[db] = __builtin_amdgcn_mfma_f32_32x32x16_bf16(pa[ks], vf, o[db], 0, 0, 0); } } while (0)
    bf16x8 pa[4];
#pragma unroll
    for (int i = 0; i < 4; ++i) pa[i] = (bf16x8){0, 0, 0, 0, 0, 0, 0, 0};
    int vprev = 2, vcur = 0, vnext = 1;
    { unsigned z0 = 0u; asm volatile("" : "+v"(z0));
      for (int i = tid; i < VBUF / 16; i += 512) *(LAS u32x4*)(lds + VOFF + 2 * VBUF + i * 16) = (u32x4){z0, z0, z0, z0}; }
    ATT_LOAD(0, 0);
    ATT_WRITE(0);
    asm volatile("s_waitcnt vmcnt(0)" ::: "memory");
    __syncthreads();
    for (int tt = 0; tt < ntiles; ++tt) {
        const int cur = tt & 1;
        if (tt + 1 < ntiles && PV_ != 4) ATT_LOAD(tt + 1, cur ^ 1);
        const ldsp_t Ks = lds + cur * KBUF;
        f32x16 s0, s1;
#pragma unroll
        for (int r = 0; r < 16; ++r) { s0[r] = 0.f; s1[r] = 0.f; }
        { bf16x8 kf[2][2];
#define ATT_LDK(p, sb) do { kf[p][0] = *(const LAS bf16x8*)(Ks + (q32 * KCH + ((2 * (sb) + hi) ^ (q32 & KM))) * 16); kf[p][1] = *(const LAS bf16x8*)(Ks + ((32 + q32) * KCH + ((2 * (sb) + hi) ^ (q32 & KM))) * 16); } while (0)
          if (PV_ != 2) {
          ATT_LDK(0, 0);
#pragma unroll
          for (int sb = 0; sb < ND; ++sb) {
              if (sb + 1 < ND) ATT_LDK((sb + 1) & 1, sb + 1);
              s0 = __builtin_amdgcn_mfma_f32_32x32x16_bf16(kf[sb & 1][0], qf[sb], s0, 0, 0, 0);
              s1 = __builtin_amdgcn_mfma_f32_32x32x16_bf16(kf[sb & 1][1], qf[sb], s1, 0, 0, 0);
              }
          }
#undef ATT_LDK
        }
        const bool msk = MASKED && a.mask_on && tt >= a.seg0_tiles;
        if (MASKED) { const int kp0 = a.kpos1 + 64 * (tt - a.seg0_tiles) + 4 * hi, qp = a.qpos0 + wid * 32 + q32;
#pragma unroll
            for (int r = 0; r < 16; ++r) { float t0 = s0[r], t1 = s1[r];
                if (msk) { const int d0 = qp - (kp0 + (r & 3) + 8 * (r >> 2)), d1 = d0 - 32; if (d0 > 128 || d0 < -128) t0 = -1e30f; if (d1 > 128 || d1 < -128) t1 = -1e30f; s0[r] = t0; s1[r] = t1; } }
            __builtin_amdgcn_sched_barrier(0); }
        float mx = -1e30f, m_new = 0.f, alpha = 1.f, ps = 0.f;
        bf16x8 pn[4] = {pa[0], pa[1], pa[2], pa[3]};
        { const ldsp_t _vt = lds + VOFF + vprev * VBUF; bf16x8 vfr[3]; vfr[2] = pa[0];
#define ATT_LDV(i) (*(const LAS bf16x8*)(_vt + ((32 * ((i) >> 2) + q32) * VST + 16 * ((i) & 3) + 8 * hi) * 2))
#define SCV(e) ((e) < 16 ? s0[(e) & 15] : s1[(e) & 15])
          vfr[0] = ATT_LDV(0); vfr[1] = ATT_LDV(1);
#pragma unroll
          for (int i = 0; i < 16; ++i) {
              if (PV_ != 3) { if (i + 2 < 16) vfr[(i + 2) % 3] = ATT_LDV(i + 2);
              o[i >> 2] = __builtin_amdgcn_mfma_f32_32x32x16_bf16(pa[i & 3], vfr[i % 3], o[i >> 2], 0, 0, 0); }
              if (PV_ == 1) {} else if (i < 4) {
#pragma unroll
                  for (int e = 0; e < 4; ++e) mx = fmaxf(mx, fmaxf(s0[4 * i + e], s1[4 * i + e]));
              } else if (i == 4) {
                  { const auto rr = __builtin_amdgcn_permlane32_swap(__float_as_uint(mx), __float_as_uint(mx), false, false);
                    mx = fmaxf(__uint_as_float(rr[0]), __uint_as_float(rr[1])); }
                  if (__all(mx - m_run <= 8.0f * LOG2E_F)) { m_new = m_run; alpha = 1.f; }
                  else { m_new = fmaxf(m_run, mx); alpha = __builtin_amdgcn_exp2f(m_run - m_new); m_run = m_new; }
              } else if (i < 13) {
#pragma unroll
                  for (int e = 0; e < 2; ++e) { const int r = 2 * (i - 5) + e; s0[r] = __builtin_amdgcn_exp2f(s0[r] - m_new); s1[r] = __builtin_amdgcn_exp2f(s1[r] - m_new); ps += s0[r] + s1[r]; }
              } else if (i == 13) {
                  u32x4 w; w.x = cvt_pk_bf16(s0[0], s0[1]); w.y = cvt_pk_bf16(s0[2], s0[3]); w.z = cvt_pk_bf16(s0[4], s0[5]); w.w = cvt_pk_bf16(s0[6], s0[7]); pn[0] = *(bf16x8*)&w;
                  u32x4 v; v.x = cvt_pk_bf16(s0[8], s0[9]); v.y = cvt_pk_bf16(s0[10], s0[11]); v.z = cvt_pk_bf16(s0[12], s0[13]); v.w = cvt_pk_bf16(s0[14], s0[15]); pn[1] = *(bf16x8*)&v;
              } else if (i == 14) {
                  u32x4 w; w.x = cvt_pk_bf16(s1[0], s1[1]); w.y = cvt_pk_bf16(s1[2], s1[3]); w.z = cvt_pk_bf16(s1[4], s1[5]); w.w = cvt_pk_bf16(s1[6], s1[7]); pn[2] = *(bf16x8*)&w;
                  u32x4 v; v.x = cvt_pk_bf16(s1[8], s1[9]); v.y = cvt_pk_bf16(s1[10], s1[11]); v.z = cvt_pk_bf16(s1[12], s1[13]); v.w = cvt_pk_bf16(s1[14], s1[15]); pn[3] = *(bf16x8*)&v;
              } else { l_run = l_run * alpha + ps; }
          }
#undef ATT_LDV
#undef SCV
        }
#pragma unroll
        for (int i = 0; i < 4; ++i) pa[i] = pn[i];
        if (__any(alpha < 1.0f)) {
            if (hi == 0) al[q32] = alpha;
            asm volatile("s_waitcnt lgkmcnt(0)" ::: "memory");
#pragma unroll
            for (int g4 = 0; g4 < 4; ++g4) { const f32x4 av = *(const LAS f32x4*)(al + 8 * g4 + 4 * hi);
#pragma unroll
                for (int db = 0; db < 4; ++db)
#pragma unroll
                    for (int j = 0; j < 4; ++j) o[db][4 * g4 + j] *= av[j]; }
        }
        if (tt + 1 < ntiles && PV_ != 4) ATT_WRITE(vnext);
        { const int t3 = vprev; vprev = vcur; vcur = vnext; vnext = t3; }
        asm volatile("s_waitcnt vmcnt(0)" ::: "memory");
        if (PV_ != 5) __syncthreads();
    }
    ATT_PV(vprev);
#undef ATT_LOAD
#undef ATT_WRITE
#undef ATT_PV
    __syncthreads();
    float l_tot; { const auto rr = __builtin_amdgcn_permlane32_swap(__float_as_uint(l_run), __float_as_uint(l_run), false, false); l_tot = __uint_as_float(rr[0]) + __uint_as_float(rr[1]); }
    if (a.has_sink) l_tot += __builtin_amdgcn_exp2f(a.sink_l2 - m_run);
    if (hi == 0) al[q32] = 1.0f / l_tot;
    asm volatile("s_waitcnt lgkmcnt(0)" ::: "memory");
    const ldsp_t Ost = lds + wid * 8192;
#pragma unroll
    for (int g4 = 0; g4 < 4; ++g4) { const f32x4 iv = *(const LAS f32x4*)(al + 8 * g4 + 4 * hi);
#pragma unroll
        for (int db = 0; db < 4; ++db)
#pragma unroll
            for (int j = 0; j < 4; ++j) *(LAS bf16_t*)(Ost + ((8 * g4 + 4 * hi + j) * 128 + 32 * db + q32) * 2) = f2bf(o[db][4 * g4 + j] * iv[j]); }
    asm volatile("s_waitcnt lgkmcnt(0)" ::: "memory");
    const int lane_o = lane_id();
#pragma unroll
    for (int i = 0; i < 8; ++i) { const int c = lane_o + 64 * i, row = c >> 4, c8 = c & 15;
        *(u32x4*)(a.O + (size_t)(wid * 32 + row) * a.ldo + 8 * c8) = *(const LAS u32x4*)(Ost + (row * 128 + 8 * c8) * 2); }
}

__device__ __forceinline__ void conv_unit(const Ctx& F, int layer, int row0  , int seq_len, int t0) {
    using namespace cf;
    const bf16_t* P = WSP(const bf16_t, WS_P); bf16_t* BR = WSP(bf16_t, WS_BR);
    const float* cw = F.in[I_CW] + (size_t)layer * 31 * 1024; const float* cb = F.in[I_CB] + layer * 1024;
    const float* lg = F.in[I_CLG] + layer * 1024; const float* lb = F.in[I_CLB] + layer * 1024;
    int tid = F.wave * 64 + lane_id(); asm volatile("" : "+v"(tid));
    const int lane = tid & 63;
    LAS float* red = (LAS float*)(F.lds + 126976); LAS float* tot = red + 8 * 32;
    __syncthreads();
    for (int c = tid; c < 62 * 128; c += 512) { const int rr = c >> 7, ch = c & 127, t = t0 - 15 + rr;
        u32x4 v = {0u, 0u, 0u, 0u};
        if (t >= 0 && t < seq_len) v = *(const u32x4*)(P + (size_t)(row0 + t) * NC + PC_GLU + ch * 8);
        *(LAS u32x4*)(F.lds + rr * 2048 + ch * 16) = v; }
    float w0[31], w1[31];
#pragma unroll
    for (int k = 0; k < 31; ++k) { const f32x2 w = *(const f32x2*)(cw + k * 1024 + 2 * tid); w0[k] = w.x; w1[k] = w.y; }
    const f32x2 bv = *(const f32x2*)(cb + 2 * tid), gg = *(const f32x2*)(lg + 2 * tid), bb = *(const f32x2*)(lb + 2 * tid);
    __syncthreads();
#pragma unroll 1
    for (int part = 0; part < 4; ++part) {
        float a0[8], a1[8];
#pragma unroll
        for (int t = 0; t < 8; ++t) { a0[t] = bv.x; a1[t] = bv.y; }
        const ldsp_t base = F.lds + part * 8 * 2048 + tid * 4;
#pragma unroll
        for (int rr = 0; rr < 38; ++rr) { const unsigned xw = *(const LAS unsigned*)(base + rr * 2048); const float x0 = bflo(xw), x1 = bfhi(xw);
#pragma unroll
            for (int t = 0; t < 8; ++t) { const int k = rr - t; if (k >= 0 && k <= 30) { a0[t] += x0 * w0[k]; a1[t] += x1 * w1[k]; } } }
        float v[16];
#pragma unroll
        for (int t = 0; t < 8; ++t) { v[t] = a0[t] + a1[t]; v[8 + t] = a0[t] * a0[t] + a1[t] * a1[t]; }
#pragma unroll
        for (int i = 0; i < 8; ++i) { const bool up = lane & 32; const float snd = up ? v[i] : v[i + 8], kp = up ? v[i + 8] : v[i]; v[i] = kp + shx(snd, 32, lane); }
#pragma unroll
        for (int i = 0; i < 4; ++i) { const bool up = lane & 16; const float snd = up ? v[i] : v[i + 4], kp = up ? v[i + 4] : v[i]; v[i] = kp + shx(snd, 16, lane); }
#pragma unroll
        for (int i = 0; i < 2; ++i) { const bool up = lane & 8; const float snd = up ? v[i] : v[i + 2], kp = up ? v[i + 2] : v[i]; v[i] = kp + shx(snd, 8, lane); }
        { const bool up = lane & 4; const float snd = up ? v[0] : v[1], kp = up ? v[1] : v[0]; v[0] = kp + shx(snd, 4, lane); }
        v[0] += shx(v[0], 2, lane); v[0] += shx(v[0], 1, lane);
        if ((lane & 3) == 0) red[F.wave * 16 + (lane >> 2)] = v[0];
        __syncthreads();
        if (tid < 16) { float s = 0.f;
#pragma unroll
            for (int w = 0; w < 8; ++w) s += red[w * 16 + tid];
            tot[tid] = s; }
        __syncthreads();
#pragma unroll
        for (int t = 0; t < 8; ++t) { const float mean = tot[t] * (1.f / 1024.f), var = fmaxf(tot[8 + t] * (1.f / 1024.f) - mean * mean, 0.f), rstd = rsqrtf(var + 1e-5f);
            const float y0 = (a0[t] - mean) * rstd * gg.x + bb.x, y1 = (a1[t] - mean) * rstd * gg.y + bb.y;
            *(unsigned*)(BR + (size_t)(row0 + t0 + part * 8 + t) * 4096 + 2048 + 2 * tid) = cvt_pk_bf16(y0 * sigmoidf_(y0), y1 * sigmoidf_(y1)); }
    }
}

__device__ __forceinline__ void attn_defaults(AttnArgs& a, int isctx) {
    a.seg0_row = 0; a.seg0_tiles = isctx ? 4 : 68; a.seg1_row = 0; a.seg1_tiles = 0; a.mask_on = 0; a.qpos0 = 0; a.kpos1 = 0; a.has_sink = 0; a.sink_l2 = 0.f; a.qss = nullptr; a.variant = 0; }
__device__ __forceinline__ void attn_unit_decode(int u, int G, bool gqa, int& b, int& h, int& qb) {
    if (G != 256) { b = u >> 7; h = (u >> 4) & 7; qb = u & 15; return; }
    const int bid = u & 255, r = u >> 8, x = bid & 7, local = (bid >> 3) + 32 * r;
    qb = local & 15;
    if (gqa) { b = x >> 1; h = (x & 1) * 4 + (local >> 4); }
    else { const int pair = x * 4 + (local >> 4); b = pair >> 3; h = pair & 7; }
}
__device__ __forceinline__ void ph_attn(const Ctx& F0, int layer) {
    const Ctx F = phase_ctx(F0);
    using namespace cf;
    const bf16_t* P = WSP(const bf16_t, WS_P); bf16_t* BR = WSP(bf16_t, WS_BR);
    for (int dup = 0; dup < DUPN(2); ++dup)
    for (int u = F.bid; u < (layer == 0 ? 544 : 512); u += F.G) {
        int b, h, qb, isctx = 0;
        if (u < 512) attn_unit_decode(u, F.G, false, b, h, qb); else { const int r = u - 512; b = r >> 3; h = r & 7; qb = 0; isctx = 1; }
        const size_t brow = (size_t)b * RB, qrow = brow + (isctx ? 0 : CTX) + (size_t)qb * 256;
        AttnArgs a; attn_defaults(a, isctx);
        a.Q = WSP(const bf16_t, WS_QB) + qrow * 1536 + h * 192; a.ldq = 1536;
        a.K = WSP(const bf16_t, WS_KB) + brow * 1536 + h * 192; a.ldk = 1536;
        a.V = WSP(const bf16_t, WS_VB) + brow * 1024 + h * 128; a.ldv = 1024;
        a.O = BR + qrow * 4096 + 1024 + h * 128; a.ldo = 4096; a.sc_log2 = SCALE_MLA * LOG2E;
        __syncthreads();
        attn_unit<192, false>(F.lds, a, F.wave);
    }
    for (int dup = 0; dup < DUPN(3); ++dup)
    for (int u0 = F.bid; u0 < (layer == 0 ? 544 : 512); u0 += F.G) {
        int b, h, qb, isctx = 0;
        if (u0 < 512) attn_unit_decode(u0, F.G, true, b, h, qb); else { const int r = u0 - 512; b = r >> 3; h = r & 7; qb = 0; isctx = 1; }
        const size_t brow = (size_t)b * RB, qrow = brow + (isctx ? 0 : CTX) + (size_t)qb * 256;
        AttnArgs a; attn_defaults(a, isctx);
        a.Q = P + qrow * NC + PC_AQ + h * 128; a.ldq = NC;
        a.K = P + brow * NC + PC_AK + (h >> 2) * 128; a.ldk = NC;
        a.V = P + brow * NC + PC_AV + (h >> 2) * 128; a.ldv = NC;
        a.O = BR + qrow * 4096 + h * 128; a.ldo = 4096; a.sc_log2 = SCALE_HD * LOG2E;
        a.qss = WSP(const float, WS_SSQ) + qrow * 16 + h * 2;
        if (MK_AV && dup == 1) { a.variant = MK_AV; a.O = WSP(bf16_t, WS_HB) + qrow * 2048 + h * 128; a.ldo = 2048; }
        __syncthreads();
        attn_unit<128, false>(F.lds, a, F.wave);
    }
    for (int dup = 0; dup < DUPN(13); ++dup)
    for (int u0 = F.bid; u0 < (layer == 0 ? 544 : 512); u0 += F.G) {
        int b, h, qb, isctx = 0;
        if (u0 < 512) attn_unit_decode(u0, F.G, true, b, h, qb); else { const int r = u0 - 512; b = r >> 3; h = r & 7; qb = 0; isctx = 1; }
        const size_t brow = (size_t)b * RB, qrow = brow + (isctx ? 0 : CTX) + (size_t)qb * 256;
        AttnArgs a; attn_defaults(a, isctx);
        a.Q = P + qrow * NC + PC_DQ + h * 128; a.ldq = NC;
        a.K = P + brow * NC + PC_DK + (h >> 2) * 128; a.ldk = NC;
        a.V = P + brow * NC + PC_DV + (h >> 2) * 128; a.ldv = NC;
        a.O = BR + qrow * 4096 + 3072 + h * 128; a.ldo = 4096; a.sc_log2 = SCALE_HD * LOG2E;
        a.has_sink = 1; a.sink_l2 = F.in[I_SINK][layer * 8 + h] * LOG2E; a.seg0_tiles = 4;
        if (!isctx) { const int start = qb * 256; const int lo = start - 128 < 0 ? 0 : start - 128, hi = start + 384 > S ? S : start + 384;
            a.seg1_row = CTX + lo; a.seg1_tiles = (hi - lo) / 64; a.mask_on = 1; a.qpos0 = start; a.kpos1 = lo; }
        __syncthreads();
        attn_unit<128, true>(F.lds, a, F.wave);
    }
    for (int dup = 0; dup < DUPN(4); ++dup)
    for (int u = F.bid; u < (layer == 0 ? 544 : 512); u += F.G) {
        int b, tb, isctx = 0;
        if (u < 512) { b = u >> 7; tb = u & 127; } else { const int r = u - 512; b = r >> 3; tb = r & 7; isctx = 1; }
        conv_unit(F, layer, b * RB + (isctx ? 0 : CTX), isctx ? CTX : S, tb * 32);
    }
}

__device__ __forceinline__ int tok_row(int layer, int tok) { return layer == 0 ? tok : (tok >> 12) * cf::RB + cf::CTX + (tok & 4095); }
__device__ __forceinline__ void ph_ln1(const Ctx& F0, int layer) {
    const Ctx F = phase_ctx(F0);
    using namespace cf;
    float* X1 = (float*)(F.ws + WS_P + X1_OFF); bf16_t* HB = WSP(bf16_t, WS_HB);
    const float* lg = F.in[I_LN1G] + layer * 2048; const float* lb = F.in[I_LN1B] + layer * 2048;
    const int ntok = layer == 0 ? MR : NB * S, lane = F.lane;
    for (int tok = F.bid * 8 + F.wave; tok < ntok; tok += F.G * 8) {
        const int R = tok_row(layer, tok), b = R / RB, j = R % RB;
        const float* mod = WSP(const float, WS_MOD) + ((size_t)layer * 5 + (j < CTX ? 4 : b)) * 12288;
        float* xp = X1 + (size_t)R * 2048;
        f32x4 v[8]; float s = 0.f;
#pragma unroll
        for (int i = 0; i < 8; ++i) { v[i] = *(const f32x4*)(xp + lane * 4 + 256 * i); s += (v[i][0] + v[i][1]) + (v[i][2] + v[i][3]); }
        const float mean = wave_sum(s, lane) * (1.f / 2048.f); float q = 0.f;
#pragma unroll
        for (int i = 0; i < 8; ++i) { const f32x4 d = v[i] - mean; q += (d[0] * d[0] + d[1] * d[1]) + (d[2] * d[2] + d[3] * d[3]); }
        const float rstd = rsqrtf(wave_sum(q, lane) * (1.f / 2048.f) + 1e-5f);
#pragma unroll
        for (int i = 0; i < 8; ++i) { const int c = lane * 4 + 256 * i;
            const f32x4 y = (v[i] - mean) * rstd * *(const f32x4*)(lg + c) + *(const f32x4*)(lb + c);
            *(f32x4*)(xp + c) = y;
            const f32x4 hp = y * (*(const f32x4*)(mod + 4 * 2048 + c) + 1.0f) + *(const f32x4*)(mod + 3 * 2048 + c);
            u32x2 w; w.x = cvt_pk_bf16(hp[0], hp[1]); w.y = cvt_pk_bf16(hp[2], hp[3]);
            *(u32x2*)(HB + (size_t)R * 2048 + c) = w; }
    }
}

typedef __bf16 bf16x2_t __attribute__((ext_vector_type(2)));
__device__ __forceinline__ unsigned ordkey(float v) { const unsigned u = __float_as_uint(v); return (u & 0x80000000u) ? ~u : (u | 0x80000000u); }
__device__ __forceinline__ int lane_rank(unsigned long long m) { return (int)__builtin_amdgcn_mbcnt_hi((unsigned)(m >> 32), __builtin_amdgcn_mbcnt_lo((unsigned)m, 0u)); }
template <int NV> __device__ __forceinline__ unsigned radix_thresh16(const unsigned (&k)[NV]) {
    unsigned T = 0u;
    for (int bit = 31; bit >= 0; --bit) { const unsigned cand = T | (1u << bit); int cnt = 0;
#pragma unroll
        for (int v = 0; v < NV; ++v) cnt += __popcll(__ballot(k[v] >= cand));
        if (cnt >= 16) { T = cand; if (cnt == 16) break; } }
    return T;
}
__device__ __forceinline__ void radix_thresh16x2(const unsigned (&ka)[2], const unsigned (&kb)[2], unsigned& Ta, unsigned& Tb) {
    unsigned T0 = 0u, T1 = 0u; bool d0 = false, d1 = false;
    for (int bit = 31; bit >= 0; --bit) { const unsigned c0 = T0 | (1u << bit), c1 = T1 | (1u << bit);
        const int n0 = __popcll(__ballot(ka[0] >= c0)) + __popcll(__ballot(ka[1] >= c0)), n1 = __popcll(__ballot(kb[0] >= c1)) + __popcll(__ballot(kb[1] >= c1));
        if (!d0 && n0 >= 16) { T0 = c0; d0 = n0 == 16; }
        if (!d1 && n1 >= 16) { T1 = c1; d1 = n1 == 16; }
        if (d0 && d1) break; }
    Ta = T0; Tb = T1;
}
__device__ __forceinline__ float dot2bf(unsigned a, unsigned b, float acc) { return __builtin_amdgcn_fdot2_f32_bf16(__builtin_bit_cast(bf16x2_t, a), __builtin_bit_cast(bf16x2_t, b), acc, false); }
__device__ __forceinline__ float dot8(const u32x4 a, const u32x4 b, float acc) {
    acc = dot2bf(a.x, b.x, acc); acc = dot2bf(a.y, b.y, acc); acc = dot2bf(a.z, b.z, acc); acc = dot2bf(a.w, b.w, acc);
    return acc;
}
__device__ __forceinline__ float gelu_as(float v) {
    const float av = fabsf(v), t = __builtin_amdgcn_rcpf(av * 0.2316418882f + 1.0f);
    float q = t * 0.5307027145f + (-0.7265760135f); q = q * t + 0.7107068705f; q = q * t + (-0.142248368f); q = q * t + 0.127414796f; q = q * t;
    const float e = __builtin_amdgcn_exp2f((v * v) * (-0.72134752044f)), m = v * (q * e);
    return v < 0.f ? m : v - m;
}
__device__ __forceinline__ void peer_load(u32x4 (&ur)[4][2], u32x4 (&vr)[4], unsigned (&vs)[4], float (&gq)[4], const LAS int* ei, const LAS float* eg,
                                          const unsigned char* U8, const unsigned char* V4, int lane, int grp) {
#pragma unroll
    for (int q = 0; q < 4; ++q) { const int id = __builtin_amdgcn_readfirstlane(ei[grp * 4 + q]); gq[q] = __uint_as_float(__builtin_amdgcn_readfirstlane(__float_as_uint(eg[grp * 4 + q])));
        ur[q][0] = *(const u32x4*)(U8 + (size_t)id * 2048 + lane * 16); ur[q][1] = *(const u32x4*)(U8 + (size_t)id * 2048 + lane * 16 + 1024);
        vr[q] = *(const u32x4*)(V4 + (size_t)id * V4_ROW + lane * 16); vs[q] = V4[(size_t)id * V4_ROW + 1024 + lane]; }
}
__device__ __forceinline__ void peer_comp(const u32x4 (&ur)[4][2], const u32x4 (&vr)[4], const unsigned (&vs)[4], const float (&gq)[4], const f32x2 (&xf)[16], f32x2 (&y2)[16], int lane) {
    float d[4];
#pragma unroll
    for (int q = 0; q < 4; ++q) { f32x2 t = {0.f, 0.f};
#pragma unroll
        for (int i = 0; i < 2; ++i)
#pragma unroll
            for (int j = 0; j < 4; ++j) { const int w = (int)ur[q][i][j];
                t += __builtin_amdgcn_cvt_pk_f32_fp8(w, false) * xf[8 * i + 2 * j]; t += __builtin_amdgcn_cvt_pk_f32_fp8(w, true) * xf[8 * i + 2 * j + 1]; }
        d[q] = t.x + t.y; }
#pragma unroll
    for (int o = 32; o >= 1; o >>= 1) {
#pragma unroll
        for (int q = 0; q < 4; ++q) d[q] += shx(d[q], o, lane); }
#pragma unroll
    for (int q = 0; q < 4; ++q) { const float dd = d[q] * (1.0f / 1024.0f); const float w = gq[q] * gelu_as(dd) * __uint_as_float(vs[q] << 23);
        const f32x2 w2 = {w, w};
#pragma unroll
        for (int j = 0; j < 4; ++j) { const unsigned vw = vr[q][j];
            y2[4 * j + 0] += w2 * __builtin_amdgcn_cvt_scalef32_pk_f32_fp4(vw, 1.0f, 0); y2[4 * j + 1] += w2 * __builtin_amdgcn_cvt_scalef32_pk_f32_fp4(vw, 1.0f, 1);
            y2[4 * j + 2] += w2 * __builtin_amdgcn_cvt_scalef32_pk_f32_fp4(vw, 1.0f, 2); y2[4 * j + 3] += w2 * __builtin_amdgcn_cvt_scalef32_pk_f32_fp4(vw, 1.0f, 3); } }
}
__device__ __forceinline__ unsigned inv_ordkey(unsigned k) { return (k & 0x80000000u) ? (k & 0x7fffffffu) : ~k; }
template <int N> __device__ __forceinline__ int count_ge(const unsigned (&key)[N], unsigned cand) {
    int cnt = 0;
#pragma unroll
    for (int n = 0; n < N; n += 4) { unsigned long long m0, m1, m2, m3;
        asm("v_cmp_ge_u32_e64 %1, %5, %9\n\tv_cmp_ge_u32_e64 %2, %6, %9\n\tv_cmp_ge_u32_e64 %3, %7, %9\n\tv_cmp_ge_u32_e64 %4, %8, %9\n\t"
            "v_addc_co_u32_e64 %0, vcc, 0, %0, %1\n\tv_addc_co_u32_e64 %0, vcc, 0, %0, %2\n\tv_addc_co_u32_e64 %0, vcc, 0, %0, %3\n\tv_addc_co_u32_e64 %0, vcc, 0, %0, %4"
            : "+v"(cnt), "=&s"(m0), "=&s"(m1), "=&s"(m2), "=&s"(m3) : "v"(key[n]), "v"(key[n + 1]), "v"(key[n + 2]), "v"(key[n + 3]), "v"(cand) : "vcc"); }
    return cnt;
}
template <int B> __device__ __forceinline__ void bit_transpose32(unsigned (&A)[64]) {
#pragma unroll
    for (int k = 0; k < 16; ++k) { const unsigned a = A[B + k], b = A[B + k + 16]; A[B + k] = __builtin_amdgcn_perm(b, a, 0x05040100u); A[B + k + 16] = __builtin_amdgcn_perm(b, a, 0x07060302u); }
#pragma unroll
    for (int k = 0; k < 32; ++k) if (!(k & 8)) { const unsigned a = A[B + k], b = A[B + k + 8]; A[B + k] = __builtin_amdgcn_perm(b, a, 0x06020400u); A[B + k + 8] = __builtin_amdgcn_perm(b, a, 0x07030501u); }
#pragma unroll
    for (int k = 0; k < 32; ++k) if (!(k & 4)) { const unsigned a = A[B + k], b = A[B + k + 4]; A[B + k] = (a & 0x0F0F0F0Fu) | ((b << 4) & 0xF0F0F0F0u); A[B + k + 4] = ((a >> 4) & 0x0F0F0F0Fu) | (b & 0xF0F0F0F0u); }
#pragma unroll
    for (int k = 0; k < 32; ++k) if (!(k & 2)) { const unsigned a = A[B + k], b = A[B + k + 2]; A[B + k] = (a & 0x33333333u) | ((b << 2) & 0xCCCCCCCCu); A[B + k + 2] = ((a >> 2) & 0x33333333u) | (b & 0xCCCCCCCCu); }
#pragma unroll
    for (int k = 0; k < 32; ++k) if (!(k & 1)) { const unsigned a = A[B + k], b = A[B + k + 1]; A[B + k] = (a & 0x55555555u) | ((b << 1) & 0xAAAAAAAAu); A[B + k + 1] = ((a >> 1) & 0x55555555u) | (b & 0xAAAAAAAAu); }
}
template <int GRP> __device__ __forceinline__ unsigned lane_radix16(const unsigned (&key)[64], int lane, int& own) {
    unsigned P[64];
#pragma unroll
    for (int n = 0; n < 64; ++n) P[n] = key[n];
    bit_transpose32<0>(P); bit_transpose32<32>(P);
    unsigned T = 0u, act_lo = ~0u, act_hi = ~0u; int above = 0; bool done = false;
#pragma unroll
    for (int bit = 31; bit >= 0; --bit) {
        const unsigned m_lo = act_lo & P[bit], m_hi = act_hi & P[32 + bit];
        const int mine = above + __builtin_popcount(m_lo) + __builtin_popcount(m_hi);
        int tot = mine + __builtin_amdgcn_ds_bpermute((lane ^ 1) << 2, mine);
        if (GRP >= 4) tot += __builtin_amdgcn_ds_bpermute((lane ^ 2) << 2, tot);
        const bool ge = tot >= 16;
        if (ge && !done) T |= 1u << bit;
        act_lo = ge ? m_lo : act_lo & ~m_lo; act_hi = ge ? m_hi : act_hi & ~m_hi;
        above = ge ? above : mine;
        if (tot == 16) { above = mine; act_lo = 0u; act_hi = 0u; done = true; }
        if (__all(done)) break; }
    own = above + __builtin_popcount(act_lo) + __builtin_popcount(act_hi);
    return T;
}
template <int N> __device__ __forceinline__ void compact_ge(const unsigned (&key)[N], unsigned T, int pos, unsigned base, unsigned dump) {
#pragma unroll
    for (int n = 0; n < N; n += 2) { unsigned long long m0, m1; unsigned a0, a1;
        asm("v_cmp_ge_u32_e64 %3, %5, %7\n\tv_cmp_ge_u32_e64 %4, %6, %7\n\tv_lshl_add_u32 %1, %0, 2, %8\n\tv_cndmask_b32_e64 %1, %9, %1, %3\n\tv_addc_co_u32_e64 %0, vcc, 0, %0, %3\n\t"
            "v_lshl_add_u32 %2, %0, 2, %8\n\tv_cndmask_b32_e64 %2, %9, %2, %4\n\tv_addc_co_u32_e64 %0, vcc, 0, %0, %4"
            : "+v"(pos), "=&v"(a0), "=&v"(a1), "=&s"(m0), "=&s"(m1) : "v"(key[n]), "v"(key[n + 1]), "v"(T), "v"(base), "v"(dump) : "vcc");
        *(LAS unsigned*)(size_t)a0 = key[n]; *(LAS unsigned*)(size_t)a1 = key[n + 1]; }
}
template <int MODE> __device__ __forceinline__ void ph_peer(const Ctx& F0, int layer) {
    const Ctx F = phase_ctx(F0);
    using namespace cf;
    const float* SC = (const float*)(F.ws + WS_P + SC_OFF); const float* X1 = (const float*)(F.ws + WS_P + X1_OFF);
    bf16_t* HB = WSP(bf16_t, WS_HB); const unsigned char* U8 = WSP(const unsigned char, WS_UB) + (size_t)layer * NEXP * 2048; const unsigned char* V4 = WSP(const unsigned char, WS_VB2) + (size_t)layer * NEXP * V4_ROW;
    const float* lg = F.in[I_LN2G] + layer * 2048; const float* lb = F.in[I_LN2B] + layer * 2048;
    const int ntok = layer == 0 ? MR : NB * S;
    constexpr int NSLOT = 34;
    ldsp_t ring = F.lds;
#ifndef NPROD
#define NPROD 1
#endif
    const int pw = F.wave - (8 - NPROD);
    ldsp_t pscr = F.lds + 73728 + (pw < 0 ? 0 : pw) * 6144;
    LAS unsigned* lstA = (LAS unsigned*)(pscr);
    LAS unsigned* lstB = (LAS unsigned*)(pscr + 2176);
    LAS unsigned* dmp = (LAS unsigned*)(pscr + 3200);
    volatile LAS unsigned* ready = (volatile LAS unsigned*)(F.lds + 71680); LAS unsigned* next_tok = (LAS unsigned*)(F.lds + 71680 + NSLOT * 4);
    __syncthreads();
    if (F.tid < NSLOT + 1) ((LAS unsigned*)(F.lds + 71680))[F.tid] = 0u;
    __syncthreads();
    const int ntw = ntok / F.G;
    if (pw >= 0) {
      for (int p = pw; p < ntw / 2; p += NPROD) {
        const int slot = p;
        LAS int* ei4 = (LAS int*)(ring + slot * 2048); LAS float* eg4 = (LAS float*)(ring + slot * 2048 + 512);
        const int tok0 = F.bid + (2 * p) * F.G, nwv = F.G;
        if (MODE != 2) {
        { int lane = F.lane; asm volatile("" : "+v"(lane));
          const int t2 = lane >> 5, set = lane >> 1, sset = set & 15, part = lane & 1;
          const int Rl = tok_row(layer, tok0 + t2 * nwv);
          unsigned key[64];
          const float* sp = SC + (size_t)Rl * 2048 + sset * 128 + part * 64;
#pragma unroll
          for (int i = 0; i < 16; ++i) { const f32x4 v = *(const f32x4*)(sp + 4 * i);
#pragma unroll
              for (int e = 0; e < 4; ++e) key[4 * i + e] = (ordkey(v[e]) & ~127u) | (unsigned)(127 - (64 * part + 4 * i + e)); }
          int own; const unsigned T = lane_radix16<2>(key, lane, own);
          const int oth = __builtin_amdgcn_ds_bpermute((lane ^ 1) << 2, own);
          compact_ge<64>(key, T, part ? oth : 0, (unsigned)(size_t)lstA + set * 68, (unsigned)(size_t)dmp + lane * 4);
        }
        asm volatile("s_waitcnt lgkmcnt(0)" ::: "memory");
        {
          int lane = F.lane; asm volatile("" : "+v"(lane));
          const int q = lane & 3, sa = (lane >> 2) * 2, sb = sa + 1;
          float Av[4], Bv[16];
#pragma unroll
          for (int i = 0; i < 4; ++i) Av[i] = __uint_as_float(inv_ordkey((lstA[sa * 17 + 4 * q + i] & ~127u) | 64u));
#pragma unroll
          for (int jx = 0; jx < 16; ++jx) Bv[jx] = __uint_as_float(inv_ordkey((lstA[sb * 17 + jx] & ~127u) | 64u));
          unsigned key[64];
#pragma unroll
          for (int i = 0; i < 4; ++i)
#pragma unroll
              for (int jx = 0; jx < 16; ++jx) key[i * 16 + jx] = (ordkey(Av[i] + Bv[jx]) & ~255u) | (unsigned)(255 - ((4 * q + i) * 16 + jx));
          int mine; const unsigned T = lane_radix16<4>(key, lane, mine);
          const int c1 = __builtin_amdgcn_ds_bpermute((lane ^ 1) << 2, mine), c2 = __builtin_amdgcn_ds_bpermute((lane ^ 2) << 2, mine), c3 = __builtin_amdgcn_ds_bpermute((lane ^ 3) << 2, mine);
          const int c = (q == 1) ? c1 : (q == 2) ? c2 + c3 : (q == 3) ? c1 + c2 + c3 : 0;
          compact_ge<64>(key, T, c, (unsigned)(size_t)lstB + (lane >> 2) * 64, (unsigned)(size_t)dmp + lane * 4);
        }
        asm volatile("s_waitcnt lgkmcnt(0)" ::: "memory");
        { int lane = F.lane; asm volatile("" : "+v"(lane));
#pragma unroll
        for (int rnd = 0; rnd < 4; ++rnd) { const int e = lane + 64 * rnd; const unsigned kk = lstB[e];
            const int cidx = (int)(~kk & 255u), sa = (e >> 4) * 2;
            const unsigned ka = lstA[sa * 17 + (cidx >> 4)], kb = lstA[(sa + 1) * 17 + (cidx & 15)];
            const float sv = __uint_as_float(inv_ordkey((ka & ~127u) | 64u)) + __uint_as_float(inv_ordkey((kb & ~127u) | 64u));
            float m = sv; m = fmaxf(m, shx(m, 1, lane)); m = fmaxf(m, shx(m, 2, lane)); m = fmaxf(m, shx(m, 4, lane)); m = fmaxf(m, shx(m, 8, lane));
            const float ex = __expf(sv - m); float sum = ex; sum += shx(sum, 1, lane); sum += shx(sum, 2, lane); sum += shx(sum, 4, lane); sum += shx(sum, 8, lane);
            ei4[(e >> 7) * 256 + (e & 127)] = (int)((~ka & 127u) * 128u + (~kb & 127u));
            eg4[(e >> 7) * 256 + (e & 127)] = ex / sum; } }
        }
        asm volatile("s_waitcnt lgkmcnt(0)" ::: "memory");
        if (F.lane == 0) ready[slot] = (unsigned)(p + 1);
      }
    }
    {
      for (;;) {
        unsigned tq = 0u; if (F.lane == 0) tq = __hip_atomic_fetch_add(next_tok, 1u, __ATOMIC_RELAXED, __HIP_MEMORY_SCOPE_WORKGROUP);
        const int t = __builtin_amdgcn_readfirstlane((int)tq);
        if (t >= ntw) break;
        const int p = t >> 1, slot = p, tslot = t & 1;
        while (ready[slot] < (unsigned)(p + 1)) __builtin_amdgcn_s_sleep(2);
        asm volatile("" ::: "memory");
        if (MODE == 1) continue;
        int zst = 0; if (MODE == 2) asm volatile("" : "+s"(zst));
        const int tok = F.bid + t * F.G;
        int lane = F.lane; asm volatile("" : "+v"(lane));
        const int R = tok_row(layer, tok), b = R / RB, j = R % RB; const bool isctx = j < CTX; const int modrow = isctx ? 4 : b;
        const LAS int* ei = (const LAS int*)(ring + slot * 2048 + tslot * 1024); const LAS float* eg = (const LAS float*)(ring + slot * 2048 + tslot * 1024 + 512);
        f32x2 xf[16];
#pragma unroll
        for (int i = 0; i < 2; ++i)
#pragma unroll
            for (int hh = 0; hh < 2; ++hh) { const u32x4 w = *(const u32x4*)(HB + (size_t)R * 2048 + lane * 16 + 1024 * i + 8 * hh);
                xf[8 * i + 4 * hh + 0] = (f32x2){bflo(w.x), bfhi(w.x)}; xf[8 * i + 4 * hh + 1] = (f32x2){bflo(w.y), bfhi(w.y)};
                xf[8 * i + 4 * hh + 2] = (f32x2){bflo(w.z), bfhi(w.z)}; xf[8 * i + 4 * hh + 3] = (f32x2){bflo(w.w), bfhi(w.w)}; }
        f32x2 y2[16];
#pragma unroll
        for (int i = 0; i < 16; ++i) y2[i] = (f32x2){0.f, 0.f};
        f32x4 xrow[8];
#pragma unroll
        for (int k = 0; k < 8; ++k) xrow[k] = *(const f32x4*)(X1 + (size_t)R * 2048 + lane * 32 + 4 * k);
        { u32x4 urA[4][2], vrA[4], urB[4][2], vrB[4]; unsigned vsA[4], vsB[4]; float gqA[4], gqB[4];
          peer_load(urA, vrA, vsA, gqA, ei, eg, U8, V4, lane, 0);
          for (int grp = 0; grp < 32; grp += 2) {
              peer_load(urB, vrB, vsB, gqB, ei, eg, U8, V4, lane, grp + 1);
              peer_comp(urA, vrA, vsA, gqA, xf, y2, lane);
              peer_load(urA, vrA, vsA, gqA, ei, eg, U8, V4, lane, grp + 2 < 32 ? grp + 2 : 31);
              peer_comp(urB, vrB, vsB, gqB, xf, y2, lane);
          } }
        const float* mod = WSP(const float, WS_MOD) + ((size_t)layer * 5 + modrow) * 12288;
        float y[32];
        float s = 0.f;
#pragma unroll
        for (int k = 0; k < 8; ++k) { const int c = lane * 32 + 4 * k;
            const f32x4 xa = xrow[k], ga = *(const f32x4*)(mod + 5 * 2048 + c);
            y[4 * k + 0] = ALPHA * xa[0] + ga[0] * y2[2 * k].x; y[4 * k + 1] = ALPHA * xa[1] + ga[1] * y2[2 * k].y;
            y[4 * k + 2] = ALPHA * xa[2] + ga[2] * y2[2 * k + 1].x; y[4 * k + 3] = ALPHA * xa[3] + ga[3] * y2[2 * k + 1].y;
            s += (y[4 * k + 0] + y[4 * k + 1]) + (y[4 * k + 2] + y[4 * k + 3]); }
        const float mean = wave_sum(s, lane) * (1.f / 2048.f); float q2 = 0.f;
#pragma unroll
        for (int i = 0; i < 32; ++i) { const float dd = y[i] - mean; q2 += dd * dd; }
        const float rstd = rsqrtf(wave_sum(q2, lane) * (1.f / 2048.f) + 1e-5f);
        if (MODE == 2 && zst == 0) continue;
        float* dst = layer == 0 ? (isctx ? WSP(float, WS_XC) + ((size_t)b * CTX + j) * 2048 : F.out + ((size_t)b * S + (j - CTX)) * 2048) : F.out + ((size_t)b * S + (j - CTX)) * 2048;
        const float* modn = WSP(const float, WS_MOD) + ((size_t)1 * 5 + modrow) * 12288;
#pragma unroll
        for (int kk = 0; kk < 4; ++kk) { f32x4 o[2];
#pragma unroll
            for (int jj = 0; jj < 2; ++jj) { const int k = 2 * kk + jj, c = lane * 32 + 4 * k; const f32x4 la = *(const f32x4*)(lg + c), ba = *(const f32x4*)(lb + c);
#pragma unroll
                for (int e = 0; e < 4; ++e) o[jj][e] = (y[4 * k + e] - mean) * rstd * la[e] + ba[e];
                *(f32x4*)(dst + c) = o[jj]; }
            if (layer == 0) {
                const int c = lane * 32 + 8 * kk;
                const f32x4 sa = *(const f32x4*)(modn + 2048 + c), sb = *(const f32x4*)(modn + 2048 + c + 4), ha = *(const f32x4*)(modn + c), hb = *(const f32x4*)(modn + c + 4);
                *(u32x4*)(HB + (size_t)R * 2048 + c) = pg8::pack8(o[0] * (sa + 1.0f) + ha, o[1] * (sb + 1.0f) + hb); } }
      }
    }
}

struct Params { const float* in[cf::N_IN]; float* out; unsigned char* ws; int ph_lo, ph_hi; };

__global__ void __launch_bounds__(512, 2) mega_fwd(Params p) {
    using namespace cf;
    extern __shared__ __attribute__((aligned(16))) unsigned char smem[];
    Ctx F0;
    F0.in = p.in;
    F0.out = p.out; F0.ws = p.ws; F0.lds = (ldsp_t)smem;
    F0.tid = 0; F0.lane = 0; F0.wave = __builtin_amdgcn_readfirstlane(threadIdx.x >> 6); F0.G = gridDim.x; F0.bid = blockIdx.x;
    if (threadIdx.x < 64) ((LAS unsigned*)(F0.lds + MISC_OFF))[threadIdx.x] = 0u;
    __syncthreads();
    const int lo = p.ph_lo, hi = p.ph_hi;
    XcdBarrier bar; bar.bar = (unsigned*)(F0.ws + WS_CTL); bar.x = 0; bar.st = (volatile LAS unsigned*)(F0.lds + MISC_OFF); bar.wave = F0.wave;
    if (hi - lo > 1) bar = xcd_barrier_post((unsigned*)(F0.ws + WS_CTL), (volatile LAS unsigned*)(F0.lds + MISC_OFF), F0.wave);
#ifndef MK_MASK
#define MK_MASK 0xFFFF
#endif
#define ON(j) ((MK_MASK >> (j)) & 1)
#define IN(k) (lo <= (k) && (k) < hi)
#define SEAM(k) do { if (IN(k) && IN((k) + 1)) xcd_barrier(bar); } while (0)

    if (ON(9) && IN(0)) { ph_prologue(F0); if (DUPN(9) == 2) { __syncthreads(); ph_prologue(F0); } }
    SEAM(0);
    if (ON(10) && IN(1)) ph_modulate0(F0);
    SEAM(1);
    for (int l = 0; l < DEPTH; ++l) {
        const int pb = 2 + 8 * l;
        const int rmode = l == 0 ? 0 : 1, nMl = l == 0 ? 68 : 64;
        for (int blk = 0; blk < DUPN(12); ++blk) {
        if (blk) xcd_barrier(bar);
        if (ON(0) && IN(pb + 0)) { const Ctx F = phase_ctx(F0);
            pg8::Gemm g{WSP(const bf16_t, WS_HB), WSP(const bf16_t, WS_WIN) + (size_t)l * NC * 2048, 2048, 2048};
            pg8::EpiInProj E{WSP(bf16_t, WS_P), WSP(bf16_t, WS_KB), WSP(const float, WS_COSH), WSP(const float, WS_SINH), WSP(const float, WS_COSR), WSP(const float, WS_SINR),
                             F.in[I_AKN] + l * 128, F.in[I_AQN] + l * 128, WSP(float, WS_SSK), WSP(float, WS_SSQ), WSP(float, WS_SSKV), WSP(float, WS_SSCQ)};
            pg8::TileOrder S; S.init(nMl, 56, F.G, F.bid, rmode);
            for (int dup = 0; dup < DUPN(0); ++dup)
            pg8::gemm_phase(F.lds, g, S, E, F.wave);
            if (l > 0) { pg8::TileOrder S2; S2.init(4, 6, F.G, F.bid, 2); pg8::gemm_phase(F.lds, g, S2, E, F.wave); }
        }
        SEAM(pb + 0);
        if (ON(2) && IN(pb + 1)) { const Ctx F = phase_ctx(F0); bf16_t* P = WSP(bf16_t, WS_P);
            knorm_pass(F);
            { pg8::Gemm g{P + PC_CKV, WSP(const bf16_t, WS_WKVUP) + (size_t)l * 2048 * 256, NC, 256}; pg8::EpiKvUp E{WSP(bf16_t, WS_KB), WSP(bf16_t, WS_VB), WSP(const float, WS_SSKV)};
              pg8::TileOrder S; S.init(68, 8, F.G, F.bid, 0); for (int dup = 0; dup < DUPN(1); ++dup) pg8::gemm_phase(F.lds, g, S, E, F.wave); }
            { pg8::Gemm g{P + PC_CQ, WSP(const bf16_t, WS_WQUP) + (size_t)l * 1536 * 512, NC, 512}; pg8::EpiQUp E{WSP(bf16_t, WS_QB), WSP(const float, WS_COSR), WSP(const float, WS_SINR), WSP(const float, WS_SSCQ)};
              pg8::TileOrder S; S.init(nMl, 6, F.G, F.bid, rmode); for (int dup = 0; dup < DUPN(1); ++dup) pg8::gemm_phase(F.lds, g, S, E, F.wave); }
        }
        SEAM(pb + 1);
        if (ON(3) && IN(pb + 2)) ph_attn(F0, l);
        }
        SEAM(pb + 2);
        if (ON(4) && IN(pb + 3)) { const Ctx F = phase_ctx(F0); bf16_t* P = WSP(bf16_t, WS_P); bf16_t* HB = WSP(bf16_t, WS_HB);
            pg8::Gemm g{WSP(const bf16_t, WS_BR), WSP(const bf16_t, WS_WBR) + (size_t)l * 4 * 2048 * 1024, 4096, 1024};
            pg8::EpiMerge E{HB, P + PC_GATE, NC};
            pg8::TileOrder S; S.init(nMl, 8, F.G, F.bid, rmode, 4, (size_t)1024 * 2, (size_t)2048 * 1024 * 2);
            for (int dup = 0; dup < DUPN(5); ++dup) pg8::gemm_phase(F.lds, g, S, E, F.wave);
        }
        SEAM(pb + 3);
        if (ON(5) && IN(pb + 4)) { const Ctx F = phase_ctx(F0); bf16_t* HB = WSP(bf16_t, WS_HB);
            pg8::Gemm g{HB, WSP(const bf16_t, WS_WO) + (size_t)l * 2048 * 2048, 2048, 2048};
            pg8::EpiWo E{(float*)(F.ws + WS_P + X1_OFF), WSP(const float, WS_MOD) + (size_t)l * 5 * 12288, l == 0 ? F.in[I_X] : (const float*)F.out, F.in[I_CTX]};
            pg8::TileOrder S; S.init(nMl, 8, F.G, F.bid, rmode); for (int dup = 0; dup < DUPN(6); ++dup) pg8::gemm_phase(F.lds, g, S, E, F.wave);
        }
        SEAM(pb + 4);
        if (ON(6) && IN(pb + 5)) ph_ln1(F0, l);
        SEAM(pb + 5);
        if (ON(7) && IN(pb + 6)) { const Ctx F = phase_ctx(F0); bf16_t* HB = WSP(bf16_t, WS_HB);
            pg8::Gemm g{HB, WSP(const bf16_t, WS_WFOLD) + (size_t)l * 2048 * 2048, 2048, 2048}; pg8::EpiF32 E{(float*)(F.ws + WS_P + SC_OFF), 2048};
            pg8::TileOrder S; S.init(nMl, 8, F.G, F.bid, rmode); for (int dup = 0; dup < DUPN(7); ++dup) pg8::gemm_phase(F.lds, g, S, E, F.wave);
        }
        SEAM(pb + 6);
        if (ON(8) && IN(pb + 7)) { ph_peer<0>(F0, l); if (DUPN(8) == 2 && l == 1) ph_peer<MK_PV>(F0, l); }
        SEAM(pb + 7);
    }
#undef IN
#undef SEAM
}

extern "C" void kernel_launch(void* const* d_in, const int* in_sizes, int n_in, void* d_out, int out_size, void* d_ws, size_t ws_size, hipStream_t stream) {
    static int grid = 0;
    if (grid == 0) {
        if (n_in != cf::N_IN || out_size != cf::NB * cf::S * cf::D || ws_size < cf::WS_END) {
            fprintf(stderr, "kernel_launch: unexpected shapes: n_in %d out %d ws %zu (need %zu)\n", n_in, out_size, ws_size, (size_t)cf::WS_END); grid = -1; return; }
        int dev = 0, cus = 0;
        if (hipGetDevice(&dev) != hipSuccess || hipDeviceGetAttribute(&cus, hipDeviceAttributeMultiprocessorCount, dev) != hipSuccess || cus < 1) { grid = -1; return; }
        if (hipFuncSetAttribute((const void*)mega_fwd, hipFuncAttributeMaxDynamicSharedMemorySize, cf::LDS_BYTES) != hipSuccess) { fprintf(stderr, "kernel_launch: hipFuncSetAttribute failed\n"); grid = -1; return; }
        int per_cu = 0;
        if (hipOccupancyMaxActiveBlocksPerMultiprocessor(&per_cu, (const void*)mega_fwd, 512, cf::LDS_BYTES) != hipSuccess || per_cu < 1)
            fprintf(stderr, "kernel_launch: note: occupancy query reports %d workgroups per CU\n", per_cu);
        (void)hipGetLastError();
        grid = cus;
    }
    if (grid < 0) return;
    (void)hipMemsetAsync((char*)d_ws + cf::WS_CTL, 0, cf::CTL_BYTES, stream);
    Params p{};
    for (int i = 0; i < cf::N_IN; ++i) p.in[i] = (const float*)d_in[i];
    p.out = (float*)d_out; p.ws = (unsigned char*)d_ws;
#if MK_PER_PHASE
    for (int k = 0; k < cf::N_PHASES; ++k) { p.ph_lo = k; p.ph_hi = k + 1; hipLaunchKernelGGL(mega_fwd, dim3(grid), dim3(512), cf::LDS_BYTES, stream, p); }
#else
    p.ph_lo = 0; p.ph_hi = cf::N_PHASES;
    hipLaunchKernelGGL(mega_fwd, dim3(grid), dim3(512), cf::LDS_BYTES, stream, p);
#endif
    const hipError_t le = hipPeekAtLastError();
    if (le != hipSuccess) fprintf(stderr, "kernel_launch: launch failed: %s\n", hipGetErrorName(le));
}
```

```cpp
#include <hip/hip_runtime.h>
#include <stdint.h>
#include <stdio.h>

#ifndef MK_DUP
#define MK_DUP 0
#endif
#define DUPN(k) (((MK_DUP >> (k)) & 1) ? 2 : 1)
#ifndef MK_PV
#define MK_PV 0
#endif
#ifndef MK_AV
#define MK_AV 0
#endif
#ifndef MK_PER_PHASE
#define MK_PER_PHASE 0
#endif

namespace cf {
constexpr int D = 2048, NB = 4, S = 4096, CTX = 256, RB = CTX + S  , MR = NB * RB  ;
constexpr int DEPTH = 2;
constexpr int PC_AK = 0, PC_AV = 256, PC_CKV = 512, PC_KR = 768, PC_DK = 1024, PC_DV = 1280, PC_KVEND = 1536;
constexpr int PC_AQ = 1536, PC_CQ = 2560, PC_DQ = 3072, PC_GLU = 4096, PC_GATE = 6144, NC = 14336;
constexpr int IN_COLS = 14144;
constexpr int NEXP = 16384;
constexpr float ALPHA = 1.4142135623730951f;
constexpr float LOG2E = 1.4426950408889634f;
constexpr float SCALE_HD = 0.08838834764831845f;
constexpr float SCALE_MLA = 0.07216878364870323f;
enum { I_X = 0, I_C, I_CTX, I_CCTX, I_WADA, I_BADA, I_WIN, I_AQN, I_AKN, I_BQN, I_WQUP, I_BKVN, I_WKVUP, I_CW, I_CB, I_CLG, I_CLB, I_SINK,
       I_WBRA, I_WBRB, I_WBRC, I_WBRD, I_WO, I_LN1G, I_LN1B, I_LN2G, I_LN2B, I_PWQ, I_PSK, I_PU, I_PV, N_IN };
constexpr size_t al(size_t x) { return (x + 255) / 256 * 256; }
constexpr size_t WS_CTL = 0;
constexpr size_t CTL_BYTES = 65536;
constexpr size_t WS_MOD = WS_CTL + CTL_BYTES;
constexpr size_t WS_COSH = WS_MOD + al((size_t)2 * 5 * 12288 * 4);
constexpr size_t WS_SINH = WS_COSH + (size_t)4096 * 64 * 4;
constexpr size_t WS_COSR = WS_SINH + (size_t)4096 * 64 * 4;
constexpr size_t WS_SINR = WS_COSR + (size_t)4096 * 32 * 4;
constexpr size_t WS_WIN = WS_SINR + (size_t)4096 * 32 * 4;
constexpr size_t WS_WQUP = WS_WIN + (size_t)2 * NC * 2048 * 2;
constexpr size_t WS_WKVUP = WS_WQUP + (size_t)2 * 1536 * 512 * 2;
constexpr size_t WS_WBR = WS_WKVUP + (size_t)2 * 2048 * 256 * 2;
constexpr size_t WS_WO = WS_WBR + (size_t)2 * 4 * 2048 * 1024 * 2;
constexpr size_t WS_WFOLD = WS_WO + (size_t)2 * 2048 * 2048 * 2;
constexpr size_t WS_UB = WS_WFOLD + (size_t)2 * 2048 * 2048 * 2;
constexpr size_t WS_VB2 = WS_UB + (size_t)2 * NEXP * 2048;
constexpr size_t WS_HB = WS_VB2 + (size_t)2 * NEXP * 2048;
constexpr size_t WS_P = WS_HB + (size_t)MR * 2048 * 2;
constexpr size_t WS_QB = WS_P + (size_t)MR * NC * 2;
constexpr size_t WS_KB = WS_QB + (size_t)MR * 1536 * 2;
constexpr size_t WS_VB = WS_KB + (size_t)MR * 1536 * 2;
constexpr size_t WS_BR = WS_VB + (size_t)MR * 1024 * 2;
constexpr size_t WS_XC = WS_BR + (size_t)MR * 4096 * 2;
constexpr size_t WS_SSK = WS_XC + (size_t)1024 * 2048 * 4;
constexpr size_t WS_SSQ = WS_SSK + (size_t)MR * 4 * 4;
constexpr size_t WS_SSKV = WS_SSQ + (size_t)MR * 16 * 4;
constexpr size_t WS_SSCQ = WS_SSKV + (size_t)MR * 4 * 4;
constexpr size_t WS_END = WS_SSCQ + (size_t)MR * 8 * 4;
constexpr size_t X1_OFF = 0, SC_OFF = (size_t)MR * 2048 * 4;
static_assert(SC_OFF * 2 <= (size_t)MR * NC * 2, "X1 + SC fit in P");
constexpr int LDS_BYTES = 132 * 1024;
constexpr int MISC_OFF = 128 * 1024;
constexpr int N_PHASES = 2 + 8 * DEPTH;
}

typedef unsigned short bf16_t;
typedef short bf16x8 __attribute__((ext_vector_type(8)));
typedef float f32x4 __attribute__((ext_vector_type(4)));
typedef float f32x2 __attribute__((ext_vector_type(2)));
typedef unsigned u32x4 __attribute__((ext_vector_type(4)));
typedef unsigned u32x2 __attribute__((ext_vector_type(2)));
#define LAS __attribute__((address_space(3)))
typedef LAS unsigned char* ldsp_t;

typedef __bf16 bf16x2v_t __attribute__((ext_vector_type(2)));
__device__ __forceinline__ unsigned cvt_pk_bf16(float lo, float hi) { const bf16x2v_t r = __builtin_convertvector((f32x2){lo, hi}, bf16x2v_t); return __builtin_bit_cast(unsigned, r); }
__device__ __forceinline__ bf16_t f2bf(float f) { return (bf16_t)(cvt_pk_bf16(f, 0.f) & 0xffffu); }
__device__ __forceinline__ float bf2f(bf16_t b) { return __uint_as_float(((unsigned)b) << 16); }
__device__ __forceinline__ float bflo(unsigned w) { return __uint_as_float(w << 16); }
__device__ __forceinline__ float bfhi(unsigned w) { return __uint_as_float(w & 0xffff0000u); }
__device__ __forceinline__ float shx(float v, int mask, int lane) { return __int_as_float(__builtin_amdgcn_ds_bpermute((lane ^ mask) << 2, __float_as_int(v))); }
__device__ __forceinline__ float wave_sum(float v, int lane) {
#pragma unroll
    for (int o = 32; o >= 1; o >>= 1) v += shx(v, o, lane);
    return v;
}
__device__ __forceinline__ int lane_id() { int l; asm volatile("v_mbcnt_lo_u32_b32 %0, -1, 0\n\tv_mbcnt_hi_u32_b32 %0, -1, %0" : "=v"(l)); return l; }
__device__ __forceinline__ float sigmoidf_(float x) { return __builtin_amdgcn_rcpf(1.0f + __builtin_amdgcn_exp2f(x * -1.4426950408889634f)); }

#define XB_TMO      128
#define XB_XCNT(j)  (256  + 64 * (j))
#define XB_XSUB(j)  (1280 + 64 * (j))
#define XB_XGEN(j)  (2304 + 64 * (j))
#define XB_TOP      3328
#define XB_TOPGEN   3392
#define XCD_BAR_WORDS 3456
#define XB_SPIN_CAP (1u << 23)
__device__ __forceinline__ unsigned xb_ld(unsigned* p)              { return __hip_atomic_load(p, __ATOMIC_RELAXED, __HIP_MEMORY_SCOPE_AGENT); }
__device__ __forceinline__ unsigned xb_add(unsigned* p, unsigned v) { return __hip_atomic_fetch_add(p, v, __ATOMIC_RELAXED, __HIP_MEMORY_SCOPE_AGENT); }
__device__ __forceinline__ unsigned xb_xcc_id() { return (unsigned)__builtin_amdgcn_s_getreg((3 << 11) | 20) & 0xFu; }
#define XB_SPIN(cond, bar) do { unsigned _sp = 0; while (cond) { __builtin_amdgcn_s_sleep(1); \
    if ((++_sp & 255u) == 0u) { if (xb_ld(&(bar)[XB_TMO])) break; if (_sp > XB_SPIN_CAP) { atomicAdd(&(bar)[XB_TMO], 1u); break; } } } } while (0)
struct XcdBarrier { unsigned* bar; unsigned x; volatile LAS unsigned* st; int wave; };
__device__ __forceinline__ XcdBarrier xcd_barrier_post(unsigned* bar, volatile LAS unsigned* st, int wave) {
    XcdBarrier b; b.bar = bar; b.x = xb_xcc_id(); b.st = st; b.wave = wave;
    if (wave == 0 && lane_id() == 0) (void)xb_add(&bar[XB_XCNT(b.x)], 1u);
    return b;
}
__device__ __forceinline__ void xcd_barrier_complete(unsigned* bar, unsigned x, unsigned& nloc, unsigned& nx) {
    const unsigned G = gridDim.x * gridDim.y * gridDim.z;
    unsigned sum, cnt, mine, sp = 0u;
    for (;;) {
        sum = 0u; cnt = 0u; mine = 0u;
#pragma unroll
        for (unsigned j = 0; j < 16; ++j) { const unsigned c = xb_ld(&bar[XB_XCNT(j)]); sum += c; cnt += (c > 0u) ? 1u : 0u; mine = (j == x) ? c : mine; }
        if (sum == G) break;
        __builtin_amdgcn_s_sleep(1);
        if ((++sp & 255u) == 0u) { if (xb_ld(&bar[XB_TMO])) break; if (sp > XB_SPIN_CAP) { atomicAdd(&bar[XB_TMO], 1u); break; } }
    }
    nloc = mine > 0u ? mine : 1u; nx = cnt > 0u ? cnt : 1u;
}
__device__ __forceinline__ void xcd_barrier(const XcdBarrier& b) {
    asm volatile("s_waitcnt vmcnt(0)" ::: "memory");
    __syncthreads();
    if (b.wave == 0 && lane_id() == 0) {
        unsigned* bar = b.bar;
        __builtin_amdgcn_s_waitcnt(0);
        unsigned nloc = b.st[0], nx = b.st[1];
        if (nloc == 0u) { xcd_barrier_complete(bar, b.x, nloc, nx); b.st[0] = nloc; b.st[1] = nx; }
        const unsigned old = xb_add(&bar[XB_XSUB(b.x)], 1u);
        const unsigned gen = old / nloc;
        if (old + 1u == (gen + 1u) * nloc) {
            __builtin_amdgcn_fence(__ATOMIC_RELEASE, "agent");
            asm volatile("s_waitcnt vmcnt(0)" ::: "memory");
            const unsigned og = xb_add(&bar[XB_TOP], 1u);
            const unsigned tg = og / nx;
            if (og + 1u == (tg + 1u) * nx) xb_add(&bar[XB_TOPGEN], 1u);
            else XB_SPIN(xb_ld(&bar[XB_TOPGEN]) == tg, bar);
            __builtin_amdgcn_fence(__ATOMIC_ACQUIRE, "agent");
            xb_add(&bar[XB_XGEN(b.x)], 1u);
            asm volatile("s_waitcnt vmcnt(0)" ::: "memory");
        } else {
            XB_SPIN(xb_ld(&bar[XB_XGEN(b.x)]) == gen, bar);
            __builtin_amdgcn_fence(__ATOMIC_ACQUIRE, "agent");
            asm volatile("s_waitcnt vmcnt(0)" ::: "memory");
        }
    }
    __syncthreads();
}

namespace pg8 {
constexpr int BM = 256, BK = 64, HALF = 128, HTB = HALF * BK * 2, STAGE_BYTES = 8 * HTB, NXCD = 8, WGM = 8;
__host__ __device__ __forceinline__ int lds_byte(int r, int c) { const int st = (r >> 4) * 2 + (c >> 5), rr = r & 15, cc = c & 31, ob = rr * 64 + cc * 2; return st * 1024 + (ob ^ (((ob >> 9) & 1) << 5)); }
__host__ __device__ __forceinline__ void stage_rc(int b, int& R, int& C) { const int st = b / 1024, sb = b % 1024, swz = sb ^ (((sb >> 9) & 1) << 5); R = (st >> 1) * 16 + swz / 64; C = (st & 1) * 32 + (swz % 64) / 2; }
__host__ __device__ __forceinline__ int perm32(int rho) { const int n = rho >> 4, i = rho & 15; return 8 * (i >> 2) + 4 * n + (i & 3); }
struct Unit { int pm, pn, sub; };
struct Gemm { const bf16_t* A; const bf16_t* Bt; int lda, K; };

struct TileOrder {
    int nM, nN, nwg, G, c, mode, nsub; size_t subA, subB;
    __device__ void init(int nM_, int nN_, int G_, int c_, int mode_, int nsub_ = 1, size_t subA_ = 0, size_t subB_ = 0) { nM = nM_; nN = nN_; nwg = nM * nN; G = G_; c = c_; mode = mode_; nsub = nsub_; subA = subA_; subB = subB_; }
    __device__ bool next(int i, Unit& u) const {
        const int it = nsub == 1 ? i : i / nsub; u.sub = nsub == 1 ? 0 : i - it * nsub;
        const long L = (long)it * G + c; if (L >= nwg) return false;
        int wgid = (int)L; { const int q = nwg / NXCD, r = nwg % NXCD, xcd = wgid % NXCD, off = wgid / NXCD; wgid = (xcd < r ? xcd * (q + 1) : r * (q + 1) + (xcd - r) * q) + off; }
        const int nig = WGM * nN, gid = wgid / nig, fm = gid * WGM, gsz = (nM - fm) < WGM ? (nM - fm) : WGM;
        const int pl = fm + ((wgid % nig) % gsz); u.pn = (wgid % nig) / gsz;
        u.pm = mode == 0 ? pl : (mode == 1 ? 17 * (pl >> 4) + 1 + (pl & 15) : 17 * pl);
        return true;
    }
    __device__ __forceinline__ void a_ready(const Unit&) const {}
    __device__ __forceinline__ void done(const Unit&) const {}
};

template <class Epi, class Sched>
__device__ __forceinline__ void gemm_phase(ldsp_t lds, const Gemm g, const Sched& S, const Epi& E, int wave_) {
    int tid = wave_ * 64 + lane_id(); asm volatile("" : "+v"(tid));
    const int wid = __builtin_amdgcn_readfirstlane(tid >> 6), lane = tid & 63, wr = wid >> 2, wc = wid & 3, fr = lane & 15, fq = lane >> 4;
    int K = g.K; asm volatile("" : "+s"(K));
    const int nt = K / BK, lda = g.lda;
    unsigned voffA[2], voffB[2];
#pragma unroll
    for (int i = 0; i < 2; ++i) { int R, C; stage_rc(tid * 16 + i * 8192, R, C); const int Rb = (R & ~31) + perm32(R & 31);
        voffA[i] = (unsigned)(R * lda + C) * 2u; voffB[i] = (unsigned)(Rb * K + C) * 2u; }
    const size_t kstep = (size_t)(BK * 2);
    const size_t hstepA = (size_t)HALF * lda * 2, hstepB = (size_t)HALF * K * 2;
    const size_t tstepA = 2 * hstepA, tstepB = 2 * hstepB;
    const unsigned ldsw = (unsigned)wid * 1024u;
    const int aoff = lds_byte(wr * 64 + fr, fq * 8), boff = lds_byte(wc * 32 + fr, fq * 8);
#define PG8_SA(b, h) (((b) * 2 + (h)) * HTB)
#define PG8_SB(b, h) ((4 + (b) * 2 + (h)) * HTB)
#define PG8_STAGE(bufoff, gbase, voff) do { _Pragma("unroll") for (int _i = 0; _i < 2; ++_i) \
        __builtin_amdgcn_global_load_lds((const unsigned*)((const char*)(gbase) + (voff)[_i]), (LAS unsigned*)(lds + (bufoff) + ldsw + _i * 8192), 16, 0, 0); } while (0)
#define PG8_LDA(dst, b, h) do { _Pragma("unroll") for (int m = 0; m < 4; ++m) _Pragma("unroll") for (int k = 0; k < 2; ++k) dst[m][k] = *(const LAS bf16x8*)(lds + PG8_SA(b, h) + aoff + m * 2048 + k * 1024); } while (0)
#define PG8_LDB(dst, b, h) do { _Pragma("unroll") for (int n = 0; n < 2; ++n) _Pragma("unroll") for (int k = 0; k < 2; ++k) dst[n][k] = *(const LAS bf16x8*)(lds + PG8_SB(b, h) + boff + n * 2048 + k * 1024); } while (0)
#define PG8_MMA(ai, bj, At, Bt) do { __builtin_amdgcn_s_setprio(1); _Pragma("unroll") for (int m = 0; m < 4; ++m) _Pragma("unroll") for (int n = 0; n < 2; ++n) _Pragma("unroll") for (int k = 0; k < 2; ++k) \
        acc[ai][bj][m][n] = __builtin_amdgcn_mfma_f32_16x16x32_bf16(Bt[n][k], At[m][k], acc[ai][bj][m][n], 0, 0, 0); __builtin_amdgcn_s_setprio(0); } while (0)
#define PG8_WAIT_V(n) asm volatile("s_waitcnt vmcnt(" #n ")" ::: "memory")
#define PG8_WAIT_L(n) asm volatile("s_waitcnt lgkmcnt(" #n ")" ::: "memory")
#define PG8_BAR __builtin_amdgcn_s_barrier()
#define PG8_SCHED __builtin_amdgcn_sched_barrier(0)
    Unit cur, nxt; int ui = 0;
    if (!S.next(0, cur)) return;
    f32x4 acc[2][2][4][2];
#pragma unroll
    for (int a = 0; a < 2; ++a)
#pragma unroll
        for (int b = 0; b < 2; ++b)
#pragma unroll
            for (int m = 0; m < 4; ++m)
#pragma unroll
                for (int n = 0; n < 2; ++n) acc[a][b][m][n] = (f32x4){0.f, 0.f, 0.f, 0.f};
    bf16x8 At[4][2], B0[2][2], B1[2][2];
    const char* cA = (const char*)g.A + (size_t)cur.pm * tstepA + cur.sub * S.subA; const char* cB = (const char*)g.Bt + (size_t)cur.pn * tstepB + cur.sub * S.subB;
    S.a_ready(cur);
    PG8_STAGE(PG8_SB(0, 0), cB, voffB); PG8_STAGE(PG8_SA(0, 0), cA, voffA); PG8_STAGE(PG8_SB(0, 1), cB + hstepB, voffB); PG8_STAGE(PG8_SA(0, 1), cA + hstepA, voffA);
    if (wr == 1) PG8_BAR;
    PG8_WAIT_V(4); PG8_BAR;
    PG8_STAGE(PG8_SB(1, 0), cB + kstep, voffB); PG8_STAGE(PG8_SA(1, 0), cA + kstep, voffA); PG8_STAGE(PG8_SB(1, 1), cB + hstepB + kstep, voffB);
    PG8_WAIT_V(6); PG8_BAR;
    for (;;) {
        const bool has_next = S.next(ui + 1, nxt);
        const char* nA = has_next ? (const char*)g.A + (size_t)nxt.pm * tstepA + nxt.sub * S.subA : cA; const char* nB = has_next ? (const char*)g.Bt + (size_t)nxt.pn * tstepB + nxt.sub * S.subB : cB;
#pragma unroll 1
        for (int t = 0; t < nt; t += 2) {
            const bool last = (t == nt - 2);
            const char* a1 = cA + (size_t)(t + 1) * kstep;
            const char* a2 = last ? nA : cA + (size_t)(t + 2) * kstep; const char* b2 = last ? nB : cB + (size_t)(t + 2) * kstep;
            const char* a3 = a2 + kstep; const char* b3 = b2 + kstep;
            if (last && has_next) S.a_ready(nxt);
            PG8_LDB(B0, 0, 0); PG8_SCHED; PG8_LDA(At, 0, 0); PG8_STAGE(PG8_SA(1, 1), a1 + hstepA, voffA);
            PG8_WAIT_L(8); PG8_BAR; PG8_WAIT_L(0); PG8_MMA(0, 0, At, B0); PG8_BAR; PG8_SCHED;
            PG8_LDB(B1, 0, 1); PG8_STAGE(PG8_SB(0, 0), b2, voffB);
            PG8_BAR; PG8_WAIT_L(0); PG8_MMA(0, 1, At, B1); PG8_BAR;
            PG8_LDA(At, 0, 1); PG8_STAGE(PG8_SA(0, 0), a2, voffA);
            PG8_BAR; PG8_WAIT_L(0); PG8_MMA(1, 0, At, B0); PG8_BAR; PG8_SCHED;
            PG8_STAGE(PG8_SB(0, 1), b2 + hstepB, voffB);
            PG8_WAIT_V(6); PG8_BAR; PG8_MMA(1, 1, At, B1); PG8_BAR;
            PG8_LDB(B0, 1, 0); PG8_SCHED; PG8_LDA(At, 1, 0); PG8_STAGE(PG8_SA(0, 1), a2 + hstepA, voffA);
            PG8_WAIT_L(8); PG8_BAR; PG8_WAIT_L(0); PG8_MMA(0, 0, At, B0); PG8_BAR; PG8_SCHED;
            PG8_LDB(B1, 1, 1); PG8_STAGE(PG8_SB(1, 0), b3, voffB);
            PG8_BAR; PG8_WAIT_L(0); PG8_MMA(0, 1, At, B1); PG8_BAR;
            PG8_LDA(At, 1, 1); PG8_STAGE(PG8_SA(1, 0), a3, voffA);
            PG8_BAR; PG8_WAIT_L(0); PG8_MMA(1, 0, At, B0); PG8_BAR; PG8_SCHED;
            PG8_STAGE(PG8_SB(1, 1), b3 + hstepB, voffB);
            PG8_WAIT_V(6); PG8_BAR; PG8_MMA(1, 1, At, B1); PG8_BAR;
        }
        E(acc, cur, wr, wc, fr, fq); S.done(cur);
        if (!has_next) break;
#pragma unroll
        for (int a = 0; a < 2; ++a)
#pragma unroll
            for (int b = 0; b < 2; ++b)
#pragma unroll
                for (int m = 0; m < 4; ++m)
#pragma unroll
                    for (int n = 0; n < 2; ++n) acc[a][b][m][n] = (f32x4){0.f, 0.f, 0.f, 0.f};
        cur = nxt; cA = nA; cB = nB; ++ui;
    }
    PG8_WAIT_V(0);
    if (wr == 0) PG8_BAR;
    PG8_BAR;
#undef PG8_SA
#undef PG8_SB
#undef PG8_STAGE
#undef PG8_LDA
#undef PG8_LDB
#undef PG8_MMA
#undef PG8_WAIT_V
#undef PG8_WAIT_L
#undef PG8_BAR
#undef PG8_SCHED
}

__device__ __forceinline__ u32x4 pack8(const f32x4 a, const f32x4 b) { u32x4 w; w.x = cvt_pk_bf16(a[0], a[1]); w.y = cvt_pk_bf16(a[2], a[3]); w.z = cvt_pk_bf16(b[0], b[1]); w.w = cvt_pk_bf16(b[2], b[3]); return w; }
#define EPI_ARGS const f32x4 (&acc)[2][2][4][2], const Unit& u, int wr, int wc, int fr_, int fq_
#define EPI_LANE int fr = fr_, fq = fq_; asm volatile("" : "+v"(fr), "+v"(fq));

struct EpiBf16 {
    bf16_t* O; int ldc;
    __device__ __forceinline__ void operator()(EPI_ARGS) const {
        EPI_LANE
        const int row0 = u.pm * BM + wr * 64 + fr, col0 = u.pn * BM + wc * 32 + 8 * fq;
#pragma unroll
        for (int ai = 0; ai < 2; ++ai)
#pragma unroll
            for (int m = 0; m < 4; ++m) { bf16_t* rowp = O + (size_t)(row0 + ai * HALF + m * 16) * ldc + col0;
#pragma unroll
                for (int bj = 0; bj < 2; ++bj) *(u32x4*)(rowp + bj * HALF) = pack8(acc[ai][bj][m][0], acc[ai][bj][m][1]); }
    }
};
struct EpiF32 {
    float* C; int ldc;
    __device__ __forceinline__ void operator()(EPI_ARGS) const {
        EPI_LANE
        const int row0 = u.pm * BM + wr * 64 + fr, col0 = u.pn * BM + wc * 32 + 8 * fq;
#pragma unroll
        for (int ai = 0; ai < 2; ++ai)
#pragma unroll
            for (int m = 0; m < 4; ++m) { float* rowp = C + (size_t)(row0 + ai * HALF + m * 16) * ldc + col0;
#pragma unroll
                for (int bj = 0; bj < 2; ++bj) { *(f32x4*)(rowp + bj * HALF) = acc[ai][bj][m][0]; *(f32x4*)(rowp + bj * HALF + 4) = acc[ai][bj][m][1]; } }
    }
};
struct EpiInProj {
    bf16_t* P; bf16_t* KB; const float* cosh; const float* sinh; const float* cosr; const float* sinr; const float* akn; const float* aqn;
    float* ssk; float* ssq; float* sskv; float* sscq;
    __device__ __forceinline__ void operator()(EPI_ARGS) const {
        EPI_LANE
        const int pn = u.pn, tb = u.pm % 17; const bool lat = tb != 0; const int posbase = (tb - 1) * 256;
        const int rl0 = wr * 64 + fr;
        if (pn >= 24) {
            const int col0 = pn * BM + wc * 32 + 8 * fq;
#pragma unroll
            for (int ai = 0; ai < 2; ++ai)
#pragma unroll
                for (int m = 0; m < 4; ++m) { bf16_t* rowp = P + ((size_t)u.pm * BM + rl0 + ai * HALF + m * 16) * cf::NC + col0;
#pragma unroll
                    for (int bj = 0; bj < 2; ++bj) { f32x4 v0 = acc[ai][bj][m][0], v1 = acc[ai][bj][m][1];
#pragma unroll
                        for (int e = 0; e < 4; ++e) { v0[e] = sigmoidf_(v0[e]); v1[e] = sigmoidf_(v1[e]); }
                        *(u32x4*)(rowp + bj * HALF) = pack8(v0, v1); } }
        } else if (pn >= 16) {
            const int col0 = cf::PC_GLU + 128 * (pn - 16) + wc * 32 + 8 * fq;
#pragma unroll
            for (int ai = 0; ai < 2; ++ai)
#pragma unroll
                for (int m = 0; m < 4; ++m) { f32x4 v0 = acc[ai][0][m][0], v1 = acc[ai][0][m][1]; const f32x4 g0 = acc[ai][1][m][0], g1 = acc[ai][1][m][1];
#pragma unroll
                    for (int e = 0; e < 4; ++e) { v0[e] *= sigmoidf_(g0[e]); v1[e] *= sigmoidf_(g1[e]); }
                    *(u32x4*)(P + ((size_t)u.pm * BM + rl0 + ai * HALF + m * 16) * cf::NC + col0) = pack8(v0, v1); }
        } else if (pn == 3) {
            if (wc == 0) { const int i0 = 8 * fq;
#pragma unroll
                for (int ai = 0; ai < 2; ++ai)
#pragma unroll
                    for (int m = 0; m < 4; ++m) { const int rl = rl0 + ai * HALF + m * 16;
                        f32x4 c0 = {1.f, 1.f, 1.f, 1.f}, c1 = c0, s0 = {0.f, 0.f, 0.f, 0.f}, s1 = s0;
                        if (lat) { const float* cp = cosr + (size_t)(posbase + rl) * 32 + i0; const float* sp = sinr + (size_t)(posbase + rl) * 32 + i0;
                            c0 = *(const f32x4*)cp; c1 = *(const f32x4*)(cp + 4); s0 = *(const f32x4*)sp; s1 = *(const f32x4*)(sp + 4); }
                        const f32x4 x1a = acc[ai][0][m][0], x1b = acc[ai][0][m][1], x2a = acc[ai][1][m][0], x2b = acc[ai][1][m][1];
                        const u32x4 w1 = pack8(x1a * c0 - x2a * s0, x1b * c1 - x2b * s1), w2 = pack8(x2a * c0 + x1a * s0, x2b * c1 + x1b * s1);
                        bf16_t* kb = KB + ((size_t)u.pm * BM + rl) * 1536 + 128 + i0;
#pragma unroll
                        for (int h = 0; h < 8; ++h) { *(u32x4*)(kb + h * 192) = w1; *(u32x4*)(kb + h * 192 + 32) = w2; }
                        asm volatile("" ::: "memory"); } }
        } else if (pn == 0 || pn == 4 || (pn >= 6 && pn <= 9) || pn >= 12) {
            const bool norm = pn == 0 || (pn >= 6 && pn <= 9);
            const int hl = wc >> 1, i0 = 32 * (wc & 1) + 8 * fq;
            f32x4 g1a = {1.f, 1.f, 1.f, 1.f}, g1b = g1a, g2a = g1a, g2b = g1a;
            if (norm) { const float* gn = (pn == 0 ? akn : aqn) + i0; g1a = *(const f32x4*)gn; g1b = *(const f32x4*)(gn + 4); g2a = *(const f32x4*)(gn + 64); g2b = *(const f32x4*)(gn + 68); }
            float* ssp = pn == 0 ? ssk + ((size_t)u.pm * BM * 2 + hl) * 2 + (wc & 1) : ssq + ((size_t)u.pm * BM * 8 + (pn - 6) * 2 + hl) * 2 + (wc & 1);
            const int sstr = pn == 0 ? 4 : 16;
#pragma unroll
            for (int ai = 0; ai < 2; ++ai)
#pragma unroll
                for (int m = 0; m < 4; ++m) { const int rl = rl0 + ai * HALF + m * 16;
                    f32x4 x1a = acc[ai][0][m][0], x1b = acc[ai][0][m][1], x2a = acc[ai][1][m][0], x2b = acc[ai][1][m][1];
                    if (norm) { const f32x4 q = x1a * x1a + x1b * x1b + x2a * x2a + x2b * x2b; float ss = (q[0] + q[1]) + (q[2] + q[3]);
                        ss += shx(ss, 16, fr + 16 * fq); ss += shx(ss, 32, fr + 16 * fq);
                        if (fq == 0) ssp[(size_t)rl * sstr] = ss;
                        x1a *= g1a; x1b *= g1b; x2a *= g2a; x2b *= g2b; }
                    f32x4 o1a = x1a, o1b = x1b, o2a = x2a, o2b = x2b;
                    if (lat) { const float* cp = cosh + (size_t)(posbase + rl) * 64 + i0; const float* sp = sinh + (size_t)(posbase + rl) * 64 + i0;
                        const f32x4 c0 = *(const f32x4*)cp, c1 = *(const f32x4*)(cp + 4), s0 = *(const f32x4*)sp, s1 = *(const f32x4*)(sp + 4);
                        o1a = x1a * c0 - x2a * s0; o1b = x1b * c1 - x2b * s1; o2a = x2a * c0 + x1a * s0; o2b = x2b * c1 + x1b * s1; }
                    bf16_t* dst = P + ((size_t)u.pm * BM + rl) * cf::NC + pn * BM + hl * 128 + i0;
                    *(u32x4*)dst = pack8(o1a, o1b); *(u32x4*)(dst + 64) = pack8(o2a, o2b);
                    asm volatile("" ::: "memory"); }
        } else {
            const int col0 = pn * BM + wc * 32 + 8 * fq;
            const bool ssq_on = pn == 2 || pn == 10 || pn == 11;
            float* ssp = pn == 2 ? sskv + (size_t)u.pm * BM * 4 + wc : sscq + (size_t)u.pm * BM * 8 + (pn - 10) * 4 + wc;
            const int sstr = pn == 2 ? 4 : 8;
#pragma unroll
            for (int ai = 0; ai < 2; ++ai)
#pragma unroll
                for (int m = 0; m < 4; ++m) { const int rl = rl0 + ai * HALF + m * 16; bf16_t* rowp = P + ((size_t)u.pm * BM + rl) * cf::NC + col0;
#pragma unroll
                    for (int bj = 0; bj < 2; ++bj) *(u32x4*)(rowp + bj * HALF) = pack8(acc[ai][bj][m][0], acc[ai][bj][m][1]);
                    if (ssq_on) { const f32x4 q = acc[ai][0][m][0] * acc[ai][0][m][0] + acc[ai][0][m][1] * acc[ai][0][m][1] + acc[ai][1][m][0] * acc[ai][1][m][0] + acc[ai][1][m][1] * acc[ai][1][m][1];
                        float ss = (q[0] + q[1]) + (q[2] + q[3]); ss += shx(ss, 16, fr + 16 * fq); ss += shx(ss, 32, fr + 16 * fq);
                        if (fq == 0) ssp[(size_t)rl * sstr] = ss; } }
        }
    }
};
struct EpiKvUp {
    bf16_t* KB; bf16_t* VB; const float* sskv;
    __device__ __forceinline__ void operator()(EPI_ARGS) const {
        EPI_LANE
        const int row0 = u.pm * BM + wr * 64 + fr, d0 = wc * 32 + 8 * fq;
        const bool isk = u.pn < 4;
        bf16_t* base = isk ? KB + (2 * u.pn) * 192 + d0 : VB + (u.pn - 4) * 256 + d0;
        const int ldr = isk ? 1536 : 1024, bjs = isk ? 192 : 128;
#pragma unroll
        for (int ai = 0; ai < 2; ++ai)
#pragma unroll
            for (int m = 0; m < 4; ++m) { const size_t row = (size_t)(row0 + ai * HALF + m * 16); bf16_t* rowp = base + row * ldr;
                const f32x4 pp = *(const f32x4*)(sskv + row * 4); const float r = rsqrtf(((pp[0] + pp[1]) + (pp[2] + pp[3])) * (1.f / 256.f) + 1e-6f);
#pragma unroll
                for (int bj = 0; bj < 2; ++bj) *(u32x4*)(rowp + bj * bjs) = pack8(acc[ai][bj][m][0] * r, acc[ai][bj][m][1] * r); }
    }
};
struct EpiQUp {
    bf16_t* QB; const float* cosr; const float* sinr; const float* sscq;
    __device__ __forceinline__ void operator()(EPI_ARGS) const {
        EPI_LANE
        const int row0 = u.pm * BM + wr * 64 + fr;
        if (u.pn < 4) {
            const int d0 = wc * 32 + 8 * fq;
#pragma unroll
            for (int ai = 0; ai < 2; ++ai)
#pragma unroll
                for (int m = 0; m < 4; ++m) { const size_t row = (size_t)(row0 + ai * HALF + m * 16);
                    const f32x4 pa = *(const f32x4*)(sscq + row * 8), pb = *(const f32x4*)(sscq + row * 8 + 4);
                    const float r = rsqrtf((((pa[0] + pa[1]) + (pa[2] + pa[3])) + ((pb[0] + pb[1]) + (pb[2] + pb[3]))) * (1.f / 512.f) + 1e-6f);
#pragma unroll
                    for (int bj = 0; bj < 2; ++bj) *(u32x4*)(QB + row * 1536 + (2 * u.pn + bj) * 192 + d0) = pack8(acc[ai][bj][m][0] * r, acc[ai][bj][m][1] * r); }
        } else {
            const int head = 4 * (u.pn - 4) + wc, i0 = 8 * fq;
            const bool lat = (u.pm % 17) != 0; const int posbase = (u.pm % 17) * 256 - 256;
#pragma unroll
            for (int ai = 0; ai < 2; ++ai)
#pragma unroll
                for (int m = 0; m < 4; ++m) { const int rl = wr * 64 + fr + ai * HALF + m * 16; const size_t row = (size_t)u.pm * BM + rl;
                    const f32x4 pa = *(const f32x4*)(sscq + row * 8), pb = *(const f32x4*)(sscq + row * 8 + 4);
                    const float r = rsqrtf((((pa[0] + pa[1]) + (pa[2] + pa[3])) + ((pb[0] + pb[1]) + (pb[2] + pb[3]))) * (1.f / 512.f) + 1e-6f);
                    f32x4 c0 = {1.f, 1.f, 1.f, 1.f}, c1 = c0, s0 = {0.f, 0.f, 0.f, 0.f}, s1 = s0;
                    if (lat) { const float* cp = cosr + (size_t)(posbase + rl) * 32 + i0; const float* sp = sinr + (size_t)(posbase + rl) * 32 + i0;
                        c0 = *(const f32x4*)cp; c1 = *(const f32x4*)(cp + 4); s0 = *(const f32x4*)sp; s1 = *(const f32x4*)(sp + 4); }
                    const f32x4 x1a = acc[ai][0][m][0] * r, x1b = acc[ai][0][m][1] * r, x2a = acc[ai][1][m][0] * r, x2b = acc[ai][1][m][1] * r;
                    const f32x4 o1a = x1a * c0 - x2a * s0, o1b = x1b * c1 - x2b * s1, o2a = x2a * c0 + x1a * s0, o2b = x2b * c1 + x1b * s1;
                    bf16_t* dst = QB + row * 1536 + head * 192 + 128 + i0;
                    *(u32x4*)dst = pack8(o1a, o1b); *(u32x4*)(dst + 32) = pack8(o2a, o2b); asm volatile("" ::: "memory"); }
        }
    }
};
struct EpiMerge {
    bf16_t* ACC; const bf16_t* gate0; int ldg;
    __device__ __forceinline__ void operator()(EPI_ARGS) const {
        EPI_LANE
        const int row0 = u.pm * BM + wr * 64 + fr, col0 = u.pn * BM + wc * 32 + 8 * fq;
        const bf16_t* gate = gate0 + u.sub * 2048; const bool first = u.sub == 0;
#pragma unroll
        for (int ai = 0; ai < 2; ++ai) {
            u32x4 gw[4][2], pw[4][2];
#pragma unroll
            for (int m = 0; m < 4; ++m) { const size_t row = (size_t)(row0 + ai * HALF + m * 16);
#pragma unroll
                for (int bj = 0; bj < 2; ++bj) { const int col = col0 + bj * HALF; gw[m][bj] = *(const u32x4*)(gate + row * ldg + col);
                    pw[m][bj] = (u32x4){0u, 0u, 0u, 0u}; if (!first) pw[m][bj] = *(const u32x4*)(ACC + row * 2048 + col); } }
#pragma unroll
            for (int m = 0; m < 4; ++m) { const size_t row = (size_t)(row0 + ai * HALF + m * 16);
#pragma unroll
                for (int bj = 0; bj < 2; ++bj) { const int col = col0 + bj * HALF; const u32x4 g = gw[m][bj], p = pw[m][bj];
                    const f32x4 a0 = acc[ai][bj][m][0], a1 = acc[ai][bj][m][1];
                    f32x4 r0, r1;
                    r0[0] = bflo(p.x) + bflo(g.x) * a0[0]; r0[1] = bfhi(p.x) + bfhi(g.x) * a0[1]; r0[2] = bflo(p.y) + bflo(g.y) * a0[2]; r0[3] = bfhi(p.y) + bfhi(g.y) * a0[3];
                    r1[0] = bflo(p.z) + bflo(g.z) * a1[0]; r1[1] = bfhi(p.z) + bfhi(g.z) * a1[1]; r1[2] = bflo(p.w) + bflo(g.w) * a1[2]; r1[3] = bfhi(p.w) + bfhi(g.w) * a1[3];
                    *(u32x4*)(ACC + row * 2048 + col) = pack8(r0, r1); } }
            asm volatile("" ::: "memory"); }
    }
};
struct EpiWo {
    float* X1; const float* mod  ; const float* xlat  ; const float* xctx  ;
    __device__ __forceinline__ void operator()(EPI_ARGS) const {
        EPI_LANE
        const int b = u.pm / 17, tb = u.pm % 17; const bool isctx = tb == 0;
        const float* g1 = mod + (size_t)(isctx ? 4 : b) * 12288 + 2 * 2048;
        const float* xbase = isctx ? xctx + (size_t)b * cf::CTX * 2048 : xlat + ((size_t)b * cf::S + (size_t)(tb - 1) * 256) * 2048;
        const int rl0 = wr * 64 + fr, col0 = u.pn * BM + wc * 32 + 8 * fq;
        f32x4 gv[2][2];
#pragma unroll
        for (int bj = 0; bj < 2; ++bj) { gv[bj][0] = *(const f32x4*)(g1 + col0 + bj * HALF); gv[bj][1] = *(const f32x4*)(g1 + col0 + bj * HALF + 4); }
#pragma unroll
        for (int ai = 0; ai < 2; ++ai) {
            f32x4 xv[4][2][2];
#pragma unroll
            for (int m = 0; m < 4; ++m) { const int rl = rl0 + ai * HALF + m * 16;
#pragma unroll
                for (int bj = 0; bj < 2; ++bj) { const float* xp = xbase + (size_t)rl * 2048 + col0 + bj * HALF; xv[m][bj][0] = *(const f32x4*)xp; xv[m][bj][1] = *(const f32x4*)(xp + 4); } }
#pragma unroll
            for (int m = 0; m < 4; ++m) { const int rl = rl0 + ai * HALF + m * 16; float* op = X1 + ((size_t)u.pm * BM + rl) * 2048 + col0;
#pragma unroll
                for (int bj = 0; bj < 2; ++bj) { *(f32x4*)(op + bj * HALF) = xv[m][bj][0] * cf::ALPHA + gv[bj][0] * acc[ai][bj][m][0];
                    *(f32x4*)(op + bj * HALF + 4) = xv[m][bj][1] * cf::ALPHA + gv[bj][1] * acc[ai][bj][m][1]; } }
            asm volatile("" ::: "memory"); }
    }
};
}

struct Ctx {
    const float* const* in; float* out; unsigned char* ws;
    ldsp_t lds; int tid, lane, wave, G, bid;
};
#define WSP(T, off) ((T*)(F.ws + (off)))
__device__ __forceinline__ Ctx phase_ctx(const Ctx& F0) {
    Ctx C = F0;
    C.tid = F0.wave * 64 + lane_id();
    asm volatile("" : "+v"(C.tid));
    { size_t z = 0; asm volatile("" : "+s"(z)); C.ws = F0.ws + z; }
    C.lane = C.tid & 63; C.wave = __builtin_amdgcn_readfirstlane(C.tid >> 6);
    return C;
}

__device__ __forceinline__ int srcmap(int mode, int n) {
    if (mode == 0) {
        const int pn = n >> 8, q = n & 255, bj = q >> 7, r = q & 127, rope = (r >> 6) * 128 + bj * 64 + (r & 63);
        if (pn == 0) return rope;
        if (pn == 1) return 256 + q;
        if (pn == 2) return 512 + q;
        if (pn == 3) return r < 32 ? 768 + bj * 32 + r : -1;
        if (pn == 4) return 832 + rope;
        if (pn == 5) return 1088 + q;
        if (pn < 10) return 1344 + (pn - 6) * 256 + rope;
        if (pn < 12) return 2368 + (pn - 10) * 256 + q;
        if (pn < 16) return 2880 + (pn - 12) * 256 + rope;
        if (pn < 24) return 3904 + bj * 1024 + 128 * (pn - 16) + r;
        return 5952 + (n - 6144);
    }
    if (mode == 1) { if (n < 1024) return (n >> 7) * 192 + (n & 127);
        const int m = n - 1024, t = m >> 8, bj = (m >> 7) & 1, q = m & 127; return (4 * t + (q >> 5)) * 192 + 128 + bj * 32 + (q & 31); }
    if (mode == 2) { if (n < 1024) return (n >> 7) * 256 + (n & 127); const int m = n - 1024; return (m >> 7) * 256 + 128 + (m & 127); }
    return n;
}
__device__ __forceinline__ void tr_tile(const Ctx& F, const float* src, int ld_src, int mode, int k0, bf16_t* dst, int ldd, int n0, const float* kscale = nullptr) {
    LAS float* T = (LAS float*)F.lds;
    const int kr = F.tid >> 6, nc = (F.tid & 63) * 4, sc = srcmap(mode, n0 + nc);
    f32x4 v[8];
#pragma unroll
    for (int h = 0; h < 8; ++h) { v[h] = (f32x4){0.f, 0.f, 0.f, 0.f}; if (sc >= 0) v[h] = *(const f32x4*)(src + (size_t)(k0 + kr + 8 * h) * ld_src + sc); }
#pragma unroll
    for (int h = 0; h < 8; ++h) { const int k = kr + 8 * h; f32x4 x = v[h]; if (kscale) x = x * kscale[k0 + k];
        T[k * 257 + nc + 0] = x[0]; T[k * 257 + nc + 1] = x[1]; T[k * 257 + nc + 2] = x[2]; T[k * 257 + nc + 3] = x[3]; }
    __syncthreads();
    const int n = F.tid >> 1, kc = (F.tid & 1) * 32;
#pragma unroll
    for (int j = 0; j < 4; ++j) { u32x4 w; const int kb = kc + 8 * j;
        w.x = cvt_pk_bf16(T[(kb + 0) * 257 + n], T[(kb + 1) * 257 + n]); w.y = cvt_pk_bf16(T[(kb + 2) * 257 + n], T[(kb + 3) * 257 + n]);
        w.z = cvt_pk_bf16(T[(kb + 4) * 257 + n], T[(kb + 5) * 257 + n]); w.w = cvt_pk_bf16(T[(kb + 6) * 257 + n], T[(kb + 7) * 257 + n]);
        *(u32x4*)(dst + (size_t)(n0 + n) * ldd + k0 + kb) = w; }
    __syncthreads();
}
__device__ __forceinline__ void cvt_rows(const Ctx& F, const float* src, bf16_t* dst, size_t n8) {
    for (size_t i = (size_t)F.bid * 512 + F.tid; i < n8; i += (size_t)F.G * 512) {
        const f32x4 a = *(const f32x4*)(src + i * 8), b = *(const f32x4*)(src + i * 8 + 4);
        *(u32x4*)(dst + i * 8) = pg8::pack8(a, b); }
}

__device__ __forceinline__ void cvt_rows_fp8(const Ctx& F, const float* src, unsigned char* dst, size_t n16, float scale) {
    const size_t stride = (size_t)F.G * 512;
    for (size_t i = (size_t)F.bid * 512 + F.tid; i < n16; i += 2 * stride) {
        const size_t i2 = i + stride; const bool two = i2 < n16;
        f32x4 a[8];
#pragma unroll
        for (int j = 0; j < 4; ++j) { a[j] = *(const f32x4*)(src + i * 16 + 4 * j); a[4 + j] = two ? *(const f32x4*)(src + i2 * 16 + 4 * j) : (f32x4){0.f, 0.f, 0.f, 0.f}; }
        u32x4 w0, w1;
#pragma unroll
        for (int j = 0; j < 4; ++j) { const f32x4 x = a[j] * scale, y = a[4 + j] * scale;
            int p = 0; p = __builtin_amdgcn_cvt_pk_fp8_f32(x[0], x[1], p, false); p = __builtin_amdgcn_cvt_pk_fp8_f32(x[2], x[3], p, true); w0[j] = (unsigned)p;
            int q = 0; q = __builtin_amdgcn_cvt_pk_fp8_f32(y[0], y[1], q, false); q = __builtin_amdgcn_cvt_pk_fp8_f32(y[2], y[3], q, true); w1[j] = (unsigned)q; }
        *(u32x4*)(dst + i * 16) = w0; if (two) *(u32x4*)(dst + i2 * 16) = w1; }
}

constexpr int UV_ROW = 2176, SC_BIAS = 103;
__device__ __forceinline__ float uv_scale(unsigned byte) { return __uint_as_float((byte << 20) + ((unsigned)SC_BIAS << 23)); }
__device__ __forceinline__ void cvt_rows_fp4(const Ctx& F, const float* src, unsigned char* dst, size_t nblk, int which) {
    for (size_t i = (size_t)F.bid * 512 + F.tid; i < nblk; i += (size_t)F.G * 512) {
        f32x4 a[8]; float amax = 0.f;
#pragma unroll
        for (int j = 0; j < 8; ++j) { a[j] = *(const f32x4*)(src + i * 32 + 4 * j); amax = fmaxf(amax, fmaxf(fmaxf(fabsf(a[j][0]), fabsf(a[j][1])), fmaxf(fabsf(a[j][2]), fabsf(a[j][3])))); }
        const unsigned rb = (__float_as_uint(amax * (1.0f / 6.0f)) + 0xFFFFFu) >> 20;
        const unsigned sb = rb < ((unsigned)SC_BIAS << 3) ? 0u : (rb - ((unsigned)SC_BIAS << 3) > 255u ? 255u : rb - ((unsigned)SC_BIAS << 3));
        const float inv = 1.0f / uv_scale(sb);
        u32x4 w;
#pragma unroll
        for (int j = 0; j < 4; ++j) { const f32x4 x = a[2 * j] * inv, y = a[2 * j + 1] * inv; unsigned p = 0u;
            p = __builtin_amdgcn_cvt_scalef32_pk_fp4_f32(p, x[0], x[1], 1.0f, 0); p = __builtin_amdgcn_cvt_scalef32_pk_fp4_f32(p, x[2], x[3], 1.0f, 1);
            p = __builtin_amdgcn_cvt_scalef32_pk_fp4_f32(p, y[0], y[1], 1.0f, 2); p = __builtin_amdgcn_cvt_scalef32_pk_fp4_f32(p, y[2], y[3], 1.0f, 3); w[j] = p; }
        const size_t row = i >> 6; const int bl = (int)(i & 63);
        *(u32x4*)(dst + row * UV_ROW + which * 1024 + bl * 16) = w; dst[row * UV_ROW + 2048 + 2 * bl + which] = (unsigned char)sb;
    }
}

__device__ __forceinline__ void ph_prologue(const Ctx& F0) {
    const Ctx F = phase_ctx(F0);
    using namespace cf;
    constexpr int T_WIN = 2 * 32 * 56, T_QUP = 2 * 8 * 6, T_KVUP = 2 * 4 * 8, T_BR = 2 * 4 * 16 * 8, T_WO = 2 * 32 * 8;
    constexpr int T_ALL = T_WIN + T_QUP + T_KVUP + T_BR + T_WO;
    for (int u = F.bid; u < T_ALL; u += F.G) {
        int t = u;
        if (t < T_WIN) { const int l = t / (32 * 56), r = t % (32 * 56), kt = r / 56, nt = r % 56;
            tr_tile(F, F.in[I_WIN] + (size_t)l * 2048 * IN_COLS, IN_COLS, 0, kt * 64, WSP(bf16_t, WS_WIN) + (size_t)l * NC * 2048, 2048, nt * 256); continue; }
        t -= T_WIN;
        if (t < T_QUP) { const int l = t / (8 * 6), r = t % (8 * 6), kt = r / 6, nt = r % 6;
            tr_tile(F, F.in[I_WQUP] + (size_t)l * 512 * 1536, 1536, 1, kt * 64, WSP(bf16_t, WS_WQUP) + (size_t)l * 1536 * 512, 512, nt * 256, F.in[I_BQN] + l * 512); continue; }
        t -= T_QUP;
        if (t < T_KVUP) { const int l = t / (4 * 8), r = t % (4 * 8), kt = r / 8, nt = r % 8;
            tr_tile(F, F.in[I_WKVUP] + (size_t)l * 256 * 2048, 2048, 2, kt * 64, WSP(bf16_t, WS_WKVUP) + (size_t)l * 2048 * 256, 256, nt * 256, F.in[I_BKVN] + l * 256); continue; }
        t -= T_KVUP;
        if (t < T_BR) { const int l = t / (4 * 128), r = t % (4 * 128), br = r / 128, r2 = r % 128, kt = r2 / 8, nt = r2 % 8;
            const float* src = (br == 0 ? F.in[I_WBRA] : br == 1 ? F.in[I_WBRB] : br == 2 ? F.in[I_WBRC] : F.in[I_WBRD]) + (size_t)l * 1024 * 2048;
            tr_tile(F, src, 2048, 3, kt * 64, WSP(bf16_t, WS_WBR) + ((size_t)l * 4 + br) * 2048 * 1024, 1024, nt * 256); continue; }
        t -= T_BR;
        { const int l = t / 256, r = t % 256, kt = r / 8, nt = r % 8;
            tr_tile(F, F.in[I_WO] + (size_t)l * 2048 * 2048, 2048, 3, kt * 64, WSP(bf16_t, WS_WO) + (size_t)l * 2048 * 2048, 2048, nt * 256); }
    }
    for (int u = F.bid; u < 2 * 16 * 32; u += F.G) {
        const int l = u / 512, g = (u % 512) / 32, d0 = (u % 32) * 64;
        LAS float* sk = (LAS float*)F.lds; LAS float* wt = (LAS float*)(F.lds + 128 * 129 * 4);
        const float* skg = F.in[I_PSK] + ((size_t)l * 16 + g) * 128 * 128;
        const float* wqg = F.in[I_PWQ] + (size_t)l * 2048 * 2048 + (size_t)d0 * 2048 + g * 128;
        for (int i = F.tid; i < 128 * 128; i += 512) sk[(i >> 7) * 129 + (i & 127)] = skg[i];
        for (int i = F.tid; i < 64 * 128; i += 512) wt[(i >> 7) * 129 + (i & 127)] = wqg[(size_t)(i >> 7) * 2048 + (i & 127)];
        __syncthreads();
        const int n = F.tid & 127, dg = F.tid >> 7;
        float a[16];
#pragma unroll
        for (int e = 0; e < 16; ++e) a[e] = 0.f;
        for (int k = 0; k < 128; ++k) { const float s = sk[n * 129 + k];
#pragma unroll
            for (int e = 0; e < 16; ++e) a[e] += wt[(dg * 16 + e) * 129 + k] * s; }
        bf16_t* dst = WSP(bf16_t, WS_WFOLD) + (size_t)l * 2048 * 2048 + (size_t)(g * 128 + n) * 2048 + d0 + dg * 16;
        u32x4 w0, w1;
        w0.x = cvt_pk_bf16(a[0], a[1]); w0.y = cvt_pk_bf16(a[2], a[3]); w0.z = cvt_pk_bf16(a[4], a[5]); w0.w = cvt_pk_bf16(a[6], a[7]);
        w1.x = cvt_pk_bf16(a[8], a[9]); w1.y = cvt_pk_bf16(a[10], a[11]); w1.z = cvt_pk_bf16(a[12], a[13]); w1.w = cvt_pk_bf16(a[14], a[15]);
        *(u32x4*)dst = w0; *(u32x4*)(dst + 8) = w1;
        __syncthreads();
    }
    for (int u = F.bid; u < 2 * 192; u += F.G) {
        const int l = u / 192, n0 = (u % 192) * 64;
        LAS float* sl = (LAS float*)F.lds; LAS float* red = (LAS float*)(F.lds + 5 * 2048 * 4);
        for (int i = F.tid; i < 5 * 2048; i += 512) { const int r = i >> 11, k = i & 2047; const float v = r < 4 ? F.in[I_C][r * 2048 + k] : F.in[I_CCTX][k]; sl[i] = v * sigmoidf_(v); }
        __syncthreads();
        const int cg = F.tid & 15, ks = F.tid >> 4;
        f32x4 a[5];
#pragma unroll
        for (int r = 0; r < 5; ++r) a[r] = (f32x4){0.f, 0.f, 0.f, 0.f};
        const float* wp = F.in[I_WADA] + (size_t)l * 2048 * 12288 + n0 + cg * 4;
#pragma unroll 8
        for (int k = ks * 64; k < ks * 64 + 64; ++k) { const f32x4 w = *(const f32x4*)(wp + (size_t)k * 12288);
#pragma unroll
            for (int r = 0; r < 5; ++r) a[r] += w * sl[r * 2048 + k]; }
#pragma unroll
        for (int r = 0; r < 5; ++r) *(LAS f32x4*)(red + (ks * 5 + r) * 64 + cg * 4) = a[r];
        __syncthreads();
        if (F.tid < 320) { const int r = F.tid >> 6, col = F.tid & 63; float sacc = 0.f;
#pragma unroll
            for (int k2 = 0; k2 < 32; ++k2) sacc += red[(k2 * 5 + r) * 64 + col];
            WSP(float, WS_MOD)[((size_t)l * 5 + r) * 12288 + n0 + col] = sacc + F.in[I_BADA][(size_t)l * 12288 + n0 + col]; }
        __syncthreads();
    }
    for (int i = F.bid * 512 + F.tid; i < 4096 * 64; i += F.G * 512) {
        const int pos = i >> 6, j = i & 63, fi = j & 31; const float fr = powf(10000.0f, -(float)(2 * fi) / 64.0f);
        const float ang = (float)(j < 32 ? (pos >> 6) : (pos & 63)) * fr;
        WSP(float, WS_COSH)[i] = cosf(ang); WSP(float, WS_SINH)[i] = sinf(ang);
    }
    for (int i = F.bid * 512 + F.tid; i < 4096 * 32; i += F.G * 512) {
        const int pos = i >> 5, j = i & 31, fi = j & 15; const float fr = powf(10000.0f, -(float)(2 * fi) / 32.0f);
        const float ang = (float)(j < 16 ? (pos >> 6) : (pos & 63)) * fr;
        WSP(float, WS_COSR)[i] = cosf(ang); WSP(float, WS_SINR)[i] = sinf(ang);
    }
    cvt_rows_fp4(F, F.in[I_PU], WSP(unsigned char, WS_UB), (size_t)2 * NEXP * 64, 0);
    cvt_rows_fp4(F, F.in[I_PV], WSP(unsigned char, WS_UB), (size_t)2 * NEXP * 64, 1);
}

__device__ __forceinline__ void ph_modulate0(const Ctx& F0) {
    const Ctx F = phase_ctx(F0);
    using namespace cf;
    const float* mod = WSP(float, WS_MOD);
    for (size_t i = (size_t)F.bid * 512 + F.tid; i < (size_t)MR * 256; i += (size_t)F.G * 512) {
        const int R = (int)(i >> 8), d = (int)(i & 255) * 8, b = R / RB, j = R % RB;
        const float* src = j < CTX ? F.in[I_CTX] + ((size_t)b * CTX + j) * 2048 : F.in[I_X] + ((size_t)b * S + (j - CTX)) * 2048;
        const float* m = mod + (size_t)(j < CTX ? 4 : b) * 12288;
        const f32x4 x0 = *(const f32x4*)(src + d), x1 = *(const f32x4*)(src + d + 4);
        const f32x4 sh0 = *(const f32x4*)(m + d), sh1 = *(const f32x4*)(m + d + 4), s0 = *(const f32x4*)(m + 2048 + d), s1 = *(const f32x4*)(m + 2048 + d + 4);
        *(u32x4*)(WSP(bf16_t, WS_HB) + (size_t)R * 2048 + d) = pg8::pack8(x0 * (s0 + 1.0f) + sh0, x1 * (s1 + 1.0f) + sh1);
    }
}

__device__ __forceinline__ void knorm_pass(const Ctx& F) {
    using namespace cf;
    bf16_t* P = WSP(bf16_t, WS_P); const float* ssk = WSP(const float, WS_SSK);
    for (int it = F.bid * 8 + F.wave; it < MR * 2; it += F.G * 8) {
        const int R = it >> 1, h = it & 1;
        const f32x2 pp = *(const f32x2*)(ssk + (size_t)it * 2); const float r = rsqrtf((pp.x + pp.y) * (1.f / 128.f) + 1e-6f);
        unsigned* q = (unsigned*)(P + (size_t)R * NC + PC_AK + h * 128) + F.lane;
        const unsigned w = *q; *q = cvt_pk_bf16(bflo(w) * r, bfhi(w) * r);
    }
}

struct AttnArgs {
    const bf16_t* Q; const bf16_t* K; const bf16_t* V; bf16_t* O; int ldq, ldk, ldv, ldo;
    int seg0_row, seg0_tiles, seg1_row, seg1_tiles;
    int mask_on, qpos0, kpos1;
    float sc_log2; int has_sink; float sink_l2;
    int variant;
    const float* qss;
};
typedef float f32x16 __attribute__((ext_vector_type(16)));
constexpr float LOG2E_F = 1.4426950408889634f;
template <int DK, bool MASKED>
__device__ __forceinline__ void attn_unit(ldsp_t lds, const AttnArgs a, int wave_) {
    constexpr int ND = DK / 16, KCH = DK / 8, KPT = (64 * KCH) / 512, VST = 72, KM = DK == 128 ? 15 : 7;
    constexpr int KBUF = 64 * DK * 2, VBUF = 128 * VST * 2, VOFF = 2 * KBUF, ALOFF = VOFF + 3 * VBUF;
    int tid = wave_ * 64 + lane_id(); asm volatile("" : "+v"(tid));
    const int wid = __builtin_amdgcn_readfirstlane(tid >> 6), lane = tid & 63, q32 = lane & 31, hi = lane >> 5;
    LAS float* al = (LAS float*)(lds + ALOFF + wid * 128);
    bf16x8 qf[ND];
    { float scq = a.sc_log2;
      if (a.qss) { const f32x2 pp = *(const f32x2*)(a.qss + (size_t)(wid * 32 + q32) * 16); scq *= rsqrtf((pp.x + pp.y) * (1.f / 128.f) + 1e-6f); }
      const bf16_t* qrow = a.Q + (size_t)(wid * 32 + q32) * a.ldq + 8 * hi;
#pragma unroll
      for (int s = 0; s < ND; ++s) { const u32x4 w = *(const u32x4*)(qrow + 16 * s); u32x4 o;
          o.x = cvt_pk_bf16(bflo(w.x) * scq, bfhi(w.x) * scq); o.y = cvt_pk_bf16(bflo(w.y) * scq, bfhi(w.y) * scq);
          o.z = cvt_pk_bf16(bflo(w.z) * scq, bfhi(w.z) * scq); o.w = cvt_pk_bf16(bflo(w.w) * scq, bfhi(w.w) * scq); qf[s] = *(bf16x8*)&o; } }
    f32x16 o[4];
#pragma unroll
    for (int db = 0; db < 4; ++db)
#pragma unroll
        for (int r = 0; r < 16; ++r) o[db][r] = 0.f;
    float m_run = -1e30f, l_run = 0.f;
    const int PV_ = MK_AV ? a.variant : 0;
    const int ntiles = a.seg0_tiles + a.seg1_tiles;
    u32x4 vreg[2];
    const int vkp = tid & 31, vdc = tid >> 5;
    const int vkey = 2 * vkp, vpos = (vkey & 48) | ((vkey & 4) << 1) | ((vkey & 8) >> 1) | (vkey & 3);
    unsigned koff[KPT];
#pragma unroll
    for (int i = 0; i < KPT; ++i) { const int P = (i * 8 + wid) * 64 + lane, row = P / KCH, cp = P % KCH; koff[i] = (unsigned)(row * a.ldk + 8 * (cp ^ (row & KM))) * 2u; }
#define ATT_LOAD(tt, kb) do { const int _r0 = (tt) < a.seg0_tiles ? a.seg0_row + 64 * (tt) : a.seg1_row + 64 * ((tt) - a.seg0_tiles); \
        const char* _kg = (const char*)(a.K + (size_t)_r0 * a.ldk); \
        _Pragma("unroll") for (int _i = 0; _i < KPT; ++_i) __builtin_amdgcn_global_load_lds((const unsigned*)(_kg + koff[_i]), (LAS unsigned*)(lds + (kb) * KBUF + (_i * 8 + wid) * 1024), 16, 0, 0); \
        vreg[0] = *(const u32x4*)(a.V + (size_t)(_r0 + 2 * vkp) * a.ldv + 8 * vdc); vreg[1] = *(const u32x4*)(a.V + (size_t)(_r0 + 2 * vkp + 1) * a.ldv + 8 * vdc); } while (0)
#define ATT_WRITE(vb) do { const ldsp_t _vb = lds + VOFF + (vb) * VBUF; \
        const unsigned _a0[4] = {vreg[0].x, vreg[0].y, vreg[0].z, vreg[0].w}, _a1[4] = {vreg[1].x, vreg[1].y, vreg[1].z, vreg[1].w}; \
        _Pragma("unroll") for (int _e = 0; _e < 4; ++_e) { \
            *(LAS unsigned*)(_vb + ((8 * vdc + 2 * _e) * VST + vpos) * 2) = (_a0[_e] & 0xffffu) | (_a1[_e] << 16); \
            *(LAS unsigned*)(_vb + ((8 * vdc + 2 * _e + 1) * VST + vpos) * 2) = (_a0[_e] >> 16) | (_a1[_e] & 0xffff0000u); } } while (0)
#define ATT_PV(vb) do { const ldsp_t _vt = lds + VOFF + (vb) * VBUF; \
        _Pragma("unroll") for (int db = 0; db < 4; ++db) _Pragma("unroll") for (int ks = 0; ks < 4; ++ks) { \
            const bf16x8 vf = *(const LAS bf16x8*)(_vt + ((32 * db + q32) * VST + 16 * ks + 8 * hi) * 2); \
            o[db] = __builtin_amdgcn_mfma_f32_32x32x16_bf16(pa[ks], vf, o[db], 0, 0, 0); } } while (0)
    bf16x8 pa[4];
#pragma unroll
    for (int i = 0; i < 4; ++i) pa[i] = (bf16x8){0, 0, 0, 0, 0, 0, 0, 0};
    int vprev = 2, vcur = 0, vnext = 1;
    { unsigned z0 = 0u; asm volatile("" : "+v"(z0));
      for (int i = tid; i < VBUF / 16; i += 512) *(LAS u32x4*)(lds + VOFF + 2 * VBUF + i * 16) = (u32x4){z0, z0, z0, z0}; }
    ATT_LOAD(0, 0);
    ATT_WRITE(0);
    asm volatile("s_waitcnt vmcnt(0)" ::: "memory");
    __syncthreads();
    for (int tt = 0; tt < ntiles; ++tt) {
        const int cur = tt & 1;
        if (tt + 1 < ntiles && PV_ != 4) ATT_LOAD(tt + 1, cur ^ 1);
        const ldsp_t Ks = lds + cur * KBUF;
        f32x16 s0, s1;
#pragma unroll
        for (int r = 0; r < 16; ++r) { s0[r] = 0.f; s1[r] = 0.f; }
        { bf16x8 kf[2][2];
#define ATT_LDK(p, sb) do { kf[p][0] = *(const LAS bf16x8*)(Ks + (q32 * KCH + ((2 * (sb) + hi) ^ (q32 & KM))) * 16); kf[p][1] = *(const LAS bf16x8*)(Ks + ((32 + q32) * KCH + ((2 * (sb) + hi) ^ (q32 & KM))) * 16); } while (0)
          if (PV_ != 2) {
          ATT_LDK(0, 0);
#pragma unroll
          for (int sb = 0; sb < ND; ++sb) {
              if (sb + 1 < ND) ATT_LDK((sb + 1) & 1, sb + 1);
              s0 = __builtin_amdgcn_mfma_f32_32x32x16_bf16(kf[sb & 1][0], qf[sb], s0, 0, 0, 0);
              s1 = __builtin_amdgcn_mfma_f32_32x32x16_bf16(kf[sb & 1][1], qf[sb], s1, 0, 0, 0);
              }
          }
#undef ATT_LDK
        }
        const bool msk = MASKED && a.mask_on && tt >= a.seg0_tiles;
        if (MASKED) { const int kp0 = a.kpos1 + 64 * (tt - a.seg0_tiles) + 4 * hi, qp = a.qpos0 + wid * 32 + q32;
#pragma unroll
            for (int r = 0; r < 16; ++r) { float t0 = s0[r], t1 = s1[r];
                if (msk) { const int d0 = qp - (kp0 + (r & 3) + 8 * (r >> 2)), d1 = d0 - 32; if (d0 > 128 || d0 < -128) t0 = -1e30f; if (d1 > 128 || d1 < -128) t1 = -1e30f; s0[r] = t0; s1[r] = t1; } }
            __builtin_amdgcn_sched_barrier(0); }
        float mx = -1e30f, m_new = 0.f, alpha = 1.f, ps = 0.f;
        bf16x8 pn[4] = {pa[0], pa[1], pa[2], pa[3]};
        { const ldsp_t _vt = lds + VOFF + vprev * VBUF; bf16x8 vfr[3]; vfr[2] = pa[0];
#define ATT_LDV(i) (*(const LAS bf16x8*)(_vt + ((32 * ((i) >> 2) + q32) * VST + 16 * ((i) & 3) + 8 * hi) * 2))
#define SCV(e) ((e) < 16 ? s0[(e) & 15] : s1[(e) & 15])
          vfr[0] = ATT_LDV(0); vfr[1] = ATT_LDV(1);
#pragma unroll
          for (int i = 0; i < 16; ++i) {
              if (PV_ != 3) { if (i + 2 < 16) vfr[(i + 2) % 3] = ATT_LDV(i + 2);
              o[i >> 2] = __builtin_amdgcn_mfma_f32_32x32x16_bf16(pa[i & 3], vfr[i % 3], o[i >> 2], 0, 0, 0); }
              if (PV_ == 1) {} else if (i < 4) {
#pragma unroll
                  for (int e = 0; e < 4; ++e) mx = fmaxf(mx, fmaxf(s0[4 * i + e], s1[4 * i + e]));
              } else if (i == 4) {
                  { const auto rr = __builtin_amdgcn_permlane32_swap(__float_as_uint(mx), __float_as_uint(mx), false, false);
                    mx = fmaxf(__uint_as_float(rr[0]), __uint_as_float(rr[1])); }
                  if (__all(mx - m_run <= 8.0f * LOG2E_F)) { m_new = m_run; alpha = 1.f; }
                  else { m_new = fmaxf(m_run, mx); alpha = __builtin_amdgcn_exp2f(m_run - m_new); m_run = m_new; }
              } else if (i < 13) {
#pragma unroll
                  for (int e = 0; e < 2; ++e) { const int r = 2 * (i - 5) + e; s0[r] = __builtin_amdgcn_exp2f(s0[r] - m_new); s1[r] = __builtin_amdgcn_exp2f(s1[r] - m_new); ps += s0[r] + s1[r]; }
              } else if (i == 13) {
                  u32x4 w; w.x = cvt_pk_bf16(s0[0], s0[1]); w.y = cvt_pk_bf16(s0[2], s0[3]); w.z = cvt_pk_bf16(s0[4], s0[5]); w.w = cvt_pk_bf16(s0[6], s0[7]); pn[0] = *(bf16x8*)&w;
                  u32x4 v; v.x = cvt_pk_bf16(s0[8], s0[9]); v.y = cvt_pk_bf16(s0[10], s0[11]); v.z = cvt_pk_bf16(s0[12], s0[13]); v.w = cvt_pk_bf16(s0[14], s0[15]); pn[1] = *(bf16x8*)&v;
              } else if (i == 14) {
                  u32x4 w; w.x = cvt_pk_bf16(s1[0], s1[1]); w.y = cvt_pk_bf16(s1[2], s1[3]); w.z = cvt_pk_bf16(s1[4], s1[5]); w.w = cvt_pk_bf16(s1[6], s1[7]); pn[2] = *(bf16x8*)&w;
                  u32x4 v; v.x = cvt_pk_bf16(s1[8], s1[9]); v.y = cvt_pk_bf16(s1[10], s1[11]); v.z = cvt_pk_bf16(s1[12], s1[13]); v.w = cvt_pk_bf16(s1[14], s1[15]); pn[3] = *(bf16x8*)&v;
              } else { l_run = l_run * alpha + ps; }
          }
#undef ATT_LDV
#undef SCV
        }
#pragma unroll
        for (int i = 0; i < 4; ++i) pa[i] = pn[i];
        if (__any(alpha < 1.0f)) {
            if (hi == 0) al[q32] = alpha;
            asm volatile("s_waitcnt lgkmcnt(0)" ::: "memory");
#pragma unroll
            for (int g4 = 0; g4 < 4; ++g4) { const f32x4 av = *(const LAS f32x4*)(al + 8 * g4 + 4 * hi);
#pragma unroll
                for (int db = 0; db < 4; ++db)
#pragma unroll
                    for (int j = 0; j < 4; ++j) o[db][4 * g4 + j] *= av[j]; }
        }
        if (tt + 1 < ntiles && PV_ != 4) ATT_WRITE(vnext);
        { const int t3 = vprev; vprev = vcur; vcur = vnext; vnext = t3; }
        asm volatile("s_waitcnt vmcnt(0)" ::: "memory");
        if (PV_ != 5) __syncthreads();
    }
    ATT_PV(vprev);
#undef ATT_LOAD
#undef ATT_WRITE
#undef ATT_PV
    __syncthreads();
    float l_tot; { const auto rr = __builtin_amdgcn_permlane32_swap(__float_as_uint(l_run), __float_as_uint(l_run), false, false); l_tot = __uint_as_float(rr[0]) + __uint_as_float(rr[1]); }
    if (a.has_sink) l_tot += __builtin_amdgcn_exp2f(a.sink_l2 - m_run);
    if (hi == 0) al[q32] = 1.0f / l_tot;
    asm volatile("s_waitcnt lgkmcnt(0)" ::: "memory");
    const ldsp_t Ost = lds + wid * 8192;
#pragma unroll
    for (int g4 = 0; g4 < 4; ++g4) { const f32x4 iv = *(const LAS f32x4*)(al + 8 * g4 + 4 * hi);
#pragma unroll
        for (int db = 0; db < 4; ++db)
#pragma unroll
            for (int j = 0; j < 4; ++j) *(LAS bf16_t*)(Ost + ((8 * g4 + 4 * hi + j) * 128 + 32 * db + q32) * 2) = f2bf(o[db][4 * g4 + j] * iv[j]); }
    asm volatile("s_waitcnt lgkmcnt(0)" ::: "memory");
    const int lane_o = lane_id();
#pragma unroll
    for (int i = 0; i < 8; ++i) { const int c = lane_o + 64 * i, row = c >> 4, c8 = c & 15;
        *(u32x4*)(a.O + (size_t)(wid * 32 + row) * a.ldo + 8 * c8) = *(const LAS u32x4*)(Ost + (row * 128 + 8 * c8) * 2); }
}

__device__ __forceinline__ void conv_unit(const Ctx& F, int layer, int row0  , int seq_len, int t0) {
    using namespace cf;
    const bf16_t* P = WSP(const bf16_t, WS_P); bf16_t* BR = WSP(bf16_t, WS_BR);
    const float* cw = F.in[I_CW] + (size_t)layer * 31 * 1024; const float* cb = F.in[I_CB] + layer * 1024;
    const float* lg = F.in[I_CLG] + layer * 1024; const float* lb = F.in[I_CLB] + layer * 1024;
    int tid = F.wave * 64 + lane_id(); asm volatile("" : "+v"(tid));
    const int lane = tid & 63;
    LAS float* red = (LAS float*)(F.lds + 126976); LAS float* tot = red + 8 * 32;
    __syncthreads();
    for (int c = tid; c < 62 * 128; c += 512) { const int rr = c >> 7, ch = c & 127, t = t0 - 15 + rr;
        u32x4 v = {0u, 0u, 0u, 0u};
        if (t >= 0 && t < seq_len) v = *(const u32x4*)(P + (size_t)(row0 + t) * NC + PC_GLU + ch * 8);
        *(LAS u32x4*)(F.lds + rr * 2048 + ch * 16) = v; }
    float w0[31], w1[31];
#pragma unroll
    for (int k = 0; k < 31; ++k) { const f32x2 w = *(const f32x2*)(cw + k * 1024 + 2 * tid); w0[k] = w.x; w1[k] = w.y; }
    const f32x2 bv = *(const f32x2*)(cb + 2 * tid), gg = *(const f32x2*)(lg + 2 * tid), bb = *(const f32x2*)(lb + 2 * tid);
    __syncthreads();
#pragma unroll 1
    for (int part = 0; part < 4; ++part) {
        float a0[8], a1[8];
#pragma unroll
        for (int t = 0; t < 8; ++t) { a0[t] = bv.x; a1[t] = bv.y; }
        const ldsp_t base = F.lds + part * 8 * 2048 + tid * 4;
#pragma unroll
        for (int rr = 0; rr < 38; ++rr) { const unsigned xw = *(const LAS unsigned*)(base + rr * 2048); const float x0 = bflo(xw), x1 = bfhi(xw);
#pragma unroll
            for (int t = 0; t < 8; ++t) { const int k = rr - t; if (k >= 0 && k <= 30) { a0[t] += x0 * w0[k]; a1[t] += x1 * w1[k]; } } }
        float v[16];
#pragma unroll
        for (int t = 0; t < 8; ++t) { v[t] = a0[t] + a1[t]; v[8 + t] = a0[t] * a0[t] + a1[t] * a1[t]; }
#pragma unroll
        for (int i = 0; i < 8; ++i) { const bool up = lane & 32; const float snd = up ? v[i] : v[i + 8], kp = up ? v[i + 8] : v[i]; v[i] = kp + shx(snd, 32, lane); }
#pragma unroll
        for (int i = 0; i < 4; ++i) { const bool up = lane & 16; const float snd = up ? v[i] : v[i + 4], kp = up ? v[i + 4] : v[i]; v[i] = kp + shx(snd, 16, lane); }
#pragma unroll
        for (int i = 0; i < 2; ++i) { const bool up = lane & 8; const float snd = up ? v[i] : v[i + 2], kp = up ? v[i + 2] : v[i]; v[i] = kp + shx(snd, 8, lane); }
        { const bool up = lane & 4; const float snd = up ? v[0] : v[1], kp = up ? v[1] : v[0]; v[0] = kp + shx(snd, 4, lane); }
        v[0] += shx(v[0], 2, lane); v[0] += shx(v[0], 1, lane);
        if ((lane & 3) == 0) red[F.wave * 16 + (lane >> 2)] = v[0];
        __syncthreads();
        if (tid < 16) { float s = 0.f;
#pragma unroll
            for (int w = 0; w < 8; ++w) s += red[w * 16 + tid];
            tot[tid] = s; }
        __syncthreads();
#pragma unroll
        for (int t = 0; t < 8; ++t) { const float mean = tot[t] * (1.f / 1024.f), var = fmaxf(tot[8 + t] * (1.f / 1024.f) - mean * mean, 0.f), rstd = rsqrtf(var + 1e-5f);
            const float y0 = (a0[t] - mean) * rstd * gg.x + bb.x, y1 = (a1[t] - mean) * rstd * gg.y + bb.y;
            *(unsigned*)(BR + (size_t)(row0 + t0 + part * 8 + t) * 4096 + 2048 + 2 * tid) = cvt_pk_bf16(y0 * sigmoidf_(y0), y1 * sigmoidf_(y1)); }
    }
}

__device__ __forceinline__ void attn_defaults(AttnArgs& a, int isctx) {
    a.seg0_row = 0; a.seg0_tiles = isctx ? 4 : 68; a.seg1_row = 0; a.seg1_tiles = 0; a.mask_on = 0; a.qpos0 = 0; a.kpos1 = 0; a.has_sink = 0; a.sink_l2 = 0.f; a.qss = nullptr; a.variant = 0; }
__device__ __forceinline__ void attn_unit_decode(int u, int G, bool gqa, int& b, int& h, int& qb) {
    if (G != 256) { b = u >> 7; h = (u >> 4) & 7; qb = u & 15; return; }
    const int bid = u & 255, r = u >> 8, x = bid & 7, local = (bid >> 3) + 32 * r;
    qb = local & 15;
    if (gqa) { b = x >> 1; h = (x & 1) * 4 + (local >> 4); }
    else { const int pair = x * 4 + (local >> 4); b = pair >> 3; h = pair & 7; }
}
__device__ __forceinline__ void ph_attn(const Ctx& F0, int layer) {
    const Ctx F = phase_ctx(F0);
    using namespace cf;
    const bf16_t* P = WSP(const bf16_t, WS_P); bf16_t* BR = WSP(bf16_t, WS_BR);
    for (int dup = 0; dup < DUPN(2); ++dup)
    for (int u = F.bid; u < (layer == 0 ? 544 : 512); u += F.G) {
        int b, h, qb, isctx = 0;
        if (u < 512) attn_unit_decode(u, F.G, false, b, h, qb); else { const int r = u - 512; b = r >> 3; h = r & 7; qb = 0; isctx = 1; }
        const size_t brow = (size_t)b * RB, qrow = brow + (isctx ? 0 : CTX) + (size_t)qb * 256;
        AttnArgs a; attn_defaults(a, isctx);
        a.Q = WSP(const bf16_t, WS_QB) + qrow * 1536 + h * 192; a.ldq = 1536;
        a.K = WSP(const bf16_t, WS_KB) + brow * 1536 + h * 192; a.ldk = 1536;
        a.V = WSP(const bf16_t, WS_VB) + brow * 1024 + h * 128; a.ldv = 1024;
        a.O = BR + qrow * 4096 + 1024 + h * 128; a.ldo = 4096; a.sc_log2 = SCALE_MLA * LOG2E;
        __syncthreads();
        attn_unit<192, false>(F.lds, a, F.wave);
    }
    for (int dup = 0; dup < DUPN(3); ++dup)
    for (int u0 = F.bid; u0 < (layer == 0 ? 544 : 512); u0 += F.G) {
        int b, h, qb, isctx = 0;
        if (u0 < 512) attn_unit_decode(u0, F.G, true, b, h, qb); else { const int r = u0 - 512; b = r >> 3; h = r & 7; qb = 0; isctx = 1; }
        const size_t brow = (size_t)b * RB, qrow = brow + (isctx ? 0 : CTX) + (size_t)qb * 256;
        AttnArgs a; attn_defaults(a, isctx);
        a.Q = P + qrow * NC + PC_AQ + h * 128; a.ldq = NC;
        a.K = P + brow * NC + PC_AK + (h >> 2) * 128; a.ldk = NC;
        a.V = P + brow * NC + PC_AV + (h >> 2) * 128; a.ldv = NC;
        a.O = BR + qrow * 4096 + h * 128; a.ldo = 4096; a.sc_log2 = SCALE_HD * LOG2E;
        a.qss = WSP(const float, WS_SSQ) + qrow * 16 + h * 2;
        if (MK_AV && dup == 1) { a.variant = MK_AV; a.O = WSP(bf16_t, WS_HB) + qrow * 2048 + h * 128; a.ldo = 2048; }
        __syncthreads();
        attn_unit<128, false>(F.lds, a, F.wave);
    }
    for (int dup = 0; dup < DUPN(13); ++dup)
    for (int u0 = F.bid; u0 < (layer == 0 ? 544 : 512); u0 += F.G) {
        int b, h, qb, isctx = 0;
        if (u0 < 512) attn_unit_decode(u0, F.G, true, b, h, qb); else { const int r = u0 - 512; b = r >> 3; h = r & 7; qb = 0; isctx = 1; }
        const size_t brow = (size_t)b * RB, qrow = brow + (isctx ? 0 : CTX) + (size_t)qb * 256;
        AttnArgs a; attn_defaults(a, isctx);
        a.Q = P + qrow * NC + PC_DQ + h * 128; a.ldq = NC;
        a.K = P + brow * NC + PC_DK + (h >> 2) * 128; a.ldk = NC;
        a.V = P + brow * NC + PC_DV + (h >> 2) * 128; a.ldv = NC;
        a.O = BR + qrow * 4096 + 3072 + h * 128; a.ldo = 4096; a.sc_log2 = SCALE_HD * LOG2E;
        a.has_sink = 1; a.sink_l2 = F.in[I_SINK][layer * 8 + h] * LOG2E; a.seg0_tiles = 4;
        if (!isctx) { const int start = qb * 256; const int lo = start - 128 < 0 ? 0 : start - 128, hi = start + 384 > S ? S : start + 384;
            a.seg1_row = CTX + lo; a.seg1_tiles = (hi - lo) / 64; a.mask_on = 1; a.qpos0 = start; a.kpos1 = lo; }
        __syncthreads();
        attn_unit<128, true>(F.lds, a, F.wave);
    }
    for (int dup = 0; dup < DUPN(4); ++dup)
    for (int u = F.bid; u < (layer == 0 ? 544 : 512); u += F.G) {
        int b, tb, isctx = 0;
        if (u < 512) { b = u >> 7; tb = u & 127; } else { const int r = u - 512; b = r >> 3; tb = r & 7; isctx = 1; }
        conv_unit(F, layer, b * RB + (isctx ? 0 : CTX), isctx ? CTX : S, tb * 32);
    }
}

__device__ __forceinline__ int tok_row(int layer, int tok) { return layer == 0 ? tok : (tok >> 12) * cf::RB + cf::CTX + (tok & 4095); }
__device__ __forceinline__ void ph_ln1(const Ctx& F0, int layer) {
    const Ctx F = phase_ctx(F0);
    using namespace cf;
    float* X1 = (float*)(F.ws + WS_P + X1_OFF); bf16_t* HB = WSP(bf16_t, WS_HB);
    const float* lg = F.in[I_LN1G] + layer * 2048; const float* lb = F.in[I_LN1B] + layer * 2048;
    const int ntok = layer == 0 ? MR : NB * S, lane = F.lane;
    for (int tok = F.bid * 8 + F.wave; tok < ntok; tok += F.G * 8) {
        const int R = tok_row(layer, tok), b = R / RB, j = R % RB;
        const float* mod = WSP(const float, WS_MOD) + ((size_t)layer * 5 + (j < CTX ? 4 : b)) * 12288;
        float* xp = X1 + (size_t)R * 2048;
        f32x4 v[8]; float s = 0.f;
#pragma unroll
        for (int i = 0; i < 8; ++i) { v[i] = *(const f32x4*)(xp + lane * 4 + 256 * i); s += (v[i][0] + v[i][1]) + (v[i][2] + v[i][3]); }
        const float mean = wave_sum(s, lane) * (1.f / 2048.f); float q = 0.f;
#pragma unroll
        for (int i = 0; i < 8; ++i) { const f32x4 d = v[i] - mean; q += (d[0] * d[0] + d[1] * d[1]) + (d[2] * d[2] + d[3] * d[3]); }
        const float rstd = rsqrtf(wave_sum(q, lane) * (1.f / 2048.f) + 1e-5f);
#pragma unroll
        for (int i = 0; i < 8; ++i) { const int c = lane * 4 + 256 * i;
            const f32x4 y = (v[i] - mean) * rstd * *(const f32x4*)(lg + c) + *(const f32x4*)(lb + c);
            *(f32x4*)(xp + c) = y;
            const f32x4 hp = y * (*(const f32x4*)(mod + 4 * 2048 + c) + 1.0f) + *(const f32x4*)(mod + 3 * 2048 + c);
            u32x2 w; w.x = cvt_pk_bf16(hp[0], hp[1]); w.y = cvt_pk_bf16(hp[2], hp[3]);
            *(u32x2*)(HB + (size_t)R * 2048 + c) = w; }
    }
}

typedef __bf16 bf16x2_t __attribute__((ext_vector_type(2)));
__device__ __forceinline__ unsigned ordkey(float v) { const unsigned u = __float_as_uint(v); return (u & 0x80000000u) ? ~u : (u | 0x80000000u); }
__device__ __forceinline__ int lane_rank(unsigned long long m) { return (int)__builtin_amdgcn_mbcnt_hi((unsigned)(m >> 32), __builtin_amdgcn_mbcnt_lo((unsigned)m, 0u)); }
template <int NV> __device__ __forceinline__ unsigned radix_thresh16(const unsigned (&k)[NV]) {
    unsigned T = 0u;
    for (int bit = 31; bit >= 0; --bit) { const unsigned cand = T | (1u << bit); int cnt = 0;
#pragma unroll
        for (int v = 0; v < NV; ++v) cnt += __popcll(__ballot(k[v] >= cand));
        if (cnt >= 16) { T = cand; if (cnt == 16) break; } }
    return T;
}
__device__ __forceinline__ void radix_thresh16x2(const unsigned (&ka)[2], const unsigned (&kb)[2], unsigned& Ta, unsigned& Tb) {
    unsigned T0 = 0u, T1 = 0u; bool d0 = false, d1 = false;
    for (int bit = 31; bit >= 0; --bit) { const unsigned c0 = T0 | (1u << bit), c1 = T1 | (1u << bit);
        const int n0 = __popcll(__ballot(ka[0] >= c0)) + __popcll(__ballot(ka[1] >= c0)), n1 = __popcll(__ballot(kb[0] >= c1)) + __popcll(__ballot(kb[1] >= c1));
        if (!d0 && n0 >= 16) { T0 = c0; d0 = n0 == 16; }
        if (!d1 && n1 >= 16) { T1 = c1; d1 = n1 == 16; }
        if (d0 && d1) break; }
    Ta = T0; Tb = T1;
}
__device__ __forceinline__ float dot2bf(unsigned a, unsigned b, float acc) { return __builtin_amdgcn_fdot2_f32_bf16(__builtin_bit_cast(bf16x2_t, a), __builtin_bit_cast(bf16x2_t, b), acc, false); }
__device__ __forceinline__ float dot8(const u32x4 a, const u32x4 b, float acc) {
    acc = dot2bf(a.x, b.x, acc); acc = dot2bf(a.y, b.y, acc); acc = dot2bf(a.z, b.z, acc); acc = dot2bf(a.w, b.w, acc);
    return acc;
}
__device__ __forceinline__ float gelu_as(float v) {
    const float av = fabsf(v), t = __builtin_amdgcn_rcpf(av * 0.2316418882f + 1.0f);
    float q = t * 0.5307027145f + (-0.7265760135f); q = q * t + 0.7107068705f; q = q * t + (-0.142248368f); q = q * t + 0.127414796f; q = q * t;
    const float e = __builtin_amdgcn_exp2f((v * v) * (-0.72134752044f)), m = v * (q * e);
    return v < 0.f ? m : v - m;
}
__device__ __forceinline__ void peer_load(u32x4 (&ur)[4], u32x4 (&vr)[4], unsigned (&vs)[4], float (&gq)[4], const LAS int* ei, const LAS float* eg,
                                          const unsigned char* UV, int lane, int grp) {
#pragma unroll
    for (int q = 0; q < 4; ++q) { const int id = __builtin_amdgcn_readfirstlane(ei[grp * 4 + q]); gq[q] = __uint_as_float(__builtin_amdgcn_readfirstlane(__float_as_uint(eg[grp * 4 + q])));
        const unsigned char* row = UV + (size_t)id * UV_ROW;
        ur[q] = *(const u32x4*)(row + lane * 16); vr[q] = *(const u32x4*)(row + 1024 + lane * 16); vs[q] = *(const unsigned short*)(row + 2048 + 2 * lane); }
}
__device__ __forceinline__ void peer_comp(const u32x4 (&ur)[4], const u32x4 (&vr)[4], const unsigned (&vs)[4], const float (&gq)[4], const f32x2 (&xf)[16], f32x2 (&y2)[16], int lane) {
    float d[4];
#pragma unroll
    for (int q = 0; q < 4; ++q) { f32x2 t = {0.f, 0.f};
#pragma unroll
        for (int j = 0; j < 4; ++j) { const unsigned uw = ur[q][j];
            t += __builtin_amdgcn_cvt_scalef32_pk_f32_fp4(uw, 1.0f, 0) * xf[4 * j + 0]; t += __builtin_amdgcn_cvt_scalef32_pk_f32_fp4(uw, 1.0f, 1) * xf[4 * j + 1];
            t += __builtin_amdgcn_cvt_scalef32_pk_f32_fp4(uw, 1.0f, 2) * xf[4 * j + 2]; t += __builtin_amdgcn_cvt_scalef32_pk_f32_fp4(uw, 1.0f, 3) * xf[4 * j + 3]; }
        d[q] = (t.x + t.y) * uv_scale(vs[q] & 255u); }
#pragma unroll
    for (int o = 32; o >= 1; o >>= 1) {
#pragma unroll
        for (int q = 0; q < 4; ++q) d[q] += shx(d[q], o, lane); }
#pragma unroll
    for (int q = 0; q < 4; ++q) { const float w = gq[q] * gelu_as(d[q]) * uv_scale(vs[q] >> 8);
        const f32x2 w2 = {w, w};
#pragma unroll
        for (int j = 0; j < 4; ++j) { const unsigned vw = vr[q][j];
            y2[4 * j + 0] += w2 * __builtin_amdgcn_cvt_scalef32_pk_f32_fp4(vw, 1.0f, 0); y2[4 * j + 1] += w2 * __builtin_amdgcn_cvt_scalef32_pk_f32_fp4(vw, 1.0f, 1);
            y2[4 * j + 2] += w2 * __builtin_amdgcn_cvt_scalef32_pk_f32_fp4(vw, 1.0f, 2); y2[4 * j + 3] += w2 * __builtin_amdgcn_cvt_scalef32_pk_f32_fp4(vw, 1.0f, 3); } }
}
__device__ __forceinline__ unsigned inv_ordkey(unsigned k) { return (k & 0x80000000u) ? (k & 0x7fffffffu) : ~k; }
template <int N> __device__ __forceinline__ int count_ge(const unsigned (&key)[N], unsigned cand) {
    int cnt = 0;
#pragma unroll
    for (int n = 0; n < N; n += 4) { unsigned long long m0, m1, m2, m3;
        asm("v_cmp_ge_u32_e64 %1, %5, %9\n\tv_cmp_ge_u32_e64 %2, %6, %9\n\tv_cmp_ge_u32_e64 %3, %7, %9\n\tv_cmp_ge_u32_e64 %4, %8, %9\n\t"
            "v_addc_co_u32_e64 %0, vcc, 0, %0, %1\n\tv_addc_co_u32_e64 %0, vcc, 0, %0, %2\n\tv_addc_co_u32_e64 %0, vcc, 0, %0, %3\n\tv_addc_co_u32_e64 %0, vcc, 0, %0, %4"
            : "+v"(cnt), "=&s"(m0), "=&s"(m1), "=&s"(m2), "=&s"(m3) : "v"(key[n]), "v"(key[n + 1]), "v"(key[n + 2]), "v"(key[n + 3]), "v"(cand) : "vcc"); }
    return cnt;
}
template <int B> __device__ __forceinline__ void bit_transpose32(unsigned (&A)[64]) {
#pragma unroll
    for (int k = 0; k < 16; ++k) { const unsigned a = A[B + k], b = A[B + k + 16]; A[B + k] = __builtin_amdgcn_perm(b, a, 0x05040100u); A[B + k + 16] = __builtin_amdgcn_perm(b, a, 0x07060302u); }
#pragma unroll
    for (int k = 0; k < 32; ++k) if (!(k & 8)) { const unsigned a = A[B + k], b = A[B + k + 8]; A[B + k] = __builtin_amdgcn_perm(b, a, 0x06020400u); A[B + k + 8] = __builtin_amdgcn_perm(b, a, 0x07030501u); }
#pragma unroll
    for (int k = 0; k < 32; ++k) if (!(k & 4)) { const unsigned a = A[B + k], b = A[B + k + 4]; A[B + k] = (a & 0x0F0F0F0Fu) | ((b << 4) & 0xF0F0F0F0u); A[B + k + 4] = ((a >> 4) & 0x0F0F0F0Fu) | (b & 0xF0F0F0F0u); }
#pragma unroll
    for (int k = 0; k < 32; ++k) if (!(k & 2)) { const unsigned a = A[B + k], b = A[B + k + 2]; A[B + k] = (a & 0x33333333u) | ((b << 2) & 0xCCCCCCCCu); A[B + k + 2] = ((a >> 2) & 0x33333333u) | (b & 0xCCCCCCCCu); }
#pragma unroll
    for (int k = 0; k < 32; ++k) if (!(k & 1)) { const unsigned a = A[B + k], b = A[B + k + 1]; A[B + k] = (a & 0x55555555u) | ((b << 1) & 0xAAAAAAAAu); A[B + k + 1] = ((a >> 1) & 0x55555555u) | (b & 0xAAAAAAAAu); }
}
template <int GRP> __device__ __forceinline__ unsigned lane_radix16(const unsigned (&key)[64], int lane, int& own) {
    unsigned P[64];
#pragma unroll
    for (int n = 0; n < 64; ++n) P[n] = key[n];
    bit_transpose32<0>(P); bit_transpose32<32>(P);
    unsigned T = 0u, act_lo = ~0u, act_hi = ~0u; int above = 0; bool done = false;
#pragma unroll
    for (int bit = 31; bit >= 0; --bit) {
        const unsigned m_lo = act_lo & P[bit], m_hi = act_hi & P[32 + bit];
        const int mine = above + __builtin_popcount(m_lo) + __builtin_popcount(m_hi);
        int tot = mine + __builtin_amdgcn_ds_bpermute((lane ^ 1) << 2, mine);
        if (GRP >= 4) tot += __builtin_amdgcn_ds_bpermute((lane ^ 2) << 2, tot);
        const bool ge = tot >= 16;
        if (ge && !done) T |= 1u << bit;
        act_lo = ge ? m_lo : act_lo & ~m_lo; act_hi = ge ? m_hi : act_hi & ~m_hi;
        above = ge ? above : mine;
        if (tot == 16) { above = mine; act_lo = 0u; act_hi = 0u; done = true; }
        if (__all(done)) break; }
    own = above + __builtin_popcount(act_lo) + __builtin_popcount(act_hi);
    return T;
}
template <int N> __device__ __forceinline__ void compact_ge(const unsigned (&key)[N], unsigned T, int pos, unsigned base, unsigned dump) {
#pragma unroll
    for (int n = 0; n < N; n += 2) { unsigned long long m0, m1; unsigned a0, a1;
        asm("v_cmp_ge_u32_e64 %3, %5, %7\n\tv_cmp_ge_u32_e64 %4, %6, %7\n\tv_lshl_add_u32 %1, %0, 2, %8\n\tv_cndmask_b32_e64 %1, %9, %1, %3\n\tv_addc_co_u32_e64 %0, vcc, 0, %0, %3\n\t"
            "v_lshl_add_u32 %2, %0, 2, %8\n\tv_cndmask_b32_e64 %2, %9, %2, %4\n\tv_addc_co_u32_e64 %0, vcc, 0, %0, %4"
            : "+v"(pos), "=&v"(a0), "=&v"(a1), "=&s"(m0), "=&s"(m1) : "v"(key[n]), "v"(key[n + 1]), "v"(T), "v"(base), "v"(dump) : "vcc");
        *(LAS unsigned*)(size_t)a0 = key[n]; *(LAS unsigned*)(size_t)a1 = key[n + 1]; }
}
template <int MODE> __device__ __forceinline__ void ph_peer(const Ctx& F0, int layer) {
    const Ctx F = phase_ctx(F0);
    using namespace cf;
    const float* SC = (const float*)(F.ws + WS_P + SC_OFF); const float* X1 = (const float*)(F.ws + WS_P + X1_OFF);
    bf16_t* HB = WSP(bf16_t, WS_HB); const unsigned char* UV = WSP(const unsigned char, WS_UB) + (size_t)layer * NEXP * UV_ROW;
    const float* lg = F.in[I_LN2G] + layer * 2048; const float* lb = F.in[I_LN2B] + layer * 2048;
    const int ntok = layer == 0 ? MR : NB * S;
    constexpr int NSLOT = 34;
    ldsp_t ring = F.lds;
#ifndef NPROD
#define NPROD 1
#endif
    const int pw = F.wave - (8 - NPROD);
    ldsp_t pscr = F.lds + 73728 + (pw < 0 ? 0 : pw) * 6144;
    LAS unsigned* lstA = (LAS unsigned*)(pscr);
    LAS unsigned* lstB = (LAS unsigned*)(pscr + 2176);
    LAS unsigned* dmp = (LAS unsigned*)(pscr + 3200);
    volatile LAS unsigned* ready = (volatile LAS unsigned*)(F.lds + 71680); LAS unsigned* next_tok = (LAS unsigned*)(F.lds + 71680 + NSLOT * 4);
    __syncthreads();
    if (F.tid < NSLOT + 1) ((LAS unsigned*)(F.lds + 71680))[F.tid] = 0u;
    __syncthreads();
    const int ntw = ntok / F.G;
    if (pw >= 0) {
      for (int p = pw; p < ntw / 2; p += NPROD) {
        const int slot = p;
        LAS int* ei4 = (LAS int*)(ring + slot * 2048); LAS float* eg4 = (LAS float*)(ring + slot * 2048 + 512);
        const int tok0 = F.bid + (2 * p) * F.G, nwv = F.G;
        if (MODE != 2) {
        { int lane = F.lane; asm volatile("" : "+v"(lane));
          const int t2 = lane >> 5, set = lane >> 1, sset = set & 15, part = lane & 1;
          const int Rl = tok_row(layer, tok0 + t2 * nwv);
          unsigned key[64];
          const float* sp = SC + (size_t)Rl * 2048 + sset * 128 + part * 64;
#pragma unroll
          for (int i = 0; i < 16; ++i) { const f32x4 v = *(const f32x4*)(sp + 4 * i);
#pragma unroll
              for (int e = 0; e < 4; ++e) key[4 * i + e] = (ordkey(v[e]) & ~127u) | (unsigned)(127 - (64 * part + 4 * i + e)); }
          int own; const unsigned T = lane_radix16<2>(key, lane, own);
          const int oth = __builtin_amdgcn_ds_bpermute((lane ^ 1) << 2, own);
          compact_ge<64>(key, T, part ? oth : 0, (unsigned)(size_t)lstA + set * 68, (unsigned)(size_t)dmp + lane * 4);
        }
        asm volatile("s_waitcnt lgkmcnt(0)" ::: "memory");
        {
          int lane = F.lane; asm volatile("" : "+v"(lane));
          const int q = lane & 3, sa = (lane >> 2) * 2, sb = sa + 1;
          float Av[4], Bv[16];
#pragma unroll
          for (int i = 0; i < 4; ++i) Av[i] = __uint_as_float(inv_ordkey((lstA[sa * 17 + 4 * q + i] & ~127u) | 64u));
#pragma unroll
          for (int jx = 0; jx < 16; ++jx) Bv[jx] = __uint_as_float(inv_ordkey((lstA[sb * 17 + jx] & ~127u) | 64u));
          unsigned key[64];
#pragma unroll
          for (int i = 0; i < 4; ++i)
#pragma unroll
              for (int jx = 0; jx < 16; ++jx) key[i * 16 + jx] = (ordkey(Av[i] + Bv[jx]) & ~255u) | (unsigned)(255 - ((4 * q + i) * 16 + jx));
          int mine; const unsigned T = lane_radix16<4>(key, lane, mine);
          const int c1 = __builtin_amdgcn_ds_bpermute((lane ^ 1) << 2, mine), c2 = __builtin_amdgcn_ds_bpermute((lane ^ 2) << 2, mine), c3 = __builtin_amdgcn_ds_bpermute((lane ^ 3) << 2, mine);
          const int c = (q == 1) ? c1 : (q == 2) ? c2 + c3 : (q == 3) ? c1 + c2 + c3 : 0;
          compact_ge<64>(key, T, c, (unsigned)(size_t)lstB + (lane >> 2) * 64, (unsigned)(size_t)dmp + lane * 4);
        }
        asm volatile("s_waitcnt lgkmcnt(0)" ::: "memory");
        { int lane = F.lane; asm volatile("" : "+v"(lane));
#pragma unroll
        for (int rnd = 0; rnd < 4; ++rnd) { const int e = lane + 64 * rnd; const unsigned kk = lstB[e];
            const int cidx = (int)(~kk & 255u), sa = (e >> 4) * 2;
            const unsigned ka = lstA[sa * 17 + (cidx >> 4)], kb = lstA[(sa + 1) * 17 + (cidx & 15)];
            const float sv = __uint_as_float(inv_ordkey((ka & ~127u) | 64u)) + __uint_as_float(inv_ordkey((kb & ~127u) | 64u));
            float m = sv; m = fmaxf(m, shx(m, 1, lane)); m = fmaxf(m, shx(m, 2, lane)); m = fmaxf(m, shx(m, 4, lane)); m = fmaxf(m, shx(m, 8, lane));
            const float ex = __expf(sv - m); float sum = ex; sum += shx(sum, 1, lane); sum += shx(sum, 2, lane); sum += shx(sum, 4, lane); sum += shx(sum, 8, lane);
            ei4[(e >> 7) * 256 + (e & 127)] = (int)((~ka & 127u) * 128u + (~kb & 127u));
            eg4[(e >> 7) * 256 + (e & 127)] = ex / sum; } }
        }
        asm volatile("s_waitcnt lgkmcnt(0)" ::: "memory");
        if (F.lane == 0) ready[slot] = (unsigned)(p + 1);
      }
    }
    {
      for (;;) {
        unsigned tq = 0u; if (F.lane == 0) tq = __hip_atomic_fetch_add(next_tok, 1u, __ATOMIC_RELAXED, __HIP_MEMORY_SCOPE_WORKGROUP);
        const int t = __builtin_amdgcn_readfirstlane((int)tq);
        if (t >= ntw) break;
        const int p = t >> 1, slot = p, tslot = t & 1;
        while (ready[slot] < (unsigned)(p + 1)) __builtin_amdgcn_s_sleep(2);
        asm volatile("" ::: "memory");
        if (MODE == 1) continue;
        int zst = 0; if (MODE == 2) asm volatile("" : "+s"(zst));
        const int tok = F.bid + t * F.G;
        int lane = F.lane; asm volatile("" : "+v"(lane));
        const int R = tok_row(layer, tok), b = R / RB, j = R % RB; const bool isctx = j < CTX; const int modrow = isctx ? 4 : b;
        const LAS int* ei = (const LAS int*)(ring + slot * 2048 + tslot * 1024); const LAS float* eg = (const LAS float*)(ring + slot * 2048 + tslot * 1024 + 512);
        f32x2 xf[16];
#pragma unroll
        for (int k = 0; k < 4; ++k) { const u32x4 w = *(const u32x4*)(HB + (size_t)R * 2048 + lane * 32 + 8 * k);
            xf[4 * k + 0] = (f32x2){bflo(w.x), bfhi(w.x)}; xf[4 * k + 1] = (f32x2){bflo(w.y), bfhi(w.y)};
            xf[4 * k + 2] = (f32x2){bflo(w.z), bfhi(w.z)}; xf[4 * k + 3] = (f32x2){bflo(w.w), bfhi(w.w)}; }
        f32x2 y2[16];
#pragma unroll
        for (int i = 0; i < 16; ++i) y2[i] = (f32x2){0.f, 0.f};
        f32x4 xrow[8];
#pragma unroll
        for (int k = 0; k < 8; ++k) xrow[k] = *(const f32x4*)(X1 + (size_t)R * 2048 + lane * 32 + 4 * k);
        { u32x4 urA[4], vrA[4], urB[4], vrB[4]; unsigned vsA[4], vsB[4]; float gqA[4], gqB[4];
          peer_load(urA, vrA, vsA, gqA, ei, eg, UV, lane, 0);
          for (int grp = 0; grp < 32; grp += 2) {
              peer_load(urB, vrB, vsB, gqB, ei, eg, UV, lane, grp + 1);
              peer_comp(urA, vrA, vsA, gqA, xf, y2, lane);
              peer_load(urA, vrA, vsA, gqA, ei, eg, UV, lane, grp + 2 < 32 ? grp + 2 : 31);
              peer_comp(urB, vrB, vsB, gqB, xf, y2, lane);
          } }
        const float* mod = WSP(const float, WS_MOD) + ((size_t)layer * 5 + modrow) * 12288;
        float y[32];
        float s = 0.f;
#pragma unroll
        for (int k = 0; k < 8; ++k) { const int c = lane * 32 + 4 * k;
            const f32x4 xa = xrow[k], ga = *(const f32x4*)(mod + 5 * 2048 + c);
            y[4 * k + 0] = ALPHA * xa[0] + ga[0] * y2[2 * k].x; y[4 * k + 1] = ALPHA * xa[1] + ga[1] * y2[2 * k].y;
            y[4 * k + 2] = ALPHA * xa[2] + ga[2] * y2[2 * k + 1].x; y[4 * k + 3] = ALPHA * xa[3] + ga[3] * y2[2 * k + 1].y;
            s += (y[4 * k + 0] + y[4 * k + 1]) + (y[4 * k + 2] + y[4 * k + 3]); }
        const float mean = wave_sum(s, lane) * (1.f / 2048.f); float q2 = 0.f;
#pragma unroll
        for (int i = 0; i < 32; ++i) { const float dd = y[i] - mean; q2 += dd * dd; }
        const float rstd = rsqrtf(wave_sum(q2, lane) * (1.f / 2048.f) + 1e-5f);
        if (MODE == 2 && zst == 0) continue;
        float* dst = layer == 0 ? (isctx ? WSP(float, WS_XC) + ((size_t)b * CTX + j) * 2048 : F.out + ((size_t)b * S + (j - CTX)) * 2048) : F.out + ((size_t)b * S + (j - CTX)) * 2048;
        const float* modn = WSP(const float, WS_MOD) + ((size_t)1 * 5 + modrow) * 12288;
#pragma unroll
        for (int kk = 0; kk < 4; ++kk) { f32x4 o[2];
#pragma unroll
            for (int jj = 0; jj < 2; ++jj) { const int k = 2 * kk + jj, c = lane * 32 + 4 * k; const f32x4 la = *(const f32x4*)(lg + c), ba = *(const f32x4*)(lb + c);
#pragma unroll
                for (int e = 0; e < 4; ++e) o[jj][e] = (y[4 * k + e] - mean) * rstd * la[e] + ba[e];
                *(f32x4*)(dst + c) = o[jj]; }
            if (layer == 0) {
                const int c = lane * 32 + 8 * kk;
                const f32x4 sa = *(const f32x4*)(modn + 2048 + c), sb = *(const f32x4*)(modn + 2048 + c + 4), ha = *(const f32x4*)(modn + c), hb = *(const f32x4*)(modn + c + 4);
                *(u32x4*)(HB + (size_t)R * 2048 + c) = pg8::pack8(o[0] * (sa + 1.0f) + ha, o[1] * (sb + 1.0f) + hb); } }
      }
    }
}

struct Params { const float* in[cf::N_IN]; float* out; unsigned char* ws; int ph_lo, ph_hi; };

__global__ void __launch_bounds__(512, 2) mega_fwd(Params p) {
    using namespace cf;
    extern __shared__ __attribute__((aligned(16))) unsigned char smem[];
    Ctx F0;
    F0.in = p.in;
    F0.out = p.out; F0.ws = p.ws; F0.lds = (ldsp_t)smem;
    F0.tid = 0; F0.lane = 0; F0.wave = __builtin_amdgcn_readfirstlane(threadIdx.x >> 6); F0.G = gridDim.x; F0.bid = blockIdx.x;
    if (threadIdx.x < 64) ((LAS unsigned*)(F0.lds + MISC_OFF))[threadIdx.x] = 0u;
    __syncthreads();
    const int lo = p.ph_lo, hi = p.ph_hi;
    XcdBarrier bar; bar.bar = (unsigned*)(F0.ws + WS_CTL); bar.x = 0; bar.st = (volatile LAS unsigned*)(F0.lds + MISC_OFF); bar.wave = F0.wave;
    if (hi - lo > 1) bar = xcd_barrier_post((unsigned*)(F0.ws + WS_CTL), (volatile LAS unsigned*)(F0.lds + MISC_OFF), F0.wave);
#ifndef MK_MASK
#define MK_MASK 0xFFFF
#endif
#define ON(j) ((MK_MASK >> (j)) & 1)
#define IN(k) (lo <= (k) && (k) < hi)
#define SEAM(k) do { if (IN(k) && IN((k) + 1)) xcd_barrier(bar); } while (0)

    if (ON(9) && IN(0)) { ph_prologue(F0); if (DUPN(9) == 2) { __syncthreads(); ph_prologue(F0); } }
    SEAM(0);
    if (ON(10) && IN(1)) ph_modulate0(F0);
    SEAM(1);
    for (int l = 0; l < DEPTH; ++l) {
        const int pb = 2 + 8 * l;
        const int rmode = l == 0 ? 0 : 1, nMl = l == 0 ? 68 : 64;
        for (int blk = 0; blk < DUPN(12); ++blk) {
        if (blk) xcd_barrier(bar);
        if (ON(0) && IN(pb + 0)) { const Ctx F = phase_ctx(F0);
            pg8::Gemm g{WSP(const bf16_t, WS_HB), WSP(const bf16_t, WS_WIN) + (size_t)l * NC * 2048, 2048, 2048};
            pg8::EpiInProj E{WSP(bf16_t, WS_P), WSP(bf16_t, WS_KB), WSP(const float, WS_COSH), WSP(const float, WS_SINH), WSP(const float, WS_COSR), WSP(const float, WS_SINR),
                             F.in[I_AKN] + l * 128, F.in[I_AQN] + l * 128, WSP(float, WS_SSK), WSP(float, WS_SSQ), WSP(float, WS_SSKV), WSP(float, WS_SSCQ)};
            pg8::TileOrder S; S.init(nMl, 56, F.G, F.bid, rmode);
            for (int dup = 0; dup < DUPN(0); ++dup)
            pg8::gemm_phase(F.lds, g, S, E, F.wave);
            if (l > 0) { pg8::TileOrder S2; S2.init(4, 6, F.G, F.bid, 2); pg8::gemm_phase(F.lds, g, S2, E, F.wave); }
        }
        SEAM(pb + 0);
        if (ON(2) && IN(pb + 1)) { const Ctx F = phase_ctx(F0); bf16_t* P = WSP(bf16_t, WS_P);
            knorm_pass(F);
            { pg8::Gemm g{P + PC_CKV, WSP(const bf16_t, WS_WKVUP) + (size_t)l * 2048 * 256, NC, 256}; pg8::EpiKvUp E{WSP(bf16_t, WS_KB), WSP(bf16_t, WS_VB), WSP(const float, WS_SSKV)};
              pg8::TileOrder S; S.init(68, 8, F.G, F.bid, 0); for (int dup = 0; dup < DUPN(1); ++dup) pg8::gemm_phase(F.lds, g, S, E, F.wave); }
            { pg8::Gemm g{P + PC_CQ, WSP(const bf16_t, WS_WQUP) + (size_t)l * 1536 * 512, NC, 512}; pg8::EpiQUp E{WSP(bf16_t, WS_QB), WSP(const float, WS_COSR), WSP(const float, WS_SINR), WSP(const float, WS_SSCQ)};
              pg8::TileOrder S; S.init(nMl, 6, F.G, F.bid, rmode); for (int dup = 0; dup < DUPN(1); ++dup) pg8::gemm_phase(F.lds, g, S, E, F.wave); }
        }
        SEAM(pb + 1);
        if (ON(3) && IN(pb + 2)) ph_attn(F0, l);
        }
        SEAM(pb + 2);
        if (ON(4) && IN(pb + 3)) { const Ctx F = phase_ctx(F0); bf16_t* P = WSP(bf16_t, WS_P); bf16_t* HB = WSP(bf16_t, WS_HB);
            pg8::Gemm g{WSP(const bf16_t, WS_BR), WSP(const bf16_t, WS_WBR) + (size_t)l * 4 * 2048 * 1024, 4096, 1024};
            pg8::EpiMerge E{HB, P + PC_GATE, NC};
            pg8::TileOrder S; S.init(nMl, 8, F.G, F.bid, rmode, 4, (size_t)1024 * 2, (size_t)2048 * 1024 * 2);
            for (int dup = 0; dup < DUPN(5); ++dup) pg8::gemm_phase(F.lds, g, S, E, F.wave);
        }
        SEAM(pb + 3);
        if (ON(5) && IN(pb + 4)) { const Ctx F = phase_ctx(F0); bf16_t* HB = WSP(bf16_t, WS_HB);
            pg8::Gemm g{HB, WSP(const bf16_t, WS_WO) + (size_t)l * 2048 * 2048, 2048, 2048};
            pg8::EpiWo E{(float*)(F.ws + WS_P + X1_OFF), WSP(const float, WS_MOD) + (size_t)l * 5 * 12288, l == 0 ? F.in[I_X] : (const float*)F.out, F.in[I_CTX]};
            pg8::TileOrder S; S.init(nMl, 8, F.G, F.bid, rmode); for (int dup = 0; dup < DUPN(6); ++dup) pg8::gemm_phase(F.lds, g, S, E, F.wave);
        }
        SEAM(pb + 4);
        if (ON(6) && IN(pb + 5)) ph_ln1(F0, l);
        SEAM(pb + 5);
        if (ON(7) && IN(pb + 6)) { const Ctx F = phase_ctx(F0); bf16_t* HB = WSP(bf16_t, WS_HB);
            pg8::Gemm g{HB, WSP(const bf16_t, WS_WFOLD) + (size_t)l * 2048 * 2048, 2048, 2048}; pg8::EpiF32 E{(float*)(F.ws + WS_P + SC_OFF), 2048};
            pg8::TileOrder S; S.init(nMl, 8, F.G, F.bid, rmode); for (int dup = 0; dup < DUPN(7); ++dup) pg8::gemm_phase(F.lds, g, S, E, F.wave);
        }
        SEAM(pb + 6);
        if (ON(8) && IN(pb + 7)) { ph_peer<0>(F0, l); if (DUPN(8) == 2 && l == 1) ph_peer<MK_PV>(F0, l); }
        SEAM(pb + 7);
    }
#undef IN
#undef SEAM
}

extern "C" void kernel_launch(void* const* d_in, const int* in_sizes, int n_in, void* d_out, int out_size, void* d_ws, size_t ws_size, hipStream_t stream) {
    static int grid = 0;
    if (grid == 0) {
        if (n_in != cf::N_IN || out_size != cf::NB * cf::S * cf::D || ws_size < cf::WS_END) {
            fprintf(stderr, "kernel_launch: unexpected shapes: n_in %d out %d ws %zu (need %zu)\n", n_in, out_size, ws_size, (size_t)cf::WS_END); grid = -1; return; }
        int dev = 0, cus = 0;
        if (hipGetDevice(&dev) != hipSuccess || hipDeviceGetAttribute(&cus, hipDeviceAttributeMultiprocessorCount, dev) != hipSuccess || cus < 1) { grid = -1; return; }
        if (hipFuncSetAttribute((const void*)mega_fwd, hipFuncAttributeMaxDynamicSharedMemorySize, cf::LDS_BYTES) != hipSuccess) { fprintf(stderr, "kernel_launch: hipFuncSetAttribute failed\n"); grid = -1; return; }
        int per_cu = 0;
        if (hipOccupancyMaxActiveBlocksPerMultiprocessor(&per_cu, (const void*)mega_fwd, 512, cf::LDS_BYTES) != hipSuccess || per_cu < 1)
            fprintf(stderr, "kernel_launch: note: occupancy query reports %d workgroups per CU\n", per_cu);
        (void)hipGetLastError();
        grid = cus;
    }
    if (grid < 0) return;
    (void)hipMemsetAsync((char*)d_ws + cf::WS_CTL, 0, cf::CTL_BYTES, stream);
    Params p{};
    for (int i = 0; i < cf::N_IN; ++i) p.in[i] = (const float*)d_in[i];
    p.out = (float*)d_out; p.ws = (unsigned char*)d_ws;
#if MK_PER_PHASE
    for (int k = 0; k < cf::N_PHASES; ++k) { p.ph_lo = k; p.ph_hi = k + 1; hipLaunchKernelGGL(mega_fwd, dim3(grid), dim3(512), cf::LDS_BYTES, stream, p); }
#else
    p.ph_lo = 0; p.ph_hi = cf::N_PHASES;
    hipLaunchKernelGGL(mega_fwd, dim3(grid), dim3(512), cf::LDS_BYTES, stream, p);
#endif
    const hipError_t le = hipPeekAtLastError();
    if (le != hipSuccess) fprintf(stderr, "kernel_launch: launch failed: %s\n", hipGetErrorName(le));
}
```

```cpp
#include <hip/hip_runtime.h>
#include <stdint.h>
#include <stdio.h>

#ifndef MK_DUP
#define MK_DUP 0
#endif
#define DUPN(k) (((MK_DUP >> (k)) & 1) ? 2 : 1)
#ifndef MK_PV
#define MK_PV 0
#endif
#ifndef MK_AV
#define MK_AV 0
#endif
#ifndef MK_PER_PHASE
#define MK_PER_PHASE 0
#endif

namespace cf {
constexpr int D = 2048, NB = 4, S = 4096, CTX = 256, RB = CTX + S  , MR = NB * RB  ;
constexpr int DEPTH = 2;
constexpr int PC_AK = 0, PC_AV = 256, PC_CKV = 512, PC_KR = 768, PC_DK = 1024, PC_DV = 1280, PC_KVEND = 1536;
constexpr int PC_AQ = 1536, PC_CQ = 2560, PC_DQ = 3072, PC_GLU = 4096, PC_GATE = 6144, NC = 14336;
constexpr int IN_COLS = 14144;
constexpr int NEXP = 16384;
constexpr float ALPHA = 1.4142135623730951f;
constexpr float LOG2E = 1.4426950408889634f;
constexpr float SCALE_HD = 0.08838834764831845f;
constexpr float SCALE_MLA = 0.07216878364870323f;
enum { I_X = 0, I_C, I_CTX, I_CCTX, I_WADA, I_BADA, I_WIN, I_AQN, I_AKN, I_BQN, I_WQUP, I_BKVN, I_WKVUP, I_CW, I_CB, I_CLG, I_CLB, I_SINK,
       I_WBRA, I_WBRB, I_WBRC, I_WBRD, I_WO, I_LN1G, I_LN1B, I_LN2G, I_LN2B, I_PWQ, I_PSK, I_PU, I_PV, N_IN };
constexpr size_t al(size_t x) { return (x + 255) / 256 * 256; }
constexpr size_t WS_CTL = 0;
constexpr size_t CTL_BYTES = 65536;
constexpr size_t WS_MOD = WS_CTL + CTL_BYTES;
constexpr size_t WS_COSH = WS_MOD + al((size_t)2 * 5 * 12288 * 4);
constexpr size_t WS_SINH = WS_COSH + (size_t)4096 * 64 * 4;
constexpr size_t WS_COSR = WS_SINH + (size_t)4096 * 64 * 4;
constexpr size_t WS_SINR = WS_COSR + (size_t)4096 * 32 * 4;
constexpr size_t WS_WIN = WS_SINR + (size_t)4096 * 32 * 4;
constexpr size_t WS_WQUP = WS_WIN + (size_t)2 * NC * 2048 * 2;
constexpr size_t WS_WKVUP = WS_WQUP + (size_t)2 * 1536 * 512 * 2;
constexpr size_t WS_WBR = WS_WKVUP + (size_t)2 * 2048 * 256 * 2;
constexpr size_t WS_WO = WS_WBR + (size_t)2 * 4 * 2048 * 1024 * 2;
constexpr size_t WS_WFOLD = WS_WO + (size_t)2 * 2048 * 2048 * 2;
constexpr size_t WS_UB = WS_WFOLD + (size_t)2 * 2048 * 2048 * 2;
constexpr size_t WS_VB2 = WS_UB + (size_t)2 * NEXP * 2048;
constexpr size_t WS_HB = WS_VB2 + (size_t)2 * NEXP * 2048;
constexpr size_t WS_P = WS_HB + (size_t)MR * 2048 * 2;
constexpr size_t WS_QB = WS_P + (size_t)MR * NC * 2;
constexpr size_t WS_KB = WS_QB + (size_t)MR * 1536 * 2;
constexpr size_t WS_VB = WS_KB + (size_t)MR * 1536 * 2;
constexpr size_t WS_BR = WS_VB + (size_t)MR * 1024 * 2;
constexpr size_t WS_XC = WS_BR + (size_t)MR * 4096 * 2;
constexpr size_t WS_SSK = WS_XC + (size_t)1024 * 2048 * 4;
constexpr size_t WS_SSQ = WS_SSK + (size_t)MR * 4 * 4;
constexpr size_t WS_SSKV = WS_SSQ + (size_t)MR * 16 * 4;
constexpr size_t WS_SSCQ = WS_SSKV + (size_t)MR * 4 * 4;
constexpr size_t WS_END = WS_SSCQ + (size_t)MR * 8 * 4;
constexpr size_t X1_OFF = 0, SC_OFF = (size_t)MR * 2048 * 4;
static_assert(SC_OFF * 2 <= (size_t)MR * NC * 2, "X1 + SC fit in P");
constexpr int LDS_BYTES = 132 * 1024;
constexpr int MISC_OFF = 128 * 1024;
constexpr int N_PHASES = 2 + 8 * DEPTH;
}

typedef unsigned short bf16_t;
typedef short bf16x8 __attribute__((ext_vector_type(8)));
typedef float f32x4 __attribute__((ext_vector_type(4)));
typedef float f32x2 __attribute__((ext_vector_type(2)));
typedef unsigned u32x4 __attribute__((ext_vector_type(4)));
typedef unsigned u32x2 __attribute__((ext_vector_type(2)));
#define LAS __attribute__((address_space(3)))
typedef LAS unsigned char* ldsp_t;

typedef __bf16 bf16x2v_t __attribute__((ext_vector_type(2)));
__device__ __forceinline__ unsigned cvt_pk_bf16(float lo, float hi) { const bf16x2v_t r = __builtin_convertvector((f32x2){lo, hi}, bf16x2v_t); return __builtin_bit_cast(unsigned, r); }
__device__ __forceinline__ bf16_t f2bf(float f) { return (bf16_t)(cvt_pk_bf16(f, 0.f) & 0xffffu); }
__device__ __forceinline__ float bf2f(bf16_t b) { return __uint_as_float(((unsigned)b) << 16); }
__device__ __forceinline__ float bflo(unsigned w) { return __uint_as_float(w << 16); }
__device__ __forceinline__ float bfhi(unsigned w) { return __uint_as_float(w & 0xffff0000u); }
__device__ __forceinline__ float shx(float v, int mask, int lane) { return __int_as_float(__builtin_amdgcn_ds_bpermute((lane ^ mask) << 2, __float_as_int(v))); }
__device__ __forceinline__ float wave_sum(float v, int lane) {
#pragma unroll
    for (int o = 32; o >= 1; o >>= 1) v += shx(v, o, lane);
    return v;
}
__device__ __forceinline__ int lane_id() { int l; asm volatile("v_mbcnt_lo_u32_b32 %0, -1, 0\n\tv_mbcnt_hi_u32_b32 %0, -1, %0" : "=v"(l)); return l; }
__device__ __forceinline__ float sigmoidf_(float x) { return __builtin_amdgcn_rcpf(1.0f + __builtin_amdgcn_exp2f(x * -1.4426950408889634f)); }

#define XB_TMO      128
#define XB_XCNT(j)  (256  + 64 * (j))
#define XB_XSUB(j)  (1280 + 64 * (j))
#define XB_XGEN(j)  (2304 + 64 * (j))
#define XB_TOP      3328
#define XB_TOPGEN   3392
#define XCD_BAR_WORDS 3456
#define XB_SPIN_CAP (1u << 23)
__device__ __forceinline__ unsigned xb_ld(unsigned* p)              { return __hip_atomic_load(p, __ATOMIC_RELAXED, __HIP_MEMORY_SCOPE_AGENT); }
__device__ __forceinline__ unsigned xb_add(unsigned* p, unsigned v) { return __hip_atomic_fetch_add(p, v, __ATOMIC_RELAXED, __HIP_MEMORY_SCOPE_AGENT); }
__device__ __forceinline__ unsigned xb_xcc_id() { return (unsigned)__builtin_amdgcn_s_getreg((3 << 11) | 20) & 0xFu; }
#define XB_SPIN(cond, bar) do { unsigned _sp = 0; while (cond) { __builtin_amdgcn_s_sleep(1); \
    if ((++_sp & 255u) == 0u) { if (xb_ld(&(bar)[XB_TMO])) break; if (_sp > XB_SPIN_CAP) { atomicAdd(&(bar)[XB_TMO], 1u); break; } } } } while (0)
struct XcdBarrier { unsigned* bar; unsigned x; volatile LAS unsigned* st; int wave; };
__device__ __forceinline__ XcdBarrier xcd_barrier_post(unsigned* bar, volatile LAS unsigned* st, int wave) {
    XcdBarrier b; b.bar = bar; b.x = xb_xcc_id(); b.st = st; b.wave = wave;
    if (wave == 0 && lane_id() == 0) (void)xb_add(&bar[XB_XCNT(b.x)], 1u);
    return b;
}
__device__ __forceinline__ void xcd_barrier_complete(unsigned* bar, unsigned x, unsigned& nloc, unsigned& nx) {
    const unsigned G = gridDim.x * gridDim.y * gridDim.z;
    unsigned sum, cnt, mine, sp = 0u;
    for (;;) {
        sum = 0u; cnt = 0u; mine = 0u;
#pragma unroll
        for (unsigned j = 0; j < 16; ++j) { const unsigned c = xb_ld(&bar[XB_XCNT(j)]); sum += c; cnt += (c > 0u) ? 1u : 0u; mine = (j == x) ? c : mine; }
        if (sum == G) break;
        __builtin_amdgcn_s_sleep(1);
        if ((++sp & 255u) == 0u) { if (xb_ld(&bar[XB_TMO])) break; if (sp > XB_SPIN_CAP) { atomicAdd(&bar[XB_TMO], 1u); break; } }
    }
    nloc = mine > 0u ? mine : 1u; nx = cnt > 0u ? cnt : 1u;
}
__device__ __forceinline__ void xcd_barrier(const XcdBarrier& b) {
    asm volatile("s_waitcnt vmcnt(0)" ::: "memory");
    __syncthreads();
    if (b.wave == 0 && lane_id() == 0) {
        unsigned* bar = b.bar;
        __builtin_amdgcn_s_waitcnt(0);
        unsigned nloc = b.st[0], nx = b.st[1];
        if (nloc == 0u) { xcd_barrier_complete(bar, b.x, nloc, nx); b.st[0] = nloc; b.st[1] = nx; }
        const unsigned old = xb_add(&bar[XB_XSUB(b.x)], 1u);
        const unsigned gen = old / nloc;
        if (old + 1u == (gen + 1u) * nloc) {
            __builtin_amdgcn_fence(__ATOMIC_RELEASE, "agent");
            asm volatile("s_waitcnt vmcnt(0)" ::: "memory");
            const unsigned og = xb_add(&bar[XB_TOP], 1u);
            const unsigned tg = og / nx;
            if (og + 1u == (tg + 1u) * nx) xb_add(&bar[XB_TOPGEN], 1u);
            else XB_SPIN(xb_ld(&bar[XB_TOPGEN]) == tg, bar);
            __builtin_amdgcn_fence(__ATOMIC_ACQUIRE, "agent");
            xb_add(&bar[XB_XGEN(b.x)], 1u);
            asm volatile("s_waitcnt vmcnt(0)" ::: "memory");
        } else {
            XB_SPIN(xb_ld(&bar[XB_XGEN(b.x)]) == gen, bar);
            __builtin_amdgcn_fence(__ATOMIC_ACQUIRE, "agent");
            asm volatile("s_waitcnt vmcnt(0)" ::: "memory");
        }
    }
    __syncthreads();
}

namespace pg8 {
constexpr int BM = 256, BK = 64, HALF = 128, HTB = HALF * BK * 2, STAGE_BYTES = 8 * HTB, NXCD = 8, WGM = 8;
__host__ __device__ __forceinline__ int lds_byte(int r, int c) { const int st = (r >> 4) * 2 + (c >> 5), rr = r & 15, cc = c & 31, ob = rr * 64 + cc * 2; return st * 1024 + (ob ^ (((ob >> 9) & 1) << 5)); }
__host__ __device__ __forceinline__ void stage_rc(int b, int& R, int& C) { const int st = b / 1024, sb = b % 1024, swz = sb ^ (((sb >> 9) & 1) << 5); R = (st >> 1) * 16 + swz / 64; C = (st & 1) * 32 + (swz % 64) / 2; }
__host__ __device__ __forceinline__ int perm32(int rho) { const int n = rho >> 4, i = rho & 15; return 8 * (i >> 2) + 4 * n + (i & 3); }
struct Unit { int pm, pn, sub; };
struct Gemm { const bf16_t* A; const bf16_t* Bt; int lda, K, ldb = 0; };

struct TileOrder {
    int nM, nN, nwg, G, c, mode, nsub; size_t subA, subB;
    __device__ void init(int nM_, int nN_, int G_, int c_, int mode_, int nsub_ = 1, size_t subA_ = 0, size_t subB_ = 0) { nM = nM_; nN = nN_; nwg = nM * nN; G = G_; c = c_; mode = mode_; nsub = nsub_; subA = subA_; subB = subB_; }
    __device__ bool next(int i, Unit& u) const {
        const int it = nsub == 1 ? i : i / nsub; u.sub = nsub == 1 ? 0 : i - it * nsub;
        const long L = (long)it * G + c; if (L >= nwg) return false;
        int wgid = (int)L; { const int q = nwg / NXCD, r = nwg % NXCD, xcd = wgid % NXCD, off = wgid / NXCD; wgid = (xcd < r ? xcd * (q + 1) : r * (q + 1) + (xcd - r) * q) + off; }
        const int nig = WGM * nN, gid = wgid / nig, fm = gid * WGM, gsz = (nM - fm) < WGM ? (nM - fm) : WGM;
        const int pl = fm + ((wgid % nig) % gsz); u.pn = (wgid % nig) / gsz;
        u.pm = mode == 0 ? pl : (mode == 1 ? 17 * (pl >> 4) + 1 + (pl & 15) : 17 * pl);
        return true;
    }
    __device__ __forceinline__ void a_ready(const Unit&) const {}
    __device__ __forceinline__ void done(const Unit&) const {}
};

template <class Epi, class Sched>
__device__ __forceinline__ void gemm_phase(ldsp_t lds, const Gemm g, const Sched& S, const Epi& E, int wave_) {
    int tid = wave_ * 64 + lane_id(); asm volatile("" : "+v"(tid));
    const int wid = __builtin_amdgcn_readfirstlane(tid >> 6), lane = tid & 63, wr = wid >> 2, wc = wid & 3, fr = lane & 15, fq = lane >> 4;
    int K = g.K; asm volatile("" : "+s"(K));
    const int nt = K / BK, lda = g.lda, ldb = g.ldb ? g.ldb : K;
    unsigned voffA[2], voffB[2];
#pragma unroll
    for (int i = 0; i < 2; ++i) { int R, C; stage_rc(tid * 16 + i * 8192, R, C); const int Rb = (R & ~31) + perm32(R & 31);
        voffA[i] = (unsigned)(R * lda + C) * 2u; voffB[i] = (unsigned)(Rb * ldb + C) * 2u; }
    const size_t kstep = (size_t)(BK * 2);
    const size_t hstepA = (size_t)HALF * lda * 2, hstepB = (size_t)HALF * ldb * 2;
    const size_t tstepA = 2 * hstepA, tstepB = 2 * hstepB;
    const unsigned ldsw = (unsigned)wid * 1024u;
    const int aoff = lds_byte(wr * 64 + fr, fq * 8), boff = lds_byte(wc * 32 + fr, fq * 8);
#define PG8_SA(b, h) (((b) * 2 + (h)) * HTB)
#define PG8_SB(b, h) ((4 + (b) * 2 + (h)) * HTB)
#define PG8_STAGE(bufoff, gbase, voff) do { _Pragma("unroll") for (int _i = 0; _i < 2; ++_i) \
        __builtin_amdgcn_global_load_lds((const unsigned*)((const char*)(gbase) + (voff)[_i]), (LAS unsigned*)(lds + (bufoff) + ldsw + _i * 8192), 16, 0, 0); } while (0)
#define PG8_LDA(dst, b, h) do { _Pragma("unroll") for (int m = 0; m < 4; ++m) _Pragma("unroll") for (int k = 0; k < 2; ++k) dst[m][k] = *(const LAS bf16x8*)(lds + PG8_SA(b, h) + aoff + m * 2048 + k * 1024); } while (0)
#define PG8_LDB(dst, b, h) do { _Pragma("unroll") for (int n = 0; n < 2; ++n) _Pragma("unroll") for (int k = 0; k < 2; ++k) dst[n][k] = *(const LAS bf16x8*)(lds + PG8_SB(b, h) + boff + n * 2048 + k * 1024); } while (0)
#define PG8_MMA(ai, bj, At, Bt) do { __builtin_amdgcn_s_setprio(1); _Pragma("unroll") for (int m = 0; m < 4; ++m) _Pragma("unroll") for (int n = 0; n < 2; ++n) _Pragma("unroll") for (int k = 0; k < 2; ++k) \
        acc[ai][bj][m][n] = __builtin_amdgcn_mfma_f32_16x16x32_bf16(Bt[n][k], At[m][k], acc[ai][bj][m][n], 0, 0, 0); __builtin_amdgcn_s_setprio(0); } while (0)
#define PG8_WAIT_V(n) asm volatile("s_waitcnt vmcnt(" #n ")" ::: "memory")
#define PG8_WAIT_L(n) asm volatile("s_waitcnt lgkmcnt(" #n ")" ::: "memory")
#define PG8_BAR __builtin_amdgcn_s_barrier()
#define PG8_SCHED __builtin_amdgcn_sched_barrier(0)
    Unit cur, nxt; int ui = 0;
    if (!S.next(0, cur)) return;
    f32x4 acc[2][2][4][2];
#pragma unroll
    for (int a = 0; a < 2; ++a)
#pragma unroll
        for (int b = 0; b < 2; ++b)
#pragma unroll
            for (int m = 0; m < 4; ++m)
#pragma unroll
                for (int n = 0; n < 2; ++n) acc[a][b][m][n] = (f32x4){0.f, 0.f, 0.f, 0.f};
    bf16x8 At[4][2], B0[2][2], B1[2][2];
    const char* cA = (const char*)g.A + (size_t)cur.pm * tstepA + cur.sub * S.subA; const char* cB = (const char*)g.Bt + (size_t)cur.pn * tstepB + cur.sub * S.subB;
    S.a_ready(cur);
    PG8_STAGE(PG8_SB(0, 0), cB, voffB); PG8_STAGE(PG8_SA(0, 0), cA, voffA); PG8_STAGE(PG8_SB(0, 1), cB + hstepB, voffB); PG8_STAGE(PG8_SA(0, 1), cA + hstepA, voffA);
    if (wr == 1) PG8_BAR;
    PG8_WAIT_V(4); PG8_BAR;
    PG8_STAGE(PG8_SB(1, 0), cB + kstep, voffB); PG8_STAGE(PG8_SA(1, 0), cA + kstep, voffA); PG8_STAGE(PG8_SB(1, 1), cB + hstepB + kstep, voffB);
    PG8_WAIT_V(6); PG8_BAR;
    for (;;) {
        const bool has_next = S.next(ui + 1, nxt);
        const char* nA = has_next ? (const char*)g.A + (size_t)nxt.pm * tstepA + nxt.sub * S.subA : cA; const char* nB = has_next ? (const char*)g.Bt + (size_t)nxt.pn * tstepB + nxt.sub * S.subB : cB;
#pragma unroll 1
        for (int t = 0; t < nt; t += 2) {
            const bool last = (t == nt - 2);
            const char* a1 = cA + (size_t)(t + 1) * kstep;
            const char* a2 = last ? nA : cA + (size_t)(t + 2) * kstep; const char* b2 = last ? nB : cB + (size_t)(t + 2) * kstep;
            const char* a3 = a2 + kstep; const char* b3 = b2 + kstep;
            if (last && has_next) S.a_ready(nxt);
            PG8_LDB(B0, 0, 0); PG8_SCHED; PG8_LDA(At, 0, 0); PG8_STAGE(PG8_SA(1, 1), a1 + hstepA, voffA);
            PG8_WAIT_L(8); PG8_BAR; PG8_WAIT_L(0); PG8_MMA(0, 0, At, B0); PG8_BAR; PG8_SCHED;
            PG8_LDB(B1, 0, 1); PG8_STAGE(PG8_SB(0, 0), b2, voffB);
            PG8_BAR; PG8_WAIT_L(0); PG8_MMA(0, 1, At, B1); PG8_BAR;
            PG8_LDA(At, 0, 1); PG8_STAGE(PG8_SA(0, 0), a2, voffA);
            PG8_BAR; PG8_WAIT_L(0); PG8_MMA(1, 0, At, B0); PG8_BAR; PG8_SCHED;
            PG8_STAGE(PG8_SB(0, 1), b2 + hstepB, voffB);
            PG8_WAIT_V(6); PG8_BAR; PG8_MMA(1, 1, At, B1); PG8_BAR;
            PG8_LDB(B0, 1, 0); PG8_SCHED; PG8_LDA(At, 1, 0); PG8_STAGE(PG8_SA(0, 1), a2 + hstepA, voffA);
            PG8_WAIT_L(8); PG8_BAR; PG8_WAIT_L(0); PG8_MMA(0, 0, At, B0); PG8_BAR; PG8_SCHED;
            PG8_LDB(B1, 1, 1); PG8_STAGE(PG8_SB(1, 0), b3, voffB);
            PG8_BAR; PG8_WAIT_L(0); PG8_MMA(0, 1, At, B1); PG8_BAR;
            PG8_LDA(At, 1, 1); PG8_STAGE(PG8_SA(1, 0), a3, voffA);
            PG8_BAR; PG8_WAIT_L(0); PG8_MMA(1, 0, At, B0); PG8_BAR; PG8_SCHED;
            PG8_STAGE(PG8_SB(1, 1), b3 + hstepB, voffB);
            PG8_WAIT_V(6); PG8_BAR; PG8_MMA(1, 1, At, B1); PG8_BAR;
        }
        E(acc, cur, wr, wc, fr, fq); S.done(cur);
        if (!has_next) break;
#pragma unroll
        for (int a = 0; a < 2; ++a)
#pragma unroll
            for (int b = 0; b < 2; ++b)
#pragma unroll
                for (int m = 0; m < 4; ++m)
#pragma unroll
                    for (int n = 0; n < 2; ++n) acc[a][b][m][n] = (f32x4){0.f, 0.f, 0.f, 0.f};
        cur = nxt; cA = nA; cB = nB; ++ui;
    }
    PG8_WAIT_V(0);
    if (wr == 0) PG8_BAR;
    PG8_BAR;
#undef PG8_SA
#undef PG8_SB
#undef PG8_STAGE
#undef PG8_LDA
#undef PG8_LDB
#undef PG8_MMA
#undef PG8_WAIT_V
#undef PG8_WAIT_L
#undef PG8_BAR
#undef PG8_SCHED
}

__device__ __forceinline__ u32x4 pack8(const f32x4 a, const f32x4 b) { u32x4 w; w.x = cvt_pk_bf16(a[0], a[1]); w.y = cvt_pk_bf16(a[2], a[3]); w.z = cvt_pk_bf16(b[0], b[1]); w.w = cvt_pk_bf16(b[2], b[3]); return w; }
#define EPI_ARGS const f32x4 (&acc)[2][2][4][2], const Unit& u, int wr, int wc, int fr_, int fq_
#define EPI_LANE int fr = fr_, fq = fq_; asm volatile("" : "+v"(fr), "+v"(fq));

struct EpiBf16 {
    bf16_t* O; int ldc;
    __device__ __forceinline__ void operator()(EPI_ARGS) const {
        EPI_LANE
        const int row0 = u.pm * BM + wr * 64 + fr, col0 = u.pn * BM + wc * 32 + 8 * fq;
#pragma unroll
        for (int ai = 0; ai < 2; ++ai)
#pragma unroll
            for (int m = 0; m < 4; ++m) { bf16_t* rowp = O + (size_t)(row0 + ai * HALF + m * 16) * ldc + col0;
#pragma unroll
                for (int bj = 0; bj < 2; ++bj) *(u32x4*)(rowp + bj * HALF) = pack8(acc[ai][bj][m][0], acc[ai][bj][m][1]); }
    }
};
struct EpiF32 {
    float* C; int ldc;
    __device__ __forceinline__ void operator()(EPI_ARGS) const {
        EPI_LANE
        const int row0 = u.pm * BM + wr * 64 + fr, col0 = u.pn * BM + wc * 32 + 8 * fq;
#pragma unroll
        for (int ai = 0; ai < 2; ++ai)
#pragma unroll
            for (int m = 0; m < 4; ++m) { float* rowp = C + (size_t)(row0 + ai * HALF + m * 16) * ldc + col0;
#pragma unroll
                for (int bj = 0; bj < 2; ++bj) { *(f32x4*)(rowp + bj * HALF) = acc[ai][bj][m][0]; *(f32x4*)(rowp + bj * HALF + 4) = acc[ai][bj][m][1]; } }
    }
};
struct EpiInProj {
    bf16_t* P; bf16_t* KB; const float* cosh; const float* sinh; const float* cosr; const float* sinr; const float* akn; const float* aqn;
    float* ssk; float* ssq; float* sskv; float* sscq;
    __device__ __forceinline__ void operator()(EPI_ARGS) const {
        EPI_LANE
        const int pn = u.pn, tb = u.pm % 17; const bool lat = tb != 0; const int posbase = (tb - 1) * 256;
        const int rl0 = wr * 64 + fr;
        if (pn >= 24) {
            const int col0 = pn * BM + wc * 32 + 8 * fq;
#pragma unroll
            for (int ai = 0; ai < 2; ++ai)
#pragma unroll
                for (int m = 0; m < 4; ++m) { bf16_t* rowp = P + ((size_t)u.pm * BM + rl0 + ai * HALF + m * 16) * cf::NC + col0;
#pragma unroll
                    for (int bj = 0; bj < 2; ++bj) { f32x4 v0 = acc[ai][bj][m][0], v1 = acc[ai][bj][m][1];
#pragma unroll
                        for (int e = 0; e < 4; ++e) { v0[e] = sigmoidf_(v0[e]); v1[e] = sigmoidf_(v1[e]); }
                        *(u32x4*)(rowp + bj * HALF) = pack8(v0, v1); } }
        } else if (pn >= 16) {
            const int col0 = cf::PC_GLU + 128 * (pn - 16) + wc * 32 + 8 * fq;
#pragma unroll
            for (int ai = 0; ai < 2; ++ai)
#pragma unroll
                for (int m = 0; m < 4; ++m) { f32x4 v0 = acc[ai][0][m][0], v1 = acc[ai][0][m][1]; const f32x4 g0 = acc[ai][1][m][0], g1 = acc[ai][1][m][1];
#pragma unroll
                    for (int e = 0; e < 4; ++e) { v0[e] *= sigmoidf_(g0[e]); v1[e] *= sigmoidf_(g1[e]); }
                    *(u32x4*)(P + ((size_t)u.pm * BM + rl0 + ai * HALF + m * 16) * cf::NC + col0) = pack8(v0, v1); }
        } else if (pn == 3) {
            if (wc == 0) { const int i0 = 8 * fq;
#pragma unroll
                for (int ai = 0; ai < 2; ++ai)
#pragma unroll
                    for (int m = 0; m < 4; ++m) { const int rl = rl0 + ai * HALF + m * 16;
                        f32x4 c0 = {1.f, 1.f, 1.f, 1.f}, c1 = c0, s0 = {0.f, 0.f, 0.f, 0.f}, s1 = s0;
                        if (lat) { const float* cp = cosr + (size_t)(posbase + rl) * 32 + i0; const float* sp = sinr + (size_t)(posbase + rl) * 32 + i0;
                            c0 = *(const f32x4*)cp; c1 = *(const f32x4*)(cp + 4); s0 = *(const f32x4*)sp; s1 = *(const f32x4*)(sp + 4); }
                        const f32x4 x1a = acc[ai][0][m][0], x1b = acc[ai][0][m][1], x2a = acc[ai][1][m][0], x2b = acc[ai][1][m][1];
                        const u32x4 w1 = pack8(x1a * c0 - x2a * s0, x1b * c1 - x2b * s1), w2 = pack8(x2a * c0 + x1a * s0, x2b * c1 + x1b * s1);
                        bf16_t* kb = KB + ((size_t)u.pm * BM + rl) * 1536 + 128 + i0;
#pragma unroll
                        for (int h = 0; h < 8; ++h) { *(u32x4*)(kb + h * 192) = w1; *(u32x4*)(kb + h * 192 + 32) = w2; }
                        asm volatile("" ::: "memory"); } }
        } else if (pn == 0 || pn == 4 || (pn >= 6 && pn <= 9) || pn >= 12) {
            const bool norm = pn == 0 || (pn >= 6 && pn <= 9);
            const int hl = wc >> 1, i0 = 32 * (wc & 1) + 8 * fq;
            f32x4 g1a = {1.f, 1.f, 1.f, 1.f}, g1b = g1a, g2a = g1a, g2b = g1a;
            if (norm) { const float* gn = (pn == 0 ? akn : aqn) + i0; g1a = *(const f32x4*)gn; g1b = *(const f32x4*)(gn + 4); g2a = *(const f32x4*)(gn + 64); g2b = *(const f32x4*)(gn + 68); }
            float* ssp = pn == 0 ? ssk + ((size_t)u.pm * BM * 2 + hl) * 2 + (wc & 1) : ssq + ((size_t)u.pm * BM * 8 + (pn - 6) * 2 + hl) * 2 + (wc & 1);
            const int sstr = pn == 0 ? 4 : 16;
#pragma unroll
            for (int ai = 0; ai < 2; ++ai)
#pragma unroll
                for (int m = 0; m < 4; ++m) { const int rl = rl0 + ai * HALF + m * 16;
                    f32x4 x1a = acc[ai][0][m][0], x1b = acc[ai][0][m][1], x2a = acc[ai][1][m][0], x2b = acc[ai][1][m][1];
                    if (norm) { const f32x4 q = x1a * x1a + x1b * x1b + x2a * x2a + x2b * x2b; float ss = (q[0] + q[1]) + (q[2] + q[3]);
                        ss += shx(ss, 16, fr + 16 * fq); ss += shx(ss, 32, fr + 16 * fq);
                        if (fq == 0) ssp[(size_t)rl * sstr] = ss;
                        x1a *= g1a; x1b *= g1b; x2a *= g2a; x2b *= g2b; }
                    f32x4 o1a = x1a, o1b = x1b, o2a = x2a, o2b = x2b;
                    if (lat) { const float* cp = cosh + (size_t)(posbase + rl) * 64 + i0; const float* sp = sinh + (size_t)(posbase + rl) * 64 + i0;
                        const f32x4 c0 = *(const f32x4*)cp, c1 = *(const f32x4*)(cp + 4), s0 = *(const f32x4*)sp, s1 = *(const f32x4*)(sp + 4);
                        o1a = x1a * c0 - x2a * s0; o1b = x1b * c1 - x2b * s1; o2a = x2a * c0 + x1a * s0; o2b = x2b * c1 + x1b * s1; }
                    bf16_t* dst = P + ((size_t)u.pm * BM + rl) * cf::NC + pn * BM + hl * 128 + i0;
                    *(u32x4*)dst = pack8(o1a, o1b); *(u32x4*)(dst + 64) = pack8(o2a, o2b);
                    asm volatile("" ::: "memory"); }
        } else {
            const int col0 = pn * BM + wc * 32 + 8 * fq;
            const bool ssq_on = pn == 2 || pn == 10 || pn == 11;
            float* ssp = pn == 2 ? sskv + (size_t)u.pm * BM * 4 + wc : sscq + (size_t)u.pm * BM * 8 + (pn - 10) * 4 + wc;
            const int sstr = pn == 2 ? 4 : 8;
#pragma unroll
            for (int ai = 0; ai < 2; ++ai)
#pragma unroll
                for (int m = 0; m < 4; ++m) { const int rl = rl0 + ai * HALF + m * 16; bf16_t* rowp = P + ((size_t)u.pm * BM + rl) * cf::NC + col0;
#pragma unroll
                    for (int bj = 0; bj < 2; ++bj) *(u32x4*)(rowp + bj * HALF) = pack8(acc[ai][bj][m][0], acc[ai][bj][m][1]);
                    if (ssq_on) { const f32x4 q = acc[ai][0][m][0] * acc[ai][0][m][0] + acc[ai][0][m][1] * acc[ai][0][m][1] + acc[ai][1][m][0] * acc[ai][1][m][0] + acc[ai][1][m][1] * acc[ai][1][m][1];
                        float ss = (q[0] + q[1]) + (q[2] + q[3]); ss += shx(ss, 16, fr + 16 * fq); ss += shx(ss, 32, fr + 16 * fq);
                        if (fq == 0) ssp[(size_t)rl * sstr] = ss; } }
        }
    }
};
struct EpiKvUp {
    bf16_t* KB; bf16_t* VB; const float* sskv;
    __device__ __forceinline__ void operator()(EPI_ARGS) const {
        EPI_LANE
        const int row0 = u.pm * BM + wr * 64 + fr, d0 = wc * 32 + 8 * fq;
        const bool isk = u.pn < 4;
        bf16_t* base = isk ? KB + (2 * u.pn) * 192 + d0 : VB + (u.pn - 4) * 256 + d0;
        const int ldr = isk ? 1536 : 1024, bjs = isk ? 192 : 128;
#pragma unroll
        for (int ai = 0; ai < 2; ++ai)
#pragma unroll
            for (int m = 0; m < 4; ++m) { const size_t row = (size_t)(row0 + ai * HALF + m * 16); bf16_t* rowp = base + row * ldr;
                const f32x4 pp = *(const f32x4*)(sskv + row * 4); const float r = rsqrtf(((pp[0] + pp[1]) + (pp[2] + pp[3])) * (1.f / 256.f) + 1e-6f);
#pragma unroll
                for (int bj = 0; bj < 2; ++bj) *(u32x4*)(rowp + bj * bjs) = pack8(acc[ai][bj][m][0] * r, acc[ai][bj][m][1] * r); }
    }
};
struct EpiQUp {
    bf16_t* QB; const float* cosr; const float* sinr; const float* sscq;
    __device__ __forceinline__ void operator()(EPI_ARGS) const {
        EPI_LANE
        const int row0 = u.pm * BM + wr * 64 + fr;
        if (u.pn < 4) {
            const int d0 = wc * 32 + 8 * fq;
#pragma unroll
            for (int ai = 0; ai < 2; ++ai)
#pragma unroll
                for (int m = 0; m < 4; ++m) { const size_t row = (size_t)(row0 + ai * HALF + m * 16);
                    const f32x4 pa = *(const f32x4*)(sscq + row * 8), pb = *(const f32x4*)(sscq + row * 8 + 4);
                    const float r = rsqrtf((((pa[0] + pa[1]) + (pa[2] + pa[3])) + ((pb[0] + pb[1]) + (pb[2] + pb[3]))) * (1.f / 512.f) + 1e-6f);
#pragma unroll
                    for (int bj = 0; bj < 2; ++bj) *(u32x4*)(QB + row * 1536 + (2 * u.pn + bj) * 192 + d0) = pack8(acc[ai][bj][m][0] * r, acc[ai][bj][m][1] * r); }
        } else {
            const int head = 4 * (u.pn - 4) + wc, i0 = 8 * fq;
            const bool lat = (u.pm % 17) != 0; const int posbase = (u.pm % 17) * 256 - 256;
#pragma unroll
            for (int ai = 0; ai < 2; ++ai)
#pragma unroll
                for (int m = 0; m < 4; ++m) { const int rl = wr * 64 + fr + ai * HALF + m * 16; const size_t row = (size_t)u.pm * BM + rl;
                    const f32x4 pa = *(const f32x4*)(sscq + row * 8), pb = *(const f32x4*)(sscq + row * 8 + 4);
                    const float r = rsqrtf((((pa[0] + pa[1]) + (pa[2] + pa[3])) + ((pb[0] + pb[1]) + (pb[2] + pb[3]))) * (1.f / 512.f) + 1e-6f);
                    f32x4 c0 = {1.f, 1.f, 1.f, 1.f}, c1 = c0, s0 = {0.f, 0.f, 0.f, 0.f}, s1 = s0;
                    if (lat) { const float* cp = cosr + (size_t)(posbase + rl) * 32 + i0; const float* sp = sinr + (size_t)(posbase + rl) * 32 + i0;
                        c0 = *(const f32x4*)cp; c1 = *(const f32x4*)(cp + 4); s0 = *(const f32x4*)sp; s1 = *(const f32x4*)(sp + 4); }
                    const f32x4 x1a = acc[ai][0][m][0] * r, x1b = acc[ai][0][m][1] * r, x2a = acc[ai][1][m][0] * r, x2b = acc[ai][1][m][1] * r;
                    const f32x4 o1a = x1a * c0 - x2a * s0, o1b = x1b * c1 - x2b * s1, o2a = x2a * c0 + x1a * s0, o2b = x2b * c1 + x1b * s1;
                    bf16_t* dst = QB + row * 1536 + head * 192 + 128 + i0;
                    *(u32x4*)dst = pack8(o1a, o1b); *(u32x4*)(dst + 32) = pack8(o2a, o2b); asm volatile("" ::: "memory"); }
        }
    }
};
struct EpiMerge {
    bf16_t* ACC; const bf16_t* gate0; int ldg;
    __device__ __forceinline__ void operator()(EPI_ARGS) const {
        EPI_LANE
        const int row0 = u.pm * BM + wr * 64 + fr, col0 = u.pn * BM + wc * 32 + 8 * fq;
        const bf16_t* gate = gate0 + u.sub * 2048; const bool first = u.sub == 0;
#pragma unroll
        for (int ai = 0; ai < 2; ++ai) {
            u32x4 gw[4][2], pw[4][2];
#pragma unroll
            for (int m = 0; m < 4; ++m) { const size_t row = (size_t)(row0 + ai * HALF + m * 16);
#pragma unroll
                for (int bj = 0; bj < 2; ++bj) { const int col = col0 + bj * HALF; gw[m][bj] = *(const u32x4*)(gate + row * ldg + col);
                    pw[m][bj] = (u32x4){0u, 0u, 0u, 0u}; if (!first) pw[m][bj] = *(const u32x4*)(ACC + row * 2048 + col); } }
#pragma unroll
            for (int m = 0; m < 4; ++m) { const size_t row = (size_t)(row0 + ai * HALF + m * 16);
#pragma unroll
                for (int bj = 0; bj < 2; ++bj) { const int col = col0 + bj * HALF; const u32x4 g = gw[m][bj], p = pw[m][bj];
                    const f32x4 a0 = acc[ai][bj][m][0], a1 = acc[ai][bj][m][1];
                    f32x4 r0, r1;
                    r0[0] = bflo(p.x) + bflo(g.x) * a0[0]; r0[1] = bfhi(p.x) + bfhi(g.x) * a0[1]; r0[2] = bflo(p.y) + bflo(g.y) * a0[2]; r0[3] = bfhi(p.y) + bfhi(g.y) * a0[3];
                    r1[0] = bflo(p.z) + bflo(g.z) * a1[0]; r1[1] = bfhi(p.z) + bfhi(g.z) * a1[1]; r1[2] = bflo(p.w) + bflo(g.w) * a1[2]; r1[3] = bfhi(p.w) + bfhi(g.w) * a1[3];
                    *(u32x4*)(ACC + row * 2048 + col) = pack8(r0, r1); } }
            asm volatile("" ::: "memory"); }
    }
};
struct EpiWo {
    float* X1; const float* mod  ; const float* xlat  ; const float* xctx  ;
    __device__ __forceinline__ void operator()(EPI_ARGS) const {
        EPI_LANE
        const int b = u.pm / 17, tb = u.pm % 17; const bool isctx = tb == 0;
        const float* g1 = mod + (size_t)(isctx ? 4 : b) * 12288 + 2 * 2048;
        const float* xbase = isctx ? xctx + (size_t)b * cf::CTX * 2048 : xlat + ((size_t)b * cf::S + (size_t)(tb - 1) * 256) * 2048;
        const int rl0 = wr * 64 + fr, col0 = u.pn * BM + wc * 32 + 8 * fq;
        f32x4 gv[2][2];
#pragma unroll
        for (int bj = 0; bj < 2; ++bj) { gv[bj][0] = *(const f32x4*)(g1 + col0 + bj * HALF); gv[bj][1] = *(const f32x4*)(g1 + col0 + bj * HALF + 4); }
#pragma unroll
        for (int ai = 0; ai < 2; ++ai) {
            f32x4 xv[4][2][2];
#pragma unroll
            for (int m = 0; m < 4; ++m) { const int rl = rl0 + ai * HALF + m * 16;
#pragma unroll
                for (int bj = 0; bj < 2; ++bj) { const float* xp = xbase + (size_t)rl * 2048 + col0 + bj * HALF; xv[m][bj][0] = *(const f32x4*)xp; xv[m][bj][1] = *(const f32x4*)(xp + 4); } }
#pragma unroll
            for (int m = 0; m < 4; ++m) { const int rl = rl0 + ai * HALF + m * 16; float* op = X1 + ((size_t)u.pm * BM + rl) * 2048 + col0;
#pragma unroll
                for (int bj = 0; bj < 2; ++bj) { *(f32x4*)(op + bj * HALF) = xv[m][bj][0] * cf::ALPHA + gv[bj][0] * acc[ai][bj][m][0];
                    *(f32x4*)(op + bj * HALF + 4) = xv[m][bj][1] * cf::ALPHA + gv[bj][1] * acc[ai][bj][m][1]; } }
            asm volatile("" ::: "memory"); }
    }
};
}

struct Ctx {
    const float* const* in; float* out; unsigned char* ws;
    ldsp_t lds; int tid, lane, wave, G, bid;
};
#define WSP(T, off) ((T*)(F.ws + (off)))
__device__ __forceinline__ Ctx phase_ctx(const Ctx& F0) {
    Ctx C = F0;
    C.tid = F0.wave * 64 + lane_id();
    asm volatile("" : "+v"(C.tid));
    { size_t z = 0; asm volatile("" : "+s"(z)); C.ws = F0.ws + z; }
    C.lane = C.tid & 63; C.wave = __builtin_amdgcn_readfirstlane(C.tid >> 6);
    return C;
}

__device__ __forceinline__ int srcmap(int mode, int n) {
    if (mode == 0) {
        const int pn = n >> 8, q = n & 255, bj = q >> 7, r = q & 127, rope = (r >> 6) * 128 + bj * 64 + (r & 63);
        if (pn == 0) return rope;
        if (pn == 1) return 256 + q;
        if (pn == 2) return 512 + q;
        if (pn == 3) return r < 32 ? 768 + bj * 32 + r : -1;
        if (pn == 4) return 832 + rope;
        if (pn == 5) return 1088 + q;
        if (pn < 10) return 1344 + (pn - 6) * 256 + rope;
        if (pn < 12) return 2368 + (pn - 10) * 256 + q;
        if (pn < 16) return 2880 + (pn - 12) * 256 + rope;
        if (pn < 24) return 3904 + bj * 1024 + 128 * (pn - 16) + r;
        return 5952 + (n - 6144);
    }
    if (mode == 1) { if (n < 1024) return (n >> 7) * 192 + (n & 127);
        const int m = n - 1024, t = m >> 8, bj = (m >> 7) & 1, q = m & 127; return (4 * t + (q >> 5)) * 192 + 128 + bj * 32 + (q & 31); }
    if (mode == 2) { if (n < 1024) return (n >> 7) * 256 + (n & 127); const int m = n - 1024; return (m >> 7) * 256 + 128 + (m & 127); }
    return n;
}
__device__ __forceinline__ void tr_tile(const Ctx& F, const float* src, int ld_src, int mode, int k0, bf16_t* dst, int ldd, int n0, const float* kscale = nullptr) {
    LAS float* T = (LAS float*)F.lds;
    const int kr = F.tid >> 6, nc = (F.tid & 63) * 4, sc = srcmap(mode, n0 + nc);
    f32x4 v[8];
#pragma unroll
    for (int h = 0; h < 8; ++h) { v[h] = (f32x4){0.f, 0.f, 0.f, 0.f}; if (sc >= 0) v[h] = *(const f32x4*)(src + (size_t)(k0 + kr + 8 * h) * ld_src + sc); }
#pragma unroll
    for (int h = 0; h < 8; ++h) { const int k = kr + 8 * h; f32x4 x = v[h]; if (kscale) x = x * kscale[k0 + k];
        T[k * 257 + nc + 0] = x[0]; T[k * 257 + nc + 1] = x[1]; T[k * 257 + nc + 2] = x[2]; T[k * 257 + nc + 3] = x[3]; }
    __syncthreads();
    const int n = F.tid >> 1, kc = (F.tid & 1) * 32;
#pragma unroll
    for (int j = 0; j < 4; ++j) { u32x4 w; const int kb = kc + 8 * j;
        w.x = cvt_pk_bf16(T[(kb + 0) * 257 + n], T[(kb + 1) * 257 + n]); w.y = cvt_pk_bf16(T[(kb + 2) * 257 + n], T[(kb + 3) * 257 + n]);
        w.z = cvt_pk_bf16(T[(kb + 4) * 257 + n], T[(kb + 5) * 257 + n]); w.w = cvt_pk_bf16(T[(kb + 6) * 257 + n], T[(kb + 7) * 257 + n]);
        *(u32x4*)(dst + (size_t)(n0 + n) * ldd + k0 + kb) = w; }
    __syncthreads();
}
__device__ __forceinline__ void cvt_rows(const Ctx& F, const float* src, bf16_t* dst, size_t n8) {
    for (size_t i = (size_t)F.bid * 512 + F.tid; i < n8; i += (size_t)F.G * 512) {
        const f32x4 a = *(const f32x4*)(src + i * 8), b = *(const f32x4*)(src + i * 8 + 4);
        *(u32x4*)(dst + i * 8) = pg8::pack8(a, b); }
}

constexpr int UV_ROW = 2176, SC_BIAS = 103;
__device__ __forceinline__ float uv_scale(unsigned byte) { return __uint_as_float((byte << 20) + ((unsigned)SC_BIAS << 23)); }
__device__ __forceinline__ void cvt_rows_fp4(const Ctx& F, const float* src, unsigned char* dst, size_t nblk, int which) {
    for (size_t i = (size_t)F.bid * 512 + F.tid; i < nblk; i += (size_t)F.G * 512) {
        f32x4 a[8]; float amax = 0.f;
#pragma unroll
        for (int j = 0; j < 8; ++j) { a[j] = *(const f32x4*)(src + i * 32 + 4 * j); amax = fmaxf(amax, fmaxf(fmaxf(fabsf(a[j][0]), fabsf(a[j][1])), fmaxf(fabsf(a[j][2]), fabsf(a[j][3])))); }
        const unsigned rb = (__float_as_uint(amax * (1.0f / 6.0f)) + 0xFFFFFu) >> 20;
        const unsigned sb = rb < ((unsigned)SC_BIAS << 3) ? 0u : (rb - ((unsigned)SC_BIAS << 3) > 255u ? 255u : rb - ((unsigned)SC_BIAS << 3));
        const float inv = 1.0f / uv_scale(sb);
        u32x4 w;
#pragma unroll
        for (int j = 0; j < 4; ++j) { const f32x4 x = a[2 * j] * inv, y = a[2 * j + 1] * inv; unsigned p = 0u;
            p = __builtin_amdgcn_cvt_scalef32_pk_fp4_f32(p, x[0], x[1], 1.0f, 0); p = __builtin_amdgcn_cvt_scalef32_pk_fp4_f32(p, x[2], x[3], 1.0f, 1);
            p = __builtin_amdgcn_cvt_scalef32_pk_fp4_f32(p, y[0], y[1], 1.0f, 2); p = __builtin_amdgcn_cvt_scalef32_pk_fp4_f32(p, y[2], y[3], 1.0f, 3); w[j] = p; }
        const size_t row = i >> 6; const int bl = (int)(i & 63);
        *(u32x4*)(dst + row * UV_ROW + which * 1024 + bl * 16) = w; dst[row * UV_ROW + 2048 + 2 * bl + which] = (unsigned char)sb;
    }
}

__device__ __forceinline__ void ph_prologue(const Ctx& F0) {
    const Ctx F = phase_ctx(F0);
    using namespace cf;
    constexpr int T_WIN = 2 * 32 * 56, T_QUP = 2 * 8 * 6, T_KVUP = 2 * 4 * 8, T_BR = 2 * 4 * 16 * 8, T_WO = 2 * 32 * 8;
    constexpr int T_ALL = T_WIN + T_QUP + T_KVUP + T_BR + T_WO;
    for (int u = F.bid; u < T_ALL; u += F.G) {
        int t = u;
        if (t < T_WIN) { const int l = t / (32 * 56), r = t % (32 * 56), kt = r / 56, nt = r % 56;
            tr_tile(F, F.in[I_WIN] + (size_t)l * 2048 * IN_COLS, IN_COLS, 0, kt * 64, WSP(bf16_t, WS_WIN) + (size_t)l * NC * 2048, 2048, nt * 256); continue; }
        t -= T_WIN;
        if (t < T_QUP) { const int l = t / (8 * 6), r = t % (8 * 6), kt = r / 6, nt = r % 6;
            tr_tile(F, F.in[I_WQUP] + (size_t)l * 512 * 1536, 1536, 1, kt * 64, WSP(bf16_t, WS_WQUP) + (size_t)l * 1536 * 512, 512, nt * 256, F.in[I_BQN] + l * 512); continue; }
        t -= T_QUP;
        if (t < T_KVUP) { const int l = t / (4 * 8), r = t % (4 * 8), kt = r / 8, nt = r % 8;
            tr_tile(F, F.in[I_WKVUP] + (size_t)l * 256 * 2048, 2048, 2, kt * 64, WSP(bf16_t, WS_WKVUP) + (size_t)l * 2048 * 256, 256, nt * 256, F.in[I_BKVN] + l * 256); continue; }
        t -= T_KVUP;
        if (t < T_BR) { const int l = t / (4 * 128), r = t % (4 * 128), br = r / 128, r2 = r % 128, kt = r2 / 8, nt = r2 % 8;
            const float* src = (br == 0 ? F.in[I_WBRA] : br == 1 ? F.in[I_WBRB] : br == 2 ? F.in[I_WBRC] : F.in[I_WBRD]) + (size_t)l * 1024 * 2048;
            tr_tile(F, src, 2048, 3, kt * 64, WSP(bf16_t, WS_WBR) + ((size_t)l * 4 + br) * 2048 * 1024, 1024, nt * 256); continue; }
        t -= T_BR;
        { const int l = t / 256, r = t % 256, kt = r / 8, nt = r % 8;
            tr_tile(F, F.in[I_WO] + (size_t)l * 2048 * 2048, 2048, 3, kt * 64, WSP(bf16_t, WS_WO) + (size_t)l * 2048 * 2048, 2048, nt * 256); }
    }
    for (int u = F.bid; u < 2 * 16 * 32; u += F.G) {
        const int l = u / 512, g = (u % 512) / 32, d0 = (u % 32) * 64;
        LAS float* sk = (LAS float*)F.lds; LAS float* wt = (LAS float*)(F.lds + 128 * 129 * 4);
        const float* skg = F.in[I_PSK] + ((size_t)l * 16 + g) * 128 * 128;
        const float* wqg = F.in[I_PWQ] + (size_t)l * 2048 * 2048 + (size_t)d0 * 2048 + g * 128;
        for (int i = F.tid; i < 128 * 128; i += 512) sk[(i >> 7) * 129 + (i & 127)] = skg[i];
        for (int i = F.tid; i < 64 * 128; i += 512) wt[(i >> 7) * 129 + (i & 127)] = wqg[(size_t)(i >> 7) * 2048 + (i & 127)];
        __syncthreads();
        const int n = F.tid & 127, dg = F.tid >> 7;
        float a[16];
#pragma unroll
        for (int e = 0; e < 16; ++e) a[e] = 0.f;
        for (int k = 0; k < 128; ++k) { const float s = sk[n * 129 + k];
#pragma unroll
            for (int e = 0; e < 16; ++e) a[e] += wt[(dg * 16 + e) * 129 + k] * s; }
        bf16_t* dst = WSP(bf16_t, WS_WFOLD) + (size_t)l * 2048 * 2048 + (size_t)(g * 128 + n) * 2048 + d0 + dg * 16;
        u32x4 w0, w1;
        w0.x = cvt_pk_bf16(a[0], a[1]); w0.y = cvt_pk_bf16(a[2], a[3]); w0.z = cvt_pk_bf16(a[4], a[5]); w0.w = cvt_pk_bf16(a[6], a[7]);
        w1.x = cvt_pk_bf16(a[8], a[9]); w1.y = cvt_pk_bf16(a[10], a[11]); w1.z = cvt_pk_bf16(a[12], a[13]); w1.w = cvt_pk_bf16(a[14], a[15]);
        *(u32x4*)dst = w0; *(u32x4*)(dst + 8) = w1;
        __syncthreads();
    }
    for (int u = F.bid; u < 2 * 192; u += F.G) {
        const int l = u / 192, n0 = (u % 192) * 64;
        LAS float* sl = (LAS float*)F.lds; LAS float* red = (LAS float*)(F.lds + 5 * 2048 * 4);
        for (int i = F.tid; i < 5 * 2048; i += 512) { const int r = i >> 11, k = i & 2047; const float v = r < 4 ? F.in[I_C][r * 2048 + k] : F.in[I_CCTX][k]; sl[i] = v * sigmoidf_(v); }
        __syncthreads();
        const int cg = F.tid & 15, ks = F.tid >> 4;
        f32x4 a[5];
#pragma unroll
        for (int r = 0; r < 5; ++r) a[r] = (f32x4){0.f, 0.f, 0.f, 0.f};
        const float* wp = F.in[I_WADA] + (size_t)l * 2048 * 12288 + n0 + cg * 4;
#pragma unroll 8
        for (int k = ks * 64; k < ks * 64 + 64; ++k) { const f32x4 w = *(const f32x4*)(wp + (size_t)k * 12288);
#pragma unroll
            for (int r = 0; r < 5; ++r) a[r] += w * sl[r * 2048 + k]; }
#pragma unroll
        for (int r = 0; r < 5; ++r) *(LAS f32x4*)(red + (ks * 5 + r) * 64 + cg * 4) = a[r];
        __syncthreads();
        if (F.tid < 320) { const int r = F.tid >> 6, col = F.tid & 63; float sacc = 0.f;
#pragma unroll
            for (int k2 = 0; k2 < 32; ++k2) sacc += red[(k2 * 5 + r) * 64 + col];
            WSP(float, WS_MOD)[((size_t)l * 5 + r) * 12288 + n0 + col] = sacc + F.in[I_BADA][(size_t)l * 12288 + n0 + col]; }
        __syncthreads();
    }
    for (int i = F.bid * 512 + F.tid; i < 4096 * 64; i += F.G * 512) {
        const int pos = i >> 6, j = i & 63, fi = j & 31; const float fr = powf(10000.0f, -(float)(2 * fi) / 64.0f);
        const float ang = (float)(j < 32 ? (pos >> 6) : (pos & 63)) * fr;
        WSP(float, WS_COSH)[i] = cosf(ang); WSP(float, WS_SINH)[i] = sinf(ang);
    }
    for (int i = F.bid * 512 + F.tid; i < 4096 * 32; i += F.G * 512) {
        const int pos = i >> 5, j = i & 31, fi = j & 15; const float fr = powf(10000.0f, -(float)(2 * fi) / 32.0f);
        const float ang = (float)(j < 16 ? (pos >> 6) : (pos & 63)) * fr;
        WSP(float, WS_COSR)[i] = cosf(ang); WSP(float, WS_SINR)[i] = sinf(ang);
    }
    cvt_rows_fp4(F, F.in[I_PU], WSP(unsigned char, WS_UB), (size_t)2 * NEXP * 64, 0);
    cvt_rows_fp4(F, F.in[I_PV], WSP(unsigned char, WS_UB), (size_t)2 * NEXP * 64, 1);
}

__device__ __forceinline__ void ph_modulate0(const Ctx& F0) {
    const Ctx F = phase_ctx(F0);
    using namespace cf;
    const float* mod = WSP(float, WS_MOD);
    for (size_t i = (size_t)F.bid * 512 + F.tid; i < (size_t)MR * 256; i += (size_t)F.G * 512) {
        const int R = (int)(i >> 8), d = (int)(i & 255) * 8, b = R / RB, j = R % RB;
        const float* src = j < CTX ? F.in[I_CTX] + ((size_t)b * CTX + j) * 2048 : F.in[I_X] + ((size_t)b * S + (j - CTX)) * 2048;
        const float* m = mod + (size_t)(j < CTX ? 4 : b) * 12288;
        const f32x4 x0 = *(const f32x4*)(src + d), x1 = *(const f32x4*)(src + d + 4);
        const f32x4 sh0 = *(const f32x4*)(m + d), sh1 = *(const f32x4*)(m + d + 4), s0 = *(const f32x4*)(m + 2048 + d), s1 = *(const f32x4*)(m + 2048 + d + 4);
        *(u32x4*)(WSP(bf16_t, WS_HB) + (size_t)R * 2048 + d) = pg8::pack8(x0 * (s0 + 1.0f) + sh0, x1 * (s1 + 1.0f) + sh1);
    }
}

__device__ __forceinline__ void knorm_pass(const Ctx& F) {
    using namespace cf;
    bf16_t* P = WSP(bf16_t, WS_P); const float* ssk = WSP(const float, WS_SSK);
    for (int it = F.bid * 8 + F.wave; it < MR * 2; it += F.G * 8) {
        const int R = it >> 1, h = it & 1;
        const f32x2 pp = *(const f32x2*)(ssk + (size_t)it * 2); const float r = rsqrtf((pp.x + pp.y) * (1.f / 128.f) + 1e-6f);
        unsigned* q = (unsigned*)(P + (size_t)R * NC + PC_AK + h * 128) + F.lane;
        const unsigned w = *q; *q = cvt_pk_bf16(bflo(w) * r, bfhi(w) * r);
    }
}

struct AttnArgs {
    const bf16_t* Q; const bf16_t* K; const bf16_t* V; bf16_t* O; int ldq, ldk, ldv, ldo;
    int seg0_row, seg0_tiles, seg1_row, seg1_tiles;
    int mask_on, qpos0, kpos1;
    float sc_log2; int has_sink; float sink_l2;
    int variant;
    const float* qss;
};
typedef float f32x16 __attribute__((ext_vector_type(16)));
constexpr float LOG2E_F = 1.4426950408889634f;
template <int DK, bool MASKED>
__device__ __forceinline__ void attn_unit(ldsp_t lds, const AttnArgs a, int wave_) {
    constexpr int ND = DK / 16, KCH = DK / 8, KPT = (64 * KCH) / 512, VST = 72, KM = DK == 128 ? 15 : 7;
    constexpr int KBUF = 64 * DK * 2, VBUF = 128 * VST * 2, VOFF = 2 * KBUF, ALOFF = VOFF + 3 * VBUF;
    int tid = wave_ * 64 + lane_id(); asm volatile("" : "+v"(tid));
    const int wid = __builtin_amdgcn_readfirstlane(tid >> 6), lane = tid & 63, q32 = lane & 31, hi = lane >> 5;
    LAS float* al = (LAS float*)(lds + ALOFF + wid * 128);
    bf16x8 qf[ND];
    { float scq = a.sc_log2;
      if (a.qss) { const f32x2 pp = *(const f32x2*)(a.qss + (size_t)(wid * 32 + q32) * 16); scq *= rsqrtf((pp.x + pp.y) * (1.f / 128.f) + 1e-6f); }
      const bf16_t* qrow = a.Q + (size_t)(wid * 32 + q32) * a.ldq + 8 * hi;
#pragma unroll
      for (int s = 0; s < ND; ++s) { const u32x4 w = *(const u32x4*)(qrow + 16 * s); u32x4 o;
          o.x = cvt_pk_bf16(bflo(w.x) * scq, bfhi(w.x) * scq); o.y = cvt_pk_bf16(bflo(w.y) * scq, bfhi(w.y) * scq);
          o.z = cvt_pk_bf16(bflo(w.z) * scq, bfhi(w.z) * scq); o.w = cvt_pk_bf16(bflo(w.w) * scq, bfhi(w.w) * scq); qf[s] = *(bf16x8*)&o; } }
    f32x16 o[4];
#pragma unroll
    for (int db = 0; db < 4; ++db)
#pragma unroll
        for (int r = 0; r < 16; ++r) o[db][r] = 0.f;
    float m_run = -1e30f, l_run = 0.f;
    const int PV_ = MK_AV ? a.variant : 0;
    const int ntiles = a.seg0_tiles + a.seg1_tiles;
    u32x4 vreg[2];
    const int vkp = tid & 31, vdc = tid >> 5;
    const int vkey = 2 * vkp, vpos = (vkey & 48) | ((vkey & 4) << 1) | ((vkey & 8) >> 1) | (vkey & 3);
    unsigned koff[KPT];
#pragma unroll
    for (int i = 0; i < KPT; ++i) { const int P = (i * 8 + wid) * 64 + lane, row = P / KCH, cp = P % KCH; koff[i] = (unsigned)(row * a.ldk + 8 * (cp ^ (row & KM))) * 2u; }
#define ATT_LOAD(tt, kb) do { const int _r0 = (tt) < a.seg0_tiles ? a.seg0_row + 64 * (tt) : a.seg1_row + 64 * ((tt) - a.seg0_tiles); \
        const char* _kg = (const char*)(a.K + (size_t)_r0 * a.ldk); \
        _Pragma("unroll") for (int _i = 0; _i < KPT; ++_i) __builtin_amdgcn_global_load_lds((const unsigned*)(_kg + koff[_i]), (LAS unsigned*)(lds + (kb) * KBUF + (_i * 8 + wid) * 1024), 16, 0, 0); \
        vreg[0] = *(const u32x4*)(a.V + (size_t)(_r0 + 2 * vkp) * a.ldv + 8 * vdc); vreg[1] = *(const u32x4*)(a.V + (size_t)(_r0 + 2 * vkp + 1) * a.ldv + 8 * vdc); } while (0)
#define ATT_WRITE(vb) do { const ldsp_t _vb = lds + VOFF + (vb) * VBUF; \
        const unsigned _a0[4] = {vreg[0].x, vreg[0].y, vreg[0].z, vreg[0].w}, _a1[4] = {vreg[1].x, vreg[1].y, vreg[1].z, vreg[1].w}; \
        _Pragma("unroll") for (int _e = 0; _e < 4; ++_e) { \
            *(LAS unsigned*)(_vb + ((8 * vdc + 2 * _e) * VST + vpos) * 2) = (_a0[_e] & 0xffffu) | (_a1[_e] << 16); \
            *(LAS unsigned*)(_vb + ((8 * vdc + 2 * _e + 1) * VST + vpos) * 2) = (_a0[_e] >> 16) | (_a1[_e] & 0xffff0000u); } } while (0)
#define ATT_PV(vb) do { const ldsp_t _vt = lds + VOFF + (vb) * VBUF; \
        _Pragma("unroll") for (int db = 0; db < 4; ++db) _Pragma("unroll") for (int ks = 0; ks < 4; ++ks) { \
            const bf16x8 vf = *(const LAS bf16x8*)(_vt + ((32 * db + q32) * VST + 16 * ks + 8 * hi) * 2); \
            o[db] = __builtin_amdgcn_mfma_f32_32x32x16_bf16(pa[ks], vf, o[db], 0, 0, 0); } } while (0)
    bf16x8 pa[4];
#pragma unroll
    for (int i = 0; i < 4; ++i) pa[i] = (bf16x8){0, 0, 0, 0, 0, 0, 0, 0};
    int vprev = 2, vcur = 0, vnext = 1;
    { unsigned z0 = 0u; asm volatile("" : "+v"(z0));
      for (int i = tid; i < VBUF / 16; i += 512) *(LAS u32x4*)(lds + VOFF + 2 * VBUF + i * 16) = (u32x4){z0, z0, z0, z0}; }
    ATT_LOAD(0, 0);
    ATT_WRITE(0);
    asm volatile("s_waitcnt vmcnt(0)" ::: "memory");
    __syncthreads();
    for (int tt = 0; tt < ntiles; ++tt) {
        const int cur = tt & 1;
        if (tt + 1 < ntiles && PV_ != 4) ATT_LOAD(tt + 1, cur ^ 1);
        const ldsp_t Ks = lds + cur * KBUF;
        f32x16 s0, s1;
#pragma unroll
        for (int r = 0; r < 16; ++r) { s0[r] = 0.f; s1[r] = 0.f; }
        { bf16x8 kf[2][2];
#define ATT_LDK(p, sb) do { kf[p][0] = *(const LAS bf16x8*)(Ks + (q32 * KCH + ((2 * (sb) + hi) ^ (q32 & KM))) * 16); kf[p][1] = *(const LAS bf16x8*)(Ks + ((32 + q32) * KCH + ((2 * (sb) + hi) ^ (q32 & KM))) * 16); } while (0)
          if (PV_ != 2) {
          ATT_LDK(0, 0);
#pragma unroll
          for (int sb = 0; sb < ND; ++sb) {
              if (sb + 1 < ND) ATT_LDK((sb + 1) & 1, sb + 1);
              s0 = __builtin_amdgcn_mfma_f32_32x32x16_bf16(kf[sb & 1][0], qf[sb], s0, 0, 0, 0);
              s1 = __builtin_amdgcn_mfma_f32_32x32x16_bf16(kf[sb & 1][1], qf[sb], s1, 0, 0, 0);
              }
          }
#undef ATT_LDK
        }
        const bool msk = MASKED && a.mask_on && tt >= a.seg0_tiles;
        if (MASKED) { const int kp0 = a.kpos1 + 64 * (tt - a.seg0_tiles) + 4 * hi, qp = a.qpos0 + wid * 32 + q32;
#pragma unroll
            for (int r = 0; r < 16; ++r) { float t0 = s0[r], t1 = s1[r];
                if (msk) { const int d0 = qp - (kp0 + (r & 3) + 8 * (r >> 2)), d1 = d0 - 32; if (d0 > 128 || d0 < -128) t0 = -1e30f; if (d1 > 128 || d1 < -128) t1 = -1e30f; s0[r] = t0; s1[r] = t1; } }
            __builtin_amdgcn_sched_barrier(0); }
        float mx = -1e30f, m_new = 0.f, alpha = 1.f, ps = 0.f;
        bf16x8 pn[4] = {pa[0], pa[1], pa[2], pa[3]};
        { const ldsp_t _vt = lds + VOFF + vprev * VBUF; bf16x8 vfr[3]; vfr[2] = pa[0];
#define ATT_LDV(i) (*(const LAS bf16x8*)(_vt + ((32 * ((i) >> 2) + q32) * VST + 16 * ((i) & 3) + 8 * hi) * 2))
#define SCV(e) ((e) < 16 ? s0[(e) & 15] : s1[(e) & 15])
          vfr[0] = ATT_LDV(0); vfr[1] = ATT_LDV(1);
#pragma unroll
          for (int i = 0; i < 16; ++i) {
              if (PV_ != 3) { if (i + 2 < 16) vfr[(i + 2) % 3] = ATT_LDV(i + 2);
              o[i >> 2] = __builtin_amdgcn_mfma_f32_32x32x16_bf16(pa[i & 3], vfr[i % 3], o[i >> 2], 0, 0, 0); }
              if (PV_ == 1) {} else if (i < 4) {
#pragma unroll
                  for (int e = 0; e < 4; ++e) mx = fmaxf(mx, fmaxf(s0[4 * i + e], s1[4 * i + e]));
              } else if (i == 4) {
                  { const auto rr = __builtin_amdgcn_permlane32_swap(__float_as_uint(mx), __float_as_uint(mx), false, false);
                    mx = fmaxf(__uint_as_float(rr[0]), __uint_as_float(rr[1])); }
                  if (__all(mx - m_run <= 8.0f * LOG2E_F)) { m_new = m_run; alpha = 1.f; }
                  else { m_new = fmaxf(m_run, mx); alpha = __builtin_amdgcn_exp2f(m_run - m_new); m_run = m_new; }
              } else if (i < 13) {
#pragma unroll
                  for (int e = 0; e < 2; ++e) { const int r = 2 * (i - 5) + e; s0[r] = __builtin_amdgcn_exp2f(s0[r] - m_new); s1[r] = __builtin_amdgcn_exp2f(s1[r] - m_new); ps += s0[r] + s1[r]; }
              } else if (i == 13) {
                  u32x4 w; w.x = cvt_pk_bf16(s0[0], s0[1]); w.y = cvt_pk_bf16(s0[2], s0[3]); w.z = cvt_pk_bf16(s0[4], s0[5]); w.w = cvt_pk_bf16(s0[6], s0[7]); pn[0] = *(bf16x8*)&w;
                  u32x4 v; v.x = cvt_pk_bf16(s0[8], s0[9]); v.y = cvt_pk_bf16(s0[10], s0[11]); v.z = cvt_pk_bf16(s0[12], s0[13]); v.w = cvt_pk_bf16(s0[14], s0[15]); pn[1] = *(bf16x8*)&v;
              } else if (i == 14) {
                  u32x4 w; w.x = cvt_pk_bf16(s1[0], s1[1]); w.y = cvt_pk_bf16(s1[2], s1[3]); w.z = cvt_pk_bf16(s1[4], s1[5]); w.w = cvt_pk_bf16(s1[6], s1[7]); pn[2] = *(bf16x8*)&w;
                  u32x4 v; v.x = cvt_pk_bf16(s1[8], s1[9]); v.y = cvt_pk_bf16(s1[10], s1[11]); v.z = cvt_pk_bf16(s1[12], s1[13]); v.w = cvt_pk_bf16(s1[14], s1[15]); pn[3] = *(bf16x8*)&v;
              } else { l_run = l_run * alpha + ps; }
          }
#undef ATT_LDV
#undef SCV
        }
#pragma unroll
        for (int i = 0; i < 4; ++i) pa[i] = pn[i];
        if (__any(alpha < 1.0f)) {
            if (hi == 0) al[q32] = alpha;
            asm volatile("s_waitcnt lgkmcnt(0)" ::: "memory");
#pragma unroll
            for (int g4 = 0; g4 < 4; ++g4) { const f32x4 av = *(const LAS f32x4*)(al + 8 * g4 + 4 * hi);
#pragma unroll
                for (int db = 0; db < 4; ++db)
#pragma unroll
                    for (int j = 0; j < 4; ++j) o[db][4 * g4 + j] *= av[j]; }
        }
        if (tt + 1 < ntiles && PV_ != 4) ATT_WRITE(vnext);
        { const int t3 = vprev; vprev = vcur; vcur = vnext; vnext = t3; }
        asm volatile("s_waitcnt vmcnt(0)" ::: "memory");
        if (PV_ != 5) __syncthreads();
    }
    ATT_PV(vprev);
#undef ATT_LOAD
#undef ATT_WRITE
#undef ATT_PV
    __syncthreads();
    float l_tot; { const auto rr = __builtin_amdgcn_permlane32_swap(__float_as_uint(l_run), __float_as_uint(l_run), false, false); l_tot = __uint_as_float(rr[0]) + __uint_as_float(rr[1]); }
    if (a.has_sink) l_tot += __builtin_amdgcn_exp2f(a.sink_l2 - m_run);
    if (hi == 0) al[q32] = 1.0f / l_tot;
    asm volatile("s_waitcnt lgkmcnt(0)" ::: "memory");
    const ldsp_t Ost = lds + wid * 8192;
#pragma unroll
    for (int g4 = 0; g4 < 4; ++g4) { const f32x4 iv = *(const LAS f32x4*)(al + 8 * g4 + 4 * hi);
#pragma unroll
        for (int db = 0; db < 4; ++db)
#pragma unroll
            for (int j = 0; j < 4; ++j) *(LAS bf16_t*)(Ost + ((8 * g4 + 4 * hi + j) * 128 + 32 * db + q32) * 2) = f2bf(o[db][4 * g4 + j] * iv[j]); }
    asm volatile("s_waitcnt lgkmcnt(0)" ::: "memory");
    const int lane_o = lane_id();
#pragma unroll
    for (int i = 0; i < 8; ++i) { const int c = lane_o + 64 * i, row = c >> 4, c8 = c & 15;
        *(u32x4*)(a.O + (size_t)(wid * 32 + row) * a.ldo + 8 * c8) = *(const LAS u32x4*)(Ost + (row * 128 + 8 * c8) * 2); }
}

__device__ __forceinline__ void conv_unit(const Ctx& F, int layer, int row0  , int seq_len, int t0) {
    using namespace cf;
    const bf16_t* P = WSP(const bf16_t, WS_P); bf16_t* BR = WSP(bf16_t, WS_BR);
    const float* cw = F.in[I_CW] + (size_t)layer * 31 * 1024; const float* cb = F.in[I_CB] + layer * 1024;
    const float* lg = F.in[I_CLG] + layer * 1024; const float* lb = F.in[I_CLB] + layer * 1024;
    int tid = F.wave * 64 + lane_id(); asm volatile("" : "+v"(tid));
    const int lane = tid & 63;
    LAS float* red = (LAS float*)(F.lds + 126976); LAS float* tot = red + 8 * 32;
    __syncthreads();
    for (int c = tid; c < 62 * 128; c += 512) { const int rr = c >> 7, ch = c & 127, t = t0 - 15 + rr;
        u32x4 v = {0u, 0u, 0u, 0u};
        if (t >= 0 && t < seq_len) v = *(const u32x4*)(P + (size_t)(row0 + t) * NC + PC_GLU + ch * 8);
        *(LAS u32x4*)(F.lds + rr * 2048 + ch * 16) = v; }
    float w0[31], w1[31];
#pragma unroll
    for (int k = 0; k < 31; ++k) { const f32x2 w = *(const f32x2*)(cw + k * 1024 + 2 * tid); w0[k] = w.x; w1[k] = w.y; }
    const f32x2 bv = *(const f32x2*)(cb + 2 * tid), gg = *(const f32x2*)(lg + 2 * tid), bb = *(const f32x2*)(lb + 2 * tid);
    __syncthreads();
#pragma unroll 1
    for (int part = 0; part < 4; ++part) {
        float a0[8], a1[8];
#pragma unroll
        for (int t = 0; t < 8; ++t) { a0[t] = bv.x; a1[t] = bv.y; }
        const ldsp_t base = F.lds + part * 8 * 2048 + tid * 4;
#pragma unroll
        for (int rr = 0; rr < 38; ++rr) { const unsigned xw = *(const LAS unsigned*)(base + rr * 2048); const float x0 = bflo(xw), x1 = bfhi(xw);
#pragma unroll
            for (int t = 0; t < 8; ++t) { const int k = rr - t; if (k >= 0 && k <= 30) { a0[t] += x0 * w0[k]; a1[t] += x1 * w1[k]; } } }
        float v[16];
#pragma unroll
        for (int t = 0; t < 8; ++t) { v[t] = a0[t] + a1[t]; v[8 + t] = a0[t] * a0[t] + a1[t] * a1[t]; }
#pragma unroll
        for (int i = 0; i < 8; ++i) { const bool up = lane & 32; const float snd = up ? v[i] : v[i + 8], kp = up ? v[i + 8] : v[i]; v[i] = kp + shx(snd, 32, lane); }
#pragma unroll
        for (int i = 0; i < 4; ++i) { const bool up = lane & 16; const float snd = up ? v[i] : v[i + 4], kp = up ? v[i + 4] : v[i]; v[i] = kp + shx(snd, 16, lane); }
#pragma unroll
        for (int i = 0; i < 2; ++i) { const bool up = lane & 8; const float snd = up ? v[i] : v[i + 2], kp = up ? v[i + 2] : v[i]; v[i] = kp + shx(snd, 8, lane); }
        { const bool up = lane & 4; const float snd = up ? v[0] : v[1], kp = up ? v[1] : v[0]; v[0] = kp + shx(snd, 4, lane); }
        v[0] += shx(v[0], 2, lane); v[0] += shx(v[0], 1, lane);
        if ((lane & 3) == 0) red[F.wave * 16 + (lane >> 2)] = v[0];
        __syncthreads();
        if (tid < 16) { float s = 0.f;
#pragma unroll
            for (int w = 0; w < 8; ++w) s += red[w * 16 + tid];
            tot[tid] = s; }
        __syncthreads();
#pragma unroll
        for (int t = 0; t < 8; ++t) { const float mean = tot[t] * (1.f / 1024.f), var = fmaxf(tot[8 + t] * (1.f / 1024.f) - mean * mean, 0.f), rstd = rsqrtf(var + 1e-5f);
            const float y0 = (a0[t] - mean) * rstd * gg.x + bb.x, y1 = (a1[t] - mean) * rstd * gg.y + bb.y;
            *(unsigned*)(BR + (size_t)(row0 + t0 + part * 8 + t) * 4096 + 2048 + 2 * tid) = cvt_pk_bf16(y0 * sigmoidf_(y0), y1 * sigmoidf_(y1)); }
    }
}

__device__ __forceinline__ void attn_defaults(AttnArgs& a, int isctx) {
    a.seg0_row = 0; a.seg0_tiles = isctx ? 4 : 68; a.seg1_row = 0; a.seg1_tiles = 0; a.mask_on = 0; a.qpos0 = 0; a.kpos1 = 0; a.has_sink = 0; a.sink_l2 = 0.f; a.qss = nullptr; a.variant = 0; }
__device__ __forceinline__ void attn_unit_decode(int u, int G, bool gqa, int& b, int& h, int& qb) {
    if (G != 256) { b = u >> 7; h = (u >> 4) & 7; qb = u & 15; return; }
    const int bid = u & 255, r = u >> 8, x = bid & 7, local = (bid >> 3) + 32 * r;
    qb = local & 15;
    if (gqa) { b = x >> 1; h = (x & 1) * 4 + (local >> 4); }
    else { const int pair = x * 4 + (local >> 4); b = pair >> 3; h = pair & 7; }
}
__device__ __forceinline__ void ph_attn(const Ctx& F0, int layer) {
    const Ctx F = phase_ctx(F0);
    using namespace cf;
    const bf16_t* P = WSP(const bf16_t, WS_P); bf16_t* BR = WSP(bf16_t, WS_BR);
    for (int dup = 0; dup < DUPN(2); ++dup)
    for (int u = F.bid; u < (layer == 0 ? 544 : 512); u += F.G) {
        int b, h, qb, isctx = 0;
        if (u < 512) attn_unit_decode(u, F.G, false, b, h, qb); else { const int r = u - 512; b = r >> 3; h = r & 7; qb = 0; isctx = 1; }
        const size_t brow = (size_t)b * RB, qrow = brow + (isctx ? 0 : CTX) + (size_t)qb * 256;
        AttnArgs a; attn_defaults(a, isctx);
        a.Q = WSP(const bf16_t, WS_QB) + qrow * 1536 + h * 192; a.ldq = 1536;
        a.K = WSP(const bf16_t, WS_KB) + brow * 1536 + h * 192; a.ldk = 1536;
        a.V = WSP(const bf16_t, WS_VB) + brow * 1024 + h * 128; a.ldv = 1024;
        a.O = BR + qrow * 4096 + 1024 + h * 128; a.ldo = 4096; a.sc_log2 = SCALE_MLA * LOG2E;
        __syncthreads();
        attn_unit<192, false>(F.lds, a, F.wave);
    }
    for (int dup = 0; dup < DUPN(3); ++dup)
    for (int u0 = F.bid; u0 < (layer == 0 ? 544 : 512); u0 += F.G) {
        int b, h, qb, isctx = 0;
        if (u0 < 512) attn_unit_decode(u0, F.G, true, b, h, qb); else { const int r = u0 - 512; b = r >> 3; h = r & 7; qb = 0; isctx = 1; }
        const size_t brow = (size_t)b * RB, qrow = brow + (isctx ? 0 : CTX) + (size_t)qb * 256;
        AttnArgs a; attn_defaults(a, isctx);
        a.Q = P + qrow * NC + PC_AQ + h * 128; a.ldq = NC;
        a.K = P + brow * NC + PC_AK + (h >> 2) * 128; a.ldk = NC;
        a.V = P + brow * NC + PC_AV + (h >> 2) * 128; a.ldv = NC;
        a.O = BR + qrow * 4096 + h * 128; a.ldo = 4096; a.sc_log2 = SCALE_HD * LOG2E;
        a.qss = WSP(const float, WS_SSQ) + qrow * 16 + h * 2;
        if (MK_AV && dup == 1) { a.variant = MK_AV; a.O = WSP(bf16_t, WS_HB) + qrow * 2048 + h * 128; a.ldo = 2048; }
        __syncthreads();
        attn_unit<128, false>(F.lds, a, F.wave);
    }
    for (int dup = 0; dup < DUPN(13); ++dup)
    for (int u0 = F.bid; u0 < (layer == 0 ? 544 : 512); u0 += F.G) {
        int b, h, qb, isctx = 0;
        if (u0 < 512) attn_unit_decode(u0, F.G, true, b, h, qb); else { const int r = u0 - 512; b = r >> 3; h = r & 7; qb = 0; isctx = 1; }
        const size_t brow = (size_t)b * RB, qrow = brow + (isctx ? 0 : CTX) + (size_t)qb * 256;
        AttnArgs a; attn_defaults(a, isctx);
        a.Q = P + qrow * NC + PC_DQ + h * 128; a.ldq = NC;
        a.K = P + brow * NC + PC_DK + (h >> 2) * 128; a.ldk = NC;
        a.V = P + brow * NC + PC_DV + (h >> 2) * 128; a.ldv = NC;
        a.O = BR + qrow * 4096 + 3072 + h * 128; a.ldo = 4096; a.sc_log2 = SCALE_HD * LOG2E;
        a.has_sink = 1; a.sink_l2 = F.in[I_SINK][layer * 8 + h] * LOG2E; a.seg0_tiles = 4;
        if (!isctx) { const int start = qb * 256; const int lo = start - 128 < 0 ? 0 : start - 128, hi = start + 384 > S ? S : start + 384;
            a.seg1_row = CTX + lo; a.seg1_tiles = (hi - lo) / 64; a.mask_on = 1; a.qpos0 = start; a.kpos1 = lo; }
        __syncthreads();
        attn_unit<128, true>(F.lds, a, F.wave);
    }
    for (int dup = 0; dup < DUPN(4); ++dup)
    for (int u = F.bid; u < (layer == 0 ? 544 : 512); u += F.G) {
        int b, tb, isctx = 0;
        if (u < 512) { b = u >> 7; tb = u & 127; } else { const int r = u - 512; b = r >> 3; tb = r & 7; isctx = 1; }
        conv_unit(F, layer, b * RB + (isctx ? 0 : CTX), isctx ? CTX : S, tb * 32);
    }
}

__device__ __forceinline__ int tok_row(int layer, int tok) { return layer == 0 ? tok : (tok >> 12) * cf::RB + cf::CTX + (tok & 4095); }
__device__ __forceinline__ void ph_ln1(const Ctx& F0, int layer) {
    const Ctx F = phase_ctx(F0);
    using namespace cf;
    float* X1 = (float*)(F.ws + WS_P + X1_OFF); bf16_t* HB = WSP(bf16_t, WS_HB);
    const float* lg = F.in[I_LN1G] + layer * 2048; const float* lb = F.in[I_LN1B] + layer * 2048;
    const int ntok = layer == 0 ? MR : NB * S, lane = F.lane;
    for (int tok = F.bid * 8 + F.wave; tok < ntok; tok += F.G * 8) {
        const int R = tok_row(layer, tok), b = R / RB, j = R % RB;
        const float* mod = WSP(const float, WS_MOD) + ((size_t)layer * 5 + (j < CTX ? 4 : b)) * 12288;
        float* xp = X1 + (size_t)R * 2048;
        f32x4 v[8]; float s = 0.f;
#pragma unroll
        for (int i = 0; i < 8; ++i) { v[i] = *(const f32x4*)(xp + lane * 4 + 256 * i); s += (v[i][0] + v[i][1]) + (v[i][2] + v[i][3]); }
        const float mean = wave_sum(s, lane) * (1.f / 2048.f); float q = 0.f;
#pragma unroll
        for (int i = 0; i < 8; ++i) { const f32x4 d = v[i] - mean; q += (d[0] * d[0] + d[1] * d[1]) + (d[2] * d[2] + d[3] * d[3]); }
        const float rstd = rsqrtf(wave_sum(q, lane) * (1.f / 2048.f) + 1e-5f);
#pragma unroll
        for (int i = 0; i < 8; ++i) { const int c = lane * 4 + 256 * i;
            const f32x4 y = (v[i] - mean) * rstd * *(const f32x4*)(lg + c) + *(const f32x4*)(lb + c);
            *(f32x4*)(xp + c) = y;
            const f32x4 hp = y * (*(const f32x4*)(mod + 4 * 2048 + c) + 1.0f) + *(const f32x4*)(mod + 3 * 2048 + c);
            u32x2 w; w.x = cvt_pk_bf16(hp[0], hp[1]); w.y = cvt_pk_bf16(hp[2], hp[3]);
            *(u32x2*)(HB + (size_t)R * 2048 + c) = w; }
    }
}

typedef __bf16 bf16x2_t __attribute__((ext_vector_type(2)));
__device__ __forceinline__ unsigned ordkey(float v) { const unsigned u = __float_as_uint(v); return (u & 0x80000000u) ? ~u : (u | 0x80000000u); }
__device__ __forceinline__ int lane_rank(unsigned long long m) { return (int)__builtin_amdgcn_mbcnt_hi((unsigned)(m >> 32), __builtin_amdgcn_mbcnt_lo((unsigned)m, 0u)); }
template <int NV> __device__ __forceinline__ unsigned radix_thresh16(const unsigned (&k)[NV]) {
    unsigned T = 0u;
    for (int bit = 31; bit >= 0; --bit) { const unsigned cand = T | (1u << bit); int cnt = 0;
#pragma unroll
        for (int v = 0; v < NV; ++v) cnt += __popcll(__ballot(k[v] >= cand));
        if (cnt >= 16) { T = cand; if (cnt == 16) break; } }
    return T;
}
__device__ __forceinline__ void radix_thresh16x2(const unsigned (&ka)[2], const unsigned (&kb)[2], unsigned& Ta, unsigned& Tb) {
    unsigned T0 = 0u, T1 = 0u; bool d0 = false, d1 = false;
    for (int bit = 31; bit >= 0; --bit) { const unsigned c0 = T0 | (1u << bit), c1 = T1 | (1u << bit);
        const int n0 = __popcll(__ballot(ka[0] >= c0)) + __popcll(__ballot(ka[1] >= c0)), n1 = __popcll(__ballot(kb[0] >= c1)) + __popcll(__ballot(kb[1] >= c1));
        if (!d0 && n0 >= 16) { T0 = c0; d0 = n0 == 16; }
        if (!d1 && n1 >= 16) { T1 = c1; d1 = n1 == 16; }
        if (d0 && d1) break; }
    Ta = T0; Tb = T1;
}
__device__ __forceinline__ float dot2bf(unsigned a, unsigned b, float acc) { return __builtin_amdgcn_fdot2_f32_bf16(__builtin_bit_cast(bf16x2_t, a), __builtin_bit_cast(bf16x2_t, b), acc, false); }
__device__ __forceinline__ float dot8(const u32x4 a, const u32x4 b, float acc) {
    acc = dot2bf(a.x, b.x, acc); acc = dot2bf(a.y, b.y, acc); acc = dot2bf(a.z, b.z, acc); acc = dot2bf(a.w, b.w, acc);
    return acc;
}
__device__ __forceinline__ float gelu_as(float v) {
    const float av = fabsf(v), t = __builtin_amdgcn_rcpf(av * 0.2316418882f + 1.0f);
    float q = t * 0.5307027145f + (-0.7265760135f); q = q * t + 0.7107068705f; q = q * t + (-0.142248368f); q = q * t + 0.127414796f; q = q * t;
    const float e = __builtin_amdgcn_exp2f((v * v) * (-0.72134752044f)), m = v * (q * e);
    return v < 0.f ? m : v - m;
}
__device__ __forceinline__ void peer_load(u32x4 (&ur)[4], u32x4 (&vr)[4], unsigned (&vs)[4], float (&gq)[4], const LAS int* ei, const LAS float* eg,
                                          const unsigned char* UV, int lane, int grp) {
#pragma unroll
    for (int q = 0; q < 4; ++q) { const int id = __builtin_amdgcn_readfirstlane(ei[grp * 4 + q]); gq[q] = __uint_as_float(__builtin_amdgcn_readfirstlane(__float_as_uint(eg[grp * 4 + q])));
        const unsigned char* row = UV + (size_t)id * UV_ROW;
        ur[q] = *(const u32x4*)(row + lane * 16); vr[q] = *(const u32x4*)(row + 1024 + lane * 16); vs[q] = *(const unsigned short*)(row + 2048 + 2 * lane); }
}
__device__ __forceinline__ void peer_comp(const u32x4 (&ur)[4], const u32x4 (&vr)[4], const unsigned (&vs)[4], const float (&gq)[4], const f32x2 (&xf)[16], f32x2 (&y2)[16], int lane) {
    float d[4];
#pragma unroll
    for (int q = 0; q < 4; ++q) { f32x2 t = {0.f, 0.f};
#pragma unroll
        for (int j = 0; j < 4; ++j) { const unsigned uw = ur[q][j];
            t += __builtin_amdgcn_cvt_scalef32_pk_f32_fp4(uw, 1.0f, 0) * xf[4 * j + 0]; t += __builtin_amdgcn_cvt_scalef32_pk_f32_fp4(uw, 1.0f, 1) * xf[4 * j + 1];
            t += __builtin_amdgcn_cvt_scalef32_pk_f32_fp4(uw, 1.0f, 2) * xf[4 * j + 2]; t += __builtin_amdgcn_cvt_scalef32_pk_f32_fp4(uw, 1.0f, 3) * xf[4 * j + 3]; }
        d[q] = (t.x + t.y) * uv_scale(vs[q] & 255u); }
#pragma unroll
    for (int o = 32; o >= 1; o >>= 1) {
#pragma unroll
        for (int q = 0; q < 4; ++q) d[q] += shx(d[q], o, lane); }
#pragma unroll
    for (int q = 0; q < 4; ++q) { const float w = gq[q] * gelu_as(d[q]) * uv_scale(vs[q] >> 8);
        const f32x2 w2 = {w, w};
#pragma unroll
        for (int j = 0; j < 4; ++j) { const unsigned vw = vr[q][j];
            y2[4 * j + 0] += w2 * __builtin_amdgcn_cvt_scalef32_pk_f32_fp4(vw, 1.0f, 0); y2[4 * j + 1] += w2 * __builtin_amdgcn_cvt_scalef32_pk_f32_fp4(vw, 1.0f, 1);
            y2[4 * j + 2] += w2 * __builtin_amdgcn_cvt_scalef32_pk_f32_fp4(vw, 1.0f, 2); y2[4 * j + 3] += w2 * __builtin_amdgcn_cvt_scalef32_pk_f32_fp4(vw, 1.0f, 3); } }
}
__device__ __forceinline__ unsigned inv_ordkey(unsigned k) { return (k & 0x80000000u) ? (k & 0x7fffffffu) : ~k; }
template <int B> __device__ __forceinline__ void bit_transpose32(unsigned (&A)[64]) {
#pragma unroll
    for (int k = 0; k < 16; ++k) { const unsigned a = A[B + k], b = A[B + k + 16]; A[B + k] = __builtin_amdgcn_perm(b, a, 0x05040100u); A[B + k + 16] = __builtin_amdgcn_perm(b, a, 0x07060302u); }
#pragma unroll
    for (int k = 0; k < 32; ++k) if (!(k & 8)) { const unsigned a = A[B + k], b = A[B + k + 8]; A[B + k] = __builtin_amdgcn_perm(b, a, 0x06020400u); A[B + k + 8] = __builtin_amdgcn_perm(b, a, 0x07030501u); }
#pragma unroll
    for (int k = 0; k < 32; ++k) if (!(k & 4)) { const unsigned a = A[B + k], b = A[B + k + 4]; A[B + k] = (a & 0x0F0F0F0Fu) | ((b << 4) & 0xF0F0F0F0u); A[B + k + 4] = ((a >> 4) & 0x0F0F0F0Fu) | (b & 0xF0F0F0F0u); }
#pragma unroll
    for (int k = 0; k < 32; ++k) if (!(k & 2)) { const unsigned a = A[B + k], b = A[B + k + 2]; A[B + k] = (a & 0x33333333u) | ((b << 2) & 0xCCCCCCCCu); A[B + k + 2] = ((a >> 2) & 0x33333333u) | (b & 0xCCCCCCCCu); }
#pragma unroll
    for (int k = 0; k < 32; ++k) if (!(k & 1)) { const unsigned a = A[B + k], b = A[B + k + 1]; A[B + k] = (a & 0x55555555u) | ((b << 1) & 0xAAAAAAAAu); A[B + k + 1] = ((a >> 1) & 0x55555555u) | (b & 0xAAAAAAAAu); }
}
template <int GRP> __device__ __forceinline__ unsigned lane_radix16(const unsigned (&key)[64], int lane, int& own) {
    unsigned P[64];
#pragma unroll
    for (int n = 0; n < 64; ++n) P[n] = key[n];
    bit_transpose32<0>(P); bit_transpose32<32>(P);
    unsigned T = 0u, act_lo = ~0u, act_hi = ~0u; int above = 0; bool done = false;
#pragma unroll
    for (int bit = 31; bit >= 0; --bit) {
        const unsigned m_lo = act_lo & P[bit], m_hi = act_hi & P[32 + bit];
        const int mine = above + __builtin_popcount(m_lo) + __builtin_popcount(m_hi);
        int tot = mine + __builtin_amdgcn_ds_bpermute((lane ^ 1) << 2, mine);
        if (GRP >= 4) tot += __builtin_amdgcn_ds_bpermute((lane ^ 2) << 2, tot);
        const bool ge = tot >= 16;
        if (ge && !done) T |= 1u << bit;
        act_lo = ge ? m_lo : act_lo & ~m_lo; act_hi = ge ? m_hi : act_hi & ~m_hi;
        above = ge ? above : mine;
        if (tot == 16) { above = mine; act_lo = 0u; act_hi = 0u; done = true; }
        if (__all(done)) break; }
    own = above + __builtin_popcount(act_lo) + __builtin_popcount(act_hi);
    return T;
}
template <int N> __device__ __forceinline__ void compact_ge(const unsigned (&key)[N], unsigned T, int pos, unsigned base, unsigned dump) {
#pragma unroll
    for (int n = 0; n < N; n += 2) { unsigned long long m0, m1; unsigned a0, a1;
        asm("v_cmp_ge_u32_e64 %3, %5, %7\n\tv_cmp_ge_u32_e64 %4, %6, %7\n\tv_lshl_add_u32 %1, %0, 2, %8\n\tv_cndmask_b32_e64 %1, %9, %1, %3\n\tv_addc_co_u32_e64 %0, vcc, 0, %0, %3\n\t"
            "v_lshl_add_u32 %2, %0, 2, %8\n\tv_cndmask_b32_e64 %2, %9, %2, %4\n\tv_addc_co_u32_e64 %0, vcc, 0, %0, %4"
            : "+v"(pos), "=&v"(a0), "=&v"(a1), "=&s"(m0), "=&s"(m1) : "v"(key[n]), "v"(key[n + 1]), "v"(T), "v"(base), "v"(dump) : "vcc");
        *(LAS unsigned*)(size_t)a0 = key[n]; *(LAS unsigned*)(size_t)a1 = key[n + 1]; }
}
template <int MODE> __device__ __forceinline__ void ph_peer(const Ctx& F0, int layer) {
    const Ctx F = phase_ctx(F0);
    using namespace cf;
    const float* SC = (const float*)(F.ws + WS_P + SC_OFF); const float* X1 = (const float*)(F.ws + WS_P + X1_OFF);
    bf16_t* HB = WSP(bf16_t, WS_HB); const unsigned char* UV = WSP(const unsigned char, WS_UB) + (size_t)layer * NEXP * UV_ROW;
    const float* lg = F.in[I_LN2G] + layer * 2048; const float* lb = F.in[I_LN2B] + layer * 2048;
    const int ntok = layer == 0 ? MR : NB * S;
    constexpr int NSLOT = 34;
    ldsp_t ring = F.lds;
#ifndef NPROD
#define NPROD 2
#endif
    const int pw = F.wave - (8 - NPROD);
    ldsp_t pscr = F.lds + 73728 + (pw < 0 ? 0 : pw) * 6144;
    LAS unsigned* lstA = (LAS unsigned*)(pscr);
    LAS unsigned* lstB = (LAS unsigned*)(pscr + 2176);
    LAS unsigned* dmp = (LAS unsigned*)(pscr + 3200);
    volatile LAS unsigned* ready = (volatile LAS unsigned*)(F.lds + 71680); LAS unsigned* next_tok = (LAS unsigned*)(F.lds + 71680 + NSLOT * 4);
    __syncthreads();
    if (F.tid < NSLOT + 1) ((LAS unsigned*)(F.lds + 71680))[F.tid] = 0u;
    __syncthreads();
    const int ntw = ntok / F.G;
    if (pw >= 0) {
      for (int p = pw; p < ntw / 2; p += NPROD) {
        const int slot = p;
        LAS int* ei4 = (LAS int*)(ring + slot * 2048); LAS float* eg4 = (LAS float*)(ring + slot * 2048 + 512);
        const int tok0 = F.bid + (2 * p) * F.G, nwv = F.G;
        if (MODE != 2) {
        { int lane = F.lane; asm volatile("" : "+v"(lane));
          const int t2 = lane >> 5, set = lane >> 1, sset = set & 15, part = lane & 1;
          const int Rl = tok_row(layer, tok0 + t2 * nwv);
          unsigned key[64];
          const float* sp = SC + (size_t)Rl * 2048 + sset * 128 + part * 64;
#pragma unroll
          for (int i = 0; i < 16; ++i) { const f32x4 v = *(const f32x4*)(sp + 4 * i);
#pragma unroll
              for (int e = 0; e < 4; ++e) key[4 * i + e] = (ordkey(v[e]) & ~127u) | (unsigned)(127 - (64 * part + 4 * i + e)); }
          int own; const unsigned T = lane_radix16<2>(key, lane, own);
          const int oth = __builtin_amdgcn_ds_bpermute((lane ^ 1) << 2, own);
          compact_ge<64>(key, T, part ? oth : 0, (unsigned)(size_t)lstA + set * 68, (unsigned)(size_t)dmp + lane * 4);
        }
        asm volatile("s_waitcnt lgkmcnt(0)" ::: "memory");
        {
          int lane = F.lane; asm volatile("" : "+v"(lane));
          const int q = lane & 3, sa = (lane >> 2) * 2, sb = sa + 1;
          float Av[4], Bv[16];
#pragma unroll
          for (int i = 0; i < 4; ++i) Av[i] = __uint_as_float(inv_ordkey((lstA[sa * 17 + 4 * q + i] & ~127u) | 64u));
#pragma unroll
          for (int jx = 0; jx < 16; ++jx) Bv[jx] = __uint_as_float(inv_ordkey((lstA[sb * 17 + jx] & ~127u) | 64u));
          unsigned key[64];
#pragma unroll
          for (int i = 0; i < 4; ++i)
#pragma unroll
              for (int jx = 0; jx < 16; ++jx) key[i * 16 + jx] = (ordkey(Av[i] + Bv[jx]) & ~255u) | (unsigned)(255 - ((4 * q + i) * 16 + jx));
          int mine; const unsigned T = lane_radix16<4>(key, lane, mine);
          const int c1 = __builtin_amdgcn_ds_bpermute((lane ^ 1) << 2, mine), c2 = __builtin_amdgcn_ds_bpermute((lane ^ 2) << 2, mine), c3 = __builtin_amdgcn_ds_bpermute((lane ^ 3) << 2, mine);
          const int c = (q == 1) ? c1 : (q == 2) ? c2 + c3 : (q == 3) ? c1 + c2 + c3 : 0;
          compact_ge<64>(key, T, c, (unsigned)(size_t)lstB + (lane >> 2) * 64, (unsigned)(size_t)dmp + lane * 4);
        }
        asm volatile("s_waitcnt lgkmcnt(0)" ::: "memory");
        { int lane = F.lane; asm volatile("" : "+v"(lane));
#pragma unroll
        for (int rnd = 0; rnd < 4; ++rnd) { const int e = lane + 64 * rnd; const unsigned kk = lstB[e];
            const int cidx = (int)(~kk & 255u), sa = (e >> 4) * 2;
            const unsigned ka = lstA[sa * 17 + (cidx >> 4)], kb = lstA[(sa + 1) * 17 + (cidx & 15)];
            const float sv = __uint_as_float(inv_ordkey((ka & ~127u) | 64u)) + __uint_as_float(inv_ordkey((kb & ~127u) | 64u));
            float m = sv; m = fmaxf(m, shx(m, 1, lane)); m = fmaxf(m, shx(m, 2, lane)); m = fmaxf(m, shx(m, 4, lane)); m = fmaxf(m, shx(m, 8, lane));
            const float ex = __expf(sv - m); float sum = ex; sum += shx(sum, 1, lane); sum += shx(sum, 2, lane); sum += shx(sum, 4, lane); sum += shx(sum, 8, lane);
            ei4[(e >> 7) * 256 + (e & 127)] = (int)((~ka & 127u) * 128u + (~kb & 127u));
            eg4[(e >> 7) * 256 + (e & 127)] = ex / sum; } }
        }
        asm volatile("s_waitcnt lgkmcnt(0)" ::: "memory");
        if (F.lane == 0) ready[slot] = (unsigned)(p + 1);
      }
    }
    {
      for (;;) {
        unsigned tq = 0u; if (F.lane == 0) tq = __hip_atomic_fetch_add(next_tok, 1u, __ATOMIC_RELAXED, __HIP_MEMORY_SCOPE_WORKGROUP);
        const int t = __builtin_amdgcn_readfirstlane((int)tq);
        if (t >= ntw) break;
        const int p = t >> 1, slot = p, tslot = t & 1;
        while (ready[slot] < (unsigned)(p + 1)) __builtin_amdgcn_s_sleep(2);
        asm volatile("" ::: "memory");
        if (MODE == 1) continue;
        int zst = 0; if (MODE == 2) asm volatile("" : "+s"(zst));
        const int tok = F.bid + t * F.G;
        int lane = F.lane; asm volatile("" : "+v"(lane));
        const int R = tok_row(layer, tok), b = R / RB, j = R % RB; const bool isctx = j < CTX; const int modrow = isctx ? 4 : b;
        const LAS int* ei = (const LAS int*)(ring + slot * 2048 + tslot * 1024); const LAS float* eg = (const LAS float*)(ring + slot * 2048 + tslot * 1024 + 512);
        f32x2 xf[16];
#pragma unroll
        for (int k = 0; k < 4; ++k) { const u32x4 w = *(const u32x4*)(HB + (size_t)R * 2048 + lane * 32 + 8 * k);
            xf[4 * k + 0] = (f32x2){bflo(w.x), bfhi(w.x)}; xf[4 * k + 1] = (f32x2){bflo(w.y), bfhi(w.y)};
            xf[4 * k + 2] = (f32x2){bflo(w.z), bfhi(w.z)}; xf[4 * k + 3] = (f32x2){bflo(w.w), bfhi(w.w)}; }
        f32x2 y2[16];
#pragma unroll
        for (int i = 0; i < 16; ++i) y2[i] = (f32x2){0.f, 0.f};
        f32x4 xrow[8];
#pragma unroll
        for (int k = 0; k < 8; ++k) xrow[k] = *(const f32x4*)(X1 + (size_t)R * 2048 + lane * 32 + 4 * k);
        { u32x4 urA[4], vrA[4], urB[4], vrB[4]; unsigned vsA[4], vsB[4]; float gqA[4], gqB[4];
          peer_load(urA, vrA, vsA, gqA, ei, eg, UV, lane, 0);
          for (int grp = 0; grp < 32; grp += 2) {
              peer_load(urB, vrB, vsB, gqB, ei, eg, UV, lane, grp + 1);
              peer_comp(urA, vrA, vsA, gqA, xf, y2, lane);
              peer_load(urA, vrA, vsA, gqA, ei, eg, UV, lane, grp + 2 < 32 ? grp + 2 : 31);
              peer_comp(urB, vrB, vsB, gqB, xf, y2, lane);
          } }
        const float* mod = WSP(const float, WS_MOD) + ((size_t)layer * 5 + modrow) * 12288;
        float y[32];
        float s = 0.f;
#pragma unroll
        for (int k = 0; k < 8; ++k) { const int c = lane * 32 + 4 * k;
            const f32x4 xa = xrow[k], ga = *(const f32x4*)(mod + 5 * 2048 + c);
            y[4 * k + 0] = ALPHA * xa[0] + ga[0] * y2[2 * k].x; y[4 * k + 1] = ALPHA * xa[1] + ga[1] * y2[2 * k].y;
            y[4 * k + 2] = ALPHA * xa[2] + ga[2] * y2[2 * k + 1].x; y[4 * k + 3] = ALPHA * xa[3] + ga[3] * y2[2 * k + 1].y;
            s += (y[4 * k + 0] + y[4 * k + 1]) + (y[4 * k + 2] + y[4 * k + 3]); }
        const float mean = wave_sum(s, lane) * (1.f / 2048.f); float q2 = 0.f;
#pragma unroll
        for (int i = 0; i < 32; ++i) { const float dd = y[i] - mean; q2 += dd * dd; }
        const float rstd = rsqrtf(wave_sum(q2, lane) * (1.f / 2048.f) + 1e-5f);
        if (MODE == 2 && zst == 0) continue;
        float* dst = layer == 0 ? (isctx ? WSP(float, WS_XC) + ((size_t)b * CTX + j) * 2048 : F.out + ((size_t)b * S + (j - CTX)) * 2048) : F.out + ((size_t)b * S + (j - CTX)) * 2048;
        const float* modn = WSP(const float, WS_MOD) + ((size_t)1 * 5 + modrow) * 12288;
#pragma unroll
        for (int kk = 0; kk < 4; ++kk) { f32x4 o[2];
#pragma unroll
            for (int jj = 0; jj < 2; ++jj) { const int k = 2 * kk + jj, c = lane * 32 + 4 * k; const f32x4 la = *(const f32x4*)(lg + c), ba = *(const f32x4*)(lb + c);
#pragma unroll
                for (int e = 0; e < 4; ++e) o[jj][e] = (y[4 * k + e] - mean) * rstd * la[e] + ba[e];
                *(f32x4*)(dst + c) = o[jj]; }
            if (layer == 0) {
                const int c = lane * 32 + 8 * kk;
                const f32x4 sa = *(const f32x4*)(modn + 2048 + c), sb = *(const f32x4*)(modn + 2048 + c + 4), ha = *(const f32x4*)(modn + c), hb = *(const f32x4*)(modn + c + 4);
                *(u32x4*)(HB + (size_t)R * 2048 + c) = pg8::pack8(o[0] * (sa + 1.0f) + ha, o[1] * (sb + 1.0f) + hb); } }
      }
    }
}

struct Params { const float* in[cf::N_IN]; float* out; unsigned char* ws; int ph_lo, ph_hi; };

__global__ void __launch_bounds__(512, 2) mega_fwd(Params p) {
    using namespace cf;
    extern __shared__ __attribute__((aligned(16))) unsigned char smem[];
    Ctx F0;
    F0.in = p.in;
    F0.out = p.out; F0.ws = p.ws; F0.lds = (ldsp_t)smem;
    F0.tid = 0; F0.lane = 0; F0.wave = __builtin_amdgcn_readfirstlane(threadIdx.x >> 6); F0.G = gridDim.x; F0.bid = blockIdx.x;
    if (threadIdx.x < 64) ((LAS unsigned*)(F0.lds + MISC_OFF))[threadIdx.x] = 0u;
    __syncthreads();
    const int lo = p.ph_lo, hi = p.ph_hi;
    XcdBarrier bar; bar.bar = (unsigned*)(F0.ws + WS_CTL); bar.x = 0; bar.st = (volatile LAS unsigned*)(F0.lds + MISC_OFF); bar.wave = F0.wave;
    if (hi - lo > 1) bar = xcd_barrier_post((unsigned*)(F0.ws + WS_CTL), (volatile LAS unsigned*)(F0.lds + MISC_OFF), F0.wave);
#ifndef MK_MASK
#define MK_MASK 0xFFFF
#endif
#define ON(j) ((MK_MASK >> (j)) & 1)
#define IN(k) (lo <= (k) && (k) < hi)
#define SEAM(k) do { if (IN(k) && IN((k) + 1)) xcd_barrier(bar); } while (0)

    if (ON(9) && IN(0)) { ph_prologue(F0); if (DUPN(9) == 2) { __syncthreads(); ph_prologue(F0); } }
    SEAM(0);
    if (ON(10) && IN(1)) ph_modulate0(F0);
    SEAM(1);
    for (int l = 0; l < DEPTH; ++l) {
        const int pb = 2 + 8 * l;
        const int rmode = l == 0 ? 0 : 1, nMl = l == 0 ? 68 : 64;
        for (int blk = 0; blk < DUPN(12); ++blk) {
        if (blk) xcd_barrier(bar);
        if (ON(0) && IN(pb + 0)) { const Ctx F = phase_ctx(F0);
            pg8::Gemm g{WSP(const bf16_t, WS_HB), WSP(const bf16_t, WS_WIN) + (size_t)l * NC * 2048, 2048, 2048};
            pg8::EpiInProj E{WSP(bf16_t, WS_P), WSP(bf16_t, WS_KB), WSP(const float, WS_COSH), WSP(const float, WS_SINH), WSP(const float, WS_COSR), WSP(const float, WS_SINR),
                             F.in[I_AKN] + l * 128, F.in[I_AQN] + l * 128, WSP(float, WS_SSK), WSP(float, WS_SSQ), WSP(float, WS_SSKV), WSP(float, WS_SSCQ)};
            pg8::TileOrder S; S.init(nMl, 56, F.G, F.bid, rmode);
            for (int dup = 0; dup < DUPN(0); ++dup) {
#ifdef MK_PITCH
            if (DUPN(0) == 2 && dup == 0) { pg8::Gemm g2 = g; g2.lda = MK_PITCH; g2.ldb = MK_PITCH; pg8::gemm_phase(F.lds, g2, S, E, F.wave); continue; }
#endif
            pg8::gemm_phase(F.lds, g, S, E, F.wave); }
            if (l > 0) { pg8::TileOrder S2; S2.init(4, 6, F.G, F.bid, 2); pg8::gemm_phase(F.lds, g, S2, E, F.wave); }
        }
        SEAM(pb + 0);
        if (ON(2) && IN(pb + 1)) { const Ctx F = phase_ctx(F0); bf16_t* P = WSP(bf16_t, WS_P);
            knorm_pass(F);
            { pg8::Gemm g{P + PC_CKV, WSP(const bf16_t, WS_WKVUP) + (size_t)l * 2048 * 256, NC, 256}; pg8::EpiKvUp E{WSP(bf16_t, WS_KB), WSP(bf16_t, WS_VB), WSP(const float, WS_SSKV)};
              pg8::TileOrder S; S.init(68, 8, F.G, F.bid, 0); for (int dup = 0; dup < DUPN(1); ++dup) pg8::gemm_phase(F.lds, g, S, E, F.wave); }
            { pg8::Gemm g{P + PC_CQ, WSP(const bf16_t, WS_WQUP) + (size_t)l * 1536 * 512, NC, 512}; pg8::EpiQUp E{WSP(bf16_t, WS_QB), WSP(const float, WS_COSR), WSP(const float, WS_SINR), WSP(const float, WS_SSCQ)};
              pg8::TileOrder S; S.init(nMl, 6, F.G, F.bid, rmode); for (int dup = 0; dup < DUPN(1); ++dup) pg8::gemm_phase(F.lds, g, S, E, F.wave); }
        }
        SEAM(pb + 1);
        if (ON(3) && IN(pb + 2)) ph_attn(F0, l);
        }
        SEAM(pb + 2);
        if (ON(4) && IN(pb + 3)) { const Ctx F = phase_ctx(F0); bf16_t* P = WSP(bf16_t, WS_P); bf16_t* HB = WSP(bf16_t, WS_HB);
            pg8::Gemm g{WSP(const bf16_t, WS_BR), WSP(const bf16_t, WS_WBR) + (size_t)l * 4 * 2048 * 1024, 4096, 1024};
            pg8::EpiMerge E{HB, P + PC_GATE, NC};
            pg8::TileOrder S; S.init(nMl, 8, F.G, F.bid, rmode, 4, (size_t)1024 * 2, (size_t)2048 * 1024 * 2);
            for (int dup = 0; dup < DUPN(5); ++dup) pg8::gemm_phase(F.lds, g, S, E, F.wave);
        }
        SEAM(pb + 3);
        if (ON(5) && IN(pb + 4)) { const Ctx F = phase_ctx(F0); bf16_t* HB = WSP(bf16_t, WS_HB);
            pg8::Gemm g{HB, WSP(const bf16_t, WS_WO) + (size_t)l * 2048 * 2048, 2048, 2048};
            pg8::EpiWo E{(float*)(F.ws + WS_P + X1_OFF), WSP(const float, WS_MOD) + (size_t)l * 5 * 12288, l == 0 ? F.in[I_X] : (const float*)F.out, F.in[I_CTX]};
            pg8::TileOrder S; S.init(nMl, 8, F.G, F.bid, rmode); for (int dup = 0; dup < DUPN(6); ++dup) pg8::gemm_phase(F.lds, g, S, E, F.wave);
        }
        SEAM(pb + 4);
        if (ON(6) && IN(pb + 5)) ph_ln1(F0, l);
        SEAM(pb + 5);
        if (ON(7) && IN(pb + 6)) { const Ctx F = phase_ctx(F0); bf16_t* HB = WSP(bf16_t, WS_HB);
            pg8::Gemm g{HB, WSP(const bf16_t, WS_WFOLD) + (size_t)l * 2048 * 2048, 2048, 2048}; pg8::EpiF32 E{(float*)(F.ws + WS_P + SC_OFF), 2048};
            pg8::TileOrder S; S.init(nMl, 8, F.G, F.bid, rmode); for (int dup = 0; dup < DUPN(7); ++dup) pg8::gemm_phase(F.lds, g, S, E, F.wave);
        }
        SEAM(pb + 6);
        if (ON(8) && IN(pb + 7)) { ph_peer<0>(F0, l); if (DUPN(8) == 2 && l == 1) ph_peer<MK_PV>(F0, l); }
        SEAM(pb + 7);
    }
#undef IN
#undef SEAM
}

extern "C" void kernel_launch(void* const* d_in, const int* in_sizes, int n_in, void* d_out, int out_size, void* d_ws, size_t ws_size, hipStream_t stream) {
    static int grid = 0;
    if (grid == 0) {
        if (n_in != cf::N_IN || out_size != cf::NB * cf::S * cf::D || ws_size < cf::WS_END) {
            fprintf(stderr, "kernel_launch: unexpected shapes: n_in %d out %d ws %zu (need %zu)\n", n_in, out_size, ws_size, (size_t)cf::WS_END); grid = -1; return; }
        int dev = 0, cus = 0;
        if (hipGetDevice(&dev) != hipSuccess || hipDeviceGetAttribute(&cus, hipDeviceAttributeMultiprocessorCount, dev) != hipSuccess || cus < 1) { grid = -1; return; }
        if (hipFuncSetAttribute((const void*)mega_fwd, hipFuncAttributeMaxDynamicSharedMemorySize, cf::LDS_BYTES) != hipSuccess) { fprintf(stderr, "kernel_launch: hipFuncSetAttribute failed\n"); grid = -1; return; }
        int per_cu = 0;
        if (hipOccupancyMaxActiveBlocksPerMultiprocessor(&per_cu, (const void*)mega_fwd, 512, cf::LDS_BYTES) != hipSuccess || per_cu < 1)
            fprintf(stderr, "kernel_launch: note: occupancy query reports %d workgroups per CU\n", per_cu);
        (void)hipGetLastError();
        grid = cus;
    }
    if (grid < 0) return;
    (void)hipMemsetAsync((char*)d_ws + cf::WS_CTL, 0, cf::CTL_BYTES, stream);
    Params p{};
    for (int i = 0; i < cf::N_IN; ++i) p.in[i] = (const float*)d_in[i];
    p.out = (float*)d_out; p.ws = (unsigned char*)d_ws;
#if MK_PER_PHASE
    for (int k = 0; k < cf::N_PHASES; ++k) { p.ph_lo = k; p.ph_hi = k + 1; hipLaunchKernelGGL(mega_fwd, dim3(grid), dim3(512), cf::LDS_BYTES, stream, p); }
#else
    p.ph_lo = 0; p.ph_hi = cf::N_PHASES;
    hipLaunchKernelGGL(mega_fwd, dim3(grid), dim3(512), cf::LDS_BYTES, stream, p);
#endif
    const hipError_t le = hipPeekAtLastError();
    if (le != hipSuccess) fprintf(stderr, "kernel_launch: launch failed: %s\n", hipGetErrorName(le));
}
```

```cpp
#include <hip/hip_runtime.h>
#include <stdint.h>
#include <stdio.h>

#ifndef MK_DUP
#define MK_DUP 0
#endif
#define DUPN(k) (((MK_DUP >> (k)) & 1) ? 2 : 1)
#ifndef MK_PV
#define MK_PV 0
#endif
#ifndef MK_AV
#define MK_AV 0
#endif
#ifndef MK_PER_PHASE
#define MK_PER_PHASE 0
#endif

namespace cf {
constexpr int D = 2048, NB = 4, S = 4096, CTX = 256, RB = CTX + S  , MR = NB * RB  ;
constexpr int DEPTH = 2;
constexpr int PC_AK = 0, PC_AV = 256, PC_CKV = 512, PC_KR = 768, PC_DK = 1024, PC_DV = 1280, PC_KVEND = 1536;
constexpr int PC_AQ = 1536, PC_CQ = 2560, PC_DQ = 3072, PC_GLU = 4096, PC_GATE = 6144, NC = 14336;
constexpr int IN_COLS = 14144;
constexpr int NEXP = 16384;
constexpr float ALPHA = 1.4142135623730951f;
constexpr float LOG2E = 1.4426950408889634f;
constexpr float SCALE_HD = 0.08838834764831845f;
constexpr float SCALE_MLA = 0.07216878364870323f;
enum { I_X = 0, I_C, I_CTX, I_CCTX, I_WADA, I_BADA, I_WIN, I_AQN, I_AKN, I_BQN, I_WQUP, I_BKVN, I_WKVUP, I_CW, I_CB, I_CLG, I_CLB, I_SINK,
       I_WBRA, I_WBRB, I_WBRC, I_WBRD, I_WO, I_LN1G, I_LN1B, I_LN2G, I_LN2B, I_PWQ, I_PSK, I_PU, I_PV, N_IN };
constexpr size_t al(size_t x) { return (x + 255) / 256 * 256; }
constexpr size_t WS_CTL = 0;
constexpr size_t CTL_BYTES = 65536;
constexpr size_t WS_MOD = WS_CTL + CTL_BYTES;
constexpr size_t WS_COSH = WS_MOD + al((size_t)2 * 5 * 12288 * 4);
constexpr size_t WS_SINH = WS_COSH + (size_t)4096 * 64 * 4;
constexpr size_t WS_COSR = WS_SINH + (size_t)4096 * 64 * 4;
constexpr size_t WS_SINR = WS_COSR + (size_t)4096 * 32 * 4;
constexpr size_t WS_WIN = WS_SINR + (size_t)4096 * 32 * 4;
constexpr size_t WS_WQUP = WS_WIN + (size_t)2 * NC * 2048 * 2;
constexpr size_t WS_WKVUP = WS_WQUP + (size_t)2 * 1536 * 512 * 2;
constexpr size_t WS_WBR = WS_WKVUP + (size_t)2 * 2048 * 256 * 2;
constexpr size_t WS_WO = WS_WBR + (size_t)2 * 4 * 2048 * 1024 * 2;
constexpr size_t WS_WFOLD = WS_WO + (size_t)2 * 2048 * 2048 * 2;
constexpr size_t WS_UB = WS_WFOLD + (size_t)2 * 2048 * 2048 * 2;
constexpr size_t WS_VB2 = WS_UB + (size_t)2 * NEXP * 2048;
constexpr size_t WS_HB = WS_VB2 + (size_t)2 * NEXP * 2048;
constexpr size_t WS_P = WS_HB + (size_t)MR * 2048 * 2;
constexpr size_t WS_QB = WS_P + (size_t)MR * NC * 2;
constexpr size_t WS_KB = WS_QB + (size_t)MR * 1536 * 2;
constexpr size_t WS_VB = WS_KB + (size_t)MR * 1536 * 2;
constexpr size_t WS_BR = WS_VB + (size_t)MR * 1024 * 2;
constexpr size_t WS_XC = WS_BR + (size_t)MR * 4096 * 2;
constexpr size_t WS_SSK = WS_XC + (size_t)1024 * 2048 * 4;
constexpr size_t WS_SSQ = WS_SSK + (size_t)MR * 4 * 4;
constexpr size_t WS_SSKV = WS_SSQ + (size_t)MR * 16 * 4;
constexpr size_t WS_SSCQ = WS_SSKV + (size_t)MR * 4 * 4;
constexpr size_t WS_END = WS_SSCQ + (size_t)MR * 8 * 4;
constexpr size_t X1_OFF = 0, SC_OFF = (size_t)MR * 2048 * 4;
static_assert(SC_OFF * 2 <= (size_t)MR * NC * 2, "X1 + SC fit in P");
constexpr int LDS_BYTES = 132 * 1024;
constexpr int MISC_OFF = 128 * 1024;
constexpr int N_PHASES = 2 + 8 * DEPTH;
}

typedef unsigned short bf16_t;
typedef short bf16x8 __attribute__((ext_vector_type(8)));
typedef float f32x4 __attribute__((ext_vector_type(4)));
typedef float f32x16 __attribute__((ext_vector_type(16)));
typedef float f32x2 __attribute__((ext_vector_type(2)));
typedef unsigned u32x4 __attribute__((ext_vector_type(4)));
typedef unsigned u32x2 __attribute__((ext_vector_type(2)));
#define LAS __attribute__((address_space(3)))
typedef LAS unsigned char* ldsp_t;

typedef __bf16 bf16x2v_t __attribute__((ext_vector_type(2)));
__device__ __forceinline__ unsigned cvt_pk_bf16(float lo, float hi) { const bf16x2v_t r = __builtin_convertvector((f32x2){lo, hi}, bf16x2v_t); return __builtin_bit_cast(unsigned, r); }
__device__ __forceinline__ bf16_t f2bf(float f) { return (bf16_t)(cvt_pk_bf16(f, 0.f) & 0xffffu); }
__device__ __forceinline__ float bf2f(bf16_t b) { return __uint_as_float(((unsigned)b) << 16); }
__device__ __forceinline__ float bflo(unsigned w) { return __uint_as_float(w << 16); }
__device__ __forceinline__ float bfhi(unsigned w) { return __uint_as_float(w & 0xffff0000u); }
__device__ __forceinline__ float shx(float v, int mask, int lane) { return __int_as_float(__builtin_amdgcn_ds_bpermute((lane ^ mask) << 2, __float_as_int(v))); }
__device__ __forceinline__ float wave_sum(float v, int lane) {
#pragma unroll
    for (int o = 32; o >= 1; o >>= 1) v += shx(v, o, lane);
    return v;
}
__device__ __forceinline__ int lane_id() { int l; asm volatile("v_mbcnt_lo_u32_b32 %0, -1, 0\n\tv_mbcnt_hi_u32_b32 %0, -1, %0" : "=v"(l)); return l; }
__device__ __forceinline__ float sigmoidf_(float x) { return __builtin_amdgcn_rcpf(1.0f + __builtin_amdgcn_exp2f(x * -1.4426950408889634f)); }

#define XB_TMO      128
#define XB_XCNT(j)  (256  + 64 * (j))
#define XB_XSUB(j)  (1280 + 64 * (j))
#define XB_XGEN(j)  (2304 + 64 * (j))
#define XB_TOP      3328
#define XB_TOPGEN   3392
#define XCD_BAR_WORDS 3456
#define XB_SPIN_CAP (1u << 23)
__device__ __forceinline__ unsigned xb_ld(unsigned* p)              { return __hip_atomic_load(p, __ATOMIC_RELAXED, __HIP_MEMORY_SCOPE_AGENT); }
__device__ __forceinline__ unsigned xb_add(unsigned* p, unsigned v) { return __hip_atomic_fetch_add(p, v, __ATOMIC_RELAXED, __HIP_MEMORY_SCOPE_AGENT); }
__device__ __forceinline__ unsigned xb_xcc_id() { return (unsigned)__builtin_amdgcn_s_getreg((3 << 11) | 20) & 0xFu; }
#define XB_SPIN(cond, bar) do { unsigned _sp = 0; while (cond) { __builtin_amdgcn_s_sleep(1); \
    if ((++_sp & 255u) == 0u) { if (xb_ld(&(bar)[XB_TMO])) break; if (_sp > XB_SPIN_CAP) { atomicAdd(&(bar)[XB_TMO], 1u); break; } } } } while (0)
struct XcdBarrier { unsigned* bar; unsigned x; volatile LAS unsigned* st; int wave; };
__device__ __forceinline__ XcdBarrier xcd_barrier_post(unsigned* bar, volatile LAS unsigned* st, int wave) {
    XcdBarrier b; b.bar = bar; b.x = xb_xcc_id(); b.st = st; b.wave = wave;
    if (wave == 0 && lane_id() == 0) (void)xb_add(&bar[XB_XCNT(b.x)], 1u);
    return b;
}
__device__ __forceinline__ void xcd_barrier_complete(unsigned* bar, unsigned x, unsigned& nloc, unsigned& nx) {
    const unsigned G = gridDim.x * gridDim.y * gridDim.z;
    unsigned sum, cnt, mine, sp = 0u;
    for (;;) {
        sum = 0u; cnt = 0u; mine = 0u;
#pragma unroll
        for (unsigned j = 0; j < 16; ++j) { const unsigned c = xb_ld(&bar[XB_XCNT(j)]); sum += c; cnt += (c > 0u) ? 1u : 0u; mine = (j == x) ? c : mine; }
        if (sum == G) break;
        __builtin_amdgcn_s_sleep(1);
        if ((++sp & 255u) == 0u) { if (xb_ld(&bar[XB_TMO])) break; if (sp > XB_SPIN_CAP) { atomicAdd(&bar[XB_TMO], 1u); break; } }
    }
    nloc = mine > 0u ? mine : 1u; nx = cnt > 0u ? cnt : 1u;
}
__device__ __forceinline__ void xcd_barrier(const XcdBarrier& b) {
    asm volatile("s_waitcnt vmcnt(0)" ::: "memory");
    __syncthreads();
    if (b.wave == 0 && lane_id() == 0) {
        unsigned* bar = b.bar;
        __builtin_amdgcn_s_waitcnt(0);
        unsigned nloc = b.st[0], nx = b.st[1];
        if (nloc == 0u) { xcd_barrier_complete(bar, b.x, nloc, nx); b.st[0] = nloc; b.st[1] = nx; }
        const unsigned old = xb_add(&bar[XB_XSUB(b.x)], 1u);
        const unsigned gen = old / nloc;
        if (old + 1u == (gen + 1u) * nloc) {
            __builtin_amdgcn_fence(__ATOMIC_RELEASE, "agent");
            asm volatile("s_waitcnt vmcnt(0)" ::: "memory");
            const unsigned og = xb_add(&bar[XB_TOP], 1u);
            const unsigned tg = og / nx;
            if (og + 1u == (tg + 1u) * nx) xb_add(&bar[XB_TOPGEN], 1u);
            else XB_SPIN(xb_ld(&bar[XB_TOPGEN]) == tg, bar);
            __builtin_amdgcn_fence(__ATOMIC_ACQUIRE, "agent");
            xb_add(&bar[XB_XGEN(b.x)], 1u);
            asm volatile("s_waitcnt vmcnt(0)" ::: "memory");
        } else {
            XB_SPIN(xb_ld(&bar[XB_XGEN(b.x)]) == gen, bar);
            __builtin_amdgcn_fence(__ATOMIC_ACQUIRE, "agent");
            asm volatile("s_waitcnt vmcnt(0)" ::: "memory");
        }
    }
    __syncthreads();
}

namespace pg8 {
constexpr int BM = 256, BK = 64, HALF = 128, HTB = HALF * BK * 2, STAGE_BYTES = 8 * HTB, NXCD = 8, WGM = 8;
__host__ __device__ __forceinline__ int lds_byte(int r, int c) { const int st = (r >> 4) * 2 + (c >> 5), rr = r & 15, cc = c & 31, ob = rr * 64 + cc * 2; return st * 1024 + (ob ^ (((ob >> 9) & 1) << 5)); }
__host__ __device__ __forceinline__ void stage_rc(int b, int& R, int& C) { const int st = b / 1024, sb = b % 1024, swz = sb ^ (((sb >> 9) & 1) << 5); R = (st >> 1) * 16 + swz / 64; C = (st & 1) * 32 + (swz % 64) / 2; }
__host__ __device__ __forceinline__ int perm32(int rho) { const int n = rho >> 4, i = rho & 15; return 8 * (i >> 2) + 4 * n + (i & 3); }
struct Unit { int pm, pn, sub; };
struct Gemm { const bf16_t* A; const bf16_t* Bt; int lda, K, ldb = 0; };

struct TileOrder {
    int nM, nN, nwg, G, c, mode, nsub; size_t subA, subB;
    __device__ void init(int nM_, int nN_, int G_, int c_, int mode_, int nsub_ = 1, size_t subA_ = 0, size_t subB_ = 0) { nM = nM_; nN = nN_; nwg = nM * nN; G = G_; c = c_; mode = mode_; nsub = nsub_; subA = subA_; subB = subB_; }
    __device__ bool next(int i, Unit& u) const {
        const int it = nsub == 1 ? i : i / nsub; u.sub = nsub == 1 ? 0 : i - it * nsub;
        const long L = (long)it * G + c; if (L >= nwg) return false;
        int wgid = (int)L; { const int q = nwg / NXCD, r = nwg % NXCD, xcd = wgid % NXCD, off = wgid / NXCD; wgid = (xcd < r ? xcd * (q + 1) : r * (q + 1) + (xcd - r) * q) + off; }
        const int nig = WGM * nN, gid = wgid / nig, fm = gid * WGM, gsz = (nM - fm) < WGM ? (nM - fm) : WGM;
        const int pl = fm + ((wgid % nig) % gsz); u.pn = (wgid % nig) / gsz;
        u.pm = mode == 0 ? pl : (mode == 1 ? 17 * (pl >> 4) + 1 + (pl & 15) : 17 * pl);
        return true;
    }
    __device__ __forceinline__ void a_ready(const Unit&) const {}
    __device__ __forceinline__ void done(const Unit&) const {}
};

template <class Epi, class Sched>
__device__ __forceinline__ void gemm_phase(ldsp_t lds, const Gemm g, const Sched& S, const Epi& E, int wave_) {
    int tid = wave_ * 64 + lane_id(); asm volatile("" : "+v"(tid));
    const int wid = __builtin_amdgcn_readfirstlane(tid >> 6), lane = tid & 63, wr = wid >> 2, wc = wid & 3, fr = lane & 15, fq = lane >> 4;
    int K = g.K; asm volatile("" : "+s"(K));
    const int nt = K / BK, lda = g.lda, ldb = g.ldb ? g.ldb : K;
    unsigned voffA[2], voffB[2];
#pragma unroll
    for (int i = 0; i < 2; ++i) { int R, C; stage_rc(tid * 16 + i * 8192, R, C); const int Rb = (R & ~31) + perm32(R & 31);
        voffA[i] = (unsigned)(R * lda + C) * 2u; voffB[i] = (unsigned)(Rb * ldb + C) * 2u; }
    const size_t kstep = (size_t)(BK * 2);
    const size_t hstepA = (size_t)HALF * lda * 2, hstepB = (size_t)HALF * ldb * 2;
    const size_t tstepA = 2 * hstepA, tstepB = 2 * hstepB;
    const unsigned ldsw = (unsigned)wid * 1024u;
    const int aoff = lds_byte(wr * 64 + fr, fq * 8), boff = lds_byte(wc * 32 + fr, fq * 8);
#define PG8_SA(b, h) (((b) * 2 + (h)) * HTB)
#define PG8_SB(b, h) ((4 + (b) * 2 + (h)) * HTB)
#define PG8_STAGE(bufoff, gbase, voff) do { _Pragma("unroll") for (int _i = 0; _i < 2; ++_i) \
        __builtin_amdgcn_global_load_lds((const unsigned*)((const char*)(gbase) + (voff)[_i]), (LAS unsigned*)(lds + (bufoff) + ldsw + _i * 8192), 16, 0, 0); } while (0)
#define PG8_LDA(dst, b, h) do { _Pragma("unroll") for (int m = 0; m < 4; ++m) _Pragma("unroll") for (int k = 0; k < 2; ++k) dst[m][k] = *(const LAS bf16x8*)(lds + PG8_SA(b, h) + aoff + m * 2048 + k * 1024); } while (0)
#define PG8_LDB(dst, b, h) do { _Pragma("unroll") for (int n = 0; n < 2; ++n) _Pragma("unroll") for (int k = 0; k < 2; ++k) dst[n][k] = *(const LAS bf16x8*)(lds + PG8_SB(b, h) + boff + n * 2048 + k * 1024); } while (0)
#define PG8_MMA(ai, bj, At, Bt) do { __builtin_amdgcn_s_setprio(1); _Pragma("unroll") for (int m = 0; m < 4; ++m) _Pragma("unroll") for (int n = 0; n < 2; ++n) _Pragma("unroll") for (int k = 0; k < 2; ++k) \
        acc[ai][bj][m][n] = __builtin_amdgcn_mfma_f32_16x16x32_bf16(Bt[n][k], At[m][k], acc[ai][bj][m][n], 0, 0, 0); __builtin_amdgcn_s_setprio(0); } while (0)
#define PG8_WAIT_V(n) asm volatile("s_waitcnt vmcnt(" #n ")" ::: "memory")
#define PG8_WAIT_L(n) asm volatile("s_waitcnt lgkmcnt(" #n ")" ::: "memory")
#define PG8_BAR __builtin_amdgcn_s_barrier()
#define PG8_SCHED __builtin_amdgcn_sched_barrier(0)
    Unit cur, nxt; int ui = 0;
    if (!S.next(0, cur)) return;
    f32x4 acc[2][2][4][2];
#pragma unroll
    for (int a = 0; a < 2; ++a)
#pragma unroll
        for (int b = 0; b < 2; ++b)
#pragma unroll
            for (int m = 0; m < 4; ++m)
#pragma unroll
                for (int n = 0; n < 2; ++n) acc[a][b][m][n] = (f32x4){0.f, 0.f, 0.f, 0.f};
    bf16x8 At[4][2], B0[2][2], B1[2][2];
    const char* cA = (const char*)g.A + (size_t)cur.pm * tstepA + cur.sub * S.subA; const char* cB = (const char*)g.Bt + (size_t)cur.pn * tstepB + cur.sub * S.subB;
    S.a_ready(cur);
    PG8_STAGE(PG8_SB(0, 0), cB, voffB); PG8_STAGE(PG8_SA(0, 0), cA, voffA); PG8_STAGE(PG8_SB(0, 1), cB + hstepB, voffB); PG8_STAGE(PG8_SA(0, 1), cA + hstepA, voffA);
    if (wr == 1) PG8_BAR;
    PG8_WAIT_V(4); PG8_BAR;
    PG8_STAGE(PG8_SB(1, 0), cB + kstep, voffB); PG8_STAGE(PG8_SA(1, 0), cA + kstep, voffA); PG8_STAGE(PG8_SB(1, 1), cB + hstepB + kstep, voffB);
    PG8_WAIT_V(6); PG8_BAR;
    for (;;) {
        const bool has_next = S.next(ui + 1, nxt);
        const char* nA = has_next ? (const char*)g.A + (size_t)nxt.pm * tstepA + nxt.sub * S.subA : cA; const char* nB = has_next ? (const char*)g.Bt + (size_t)nxt.pn * tstepB + nxt.sub * S.subB : cB;
#pragma unroll 1
        for (int t = 0; t < nt; t += 2) {
            const bool last = (t == nt - 2);
            const char* a1 = cA + (size_t)(t + 1) * kstep;
            const char* a2 = last ? nA : cA + (size_t)(t + 2) * kstep; const char* b2 = last ? nB : cB + (size_t)(t + 2) * kstep;
            const char* a3 = a2 + kstep; const char* b3 = b2 + kstep;
            if (last && has_next) S.a_ready(nxt);
            PG8_LDB(B0, 0, 0); PG8_SCHED; PG8_LDA(At, 0, 0); PG8_STAGE(PG8_SA(1, 1), a1 + hstepA, voffA);
            PG8_WAIT_L(8); PG8_BAR; PG8_WAIT_L(0); PG8_MMA(0, 0, At, B0); PG8_BAR; PG8_SCHED;
            PG8_LDB(B1, 0, 1); PG8_STAGE(PG8_SB(0, 0), b2, voffB);
            PG8_BAR; PG8_WAIT_L(0); PG8_MMA(0, 1, At, B1); PG8_BAR;
            PG8_LDA(At, 0, 1); PG8_STAGE(PG8_SA(0, 0), a2, voffA);
            PG8_BAR; PG8_WAIT_L(0); PG8_MMA(1, 0, At, B0); PG8_BAR; PG8_SCHED;
            PG8_STAGE(PG8_SB(0, 1), b2 + hstepB, voffB);
            PG8_WAIT_V(6); PG8_BAR; PG8_MMA(1, 1, At, B1); PG8_BAR;
            PG8_LDB(B0, 1, 0); PG8_SCHED; PG8_LDA(At, 1, 0); PG8_STAGE(PG8_SA(0, 1), a2 + hstepA, voffA);
            PG8_WAIT_L(8); PG8_BAR; PG8_WAIT_L(0); PG8_MMA(0, 0, At, B0); PG8_BAR; PG8_SCHED;
            PG8_LDB(B1, 1, 1); PG8_STAGE(PG8_SB(1, 0), b3, voffB);
            PG8_BAR; PG8_WAIT_L(0); PG8_MMA(0, 1, At, B1); PG8_BAR;
            PG8_LDA(At, 1, 1); PG8_STAGE(PG8_SA(1, 0), a3, voffA);
            PG8_BAR; PG8_WAIT_L(0); PG8_MMA(1, 0, At, B0); PG8_BAR; PG8_SCHED;
            PG8_STAGE(PG8_SB(1, 1), b3 + hstepB, voffB);
            PG8_WAIT_V(6); PG8_BAR; PG8_MMA(1, 1, At, B1); PG8_BAR;
        }
        E(acc, cur, wr, wc, fr, fq); S.done(cur);
        if (!has_next) break;
#pragma unroll
        for (int a = 0; a < 2; ++a)
#pragma unroll
            for (int b = 0; b < 2; ++b)
#pragma unroll
                for (int m = 0; m < 4; ++m)
#pragma unroll
                    for (int n = 0; n < 2; ++n) acc[a][b][m][n] = (f32x4){0.f, 0.f, 0.f, 0.f};
        cur = nxt; cA = nA; cB = nB; ++ui;
    }
    PG8_WAIT_V(0);
    if (wr == 0) PG8_BAR;
    PG8_BAR;
#undef PG8_SA
#undef PG8_SB
#undef PG8_STAGE
#undef PG8_LDA
#undef PG8_LDB
#undef PG8_MMA
#undef PG8_WAIT_V
#undef PG8_WAIT_L
#undef PG8_BAR
#undef PG8_SCHED
}

__device__ __forceinline__ u32x4 pack8(const f32x4 a, const f32x4 b) { u32x4 w; w.x = cvt_pk_bf16(a[0], a[1]); w.y = cvt_pk_bf16(a[2], a[3]); w.z = cvt_pk_bf16(b[0], b[1]); w.w = cvt_pk_bf16(b[2], b[3]); return w; }
#define EPI_ARGS const f32x4 (&acc)[2][2][4][2], const Unit& u, int wr, int wc, int fr_, int fq_
#define EPI_LANE int fr = fr_, fq = fq_; asm volatile("" : "+v"(fr), "+v"(fq));

struct EpiBf16 {
    bf16_t* O; int ldc;
    __device__ __forceinline__ void operator()(EPI_ARGS) const {
        EPI_LANE
        const int row0 = u.pm * BM + wr * 64 + fr, col0 = u.pn * BM + wc * 32 + 8 * fq;
#pragma unroll
        for (int ai = 0; ai < 2; ++ai)
#pragma unroll
            for (int m = 0; m < 4; ++m) { bf16_t* rowp = O + (size_t)(row0 + ai * HALF + m * 16) * ldc + col0;
#pragma unroll
                for (int bj = 0; bj < 2; ++bj) *(u32x4*)(rowp + bj * HALF) = pack8(acc[ai][bj][m][0], acc[ai][bj][m][1]); }
    }
};
struct EpiF32 {
    float* C; int ldc;
    __device__ __forceinline__ void operator()(EPI_ARGS) const {
        EPI_LANE
        const int row0 = u.pm * BM + wr * 64 + fr, col0 = u.pn * BM + wc * 32 + 8 * fq;
#pragma unroll
        for (int ai = 0; ai < 2; ++ai)
#pragma unroll
            for (int m = 0; m < 4; ++m) { float* rowp = C + (size_t)(row0 + ai * HALF + m * 16) * ldc + col0;
#pragma unroll
                for (int bj = 0; bj < 2; ++bj) { *(f32x4*)(rowp + bj * HALF) = acc[ai][bj][m][0]; *(f32x4*)(rowp + bj * HALF + 4) = acc[ai][bj][m][1]; } }
    }
};
struct EpiInProj {
    bf16_t* P; bf16_t* KB; const float* cosh; const float* sinh; const float* cosr; const float* sinr; const float* akn; const float* aqn;
    float* ssk; float* ssq; float* sskv; float* sscq;
    __device__ __forceinline__ void operator()(EPI_ARGS) const {
        EPI_LANE
        const int pn = u.pn, tb = u.pm % 17; const bool lat = tb != 0; const int posbase = (tb - 1) * 256;
        const int rl0 = wr * 64 + fr;
        if (pn >= 24) {
            const int col0 = pn * BM + wc * 32 + 8 * fq;
#pragma unroll
            for (int ai = 0; ai < 2; ++ai)
#pragma unroll
                for (int m = 0; m < 4; ++m) { bf16_t* rowp = P + ((size_t)u.pm * BM + rl0 + ai * HALF + m * 16) * cf::NC + col0;
#pragma unroll
                    for (int bj = 0; bj < 2; ++bj) { f32x4 v0 = acc[ai][bj][m][0], v1 = acc[ai][bj][m][1];
#pragma unroll
                        for (int e = 0; e < 4; ++e) { v0[e] = sigmoidf_(v0[e]); v1[e] = sigmoidf_(v1[e]); }
                        *(u32x4*)(rowp + bj * HALF) = pack8(v0, v1); } }
        } else if (pn >= 16) {
            const int col0 = cf::PC_GLU + 128 * (pn - 16) + wc * 32 + 8 * fq;
#pragma unroll
            for (int ai = 0; ai < 2; ++ai)
#pragma unroll
                for (int m = 0; m < 4; ++m) { f32x4 v0 = acc[ai][0][m][0], v1 = acc[ai][0][m][1]; const f32x4 g0 = acc[ai][1][m][0], g1 = acc[ai][1][m][1];
#pragma unroll
                    for (int e = 0; e < 4; ++e) { v0[e] *= sigmoidf_(g0[e]); v1[e] *= sigmoidf_(g1[e]); }
                    *(u32x4*)(P + ((size_t)u.pm * BM + rl0 + ai * HALF + m * 16) * cf::NC + col0) = pack8(v0, v1); }
        } else if (pn == 3) {
            if (wc == 0) { const int i0 = 8 * fq;
#pragma unroll
                for (int ai = 0; ai < 2; ++ai)
#pragma unroll
                    for (int m = 0; m < 4; ++m) { const int rl = rl0 + ai * HALF + m * 16;
                        f32x4 c0 = {1.f, 1.f, 1.f, 1.f}, c1 = c0, s0 = {0.f, 0.f, 0.f, 0.f}, s1 = s0;
                        if (lat) { const float* cp = cosr + (size_t)(posbase + rl) * 32 + i0; const float* sp = sinr + (size_t)(posbase + rl) * 32 + i0;
                            c0 = *(const f32x4*)cp; c1 = *(const f32x4*)(cp + 4); s0 = *(const f32x4*)sp; s1 = *(const f32x4*)(sp + 4); }
                        const f32x4 x1a = acc[ai][0][m][0], x1b = acc[ai][0][m][1], x2a = acc[ai][1][m][0], x2b = acc[ai][1][m][1];
                        const u32x4 w1 = pack8(x1a * c0 - x2a * s0, x1b * c1 - x2b * s1), w2 = pack8(x2a * c0 + x1a * s0, x2b * c1 + x1b * s1);
                        bf16_t* kb = KB + ((size_t)u.pm * BM + rl) * 1536 + 128 + i0;
#pragma unroll
                        for (int h = 0; h < 8; ++h) { *(u32x4*)(kb + h * 192) = w1; *(u32x4*)(kb + h * 192 + 32) = w2; }
                        asm volatile("" ::: "memory"); } }
        } else if (pn == 0 || pn == 4 || (pn >= 6 && pn <= 9) || pn >= 12) {
            const bool norm = pn == 0 || (pn >= 6 && pn <= 9);
            const int hl = wc >> 1, i0 = 32 * (wc & 1) + 8 * fq;
            f32x4 g1a = {1.f, 1.f, 1.f, 1.f}, g1b = g1a, g2a = g1a, g2b = g1a;
            if (norm) { const float* gn = (pn == 0 ? akn : aqn) + i0; g1a = *(const f32x4*)gn; g1b = *(const f32x4*)(gn + 4); g2a = *(const f32x4*)(gn + 64); g2b = *(const f32x4*)(gn + 68); }
            float* ssp = pn == 0 ? ssk + ((size_t)u.pm * BM * 2 + hl) * 2 + (wc & 1) : ssq + ((size_t)u.pm * BM * 8 + (pn - 6) * 2 + hl) * 2 + (wc & 1);
            const int sstr = pn == 0 ? 4 : 16;
#pragma unroll
            for (int ai = 0; ai < 2; ++ai)
#pragma unroll
                for (int m = 0; m < 4; ++m) { const int rl = rl0 + ai * HALF + m * 16;
                    f32x4 x1a = acc[ai][0][m][0], x1b = acc[ai][0][m][1], x2a = acc[ai][1][m][0], x2b = acc[ai][1][m][1];
                    if (norm) { const f32x4 q = x1a * x1a + x1b * x1b + x2a * x2a + x2b * x2b; float ss = (q[0] + q[1]) + (q[2] + q[3]);
                        ss += shx(ss, 16, fr + 16 * fq); ss += shx(ss, 32, fr + 16 * fq);
                        if (fq == 0) ssp[(size_t)rl * sstr] = ss;
                        x1a *= g1a; x1b *= g1b; x2a *= g2a; x2b *= g2b; }
                    f32x4 o1a = x1a, o1b = x1b, o2a = x2a, o2b = x2b;
                    if (lat) { const float* cp = cosh + (size_t)(posbase + rl) * 64 + i0; const float* sp = sinh + (size_t)(posbase + rl) * 64 + i0;
                        const f32x4 c0 = *(const f32x4*)cp, c1 = *(const f32x4*)(cp + 4), s0 = *(const f32x4*)sp, s1 = *(const f32x4*)(sp + 4);
                        o1a = x1a * c0 - x2a * s0; o1b = x1b * c1 - x2b * s1; o2a = x2a * c0 + x1a * s0; o2b = x2b * c1 + x1b * s1; }
                    bf16_t* dst = P + ((size_t)u.pm * BM + rl) * cf::NC + pn * BM + hl * 128 + i0;
                    *(u32x4*)dst = pack8(o1a, o1b); *(u32x4*)(dst + 64) = pack8(o2a, o2b);
                    asm volatile("" ::: "memory"); }
        } else {
            const int col0 = pn * BM + wc * 32 + 8 * fq;
            const bool ssq_on = pn == 2 || pn == 10 || pn == 11;
            float* ssp = pn == 2 ? sskv + (size_t)u.pm * BM * 4 + wc : sscq + (size_t)u.pm * BM * 8 + (pn - 10) * 4 + wc;
            const int sstr = pn == 2 ? 4 : 8;
#pragma unroll
            for (int ai = 0; ai < 2; ++ai)
#pragma unroll
                for (int m = 0; m < 4; ++m) { const int rl = rl0 + ai * HALF + m * 16; bf16_t* rowp = P + ((size_t)u.pm * BM + rl) * cf::NC + col0;
#pragma unroll
                    for (int bj = 0; bj < 2; ++bj) *(u32x4*)(rowp + bj * HALF) = pack8(acc[ai][bj][m][0], acc[ai][bj][m][1]);
                    if (ssq_on) { const f32x4 q = acc[ai][0][m][0] * acc[ai][0][m][0] + acc[ai][0][m][1] * acc[ai][0][m][1] + acc[ai][1][m][0] * acc[ai][1][m][0] + acc[ai][1][m][1] * acc[ai][1][m][1];
                        float ss = (q[0] + q[1]) + (q[2] + q[3]); ss += shx(ss, 16, fr + 16 * fq); ss += shx(ss, 32, fr + 16 * fq);
                        if (fq == 0) ssp[(size_t)rl * sstr] = ss; } }
        }
    }
};
struct EpiKvUp {
    bf16_t* KB; bf16_t* VB; const float* sskv;
    __device__ __forceinline__ void operator()(EPI_ARGS) const {
        EPI_LANE
        const int row0 = u.pm * BM + wr * 64 + fr, d0 = wc * 32 + 8 * fq;
        const bool isk = u.pn < 4;
        bf16_t* base = isk ? KB + (2 * u.pn) * 192 + d0 : VB + (u.pn - 4) * 256 + d0;
        const int ldr = isk ? 1536 : 1024, bjs = isk ? 192 : 128;
#pragma unroll
        for (int ai = 0; ai < 2; ++ai)
#pragma unroll
            for (int m = 0; m < 4; ++m) { const size_t row = (size_t)(row0 + ai * HALF + m * 16); bf16_t* rowp = base + row * ldr;
                const f32x4 pp = *(const f32x4*)(sskv + row * 4); const float r = rsqrtf(((pp[0] + pp[1]) + (pp[2] + pp[3])) * (1.f / 256.f) + 1e-6f);
#pragma unroll
                for (int bj = 0; bj < 2; ++bj) *(u32x4*)(rowp + bj * bjs) = pack8(acc[ai][bj][m][0] * r, acc[ai][bj][m][1] * r); }
    }
};
struct EpiQUp {
    bf16_t* QB; const float* cosr; const float* sinr; const float* sscq;
    __device__ __forceinline__ void operator()(EPI_ARGS) const {
        EPI_LANE
        const int row0 = u.pm * BM + wr * 64 + fr;
        if (u.pn < 4) {
            const int d0 = wc * 32 + 8 * fq;
#pragma unroll
            for (int ai = 0; ai < 2; ++ai)
#pragma unroll
                for (int m = 0; m < 4; ++m) { const size_t row = (size_t)(row0 + ai * HALF + m * 16);
                    const f32x4 pa = *(const f32x4*)(sscq + row * 8), pb = *(const f32x4*)(sscq + row * 8 + 4);
                    const float r = rsqrtf((((pa[0] + pa[1]) + (pa[2] + pa[3])) + ((pb[0] + pb[1]) + (pb[2] + pb[3]))) * (1.f / 512.f) + 1e-6f);
#pragma unroll
                    for (int bj = 0; bj < 2; ++bj) *(u32x4*)(QB + row * 1536 + (2 * u.pn + bj) * 192 + d0) = pack8(acc[ai][bj][m][0] * r, acc[ai][bj][m][1] * r); }
        } else {
            const int head = 4 * (u.pn - 4) + wc, i0 = 8 * fq;
            const bool lat = (u.pm % 17) != 0; const int posbase = (u.pm % 17) * 256 - 256;
#pragma unroll
            for (int ai = 0; ai < 2; ++ai)
#pragma unroll
                for (int m = 0; m < 4; ++m) { const int rl = wr * 64 + fr + ai * HALF + m * 16; const size_t row = (size_t)u.pm * BM + rl;
                    const f32x4 pa = *(const f32x4*)(sscq + row * 8), pb = *(const f32x4*)(sscq + row * 8 + 4);
                    const float r = rsqrtf((((pa[0] + pa[1]) + (pa[2] + pa[3])) + ((pb[0] + pb[1]) + (pb[2] + pb[3]))) * (1.f / 512.f) + 1e-6f);
                    f32x4 c0 = {1.f, 1.f, 1.f, 1.f}, c1 = c0, s0 = {0.f, 0.f, 0.f, 0.f}, s1 = s0;
                    if (lat) { const float* cp = cosr + (size_t)(posbase + rl) * 32 + i0; const float* sp = sinr + (size_t)(posbase + rl) * 32 + i0;
                        c0 = *(const f32x4*)cp; c1 = *(const f32x4*)(cp + 4); s0 = *(const f32x4*)sp; s1 = *(const f32x4*)(sp + 4); }
                    const f32x4 x1a = acc[ai][0][m][0] * r, x1b = acc[ai][0][m][1] * r, x2a = acc[ai][1][m][0] * r, x2b = acc[ai][1][m][1] * r;
                    const f32x4 o1a = x1a * c0 - x2a * s0, o1b = x1b * c1 - x2b * s1, o2a = x2a * c0 + x1a * s0, o2b = x2b * c1 + x1b * s1;
                    bf16_t* dst = QB + row * 1536 + head * 192 + 128 + i0;
                    *(u32x4*)dst = pack8(o1a, o1b); *(u32x4*)(dst + 32) = pack8(o2a, o2b); asm volatile("" ::: "memory"); }
        }
    }
};
struct EpiMerge {
    bf16_t* ACC; const bf16_t* gate0; int ldg;
    __device__ __forceinline__ void operator()(EPI_ARGS) const {
        EPI_LANE
        const int row0 = u.pm * BM + wr * 64 + fr, col0 = u.pn * BM + wc * 32 + 8 * fq;
        const bf16_t* gate = gate0 + u.sub * 2048; const bool first = u.sub == 0;
#pragma unroll
        for (int ai = 0; ai < 2; ++ai) {
            u32x4 gw[4][2], pw[4][2];
#pragma unroll
            for (int m = 0; m < 4; ++m) { const size_t row = (size_t)(row0 + ai * HALF + m * 16);
#pragma unroll
                for (int bj = 0; bj < 2; ++bj) { const int col = col0 + bj * HALF; gw[m][bj] = *(const u32x4*)(gate + row * ldg + col);
                    pw[m][bj] = (u32x4){0u, 0u, 0u, 0u}; if (!first) pw[m][bj] = *(const u32x4*)(ACC + row * 2048 + col); } }
#pragma unroll
            for (int m = 0; m < 4; ++m) { const size_t row = (size_t)(row0 + ai * HALF + m * 16);
#pragma unroll
                for (int bj = 0; bj < 2; ++bj) { const int col = col0 + bj * HALF; const u32x4 g = gw[m][bj], p = pw[m][bj];
                    const f32x4 a0 = acc[ai][bj][m][0], a1 = acc[ai][bj][m][1];
                    f32x4 r0, r1;
                    r0[0] = bflo(p.x) + bflo(g.x) * a0[0]; r0[1] = bfhi(p.x) + bfhi(g.x) * a0[1]; r0[2] = bflo(p.y) + bflo(g.y) * a0[2]; r0[3] = bfhi(p.y) + bfhi(g.y) * a0[3];
                    r1[0] = bflo(p.z) + bflo(g.z) * a1[0]; r1[1] = bfhi(p.z) + bfhi(g.z) * a1[1]; r1[2] = bflo(p.w) + bflo(g.w) * a1[2]; r1[3] = bfhi(p.w) + bfhi(g.w) * a1[3];
                    *(u32x4*)(ACC + row * 2048 + col) = pack8(r0, r1); } }
            asm volatile("" ::: "memory"); }
    }
};
struct EpiWo {
    float* X1; const float* mod  ; const float* xlat  ; const float* xctx  ;
    __device__ __forceinline__ void operator()(EPI_ARGS) const {
        EPI_LANE
        const int b = u.pm / 17, tb = u.pm % 17; const bool isctx = tb == 0;
        const float* g1 = mod + (size_t)(isctx ? 4 : b) * 12288 + 2 * 2048;
        const float* xbase = isctx ? xctx + (size_t)b * cf::CTX * 2048 : xlat + ((size_t)b * cf::S + (size_t)(tb - 1) * 256) * 2048;
        const int rl0 = wr * 64 + fr, col0 = u.pn * BM + wc * 32 + 8 * fq;
        f32x4 gv[2][2];
#pragma unroll
        for (int bj = 0; bj < 2; ++bj) { gv[bj][0] = *(const f32x4*)(g1 + col0 + bj * HALF); gv[bj][1] = *(const f32x4*)(g1 + col0 + bj * HALF + 4); }
#pragma unroll
        for (int ai = 0; ai < 2; ++ai) {
            f32x4 xv[4][2][2];
#pragma unroll
            for (int m = 0; m < 4; ++m) { const int rl = rl0 + ai * HALF + m * 16;
#pragma unroll
                for (int bj = 0; bj < 2; ++bj) { const float* xp = xbase + (size_t)rl * 2048 + col0 + bj * HALF; xv[m][bj][0] = *(const f32x4*)xp; xv[m][bj][1] = *(const f32x4*)(xp + 4); } }
#pragma unroll
            for (int m = 0; m < 4; ++m) { const int rl = rl0 + ai * HALF + m * 16; float* op = X1 + ((size_t)u.pm * BM + rl) * 2048 + col0;
#pragma unroll
                for (int bj = 0; bj < 2; ++bj) { *(f32x4*)(op + bj * HALF) = xv[m][bj][0] * cf::ALPHA + gv[bj][0] * acc[ai][bj][m][0];
                    *(f32x4*)(op + bj * HALF + 4) = xv[m][bj][1] * cf::ALPHA + gv[bj][1] * acc[ai][bj][m][1]; } }
            asm volatile("" ::: "memory"); }
    }
};
}

struct Ctx {
    const float* const* in; float* out; unsigned char* ws;
    ldsp_t lds; int tid, lane, wave, G, bid;
};
#define WSP(T, off) ((T*)(F.ws + (off)))
__device__ __forceinline__ Ctx phase_ctx(const Ctx& F0) {
    Ctx C = F0;
    C.tid = F0.wave * 64 + lane_id();
    asm volatile("" : "+v"(C.tid));
    { size_t z = 0; asm volatile("" : "+s"(z)); C.ws = F0.ws + z; }
    C.lane = C.tid & 63; C.wave = __builtin_amdgcn_readfirstlane(C.tid >> 6);
    return C;
}

__device__ __forceinline__ int srcmap(int mode, int n) {
    if (mode == 0) {
        const int pn = n >> 8, q = n & 255, bj = q >> 7, r = q & 127, rope = (r >> 6) * 128 + bj * 64 + (r & 63);
        if (pn == 0) return rope;
        if (pn == 1) return 256 + q;
        if (pn == 2) return 512 + q;
        if (pn == 3) return r < 32 ? 768 + bj * 32 + r : -1;
        if (pn == 4) return 832 + rope;
        if (pn == 5) return 1088 + q;
        if (pn < 10) return 1344 + (pn - 6) * 256 + rope;
        if (pn < 12) return 2368 + (pn - 10) * 256 + q;
        if (pn < 16) return 2880 + (pn - 12) * 256 + rope;
        if (pn < 24) return 3904 + bj * 1024 + 128 * (pn - 16) + r;
        return 5952 + (n - 6144);
    }
    if (mode == 1) { if (n < 1024) return (n >> 7) * 192 + (n & 127);
        const int m = n - 1024, t = m >> 8, bj = (m >> 7) & 1, q = m & 127; return (4 * t + (q >> 5)) * 192 + 128 + bj * 32 + (q & 31); }
    if (mode == 2) { if (n < 1024) return (n >> 7) * 256 + (n & 127); const int m = n - 1024; return (m >> 7) * 256 + 128 + (m & 127); }
    return n;
}
__device__ __forceinline__ void tr_tile(const Ctx& F, const float* src, int ld_src, int mode, int k0, bf16_t* dst, int ldd, int n0, const float* kscale = nullptr) {
    LAS float* T = (LAS float*)F.lds;
    const int kr = F.tid >> 6, nc = (F.tid & 63) * 4, sc = srcmap(mode, n0 + nc);
    f32x4 v[8];
#pragma unroll
    for (int h = 0; h < 8; ++h) { v[h] = (f32x4){0.f, 0.f, 0.f, 0.f}; if (sc >= 0) v[h] = *(const f32x4*)(src + (size_t)(k0 + kr + 8 * h) * ld_src + sc); }
#pragma unroll
    for (int h = 0; h < 8; ++h) { const int k = kr + 8 * h; f32x4 x = v[h]; if (kscale) x = x * kscale[k0 + k];
        T[k * 257 + nc + 0] = x[0]; T[k * 257 + nc + 1] = x[1]; T[k * 257 + nc + 2] = x[2]; T[k * 257 + nc + 3] = x[3]; }
    __syncthreads();
    const int n = F.tid >> 1, kc = (F.tid & 1) * 32;
#pragma unroll
    for (int j = 0; j < 4; ++j) { u32x4 w; const int kb = kc + 8 * j;
        w.x = cvt_pk_bf16(T[(kb + 0) * 257 + n], T[(kb + 1) * 257 + n]); w.y = cvt_pk_bf16(T[(kb + 2) * 257 + n], T[(kb + 3) * 257 + n]);
        w.z = cvt_pk_bf16(T[(kb + 4) * 257 + n], T[(kb + 5) * 257 + n]); w.w = cvt_pk_bf16(T[(kb + 6) * 257 + n], T[(kb + 7) * 257 + n]);
        *(u32x4*)(dst + (size_t)(n0 + n) * ldd + k0 + kb) = w; }
    __syncthreads();
}
__device__ __forceinline__ void cvt_rows(const Ctx& F, const float* src, bf16_t* dst, size_t n8) {
    for (size_t i = (size_t)F.bid * 512 + F.tid; i < n8; i += (size_t)F.G * 512) {
        const f32x4 a = *(const f32x4*)(src + i * 8), b = *(const f32x4*)(src + i * 8 + 4);
        *(u32x4*)(dst + i * 8) = pg8::pack8(a, b); }
}

constexpr int UV_ROW = 2176, SC_BIAS = 103;
__device__ __forceinline__ float uv_scale(unsigned byte) { return __uint_as_float((byte << 20) + ((unsigned)SC_BIAS << 23)); }
__device__ __forceinline__ void cvt_rows_fp4(const Ctx& F, const float* src, unsigned char* dst, size_t nblk, int which) {
    for (size_t i = (size_t)F.bid * 512 + F.tid; i < nblk; i += (size_t)F.G * 512) {
        f32x4 a[8]; float amax = 0.f;
#pragma unroll
        for (int j = 0; j < 8; ++j) { a[j] = *(const f32x4*)(src + i * 32 + 4 * j); amax = fmaxf(amax, fmaxf(fmaxf(fabsf(a[j][0]), fabsf(a[j][1])), fmaxf(fabsf(a[j][2]), fabsf(a[j][3])))); }
        const unsigned rb = (__float_as_uint(amax * (1.0f / 6.0f)) + 0xFFFFFu) >> 20;
        const unsigned sb = rb < ((unsigned)SC_BIAS << 3) ? 0u : (rb - ((unsigned)SC_BIAS << 3) > 255u ? 255u : rb - ((unsigned)SC_BIAS << 3));
        const float inv = 1.0f / uv_scale(sb);
        u32x4 w;
#pragma unroll
        for (int j = 0; j < 4; ++j) { const f32x4 x = a[2 * j] * inv, y = a[2 * j + 1] * inv; unsigned p = 0u;
            p = __builtin_amdgcn_cvt_scalef32_pk_fp4_f32(p, x[0], x[1], 1.0f, 0); p = __builtin_amdgcn_cvt_scalef32_pk_fp4_f32(p, x[2], x[3], 1.0f, 1);
            p = __builtin_amdgcn_cvt_scalef32_pk_fp4_f32(p, y[0], y[1], 1.0f, 2); p = __builtin_amdgcn_cvt_scalef32_pk_fp4_f32(p, y[2], y[3], 1.0f, 3); w[j] = p; }
        const size_t row = i >> 6; const int bl = (int)(i & 63);
        *(u32x4*)(dst + row * UV_ROW + which * 1024 + bl * 16) = w; dst[row * UV_ROW + 2048 + 2 * bl + which] = (unsigned char)sb;
    }
}

__device__ __forceinline__ void ph_prologue(const Ctx& F0) {
    const Ctx F = phase_ctx(F0);
    using namespace cf;
    constexpr int T_WIN = 2 * 32 * 56, T_QUP = 2 * 8 * 6, T_KVUP = 2 * 4 * 8, T_BR = 2 * 4 * 16 * 8, T_WO = 2 * 32 * 8;
    constexpr int T_ALL = T_WIN + T_QUP + T_KVUP + T_BR + T_WO;
    for (int u = F.bid; u < T_ALL; u += F.G) {
        int t = u;
        if (t < T_WIN) { const int l = t / (32 * 56), r = t % (32 * 56), kt = r / 56, nt = r % 56;
            tr_tile(F, F.in[I_WIN] + (size_t)l * 2048 * IN_COLS, IN_COLS, 0, kt * 64, WSP(bf16_t, WS_WIN) + (size_t)l * NC * 2048, 2048, nt * 256); continue; }
        t -= T_WIN;
        if (t < T_QUP) { const int l = t / (8 * 6), r = t % (8 * 6), kt = r / 6, nt = r % 6;
            tr_tile(F, F.in[I_WQUP] + (size_t)l * 512 * 1536, 1536, 1, kt * 64, WSP(bf16_t, WS_WQUP) + (size_t)l * 1536 * 512, 512, nt * 256, F.in[I_BQN] + l * 512); continue; }
        t -= T_QUP;
        if (t < T_KVUP) { const int l = t / (4 * 8), r = t % (4 * 8), kt = r / 8, nt = r % 8;
            tr_tile(F, F.in[I_WKVUP] + (size_t)l * 256 * 2048, 2048, 2, kt * 64, WSP(bf16_t, WS_WKVUP) + (size_t)l * 2048 * 256, 256, nt * 256, F.in[I_BKVN] + l * 256); continue; }
        t -= T_KVUP;
        if (t < T_BR) { const int l = t / (4 * 128), r = t % (4 * 128), br = r / 128, r2 = r % 128, kt = r2 / 8, nt = r2 % 8;
            const float* src = (br == 0 ? F.in[I_WBRA] : br == 1 ? F.in[I_WBRB] : br == 2 ? F.in[I_WBRC] : F.in[I_WBRD]) + (size_t)l * 1024 * 2048;
            tr_tile(F, src, 2048, 3, kt * 64, WSP(bf16_t, WS_WBR) + ((size_t)l * 4 + br) * 2048 * 1024, 1024, nt * 256); continue; }
        t -= T_BR;
        { const int l = t / 256, r = t % 256, kt = r / 8, nt = r % 8;
            tr_tile(F, F.in[I_WO] + (size_t)l * 2048 * 2048, 2048, 3, kt * 64, WSP(bf16_t, WS_WO) + (size_t)l * 2048 * 2048, 2048, nt * 256); }
    }
    for (int u = F.bid; u < 2 * 16 * 32; u += F.G) {
        const int l = u / 512, g = (u % 512) / 32, d0 = (u % 32) * 64;
        LAS float* sk = (LAS float*)F.lds; LAS float* wt = (LAS float*)(F.lds + 128 * 129 * 4);
        const float* skg = F.in[I_PSK] + ((size_t)l * 16 + g) * 128 * 128;
        const float* wqg = F.in[I_PWQ] + (size_t)l * 2048 * 2048 + (size_t)d0 * 2048 + g * 128;
#pragma unroll
        for (int r = 0; r < 8; ++r) { const int i = (r * 512 + F.tid) * 4; const f32x4 v = *(const f32x4*)(skg + i); LAS float* p = sk + (i >> 7) * 129 + (i & 127); p[0] = v[0]; p[1] = v[1]; p[2] = v[2]; p[3] = v[3]; }
#pragma unroll
        for (int r = 0; r < 4; ++r) { const int i = (r * 512 + F.tid) * 4; const f32x4 v = *(const f32x4*)(wqg + (size_t)(i >> 7) * 2048 + (i & 127)); LAS float* p = wt + (i >> 7) * 129 + (i & 127); p[0] = v[0]; p[1] = v[1]; p[2] = v[2]; p[3] = v[3]; }
        __syncthreads();
        const int db = F.wave & 1, nb = F.wave >> 1, li = F.lane & 31, kk = F.lane >> 5;
        const LAS float* ap = wt + (db * 32 + li) * 129 + kk; const LAS float* bp = sk + (nb * 32 + li) * 129 + kk;
        f32x16 acc;
#pragma unroll
        for (int e = 0; e < 16; ++e) acc[e] = 0.f;
#pragma unroll 16
        for (int st = 0; st < 64; ++st) acc = __builtin_amdgcn_mfma_f32_32x32x2f32(ap[2 * st], bp[2 * st], acc, 0, 0, 0);
        bf16_t* dst = WSP(bf16_t, WS_WFOLD) + (size_t)l * 2048 * 2048 + (size_t)(g * 128 + nb * 32 + li) * 2048 + d0 + db * 32 + 4 * kk;
#pragma unroll
        for (int q = 0; q < 4; ++q) { u32x2 w; w.x = cvt_pk_bf16(acc[4 * q], acc[4 * q + 1]); w.y = cvt_pk_bf16(acc[4 * q + 2], acc[4 * q + 3]); *(u32x2*)(dst + 8 * q) = w; }
        __syncthreads();
    }
    for (int u = F.bid; u < 2 * 192; u += F.G) {
        const int l = u / 192, n0 = (u % 192) * 64;
        LAS float* sl = (LAS float*)F.lds; LAS float* red = (LAS float*)(F.lds + 5 * 2048 * 4);
        for (int i = F.tid; i < 5 * 2048; i += 512) { const int r = i >> 11, k = i & 2047; const float v = r < 4 ? F.in[I_C][r * 2048 + k] : F.in[I_CCTX][k]; sl[i] = v * sigmoidf_(v); }
        __syncthreads();
        const int cg = F.tid & 15, ks = F.tid >> 4;
        f32x4 a[5];
#pragma unroll
        for (int r = 0; r < 5; ++r) a[r] = (f32x4){0.f, 0.f, 0.f, 0.f};
        const float* wp = F.in[I_WADA] + (size_t)l * 2048 * 12288 + n0 + cg * 4;
#pragma unroll 8
        for (int k = ks * 64; k < ks * 64 + 64; ++k) { const f32x4 w = *(const f32x4*)(wp + (size_t)k * 12288);
#pragma unroll
            for (int r = 0; r < 5; ++r) a[r] += w * sl[r * 2048 + k]; }
#pragma unroll
        for (int r = 0; r < 5; ++r) *(LAS f32x4*)(red + (ks * 5 + r) * 64 + cg * 4) = a[r];
        __syncthreads();
        if (F.tid < 320) { const int r = F.tid >> 6, col = F.tid & 63; float sacc = 0.f;
#pragma unroll
            for (int k2 = 0; k2 < 32; ++k2) sacc += red[(k2 * 5 + r) * 64 + col];
            WSP(float, WS_MOD)[((size_t)l * 5 + r) * 12288 + n0 + col] = sacc + F.in[I_BADA][(size_t)l * 12288 + n0 + col]; }
        __syncthreads();
    }
    for (int i = F.bid * 512 + F.tid; i < 4096 * 64; i += F.G * 512) {
        const int pos = i >> 6, j = i & 63, fi = j & 31; const float fr = powf(10000.0f, -(float)(2 * fi) / 64.0f);
        const float ang = (float)(j < 32 ? (pos >> 6) : (pos & 63)) * fr;
        WSP(float, WS_COSH)[i] = cosf(ang); WSP(float, WS_SINH)[i] = sinf(ang);
    }
    for (int i = F.bid * 512 + F.tid; i < 4096 * 32; i += F.G * 512) {
        const int pos = i >> 5, j = i & 31, fi = j & 15; const float fr = powf(10000.0f, -(float)(2 * fi) / 32.0f);
        const float ang = (float)(j < 16 ? (pos >> 6) : (pos & 63)) * fr;
        WSP(float, WS_COSR)[i] = cosf(ang); WSP(float, WS_SINR)[i] = sinf(ang);
    }
    cvt_rows_fp4(F, F.in[I_PU], WSP(unsigned char, WS_UB), (size_t)2 * NEXP * 64, 0);
    cvt_rows_fp4(F, F.in[I_PV], WSP(unsigned char, WS_UB), (size_t)2 * NEXP * 64, 1);
}

__device__ __forceinline__ void ph_modulate0(const Ctx& F0) {
    const Ctx F = phase_ctx(F0);
    using namespace cf;
    const float* mod = WSP(float, WS_MOD);
    for (size_t i = (size_t)F.bid * 512 + F.tid; i < (size_t)MR * 256; i += (size_t)F.G * 512) {
        const int R = (int)(i >> 8), d = (int)(i & 255) * 8, b = R / RB, j = R % RB;
        const float* src = j < CTX ? F.in[I_CTX] + ((size_t)b * CTX + j) * 2048 : F.in[I_X] + ((size_t)b * S + (j - CTX)) * 2048;
        const float* m = mod + (size_t)(j < CTX ? 4 : b) * 12288;
        const f32x4 x0 = *(const f32x4*)(src + d), x1 = *(const f32x4*)(src + d + 4);
        const f32x4 sh0 = *(const f32x4*)(m + d), sh1 = *(const f32x4*)(m + d + 4), s0 = *(const f32x4*)(m + 2048 + d), s1 = *(const f32x4*)(m + 2048 + d + 4);
        *(u32x4*)(WSP(bf16_t, WS_HB) + (size_t)R * 2048 + d) = pg8::pack8(x0 * (s0 + 1.0f) + sh0, x1 * (s1 + 1.0f) + sh1);
    }
}

__device__ __forceinline__ void knorm_pass(const Ctx& F) {
    using namespace cf;
    bf16_t* P = WSP(bf16_t, WS_P); const float* ssk = WSP(const float, WS_SSK);
    for (int it = F.bid * 8 + F.wave; it < MR * 2; it += F.G * 8) {
        const int R = it >> 1, h = it & 1;
        const f32x2 pp = *(const f32x2*)(ssk + (size_t)it * 2); const float r = rsqrtf((pp.x + pp.y) * (1.f / 128.f) + 1e-6f);
        unsigned* q = (unsigned*)(P + (size_t)R * NC + PC_AK + h * 128) + F.lane;
        const unsigned w = *q; *q = cvt_pk_bf16(bflo(w) * r, bfhi(w) * r);
    }
}

struct AttnArgs {
    const bf16_t* Q; const bf16_t* K; const bf16_t* V; bf16_t* O; int ldq, ldk, ldv, ldo;
    int seg0_row, seg0_tiles, seg1_row, seg1_tiles;
    int mask_on, qpos0, kpos1;
    float sc_log2; int has_sink; float sink_l2;
    int variant;
    const float* qss;
};
constexpr float LOG2E_F = 1.4426950408889634f;
template <int DK, bool MASKED>
__device__ __forceinline__ void attn_unit(ldsp_t lds, const AttnArgs a, int wave_) {
    constexpr int ND = DK / 16, KCH = DK / 8, KPT = (64 * KCH) / 512, VST = 72, KM = DK == 128 ? 15 : 7;
    constexpr int KBUF = 64 * DK * 2, VBUF = 128 * VST * 2, VOFF = 2 * KBUF, ALOFF = VOFF + 3 * VBUF;
    int tid = wave_ * 64 + lane_id(); asm volatile("" : "+v"(tid));
    const int wid = __builtin_amdgcn_readfirstlane(tid >> 6), lane = tid & 63, q32 = lane & 31, hi = lane >> 5;
    LAS float* al = (LAS float*)(lds + ALOFF + wid * 128);
    bf16x8 qf[ND];
    { float scq = a.sc_log2;
      if (a.qss) { const f32x2 pp = *(const f32x2*)(a.qss + (size_t)(wid * 32 + q32) * 16); scq *= rsqrtf((pp.x + pp.y) * (1.f / 128.f) + 1e-6f); }
      const bf16_t* qrow = a.Q + (size_t)(wid * 32 + q32) * a.ldq + 8 * hi;
#pragma unroll
      for (int s = 0; s < ND; ++s) { const u32x4 w = *(const u32x4*)(qrow + 16 * s); u32x4 o;
          o.x = cvt_pk_bf16(bflo(w.x) * scq, bfhi(w.x) * scq); o.y = cvt_pk_bf16(bflo(w.y) * scq, bfhi(w.y) * scq);
          o.z = cvt_pk_bf16(bflo(w.z) * scq, bfhi(w.z) * scq); o.w = cvt_pk_bf16(bflo(w.w) * scq, bfhi(w.w) * scq); qf[s] = *(bf16x8*)&o; } }
    f32x16 o[4];
#pragma unroll
    for (int db = 0; db < 4; ++db)
#pragma unroll
        for (int r = 0; r < 16; ++r) o[db][r] = 0.f;
    float m_run = -1e30f, l_run = 0.f;
    const int PV_ = MK_AV ? a.variant : 0;
    const int ntiles = a.seg0_tiles + a.seg1_tiles;
    u32x4 vreg[2];
    const int vkp = tid & 31, vdc = tid >> 5;
    const int vkey = 2 * vkp, vpos = (vkey & 48) | ((vkey & 4) << 1) | ((vkey & 8) >> 1) | (vkey & 3);
    unsigned koff[KPT];
#pragma unroll
    for (int i = 0; i < KPT; ++i) { const int P = (i * 8 + wid) * 64 + lane, row = P / KCH, cp = P % KCH; koff[i] = (unsigned)(row * a.ldk + 8 * (cp ^ (row & KM))) * 2u; }
#define ATT_LOAD(tt, kb) do { const int _r0 = (tt) < a.seg0_tiles ? a.seg0_row + 64 * (tt) : a.seg1_row + 64 * ((tt) - a.seg0_tiles); \
        const char* _kg = (const char*)(a.K + (size_t)_r0 * a.ldk); \
        _Pragma("unroll") for (int _i = 0; _i < KPT; ++_i) __builtin_amdgcn_global_load_lds((const unsigned*)(_kg + koff[_i]), (LAS unsigned*)(lds + (kb) * KBUF + (_i * 8 + wid) * 1024), 16, 0, 0); \
        vreg[0] = *(const u32x4*)(a.V + (size_t)(_r0 + 2 * vkp) * a.ldv + 8 * vdc); vreg[1] = *(const u32x4*)(a.V + (size_t)(_r0 + 2 * vkp + 1) * a.ldv + 8 * vdc); } while (0)
#define ATT_WRITE(vb) do { const ldsp_t _vb = lds + VOFF + (vb) * VBUF; \
        const unsigned _a0[4] = {vreg[0].x, vreg[0].y, vreg[0].z, vreg[0].w}, _a1[4] = {vreg[1].x, vreg[1].y, vreg[1].z, vreg[1].w}; \
        _Pragma("unroll") for (int _e = 0; _e < 4; ++_e) { \
            *(LAS unsigned*)(_vb + ((8 * vdc + 2 * _e) * VST + vpos) * 2) = (_a0[_e] & 0xffffu) | (_a1[_e] << 16); \
            *(LAS unsigned*)(_vb + ((8 * vdc + 2 * _e + 1) * VST + vpos) * 2) = (_a0[_e] >> 16) | (_a1[_e] & 0xffff0000u); } } while (0)
#define ATT_PV(vb) do { const ldsp_t _vt = lds + VOFF + (vb) * VBUF; \
        _Pragma("unroll") for (int db = 0; db < 4; ++db) _Pragma("unroll") for (int ks = 0; ks < 4; ++ks) { \
            const bf16x8 vf = *(const LAS bf16x8*)(_vt + ((32 * db + q32) * VST + 16 * ks + 8 * hi) * 2); \
            o[db] = __builtin_amdgcn_mfma_f32_32x32x16_bf16(pa[ks], vf, o[db], 0, 0, 0); } } while (0)
    bf16x8 pa[4];
#pragma unroll
    for (int i = 0; i < 4; ++i) pa[i] = (bf16x8){0, 0, 0, 0, 0, 0, 0, 0};
    int vprev = 2, vcur = 0, vnext = 1;
    { unsigned z0 = 0u; asm volatile("" : "+v"(z0));
      for (int i = tid; i < VBUF / 16; i += 512) *(LAS u32x4*)(lds + VOFF + 2 * VBUF + i * 16) = (u32x4){z0, z0, z0, z0}; }
    ATT_LOAD(0, 0);
    ATT_WRITE(0);
    asm volatile("s_waitcnt vmcnt(0)" ::: "memory");
    __syncthreads();
    for (int tt = 0; tt < ntiles; ++tt) {
        const int cur = tt & 1;
        if (tt + 1 < ntiles && PV_ != 4) ATT_LOAD(tt + 1, cur ^ 1);
        const ldsp_t Ks = lds + cur * KBUF;
        f32x16 s0, s1;
#pragma unroll
        for (int r = 0; r < 16; ++r) { s0[r] = 0.f; s1[r] = 0.f; }
        { bf16x8 kf[2][2];
#define ATT_LDK(p, sb) do { kf[p][0] = *(const LAS bf16x8*)(Ks + (q32 * KCH + ((2 * (sb) + hi) ^ (q32 & KM))) * 16); kf[p][1] = *(const LAS bf16x8*)(Ks + ((32 + q32) * KCH + ((2 * (sb) + hi) ^ (q32 & KM))) * 16); } while (0)
          if (PV_ != 2) {
          ATT_LDK(0, 0);
#pragma unroll
          for (int sb = 0; sb < ND; ++sb) {
              if (sb + 1 < ND) ATT_LDK((sb + 1) & 1, sb + 1);
              s0 = __builtin_amdgcn_mfma_f32_32x32x16_bf16(kf[sb & 1][0], qf[sb], s0, 0, 0, 0);
              s1 = __builtin_amdgcn_mfma_f32_32x32x16_bf16(kf[sb & 1][1], qf[sb], s1, 0, 0, 0);
              }
          }
#undef ATT_LDK
        }
        const bool msk = MASKED && a.mask_on && tt >= a.seg0_tiles;
        if (MASKED) { const int kp0 = a.kpos1 + 64 * (tt - a.seg0_tiles) + 4 * hi, qp = a.qpos0 + wid * 32 + q32;
#pragma unroll
            for (int r = 0; r < 16; ++r) { float t0 = s0[r], t1 = s1[r];
                if (msk) { const int d0 = qp - (kp0 + (r & 3) + 8 * (r >> 2)), d1 = d0 - 32; if (d0 > 128 || d0 < -128) t0 = -1e30f; if (d1 > 128 || d1 < -128) t1 = -1e30f; s0[r] = t0; s1[r] = t1; } }
            __builtin_amdgcn_sched_barrier(0); }
        float mx = -1e30f, m_new = 0.f, alpha = 1.f, ps = 0.f;
        bf16x8 pn[4] = {pa[0], pa[1], pa[2], pa[3]};
        { const ldsp_t _vt = lds + VOFF + vprev * VBUF; bf16x8 vfr[3]; vfr[2] = pa[0];
#define ATT_LDV(i) (*(const LAS bf16x8*)(_vt + ((32 * ((i) >> 2) + q32) * VST + 16 * ((i) & 3) + 8 * hi) * 2))
#define SCV(e) ((e) < 16 ? s0[(e) & 15] : s1[(e) & 15])
          vfr[0] = ATT_LDV(0); vfr[1] = ATT_LDV(1);
#pragma unroll
          for (int i = 0; i < 16; ++i) {
              if (PV_ != 3) { if (i + 2 < 16) vfr[(i + 2) % 3] = ATT_LDV(i + 2);
              o[i >> 2] = __builtin_amdgcn_mfma_f32_32x32x16_bf16(pa[i & 3], vfr[i % 3], o[i >> 2], 0, 0, 0); }
              if (PV_ == 1) {} else if (i < 4) {
#pragma unroll
                  for (int e = 0; e < 4; ++e) mx = fmaxf(mx, fmaxf(s0[4 * i + e], s1[4 * i + e]));
              } else if (i == 4) {
                  { const auto rr = __builtin_amdgcn_permlane32_swap(__float_as_uint(mx), __float_as_uint(mx), false, false);
                    mx = fmaxf(__uint_as_float(rr[0]), __uint_as_float(rr[1])); }
                  if (__all(mx - m_run <= 8.0f * LOG2E_F)) { m_new = m_run; alpha = 1.f; }
                  else { m_new = fmaxf(m_run, mx); alpha = __builtin_amdgcn_exp2f(m_run - m_new); m_run = m_new; }
              } else if (i < 13) {
#pragma unroll
                  for (int e = 0; e < 2; ++e) { const int r = 2 * (i - 5) + e; s0[r] = __builtin_amdgcn_exp2f(s0[r] - m_new); s1[r] = __builtin_amdgcn_exp2f(s1[r] - m_new); ps += s0[r] + s1[r]; }
              } else if (i == 13) {
                  u32x4 w; w.x = cvt_pk_bf16(s0[0], s0[1]); w.y = cvt_pk_bf16(s0[2], s0[3]); w.z = cvt_pk_bf16(s0[4], s0[5]); w.w = cvt_pk_bf16(s0[6], s0[7]); pn[0] = *(bf16x8*)&w;
                  u32x4 v; v.x = cvt_pk_bf16(s0[8], s0[9]); v.y = cvt_pk_bf16(s0[10], s0[11]); v.z = cvt_pk_bf16(s0[12], s0[13]); v.w = cvt_pk_bf16(s0[14], s0[15]); pn[1] = *(bf16x8*)&v;
              } else if (i == 14) {
                  u32x4 w; w.x = cvt_pk_bf16(s1[0], s1[1]); w.y = cvt_pk_bf16(s1[2], s1[3]); w.z = cvt_pk_bf16(s1[4], s1[5]); w.w = cvt_pk_bf16(s1[6], s1[7]); pn[2] = *(bf16x8*)&w;
                  u32x4 v; v.x = cvt_pk_bf16(s1[8], s1[9]); v.y = cvt_pk_bf16(s1[10], s1[11]); v.z = cvt_pk_bf16(s1[12], s1[13]); v.w = cvt_pk_bf16(s1[14], s1[15]); pn[3] = *(bf16x8*)&v;
              } else { l_run = l_run * alpha + ps; }
          }
#undef ATT_LDV
#undef SCV
        }
#pragma unroll
        for (int i = 0; i < 4; ++i) pa[i] = pn[i];
        if (__any(alpha < 1.0f)) {
            if (hi == 0) al[q32] = alpha;
            asm volatile("s_waitcnt lgkmcnt(0)" ::: "memory");
#pragma unroll
            for (int g4 = 0; g4 < 4; ++g4) { const f32x4 av = *(const LAS f32x4*)(al + 8 * g4 + 4 * hi);
#pragma unroll
                for (int db = 0; db < 4; ++db)
#pragma unroll
                    for (int j = 0; j < 4; ++j) o[db][4 * g4 + j] *= av[j]; }
        }
        if (tt + 1 < ntiles && PV_ != 4) ATT_WRITE(vnext);
        { const int t3 = vprev; vprev = vcur; vcur = vnext; vnext = t3; }
        asm volatile("s_waitcnt vmcnt(0)" ::: "memory");
        if (PV_ != 5) __syncthreads();
    }
    ATT_PV(vprev);
#undef ATT_LOAD
#undef ATT_WRITE
#undef ATT_PV
    __syncthreads();
    float l_tot; { const auto rr = __builtin_amdgcn_permlane32_swap(__float_as_uint(l_run), __float_as_uint(l_run), false, false); l_tot = __uint_as_float(rr[0]) + __uint_as_float(rr[1]); }
    if (a.has_sink) l_tot += __builtin_amdgcn_exp2f(a.sink_l2 - m_run);
    if (hi == 0) al[q32] = 1.0f / l_tot;
    asm volatile("s_waitcnt lgkmcnt(0)" ::: "memory");
    const ldsp_t Ost = lds + wid * 8192;
#pragma unroll
    for (int g4 = 0; g4 < 4; ++g4) { const f32x4 iv = *(const LAS f32x4*)(al + 8 * g4 + 4 * hi);
#pragma unroll
        for (int db = 0; db < 4; ++db)
#pragma unroll
            for (int j = 0; j < 4; ++j) *(LAS bf16_t*)(Ost + ((8 * g4 + 4 * hi + j) * 128 + 32 * db + q32) * 2) = f2bf(o[db][4 * g4 + j] * iv[j]); }
    asm volatile("s_waitcnt lgkmcnt(0)" ::: "memory");
    const int lane_o = lane_id();
#pragma unroll
    for (int i = 0; i < 8; ++i) { const int c = lane_o + 64 * i, row = c >> 4, c8 = c & 15;
        *(u32x4*)(a.O + (size_t)(wid * 32 + row) * a.ldo + 8 * c8) = *(const LAS u32x4*)(Ost + (row * 128 + 8 * c8) * 2); }
}

__device__ __forceinline__ void conv_unit(const Ctx& F, int layer, int row0  , int seq_len, int t0) {
    using namespace cf;
    const bf16_t* P = WSP(const bf16_t, WS_P); bf16_t* BR = WSP(bf16_t, WS_BR);
    const float* cw = F.in[I_CW] + (size_t)layer * 31 * 1024; const float* cb = F.in[I_CB] + layer * 1024;
    const float* lg = F.in[I_CLG] + layer * 1024; const float* lb = F.in[I_CLB] + layer * 1024;
    int tid = F.wave * 64 + lane_id(); asm volatile("" : "+v"(tid));
    const int lane = tid & 63;
    LAS float* red = (LAS float*)(F.lds + 126976); LAS float* tot = red + 8 * 32;
    __syncthreads();
    for (int c = tid; c < 62 * 128; c += 512) { const int rr = c >> 7, ch = c & 127, t = t0 - 15 + rr;
        u32x4 v = {0u, 0u, 0u, 0u};
        if (t >= 0 && t < seq_len) v = *(const u32x4*)(P + (size_t)(row0 + t) * NC + PC_GLU + ch * 8);
        *(LAS u32x4*)(F.lds + rr * 2048 + ch * 16) = v; }
    float w0[31], w1[31];
#pragma unroll
    for (int k = 0; k < 31; ++k) { const f32x2 w = *(const f32x2*)(cw + k * 1024 + 2 * tid); w0[k] = w.x; w1[k] = w.y; }
    const f32x2 bv = *(const f32x2*)(cb + 2 * tid), gg = *(const f32x2*)(lg + 2 * tid), bb = *(const f32x2*)(lb + 2 * tid);
    __syncthreads();
#pragma unroll 1
    for (int part = 0; part < 4; ++part) {
        float a0[8], a1[8];
#pragma unroll
        for (int t = 0; t < 8; ++t) { a0[t] = bv.x; a1[t] = bv.y; }
        const ldsp_t base = F.lds + part * 8 * 2048 + tid * 4;
#pragma unroll
        for (int rr = 0; rr < 38; ++rr) { const unsigned xw = *(const LAS unsigned*)(base + rr * 2048); const float x0 = bflo(xw), x1 = bfhi(xw);
#pragma unroll
            for (int t = 0; t < 8; ++t) { const int k = rr - t; if (k >= 0 && k <= 30) { a0[t] += x0 * w0[k]; a1[t] += x1 * w1[k]; } } }
        float v[16];
#pragma unroll
        for (int t = 0; t < 8; ++t) { v[t] = a0[t] + a1[t]; v[8 + t] = a0[t] * a0[t] + a1[t] * a1[t]; }
#pragma unroll
        for (int i = 0; i < 8; ++i) { const bool up = lane & 32; const float snd = up ? v[i] : v[i + 8], kp = up ? v[i + 8] : v[i]; v[i] = kp + shx(snd, 32, lane); }
#pragma unroll
        for (int i = 0; i < 4; ++i) { const bool up = lane & 16; const float snd = up ? v[i] : v[i + 4], kp = up ? v[i + 4] : v[i]; v[i] = kp + shx(snd, 16, lane); }
#pragma unroll
        for (int i = 0; i < 2; ++i) { const bool up = lane & 8; const float snd = up ? v[i] : v[i + 2], kp = up ? v[i + 2] : v[i]; v[i] = kp + shx(snd, 8, lane); }
        { const bool up = lane & 4; const float snd = up ? v[0] : v[1], kp = up ? v[1] : v[0]; v[0] = kp + shx(snd, 4, lane); }
        v[0] += shx(v[0], 2, lane); v[0] += shx(v[0], 1, lane);
        if ((lane & 3) == 0) red[F.wave * 16 + (lane >> 2)] = v[0];
        __syncthreads();
        if (tid < 16) { float s = 0.f;
#pragma unroll
            for (int w = 0; w < 8; ++w) s += red[w * 16 + tid];
            tot[tid] = s; }
        __syncthreads();
#pragma unroll
        for (int t = 0; t < 8; ++t) { const float mean = tot[t] * (1.f / 1024.f), var = fmaxf(tot[8 + t] * (1.f / 1024.f) - mean * mean, 0.f), rstd = rsqrtf(var + 1e-5f);
            const float y0 = (a0[t] - mean) * rstd * gg.x + bb.x, y1 = (a1[t] - mean) * rstd * gg.y + bb.y;
            *(unsigned*)(BR + (size_t)(row0 + t0 + part * 8 + t) * 4096 + 2048 + 2 * tid) = cvt_pk_bf16(y0 * sigmoidf_(y0), y1 * sigmoidf_(y1)); }
    }
}

__device__ __forceinline__ void attn_defaults(AttnArgs& a, int isctx) {
    a.seg0_row = 0; a.seg0_tiles = isctx ? 4 : 68; a.seg1_row = 0; a.seg1_tiles = 0; a.mask_on = 0; a.qpos0 = 0; a.kpos1 = 0; a.has_sink = 0; a.sink_l2 = 0.f; a.qss = nullptr; a.variant = 0; }
__device__ __forceinline__ void attn_unit_decode(int u, int G, bool gqa, int& b, int& h, int& qb) {
    if (G != 256) { b = u >> 7; h = (u >> 4) & 7; qb = u & 15; return; }
    const int bid = u & 255, r = u >> 8, x = bid & 7, local = (bid >> 3) + 32 * r;
    qb = local & 15;
    if (gqa) { b = x >> 1; h = (x & 1) * 4 + (local >> 4); }
    else { const int pair = x * 4 + (local >> 4); b = pair >> 3; h = pair & 7; }
}
__device__ __forceinline__ void ph_attn(const Ctx& F0, int layer) {
    const Ctx F = phase_ctx(F0);
    using namespace cf;
    const bf16_t* P = WSP(const bf16_t, WS_P); bf16_t* BR = WSP(bf16_t, WS_BR);
    for (int dup = 0; dup < DUPN(2); ++dup)
    for (int u = F.bid; u < (layer == 0 ? 544 : 512); u += F.G) {
        int b, h, qb, isctx = 0;
        if (u < 512) attn_unit_decode(u, F.G, false, b, h, qb); else { const int r = u - 512; b = r >> 3; h = r & 7; qb = 0; isctx = 1; }
        const size_t brow = (size_t)b * RB, qrow = brow + (isctx ? 0 : CTX) + (size_t)qb * 256;
        AttnArgs a; attn_defaults(a, isctx);
        a.Q = WSP(const bf16_t, WS_QB) + qrow * 1536 + h * 192; a.ldq = 1536;
        a.K = WSP(const bf16_t, WS_KB) + brow * 1536 + h * 192; a.ldk = 1536;
        a.V = WSP(const bf16_t, WS_VB) + brow * 1024 + h * 128; a.ldv = 1024;
        a.O = BR + qrow * 4096 + 1024 + h * 128; a.ldo = 4096; a.sc_log2 = SCALE_MLA * LOG2E;
        __syncthreads();
        attn_unit<192, false>(F.lds, a, F.wave);
    }
    for (int dup = 0; dup < DUPN(3); ++dup)
    for (int u0 = F.bid; u0 < (layer == 0 ? 544 : 512); u0 += F.G) {
        int b, h, qb, isctx = 0;
        if (u0 < 512) attn_unit_decode(u0, F.G, true, b, h, qb); else { const int r = u0 - 512; b = r >> 3; h = r & 7; qb = 0; isctx = 1; }
        const size_t brow = (size_t)b * RB, qrow = brow + (isctx ? 0 : CTX) + (size_t)qb * 256;
        AttnArgs a; attn_defaults(a, isctx);
        a.Q = P + qrow * NC + PC_AQ + h * 128; a.ldq = NC;
        a.K = P + brow * NC + PC_AK + (h >> 2) * 128; a.ldk = NC;
        a.V = P + brow * NC + PC_AV + (h >> 2) * 128; a.ldv = NC;
        a.O = BR + qrow * 4096 + h * 128; a.ldo = 4096; a.sc_log2 = SCALE_HD * LOG2E;
        a.qss = WSP(const float, WS_SSQ) + qrow * 16 + h * 2;
        if (MK_AV && dup == 1) { a.variant = MK_AV; a.O = WSP(bf16_t, WS_HB) + qrow * 2048 + h * 128; a.ldo = 2048; }
        __syncthreads();
        attn_unit<128, false>(F.lds, a, F.wave);
    }
    for (int dup = 0; dup < DUPN(13); ++dup)
    for (int u0 = F.bid; u0 < (layer == 0 ? 544 : 512); u0 += F.G) {
        int b, h, qb, isctx = 0;
        if (u0 < 512) attn_unit_decode(u0, F.G, true, b, h, qb); else { const int r = u0 - 512; b = r >> 3; h = r & 7; qb = 0; isctx = 1; }
        const size_t brow = (size_t)b * RB, qrow = brow + (isctx ? 0 : CTX) + (size_t)qb * 256;
        AttnArgs a; attn_defaults(a, isctx);
        a.Q = P + qrow * NC + PC_DQ + h * 128; a.ldq = NC;
        a.K = P + brow * NC + PC_DK + (h >> 2) * 128; a.ldk = NC;
        a.V = P + brow * NC + PC_DV + (h >> 2) * 128; a.ldv = NC;
        a.O = BR + qrow * 4096 + 3072 + h * 128; a.ldo = 4096; a.sc_log2 = SCALE_HD * LOG2E;
        a.has_sink = 1; a.sink_l2 = F.in[I_SINK][layer * 8 + h] * LOG2E; a.seg0_tiles = 4;
        if (!isctx) { const int start = qb * 256; const int lo = start - 128 < 0 ? 0 : start - 128, hi = start + 384 > S ? S : start + 384;
            a.seg1_row = CTX + lo; a.seg1_tiles = (hi - lo) / 64; a.mask_on = 1; a.qpos0 = start; a.kpos1 = lo; }
        __syncthreads();
        attn_unit<128, true>(F.lds, a, F.wave);
    }
    for (int dup = 0; dup < DUPN(4); ++dup)
    for (int u = F.bid; u < (layer == 0 ? 544 : 512); u += F.G) {
        int b, tb, isctx = 0;
        if (u < 512) { b = u >> 7; tb = u & 127; } else { const int r = u - 512; b = r >> 3; tb = r & 7; isctx = 1; }
        conv_unit(F, layer, b * RB + (isctx ? 0 : CTX), isctx ? CTX : S, tb * 32);
    }
}

__device__ __forceinline__ int tok_row(int layer, int tok) { return layer == 0 ? tok : (tok >> 12) * cf::RB + cf::CTX + (tok & 4095); }
__device__ __forceinline__ void ph_ln1(const Ctx& F0, int layer) {
    const Ctx F = phase_ctx(F0);
    using namespace cf;
    float* X1 = (float*)(F.ws + WS_P + X1_OFF); bf16_t* HB = WSP(bf16_t, WS_HB);
    const float* lg = F.in[I_LN1G] + layer * 2048; const float* lb = F.in[I_LN1B] + layer * 2048;
    const int ntok = layer == 0 ? MR : NB * S, lane = F.lane;
    for (int tok = F.bid * 8 + F.wave; tok < ntok; tok += F.G * 8) {
        const int R = tok_row(layer, tok), b = R / RB, j = R % RB;
        const float* mod = WSP(const float, WS_MOD) + ((size_t)layer * 5 + (j < CTX ? 4 : b)) * 12288;
        float* xp = X1 + (size_t)R * 2048;
        f32x4 v[8]; float s = 0.f;
#pragma unroll
        for (int i = 0; i < 8; ++i) { v[i] = *(const f32x4*)(xp + lane * 4 + 256 * i); s += (v[i][0] + v[i][1]) + (v[i][2] + v[i][3]); }
        const float mean = wave_sum(s, lane) * (1.f / 2048.f); float q = 0.f;
#pragma unroll
        for (int i = 0; i < 8; ++i) { const f32x4 d = v[i] - mean; q += (d[0] * d[0] + d[1] * d[1]) + (d[2] * d[2] + d[3] * d[3]); }
        const float rstd = rsqrtf(wave_sum(q, lane) * (1.f / 2048.f) + 1e-5f);
#pragma unroll
        for (int i = 0; i < 8; ++i) { const int c = lane * 4 + 256 * i;
            const f32x4 y = (v[i] - mean) * rstd * *(const f32x4*)(lg + c) + *(const f32x4*)(lb + c);
            *(f32x4*)(xp + c) = y;
            const f32x4 hp = y * (*(const f32x4*)(mod + 4 * 2048 + c) + 1.0f) + *(const f32x4*)(mod + 3 * 2048 + c);
            u32x2 w; w.x = cvt_pk_bf16(hp[0], hp[1]); w.y = cvt_pk_bf16(hp[2], hp[3]);
            *(u32x2*)(HB + (size_t)R * 2048 + c) = w; }
    }
}

typedef __bf16 bf16x2_t __attribute__((ext_vector_type(2)));
__device__ __forceinline__ unsigned ordkey(float v) { const unsigned u = __float_as_uint(v); return (u & 0x80000000u) ? ~u : (u | 0x80000000u); }
__device__ __forceinline__ int lane_rank(unsigned long long m) { return (int)__builtin_amdgcn_mbcnt_hi((unsigned)(m >> 32), __builtin_amdgcn_mbcnt_lo((unsigned)m, 0u)); }
template <int NV> __device__ __forceinline__ unsigned radix_thresh16(const unsigned (&k)[NV]) {
    unsigned T = 0u;
    for (int bit = 31; bit >= 0; --bit) { const unsigned cand = T | (1u << bit); int cnt = 0;
#pragma unroll
        for (int v = 0; v < NV; ++v) cnt += __popcll(__ballot(k[v] >= cand));
        if (cnt >= 16) { T = cand; if (cnt == 16) break; } }
    return T;
}
__device__ __forceinline__ void radix_thresh16x2(const unsigned (&ka)[2], const unsigned (&kb)[2], unsigned& Ta, unsigned& Tb) {
    unsigned T0 = 0u, T1 = 0u; bool d0 = false, d1 = false;
    for (int bit = 31; bit >= 0; --bit) { const unsigned c0 = T0 | (1u << bit), c1 = T1 | (1u << bit);
        const int n0 = __popcll(__ballot(ka[0] >= c0)) + __popcll(__ballot(ka[1] >= c0)), n1 = __popcll(__ballot(kb[0] >= c1)) + __popcll(__ballot(kb[1] >= c1));
        if (!d0 && n0 >= 16) { T0 = c0; d0 = n0 == 16; }
        if (!d1 && n1 >= 16) { T1 = c1; d1 = n1 == 16; }
        if (d0 && d1) break; }
    Ta = T0; Tb = T1;
}
__device__ __forceinline__ float dot2bf(unsigned a, unsigned b, float acc) { return __builtin_amdgcn_fdot2_f32_bf16(__builtin_bit_cast(bf16x2_t, a), __builtin_bit_cast(bf16x2_t, b), acc, false); }
__device__ __forceinline__ float dot8(const u32x4 a, const u32x4 b, float acc) {
    acc = dot2bf(a.x, b.x, acc); acc = dot2bf(a.y, b.y, acc); acc = dot2bf(a.z, b.z, acc); acc = dot2bf(a.w, b.w, acc);
    return acc;
}
__device__ __forceinline__ float gelu_as(float v) {
    const float av = fabsf(v), t = __builtin_amdgcn_rcpf(av * 0.2316418882f + 1.0f);
    float q = t * 0.5307027145f + (-0.7265760135f); q = q * t + 0.7107068705f; q = q * t + (-0.142248368f); q = q * t + 0.127414796f; q = q * t;
    const float e = __builtin_amdgcn_exp2f((v * v) * (-0.72134752044f)), m = v * (q * e);
    return v < 0.f ? m : v - m;
}
__device__ __forceinline__ void peer_load(u32x4 (&ur)[4], u32x4 (&vr)[4], unsigned (&vs)[4], float (&gq)[4], const LAS int* ei, const LAS float* eg,
                                          const unsigned char* UV, int lane, int grp) {
#pragma unroll
    for (int q = 0; q < 4; ++q) { const int id = __builtin_amdgcn_readfirstlane(ei[grp * 4 + q]); gq[q] = __uint_as_float(__builtin_amdgcn_readfirstlane(__float_as_uint(eg[grp * 4 + q])));
        const unsigned char* row = UV + (size_t)id * UV_ROW;
        ur[q] = *(const u32x4*)(row + lane * 16); vr[q] = *(const u32x4*)(row + 1024 + lane * 16); vs[q] = *(const unsigned short*)(row + 2048 + 2 * lane); }
}
__device__ __forceinline__ void peer_comp(const u32x4 (&ur)[4], const u32x4 (&vr)[4], const unsigned (&vs)[4], const float (&gq)[4], const f32x2 (&xf)[16], f32x2 (&y2)[16], int lane) {
    float d[4];
#pragma unroll
    for (int q = 0; q < 4; ++q) { f32x2 t = {0.f, 0.f};
#pragma unroll
        for (int j = 0; j < 4; ++j) { const unsigned uw = ur[q][j];
            t += __builtin_amdgcn_cvt_scalef32_pk_f32_fp4(uw, 1.0f, 0) * xf[4 * j + 0]; t += __builtin_amdgcn_cvt_scalef32_pk_f32_fp4(uw, 1.0f, 1) * xf[4 * j + 1];
            t += __builtin_amdgcn_cvt_scalef32_pk_f32_fp4(uw, 1.0f, 2) * xf[4 * j + 2]; t += __builtin_amdgcn_cvt_scalef32_pk_f32_fp4(uw, 1.0f, 3) * xf[4 * j + 3]; }
        d[q] = (t.x + t.y) * uv_scale(vs[q] & 255u); }
#pragma unroll
    for (int o = 32; o >= 1; o >>= 1) {
#pragma unroll
        for (int q = 0; q < 4; ++q) d[q] += shx(d[q], o, lane); }
#pragma unroll
    for (int q = 0; q < 4; ++q) { const float w = gq[q] * gelu_as(d[q]) * uv_scale(vs[q] >> 8);
        const f32x2 w2 = {w, w};
#pragma unroll
        for (int j = 0; j < 4; ++j) { const unsigned vw = vr[q][j];
            y2[4 * j + 0] += w2 * __builtin_amdgcn_cvt_scalef32_pk_f32_fp4(vw, 1.0f, 0); y2[4 * j + 1] += w2 * __builtin_amdgcn_cvt_scalef32_pk_f32_fp4(vw, 1.0f, 1);
            y2[4 * j + 2] += w2 * __builtin_amdgcn_cvt_scalef32_pk_f32_fp4(vw, 1.0f, 2); y2[4 * j + 3] += w2 * __builtin_amdgcn_cvt_scalef32_pk_f32_fp4(vw, 1.0f, 3); } }
}
__device__ __forceinline__ unsigned inv_ordkey(unsigned k) { return (k & 0x80000000u) ? (k & 0x7fffffffu) : ~k; }
template <int B> __device__ __forceinline__ void bit_transpose32(unsigned (&A)[64]) {
#pragma unroll
    for (int k = 0; k < 16; ++k) { const unsigned a = A[B + k], b = A[B + k + 16]; A[B + k] = __builtin_amdgcn_perm(b, a, 0x05040100u); A[B + k + 16] = __builtin_amdgcn_perm(b, a, 0x07060302u); }
#pragma unroll
    for (int k = 0; k < 32; ++k) if (!(k & 8)) { const unsigned a = A[B + k], b = A[B + k + 8]; A[B + k] = __builtin_amdgcn_perm(b, a, 0x06020400u); A[B + k + 8] = __builtin_amdgcn_perm(b, a, 0x07030501u); }
#pragma unroll
    for (int k = 0; k < 32; ++k) if (!(k & 4)) { const unsigned a = A[B + k], b = A[B + k + 4]; A[B + k] = (a & 0x0F0F0F0Fu) | ((b << 4) & 0xF0F0F0F0u); A[B + k + 4] = ((a >> 4) & 0x0F0F0F0Fu) | (b & 0xF0F0F0F0u); }
#pragma unroll
    for (int k = 0; k < 32; ++k) if (!(k & 2)) { const unsigned a = A[B + k], b = A[B + k + 2]; A[B + k] = (a & 0x33333333u) | ((b << 2) & 0xCCCCCCCCu); A[B + k + 2] = ((a >> 2) & 0x33333333u) | (b & 0xCCCCCCCCu); }
#pragma unroll
    for (int k = 0; k < 32; ++k) if (!(k & 1)) { const unsigned a = A[B + k], b = A[B + k + 1]; A[B + k] = (a & 0x55555555u) | ((b << 1) & 0xAAAAAAAAu); A[B + k + 1] = ((a >> 1) & 0x55555555u) | (b & 0xAAAAAAAAu); }
}
template <int GRP> __device__ __forceinline__ unsigned lane_radix16(const unsigned (&key)[64], int lane, int& own) {
    unsigned P[64];
#pragma unroll
    for (int n = 0; n < 64; ++n) P[n] = key[n];
    bit_transpose32<0>(P); bit_transpose32<32>(P);
    unsigned T = 0u, act_lo = ~0u, act_hi = ~0u; int above = 0; bool done = false;
#pragma unroll
    for (int bit = 31; bit >= 0; --bit) {
        const unsigned m_lo = act_lo & P[bit], m_hi = act_hi & P[32 + bit];
        const int mine = above + __builtin_popcount(m_lo) + __builtin_popcount(m_hi);
        int tot = mine + __builtin_amdgcn_ds_bpermute((lane ^ 1) << 2, mine);
        if (GRP >= 4) tot += __builtin_amdgcn_ds_bpermute((lane ^ 2) << 2, tot);
        const bool ge = tot >= 16;
        if (ge && !done) T |= 1u << bit;
        act_lo = ge ? m_lo : act_lo & ~m_lo; act_hi = ge ? m_hi : act_hi & ~m_hi;
        above = ge ? above : mine;
        if (tot == 16) { above = mine; act_lo = 0u; act_hi = 0u; done = true; }
        if (__all(done)) break; }
    own = above + __builtin_popcount(act_lo) + __builtin_popcount(act_hi);
    return T;
}
template <int N> __device__ __forceinline__ void compact_ge(const unsigned (&key)[N], unsigned T, int pos, unsigned base, unsigned dump) {
#pragma unroll
    for (int n = 0; n < N; n += 2) { unsigned long long m0, m1; unsigned a0, a1;
        asm("v_cmp_ge_u32_e64 %3, %5, %7\n\tv_cmp_ge_u32_e64 %4, %6, %7\n\tv_lshl_add_u32 %1, %0, 2, %8\n\tv_cndmask_b32_e64 %1, %9, %1, %3\n\tv_addc_co_u32_e64 %0, vcc, 0, %0, %3\n\t"
            "v_lshl_add_u32 %2, %0, 2, %8\n\tv_cndmask_b32_e64 %2, %9, %2, %4\n\tv_addc_co_u32_e64 %0, vcc, 0, %0, %4"
            : "+v"(pos), "=&v"(a0), "=&v"(a1), "=&s"(m0), "=&s"(m1) : "v"(key[n]), "v"(key[n + 1]), "v"(T), "v"(base), "v"(dump) : "vcc");
        *(LAS unsigned*)(size_t)a0 = key[n]; *(LAS unsigned*)(size_t)a1 = key[n + 1]; }
}
template <int MODE> __device__ __forceinline__ void ph_peer(const Ctx& F0, int layer) {
    const Ctx F = phase_ctx(F0);
    using namespace cf;
    const float* SC = (const float*)(F.ws + WS_P + SC_OFF); const float* X1 = (const float*)(F.ws + WS_P + X1_OFF);
    bf16_t* HB = WSP(bf16_t, WS_HB); const unsigned char* UV = WSP(const unsigned char, WS_UB) + (size_t)layer * NEXP * UV_ROW;
    const float* lg = F.in[I_LN2G] + layer * 2048; const float* lb = F.in[I_LN2B] + layer * 2048;
    const int ntok = layer == 0 ? MR : NB * S;
    constexpr int NSLOT = 34;
    ldsp_t ring = F.lds;
#ifndef NPROD
#define NPROD 2
#endif
    const int pw = F.wave - (8 - NPROD);
    ldsp_t pscr = F.lds + 73728 + (pw < 0 ? 0 : pw) * 6144;
    LAS unsigned* lstA = (LAS unsigned*)(pscr);
    LAS unsigned* lstB = (LAS unsigned*)(pscr + 2176);
    LAS unsigned* dmp = (LAS unsigned*)(pscr + 3200);
    volatile LAS unsigned* ready = (volatile LAS unsigned*)(F.lds + 71680); LAS unsigned* next_tok = (LAS unsigned*)(F.lds + 71680 + NSLOT * 4);
    __syncthreads();
    if (F.tid < NSLOT + 1) ((LAS unsigned*)(F.lds + 71680))[F.tid] = 0u;
    __syncthreads();
    const int ntw = ntok / F.G;
    if (pw >= 0) {
      for (int p = pw; p < ntw / 2; p += NPROD) {
        const int slot = p;
        LAS int* ei4 = (LAS int*)(ring + slot * 2048); LAS float* eg4 = (LAS float*)(ring + slot * 2048 + 512);
        const int tok0 = F.bid + (2 * p) * F.G, nwv = F.G;
        if (MODE != 2) {
        { int lane = F.lane; asm volatile("" : "+v"(lane));
          const int t2 = lane >> 5, set = lane >> 1, sset = set & 15, part = lane & 1;
          const int Rl = tok_row(layer, tok0 + t2 * nwv);
          unsigned key[64];
          const float* sp = SC + (size_t)Rl * 2048 + sset * 128 + part * 64;
#pragma unroll
          for (int i = 0; i < 16; ++i) { const f32x4 v = *(const f32x4*)(sp + 4 * i);
#pragma unroll
              for (int e = 0; e < 4; ++e) key[4 * i + e] = (ordkey(v[e]) & ~127u) | (unsigned)(127 - (64 * part + 4 * i + e)); }
          int own; const unsigned T = lane_radix16<2>(key, lane, own);
          const int oth = __builtin_amdgcn_ds_bpermute((lane ^ 1) << 2, own);
          compact_ge<64>(key, T, part ? oth : 0, (unsigned)(size_t)lstA + set * 68, (unsigned)(size_t)dmp + lane * 4);
        }
        asm volatile("s_waitcnt lgkmcnt(0)" ::: "memory");
        {
          int lane = F.lane; asm volatile("" : "+v"(lane));
          const int q = lane & 3, sa = (lane >> 2) * 2, sb = sa + 1;
          float Av[4], Bv[16];
#pragma unroll
          for (int i = 0; i < 4; ++i) Av[i] = __uint_as_float(inv_ordkey((lstA[sa * 17 + 4 * q + i] & ~127u) | 64u));
#pragma unroll
          for (int jx = 0; jx < 16; ++jx) Bv[jx] = __uint_as_float(inv_ordkey((lstA[sb * 17 + jx] & ~127u) | 64u));
          unsigned key[64];
#pragma unroll
          for (int i = 0; i < 4; ++i)
#pragma unroll
              for (int jx = 0; jx < 16; ++jx) key[i * 16 + jx] = (ordkey(Av[i] + Bv[jx]) & ~255u) | (unsigned)(255 - ((4 * q + i) * 16 + jx));
          int mine; const unsigned T = lane_radix16<4>(key, lane, mine);
          const int c1 = __builtin_amdgcn_ds_bpermute((lane ^ 1) << 2, mine), c2 = __builtin_amdgcn_ds_bpermute((lane ^ 2) << 2, mine), c3 = __builtin_amdgcn_ds_bpermute((lane ^ 3) << 2, mine);
          const int c = (q == 1) ? c1 : (q == 2) ? c2 + c3 : (q == 3) ? c1 + c2 + c3 : 0;
          compact_ge<64>(key, T, c, (unsigned)(size_t)lstB + (lane >> 2) * 64, (unsigned)(size_t)dmp + lane * 4);
        }
        asm volatile("s_waitcnt lgkmcnt(0)" ::: "memory");
        { int lane = F.lane; asm volatile("" : "+v"(lane));
#pragma unroll
        for (int rnd = 0; rnd < 4; ++rnd) { const int e = lane + 64 * rnd; const unsigned kk = lstB[e];
            const int cidx = (int)(~kk & 255u), sa = (e >> 4) * 2;
            const unsigned ka = lstA[sa * 17 + (cidx >> 4)], kb = lstA[(sa + 1) * 17 + (cidx & 15)];
            const float sv = __uint_as_float(inv_ordkey((ka & ~127u) | 64u)) + __uint_as_float(inv_ordkey((kb & ~127u) | 64u));
            float m = sv; m = fmaxf(m, shx(m, 1, lane)); m = fmaxf(m, shx(m, 2, lane)); m = fmaxf(m, shx(m, 4, lane)); m = fmaxf(m, shx(m, 8, lane));
            const float ex = __expf(sv - m); float sum = ex; sum += shx(sum, 1, lane); sum += shx(sum, 2, lane); sum += shx(sum, 4, lane); sum += shx(sum, 8, lane);
            ei4[(e >> 7) * 256 + (e & 127)] = (int)((~ka & 127u) * 128u + (~kb & 127u));
            eg4[(e >> 7) * 256 + (e & 127)] = ex / sum; } }
        }
        asm volatile("s_waitcnt lgkmcnt(0)" ::: "memory");
        if (F.lane == 0) ready[slot] = (unsigned)(p + 1);
      }
    }
    {
      for (;;) {
        unsigned tq = 0u; if (F.lane == 0) tq = __hip_atomic_fetch_add(next_tok, 1u, __ATOMIC_RELAXED, __HIP_MEMORY_SCOPE_WORKGROUP);
        const int t = __builtin_amdgcn_readfirstlane((int)tq);
        if (t >= ntw) break;
        const int p = t >> 1, slot = p, tslot = t & 1;
        while (ready[slot] < (unsigned)(p + 1)) __builtin_amdgcn_s_sleep(2);
        asm volatile("" ::: "memory");
        if (MODE == 1) continue;
        int zst = 0; if (MODE == 2) asm volatile("" : "+s"(zst));
        const int tok = F.bid + t * F.G;
        int lane = F.lane; asm volatile("" : "+v"(lane));
        const int R = tok_row(layer, tok), b = R / RB, j = R % RB; const bool isctx = j < CTX; const int modrow = isctx ? 4 : b;
        const LAS int* ei = (const LAS int*)(ring + slot * 2048 + tslot * 1024); const LAS float* eg = (const LAS float*)(ring + slot * 2048 + tslot * 1024 + 512);
        f32x2 xf[16];
#pragma unroll
        for (int k = 0; k < 4; ++k) { const u32x4 w = *(const u32x4*)(HB + (size_t)R * 2048 + lane * 32 + 8 * k);
            xf[4 * k + 0] = (f32x2){bflo(w.x), bfhi(w.x)}; xf[4 * k + 1] = (f32x2){bflo(w.y), bfhi(w.y)};
            xf[4 * k + 2] = (f32x2){bflo(w.z), bfhi(w.z)}; xf[4 * k + 3] = (f32x2){bflo(w.w), bfhi(w.w)}; }
        f32x2 y2[16];
#pragma unroll
        for (int i = 0; i < 16; ++i) y2[i] = (f32x2){0.f, 0.f};
        f32x4 xrow[8];
#pragma unroll
        for (int k = 0; k < 8; ++k) xrow[k] = *(const f32x4*)(X1 + (size_t)R * 2048 + lane * 32 + 4 * k);
        { u32x4 urA[4], vrA[4], urB[4], vrB[4]; unsigned vsA[4], vsB[4]; float gqA[4], gqB[4];
          peer_load(urA, vrA, vsA, gqA, ei, eg, UV, lane, 0);
          for (int grp = 0; grp < 32; grp += 2) {
              peer_load(urB, vrB, vsB, gqB, ei, eg, UV, lane, grp + 1);
              peer_comp(urA, vrA, vsA, gqA, xf, y2, lane);
              peer_load(urA, vrA, vsA, gqA, ei, eg, UV, lane, grp + 2 < 32 ? grp + 2 : 31);
              peer_comp(urB, vrB, vsB, gqB, xf, y2, lane);
          } }
        const float* mod = WSP(const float, WS_MOD) + ((size_t)layer * 5 + modrow) * 12288;
        float y[32];
        float s = 0.f;
#pragma unroll
        for (int k = 0; k < 8; ++k) { const int c = lane * 32 + 4 * k;
            const f32x4 xa = xrow[k], ga = *(const f32x4*)(mod + 5 * 2048 + c);
            y[4 * k + 0] = ALPHA * xa[0] + ga[0] * y2[2 * k].x; y[4 * k + 1] = ALPHA * xa[1] + ga[1] * y2[2 * k].y;
            y[4 * k + 2] = ALPHA * xa[2] + ga[2] * y2[2 * k + 1].x; y[4 * k + 3] = ALPHA * xa[3] + ga[3] * y2[2 * k + 1].y;
            s += (y[4 * k + 0] + y[4 * k + 1]) + (y[4 * k + 2] + y[4 * k + 3]); }
        const float mean = wave_sum(s, lane) * (1.f / 2048.f); float q2 = 0.f;
#pragma unroll
        for (int i = 0; i < 32; ++i) { const float dd = y[i] - mean; q2 += dd * dd; }
        const float rstd = rsqrtf(wave_sum(q2, lane) * (1.f / 2048.f) + 1e-5f);
        if (MODE == 2 && zst == 0) continue;
        float* dst = layer == 0 ? (isctx ? WSP(float, WS_XC) + ((size_t)b * CTX + j) * 2048 : F.out + ((size_t)b * S + (j - CTX)) * 2048) : F.out + ((size_t)b * S + (j - CTX)) * 2048;
        const float* modn = WSP(const float, WS_MOD) + ((size_t)1 * 5 + modrow) * 12288;
#pragma unroll
        for (int kk = 0; kk < 4; ++kk) { f32x4 o[2];
#pragma unroll
            for (int jj = 0; jj < 2; ++jj) { const int k = 2 * kk + jj, c = lane * 32 + 4 * k; const f32x4 la = *(const f32x4*)(lg + c), ba = *(const f32x4*)(lb + c);
#pragma unroll
                for (int e = 0; e < 4; ++e) o[jj][e] = (y[4 * k + e] - mean) * rstd * la[e] + ba[e];
                *(f32x4*)(dst + c) = o[jj]; }
            if (layer == 0) {
                const int c = lane * 32 + 8 * kk;
                const f32x4 sa = *(const f32x4*)(modn + 2048 + c), sb = *(const f32x4*)(modn + 2048 + c + 4), ha = *(const f32x4*)(modn + c), hb = *(const f32x4*)(modn + c + 4);
                *(u32x4*)(HB + (size_t)R * 2048 + c) = pg8::pack8(o[0] * (sa + 1.0f) + ha, o[1] * (sb + 1.0f) + hb); } }
      }
    }
}

struct Params { const float* in[cf::N_IN]; float* out; unsigned char* ws; int ph_lo, ph_hi; };

__global__ void __launch_bounds__(512, 2) mega_fwd(Params p) {
    using namespace cf;
    extern __shared__ __attribute__((aligned(16))) unsigned char smem[];
    Ctx F0;
    F0.in = p.in;
    F0.out = p.out; F0.ws = p.ws; F0.lds = (ldsp_t)smem;
    F0.tid = 0; F0.lane = 0; F0.wave = __builtin_amdgcn_readfirstlane(threadIdx.x >> 6); F0.G = gridDim.x; F0.bid = blockIdx.x;
    if (threadIdx.x < 64) ((LAS unsigned*)(F0.lds + MISC_OFF))[threadIdx.x] = 0u;
    __syncthreads();
    const int lo = p.ph_lo, hi = p.ph_hi;
    XcdBarrier bar; bar.bar = (unsigned*)(F0.ws + WS_CTL); bar.x = 0; bar.st = (volatile LAS unsigned*)(F0.lds + MISC_OFF); bar.wave = F0.wave;
    if (hi - lo > 1) bar = xcd_barrier_post((unsigned*)(F0.ws + WS_CTL), (volatile LAS unsigned*)(F0.lds + MISC_OFF), F0.wave);
#ifndef MK_MASK
#define MK_MASK 0xFFFF
#endif
#define ON(j) ((MK_MASK >> (j)) & 1)
#define IN(k) (lo <= (k) && (k) < hi)
#define SEAM(k) do { if (IN(k) && IN((k) + 1)) xcd_barrier(bar); } while (0)

    if (ON(9) && IN(0)) { ph_prologue(F0); if (DUPN(9) == 2) { __syncthreads(); ph_prologue(F0); } }
    SEAM(0);
    if (ON(10) && IN(1)) ph_modulate0(F0);
    SEAM(1);
    for (int l = 0; l < DEPTH; ++l) {
        const int pb = 2 + 8 * l;
        const int rmode = l == 0 ? 0 : 1, nMl = l == 0 ? 68 : 64;
        for (int blk = 0; blk < DUPN(12); ++blk) {
        if (blk) xcd_barrier(bar);
        if (ON(0) && IN(pb + 0)) { const Ctx F = phase_ctx(F0);
            pg8::Gemm g{WSP(const bf16_t, WS_HB), WSP(const bf16_t, WS_WIN) + (size_t)l * NC * 2048, 2048, 2048};
            pg8::EpiInProj E{WSP(bf16_t, WS_P), WSP(bf16_t, WS_KB), WSP(const float, WS_COSH), WSP(const float, WS_SINH), WSP(const float, WS_COSR), WSP(const float, WS_SINR),
                             F.in[I_AKN] + l * 128, F.in[I_AQN] + l * 128, WSP(float, WS_SSK), WSP(float, WS_SSQ), WSP(float, WS_SSKV), WSP(float, WS_SSCQ)};
            pg8::TileOrder S; S.init(nMl, 56, F.G, F.bid, rmode);
            for (int dup = 0; dup < DUPN(0); ++dup) {
#ifdef MK_PITCH
            if (DUPN(0) == 2 && dup == 0) { pg8::Gemm g2 = g; g2.lda = MK_PITCH; g2.ldb = MK_PITCH; pg8::gemm_phase(F.lds, g2, S, E, F.wave); continue; }
#endif
            pg8::gemm_phase(F.lds, g, S, E, F.wave); }
            if (l > 0) { pg8::TileOrder S2; S2.init(4, 6, F.G, F.bid, 2); pg8::gemm_phase(F.lds, g, S2, E, F.wave); }
        }
        SEAM(pb + 0);
        if (ON(2) && IN(pb + 1)) { const Ctx F = phase_ctx(F0); bf16_t* P = WSP(bf16_t, WS_P);
            knorm_pass(F);
            { pg8::Gemm g{P + PC_CKV, WSP(const bf16_t, WS_WKVUP) + (size_t)l * 2048 * 256, NC, 256}; pg8::EpiKvUp E{WSP(bf16_t, WS_KB), WSP(bf16_t, WS_VB), WSP(const float, WS_SSKV)};
              pg8::TileOrder S; S.init(68, 8, F.G, F.bid, 0); for (int dup = 0; dup < DUPN(1); ++dup) pg8::gemm_phase(F.lds, g, S, E, F.wave); }
            { pg8::Gemm g{P + PC_CQ, WSP(const bf16_t, WS_WQUP) + (size_t)l * 1536 * 512, NC, 512}; pg8::EpiQUp E{WSP(bf16_t, WS_QB), WSP(const float, WS_COSR), WSP(const float, WS_SINR), WSP(const float, WS_SSCQ)};
              pg8::TileOrder S; S.init(nMl, 6, F.G, F.bid, rmode); for (int dup = 0; dup < DUPN(1); ++dup) pg8::gemm_phase(F.lds, g, S, E, F.wave); }
        }
        SEAM(pb + 1);
        if (ON(3) && IN(pb + 2)) ph_attn(F0, l);
        }
        SEAM(pb + 2);
        if (ON(4) && IN(pb + 3)) { const Ctx F = phase_ctx(F0); bf16_t* P = WSP(bf16_t, WS_P); bf16_t* HB = WSP(bf16_t, WS_HB);
            pg8::Gemm g{WSP(const bf16_t, WS_BR), WSP(const bf16_t, WS_WBR) + (size_t)l * 4 * 2048 * 1024, 4096, 1024};
            pg8::EpiMerge E{HB, P + PC_GATE, NC};
            pg8::TileOrder S; S.init(nMl, 8, F.G, F.bid, rmode, 4, (size_t)1024 * 2, (size_t)2048 * 1024 * 2);
            for (int dup = 0; dup < DUPN(5); ++dup) pg8::gemm_phase(F.lds, g, S, E, F.wave);
        }
        SEAM(pb + 3);
        if (ON(5) && IN(pb + 4)) { const Ctx F = phase_ctx(F0); bf16_t* HB = WSP(bf16_t, WS_HB);
            pg8::Gemm g{HB, WSP(const bf16_t, WS_WO) + (size_t)l * 2048 * 2048, 2048, 2048};
            pg8::EpiWo E{(float*)(F.ws + WS_P + X1_OFF), WSP(const float, WS_MOD) + (size_t)l * 5 * 12288, l == 0 ? F.in[I_X] : (const float*)F.out, F.in[I_CTX]};
            pg8::TileOrder S; S.init(nMl, 8, F.G, F.bid, rmode); for (int dup = 0; dup < DUPN(6); ++dup) pg8::gemm_phase(F.lds, g, S, E, F.wave);
        }
        SEAM(pb + 4);
        if (ON(6) && IN(pb + 5)) ph_ln1(F0, l);
        SEAM(pb + 5);
        if (ON(7) && IN(pb + 6)) { const Ctx F = phase_ctx(F0); bf16_t* HB = WSP(bf16_t, WS_HB);
            pg8::Gemm g{HB, WSP(const bf16_t, WS_WFOLD) + (size_t)l * 2048 * 2048, 2048, 2048}; pg8::EpiF32 E{(float*)(F.ws + WS_P + SC_OFF), 2048};
            pg8::TileOrder S; S.init(nMl, 8, F.G, F.bid, rmode); for (int dup = 0; dup < DUPN(7); ++dup) pg8::gemm_phase(F.lds, g, S, E, F.wave);
        }
        SEAM(pb + 6);
        if (ON(8) && IN(pb + 7)) { ph_peer<0>(F0, l); if (DUPN(8) == 2 && l == 1) ph_peer<MK_PV>(F0, l); }
        SEAM(pb + 7);
    }
#undef IN
#undef SEAM
}

extern "C" void kernel_launch(void* const* d_in, const int* in_sizes, int n_in, void* d_out, int out_size, void* d_ws, size_t ws_size, hipStream_t stream) {
    static int grid = 0;
    if (grid == 0) {
        if (n_in != cf::N_IN || out_size != cf::NB * cf::S * cf::D || ws_size < cf::WS_END) {
            fprintf(stderr, "kernel_launch: unexpected shapes: n_in %d out %d ws %zu (need %zu)\n", n_in, out_size, ws_size, (size_t)cf::WS_END); grid = -1; return; }
        int dev = 0, cus = 0;
        if (hipGetDevice(&dev) != hipSuccess || hipDeviceGetAttribute(&cus, hipDeviceAttributeMultiprocessorCount, dev) != hipSuccess || cus < 1) { grid = -1; return; }
        if (hipFuncSetAttribute((const void*)mega_fwd, hipFuncAttributeMaxDynamicSharedMemorySize, cf::LDS_BYTES) != hipSuccess) { fprintf(stderr, "kernel_launch: hipFuncSetAttribute failed\n"); grid = -1; return; }
        int per_cu = 0;
        if (hipOccupancyMaxActiveBlocksPerMultiprocessor(&per_cu, (const void*)mega_fwd, 512, cf::LDS_BYTES) != hipSuccess || per_cu < 1)
            fprintf(stderr, "kernel_launch: note: occupancy query reports %d workgroups per CU\n", per_cu);
        (void)hipGetLastError();
        grid = cus;
    }
    if (grid < 0) return;
    (void)hipMemsetAsync((char*)d_ws + cf::WS_CTL, 0, cf::CTL_BYTES, stream);
    Params p{};
    for (int i = 0; i < cf::N_IN; ++i) p.in[i] = (const float*)d_in[i];
    p.out = (float*)d_out; p.ws = (unsigned char*)d_ws;
#if MK_PER_PHASE
    for (int k = 0; k < cf::N_PHASES; ++k) { p.ph_lo = k; p.ph_hi = k + 1; hipLaunchKernelGGL(mega_fwd, dim3(grid), dim3(512), cf::LDS_BYTES, stream, p); }
#else
    p.ph_lo = 0; p.ph_hi = cf::N_PHASES;
    hipLaunchKernelGGL(mega_fwd, dim3(grid), dim3(512), cf::LDS_BYTES, stream, p);
#endif
    const hipError_t le = hipPeekAtLastError();
    if (le != hipSuccess) fprintf(stderr, "kernel_launch: launch failed: %s\n", hipGetErrorName(le));
}
```

```cpp
#include <hip/hip_runtime.h>
#include <stdint.h>
#include <stdio.h>

#ifndef MK_DUP
#define MK_DUP 0
#endif
#define DUPN(k) (((MK_DUP >> (k)) & 1) ? 2 : 1)
#ifndef MK_PV
#define MK_PV 0
#endif
#ifndef MK_AV
#define MK_AV 0
#endif
#ifndef MK_PER_PHASE
#define MK_PER_PHASE 0
#endif

namespace cf {
constexpr int D = 2048, NB = 4, S = 4096, CTX = 256, RB = CTX + S  , MR = NB * RB  ;
constexpr int DEPTH = 2;
constexpr int PC_AK = 0, PC_AV = 256, PC_CKV = 512, PC_KR = 768, PC_DK = 1024, PC_DV = 1280, PC_KVEND = 1536;
constexpr int PC_AQ = 1536, PC_CQ = 2560, PC_DQ = 3072, PC_GLU = 4096, PC_GATE = 6144, NC = 14336;
constexpr int IN_COLS = 14144;
constexpr int NEXP = 16384;
constexpr float ALPHA = 1.4142135623730951f;
constexpr float LOG2E = 1.4426950408889634f;
constexpr float SCALE_HD = 0.08838834764831845f;
constexpr float SCALE_MLA = 0.07216878364870323f;
enum { I_X = 0, I_C, I_CTX, I_CCTX, I_WADA, I_BADA, I_WIN, I_AQN, I_AKN, I_BQN, I_WQUP, I_BKVN, I_WKVUP, I_CW, I_CB, I_CLG, I_CLB, I_SINK,
       I_WBRA, I_WBRB, I_WBRC, I_WBRD, I_WO, I_LN1G, I_LN1B, I_LN2G, I_LN2B, I_PWQ, I_PSK, I_PU, I_PV, N_IN };
constexpr size_t al(size_t x) { return (x + 255) / 256 * 256; }
constexpr size_t WS_CTL = 0;
constexpr size_t CTL_BYTES = 65536;
constexpr size_t WS_MOD = WS_CTL + CTL_BYTES;
constexpr size_t WS_COSH = WS_MOD + al((size_t)2 * 5 * 12288 * 4);
constexpr size_t WS_SINH = WS_COSH + (size_t)4096 * 64 * 4;
constexpr size_t WS_COSR = WS_SINH + (size_t)4096 * 64 * 4;
constexpr size_t WS_SINR = WS_COSR + (size_t)4096 * 32 * 4;
constexpr size_t WS_WIN = WS_SINR + (size_t)4096 * 32 * 4;
constexpr size_t WS_WQUP = WS_WIN + (size_t)2 * NC * 2048 * 2;
constexpr size_t WS_WKVUP = WS_WQUP + (size_t)2 * 1536 * 512 * 2;
constexpr size_t WS_WBR = WS_WKVUP + (size_t)2 * 2048 * 256 * 2;
constexpr size_t WS_WO = WS_WBR + (size_t)2 * 4 * 2048 * 1024 * 2;
constexpr size_t WS_WFOLD = WS_WO + (size_t)2 * 2048 * 2048 * 2;
constexpr size_t WS_UB = WS_WFOLD + (size_t)2 * 2048 * 2048 * 2;
constexpr size_t WS_VB2 = WS_UB + (size_t)2 * NEXP * 2048;
constexpr size_t WS_HB = WS_VB2 + (size_t)2 * NEXP * 2048;
constexpr size_t WS_P = WS_HB + (size_t)MR * 2048 * 2;
constexpr size_t WS_QB = WS_P + (size_t)MR * NC * 2;
constexpr size_t WS_KB = WS_QB + (size_t)MR * 1536 * 2;
constexpr size_t WS_VB = WS_KB + (size_t)MR * 1536 * 2;
constexpr size_t WS_BR = WS_VB + (size_t)MR * 1024 * 2;
constexpr size_t WS_XC = WS_BR + (size_t)MR * 4096 * 2;
constexpr size_t WS_SSK = WS_XC + (size_t)1024 * 2048 * 4;
constexpr size_t WS_SSQ = WS_SSK + (size_t)MR * 4 * 4;
constexpr size_t WS_SSKV = WS_SSQ + (size_t)MR * 16 * 4;
constexpr size_t WS_SSCQ = WS_SSKV + (size_t)MR * 4 * 4;
constexpr size_t WS_END = WS_SSCQ + (size_t)MR * 8 * 4;
constexpr size_t SC_OFF = (size_t)MR * 2048 * 4;
constexpr size_t WS_X1 = WS_QB;
static_assert(SC_OFF * 2 <= (size_t)MR * NC * 2, "SC fits in P"); static_assert(WS_BR - WS_QB == (size_t)MR * 2048 * 4, "X1 fits over Q | K | V");
constexpr int LDS_BYTES = 132 * 1024;
constexpr int MISC_OFF = 128 * 1024;
constexpr int N_PHASES = 2 + 8 * DEPTH;
}

typedef unsigned short bf16_t;
typedef short bf16x8 __attribute__((ext_vector_type(8)));
typedef float f32x4 __attribute__((ext_vector_type(4)));
typedef float f32x16 __attribute__((ext_vector_type(16)));
typedef float f32x2 __attribute__((ext_vector_type(2)));
typedef unsigned u32x4 __attribute__((ext_vector_type(4)));
typedef unsigned u32x2 __attribute__((ext_vector_type(2)));
#define LAS __attribute__((address_space(3)))
typedef LAS unsigned char* ldsp_t;

typedef __bf16 bf16x2v_t __attribute__((ext_vector_type(2)));
__device__ __forceinline__ unsigned cvt_pk_bf16(float lo, float hi) { const bf16x2v_t r = __builtin_convertvector((f32x2){lo, hi}, bf16x2v_t); return __builtin_bit_cast(unsigned, r); }
__device__ __forceinline__ bf16_t f2bf(float f) { return (bf16_t)(cvt_pk_bf16(f, 0.f) & 0xffffu); }
__device__ __forceinline__ float bf2f(bf16_t b) { return __uint_as_float(((unsigned)b) << 16); }
__device__ __forceinline__ float bflo(unsigned w) { return __uint_as_float(w << 16); }
__device__ __forceinline__ float bfhi(unsigned w) { return __uint_as_float(w & 0xffff0000u); }
__device__ __forceinline__ float shx(float v, int mask, int lane) { return __int_as_float(__builtin_amdgcn_ds_bpermute((lane ^ mask) << 2, __float_as_int(v))); }
__device__ __forceinline__ float wave_sum(float v, int lane) {
#pragma unroll
    for (int o = 32; o >= 1; o >>= 1) v += shx(v, o, lane);
    return v;
}
__device__ __forceinline__ int lane_id() { int l; asm volatile("v_mbcnt_lo_u32_b32 %0, -1, 0\n\tv_mbcnt_hi_u32_b32 %0, -1, %0" : "=v"(l)); return l; }
__device__ __forceinline__ float sigmoidf_(float x) { return __builtin_amdgcn_rcpf(1.0f + __builtin_amdgcn_exp2f(x * -1.4426950408889634f)); }

#define XB_TMO      128
#define XB_XCNT(j)  (256  + 64 * (j))
#define XB_XSUB(j)  (1280 + 64 * (j))
#define XB_XGEN(j)  (2304 + 64 * (j))
#define XB_TOP      3328
#define XB_TOPGEN   3392
#define XCD_BAR_WORDS 3456
#define XB_SPIN_CAP (1u << 23)
__device__ __forceinline__ unsigned xb_ld(unsigned* p)              { return __hip_atomic_load(p, __ATOMIC_RELAXED, __HIP_MEMORY_SCOPE_AGENT); }
__device__ __forceinline__ unsigned xb_add(unsigned* p, unsigned v) { return __hip_atomic_fetch_add(p, v, __ATOMIC_RELAXED, __HIP_MEMORY_SCOPE_AGENT); }
__device__ __forceinline__ unsigned xb_xcc_id() { return (unsigned)__builtin_amdgcn_s_getreg((3 << 11) | 20) & 0xFu; }
#define XB_SPIN(cond, bar) do { unsigned _sp = 0; while (cond) { __builtin_amdgcn_s_sleep(1); \
    if ((++_sp & 255u) == 0u) { if (xb_ld(&(bar)[XB_TMO])) break; if (_sp > XB_SPIN_CAP) { atomicAdd(&(bar)[XB_TMO], 1u); break; } } } } while (0)
struct XcdBarrier { unsigned* bar; unsigned x; volatile LAS unsigned* st; int wave; };
__device__ __forceinline__ XcdBarrier xcd_barrier_post(unsigned* bar, volatile LAS unsigned* st, int wave) {
    XcdBarrier b; b.bar = bar; b.x = xb_xcc_id(); b.st = st; b.wave = wave;
    if (wave == 0 && lane_id() == 0) (void)xb_add(&bar[XB_XCNT(b.x)], 1u);
    return b;
}
__device__ __forceinline__ void xcd_barrier_complete(unsigned* bar, unsigned x, unsigned& nloc, unsigned& nx) {
    const unsigned G = gridDim.x * gridDim.y * gridDim.z;
    unsigned sum, cnt, mine, sp = 0u;
    for (;;) {
        sum = 0u; cnt = 0u; mine = 0u;
#pragma unroll
        for (unsigned j = 0; j < 16; ++j) { const unsigned c = xb_ld(&bar[XB_XCNT(j)]); sum += c; cnt += (c > 0u) ? 1u : 0u; mine = (j == x) ? c : mine; }
        if (sum == G) break;
        __builtin_amdgcn_s_sleep(1);
        if ((++sp & 255u) == 0u) { if (xb_ld(&bar[XB_TMO])) break; if (sp > XB_SPIN_CAP) { atomicAdd(&bar[XB_TMO], 1u); break; } }
    }
    nloc = mine > 0u ? mine : 1u; nx = cnt > 0u ? cnt : 1u;
}
__device__ __forceinline__ void xcd_barrier(const XcdBarrier& b) {
    asm volatile("s_waitcnt vmcnt(0)" ::: "memory");
    __syncthreads();
    if (b.wave == 0 && lane_id() == 0) {
        unsigned* bar = b.bar;
        __builtin_amdgcn_s_waitcnt(0);
        unsigned nloc = b.st[0], nx = b.st[1];
        if (nloc == 0u) { xcd_barrier_complete(bar, b.x, nloc, nx); b.st[0] = nloc; b.st[1] = nx; }
        const unsigned old = xb_add(&bar[XB_XSUB(b.x)], 1u);
        const unsigned gen = old / nloc;
        if (old + 1u == (gen + 1u) * nloc) {
            __builtin_amdgcn_fence(__ATOMIC_RELEASE, "agent");
            asm volatile("s_waitcnt vmcnt(0)" ::: "memory");
            const unsigned og = xb_add(&bar[XB_TOP], 1u);
            const unsigned tg = og / nx;
            if (og + 1u == (tg + 1u) * nx) xb_add(&bar[XB_TOPGEN], 1u);
            else XB_SPIN(xb_ld(&bar[XB_TOPGEN]) == tg, bar);
            __builtin_amdgcn_fence(__ATOMIC_ACQUIRE, "agent");
            xb_add(&bar[XB_XGEN(b.x)], 1u);
            asm volatile("s_waitcnt vmcnt(0)" ::: "memory");
        } else {
            XB_SPIN(xb_ld(&bar[XB_XGEN(b.x)]) == gen, bar);
            __builtin_amdgcn_fence(__ATOMIC_ACQUIRE, "agent");
            asm volatile("s_waitcnt vmcnt(0)" ::: "memory");
        }
    }
    __syncthreads();
}

namespace pg8 {
constexpr int BM = 256, BK = 64, HALF = 128, HTB = HALF * BK * 2, STAGE_BYTES = 8 * HTB, NXCD = 8, WGM = 8;
__host__ __device__ __forceinline__ int lds_byte(int r, int c) { const int st = (r >> 4) * 2 + (c >> 5), rr = r & 15, cc = c & 31, ob = rr * 64 + cc * 2; return st * 1024 + (ob ^ (((ob >> 9) & 1) << 5)); }
__host__ __device__ __forceinline__ void stage_rc(int b, int& R, int& C) { const int st = b / 1024, sb = b % 1024, swz = sb ^ (((sb >> 9) & 1) << 5); R = (st >> 1) * 16 + swz / 64; C = (st & 1) * 32 + (swz % 64) / 2; }
__host__ __device__ __forceinline__ int perm32(int rho) { const int n = rho >> 4, i = rho & 15; return 8 * (i >> 2) + 4 * n + (i & 3); }
struct Unit { int pm, pn, sub; };
struct Gemm { const bf16_t* A; const bf16_t* Bt; int lda, K, ldb = 0; };

struct TileOrder {
    int nM, nN, nwg, G, c, mode, nsub; size_t subA, subB;
    __device__ void init(int nM_, int nN_, int G_, int c_, int mode_, int nsub_ = 1, size_t subA_ = 0, size_t subB_ = 0) { nM = nM_; nN = nN_; nwg = nM * nN; G = G_; c = c_; mode = mode_; nsub = nsub_; subA = subA_; subB = subB_; }
    __device__ bool next(int i, Unit& u) const {
        const int it = nsub == 1 ? i : i / nsub; u.sub = nsub == 1 ? 0 : i - it * nsub;
        const long L = (long)it * G + c; if (L >= nwg) return false;
        int wgid = (int)L; { const int q = nwg / NXCD, r = nwg % NXCD, xcd = wgid % NXCD, off = wgid / NXCD; wgid = (xcd < r ? xcd * (q + 1) : r * (q + 1) + (xcd - r) * q) + off; }
        const int nig = WGM * nN, gid = wgid / nig, fm = gid * WGM, gsz = (nM - fm) < WGM ? (nM - fm) : WGM;
        const int pl = fm + ((wgid % nig) % gsz); u.pn = (wgid % nig) / gsz;
        u.pm = mode == 0 ? pl : (mode == 1 ? 17 * (pl >> 4) + 1 + (pl & 15) : 17 * pl);
        return true;
    }
    __device__ __forceinline__ void a_ready(const Unit&) const {}
    __device__ __forceinline__ void done(const Unit&) const {}
};

struct CtrOrder : TileOrder {
    unsigned* pub = nullptr; const unsigned* ready = nullptr; unsigned need = 0; int wave = 0;
    __device__ __forceinline__ void a_ready(const Unit& u) const {
        if (ready == nullptr) return;
        if (wave == 0) {
            unsigned polls = 0;
            while ((unsigned)__builtin_amdgcn_readfirstlane(__hip_atomic_load(ready + 64 * u.pm, __ATOMIC_RELAXED, __HIP_MEMORY_SCOPE_AGENT)) < need) { if (++polls > (1u << 22)) break; __builtin_amdgcn_s_sleep(2); }
            __builtin_amdgcn_fence(__ATOMIC_ACQUIRE, "agent");
            asm volatile("s_waitcnt vmcnt(0)" ::: "memory");
        }
        asm volatile("" ::: "memory"); __builtin_amdgcn_s_barrier(); asm volatile("" ::: "memory");
    }
    __device__ __forceinline__ void done(const Unit& u) const {
        if (pub == nullptr || u.sub != nsub - 1) return;
        asm volatile("s_waitcnt vmcnt(0)" ::: "memory");
        if (lane_id() == 0) __hip_atomic_fetch_add(pub + 64 * u.pm, 1u, __ATOMIC_RELAXED, __HIP_MEMORY_SCOPE_AGENT);
    }
};

template <class Epi, class Sched>
__device__ __forceinline__ void gemm_phase(ldsp_t lds, const Gemm g, const Sched& S, const Epi& E, int wave_) {
    int tid = wave_ * 64 + lane_id(); asm volatile("" : "+v"(tid));
    const int wid = __builtin_amdgcn_readfirstlane(tid >> 6), lane = tid & 63, wr = wid >> 2, wc = wid & 3, fr = lane & 15, fq = lane >> 4;
    int K = g.K; asm volatile("" : "+s"(K));
    const int nt = K / BK, lda = g.lda, ldb = g.ldb ? g.ldb : K;
    unsigned voffA[2], voffB[2];
#pragma unroll
    for (int i = 0; i < 2; ++i) { int R, C; stage_rc(tid * 16 + i * 8192, R, C); const int Rb = (R & ~31) + perm32(R & 31);
        voffA[i] = (unsigned)(R * lda + C) * 2u; voffB[i] = (unsigned)(Rb * ldb + C) * 2u; }
    const size_t kstep = (size_t)(BK * 2);
    const size_t hstepA = (size_t)HALF * lda * 2, hstepB = (size_t)HALF * ldb * 2;
    const size_t tstepA = 2 * hstepA, tstepB = 2 * hstepB;
    const unsigned ldsw = (unsigned)wid * 1024u;
    const int aoff = lds_byte(wr * 64 + fr, fq * 8), boff = lds_byte(wc * 32 + fr, fq * 8);
#define PG8_SA(b, h) (((b) * 2 + (h)) * HTB)
#define PG8_SB(b, h) ((4 + (b) * 2 + (h)) * HTB)
#define PG8_STAGE(bufoff, gbase, voff) do { _Pragma("unroll") for (int _i = 0; _i < 2; ++_i) \
        __builtin_amdgcn_global_load_lds((const unsigned*)((const char*)(gbase) + (voff)[_i]), (LAS unsigned*)(lds + (bufoff) + ldsw + _i * 8192), 16, 0, 0); } while (0)
#define PG8_LDA(dst, b, h) do { _Pragma("unroll") for (int m = 0; m < 4; ++m) _Pragma("unroll") for (int k = 0; k < 2; ++k) dst[m][k] = *(const LAS bf16x8*)(lds + PG8_SA(b, h) + aoff + m * 2048 + k * 1024); } while (0)
#define PG8_LDB(dst, b, h) do { _Pragma("unroll") for (int n = 0; n < 2; ++n) _Pragma("unroll") for (int k = 0; k < 2; ++k) dst[n][k] = *(const LAS bf16x8*)(lds + PG8_SB(b, h) + boff + n * 2048 + k * 1024); } while (0)
#define PG8_MMA(ai, bj, At, Bt) do { __builtin_amdgcn_s_setprio(1); _Pragma("unroll") for (int m = 0; m < 4; ++m) _Pragma("unroll") for (int n = 0; n < 2; ++n) _Pragma("unroll") for (int k = 0; k < 2; ++k) \
        acc[ai][bj][m][n] = __builtin_amdgcn_mfma_f32_16x16x32_bf16(Bt[n][k], At[m][k], acc[ai][bj][m][n], 0, 0, 0); __builtin_amdgcn_s_setprio(0); } while (0)
#define PG8_WAIT_V(n) asm volatile("s_waitcnt vmcnt(" #n ")" ::: "memory")
#define PG8_WAIT_L(n) asm volatile("s_waitcnt lgkmcnt(" #n ")" ::: "memory")
#define PG8_BAR __builtin_amdgcn_s_barrier()
#define PG8_SCHED __builtin_amdgcn_sched_barrier(0)
    Unit cur, nxt; int ui = 0;
    if (!S.next(0, cur)) return;
    f32x4 acc[2][2][4][2];
#pragma unroll
    for (int a = 0; a < 2; ++a)
#pragma unroll
        for (int b = 0; b < 2; ++b)
#pragma unroll
            for (int m = 0; m < 4; ++m)
#pragma unroll
                for (int n = 0; n < 2; ++n) acc[a][b][m][n] = (f32x4){0.f, 0.f, 0.f, 0.f};
    bf16x8 At[4][2], B0[2][2], B1[2][2];
    const char* cA = (const char*)g.A + (size_t)cur.pm * tstepA + cur.sub * S.subA; const char* cB = (const char*)g.Bt + (size_t)cur.pn * tstepB + cur.sub * S.subB;
    S.a_ready(cur);
    PG8_STAGE(PG8_SB(0, 0), cB, voffB); PG8_STAGE(PG8_SA(0, 0), cA, voffA); PG8_STAGE(PG8_SB(0, 1), cB + hstepB, voffB); PG8_STAGE(PG8_SA(0, 1), cA + hstepA, voffA);
    if (wr == 1) PG8_BAR;
    PG8_WAIT_V(4); PG8_BAR;
    PG8_STAGE(PG8_SB(1, 0), cB + kstep, voffB); PG8_STAGE(PG8_SA(1, 0), cA + kstep, voffA); PG8_STAGE(PG8_SB(1, 1), cB + hstepB + kstep, voffB);
    PG8_WAIT_V(6); PG8_BAR;
    for (;;) {
        const bool has_next = S.next(ui + 1, nxt);
        const char* nA = has_next ? (const char*)g.A + (size_t)nxt.pm * tstepA + nxt.sub * S.subA : cA; const char* nB = has_next ? (const char*)g.Bt + (size_t)nxt.pn * tstepB + nxt.sub * S.subB : cB;
#pragma unroll 1
        for (int t = 0; t < nt; t += 2) {
            const bool last = (t == nt - 2);
            const char* a1 = cA + (size_t)(t + 1) * kstep;
            const char* a2 = last ? nA : cA + (size_t)(t + 2) * kstep; const char* b2 = last ? nB : cB + (size_t)(t + 2) * kstep;
            const char* a3 = a2 + kstep; const char* b3 = b2 + kstep;
            if (last && has_next) S.a_ready(nxt);
            PG8_LDB(B0, 0, 0); PG8_SCHED; PG8_LDA(At, 0, 0); PG8_STAGE(PG8_SA(1, 1), a1 + hstepA, voffA);
            PG8_WAIT_L(8); PG8_BAR; PG8_WAIT_L(0); PG8_MMA(0, 0, At, B0); PG8_BAR; PG8_SCHED;
            PG8_LDB(B1, 0, 1); PG8_STAGE(PG8_SB(0, 0), b2, voffB);
            PG8_BAR; PG8_WAIT_L(0); PG8_MMA(0, 1, At, B1); PG8_BAR;
            PG8_LDA(At, 0, 1); PG8_STAGE(PG8_SA(0, 0), a2, voffA);
            PG8_BAR; PG8_WAIT_L(0); PG8_MMA(1, 0, At, B0); PG8_BAR; PG8_SCHED;
            PG8_STAGE(PG8_SB(0, 1), b2 + hstepB, voffB);
            PG8_WAIT_V(6); PG8_BAR; PG8_MMA(1, 1, At, B1); PG8_BAR;
            PG8_LDB(B0, 1, 0); PG8_SCHED; PG8_LDA(At, 1, 0); PG8_STAGE(PG8_SA(0, 1), a2 + hstepA, voffA);
            PG8_WAIT_L(8); PG8_BAR; PG8_WAIT_L(0); PG8_MMA(0, 0, At, B0); PG8_BAR; PG8_SCHED;
            PG8_LDB(B1, 1, 1); PG8_STAGE(PG8_SB(1, 0), b3, voffB);
            PG8_BAR; PG8_WAIT_L(0); PG8_MMA(0, 1, At, B1); PG8_BAR;
            PG8_LDA(At, 1, 1); PG8_STAGE(PG8_SA(1, 0), a3, voffA);
            PG8_BAR; PG8_WAIT_L(0); PG8_MMA(1, 0, At, B0); PG8_BAR; PG8_SCHED;
            PG8_STAGE(PG8_SB(1, 1), b3 + hstepB, voffB);
            PG8_WAIT_V(6); PG8_BAR; PG8_MMA(1, 1, At, B1); PG8_BAR;
        }
        E(acc, cur, wr, wc, fr, fq); S.done(cur);
        if (!has_next) break;
#pragma unroll
        for (int a = 0; a < 2; ++a)
#pragma unroll
            for (int b = 0; b < 2; ++b)
#pragma unroll
                for (int m = 0; m < 4; ++m)
#pragma unroll
                    for (int n = 0; n < 2; ++n) acc[a][b][m][n] = (f32x4){0.f, 0.f, 0.f, 0.f};
        cur = nxt; cA = nA; cB = nB; ++ui;
    }
    PG8_WAIT_V(0);
    if (wr == 0) PG8_BAR;
    PG8_BAR;
#undef PG8_SA
#undef PG8_SB
#undef PG8_STAGE
#undef PG8_LDA
#undef PG8_LDB
#undef PG8_MMA
#undef PG8_WAIT_V
#undef PG8_WAIT_L
#undef PG8_BAR
#undef PG8_SCHED
}

__device__ __forceinline__ u32x4 pack8(const f32x4 a, const f32x4 b) { u32x4 w; w.x = cvt_pk_bf16(a[0], a[1]); w.y = cvt_pk_bf16(a[2], a[3]); w.z = cvt_pk_bf16(b[0], b[1]); w.w = cvt_pk_bf16(b[2], b[3]); return w; }
#define EPI_ARGS const f32x4 (&acc)[2][2][4][2], const Unit& u, int wr, int wc, int fr_, int fq_
#define EPI_LANE int fr = fr_, fq = fq_; asm volatile("" : "+v"(fr), "+v"(fq));

struct EpiBf16 {
    bf16_t* O; int ldc;
    __device__ __forceinline__ void operator()(EPI_ARGS) const {
        EPI_LANE
        const int row0 = u.pm * BM + wr * 64 + fr, col0 = u.pn * BM + wc * 32 + 8 * fq;
#pragma unroll
        for (int ai = 0; ai < 2; ++ai)
#pragma unroll
            for (int m = 0; m < 4; ++m) { bf16_t* rowp = O + (size_t)(row0 + ai * HALF + m * 16) * ldc + col0;
#pragma unroll
                for (int bj = 0; bj < 2; ++bj) *(u32x4*)(rowp + bj * HALF) = pack8(acc[ai][bj][m][0], acc[ai][bj][m][1]); }
    }
};
struct EpiF32 {
    float* C; int ldc;
    __device__ __forceinline__ void operator()(EPI_ARGS) const {
        EPI_LANE
        const int row0 = u.pm * BM + wr * 64 + fr, col0 = u.pn * BM + wc * 32 + 8 * fq;
#pragma unroll
        for (int ai = 0; ai < 2; ++ai)
#pragma unroll
            for (int m = 0; m < 4; ++m) { float* rowp = C + (size_t)(row0 + ai * HALF + m * 16) * ldc + col0;
#pragma unroll
                for (int bj = 0; bj < 2; ++bj) { *(f32x4*)(rowp + bj * HALF) = acc[ai][bj][m][0]; *(f32x4*)(rowp + bj * HALF + 4) = acc[ai][bj][m][1]; } }
    }
};
struct EpiInProj {
    bf16_t* P; bf16_t* KB; const float* cosh; const float* sinh; const float* cosr; const float* sinr; const float* akn; const float* aqn;
    float* ssk; float* ssq; float* sskv; float* sscq;
    __device__ __forceinline__ void operator()(EPI_ARGS) const {
        EPI_LANE
        const int pn = u.pn, tb = u.pm % 17; const bool lat = tb != 0; const int posbase = (tb - 1) * 256;
        const int rl0 = wr * 64 + fr;
        if (pn >= 24) {
            const int col0 = pn * BM + wc * 32 + 8 * fq;
#pragma unroll
            for (int ai = 0; ai < 2; ++ai)
#pragma unroll
                for (int m = 0; m < 4; ++m) { bf16_t* rowp = P + ((size_t)u.pm * BM + rl0 + ai * HALF + m * 16) * cf::NC + col0;
#pragma unroll
                    for (int bj = 0; bj < 2; ++bj) { f32x4 v0 = acc[ai][bj][m][0], v1 = acc[ai][bj][m][1];
#pragma unroll
                        for (int e = 0; e < 4; ++e) { v0[e] = sigmoidf_(v0[e]); v1[e] = sigmoidf_(v1[e]); }
                        *(u32x4*)(rowp + bj * HALF) = pack8(v0, v1); } }
        } else if (pn >= 16) {
            const int col0 = cf::PC_GLU + 128 * (pn - 16) + wc * 32 + 8 * fq;
#pragma unroll
            for (int ai = 0; ai < 2; ++ai)
#pragma unroll
                for (int m = 0; m < 4; ++m) { f32x4 v0 = acc[ai][0][m][0], v1 = acc[ai][0][m][1]; const f32x4 g0 = acc[ai][1][m][0], g1 = acc[ai][1][m][1];
#pragma unroll
                    for (int e = 0; e < 4; ++e) { v0[e] *= sigmoidf_(g0[e]); v1[e] *= sigmoidf_(g1[e]); }
                    *(u32x4*)(P + ((size_t)u.pm * BM + rl0 + ai * HALF + m * 16) * cf::NC + col0) = pack8(v0, v1); }
        } else if (pn == 3) {
            if (wc == 0) { const int i0 = 8 * fq;
#pragma unroll
                for (int ai = 0; ai < 2; ++ai)
#pragma unroll
                    for (int m = 0; m < 4; ++m) { const int rl = rl0 + ai * HALF + m * 16;
                        f32x4 c0 = {1.f, 1.f, 1.f, 1.f}, c1 = c0, s0 = {0.f, 0.f, 0.f, 0.f}, s1 = s0;
                        if (lat) { const float* cp = cosr + (size_t)(posbase + rl) * 32 + i0; const float* sp = sinr + (size_t)(posbase + rl) * 32 + i0;
                            c0 = *(const f32x4*)cp; c1 = *(const f32x4*)(cp + 4); s0 = *(const f32x4*)sp; s1 = *(const f32x4*)(sp + 4); }
                        const f32x4 x1a = acc[ai][0][m][0], x1b = acc[ai][0][m][1], x2a = acc[ai][1][m][0], x2b = acc[ai][1][m][1];
                        const u32x4 w1 = pack8(x1a * c0 - x2a * s0, x1b * c1 - x2b * s1), w2 = pack8(x2a * c0 + x1a * s0, x2b * c1 + x1b * s1);
                        bf16_t* kb = KB + ((size_t)u.pm * BM + rl) * 1536 + 128 + i0;
#pragma unroll
                        for (int h = 0; h < 8; ++h) { *(u32x4*)(kb + h * 192) = w1; *(u32x4*)(kb + h * 192 + 32) = w2; }
                        asm volatile("" ::: "memory"); } }
        } else if (pn == 0 || pn == 4 || (pn >= 6 && pn <= 9) || pn >= 12) {
            const bool norm = pn == 0 || (pn >= 6 && pn <= 9);
            const int hl = wc >> 1, i0 = 32 * (wc & 1) + 8 * fq;
            f32x4 g1a = {1.f, 1.f, 1.f, 1.f}, g1b = g1a, g2a = g1a, g2b = g1a;
            if (norm) { const float* gn = (pn == 0 ? akn : aqn) + i0; g1a = *(const f32x4*)gn; g1b = *(const f32x4*)(gn + 4); g2a = *(const f32x4*)(gn + 64); g2b = *(const f32x4*)(gn + 68); }
            float* ssp = pn == 0 ? ssk + ((size_t)u.pm * BM * 2 + hl) * 2 + (wc & 1) : ssq + ((size_t)u.pm * BM * 8 + (pn - 6) * 2 + hl) * 2 + (wc & 1);
            const int sstr = pn == 0 ? 4 : 16;
#pragma unroll
            for (int ai = 0; ai < 2; ++ai)
#pragma unroll
                for (int m = 0; m < 4; ++m) { const int rl = rl0 + ai * HALF + m * 16;
                    f32x4 x1a = acc[ai][0][m][0], x1b = acc[ai][0][m][1], x2a = acc[ai][1][m][0], x2b = acc[ai][1][m][1];
                    if (norm) { const f32x4 q = x1a * x1a + x1b * x1b + x2a * x2a + x2b * x2b; float ss = (q[0] + q[1]) + (q[2] + q[3]);
                        ss += shx(ss, 16, fr + 16 * fq); ss += shx(ss, 32, fr + 16 * fq);
                        if (fq == 0) ssp[(size_t)rl * sstr] = ss;
                        x1a *= g1a; x1b *= g1b; x2a *= g2a; x2b *= g2b; }
                    f32x4 o1a = x1a, o1b = x1b, o2a = x2a, o2b = x2b;
                    if (lat) { const float* cp = cosh + (size_t)(posbase + rl) * 64 + i0; const float* sp = sinh + (size_t)(posbase + rl) * 64 + i0;
                        const f32x4 c0 = *(const f32x4*)cp, c1 = *(const f32x4*)(cp + 4), s0 = *(const f32x4*)sp, s1 = *(const f32x4*)(sp + 4);
                        o1a = x1a * c0 - x2a * s0; o1b = x1b * c1 - x2b * s1; o2a = x2a * c0 + x1a * s0; o2b = x2b * c1 + x1b * s1; }
                    bf16_t* dst = P + ((size_t)u.pm * BM + rl) * cf::NC + pn * BM + hl * 128 + i0;
                    *(u32x4*)dst = pack8(o1a, o1b); *(u32x4*)(dst + 64) = pack8(o2a, o2b);
                    asm volatile("" ::: "memory"); }
        } else {
            const int col0 = pn * BM + wc * 32 + 8 * fq;
            const bool ssq_on = pn == 2 || pn == 10 || pn == 11;
            float* ssp = pn == 2 ? sskv + (size_t)u.pm * BM * 4 + wc : sscq + (size_t)u.pm * BM * 8 + (pn - 10) * 4 + wc;
            const int sstr = pn == 2 ? 4 : 8;
#pragma unroll
            for (int ai = 0; ai < 2; ++ai)
#pragma unroll
                for (int m = 0; m < 4; ++m) { const int rl = rl0 + ai * HALF + m * 16; bf16_t* rowp = P + ((size_t)u.pm * BM + rl) * cf::NC + col0;
#pragma unroll
                    for (int bj = 0; bj < 2; ++bj) *(u32x4*)(rowp + bj * HALF) = pack8(acc[ai][bj][m][0], acc[ai][bj][m][1]);
                    if (ssq_on) { const f32x4 q = acc[ai][0][m][0] * acc[ai][0][m][0] + acc[ai][0][m][1] * acc[ai][0][m][1] + acc[ai][1][m][0] * acc[ai][1][m][0] + acc[ai][1][m][1] * acc[ai][1][m][1];
                        float ss = (q[0] + q[1]) + (q[2] + q[3]); ss += shx(ss, 16, fr + 16 * fq); ss += shx(ss, 32, fr + 16 * fq);
                        if (fq == 0) ssp[(size_t)rl * sstr] = ss; } }
        }
    }
};
struct EpiKvUp {
    bf16_t* KB; bf16_t* VB; const float* sskv;
    __device__ __forceinline__ void operator()(EPI_ARGS) const {
        EPI_LANE
        const int row0 = u.pm * BM + wr * 64 + fr, d0 = wc * 32 + 8 * fq;
        const bool isk = u.pn < 4;
        bf16_t* base = isk ? KB + (2 * u.pn) * 192 + d0 : VB + (u.pn - 4) * 256 + d0;
        const int ldr = isk ? 1536 : 1024, bjs = isk ? 192 : 128;
#pragma unroll
        for (int ai = 0; ai < 2; ++ai)
#pragma unroll
            for (int m = 0; m < 4; ++m) { const size_t row = (size_t)(row0 + ai * HALF + m * 16); bf16_t* rowp = base + row * ldr;
                const f32x4 pp = *(const f32x4*)(sskv + row * 4); const float r = rsqrtf(((pp[0] + pp[1]) + (pp[2] + pp[3])) * (1.f / 256.f) + 1e-6f);
#pragma unroll
                for (int bj = 0; bj < 2; ++bj) *(u32x4*)(rowp + bj * bjs) = pack8(acc[ai][bj][m][0] * r, acc[ai][bj][m][1] * r); }
    }
};
struct EpiQUp {
    bf16_t* QB; const float* cosr; const float* sinr; const float* sscq;
    __device__ __forceinline__ void operator()(EPI_ARGS) const {
        EPI_LANE
        const int row0 = u.pm * BM + wr * 64 + fr;
        if (u.pn < 4) {
            const int d0 = wc * 32 + 8 * fq;
#pragma unroll
            for (int ai = 0; ai < 2; ++ai)
#pragma unroll
                for (int m = 0; m < 4; ++m) { const size_t row = (size_t)(row0 + ai * HALF + m * 16);
                    const f32x4 pa = *(const f32x4*)(sscq + row * 8), pb = *(const f32x4*)(sscq + row * 8 + 4);
                    const float r = rsqrtf((((pa[0] + pa[1]) + (pa[2] + pa[3])) + ((pb[0] + pb[1]) + (pb[2] + pb[3]))) * (1.f / 512.f) + 1e-6f);
#pragma unroll
                    for (int bj = 0; bj < 2; ++bj) *(u32x4*)(QB + row * 1536 + (2 * u.pn + bj) * 192 + d0) = pack8(acc[ai][bj][m][0] * r, acc[ai][bj][m][1] * r); }
        } else {
            const int head = 4 * (u.pn - 4) + wc, i0 = 8 * fq;
            const bool lat = (u.pm % 17) != 0; const int posbase = (u.pm % 17) * 256 - 256;
#pragma unroll
            for (int ai = 0; ai < 2; ++ai)
#pragma unroll
                for (int m = 0; m < 4; ++m) { const int rl = wr * 64 + fr + ai * HALF + m * 16; const size_t row = (size_t)u.pm * BM + rl;
                    const f32x4 pa = *(const f32x4*)(sscq + row * 8), pb = *(const f32x4*)(sscq + row * 8 + 4);
                    const float r = rsqrtf((((pa[0] + pa[1]) + (pa[2] + pa[3])) + ((pb[0] + pb[1]) + (pb[2] + pb[3]))) * (1.f / 512.f) + 1e-6f);
                    f32x4 c0 = {1.f, 1.f, 1.f, 1.f}, c1 = c0, s0 = {0.f, 0.f, 0.f, 0.f}, s1 = s0;
                    if (lat) { const float* cp = cosr + (size_t)(posbase + rl) * 32 + i0; const float* sp = sinr + (size_t)(posbase + rl) * 32 + i0;
                        c0 = *(const f32x4*)cp; c1 = *(const f32x4*)(cp + 4); s0 = *(const f32x4*)sp; s1 = *(const f32x4*)(sp + 4); }
                    const f32x4 x1a = acc[ai][0][m][0] * r, x1b = acc[ai][0][m][1] * r, x2a = acc[ai][1][m][0] * r, x2b = acc[ai][1][m][1] * r;
                    const f32x4 o1a = x1a * c0 - x2a * s0, o1b = x1b * c1 - x2b * s1, o2a = x2a * c0 + x1a * s0, o2b = x2b * c1 + x1b * s1;
                    bf16_t* dst = QB + row * 1536 + head * 192 + 128 + i0;
                    *(u32x4*)dst = pack8(o1a, o1b); *(u32x4*)(dst + 32) = pack8(o2a, o2b); asm volatile("" ::: "memory"); }
        }
    }
};
struct EpiMerge {
    bf16_t* ACC; const bf16_t* gate0; int ldg;
    __device__ __forceinline__ void operator()(EPI_ARGS) const {
        EPI_LANE
        const int row0 = u.pm * BM + wr * 64 + fr, col0 = u.pn * BM + wc * 32 + 8 * fq;
        const bf16_t* gate = gate0 + u.sub * 2048; const bool first = u.sub == 0;
#pragma unroll
        for (int ai = 0; ai < 2; ++ai) {
            u32x4 gw[4][2], pw[4][2];
#pragma unroll
            for (int m = 0; m < 4; ++m) { const size_t row = (size_t)(row0 + ai * HALF + m * 16);
#pragma unroll
                for (int bj = 0; bj < 2; ++bj) { const int col = col0 + bj * HALF; gw[m][bj] = *(const u32x4*)(gate + row * ldg + col);
                    pw[m][bj] = (u32x4){0u, 0u, 0u, 0u}; if (!first) pw[m][bj] = *(const u32x4*)(ACC + row * 2048 + col); } }
#pragma unroll
            for (int m = 0; m < 4; ++m) { const size_t row = (size_t)(row0 + ai * HALF + m * 16);
#pragma unroll
                for (int bj = 0; bj < 2; ++bj) { const int col = col0 + bj * HALF; const u32x4 g = gw[m][bj], p = pw[m][bj];
                    const f32x4 a0 = acc[ai][bj][m][0], a1 = acc[ai][bj][m][1];
                    f32x4 r0, r1;
                    r0[0] = bflo(p.x) + bflo(g.x) * a0[0]; r0[1] = bfhi(p.x) + bfhi(g.x) * a0[1]; r0[2] = bflo(p.y) + bflo(g.y) * a0[2]; r0[3] = bfhi(p.y) + bfhi(g.y) * a0[3];
                    r1[0] = bflo(p.z) + bflo(g.z) * a1[0]; r1[1] = bfhi(p.z) + bfhi(g.z) * a1[1]; r1[2] = bflo(p.w) + bflo(g.w) * a1[2]; r1[3] = bfhi(p.w) + bfhi(g.w) * a1[3];
                    const u32x4 pk = pack8(r0, r1); bf16_t* dp = ACC + row * 2048 + col;
                    if (u.sub == 3) asm volatile("global_store_dwordx4 %0, %1, off sc1" :: "v"(dp), "v"(pk) : "memory");
                    else *(u32x4*)dp = pk; } }
            asm volatile("" ::: "memory"); }
    }
};
struct EpiWo {
    float* X1; const float* mod  ; const float* xlat  ; const float* xctx  ;
    __device__ __forceinline__ void operator()(EPI_ARGS) const {
        EPI_LANE
        const int b = u.pm / 17, tb = u.pm % 17; const bool isctx = tb == 0;
        const float* g1 = mod + (size_t)(isctx ? 4 : b) * 12288 + 2 * 2048;
        const float* xbase = isctx ? xctx + (size_t)b * cf::CTX * 2048 : xlat + ((size_t)b * cf::S + (size_t)(tb - 1) * 256) * 2048;
        const int rl0 = wr * 64 + fr, col0 = u.pn * BM + wc * 32 + 8 * fq;
        f32x4 gv[2][2];
#pragma unroll
        for (int bj = 0; bj < 2; ++bj) { gv[bj][0] = *(const f32x4*)(g1 + col0 + bj * HALF); gv[bj][1] = *(const f32x4*)(g1 + col0 + bj * HALF + 4); }
#pragma unroll
        for (int ai = 0; ai < 2; ++ai) {
            f32x4 xv[4][2][2];
#pragma unroll
            for (int m = 0; m < 4; ++m) { const int rl = rl0 + ai * HALF + m * 16;
#pragma unroll
                for (int bj = 0; bj < 2; ++bj) { const float* xp = xbase + (size_t)rl * 2048 + col0 + bj * HALF; xv[m][bj][0] = *(const f32x4*)xp; xv[m][bj][1] = *(const f32x4*)(xp + 4); } }
#pragma unroll
            for (int m = 0; m < 4; ++m) { const int rl = rl0 + ai * HALF + m * 16; float* op = X1 + ((size_t)u.pm * BM + rl) * 2048 + col0;
#pragma unroll
                for (int bj = 0; bj < 2; ++bj) { *(f32x4*)(op + bj * HALF) = xv[m][bj][0] * cf::ALPHA + gv[bj][0] * acc[ai][bj][m][0];
                    *(f32x4*)(op + bj * HALF + 4) = xv[m][bj][1] * cf::ALPHA + gv[bj][1] * acc[ai][bj][m][1]; } }
            asm volatile("" ::: "memory"); }
    }
};
}

struct Ctx {
    const float* const* in; float* out; unsigned char* ws;
    ldsp_t lds; int tid, lane, wave, G, bid;
};
#define WSP(T, off) ((T*)(F.ws + (off)))
__device__ __forceinline__ Ctx phase_ctx(const Ctx& F0) {
    Ctx C = F0;
    C.tid = F0.wave * 64 + lane_id();
    asm volatile("" : "+v"(C.tid));
    { size_t z = 0; asm volatile("" : "+s"(z)); C.ws = F0.ws + z; }
    C.lane = C.tid & 63; C.wave = __builtin_amdgcn_readfirstlane(C.tid >> 6);
    return C;
}

__device__ __forceinline__ int srcmap(int mode, int n) {
    if (mode == 0) {
        const int pn = n >> 8, q = n & 255, bj = q >> 7, r = q & 127, rope = (r >> 6) * 128 + bj * 64 + (r & 63);
        if (pn == 0) return rope;
        if (pn == 1) return 256 + q;
        if (pn == 2) return 512 + q;
        if (pn == 3) return r < 32 ? 768 + bj * 32 + r : -1;
        if (pn == 4) return 832 + rope;
        if (pn == 5) return 1088 + q;
        if (pn < 10) return 1344 + (pn - 6) * 256 + rope;
        if (pn < 12) return 2368 + (pn - 10) * 256 + q;
        if (pn < 16) return 2880 + (pn - 12) * 256 + rope;
        if (pn < 24) return 3904 + bj * 1024 + 128 * (pn - 16) + r;
        return 5952 + (n - 6144);
    }
    if (mode == 1) { if (n < 1024) return (n >> 7) * 192 + (n & 127);
        const int m = n - 1024, t = m >> 8, bj = (m >> 7) & 1, q = m & 127; return (4 * t + (q >> 5)) * 192 + 128 + bj * 32 + (q & 31); }
    if (mode == 2) { if (n < 1024) return (n >> 7) * 256 + (n & 127); const int m = n - 1024; return (m >> 7) * 256 + 128 + (m & 127); }
    return n;
}
__device__ __forceinline__ void tr_tile(const Ctx& F, const float* src, int ld_src, int mode, int k0, bf16_t* dst, int ldd, int n0, const float* kscale = nullptr) {
    LAS float* T = (LAS float*)F.lds;
    const int kr = F.tid >> 6, nc = (F.tid & 63) * 4, sc = srcmap(mode, n0 + nc);
    f32x4 v[8];
#pragma unroll
    for (int h = 0; h < 8; ++h) { v[h] = (f32x4){0.f, 0.f, 0.f, 0.f}; if (sc >= 0) v[h] = *(const f32x4*)(src + (size_t)(k0 + kr + 8 * h) * ld_src + sc); }
#pragma unroll
    for (int h = 0; h < 8; ++h) { const int k = kr + 8 * h; f32x4 x = v[h]; if (kscale) x = x * kscale[k0 + k];
        T[k * 257 + nc + 0] = x[0]; T[k * 257 + nc + 1] = x[1]; T[k * 257 + nc + 2] = x[2]; T[k * 257 + nc + 3] = x[3]; }
    __syncthreads();
    const int n = F.tid >> 1, kc = (F.tid & 1) * 32;
#pragma unroll
    for (int j = 0; j < 4; ++j) { u32x4 w; const int kb = kc + 8 * j;
        w.x = cvt_pk_bf16(T[(kb + 0) * 257 + n], T[(kb + 1) * 257 + n]); w.y = cvt_pk_bf16(T[(kb + 2) * 257 + n], T[(kb + 3) * 257 + n]);
        w.z = cvt_pk_bf16(T[(kb + 4) * 257 + n], T[(kb + 5) * 257 + n]); w.w = cvt_pk_bf16(T[(kb + 6) * 257 + n], T[(kb + 7) * 257 + n]);
        *(u32x4*)(dst + (size_t)(n0 + n) * ldd + k0 + kb) = w; }
    __syncthreads();
}
__device__ __forceinline__ void cvt_rows(const Ctx& F, const float* src, bf16_t* dst, size_t n8) {
    for (size_t i = (size_t)F.bid * 512 + F.tid; i < n8; i += (size_t)F.G * 512) {
        const f32x4 a = *(const f32x4*)(src + i * 8), b = *(const f32x4*)(src + i * 8 + 4);
        *(u32x4*)(dst + i * 8) = pg8::pack8(a, b); }
}

constexpr int UV_ROW = 2176, SC_BIAS = 103;
__device__ __forceinline__ float uv_scale(unsigned byte) { return __uint_as_float((byte << 20) + ((unsigned)SC_BIAS << 23)); }
__device__ __forceinline__ void cvt_rows_fp4(const Ctx& F, const float* src, unsigned char* dst, size_t nblk, int which) {
    for (size_t i = (size_t)F.bid * 512 + F.tid; i < nblk; i += (size_t)F.G * 512) {
        f32x4 a[8]; float amax = 0.f;
#pragma unroll
        for (int j = 0; j < 8; ++j) { a[j] = *(const f32x4*)(src + i * 32 + 4 * j); amax = fmaxf(amax, fmaxf(fmaxf(fabsf(a[j][0]), fabsf(a[j][1])), fmaxf(fabsf(a[j][2]), fabsf(a[j][3])))); }
        const unsigned rb = (__float_as_uint(amax * (1.0f / 6.0f)) + 0xFFFFFu) >> 20;
        const unsigned sb = rb < ((unsigned)SC_BIAS << 3) ? 0u : (rb - ((unsigned)SC_BIAS << 3) > 255u ? 255u : rb - ((unsigned)SC_BIAS << 3));
        const float inv = 1.0f / uv_scale(sb);
        u32x4 w;
#pragma unroll
        for (int j = 0; j < 4; ++j) { const f32x4 x = a[2 * j] * inv, y = a[2 * j + 1] * inv; unsigned p = 0u;
            p = __builtin_amdgcn_cvt_scalef32_pk_fp4_f32(p, x[0], x[1], 1.0f, 0); p = __builtin_amdgcn_cvt_scalef32_pk_fp4_f32(p, x[2], x[3], 1.0f, 1);
            p = __builtin_amdgcn_cvt_scalef32_pk_fp4_f32(p, y[0], y[1], 1.0f, 2); p = __builtin_amdgcn_cvt_scalef32_pk_fp4_f32(p, y[2], y[3], 1.0f, 3); w[j] = p; }
        const size_t row = i >> 6; const int bl = (int)(i & 63);
        *(u32x4*)(dst + row * UV_ROW + which * 1024 + bl * 16) = w; dst[row * UV_ROW + 2048 + 2 * bl + which] = (unsigned char)sb;
    }
}

__device__ __forceinline__ void ph_prologue(const Ctx& F0) {
    const Ctx F = phase_ctx(F0);
    using namespace cf;
    constexpr int T_WIN = 2 * 32 * 56, T_QUP = 2 * 8 * 6, T_KVUP = 2 * 4 * 8, T_BR = 2 * 4 * 16 * 8, T_WO = 2 * 32 * 8;
    constexpr int T_ALL = T_WIN + T_QUP + T_KVUP + T_BR + T_WO;
    for (int u = F.bid; u < T_ALL; u += F.G) {
        int t = u;
        if (t < T_WIN) { const int l = t / (32 * 56), r = t % (32 * 56), kt = r / 56, nt = r % 56;
            tr_tile(F, F.in[I_WIN] + (size_t)l * 2048 * IN_COLS, IN_COLS, 0, kt * 64, WSP(bf16_t, WS_WIN) + (size_t)l * NC * 2048, 2048, nt * 256); continue; }
        t -= T_WIN;
        if (t < T_QUP) { const int l = t / (8 * 6), r = t % (8 * 6), kt = r / 6, nt = r % 6;
            tr_tile(F, F.in[I_WQUP] + (size_t)l * 512 * 1536, 1536, 1, kt * 64, WSP(bf16_t, WS_WQUP) + (size_t)l * 1536 * 512, 512, nt * 256, F.in[I_BQN] + l * 512); continue; }
        t -= T_QUP;
        if (t < T_KVUP) { const int l = t / (4 * 8), r = t % (4 * 8), kt = r / 8, nt = r % 8;
            tr_tile(F, F.in[I_WKVUP] + (size_t)l * 256 * 2048, 2048, 2, kt * 64, WSP(bf16_t, WS_WKVUP) + (size_t)l * 2048 * 256, 256, nt * 256, F.in[I_BKVN] + l * 256); continue; }
        t -= T_KVUP;
        if (t < T_BR) { const int l = t / (4 * 128), r = t % (4 * 128), br = r / 128, r2 = r % 128, kt = r2 / 8, nt = r2 % 8;
            const float* src = (br == 0 ? F.in[I_WBRA] : br == 1 ? F.in[I_WBRB] : br == 2 ? F.in[I_WBRC] : F.in[I_WBRD]) + (size_t)l * 1024 * 2048;
            tr_tile(F, src, 2048, 3, kt * 64, WSP(bf16_t, WS_WBR) + ((size_t)l * 4 + br) * 2048 * 1024, 1024, nt * 256); continue; }
        t -= T_BR;
        { const int l = t / 256, r = t % 256, kt = r / 8, nt = r % 8;
            tr_tile(F, F.in[I_WO] + (size_t)l * 2048 * 2048, 2048, 3, kt * 64, WSP(bf16_t, WS_WO) + (size_t)l * 2048 * 2048, 2048, nt * 256); }
    }
    for (int u = F.bid; u < 2 * 16 * 32; u += F.G) {
        const int l = u / 512, g = (u % 512) / 32, d0 = (u % 32) * 64;
        LAS float* sk = (LAS float*)F.lds; LAS float* wt = (LAS float*)(F.lds + 128 * 129 * 4);
        const float* skg = F.in[I_PSK] + ((size_t)l * 16 + g) * 128 * 128;
        const float* wqg = F.in[I_PWQ] + (size_t)l * 2048 * 2048 + (size_t)d0 * 2048 + g * 128;
#pragma unroll
        for (int r = 0; r < 8; ++r) { const int i = (r * 512 + F.tid) * 4; const f32x4 v = *(const f32x4*)(skg + i); LAS float* p = sk + (i >> 7) * 129 + (i & 127); p[0] = v[0]; p[1] = v[1]; p[2] = v[2]; p[3] = v[3]; }
#pragma unroll
        for (int r = 0; r < 4; ++r) { const int i = (r * 512 + F.tid) * 4; const f32x4 v = *(const f32x4*)(wqg + (size_t)(i >> 7) * 2048 + (i & 127)); LAS float* p = wt + (i >> 7) * 129 + (i & 127); p[0] = v[0]; p[1] = v[1]; p[2] = v[2]; p[3] = v[3]; }
        __syncthreads();
        const int db = F.wave & 1, nb = F.wave >> 1, li = F.lane & 31, kk = F.lane >> 5;
        const LAS float* ap = wt + (db * 32 + li) * 129 + kk; const LAS float* bp = sk + (nb * 32 + li) * 129 + kk;
        f32x16 acc;
#pragma unroll
        for (int e = 0; e < 16; ++e) acc[e] = 0.f;
#pragma unroll 16
        for (int st = 0; st < 64; ++st) acc = __builtin_amdgcn_mfma_f32_32x32x2f32(ap[2 * st], bp[2 * st], acc, 0, 0, 0);
        bf16_t* dst = WSP(bf16_t, WS_WFOLD) + (size_t)l * 2048 * 2048 + (size_t)(g * 128 + nb * 32 + li) * 2048 + d0 + db * 32 + 4 * kk;
#pragma unroll
        for (int q = 0; q < 4; ++q) { u32x2 w; w.x = cvt_pk_bf16(acc[4 * q], acc[4 * q + 1]); w.y = cvt_pk_bf16(acc[4 * q + 2], acc[4 * q + 3]); *(u32x2*)(dst + 8 * q) = w; }
        __syncthreads();
    }
    for (int u = F.bid; u < 2 * 192; u += F.G) {
        const int l = u / 192, n0 = (u % 192) * 64;
        LAS float* sl = (LAS float*)F.lds; LAS float* red = (LAS float*)(F.lds + 5 * 2048 * 4);
        for (int i = F.tid; i < 5 * 2048; i += 512) { const int r = i >> 11, k = i & 2047; const float v = r < 4 ? F.in[I_C][r * 2048 + k] : F.in[I_CCTX][k]; sl[i] = v * sigmoidf_(v); }
        __syncthreads();
        const int cg = F.tid & 15, ks = F.tid >> 4;
        f32x4 a[5];
#pragma unroll
        for (int r = 0; r < 5; ++r) a[r] = (f32x4){0.f, 0.f, 0.f, 0.f};
        const float* wp = F.in[I_WADA] + (size_t)l * 2048 * 12288 + n0 + cg * 4;
#pragma unroll 8
        for (int k = ks * 64; k < ks * 64 + 64; ++k) { const f32x4 w = *(const f32x4*)(wp + (size_t)k * 12288);
#pragma unroll
            for (int r = 0; r < 5; ++r) a[r] += w * sl[r * 2048 + k]; }
#pragma unroll
        for (int r = 0; r < 5; ++r) *(LAS f32x4*)(red + (ks * 5 + r) * 64 + cg * 4) = a[r];
        __syncthreads();
        if (F.tid < 320) { const int r = F.tid >> 6, col = F.tid & 63; float sacc = 0.f;
#pragma unroll
            for (int k2 = 0; k2 < 32; ++k2) sacc += red[(k2 * 5 + r) * 64 + col];
            WSP(float, WS_MOD)[((size_t)l * 5 + r) * 12288 + n0 + col] = sacc + F.in[I_BADA][(size_t)l * 12288 + n0 + col]; }
        __syncthreads();
    }
    for (int i = F.bid * 512 + F.tid; i < 4096 * 64; i += F.G * 512) {
        const int pos = i >> 6, j = i & 63, fi = j & 31; const float fr = powf(10000.0f, -(float)(2 * fi) / 64.0f);
        const float ang = (float)(j < 32 ? (pos >> 6) : (pos & 63)) * fr;
        WSP(float, WS_COSH)[i] = cosf(ang); WSP(float, WS_SINH)[i] = sinf(ang);
    }
    for (int i = F.bid * 512 + F.tid; i < 4096 * 32; i += F.G * 512) {
        const int pos = i >> 5, j = i & 31, fi = j & 15; const float fr = powf(10000.0f, -(float)(2 * fi) / 32.0f);
        const float ang = (float)(j < 16 ? (pos >> 6) : (pos & 63)) * fr;
        WSP(float, WS_COSR)[i] = cosf(ang); WSP(float, WS_SINR)[i] = sinf(ang);
    }
    cvt_rows_fp4(F, F.in[I_PU], WSP(unsigned char, WS_UB), (size_t)2 * NEXP * 64, 0);
    cvt_rows_fp4(F, F.in[I_PV], WSP(unsigned char, WS_UB), (size_t)2 * NEXP * 64, 1);
}

__device__ __forceinline__ void ph_modulate0(const Ctx& F0) {
    const Ctx F = phase_ctx(F0);
    using namespace cf;
    const float* mod = WSP(float, WS_MOD);
    for (size_t i = (size_t)F.bid * 512 + F.tid; i < (size_t)MR * 256; i += (size_t)F.G * 512) {
        const int R = (int)(i >> 8), d = (int)(i & 255) * 8, b = R / RB, j = R % RB;
        const float* src = j < CTX ? F.in[I_CTX] + ((size_t)b * CTX + j) * 2048 : F.in[I_X] + ((size_t)b * S + (j - CTX)) * 2048;
        const float* m = mod + (size_t)(j < CTX ? 4 : b) * 12288;
        const f32x4 x0 = *(const f32x4*)(src + d), x1 = *(const f32x4*)(src + d + 4);
        const f32x4 sh0 = *(const f32x4*)(m + d), sh1 = *(const f32x4*)(m + d + 4), s0 = *(const f32x4*)(m + 2048 + d), s1 = *(const f32x4*)(m + 2048 + d + 4);
        *(u32x4*)(WSP(bf16_t, WS_HB) + (size_t)R * 2048 + d) = pg8::pack8(x0 * (s0 + 1.0f) + sh0, x1 * (s1 + 1.0f) + sh1);
    }
}

__device__ __forceinline__ void knorm_pass(const Ctx& F) {
    using namespace cf;
    bf16_t* P = WSP(bf16_t, WS_P); const float* ssk = WSP(const float, WS_SSK);
    for (int it = F.bid * 8 + F.wave; it < MR * 2; it += F.G * 8) {
        const int R = it >> 1, h = it & 1;
        const f32x2 pp = *(const f32x2*)(ssk + (size_t)it * 2); const float r = rsqrtf((pp.x + pp.y) * (1.f / 128.f) + 1e-6f);
        unsigned* q = (unsigned*)(P + (size_t)R * NC + PC_AK + h * 128) + F.lane;
        const unsigned w = *q; *q = cvt_pk_bf16(bflo(w) * r, bfhi(w) * r);
    }
}

struct AttnArgs {
    const bf16_t* Q; const bf16_t* K; const bf16_t* V; bf16_t* O; int ldq, ldk, ldv, ldo;
    int seg0_row, seg0_tiles, seg1_row, seg1_tiles;
    int mask_on, qpos0, kpos1;
    float sc_log2; int has_sink; float sink_l2;
    int variant;
    const float* qss;
};
constexpr float LOG2E_F = 1.4426950408889634f;
template <int DK, bool MASKED>
__device__ __forceinline__ void attn_unit(ldsp_t lds, const AttnArgs a, int wave_) {
    constexpr int ND = DK / 16, KCH = DK / 8, KPT = (64 * KCH) / 512, VST = 72, KM = DK == 128 ? 15 : 7;
    constexpr int KBUF = 64 * DK * 2, VBUF = 128 * VST * 2, VOFF = 2 * KBUF, ALOFF = VOFF + 3 * VBUF;
    int tid = wave_ * 64 + lane_id(); asm volatile("" : "+v"(tid));
    const int wid = __builtin_amdgcn_readfirstlane(tid >> 6), lane = tid & 63, q32 = lane & 31, hi = lane >> 5;
    LAS float* al = (LAS float*)(lds + ALOFF + wid * 128);
    bf16x8 qf[ND];
    { float scq = a.sc_log2;
      if (a.qss) { const f32x2 pp = *(const f32x2*)(a.qss + (size_t)(wid * 32 + q32) * 16); scq *= rsqrtf((pp.x + pp.y) * (1.f / 128.f) + 1e-6f); }
      const bf16_t* qrow = a.Q + (size_t)(wid * 32 + q32) * a.ldq + 8 * hi;
#pragma unroll
      for (int s = 0; s < ND; ++s) { const u32x4 w = *(const u32x4*)(qrow + 16 * s); u32x4 o;
          o.x = cvt_pk_bf16(bflo(w.x) * scq, bfhi(w.x) * scq); o.y = cvt_pk_bf16(bflo(w.y) * scq, bfhi(w.y) * scq);
          o.z = cvt_pk_bf16(bflo(w.z) * scq, bfhi(w.z) * scq); o.w = cvt_pk_bf16(bflo(w.w) * scq, bfhi(w.w) * scq); qf[s] = *(bf16x8*)&o; } }
    f32x16 o[4];
#pragma unroll
    for (int db = 0; db < 4; ++db)
#pragma unroll
        for (int r = 0; r < 16; ++r) o[db][r] = 0.f;
    float m_run = -1e30f, l_run = 0.f;
    const int PV_ = MK_AV ? a.variant : 0;
    const int ntiles = a.seg0_tiles + a.seg1_tiles;
    u32x4 vreg[2];
    const int vkp = tid & 31, vdc = tid >> 5;
    const int vkey = 2 * vkp, vpos = (vkey & 48) | ((vkey & 4) << 1) | ((vkey & 8) >> 1) | (vkey & 3);
    unsigned koff[KPT];
#pragma unroll
    for (int i = 0; i < KPT; ++i) { const int P = (i * 8 + wid) * 64 + lane, row = P / KCH, cp = P % KCH; koff[i] = (unsigned)(row * a.ldk + 8 * (cp ^ (row & KM))) * 2u; }
#define ATT_LOAD(tt, kb) do { const int _r0 = (tt) < a.seg0_tiles ? a.seg0_row + 64 * (tt) : a.seg1_row + 64 * ((tt) - a.seg0_tiles); \
        const char* _kg = (const char*)(a.K + (size_t)_r0 * a.ldk); \
        _Pragma("unroll") for (int _i = 0; _i < KPT; ++_i) __builtin_amdgcn_global_load_lds((const unsigned*)(_kg + koff[_i]), (LAS unsigned*)(lds + (kb) * KBUF + (_i * 8 + wid) * 1024), 16, 0, 0); \
        vreg[0] = *(const u32x4*)(a.V + (size_t)(_r0 + 2 * vkp) * a.ldv + 8 * vdc); vreg[1] = *(const u32x4*)(a.V + (size_t)(_r0 + 2 * vkp + 1) * a.ldv + 8 * vdc); } while (0)
#define ATT_WRITE(vb) do { const ldsp_t _vb = lds + VOFF + (vb) * VBUF; \
        const unsigned _a0[4] = {vreg[0].x, vreg[0].y, vreg[0].z, vreg[0].w}, _a1[4] = {vreg[1].x, vreg[1].y, vreg[1].z, vreg[1].w}; \
        _Pragma("unroll") for (int _e = 0; _e < 4; ++_e) { \
            *(LAS unsigned*)(_vb + ((8 * vdc + 2 * _e) * VST + vpos) * 2) = (_a0[_e] & 0xffffu) | (_a1[_e] << 16); \
            *(LAS unsigned*)(_vb + ((8 * vdc + 2 * _e + 1) * VST + vpos) * 2) = (_a0[_e] >> 16) | (_a1[_e] & 0xffff0000u); } } while (0)
#define ATT_PV(vb) do { const ldsp_t _vt = lds + VOFF + (vb) * VBUF; \
        _Pragma("unroll") for (int db = 0; db < 4; ++db) _Pragma("unroll") for (int ks = 0; ks < 4; ++ks) { \
            const bf16x8 vf = *(const LAS bf16x8*)(_vt + ((32 * db + q32) * VST + 16 * ks + 8 * hi) * 2); \
            o[db] = __builtin_amdgcn_mfma_f32_32x32x16_bf16(pa[ks], vf, o[db], 0, 0, 0); } } while (0)
    bf16x8 pa[4];
#pragma unroll
    for (int i = 0; i < 4; ++i) pa[i] = (bf16x8){0, 0, 0, 0, 0, 0, 0, 0};
    int vprev = 2, vcur = 0, vnext = 1;
    { unsigned z0 = 0u; asm volatile("" : "+v"(z0));
      for (int i = tid; i < VBUF / 16; i += 512) *(LAS u32x4*)(lds + VOFF + 2 * VBUF + i * 16) = (u32x4){z0, z0, z0, z0}; }
    ATT_LOAD(0, 0);
    ATT_WRITE(0);
    asm volatile("s_waitcnt vmcnt(0)" ::: "memory");
    __syncthreads();
    for (int tt = 0; tt < ntiles; ++tt) {
        const int cur = tt & 1;
        if (tt + 1 < ntiles && PV_ != 4) ATT_LOAD(tt + 1, cur ^ 1);
        const ldsp_t Ks = lds + cur * KBUF;
        f32x16 s0, s1;
#pragma unroll
        for (int r = 0; r < 16; ++r) { s0[r] = 0.f; s1[r] = 0.f; }
        { bf16x8 kf[2][2];
#define ATT_LDK(p, sb) do { kf[p][0] = *(const LAS bf16x8*)(Ks + (q32 * KCH + ((2 * (sb) + hi) ^ (q32 & KM))) * 16); kf[p][1] = *(const LAS bf16x8*)(Ks + ((32 + q32) * KCH + ((2 * (sb) + hi) ^ (q32 & KM))) * 16); } while (0)
          if (PV_ != 2) {
          ATT_LDK(0, 0);
#pragma unroll
          for (int sb = 0; sb < ND; ++sb) {
              if (sb + 1 < ND) ATT_LDK((sb + 1) & 1, sb + 1);
              s0 = __builtin_amdgcn_mfma_f32_32x32x16_bf16(kf[sb & 1][0], qf[sb], s0, 0, 0, 0);
              s1 = __builtin_amdgcn_mfma_f32_32x32x16_bf16(kf[sb & 1][1], qf[sb], s1, 0, 0, 0);
              }
          }
#undef ATT_LDK
        }
        const bool msk = MASKED && a.mask_on && tt >= a.seg0_tiles;
        if (MASKED) { const int kp0 = a.kpos1 + 64 * (tt - a.seg0_tiles) + 4 * hi, qp = a.qpos0 + wid * 32 + q32;
#pragma unroll
            for (int r = 0; r < 16; ++r) { float t0 = s0[r], t1 = s1[r];
                if (msk) { const int d0 = qp - (kp0 + (r & 3) + 8 * (r >> 2)), d1 = d0 - 32; if (d0 > 128 || d0 < -128) t0 = -1e30f; if (d1 > 128 || d1 < -128) t1 = -1e30f; s0[r] = t0; s1[r] = t1; } }
            __builtin_amdgcn_sched_barrier(0); }
        float mx = -1e30f, m_new = 0.f, alpha = 1.f, ps = 0.f;
        bf16x8 pn[4] = {pa[0], pa[1], pa[2], pa[3]};
        { const ldsp_t _vt = lds + VOFF + vprev * VBUF; bf16x8 vfr[3]; vfr[2] = pa[0];
#define ATT_LDV(i) (*(const LAS bf16x8*)(_vt + ((32 * ((i) >> 2) + q32) * VST + 16 * ((i) & 3) + 8 * hi) * 2))
#define SCV(e) ((e) < 16 ? s0[(e) & 15] : s1[(e) & 15])
          vfr[0] = ATT_LDV(0); vfr[1] = ATT_LDV(1);
#pragma unroll
          for (int i = 0; i < 16; ++i) {
              if (PV_ != 3) { if (i + 2 < 16) vfr[(i + 2) % 3] = ATT_LDV(i + 2);
              o[i >> 2] = __builtin_amdgcn_mfma_f32_32x32x16_bf16(pa[i & 3], vfr[i % 3], o[i >> 2], 0, 0, 0); }
              if (PV_ == 1) {} else if (i < 4) {
#pragma unroll
                  for (int e = 0; e < 4; ++e) mx = fmaxf(mx, fmaxf(s0[4 * i + e], s1[4 * i + e]));
              } else if (i == 4) {
                  { const auto rr = __builtin_amdgcn_permlane32_swap(__float_as_uint(mx), __float_as_uint(mx), false, false);
                    mx = fmaxf(__uint_as_float(rr[0]), __uint_as_float(rr[1])); }
                  if (__all(mx - m_run <= 8.0f * LOG2E_F)) { m_new = m_run; alpha = 1.f; }
                  else { m_new = fmaxf(m_run, mx); alpha = __builtin_amdgcn_exp2f(m_run - m_new); m_run = m_new; }
              } else if (i < 13) {
#pragma unroll
                  for (int e = 0; e < 2; ++e) { const int r = 2 * (i - 5) + e; s0[r] = __builtin_amdgcn_exp2f(s0[r] - m_new); s1[r] = __builtin_amdgcn_exp2f(s1[r] - m_new); ps += s0[r] + s1[r]; }
              } else if (i == 13) {
                  u32x4 w; w.x = cvt_pk_bf16(s0[0], s0[1]); w.y = cvt_pk_bf16(s0[2], s0[3]); w.z = cvt_pk_bf16(s0[4], s0[5]); w.w = cvt_pk_bf16(s0[6], s0[7]); pn[0] = *(bf16x8*)&w;
                  u32x4 v; v.x = cvt_pk_bf16(s0[8], s0[9]); v.y = cvt_pk_bf16(s0[10], s0[11]); v.z = cvt_pk_bf16(s0[12], s0[13]); v.w = cvt_pk_bf16(s0[14], s0[15]); pn[1] = *(bf16x8*)&v;
              } else if (i == 14) {
                  u32x4 w; w.x = cvt_pk_bf16(s1[0], s1[1]); w.y = cvt_pk_bf16(s1[2], s1[3]); w.z = cvt_pk_bf16(s1[4], s1[5]); w.w = cvt_pk_bf16(s1[6], s1[7]); pn[2] = *(bf16x8*)&w;
                  u32x4 v; v.x = cvt_pk_bf16(s1[8], s1[9]); v.y = cvt_pk_bf16(s1[10], s1[11]); v.z = cvt_pk_bf16(s1[12], s1[13]); v.w = cvt_pk_bf16(s1[14], s1[15]); pn[3] = *(bf16x8*)&v;
              } else { l_run = l_run * alpha + ps; }
          }
#undef ATT_LDV
#undef SCV
        }
#pragma unroll
        for (int i = 0; i < 4; ++i) pa[i] = pn[i];
        if (__any(alpha < 1.0f)) {
            if (hi == 0) al[q32] = alpha;
            asm volatile("s_waitcnt lgkmcnt(0)" ::: "memory");
#pragma unroll
            for (int g4 = 0; g4 < 4; ++g4) { const f32x4 av = *(const LAS f32x4*)(al + 8 * g4 + 4 * hi);
#pragma unroll
                for (int db = 0; db < 4; ++db)
#pragma unroll
                    for (int j = 0; j < 4; ++j) o[db][4 * g4 + j] *= av[j]; }
        }
        if (tt + 1 < ntiles && PV_ != 4) ATT_WRITE(vnext);
        { const int t3 = vprev; vprev = vcur; vcur = vnext; vnext = t3; }
        asm volatile("s_waitcnt vmcnt(0)" ::: "memory");
        if (PV_ != 5) __syncthreads();
    }
    ATT_PV(vprev);
#undef ATT_LOAD
#undef ATT_WRITE
#undef ATT_PV
    __syncthreads();
    float l_tot; { const auto rr = __builtin_amdgcn_permlane32_swap(__float_as_uint(l_run), __float_as_uint(l_run), false, false); l_tot = __uint_as_float(rr[0]) + __uint_as_float(rr[1]); }
    if (a.has_sink) l_tot += __builtin_amdgcn_exp2f(a.sink_l2 - m_run);
    if (hi == 0) al[q32] = 1.0f / l_tot;
    asm volatile("s_waitcnt lgkmcnt(0)" ::: "memory");
    const ldsp_t Ost = lds + wid * 8192;
#pragma unroll
    for (int g4 = 0; g4 < 4; ++g4) { const f32x4 iv = *(const LAS f32x4*)(al + 8 * g4 + 4 * hi);
#pragma unroll
        for (int db = 0; db < 4; ++db)
#pragma unroll
            for (int j = 0; j < 4; ++j) *(LAS bf16_t*)(Ost + ((8 * g4 + 4 * hi + j) * 128 + 32 * db + q32) * 2) = f2bf(o[db][4 * g4 + j] * iv[j]); }
    asm volatile("s_waitcnt lgkmcnt(0)" ::: "memory");
    const int lane_o = lane_id();
#pragma unroll
    for (int i = 0; i < 8; ++i) { const int c = lane_o + 64 * i, row = c >> 4, c8 = c & 15;
        *(u32x4*)(a.O + (size_t)(wid * 32 + row) * a.ldo + 8 * c8) = *(const LAS u32x4*)(Ost + (row * 128 + 8 * c8) * 2); }
}

__device__ __forceinline__ void conv_unit(const Ctx& F, int layer, int row0  , int seq_len, int t0) {
    using namespace cf;
    const bf16_t* P = WSP(const bf16_t, WS_P); bf16_t* BR = WSP(bf16_t, WS_BR);
    const float* cw = F.in[I_CW] + (size_t)layer * 31 * 1024; const float* cb = F.in[I_CB] + layer * 1024;
    const float* lg = F.in[I_CLG] + layer * 1024; const float* lb = F.in[I_CLB] + layer * 1024;
    int tid = F.wave * 64 + lane_id(); asm volatile("" : "+v"(tid));
    const int lane = tid & 63;
    LAS float* red = (LAS float*)(F.lds + 126976); LAS float* tot = red + 8 * 32;
    __syncthreads();
    for (int c = tid; c < 62 * 128; c += 512) { const int rr = c >> 7, ch = c & 127, t = t0 - 15 + rr;
        u32x4 v = {0u, 0u, 0u, 0u};
        if (t >= 0 && t < seq_len) v = *(const u32x4*)(P + (size_t)(row0 + t) * NC + PC_GLU + ch * 8);
        *(LAS u32x4*)(F.lds + rr * 2048 + ch * 16) = v; }
    float w0[31], w1[31];
#pragma unroll
    for (int k = 0; k < 31; ++k) { const f32x2 w = *(const f32x2*)(cw + k * 1024 + 2 * tid); w0[k] = w.x; w1[k] = w.y; }
    const f32x2 bv = *(const f32x2*)(cb + 2 * tid), gg = *(const f32x2*)(lg + 2 * tid), bb = *(const f32x2*)(lb + 2 * tid);
    __syncthreads();
#pragma unroll 1
    for (int part = 0; part < 4; ++part) {
        float a0[8], a1[8];
#pragma unroll
        for (int t = 0; t < 8; ++t) { a0[t] = bv.x; a1[t] = bv.y; }
        const ldsp_t base = F.lds + part * 8 * 2048 + tid * 4;
#pragma unroll
        for (int rr = 0; rr < 38; ++rr) { const unsigned xw = *(const LAS unsigned*)(base + rr * 2048); const float x0 = bflo(xw), x1 = bfhi(xw);
#pragma unroll
            for (int t = 0; t < 8; ++t) { const int k = rr - t; if (k >= 0 && k <= 30) { a0[t] += x0 * w0[k]; a1[t] += x1 * w1[k]; } } }
        float v[16];
#pragma unroll
        for (int t = 0; t < 8; ++t) { v[t] = a0[t] + a1[t]; v[8 + t] = a0[t] * a0[t] + a1[t] * a1[t]; }
#pragma unroll
        for (int i = 0; i < 8; ++i) { const bool up = lane & 32; const float snd = up ? v[i] : v[i + 8], kp = up ? v[i + 8] : v[i]; v[i] = kp + shx(snd, 32, lane); }
#pragma unroll
        for (int i = 0; i < 4; ++i) { const bool up = lane & 16; const float snd = up ? v[i] : v[i + 4], kp = up ? v[i + 4] : v[i]; v[i] = kp + shx(snd, 16, lane); }
#pragma unroll
        for (int i = 0; i < 2; ++i) { const bool up = lane & 8; const float snd = up ? v[i] : v[i + 2], kp = up ? v[i + 2] : v[i]; v[i] = kp + shx(snd, 8, lane); }
        { const bool up = lane & 4; const float snd = up ? v[0] : v[1], kp = up ? v[1] : v[0]; v[0] = kp + shx(snd, 4, lane); }
        v[0] += shx(v[0], 2, lane); v[0] += shx(v[0], 1, lane);
        if ((lane & 3) == 0) red[F.wave * 16 + (lane >> 2)] = v[0];
        __syncthreads();
        if (tid < 16) { float s = 0.f;
#pragma unroll
            for (int w = 0; w < 8; ++w) s += red[w * 16 + tid];
            tot[tid] = s; }
        __syncthreads();
#pragma unroll
        for (int t = 0; t < 8; ++t) { const float mean = tot[t] * (1.f / 1024.f), var = fmaxf(tot[8 + t] * (1.f / 1024.f) - mean * mean, 0.f), rstd = rsqrtf(var + 1e-5f);
            const float y0 = (a0[t] - mean) * rstd * gg.x + bb.x, y1 = (a1[t] - mean) * rstd * gg.y + bb.y;
            *(unsigned*)(BR + (size_t)(row0 + t0 + part * 8 + t) * 4096 + 2048 + 2 * tid) = cvt_pk_bf16(y0 * sigmoidf_(y0), y1 * sigmoidf_(y1)); }
    }
}

__device__ __forceinline__ void attn_defaults(AttnArgs& a, int isctx) {
    a.seg0_row = 0; a.seg0_tiles = isctx ? 4 : 68; a.seg1_row = 0; a.seg1_tiles = 0; a.mask_on = 0; a.qpos0 = 0; a.kpos1 = 0; a.has_sink = 0; a.sink_l2 = 0.f; a.qss = nullptr; a.variant = 0; }
__device__ __forceinline__ void attn_unit_decode(int u, int G, bool gqa, int& b, int& h, int& qb) {
    if (G != 256) { b = u >> 7; h = (u >> 4) & 7; qb = u & 15; return; }
    const int bid = u & 255, r = u >> 8, x = bid & 7, local = (bid >> 3) + 32 * r;
    qb = local & 15;
    if (gqa) { b = x >> 1; h = (x & 1) * 4 + (local >> 4); }
    else { const int pair = x * 4 + (local >> 4); b = pair >> 3; h = pair & 7; }
}
__device__ __forceinline__ void ph_attn(const Ctx& F0, int layer) {
    const Ctx F = phase_ctx(F0);
    using namespace cf;
    const bf16_t* P = WSP(const bf16_t, WS_P); bf16_t* BR = WSP(bf16_t, WS_BR);
    for (int dup = 0; dup < DUPN(2); ++dup)
    for (int u = F.bid; u < (layer == 0 ? 544 : 512); u += F.G) {
        int b, h, qb, isctx = 0;
        if (u < 512) attn_unit_decode(u, F.G, false, b, h, qb); else { const int r = u - 512; b = r >> 3; h = r & 7; qb = 0; isctx = 1; }
        const size_t brow = (size_t)b * RB, qrow = brow + (isctx ? 0 : CTX) + (size_t)qb * 256;
        AttnArgs a; attn_defaults(a, isctx);
        a.Q = WSP(const bf16_t, WS_QB) + qrow * 1536 + h * 192; a.ldq = 1536;
        a.K = WSP(const bf16_t, WS_KB) + brow * 1536 + h * 192; a.ldk = 1536;
        a.V = WSP(const bf16_t, WS_VB) + brow * 1024 + h * 128; a.ldv = 1024;
        a.O = BR + qrow * 4096 + 1024 + h * 128; a.ldo = 4096; a.sc_log2 = SCALE_MLA * LOG2E;
        __syncthreads();
        attn_unit<192, false>(F.lds, a, F.wave);
    }
    for (int dup = 0; dup < DUPN(3); ++dup)
    for (int u0 = F.bid; u0 < (layer == 0 ? 544 : 512); u0 += F.G) {
        int b, h, qb, isctx = 0;
        if (u0 < 512) attn_unit_decode(u0, F.G, true, b, h, qb); else { const int r = u0 - 512; b = r >> 3; h = r & 7; qb = 0; isctx = 1; }
        const size_t brow = (size_t)b * RB, qrow = brow + (isctx ? 0 : CTX) + (size_t)qb * 256;
        AttnArgs a; attn_defaults(a, isctx);
        a.Q = P + qrow * NC + PC_AQ + h * 128; a.ldq = NC;
        a.K = P + brow * NC + PC_AK + (h >> 2) * 128; a.ldk = NC;
        a.V = P + brow * NC + PC_AV + (h >> 2) * 128; a.ldv = NC;
        a.O = BR + qrow * 4096 + h * 128; a.ldo = 4096; a.sc_log2 = SCALE_HD * LOG2E;
        a.qss = WSP(const float, WS_SSQ) + qrow * 16 + h * 2;
        if (MK_AV && dup == 1) { a.variant = MK_AV; a.O = WSP(bf16_t, WS_HB) + qrow * 2048 + h * 128; a.ldo = 2048; }
        __syncthreads();
        attn_unit<128, false>(F.lds, a, F.wave);
    }
    for (int dup = 0; dup < DUPN(13); ++dup)
    for (int u0 = F.bid; u0 < (layer == 0 ? 544 : 512); u0 += F.G) {
        int b, h, qb, isctx = 0;
        if (u0 < 512) attn_unit_decode(u0, F.G, true, b, h, qb); else { const int r = u0 - 512; b = r >> 3; h = r & 7; qb = 0; isctx = 1; }
        const size_t brow = (size_t)b * RB, qrow = brow + (isctx ? 0 : CTX) + (size_t)qb * 256;
        AttnArgs a; attn_defaults(a, isctx);
        a.Q = P + qrow * NC + PC_DQ + h * 128; a.ldq = NC;
        a.K = P + brow * NC + PC_DK + (h >> 2) * 128; a.ldk = NC;
        a.V = P + brow * NC + PC_DV + (h >> 2) * 128; a.ldv = NC;
        a.O = BR + qrow * 4096 + 3072 + h * 128; a.ldo = 4096; a.sc_log2 = SCALE_HD * LOG2E;
        a.has_sink = 1; a.sink_l2 = F.in[I_SINK][layer * 8 + h] * LOG2E; a.seg0_tiles = 4;
        if (!isctx) { const int start = qb * 256; const int lo = start - 128 < 0 ? 0 : start - 128, hi = start + 384 > S ? S : start + 384;
            a.seg1_row = CTX + lo; a.seg1_tiles = (hi - lo) / 64; a.mask_on = 1; a.qpos0 = start; a.kpos1 = lo; }
        __syncthreads();
        attn_unit<128, true>(F.lds, a, F.wave);
    }
    for (int dup = 0; dup < DUPN(4); ++dup)
    for (int u = F.bid; u < (layer == 0 ? 544 : 512); u += F.G) {
        int b, tb, isctx = 0;
        if (u < 512) { b = u >> 7; tb = u & 127; } else { const int r = u - 512; b = r >> 3; tb = r & 7; isctx = 1; }
        conv_unit(F, layer, b * RB + (isctx ? 0 : CTX), isctx ? CTX : S, tb * 32);
    }
}

__device__ __forceinline__ int tok_row(int layer, int tok) { return layer == 0 ? tok : (tok >> 12) * cf::RB + cf::CTX + (tok & 4095); }
__device__ __forceinline__ void ph_ln1(const Ctx& F0, int layer) {
    const Ctx F = phase_ctx(F0);
    using namespace cf;
    float* X1 = (float*)(F.ws + WS_X1); bf16_t* HB = WSP(bf16_t, WS_HB);
    const float* lg = F.in[I_LN1G] + layer * 2048; const float* lb = F.in[I_LN1B] + layer * 2048;
    const int ntok = layer == 0 ? MR : NB * S, lane = F.lane;
    for (int tok = F.bid * 8 + F.wave; tok < ntok; tok += F.G * 8) {
        const int R = tok_row(layer, tok), b = R / RB, j = R % RB;
        const float* mod = WSP(const float, WS_MOD) + ((size_t)layer * 5 + (j < CTX ? 4 : b)) * 12288;
        float* xp = X1 + (size_t)R * 2048;
        f32x4 v[8]; float s = 0.f;
#pragma unroll
        for (int i = 0; i < 8; ++i) { v[i] = *(const f32x4*)(xp + lane * 4 + 256 * i); s += (v[i][0] + v[i][1]) + (v[i][2] + v[i][3]); }
        const float mean = wave_sum(s, lane) * (1.f / 2048.f); float q = 0.f;
#pragma unroll
        for (int i = 0; i < 8; ++i) { const f32x4 d = v[i] - mean; q += (d[0] * d[0] + d[1] * d[1]) + (d[2] * d[2] + d[3] * d[3]); }
        const float rstd = rsqrtf(wave_sum(q, lane) * (1.f / 2048.f) + 1e-5f);
#pragma unroll
        for (int i = 0; i < 8; ++i) { const int c = lane * 4 + 256 * i;
            const f32x4 y = (v[i] - mean) * rstd * *(const f32x4*)(lg + c) + *(const f32x4*)(lb + c);
            *(f32x4*)(xp + c) = y;
            const f32x4 hp = y * (*(const f32x4*)(mod + 4 * 2048 + c) + 1.0f) + *(const f32x4*)(mod + 3 * 2048 + c);
            u32x2 w; w.x = cvt_pk_bf16(hp[0], hp[1]); w.y = cvt_pk_bf16(hp[2], hp[3]);
            *(u32x2*)(HB + (size_t)R * 2048 + c) = w; }
    }
}

typedef __bf16 bf16x2_t __attribute__((ext_vector_type(2)));
__device__ __forceinline__ unsigned ordkey(float v) { const unsigned u = __float_as_uint(v); return (u & 0x80000000u) ? ~u : (u | 0x80000000u); }
__device__ __forceinline__ int lane_rank(unsigned long long m) { return (int)__builtin_amdgcn_mbcnt_hi((unsigned)(m >> 32), __builtin_amdgcn_mbcnt_lo((unsigned)m, 0u)); }
template <int NV> __device__ __forceinline__ unsigned radix_thresh16(const unsigned (&k)[NV]) {
    unsigned T = 0u;
    for (int bit = 31; bit >= 0; --bit) { const unsigned cand = T | (1u << bit); int cnt = 0;
#pragma unroll
        for (int v = 0; v < NV; ++v) cnt += __popcll(__ballot(k[v] >= cand));
        if (cnt >= 16) { T = cand; if (cnt == 16) break; } }
    return T;
}
__device__ __forceinline__ void radix_thresh16x2(const unsigned (&ka)[2], const unsigned (&kb)[2], unsigned& Ta, unsigned& Tb) {
    unsigned T0 = 0u, T1 = 0u; bool d0 = false, d1 = false;
    for (int bit = 31; bit >= 0; --bit) { const unsigned c0 = T0 | (1u << bit), c1 = T1 | (1u << bit);
        const int n0 = __popcll(__ballot(ka[0] >= c0)) + __popcll(__ballot(ka[1] >= c0)), n1 = __popcll(__ballot(kb[0] >= c1)) + __popcll(__ballot(kb[1] >= c1));
        if (!d0 && n0 >= 16) { T0 = c0; d0 = n0 == 16; }
        if (!d1 && n1 >= 16) { T1 = c1; d1 = n1 == 16; }
        if (d0 && d1) break; }
    Ta = T0; Tb = T1;
}
__device__ __forceinline__ float dot2bf(unsigned a, unsigned b, float acc) { return __builtin_amdgcn_fdot2_f32_bf16(__builtin_bit_cast(bf16x2_t, a), __builtin_bit_cast(bf16x2_t, b), acc, false); }
__device__ __forceinline__ float dot8(const u32x4 a, const u32x4 b, float acc) {
    acc = dot2bf(a.x, b.x, acc); acc = dot2bf(a.y, b.y, acc); acc = dot2bf(a.z, b.z, acc); acc = dot2bf(a.w, b.w, acc);
    return acc;
}
__device__ __forceinline__ float gelu_as(float v) {
    const float av = fabsf(v), t = __builtin_amdgcn_rcpf(av * 0.2316418882f + 1.0f);
    float q = t * 0.5307027145f + (-0.7265760135f); q = q * t + 0.7107068705f; q = q * t + (-0.142248368f); q = q * t + 0.127414796f; q = q * t;
    const float e = __builtin_amdgcn_exp2f((v * v) * (-0.72134752044f)), m = v * (q * e);
    return v < 0.f ? m : v - m;
}
__device__ __forceinline__ void peer_load(u32x4 (&ur)[4], u32x4 (&vr)[4], unsigned (&vs)[4], float (&gq)[4], const LAS int* ei, const LAS float* eg,
                                          const unsigned char* UV, int lane, int grp) {
#pragma unroll
    for (int q = 0; q < 4; ++q) { const int id = __builtin_amdgcn_readfirstlane(ei[grp * 4 + q]); gq[q] = __uint_as_float(__builtin_amdgcn_readfirstlane(__float_as_uint(eg[grp * 4 + q])));
        const unsigned char* row = UV + (size_t)id * UV_ROW;
        ur[q] = *(const u32x4*)(row + lane * 16); vr[q] = *(const u32x4*)(row + 1024 + lane * 16); vs[q] = *(const unsigned short*)(row + 2048 + 2 * lane); }
}
__device__ __forceinline__ void peer_comp(const u32x4 (&ur)[4], const u32x4 (&vr)[4], const unsigned (&vs)[4], const float (&gq)[4], const f32x2 (&xf)[16], f32x2 (&y2)[16], int lane) {
    float d[4];
#pragma unroll
    for (int q = 0; q < 4; ++q) { f32x2 t = {0.f, 0.f};
#pragma unroll
        for (int j = 0; j < 4; ++j) { const unsigned uw = ur[q][j];
            t += __builtin_amdgcn_cvt_scalef32_pk_f32_fp4(uw, 1.0f, 0) * xf[4 * j + 0]; t += __builtin_amdgcn_cvt_scalef32_pk_f32_fp4(uw, 1.0f, 1) * xf[4 * j + 1];
            t += __builtin_amdgcn_cvt_scalef32_pk_f32_fp4(uw, 1.0f, 2) * xf[4 * j + 2]; t += __builtin_amdgcn_cvt_scalef32_pk_f32_fp4(uw, 1.0f, 3) * xf[4 * j + 3]; }
        d[q] = (t.x + t.y) * uv_scale(vs[q] & 255u); }
#pragma unroll
    for (int o = 32; o >= 1; o >>= 1) {
#pragma unroll
        for (int q = 0; q < 4; ++q) d[q] += shx(d[q], o, lane); }
#pragma unroll
    for (int q = 0; q < 4; ++q) { const float w = gq[q] * gelu_as(d[q]) * uv_scale(vs[q] >> 8);
        const f32x2 w2 = {w, w};
#pragma unroll
        for (int j = 0; j < 4; ++j) { const unsigned vw = vr[q][j];
            y2[4 * j + 0] += w2 * __builtin_amdgcn_cvt_scalef32_pk_f32_fp4(vw, 1.0f, 0); y2[4 * j + 1] += w2 * __builtin_amdgcn_cvt_scalef32_pk_f32_fp4(vw, 1.0f, 1);
            y2[4 * j + 2] += w2 * __builtin_amdgcn_cvt_scalef32_pk_f32_fp4(vw, 1.0f, 2); y2[4 * j + 3] += w2 * __builtin_amdgcn_cvt_scalef32_pk_f32_fp4(vw, 1.0f, 3); } }
}
__device__ __forceinline__ unsigned inv_ordkey(unsigned k) { return (k & 0x80000000u) ? (k & 0x7fffffffu) : ~k; }
template <int B> __device__ __forceinline__ void bit_transpose32(unsigned (&A)[64]) {
#pragma unroll
    for (int k = 0; k < 16; ++k) { const unsigned a = A[B + k], b = A[B + k + 16]; A[B + k] = __builtin_amdgcn_perm(b, a, 0x05040100u); A[B + k + 16] = __builtin_amdgcn_perm(b, a, 0x07060302u); }
#pragma unroll
    for (int k = 0; k < 32; ++k) if (!(k & 8)) { const unsigned a = A[B + k], b = A[B + k + 8]; A[B + k] = __builtin_amdgcn_perm(b, a, 0x06020400u); A[B + k + 8] = __builtin_amdgcn_perm(b, a, 0x07030501u); }
#pragma unroll
    for (int k = 0; k < 32; ++k) if (!(k & 4)) { const unsigned a = A[B + k], b = A[B + k + 4]; A[B + k] = (a & 0x0F0F0F0Fu) | ((b << 4) & 0xF0F0F0F0u); A[B + k + 4] = ((a >> 4) & 0x0F0F0F0Fu) | (b & 0xF0F0F0F0u); }
#pragma unroll
    for (int k = 0; k < 32; ++k) if (!(k & 2)) { const unsigned a = A[B + k], b = A[B + k + 2]; A[B + k] = (a & 0x33333333u) | ((b << 2) & 0xCCCCCCCCu); A[B + k + 2] = ((a >> 2) & 0x33333333u) | (b & 0xCCCCCCCCu); }
#pragma unroll
    for (int k = 0; k < 32; ++k) if (!(k & 1)) { const unsigned a = A[B + k], b = A[B + k + 1]; A[B + k] = (a & 0x55555555u) | ((b << 1) & 0xAAAAAAAAu); A[B + k + 1] = ((a >> 1) & 0x55555555u) | (b & 0xAAAAAAAAu); }
}
template <int GRP> __device__ __forceinline__ unsigned lane_radix16(const unsigned (&key)[64], int lane, int& own) {
    unsigned P[64];
#pragma unroll
    for (int n = 0; n < 64; ++n) P[n] = key[n];
    bit_transpose32<0>(P); bit_transpose32<32>(P);
    unsigned T = 0u, act_lo = ~0u, act_hi = ~0u; int above = 0; bool done = false;
#pragma unroll
    for (int bit = 31; bit >= 0; --bit) {
        const unsigned m_lo = act_lo & P[bit], m_hi = act_hi & P[32 + bit];
        const int mine = above + __builtin_popcount(m_lo) + __builtin_popcount(m_hi);
        int tot = mine + __builtin_amdgcn_ds_bpermute((lane ^ 1) << 2, mine);
        if (GRP >= 4) tot += __builtin_amdgcn_ds_bpermute((lane ^ 2) << 2, tot);
        const bool ge = tot >= 16;
        if (ge && !done) T |= 1u << bit;
        act_lo = ge ? m_lo : act_lo & ~m_lo; act_hi = ge ? m_hi : act_hi & ~m_hi;
        above = ge ? above : mine;
        if (tot == 16) { above = mine; act_lo = 0u; act_hi = 0u; done = true; }
        if (__all(done)) break; }
    own = above + __builtin_popcount(act_lo) + __builtin_popcount(act_hi);
    return T;
}
template <int N> __device__ __forceinline__ void compact_ge(const unsigned (&key)[N], unsigned T, int pos, unsigned base, unsigned dump) {
#pragma unroll
    for (int n = 0; n < N; n += 2) { unsigned long long m0, m1; unsigned a0, a1;
        asm("v_cmp_ge_u32_e64 %3, %5, %7\n\tv_cmp_ge_u32_e64 %4, %6, %7\n\tv_lshl_add_u32 %1, %0, 2, %8\n\tv_cndmask_b32_e64 %1, %9, %1, %3\n\tv_addc_co_u32_e64 %0, vcc, 0, %0, %3\n\t"
            "v_lshl_add_u32 %2, %0, 2, %8\n\tv_cndmask_b32_e64 %2, %9, %2, %4\n\tv_addc_co_u32_e64 %0, vcc, 0, %0, %4"
            : "+v"(pos), "=&v"(a0), "=&v"(a1), "=&s"(m0), "=&s"(m1) : "v"(key[n]), "v"(key[n + 1]), "v"(T), "v"(base), "v"(dump) : "vcc");
        *(LAS unsigned*)(size_t)a0 = key[n]; *(LAS unsigned*)(size_t)a1 = key[n + 1]; }
}
template <int MODE> __device__ __forceinline__ void ph_peer(const Ctx& F0, int layer) {
    const Ctx F = phase_ctx(F0);
    using namespace cf;
    const float* SC = (const float*)(F.ws + WS_P + SC_OFF); const float* X1 = (const float*)(F.ws + WS_X1);
    bf16_t* HB = WSP(bf16_t, WS_HB); const unsigned char* UV = WSP(const unsigned char, WS_UB) + (size_t)layer * NEXP * UV_ROW;
    const float* lg = F.in[I_LN2G] + layer * 2048; const float* lb = F.in[I_LN2B] + layer * 2048;
    const int ntok = layer == 0 ? MR : NB * S;
    constexpr int NSLOT = 34;
    ldsp_t ring = F.lds;
#ifndef NPROD
#define NPROD 2
#endif
    const int pw = F.wave - (8 - NPROD);
    ldsp_t pscr = F.lds + 73728 + (pw < 0 ? 0 : pw) * 6144;
    LAS unsigned* lstA = (LAS unsigned*)(pscr);
    LAS unsigned* lstB = (LAS unsigned*)(pscr + 2176);
    LAS unsigned* dmp = (LAS unsigned*)(pscr + 3200);
    volatile LAS unsigned* ready = (volatile LAS unsigned*)(F.lds + 71680); LAS unsigned* next_tok = (LAS unsigned*)(F.lds + 71680 + NSLOT * 4);
    __syncthreads();
    if (F.tid < NSLOT + 1) ((LAS unsigned*)(F.lds + 71680))[F.tid] = 0u;
    __syncthreads();
    const int ntw = ntok / F.G;
    if (pw >= 0) {
      for (int p = pw; p < ntw / 2; p += NPROD) {
        const int slot = p;
        LAS int* ei4 = (LAS int*)(ring + slot * 2048); LAS float* eg4 = (LAS float*)(ring + slot * 2048 + 512);
        const int tok0 = F.bid + (2 * p) * F.G, nwv = F.G;
        if (MODE != 2) {
        { int lane = F.lane; asm volatile("" : "+v"(lane));
          const int t2 = lane >> 5, set = lane >> 1, sset = set & 15, part = lane & 1;
          const int Rl = tok_row(layer, tok0 + t2 * nwv);
          unsigned key[64];
          const float* sp = SC + (size_t)Rl * 2048 + sset * 128 + part * 64;
#pragma unroll
          for (int i = 0; i < 16; ++i) { const f32x4 v = *(const f32x4*)(sp + 4 * i);
#pragma unroll
              for (int e = 0; e < 4; ++e) key[4 * i + e] = (ordkey(v[e]) & ~127u) | (unsigned)(127 - (64 * part + 4 * i + e)); }
          int own; const unsigned T = lane_radix16<2>(key, lane, own);
          const int oth = __builtin_amdgcn_ds_bpermute((lane ^ 1) << 2, own);
          compact_ge<64>(key, T, part ? oth : 0, (unsigned)(size_t)lstA + set * 68, (unsigned)(size_t)dmp + lane * 4);
        }
        asm volatile("s_waitcnt lgkmcnt(0)" ::: "memory");
        {
          int lane = F.lane; asm volatile("" : "+v"(lane));
          const int q = lane & 3, sa = (lane >> 2) * 2, sb = sa + 1;
          float Av[4], Bv[16];
#pragma unroll
          for (int i = 0; i < 4; ++i) Av[i] = __uint_as_float(inv_ordkey((lstA[sa * 17 + 4 * q + i] & ~127u) | 64u));
#pragma unroll
          for (int jx = 0; jx < 16; ++jx) Bv[jx] = __uint_as_float(inv_ordkey((lstA[sb * 17 + jx] & ~127u) | 64u));
          unsigned key[64];
#pragma unroll
          for (int i = 0; i < 4; ++i)
#pragma unroll
              for (int jx = 0; jx < 16; ++jx) key[i * 16 + jx] = (ordkey(Av[i] + Bv[jx]) & ~255u) | (unsigned)(255 - ((4 * q + i) * 16 + jx));
          int mine; const unsigned T = lane_radix16<4>(key, lane, mine);
          const int c1 = __builtin_amdgcn_ds_bpermute((lane ^ 1) << 2, mine), c2 = __builtin_amdgcn_ds_bpermute((lane ^ 2) << 2, mine), c3 = __builtin_amdgcn_ds_bpermute((lane ^ 3) << 2, mine);
          const int c = (q == 1) ? c1 : (q == 2) ? c2 + c3 : (q == 3) ? c1 + c2 + c3 : 0;
          compact_ge<64>(key, T, c, (unsigned)(size_t)lstB + (lane >> 2) * 64, (unsigned)(size_t)dmp + lane * 4);
        }
        asm volatile("s_waitcnt lgkmcnt(0)" ::: "memory");
        { int lane = F.lane; asm volatile("" : "+v"(lane));
#pragma unroll
        for (int rnd = 0; rnd < 4; ++rnd) { const int e = lane + 64 * rnd; const unsigned kk = lstB[e];
            const int cidx = (int)(~kk & 255u), sa = (e >> 4) * 2;
            const unsigned ka = lstA[sa * 17 + (cidx >> 4)], kb = lstA[(sa + 1) * 17 + (cidx & 15)];
            const float sv = __uint_as_float(inv_ordkey((ka & ~127u) | 64u)) + __uint_as_float(inv_ordkey((kb & ~127u) | 64u));
            float m = sv; m = fmaxf(m, shx(m, 1, lane)); m = fmaxf(m, shx(m, 2, lane)); m = fmaxf(m, shx(m, 4, lane)); m = fmaxf(m, shx(m, 8, lane));
            const float ex = __expf(sv - m); float sum = ex; sum += shx(sum, 1, lane); sum += shx(sum, 2, lane); sum += shx(sum, 4, lane); sum += shx(sum, 8, lane);
            ei4[(e >> 7) * 256 + (e & 127)] = (int)((~ka & 127u) * 128u + (~kb & 127u));
            eg4[(e >> 7) * 256 + (e & 127)] = ex / sum; } }
        }
        asm volatile("s_waitcnt lgkmcnt(0)" ::: "memory");
        if (F.lane == 0) ready[slot] = (unsigned)(p + 1);
      }
    }
    {
      for (;;) {
        unsigned tq = 0u; if (F.lane == 0) tq = __hip_atomic_fetch_add(next_tok, 1u, __ATOMIC_RELAXED, __HIP_MEMORY_SCOPE_WORKGROUP);
        const int t = __builtin_amdgcn_readfirstlane((int)tq);
        if (t >= ntw) break;
        const int p = t >> 1, slot = p, tslot = t & 1;
        while (ready[slot] < (unsigned)(p + 1)) __builtin_amdgcn_s_sleep(2);
        asm volatile("" ::: "memory");
        if (MODE == 1) continue;
        int zst = 0; if (MODE == 2) asm volatile("" : "+s"(zst));
        const int tok = F.bid + t * F.G;
        int lane = F.lane; asm volatile("" : "+v"(lane));
        const int R = tok_row(layer, tok), b = R / RB, j = R % RB; const bool isctx = j < CTX; const int modrow = isctx ? 4 : b;
        const LAS int* ei = (const LAS int*)(ring + slot * 2048 + tslot * 1024); const LAS float* eg = (const LAS float*)(ring + slot * 2048 + tslot * 1024 + 512);
        f32x2 xf[16];
#pragma unroll
        for (int k = 0; k < 4; ++k) { const u32x4 w = *(const u32x4*)(HB + (size_t)R * 2048 + lane * 32 + 8 * k);
            xf[4 * k + 0] = (f32x2){bflo(w.x), bfhi(w.x)}; xf[4 * k + 1] = (f32x2){bflo(w.y), bfhi(w.y)};
            xf[4 * k + 2] = (f32x2){bflo(w.z), bfhi(w.z)}; xf[4 * k + 3] = (f32x2){bflo(w.w), bfhi(w.w)}; }
        f32x2 y2[16];
#pragma unroll
        for (int i = 0; i < 16; ++i) y2[i] = (f32x2){0.f, 0.f};
        f32x4 xrow[8];
#pragma unroll
        for (int k = 0; k < 8; ++k) xrow[k] = *(const f32x4*)(X1 + (size_t)R * 2048 + lane * 32 + 4 * k);
        { u32x4 urA[4], vrA[4], urB[4], vrB[4]; unsigned vsA[4], vsB[4]; float gqA[4], gqB[4];
          peer_load(urA, vrA, vsA, gqA, ei, eg, UV, lane, 0);
          for (int grp = 0; grp < 32; grp += 2) {
              peer_load(urB, vrB, vsB, gqB, ei, eg, UV, lane, grp + 1);
              peer_comp(urA, vrA, vsA, gqA, xf, y2, lane);
              peer_load(urA, vrA, vsA, gqA, ei, eg, UV, lane, grp + 2 < 32 ? grp + 2 : 31);
              peer_comp(urB, vrB, vsB, gqB, xf, y2, lane);
          } }
        const float* mod = WSP(const float, WS_MOD) + ((size_t)layer * 5 + modrow) * 12288;
        float y[32];
        float s = 0.f;
#pragma unroll
        for (int k = 0; k < 8; ++k) { const int c = lane * 32 + 4 * k;
            const f32x4 xa = xrow[k], ga = *(const f32x4*)(mod + 5 * 2048 + c);
            y[4 * k + 0] = ALPHA * xa[0] + ga[0] * y2[2 * k].x; y[4 * k + 1] = ALPHA * xa[1] + ga[1] * y2[2 * k].y;
            y[4 * k + 2] = ALPHA * xa[2] + ga[2] * y2[2 * k + 1].x; y[4 * k + 3] = ALPHA * xa[3] + ga[3] * y2[2 * k + 1].y;
            s += (y[4 * k + 0] + y[4 * k + 1]) + (y[4 * k + 2] + y[4 * k + 3]); }
        const float mean = wave_sum(s, lane) * (1.f / 2048.f); float q2 = 0.f;
#pragma unroll
        for (int i = 0; i < 32; ++i) { const float dd = y[i] - mean; q2 += dd * dd; }
        const float rstd = rsqrtf(wave_sum(q2, lane) * (1.f / 2048.f) + 1e-5f);
        if (MODE == 2 && zst == 0) continue;
        float* dst = layer == 0 ? (isctx ? WSP(float, WS_XC) + ((size_t)b * CTX + j) * 2048 : F.out + ((size_t)b * S + (j - CTX)) * 2048) : F.out + ((size_t)b * S + (j - CTX)) * 2048;
        const float* modn = WSP(const float, WS_MOD) + ((size_t)1 * 5 + modrow) * 12288;
#pragma unroll
        for (int kk = 0; kk < 4; ++kk) { f32x4 o[2];
#pragma unroll
            for (int jj = 0; jj < 2; ++jj) { const int k = 2 * kk + jj, c = lane * 32 + 4 * k; const f32x4 la = *(const f32x4*)(lg + c), ba = *(const f32x4*)(lb + c);
#pragma unroll
                for (int e = 0; e < 4; ++e) o[jj][e] = (y[4 * k + e] - mean) * rstd * la[e] + ba[e];
                *(f32x4*)(dst + c) = o[jj]; }
            if (layer == 0) {
                const int c = lane * 32 + 8 * kk;
                const f32x4 sa = *(const f32x4*)(modn + 2048 + c), sb = *(const f32x4*)(modn + 2048 + c + 4), ha = *(const f32x4*)(modn + c), hb = *(const f32x4*)(modn + c + 4);
                *(u32x4*)(HB + (size_t)R * 2048 + c) = pg8::pack8(o[0] * (sa + 1.0f) + ha, o[1] * (sb + 1.0f) + hb); } }
      }
    }
}

struct Params { const float* in[cf::N_IN]; float* out; unsigned char* ws; int ph_lo, ph_hi; };

__global__ void __launch_bounds__(512, 2) mega_fwd(Params p) {
    using namespace cf;
    extern __shared__ __attribute__((aligned(16))) unsigned char smem[];
    Ctx F0;
    F0.in = p.in;
    F0.out = p.out; F0.ws = p.ws; F0.lds = (ldsp_t)smem;
    F0.tid = 0; F0.lane = 0; F0.wave = __builtin_amdgcn_readfirstlane(threadIdx.x >> 6); F0.G = gridDim.x; F0.bid = blockIdx.x;
    if (threadIdx.x < 64) ((LAS unsigned*)(F0.lds + MISC_OFF))[threadIdx.x] = 0u;
    __syncthreads();
    const int lo = p.ph_lo, hi = p.ph_hi;
    XcdBarrier bar; bar.bar = (unsigned*)(F0.ws + WS_CTL); bar.x = 0; bar.st = (volatile LAS unsigned*)(F0.lds + MISC_OFF); bar.wave = F0.wave;
    if (hi - lo > 1) bar = xcd_barrier_post((unsigned*)(F0.ws + WS_CTL), (volatile LAS unsigned*)(F0.lds + MISC_OFF), F0.wave);
#ifndef MK_MASK
#define MK_MASK 0xFFFF
#endif
#define ON(j) ((MK_MASK >> (j)) & 1)
#define IN(k) (lo <= (k) && (k) < hi)
#define SEAM(k) do { if (IN(k) && IN((k) + 1)) xcd_barrier(bar); } while (0)

    if (ON(9) && IN(0)) { ph_prologue(F0); if (DUPN(9) == 2) { __syncthreads(); ph_prologue(F0); } }
    SEAM(0);
    if (ON(10) && IN(1)) ph_modulate0(F0);
    SEAM(1);
    for (int l = 0; l < DEPTH; ++l) {
        const int pb = 2 + 8 * l;
        const int rmode = l == 0 ? 0 : 1, nMl = l == 0 ? 68 : 64;
        for (int blk = 0; blk < DUPN(12); ++blk) {
        if (blk) xcd_barrier(bar);
        if (ON(0) && IN(pb + 0)) { const Ctx F = phase_ctx(F0);
            pg8::Gemm g{WSP(const bf16_t, WS_HB), WSP(const bf16_t, WS_WIN) + (size_t)l * NC * 2048, 2048, 2048};
            pg8::EpiInProj E{WSP(bf16_t, WS_P), WSP(bf16_t, WS_KB), WSP(const float, WS_COSH), WSP(const float, WS_SINH), WSP(const float, WS_COSR), WSP(const float, WS_SINR),
                             F.in[I_AKN] + l * 128, F.in[I_AQN] + l * 128, WSP(float, WS_SSK), WSP(float, WS_SSQ), WSP(float, WS_SSKV), WSP(float, WS_SSCQ)};
            pg8::TileOrder S; S.init(nMl, 56, F.G, F.bid, rmode);
            for (int dup = 0; dup < DUPN(0); ++dup) {
#ifdef MK_PITCH
            if (DUPN(0) == 2 && dup == 0) { pg8::Gemm g2 = g; g2.lda = MK_PITCH; g2.ldb = MK_PITCH; pg8::gemm_phase(F.lds, g2, S, E, F.wave); continue; }
#endif
            pg8::gemm_phase(F.lds, g, S, E, F.wave); }
            if (l > 0) { pg8::TileOrder S2; S2.init(4, 6, F.G, F.bid, 2); pg8::gemm_phase(F.lds, g, S2, E, F.wave); }
        }
        SEAM(pb + 0);
        if (ON(2) && IN(pb + 1)) { const Ctx F = phase_ctx(F0); bf16_t* P = WSP(bf16_t, WS_P);
            knorm_pass(F);
            { pg8::Gemm g{P + PC_CKV, WSP(const bf16_t, WS_WKVUP) + (size_t)l * 2048 * 256, NC, 256}; pg8::EpiKvUp E{WSP(bf16_t, WS_KB), WSP(bf16_t, WS_VB), WSP(const float, WS_SSKV)};
              pg8::TileOrder S; S.init(68, 8, F.G, F.bid, 0); for (int dup = 0; dup < DUPN(1); ++dup) pg8::gemm_phase(F.lds, g, S, E, F.wave); }
            { pg8::Gemm g{P + PC_CQ, WSP(const bf16_t, WS_WQUP) + (size_t)l * 1536 * 512, NC, 512}; pg8::EpiQUp E{WSP(bf16_t, WS_QB), WSP(const float, WS_COSR), WSP(const float, WS_SINR), WSP(const float, WS_SSCQ)};
              pg8::TileOrder S; S.init(nMl, 6, F.G, F.bid, rmode); for (int dup = 0; dup < DUPN(1); ++dup) pg8::gemm_phase(F.lds, g, S, E, F.wave); }
        }
        SEAM(pb + 1);
        if (ON(3) && IN(pb + 2)) ph_attn(F0, l);
        }
        SEAM(pb + 2);
        unsigned* pctr = (unsigned*)(F0.ws + WS_CTL + 16384);
        if (ON(4) && IN(pb + 3)) { const Ctx F = phase_ctx(F0); bf16_t* P = WSP(bf16_t, WS_P); bf16_t* HB = WSP(bf16_t, WS_HB);
            pg8::Gemm g{WSP(const bf16_t, WS_BR), WSP(const bf16_t, WS_WBR) + (size_t)l * 4 * 2048 * 1024, 4096, 1024};
            pg8::EpiMerge E{HB, P + PC_GATE, NC};
            { pg8::CtrOrder S; S.init(64, 8, F.G, F.bid, 1, 4, (size_t)1024 * 2, (size_t)2048 * 1024 * 2); S.wave = F.wave; S.pub = l == 0 ? pctr : nullptr;
              for (int dup = 0; dup < DUPN(5); ++dup) pg8::gemm_phase(F.lds, g, S, E, F.wave); }
            if (l == 0) { pg8::CtrOrder S; S.init(4, 8, F.G, F.bid, 2, 4, (size_t)1024 * 2, (size_t)2048 * 1024 * 2); S.wave = F.wave; S.pub = pctr;
              pg8::gemm_phase(F.lds, g, S, E, F.wave); }
        }
        if (l != 0) SEAM(pb + 3);
        if (ON(5) && IN(pb + 4)) { const Ctx F = phase_ctx(F0); bf16_t* HB = WSP(bf16_t, WS_HB);
            pg8::Gemm g{HB, WSP(const bf16_t, WS_WO) + (size_t)l * 2048 * 2048, 2048, 2048};
            pg8::EpiWo E{(float*)(F.ws + WS_X1), WSP(const float, WS_MOD) + (size_t)l * 5 * 12288, l == 0 ? F.in[I_X] : (const float*)F.out, F.in[I_CTX]};
            if (l != 0 || F.bid >= 32) { pg8::CtrOrder S; if (l == 0) { S.init(64, 8, F.G - 32, F.bid - 32, 1); S.ready = pctr; S.need = 64u; } else S.init(64, 8, F.G, F.bid, 1); S.wave = F.wave;
              for (int dup = 0; dup < DUPN(6); ++dup) pg8::gemm_phase(F.lds, g, S, E, F.wave); }
            if (l == 0) { pg8::CtrOrder S; S.init(4, 8, F.G, F.bid, 2); S.wave = F.wave; S.ready = pctr; S.need = 64u;
              pg8::gemm_phase(F.lds, g, S, E, F.wave); }
        }
        SEAM(pb + 4);
        if (ON(6) && IN(pb + 5)) ph_ln1(F0, l);
        SEAM(pb + 5);
        if (ON(7) && IN(pb + 6)) { const Ctx F = phase_ctx(F0); bf16_t* HB = WSP(bf16_t, WS_HB);
            pg8::Gemm g{HB, WSP(const bf16_t, WS_WFOLD) + (size_t)l * 2048 * 2048, 2048, 2048}; pg8::EpiF32 E{(float*)(F.ws + WS_P + SC_OFF), 2048};
            pg8::TileOrder S; S.init(nMl, 8, F.G, F.bid, rmode); for (int dup = 0; dup < DUPN(7); ++dup) pg8::gemm_phase(F.lds, g, S, E, F.wave);
        }
        SEAM(pb + 6);
        if (ON(8) && IN(pb + 7)) { ph_peer<0>(F0, l); if (DUPN(8) == 2 && l == 1) ph_peer<MK_PV>(F0, l); }
        SEAM(pb + 7);
    }
#undef IN
#undef SEAM
}

extern "C" void kernel_launch(void* const* d_in, const int* in_sizes, int n_in, void* d_out, int out_size, void* d_ws, size_t ws_size, hipStream_t stream) {
    static int grid = 0;
    if (grid == 0) {
        if (n_in != cf::N_IN || out_size != cf::NB * cf::S * cf::D || ws_size < cf::WS_END) {
            fprintf(stderr, "kernel_launch: unexpected shapes: n_in %d out %d ws %zu (need %zu)\n", n_in, out_size, ws_size, (size_t)cf::WS_END); grid = -1; return; }
        int dev = 0, cus = 0;
        if (hipGetDevice(&dev) != hipSuccess || hipDeviceGetAttribute(&cus, hipDeviceAttributeMultiprocessorCount, dev) != hipSuccess || cus < 1) { grid = -1; return; }
        if (hipFuncSetAttribute((const void*)mega_fwd, hipFuncAttributeMaxDynamicSharedMemorySize, cf::LDS_BYTES) != hipSuccess) { fprintf(stderr, "kernel_launch: hipFuncSetAttribute failed\n"); grid = -1; return; }
        int per_cu = 0;
        if (hipOccupancyMaxActiveBlocksPerMultiprocessor(&per_cu, (const void*)mega_fwd, 512, cf::LDS_BYTES) != hipSuccess || per_cu < 1)
            fprintf(stderr, "kernel_launch: note: occupancy query reports %d workgroups per CU\n", per_cu);
        (void)hipGetLastError();
        grid = cus;
    }
    if (grid < 0) return;
    (void)hipMemsetAsync((char*)d_ws + cf::WS_CTL, 0, cf::CTL_BYTES, stream);
    Params p{};
    for (int i = 0; i < cf::N_IN; ++i) p.in[i] = (const float*)d_in[i];
    p.out = (float*)d_out; p.ws = (unsigned char*)d_ws;
#if MK_PER_PHASE
    for (int k = 0; k < cf::N_PHASES; ++k) { p.ph_lo = k; p.ph_hi = k + 1; hipLaunchKernelGGL(mega_fwd, dim3(grid), dim3(512), cf::LDS_BYTES, stream, p); }
#else
    p.ph_lo = 0; p.ph_hi = cf::N_PHASES;
    hipLaunchKernelGGL(mega_fwd, dim3(grid), dim3(512), cf::LDS_BYTES, stream, p);
#endif
    const hipError_t le = hipPeekAtLastError();
    if (le != hipSuccess) fprintf(stderr, "kernel_launch: launch failed: %s\n", hipGetErrorName(le));
}
```
